# Optimizing an MI355X kernel written in HIP

```python
import math
import numpy as np
import jax
import jax.numpy as jnp
from jax import lax

D_MODEL = 1024
BATCH = 8
SEQ = 4096
DEPTH = 2

CTX_LEN = 256
GRID_W = 64

SSD_HEADS = 8
SSD_HEAD_DIM = 64
SSD_WIDTH = SSD_HEADS * SSD_HEAD_DIM
SSD_GROUPS = 2
SSD_STATE = 64
SSD_CONV = 5
SSD_CHUNK = 128
SSD_XBC = SSD_WIDTH + 2 * SSD_GROUPS * SSD_STATE
DT_MIN = 0.001
DT_MAX = 0.1

GLA_HEADS = 4
GLA_KEY_DIM = 64
GLA_VAL_DIM = 128
GLA_QK = GLA_HEADS * GLA_KEY_DIM
GLA_WIDTH = GLA_HEADS * GLA_VAL_DIM
GLA_GATE_RANK = 16
GLA_GATE_NORM = 16.0
GLA_CHUNK = 64

MIX_WIDTH = SSD_WIDTH + GLA_WIDTH
IN_DIM = SSD_WIDTH + SSD_XBC + SSD_HEADS + 2 * GLA_QK + 2 * GLA_WIDTH + GLA_GATE_RANK

N_EXPERTS = 32
N_EXPERT_GROUPS = 8
EXPERTS_PER_GROUP = N_EXPERTS // N_EXPERT_GROUPS
TOP_K = 2
EXPERT_FF = 512
MOE_BLOCK = 128

NORM_EPS = 1e-6

kernel_name = 'hybrid_ssd_gla_moe_prefix_dit'


def rmsnorm(x, gain):
    xf = x.astype(jnp.float32)
    y = xf * lax.rsqrt(jnp.mean(xf * xf, axis=-1, keepdims=True) + NORM_EPS)
    return (y * gain.astype(jnp.float32)).astype(x.dtype)


def modulate(h, shift, scale):
    return h * (1.0 + scale) + shift


def dwconv_centred(u, w, b):
    K, C = w.shape
    pad = K // 2
    y = lax.conv_general_dilated(u, w[:, None, :].astype(u.dtype), window_strides=(1,),
                                 padding=[(pad, K - 1 - pad)],
                                 dimension_numbers=('NWC', 'WIO', 'NWC'),
                                 feature_group_count=C)
    return y + b


def conv_latent(u, w, b):
    Bsz, L, C = u.shape
    rows = L // GRID_W
    y = dwconv_centred(u.reshape(Bsz * rows, GRID_W, C), w, b)
    return y.reshape(Bsz, L, C)


def ssd_scan(x, dt, Bm, Cm, A, h0, with_output):
    f32 = jnp.float32
    Bsz, L, H, P = x.shape
    G, N = Bm.shape[2], Bm.shape[3]
    Q = SSD_CHUNK
    nc = L // Q
    xc = x.astype(f32).reshape(Bsz, nc, Q, H, P)
    dtc = dt.astype(f32).reshape(Bsz, nc, Q, H)
    Bc = jnp.repeat(Bm.astype(f32), H // G, axis=2).reshape(Bsz, nc, Q, H, N)
    Cc = jnp.repeat(Cm.astype(f32), H // G, axis=2).reshape(Bsz, nc, Q, H, N)
    a_cs = jnp.cumsum(dtc * A.astype(f32), axis=2)
    a_end = a_cs[:, :, -1]
    w_end = jnp.exp(a_end[:, :, None] - a_cs) * dtc
    chunk_states = jnp.einsum('bcjh,bcjhn,bcjhp->bchpn', w_end, Bc, xc)

    def step(h, inp):
        decay, s = inp
        return decay[..., None, None] * h + s, h

    h_final, h_in = lax.scan(step, h0.astype(f32),
                             (jnp.moveaxis(jnp.exp(a_end), 1, 0), jnp.moveaxis(chunk_states, 1, 0)))
    if not with_output:
        return None, h_final
    h_in = jnp.moveaxis(h_in, 0, 1)
    causal = jnp.tril(jnp.ones((Q, Q), dtype=bool))
    seg = a_cs[:, :, :, None, :] - a_cs[:, :, None, :, :]
    decay_ij = jnp.exp(jnp.where(causal[None, None, :, :, None], seg, -jnp.inf))
    scores = jnp.einsum('bcihn,bcjhn->bcijh', Cc, Bc) * decay_ij * dtc[:, :, None, :, :]
    y = jnp.einsum('bcijh,bcjhp->bcihp', scores, xc)
    y = y + jnp.einsum('bcihn,bchpn->bcihp', Cc, h_in) * jnp.exp(a_cs)[..., None]
    return y.reshape(Bsz, L, H, P).astype(x.dtype), h_final


def gla_scan(q, k, v, g, S0, with_output):
    f32 = jnp.float32
    Bsz, L, H, K = q.shape
    V = v.shape[-1]
    Q = GLA_CHUNK
    nc = L // Q
    qc = (q.astype(f32) * (K ** -0.5)).reshape(Bsz, nc, Q, H, K)
    kc = k.astype(f32).reshape(Bsz, nc, Q, H, K)
    vc = v.astype(f32).reshape(Bsz, nc, Q, H, V)
    b = jnp.cumsum(g.astype(f32).reshape(Bsz, nc, Q, H, K), axis=2)
    b_end = b[:, :, -1]
    k_end = kc * jnp.exp(b_end[:, :, None] - b)
    chunk_states = jnp.einsum('bcjhk,bcjhv->bchkv', k_end, vc)

    def step(S, inp):
        decay, s = inp
        return decay[..., None] * S + s, S

    S_final, S_in = lax.scan(step, S0.astype(f32),
                             (jnp.moveaxis(jnp.exp(b_end), 1, 0), jnp.moveaxis(chunk_states, 1, 0)))
    if not with_output:
        return None, S_final
    S_in = jnp.moveaxis(S_in, 0, 1)
    q_dec = qc * jnp.exp(b)
    k_inv = kc * jnp.exp(-b)
    causal = jnp.tril(jnp.ones((Q, Q), dtype=bool))
    attn = jnp.where(causal, jnp.einsum('bcihk,bcjhk->bchij', q_dec, k_inv), 0.0)
    o = jnp.einsum('bchij,bcjhv->bcihv', attn, vc) + jnp.einsum('bcihk,bchkv->bcihv', q_dec, S_in)
    return o.reshape(Bsz, L, H, V).astype(q.dtype), S_final


def run_scan(scan_fn, seqs, params, state0, reverse, with_output):
    if reverse:
        seqs = [jnp.flip(s, axis=1) for s in seqs]
    y, state = scan_fn(*seqs, *params, state0, with_output)
    if reverse and with_output:
        y = jnp.flip(y, axis=1)
    return y, state


def mixer_inputs(h, p, conv_fn):
    f32 = jnp.float32
    Bsz, L, _ = h.shape
    sizes = [SSD_WIDTH, SSD_XBC, SSD_HEADS, GLA_QK, GLA_QK, GLA_WIDTH, GLA_WIDTH, GLA_GATE_RANK]
    offsets = np.cumsum(sizes)[:-1].tolist()
    z, xbc, dt_raw, q, k, v, g_out, gk_low = jnp.split(h @ p['w_in'], offsets, axis=-1)
    xbc = jax.nn.silu(conv_fn(xbc, p['conv_w'], p['conv_b']))
    xs, bm, cm = jnp.split(xbc, [SSD_WIDTH, SSD_WIDTH + SSD_GROUPS * SSD_STATE], axis=-1)
    gf = jax.nn.log_sigmoid((gk_low @ p['gk_up_f'] + p['gk_bias_f']).astype(f32)) / GLA_GATE_NORM
    gb = jax.nn.log_sigmoid((gk_low @ p['gk_up_b'] + p['gk_bias_b']).astype(f32)) / GLA_GATE_NORM

    def heads(t, n, d):
        return t.reshape(Bsz, L, n, d)

    return {
        'z': z,
        'g_out': g_out,
        'x': heads(xs, SSD_HEADS, SSD_HEAD_DIM),
        'B': heads(bm, SSD_GROUPS, SSD_STATE),
        'C': heads(cm, SSD_GROUPS, SSD_STATE),
        'dt_f': jax.nn.softplus((dt_raw + p['dt_bias_f']).astype(f32)),
        'dt_b': jax.nn.softplus((dt_raw + p['dt_bias_b']).astype(f32)),
        'q': heads(q, GLA_HEADS, GLA_KEY_DIM),
        'k': heads(k, GLA_HEADS, GLA_KEY_DIM),
        'v': heads(v, GLA_HEADS, GLA_VAL_DIM),
        'g_f': heads(gf, GLA_HEADS, GLA_KEY_DIM),
        'g_b': heads(gb, GLA_HEADS, GLA_KEY_DIM),
    }


def merge_heads(m, y_ssd, o_gla, p):
    Bsz, L = m['z'].shape[:2]
    y = (y_ssd + p['d_skip'][:, None] * m['x']).reshape(Bsz, L, SSD_WIDTH)
    y = rmsnorm(y * jax.nn.silu(m['z']), p['ssd_norm_g'])
    o = rmsnorm(o_gla, p['gla_norm_g']).reshape(Bsz, L, GLA_WIDTH) * jax.nn.silu(m['g_out'])
    return jnp.concatenate([y, o], axis=-1) @ p['w_out']


def token_mixers(h_ctx, h_lat, p, ctx_out):
    mc = mixer_inputs(h_ctx, p, dwconv_centred)
    ml = mixer_inputs(h_lat, p, conv_latent)
    a_f = -jnp.exp(p['a_log_f'].astype(jnp.float32))
    a_b = -jnp.exp(p['a_log_b'].astype(jnp.float32))
    Bsz = h_lat.shape[0]
    hs0 = jnp.zeros((Bsz, SSD_HEADS, SSD_HEAD_DIM, SSD_STATE), jnp.float32)
    gs0 = jnp.zeros((Bsz, GLA_HEADS, GLA_KEY_DIM, GLA_VAL_DIM), jnp.float32)
    ysc_f, hs_f = run_scan(ssd_scan, [mc['x'], mc['dt_f'], mc['B'], mc['C']], [a_f], hs0, False, ctx_out)
    ysc_b, hs_b = run_scan(ssd_scan, [mc['x'], mc['dt_b'], mc['B'], mc['C']], [a_b], hs0, True, ctx_out)
    ysl_f, _ = run_scan(ssd_scan, [ml['x'], ml['dt_f'], ml['B'], ml['C']], [a_f], hs_f, False, True)
    ysl_b, _ = run_scan(ssd_scan, [ml['x'], ml['dt_b'], ml['B'], ml['C']], [a_b], hs_b, True, True)
    goc_f, gs_f = run_scan(gla_scan, [mc['q'], mc['k'], mc['v'], mc['g_f']], [], gs0, False, ctx_out)
    goc_b, gs_b = run_scan(gla_scan, [mc['q'], mc['k'], mc['v'], mc['g_b']], [], gs0, True, ctx_out)
    gol_f, _ = run_scan(gla_scan, [ml['q'], ml['k'], ml['v'], ml['g_f']], [], gs_f, False, True)
    gol_b, _ = run_scan(gla_scan, [ml['q'], ml['k'], ml['v'], ml['g_b']], [], gs_b, True, True)
    out_lat = merge_heads(ml, ysl_f + ysl_b, gol_f + gol_b, p)
    out_ctx = merge_heads(mc, ysc_f + ysc_b, goc_f + goc_b, p) if ctx_out else None
    return out_ctx, out_lat


def route(t, w_router, router_bias):
    T = t.shape[0]
    s = jax.nn.sigmoid((t @ w_router).astype(jnp.float32))
    sel = (s + router_bias.astype(jnp.float32)).reshape(T, N_EXPERT_GROUPS, EXPERTS_PER_GROUP)
    group_score = lax.top_k(sel, 2)[0].sum(axis=-1)
    grp = jnp.argmax(group_score, axis=-1)
    in_grp = sel[jnp.arange(T), grp]
    _, local = lax.top_k(in_grp, TOP_K)
    ids = grp[:, None] * EXPERTS_PER_GROUP + local
    w = jnp.take_along_axis(s, ids, axis=1)
    return ids, w / jnp.sum(w, axis=-1, keepdims=True)


def moe(t, w_router, router_bias, w_gate, w_up, w_down):
    T, D = t.shape
    ids, gates = route(t, w_router, router_bias)
    flat_e = ids.reshape(-1)
    order = jnp.argsort(flat_e)
    e_sorted = flat_e[order]
    tok = order // TOP_K
    counts = jnp.zeros((N_EXPERTS,), jnp.int32).at[flat_e].add(1)
    padded = (counts + MOE_BLOCK - 1) // MOE_BLOCK * MOE_BLOCK
    start = jnp.cumsum(counts) - counts
    pend = jnp.cumsum(padded)
    pstart = pend - padded
    dest = pstart[e_sorted] + jnp.arange(T * TOP_K) - start[e_sorted]
    n_blocks = -(-(T * TOP_K) // MOE_BLOCK) + N_EXPERTS
    buf = jnp.zeros((n_blocks * MOE_BLOCK, D), t.dtype).at[dest].set(t[tok])
    block_e = jnp.minimum(jnp.searchsorted(pend, jnp.arange(n_blocks) * MOE_BLOCK, side='right'),
                          N_EXPERTS - 1)

    def expert_block(args):
        xb, e = args
        return (jax.nn.silu(xb @ w_gate[e]) * (xb @ w_up[e])) @ w_down[e]

    yb = lax.map(expert_block, (buf.reshape(n_blocks, MOE_BLOCK, D), block_e))
    y = yb.reshape(-1, D)[dest] * gates.reshape(-1)[order][:, None].astype(t.dtype)
    return jnp.zeros_like(t).at[tok].add(y)


def setup_inputs(seed: int = 0) -> dict:
    key = jax.random.key(seed)
    ks = jax.random.split(key, 32)
    f32 = jnp.float32

    def nrm(k, shape, scale):
        return jax.random.normal(k, shape, f32) * scale

    def gain(k, shape):
        return 1.0 + 0.05 * jax.random.normal(k, shape, f32)

    def dt_bias(k):
        dt = jnp.exp(jax.random.uniform(k, (DEPTH, SSD_HEADS), f32,
                                        minval=math.log(DT_MIN), maxval=math.log(DT_MAX)))
        return dt + jnp.log(-jnp.expm1(-dt))

    def a_log(k):
        return jnp.log(jax.random.uniform(k, (DEPTH, SSD_HEADS), f32, minval=1.0, maxval=16.0))

    return {
        'x': nrm(ks[0], (BATCH, SEQ, D_MODEL), 1.0),
        'c': nrm(ks[1], (BATCH, D_MODEL), 1.0),
        'ctx': nrm(ks[2], (BATCH, CTX_LEN, D_MODEL), 1.0),
        'c_ctx': nrm(ks[3], (D_MODEL,), 1.0),
        'w_mod': nrm(ks[4], (DEPTH, D_MODEL, 6 * D_MODEL), 0.5 * D_MODEL ** -0.5),
        'b_mod': nrm(ks[5], (DEPTH, 6 * D_MODEL), 0.02),
        'norm1_g': gain(ks[6], (DEPTH, D_MODEL)),
        'norm2_g': gain(ks[7], (DEPTH, D_MODEL)),
        'w_in': nrm(ks[8], (DEPTH, D_MODEL, IN_DIM), D_MODEL ** -0.5),
        'conv_w': nrm(ks[9], (DEPTH, SSD_CONV, SSD_XBC), SSD_CONV ** -0.5),
        'conv_b': nrm(ks[10], (DEPTH, SSD_XBC), 0.02),
        'dt_bias_f': dt_bias(ks[11]),
        'dt_bias_b': dt_bias(ks[12]),
        'a_log_f': a_log(ks[13]),
        'a_log_b': a_log(ks[14]),
        'd_skip': gain(ks[15], (DEPTH, SSD_HEADS)),
        'ssd_norm_g': gain(ks[16], (DEPTH, SSD_WIDTH)),
        'gk_up_f': nrm(ks[17], (DEPTH, GLA_GATE_RANK, GLA_QK), GLA_GATE_RANK ** -0.5),
        'gk_bias_f': nrm(ks[18], (DEPTH, GLA_QK), 0.02),
        'gk_up_b': nrm(ks[19], (DEPTH, GLA_GATE_RANK, GLA_QK), GLA_GATE_RANK ** -0.5),
        'gk_bias_b': nrm(ks[20], (DEPTH, GLA_QK), 0.02),
        'gla_norm_g': gain(ks[21], (DEPTH, GLA_VAL_DIM)),
        'w_out': nrm(ks[22], (DEPTH, MIX_WIDTH, D_MODEL), MIX_WIDTH ** -0.5),
        'w_router': nrm(ks[23], (D_MODEL, N_EXPERTS), D_MODEL ** -0.5),
        'router_bias': nrm(ks[24], (N_EXPERTS,), 0.01),
        'w_gate': nrm(ks[25], (DEPTH, N_EXPERTS, D_MODEL, EXPERT_FF), D_MODEL ** -0.5),
        'w_up': nrm(ks[26], (DEPTH, N_EXPERTS, D_MODEL, EXPERT_FF), D_MODEL ** -0.5),
        'w_down': nrm(ks[27], (DEPTH, N_EXPERTS, EXPERT_FF, D_MODEL), EXPERT_FF ** -0.5),
        'final_norm_g': gain(ks[28], (D_MODEL,)),
    }


def reference(x, c, ctx, c_ctx, w_mod, b_mod, norm1_g, norm2_g, w_in, conv_w, conv_b,
              dt_bias_f, dt_bias_b, a_log_f, a_log_b, d_skip, ssd_norm_g, gk_up_f, gk_bias_f,
              gk_up_b, gk_bias_b, gla_norm_g, w_out, w_router, router_bias, w_gate, w_up, w_down,
              final_norm_g):
    sc = jax.nn.silu(c)
    scc = jax.nn.silu(c_ctx)
    for l in range(DEPTH):
        last = l == DEPTH - 1
        p = {
            'w_in': w_in[l], 'conv_w': conv_w[l], 'conv_b': conv_b[l],
            'dt_bias_f': dt_bias_f[l], 'dt_bias_b': dt_bias_b[l],
            'a_log_f': a_log_f[l], 'a_log_b': a_log_b[l], 'd_skip': d_skip[l],
            'ssd_norm_g': ssd_norm_g[l], 'gk_up_f': gk_up_f[l], 'gk_bias_f': gk_bias_f[l],
            'gk_up_b': gk_up_b[l], 'gk_bias_b': gk_bias_b[l], 'gla_norm_g': gla_norm_g[l],
            'w_out': w_out[l],
        }
        m_lat = jnp.split((sc @ w_mod[l] + b_mod[l])[:, None, :], 6, axis=-1)
        m_ctx = jnp.split(scc @ w_mod[l] + b_mod[l], 6, axis=-1)
        h_lat = modulate(rmsnorm(x, norm1_g[l]), m_lat[0], m_lat[1])
        h_ctx = modulate(rmsnorm(ctx, norm1_g[l]), m_ctx[0], m_ctx[1])
        mix_ctx, mix_lat = token_mixers(h_ctx, h_lat, p, not last)
        x = x + m_lat[2] * mix_lat
        h2_lat = modulate(rmsnorm(x, norm2_g[l]), m_lat[3], m_lat[4])
        if last:
            ffn = moe(h2_lat.reshape(-1, D_MODEL), w_router, router_bias, w_gate[l], w_up[l], w_down[l])
            x = x + m_lat[5] * ffn.reshape(x.shape)
        else:
            ctx = ctx + m_ctx[2] * mix_ctx
            h2_ctx = modulate(rmsnorm(ctx, norm2_g[l]), m_ctx[3], m_ctx[4])
            n_ctx = h2_ctx.shape[0] * h2_ctx.shape[1]
            tokens = jnp.concatenate([h2_ctx.reshape(-1, D_MODEL), h2_lat.reshape(-1, D_MODEL)], axis=0)
            ffn = moe(tokens, w_router, router_bias, w_gate[l], w_up[l], w_down[l])
            ctx = ctx + m_ctx[5] * ffn[:n_ctx].reshape(ctx.shape)
            x = x + m_lat[5] * ffn[n_ctx:].reshape(x.shape)
    return rmsnorm(x, final_norm_g)
```

```cpp
#include <hip/hip_runtime.h>
#include <stdint.h>

typedef unsigned short bf16_t;
#define DI __device__ __forceinline__

constexpr int D = 1024, NB = 8, SEQ = 4096, CTXL = 256, TC = NB * CTXL, TL = NB * SEQ, T = TC + TL;
constexpr int INDIM = 2840, LDP = 2848;
constexpr int OFF_Z = 0, OFF_XBC = 512, OFF_DT = 1280, OFF_Q = 1288, OFF_K = 1544, OFF_V = 1800, OFF_GO = 2312, OFF_GK = 2824;
constexpr int NE = 32;

DI float bf2f(bf16_t v) { return __uint_as_float(((unsigned)v) << 16); }
DI bf16_t f2bf(float f) { unsigned u = __float_as_uint(f); u += 0x7FFFu + ((u >> 16) & 1u); return (bf16_t)(u >> 16); }
DI float siluf(float x) { return x / (1.0f + __expf(-x)); }
DI float softplusf(float x) { return fmaxf(x, 0.f) + log1pf(__expf(-fabsf(x))); }
DI float logsigmoidf(float x) { return -softplusf(-x); }
DI float wave_sum(float v) {
#pragma unroll
    for (int o = 32; o >= 1; o >>= 1) v += __shfl_xor(v, o);
    return v;
}
DI int tok_modrow(int t) { return t < TC ? 8 : ((t - TC) >> 12); }

__global__ void k_init(float* X, const float* x, const float* ctx, int* counts) {
    size_t i = (size_t)blockIdx.x * blockDim.x + threadIdx.x;
    const size_t n4c = (size_t)TC * D / 4, n4 = (size_t)T * D / 4;
    if (i < 64) counts[i] = 0;
    for (; i < n4; i += (size_t)gridDim.x * blockDim.x)
        ((float4*)X)[i] = i < n4c ? ((const float4*)ctx)[i] : ((const float4*)x)[i - n4c];
}

__global__ void k_mod(float* MOD, const float* c, const float* c_ctx, const float* w_mod, const float* b_mod) {
    __shared__ float s[9][1024];
    const int l = blockIdx.y, n = blockIdx.x * 256 + threadIdx.x;
    for (int i = threadIdx.x; i < 9 * 1024; i += 256) { const int r = i >> 10, k = i & 1023; const float v = r < 8 ? c[r * 1024 + k] : c_ctx[k]; s[r][k] = siluf(v); }
    __syncthreads();
    float acc[9];
#pragma unroll
    for (int r = 0; r < 9; ++r) acc[r] = 0.f;
    const float* w = w_mod + (size_t)l * 1024 * 6144 + n;
    for (int k = 0; k < 1024; ++k) { const float wv = w[(size_t)k * 6144];
#pragma unroll
        for (int r = 0; r < 9; ++r) acc[r] += s[r][k] * wv; }
    const float b = b_mod[l * 6144 + n];
#pragma unroll
    for (int r = 0; r < 9; ++r) MOD[((size_t)l * 9 + r) * 6144 + n] = acc[r] + b;
}

__global__ void k_normmod(const float* X, bf16_t* H, const float* g, const float* MODl, int shift_idx, int scale_idx, int t0, int nt) {
    const int w = (blockIdx.x * blockDim.x + threadIdx.x) >> 6, lane = threadIdx.x & 63;
    if (w >= nt) return;
    const int t = t0 + w;
    const float* xr = X + (size_t)t * D;
    float4 v[4]; float ss = 0.f;
#pragma unroll
    for (int i = 0; i < 4; ++i) { v[i] = ((const float4*)xr)[i * 64 + lane]; ss += v[i].x * v[i].x + v[i].y * v[i].y + v[i].z * v[i].z + v[i].w * v[i].w; }
    ss = wave_sum(ss);
    const float rstd = rsqrtf(ss * (1.0f / D) + 1e-6f);
    const float* mr = MODl + (size_t)tok_modrow(t) * 6144;
#pragma unroll
    for (int i = 0; i < 4; ++i) {
        const int c = (i * 64 + lane) * 4;
        const float4 gg = *(const float4*)(g + c), sh = *(const float4*)(mr + shift_idx * 1024 + c), sc = *(const float4*)(mr + scale_idx * 1024 + c);
        ushort4 o;
        o.x = f2bf(v[i].x * rstd * gg.x * (1.f + sc.x) + sh.x); o.y = f2bf(v[i].y * rstd * gg.y * (1.f + sc.y) + sh.y);
        o.z = f2bf(v[i].z * rstd * gg.z * (1.f + sc.z) + sh.z); o.w = f2bf(v[i].w * rstd * gg.w * (1.f + sc.w) + sh.w);
        *(ushort4*)(H + (size_t)t * D + c) = o;
    }
}

struct GemmP {
    const bf16_t* A; int lda;
    const int* gather; int gstride;
    const int* counts;
    int slot_rows;
    int M, N, K;
    const float* B; const float* B2; int ldb; size_t bstride;
    int mode;
    bf16_t* Obf; int ldo; float* X; const float* MODl;
};
__global__ __launch_bounds__(256) void k_gemm(GemmP p) {
    __shared__ float As[16][68], Bs[16][68], Bs2[16][68];
    const int z = blockIdx.z; int M = p.M, pstart = 0;
    if (p.counts) { M = p.counts[z]; for (int i = 0; i < z; ++i) pstart += p.counts[i]; }
    const int m0 = blockIdx.y * 64, n0 = blockIdx.x * 64;
    if (m0 >= M) return;
    const int tid = threadIdx.x, tx = tid & 15, ty = tid >> 4;
    const float* B = p.B + (size_t)z * p.bstride; const float* B2 = p.B2 ? p.B2 + (size_t)z * p.bstride : nullptr;
    const int ar = tid >> 2, ak = (tid & 3) * 4;
    int arow = m0 + ar; const bool avalid = arow < M; if (!avalid) arow = M - 1;
    size_t arow_idx;
    if (p.gather) arow_idx = (size_t)p.gather[(size_t)z * p.gstride + arow];
    else if (p.slot_rows) arow_idx = (size_t)(pstart + arow);
    else arow_idx = (size_t)arow;
    const bf16_t* ap = p.A + arow_idx * p.lda + ak;
    const int bk = tid >> 4, bn = (tid & 15) * 4;
    float acc[4][4], acc2[4][4];
#pragma unroll
    for (int i = 0; i < 4; ++i)
#pragma unroll
        for (int j = 0; j < 4; ++j) { acc[i][j] = 0.f; acc2[i][j] = 0.f; }
    for (int k0 = 0; k0 < p.K; k0 += 16) {
        const ushort4 av = *(const ushort4*)(ap + k0);
        As[ak + 0][ar] = bf2f(av.x); As[ak + 1][ar] = bf2f(av.y); As[ak + 2][ar] = bf2f(av.z); As[ak + 3][ar] = bf2f(av.w);
        float4 bv = make_float4(0.f, 0.f, 0.f, 0.f), bv2 = bv;
        if (n0 + bn < p.N) { bv = *(const float4*)(B + (size_t)(k0 + bk) * p.ldb + n0 + bn); if (B2) bv2 = *(const float4*)(B2 + (size_t)(k0 + bk) * p.ldb + n0 + bn); }
        *(float4*)&Bs[bk][bn] = bv; if (B2) *(float4*)&Bs2[bk][bn] = bv2;
        __syncthreads();
#pragma unroll
        for (int k = 0; k < 16; ++k) {
            const float4 a = *(const float4*)&As[k][ty * 4]; const float4 b = *(const float4*)&Bs[k][tx * 4];
            const float aa[4] = {a.x, a.y, a.z, a.w}, bb[4] = {b.x, b.y, b.z, b.w};
#pragma unroll
            for (int i = 0; i < 4; ++i)
#pragma unroll
                for (int j = 0; j < 4; ++j) acc[i][j] += aa[i] * bb[j];
            if (B2) { const float4 b2 = *(const float4*)&Bs2[k][tx * 4]; const float bb2[4] = {b2.x, b2.y, b2.z, b2.w};
#pragma unroll
                for (int i = 0; i < 4; ++i)
#pragma unroll
                    for (int j = 0; j < 4; ++j) acc2[i][j] += aa[i] * bb2[j]; }
        }
        __syncthreads();
    }
#pragma unroll
    for (int i = 0; i < 4; ++i) {
        const int m = m0 + ty * 4 + i; if (m >= M) continue;
#pragma unroll
        for (int j = 0; j < 4; ++j) {
            const int n = n0 + tx * 4 + j; if (n >= p.N) continue;
            const float a = acc[i][j];
            if (p.mode == 0) p.Obf[(size_t)m * p.ldo + n] = f2bf(a);
            else if (p.mode == 1) { const float gt = p.MODl[(size_t)tok_modrow(m) * 6144 + 2 * 1024 + n]; p.X[(size_t)m * D + n] += gt * a; }
            else if (p.mode == 2) p.Obf[(size_t)(pstart + m) * p.ldo + n] = f2bf(siluf(a) * acc2[i][j]);
            else p.Obf[(size_t)(pstart + m) * p.ldo + n] = f2bf(a);
        }
    }
}

__global__ void k_conv(const bf16_t* PROJ, bf16_t* XBC, const float* cw, const float* cb) {
    const size_t i = (size_t)blockIdx.x * blockDim.x + threadIdx.x;
    if (i >= (size_t)T * 768) return;
    const int t = (int)(i / 768), ch = (int)(i % 768);
    int lo, hi;
    if (t < TC) { lo = t & ~255; hi = lo + 255; } else { const int u = t - TC; lo = TC + (u & ~63); hi = lo + 63; }
    float acc = cb[ch];
#pragma unroll
    for (int k = 0; k < 5; ++k) { const int tt = t + k - 2; if (tt >= lo && tt <= hi) acc += cw[k * 768 + ch] * bf2f(PROJ[(size_t)tt * LDP + OFF_XBC + ch]); }
    XBC[(size_t)t * 768 + ch] = f2bf(siluf(acc));
}

DI int seq_tok(int b, int s, bool rev) {
    if (s < CTXL) return b * CTXL + (rev ? CTXL - 1 - s : s);
    const int u = s - CTXL; return TC + b * SEQ + (rev ? SEQ - 1 - u : u);
}

__global__ __launch_bounds__(256) void k_scan_ssd(const bf16_t* PROJ, const bf16_t* XBC, float* YS, const float* dtb_f, const float* dtb_b, const float* alog_f, const float* alog_b) {
    const int w = (blockIdx.x * blockDim.x + threadIdx.x) >> 6, lane = threadIdx.x & 63;
    const int p = w & 63, h = (w >> 6) & 7, b = w >> 9, g = h >> 2;
    for (int dir = 0; dir < 2; ++dir) {
        const float A = -__expf(dir ? alog_b[h] : alog_f[h]), bias = dir ? dtb_b[h] : dtb_f[h];
        float st = 0.f;
        for (int s0 = 0; s0 < CTXL + SEQ; s0 += 8) {
            float dtr[8], xv[8], Bv[8], Cv[8]; int tt[8];
#pragma unroll
            for (int u = 0; u < 8; ++u) { const int t = seq_tok(b, s0 + u, dir); tt[u] = t;
                dtr[u] = bf2f(PROJ[(size_t)t * LDP + OFF_DT + h]); xv[u] = bf2f(XBC[(size_t)t * 768 + h * 64 + p]);
                Bv[u] = bf2f(XBC[(size_t)t * 768 + 512 + g * 64 + lane]); Cv[u] = bf2f(XBC[(size_t)t * 768 + 640 + g * 64 + lane]); }
#pragma unroll
            for (int u = 0; u < 8; ++u) {
                const float dt = softplusf(dtr[u] + bias);
                st = __expf(dt * A) * st + dt * xv[u] * Bv[u];
                const float y = wave_sum(Cv[u] * st);
                if (lane == 0) { float* yp = YS + (size_t)tt[u] * 512 + h * 64 + p; if (dir) *yp += y; else *yp = y; }
            }
        }
    }
}

__global__ __launch_bounds__(256) void k_scan_gla(const bf16_t* PROJ, float* OG, const float* up_f, const float* bias_f, const float* up_b, const float* bias_b) {
    const int w = (blockIdx.x * blockDim.x + threadIdx.x) >> 6, lane = threadIdx.x & 63;
    const int v = w & 127, h = (w >> 7) & 3, b = w >> 9;
    for (int dir = 0; dir < 2; ++dir) {
        const float* up = dir ? up_b : up_f; const float gb = (dir ? bias_b : bias_f)[h * 64 + lane];
        float upc[16];
#pragma unroll
        for (int r = 0; r < 16; ++r) upc[r] = up[r * 256 + h * 64 + lane];
        float st = 0.f;
        for (int s0 = 0; s0 < CTXL + SEQ; s0 += 4) {
            float qv[4], kv[4], vv[4], gl[4][16]; int tt[4];
#pragma unroll
            for (int u = 0; u < 4; ++u) { const int t = seq_tok(b, s0 + u, dir); tt[u] = t; const bf16_t* pr = PROJ + (size_t)t * LDP;
                qv[u] = bf2f(pr[OFF_Q + h * 64 + lane]) * 0.125f; kv[u] = bf2f(pr[OFF_K + h * 64 + lane]); vv[u] = bf2f(pr[OFF_V + h * 128 + v]);
#pragma unroll
                for (int r = 0; r < 16; ++r) gl[u][r] = bf2f(pr[OFF_GK + r]); }
#pragma unroll
            for (int u = 0; u < 4; ++u) {
                float a = gb;
#pragma unroll
                for (int r = 0; r < 16; ++r) a += gl[u][r] * upc[r];
                const float gd = logsigmoidf(a) * (1.0f / 16.0f);
                st = __expf(gd) * st + kv[u] * vv[u];
                const float o = wave_sum(qv[u] * st);
                if (lane == 0) { float* op = OG + (size_t)tt[u] * 512 + h * 128 + v; if (dir) *op += o; else *op = o; }
            }
        }
    }
}

__global__ void k_merge(const float* YS, const float* OG, const bf16_t* PROJ, const bf16_t* XBC, bf16_t* MIXED, const float* d_skip, const float* ssd_g, const float* gla_g) {
    const int t = (blockIdx.x * blockDim.x + threadIdx.x) >> 6, lane = threadIdx.x & 63;
    if (t >= T) return;
    const int c0 = lane * 8, h = c0 >> 6;
    float y[8], o[8]; float ss = 0.f, so = 0.f;
    const float dsk = d_skip[h];
#pragma unroll
    for (int j = 0; j < 8; ++j) {
        const int c = c0 + j;
        const float xs = bf2f(XBC[(size_t)t * 768 + c]), z = bf2f(PROJ[(size_t)t * LDP + OFF_Z + c]);
        y[j] = (YS[(size_t)t * 512 + c] + dsk * xs) * siluf(z); ss += y[j] * y[j];
        o[j] = OG[(size_t)t * 512 + c]; so += o[j] * o[j];
    }
    ss = wave_sum(ss);
    so += __shfl_xor(so, 1); so += __shfl_xor(so, 2); so += __shfl_xor(so, 4); so += __shfl_xor(so, 8);
    const float rs = rsqrtf(ss * (1.0f / 512.0f) + 1e-6f), ro = rsqrtf(so * (1.0f / 128.0f) + 1e-6f);
#pragma unroll
    for (int j = 0; j < 8; ++j) {
        const int c = c0 + j;
        MIXED[(size_t)t * D + c] = f2bf(y[j] * rs * ssd_g[c]);
        const float go = bf2f(PROJ[(size_t)t * LDP + OFF_GO + c]);
        MIXED[(size_t)t * D + 512 + c] = f2bf(o[j] * ro * gla_g[c & 127] * siluf(go));
    }
}

__global__ void k_route(const bf16_t* H, const float* w_router, const float* router_bias, int* TOKSLOT, float* EW, int* counts, int* MAP, int t0, int nt) {
    const int w = (blockIdx.x * blockDim.x + threadIdx.x) >> 6, lane = threadIdx.x & 63;
    if (w >= nt) return;
    const int t = t0 + w;
    float hv[16];
#pragma unroll
    for (int j = 0; j < 16; ++j) hv[j] = bf2f(H[(size_t)t * D + lane * 16 + j]);
    float s[32];
#pragma unroll
    for (int e = 0; e < 32; ++e) { float a = 0.f;
#pragma unroll
        for (int j = 0; j < 16; ++j) a += hv[j] * w_router[(size_t)(lane * 16 + j) * 32 + e];
        a = wave_sum(a); s[e] = 1.0f / (1.0f + __expf(-a)); }
    if (lane == 0) {
        float bgs = -1e30f; int e1 = 0, e2 = 0; float w1 = 0.f, w2 = 0.f;
#pragma unroll
        for (int g = 0; g < 8; ++g) { float m1 = -1e30f, m2 = -1e30f, s1 = 0.f, s2 = 0.f; int i1 = 0, i2 = 0;
#pragma unroll
            for (int j = 0; j < 4; ++j) { const float sv = s[g * 4 + j], v = sv + router_bias[g * 4 + j];
                if (v > m1) { m2 = m1; i2 = i1; s2 = s1; m1 = v; i1 = g * 4 + j; s1 = sv; } else if (v > m2) { m2 = v; i2 = g * 4 + j; s2 = sv; } }
            if (m1 + m2 > bgs) { bgs = m1 + m2; e1 = i1; e2 = i2; w1 = s1; w2 = s2; } }
        const float inv = 1.0f / (w1 + w2);
        const int r1 = atomicAdd(&counts[e1], 1), r2 = atomicAdd(&counts[e2], 1);
        MAP[(size_t)e1 * T + r1] = t; MAP[(size_t)e2 * T + r2] = t;
        TOKSLOT[t * 4 + 0] = e1; TOKSLOT[t * 4 + 1] = r1; TOKSLOT[t * 4 + 2] = e2; TOKSLOT[t * 4 + 3] = r2;
        EW[t * 2 + 0] = w1 * inv; EW[t * 2 + 1] = w2 * inv;
    }
}

__global__ void k_combine(float* X, const bf16_t* Y, const int* TOKSLOT, const float* EW, const int* counts, const float* MODl, int t0, int nt) {
    const int w = (blockIdx.x * blockDim.x + threadIdx.x) >> 6, lane = threadIdx.x & 63;
    if (w >= nt) return;
    const int t = t0 + w;
    const int e1 = TOKSLOT[t * 4], r1 = TOKSLOT[t * 4 + 1], e2 = TOKSLOT[t * 4 + 2], r2 = TOKSLOT[t * 4 + 3];
    int p1 = 0, p2 = 0;
    for (int i = 0; i < 32; ++i) { const int c = counts[i]; if (i < e1) p1 += c; if (i < e2) p2 += c; }
    const bf16_t* y1 = Y + (size_t)(p1 + r1) * D; const bf16_t* y2 = Y + (size_t)(p2 + r2) * D;
    const float w1 = EW[t * 2], w2 = EW[t * 2 + 1];
    const float* g5 = MODl + (size_t)tok_modrow(t) * 6144 + 5 * 1024;
    for (int i = 0; i < 16; ++i) { const int c = i * 64 + lane; X[(size_t)t * D + c] += g5[c] * (w1 * bf2f(y1[c]) + w2 * bf2f(y2[c])); }
}

__global__ void k_final(const float* X, float* out, const float* g) {
    const int u = (blockIdx.x * blockDim.x + threadIdx.x) >> 6, lane = threadIdx.x & 63;
    if (u >= TL) return;
    const float* xr = X + (size_t)(TC + u) * D;
    float4 v[4]; float ss = 0.f;
#pragma unroll
    for (int i = 0; i < 4; ++i) { v[i] = ((const float4*)xr)[i * 64 + lane]; ss += v[i].x * v[i].x + v[i].y * v[i].y + v[i].z * v[i].z + v[i].w * v[i].w; }
    ss = wave_sum(ss);
    const float rstd = rsqrtf(ss * (1.0f / D) + 1e-6f);
#pragma unroll
    for (int i = 0; i < 4; ++i) { const float4 gg = ((const float4*)g)[i * 64 + lane];
        ((float4*)(out + (size_t)u * D))[i * 64 + lane] = make_float4(v[i].x * rstd * gg.x, v[i].y * rstd * gg.y, v[i].z * rstd * gg.z, v[i].w * rstd * gg.w); }
}

static inline size_t al(size_t x) { return (x + 255) & ~(size_t)255; }

extern "C" void kernel_launch(void* const* d_in, const int* in_sizes, int n_in, void* d_out, int out_size, void* d_ws, size_t ws_size, hipStream_t stream) {
    const float* x = (const float*)d_in[0]; const float* c = (const float*)d_in[1]; const float* ctx = (const float*)d_in[2]; const float* c_ctx = (const float*)d_in[3];
    const float* w_mod = (const float*)d_in[4]; const float* b_mod = (const float*)d_in[5]; const float* norm1_g = (const float*)d_in[6]; const float* norm2_g = (const float*)d_in[7];
    const float* w_in = (const float*)d_in[8]; const float* conv_w = (const float*)d_in[9]; const float* conv_b = (const float*)d_in[10];
    const float* dt_bias_f = (const float*)d_in[11]; const float* dt_bias_b = (const float*)d_in[12]; const float* a_log_f = (const float*)d_in[13]; const float* a_log_b = (const float*)d_in[14];
    const float* d_skip = (const float*)d_in[15]; const float* ssd_norm_g = (const float*)d_in[16];
    const float* gk_up_f = (const float*)d_in[17]; const float* gk_bias_f = (const float*)d_in[18]; const float* gk_up_b = (const float*)d_in[19]; const float* gk_bias_b = (const float*)d_in[20];
    const float* gla_norm_g = (const float*)d_in[21]; const float* w_out = (const float*)d_in[22]; const float* w_router = (const float*)d_in[23]; const float* router_bias = (const float*)d_in[24];
    const float* w_gate = (const float*)d_in[25]; const float* w_up = (const float*)d_in[26]; const float* w_down = (const float*)d_in[27]; const float* final_g = (const float*)d_in[28];
    float* out = (float*)d_out;

    char* ws = (char*)d_ws; size_t off = 0;
    auto take = [&](size_t bytes) { char* p = ws + off; off += al(bytes); return p; };
    float* X = (float*)take((size_t)T * D * 4);
    bf16_t* H = (bf16_t*)take((size_t)T * D * 2);
    bf16_t* PROJ = (bf16_t*)take((size_t)T * LDP * 2);
    bf16_t* XBC = (bf16_t*)take((size_t)T * 768 * 2);
    float* YS = (float*)take((size_t)T * 512 * 4);
    float* OG = (float*)take((size_t)T * 512 * 4);
    float* MOD = (float*)take((size_t)2 * 9 * 6144 * 4);
    int* counts = (int*)take(64 * 4);
    int* TOKSLOT = (int*)take((size_t)T * 4 * 4);
    float* EW = (float*)take((size_t)T * 2 * 4);
    int* MAP = (int*)take((size_t)NE * T * 4);
    if (off > ws_size) return;
    bf16_t* Yb = PROJ; bf16_t* ACT = (bf16_t*)YS;

    k_init<<<2048, 256, 0, stream>>>(X, x, ctx, counts);
    k_mod<<<dim3(6144 / 256, 2), 256, 0, stream>>>(MOD, c, c_ctx, w_mod, b_mod);
    for (int l = 0; l < 2; ++l) {
        const float* MODl = MOD + (size_t)l * 9 * 6144;
        k_normmod<<<T / 4, 256, 0, stream>>>(X, H, norm1_g + l * D, MODl, 0, 1, 0, T);
        { GemmP p{}; p.A = H; p.lda = D; p.M = T; p.N = INDIM; p.K = D; p.B = w_in + (size_t)l * D * INDIM; p.ldb = INDIM; p.mode = 0; p.Obf = PROJ; p.ldo = LDP;
          k_gemm<<<dim3((INDIM + 63) / 64, T / 64, 1), 256, 0, stream>>>(p); }
        k_conv<<<(unsigned)(((size_t)T * 768 + 255) / 256), 256, 0, stream>>>(PROJ, XBC, conv_w + l * 5 * 768, conv_b + l * 768);
        k_scan_ssd<<<NB * 8 * 64 / 4, 256, 0, stream>>>(PROJ, XBC, YS, dt_bias_f + l * 8, dt_bias_b + l * 8, a_log_f + l * 8, a_log_b + l * 8);
        k_scan_gla<<<NB * 4 * 128 / 4, 256, 0, stream>>>(PROJ, OG, gk_up_f + l * 16 * 256, gk_bias_f + l * 256, gk_up_b + l * 16 * 256, gk_bias_b + l * 256);
        k_merge<<<T / 4, 256, 0, stream>>>(YS, OG, PROJ, XBC, H, d_skip + l * 8, ssd_norm_g + l * 512, gla_norm_g + l * 128);
        { GemmP p{}; p.A = H; p.lda = D; p.M = T; p.N = D; p.K = D; p.B = w_out + (size_t)l * D * D; p.ldb = D; p.mode = 1; p.X = X; p.MODl = MODl;
          k_gemm<<<dim3(D / 64, T / 64, 1), 256, 0, stream>>>(p); }
        const int t0 = l == 0 ? 0 : TC, nt = T - t0;
        k_normmod<<<(nt + 3) / 4, 256, 0, stream>>>(X, H, norm2_g + l * D, MODl, 3, 4, t0, nt);
        k_route<<<(nt + 3) / 4, 256, 0, stream>>>(H, w_router, router_bias, TOKSLOT, EW, counts + l * 32, MAP, t0, nt);
        { GemmP p{}; p.A = H; p.lda = D; p.gather = MAP; p.gstride = T; p.counts = counts + l * 32; p.M = 0; p.N = 512; p.K = D;
          p.B = w_gate + (size_t)l * NE * D * 512; p.B2 = w_up + (size_t)l * NE * D * 512; p.ldb = 512; p.bstride = (size_t)D * 512; p.mode = 2; p.Obf = ACT; p.ldo = 512;
          k_gemm<<<dim3(512 / 64, T / 64, NE), 256, 0, stream>>>(p); }
        { GemmP p{}; p.A = ACT; p.lda = 512; p.slot_rows = 1; p.counts = counts + l * 32; p.M = 0; p.N = D; p.K = 512;
          p.B = w_down + (size_t)l * NE * 512 * D; p.ldb = D; p.bstride = (size_t)512 * D; p.mode = 3; p.Obf = Yb; p.ldo = D;
          k_gemm<<<dim3(D / 64, T / 64, NE), 256, 0, stream>>>(p); }
        k_combine<<<(nt + 3) / 4, 256, 0, stream>>>(X, Yb, TOKSLOT, EW, counts + l * 32, MODl, t0, nt);
    }
    k_final<<<TL / 4, 256, 0, stream>>>(X, out, final_g);
}
```

```cpp
#include <hip/hip_runtime.h>
#include <hip/hip_cooperative_groups.h>
#include <stdint.h>
#include <cstdio>
namespace cg = cooperative_groups;

typedef unsigned short bf16_t;
#define DI __device__ __forceinline__

constexpr int D = 1024, NB = 8, SEQ = 4096, CTXL = 256, TC = NB * CTXL, TL = NB * SEQ, T = TC + TL;
constexpr int INDIM = 2840, LDP = 2848;
constexpr int OFF_Z = 0, OFF_XBC = 512, OFF_DT = 1280, OFF_Q = 1288, OFF_K = 1544, OFF_V = 1800, OFF_GO = 2312, OFF_GK = 2824;
constexpr int NE = 32;

DI float bf2f(bf16_t v) { return __uint_as_float(((unsigned)v) << 16); }
DI bf16_t f2bf(float f) { unsigned u = __float_as_uint(f); u += 0x7FFFu + ((u >> 16) & 1u); return (bf16_t)(u >> 16); }
DI float siluf(float x) { return x / (1.0f + __expf(-x)); }
DI float softplusf(float x) { return fmaxf(x, 0.f) + log1pf(__expf(-fabsf(x))); }
DI float logsigmoidf(float x) { return -softplusf(-x); }
DI float wave_sum(float v) {
#pragma unroll
    for (int o = 32; o >= 1; o >>= 1) v += __shfl_xor(v, o);
    return v;
}
DI int tok_modrow(int t) { return t < TC ? 8 : ((t - TC) >> 12); }


constexpr int NTHR = 512, NWV = 8, LDS_BYTES = 147456;

struct P {
    const float *x, *c, *ctx, *c_ctx, *w_mod, *b_mod, *norm1_g, *norm2_g, *w_in, *conv_w, *conv_b, *dt_bias_f, *dt_bias_b, *a_log_f, *a_log_b, *d_skip, *ssd_norm_g,
        *gk_up_f, *gk_bias_f, *gk_up_b, *gk_bias_b, *gla_norm_g, *w_out, *w_router, *router_bias, *w_gate, *w_up, *w_down, *final_g;
    float* out; float* X; bf16_t* H; bf16_t* PROJ; bf16_t* XBC; float* YS; float* OG; float* MOD; int* counts; int* TOKSLOT; float* EW; int* MAP;
};

DI void ph_init(const P& p) {
    size_t i = (size_t)blockIdx.x * NTHR + threadIdx.x;
    const size_t n4c = (size_t)TC * D / 4, n4 = (size_t)T * D / 4;
    if (i < 64) p.counts[i] = 0;
    for (; i < n4; i += (size_t)gridDim.x * NTHR)
        ((float4*)p.X)[i] = i < n4c ? ((const float4*)p.ctx)[i] : ((const float4*)p.x)[i - n4c];
}

DI void ph_mod(const P& p, float* s  ) {
    if (blockIdx.x >= 24) return;
    for (int i = threadIdx.x; i < 9 * 1024; i += NTHR) { const int r = i >> 10, k = i & 1023; const float v = r < 8 ? p.c[r * 1024 + k] : p.c_ctx[k]; s[i] = siluf(v); }
    __syncthreads();
    for (int vb = blockIdx.x; vb < 24; vb += gridDim.x) {
        const int l = vb / 12, n = (vb % 12) * NTHR + threadIdx.x;
        float acc[9];
#pragma unroll
        for (int r = 0; r < 9; ++r) acc[r] = 0.f;
        const float* w = p.w_mod + (size_t)l * 1024 * 6144 + n;
        for (int k = 0; k < 1024; ++k) { const float wv = w[(size_t)k * 6144];
#pragma unroll
            for (int r = 0; r < 9; ++r) acc[r] += s[r * 1024 + k] * wv; }
        const float b = p.b_mod[l * 6144 + n];
#pragma unroll
        for (int r = 0; r < 9; ++r) p.MOD[((size_t)l * 9 + r) * 6144 + n] = acc[r] + b;
    }
    __syncthreads();
}

DI void row_normmod(float4 (&v)[4], const float* g, const float* mr, int shift_idx, int scale_idx, int lane) {
    float ss = 0.f;
#pragma unroll
    for (int i = 0; i < 4; ++i) ss += v[i].x * v[i].x + v[i].y * v[i].y + v[i].z * v[i].z + v[i].w * v[i].w;
    ss = wave_sum(ss);
    const float rstd = rsqrtf(ss * (1.0f / D) + 1e-6f);
#pragma unroll
    for (int i = 0; i < 4; ++i) {
        const int c = (i * 64 + lane) * 4;
        const float4 gg = *(const float4*)(g + c), sh = *(const float4*)(mr + shift_idx * 1024 + c), sc = *(const float4*)(mr + scale_idx * 1024 + c);
        v[i].x = v[i].x * rstd * gg.x * (1.f + sc.x) + sh.x; v[i].y = v[i].y * rstd * gg.y * (1.f + sc.y) + sh.y;
        v[i].z = v[i].z * rstd * gg.z * (1.f + sc.z) + sh.z; v[i].w = v[i].w * rstd * gg.w * (1.f + sc.w) + sh.w;
    }
}
DI void row_store_bf16(bf16_t* hrow, float4 (&v)[4], int lane) {
#pragma unroll
    for (int i = 0; i < 4; ++i) { ushort4 o; o.x = f2bf(v[i].x); o.y = f2bf(v[i].y); o.z = f2bf(v[i].z); o.w = f2bf(v[i].w);
        *(ushort4*)(hrow + (i * 64 + lane) * 4) = o; v[i] = make_float4(bf2f(o.x), bf2f(o.y), bf2f(o.z), bf2f(o.w)); }
}

DI void ph_normmod1(const P& p, int l, int gw, int NW, int lane) {
    const float* MODl = p.MOD + (size_t)l * 9 * 6144;
    for (int t = gw; t < T; t += NW) {
        float4 v[4];
#pragma unroll
        for (int i = 0; i < 4; ++i) v[i] = ((const float4*)(p.X + (size_t)t * D))[i * 64 + lane];
        row_normmod(v, p.norm1_g + l * D, MODl + (size_t)tok_modrow(t) * 6144, 0, 1, lane);
        row_store_bf16(p.H + (size_t)t * D, v, lane);
    }
}

struct GemmP {
    const bf16_t* A; int lda;
    const int* gather; int gstride;
    const int* counts;
    int slot_rows;
    int M, N, K, nz;
    const float* B; const float* B2; int ldb; size_t bstride;
    int mode;
    bf16_t* Obf; int ldo; float* X; const float* MODl;
};
template <int MODE> DI void ph_gemm(const GemmP& p, float* lds) {
    constexpr bool DUAL = (MODE == 2);
    float (*As)[132] = (float (*)[132])lds; float (*Bs)[68] = (float (*)[68])(lds + 16 * 132); float (*Bs2)[68] = (float (*)[68])(lds + 16 * 132 + 16 * 68);
    const int nx = (p.N + 63) / 64, ny = (p.M + 127) / 128, total = nx * ny * p.nz;
    const int tid = threadIdx.x, tx = tid & 15, ty = tid >> 4;
    for (int vt = blockIdx.x; vt < total; vt += gridDim.x) {
        const int z = vt / (nx * ny), rem = vt - z * nx * ny, by = rem / nx, bx = rem - by * nx;
        int M = p.M, pstart = 0;
        if (p.counts) { M = p.counts[z]; for (int i = 0; i < z; ++i) pstart += p.counts[i]; }
        const int m0 = by * 128, n0 = bx * 64;
        if (m0 >= M) continue;
        const float* B = p.B + (size_t)z * p.bstride; const float* B2 = DUAL ? p.B2 + (size_t)z * p.bstride : nullptr;
        const int ar = tid >> 2, ak = (tid & 3) * 4;
        int arow = m0 + ar; if (arow >= M) arow = M - 1;
        size_t arow_idx;
        if (p.gather) arow_idx = (size_t)p.gather[(size_t)z * p.gstride + arow];
        else if (p.slot_rows) arow_idx = (size_t)(pstart + arow);
        else arow_idx = (size_t)arow;
        const bf16_t* ap = p.A + arow_idx * p.lda + ak;
        const int bk = (tid & 255) >> 4, bn = (tid & 15) * 4;
        float acc[4][4], acc2[4][4];
#pragma unroll
        for (int i = 0; i < 4; ++i)
#pragma unroll
            for (int j = 0; j < 4; ++j) { acc[i][j] = 0.f; acc2[i][j] = 0.f; }
        for (int k0 = 0; k0 < p.K; k0 += 16) {
            const ushort4 av = *(const ushort4*)(ap + k0);
            As[ak + 0][ar] = bf2f(av.x); As[ak + 1][ar] = bf2f(av.y); As[ak + 2][ar] = bf2f(av.z); As[ak + 3][ar] = bf2f(av.w);
            if (tid < 256) {
                float4 bv = make_float4(0.f, 0.f, 0.f, 0.f), bv2 = bv;
                if (n0 + bn < p.N) { bv = *(const float4*)(B + (size_t)(k0 + bk) * p.ldb + n0 + bn); if (DUAL) bv2 = *(const float4*)(B2 + (size_t)(k0 + bk) * p.ldb + n0 + bn); }
                *(float4*)&Bs[bk][bn] = bv; if (DUAL) *(float4*)&Bs2[bk][bn] = bv2;
            }
            __syncthreads();
#pragma unroll 4
            for (int k = 0; k < 16; ++k) {
                const float4 a = *(const float4*)&As[k][ty * 4]; const float4 b = *(const float4*)&Bs[k][tx * 4];
                const float aa[4] = {a.x, a.y, a.z, a.w}, bb[4] = {b.x, b.y, b.z, b.w};
#pragma unroll
                for (int i = 0; i < 4; ++i)
#pragma unroll
                    for (int j = 0; j < 4; ++j) acc[i][j] += aa[i] * bb[j];
                if (DUAL) { const float4 b2 = *(const float4*)&Bs2[k][tx * 4]; const float bb2[4] = {b2.x, b2.y, b2.z, b2.w};
#pragma unroll
                    for (int i = 0; i < 4; ++i)
#pragma unroll
                        for (int j = 0; j < 4; ++j) acc2[i][j] += aa[i] * bb2[j]; }
            }
            __syncthreads();
        }
#pragma unroll
        for (int i = 0; i < 4; ++i) {
            const int m = m0 + ty * 4 + i; if (m >= M) continue;
#pragma unroll
            for (int j = 0; j < 4; ++j) {
                const int n = n0 + tx * 4 + j; if (n >= p.N) continue;
                const float a = acc[i][j];
                if (MODE == 0) p.Obf[(size_t)m * p.ldo + n] = f2bf(a);
                else if (MODE == 1) { const float gt = p.MODl[(size_t)tok_modrow(m) * 6144 + 2 * 1024 + n]; p.X[(size_t)m * D + n] += gt * a; }
                else if (MODE == 2) p.Obf[(size_t)(pstart + m) * p.ldo + n] = f2bf(siluf(a) * acc2[i][j]);
                else p.Obf[(size_t)(pstart + m) * p.ldo + n] = f2bf(a);
            }
        }
    }
}

DI void ph_conv(const P& p, int l) {
    const float* cw = p.conv_w + l * 5 * 768; const float* cb = p.conv_b + l * 768;
    for (size_t i = (size_t)blockIdx.x * NTHR + threadIdx.x; i < (size_t)T * 768; i += (size_t)gridDim.x * NTHR) {
        const int t = (int)(i / 768), ch = (int)(i % 768);
        int lo, hi;
        if (t < TC) { lo = t & ~255; hi = lo + 255; } else { const int u = t - TC; lo = TC + (u & ~63); hi = lo + 63; }
        float acc = cb[ch];
#pragma unroll
        for (int k = 0; k < 5; ++k) { const int tt = t + k - 2; if (tt >= lo && tt <= hi) acc += cw[k * 768 + ch] * bf2f(p.PROJ[(size_t)tt * LDP + OFF_XBC + ch]); }
        p.XBC[(size_t)t * 768 + ch] = f2bf(siluf(acc));
    }
}

DI int seq_tok(int b, int s, bool rev) {
    if (s < CTXL) return b * CTXL + (rev ? CTXL - 1 - s : s);
    const int u = s - CTXL; return TC + b * SEQ + (rev ? SEQ - 1 - u : u);
}

DI void scan_ssd_wave(const P& p, int l, int w, int lane) {
    const int pp = w & 63, h = (w >> 6) & 7, b = w >> 9, g = h >> 2;
    for (int dir = 0; dir < 2; ++dir) {
        const float A = -__expf(dir ? p.a_log_b[l * 8 + h] : p.a_log_f[l * 8 + h]), bias = dir ? p.dt_bias_b[l * 8 + h] : p.dt_bias_f[l * 8 + h];
        float st = 0.f;
        for (int s0 = 0; s0 < CTXL + SEQ; s0 += 8) {
            float dtr[8], xv[8], Bv[8], Cv[8]; int tt[8];
#pragma unroll
            for (int u = 0; u < 8; ++u) { const int t = seq_tok(b, s0 + u, dir); tt[u] = t;
                dtr[u] = bf2f(p.PROJ[(size_t)t * LDP + OFF_DT + h]); xv[u] = bf2f(p.XBC[(size_t)t * 768 + h * 64 + pp]);
                Bv[u] = bf2f(p.XBC[(size_t)t * 768 + 512 + g * 64 + lane]); Cv[u] = bf2f(p.XBC[(size_t)t * 768 + 640 + g * 64 + lane]); }
#pragma unroll
            for (int u = 0; u < 8; ++u) {
                const float dt = softplusf(dtr[u] + bias);
                st = __expf(dt * A) * st + dt * xv[u] * Bv[u];
                const float y = wave_sum(Cv[u] * st);
                if (lane == 0) { float* yp = p.YS + (size_t)tt[u] * 512 + h * 64 + pp; if (dir) *yp += y; else *yp = y; }
            }
        }
    }
}
DI void scan_gla_wave(const P& p, int l, int w, int lane) {
    const int v = w & 127, h = (w >> 7) & 3, b = w >> 9;
    for (int dir = 0; dir < 2; ++dir) {
        const float* up = (dir ? p.gk_up_b : p.gk_up_f) + l * 16 * 256; const float gb = (dir ? p.gk_bias_b : p.gk_bias_f)[l * 256 + h * 64 + lane];
        float upc[16];
#pragma unroll
        for (int r = 0; r < 16; ++r) upc[r] = up[r * 256 + h * 64 + lane];
        float st = 0.f;
        for (int s0 = 0; s0 < CTXL + SEQ; s0 += 4) {
            float qv[4], kv[4], vv[4], gl[4][16]; int tt[4];
#pragma unroll
            for (int u = 0; u < 4; ++u) { const int t = seq_tok(b, s0 + u, dir); tt[u] = t; const bf16_t* pr = p.PROJ + (size_t)t * LDP;
                qv[u] = bf2f(pr[OFF_Q + h * 64 + lane]) * 0.125f; kv[u] = bf2f(pr[OFF_K + h * 64 + lane]); vv[u] = bf2f(pr[OFF_V + h * 128 + v]);
#pragma unroll
                for (int r = 0; r < 16; ++r) gl[u][r] = bf2f(pr[OFF_GK + r]); }
#pragma unroll
            for (int u = 0; u < 4; ++u) {
                float a = gb;
#pragma unroll
                for (int r = 0; r < 16; ++r) a += gl[u][r] * upc[r];
                const float gd = logsigmoidf(a) * (1.0f / 16.0f);
                st = __expf(gd) * st + kv[u] * vv[u];
                const float o = wave_sum(qv[u] * st);
                if (lane == 0) { float* op = p.OG + (size_t)tt[u] * 512 + h * 128 + v; if (dir) *op += o; else *op = o; }
            }
        }
    }
}
DI void ph_scan(const P& p, int l, int gw, int NW, int lane) {
    for (int vw = gw; vw < 8192; vw += NW) { if (vw < 4096) scan_ssd_wave(p, l, vw, lane); else scan_gla_wave(p, l, vw - 4096, lane); }
}

DI void ph_merge(const P& p, int l, int gw, int NW, int lane) {
    const float* d_skip = p.d_skip + l * 8; const float* ssd_g = p.ssd_norm_g + l * 512; const float* gla_g = p.gla_norm_g + l * 128;
    for (int t = gw; t < T; t += NW) {
        const int c0 = lane * 8, h = c0 >> 6;
        float y[8], o[8]; float ss = 0.f, so = 0.f;
        const float dsk = d_skip[h];
#pragma unroll
        for (int j = 0; j < 8; ++j) {
            const int c = c0 + j;
            const float xs = bf2f(p.XBC[(size_t)t * 768 + c]), z = bf2f(p.PROJ[(size_t)t * LDP + OFF_Z + c]);
            y[j] = (p.YS[(size_t)t * 512 + c] + dsk * xs) * siluf(z); ss += y[j] * y[j];
            o[j] = p.OG[(size_t)t * 512 + c]; so += o[j] * o[j];
        }
        ss = wave_sum(ss);
        so += __shfl_xor(so, 1); so += __shfl_xor(so, 2); so += __shfl_xor(so, 4); so += __shfl_xor(so, 8);
        const float rs = rsqrtf(ss * (1.0f / 512.0f) + 1e-6f), ro = rsqrtf(so * (1.0f / 128.0f) + 1e-6f);
#pragma unroll
        for (int j = 0; j < 8; ++j) {
            const int c = c0 + j;
            p.H[(size_t)t * D + c] = f2bf(y[j] * rs * ssd_g[c]);
            const float go = bf2f(p.PROJ[(size_t)t * LDP + OFF_GO + c]);
            p.H[(size_t)t * D + 512 + c] = f2bf(o[j] * ro * gla_g[c & 127] * siluf(go));
        }
    }
}

DI void ph_normroute(const P& p, int l, int t0, int gw, int NW, int lane, float* s  ) {
    const float* MODl = p.MOD + (size_t)l * 9 * 6144; int* counts = p.counts + l * 32;
    for (int t = t0 + gw; t < T; t += NW) {
        float4 v[4];
#pragma unroll
        for (int i = 0; i < 4; ++i) v[i] = ((const float4*)(p.X + (size_t)t * D))[i * 64 + lane];
        row_normmod(v, p.norm2_g + l * D, MODl + (size_t)tok_modrow(t) * 6144, 3, 4, lane);
        row_store_bf16(p.H + (size_t)t * D, v, lane);
#pragma unroll 2
        for (int e = 0; e < 32; ++e) { float a = 0.f;
#pragma unroll
            for (int i = 0; i < 4; ++i) { const float* wr = p.w_router + (size_t)((i * 64 + lane) * 4) * 32 + e;
                a += v[i].x * wr[0] + v[i].y * wr[32] + v[i].z * wr[64] + v[i].w * wr[96]; }
            a = wave_sum(a); if (lane == 0) s[e] = 1.0f / (1.0f + __expf(-a)); }
        if (lane == 0) {
            float bgs = -1e30f; int e1 = 0, e2 = 0; float w1 = 0.f, w2 = 0.f;
#pragma unroll
            for (int g = 0; g < 8; ++g) { float m1 = -1e30f, m2 = -1e30f, s1 = 0.f, s2 = 0.f; int i1 = 0, i2 = 0;
#pragma unroll
                for (int j = 0; j < 4; ++j) { const float sv = s[g * 4 + j], vv = sv + p.router_bias[g * 4 + j];
                    if (vv > m1) { m2 = m1; i2 = i1; s2 = s1; m1 = vv; i1 = g * 4 + j; s1 = sv; } else if (vv > m2) { m2 = vv; i2 = g * 4 + j; s2 = sv; } }
                if (m1 + m2 > bgs) { bgs = m1 + m2; e1 = i1; e2 = i2; w1 = s1; w2 = s2; } }
            const float inv = 1.0f / (w1 + w2);
            const int r1 = atomicAdd(&counts[e1], 1), r2 = atomicAdd(&counts[e2], 1);
            p.MAP[(size_t)e1 * T + r1] = t; p.MAP[(size_t)e2 * T + r2] = t;
            p.TOKSLOT[t * 4 + 0] = e1; p.TOKSLOT[t * 4 + 1] = r1; p.TOKSLOT[t * 4 + 2] = e2; p.TOKSLOT[t * 4 + 3] = r2;
            p.EW[t * 2 + 0] = w1 * inv; p.EW[t * 2 + 1] = w2 * inv;
        }
    }
}

DI void ph_combine(const P& p, int l, int t0, const bf16_t* Y, int gw, int NW, int lane) {
    const float* MODl = p.MOD + (size_t)l * 9 * 6144; const int* counts = p.counts + l * 32;
    for (int t = t0 + gw; t < T; t += NW) {
        const int e1 = p.TOKSLOT[t * 4], r1 = p.TOKSLOT[t * 4 + 1], e2 = p.TOKSLOT[t * 4 + 2], r2 = p.TOKSLOT[t * 4 + 3];
        int p1 = 0, p2 = 0;
        for (int i = 0; i < 32; ++i) { const int c = counts[i]; if (i < e1) p1 += c; if (i < e2) p2 += c; }
        const bf16_t* y1 = Y + (size_t)(p1 + r1) * D; const bf16_t* y2 = Y + (size_t)(p2 + r2) * D;
        const float w1 = p.EW[t * 2], w2 = p.EW[t * 2 + 1];
        const float* g5 = MODl + (size_t)tok_modrow(t) * 6144 + 5 * 1024;
        float4 v[4];
#pragma unroll
        for (int i = 0; i < 4; ++i) { const int c = (i * 64 + lane) * 4;
            v[i] = *(const float4*)(p.X + (size_t)t * D + c); const float4 gg = *(const float4*)(g5 + c);
            const ushort4 a = *(const ushort4*)(y1 + c), b = *(const ushort4*)(y2 + c);
            v[i].x += gg.x * (w1 * bf2f(a.x) + w2 * bf2f(b.x)); v[i].y += gg.y * (w1 * bf2f(a.y) + w2 * bf2f(b.y));
            v[i].z += gg.z * (w1 * bf2f(a.z) + w2 * bf2f(b.z)); v[i].w += gg.w * (w1 * bf2f(a.w) + w2 * bf2f(b.w));
            *(float4*)(p.X + (size_t)t * D + c) = v[i]; }
        if (l == 0) {
            row_normmod(v, p.norm1_g + D, p.MOD + (size_t)9 * 6144 + (size_t)tok_modrow(t) * 6144, 0, 1, lane);
            row_store_bf16(p.H + (size_t)t * D, v, lane);
        } else {
            float ss = 0.f;
#pragma unroll
            for (int i = 0; i < 4; ++i) ss += v[i].x * v[i].x + v[i].y * v[i].y + v[i].z * v[i].z + v[i].w * v[i].w;
            ss = wave_sum(ss);
            const float rstd = rsqrtf(ss * (1.0f / D) + 1e-6f);
#pragma unroll
            for (int i = 0; i < 4; ++i) { const float4 gg = ((const float4*)p.final_g)[i * 64 + lane];
                ((float4*)(p.out + (size_t)(t - TC) * D))[i * 64 + lane] = make_float4(v[i].x * rstd * gg.x, v[i].y * rstd * gg.y, v[i].z * rstd * gg.z, v[i].w * rstd * gg.w); }
        }
    }
}

__global__ void __launch_bounds__(NTHR) mega(P p) {
    extern __shared__ __attribute__((aligned(16))) unsigned char smem[];
    cg::grid_group grid = cg::this_grid();
    const int tid = threadIdx.x, lane = tid & 63, gw = blockIdx.x * NWV + (tid >> 6), NW = gridDim.x * NWV;
    float* ldsf = (float*)smem;
    ph_init(p); ph_mod(p, ldsf);
    grid.sync();
    ph_normmod1(p, 0, gw, NW, lane);
    grid.sync();
    for (int l = 0; l < 2; ++l) {
        const float* MODl = p.MOD + (size_t)l * 9 * 6144;
        { GemmP g{}; g.A = p.H; g.lda = D; g.M = T; g.N = INDIM; g.K = D; g.nz = 1; g.B = p.w_in + (size_t)l * D * INDIM; g.ldb = INDIM; g.mode = 0; g.Obf = p.PROJ; g.ldo = LDP;
          ph_gemm<0>(g, ldsf); }
        grid.sync();
        ph_conv(p, l);
        grid.sync();
        ph_scan(p, l, gw, NW, lane);
        grid.sync();
        ph_merge(p, l, gw, NW, lane);
        grid.sync();
        { GemmP g{}; g.A = p.H; g.lda = D; g.M = T; g.N = D; g.K = D; g.nz = 1; g.B = p.w_out + (size_t)l * D * D; g.ldb = D; g.mode = 1; g.X = p.X; g.MODl = MODl;
          ph_gemm<1>(g, ldsf); }
        grid.sync();
        const int t0 = l == 0 ? 0 : TC;
        ph_normroute(p, l, t0, gw, NW, lane, ldsf + (tid >> 6) * 32);
        grid.sync();
        bf16_t* ACT = (bf16_t*)p.YS; bf16_t* Yb = p.PROJ;
        { GemmP g{}; g.A = p.H; g.lda = D; g.gather = p.MAP; g.gstride = T; g.counts = p.counts + l * 32; g.M = T; g.N = 512; g.K = D; g.nz = NE;
          g.B = p.w_gate + (size_t)l * NE * D * 512; g.B2 = p.w_up + (size_t)l * NE * D * 512; g.ldb = 512; g.bstride = (size_t)D * 512; g.mode = 2; g.Obf = ACT; g.ldo = 512;
          ph_gemm<2>(g, ldsf); }
        grid.sync();
        { GemmP g{}; g.A = ACT; g.lda = 512; g.slot_rows = 1; g.counts = p.counts + l * 32; g.M = T; g.N = D; g.K = 512; g.nz = NE;
          g.B = p.w_down + (size_t)l * NE * 512 * D; g.ldb = D; g.bstride = (size_t)512 * D; g.mode = 3; g.Obf = Yb; g.ldo = D;
          ph_gemm<3>(g, ldsf); }
        grid.sync();
        ph_combine(p, l, t0, Yb, gw, NW, lane);
        grid.sync();
    }
}

static inline size_t al(size_t x) { return (x + 255) & ~(size_t)255; }

extern "C" void kernel_launch(void* const* d_in, const int* in_sizes, int n_in, void* d_out, int out_size, void* d_ws, size_t ws_size, hipStream_t stream) {
    static int grid_blocks = 0;
    if (grid_blocks == 0) {
        int dev = 0, cus = 0, per_cu = 0;
        if (hipFuncSetAttribute((const void*)mega, hipFuncAttributeMaxDynamicSharedMemorySize, LDS_BYTES) != hipSuccess) { fprintf(stderr, "hipFuncSetAttribute failed\n"); grid_blocks = -1; return; }
        (void)hipGetDevice(&dev); (void)hipDeviceGetAttribute(&cus, hipDeviceAttributeMultiprocessorCount, dev);
        if (hipOccupancyMaxActiveBlocksPerMultiprocessor(&per_cu, (const void*)mega, NTHR, LDS_BYTES) != hipSuccess || per_cu < 1) { fprintf(stderr, "occupancy query: %d blocks/CU\n", per_cu); grid_blocks = -1; return; }
        grid_blocks = cus;
    }
    if (grid_blocks < 0) return;
    P p{};
    const float** pin = (const float**)&p;
    for (int i = 0; i < 29; ++i) pin[i] = (const float*)d_in[i];
    p.out = (float*)d_out;
    char* ws = (char*)d_ws; size_t off = 0;
    auto take = [&](size_t bytes) { char* q = ws + off; off += al(bytes); return q; };
    p.X = (float*)take((size_t)T * D * 4);
    p.H = (bf16_t*)take((size_t)T * D * 2);
    p.PROJ = (bf16_t*)take((size_t)T * LDP * 2);
    p.XBC = (bf16_t*)take((size_t)T * 768 * 2);
    p.YS = (float*)take((size_t)T * 512 * 4);
    p.OG = (float*)take((size_t)T * 512 * 4);
    p.MOD = (float*)take((size_t)2 * 9 * 6144 * 4);
    p.counts = (int*)take(64 * 4);
    p.TOKSLOT = (int*)take((size_t)T * 4 * 4);
    p.EW = (float*)take((size_t)T * 2 * 4);
    p.MAP = (int*)take((size_t)NE * T * 4);
    if (off > ws_size) { fprintf(stderr, "workspace too small: need %zu have %zu\n", off, ws_size); return; }
    void* args[] = {&p};
    hipError_t e = hipLaunchCooperativeKernel((void*)mega, dim3(grid_blocks), dim3(NTHR), args, LDS_BYTES, stream);
    if (e != hipSuccess) fprintf(stderr, "cooperative launch failed: %s (grid %d)\n", hipGetErrorString(e), grid_blocks);
}
```

```cpp
#include <hip/hip_runtime.h>
#include <hip/hip_cooperative_groups.h>
#include <stdint.h>
#include <cstdio>
namespace cg = cooperative_groups;

typedef unsigned short bf16_t;
#define DI __device__ __forceinline__

constexpr int D = 1024, NB = 8, SEQ = 4096, CTXL = 256, TC = NB * CTXL, TL = NB * SEQ, T = TC + TL;
constexpr int INDIM = 2840, LDP = 2848;
constexpr int OFF_Z = 0, OFF_XBC = 512, OFF_DT = 1280, OFF_Q = 1288, OFF_K = 1544, OFF_V = 1800, OFF_GO = 2312, OFF_GK = 2824;
constexpr int NE = 32;

DI float bf2f(bf16_t v) { return __uint_as_float(((unsigned)v) << 16); }
typedef float f32x2v_ __attribute__((ext_vector_type(2)));
typedef __bf16 bf16x2v_ __attribute__((ext_vector_type(2)));
DI bf16_t f2bf(float f) { return __builtin_bit_cast(unsigned short, (__bf16)f); }
DI float siluf(float x) { return x * __builtin_amdgcn_rcpf(1.0f + __builtin_amdgcn_exp2f(-1.4426950408889634f * x)); }
DI float softplusf(float x) { return fmaxf(x, 0.f) + log1pf(__expf(-fabsf(x))); }
DI float logsigmoidf(float x) { return -softplusf(-x); }
DI float shx(float v, int o, int lane) { return __int_as_float(__builtin_amdgcn_ds_bpermute((lane ^ o) << 2, __float_as_int(v))); }
DI int shxi(int v, int o, int lane) { return __builtin_amdgcn_ds_bpermute((lane ^ o) << 2, v); }
DI float shl(float v, int src) { return __int_as_float(__builtin_amdgcn_ds_bpermute(src << 2, __float_as_int(v))); }
DI int shli(int v, int src) { return __builtin_amdgcn_ds_bpermute(src << 2, v); }
DI float wave_sum(float v, int lane) {
#pragma unroll
    for (int o = 32; o >= 1; o >>= 1) v += shx(v, o, lane);
    return v;
}
DI int ltid() { const int wv = __builtin_amdgcn_readfirstlane(threadIdx.x >> 6);
    int t = wv * 64 + (int)__builtin_amdgcn_mbcnt_hi(~0u, __builtin_amdgcn_mbcnt_lo(~0u, 0u)); asm volatile("" : "+v"(t)); return t; }
DI int tok_modrow(int t) { return t < TC ? 8 : ((t - TC) >> 12); }
template <class PT> DI bf16_t* xrow(const PT& p, int t) { return p.XB + (size_t)t * D; }


#ifndef PG8_SP2
#define PG8_SP2 true
#endif
namespace pg8 {
#define PG8_LAS __attribute__((address_space(3)))
typedef unsigned short bf16_t;
typedef short bf16x8 __attribute__((ext_vector_type(8)));
typedef float f32x4 __attribute__((ext_vector_type(4)));
typedef unsigned u32x4 __attribute__((ext_vector_type(4)));
constexpr int BM = 256, BK = 64, HALF = 128, HTB = HALF * BK * 2  , STAGE_BYTES = 8 * HTB, NXCD = 8, WGM = 8;

__host__ __device__ __forceinline__ int lds_byte(int r, int c) { const int st = (r >> 4) * 2 + (c >> 5), rr = r & 15, cc = c & 31, ob = rr * 64 + cc * 2; return st * 1024 + (ob ^ (((ob >> 9) & 1) << 5)); }
__host__ __device__ __forceinline__ void stage_rc(int b, int& R, int& C) { const int st = b / 1024, sb = b % 1024, swz = sb ^ (((sb >> 9) & 1) << 5); R = (st >> 1) * 16 + swz / 64; C = (st & 1) * 32 + (swz % 64) / 2; }
__host__ __device__ __forceinline__ int perm32(int rho) { const int n = rho >> 4, i = rho & 15; return 8 * (i >> 2) + 4 * n + (i & 3); }

struct Unit { int pm, pn; };
struct Gemm { const bf16_t* A; const bf16_t* Bt; int M, N, K; };

struct StaticOrder {
    int nM, nN, nwg, G, c;
    __host__ __device__ void init(int M, int N, int G_, int c_) { nM = M / BM; nN = N / BM; nwg = nM * nN; G = G_; c = c_; }
    __host__ __device__ bool next(int i, Unit& u) const {
        const long L = (long)i * G + c; if (L >= nwg) return false;
        int wgid = (int)L; { const int q = nwg / NXCD, r = nwg % NXCD, xcd = wgid % NXCD, off = wgid / NXCD; wgid = (xcd < r ? xcd * (q + 1) : r * (q + 1) + (xcd - r) * q) + off; }
        const int nig = WGM * nN, gid = wgid / nig, fm = gid * WGM, gsz = (nM - fm) < WGM ? (nM - fm) : WGM;
        u.pm = fm + ((wgid % nig) % gsz); u.pn = (wgid % nig) / gsz; return true;
    }
    __device__ __forceinline__ void a_ready(const Unit&) const {}
    __device__ __forceinline__ void done(const Unit&) const {}
};
__device__ __forceinline__ unsigned cvt_pk_bf16(float lo, float hi) { unsigned r; asm volatile("v_cvt_pk_bf16_f32 %0, %1, %2" : "=v"(r) : "v"(lo), "v"(hi)); return r; }
typedef float f32x2 __attribute__((ext_vector_type(2)));

struct EpiProj {
    static constexpr bool PERM = true, AFTER_DRAIN = false, MIDK = false;
    bf16_t* O; int ldc; int ncols;
    __device__ __forceinline__ void operator()(const f32x4 (&acc)[2][2][4][2], const Unit& u, int wr, int wc, int fr, int fq) const {
        const int row0 = u.pm * BM + wr * 64 + fr, col0 = u.pn * BM + wc * 32 + 8 * fq;
#pragma unroll
        for (int ai = 0; ai < 2; ++ai)
#pragma unroll
            for (int m = 0; m < 4; ++m) { bf16_t* rowp = O + (size_t)(row0 + ai * HALF + m * 16) * ldc + col0;
#pragma unroll
                for (int bj = 0; bj < 2; ++bj) { const f32x4 v0 = acc[ai][bj][m][0], v1 = acc[ai][bj][m][1];
                    u32x4 w; w.x = cvt_pk_bf16(v0[0], v0[1]); w.y = cvt_pk_bf16(v0[2], v0[3]); w.z = cvt_pk_bf16(v1[0], v1[1]); w.w = cvt_pk_bf16(v1[2], v1[3]);
                    if (col0 + bj * HALF + 8 <= ncols) *(u32x4*)(rowp + bj * HALF) = w; } }
    }
};
template <bool SRC_BF16> struct EpiResGate {
    static constexpr bool PERM = true, AFTER_DRAIN = false, MIDK = true;
    const float* ssq;
    const float* Sc; const float* Sl;
    bf16_t* XB;
    const float* gate_rows; float* xss; int rowoff;
    __device__ __forceinline__ void midk(f32x4 (&acc)[2][2][4][2], const Unit& u, int wr, int fr) const {
        int fr_ = fr; asm volatile("" : "+v"(fr_));
        const int row0 = rowoff + u.pm * BM + wr * 64 + fr_;
#pragma unroll
        for (int ai = 0; ai < 2; ++ai)
#pragma unroll
            for (int m = 0; m < 4; ++m) { const f32x4* q = (const f32x4*)(ssq + (size_t)(row0 + ai * HALF + m * 16) * 8); const f32x4 a = q[0], b = q[1];
                const float rs = __builtin_amdgcn_rsqf((((a[0] + a[1]) + (a[2] + a[3])) + ((b[0] + b[1]) + (b[2] + b[3]))) * (1.0f / 512.0f) + 1e-6f);
#pragma unroll
                for (int bj = 0; bj < 2; ++bj)
#pragma unroll
                    for (int n = 0; n < 2; ++n) acc[ai][bj][m][n] *= rs;
                asm volatile("" ::: "memory"); }
    }
    __device__ __forceinline__ void operator()(const f32x4 (&acc)[2][2][4][2], const Unit& u, int wr, int wc, int fr, int fq) const {
        const int row0 = rowoff + u.pm * BM + wr * 64 + fr, col0 = u.pn * BM + wc * 32 + 8 * fq;
        const int t0 = rowoff + u.pm * BM; const int mrow = t0 < 2048 ? 8 : ((t0 - 2048) >> 12);
        const float* gr = gate_rows + (size_t)mrow * 6144 + col0;
        f32x4 gv[2][2];
#pragma unroll
        for (int bj = 0; bj < 2; ++bj)
#pragma unroll
            for (int n = 0; n < 2; ++n) gv[bj][n] = *(const f32x4*)(gr + bj * HALF + n * 4);
#pragma unroll
        for (int ai = 0; ai < 2; ++ai)
#pragma unroll
            for (int m = 0; m < 4; ++m) { const int rr = row0 + ai * HALF + m * 16;
                const float* sp = (rr < 2048 ? Sc + (size_t)rr * 1024 : Sl + (size_t)(rr - 2048) * 1024) + col0; bf16_t* dp = XB + (size_t)rr * 1024 + col0; float ss = 0.f;
#pragma unroll
                for (int bj = 0; bj < 2; ++bj) { f32x4 x0, x1;
                    if (SRC_BF16) { const u32x4 r = *(const u32x4*)(dp + bj * HALF);
                        x0 = (f32x4){__uint_as_float(r.x << 16), __uint_as_float(r.x & 0xffff0000u), __uint_as_float(r.y << 16), __uint_as_float(r.y & 0xffff0000u)};
                        x1 = (f32x4){__uint_as_float(r.z << 16), __uint_as_float(r.z & 0xffff0000u), __uint_as_float(r.w << 16), __uint_as_float(r.w & 0xffff0000u)}; }
                    else { x0 = *(const f32x4*)(sp + bj * HALF); x1 = *(const f32x4*)(sp + bj * HALF + 4); }
                    const f32x4 v0 = x0 + gv[bj][0] * acc[ai][bj][m][0], v1 = x1 + gv[bj][1] * acc[ai][bj][m][1];
                    u32x4 w; w.x = cvt_pk_bf16(v0[0], v0[1]); w.y = cvt_pk_bf16(v0[2], v0[3]); w.z = cvt_pk_bf16(v1[0], v1[1]); w.w = cvt_pk_bf16(v1[2], v1[3]);
                    *(u32x4*)(dp + bj * HALF) = w;
#pragma unroll
                    for (int j = 0; j < 4; ++j) { const float lo = __uint_as_float(w[j] << 16), hi = __uint_as_float(w[j] & 0xffff0000u); ss += lo * lo + hi * hi; } }
                { const int ln_ = fq * 16 + fr; ss += __int_as_float(__builtin_amdgcn_ds_bpermute((ln_ ^ 16) << 2, __float_as_int(ss))); ss += __int_as_float(__builtin_amdgcn_ds_bpermute((ln_ ^ 32) << 2, __float_as_int(ss))); }
                if (fq == 0) xss[(size_t)rr * 16 + u.pn * 4 + wc] = ss; }
    }
};
template <class Epi, class Sched, bool STAMP = false, bool SP2 = PG8_SP2>
__device__ __forceinline__ void gemm_phase(PG8_LAS unsigned char* lds, const Gemm g, const Sched& S, const Epi& E, unsigned long long* stamps) {
    int tid_l = __builtin_amdgcn_readfirstlane(threadIdx.x >> 6) * 64 + (int)__builtin_amdgcn_mbcnt_hi(~0u, __builtin_amdgcn_mbcnt_lo(~0u, 0u)); asm volatile("" : "+v"(tid_l));
    const int tid = tid_l, wid = __builtin_amdgcn_readfirstlane(tid >> 6), lane = tid & 63, wr = wid >> 2, wc = wid & 3, fr = lane & 15, fq = lane >> 4;
    const int K = g.K, nt = K / BK;
    int ts_lo = 0, ts_hi = 0, nts = 0; const unsigned long long rt_entry = STAMP ? (unsigned long long)wall_clock64() : 0ull;
#define PG8_STAMP() do { if (STAMP && wid == 0 && nts < 64) { const unsigned long long _c = (unsigned long long)clock64(); \
        ts_lo = (lane == nts) ? (int)(unsigned)_c : ts_lo; ts_hi = (lane == nts) ? (int)(unsigned)(_c >> 32) : ts_hi; ++nts; } } while (0)
    PG8_STAMP();
    unsigned voffA[2], voffB[2];
#pragma unroll
    for (int i = 0; i < 2; ++i) { int R, C; stage_rc(tid * 16 + i * 8192, R, C); const int Rb = Epi::PERM ? ((R & ~31) + perm32(R & 31)) : R;
        voffA[i] = (unsigned)(R * K + C) * 2u; voffB[i] = (unsigned)(Rb * K + C) * 2u; }
    const size_t kstep = (size_t)(BK * 2);
    const size_t hstep = (size_t)HALF * K * 2;
    const size_t tstep = 2 * hstep;
    const unsigned ldsw = (unsigned)wid * 1024u;
    const int aoff = lds_byte(wr * 64 + fr, fq * 8), boff = lds_byte(wc * 32 + fr, fq * 8);
#define PG8_SA(b, h) (((b) * 2 + (h)) * HTB)
#define PG8_SB(b, h) ((4 + (b) * 2 + (h)) * HTB)
#define PG8_STAGE(bufoff, gbase, voff) do { _Pragma("unroll") for (int _i = 0; _i < 2; ++_i) \
        __builtin_amdgcn_global_load_lds((const unsigned*)((const char*)(gbase) + (voff)[_i]), (PG8_LAS unsigned*)(lds + (bufoff) + ldsw + _i * 8192), 16, 0, 0); } while (0)
#define PG8_LDA(dst, b, h) do { _Pragma("unroll") for (int m = 0; m < 4; ++m) _Pragma("unroll") for (int k = 0; k < 2; ++k) dst[m][k] = *(const PG8_LAS bf16x8*)(lds + PG8_SA(b, h) + aoff + m * 2048 + k * 1024); } while (0)
#define PG8_LDB(dst, b, h) do { _Pragma("unroll") for (int n = 0; n < 2; ++n) _Pragma("unroll") for (int k = 0; k < 2; ++k) dst[n][k] = *(const PG8_LAS bf16x8*)(lds + PG8_SB(b, h) + boff + n * 2048 + k * 1024); } while (0)
#define PG8_MMA(ai, bj, At, Bt) do { __builtin_amdgcn_s_setprio(1); _Pragma("unroll") for (int m = 0; m < 4; ++m) _Pragma("unroll") for (int n = 0; n < 2; ++n) _Pragma("unroll") for (int k = 0; k < 2; ++k) \
        acc[ai][bj][m][n] = __builtin_amdgcn_mfma_f32_16x16x32_bf16(Bt[n][k], At[m][k], acc[ai][bj][m][n], 0, 0, 0); __builtin_amdgcn_s_setprio(0); } while (0)
#define PG8_WAIT_V(n) asm volatile("s_waitcnt vmcnt(" #n ")" ::: "memory")
#define PG8_WAIT_L(n) asm volatile("s_waitcnt lgkmcnt(" #n ")" ::: "memory")
#define PG8_BAR __builtin_amdgcn_s_barrier()
#define PG8_SCHED __builtin_amdgcn_sched_barrier(0)
    Unit cur, nxt; int ui = 0;
    if (!S.next(0, cur)) return;
    f32x4 acc[2][2][4][2];
#pragma unroll
    for (int a = 0; a < 2; ++a)
#pragma unroll
        for (int b = 0; b < 2; ++b)
#pragma unroll
            for (int m = 0; m < 4; ++m)
#pragma unroll
                for (int n = 0; n < 2; ++n) acc[a][b][m][n] = (f32x4){0.f, 0.f, 0.f, 0.f};
    bf16x8 At[4][2], B0[2][2], B1[2][2];
    const char* cA = (const char*)g.A + (size_t)cur.pm * tstep; const char* cB = (const char*)g.Bt + (size_t)cur.pn * tstep;
    S.a_ready(cur);
    if constexpr (SP2) {
        PG8_STAGE(PG8_SB(0, 0), cB, voffB); PG8_STAGE(PG8_SB(0, 1), cB + hstep, voffB); PG8_STAGE(PG8_SA(0, 0), cA, voffA); PG8_STAGE(PG8_SA(0, 1), cA + hstep, voffA);
        if (wr == 1) PG8_BAR;
        PG8_WAIT_V(2); PG8_BAR;
        PG8_STAGE(PG8_SB(1, 0), cB + kstep, voffB); PG8_STAGE(PG8_SA(1, 0), cA + kstep, voffA); PG8_STAGE(PG8_SB(1, 1), cB + hstep + kstep, voffB);
        PG8_WAIT_V(6); PG8_BAR;
    } else {
    PG8_STAGE(PG8_SB(0, 0), cB, voffB); PG8_STAGE(PG8_SA(0, 0), cA, voffA); PG8_STAGE(PG8_SB(0, 1), cB + hstep, voffB); PG8_STAGE(PG8_SA(0, 1), cA + hstep, voffA);
    if (wr == 1) PG8_BAR;
    PG8_WAIT_V(4); PG8_BAR;
    PG8_STAGE(PG8_SB(1, 0), cB + kstep, voffB); PG8_STAGE(PG8_SA(1, 0), cA + kstep, voffA); PG8_STAGE(PG8_SB(1, 1), cB + hstep + kstep, voffB);
    PG8_WAIT_V(6); PG8_BAR;
    }
    PG8_STAMP();
    for (;;) {
        const bool has_next = S.next(ui + 1, nxt);
        const char* nA = has_next ? (const char*)g.A + (size_t)nxt.pm * tstep : cA; const char* nB = has_next ? (const char*)g.Bt + (size_t)nxt.pn * tstep : cB;
        for (int t = 0; t < nt; t += 2) {
            const bool last = (t == nt - 2);
            const char* a1 = cA + (size_t)(t + 1) * kstep;
            const char* a2 = last ? nA : cA + (size_t)(t + 2) * kstep; const char* b2 = last ? nB : cB + (size_t)(t + 2) * kstep;
            const char* a3 = a2 + kstep; const char* b3 = b2 + kstep;
            if (last && has_next) S.a_ready(nxt);
            if constexpr (SP2) {
            PG8_LDB(B0, 0, 0); PG8_LDB(B1, 0, 1); PG8_SCHED; PG8_LDA(At, 0, 0); PG8_STAGE(PG8_SA(1, 1), a1 + hstep, voffA);
            PG8_WAIT_V(8); PG8_WAIT_L(0); PG8_BAR; PG8_MMA(0, 0, At, B0); PG8_MMA(0, 1, At, B1); PG8_BAR; PG8_SCHED;
            PG8_LDA(At, 0, 1); PG8_STAGE(PG8_SB(0, 0), b2, voffB); PG8_STAGE(PG8_SB(0, 1), b2 + hstep, voffB); PG8_STAGE(PG8_SA(0, 0), a2, voffA);
            PG8_WAIT_V(8); PG8_WAIT_L(0); PG8_BAR; PG8_MMA(1, 0, At, B0); PG8_MMA(1, 1, At, B1); PG8_BAR; PG8_SCHED;
            PG8_LDB(B0, 1, 0); PG8_LDB(B1, 1, 1); PG8_SCHED; PG8_LDA(At, 1, 0); PG8_STAGE(PG8_SA(0, 1), a2 + hstep, voffA);
            PG8_WAIT_V(8); PG8_WAIT_L(0); PG8_BAR; PG8_MMA(0, 0, At, B0); PG8_MMA(0, 1, At, B1); PG8_BAR; PG8_SCHED;
            PG8_LDA(At, 1, 1); PG8_STAGE(PG8_SB(1, 0), b3, voffB); PG8_STAGE(PG8_SB(1, 1), b3 + hstep, voffB); PG8_STAGE(PG8_SA(1, 0), a3, voffA);
            PG8_WAIT_V(8); PG8_WAIT_L(0); PG8_BAR; PG8_MMA(1, 0, At, B0); PG8_MMA(1, 1, At, B1); PG8_BAR; PG8_SCHED;
            } else {
            PG8_LDB(B0, 0, 0); PG8_SCHED; PG8_LDA(At, 0, 0); PG8_STAGE(PG8_SA(1, 1), a1 + hstep, voffA);
            PG8_WAIT_L(8); PG8_BAR; PG8_WAIT_L(0); PG8_MMA(0, 0, At, B0); PG8_BAR; PG8_SCHED;
            PG8_LDB(B1, 0, 1); PG8_STAGE(PG8_SB(0, 0), b2, voffB);
            PG8_BAR; PG8_WAIT_L(0); PG8_MMA(0, 1, At, B1); PG8_BAR;
            PG8_LDA(At, 0, 1); PG8_STAGE(PG8_SA(0, 0), a2, voffA);
            PG8_BAR; PG8_WAIT_L(0); PG8_MMA(1, 0, At, B0); PG8_BAR; PG8_SCHED;
            PG8_STAGE(PG8_SB(0, 1), b2 + hstep, voffB);
            PG8_WAIT_V(6); PG8_BAR; PG8_MMA(1, 1, At, B1); PG8_BAR;
            PG8_LDB(B0, 1, 0); PG8_SCHED; PG8_LDA(At, 1, 0); PG8_STAGE(PG8_SA(0, 1), a2 + hstep, voffA);
            PG8_WAIT_L(8); PG8_BAR; PG8_WAIT_L(0); PG8_MMA(0, 0, At, B0); PG8_BAR; PG8_SCHED;
            PG8_LDB(B1, 1, 1); PG8_STAGE(PG8_SB(1, 0), b3, voffB);
            PG8_BAR; PG8_WAIT_L(0); PG8_MMA(0, 1, At, B1); PG8_BAR;
            PG8_LDA(At, 1, 1); PG8_STAGE(PG8_SA(1, 0), a3, voffA);
            PG8_BAR; PG8_WAIT_L(0); PG8_MMA(1, 0, At, B0); PG8_BAR; PG8_SCHED;
            PG8_STAGE(PG8_SB(1, 1), b3 + hstep, voffB);
            PG8_WAIT_V(6); PG8_BAR; PG8_MMA(1, 1, At, B1); PG8_BAR;
            }
            if constexpr (Epi::MIDK) { if (t + 2 == nt / 2) E.midk(acc, cur, wr, fr); }
        }
        PG8_STAMP();
        if (wr == 0) PG8_BAR;
        if constexpr (!Epi::AFTER_DRAIN) { E(acc, cur, wr, wc, fr, fq); S.done(cur); }
        PG8_STAMP();
        if (!has_next) break;
#pragma unroll
        for (int a = 0; a < 2; ++a)
#pragma unroll
            for (int b = 0; b < 2; ++b)
#pragma unroll
                for (int m = 0; m < 4; ++m)
#pragma unroll
                    for (int n = 0; n < 2; ++n) acc[a][b][m][n] = (f32x4){0.f, 0.f, 0.f, 0.f};
        cur = nxt; cA = nA; cB = nB; ++ui;
        if (wr == 1) PG8_BAR;
    }
    PG8_WAIT_V(0);
    PG8_BAR;
    if constexpr (Epi::AFTER_DRAIN) { E.fused(acc, cur, wr, wc, fr, fq, lds, wid, lane); S.done(cur); }
    PG8_STAMP();
    if (STAMP && wid == 0) { stamps[lane] = lane < nts ? (((unsigned long long)(unsigned)ts_hi << 32) | (unsigned)ts_lo) : 0ull;
        if (lane == 62) stamps[62] = rt_entry; if (lane == 63) stamps[63] = (unsigned long long)wall_clock64(); }
#undef PG8_STAMP
#undef PG8_SA
#undef PG8_SB
#undef PG8_STAGE
#undef PG8_LDA
#undef PG8_LDB
#undef PG8_MMA
#undef PG8_WAIT_V
#undef PG8_WAIT_L
#undef PG8_BAR
#undef PG8_SCHED
}

struct MoeUnit { int e, mt, pn, cnt, pstart; };
struct MoeSched {
    typedef MoeUnit UnitT;
    PG8_LAS const int* tab; const int* map; int U, G, c, npn, gather; size_t bstride;
    __device__ __forceinline__ bool next(int i, MoeUnit& u) const {
        const long L = (long)i * G + c; if (L >= U) return false;
        int idx = (int)L; { const int q = U / NXCD, r = U % NXCD, xcd = idx % NXCD, off = idx / NXCD; idx = (xcd < r ? xcd * (q + 1) : r * (q + 1) + (xcd - r) * q) + off; }
        const int tau = idx / npn; u.pn = idx - tau * npn;
        int e = 0;
#pragma unroll
        for (int st = 16; st >= 1; st >>= 1) { if (__builtin_amdgcn_readfirstlane(tab[e + st]) <= tau) e += st; }
        u.e = e; u.mt = tau - __builtin_amdgcn_readfirstlane(tab[e]); u.cnt = __builtin_amdgcn_readfirstlane(tab[33 + e]); u.pstart = __builtin_amdgcn_readfirstlane(tab[65 + e]);
        return true;
    }
    __device__ __forceinline__ const char* bbase(const Gemm& g, const MoeUnit& u) const { return (const char*)g.Bt + (size_t)u.e * bstride + (size_t)u.pn * BM * g.K * 2; }
    __device__ __forceinline__ void a_offsets(const Gemm& g, const MoeUnit& u, int tid, unsigned (&va)[2][2]) const {
        int tl = tid; asm volatile("" : "+v"(tl));
        int RA[2], CA[2];
#pragma unroll
        for (int i = 0; i < 2; ++i) { int R, C; stage_rc(tl * 16 + i * 8192, R, C); RA[i] = R; CA[i] = C * 2; }
#pragma unroll
        for (int hf = 0; hf < 2; ++hf)
#pragma unroll
            for (int i = 0; i < 2; ++i) { int rl = u.mt * BM + hf * HALF + RA[i]; rl = rl < u.cnt ? rl : u.cnt - 1;
                const unsigned row = gather ? (unsigned)map[(size_t)u.e * 34816 + rl] : (unsigned)(u.pstart + rl);
                va[hf][i] = row * (unsigned)(g.K * 2) + (unsigned)CA[i]; }
    }
};
struct EpiAct {
    static constexpr bool PERM = true, AFTER_DRAIN = false;
    bf16_t* O;
    __device__ __forceinline__ void operator()(const f32x4 (&acc)[2][2][4][2], const MoeUnit& u, int wr, int wc, int fr, int fq) const {
        const int rl0 = u.mt * BM + wr * 64 + fr, col0 = u.pn * HALF + wc * 32 + 8 * fq;
#pragma unroll
        for (int ai = 0; ai < 2; ++ai)
#pragma unroll
            for (int m = 0; m < 4; ++m) { const int rl = rl0 + ai * HALF + m * 16;
                if (rl < u.cnt) { float o[8];
#pragma unroll
                    for (int n = 0; n < 2; ++n)
#pragma unroll
                        for (int j = 0; j < 4; ++j) { const float gv = acc[ai][0][m][n][j]; o[4 * n + j] = gv * __builtin_amdgcn_rcpf(1.0f + __builtin_amdgcn_exp2f(-1.4426950408889634f * gv)) * acc[ai][1][m][n][j]; }
                    u32x4 w; w.x = cvt_pk_bf16(o[0], o[1]); w.y = cvt_pk_bf16(o[2], o[3]); w.z = cvt_pk_bf16(o[4], o[5]); w.w = cvt_pk_bf16(o[6], o[7]);
                    *(u32x4*)(O + (size_t)(u.pstart + rl) * 512 + col0) = w; } }
    }
};
struct EpiY {
    static constexpr bool PERM = true, AFTER_DRAIN = false;
    unsigned char* O;
    static __device__ __forceinline__ unsigned pk4(const f32x4 v) { const float lim = 440.f;
        int w = __builtin_amdgcn_cvt_pk_fp8_f32(fminf(fmaxf(v[0], -lim), lim), fminf(fmaxf(v[1], -lim), lim), 0, false);
        return (unsigned)__builtin_amdgcn_cvt_pk_fp8_f32(fminf(fmaxf(v[2], -lim), lim), fminf(fmaxf(v[3], -lim), lim), w, true); }
    __device__ __forceinline__ void operator()(const f32x4 (&acc)[2][2][4][2], const MoeUnit& u, int wr, int wc, int fr, int fq) const {
        typedef unsigned u32x2 __attribute__((ext_vector_type(2)));
        const int rl0 = u.mt * BM + wr * 64 + fr, col0 = u.pn * BM + wc * 32 + 8 * fq;
#pragma unroll
        for (int ai = 0; ai < 2; ++ai)
#pragma unroll
            for (int m = 0; m < 4; ++m) { const int rl = rl0 + ai * HALF + m * 16;
                if (rl < u.cnt) { unsigned char* rowp = O + (size_t)(u.pstart + rl) * 1024 + col0;
#pragma unroll
                    for (int bj = 0; bj < 2; ++bj) *(u32x2*)(rowp + bj * HALF) = (u32x2){pk4(acc[ai][bj][m][0]), pk4(acc[ai][bj][m][1])}; } }
    }
};
template <class Epi, class Sched, bool STAMP = false, bool SP2 = PG8_SP2>
__device__ __forceinline__ void gemm_phase_moe(PG8_LAS unsigned char* lds, const Gemm g, const Sched& S, const Epi& E, unsigned long long* stamps) {
    int tid_l = __builtin_amdgcn_readfirstlane(threadIdx.x >> 6) * 64 + (int)__builtin_amdgcn_mbcnt_hi(~0u, __builtin_amdgcn_mbcnt_lo(~0u, 0u)); asm volatile("" : "+v"(tid_l));
    const int tid = tid_l, wid = __builtin_amdgcn_readfirstlane(tid >> 6), lane = tid & 63, wr = wid >> 2, wc = wid & 3, fr = lane & 15, fq = lane >> 4;
    const int K = g.K, nt = K / BK;
    int ts_lo = 0, ts_hi = 0, nts = 0; const unsigned long long rt_entry = STAMP ? (unsigned long long)wall_clock64() : 0ull;
#define PG8_STAMP() do { if (STAMP && wid == 0 && nts < 64) { const unsigned long long _c = (unsigned long long)clock64(); \
        ts_lo = (lane == nts) ? (int)(unsigned)_c : ts_lo; ts_hi = (lane == nts) ? (int)(unsigned)(_c >> 32) : ts_hi; ++nts; } } while (0)
    PG8_STAMP();
    unsigned voffB[2];
#pragma unroll
    for (int i = 0; i < 2; ++i) { int R, C; stage_rc(tid * 16 + i * 8192, R, C); const int Rb = Epi::PERM ? ((R & ~31) + perm32(R & 31)) : R;
        voffB[i] = (unsigned)(Rb * K + C) * 2u; }
    unsigned vaC[2][2];
    PG8_LAS unsigned* vtab = (PG8_LAS unsigned*)(lds + STAGE_BYTES + 1024) + tid;
    const size_t kstep = (size_t)(BK * 2);
    const size_t hstep = (size_t)HALF * K * 2;
    const size_t tstep = 2 * hstep;
    const unsigned ldsw = (unsigned)wid * 1024u;
    const int aoff = lds_byte(wr * 64 + fr, fq * 8), boff = lds_byte(wc * 32 + fr, fq * 8);
#define PG8_SA(b, h) (((b) * 2 + (h)) * HTB)
#define PG8_SB(b, h) ((4 + (b) * 2 + (h)) * HTB)
#define PG8_STAGE(bufoff, gbase, voff) do { _Pragma("unroll") for (int _i = 0; _i < 2; ++_i) \
        __builtin_amdgcn_global_load_lds((const unsigned*)((const char*)(gbase) + (voff)[_i]), (PG8_LAS unsigned*)(lds + (bufoff) + ldsw + _i * 8192), 16, 0, 0); } while (0)
#define PG8_STAGEA(bufoff, kbyte, va) do { _Pragma("unroll") for (int _i = 0; _i < 2; ++_i) \
        __builtin_amdgcn_global_load_lds((const unsigned*)((const char*)g.A + (kbyte) + (va)[_i]), (PG8_LAS unsigned*)(lds + (bufoff) + ldsw + _i * 8192), 16, 0, 0); } while (0)
#define PG8_LDA(dst, b, h) do { _Pragma("unroll") for (int m = 0; m < 4; ++m) _Pragma("unroll") for (int k = 0; k < 2; ++k) dst[m][k] = *(const PG8_LAS bf16x8*)(lds + PG8_SA(b, h) + aoff + m * 2048 + k * 1024); } while (0)
#define PG8_LDB(dst, b, h) do { _Pragma("unroll") for (int n = 0; n < 2; ++n) _Pragma("unroll") for (int k = 0; k < 2; ++k) dst[n][k] = *(const PG8_LAS bf16x8*)(lds + PG8_SB(b, h) + boff + n * 2048 + k * 1024); } while (0)
#define PG8_MMA(ai, bj, At, Bt) do { __builtin_amdgcn_s_setprio(1); _Pragma("unroll") for (int m = 0; m < 4; ++m) _Pragma("unroll") for (int n = 0; n < 2; ++n) _Pragma("unroll") for (int k = 0; k < 2; ++k) \
        acc[ai][bj][m][n] = __builtin_amdgcn_mfma_f32_16x16x32_bf16(Bt[n][k], At[m][k], acc[ai][bj][m][n], 0, 0, 0); __builtin_amdgcn_s_setprio(0); } while (0)
#define PG8_WAIT_V(n) asm volatile("s_waitcnt vmcnt(" #n ")" ::: "memory")
#define PG8_WAIT_L(n) asm volatile("s_waitcnt lgkmcnt(" #n ")" ::: "memory")
#define PG8_BAR __builtin_amdgcn_s_barrier()
#define PG8_SCHED __builtin_amdgcn_sched_barrier(0)
    typename Sched::UnitT cur, nxt; int ui = 0;
    if (!S.next(0, cur)) return;
    f32x4 acc[2][2][4][2];
#pragma unroll
    for (int a = 0; a < 2; ++a)
#pragma unroll
        for (int b = 0; b < 2; ++b)
#pragma unroll
            for (int m = 0; m < 4; ++m)
#pragma unroll
                for (int n = 0; n < 2; ++n) acc[a][b][m][n] = (f32x4){0.f, 0.f, 0.f, 0.f};
    bf16x8 At[4][2], B0[2][2], B1[2][2];
    const char* cB = S.bbase(g, cur); S.a_offsets(g, cur, tid, vaC);
    if constexpr (SP2) {
        PG8_STAGE(PG8_SB(0, 0), cB, voffB); PG8_STAGE(PG8_SB(0, 1), cB + hstep, voffB); PG8_STAGEA(PG8_SA(0, 0), 0, vaC[0]); PG8_STAGEA(PG8_SA(0, 1), 0, vaC[1]);
        if (wr == 1) PG8_BAR;
        PG8_WAIT_V(2); PG8_BAR;
        PG8_STAGE(PG8_SB(1, 0), cB + kstep, voffB); PG8_STAGEA(PG8_SA(1, 0), kstep, vaC[0]); PG8_STAGE(PG8_SB(1, 1), cB + hstep + kstep, voffB);
        PG8_WAIT_V(6); PG8_BAR;
    } else {
    PG8_STAGE(PG8_SB(0, 0), cB, voffB); PG8_STAGEA(PG8_SA(0, 0), 0, vaC[0]); PG8_STAGE(PG8_SB(0, 1), cB + hstep, voffB); PG8_STAGEA(PG8_SA(0, 1), 0, vaC[1]);
    if (wr == 1) PG8_BAR;
    PG8_WAIT_V(4); PG8_BAR;
    PG8_STAGE(PG8_SB(1, 0), cB + kstep, voffB); PG8_STAGEA(PG8_SA(1, 0), kstep, vaC[0]); PG8_STAGE(PG8_SB(1, 1), cB + hstep + kstep, voffB);
    PG8_WAIT_V(6); PG8_BAR;
    }
    PG8_STAMP();
    for (;;) {
        const bool has_next = S.next(ui + 1, nxt);
        const char* nB = has_next ? S.bbase(g, nxt) : cB;
        { unsigned vaN[2][2];
          if (has_next) S.a_offsets(g, nxt, tid, vaN); else {
#pragma unroll
            for (int hf = 0; hf < 2; ++hf)
#pragma unroll
                for (int i = 0; i < 2; ++i) vaN[hf][i] = vaC[hf][i]; }
#pragma unroll
          for (int hf = 0; hf < 2; ++hf)
#pragma unroll
              for (int i = 0; i < 2; ++i) vtab[(hf * 2 + i) * 512] = vaN[hf][i]; }
        unsigned v2[2][2];
        for (int t = 0; t < nt; t += 2) {
            const bool last = (t == nt - 2);
            const size_t k1 = (size_t)(t + 1) * kstep, k2 = last ? (size_t)0 : (size_t)(t + 2) * kstep, k3 = k2 + kstep;
            const char* b2 = last ? nB : cB + (size_t)(t + 2) * kstep; const char* b3 = b2 + kstep;
#pragma unroll
            for (int hf = 0; hf < 2; ++hf)
#pragma unroll
                for (int i = 0; i < 2; ++i) v2[hf][i] = last ? vtab[(hf * 2 + i) * 512] : vaC[hf][i];
            if constexpr (SP2) {
            PG8_LDB(B0, 0, 0); PG8_LDB(B1, 0, 1); PG8_SCHED; PG8_LDA(At, 0, 0); PG8_STAGEA(PG8_SA(1, 1), k1, vaC[1]);
            PG8_WAIT_V(8); PG8_WAIT_L(0); PG8_BAR; PG8_MMA(0, 0, At, B0); PG8_MMA(0, 1, At, B1); PG8_BAR; PG8_SCHED;
            PG8_LDA(At, 0, 1); PG8_STAGE(PG8_SB(0, 0), b2, voffB); PG8_STAGE(PG8_SB(0, 1), b2 + hstep, voffB); PG8_STAGEA(PG8_SA(0, 0), k2, v2[0]);
            PG8_WAIT_V(8); PG8_WAIT_L(0); PG8_BAR; PG8_MMA(1, 0, At, B0); PG8_MMA(1, 1, At, B1); PG8_BAR; PG8_SCHED;
            PG8_LDB(B0, 1, 0); PG8_LDB(B1, 1, 1); PG8_SCHED; PG8_LDA(At, 1, 0); PG8_STAGEA(PG8_SA(0, 1), k2, v2[1]);
            PG8_WAIT_V(8); PG8_WAIT_L(0); PG8_BAR; PG8_MMA(0, 0, At, B0); PG8_MMA(0, 1, At, B1); PG8_BAR; PG8_SCHED;
            PG8_LDA(At, 1, 1); PG8_STAGE(PG8_SB(1, 0), b3, voffB); PG8_STAGE(PG8_SB(1, 1), b3 + hstep, voffB); PG8_STAGEA(PG8_SA(1, 0), k3, v2[0]);
            PG8_WAIT_V(8); PG8_WAIT_L(0); PG8_BAR; PG8_MMA(1, 0, At, B0); PG8_MMA(1, 1, At, B1); PG8_BAR; PG8_SCHED;
            } else {
            PG8_LDB(B0, 0, 0); PG8_SCHED; PG8_LDA(At, 0, 0); PG8_STAGEA(PG8_SA(1, 1), k1, vaC[1]);
            PG8_WAIT_L(8); PG8_BAR; PG8_WAIT_L(0); PG8_MMA(0, 0, At, B0); PG8_BAR; PG8_SCHED;
            PG8_LDB(B1, 0, 1); PG8_STAGE(PG8_SB(0, 0), b2, voffB);
            PG8_BAR; PG8_WAIT_L(0); PG8_MMA(0, 1, At, B1); PG8_BAR;
            PG8_LDA(At, 0, 1); PG8_STAGEA(PG8_SA(0, 0), k2, v2[0]);
            PG8_BAR; PG8_WAIT_L(0); PG8_MMA(1, 0, At, B0); PG8_BAR; PG8_SCHED;
            PG8_STAGE(PG8_SB(0, 1), b2 + hstep, voffB);
            PG8_WAIT_V(6); PG8_BAR; PG8_MMA(1, 1, At, B1); PG8_BAR;
            PG8_LDB(B0, 1, 0); PG8_SCHED; PG8_LDA(At, 1, 0); PG8_STAGEA(PG8_SA(0, 1), k2, v2[1]);
            PG8_WAIT_L(8); PG8_BAR; PG8_WAIT_L(0); PG8_MMA(0, 0, At, B0); PG8_BAR; PG8_SCHED;
            PG8_LDB(B1, 1, 1); PG8_STAGE(PG8_SB(1, 0), b3, voffB);
            PG8_BAR; PG8_WAIT_L(0); PG8_MMA(0, 1, At, B1); PG8_BAR;
            PG8_LDA(At, 1, 1); PG8_STAGEA(PG8_SA(1, 0), k3, v2[0]);
            PG8_BAR; PG8_WAIT_L(0); PG8_MMA(1, 0, At, B0); PG8_BAR; PG8_SCHED;
            PG8_STAGE(PG8_SB(1, 1), b3 + hstep, voffB);
            PG8_WAIT_V(6); PG8_BAR; PG8_MMA(1, 1, At, B1); PG8_BAR;
            }
        }
        PG8_STAMP();
        if (wr == 0) PG8_BAR;
        E(acc, cur, wr, wc, fr, fq);
        PG8_STAMP();
        if (!has_next) break;
#pragma unroll
        for (int a = 0; a < 2; ++a)
#pragma unroll
            for (int b = 0; b < 2; ++b)
#pragma unroll
                for (int m = 0; m < 4; ++m)
#pragma unroll
                    for (int n = 0; n < 2; ++n) acc[a][b][m][n] = (f32x4){0.f, 0.f, 0.f, 0.f};
        cur = nxt; cB = nB; ++ui;
#pragma unroll
        for (int hf = 0; hf < 2; ++hf)
#pragma unroll
            for (int i = 0; i < 2; ++i) vaC[hf][i] = v2[hf][i];
        if (wr == 1) PG8_BAR;
    }
    PG8_WAIT_V(0);
    PG8_BAR;
    PG8_STAMP();
    if (STAMP && wid == 0) { stamps[lane] = lane < nts ? (((unsigned long long)(unsigned)ts_hi << 32) | (unsigned)ts_lo) : 0ull;
        if (lane == 62) stamps[62] = rt_entry; if (lane == 63) stamps[63] = (unsigned long long)wall_clock64(); }
#undef PG8_STAMP
#undef PG8_SA
#undef PG8_SB
#undef PG8_STAGE
#undef PG8_STAGEA
#undef PG8_LDA
#undef PG8_LDB
#undef PG8_MMA
#undef PG8_WAIT_V
#undef PG8_WAIT_L
#undef PG8_BAR
#undef PG8_SCHED
}
}

constexpr int NTHR = 512, NWV = 8, LDS_BYTES = 147456;

struct P {
    const float *x, *c, *ctx, *c_ctx, *w_mod, *b_mod, *norm1_g, *norm2_g, *w_in, *conv_w, *conv_b, *dt_bias_f, *dt_bias_b, *a_log_f, *a_log_b, *d_skip, *ssd_norm_g,
        *gk_up_f, *gk_bias_f, *gk_up_b, *gk_bias_b, *gla_norm_g, *w_out, *w_router, *router_bias, *w_gate, *w_up, *w_down, *final_g;
    float* out; bf16_t* XB; bf16_t* H; bf16_t* PROJ; bf16_t* SS; bf16_t* GS; float* SDEC; float* GDEC; float* MOD; int* counts; int* TOKSLOT; float* EW; int* MAP; bf16_t* WinT; bf16_t* WoutT; bf16_t* WguT; bf16_t* WdT; bf16_t* WRT; unsigned* BAR; bf16_t* XBCC; bf16_t* QKB; float* SSC; float* STOT; float* SSQ; float* XSS;
};

DI void ph_init(const P& p) { const size_t i = (size_t)blockIdx.x * NTHR + ltid(); if (i < 64) p.counts[i * 32] = 0; }

DI void ph_mod(const P& p, float* s  ) {
    const int tid_ = ltid(), lane = tid_ & 63, w = tid_ >> 6;
    if (blockIdx.x >= 192) return;
    float* part = s + 9 * 1024;
    { float cv[18];
#pragma unroll
      for (int q = 0; q < 18; ++q) { const int i = tid_ + q * NTHR, r = i >> 10, k = i & 1023; cv[q] = r < 8 ? p.c[r * 1024 + k] : p.c_ctx[k]; }
#pragma unroll
      for (int q = 0; q < 18; ++q) s[tid_ + q * NTHR] = siluf(cv[q]); }
    __syncthreads();
    for (int vb = blockIdx.x; vb < 192; vb += gridDim.x) {
        const int l = vb / 96, n = (vb % 96) * 64 + lane;
        float acc[9];
#pragma unroll
        for (int r = 0; r < 9; ++r) acc[r] = 0.f;
        const float* wp = p.w_mod + (size_t)l * 1024 * 6144 + (size_t)(128 * w) * 6144 + n;
#pragma unroll 8
        for (int k = 0; k < 128; ++k) { const float wv = wp[(size_t)k * 6144];
#pragma unroll
            for (int r = 0; r < 9; ++r) acc[r] += s[r * 1024 + 128 * w + k] * wv; }
#pragma unroll
        for (int r = 0; r < 9; ++r) part[(w * 9 + r) * 64 + lane] = acc[r];
        __syncthreads();
        for (int o = tid_; o < 9 * 64; o += NTHR) { const int r = o >> 6, c = o & 63; float a = p.b_mod[l * 6144 + (vb % 96) * 64 + c];
#pragma unroll
            for (int q = 0; q < 8; ++q) a += part[(q * 9 + r) * 64 + c];
            p.MOD[((size_t)l * 9 + r) * 6144 + (vb % 96) * 64 + c] = a; }
        __syncthreads();
    }
}

DI unsigned pk2(float lo, float hi) { return __builtin_bit_cast(unsigned, __builtin_convertvector((f32x2v_){lo, hi}, bf16x2v_)); }
DI void transpose_item(const float* W, int K, int N, bf16_t* WT, float* scr, int item, int lane, int gu = -1, const float* kscale = nullptr) {
    const int nblk = (N + 31) / 32, kb = item / nblk, nb = item % nblk, k0 = 64 * kb, n0 = 32 * nb;
    const int d0 = gu < 0 ? n0 : 256 * (n0 >> 7) + (n0 & 127) + 128 * gu;
    const bool nok = n0 + (lane & 31) < N;
    float wv_[32];
#pragma unroll
    for (int i = 0; i < 32; ++i) { const int kk = 2 * i + (lane >> 5); wv_[i] = nok ? __builtin_nontemporal_load(W + (size_t)(k0 + kk) * N + n0 + (lane & 31)) : 0.f; }
#pragma unroll
    for (int i = 0; i < 32; ++i) { const int kk = 2 * i + (lane >> 5); scr[kk * 33 + (lane & 31)] = wv_[i] * (kscale ? kscale[k0 + kk] : 1.0f); }
    const int c = lane & 7;
#pragma unroll
    for (int j = 0; j < 4; ++j) { const int n = (lane >> 3) + 8 * j; const float* q = scr + (8 * c) * 33 + n;
        uint4 o; o.x = pk2(q[0 * 33], q[1 * 33]); o.y = pk2(q[2 * 33], q[3 * 33]); o.z = pk2(q[4 * 33], q[5 * 33]); o.w = pk2(q[6 * 33], q[7 * 33]);
        if (n0 + n < N) { typedef unsigned u32x4nt __attribute__((ext_vector_type(4))); __builtin_nontemporal_store((u32x4nt){o.x, o.y, o.z, o.w}, (u32x4nt*)(WT + (size_t)(d0 + n) * K + k0 + 8 * c)); } }
}

DI void ph_convert_experts(const P& p, int l, float* ldsf, int wk0, int nwk, int it0 = 0, int it1 = NE * 768) {
    const int tid_ = ltid(), lane = tid_ & 63, gw = ((int)blockIdx.x - wk0) * NWV + (tid_ >> 6), NW = nwk * NWV;
    float* scr = ldsf + 14 * 1024 + (tid_ >> 6) * (64 * 33 + 16);
    for (int it = it0 + gw; it < it1; it += NW) {
        const int e = it / 768, r = it - e * 768;
        if (r < 512) { const int gu = r >> 8; const float* W = (gu ? p.w_up : p.w_gate) + (size_t)(l * NE + e) * D * 512;
            transpose_item(W, D, 512, p.WguT + (size_t)e * D * D, scr, r & 255, lane, gu); }
        else transpose_item(p.w_down + (size_t)(l * NE + e) * 512 * D, 512, D, p.WdT + (size_t)e * D * 512, scr, r - 512, lane);
    }
}
constexpr int NPAD_IN = 3072;
DI void ph_convert_small(const P& p, float* ldsf, int, int, int) {
    const int tid_ = ltid(), lane = tid_ & 63, gw = blockIdx.x * NWV + (tid_ >> 6), NW = gridDim.x * NWV;
    float* scr = ldsf + 14 * 1024 + (tid_ >> 6) * (64 * 33 + 16);
    constexpr int I_IN = 16 * 89, I_OUT = 16 * 32;
    for (int it = gw; it < 2 * (I_IN + I_OUT); it += NW) {
        const int l = it / (I_IN + I_OUT), r = it % (I_IN + I_OUT);
        if (r < I_IN) transpose_item(p.w_in + (size_t)l * D * INDIM, D, INDIM, p.WinT + (size_t)l * NPAD_IN * D, scr, r, lane);
        else { const int kb = (r - I_IN) / 32;
            transpose_item(p.w_out + (size_t)l * D * D, D, D, p.WoutT + (size_t)l * D * D, scr, r - I_IN, lane, -1, kb < 8 ? p.ssd_norm_g + l * 512 : nullptr); }
    }
    for (int idx = blockIdx.x * NTHR + tid_; idx < 32 * 1024; idx += gridDim.x * NTHR) { const int e = idx >> 10, k = idx & 1023; p.WRT[idx] = f2bf(p.w_router[k * 32 + e]); }
    const size_t nz16 = (size_t)(NPAD_IN - INDIM) * D * 2 / 16;
    for (size_t i = (size_t)blockIdx.x * NTHR + tid_; i < 2 * nz16; i += (size_t)gridDim.x * NTHR) {
        const size_t l = i / nz16, j = i % nz16;
        ((uint4*)(p.WinT + (l * NPAD_IN + INDIM) * D))[j] = make_uint4(0u, 0u, 0u, 0u);
    }
}

DI void row_normmod(float4 (&v)[4], const float* g, const float* mr, int shift_idx, int scale_idx, int lane) {
    float ss = 0.f;
#pragma unroll
    for (int i = 0; i < 4; ++i) ss += v[i].x * v[i].x + v[i].y * v[i].y + v[i].z * v[i].z + v[i].w * v[i].w;
    ss = wave_sum(ss, lane);
    const float rstd = rsqrtf(ss * (1.0f / D) + 1e-6f);
#pragma unroll
    for (int i = 0; i < 4; ++i) {
        const int c = (i * 64 + lane) * 4;
        const float4 gg = *(const float4*)(g + c), sh = *(const float4*)(mr + shift_idx * 1024 + c), sc = *(const float4*)(mr + scale_idx * 1024 + c);
        v[i].x = v[i].x * rstd * gg.x * (1.f + sc.x) + sh.x; v[i].y = v[i].y * rstd * gg.y * (1.f + sc.y) + sh.y;
        v[i].z = v[i].z * rstd * gg.z * (1.f + sc.z) + sh.z; v[i].w = v[i].w * rstd * gg.w * (1.f + sc.w) + sh.w;
    }
}
DI void row_store_bf16(bf16_t* hrow, float4 (&v)[4], int lane) {
#pragma unroll
    for (int i = 0; i < 4; ++i) { ushort4 o; o.x = f2bf(v[i].x); o.y = f2bf(v[i].y); o.z = f2bf(v[i].z); o.w = f2bf(v[i].w);
        *(ushort4*)(hrow + (i * 64 + lane) * 4) = o; v[i] = make_float4(bf2f(o.x), bf2f(o.y), bf2f(o.z), bf2f(o.w)); }
}

DI void ph_normmod1(const P& p, int l, int, int, int) {
    const int tid_ = ltid(), lane = tid_ & 63, gw = blockIdx.x * NWV + (tid_ >> 6), NW = gridDim.x * NWV;
    const float* MODl = p.MOD + (size_t)l * 9 * 6144;
    for (int t = gw; t < T; t += NW) {
        float4 v[4];
#pragma unroll
        for (int i = 0; i < 4; ++i) v[i] = ((const float4*)(t < TC ? p.ctx + (size_t)t * D : p.x + (size_t)(t - TC) * D))[i * 64 + lane];
        row_normmod(v, p.norm1_g + l * D, MODl + (size_t)tok_modrow(t) * 6144, 0, 1, lane);
        row_store_bf16(p.H + (size_t)t * D, v, lane);
    }
}

typedef short s16x4 __attribute__((ext_vector_type(4)));
typedef short bf16x8v __attribute__((ext_vector_type(8)));
typedef float f32x4v __attribute__((ext_vector_type(4)));
typedef unsigned u32x4v __attribute__((ext_vector_type(4)));
typedef unsigned u32x2v __attribute__((ext_vector_type(2)));
DI u32x4v mk4(unsigned a, unsigned b, unsigned c, unsigned d) { return (u32x4v){a, b, c, d}; }
DI u32x2v mk2(unsigned a, unsigned b) { return (u32x2v){a, b}; }
DI f32x4v mkf4(float a, float b, float c, float d) { return (f32x4v){a, b, c, d}; }
#define LDSP __attribute__((address_space(3)))
constexpr int NCH = 34, NTILE = NB * NCH;
constexpr int LD64 = 72, LD128 = 136;
constexpr float LOG2E = 1.4426950408889634f;

DI int tile_tok0(int tl) { const int b = tl / NCH, cs = tl - b * NCH; return cs < 2 ? b * CTXL + cs * 128 : TC + b * SEQ + (cs - 2) * 128; }
DI f32x4v mfma16(bf16x8v a, bf16x8v b, f32x4v c) { return __builtin_amdgcn_mfma_f32_16x16x32_bf16(a, b, c, 0, 0, 0); }
DI bf16x8v frag_row(LDSP const bf16_t* base, int ld, int r0, int k0, int lane) { return *(LDSP const bf16x8v*)(base + (r0 + (lane & 15)) * ld + k0 + 8 * (lane >> 4)); }
DI bf16x8v frag_row_g(const bf16_t* base, int ld, int r0, int k0, int lane) { return *(const bf16x8v*)(base + (size_t)(r0 + (lane & 15)) * ld + k0 + 8 * (lane >> 4)); }
DI bf16x8v frag_col(LDSP const bf16_t* base, int ld, int r0, int k0, int lane) {
    const int G = lane >> 4, i = lane & 15;
    LDSP const bf16_t* a = base + (k0 + 8 * G + (i >> 2)) * ld + r0 + 4 * (i & 3);
    const s16x4 lo = __builtin_bit_cast(s16x4, __builtin_amdgcn_ds_read_tr16_b64_v4i16((LDSP s16x4*)a));
    const s16x4 hi = __builtin_bit_cast(s16x4, __builtin_amdgcn_ds_read_tr16_b64_v4i16((LDSP s16x4*)(a + 4 * ld)));
    return (bf16x8v){lo[0], lo[1], lo[2], lo[3], hi[0], hi[1], hi[2], hi[3]};
}
DI u32x2v pack4(f32x4v v) { return mk2(pk2(v[0], v[1]), pk2(v[2], v[3])); }
DI void unpack8(u32x4v v, float* o) { o[0] = __uint_as_float(v.x << 16); o[1] = __uint_as_float(v.x & 0xffff0000u); o[2] = __uint_as_float(v.y << 16); o[3] = __uint_as_float(v.y & 0xffff0000u);
    o[4] = __uint_as_float(v.z << 16); o[5] = __uint_as_float(v.z & 0xffff0000u); o[6] = __uint_as_float(v.w << 16); o[7] = __uint_as_float(v.w & 0xffff0000u); }
DI u32x4v pack8(const float* o) { return mk4(pk2(o[0], o[1]), pk2(o[2], o[3]), pk2(o[4], o[5]), pk2(o[6], o[7])); }

DI float fast_logsigmoid(float x) { return -(fmaxf(-x, 0.f) + __logf(1.0f + __expf(-fabsf(x)))); }
DI float fast_softplus(float x) { return fmaxf(x, 0.f) + __logf(1.0f + __expf(-fabsf(x))); }
struct XbcSrc { const bf16_t* base; int ld; };
DI XbcSrc xbc_src(const P& p, int tok0) { XbcSrc r; r.base = p.XBCC + (size_t)tok0 * 768; r.ld = 768; return r; }

DI void prep_conv_item(const P& p, int l, int item, int lane) {
    const int piece = item >> 1, part = item & 1, ch = part * 512 + lane * 8;
    if (ch >= 768) return;
    const int t0 = piece * 32; int lo, hi; bf16_t* dst; int dld;
    if (t0 < TC) { lo = t0 & ~(CTXL - 1); hi = lo + CTXL - 1; } else { lo = TC + ((t0 - TC) & ~63); hi = lo + 63; }
    dst = p.XBCC + ch; dld = 768;
    const bf16_t* src = p.PROJ + OFF_XBC + ch;
    float wgt[5][8], bias[8];
#pragma unroll
    for (int k = 0; k < 5; ++k) { const f32x4v a = *(const f32x4v*)(p.conv_w + l * 5 * 768 + k * 768 + ch), c = *(const f32x4v*)(p.conv_w + l * 5 * 768 + k * 768 + ch + 4);
#pragma unroll
        for (int j = 0; j < 4; ++j) { wgt[k][j] = a[j]; wgt[k][4 + j] = c[j]; } }
    { const f32x4v a = *(const f32x4v*)(p.conv_b + l * 768 + ch), c = *(const f32x4v*)(p.conv_b + l * 768 + ch + 4);
#pragma unroll
      for (int j = 0; j < 4; ++j) { bias[j] = a[j]; bias[4 + j] = c[j]; } }
    const u32x4v zero4 = mk4(0u, 0u, 0u, 0u);
    u32x4v rw[13];
#pragma unroll
    for (int i = 0; i < 5; ++i) { const int tt = t0 - 2 + i; rw[i] = (tt >= lo && tt <= hi) ? *(const u32x4v*)(src + (size_t)tt * LDP) : zero4; }
    for (int s0 = 0; s0 < 32; s0 += 8) {
        const int t = t0 + s0;
#pragma unroll
        for (int i = 0; i < 8; ++i) { const int tt = t + 3 + i; rw[5 + i] = (tt <= hi) ? *(const u32x4v*)(src + (size_t)tt * LDP) : zero4; }
#pragma unroll
        for (int i = 0; i < 8; ++i) {
            float o[8];
#pragma unroll
            for (int c = 0; c < 8; ++c) o[c] = bias[c];
#pragma unroll
            for (int k = 0; k < 5; ++k) { float v[8]; unpack8(rw[i + k], v);
#pragma unroll
                for (int c = 0; c < 8; ++c) o[c] += wgt[k][c] * v[c]; }
#pragma unroll
            for (int c = 0; c < 8; ++c) o[c] = siluf(o[c]);
            *(u32x4v*)(dst + (size_t)(t + i) * dld) = pack8(o);
        }
#pragma unroll
        for (int i = 0; i < 5; ++i) rw[i] = rw[i + 8];
    }
}
DI void prep_ssd_item(const P& p, int l, int item, int lane) {
    const int tl = item >> 3, h = item & 7, tok0 = tile_tok0(tl);
    const float bsf = p.dt_bias_f[l * 8 + h], bsb = p.dt_bias_b[l * 8 + h];
    const float r0 = bf2f(p.PROJ[(size_t)(tok0 + 2 * lane) * LDP + OFF_DT + h]), r1 = bf2f(p.PROJ[(size_t)(tok0 + 2 * lane + 1) * LDP + OFF_DT + h]);
    const float f0 = fast_softplus(r0 + bsf), f1 = fast_softplus(r1 + bsf), b0 = fast_softplus(r0 + bsb), b1 = fast_softplus(r1 + bsb);
    float pf = f0 + f1, sb = b0 + b1;
#pragma unroll
    for (int o = 1; o < 64; o <<= 1) { const float t = shl(pf, lane >= o ? lane - o : lane); if (lane >= o) pf += t; }
#pragma unroll
    for (int o = 1; o < 64; o <<= 1) { const float t = shl(sb, lane + o < 64 ? lane + o : lane); if (lane + o < 64) sb += t; }
    const float Af = -__expf(p.a_log_f[l * 8 + h]) * LOG2E, Ab = -__expf(p.a_log_b[l * 8 + h]) * LOG2E;
    const float af0 = Af * (pf - f1), af1 = Af * pf, ab0 = Ab * sb, ab1 = Ab * (sb - b0);
    f32x4v* dst = (f32x4v*)p.SSC + (size_t)(tok0 + 2 * lane) * 8 + h;
    dst[0] = mkf4(af0, af0 - __log2f(f0), ab0, ab0 - __log2f(b0));
    dst[8] = mkf4(af1, af1 - __log2f(f1), ab1, ab1 - __log2f(b1));
    if (lane == 63) { p.STOT[(tl * 8 + h) * 2 + 0] = af1; p.SDEC[(tl * 8 + h) * 2 + 0] = __builtin_amdgcn_exp2f(af1); }
    if (lane == 0) { p.STOT[(tl * 8 + h) * 2 + 1] = ab0; p.SDEC[(tl * 8 + h) * 2 + 1] = __builtin_amdgcn_exp2f(ab0); }
}
DI void prep_gla_block(const P& p, int l, int tl, int h, LDSP unsigned char* lds) {
    const int tid = ltid(), lane = tid & 63, k = tid >> 3, seg = tid & 7, base = lane & ~7, tok0 = tile_tok0(tl);
    LDSP bf16_t* QT = (LDSP bf16_t*)lds; LDSP bf16_t* KT = QT + 128 * LD64; LDSP bf16_t* O4 = KT + 128 * LD64; LDSP float* GKL = (LDSP float*)(O4 + 4 * 128 * LD64);
    u32x4v qv_[2], kv_[2], vv_[4]; u32x4v gk = mk4(0u, 0u, 0u, 0u);
#pragma unroll
    for (int q = 0; q < 4; ++q) { const int c = tid + q * NTHR, r = c >> 4, cc = c & 15; vv_[q] = *(const u32x4v*)(p.PROJ + (size_t)(tok0 + r) * LDP + OFF_V + h * 128 + cc * 8); }
#pragma unroll
    for (int q = 0; q < 2; ++q) { const int c = tid + q * NTHR, r = c >> 3, cc = c & 7; const bf16_t* pr = p.PROJ + (size_t)(tok0 + r) * LDP;
        qv_[q] = *(const u32x4v*)(pr + OFF_Q + h * 64 + cc * 8); kv_[q] = *(const u32x4v*)(pr + OFF_K + h * 64 + cc * 8); }
    if (tid < 256) gk = *(const u32x4v*)(p.PROJ + (size_t)(tok0 + (tid >> 1)) * LDP + OFF_GK + (tid & 1) * 8);
    float upf[16], upb[16];
#pragma unroll
    for (int r = 0; r < 16; ++r) { upf[r] = p.gk_up_f[l * 16 * 256 + r * 256 + h * 64 + k]; upb[r] = p.gk_up_b[l * 16 * 256 + r * 256 + h * 64 + k]; }
    const float biasf = p.gk_bias_f[l * 256 + h * 64 + k], biasb = p.gk_bias_b[l * 256 + h * 64 + k];
    __syncthreads();
#pragma unroll
    for (int q = 0; q < 2; ++q) { const int c = tid + q * NTHR, r = c >> 3, cc = c & 7; *(LDSP u32x4v*)(QT + r * LD64 + cc * 8) = qv_[q]; *(LDSP u32x4v*)(KT + r * LD64 + cc * 8) = kv_[q]; }
    if (tid < 256) { float v[8]; unpack8(gk, v); LDSP f32x4v* d = (LDSP f32x4v*)(GKL + (tid >> 1) * 16 + (tid & 1) * 8); d[0] = mkf4(v[0], v[1], v[2], v[3]); d[1] = mkf4(v[4], v[5], v[6], v[7]); }
    __syncthreads();
    float gf[16], gb[16];
#pragma unroll
    for (int s = 0; s < 16; ++s) { LDSP const f32x4v* gl = (LDSP const f32x4v*)(GKL + (16 * seg + s) * 16); float af = biasf, ab = biasb;
#pragma unroll
        for (int q = 0; q < 4; ++q) { const f32x4v v = gl[q];
#pragma unroll
            for (int j = 0; j < 4; ++j) { af += v[j] * upf[4 * q + j]; ab += v[j] * upb[4 * q + j]; } }
        gf[s] = fast_logsigmoid(af) * (1.0f / 16.0f); gb[s] = fast_logsigmoid(ab) * (1.0f / 16.0f); }
    float runf = 0.f, runb = 0.f;
#pragma unroll
    for (int s = 0; s < 16; ++s) { runf += gf[s]; gf[s] = runf; }
#pragma unroll
    for (int s = 15; s >= 0; --s) { runb += gb[s]; gb[s] = runb; }
    float offf = 0.f, offb = 0.f, totf = 0.f, totb = 0.f;
#pragma unroll
    for (int q = 0; q < 8; ++q) { const float tf = shl(runf, base + q), tb = shl(runb, base + q); totf += tf; totb += tb; if (q < seg) offf += tf; if (q > seg) offb += tb; }
#pragma unroll
    for (int s = 0; s < 16; ++s) { const int j = 16 * seg + s; const float qv = bf2f(QT[j * LD64 + k]) * 0.125f, kv = bf2f(KT[j * LD64 + k]);
        const float bf = gf[s] + offf, bb = gb[s] + offb; LDSP bf16_t* o = O4 + j * LD64 + k;
        o[0] = f2bf(qv * __expf(bf)); o[128 * LD64] = f2bf(kv * __expf(-bf)); o[2 * 128 * LD64] = f2bf(qv * __expf(bb)); o[3 * 128 * LD64] = f2bf(kv * __expf(-bb)); }
    LDSP float* DEC = GKL;
    __syncthreads();
    if (seg == 0) { const float df = __expf(totf), db = __expf(totb); p.GDEC[(size_t)((tl * 4 + h) * 2 + 0) * 64 + k] = df; p.GDEC[(size_t)((tl * 4 + h) * 2 + 1) * 64 + k] = db; DEC[k] = df; DEC[64 + k] = db; }
    LDSP bf16_t* VT = QT;
#pragma unroll
    for (int q = 0; q < 4; ++q) { const int c = tid + q * NTHR, r = c >> 4, cc = c & 15; *(LDSP u32x4v*)(VT + r * LD128 + cc * 8) = vv_[q]; }
#pragma unroll
    for (int q = 0; q < 8; ++q) { const int c = tid + q * NTHR, a4 = c >> 10, r = (c >> 3) & 127, cc = c & 7;
        *(u32x4v*)(p.QKB + (size_t)(tok0 + r) * 1024 + a4 * 256 + h * 64 + cc * 8) = *(LDSP const u32x4v*)(O4 + (a4 * 128 + r) * LD64 + cc * 8); }
    __syncthreads();
    { const int w = __builtin_amdgcn_readfirstlane(tid >> 6), dir = w >> 2, ut = w & 3; LDSP const bf16_t* KE = O4 + (dir ? 3 : 1) * 128 * LD64;
      f32x4v acc[8];
#pragma unroll
      for (int q = 0; q < 8; ++q) acc[q] = (f32x4v){0.f, 0.f, 0.f, 0.f};
#pragma unroll
      for (int ks = 0; ks < 4; ++ks) { const bf16x8v u = frag_col(KE, LD64, 16 * ut, 32 * ks, lane);
#pragma unroll
          for (int q = 0; q < 8; ++q) acc[q] = mfma16(u, frag_col(VT, LD128, 16 * q, 32 * ks, lane), acc[q]); }
      const f32x4v dec = *(LDSP const f32x4v*)(DEC + dir * 64 + 16 * ut + 4 * (lane >> 4));
      bf16_t* dst = p.GS + ((size_t)((tl * 4 + h) * 2 + dir) * 128) * 64;
#pragma unroll
      for (int q = 0; q < 8; ++q) *(u32x2v*)(dst + (size_t)(16 * q + (lane & 15)) * 64 + 16 * ut + 4 * (lane >> 4)) = pack4(acc[q] * dec); }
}
constexpr int NPREP_A = (T / 32) * 2, NPREP_B = NTILE * 8;
DI void ph_prep(const P& p, int l, LDSP unsigned char* lds) {
    const int tid_ = ltid(), lane = tid_ & 63, gw = blockIdx.x * NWV + (tid_ >> 6), NW = gridDim.x * NWV;
    for (int it = gw; it < NPREP_A + NPREP_B; it += NW) {
        if (it < NPREP_A) prep_conv_item(p, l, it, lane); else prep_ssd_item(p, l, it - NPREP_A, lane);
    }
    for (int it = blockIdx.x; it < NTILE * 4; it += gridDim.x) prep_gla_block(p, l, it >> 2, it & 3, lds);
}

DI void s1_ssd(const P& p, int tl, int h, LDSP unsigned char* lds) {
    const int tid = ltid(), lane = tid & 63, w = __builtin_amdgcn_readfirstlane(tid >> 6);
    const int tok0 = tile_tok0(tl), g = h >> 2; const XbcSrc xs = xbc_src(p, tok0);
    LDSP bf16_t* XWF = (LDSP bf16_t*)lds; LDSP bf16_t* XWB = XWF + 128 * LD64; LDSP bf16_t* BG = XWB + 128 * LD64;
    const int j = tid >> 2, cq = tid & 3;
    const bf16_t* row = xs.base + (size_t)j * xs.ld;
    const u32x4v x0 = *(const u32x4v*)(row + h * 64 + cq * 16), x1 = *(const u32x4v*)(row + h * 64 + cq * 16 + 8);
    const u32x4v b0 = *(const u32x4v*)(row + 512 + g * 64 + cq * 16), b1 = *(const u32x4v*)(row + 512 + g * 64 + cq * 16 + 8);
    const f32x4v sc = *((const f32x4v*)p.SSC + (size_t)(tok0 + j) * 8 + h);
    const float wf = __builtin_amdgcn_exp2f(p.STOT[(tl * 8 + h) * 2 + 0] - sc.y), wb = __builtin_amdgcn_exp2f(p.STOT[(tl * 8 + h) * 2 + 1] - sc.w);
    float xv[16], of[16], ob[16]; unpack8(x0, xv); unpack8(x1, xv + 8);
#pragma unroll
    for (int c = 0; c < 16; ++c) { of[c] = xv[c] * wf; ob[c] = xv[c] * wb; }
    __syncthreads();
    *(LDSP u32x4v*)(XWF + j * LD64 + cq * 16) = pack8(of); *(LDSP u32x4v*)(XWF + j * LD64 + cq * 16 + 8) = pack8(of + 8);
    *(LDSP u32x4v*)(XWB + j * LD64 + cq * 16) = pack8(ob); *(LDSP u32x4v*)(XWB + j * LD64 + cq * 16 + 8) = pack8(ob + 8);
    *(LDSP u32x4v*)(BG + j * LD64 + cq * 16) = b0; *(LDSP u32x4v*)(BG + j * LD64 + cq * 16 + 8) = b1;
    __syncthreads();
    const int dir = w >> 2, ut = w & 3; LDSP const bf16_t* XW = dir ? XWB : XWF;
    f32x4v acc[4];
#pragma unroll
    for (int q = 0; q < 4; ++q) acc[q] = (f32x4v){0.f, 0.f, 0.f, 0.f};
#pragma unroll
    for (int ks = 0; ks < 4; ++ks) { const bf16x8v u = frag_col(BG, LD64, 16 * ut, 32 * ks, lane);
#pragma unroll
        for (int q = 0; q < 4; ++q) acc[q] = mfma16(u, frag_col(XW, LD64, 16 * q, 32 * ks, lane), acc[q]); }
    bf16_t* dst = p.SS + ((size_t)((tl * 8 + h) * 2 + dir) * 64) * 64;
#pragma unroll
    for (int q = 0; q < 4; ++q) *(u32x2v*)(dst + (size_t)(16 * q + (lane & 15)) * 64 + 16 * ut + 4 * (lane >> 4)) = pack4(acc[q]);
}
DI void ph_s1(const P& p, int l, LDSP unsigned char* lds) {
    for (int it = blockIdx.x; it < NTILE * 8; it += gridDim.x) s1_ssd(p, it >> 3, it & 7, lds);
}

DI int s2_chunk(int dir, int s) { return dir == 0 ? s : (s < 2 ? 1 - s : 35 - s); }
DI void ph_s2(const P& p) {
    const int g = blockIdx.x * NTHR + ltid();
    for (int v = g; v < 131072; v += gridDim.x * NTHR) {
        const bool gla = v >= 65536; const int r = v & 65535;
        int b, h, dir, vi;
        if (!gla) { vi = r & 511; dir = (r >> 9) & 1; h = (r >> 10) & 7; b = r >> 13; } else { vi = r & 1023; dir = (r >> 10) & 1; h = (r >> 11) & 3; b = r >> 13; }
        float st[8];
#pragma unroll
        for (int e = 0; e < 8; ++e) st[e] = 0.f;
        for (int s0 = 0; s0 < NCH; s0 += 6) {
            u32x4v sv[6]; float dsc[6]; f32x4v dv0[6], dv1[6];
#pragma unroll
            for (int u = 0; u < 6; ++u) { if (s0 + u >= NCH) continue; const int tl = b * NCH + s2_chunk(dir, s0 + u);
                if (!gla) { sv[u] = *(const u32x4v*)(p.SS + ((size_t)((tl * 8 + h) * 2 + dir) * 512 + vi) * 8); dsc[u] = p.SDEC[(tl * 8 + h) * 2 + dir]; }
                else { sv[u] = *(const u32x4v*)(p.GS + ((size_t)((tl * 4 + h) * 2 + dir) * 1024 + vi) * 8); const f32x4v* d = (const f32x4v*)(p.GDEC + (size_t)((tl * 4 + h) * 2 + dir) * 64 + (vi & 7) * 8); dv0[u] = d[0]; dv1[u] = d[1]; } }
#pragma unroll
            for (int u = 0; u < 6; ++u) { if (s0 + u >= NCH) continue; const int tl = b * NCH + s2_chunk(dir, s0 + u);
                float loc[8]; unpack8(sv[u], loc);
                const u32x4v hin = pack8(st);
                if (!gla) { *(u32x4v*)(p.SS + ((size_t)((tl * 8 + h) * 2 + dir) * 512 + vi) * 8) = hin;
#pragma unroll
                    for (int e = 0; e < 8; ++e) st[e] = dsc[u] * st[e] + loc[e]; }
                else { *(u32x4v*)(p.GS + ((size_t)((tl * 4 + h) * 2 + dir) * 1024 + vi) * 8) = hin;
                    const float dd[8] = {dv0[u].x, dv0[u].y, dv0[u].z, dv0[u].w, dv1[u].x, dv1[u].y, dv1[u].z, dv1[u].w};
#pragma unroll
                    for (int e = 0; e < 8; ++e) st[e] = dd[e] * st[e] + loc[e]; } }
        }
    }
}

DI int s3_tile(int l, int q) { return l == 0 ? q : (q >> 5) * NCH + 2 + (q & 31); }
struct SsdPre { u32x4v x0, x1, b0, b1, c0, c1, hf, hb; f32x4v sc; };
DI void s3_ssd_load(const P& p, int tl, int h, int tid, int i, int G, SsdPre& r) {
    const int tok0 = tile_tok0(tl), g = h >> 2; const XbcSrc xs = xbc_src(p, tok0);
    const int j = tid >> 2, cq = tid & 3; const bf16_t* row = xs.base + (size_t)j * xs.ld;
    r.x0 = *(const u32x4v*)(row + h * 64 + cq * 16); r.x1 = *(const u32x4v*)(row + h * 64 + cq * 16 + 8);
    r.b0 = *(const u32x4v*)(row + 512 + g * 64 + cq * 16); r.b1 = *(const u32x4v*)(row + 512 + g * 64 + cq * 16 + 8);
    r.c0 = *(const u32x4v*)(row + 640 + g * 64 + cq * 16); r.c1 = *(const u32x4v*)(row + 640 + g * 64 + cq * 16 + 8);
    const bf16_t* Hf = p.SS + (size_t)((tl * 8 + h) * 2 + 0) * 4096 + (tid >> 3) * 64 + (tid & 7) * 8;
    r.hf = *(const u32x4v*)Hf; r.hb = *(const u32x4v*)(Hf + 4096);
    r.sc = *((const f32x4v*)p.SSC + (size_t)(tok0 + (tid & 127)) * 8 + h);
}
DI void ph_s3_ssd(const P& p, int l, LDSP unsigned char* lds) {
    const int tid = ltid(), lane = tid & 63, w = __builtin_amdgcn_readfirstlane(tid >> 6), G = lane >> 4, li = lane & 15, i = 16 * w + li;
    LDSP bf16_t* XH = (LDSP bf16_t*)lds; LDSP bf16_t* BG = XH + 128 * LD64; LDSP bf16_t* CG = BG + 128 * LD64; LDSP bf16_t* MM = CG + 128 * LD64; LDSP f32x4v* SC = (LDSP f32x4v*)(MM + 128 * LD128);
    LDSP bf16_t* HF = (LDSP bf16_t*)(SC + 128); LDSP bf16_t* HB = HF + 64 * LD64;
    const int nit = (l == 0 ? NTILE : NB * 32) * 8, GS_ = gridDim.x;
    int it = ((int)blockIdx.x + (GS_ >> 1)) % GS_; SsdPre pre;
    if (it < nit) s3_ssd_load(p, s3_tile(l, it >> 3), it & 7, tid, i, G, pre);
    for (; it < nit; it += GS_) {
        const int tl = s3_tile(l, it >> 3), h = it & 7, tok0 = tile_tok0(tl);
        __syncthreads();
        { const int j = tid >> 2, cq = tid & 3;
          *(LDSP u32x4v*)(XH + j * LD64 + cq * 16) = pre.x0; *(LDSP u32x4v*)(XH + j * LD64 + cq * 16 + 8) = pre.x1;
          *(LDSP u32x4v*)(BG + j * LD64 + cq * 16) = pre.b0; *(LDSP u32x4v*)(BG + j * LD64 + cq * 16 + 8) = pre.b1;
          *(LDSP u32x4v*)(CG + j * LD64 + cq * 16) = pre.c0; *(LDSP u32x4v*)(CG + j * LD64 + cq * 16 + 8) = pre.c1;
          *(LDSP u32x4v*)(HF + (tid >> 3) * LD64 + (tid & 7) * 8) = pre.hf; *(LDSP u32x4v*)(HB + (tid >> 3) * LD64 + (tid & 7) * 8) = pre.hb;
          if (tid < 128) SC[tid] = pre.sc; }
        if (it + GS_ < nit) s3_ssd_load(p, s3_tile(l, (it + GS_) >> 3), (it + GS_) & 7, tid, i, G, pre);
        __syncthreads();
        u32x2v zr[4];
#pragma unroll
        for (int pt = 0; pt < 4; ++pt) zr[pt] = *(const u32x2v*)(p.PROJ + (size_t)(tok0 + i) * LDP + OFF_Z + h * 64 + 16 * pt + 4 * G);
        const f32x4v sci = SC[i];
        {
            f32x4v am[8];
#pragma unroll
            for (int ut = 0; ut < 8; ++ut) am[ut] = (f32x4v){0.f, 0.f, 0.f, 0.f};
#pragma unroll
            for (int ks = 0; ks < 2; ++ks) { const bf16x8v vfr = frag_row(CG, LD64, 16 * w, 32 * ks, lane);
#pragma unroll
                for (int ut = 0; ut < 8; ++ut) am[ut] = mfma16(frag_row(BG, LD64, 16 * ut, 32 * ks, lane), vfr, am[ut]); }
#pragma unroll
            for (int ut = 0; ut < 8; ++ut) { f32x4v m;
#pragma unroll
                for (int r = 0; r < 4; ++r) { const int jj = 16 * ut + 4 * G + r; const f32x4v scj = SC[jj];
                    const float Lf = jj <= i ? __builtin_amdgcn_exp2f(fminf(sci.x - scj.y, 30.f)) : 0.f, Lb = jj >= i ? __builtin_amdgcn_exp2f(fminf(sci.z - scj.w, 30.f)) : 0.f;
                    m[r] = am[ut][r] * (Lf + Lb); }
                *(LDSP u32x2v*)(MM + i * LD128 + 16 * ut + 4 * G) = pack4(m); }
        }
        asm volatile("s_waitcnt lgkmcnt(0)" ::: "memory");
        f32x4v ay[4], af_[4], ab_[4];
#pragma unroll
        for (int pt = 0; pt < 4; ++pt) { ay[pt] = (f32x4v){0.f, 0.f, 0.f, 0.f}; af_[pt] = ay[pt]; ab_[pt] = ay[pt]; }
#pragma unroll
        for (int ks = 0; ks < 2; ++ks) { const bf16x8v vfr = frag_row(CG, LD64, 16 * w, 32 * ks, lane);
#pragma unroll
            for (int pt = 0; pt < 4; ++pt) { af_[pt] = mfma16(frag_row(HF, LD64, 16 * pt, 32 * ks, lane), vfr, af_[pt]); ab_[pt] = mfma16(frag_row(HB, LD64, 16 * pt, 32 * ks, lane), vfr, ab_[pt]); } }
#pragma unroll
        for (int ks = 0; ks < 4; ++ks) { const bf16x8v vfr = frag_row(MM, LD128, 16 * w, 32 * ks, lane);
#pragma unroll
            for (int pt = 0; pt < 4; ++pt) ay[pt] = mfma16(frag_col(XH, LD64, 16 * pt, 32 * ks, lane), vfr, ay[pt]); }
        const float sf = __builtin_amdgcn_exp2f(sci.x), sb = __builtin_amdgcn_exp2f(sci.z), dsk = p.d_skip[l * 8 + h];
        float ssq = 0.f;
#pragma unroll
        for (int pt = 0; pt < 4; ++pt) { const int pc = 16 * pt + 4 * G;
            const u32x2v xr = *(LDSP const u32x2v*)(XH + i * LD64 + pc);
            const float xv[4] = {__uint_as_float(xr.x << 16), __uint_as_float(xr.x & 0xffff0000u), __uint_as_float(xr.y << 16), __uint_as_float(xr.y & 0xffff0000u)};
            const float zv[4] = {__uint_as_float(zr[pt].x << 16), __uint_as_float(zr[pt].x & 0xffff0000u), __uint_as_float(zr[pt].y << 16), __uint_as_float(zr[pt].y & 0xffff0000u)};
            float yv[4];
#pragma unroll
            for (int r = 0; r < 4; ++r) { yv[r] = (ay[pt][r] + sf * af_[pt][r] + sb * ab_[pt][r] + dsk * xv[r]) * siluf(zv[r]); yv[r] = bf2f(f2bf(yv[r])); ssq += yv[r] * yv[r]; }
            *(u32x2v*)(p.H + (size_t)(tok0 + i) * D + h * 64 + pc) = mk2(pk2(yv[0], yv[1]), pk2(yv[2], yv[3])); }
        ssq += shx(ssq, 16, lane); ssq += shx(ssq, 32, lane);
        if (G == 0) p.SSQ[(size_t)(tok0 + i) * 8 + h] = ssq;
    }
}
struct GlaPre { u32x4v qk[2][4], vv[4], sf[2], sb[2]; };
DI void s3_gla_load(const P& p, int tl, int h, int tid, int i, int G, GlaPre& r) {
    const int tok0 = tile_tok0(tl);
#pragma unroll
    for (int q = 0; q < 2; ++q) { const int c = tid + q * NTHR, rr = c >> 3, cc = c & 7; const bf16_t* qb = p.QKB + (size_t)(tok0 + rr) * 1024 + h * 64 + cc * 8;
        r.qk[q][0] = *(const u32x4v*)qb; r.qk[q][1] = *(const u32x4v*)(qb + 256);
        r.qk[q][2] = *(const u32x4v*)(qb + 512); r.qk[q][3] = *(const u32x4v*)(qb + 768);
        const bf16_t* Sg = p.GS + (size_t)((tl * 4 + h) * 2 + 0) * 8192 + (size_t)rr * 64 + cc * 8; r.sf[q] = *(const u32x4v*)Sg; r.sb[q] = *(const u32x4v*)(Sg + 8192); }
#pragma unroll
    for (int q = 0; q < 4; ++q) { const int c = tid + q * NTHR, rr = c >> 4, cc = c & 15; r.vv[q] = *(const u32x4v*)(p.PROJ + (size_t)(tok0 + rr) * LDP + OFF_V + h * 128 + cc * 8); }
}
DI void ph_s3_gla(const P& p, int l, LDSP unsigned char* lds) {
    const int tid = ltid(), lane = tid & 63, w = __builtin_amdgcn_readfirstlane(tid >> 6), G = lane >> 4, li = lane & 15, i = 16 * w + li;
    LDSP bf16_t* Q2 = (LDSP bf16_t*)lds;
    LDSP bf16_t* KF = Q2 + 8 * 2 * 16 * LD64; LDSP bf16_t* KB = KF + 128 * LD64; LDSP bf16_t* VT = KB + 128 * LD64; LDSP bf16_t* SF = VT + 128 * LD128; LDSP bf16_t* SB = SF + 128 * LD64;
    LDSP bf16_t* AMw = SF + w * 16 * LD128;
    const int nit = (l == 0 ? NTILE : NB * 32) * 4, GS_ = gridDim.x;
    int it = blockIdx.x; GlaPre pre;
    if (it < nit) s3_gla_load(p, s3_tile(l, it >> 2), it & 3, tid, i, G, pre);
    for (; it < nit; it += GS_) {
        const int tl = s3_tile(l, it >> 2), h = it & 3, tok0 = tile_tok0(tl);
        __syncthreads();
#pragma unroll
        for (int q = 0; q < 2; ++q) { const int c = tid + q * NTHR, rr = c >> 3, cc = c & 7; LDSP bf16_t* qrow = Q2 + (rr >> 4) * (2 * 16 * LD64) + (rr & 15) * LD64 + cc * 8;
            *(LDSP u32x4v*)qrow = pre.qk[q][0]; *(LDSP u32x4v*)(qrow + 16 * LD64) = pre.qk[q][2];
            *(LDSP u32x4v*)(KF + rr * LD64 + cc * 8) = pre.qk[q][1]; *(LDSP u32x4v*)(KB + rr * LD64 + cc * 8) = pre.qk[q][3];
            *(LDSP u32x4v*)(SF + rr * LD64 + cc * 8) = pre.sf[q]; *(LDSP u32x4v*)(SB + rr * LD64 + cc * 8) = pre.sb[q]; }
#pragma unroll
        for (int q = 0; q < 4; ++q) { const int c = tid + q * NTHR, rr = c >> 4, cc = c & 15; *(LDSP u32x4v*)(VT + rr * LD128 + cc * 8) = pre.vv[q]; }
        if (it + GS_ < nit) s3_gla_load(p, s3_tile(l, (it + GS_) >> 2), (it + GS_) & 3, tid, i, G, pre);
        __syncthreads();
        f32x4v ao[8];
#pragma unroll
        for (int q = 0; q < 8; ++q) ao[q] = (f32x4v){0.f, 0.f, 0.f, 0.f};
#pragma unroll
        for (int dir = 0; dir < 2; ++dir) {
            LDSP const bf16_t* QSw = Q2 + w * (2 * 16 * LD64) + dir * 16 * LD64; LDSP const bf16_t* SS_ = dir ? SB : SF;
#pragma unroll
            for (int ks = 0; ks < 2; ++ks) { const bf16x8v vfr = frag_row(QSw, LD64, 0, 32 * ks, lane);
#pragma unroll
                for (int vt = 0; vt < 8; ++vt) ao[vt] = mfma16(frag_row(SS_, LD64, 16 * vt, 32 * ks, lane), vfr, ao[vt]); }
        }
        __syncthreads();
#pragma unroll
        for (int uh = 0; uh < 4; ++uh) {
            f32x4v a2[2]; a2[0] = (f32x4v){0.f, 0.f, 0.f, 0.f}; a2[1] = a2[0];
#pragma unroll
            for (int dir = 0; dir < 2; ++dir) {
                LDSP const bf16_t* QSw = Q2 + w * (2 * 16 * LD64) + dir * 16 * LD64; LDSP const bf16_t* KS = dir ? KB : KF;
                f32x4v as[2]; as[0] = (f32x4v){0.f, 0.f, 0.f, 0.f}; as[1] = as[0];
#pragma unroll
                for (int ks = 0; ks < 2; ++ks) { const bf16x8v vfr = frag_row(QSw, LD64, 0, 32 * ks, lane);
#pragma unroll
                    for (int q = 0; q < 2; ++q) as[q] = mfma16(frag_row(KS, LD64, 16 * (2 * uh + q), 32 * ks, lane), vfr, as[q]); }
#pragma unroll
                for (int q = 0; q < 2; ++q)
#pragma unroll
                    for (int r = 0; r < 4; ++r) { const int jj = 16 * (2 * uh + q) + 4 * G + r; const bool keep = dir == 0 ? (jj <= i) : (jj >= i); a2[q][r] += keep ? as[q][r] : 0.f; }
            }
#pragma unroll
            for (int q = 0; q < 2; ++q) *(LDSP u32x2v*)(AMw + li * LD128 + 16 * (2 * uh + q) + 4 * G) = pack4(a2[q]);
        }
        u32x2v gr[8];
#pragma unroll
        for (int vt = 0; vt < 8; ++vt) gr[vt] = *(const u32x2v*)(p.PROJ + (size_t)(tok0 + i) * LDP + OFF_GO + h * 128 + 16 * vt + 4 * G);
        asm volatile("s_waitcnt lgkmcnt(0)" ::: "memory");
#pragma unroll
        for (int ks = 0; ks < 4; ++ks) { const bf16x8v vfr = frag_row(AMw, LD128, 0, 32 * ks, lane);
#pragma unroll
            for (int vt = 0; vt < 8; ++vt) ao[vt] = mfma16(frag_col(VT, LD128, 16 * vt, 32 * ks, lane), vfr, ao[vt]); }
        float so = 0.f;
#pragma unroll
        for (int vt = 0; vt < 8; ++vt)
#pragma unroll
            for (int r = 0; r < 4; ++r) so += ao[vt][r] * ao[vt][r];
        so += shx(so, 16, lane); so += shx(so, 32, lane);
        const float ro = rsqrtf(so * (1.0f / 128.0f) + 1e-6f);
#pragma unroll
        for (int vt = 0; vt < 8; ++vt) { const int vc = 16 * vt + 4 * G; const f32x4v gg = *(const f32x4v*)(p.gla_norm_g + l * 128 + vc);
            const float g0 = __uint_as_float(gr[vt].x << 16), g1 = __uint_as_float(gr[vt].x & 0xffff0000u), g2 = __uint_as_float(gr[vt].y << 16), g3 = __uint_as_float(gr[vt].y & 0xffff0000u);
            *(u32x2v*)(p.H + (size_t)(tok0 + i) * D + 512 + h * 128 + vc) = mk2(pk2(ao[vt][0] * ro * gg.x * siluf(g0), ao[vt][1] * ro * gg.y * siluf(g1)), pk2(ao[vt][2] * ro * gg.z * siluf(g2), ao[vt][3] * ro * gg.w * siluf(g3))); }
    }
}
DI void ph_s3(const P& p, int l, LDSP unsigned char* lds) { ph_s3_gla(p, l, lds); ph_s3_ssd(p, l, lds); }
DI void ph_normroute(const P& p, int l, int t0, LDSP unsigned char* lds) {
    const int tid_ = ltid(), lane = tid_ & 63, wv = tid_ >> 6, gw = blockIdx.x * NWV + wv, NW = gridDim.x * NWV, G = lane >> 4, li = lane & 15;
    const float* MODl = p.MOD + (size_t)l * 9 * 6144; int* counts = p.counts + l * 32 * 32;
    constexpr int LDW = 1032, LDT = 264;
    LDSP bf16_t* WR = (LDSP bf16_t*)lds;
    LDSP bf16_t* HT = WR + 32 * LDW + wv * 16 * LDT;
    { u32x4v wv_[8];
#pragma unroll
      for (int q = 0; q < 8; ++q) wv_[q] = *(const u32x4v*)(p.WRT + (size_t)(tid_ + q * NTHR) * 8);
#pragma unroll
      for (int q = 0; q < 8; ++q) { const int c = tid_ + q * NTHR; *(LDSP u32x4v*)(WR + (c >> 7) * LDW + (c & 127) * 8) = wv_[q]; } }
    __syncthreads();
    const int ntile = (T - t0) >> 4;
    const float* g2 = p.norm2_g + l * D;
    for (int tile = gw; tile < ntile; tile += NW) {
        const int tb = t0 + tile * 16;
        const float* mr = MODl + (size_t)tok_modrow(tb) * 6144;
        float rs[16];
        { const f32x4v* q = (const f32x4v*)(p.XSS + (size_t)(tb + li) * 16); const f32x4v a = q[0], b = q[1], c = q[2], d = q[3];
          const float ss = (((a.x + a.y) + (a.z + a.w)) + ((b.x + b.y) + (b.z + b.w))) + (((c.x + c.y) + (c.z + c.w)) + ((d.x + d.y) + (d.z + d.w)));
          const float r = rsqrtf(ss * (1.0f / D) + 1e-6f);
#pragma unroll
          for (int i = 0; i < 16; ++i) rs[i] = shl(r, i); }
        f32x4v acc[2]; acc[0] = (f32x4v){0.f, 0.f, 0.f, 0.f}; acc[1] = acc[0];
        u32x2v xq[16];
#pragma unroll
        for (int i = 0; i < 16; ++i) xq[i] = *(const u32x2v*)(xrow(p, tb + i) + lane * 4);
#pragma unroll
        for (int kc = 0; kc < 4; ++kc) {
            const int kk = kc * 256 + lane * 4;
            const f32x4v gg = *(const f32x4v*)(g2 + kk), sh = *(const f32x4v*)(mr + 3 * 1024 + kk), sc = *(const f32x4v*)(mr + 4 * 1024 + kk);
            f32x4v gs;
#pragma unroll
            for (int j = 0; j < 4; ++j) gs[j] = gg[j] * (1.f + sc[j]);
#pragma unroll
            for (int i = 0; i < 16; ++i) { const u32x2v r = xq[i];
                const f32x4v xv = mkf4(__uint_as_float(r.x << 16), __uint_as_float(r.x & 0xffff0000u), __uint_as_float(r.y << 16), __uint_as_float(r.y & 0xffff0000u));
                const f32x4v h = xv * rs[i] * gs + sh; const u32x2v hb = pack4(h);
                *(u32x2v*)(p.H + (size_t)(tb + i) * D + kk) = hb; *(LDSP u32x2v*)(HT + i * LDT + lane * 4) = hb; }
            if (kc < 3) {
#pragma unroll
                for (int i = 0; i < 16; ++i) xq[i] = *(const u32x2v*)(xrow(p, tb + i) + kk + 256); }
            asm volatile("s_waitcnt lgkmcnt(0)" ::: "memory");
#pragma unroll
            for (int ks = 0; ks < 8; ++ks) { const bf16x8v vfr = frag_row(HT, LDT, 0, 32 * ks, lane);
                acc[0] = mfma16(frag_row(WR, LDW, 0, kc * 256 + 32 * ks, lane), vfr, acc[0]);
                acc[1] = mfma16(frag_row(WR, LDW, 16, kc * 256 + 32 * ks, lane), vfr, acc[1]); }
            asm volatile("s_waitcnt lgkmcnt(0)" ::: "memory");
        }
        float bgs = -1e30f; int bgi = 0, e1 = 0, e2 = 0; float w1 = 0.f, w2 = 0.f;
#pragma unroll
        for (int ut = 0; ut < 2; ++ut) { const int gi = ut * 4 + G; float m1 = -1e30f, m2 = -1e30f, s1 = 0.f, s2 = 0.f; int i1 = 0, i2 = 0;
#pragma unroll
            for (int r = 0; r < 4; ++r) { const float sv = 1.0f / (1.0f + __expf(-acc[ut][r])), vv = sv + p.router_bias[gi * 4 + r];
                if (vv > m1) { m2 = m1; i2 = i1; s2 = s1; m1 = vv; i1 = gi * 4 + r; s1 = sv; } else if (vv > m2) { m2 = vv; i2 = gi * 4 + r; s2 = sv; } }
            if (m1 + m2 > bgs) { bgs = m1 + m2; bgi = gi; e1 = i1; e2 = i2; w1 = s1; w2 = s2; } }
#pragma unroll
        for (int o = 16; o <= 32; o <<= 1) {
            const float ogs = shx(bgs, o, lane), ow1 = shx(w1, o, lane), ow2 = shx(w2, o, lane); const int ogi = shxi(bgi, o, lane), oe1 = shxi(e1, o, lane), oe2 = shxi(e2, o, lane);
            if (ogs > bgs || (ogs == bgs && ogi < bgi)) { bgs = ogs; bgi = ogi; e1 = oe1; e2 = oe2; w1 = ow1; w2 = ow2; } }
        if (G == 0) {
            const int t = tb + li; const float inv = 1.0f / (w1 + w2);
            const int r1 = atomicAdd(&counts[e1 * 32], 1), r2 = atomicAdd(&counts[e2 * 32], 1);
            p.MAP[(size_t)e1 * T + r1] = t; p.MAP[(size_t)e2 * T + r2] = t;
            p.TOKSLOT[t * 4 + 0] = e1; p.TOKSLOT[t * 4 + 1] = r1; p.TOKSLOT[t * 4 + 2] = e2; p.TOKSLOT[t * 4 + 3] = r2;
            p.EW[t * 2 + 0] = w1 * inv; p.EW[t * 2 + 1] = w2 * inv;
        }
    }
}

DI void ph_combine(const P& p, int l, int t0, const unsigned char* Y  , LDSP int* ps  ) {
    const int tid_ = ltid(), lane = tid_ & 63, gw = blockIdx.x * NWV + (tid_ >> 6), NW = gridDim.x * NWV;
    const float* MODl = p.MOD + (size_t)l * 9 * 6144; const int* counts = p.counts + l * 32 * 32;
    if (tid_ < 64) { const int cnt = tid_ < 32 ? counts[tid_ * 32] : 0; int pc = cnt;
#pragma unroll
        for (int o = 1; o < 32; o <<= 1) { const int src = lane >= o ? lane - o : lane; const int a = shli(pc, src); if (lane >= o) pc += a; }
        if (tid_ < 32) ps[tid_] = pc - cnt; }
    __syncthreads();
    for (int t = t0 + 4 * gw; t < T; t += 4 * NW) {
        int4 sl[4]; float4 ew[2];
#pragma unroll
        for (int u = 0; u < 4; ++u) sl[u] = *(const int4*)(p.TOKSLOT + (size_t)(t + u) * 4);
        ew[0] = *(const float4*)(p.EW + (size_t)t * 2); ew[1] = *(const float4*)(p.EW + (size_t)(t + 2) * 2);
        unsigned yr[4][2][4];
#pragma unroll
        for (int u = 0; u < 4; ++u) { const unsigned char* y0 = Y + (size_t)(ps[sl[u].x] + sl[u].y) * D; const unsigned char* y1 = Y + (size_t)(ps[sl[u].z] + sl[u].w) * D;
#pragma unroll
            for (int i = 0; i < 4; ++i) { yr[u][0][i] = *(const unsigned*)(y0 + (i * 64 + lane) * 4); yr[u][1][i] = *(const unsigned*)(y1 + (i * 64 + lane) * 4); } }
        const float* mrow = MODl + (size_t)tok_modrow(t) * 6144; const float* g5 = mrow + 5 * 1024;
        const float* mr1 = p.MOD + (size_t)9 * 6144 + (size_t)tok_modrow(t) * 6144;
#pragma unroll
        for (int pr = 0; pr < 2; ++pr) {
            const float wgt[2][2] = {{ew[pr].x, ew[pr].y}, {ew[pr].z, ew[pr].w}};
            u32x2v xr[2][4];
#pragma unroll
            for (int u = 0; u < 2; ++u)
#pragma unroll
                for (int i = 0; i < 4; ++i) xr[u][i] = *(const u32x2v*)(xrow(p, t + 2 * pr + u) + (i * 64 + lane) * 4);
            float4 v[2][4];
#pragma unroll
            for (int i = 0; i < 4; ++i) { const int c = (i * 64 + lane) * 4; const float4 gg = *(const float4*)(g5 + c);
#pragma unroll
                for (int u = 0; u < 2; ++u) { const u32x2v x = xr[u][i]; const int a = (int)yr[2 * pr + u][0][i], b = (int)yr[2 * pr + u][1][i]; const float w1 = wgt[u][0], w2 = wgt[u][1];
                    v[u][i].x = __uint_as_float(x.x << 16) + gg.x * (w1 * __builtin_amdgcn_cvt_f32_fp8(a, 0) + w2 * __builtin_amdgcn_cvt_f32_fp8(b, 0));
                    v[u][i].y = __uint_as_float(x.x & 0xffff0000u) + gg.y * (w1 * __builtin_amdgcn_cvt_f32_fp8(a, 1) + w2 * __builtin_amdgcn_cvt_f32_fp8(b, 1));
                    v[u][i].z = __uint_as_float(x.y << 16) + gg.z * (w1 * __builtin_amdgcn_cvt_f32_fp8(a, 2) + w2 * __builtin_amdgcn_cvt_f32_fp8(b, 2));
                    v[u][i].w = __uint_as_float(x.y & 0xffff0000u) + gg.w * (w1 * __builtin_amdgcn_cvt_f32_fp8(a, 3) + w2 * __builtin_amdgcn_cvt_f32_fp8(b, 3));
                    if (l == 0) *(u32x2v*)(xrow(p, t + 2 * pr + u) + c) = mk2(pk2(v[u][i].x, v[u][i].y), pk2(v[u][i].z, v[u][i].w)); } }
            float rstd[2];
#pragma unroll
            for (int u = 0; u < 2; ++u) { float ss = 0.f;
#pragma unroll
                for (int i = 0; i < 4; ++i) ss += v[u][i].x * v[u][i].x + v[u][i].y * v[u][i].y + v[u][i].z * v[u][i].z + v[u][i].w * v[u][i].w;
                rstd[u] = rsqrtf(wave_sum(ss, lane) * (1.0f / D) + 1e-6f); }
            if (l == 0) {
#pragma unroll
                for (int i = 0; i < 4; ++i) { const int c = (i * 64 + lane) * 4;
                    const float4 gg = *(const float4*)(p.norm1_g + D + c), sh = *(const float4*)(mr1 + c), sc = *(const float4*)(mr1 + 1024 + c);
#pragma unroll
                    for (int u = 0; u < 2; ++u) { const float r = rstd[u];
                        *(u32x2v*)(p.H + (size_t)(t + 2 * pr + u) * D + c) = mk2(pk2(v[u][i].x * r * gg.x * (1.f + sc.x) + sh.x, v[u][i].y * r * gg.y * (1.f + sc.y) + sh.y), pk2(v[u][i].z * r * gg.z * (1.f + sc.z) + sh.z, v[u][i].w * r * gg.w * (1.f + sc.w) + sh.w)); } }
            } else {
#pragma unroll
                for (int u = 0; u < 2; ++u)
#pragma unroll
                    for (int i = 0; i < 4; ++i) { const float4 gg = ((const float4*)p.final_g)[i * 64 + lane]; const float r = rstd[u];
                        ((float4*)(p.out + (size_t)(t + 2 * pr + u - TC) * D))[i * 64 + lane] = make_float4(v[u][i].x * r * gg.x, v[u][i].y * r * gg.y, v[u][i].z * r * gg.z, v[u][i].w * r * gg.w); }
            }
        }
    }
}

#define XLAS __attribute__((address_space(3)))
#define XB_TMO      128
#define XB_XCNT(j)  (256  + 64 * (j))
#define XB_XSUB(j)  (1280 + 64 * (j))
#define XB_XGEN(j)  (2304 + 64 * (j))
#define XB_TOP      3328
#define XB_TOPGEN   3392
#define XCD_BAR_WORDS 3456
#define XB_SPIN_CAP (1u << 18)

__device__ __forceinline__ unsigned xb_ld(unsigned* p)              { return __hip_atomic_load(p, __ATOMIC_RELAXED, __HIP_MEMORY_SCOPE_AGENT); }
__device__ __forceinline__ unsigned xb_add(unsigned* p, unsigned v) { return __hip_atomic_fetch_add(p, v, __ATOMIC_RELAXED, __HIP_MEMORY_SCOPE_AGENT); }
__device__ __forceinline__ unsigned xb_xcc_id() { return (unsigned)__builtin_amdgcn_s_getreg((3 << 11) | 20) & 0xFu; }
#define XB_SPIN(cond, bar) do { unsigned _sp = 0; while (cond) { __builtin_amdgcn_s_sleep(1); \
    if ((++_sp & 255u) == 0u) { if (xb_ld(&(bar)[XB_TMO])) break; if (_sp > XB_SPIN_CAP) { atomicAdd(&(bar)[XB_TMO], 1u); break; } } } } while (0)

struct XcdBarrier {
    unsigned* bar; unsigned x;
    volatile XLAS unsigned* st;
};

__device__ __forceinline__ XcdBarrier xcd_barrier_post(unsigned* bar, volatile XLAS unsigned* st) {
    XcdBarrier b; b.bar = bar; b.x = xb_xcc_id(); b.st = st;
    if (ltid() == 0) (void)xb_add(&bar[XB_XCNT(b.x)], 1u);
    return b;
}
__device__ __forceinline__ void xcd_barrier_complete(unsigned* bar, unsigned x, unsigned& nloc, unsigned& nx) {
    const unsigned G = gridDim.x * gridDim.y * gridDim.z;
    unsigned sum, cnt, mine, sp = 0u;
    for (;;) {
        sum = 0u; cnt = 0u; mine = 0u;
#pragma unroll
        for (unsigned j = 0; j < 16; ++j) { const unsigned c = xb_ld(&bar[XB_XCNT(j)]); sum += c; cnt += (c > 0u) ? 1u : 0u; mine = (j == x) ? c : mine; }
        if (sum == G) break;
        __builtin_amdgcn_s_sleep(1);
        if ((++sp & 255u) == 0u) { if (xb_ld(&bar[XB_TMO])) break; if (sp > XB_SPIN_CAP) { atomicAdd(&bar[XB_TMO], 1u); break; } }
    }
    nloc = mine > 0u ? mine : 1u; nx = cnt > 0u ? cnt : 1u;
}

__device__ __forceinline__ void xcd_barrier(const XcdBarrier& b) {
    asm volatile("s_waitcnt vmcnt(0)" ::: "memory");
    __syncthreads();
    if (ltid() == 0) {
        unsigned* bar = b.bar;
        __builtin_amdgcn_s_waitcnt(0);
        unsigned nloc = b.st[0], nx = b.st[1];
        if (nloc == 0u) { xcd_barrier_complete(bar, b.x, nloc, nx); b.st[0] = nloc; b.st[1] = nx; }
        const unsigned old = xb_add(&bar[XB_XSUB(b.x)], 1u);
        const unsigned gen = old / nloc;
        if (old + 1u == (gen + 1u) * nloc) {
            __builtin_amdgcn_fence(__ATOMIC_RELEASE, "agent");
            asm volatile("s_waitcnt vmcnt(0)" ::: "memory");
            const unsigned og = xb_add(&bar[XB_TOP], 1u);
            const unsigned tg = og / nx;
            if (og + 1u == (tg + 1u) * nx) xb_add(&bar[XB_TOPGEN], 1u);
            else XB_SPIN(xb_ld(&bar[XB_TOPGEN]) == tg, bar);
            __builtin_amdgcn_fence(__ATOMIC_ACQUIRE, "agent");
            xb_add(&bar[XB_XGEN(b.x)], 1u);
            asm volatile("s_waitcnt vmcnt(0)" ::: "memory");
        } else {
            XB_SPIN(xb_ld(&bar[XB_XGEN(b.x)]) == gen, bar);
            __builtin_amdgcn_fence(__ATOMIC_ACQUIRE, "agent");
            asm volatile("s_waitcnt vmcnt(0)" ::: "memory");
        }
    }
    __syncthreads();
}

DI void moe_table(const P& p, int l, PG8_LAS int* tab) {
    const int tid_ = ltid();
    if (tid_ < 64) { const int cnt = tid_ < 32 ? p.counts[(l * 32 + tid_) * 32] : 0; const int nt = (cnt + 255) >> 8; int pt = nt, pc = cnt;
#pragma unroll
        for (int o = 1; o < 32; o <<= 1) { const int ln_ = tid_ & 63, src = ln_ >= o ? ln_ - o : ln_; const int a = shli(pt, src), b = shli(pc, src); if (ln_ >= o) { pt += a; pc += b; } }
        if (tid_ < 32) { tab[tid_ + 1] = pt; tab[33 + tid_] = cnt; tab[65 + tid_] = pc - cnt; if (tid_ == 0) tab[0] = 0; } }
    __syncthreads();
}
typedef const __attribute__((address_space(4))) P* PK;
DI PK lp(PK q) { asm volatile("" : "+s"(q)); return q; }
#define PHASE(...) do { const P p = *(const P*)lp(pk); __VA_ARGS__; } while (0)

template <int l> DI void layer(PK pk, unsigned char* smem, const XcdBarrier& xbar) {
    float* ldsf = (float*)smem; const int gw = 0, NW = 0, lane = 0;
    {
        constexpr int NG = l == 0 ? 234 : 204;
        constexpr int CV1 = l == 0 ? 10 * 768 : NE * 768;
        const int G = (int)gridDim.x == 256 ? NG : (int)gridDim.x;
        if ((int)blockIdx.x < G) PHASE({ pg8::Gemm g{p.H, p.WinT + (size_t)l * NPAD_IN * D, T, NPAD_IN, D}; pg8::StaticOrder S; S.init(T, NPAD_IN, G, (int)blockIdx.x);
            pg8::EpiProj E{p.PROJ, LDP, INDIM};
            pg8::gemm_phase<pg8::EpiProj, pg8::StaticOrder>((PG8_LAS unsigned char*)smem, g, S, E, nullptr); });
        else PHASE(ph_convert_experts(p, l, ldsf, G, (int)gridDim.x - G, 0, CV1));
        if ((int)gridDim.x != 256) PHASE(ph_convert_experts(p, l, ldsf, 0, (int)gridDim.x, 0, CV1));
    }
    xcd_barrier(xbar);
    PHASE(ph_prep(p, l, (LDSP unsigned char*)smem));
    xcd_barrier(xbar);
    PHASE(ph_s1(p, l, (LDSP unsigned char*)smem));
    xcd_barrier(xbar);
    PHASE(ph_s2(p));
    xcd_barrier(xbar);
    PHASE(ph_s3(p, l, (LDSP unsigned char*)smem));
    xcd_barrier(xbar);
    {
        constexpr int ro = l == 0 ? 0 : TC;
        constexpr int NG = l == 0 ? 182 : 256;
        const int G = (int)gridDim.x == 256 ? NG : (int)gridDim.x;
        if ((int)blockIdx.x < G) PHASE({ pg8::Gemm g{p.H + (size_t)ro * D, p.WoutT + (size_t)l * D * D, T - ro, D, D}; pg8::StaticOrder S; S.init(T - ro, D, G, (int)blockIdx.x);
            pg8::EpiResGate<l != 0> E{p.SSQ, p.ctx, p.x, p.XB, p.MOD + (size_t)l * 9 * 6144 + 2 * 1024, p.XSS, ro};
            pg8::gemm_phase<pg8::EpiResGate<l != 0>, pg8::StaticOrder>((PG8_LAS unsigned char*)smem, g, S, E, nullptr); });
        else if (l == 0) PHASE(ph_convert_experts(p, l, ldsf, G, (int)gridDim.x - G, 10 * 768, NE * 768));
        if (l == 0 && (int)gridDim.x != 256) PHASE(ph_convert_experts(p, l, ldsf, 0, (int)gridDim.x, 10 * 768, NE * 768));
    }
    xcd_barrier(xbar);
    const int t0 = l == 0 ? 0 : TC;
    PHASE(ph_normroute(p, l, t0, (LDSP unsigned char*)smem));
    xcd_barrier(xbar);
    PG8_LAS int* tab = (PG8_LAS int*)((PG8_LAS unsigned char*)smem + pg8::STAGE_BYTES);
#pragma unroll
    for (int ph = 0; ph < 2; ++ph) {
        PHASE(moe_table(p, l, tab));
        const int U = __builtin_amdgcn_readfirstlane(tab[32]) * 4;
        if (ph == 0) PHASE({ pg8::Gemm g{p.H, p.WguT, T, D, D}; pg8::MoeSched S{tab, p.MAP, U, (int)gridDim.x, (int)blockIdx.x, 4, 1, (size_t)D * D * 2};
            pg8::EpiAct E{p.SS}; pg8::gemm_phase_moe<pg8::EpiAct, pg8::MoeSched>((PG8_LAS unsigned char*)smem, g, S, E, nullptr); });
        else PHASE({ pg8::Gemm g{p.SS, p.WdT, T, D, 512}; pg8::MoeSched S{tab, p.MAP, U, (int)gridDim.x, (int)blockIdx.x, 4, 0, (size_t)D * 512 * 2};
            pg8::EpiY E{(unsigned char*)p.PROJ}; pg8::gemm_phase_moe<pg8::EpiY, pg8::MoeSched>((PG8_LAS unsigned char*)smem, g, S, E, nullptr); });
        xcd_barrier(xbar);
    }
    PHASE(ph_combine(p, l, t0, (const unsigned char*)p.PROJ, (LDSP int*)smem));
    xcd_barrier(xbar);
}

__global__ void __launch_bounds__(NTHR) mega(P p_arg) {
    extern __shared__ __attribute__((aligned(16))) unsigned char smem[];
    cg::grid_group grid = cg::this_grid();
    PK pk = (PK)__builtin_amdgcn_kernarg_segment_ptr();
    const int lane = 0, gw = 0, NW = 0;
    float* ldsf = (float*)smem;
    volatile XLAS unsigned* bst = (volatile XLAS unsigned*)((XLAS unsigned char*)smem + LDS_BYTES - 16);
    { const int t_ = ltid(); if (t_ < 2) bst[t_] = 0u; }
    __syncthreads();
    const XcdBarrier xbar = xcd_barrier_post(pk->BAR, bst);
    PHASE(ph_init(p)); PHASE(ph_mod(p, ldsf)); PHASE(ph_convert_small(p, ldsf, gw, NW, lane));
    grid.sync();
    PHASE(ph_normmod1(p, 0, gw, NW, lane));
    xcd_barrier(xbar);
    layer<0>(pk, smem, xbar);
    layer<1>(pk, smem, xbar);
}

static inline size_t al(size_t x) { return (x + 255) & ~(size_t)255; }

extern "C" void kernel_launch(void* const* d_in, const int* in_sizes, int n_in, void* d_out, int out_size, void* d_ws, size_t ws_size, hipStream_t stream) {
    static int grid_blocks = 0;
    if (grid_blocks == 0) {
        int dev = 0, cus = 0, per_cu = 0;
        if (hipFuncSetAttribute((const void*)mega, hipFuncAttributeMaxDynamicSharedMemorySize, LDS_BYTES) != hipSuccess) { fprintf(stderr, "hipFuncSetAttribute failed\n"); grid_blocks = -1; return; }
        (void)hipGetDevice(&dev); (void)hipDeviceGetAttribute(&cus, hipDeviceAttributeMultiprocessorCount, dev);
        if (hipOccupancyMaxActiveBlocksPerMultiprocessor(&per_cu, (const void*)mega, NTHR, LDS_BYTES) != hipSuccess || per_cu < 1) { fprintf(stderr, "occupancy query: %d blocks/CU\n", per_cu); grid_blocks = -1; return; }
        grid_blocks = cus;
    }
    if (grid_blocks < 0) return;
    P p{};
    const float** pin = (const float**)&p;
    for (int i = 0; i < 29; ++i) pin[i] = (const float*)d_in[i];
    p.out = (float*)d_out;
    char* ws = (char*)d_ws; size_t off = 0;
    auto take = [&](size_t bytes) { char* q = ws + off; off += al(bytes); return q; };
    p.XB = (bf16_t*)take((size_t)T * D * 2);
    p.H = (bf16_t*)take((size_t)T * D * 2);
    p.PROJ = (bf16_t*)take((size_t)T * LDP * 2);
    p.SS = (bf16_t*)take((size_t)NTILE * 8 * 2 * 4096 * 2);
    p.GS = (bf16_t*)take((size_t)NTILE * 4 * 2 * 8192 * 2);
    p.SDEC = (float*)take((size_t)NTILE * 8 * 2 * 4);
    p.GDEC = (float*)take((size_t)NTILE * 4 * 2 * 64 * 4);
    p.MOD = (float*)take((size_t)2 * 9 * 6144 * 4);
    p.counts = (int*)take(64 * 32 * 4);
    p.TOKSLOT = (int*)take((size_t)T * 4 * 4);
    p.EW = (float*)take((size_t)T * 2 * 4);
    p.MAP = (int*)take((size_t)NE * T * 4);
    p.WinT = (bf16_t*)take((size_t)2 * NPAD_IN * D * 2);
    p.WoutT = (bf16_t*)take((size_t)2 * D * D * 2);
    p.WguT = (bf16_t*)take((size_t)NE * D * D * 2);
    p.WdT = (bf16_t*)take((size_t)NE * D * 512 * 2);
    p.WRT = (bf16_t*)take((size_t)32 * 1024 * 2);
    p.BAR = (unsigned*)take(XCD_BAR_WORDS * 4);
    p.XBCC = (bf16_t*)d_out;
    p.QKB = (bf16_t*)d_out + (size_t)T * 768;
    p.SSC = (float*)take((size_t)T * 8 * 4 * 4);
    p.STOT = (float*)take((size_t)NTILE * 8 * 2 * 4);
    p.SSQ = (float*)take((size_t)T * 8 * 4);
    p.XSS = (float*)take((size_t)T * 16 * 4);
    if (off > ws_size) { fprintf(stderr, "workspace too small: need %zu have %zu\n", off, ws_size); return; }
    if (hipMemsetAsync(p.BAR, 0, XCD_BAR_WORDS * 4, stream) != hipSuccess) { fprintf(stderr, "memset of barrier words failed\n"); return; }
    void* args[] = {&p};
    hipError_t e = hipLaunchCooperativeKernel((void*)mega, dim3(grid_blocks), dim3(NTHR), args, LDS_BYTES, stream);
    if (e != hipSuccess) fprintf(stderr, "cooperative launch failed: %s (grid %d)\n", hipGetErrorString(e), grid_blocks);
}
```

```cpp
#include <hip/hip_runtime.h>
#include <hip/hip_cooperative_groups.h>
#include <stdint.h>
#include <cstdio>
namespace cg = cooperative_groups;

typedef unsigned short bf16_t;
#define DI __device__ __forceinline__

constexpr int D = 1024, NB = 8, SEQ = 4096, CTXL = 256, TC = NB * CTXL, TL = NB * SEQ, T = TC + TL;
constexpr int INDIM = 2840, LDP = 2848;
constexpr int OFF_Z = 0, OFF_XBC = 512, OFF_DT = 1280, OFF_Q = 1288, OFF_K = 1544, OFF_V = 1800, OFF_GO = 2312, OFF_GK = 2824;
constexpr int NE = 32;

DI float bf2f(bf16_t v) { return __uint_as_float(((unsigned)v) << 16); }
typedef float f32x2v_ __attribute__((ext_vector_type(2)));
typedef __bf16 bf16x2v_ __attribute__((ext_vector_type(2)));
DI bf16_t f2bf(float f) { return __builtin_bit_cast(unsigned short, (__bf16)f); }
DI float siluf(float x) { return x * __builtin_amdgcn_rcpf(1.0f + __builtin_amdgcn_exp2f(-1.4426950408889634f * x)); }
DI float softplusf(float x) { return fmaxf(x, 0.f) + log1pf(__expf(-fabsf(x))); }
DI float logsigmoidf(float x) { return -softplusf(-x); }
DI float shx(float v, int o, int lane) { return __int_as_float(__builtin_amdgcn_ds_bpermute((lane ^ o) << 2, __float_as_int(v))); }
DI int shxi(int v, int o, int lane) { return __builtin_amdgcn_ds_bpermute((lane ^ o) << 2, v); }
DI float shl(float v, int src) { return __int_as_float(__builtin_amdgcn_ds_bpermute(src << 2, __float_as_int(v))); }
DI int shli(int v, int src) { return __builtin_amdgcn_ds_bpermute(src << 2, v); }
DI float wave_sum(float v, int lane) {
#pragma unroll
    for (int o = 32; o >= 1; o >>= 1) v += shx(v, o, lane);
    return v;
}
DI int ltid() { const int wv = __builtin_amdgcn_readfirstlane(threadIdx.x >> 6);
    int t = wv * 64 + (int)__builtin_amdgcn_mbcnt_hi(~0u, __builtin_amdgcn_mbcnt_lo(~0u, 0u)); asm volatile("" : "+v"(t)); return t; }
DI int tok_modrow(int t) { return t < TC ? 8 : ((t - TC) >> 12); }
template <class PT> DI bf16_t* xrow(const PT& p, int t) { return p.XB + (size_t)t * D; }


#ifndef PG8_SP2
#define PG8_SP2 true
#endif
namespace pg8 {
#define PG8_LAS __attribute__((address_space(3)))
typedef unsigned short bf16_t;
typedef short bf16x8 __attribute__((ext_vector_type(8)));
typedef float f32x4 __attribute__((ext_vector_type(4)));
typedef unsigned u32x4 __attribute__((ext_vector_type(4)));
constexpr int BM = 256, BK = 64, HALF = 128, HTB = HALF * BK * 2  , STAGE_BYTES = 8 * HTB, NXCD = 8, WGM = 8;

__host__ __device__ __forceinline__ int lds_byte(int r, int c) { const int st = (r >> 4) * 2 + (c >> 5), rr = r & 15, cc = c & 31, ob = rr * 64 + cc * 2; return st * 1024 + (ob ^ (((ob >> 9) & 1) << 5)); }
__host__ __device__ __forceinline__ void stage_rc(int b, int& R, int& C) { const int st = b / 1024, sb = b % 1024, swz = sb ^ (((sb >> 9) & 1) << 5); R = (st >> 1) * 16 + swz / 64; C = (st & 1) * 32 + (swz % 64) / 2; }
__host__ __device__ __forceinline__ int perm32(int rho) { const int n = rho >> 4, i = rho & 15; return 8 * (i >> 2) + 4 * n + (i & 3); }

struct Unit { int pm, pn; };
struct Gemm { const bf16_t* A; const bf16_t* Bt; int M, N, K; };

struct StaticOrder {
    int nM, nN, nwg, G, c;
    __host__ __device__ void init(int M, int N, int G_, int c_) { nM = M / BM; nN = N / BM; nwg = nM * nN; G = G_; c = c_; }
    __host__ __device__ bool next(int i, Unit& u) const {
        const long L = (long)i * G + c; if (L >= nwg) return false;
        int wgid = (int)L; { const int q = nwg / NXCD, r = nwg % NXCD, xcd = wgid % NXCD, off = wgid / NXCD; wgid = (xcd < r ? xcd * (q + 1) : r * (q + 1) + (xcd - r) * q) + off; }
        const int nig = WGM * nN, gid = wgid / nig, fm = gid * WGM, gsz = (nM - fm) < WGM ? (nM - fm) : WGM;
        u.pm = fm + ((wgid % nig) % gsz); u.pn = (wgid % nig) / gsz; return true;
    }
    __device__ __forceinline__ void a_ready(const Unit&) const {}
    __device__ __forceinline__ void done(const Unit&) const {}
};
__device__ __forceinline__ unsigned cvt_pk_bf16(float lo, float hi) { unsigned r; asm volatile("v_cvt_pk_bf16_f32 %0, %1, %2" : "=v"(r) : "v"(lo), "v"(hi)); return r; }
typedef float f32x2 __attribute__((ext_vector_type(2)));

struct EpiProj {
    static constexpr bool PERM = true, AFTER_DRAIN = false, MIDK = false;
    bf16_t* O; int ldc; int ncols;
    __device__ __forceinline__ void operator()(const f32x4 (&acc)[2][2][4][2], const Unit& u, int wr, int wc, int fr, int fq) const {
        const int row0 = u.pm * BM + wr * 64 + fr, col0 = u.pn * BM + wc * 32 + 8 * fq;
#pragma unroll
        for (int ai = 0; ai < 2; ++ai)
#pragma unroll
            for (int m = 0; m < 4; ++m) { bf16_t* rowp = O + (size_t)(row0 + ai * HALF + m * 16) * ldc + col0;
#pragma unroll
                for (int bj = 0; bj < 2; ++bj) { const f32x4 v0 = acc[ai][bj][m][0], v1 = acc[ai][bj][m][1];
                    u32x4 w; w.x = cvt_pk_bf16(v0[0], v0[1]); w.y = cvt_pk_bf16(v0[2], v0[3]); w.z = cvt_pk_bf16(v1[0], v1[1]); w.w = cvt_pk_bf16(v1[2], v1[3]);
                    if (col0 + bj * HALF + 8 <= ncols) *(u32x4*)(rowp + bj * HALF) = w; } }
    }
};
template <bool SRC_BF16> struct EpiResGate {
    static constexpr bool PERM = true, AFTER_DRAIN = false, MIDK = true;
    const float* ssq;
    const float* Sc; const float* Sl;
    bf16_t* XB;
    const float* gate_rows; float* xss; int rowoff;
    __device__ __forceinline__ void midk(f32x4 (&acc)[2][2][4][2], const Unit& u, int wr, int fr) const {
        int fr_ = fr; asm volatile("" : "+v"(fr_));
        const int row0 = rowoff + u.pm * BM + wr * 64 + fr_;
#pragma unroll
        for (int ai = 0; ai < 2; ++ai)
#pragma unroll
            for (int m = 0; m < 4; ++m) { const f32x4* q = (const f32x4*)(ssq + (size_t)(row0 + ai * HALF + m * 16) * 8); const f32x4 a = q[0], b = q[1];
                const float rs = __builtin_amdgcn_rsqf((((a[0] + a[1]) + (a[2] + a[3])) + ((b[0] + b[1]) + (b[2] + b[3]))) * (1.0f / 512.0f) + 1e-6f);
#pragma unroll
                for (int bj = 0; bj < 2; ++bj)
#pragma unroll
                    for (int n = 0; n < 2; ++n) acc[ai][bj][m][n] *= rs;
                asm volatile("" ::: "memory"); }
    }
    __device__ __forceinline__ void operator()(const f32x4 (&acc)[2][2][4][2], const Unit& u, int wr, int wc, int fr, int fq) const {
        const int row0 = rowoff + u.pm * BM + wr * 64 + fr, col0 = u.pn * BM + wc * 32 + 8 * fq;
        const int t0 = rowoff + u.pm * BM; const int mrow = t0 < 2048 ? 8 : ((t0 - 2048) >> 12);
        const float* gr = gate_rows + (size_t)mrow * 6144 + col0;
        f32x4 gv[2][2];
#pragma unroll
        for (int bj = 0; bj < 2; ++bj)
#pragma unroll
            for (int n = 0; n < 2; ++n) gv[bj][n] = *(const f32x4*)(gr + bj * HALF + n * 4);
#pragma unroll
        for (int ai = 0; ai < 2; ++ai)
#pragma unroll
            for (int m = 0; m < 4; ++m) { const int rr = row0 + ai * HALF + m * 16;
                const float* sp = (rr < 2048 ? Sc + (size_t)rr * 1024 : Sl + (size_t)(rr - 2048) * 1024) + col0; bf16_t* dp = XB + (size_t)rr * 1024 + col0; float ss = 0.f;
#pragma unroll
                for (int bj = 0; bj < 2; ++bj) { f32x4 x0, x1;
                    if (SRC_BF16) { const u32x4 r = *(const u32x4*)(dp + bj * HALF);
                        x0 = (f32x4){__uint_as_float(r.x << 16), __uint_as_float(r.x & 0xffff0000u), __uint_as_float(r.y << 16), __uint_as_float(r.y & 0xffff0000u)};
                        x1 = (f32x4){__uint_as_float(r.z << 16), __uint_as_float(r.z & 0xffff0000u), __uint_as_float(r.w << 16), __uint_as_float(r.w & 0xffff0000u)}; }
                    else { x0 = *(const f32x4*)(sp + bj * HALF); x1 = *(const f32x4*)(sp + bj * HALF + 4); }
                    const f32x4 v0 = x0 + gv[bj][0] * acc[ai][bj][m][0], v1 = x1 + gv[bj][1] * acc[ai][bj][m][1];
                    u32x4 w; w.x = cvt_pk_bf16(v0[0], v0[1]); w.y = cvt_pk_bf16(v0[2], v0[3]); w.z = cvt_pk_bf16(v1[0], v1[1]); w.w = cvt_pk_bf16(v1[2], v1[3]);
                    *(u32x4*)(dp + bj * HALF) = w;
#pragma unroll
                    for (int j = 0; j < 4; ++j) { const float lo = __uint_as_float(w[j] << 16), hi = __uint_as_float(w[j] & 0xffff0000u); ss += lo * lo + hi * hi; } }
                { const int ln_ = fq * 16 + fr; ss += __int_as_float(__builtin_amdgcn_ds_bpermute((ln_ ^ 16) << 2, __float_as_int(ss))); ss += __int_as_float(__builtin_amdgcn_ds_bpermute((ln_ ^ 32) << 2, __float_as_int(ss))); }
                if (fq == 0) xss[(size_t)rr * 16 + u.pn * 4 + wc] = ss; }
    }
};
template <class Epi, class Sched, bool STAMP = false, bool SP2 = PG8_SP2>
__device__ __forceinline__ void gemm_phase(PG8_LAS unsigned char* lds, const Gemm g, const Sched& S, const Epi& E, unsigned long long* stamps) {
    int tid_l = __builtin_amdgcn_readfirstlane(threadIdx.x >> 6) * 64 + (int)__builtin_amdgcn_mbcnt_hi(~0u, __builtin_amdgcn_mbcnt_lo(~0u, 0u)); asm volatile("" : "+v"(tid_l));
    const int tid = tid_l, wid = __builtin_amdgcn_readfirstlane(tid >> 6), lane = tid & 63, wr = wid >> 2, wc = wid & 3, fr = lane & 15, fq = lane >> 4;
    const int K = g.K, nt = K / BK;
    int ts_lo = 0, ts_hi = 0, nts = 0; const unsigned long long rt_entry = STAMP ? (unsigned long long)wall_clock64() : 0ull;
#define PG8_STAMP() do { if (STAMP && wid == 0 && nts < 64) { const unsigned long long _c = (unsigned long long)clock64(); \
        ts_lo = (lane == nts) ? (int)(unsigned)_c : ts_lo; ts_hi = (lane == nts) ? (int)(unsigned)(_c >> 32) : ts_hi; ++nts; } } while (0)
    PG8_STAMP();
    unsigned voffA[2], voffB[2];
#pragma unroll
    for (int i = 0; i < 2; ++i) { int R, C; stage_rc(tid * 16 + i * 8192, R, C); const int Rb = Epi::PERM ? ((R & ~31) + perm32(R & 31)) : R;
        voffA[i] = (unsigned)(R * K + C) * 2u; voffB[i] = (unsigned)(Rb * K + C) * 2u; }
    const size_t kstep = (size_t)(BK * 2);
    const size_t hstep = (size_t)HALF * K * 2;
    const size_t tstep = 2 * hstep;
    const unsigned ldsw = (unsigned)wid * 1024u;
    const int aoff = lds_byte(wr * 64 + fr, fq * 8), boff = lds_byte(wc * 32 + fr, fq * 8);
#define PG8_SA(b, h) (((b) * 2 + (h)) * HTB)
#define PG8_SB(b, h) ((4 + (b) * 2 + (h)) * HTB)
#define PG8_STAGE(bufoff, gbase, voff) do { _Pragma("unroll") for (int _i = 0; _i < 2; ++_i) \
        __builtin_amdgcn_global_load_lds((const unsigned*)((const char*)(gbase) + (voff)[_i]), (PG8_LAS unsigned*)(lds + (bufoff) + ldsw + _i * 8192), 16, 0, 0); } while (0)
#define PG8_LDA(dst, b, h) do { _Pragma("unroll") for (int m = 0; m < 4; ++m) _Pragma("unroll") for (int k = 0; k < 2; ++k) dst[m][k] = *(const PG8_LAS bf16x8*)(lds + PG8_SA(b, h) + aoff + m * 2048 + k * 1024); } while (0)
#define PG8_LDB(dst, b, h) do { _Pragma("unroll") for (int n = 0; n < 2; ++n) _Pragma("unroll") for (int k = 0; k < 2; ++k) dst[n][k] = *(const PG8_LAS bf16x8*)(lds + PG8_SB(b, h) + boff + n * 2048 + k * 1024); } while (0)
#define PG8_MMA(ai, bj, At, Bt) do { __builtin_amdgcn_s_setprio(1); _Pragma("unroll") for (int m = 0; m < 4; ++m) _Pragma("unroll") for (int n = 0; n < 2; ++n) _Pragma("unroll") for (int k = 0; k < 2; ++k) \
        acc[ai][bj][m][n] = __builtin_amdgcn_mfma_f32_16x16x32_bf16(Bt[n][k], At[m][k], acc[ai][bj][m][n], 0, 0, 0); __builtin_amdgcn_s_setprio(0); } while (0)
#define PG8_WAIT_V(n) asm volatile("s_waitcnt vmcnt(" #n ")" ::: "memory")
#define PG8_WAIT_L(n) asm volatile("s_waitcnt lgkmcnt(" #n ")" ::: "memory")
#define PG8_BAR __builtin_amdgcn_s_barrier()
#define PG8_SCHED __builtin_amdgcn_sched_barrier(0)
    Unit cur, nxt; int ui = 0;
    if (!S.next(0, cur)) return;
    f32x4 acc[2][2][4][2];
#pragma unroll
    for (int a = 0; a < 2; ++a)
#pragma unroll
        for (int b = 0; b < 2; ++b)
#pragma unroll
            for (int m = 0; m < 4; ++m)
#pragma unroll
                for (int n = 0; n < 2; ++n) acc[a][b][m][n] = (f32x4){0.f, 0.f, 0.f, 0.f};
    bf16x8 At[4][2], B0[2][2], B1[2][2];
    const char* cA = (const char*)g.A + (size_t)cur.pm * tstep; const char* cB = (const char*)g.Bt + (size_t)cur.pn * tstep;
    S.a_ready(cur);
    if constexpr (SP2) {
        PG8_STAGE(PG8_SB(0, 0), cB, voffB); PG8_STAGE(PG8_SB(0, 1), cB + hstep, voffB); PG8_STAGE(PG8_SA(0, 0), cA, voffA); PG8_STAGE(PG8_SA(0, 1), cA + hstep, voffA);
        if (wr == 1) PG8_BAR;
        PG8_WAIT_V(2); PG8_BAR;
        PG8_STAGE(PG8_SB(1, 0), cB + kstep, voffB); PG8_STAGE(PG8_SA(1, 0), cA + kstep, voffA); PG8_STAGE(PG8_SB(1, 1), cB + hstep + kstep, voffB);
        PG8_WAIT_V(6); PG8_BAR;
    } else {
    PG8_STAGE(PG8_SB(0, 0), cB, voffB); PG8_STAGE(PG8_SA(0, 0), cA, voffA); PG8_STAGE(PG8_SB(0, 1), cB + hstep, voffB); PG8_STAGE(PG8_SA(0, 1), cA + hstep, voffA);
    if (wr == 1) PG8_BAR;
    PG8_WAIT_V(4); PG8_BAR;
    PG8_STAGE(PG8_SB(1, 0), cB + kstep, voffB); PG8_STAGE(PG8_SA(1, 0), cA + kstep, voffA); PG8_STAGE(PG8_SB(1, 1), cB + hstep + kstep, voffB);
    PG8_WAIT_V(6); PG8_BAR;
    }
    PG8_STAMP();
    for (;;) {
        const bool has_next = S.next(ui + 1, nxt);
        const char* nA = has_next ? (const char*)g.A + (size_t)nxt.pm * tstep : cA; const char* nB = has_next ? (const char*)g.Bt + (size_t)nxt.pn * tstep : cB;
        for (int t = 0; t < nt; t += 2) {
            const bool last = (t == nt - 2);
            const char* a1 = cA + (size_t)(t + 1) * kstep;
            const char* a2 = last ? nA : cA + (size_t)(t + 2) * kstep; const char* b2 = last ? nB : cB + (size_t)(t + 2) * kstep;
            const char* a3 = a2 + kstep; const char* b3 = b2 + kstep;
            if (last && has_next) S.a_ready(nxt);
            if constexpr (SP2) {
            PG8_LDB(B0, 0, 0); PG8_LDB(B1, 0, 1); PG8_SCHED; PG8_LDA(At, 0, 0); PG8_STAGE(PG8_SA(1, 1), a1 + hstep, voffA);
            PG8_WAIT_V(8); PG8_WAIT_L(0); PG8_BAR; PG8_MMA(0, 0, At, B0); PG8_MMA(0, 1, At, B1); PG8_BAR; PG8_SCHED;
            PG8_LDA(At, 0, 1); PG8_STAGE(PG8_SB(0, 0), b2, voffB); PG8_STAGE(PG8_SB(0, 1), b2 + hstep, voffB); PG8_STAGE(PG8_SA(0, 0), a2, voffA);
            PG8_WAIT_V(8); PG8_WAIT_L(0); PG8_BAR; PG8_MMA(1, 0, At, B0); PG8_MMA(1, 1, At, B1); PG8_BAR; PG8_SCHED;
            PG8_LDB(B0, 1, 0); PG8_LDB(B1, 1, 1); PG8_SCHED; PG8_LDA(At, 1, 0); PG8_STAGE(PG8_SA(0, 1), a2 + hstep, voffA);
            PG8_WAIT_V(8); PG8_WAIT_L(0); PG8_BAR; PG8_MMA(0, 0, At, B0); PG8_MMA(0, 1, At, B1); PG8_BAR; PG8_SCHED;
            PG8_LDA(At, 1, 1); PG8_STAGE(PG8_SB(1, 0), b3, voffB); PG8_STAGE(PG8_SB(1, 1), b3 + hstep, voffB); PG8_STAGE(PG8_SA(1, 0), a3, voffA);
            PG8_WAIT_V(8); PG8_WAIT_L(0); PG8_BAR; PG8_MMA(1, 0, At, B0); PG8_MMA(1, 1, At, B1); PG8_BAR; PG8_SCHED;
            } else {
            PG8_LDB(B0, 0, 0); PG8_SCHED; PG8_LDA(At, 0, 0); PG8_STAGE(PG8_SA(1, 1), a1 + hstep, voffA);
            PG8_WAIT_L(8); PG8_BAR; PG8_WAIT_L(0); PG8_MMA(0, 0, At, B0); PG8_BAR; PG8_SCHED;
            PG8_LDB(B1, 0, 1); PG8_STAGE(PG8_SB(0, 0), b2, voffB);
            PG8_BAR; PG8_WAIT_L(0); PG8_MMA(0, 1, At, B1); PG8_BAR;
            PG8_LDA(At, 0, 1); PG8_STAGE(PG8_SA(0, 0), a2, voffA);
            PG8_BAR; PG8_WAIT_L(0); PG8_MMA(1, 0, At, B0); PG8_BAR; PG8_SCHED;
            PG8_STAGE(PG8_SB(0, 1), b2 + hstep, voffB);
            PG8_WAIT_V(6); PG8_BAR; PG8_MMA(1, 1, At, B1); PG8_BAR;
            PG8_LDB(B0, 1, 0); PG8_SCHED; PG8_LDA(At, 1, 0); PG8_STAGE(PG8_SA(0, 1), a2 + hstep, voffA);
            PG8_WAIT_L(8); PG8_BAR; PG8_WAIT_L(0); PG8_MMA(0, 0, At, B0); PG8_BAR; PG8_SCHED;
            PG8_LDB(B1, 1, 1); PG8_STAGE(PG8_SB(1, 0), b3, voffB);
            PG8_BAR; PG8_WAIT_L(0); PG8_MMA(0, 1, At, B1); PG8_BAR;
            PG8_LDA(At, 1, 1); PG8_STAGE(PG8_SA(1, 0), a3, voffA);
            PG8_BAR; PG8_WAIT_L(0); PG8_MMA(1, 0, At, B0); PG8_BAR; PG8_SCHED;
            PG8_STAGE(PG8_SB(1, 1), b3 + hstep, voffB);
            PG8_WAIT_V(6); PG8_BAR; PG8_MMA(1, 1, At, B1); PG8_BAR;
            }
            if constexpr (Epi::MIDK) { if (t + 2 == nt / 2) E.midk(acc, cur, wr, fr); }
        }
        PG8_STAMP();
        if (wr == 0) PG8_BAR;
        if constexpr (!Epi::AFTER_DRAIN) { E(acc, cur, wr, wc, fr, fq); S.done(cur); }
        PG8_STAMP();
        if (!has_next) break;
#pragma unroll
        for (int a = 0; a < 2; ++a)
#pragma unroll
            for (int b = 0; b < 2; ++b)
#pragma unroll
                for (int m = 0; m < 4; ++m)
#pragma unroll
                    for (int n = 0; n < 2; ++n) acc[a][b][m][n] = (f32x4){0.f, 0.f, 0.f, 0.f};
        cur = nxt; cA = nA; cB = nB; ++ui;
        if (wr == 1) PG8_BAR;
    }
    PG8_WAIT_V(0);
    PG8_BAR;
    if constexpr (Epi::AFTER_DRAIN) { E.fused(acc, cur, wr, wc, fr, fq, lds, wid, lane); S.done(cur); }
    PG8_STAMP();
    if (STAMP && wid == 0) { stamps[lane] = lane < nts ? (((unsigned long long)(unsigned)ts_hi << 32) | (unsigned)ts_lo) : 0ull;
        if (lane == 62) stamps[62] = rt_entry; if (lane == 63) stamps[63] = (unsigned long long)wall_clock64(); }
#undef PG8_STAMP
#undef PG8_SA
#undef PG8_SB
#undef PG8_STAGE
#undef PG8_LDA
#undef PG8_LDB
#undef PG8_MMA
#undef PG8_WAIT_V
#undef PG8_WAIT_L
#undef PG8_BAR
#undef PG8_SCHED
}

struct MoeUnit { int e, mt, pn, cnt, pstart; };
struct MoeSched {
    typedef MoeUnit UnitT;
    PG8_LAS const int* tab; const int* map; int U, G, c, npn, gather; size_t bstride;
    __device__ __forceinline__ bool next(int i, MoeUnit& u) const {
        const long L = (long)i * G + c; if (L >= U) return false;
        int idx = (int)L; { const int q = U / NXCD, r = U % NXCD, xcd = idx % NXCD, off = idx / NXCD; idx = (xcd < r ? xcd * (q + 1) : r * (q + 1) + (xcd - r) * q) + off; }
        const int tau = idx / npn; u.pn = idx - tau * npn;
        int e = 0;
#pragma unroll
        for (int st = 16; st >= 1; st >>= 1) { if (__builtin_amdgcn_readfirstlane(tab[e + st]) <= tau) e += st; }
        u.e = e; u.mt = tau - __builtin_amdgcn_readfirstlane(tab[e]); u.cnt = __builtin_amdgcn_readfirstlane(tab[33 + e]); u.pstart = __builtin_amdgcn_readfirstlane(tab[65 + e]);
        return true;
    }
    __device__ __forceinline__ const char* bbase(const Gemm& g, const MoeUnit& u) const { return (const char*)g.Bt + (size_t)u.e * bstride + (size_t)u.pn * BM * g.K * 2; }
    __device__ __forceinline__ void a_offsets(const Gemm& g, const MoeUnit& u, int tid, unsigned (&va)[2][2]) const {
        int tl = tid; asm volatile("" : "+v"(tl));
        int RA[2], CA[2];
#pragma unroll
        for (int i = 0; i < 2; ++i) { int R, C; stage_rc(tl * 16 + i * 8192, R, C); RA[i] = R; CA[i] = C * 2; }
#pragma unroll
        for (int hf = 0; hf < 2; ++hf)
#pragma unroll
            for (int i = 0; i < 2; ++i) { int rl = u.mt * BM + hf * HALF + RA[i]; rl = rl < u.cnt ? rl : u.cnt - 1;
                const unsigned row = gather ? (unsigned)map[(size_t)u.e * 34816 + rl] : (unsigned)(u.pstart + rl);
                va[hf][i] = row * (unsigned)(g.K * 2) + (unsigned)CA[i]; }
    }
};
struct EpiAct {
    static constexpr bool PERM = true, AFTER_DRAIN = false;
    bf16_t* O;
    __device__ __forceinline__ void operator()(const f32x4 (&acc)[2][2][4][2], const MoeUnit& u, int wr, int wc, int fr, int fq) const {
        const int rl0 = u.mt * BM + wr * 64 + fr, col0 = u.pn * HALF + wc * 32 + 8 * fq;
#pragma unroll
        for (int ai = 0; ai < 2; ++ai)
#pragma unroll
            for (int m = 0; m < 4; ++m) { const int rl = rl0 + ai * HALF + m * 16;
                if (rl < u.cnt) { float o[8];
#pragma unroll
                    for (int n = 0; n < 2; ++n)
#pragma unroll
                        for (int j = 0; j < 4; ++j) { const float gv = acc[ai][0][m][n][j]; o[4 * n + j] = gv * __builtin_amdgcn_rcpf(1.0f + __builtin_amdgcn_exp2f(-1.4426950408889634f * gv)) * acc[ai][1][m][n][j]; }
                    u32x4 w; w.x = cvt_pk_bf16(o[0], o[1]); w.y = cvt_pk_bf16(o[2], o[3]); w.z = cvt_pk_bf16(o[4], o[5]); w.w = cvt_pk_bf16(o[6], o[7]);
                    *(u32x4*)(O + (size_t)(u.pstart + rl) * 512 + col0) = w; } }
    }
};
struct EpiY {
    static constexpr bool PERM = true, AFTER_DRAIN = false;
    unsigned char* O;
    static __device__ __forceinline__ unsigned pk4(const f32x4 v) { const float lim = 440.f;
        int w = __builtin_amdgcn_cvt_pk_fp8_f32(fminf(fmaxf(v[0], -lim), lim), fminf(fmaxf(v[1], -lim), lim), 0, false);
        return (unsigned)__builtin_amdgcn_cvt_pk_fp8_f32(fminf(fmaxf(v[2], -lim), lim), fminf(fmaxf(v[3], -lim), lim), w, true); }
    __device__ __forceinline__ void operator()(const f32x4 (&acc)[2][2][4][2], const MoeUnit& u, int wr, int wc, int fr, int fq) const {
        typedef unsigned u32x2 __attribute__((ext_vector_type(2)));
        const int rl0 = u.mt * BM + wr * 64 + fr, col0 = u.pn * BM + wc * 32 + 8 * fq;
#pragma unroll
        for (int ai = 0; ai < 2; ++ai)
#pragma unroll
            for (int m = 0; m < 4; ++m) { const int rl = rl0 + ai * HALF + m * 16;
                if (rl < u.cnt) { unsigned char* rowp = O + (size_t)(u.pstart + rl) * 1024 + col0;
#pragma unroll
                    for (int bj = 0; bj < 2; ++bj) *(u32x2*)(rowp + bj * HALF) = (u32x2){pk4(acc[ai][bj][m][0]), pk4(acc[ai][bj][m][1])}; } }
    }
};
template <class Epi, class Sched, bool STAMP = false, bool SP2 = PG8_SP2>
__device__ __forceinline__ void gemm_phase_moe(PG8_LAS unsigned char* lds, const Gemm g, const Sched& S, const Epi& E, unsigned long long* stamps) {
    int tid_l = __builtin_amdgcn_readfirstlane(threadIdx.x >> 6) * 64 + (int)__builtin_amdgcn_mbcnt_hi(~0u, __builtin_amdgcn_mbcnt_lo(~0u, 0u)); asm volatile("" : "+v"(tid_l));
    const int tid = tid_l, wid = __builtin_amdgcn_readfirstlane(tid >> 6), lane = tid & 63, wr = wid >> 2, wc = wid & 3, fr = lane & 15, fq = lane >> 4;
    const int K = g.K, nt = K / BK;
    int ts_lo = 0, ts_hi = 0, nts = 0; const unsigned long long rt_entry = STAMP ? (unsigned long long)wall_clock64() : 0ull;
#define PG8_STAMP() do { if (STAMP && wid == 0 && nts < 64) { const unsigned long long _c = (unsigned long long)clock64(); \
        ts_lo = (lane == nts) ? (int)(unsigned)_c : ts_lo; ts_hi = (lane == nts) ? (int)(unsigned)(_c >> 32) : ts_hi; ++nts; } } while (0)
    PG8_STAMP();
    unsigned voffB[2];
#pragma unroll
    for (int i = 0; i < 2; ++i) { int R, C; stage_rc(tid * 16 + i * 8192, R, C); const int Rb = Epi::PERM ? ((R & ~31) + perm32(R & 31)) : R;
        voffB[i] = (unsigned)(Rb * K + C) * 2u; }
    unsigned vaC[2][2];
    PG8_LAS unsigned* vtab = (PG8_LAS unsigned*)(lds + STAGE_BYTES + 1024) + tid;
    const size_t kstep = (size_t)(BK * 2);
    const size_t hstep = (size_t)HALF * K * 2;
    const size_t tstep = 2 * hstep;
    const unsigned ldsw = (unsigned)wid * 1024u;
    const int aoff = lds_byte(wr * 64 + fr, fq * 8), boff = lds_byte(wc * 32 + fr, fq * 8);
#define PG8_SA(b, h) (((b) * 2 + (h)) * HTB)
#define PG8_SB(b, h) ((4 + (b) * 2 + (h)) * HTB)
#define PG8_STAGE(bufoff, gbase, voff) do { _Pragma("unroll") for (int _i = 0; _i < 2; ++_i) \
        __builtin_amdgcn_global_load_lds((const unsigned*)((const char*)(gbase) + (voff)[_i]), (PG8_LAS unsigned*)(lds + (bufoff) + ldsw + _i * 8192), 16, 0, 0); } while (0)
#define PG8_STAGEA(bufoff, kbyte, va) do { _Pragma("unroll") for (int _i = 0; _i < 2; ++_i) \
        __builtin_amdgcn_global_load_lds((const unsigned*)((const char*)g.A + (kbyte) + (va)[_i]), (PG8_LAS unsigned*)(lds + (bufoff) + ldsw + _i * 8192), 16, 0, 0); } while (0)
#define PG8_LDA(dst, b, h) do { _Pragma("unroll") for (int m = 0; m < 4; ++m) _Pragma("unroll") for (int k = 0; k < 2; ++k) dst[m][k] = *(const PG8_LAS bf16x8*)(lds + PG8_SA(b, h) + aoff + m * 2048 + k * 1024); } while (0)
#define PG8_LDB(dst, b, h) do { _Pragma("unroll") for (int n = 0; n < 2; ++n) _Pragma("unroll") for (int k = 0; k < 2; ++k) dst[n][k] = *(const PG8_LAS bf16x8*)(lds + PG8_SB(b, h) + boff + n * 2048 + k * 1024); } while (0)
#define PG8_MMA(ai, bj, At, Bt) do { __builtin_amdgcn_s_setprio(1); _Pragma("unroll") for (int m = 0; m < 4; ++m) _Pragma("unroll") for (int n = 0; n < 2; ++n) _Pragma("unroll") for (int k = 0; k < 2; ++k) \
        acc[ai][bj][m][n] = __builtin_amdgcn_mfma_f32_16x16x32_bf16(Bt[n][k], At[m][k], acc[ai][bj][m][n], 0, 0, 0); __builtin_amdgcn_s_setprio(0); } while (0)
#define PG8_WAIT_V(n) asm volatile("s_waitcnt vmcnt(" #n ")" ::: "memory")
#define PG8_WAIT_L(n) asm volatile("s_waitcnt lgkmcnt(" #n ")" ::: "memory")
#define PG8_BAR __builtin_amdgcn_s_barrier()
#define PG8_SCHED __builtin_amdgcn_sched_barrier(0)
    typename Sched::UnitT cur, nxt; int ui = 0;
    if (!S.next(0, cur)) return;
    f32x4 acc[2][2][4][2];
#pragma unroll
    for (int a = 0; a < 2; ++a)
#pragma unroll
        for (int b = 0; b < 2; ++b)
#pragma unroll
            for (int m = 0; m < 4; ++m)
#pragma unroll
                for (int n = 0; n < 2; ++n) acc[a][b][m][n] = (f32x4){0.f, 0.f, 0.f, 0.f};
    bf16x8 At[4][2], B0[2][2], B1[2][2];
    const char* cB = S.bbase(g, cur); S.a_offsets(g, cur, tid, vaC);
    if constexpr (SP2) {
        PG8_STAGE(PG8_SB(0, 0), cB, voffB); PG8_STAGE(PG8_SB(0, 1), cB + hstep, voffB); PG8_STAGEA(PG8_SA(0, 0), 0, vaC[0]); PG8_STAGEA(PG8_SA(0, 1), 0, vaC[1]);
        if (wr == 1) PG8_BAR;
        PG8_WAIT_V(2); PG8_BAR;
        PG8_STAGE(PG8_SB(1, 0), cB + kstep, voffB); PG8_STAGEA(PG8_SA(1, 0), kstep, vaC[0]); PG8_STAGE(PG8_SB(1, 1), cB + hstep + kstep, voffB);
        PG8_WAIT_V(6); PG8_BAR;
    } else {
    PG8_STAGE(PG8_SB(0, 0), cB, voffB); PG8_STAGEA(PG8_SA(0, 0), 0, vaC[0]); PG8_STAGE(PG8_SB(0, 1), cB + hstep, voffB); PG8_STAGEA(PG8_SA(0, 1), 0, vaC[1]);
    if (wr == 1) PG8_BAR;
    PG8_WAIT_V(4); PG8_BAR;
    PG8_STAGE(PG8_SB(1, 0), cB + kstep, voffB); PG8_STAGEA(PG8_SA(1, 0), kstep, vaC[0]); PG8_STAGE(PG8_SB(1, 1), cB + hstep + kstep, voffB);
    PG8_WAIT_V(6); PG8_BAR;
    }
    PG8_STAMP();
    for (;;) {
        const bool has_next = S.next(ui + 1, nxt);
        const char* nB = has_next ? S.bbase(g, nxt) : cB;
        { unsigned vaN[2][2];
          if (has_next) S.a_offsets(g, nxt, tid, vaN); else {
#pragma unroll
            for (int hf = 0; hf < 2; ++hf)
#pragma unroll
                for (int i = 0; i < 2; ++i) vaN[hf][i] = vaC[hf][i]; }
#pragma unroll
          for (int hf = 0; hf < 2; ++hf)
#pragma unroll
              for (int i = 0; i < 2; ++i) vtab[(hf * 2 + i) * 512] = vaN[hf][i]; }
        unsigned v2[2][2];
        for (int t = 0; t < nt; t += 2) {
            const bool last = (t == nt - 2);
            const size_t k1 = (size_t)(t + 1) * kstep, k2 = last ? (size_t)0 : (size_t)(t + 2) * kstep, k3 = k2 + kstep;
            const char* b2 = last ? nB : cB + (size_t)(t + 2) * kstep; const char* b3 = b2 + kstep;
#pragma unroll
            for (int hf = 0; hf < 2; ++hf)
#pragma unroll
                for (int i = 0; i < 2; ++i) v2[hf][i] = last ? vtab[(hf * 2 + i) * 512] : vaC[hf][i];
            if constexpr (SP2) {
            PG8_LDB(B0, 0, 0); PG8_LDB(B1, 0, 1); PG8_SCHED; PG8_LDA(At, 0, 0); PG8_STAGEA(PG8_SA(1, 1), k1, vaC[1]);
            PG8_WAIT_V(8); PG8_WAIT_L(0); PG8_BAR; PG8_MMA(0, 0, At, B0); PG8_MMA(0, 1, At, B1); PG8_BAR; PG8_SCHED;
            PG8_LDA(At, 0, 1); PG8_STAGE(PG8_SB(0, 0), b2, voffB); PG8_STAGE(PG8_SB(0, 1), b2 + hstep, voffB); PG8_STAGEA(PG8_SA(0, 0), k2, v2[0]);
            PG8_WAIT_V(8); PG8_WAIT_L(0); PG8_BAR; PG8_MMA(1, 0, At, B0); PG8_MMA(1, 1, At, B1); PG8_BAR; PG8_SCHED;
            PG8_LDB(B0, 1, 0); PG8_LDB(B1, 1, 1); PG8_SCHED; PG8_LDA(At, 1, 0); PG8_STAGEA(PG8_SA(0, 1), k2, v2[1]);
            PG8_WAIT_V(8); PG8_WAIT_L(0); PG8_BAR; PG8_MMA(0, 0, At, B0); PG8_MMA(0, 1, At, B1); PG8_BAR; PG8_SCHED;
            PG8_LDA(At, 1, 1); PG8_STAGE(PG8_SB(1, 0), b3, voffB); PG8_STAGE(PG8_SB(1, 1), b3 + hstep, voffB); PG8_STAGEA(PG8_SA(1, 0), k3, v2[0]);
            PG8_WAIT_V(8); PG8_WAIT_L(0); PG8_BAR; PG8_MMA(1, 0, At, B0); PG8_MMA(1, 1, At, B1); PG8_BAR; PG8_SCHED;
            } else {
            PG8_LDB(B0, 0, 0); PG8_SCHED; PG8_LDA(At, 0, 0); PG8_STAGEA(PG8_SA(1, 1), k1, vaC[1]);
            PG8_WAIT_L(8); PG8_BAR; PG8_WAIT_L(0); PG8_MMA(0, 0, At, B0); PG8_BAR; PG8_SCHED;
            PG8_LDB(B1, 0, 1); PG8_STAGE(PG8_SB(0, 0), b2, voffB);
            PG8_BAR; PG8_WAIT_L(0); PG8_MMA(0, 1, At, B1); PG8_BAR;
            PG8_LDA(At, 0, 1); PG8_STAGEA(PG8_SA(0, 0), k2, v2[0]);
            PG8_BAR; PG8_WAIT_L(0); PG8_MMA(1, 0, At, B0); PG8_BAR; PG8_SCHED;
            PG8_STAGE(PG8_SB(0, 1), b2 + hstep, voffB);
            PG8_WAIT_V(6); PG8_BAR; PG8_MMA(1, 1, At, B1); PG8_BAR;
            PG8_LDB(B0, 1, 0); PG8_SCHED; PG8_LDA(At, 1, 0); PG8_STAGEA(PG8_SA(0, 1), k2, v2[1]);
            PG8_WAIT_L(8); PG8_BAR; PG8_WAIT_L(0); PG8_MMA(0, 0, At, B0); PG8_BAR; PG8_SCHED;
            PG8_LDB(B1, 1, 1); PG8_STAGE(PG8_SB(1, 0), b3, voffB);
            PG8_BAR; PG8_WAIT_L(0); PG8_MMA(0, 1, At, B1); PG8_BAR;
            PG8_LDA(At, 1, 1); PG8_STAGEA(PG8_SA(1, 0), k3, v2[0]);
            PG8_BAR; PG8_WAIT_L(0); PG8_MMA(1, 0, At, B0); PG8_BAR; PG8_SCHED;
            PG8_STAGE(PG8_SB(1, 1), b3 + hstep, voffB);
            PG8_WAIT_V(6); PG8_BAR; PG8_MMA(1, 1, At, B1); PG8_BAR;
            }
        }
        PG8_STAMP();
        if (wr == 0) PG8_BAR;
        E(acc, cur, wr, wc, fr, fq);
        PG8_STAMP();
        if (!has_next) break;
#pragma unroll
        for (int a = 0; a < 2; ++a)
#pragma unroll
            for (int b = 0; b < 2; ++b)
#pragma unroll
                for (int m = 0; m < 4; ++m)
#pragma unroll
                    for (int n = 0; n < 2; ++n) acc[a][b][m][n] = (f32x4){0.f, 0.f, 0.f, 0.f};
        cur = nxt; cB = nB; ++ui;
#pragma unroll
        for (int hf = 0; hf < 2; ++hf)
#pragma unroll
            for (int i = 0; i < 2; ++i) vaC[hf][i] = v2[hf][i];
        if (wr == 1) PG8_BAR;
    }
    PG8_WAIT_V(0);
    PG8_BAR;
    PG8_STAMP();
    if (STAMP && wid == 0) { stamps[lane] = lane < nts ? (((unsigned long long)(unsigned)ts_hi << 32) | (unsigned)ts_lo) : 0ull;
        if (lane == 62) stamps[62] = rt_entry; if (lane == 63) stamps[63] = (unsigned long long)wall_clock64(); }
#undef PG8_STAMP
#undef PG8_SA
#undef PG8_SB
#undef PG8_STAGE
#undef PG8_STAGEA
#undef PG8_LDA
#undef PG8_LDB
#undef PG8_MMA
#undef PG8_WAIT_V
#undef PG8_WAIT_L
#undef PG8_BAR
#undef PG8_SCHED
}
}

constexpr int NTHR = 512, NWV = 8, LDS_BYTES = 147456;

struct P {
    const float *x, *c, *ctx, *c_ctx, *w_mod, *b_mod, *norm1_g, *norm2_g, *w_in, *conv_w, *conv_b, *dt_bias_f, *dt_bias_b, *a_log_f, *a_log_b, *d_skip, *ssd_norm_g,
        *gk_up_f, *gk_bias_f, *gk_up_b, *gk_bias_b, *gla_norm_g, *w_out, *w_router, *router_bias, *w_gate, *w_up, *w_down, *final_g;
    float* out; bf16_t* XB; bf16_t* H; bf16_t* PROJ; bf16_t* SS; bf16_t* GS; float* SDEC; float* GDEC; float* MOD; int* counts; int* TOKSLOT; float* EW; int* MAP; bf16_t* WinT; bf16_t* WoutT; bf16_t* WguT; bf16_t* WdT; bf16_t* WRT; unsigned* BAR; bf16_t* XBCC; bf16_t* QKB; float* SSC; float* STOT; float* SSQ; float* XSS;
};

DI void ph_init(const P& p) { const size_t i = (size_t)blockIdx.x * NTHR + ltid(); if (i < 64) p.counts[i * 32] = 0; }

DI void ph_mod(const P& p, float* s  ) {
    const int tid_ = ltid(), lane = tid_ & 63, w = tid_ >> 6;
    if (blockIdx.x >= 192) return;
    float* part = s + 9 * 1024;
    { float cv[18];
#pragma unroll
      for (int q = 0; q < 18; ++q) { const int i = tid_ + q * NTHR, r = i >> 10, k = i & 1023; cv[q] = r < 8 ? p.c[r * 1024 + k] : p.c_ctx[k]; }
#pragma unroll
      for (int q = 0; q < 18; ++q) s[tid_ + q * NTHR] = siluf(cv[q]); }
    __syncthreads();
    for (int vb = blockIdx.x; vb < 192; vb += gridDim.x) {
        const int l = vb / 96, n = (vb % 96) * 64 + lane;
        float acc[9];
#pragma unroll
        for (int r = 0; r < 9; ++r) acc[r] = 0.f;
        const float* wp = p.w_mod + (size_t)l * 1024 * 6144 + (size_t)(128 * w) * 6144 + n;
#pragma unroll 8
        for (int k = 0; k < 128; ++k) { const float wv = wp[(size_t)k * 6144];
#pragma unroll
            for (int r = 0; r < 9; ++r) acc[r] += s[r * 1024 + 128 * w + k] * wv; }
#pragma unroll
        for (int r = 0; r < 9; ++r) part[(w * 9 + r) * 64 + lane] = acc[r];
        __syncthreads();
        for (int o = tid_; o < 9 * 64; o += NTHR) { const int r = o >> 6, c = o & 63; float a = p.b_mod[l * 6144 + (vb % 96) * 64 + c];
#pragma unroll
            for (int q = 0; q < 8; ++q) a += part[(q * 9 + r) * 64 + c];
            p.MOD[((size_t)l * 9 + r) * 6144 + (vb % 96) * 64 + c] = a; }
        __syncthreads();
    }
}

DI unsigned pk2(float lo, float hi) { return __builtin_bit_cast(unsigned, __builtin_convertvector((f32x2v_){lo, hi}, bf16x2v_)); }
DI void transpose_item(const float* W, int K, int N, bf16_t* WT, float* scr, int item, int lane, int gu = -1, const float* kscale = nullptr) {
    const int nblk = (N + 31) / 32, kb = item / nblk, nb = item % nblk, k0 = 64 * kb, n0 = 32 * nb;
    const int d0 = gu < 0 ? n0 : 256 * (n0 >> 7) + (n0 & 127) + 128 * gu;
    const bool nok = n0 + (lane & 31) < N;
    float wv_[32];
#pragma unroll
    for (int i = 0; i < 32; ++i) { const int kk = 2 * i + (lane >> 5); wv_[i] = nok ? __builtin_nontemporal_load(W + (size_t)(k0 + kk) * N + n0 + (lane & 31)) : 0.f; }
#pragma unroll
    for (int i = 0; i < 32; ++i) { const int kk = 2 * i + (lane >> 5); scr[kk * 33 + (lane & 31)] = wv_[i] * (kscale ? kscale[k0 + kk] : 1.0f); }
    const int c = lane & 7;
#pragma unroll
    for (int j = 0; j < 4; ++j) { const int n = (lane >> 3) + 8 * j; const float* q = scr + (8 * c) * 33 + n;
        uint4 o; o.x = pk2(q[0 * 33], q[1 * 33]); o.y = pk2(q[2 * 33], q[3 * 33]); o.z = pk2(q[4 * 33], q[5 * 33]); o.w = pk2(q[6 * 33], q[7 * 33]);
        if (n0 + n < N) { typedef unsigned u32x4nt __attribute__((ext_vector_type(4))); __builtin_nontemporal_store((u32x4nt){o.x, o.y, o.z, o.w}, (u32x4nt*)(WT + (size_t)(d0 + n) * K + k0 + 8 * c)); } }
}

DI void ph_convert_experts(const P& p, int l, float* ldsf, int wk0, int nwk, int it0 = 0, int it1 = NE * 768) {
    const int tid_ = ltid(), lane = tid_ & 63, gw = ((int)blockIdx.x - wk0) * NWV + (tid_ >> 6), NW = nwk * NWV;
    float* scr = ldsf + 14 * 1024 + (tid_ >> 6) * (64 * 33 + 16);
    for (int it = it0 + gw; it < it1; it += NW) {
        const int e = it / 768, r = it - e * 768;
        if (r < 512) { const int gu = r >> 8; const float* W = (gu ? p.w_up : p.w_gate) + (size_t)(l * NE + e) * D * 512;
            transpose_item(W, D, 512, p.WguT + (size_t)e * D * D, scr, r & 255, lane, gu); }
        else transpose_item(p.w_down + (size_t)(l * NE + e) * 512 * D, 512, D, p.WdT + (size_t)e * D * 512, scr, r - 512, lane);
    }
}
constexpr int NPAD_IN = 3072;
DI void ph_convert_small(const P& p, float* ldsf, int, int, int) {
    const int tid_ = ltid(), lane = tid_ & 63, gw = blockIdx.x * NWV + (tid_ >> 6), NW = gridDim.x * NWV;
    float* scr = ldsf + 14 * 1024 + (tid_ >> 6) * (64 * 33 + 16);
    constexpr int I_IN = 16 * 89, I_OUT = 16 * 32;
    for (int it = gw; it < 2 * (I_IN + I_OUT); it += NW) {
        const int l = it / (I_IN + I_OUT), r = it % (I_IN + I_OUT);
        if (r < I_IN) transpose_item(p.w_in + (size_t)l * D * INDIM, D, INDIM, p.WinT + (size_t)l * NPAD_IN * D, scr, r, lane);
        else { const int kb = (r - I_IN) / 32;
            transpose_item(p.w_out + (size_t)l * D * D, D, D, p.WoutT + (size_t)l * D * D, scr, r - I_IN, lane, -1, kb < 8 ? p.ssd_norm_g + l * 512 : nullptr); }
    }
    for (int idx = blockIdx.x * NTHR + tid_; idx < 32 * 1024; idx += gridDim.x * NTHR) { const int e = idx >> 10, k = idx & 1023; p.WRT[idx] = f2bf(p.w_router[k * 32 + e]); }
    const size_t nz16 = (size_t)(NPAD_IN - INDIM) * D * 2 / 16;
    for (size_t i = (size_t)blockIdx.x * NTHR + tid_; i < 2 * nz16; i += (size_t)gridDim.x * NTHR) {
        const size_t l = i / nz16, j = i % nz16;
        ((uint4*)(p.WinT + (l * NPAD_IN + INDIM) * D))[j] = make_uint4(0u, 0u, 0u, 0u);
    }
}

DI void row_normmod(float4 (&v)[4], const float* g, const float* mr, int shift_idx, int scale_idx, int lane) {
    float ss = 0.f;
#pragma unroll
    for (int i = 0; i < 4; ++i) ss += v[i].x * v[i].x + v[i].y * v[i].y + v[i].z * v[i].z + v[i].w * v[i].w;
    ss = wave_sum(ss, lane);
    const float rstd = rsqrtf(ss * (1.0f / D) + 1e-6f);
#pragma unroll
    for (int i = 0; i < 4; ++i) {
        const int c = (i * 64 + lane) * 4;
        const float4 gg = *(const float4*)(g + c), sh = *(const float4*)(mr + shift_idx * 1024 + c), sc = *(const float4*)(mr + scale_idx * 1024 + c);
        v[i].x = v[i].x * rstd * gg.x * (1.f + sc.x) + sh.x; v[i].y = v[i].y * rstd * gg.y * (1.f + sc.y) + sh.y;
        v[i].z = v[i].z * rstd * gg.z * (1.f + sc.z) + sh.z; v[i].w = v[i].w * rstd * gg.w * (1.f + sc.w) + sh.w;
    }
}
DI void row_store_bf16(bf16_t* hrow, float4 (&v)[4], int lane) {
#pragma unroll
    for (int i = 0; i < 4; ++i) { ushort4 o; o.x = f2bf(v[i].x); o.y = f2bf(v[i].y); o.z = f2bf(v[i].z); o.w = f2bf(v[i].w);
        *(ushort4*)(hrow + (i * 64 + lane) * 4) = o; v[i] = make_float4(bf2f(o.x), bf2f(o.y), bf2f(o.z), bf2f(o.w)); }
}

DI void ph_normmod1(const P& p, int l, int, int, int) {
    const int tid_ = ltid(), lane = tid_ & 63, gw = blockIdx.x * NWV + (tid_ >> 6), NW = gridDim.x * NWV;
    const float* MODl = p.MOD + (size_t)l * 9 * 6144;
    for (int t = gw; t < T; t += NW) {
        float4 v[4];
#pragma unroll
        for (int i = 0; i < 4; ++i) v[i] = ((const float4*)(t < TC ? p.ctx + (size_t)t * D : p.x + (size_t)(t - TC) * D))[i * 64 + lane];
        row_normmod(v, p.norm1_g + l * D, MODl + (size_t)tok_modrow(t) * 6144, 0, 1, lane);
        row_store_bf16(p.H + (size_t)t * D, v, lane);
    }
}

typedef short s16x4 __attribute__((ext_vector_type(4)));
typedef short bf16x8v __attribute__((ext_vector_type(8)));
typedef float f32x4v __attribute__((ext_vector_type(4)));
typedef unsigned u32x4v __attribute__((ext_vector_type(4)));
typedef unsigned u32x2v __attribute__((ext_vector_type(2)));
DI u32x4v mk4(unsigned a, unsigned b, unsigned c, unsigned d) { return (u32x4v){a, b, c, d}; }
DI u32x2v mk2(unsigned a, unsigned b) { return (u32x2v){a, b}; }
DI f32x4v mkf4(float a, float b, float c, float d) { return (f32x4v){a, b, c, d}; }
#define LDSP __attribute__((address_space(3)))
constexpr int NCH = 34, NTILE = NB * NCH;
constexpr int LD64 = 72, LD128 = 136;
constexpr float LOG2E = 1.4426950408889634f;

DI int tile_tok0(int tl) { const int b = tl / NCH, cs = tl - b * NCH; return cs < 2 ? b * CTXL + cs * 128 : TC + b * SEQ + (cs - 2) * 128; }
DI f32x4v mfma16(bf16x8v a, bf16x8v b, f32x4v c) { return __builtin_amdgcn_mfma_f32_16x16x32_bf16(a, b, c, 0, 0, 0); }
DI bf16x8v frag_row(LDSP const bf16_t* base, int ld, int r0, int k0, int lane) { return *(LDSP const bf16x8v*)(base + (r0 + (lane & 15)) * ld + k0 + 8 * (lane >> 4)); }
DI bf16x8v frag_row_g(const bf16_t* base, int ld, int r0, int k0, int lane) { return *(const bf16x8v*)(base + (size_t)(r0 + (lane & 15)) * ld + k0 + 8 * (lane >> 4)); }
DI bf16x8v frag_col(LDSP const bf16_t* base, int ld, int r0, int k0, int lane) {
    const int G = lane >> 4, i = lane & 15;
    LDSP const bf16_t* a = base + (k0 + 8 * G + (i >> 2)) * ld + r0 + 4 * (i & 3);
    const s16x4 lo = __builtin_bit_cast(s16x4, __builtin_amdgcn_ds_read_tr16_b64_v4i16((LDSP s16x4*)a));
    const s16x4 hi = __builtin_bit_cast(s16x4, __builtin_amdgcn_ds_read_tr16_b64_v4i16((LDSP s16x4*)(a + 4 * ld)));
    return (bf16x8v){lo[0], lo[1], lo[2], lo[3], hi[0], hi[1], hi[2], hi[3]};
}
DI u32x2v pack4(f32x4v v) { return mk2(pk2(v[0], v[1]), pk2(v[2], v[3])); }
DI void unpack8(u32x4v v, float* o) { o[0] = __uint_as_float(v.x << 16); o[1] = __uint_as_float(v.x & 0xffff0000u); o[2] = __uint_as_float(v.y << 16); o[3] = __uint_as_float(v.y & 0xffff0000u);
    o[4] = __uint_as_float(v.z << 16); o[5] = __uint_as_float(v.z & 0xffff0000u); o[6] = __uint_as_float(v.w << 16); o[7] = __uint_as_float(v.w & 0xffff0000u); }
DI u32x4v pack8(const float* o) { return mk4(pk2(o[0], o[1]), pk2(o[2], o[3]), pk2(o[4], o[5]), pk2(o[6], o[7])); }

DI float fast_logsigmoid(float x) { return -(fmaxf(-x, 0.f) + __logf(1.0f + __expf(-fabsf(x)))); }
DI float fast_softplus(float x) { return fmaxf(x, 0.f) + __logf(1.0f + __expf(-fabsf(x))); }
struct XbcSrc { const bf16_t* base; int ld; };
DI XbcSrc xbc_src(const P& p, int tok0) { XbcSrc r; r.base = p.XBCC + (size_t)tok0 * 768; r.ld = 768; return r; }

DI void prep_conv_item(const P& p, int l, int item, int lane) {
    const int piece = item >> 1, part = item & 1, ch = part * 512 + lane * 8;
    if (ch >= 768) return;
    const int t0 = piece * 32; int lo, hi; bf16_t* dst; int dld;
    if (t0 < TC) { lo = t0 & ~(CTXL - 1); hi = lo + CTXL - 1; } else { lo = TC + ((t0 - TC) & ~63); hi = lo + 63; }
    dst = p.XBCC + ch; dld = 768;
    const bf16_t* src = p.PROJ + OFF_XBC + ch;
    float wgt[5][8], bias[8];
#pragma unroll
    for (int k = 0; k < 5; ++k) { const f32x4v a = *(const f32x4v*)(p.conv_w + l * 5 * 768 + k * 768 + ch), c = *(const f32x4v*)(p.conv_w + l * 5 * 768 + k * 768 + ch + 4);
#pragma unroll
        for (int j = 0; j < 4; ++j) { wgt[k][j] = a[j]; wgt[k][4 + j] = c[j]; } }
    { const f32x4v a = *(const f32x4v*)(p.conv_b + l * 768 + ch), c = *(const f32x4v*)(p.conv_b + l * 768 + ch + 4);
#pragma unroll
      for (int j = 0; j < 4; ++j) { bias[j] = a[j]; bias[4 + j] = c[j]; } }
    const u32x4v zero4 = mk4(0u, 0u, 0u, 0u);
    u32x4v rw[13];
#pragma unroll
    for (int i = 0; i < 5; ++i) { const int tt = t0 - 2 + i; rw[i] = (tt >= lo && tt <= hi) ? *(const u32x4v*)(src + (size_t)tt * LDP) : zero4; }
    for (int s0 = 0; s0 < 32; s0 += 8) {
        const int t = t0 + s0;
#pragma unroll
        for (int i = 0; i < 8; ++i) { const int tt = t + 3 + i; rw[5 + i] = (tt <= hi) ? *(const u32x4v*)(src + (size_t)tt * LDP) : zero4; }
#pragma unroll
        for (int i = 0; i < 8; ++i) {
            float o[8];
#pragma unroll
            for (int c = 0; c < 8; ++c) o[c] = bias[c];
#pragma unroll
            for (int k = 0; k < 5; ++k) { float v[8]; unpack8(rw[i + k], v);
#pragma unroll
                for (int c = 0; c < 8; ++c) o[c] += wgt[k][c] * v[c]; }
#pragma unroll
            for (int c = 0; c < 8; ++c) o[c] = siluf(o[c]);
            *(u32x4v*)(dst + (size_t)(t + i) * dld) = pack8(o);
        }
#pragma unroll
        for (int i = 0; i < 5; ++i) rw[i] = rw[i + 8];
    }
}
DI void prep_ssd_item(const P& p, int l, int item, int lane) {
    const int tl = item >> 3, h = item & 7, tok0 = tile_tok0(tl);
    const float bsf = p.dt_bias_f[l * 8 + h], bsb = p.dt_bias_b[l * 8 + h];
    const float r0 = bf2f(p.PROJ[(size_t)(tok0 + 2 * lane) * LDP + OFF_DT + h]), r1 = bf2f(p.PROJ[(size_t)(tok0 + 2 * lane + 1) * LDP + OFF_DT + h]);
    const float f0 = fast_softplus(r0 + bsf), f1 = fast_softplus(r1 + bsf), b0 = fast_softplus(r0 + bsb), b1 = fast_softplus(r1 + bsb);
    float pf = f0 + f1, sb = b0 + b1;
#pragma unroll
    for (int o = 1; o < 64; o <<= 1) { const float t = shl(pf, lane >= o ? lane - o : lane); if (lane >= o) pf += t; }
#pragma unroll
    for (int o = 1; o < 64; o <<= 1) { const float t = shl(sb, lane + o < 64 ? lane + o : lane); if (lane + o < 64) sb += t; }
    const float Af = -__expf(p.a_log_f[l * 8 + h]) * LOG2E, Ab = -__expf(p.a_log_b[l * 8 + h]) * LOG2E;
    const float af0 = Af * (pf - f1), af1 = Af * pf, ab0 = Ab * sb, ab1 = Ab * (sb - b0);
    f32x4v* dst = (f32x4v*)p.SSC + (size_t)(tok0 + 2 * lane) * 8 + h;
    dst[0] = mkf4(af0, af0 - __log2f(f0), ab0, ab0 - __log2f(b0));
    dst[8] = mkf4(af1, af1 - __log2f(f1), ab1, ab1 - __log2f(b1));
    if (lane == 63) { p.STOT[(tl * 8 + h) * 2 + 0] = af1; p.SDEC[(tl * 8 + h) * 2 + 0] = __builtin_amdgcn_exp2f(af1); }
    if (lane == 0) { p.STOT[(tl * 8 + h) * 2 + 1] = ab0; p.SDEC[(tl * 8 + h) * 2 + 1] = __builtin_amdgcn_exp2f(ab0); }
}
DI void prep_gla_block(const P& p, int l, int tl, int h, LDSP unsigned char* lds) {
    const int tid = ltid(), lane = tid & 63, k = tid >> 3, seg = tid & 7, base = lane & ~7, tok0 = tile_tok0(tl);
    LDSP bf16_t* QT = (LDSP bf16_t*)lds; LDSP bf16_t* KT = QT + 128 * LD64; LDSP bf16_t* O4 = KT + 128 * LD64; LDSP float* GKL = (LDSP float*)(O4 + 4 * 128 * LD64);
    u32x4v qv_[2], kv_[2], vv_[4]; u32x4v gk = mk4(0u, 0u, 0u, 0u);
#pragma unroll
    for (int q = 0; q < 4; ++q) { const int c = tid + q * NTHR, r = c >> 4, cc = c & 15; vv_[q] = *(const u32x4v*)(p.PROJ + (size_t)(tok0 + r) * LDP + OFF_V + h * 128 + cc * 8); }
#pragma unroll
    for (int q = 0; q < 2; ++q) { const int c = tid + q * NTHR, r = c >> 3, cc = c & 7; const bf16_t* pr = p.PROJ + (size_t)(tok0 + r) * LDP;
        qv_[q] = *(const u32x4v*)(pr + OFF_Q + h * 64 + cc * 8); kv_[q] = *(const u32x4v*)(pr + OFF_K + h * 64 + cc * 8); }
    if (tid < 256) gk = *(const u32x4v*)(p.PROJ + (size_t)(tok0 + (tid >> 1)) * LDP + OFF_GK + (tid & 1) * 8);
    float upf[16], upb[16];
#pragma unroll
    for (int r = 0; r < 16; ++r) { upf[r] = p.gk_up_f[l * 16 * 256 + r * 256 + h * 64 + k]; upb[r] = p.gk_up_b[l * 16 * 256 + r * 256 + h * 64 + k]; }
    const float biasf = p.gk_bias_f[l * 256 + h * 64 + k], biasb = p.gk_bias_b[l * 256 + h * 64 + k];
    __syncthreads();
#pragma unroll
    for (int q = 0; q < 2; ++q) { const int c = tid + q * NTHR, r = c >> 3, cc = c & 7; *(LDSP u32x4v*)(QT + r * LD64 + cc * 8) = qv_[q]; *(LDSP u32x4v*)(KT + r * LD64 + cc * 8) = kv_[q]; }
    if (tid < 256) { float v[8]; unpack8(gk, v); LDSP f32x4v* d = (LDSP f32x4v*)(GKL + (tid >> 1) * 16 + (tid & 1) * 8); d[0] = mkf4(v[0], v[1], v[2], v[3]); d[1] = mkf4(v[4], v[5], v[6], v[7]); }
    __syncthreads();
    float gf[16], gb[16];
#pragma unroll
    for (int s = 0; s < 16; ++s) { LDSP const f32x4v* gl = (LDSP const f32x4v*)(GKL + (8 * s + seg) * 16); float af = biasf, ab = biasb;
#pragma unroll
        for (int q = 0; q < 4; ++q) { const f32x4v v = gl[q];
#pragma unroll
            for (int j = 0; j < 4; ++j) { af += v[j] * upf[4 * q + j]; ab += v[j] * upb[4 * q + j]; } }
        gf[s] = fast_logsigmoid(af) * (1.0f / 16.0f); gb[s] = fast_logsigmoid(ab) * (1.0f / 16.0f); }
    float totf = 0.f, totb = 0.f;
#pragma unroll
    for (int s = 0; s < 16; ++s) { float x = gf[s];
        float t = shl(x, lane - 1); if (seg >= 1) x += t; t = shl(x, lane - 2); if (seg >= 2) x += t; t = shl(x, lane - 4); if (seg >= 4) x += t;
        gf[s] = totf + x; totf += shl(x, base + 7); }
#pragma unroll
    for (int s = 15; s >= 0; --s) { float x = gb[s];
        float t = shl(x, lane + 1); if (seg <= 6) x += t; t = shl(x, lane + 2); if (seg <= 5) x += t; t = shl(x, lane + 4); if (seg <= 3) x += t;
        gb[s] = totb + x; totb += shl(x, base); }
#pragma unroll
    for (int s = 0; s < 16; ++s) { const int j = 8 * s + seg; const float qv = bf2f(QT[j * LD64 + k]) * 0.125f, kv = bf2f(KT[j * LD64 + k]);
        const float bf = gf[s], bb = gb[s]; LDSP bf16_t* o = O4 + j * LD64 + k;
        o[0] = f2bf(qv * __expf(bf)); o[128 * LD64] = f2bf(kv * __expf(-bf)); o[2 * 128 * LD64] = f2bf(qv * __expf(bb)); o[3 * 128 * LD64] = f2bf(kv * __expf(-bb)); }
    LDSP float* DEC = GKL;
    __syncthreads();
    if (seg == 0) { const float df = __expf(totf), db = __expf(totb); p.GDEC[(size_t)((tl * 4 + h) * 2 + 0) * 64 + k] = df; p.GDEC[(size_t)((tl * 4 + h) * 2 + 1) * 64 + k] = db; DEC[k] = df; DEC[64 + k] = db; }
    LDSP bf16_t* VT = QT;
#pragma unroll
    for (int q = 0; q < 4; ++q) { const int c = tid + q * NTHR, r = c >> 4, cc = c & 15; *(LDSP u32x4v*)(VT + r * LD128 + cc * 8) = vv_[q]; }
#pragma unroll
    for (int q = 0; q < 8; ++q) { const int c = tid + q * NTHR, a4 = c >> 10, r = (c >> 3) & 127, cc = c & 7;
        *(u32x4v*)(p.QKB + (size_t)(tok0 + r) * 1024 + a4 * 256 + h * 64 + cc * 8) = *(LDSP const u32x4v*)(O4 + (a4 * 128 + r) * LD64 + cc * 8); }
    __syncthreads();
    { const int w = __builtin_amdgcn_readfirstlane(tid >> 6), dir = w >> 2, ut = w & 3; LDSP const bf16_t* KE = O4 + (dir ? 3 : 1) * 128 * LD64;
      f32x4v acc[8];
#pragma unroll
      for (int q = 0; q < 8; ++q) acc[q] = (f32x4v){0.f, 0.f, 0.f, 0.f};
#pragma unroll
      for (int ks = 0; ks < 4; ++ks) { const bf16x8v u = frag_col(KE, LD64, 16 * ut, 32 * ks, lane);
#pragma unroll
          for (int q = 0; q < 8; ++q) acc[q] = mfma16(u, frag_col(VT, LD128, 16 * q, 32 * ks, lane), acc[q]); }
      const f32x4v dec = *(LDSP const f32x4v*)(DEC + dir * 64 + 16 * ut + 4 * (lane >> 4));
      bf16_t* dst = p.GS + ((size_t)((tl * 4 + h) * 2 + dir) * 128) * 64;
#pragma unroll
      for (int q = 0; q < 8; ++q) *(u32x2v*)(dst + (size_t)(16 * q + (lane & 15)) * 64 + 16 * ut + 4 * (lane >> 4)) = pack4(acc[q] * dec); }
}
constexpr int NPREP_A = (T / 32) * 2, NPREP_B = NTILE * 8;
DI void ph_prep(const P& p, int l, LDSP unsigned char* lds) {
    const int tid_ = ltid(), lane = tid_ & 63, gw = blockIdx.x * NWV + (tid_ >> 6), NW = gridDim.x * NWV;
    for (int it = gw; it < NPREP_A + NPREP_B; it += NW) {
        if (it < NPREP_A) prep_conv_item(p, l, it, lane); else prep_ssd_item(p, l, it - NPREP_A, lane);
    }
    for (int it = blockIdx.x; it < NTILE * 4; it += gridDim.x) prep_gla_block(p, l, it >> 2, it & 3, lds);
}

DI void s1_ssd(const P& p, int tl, int h, LDSP unsigned char* lds) {
    const int tid = ltid(), lane = tid & 63, w = __builtin_amdgcn_readfirstlane(tid >> 6);
    const int tok0 = tile_tok0(tl), g = h >> 2; const XbcSrc xs = xbc_src(p, tok0);
    LDSP bf16_t* XWF = (LDSP bf16_t*)lds; LDSP bf16_t* XWB = XWF + 128 * LD64; LDSP bf16_t* BG = XWB + 128 * LD64;
    const int j = tid >> 2, cq = tid & 3;
    const bf16_t* row = xs.base + (size_t)j * xs.ld;
    const u32x4v x0 = *(const u32x4v*)(row + h * 64 + cq * 16), x1 = *(const u32x4v*)(row + h * 64 + cq * 16 + 8);
    const u32x4v b0 = *(const u32x4v*)(row + 512 + g * 64 + cq * 16), b1 = *(const u32x4v*)(row + 512 + g * 64 + cq * 16 + 8);
    const f32x4v sc = *((const f32x4v*)p.SSC + (size_t)(tok0 + j) * 8 + h);
    const float wf = __builtin_amdgcn_exp2f(p.STOT[(tl * 8 + h) * 2 + 0] - sc.y), wb = __builtin_amdgcn_exp2f(p.STOT[(tl * 8 + h) * 2 + 1] - sc.w);
    float xv[16], of[16], ob[16]; unpack8(x0, xv); unpack8(x1, xv + 8);
#pragma unroll
    for (int c = 0; c < 16; ++c) { of[c] = xv[c] * wf; ob[c] = xv[c] * wb; }
    __syncthreads();
    *(LDSP u32x4v*)(XWF + j * LD64 + cq * 16) = pack8(of); *(LDSP u32x4v*)(XWF + j * LD64 + cq * 16 + 8) = pack8(of + 8);
    *(LDSP u32x4v*)(XWB + j * LD64 + cq * 16) = pack8(ob); *(LDSP u32x4v*)(XWB + j * LD64 + cq * 16 + 8) = pack8(ob + 8);
    *(LDSP u32x4v*)(BG + j * LD64 + cq * 16) = b0; *(LDSP u32x4v*)(BG + j * LD64 + cq * 16 + 8) = b1;
    __syncthreads();
    const int dir = w >> 2, ut = w & 3; LDSP const bf16_t* XW = dir ? XWB : XWF;
    f32x4v acc[4];
#pragma unroll
    for (int q = 0; q < 4; ++q) acc[q] = (f32x4v){0.f, 0.f, 0.f, 0.f};
#pragma unroll
    for (int ks = 0; ks < 4; ++ks) { const bf16x8v u = frag_col(BG, LD64, 16 * ut, 32 * ks, lane);
#pragma unroll
        for (int q = 0; q < 4; ++q) acc[q] = mfma16(u, frag_col(XW, LD64, 16 * q, 32 * ks, lane), acc[q]); }
    bf16_t* dst = p.SS + ((size_t)((tl * 8 + h) * 2 + dir) * 64) * 64;
#pragma unroll
    for (int q = 0; q < 4; ++q) *(u32x2v*)(dst + (size_t)(16 * q + (lane & 15)) * 64 + 16 * ut + 4 * (lane >> 4)) = pack4(acc[q]);
}
DI void ph_s1(const P& p, int l, LDSP unsigned char* lds) {
    for (int it = blockIdx.x; it < NTILE * 8; it += gridDim.x) s1_ssd(p, it >> 3, it & 7, lds);
}

DI int s2_chunk(int dir, int s) { return dir == 0 ? s : (s < 2 ? 1 - s : 35 - s); }
DI void ph_s2(const P& p) {
    const int g = blockIdx.x * NTHR + ltid();
    for (int v = g; v < 131072; v += gridDim.x * NTHR) {
        const bool gla = v >= 65536; const int r = v & 65535;
        int b, h, dir, vi;
        if (!gla) { vi = r & 511; dir = (r >> 9) & 1; h = (r >> 10) & 7; b = r >> 13; } else { vi = r & 1023; dir = (r >> 10) & 1; h = (r >> 11) & 3; b = r >> 13; }
        float st[8];
#pragma unroll
        for (int e = 0; e < 8; ++e) st[e] = 0.f;
        for (int s0 = 0; s0 < NCH; s0 += 6) {
            u32x4v sv[6]; float dsc[6]; f32x4v dv0[6], dv1[6];
#pragma unroll
            for (int u = 0; u < 6; ++u) { if (s0 + u >= NCH) continue; const int tl = b * NCH + s2_chunk(dir, s0 + u);
                if (!gla) { sv[u] = *(const u32x4v*)(p.SS + ((size_t)((tl * 8 + h) * 2 + dir) * 512 + vi) * 8); dsc[u] = p.SDEC[(tl * 8 + h) * 2 + dir]; }
                else { sv[u] = *(const u32x4v*)(p.GS + ((size_t)((tl * 4 + h) * 2 + dir) * 1024 + vi) * 8); const f32x4v* d = (const f32x4v*)(p.GDEC + (size_t)((tl * 4 + h) * 2 + dir) * 64 + (vi & 7) * 8); dv0[u] = d[0]; dv1[u] = d[1]; } }
#pragma unroll
            for (int u = 0; u < 6; ++u) { if (s0 + u >= NCH) continue; const int tl = b * NCH + s2_chunk(dir, s0 + u);
                float loc[8]; unpack8(sv[u], loc);
                const u32x4v hin = pack8(st);
                if (!gla) { *(u32x4v*)(p.SS + ((size_t)((tl * 8 + h) * 2 + dir) * 512 + vi) * 8) = hin;
#pragma unroll
                    for (int e = 0; e < 8; ++e) st[e] = dsc[u] * st[e] + loc[e]; }
                else { *(u32x4v*)(p.GS + ((size_t)((tl * 4 + h) * 2 + dir) * 1024 + vi) * 8) = hin;
                    const float dd[8] = {dv0[u].x, dv0[u].y, dv0[u].z, dv0[u].w, dv1[u].x, dv1[u].y, dv1[u].z, dv1[u].w};
#pragma unroll
                    for (int e = 0; e < 8; ++e) st[e] = dd[e] * st[e] + loc[e]; } }
        }
    }
}

DI int s3_tile(int l, int q) { return l == 0 ? q : (q >> 5) * NCH + 2 + (q & 31); }
struct SsdPre { u32x4v x0, x1, b0, b1, c0, c1, hf, hb; f32x4v sc; };
DI void s3_ssd_load(const P& p, int tl, int h, int tid, int i, int G, SsdPre& r) {
    const int tok0 = tile_tok0(tl), g = h >> 2; const XbcSrc xs = xbc_src(p, tok0);
    const int j = tid >> 2, cq = tid & 3; const bf16_t* row = xs.base + (size_t)j * xs.ld;
    r.x0 = *(const u32x4v*)(row + h * 64 + cq * 16); r.x1 = *(const u32x4v*)(row + h * 64 + cq * 16 + 8);
    r.b0 = *(const u32x4v*)(row + 512 + g * 64 + cq * 16); r.b1 = *(const u32x4v*)(row + 512 + g * 64 + cq * 16 + 8);
    r.c0 = *(const u32x4v*)(row + 640 + g * 64 + cq * 16); r.c1 = *(const u32x4v*)(row + 640 + g * 64 + cq * 16 + 8);
    const bf16_t* Hf = p.SS + (size_t)((tl * 8 + h) * 2 + 0) * 4096 + (tid >> 3) * 64 + (tid & 7) * 8;
    r.hf = *(const u32x4v*)Hf; r.hb = *(const u32x4v*)(Hf + 4096);
    r.sc = *((const f32x4v*)p.SSC + (size_t)(tok0 + (tid & 127)) * 8 + h);
}
DI void ph_s3_ssd(const P& p, int l, LDSP unsigned char* lds) {
    const int tid = ltid(), lane = tid & 63, w = __builtin_amdgcn_readfirstlane(tid >> 6), G = lane >> 4, li = lane & 15, i = 16 * w + li;
    LDSP bf16_t* XH = (LDSP bf16_t*)lds; LDSP bf16_t* BG = XH + 128 * LD64; LDSP bf16_t* CG = BG + 128 * LD64; LDSP bf16_t* MM = CG + 128 * LD64; LDSP f32x4v* SC = (LDSP f32x4v*)(MM + 128 * LD128);
    LDSP bf16_t* HF = (LDSP bf16_t*)(SC + 128); LDSP bf16_t* HB = HF + 64 * LD64;
    const int nit = (l == 0 ? NTILE : NB * 32) * 8, GS_ = gridDim.x;
    int it = ((int)blockIdx.x + (GS_ >> 1)) % GS_; SsdPre pre;
    if (it < nit) s3_ssd_load(p, s3_tile(l, it >> 3), it & 7, tid, i, G, pre);
    for (; it < nit; it += GS_) {
        const int tl = s3_tile(l, it >> 3), h = it & 7, tok0 = tile_tok0(tl);
        __syncthreads();
        { const int j = tid >> 2, cq = tid & 3;
          *(LDSP u32x4v*)(XH + j * LD64 + cq * 16) = pre.x0; *(LDSP u32x4v*)(XH + j * LD64 + cq * 16 + 8) = pre.x1;
          *(LDSP u32x4v*)(BG + j * LD64 + cq * 16) = pre.b0; *(LDSP u32x4v*)(BG + j * LD64 + cq * 16 + 8) = pre.b1;
          *(LDSP u32x4v*)(CG + j * LD64 + cq * 16) = pre.c0; *(LDSP u32x4v*)(CG + j * LD64 + cq * 16 + 8) = pre.c1;
          *(LDSP u32x4v*)(HF + (tid >> 3) * LD64 + (tid & 7) * 8) = pre.hf; *(LDSP u32x4v*)(HB + (tid >> 3) * LD64 + (tid & 7) * 8) = pre.hb;
          if (tid < 128) SC[tid] = pre.sc; }
        if (it + GS_ < nit) s3_ssd_load(p, s3_tile(l, (it + GS_) >> 3), (it + GS_) & 7, tid, i, G, pre);
        __syncthreads();
        u32x2v zr[4];
#pragma unroll
        for (int pt = 0; pt < 4; ++pt) zr[pt] = *(const u32x2v*)(p.PROJ + (size_t)(tok0 + i) * LDP + OFF_Z + h * 64 + 16 * pt + 4 * G);
        const f32x4v sci = SC[i];
        {
            f32x4v am[8];
#pragma unroll
            for (int ut = 0; ut < 8; ++ut) am[ut] = (f32x4v){0.f, 0.f, 0.f, 0.f};
#pragma unroll
            for (int ks = 0; ks < 2; ++ks) { const bf16x8v vfr = frag_row(CG, LD64, 16 * w, 32 * ks, lane);
#pragma unroll
                for (int ut = 0; ut < 8; ++ut) am[ut] = mfma16(frag_row(BG, LD64, 16 * ut, 32 * ks, lane), vfr, am[ut]); }
#pragma unroll
            for (int ut = 0; ut < 8; ++ut) { f32x4v m;
#pragma unroll
                for (int r = 0; r < 4; ++r) { const int jj = 16 * ut + 4 * G + r; const f32x4v scj = SC[jj];
                    const float Lf = jj <= i ? __builtin_amdgcn_exp2f(fminf(sci.x - scj.y, 30.f)) : 0.f, Lb = jj >= i ? __builtin_amdgcn_exp2f(fminf(sci.z - scj.w, 30.f)) : 0.f;
                    m[r] = am[ut][r] * (Lf + Lb); }
                *(LDSP u32x2v*)(MM + i * LD128 + 16 * ut + 4 * G) = pack4(m); }
        }
        asm volatile("s_waitcnt lgkmcnt(0)" ::: "memory");
        f32x4v ay[4], af_[4], ab_[4];
#pragma unroll
        for (int pt = 0; pt < 4; ++pt) { ay[pt] = (f32x4v){0.f, 0.f, 0.f, 0.f}; af_[pt] = ay[pt]; ab_[pt] = ay[pt]; }
#pragma unroll
        for (int ks = 0; ks < 2; ++ks) { const bf16x8v vfr = frag_row(CG, LD64, 16 * w, 32 * ks, lane);
#pragma unroll
            for (int pt = 0; pt < 4; ++pt) { af_[pt] = mfma16(frag_row(HF, LD64, 16 * pt, 32 * ks, lane), vfr, af_[pt]); ab_[pt] = mfma16(frag_row(HB, LD64, 16 * pt, 32 * ks, lane), vfr, ab_[pt]); } }
#pragma unroll
        for (int ks = 0; ks < 4; ++ks) { const bf16x8v vfr = frag_row(MM, LD128, 16 * w, 32 * ks, lane);
#pragma unroll
            for (int pt = 0; pt < 4; ++pt) ay[pt] = mfma16(frag_col(XH, LD64, 16 * pt, 32 * ks, lane), vfr, ay[pt]); }
        const float sf = __builtin_amdgcn_exp2f(sci.x), sb = __builtin_amdgcn_exp2f(sci.z), dsk = p.d_skip[l * 8 + h];
        float ssq = 0.f;
#pragma unroll
        for (int pt = 0; pt < 4; ++pt) { const int pc = 16 * pt + 4 * G;
            const u32x2v xr = *(LDSP const u32x2v*)(XH + i * LD64 + pc);
            const float xv[4] = {__uint_as_float(xr.x << 16), __uint_as_float(xr.x & 0xffff0000u), __uint_as_float(xr.y << 16), __uint_as_float(xr.y & 0xffff0000u)};
            const float zv[4] = {__uint_as_float(zr[pt].x << 16), __uint_as_float(zr[pt].x & 0xffff0000u), __uint_as_float(zr[pt].y << 16), __uint_as_float(zr[pt].y & 0xffff0000u)};
            float yv[4];
#pragma unroll
            for (int r = 0; r < 4; ++r) { yv[r] = (ay[pt][r] + sf * af_[pt][r] + sb * ab_[pt][r] + dsk * xv[r]) * siluf(zv[r]); yv[r] = bf2f(f2bf(yv[r])); ssq += yv[r] * yv[r]; }
            *(u32x2v*)(p.H + (size_t)(tok0 + i) * D + h * 64 + pc) = mk2(pk2(yv[0], yv[1]), pk2(yv[2], yv[3])); }
        ssq += shx(ssq, 16, lane); ssq += shx(ssq, 32, lane);
        if (G == 0) p.SSQ[(size_t)(tok0 + i) * 8 + h] = ssq;
    }
}
struct GlaPre { u32x4v qk[2][4], vv[4], sf[2], sb[2]; };
DI void s3_gla_load(const P& p, int tl, int h, int tid, int i, int G, GlaPre& r) {
    const int tok0 = tile_tok0(tl);
#pragma unroll
    for (int q = 0; q < 2; ++q) { const int c = tid + q * NTHR, rr = c >> 3, cc = c & 7; const bf16_t* qb = p.QKB + (size_t)(tok0 + rr) * 1024 + h * 64 + cc * 8;
        r.qk[q][0] = *(const u32x4v*)qb; r.qk[q][1] = *(const u32x4v*)(qb + 256);
        r.qk[q][2] = *(const u32x4v*)(qb + 512); r.qk[q][3] = *(const u32x4v*)(qb + 768);
        const bf16_t* Sg = p.GS + (size_t)((tl * 4 + h) * 2 + 0) * 8192 + (size_t)rr * 64 + cc * 8; r.sf[q] = *(const u32x4v*)Sg; r.sb[q] = *(const u32x4v*)(Sg + 8192); }
#pragma unroll
    for (int q = 0; q < 4; ++q) { const int c = tid + q * NTHR, rr = c >> 4, cc = c & 15; r.vv[q] = *(const u32x4v*)(p.PROJ + (size_t)(tok0 + rr) * LDP + OFF_V + h * 128 + cc * 8); }
}
DI void ph_s3_gla(const P& p, int l, LDSP unsigned char* lds) {
    const int tid = ltid(), lane = tid & 63, w = __builtin_amdgcn_readfirstlane(tid >> 6), G = lane >> 4, li = lane & 15, i = 16 * w + li;
    LDSP bf16_t* Q2 = (LDSP bf16_t*)lds;
    LDSP bf16_t* KF = Q2 + 8 * 2 * 16 * LD64; LDSP bf16_t* KB = KF + 128 * LD64; LDSP bf16_t* VT = KB + 128 * LD64; LDSP bf16_t* SF = VT + 128 * LD128; LDSP bf16_t* SB = SF + 128 * LD64;
    LDSP bf16_t* AMw = SF + w * 16 * LD128;
    const int nit = (l == 0 ? NTILE : NB * 32) * 4, GS_ = gridDim.x;
    int it = blockIdx.x; GlaPre pre;
    if (it < nit) s3_gla_load(p, s3_tile(l, it >> 2), it & 3, tid, i, G, pre);
    for (; it < nit; it += GS_) {
        const int tl = s3_tile(l, it >> 2), h = it & 3, tok0 = tile_tok0(tl);
        __syncthreads();
#pragma unroll
        for (int q = 0; q < 2; ++q) { const int c = tid + q * NTHR, rr = c >> 3, cc = c & 7; LDSP bf16_t* qrow = Q2 + (rr >> 4) * (2 * 16 * LD64) + (rr & 15) * LD64 + cc * 8;
            *(LDSP u32x4v*)qrow = pre.qk[q][0]; *(LDSP u32x4v*)(qrow + 16 * LD64) = pre.qk[q][2];
            *(LDSP u32x4v*)(KF + rr * LD64 + cc * 8) = pre.qk[q][1]; *(LDSP u32x4v*)(KB + rr * LD64 + cc * 8) = pre.qk[q][3];
            *(LDSP u32x4v*)(SF + rr * LD64 + cc * 8) = pre.sf[q]; *(LDSP u32x4v*)(SB + rr * LD64 + cc * 8) = pre.sb[q]; }
#pragma unroll
        for (int q = 0; q < 4; ++q) { const int c = tid + q * NTHR, rr = c >> 4, cc = c & 15; *(LDSP u32x4v*)(VT + rr * LD128 + cc * 8) = pre.vv[q]; }
        if (it + GS_ < nit) s3_gla_load(p, s3_tile(l, (it + GS_) >> 2), (it + GS_) & 3, tid, i, G, pre);
        __syncthreads();
        f32x4v ao[8];
#pragma unroll
        for (int q = 0; q < 8; ++q) ao[q] = (f32x4v){0.f, 0.f, 0.f, 0.f};
#pragma unroll
        for (int dir = 0; dir < 2; ++dir) {
            LDSP const bf16_t* QSw = Q2 + w * (2 * 16 * LD64) + dir * 16 * LD64; LDSP const bf16_t* SS_ = dir ? SB : SF;
#pragma unroll
            for (int ks = 0; ks < 2; ++ks) { const bf16x8v vfr = frag_row(QSw, LD64, 0, 32 * ks, lane);
#pragma unroll
                for (int vt = 0; vt < 8; ++vt) ao[vt] = mfma16(frag_row(SS_, LD64, 16 * vt, 32 * ks, lane), vfr, ao[vt]); }
        }
        __syncthreads();
#pragma unroll
        for (int uh = 0; uh < 4; ++uh) {
            f32x4v a2[2]; a2[0] = (f32x4v){0.f, 0.f, 0.f, 0.f}; a2[1] = a2[0];
#pragma unroll
            for (int dir = 0; dir < 2; ++dir) {
                LDSP const bf16_t* QSw = Q2 + w * (2 * 16 * LD64) + dir * 16 * LD64; LDSP const bf16_t* KS = dir ? KB : KF;
                f32x4v as[2]; as[0] = (f32x4v){0.f, 0.f, 0.f, 0.f}; as[1] = as[0];
#pragma unroll
                for (int ks = 0; ks < 2; ++ks) { const bf16x8v vfr = frag_row(QSw, LD64, 0, 32 * ks, lane);
#pragma unroll
                    for (int q = 0; q < 2; ++q) as[q] = mfma16(frag_row(KS, LD64, 16 * (2 * uh + q), 32 * ks, lane), vfr, as[q]); }
#pragma unroll
                for (int q = 0; q < 2; ++q)
#pragma unroll
                    for (int r = 0; r < 4; ++r) { const int jj = 16 * (2 * uh + q) + 4 * G + r; const bool keep = dir == 0 ? (jj <= i) : (jj >= i); a2[q][r] += keep ? as[q][r] : 0.f; }
            }
#pragma unroll
            for (int q = 0; q < 2; ++q) *(LDSP u32x2v*)(AMw + li * LD128 + 16 * (2 * uh + q) + 4 * G) = pack4(a2[q]);
        }
        u32x2v gr[8];
#pragma unroll
        for (int vt = 0; vt < 8; ++vt) gr[vt] = *(const u32x2v*)(p.PROJ + (size_t)(tok0 + i) * LDP + OFF_GO + h * 128 + 16 * vt + 4 * G);
        asm volatile("s_waitcnt lgkmcnt(0)" ::: "memory");
#pragma unroll
        for (int ks = 0; ks < 4; ++ks) { const bf16x8v vfr = frag_row(AMw, LD128, 0, 32 * ks, lane);
#pragma unroll
            for (int vt = 0; vt < 8; ++vt) ao[vt] = mfma16(frag_col(VT, LD128, 16 * vt, 32 * ks, lane), vfr, ao[vt]); }
        float so = 0.f;
#pragma unroll
        for (int vt = 0; vt < 8; ++vt)
#pragma unroll
            for (int r = 0; r < 4; ++r) so += ao[vt][r] * ao[vt][r];
        so += shx(so, 16, lane); so += shx(so, 32, lane);
        const float ro = rsqrtf(so * (1.0f / 128.0f) + 1e-6f);
#pragma unroll
        for (int vt = 0; vt < 8; ++vt) { const int vc = 16 * vt + 4 * G; const f32x4v gg = *(const f32x4v*)(p.gla_norm_g + l * 128 + vc);
            const float g0 = __uint_as_float(gr[vt].x << 16), g1 = __uint_as_float(gr[vt].x & 0xffff0000u), g2 = __uint_as_float(gr[vt].y << 16), g3 = __uint_as_float(gr[vt].y & 0xffff0000u);
            *(u32x2v*)(p.H + (size_t)(tok0 + i) * D + 512 + h * 128 + vc) = mk2(pk2(ao[vt][0] * ro * gg.x * siluf(g0), ao[vt][1] * ro * gg.y * siluf(g1)), pk2(ao[vt][2] * ro * gg.z * siluf(g2), ao[vt][3] * ro * gg.w * siluf(g3))); }
    }
}
DI void ph_s3(const P& p, int l, LDSP unsigned char* lds) { ph_s3_gla(p, l, lds); ph_s3_ssd(p, l, lds); }
DI void ph_normroute(const P& p, int l, int t0, LDSP unsigned char* lds) {
    const int tid_ = ltid(), lane = tid_ & 63, wv = tid_ >> 6, gw = blockIdx.x * NWV + wv, NW = gridDim.x * NWV, G = lane >> 4, li = lane & 15;
    const float* MODl = p.MOD + (size_t)l * 9 * 6144; int* counts = p.counts + l * 32 * 32;
    constexpr int LDW = 1032, LDT = 264;
    LDSP bf16_t* WR = (LDSP bf16_t*)lds;
    LDSP bf16_t* HT = WR + 32 * LDW + wv * 16 * LDT;
    { u32x4v wv_[8];
#pragma unroll
      for (int q = 0; q < 8; ++q) wv_[q] = *(const u32x4v*)(p.WRT + (size_t)(tid_ + q * NTHR) * 8);
#pragma unroll
      for (int q = 0; q < 8; ++q) { const int c = tid_ + q * NTHR; *(LDSP u32x4v*)(WR + (c >> 7) * LDW + (c & 127) * 8) = wv_[q]; } }
    __syncthreads();
    const int ntile = (T - t0) >> 4;
    const float* g2 = p.norm2_g + l * D;
    for (int tile = gw; tile < ntile; tile += NW) {
        const int tb = t0 + tile * 16;
        const float* mr = MODl + (size_t)tok_modrow(tb) * 6144;
        float rs[16];
        { const f32x4v* q = (const f32x4v*)(p.XSS + (size_t)(tb + li) * 16); const f32x4v a = q[0], b = q[1], c = q[2], d = q[3];
          const float ss = (((a.x + a.y) + (a.z + a.w)) + ((b.x + b.y) + (b.z + b.w))) + (((c.x + c.y) + (c.z + c.w)) + ((d.x + d.y) + (d.z + d.w)));
          const float r = rsqrtf(ss * (1.0f / D) + 1e-6f);
#pragma unroll
          for (int i = 0; i < 16; ++i) rs[i] = shl(r, i); }
        f32x4v acc[2]; acc[0] = (f32x4v){0.f, 0.f, 0.f, 0.f}; acc[1] = acc[0];
        u32x2v xq[16];
#pragma unroll
        for (int i = 0; i < 16; ++i) xq[i] = *(const u32x2v*)(xrow(p, tb + i) + lane * 4);
#pragma unroll
        for (int kc = 0; kc < 4; ++kc) {
            const int kk = kc * 256 + lane * 4;
            const f32x4v gg = *(const f32x4v*)(g2 + kk), sh = *(const f32x4v*)(mr + 3 * 1024 + kk), sc = *(const f32x4v*)(mr + 4 * 1024 + kk);
            f32x4v gs;
#pragma unroll
            for (int j = 0; j < 4; ++j) gs[j] = gg[j] * (1.f + sc[j]);
#pragma unroll
            for (int i = 0; i < 16; ++i) { const u32x2v r = xq[i];
                const f32x4v xv = mkf4(__uint_as_float(r.x << 16), __uint_as_float(r.x & 0xffff0000u), __uint_as_float(r.y << 16), __uint_as_float(r.y & 0xffff0000u));
                const f32x4v h = xv * rs[i] * gs + sh; const u32x2v hb = pack4(h);
                *(u32x2v*)(p.H + (size_t)(tb + i) * D + kk) = hb; *(LDSP u32x2v*)(HT + i * LDT + lane * 4) = hb; }
            if (kc < 3) {
#pragma unroll
                for (int i = 0; i < 16; ++i) xq[i] = *(const u32x2v*)(xrow(p, tb + i) + kk + 256); }
            asm volatile("s_waitcnt lgkmcnt(0)" ::: "memory");
#pragma unroll
            for (int ks = 0; ks < 8; ++ks) { const bf16x8v vfr = frag_row(HT, LDT, 0, 32 * ks, lane);
                acc[0] = mfma16(frag_row(WR, LDW, 0, kc * 256 + 32 * ks, lane), vfr, acc[0]);
                acc[1] = mfma16(frag_row(WR, LDW, 16, kc * 256 + 32 * ks, lane), vfr, acc[1]); }
            asm volatile("s_waitcnt lgkmcnt(0)" ::: "memory");
        }
        float bgs = -1e30f; int bgi = 0, e1 = 0, e2 = 0; float w1 = 0.f, w2 = 0.f;
#pragma unroll
        for (int ut = 0; ut < 2; ++ut) { const int gi = ut * 4 + G; float m1 = -1e30f, m2 = -1e30f, s1 = 0.f, s2 = 0.f; int i1 = 0, i2 = 0;
#pragma unroll
            for (int r = 0; r < 4; ++r) { const float sv = 1.0f / (1.0f + __expf(-acc[ut][r])), vv = sv + p.router_bias[gi * 4 + r];
                if (vv > m1) { m2 = m1; i2 = i1; s2 = s1; m1 = vv; i1 = gi * 4 + r; s1 = sv; } else if (vv > m2) { m2 = vv; i2 = gi * 4 + r; s2 = sv; } }
            if (m1 + m2 > bgs) { bgs = m1 + m2; bgi = gi; e1 = i1; e2 = i2; w1 = s1; w2 = s2; } }
#pragma unroll
        for (int o = 16; o <= 32; o <<= 1) {
            const float ogs = shx(bgs, o, lane), ow1 = shx(w1, o, lane), ow2 = shx(w2, o, lane); const int ogi = shxi(bgi, o, lane), oe1 = shxi(e1, o, lane), oe2 = shxi(e2, o, lane);
            if (ogs > bgs || (ogs == bgs && ogi < bgi)) { bgs = ogs; bgi = ogi; e1 = oe1; e2 = oe2; w1 = ow1; w2 = ow2; } }
        if (G == 0) {
            const int t = tb + li; const float inv = 1.0f / (w1 + w2);
            const int r1 = atomicAdd(&counts[e1 * 32], 1), r2 = atomicAdd(&counts[e2 * 32], 1);
            p.MAP[(size_t)e1 * T + r1] = t; p.MAP[(size_t)e2 * T + r2] = t;
            p.TOKSLOT[t * 4 + 0] = e1; p.TOKSLOT[t * 4 + 1] = r1; p.TOKSLOT[t * 4 + 2] = e2; p.TOKSLOT[t * 4 + 3] = r2;
            p.EW[t * 2 + 0] = w1 * inv; p.EW[t * 2 + 1] = w2 * inv;
        }
    }
}

DI void ph_combine(const P& p, int l, int t0, const unsigned char* Y  , LDSP int* ps  ) {
    const int tid_ = ltid(), lane = tid_ & 63, gw = blockIdx.x * NWV + (tid_ >> 6), NW = gridDim.x * NWV;
    const float* MODl = p.MOD + (size_t)l * 9 * 6144; const int* counts = p.counts + l * 32 * 32;
    if (tid_ < 64) { const int cnt = tid_ < 32 ? counts[tid_ * 32] : 0; int pc = cnt;
#pragma unroll
        for (int o = 1; o < 32; o <<= 1) { const int src = lane >= o ? lane - o : lane; const int a = shli(pc, src); if (lane >= o) pc += a; }
        if (tid_ < 32) ps[tid_] = pc - cnt; }
    __syncthreads();
    for (int t = t0 + 4 * gw; t < T; t += 4 * NW) {
        int4 sl[4]; float4 ew[2];
#pragma unroll
        for (int u = 0; u < 4; ++u) sl[u] = *(const int4*)(p.TOKSLOT + (size_t)(t + u) * 4);
        ew[0] = *(const float4*)(p.EW + (size_t)t * 2); ew[1] = *(const float4*)(p.EW + (size_t)(t + 2) * 2);
        unsigned yr[4][2][4];
#pragma unroll
        for (int u = 0; u < 4; ++u) { const unsigned char* y0 = Y + (size_t)(ps[sl[u].x] + sl[u].y) * D; const unsigned char* y1 = Y + (size_t)(ps[sl[u].z] + sl[u].w) * D;
#pragma unroll
            for (int i = 0; i < 4; ++i) { yr[u][0][i] = *(const unsigned*)(y0 + (i * 64 + lane) * 4); yr[u][1][i] = *(const unsigned*)(y1 + (i * 64 + lane) * 4); } }
        const float* mrow = MODl + (size_t)tok_modrow(t) * 6144; const float* g5 = mrow + 5 * 1024;
        const float* mr1 = p.MOD + (size_t)9 * 6144 + (size_t)tok_modrow(t) * 6144;
#pragma unroll
        for (int pr = 0; pr < 2; ++pr) {
            const float wgt[2][2] = {{ew[pr].x, ew[pr].y}, {ew[pr].z, ew[pr].w}};
            u32x2v xr[2][4];
#pragma unroll
            for (int u = 0; u < 2; ++u)
#pragma unroll
                for (int i = 0; i < 4; ++i) xr[u][i] = *(const u32x2v*)(xrow(p, t + 2 * pr + u) + (i * 64 + lane) * 4);
            float4 v[2][4];
#pragma unroll
            for (int i = 0; i < 4; ++i) { const int c = (i * 64 + lane) * 4; const float4 gg = *(const float4*)(g5 + c);
#pragma unroll
                for (int u = 0; u < 2; ++u) { const u32x2v x = xr[u][i]; const int a = (int)yr[2 * pr + u][0][i], b = (int)yr[2 * pr + u][1][i]; const float w1 = wgt[u][0], w2 = wgt[u][1];
                    v[u][i].x = __uint_as_float(x.x << 16) + gg.x * (w1 * __builtin_amdgcn_cvt_f32_fp8(a, 0) + w2 * __builtin_amdgcn_cvt_f32_fp8(b, 0));
                    v[u][i].y = __uint_as_float(x.x & 0xffff0000u) + gg.y * (w1 * __builtin_amdgcn_cvt_f32_fp8(a, 1) + w2 * __builtin_amdgcn_cvt_f32_fp8(b, 1));
                    v[u][i].z = __uint_as_float(x.y << 16) + gg.z * (w1 * __builtin_amdgcn_cvt_f32_fp8(a, 2) + w2 * __builtin_amdgcn_cvt_f32_fp8(b, 2));
                    v[u][i].w = __uint_as_float(x.y & 0xffff0000u) + gg.w * (w1 * __builtin_amdgcn_cvt_f32_fp8(a, 3) + w2 * __builtin_amdgcn_cvt_f32_fp8(b, 3));
                    if (l == 0) *(u32x2v*)(xrow(p, t + 2 * pr + u) + c) = mk2(pk2(v[u][i].x, v[u][i].y), pk2(v[u][i].z, v[u][i].w)); } }
            float rstd[2];
#pragma unroll
            for (int u = 0; u < 2; ++u) { float ss = 0.f;
#pragma unroll
                for (int i = 0; i < 4; ++i) ss += v[u][i].x * v[u][i].x + v[u][i].y * v[u][i].y + v[u][i].z * v[u][i].z + v[u][i].w * v[u][i].w;
                rstd[u] = rsqrtf(wave_sum(ss, lane) * (1.0f / D) + 1e-6f); }
            if (l == 0) {
#pragma unroll
                for (int i = 0; i < 4; ++i) { const int c = (i * 64 + lane) * 4;
                    const float4 gg = *(const float4*)(p.norm1_g + D + c), sh = *(const float4*)(mr1 + c), sc = *(const float4*)(mr1 + 1024 + c);
#pragma unroll
                    for (int u = 0; u < 2; ++u) { const float r = rstd[u];
                        *(u32x2v*)(p.H + (size_t)(t + 2 * pr + u) * D + c) = mk2(pk2(v[u][i].x * r * gg.x * (1.f + sc.x) + sh.x, v[u][i].y * r * gg.y * (1.f + sc.y) + sh.y), pk2(v[u][i].z * r * gg.z * (1.f + sc.z) + sh.z, v[u][i].w * r * gg.w * (1.f + sc.w) + sh.w)); } }
            } else {
#pragma unroll
                for (int u = 0; u < 2; ++u)
#pragma unroll
                    for (int i = 0; i < 4; ++i) { const float4 gg = ((const float4*)p.final_g)[i * 64 + lane]; const float r = rstd[u];
                        ((float4*)(p.out + (size_t)(t + 2 * pr + u - TC) * D))[i * 64 + lane] = make_float4(v[u][i].x * r * gg.x, v[u][i].y * r * gg.y, v[u][i].z * r * gg.z, v[u][i].w * r * gg.w); }
            }
        }
    }
}

#define XLAS __attribute__((address_space(3)))
#define XB_TMO      128
#define XB_XCNT(j)  (256  + 64 * (j))
#define XB_XSUB(j)  (1280 + 64 * (j))
#define XB_XGEN(j)  (2304 + 64 * (j))
#define XB_TOP      3328
#define XB_TOPGEN   3392
#define XCD_BAR_WORDS 3456
#define XB_SPIN_CAP (1u << 18)

__device__ __forceinline__ unsigned xb_ld(unsigned* p)              { return __hip_atomic_load(p, __ATOMIC_RELAXED, __HIP_MEMORY_SCOPE_AGENT); }
__device__ __forceinline__ unsigned xb_add(unsigned* p, unsigned v) { return __hip_atomic_fetch_add(p, v, __ATOMIC_RELAXED, __HIP_MEMORY_SCOPE_AGENT); }
__device__ __forceinline__ unsigned xb_xcc_id() { return (unsigned)__builtin_amdgcn_s_getreg((3 << 11) | 20) & 0xFu; }
#define XB_SPIN(cond, bar) do { unsigned _sp = 0; while (cond) { __builtin_amdgcn_s_sleep(1); \
    if ((++_sp & 255u) == 0u) { if (xb_ld(&(bar)[XB_TMO])) break; if (_sp > XB_SPIN_CAP) { atomicAdd(&(bar)[XB_TMO], 1u); break; } } } } while (0)

struct XcdBarrier {
    unsigned* bar; unsigned x;
    volatile XLAS unsigned* st;
};

__device__ __forceinline__ XcdBarrier xcd_barrier_post(unsigned* bar, volatile XLAS unsigned* st) {
    XcdBarrier b; b.bar = bar; b.x = xb_xcc_id(); b.st = st;
    if (ltid() == 0) (void)xb_add(&bar[XB_XCNT(b.x)], 1u);
    return b;
}
__device__ __forceinline__ void xcd_barrier_complete(unsigned* bar, unsigned x, unsigned& nloc, unsigned& nx) {
    const unsigned G = gridDim.x * gridDim.y * gridDim.z;
    unsigned sum, cnt, mine, sp = 0u;
    for (;;) {
        sum = 0u; cnt = 0u; mine = 0u;
#pragma unroll
        for (unsigned j = 0; j < 16; ++j) { const unsigned c = xb_ld(&bar[XB_XCNT(j)]); sum += c; cnt += (c > 0u) ? 1u : 0u; mine = (j == x) ? c : mine; }
        if (sum == G) break;
        __builtin_amdgcn_s_sleep(1);
        if ((++sp & 255u) == 0u) { if (xb_ld(&bar[XB_TMO])) break; if (sp > XB_SPIN_CAP) { atomicAdd(&bar[XB_TMO], 1u); break; } }
    }
    nloc = mine > 0u ? mine : 1u; nx = cnt > 0u ? cnt : 1u;
}

__device__ __forceinline__ void xcd_barrier(const XcdBarrier& b) {
    asm volatile("s_waitcnt vmcnt(0)" ::: "memory");
    __syncthreads();
    if (ltid() == 0) {
        unsigned* bar = b.bar;
        __builtin_amdgcn_s_waitcnt(0);
        unsigned nloc = b.st[0], nx = b.st[1];
        if (nloc == 0u) { xcd_barrier_complete(bar, b.x, nloc, nx); b.st[0] = nloc; b.st[1] = nx; }
        const unsigned old = xb_add(&bar[XB_XSUB(b.x)], 1u);
        const unsigned gen = old / nloc;
        if (old + 1u == (gen + 1u) * nloc) {
            __builtin_amdgcn_fence(__ATOMIC_RELEASE, "agent");
            asm volatile("s_waitcnt vmcnt(0)" ::: "memory");
            const unsigned og = xb_add(&bar[XB_TOP], 1u);
            const unsigned tg = og / nx;
            if (og + 1u == (tg + 1u) * nx) xb_add(&bar[XB_TOPGEN], 1u);
            else XB_SPIN(xb_ld(&bar[XB_TOPGEN]) == tg, bar);
            __builtin_amdgcn_fence(__ATOMIC_ACQUIRE, "agent");
            xb_add(&bar[XB_XGEN(b.x)], 1u);
            asm volatile("s_waitcnt vmcnt(0)" ::: "memory");
        } else {
            XB_SPIN(xb_ld(&bar[XB_XGEN(b.x)]) == gen, bar);
            __builtin_amdgcn_fence(__ATOMIC_ACQUIRE, "agent");
            asm volatile("s_waitcnt vmcnt(0)" ::: "memory");
        }
    }
    __syncthreads();
}

DI void moe_table(const P& p, int l, PG8_LAS int* tab) {
    const int tid_ = ltid();
    if (tid_ < 64) { const int cnt = tid_ < 32 ? p.counts[(l * 32 + tid_) * 32] : 0; const int nt = (cnt + 255) >> 8; int pt = nt, pc = cnt;
#pragma unroll
        for (int o = 1; o < 32; o <<= 1) { const int ln_ = tid_ & 63, src = ln_ >= o ? ln_ - o : ln_; const int a = shli(pt, src), b = shli(pc, src); if (ln_ >= o) { pt += a; pc += b; } }
        if (tid_ < 32) { tab[tid_ + 1] = pt; tab[33 + tid_] = cnt; tab[65 + tid_] = pc - cnt; if (tid_ == 0) tab[0] = 0; } }
    __syncthreads();
}
typedef const __attribute__((address_space(4))) P* PK;
DI PK lp(PK q) { asm volatile("" : "+s"(q)); return q; }
#define PHASE(...) do { const P p = *(const P*)lp(pk); __VA_ARGS__; } while (0)

template <int l> DI void layer(PK pk, unsigned char* smem, const XcdBarrier& xbar) {
    float* ldsf = (float*)smem; const int gw = 0, NW = 0, lane = 0;
    {
        constexpr int NG = l == 0 ? 234 : 204;
        constexpr int CV1 = l == 0 ? 10 * 768 : NE * 768;
        const int G = (int)gridDim.x == 256 ? NG : (int)gridDim.x;
        if ((int)blockIdx.x < G) PHASE({ pg8::Gemm g{p.H, p.WinT + (size_t)l * NPAD_IN * D, T, NPAD_IN, D}; pg8::StaticOrder S; S.init(T, NPAD_IN, G, (int)blockIdx.x);
            pg8::EpiProj E{p.PROJ, LDP, INDIM};
            pg8::gemm_phase<pg8::EpiProj, pg8::StaticOrder>((PG8_LAS unsigned char*)smem, g, S, E, nullptr); });
        else PHASE(ph_convert_experts(p, l, ldsf, G, (int)gridDim.x - G, 0, CV1));
        if ((int)gridDim.x != 256) PHASE(ph_convert_experts(p, l, ldsf, 0, (int)gridDim.x, 0, CV1));
    }
    xcd_barrier(xbar);
    PHASE(ph_prep(p, l, (LDSP unsigned char*)smem));
    xcd_barrier(xbar);
    PHASE(ph_s1(p, l, (LDSP unsigned char*)smem));
    xcd_barrier(xbar);
    PHASE(ph_s2(p));
    xcd_barrier(xbar);
    PHASE(ph_s3(p, l, (LDSP unsigned char*)smem));
    xcd_barrier(xbar);
    {
        constexpr int ro = l == 0 ? 0 : TC;
        constexpr int NG = l == 0 ? 182 : 256;
        const int G = (int)gridDim.x == 256 ? NG : (int)gridDim.x;
        if ((int)blockIdx.x < G) PHASE({ pg8::Gemm g{p.H + (size_t)ro * D, p.WoutT + (size_t)l * D * D, T - ro, D, D}; pg8::StaticOrder S; S.init(T - ro, D, G, (int)blockIdx.x);
            pg8::EpiResGate<l != 0> E{p.SSQ, p.ctx, p.x, p.XB, p.MOD + (size_t)l * 9 * 6144 + 2 * 1024, p.XSS, ro};
            pg8::gemm_phase<pg8::EpiResGate<l != 0>, pg8::StaticOrder>((PG8_LAS unsigned char*)smem, g, S, E, nullptr); });
        else if (l == 0) PHASE(ph_convert_experts(p, l, ldsf, G, (int)gridDim.x - G, 10 * 768, NE * 768));
        if (l == 0 && (int)gridDim.x != 256) PHASE(ph_convert_experts(p, l, ldsf, 0, (int)gridDim.x, 10 * 768, NE * 768));
    }
    xcd_barrier(xbar);
    const int t0 = l == 0 ? 0 : TC;
    PHASE(ph_normroute(p, l, t0, (LDSP unsigned char*)smem));
    xcd_barrier(xbar);
    PG8_LAS int* tab = (PG8_LAS int*)((PG8_LAS unsigned char*)smem + pg8::STAGE_BYTES);
#pragma unroll
    for (int ph = 0; ph < 2; ++ph) {
        PHASE(moe_table(p, l, tab));
        const int U = __builtin_amdgcn_readfirstlane(tab[32]) * 4;
        if (ph == 0) PHASE({ pg8::Gemm g{p.H, p.WguT, T, D, D}; pg8::MoeSched S{tab, p.MAP, U, (int)gridDim.x, (int)blockIdx.x, 4, 1, (size_t)D * D * 2};
            pg8::EpiAct E{p.SS}; pg8::gemm_phase_moe<pg8::EpiAct, pg8::MoeSched>((PG8_LAS unsigned char*)smem, g, S, E, nullptr); });
        else PHASE({ pg8::Gemm g{p.SS, p.WdT, T, D, 512}; pg8::MoeSched S{tab, p.MAP, U, (int)gridDim.x, (int)blockIdx.x, 4, 0, (size_t)D * 512 * 2};
            pg8::EpiY E{(unsigned char*)p.PROJ}; pg8::gemm_phase_moe<pg8::EpiY, pg8::MoeSched>((PG8_LAS unsigned char*)smem, g, S, E, nullptr); });
        xcd_barrier(xbar);
    }
    PHASE(ph_combine(p, l, t0, (const unsigned char*)p.PROJ, (LDSP int*)smem));
    xcd_barrier(xbar);
}

__global__ void __launch_bounds__(NTHR) mega(P p_arg) {
    extern __shared__ __attribute__((aligned(16))) unsigned char smem[];
    cg::grid_group grid = cg::this_grid();
    PK pk = (PK)__builtin_amdgcn_kernarg_segment_ptr();
    const int lane = 0, gw = 0, NW = 0;
    float* ldsf = (float*)smem;
    volatile XLAS unsigned* bst = (volatile XLAS unsigned*)((XLAS unsigned char*)smem + LDS_BYTES - 16);
    { const int t_ = ltid(); if (t_ < 2) bst[t_] = 0u; }
    __syncthreads();
    const XcdBarrier xbar = xcd_barrier_post(pk->BAR, bst);
    PHASE(ph_init(p)); PHASE(ph_mod(p, ldsf)); PHASE(ph_convert_small(p, ldsf, gw, NW, lane));
    grid.sync();
    PHASE(ph_normmod1(p, 0, gw, NW, lane));
    xcd_barrier(xbar);
    layer<0>(pk, smem, xbar);
    layer<1>(pk, smem, xbar);
}

static inline size_t al(size_t x) { return (x + 255) & ~(size_t)255; }

extern "C" void kernel_launch(void* const* d_in, const int* in_sizes, int n_in, void* d_out, int out_size, void* d_ws, size_t ws_size, hipStream_t stream) {
    static int grid_blocks = 0;
    if (grid_blocks == 0) {
        int dev = 0, cus = 0, per_cu = 0;
        if (hipFuncSetAttribute((const void*)mega, hipFuncAttributeMaxDynamicSharedMemorySize, LDS_BYTES) != hipSuccess) { fprintf(stderr, "hipFuncSetAttribute failed\n"); grid_blocks = -1; return; }
        (void)hipGetDevice(&dev); (void)hipDeviceGetAttribute(&cus, hipDeviceAttributeMultiprocessorCount, dev);
        if (hipOccupancyMaxActiveBlocksPerMultiprocessor(&per_cu, (const void*)mega, NTHR, LDS_BYTES) != hipSuccess || per_cu < 1) { fprintf(stderr, "occupancy query: %d blocks/CU\n", per_cu); grid_blocks = -1; return; }
        grid_blocks = cus;
    }
    if (grid_blocks < 0) return;
    P p{};
    const float** pin = (const float**)&p;
    for (int i = 0; i < 29; ++i) pin[i] = (const float*)d_in[i];
    p.out = (float*)d_out;
    char* ws = (char*)d_ws; size_t off = 0;
    auto take = [&](size_t bytes) { char* q = ws + off; off += al(bytes); return q; };
    p.XB = (bf16_t*)take((size_t)T * D * 2);
    p.H = (bf16_t*)take((size_t)T * D * 2);
    p.PROJ = (bf16_t*)take((size_t)T * LDP * 2);
    p.SS = (bf16_t*)take((size_t)NTILE * 8 * 2 * 4096 * 2);
    p.GS = (bf16_t*)take((size_t)NTILE * 4 * 2 * 8192 * 2);
    p.SDEC = (float*)take((size_t)NTILE * 8 * 2 * 4);
    p.GDEC = (float*)take((size_t)NTILE * 4 * 2 * 64 * 4);
    p.MOD = (float*)take((size_t)2 * 9 * 6144 * 4);
    p.counts = (int*)take(64 * 32 * 4);
    p.TOKSLOT = (int*)take((size_t)T * 4 * 4);
    p.EW = (float*)take((size_t)T * 2 * 4);
    p.MAP = (int*)take((size_t)NE * T * 4);
    p.WinT = (bf16_t*)take((size_t)2 * NPAD_IN * D * 2);
    p.WoutT = (bf16_t*)take((size_t)2 * D * D * 2);
    p.WguT = (bf16_t*)take((size_t)NE * D * D * 2);
    p.WdT = (bf16_t*)take((size_t)NE * D * 512 * 2);
    p.WRT = (bf16_t*)take((size_t)32 * 1024 * 2);
    p.BAR = (unsigned*)take(XCD_BAR_WORDS * 4);
    p.XBCC = (bf16_t*)d_out;
    p.QKB = (bf16_t*)d_out + (size_t)T * 768;
    p.SSC = (float*)take((size_t)T * 8 * 4 * 4);
    p.STOT = (float*)take((size_t)NTILE * 8 * 2 * 4);
    p.SSQ = (float*)take((size_t)T * 8 * 4);
    p.XSS = (float*)take((size_t)T * 16 * 4);
    if (off > ws_size) { fprintf(stderr, "workspace too small: need %zu have %zu\n", off, ws_size); return; }
    if (hipMemsetAsync(p.BAR, 0, XCD_BAR_WORDS * 4, stream) != hipSuccess) { fprintf(stderr, "memset of barrier words failed\n"); return; }
    void* args[] = {&p};
    hipError_t e = hipLaunchCooperativeKernel((void*)mega, dim3(grid_blocks), dim3(NTHR), args, LDS_BYTES, stream);
    if (e != hipSuccess) fprintf(stderr, "cooperative launch failed: %s (grid %d)\n", hipGetErrorString(e), grid_blocks);
}
```

```cpp
#include <hip/hip_runtime.h>
#include <hip/hip_cooperative_groups.h>
#include <stdint.h>
#include <cstdio>
namespace cg = cooperative_groups;

typedef unsigned short bf16_t;
#define DI __device__ __forceinline__

constexpr int D = 1024, NB = 8, SEQ = 4096, CTXL = 256, TC = NB * CTXL, TL = NB * SEQ, T = TC + TL;
constexpr int INDIM = 2840, LDP = 2848;
constexpr int OFF_Z = 0, OFF_XBC = 512, OFF_DT = 1280, OFF_Q = 1288, OFF_K = 1544, OFF_V = 1800, OFF_GO = 2312, OFF_GK = 2824;
constexpr int NE = 32;

DI float bf2f(bf16_t v) { return __uint_as_float(((unsigned)v) << 16); }
typedef float f32x2v_ __attribute__((ext_vector_type(2)));
typedef __bf16 bf16x2v_ __attribute__((ext_vector_type(2)));
DI bf16_t f2bf(float f) { return __builtin_bit_cast(unsigned short, (__bf16)f); }
DI float siluf(float x) { return x * __builtin_amdgcn_rcpf(1.0f + __builtin_amdgcn_exp2f(-1.4426950408889634f * x)); }
DI float softplusf(float x) { return fmaxf(x, 0.f) + log1pf(__expf(-fabsf(x))); }
DI float logsigmoidf(float x) { return -softplusf(-x); }
DI float shx(float v, int o, int lane) { return __int_as_float(__builtin_amdgcn_ds_bpermute((lane ^ o) << 2, __float_as_int(v))); }
DI int shxi(int v, int o, int lane) { return __builtin_amdgcn_ds_bpermute((lane ^ o) << 2, v); }
DI float shl(float v, int src) { return __int_as_float(__builtin_amdgcn_ds_bpermute(src << 2, __float_as_int(v))); }
DI int shli(int v, int src) { return __builtin_amdgcn_ds_bpermute(src << 2, v); }
DI float wave_sum(float v, int lane) {
#pragma unroll
    for (int o = 32; o >= 1; o >>= 1) v += shx(v, o, lane);
    return v;
}
DI int ltid() { const int wv = __builtin_amdgcn_readfirstlane(threadIdx.x >> 6);
    int t = wv * 64 + (int)__builtin_amdgcn_mbcnt_hi(~0u, __builtin_amdgcn_mbcnt_lo(~0u, 0u)); asm volatile("" : "+v"(t)); return t; }
DI int tok_modrow(int t) { return t < TC ? 8 : ((t - TC) >> 12); }
template <class PT> DI bf16_t* xrow(const PT& p, int t) { return p.XB + (size_t)t * D; }


#ifndef PG8_SP2
#define PG8_SP2 true
#endif
namespace pg8 {
#define PG8_LAS __attribute__((address_space(3)))
typedef unsigned short bf16_t;
typedef short bf16x8 __attribute__((ext_vector_type(8)));
typedef float f32x4 __attribute__((ext_vector_type(4)));
typedef unsigned u32x4 __attribute__((ext_vector_type(4)));
constexpr int BM = 256, BK = 64, HALF = 128, HTB = HALF * BK * 2  , STAGE_BYTES = 8 * HTB, NXCD = 8, WGM = 8;

__host__ __device__ __forceinline__ int lds_byte(int r, int c) { const int st = (r >> 4) * 2 + (c >> 5), rr = r & 15, cc = c & 31, ob = rr * 64 + cc * 2; return st * 1024 + (ob ^ (((ob >> 9) & 1) << 5)); }
__host__ __device__ __forceinline__ void stage_rc(int b, int& R, int& C) { const int st = b / 1024, sb = b % 1024, swz = sb ^ (((sb >> 9) & 1) << 5); R = (st >> 1) * 16 + swz / 64; C = (st & 1) * 32 + (swz % 64) / 2; }
__host__ __device__ __forceinline__ int perm32(int rho) { const int n = rho >> 4, i = rho & 15; return 8 * (i >> 2) + 4 * n + (i & 3); }

struct Unit { int pm, pn; };
struct Gemm { const bf16_t* A; const bf16_t* Bt; int M, N, K; };

struct StaticOrder {
    int nM, nN, nwg, G, c;
    __host__ __device__ void init(int M, int N, int G_, int c_) { nM = M / BM; nN = N / BM; nwg = nM * nN; G = G_; c = c_; }
    __host__ __device__ bool next(int i, Unit& u) const {
        const long L = (long)i * G + c; if (L >= nwg) return false;
        int wgid = (int)L; { const int q = nwg / NXCD, r = nwg % NXCD, xcd = wgid % NXCD, off = wgid / NXCD; wgid = (xcd < r ? xcd * (q + 1) : r * (q + 1) + (xcd - r) * q) + off; }
        const int nig = WGM * nN, gid = wgid / nig, fm = gid * WGM, gsz = (nM - fm) < WGM ? (nM - fm) : WGM;
        u.pm = fm + ((wgid % nig) % gsz); u.pn = (wgid % nig) / gsz; return true;
    }
    __device__ __forceinline__ void a_ready(const Unit&) const {}
    __device__ __forceinline__ void done(const Unit&) const {}
};
__device__ __forceinline__ unsigned cvt_pk_bf16(float lo, float hi) { unsigned r; asm volatile("v_cvt_pk_bf16_f32 %0, %1, %2" : "=v"(r) : "v"(lo), "v"(hi)); return r; }
typedef float f32x2 __attribute__((ext_vector_type(2)));

struct EpiProj {
    static constexpr bool PERM = true, AFTER_DRAIN = false, MIDK = false;
    bf16_t* O; int ldc; int ncols;
    __device__ __forceinline__ void operator()(const f32x4 (&acc)[2][2][4][2], const Unit& u, int wr, int wc, int fr, int fq) const {
        const int row0 = u.pm * BM + wr * 64 + fr, col0 = u.pn * BM + wc * 32 + 8 * fq;
#pragma unroll
        for (int ai = 0; ai < 2; ++ai)
#pragma unroll
            for (int m = 0; m < 4; ++m) { bf16_t* rowp = O + (size_t)(row0 + ai * HALF + m * 16) * ldc + col0;
#pragma unroll
                for (int bj = 0; bj < 2; ++bj) { const f32x4 v0 = acc[ai][bj][m][0], v1 = acc[ai][bj][m][1];
                    u32x4 w; w.x = cvt_pk_bf16(v0[0], v0[1]); w.y = cvt_pk_bf16(v0[2], v0[3]); w.z = cvt_pk_bf16(v1[0], v1[1]); w.w = cvt_pk_bf16(v1[2], v1[3]);
                    if (col0 + bj * HALF + 8 <= ncols) *(u32x4*)(rowp + bj * HALF) = w; } }
    }
};
template <bool SRC_BF16> struct EpiResGate {
    static constexpr bool PERM = true, AFTER_DRAIN = false, MIDK = true;
    const float* ssq;
    const float* Sc; const float* Sl;
    bf16_t* XB;
    const float* gate_rows; float* xss; int rowoff;
    __device__ __forceinline__ void midk(f32x4 (&acc)[2][2][4][2], const Unit& u, int wr, int fr) const {
        int fr_ = fr; asm volatile("" : "+v"(fr_));
        const int row0 = rowoff + u.pm * BM + wr * 64 + fr_;
#pragma unroll
        for (int ai = 0; ai < 2; ++ai)
#pragma unroll
            for (int m = 0; m < 4; ++m) { const f32x4* q = (const f32x4*)(ssq + (size_t)(row0 + ai * HALF + m * 16) * 8); const f32x4 a = q[0], b = q[1];
                const float rs = __builtin_amdgcn_rsqf((((a[0] + a[1]) + (a[2] + a[3])) + ((b[0] + b[1]) + (b[2] + b[3]))) * (1.0f / 512.0f) + 1e-6f);
#pragma unroll
                for (int bj = 0; bj < 2; ++bj)
#pragma unroll
                    for (int n = 0; n < 2; ++n) acc[ai][bj][m][n] *= rs;
                asm volatile("" ::: "memory"); }
    }
    __device__ __forceinline__ void operator()(const f32x4 (&acc)[2][2][4][2], const Unit& u, int wr, int wc, int fr, int fq) const {
        const int row0 = rowoff + u.pm * BM + wr * 64 + fr, col0 = u.pn * BM + wc * 32 + 8 * fq;
        const int t0 = rowoff + u.pm * BM; const int mrow = t0 < 2048 ? 8 : ((t0 - 2048) >> 12);
        const float* gr = gate_rows + (size_t)mrow * 6144 + col0;
        f32x4 gv[2][2];
#pragma unroll
        for (int bj = 0; bj < 2; ++bj)
#pragma unroll
            for (int n = 0; n < 2; ++n) gv[bj][n] = *(const f32x4*)(gr + bj * HALF + n * 4);
#pragma unroll
        for (int ai = 0; ai < 2; ++ai)
#pragma unroll
            for (int m = 0; m < 4; ++m) { const int rr = row0 + ai * HALF + m * 16;
                const float* sp = (rr < 2048 ? Sc + (size_t)rr * 1024 : Sl + (size_t)(rr - 2048) * 1024) + col0; bf16_t* dp = XB + (size_t)rr * 1024 + col0; float ss = 0.f;
#pragma unroll
                for (int bj = 0; bj < 2; ++bj) { f32x4 x0, x1;
                    if (SRC_BF16) { const u32x4 r = *(const u32x4*)(dp + bj * HALF);
                        x0 = (f32x4){__uint_as_float(r.x << 16), __uint_as_float(r.x & 0xffff0000u), __uint_as_float(r.y << 16), __uint_as_float(r.y & 0xffff0000u)};
                        x1 = (f32x4){__uint_as_float(r.z << 16), __uint_as_float(r.z & 0xffff0000u), __uint_as_float(r.w << 16), __uint_as_float(r.w & 0xffff0000u)}; }
                    else { x0 = *(const f32x4*)(sp + bj * HALF); x1 = *(const f32x4*)(sp + bj * HALF + 4); }
                    const f32x4 v0 = x0 + gv[bj][0] * acc[ai][bj][m][0], v1 = x1 + gv[bj][1] * acc[ai][bj][m][1];
                    u32x4 w; w.x = cvt_pk_bf16(v0[0], v0[1]); w.y = cvt_pk_bf16(v0[2], v0[3]); w.z = cvt_pk_bf16(v1[0], v1[1]); w.w = cvt_pk_bf16(v1[2], v1[3]);
                    *(u32x4*)(dp + bj * HALF) = w;
#pragma unroll
                    for (int j = 0; j < 4; ++j) { const float lo = __uint_as_float(w[j] << 16), hi = __uint_as_float(w[j] & 0xffff0000u); ss += lo * lo + hi * hi; } }
                { const int ln_ = fq * 16 + fr; ss += __int_as_float(__builtin_amdgcn_ds_bpermute((ln_ ^ 16) << 2, __float_as_int(ss))); ss += __int_as_float(__builtin_amdgcn_ds_bpermute((ln_ ^ 32) << 2, __float_as_int(ss))); }
                if (fq == 0) xss[(size_t)rr * 16 + u.pn * 4 + wc] = ss; }
    }
};
template <class Epi, class Sched, bool STAMP = false, bool SP2 = PG8_SP2>
__device__ __forceinline__ void gemm_phase(PG8_LAS unsigned char* lds, const Gemm g, const Sched& S, const Epi& E, unsigned long long* stamps) {
    int tid_l = __builtin_amdgcn_readfirstlane(threadIdx.x >> 6) * 64 + (int)__builtin_amdgcn_mbcnt_hi(~0u, __builtin_amdgcn_mbcnt_lo(~0u, 0u)); asm volatile("" : "+v"(tid_l));
    const int tid = tid_l, wid = __builtin_amdgcn_readfirstlane(tid >> 6), lane = tid & 63, wr = wid >> 2, wc = wid & 3, fr = lane & 15, fq = lane >> 4;
    const int K = g.K, nt = K / BK;
    int ts_lo = 0, ts_hi = 0, nts = 0; const unsigned long long rt_entry = STAMP ? (unsigned long long)wall_clock64() : 0ull;
#define PG8_STAMP() do { if (STAMP && wid == 0 && nts < 64) { const unsigned long long _c = (unsigned long long)clock64(); \
        ts_lo = (lane == nts) ? (int)(unsigned)_c : ts_lo; ts_hi = (lane == nts) ? (int)(unsigned)(_c >> 32) : ts_hi; ++nts; } } while (0)
    PG8_STAMP();
    unsigned voffA[2], voffB[2];
#pragma unroll
    for (int i = 0; i < 2; ++i) { int R, C; stage_rc(tid * 16 + i * 8192, R, C); const int Rb = Epi::PERM ? ((R & ~31) + perm32(R & 31)) : R;
        voffA[i] = (unsigned)(R * K + C) * 2u; voffB[i] = (unsigned)(Rb * K + C) * 2u; }
    const size_t kstep = (size_t)(BK * 2);
    const size_t hstep = (size_t)HALF * K * 2;
    const size_t tstep = 2 * hstep;
    const unsigned ldsw = (unsigned)wid * 1024u;
    const int aoff = lds_byte(wr * 64 + fr, fq * 8), boff = lds_byte(wc * 32 + fr, fq * 8);
#define PG8_SA(b, h) (((b) * 2 + (h)) * HTB)
#define PG8_SB(b, h) ((4 + (b) * 2 + (h)) * HTB)
#define PG8_STAGE(bufoff, gbase, voff) do { _Pragma("unroll") for (int _i = 0; _i < 2; ++_i) \
        __builtin_amdgcn_global_load_lds((const unsigned*)((const char*)(gbase) + (voff)[_i]), (PG8_LAS unsigned*)(lds + (bufoff) + ldsw + _i * 8192), 16, 0, 0); } while (0)
#define PG8_LDA(dst, b, h) do { _Pragma("unroll") for (int m = 0; m < 4; ++m) _Pragma("unroll") for (int k = 0; k < 2; ++k) dst[m][k] = *(const PG8_LAS bf16x8*)(lds + PG8_SA(b, h) + aoff + m * 2048 + k * 1024); } while (0)
#define PG8_LDB(dst, b, h) do { _Pragma("unroll") for (int n = 0; n < 2; ++n) _Pragma("unroll") for (int k = 0; k < 2; ++k) dst[n][k] = *(const PG8_LAS bf16x8*)(lds + PG8_SB(b, h) + boff + n * 2048 + k * 1024); } while (0)
#define PG8_MMA(ai, bj, At, Bt) do { __builtin_amdgcn_s_setprio(1); _Pragma("unroll") for (int m = 0; m < 4; ++m) _Pragma("unroll") for (int n = 0; n < 2; ++n) _Pragma("unroll") for (int k = 0; k < 2; ++k) \
        acc[ai][bj][m][n] = __builtin_amdgcn_mfma_f32_16x16x32_bf16(Bt[n][k], At[m][k], acc[ai][bj][m][n], 0, 0, 0); __builtin_amdgcn_s_setprio(0); } while (0)
#define PG8_WAIT_V(n) asm volatile("s_waitcnt vmcnt(" #n ")" ::: "memory")
#define PG8_WAIT_L(n) asm volatile("s_waitcnt lgkmcnt(" #n ")" ::: "memory")
#define PG8_BAR __builtin_amdgcn_s_barrier()
#define PG8_SCHED __builtin_amdgcn_sched_barrier(0)
    Unit cur, nxt; int ui = 0;
    if (!S.next(0, cur)) return;
    f32x4 acc[2][2][4][2];
#pragma unroll
    for (int a = 0; a < 2; ++a)
#pragma unroll
        for (int b = 0; b < 2; ++b)
#pragma unroll
            for (int m = 0; m < 4; ++m)
#pragma unroll
                for (int n = 0; n < 2; ++n) acc[a][b][m][n] = (f32x4){0.f, 0.f, 0.f, 0.f};
    bf16x8 At[4][2], B0[2][2], B1[2][2];
    const char* cA = (const char*)g.A + (size_t)cur.pm * tstep; const char* cB = (const char*)g.Bt + (size_t)cur.pn * tstep;
    S.a_ready(cur);
    if constexpr (SP2) {
        PG8_STAGE(PG8_SB(0, 0), cB, voffB); PG8_STAGE(PG8_SB(0, 1), cB + hstep, voffB); PG8_STAGE(PG8_SA(0, 0), cA, voffA); PG8_STAGE(PG8_SA(0, 1), cA + hstep, voffA);
        if (wr == 1) PG8_BAR;
        PG8_WAIT_V(2); PG8_BAR;
        PG8_STAGE(PG8_SB(1, 0), cB + kstep, voffB); PG8_STAGE(PG8_SA(1, 0), cA + kstep, voffA); PG8_STAGE(PG8_SB(1, 1), cB + hstep + kstep, voffB);
        PG8_WAIT_V(6); PG8_BAR;
    } else {
    PG8_STAGE(PG8_SB(0, 0), cB, voffB); PG8_STAGE(PG8_SA(0, 0), cA, voffA); PG8_STAGE(PG8_SB(0, 1), cB + hstep, voffB); PG8_STAGE(PG8_SA(0, 1), cA + hstep, voffA);
    if (wr == 1) PG8_BAR;
    PG8_WAIT_V(4); PG8_BAR;
    PG8_STAGE(PG8_SB(1, 0), cB + kstep, voffB); PG8_STAGE(PG8_SA(1, 0), cA + kstep, voffA); PG8_STAGE(PG8_SB(1, 1), cB + hstep + kstep, voffB);
    PG8_WAIT_V(6); PG8_BAR;
    }
    PG8_STAMP();
    for (;;) {
        const bool has_next = S.next(ui + 1, nxt);
        const char* nA = has_next ? (const char*)g.A + (size_t)nxt.pm * tstep : cA; const char* nB = has_next ? (const char*)g.Bt + (size_t)nxt.pn * tstep : cB;
        for (int t = 0; t < nt; t += 2) {
            const bool last = (t == nt - 2);
            const char* a1 = cA + (size_t)(t + 1) * kstep;
            const char* a2 = last ? nA : cA + (size_t)(t + 2) * kstep; const char* b2 = last ? nB : cB + (size_t)(t + 2) * kstep;
            const char* a3 = a2 + kstep; const char* b3 = b2 + kstep;
            if (last && has_next) S.a_ready(nxt);
            if constexpr (SP2) {
            PG8_LDB(B0, 0, 0); PG8_LDB(B1, 0, 1); PG8_SCHED; PG8_LDA(At, 0, 0); PG8_STAGE(PG8_SA(1, 1), a1 + hstep, voffA);
            PG8_WAIT_V(8); PG8_WAIT_L(0); PG8_BAR; PG8_MMA(0, 0, At, B0); PG8_MMA(0, 1, At, B1); PG8_BAR; PG8_SCHED;
            PG8_LDA(At, 0, 1); PG8_STAGE(PG8_SB(0, 0), b2, voffB); PG8_STAGE(PG8_SB(0, 1), b2 + hstep, voffB); PG8_STAGE(PG8_SA(0, 0), a2, voffA);
            PG8_WAIT_V(8); PG8_WAIT_L(0); PG8_BAR; PG8_MMA(1, 0, At, B0); PG8_MMA(1, 1, At, B1); PG8_BAR; PG8_SCHED;
            PG8_LDB(B0, 1, 0); PG8_LDB(B1, 1, 1); PG8_SCHED; PG8_LDA(At, 1, 0); PG8_STAGE(PG8_SA(0, 1), a2 + hstep, voffA);
            PG8_WAIT_V(8); PG8_WAIT_L(0); PG8_BAR; PG8_MMA(0, 0, At, B0); PG8_MMA(0, 1, At, B1); PG8_BAR; PG8_SCHED;
            PG8_LDA(At, 1, 1); PG8_STAGE(PG8_SB(1, 0), b3, voffB); PG8_STAGE(PG8_SB(1, 1), b3 + hstep, voffB); PG8_STAGE(PG8_SA(1, 0), a3, voffA);
            PG8_WAIT_V(8); PG8_WAIT_L(0); PG8_BAR; PG8_MMA(1, 0, At, B0); PG8_MMA(1, 1, At, B1); PG8_BAR; PG8_SCHED;
            } else {
            PG8_LDB(B0, 0, 0); PG8_SCHED; PG8_LDA(At, 0, 0); PG8_STAGE(PG8_SA(1, 1), a1 + hstep, voffA);
            PG8_WAIT_L(8); PG8_BAR; PG8_WAIT_L(0); PG8_MMA(0, 0, At, B0); PG8_BAR; PG8_SCHED;
            PG8_LDB(B1, 0, 1); PG8_STAGE(PG8_SB(0, 0), b2, voffB);
            PG8_BAR; PG8_WAIT_L(0); PG8_MMA(0, 1, At, B1); PG8_BAR;
            PG8_LDA(At, 0, 1); PG8_STAGE(PG8_SA(0, 0), a2, voffA);
            PG8_BAR; PG8_WAIT_L(0); PG8_MMA(1, 0, At, B0); PG8_BAR; PG8_SCHED;
            PG8_STAGE(PG8_SB(0, 1), b2 + hstep, voffB);
            PG8_WAIT_V(6); PG8_BAR; PG8_MMA(1, 1, At, B1); PG8_BAR;
            PG8_LDB(B0, 1, 0); PG8_SCHED; PG8_LDA(At, 1, 0); PG8_STAGE(PG8_SA(0, 1), a2 + hstep, voffA);
            PG8_WAIT_L(8); PG8_BAR; PG8_WAIT_L(0); PG8_MMA(0, 0, At, B0); PG8_BAR; PG8_SCHED;
            PG8_LDB(B1, 1, 1); PG8_STAGE(PG8_SB(1, 0), b3, voffB);
            PG8_BAR; PG8_WAIT_L(0); PG8_MMA(0, 1, At, B1); PG8_BAR;
            PG8_LDA(At, 1, 1); PG8_STAGE(PG8_SA(1, 0), a3, voffA);
            PG8_BAR; PG8_WAIT_L(0); PG8_MMA(1, 0, At, B0); PG8_BAR; PG8_SCHED;
            PG8_STAGE(PG8_SB(1, 1), b3 + hstep, voffB);
            PG8_WAIT_V(6); PG8_BAR; PG8_MMA(1, 1, At, B1); PG8_BAR;
            }
            if constexpr (Epi::MIDK) { if (t + 2 == nt / 2) E.midk(acc, cur, wr, fr); }
        }
        PG8_STAMP();
        if (wr == 0) PG8_BAR;
        if constexpr (!Epi::AFTER_DRAIN) { E(acc, cur, wr, wc, fr, fq); S.done(cur); }
        PG8_STAMP();
        if (!has_next) break;
#pragma unroll
        for (int a = 0; a < 2; ++a)
#pragma unroll
            for (int b = 0; b < 2; ++b)
#pragma unroll
                for (int m = 0; m < 4; ++m)
#pragma unroll
                    for (int n = 0; n < 2; ++n) acc[a][b][m][n] = (f32x4){0.f, 0.f, 0.f, 0.f};
        cur = nxt; cA = nA; cB = nB; ++ui;
        if (wr == 1) PG8_BAR;
    }
    PG8_WAIT_V(0);
    PG8_BAR;
    if constexpr (Epi::AFTER_DRAIN) { E.fused(acc, cur, wr, wc, fr, fq, lds, wid, lane); S.done(cur); }
    PG8_STAMP();
    if (STAMP && wid == 0) { stamps[lane] = lane < nts ? (((unsigned long long)(unsigned)ts_hi << 32) | (unsigned)ts_lo) : 0ull;
        if (lane == 62) stamps[62] = rt_entry; if (lane == 63) stamps[63] = (unsigned long long)wall_clock64(); }
#undef PG8_STAMP
#undef PG8_SA
#undef PG8_SB
#undef PG8_STAGE
#undef PG8_LDA
#undef PG8_LDB
#undef PG8_MMA
#undef PG8_WAIT_V
#undef PG8_WAIT_L
#undef PG8_BAR
#undef PG8_SCHED
}

struct MoeUnit { int e, mt, pn, cnt, pstart; };
struct MoeSched {
    typedef MoeUnit UnitT;
    PG8_LAS const int* tab; const int* map; int U, G, c, npn, gather; size_t bstride;
    __device__ __forceinline__ bool next(int i, MoeUnit& u) const {
        const long L = (long)i * G + c; if (L >= U) return false;
        int idx = (int)L; { const int q = U / NXCD, r = U % NXCD, xcd = idx % NXCD, off = idx / NXCD; idx = (xcd < r ? xcd * (q + 1) : r * (q + 1) + (xcd - r) * q) + off; }
        const int tau = idx / npn; u.pn = idx - tau * npn;
        int e = 0;
#pragma unroll
        for (int st = 16; st >= 1; st >>= 1) { if (__builtin_amdgcn_readfirstlane(tab[e + st]) <= tau) e += st; }
        u.e = e; u.mt = tau - __builtin_amdgcn_readfirstlane(tab[e]); u.cnt = __builtin_amdgcn_readfirstlane(tab[33 + e]); u.pstart = __builtin_amdgcn_readfirstlane(tab[65 + e]);
        return true;
    }
    __device__ __forceinline__ const char* bbase(const Gemm& g, const MoeUnit& u) const { return (const char*)g.Bt + (size_t)u.e * bstride + (size_t)u.pn * BM * g.K * 2; }
    __device__ __forceinline__ void a_offsets(const Gemm& g, const MoeUnit& u, int tid, unsigned (&va)[2][2]) const {
        int tl = tid; asm volatile("" : "+v"(tl));
        int RA[2], CA[2];
#pragma unroll
        for (int i = 0; i < 2; ++i) { int R, C; stage_rc(tl * 16 + i * 8192, R, C); RA[i] = R; CA[i] = C * 2; }
#pragma unroll
        for (int hf = 0; hf < 2; ++hf)
#pragma unroll
            for (int i = 0; i < 2; ++i) { int rl = u.mt * BM + hf * HALF + RA[i]; rl = rl < u.cnt ? rl : u.cnt - 1;
                const unsigned row = gather ? (unsigned)map[(size_t)u.e * 34816 + rl] : (unsigned)(u.pstart + rl);
                va[hf][i] = row * (unsigned)(g.K * 2) + (unsigned)CA[i]; }
    }
};
struct EpiAct {
    static constexpr bool PERM = true, AFTER_DRAIN = false;
    bf16_t* O;
    __device__ __forceinline__ void operator()(const f32x4 (&acc)[2][2][4][2], const MoeUnit& u, int wr, int wc, int fr, int fq) const {
        const int rl0 = u.mt * BM + wr * 64 + fr, col0 = u.pn * HALF + wc * 32 + 8 * fq;
#pragma unroll
        for (int ai = 0; ai < 2; ++ai)
#pragma unroll
            for (int m = 0; m < 4; ++m) { const int rl = rl0 + ai * HALF + m * 16;
                if (rl < u.cnt) { float o[8];
#pragma unroll
                    for (int n = 0; n < 2; ++n)
#pragma unroll
                        for (int j = 0; j < 4; ++j) { const float gv = acc[ai][0][m][n][j]; o[4 * n + j] = gv * __builtin_amdgcn_rcpf(1.0f + __builtin_amdgcn_exp2f(-1.4426950408889634f * gv)) * acc[ai][1][m][n][j]; }
                    u32x4 w; w.x = cvt_pk_bf16(o[0], o[1]); w.y = cvt_pk_bf16(o[2], o[3]); w.z = cvt_pk_bf16(o[4], o[5]); w.w = cvt_pk_bf16(o[6], o[7]);
                    *(u32x4*)(O + (size_t)(u.pstart + rl) * 512 + col0) = w; } }
    }
};
struct EpiY {
    static constexpr bool PERM = true, AFTER_DRAIN = false;
    unsigned char* O;
    static __device__ __forceinline__ unsigned pk4(const f32x4 v) { const float lim = 440.f;
        int w = __builtin_amdgcn_cvt_pk_fp8_f32(fminf(fmaxf(v[0], -lim), lim), fminf(fmaxf(v[1], -lim), lim), 0, false);
        return (unsigned)__builtin_amdgcn_cvt_pk_fp8_f32(fminf(fmaxf(v[2], -lim), lim), fminf(fmaxf(v[3], -lim), lim), w, true); }
    __device__ __forceinline__ void operator()(const f32x4 (&acc)[2][2][4][2], const MoeUnit& u, int wr, int wc, int fr, int fq) const {
        typedef unsigned u32x2 __attribute__((ext_vector_type(2)));
        const int rl0 = u.mt * BM + wr * 64 + fr, col0 = u.pn * BM + wc * 32 + 8 * fq;
#pragma unroll
        for (int ai = 0; ai < 2; ++ai)
#pragma unroll
            for (int m = 0; m < 4; ++m) { const int rl = rl0 + ai * HALF + m * 16;
                if (rl < u.cnt) { unsigned char* rowp = O + (size_t)(u.pstart + rl) * 1024 + col0;
#pragma unroll
                    for (int bj = 0; bj < 2; ++bj) *(u32x2*)(rowp + bj * HALF) = (u32x2){pk4(acc[ai][bj][m][0]), pk4(acc[ai][bj][m][1])}; } }
    }
};
template <class Epi, class Sched, bool STAMP = false, bool SP2 = PG8_SP2>
__device__ __forceinline__ void gemm_phase_moe(PG8_LAS unsigned char* lds, const Gemm g, const Sched& S, const Epi& E, unsigned long long* stamps) {
    int tid_l = __builtin_amdgcn_readfirstlane(threadIdx.x >> 6) * 64 + (int)__builtin_amdgcn_mbcnt_hi(~0u, __builtin_amdgcn_mbcnt_lo(~0u, 0u)); asm volatile("" : "+v"(tid_l));
    const int tid = tid_l, wid = __builtin_amdgcn_readfirstlane(tid >> 6), lane = tid & 63, wr = wid >> 2, wc = wid & 3, fr = lane & 15, fq = lane >> 4;
    const int K = g.K, nt = K / BK;
    int ts_lo = 0, ts_hi = 0, nts = 0; const unsigned long long rt_entry = STAMP ? (unsigned long long)wall_clock64() : 0ull;
#define PG8_STAMP() do { if (STAMP && wid == 0 && nts < 64) { const unsigned long long _c = (unsigned long long)clock64(); \
        ts_lo = (lane == nts) ? (int)(unsigned)_c : ts_lo; ts_hi = (lane == nts) ? (int)(unsigned)(_c >> 32) : ts_hi; ++nts; } } while (0)
    PG8_STAMP();
    unsigned voffB[2];
#pragma unroll
    for (int i = 0; i < 2; ++i) { int R, C; stage_rc(tid * 16 + i * 8192, R, C); const int Rb = Epi::PERM ? ((R & ~31) + perm32(R & 31)) : R;
        voffB[i] = (unsigned)(Rb * K + C) * 2u; }
    unsigned vaC[2][2];
    PG8_LAS unsigned* vtab = (PG8_LAS unsigned*)(lds + STAGE_BYTES + 1024) + tid;
    const size_t kstep = (size_t)(BK * 2);
    const size_t hstep = (size_t)HALF * K * 2;
    const size_t tstep = 2 * hstep;
    const unsigned ldsw = (unsigned)wid * 1024u;
    const int aoff = lds_byte(wr * 64 + fr, fq * 8), boff = lds_byte(wc * 32 + fr, fq * 8);
#define PG8_SA(b, h) (((b) * 2 + (h)) * HTB)
#define PG8_SB(b, h) ((4 + (b) * 2 + (h)) * HTB)
#define PG8_STAGE(bufoff, gbase, voff) do { _Pragma("unroll") for (int _i = 0; _i < 2; ++_i) \
        __builtin_amdgcn_global_load_lds((const unsigned*)((const char*)(gbase) + (voff)[_i]), (PG8_LAS unsigned*)(lds + (bufoff) + ldsw + _i * 8192), 16, 0, 0); } while (0)
#define PG8_STAGEA(bufoff, kbyte, va) do { _Pragma("unroll") for (int _i = 0; _i < 2; ++_i) \
        __builtin_amdgcn_global_load_lds((const unsigned*)((const char*)g.A + (kbyte) + (va)[_i]), (PG8_LAS unsigned*)(lds + (bufoff) + ldsw + _i * 8192), 16, 0, 0); } while (0)
#define PG8_LDA(dst, b, h) do { _Pragma("unroll") for (int m = 0; m < 4; ++m) _Pragma("unroll") for (int k = 0; k < 2; ++k) dst[m][k] = *(const PG8_LAS bf16x8*)(lds + PG8_SA(b, h) + aoff + m * 2048 + k * 1024); } while (0)
#define PG8_LDB(dst, b, h) do { _Pragma("unroll") for (int n = 0; n < 2; ++n) _Pragma("unroll") for (int k = 0; k < 2; ++k) dst[n][k] = *(const PG8_LAS bf16x8*)(lds + PG8_SB(b, h) + boff + n * 2048 + k * 1024); } while (0)
#define PG8_MMA(ai, bj, At, Bt) do { __builtin_amdgcn_s_setprio(1); _Pragma("unroll") for (int m = 0; m < 4; ++m) _Pragma("unroll") for (int n = 0; n < 2; ++n) _Pragma("unroll") for (int k = 0; k < 2; ++k) \
        acc[ai][bj][m][n] = __builtin_amdgcn_mfma_f32_16x16x32_bf16(Bt[n][k], At[m][k], acc[ai][bj][m][n], 0, 0, 0); __builtin_amdgcn_s_setprio(0); } while (0)
#define PG8_WAIT_V(n) asm volatile("s_waitcnt vmcnt(" #n ")" ::: "memory")
#define PG8_WAIT_L(n) asm volatile("s_waitcnt lgkmcnt(" #n ")" ::: "memory")
#define PG8_BAR __builtin_amdgcn_s_barrier()
#define PG8_SCHED __builtin_amdgcn_sched_barrier(0)
    typename Sched::UnitT cur, nxt; int ui = 0;
    if (!S.next(0, cur)) return;
    f32x4 acc[2][2][4][2];
#pragma unroll
    for (int a = 0; a < 2; ++a)
#pragma unroll
        for (int b = 0; b < 2; ++b)
#pragma unroll
            for (int m = 0; m < 4; ++m)
#pragma unroll
                for (int n = 0; n < 2; ++n) acc[a][b][m][n] = (f32x4){0.f, 0.f, 0.f, 0.f};
    bf16x8 At[4][2], B0[2][2], B1[2][2];
    const char* cB = S.bbase(g, cur); S.a_offsets(g, cur, tid, vaC);
    if constexpr (SP2) {
        PG8_STAGE(PG8_SB(0, 0), cB, voffB); PG8_STAGE(PG8_SB(0, 1), cB + hstep, voffB); PG8_STAGEA(PG8_SA(0, 0), 0, vaC[0]); PG8_STAGEA(PG8_SA(0, 1), 0, vaC[1]);
        if (wr == 1) PG8_BAR;
        PG8_WAIT_V(2); PG8_BAR;
        PG8_STAGE(PG8_SB(1, 0), cB + kstep, voffB); PG8_STAGEA(PG8_SA(1, 0), kstep, vaC[0]); PG8_STAGE(PG8_SB(1, 1), cB + hstep + kstep, voffB);
        PG8_WAIT_V(6); PG8_BAR;
    } else {
    PG8_STAGE(PG8_SB(0, 0), cB, voffB); PG8_STAGEA(PG8_SA(0, 0), 0, vaC[0]); PG8_STAGE(PG8_SB(0, 1), cB + hstep, voffB); PG8_STAGEA(PG8_SA(0, 1), 0, vaC[1]);
    if (wr == 1) PG8_BAR;
    PG8_WAIT_V(4); PG8_BAR;
    PG8_STAGE(PG8_SB(1, 0), cB + kstep, voffB); PG8_STAGEA(PG8_SA(1, 0), kstep, vaC[0]); PG8_STAGE(PG8_SB(1, 1), cB + hstep + kstep, voffB);
    PG8_WAIT_V(6); PG8_BAR;
    }
    PG8_STAMP();
    for (;;) {
        const bool has_next = S.next(ui + 1, nxt);
        const char* nB = has_next ? S.bbase(g, nxt) : cB;
        { unsigned vaN[2][2];
          if (has_next) S.a_offsets(g, nxt, tid, vaN); else {
#pragma unroll
            for (int hf = 0; hf < 2; ++hf)
#pragma unroll
                for (int i = 0; i < 2; ++i) vaN[hf][i] = vaC[hf][i]; }
#pragma unroll
          for (int hf = 0; hf < 2; ++hf)
#pragma unroll
              for (int i = 0; i < 2; ++i) vtab[(hf * 2 + i) * 512] = vaN[hf][i]; }
        unsigned v2[2][2];
        for (int t = 0; t < nt; t += 2) {
            const bool last = (t == nt - 2);
            const size_t k1 = (size_t)(t + 1) * kstep, k2 = last ? (size_t)0 : (size_t)(t + 2) * kstep, k3 = k2 + kstep;
            const char* b2 = last ? nB : cB + (size_t)(t + 2) * kstep; const char* b3 = b2 + kstep;
#pragma unroll
            for (int hf = 0; hf < 2; ++hf)
#pragma unroll
                for (int i = 0; i < 2; ++i) v2[hf][i] = last ? vtab[(hf * 2 + i) * 512] : vaC[hf][i];
            if constexpr (SP2) {
            PG8_LDB(B0, 0, 0); PG8_LDB(B1, 0, 1); PG8_SCHED; PG8_LDA(At, 0, 0); PG8_STAGEA(PG8_SA(1, 1), k1, vaC[1]);
            PG8_WAIT_V(8); PG8_WAIT_L(0); PG8_BAR; PG8_MMA(0, 0, At, B0); PG8_MMA(0, 1, At, B1); PG8_BAR; PG8_SCHED;
            PG8_LDA(At, 0, 1); PG8_STAGE(PG8_SB(0, 0), b2, voffB); PG8_STAGE(PG8_SB(0, 1), b2 + hstep, voffB); PG8_STAGEA(PG8_SA(0, 0), k2, v2[0]);
            PG8_WAIT_V(8); PG8_WAIT_L(0); PG8_BAR; PG8_MMA(1, 0, At, B0); PG8_MMA(1, 1, At, B1); PG8_BAR; PG8_SCHED;
            PG8_LDB(B0, 1, 0); PG8_LDB(B1, 1, 1); PG8_SCHED; PG8_LDA(At, 1, 0); PG8_STAGEA(PG8_SA(0, 1), k2, v2[1]);
            PG8_WAIT_V(8); PG8_WAIT_L(0); PG8_BAR; PG8_MMA(0, 0, At, B0); PG8_MMA(0, 1, At, B1); PG8_BAR; PG8_SCHED;
            PG8_LDA(At, 1, 1); PG8_STAGE(PG8_SB(1, 0), b3, voffB); PG8_STAGE(PG8_SB(1, 1), b3 + hstep, voffB); PG8_STAGEA(PG8_SA(1, 0), k3, v2[0]);
            PG8_WAIT_V(8); PG8_WAIT_L(0); PG8_BAR; PG8_MMA(1, 0, At, B0); PG8_MMA(1, 1, At, B1); PG8_BAR; PG8_SCHED;
            } else {
            PG8_LDB(B0, 0, 0); PG8_SCHED; PG8_LDA(At, 0, 0); PG8_STAGEA(PG8_SA(1, 1), k1, vaC[1]);
            PG8_WAIT_L(8); PG8_BAR; PG8_WAIT_L(0); PG8_MMA(0, 0, At, B0); PG8_BAR; PG8_SCHED;
            PG8_LDB(B1, 0, 1); PG8_STAGE(PG8_SB(0, 0), b2, voffB);
            PG8_BAR; PG8_WAIT_L(0); PG8_MMA(0, 1, At, B1); PG8_BAR;
            PG8_LDA(At, 0, 1); PG8_STAGEA(PG8_SA(0, 0), k2, v2[0]);
            PG8_BAR; PG8_WAIT_L(0); PG8_MMA(1, 0, At, B0); PG8_BAR; PG8_SCHED;
            PG8_STAGE(PG8_SB(0, 1), b2 + hstep, voffB);
            PG8_WAIT_V(6); PG8_BAR; PG8_MMA(1, 1, At, B1); PG8_BAR;
            PG8_LDB(B0, 1, 0); PG8_SCHED; PG8_LDA(At, 1, 0); PG8_STAGEA(PG8_SA(0, 1), k2, v2[1]);
            PG8_WAIT_L(8); PG8_BAR; PG8_WAIT_L(0); PG8_MMA(0, 0, At, B0); PG8_BAR; PG8_SCHED;
            PG8_LDB(B1, 1, 1); PG8_STAGE(PG8_SB(1, 0), b3, voffB);
            PG8_BAR; PG8_WAIT_L(0); PG8_MMA(0, 1, At, B1); PG8_BAR;
            PG8_LDA(At, 1, 1); PG8_STAGEA(PG8_SA(1, 0), k3, v2[0]);
            PG8_BAR; PG8_WAIT_L(0); PG8_MMA(1, 0, At, B0); PG8_BAR; PG8_SCHED;
            PG8_STAGE(PG8_SB(1, 1), b3 + hstep, voffB);
            PG8_WAIT_V(6); PG8_BAR; PG8_MMA(1, 1, At, B1); PG8_BAR;
            }
        }
        PG8_STAMP();
        if (wr == 0) PG8_BAR;
        E(acc, cur, wr, wc, fr, fq);
        PG8_STAMP();
        if (!has_next) break;
#pragma unroll
        for (int a = 0; a < 2; ++a)
#pragma unroll
            for (int b = 0; b < 2; ++b)
#pragma unroll
                for (int m = 0; m < 4; ++m)
#pragma unroll
                    for (int n = 0; n < 2; ++n) acc[a][b][m][n] = (f32x4){0.f, 0.f, 0.f, 0.f};
        cur = nxt; cB = nB; ++ui;
#pragma unroll
        for (int hf = 0; hf < 2; ++hf)
#pragma unroll
            for (int i = 0; i < 2; ++i) vaC[hf][i] = v2[hf][i];
        if (wr == 1) PG8_BAR;
    }
    PG8_WAIT_V(0);
    PG8_BAR;
    PG8_STAMP();
    if (STAMP && wid == 0) { stamps[lane] = lane < nts ? (((unsigned long long)(unsigned)ts_hi << 32) | (unsigned)ts_lo) : 0ull;
        if (lane == 62) stamps[62] = rt_entry; if (lane == 63) stamps[63] = (unsigned long long)wall_clock64(); }
#undef PG8_STAMP
#undef PG8_SA
#undef PG8_SB
#undef PG8_STAGE
#undef PG8_STAGEA
#undef PG8_LDA
#undef PG8_LDB
#undef PG8_MMA
#undef PG8_WAIT_V
#undef PG8_WAIT_L
#undef PG8_BAR
#undef PG8_SCHED
}
}

constexpr int NTHR = 512, NWV = 8, LDS_BYTES = 147456;

struct P {
    const float *x, *c, *ctx, *c_ctx, *w_mod, *b_mod, *norm1_g, *norm2_g, *w_in, *conv_w, *conv_b, *dt_bias_f, *dt_bias_b, *a_log_f, *a_log_b, *d_skip, *ssd_norm_g,
        *gk_up_f, *gk_bias_f, *gk_up_b, *gk_bias_b, *gla_norm_g, *w_out, *w_router, *router_bias, *w_gate, *w_up, *w_down, *final_g;
    float* out; bf16_t* XB; bf16_t* H; bf16_t* PROJ; bf16_t* SS; bf16_t* GS; float* SDEC; float* GDEC; float* MOD; int* counts; int* TOKSLOT; float* EW; int* MAP; bf16_t* WinT; bf16_t* WoutT; bf16_t* WguT; bf16_t* WdT; bf16_t* WRT; unsigned* BAR; bf16_t* XBCC; bf16_t* QKB; float* SSC; float* STOT; float* SSQ; float* XSS;
};

DI void ph_init(const P& p) { const size_t i = (size_t)blockIdx.x * NTHR + ltid(); if (i < 64) p.counts[i * 32] = 0; }

DI void ph_mod(const P& p, float* s  ) {
    const int tid_ = ltid(), lane = tid_ & 63, w = tid_ >> 6;
    if (blockIdx.x >= 192) return;
    float* part = s + 9 * 1024;
    { float cv[18];
#pragma unroll
      for (int q = 0; q < 18; ++q) { const int i = tid_ + q * NTHR, r = i >> 10, k = i & 1023; cv[q] = r < 8 ? p.c[r * 1024 + k] : p.c_ctx[k]; }
#pragma unroll
      for (int q = 0; q < 18; ++q) s[tid_ + q * NTHR] = siluf(cv[q]); }
    __syncthreads();
    for (int vb = blockIdx.x; vb < 192; vb += gridDim.x) {
        const int l = vb / 96, n = (vb % 96) * 64 + lane;
        float acc[9];
#pragma unroll
        for (int r = 0; r < 9; ++r) acc[r] = 0.f;
        const float* wp = p.w_mod + (size_t)l * 1024 * 6144 + (size_t)(128 * w) * 6144 + n;
#pragma unroll 8
        for (int k = 0; k < 128; ++k) { const float wv = wp[(size_t)k * 6144];
#pragma unroll
            for (int r = 0; r < 9; ++r) acc[r] += s[r * 1024 + 128 * w + k] * wv; }
#pragma unroll
        for (int r = 0; r < 9; ++r) part[(w * 9 + r) * 64 + lane] = acc[r];
        __syncthreads();
        for (int o = tid_; o < 9 * 64; o += NTHR) { const int r = o >> 6, c = o & 63; float a = p.b_mod[l * 6144 + (vb % 96) * 64 + c];
#pragma unroll
            for (int q = 0; q < 8; ++q) a += part[(q * 9 + r) * 64 + c];
            p.MOD[((size_t)l * 9 + r) * 6144 + (vb % 96) * 64 + c] = a; }
        __syncthreads();
    }
}

DI unsigned pk2(float lo, float hi) { return __builtin_bit_cast(unsigned, __builtin_convertvector((f32x2v_){lo, hi}, bf16x2v_)); }
DI void transpose_item(const float* W, int K, int N, bf16_t* WT, float* scr, int item, int lane, int gu = -1, const float* kscale = nullptr) {
    const int nblk = (N + 31) / 32, kb = item / nblk, nb = item % nblk, k0 = 64 * kb, n0 = 32 * nb;
    const int d0 = gu < 0 ? n0 : 256 * (n0 >> 7) + (n0 & 127) + 128 * gu;
    const bool nok = n0 + (lane & 31) < N;
    float wv_[32];
#pragma unroll
    for (int i = 0; i < 32; ++i) { const int kk = 2 * i + (lane >> 5); wv_[i] = nok ? __builtin_nontemporal_load(W + (size_t)(k0 + kk) * N + n0 + (lane & 31)) : 0.f; }
#pragma unroll
    for (int i = 0; i < 32; ++i) { const int kk = 2 * i + (lane >> 5); scr[kk * 33 + (lane & 31)] = wv_[i] * (kscale ? kscale[k0 + kk] : 1.0f); }
    const int c = lane & 7;
#pragma unroll
    for (int j = 0; j < 4; ++j) { const int n = (lane >> 3) + 8 * j; const float* q = scr + (8 * c) * 33 + n;
        uint4 o; o.x = pk2(q[0 * 33], q[1 * 33]); o.y = pk2(q[2 * 33], q[3 * 33]); o.z = pk2(q[4 * 33], q[5 * 33]); o.w = pk2(q[6 * 33], q[7 * 33]);
        if (n0 + n < N) { typedef unsigned u32x4nt __attribute__((ext_vector_type(4))); __builtin_nontemporal_store((u32x4nt){o.x, o.y, o.z, o.w}, (u32x4nt*)(WT + (size_t)(d0 + n) * K + k0 + 8 * c)); } }
}

DI void ph_convert_experts(const P& p, int l, float* ldsf, int wk0, int nwk, int it0 = 0, int it1 = NE * 768) {
    const int tid_ = ltid(), lane = tid_ & 63, gw = ((int)blockIdx.x - wk0) * NWV + (tid_ >> 6), NW = nwk * NWV;
    float* scr = ldsf + 14 * 1024 + (tid_ >> 6) * (64 * 33 + 16);
    for (int it = it0 + gw; it < it1; it += NW) {
        const int e = it / 768, r = it - e * 768;
        if (r < 512) { const int gu = r >> 8; const float* W = (gu ? p.w_up : p.w_gate) + (size_t)(l * NE + e) * D * 512;
            transpose_item(W, D, 512, p.WguT + (size_t)e * D * D, scr, r & 255, lane, gu); }
        else transpose_item(p.w_down + (size_t)(l * NE + e) * 512 * D, 512, D, p.WdT + (size_t)e * D * 512, scr, r - 512, lane);
    }
}
constexpr int NPAD_IN = 3072;
DI void ph_convert_small(const P& p, float* ldsf, int, int, int) {
    const int tid_ = ltid(), lane = tid_ & 63, gw = blockIdx.x * NWV + (tid_ >> 6), NW = gridDim.x * NWV;
    float* scr = ldsf + 14 * 1024 + (tid_ >> 6) * (64 * 33 + 16);
    constexpr int I_IN = 16 * 89, I_OUT = 16 * 32;
    for (int it = gw; it < 2 * (I_IN + I_OUT); it += NW) {
        const int l = it / (I_IN + I_OUT), r = it % (I_IN + I_OUT);
        if (r < I_IN) transpose_item(p.w_in + (size_t)l * D * INDIM, D, INDIM, p.WinT + (size_t)l * NPAD_IN * D, scr, r, lane);
        else { const int kb = (r - I_IN) / 32;
            transpose_item(p.w_out + (size_t)l * D * D, D, D, p.WoutT + (size_t)l * D * D, scr, r - I_IN, lane, -1, kb < 8 ? p.ssd_norm_g + l * 512 : nullptr); }
    }
    for (int idx = blockIdx.x * NTHR + tid_; idx < 32 * 1024; idx += gridDim.x * NTHR) { const int e = idx >> 10, k = idx & 1023; p.WRT[idx] = f2bf(p.w_router[k * 32 + e]); }
    const size_t nz16 = (size_t)(NPAD_IN - INDIM) * D * 2 / 16;
    for (size_t i = (size_t)blockIdx.x * NTHR + tid_; i < 2 * nz16; i += (size_t)gridDim.x * NTHR) {
        const size_t l = i / nz16, j = i % nz16;
        ((uint4*)(p.WinT + (l * NPAD_IN + INDIM) * D))[j] = make_uint4(0u, 0u, 0u, 0u);
    }
}

DI void row_normmod(float4 (&v)[4], const float* g, const float* mr, int shift_idx, int scale_idx, int lane) {
    float ss = 0.f;
#pragma unroll
    for (int i = 0; i < 4; ++i) ss += v[i].x * v[i].x + v[i].y * v[i].y + v[i].z * v[i].z + v[i].w * v[i].w;
    ss = wave_sum(ss, lane);
    const float rstd = rsqrtf(ss * (1.0f / D) + 1e-6f);
#pragma unroll
    for (int i = 0; i < 4; ++i) {
        const int c = (i * 64 + lane) * 4;
        const float4 gg = *(const float4*)(g + c), sh = *(const float4*)(mr + shift_idx * 1024 + c), sc = *(const float4*)(mr + scale_idx * 1024 + c);
        v[i].x = v[i].x * rstd * gg.x * (1.f + sc.x) + sh.x; v[i].y = v[i].y * rstd * gg.y * (1.f + sc.y) + sh.y;
        v[i].z = v[i].z * rstd * gg.z * (1.f + sc.z) + sh.z; v[i].w = v[i].w * rstd * gg.w * (1.f + sc.w) + sh.w;
    }
}
DI void row_store_bf16(bf16_t* hrow, float4 (&v)[4], int lane) {
#pragma unroll
    for (int i = 0; i < 4; ++i) { ushort4 o; o.x = f2bf(v[i].x); o.y = f2bf(v[i].y); o.z = f2bf(v[i].z); o.w = f2bf(v[i].w);
        *(ushort4*)(hrow + (i * 64 + lane) * 4) = o; v[i] = make_float4(bf2f(o.x), bf2f(o.y), bf2f(o.z), bf2f(o.w)); }
}

DI void ph_normmod1(const P& p, int l, int, int, int) {
    const int tid_ = ltid(), lane = tid_ & 63, gw = blockIdx.x * NWV + (tid_ >> 6), NW = gridDim.x * NWV;
    const float* MODl = p.MOD + (size_t)l * 9 * 6144;
    for (int t = gw; t < T; t += NW) {
        float4 v[4];
#pragma unroll
        for (int i = 0; i < 4; ++i) v[i] = ((const float4*)(t < TC ? p.ctx + (size_t)t * D : p.x + (size_t)(t - TC) * D))[i * 64 + lane];
        row_normmod(v, p.norm1_g + l * D, MODl + (size_t)tok_modrow(t) * 6144, 0, 1, lane);
        row_store_bf16(p.H + (size_t)t * D, v, lane);
    }
}

typedef short s16x4 __attribute__((ext_vector_type(4)));
typedef short bf16x8v __attribute__((ext_vector_type(8)));
typedef float f32x4v __attribute__((ext_vector_type(4)));
typedef unsigned u32x4v __attribute__((ext_vector_type(4)));
typedef unsigned u32x2v __attribute__((ext_vector_type(2)));
DI u32x4v mk4(unsigned a, unsigned b, unsigned c, unsigned d) { return (u32x4v){a, b, c, d}; }
DI u32x2v mk2(unsigned a, unsigned b) { return (u32x2v){a, b}; }
DI f32x4v mkf4(float a, float b, float c, float d) { return (f32x4v){a, b, c, d}; }
#define LDSP __attribute__((address_space(3)))
constexpr int NCH = 34, NTILE = NB * NCH;
constexpr int LD64 = 72, LD128 = 136;
constexpr float LOG2E = 1.4426950408889634f;

DI int tile_tok0(int tl) { const int b = tl / NCH, cs = tl - b * NCH; return cs < 2 ? b * CTXL + cs * 128 : TC + b * SEQ + (cs - 2) * 128; }
DI f32x4v mfma16(bf16x8v a, bf16x8v b, f32x4v c) { return __builtin_amdgcn_mfma_f32_16x16x32_bf16(a, b, c, 0, 0, 0); }
DI bf16x8v frag_row(LDSP const bf16_t* base, int ld, int r0, int k0, int lane) { return *(LDSP const bf16x8v*)(base + (r0 + (lane & 15)) * ld + k0 + 8 * (lane >> 4)); }
DI bf16x8v frag_row_g(const bf16_t* base, int ld, int r0, int k0, int lane) { return *(const bf16x8v*)(base + (size_t)(r0 + (lane & 15)) * ld + k0 + 8 * (lane >> 4)); }
DI bf16x8v frag_col(LDSP const bf16_t* base, int ld, int r0, int k0, int lane) {
    const int G = lane >> 4, i = lane & 15;
    LDSP const bf16_t* a = base + (k0 + 8 * G + (i >> 2)) * ld + r0 + 4 * (i & 3);
    const s16x4 lo = __builtin_bit_cast(s16x4, __builtin_amdgcn_ds_read_tr16_b64_v4i16((LDSP s16x4*)a));
    const s16x4 hi = __builtin_bit_cast(s16x4, __builtin_amdgcn_ds_read_tr16_b64_v4i16((LDSP s16x4*)(a + 4 * ld)));
    return (bf16x8v){lo[0], lo[1], lo[2], lo[3], hi[0], hi[1], hi[2], hi[3]};
}
DI u32x2v pack4(f32x4v v) { return mk2(pk2(v[0], v[1]), pk2(v[2], v[3])); }
DI void unpack8(u32x4v v, float* o) { o[0] = __uint_as_float(v.x << 16); o[1] = __uint_as_float(v.x & 0xffff0000u); o[2] = __uint_as_float(v.y << 16); o[3] = __uint_as_float(v.y & 0xffff0000u);
    o[4] = __uint_as_float(v.z << 16); o[5] = __uint_as_float(v.z & 0xffff0000u); o[6] = __uint_as_float(v.w << 16); o[7] = __uint_as_float(v.w & 0xffff0000u); }
DI u32x4v pack8(const float* o) { return mk4(pk2(o[0], o[1]), pk2(o[2], o[3]), pk2(o[4], o[5]), pk2(o[6], o[7])); }

DI float fast_logsigmoid(float x) { return -(fmaxf(-x, 0.f) + __logf(1.0f + __expf(-fabsf(x)))); }
DI float fast_softplus(float x) { return fmaxf(x, 0.f) + __logf(1.0f + __expf(-fabsf(x))); }
struct XbcSrc { const bf16_t* base; int ld; };
DI XbcSrc xbc_src(const P& p, int tok0) { XbcSrc r; r.base = p.XBCC + (size_t)tok0 * 768; r.ld = 768; return r; }

DI void prep_conv_item(const P& p, int l, int item, int lane) {
    const int piece = item >> 1, part = item & 1, ch = part * 512 + lane * 8;
    if (ch >= 768) return;
    const int t0 = piece * 32; int lo, hi; bf16_t* dst; int dld;
    if (t0 < TC) { lo = t0 & ~(CTXL - 1); hi = lo + CTXL - 1; } else { lo = TC + ((t0 - TC) & ~63); hi = lo + 63; }
    dst = p.XBCC + ch; dld = 768;
    const bf16_t* src = p.PROJ + OFF_XBC + ch;
    float wgt[5][8], bias[8];
#pragma unroll
    for (int k = 0; k < 5; ++k) { const f32x4v a = *(const f32x4v*)(p.conv_w + l * 5 * 768 + k * 768 + ch), c = *(const f32x4v*)(p.conv_w + l * 5 * 768 + k * 768 + ch + 4);
#pragma unroll
        for (int j = 0; j < 4; ++j) { wgt[k][j] = a[j]; wgt[k][4 + j] = c[j]; } }
    { const f32x4v a = *(const f32x4v*)(p.conv_b + l * 768 + ch), c = *(const f32x4v*)(p.conv_b + l * 768 + ch + 4);
#pragma unroll
      for (int j = 0; j < 4; ++j) { bias[j] = a[j]; bias[4 + j] = c[j]; } }
    const u32x4v zero4 = mk4(0u, 0u, 0u, 0u);
    u32x4v rw[13];
#pragma unroll
    for (int i = 0; i < 5; ++i) { const int tt = t0 - 2 + i; rw[i] = (tt >= lo && tt <= hi) ? *(const u32x4v*)(src + (size_t)tt * LDP) : zero4; }
    for (int s0 = 0; s0 < 32; s0 += 8) {
        const int t = t0 + s0;
#pragma unroll
        for (int i = 0; i < 8; ++i) { const int tt = t + 3 + i; rw[5 + i] = (tt <= hi) ? *(const u32x4v*)(src + (size_t)tt * LDP) : zero4; }
#pragma unroll
        for (int i = 0; i < 8; ++i) {
            float o[8];
#pragma unroll
            for (int c = 0; c < 8; ++c) o[c] = bias[c];
#pragma unroll
            for (int k = 0; k < 5; ++k) { float v[8]; unpack8(rw[i + k], v);
#pragma unroll
                for (int c = 0; c < 8; ++c) o[c] += wgt[k][c] * v[c]; }
#pragma unroll
            for (int c = 0; c < 8; ++c) o[c] = siluf(o[c]);
            *(u32x4v*)(dst + (size_t)(t + i) * dld) = pack8(o);
        }
#pragma unroll
        for (int i = 0; i < 5; ++i) rw[i] = rw[i + 8];
    }
}
DI void prep_ssd_item(const P& p, int l, int item, int lane) {
    const int tl = item >> 3, h = item & 7, tok0 = tile_tok0(tl);
    const float bsf = p.dt_bias_f[l * 8 + h], bsb = p.dt_bias_b[l * 8 + h];
    const float r0 = bf2f(p.PROJ[(size_t)(tok0 + 2 * lane) * LDP + OFF_DT + h]), r1 = bf2f(p.PROJ[(size_t)(tok0 + 2 * lane + 1) * LDP + OFF_DT + h]);
    const float f0 = fast_softplus(r0 + bsf), f1 = fast_softplus(r1 + bsf), b0 = fast_softplus(r0 + bsb), b1 = fast_softplus(r1 + bsb);
    float pf = f0 + f1, sb = b0 + b1;
#pragma unroll
    for (int o = 1; o < 64; o <<= 1) { const float t = shl(pf, lane >= o ? lane - o : lane); if (lane >= o) pf += t; }
#pragma unroll
    for (int o = 1; o < 64; o <<= 1) { const float t = shl(sb, lane + o < 64 ? lane + o : lane); if (lane + o < 64) sb += t; }
    const float Af = -__expf(p.a_log_f[l * 8 + h]) * LOG2E, Ab = -__expf(p.a_log_b[l * 8 + h]) * LOG2E;
    const float af0 = Af * (pf - f1), af1 = Af * pf, ab0 = Ab * sb, ab1 = Ab * (sb - b0);
    f32x4v* dst = (f32x4v*)p.SSC + (size_t)(tok0 + 2 * lane) * 8 + h;
    dst[0] = mkf4(af0, af0 - __log2f(f0), ab0, ab0 - __log2f(b0));
    dst[8] = mkf4(af1, af1 - __log2f(f1), ab1, ab1 - __log2f(b1));
    if (lane == 63) { p.STOT[(tl * 8 + h) * 2 + 0] = af1; p.SDEC[(tl * 8 + h) * 2 + 0] = __builtin_amdgcn_exp2f(af1); }
    if (lane == 0) { p.STOT[(tl * 8 + h) * 2 + 1] = ab0; p.SDEC[(tl * 8 + h) * 2 + 1] = __builtin_amdgcn_exp2f(ab0); }
}
DI void prep_gla_block(const P& p, int l, int tl, int h, LDSP unsigned char* lds) {
    const int tid = ltid(), lane = tid & 63, k = tid >> 3, seg = tid & 7, base = lane & ~7, tok0 = tile_tok0(tl);
    LDSP bf16_t* QT = (LDSP bf16_t*)lds; LDSP bf16_t* KT = QT + 128 * LD64; LDSP bf16_t* O4 = KT + 128 * LD64; LDSP float* GKL = (LDSP float*)(O4 + 4 * 128 * LD64);
    u32x4v qv_[2], kv_[2], vv_[4]; u32x4v gk = mk4(0u, 0u, 0u, 0u);
#pragma unroll
    for (int q = 0; q < 4; ++q) { const int c = tid + q * NTHR, r = c >> 4, cc = c & 15; vv_[q] = *(const u32x4v*)(p.PROJ + (size_t)(tok0 + r) * LDP + OFF_V + h * 128 + cc * 8); }
#pragma unroll
    for (int q = 0; q < 2; ++q) { const int c = tid + q * NTHR, r = c >> 3, cc = c & 7; const bf16_t* pr = p.PROJ + (size_t)(tok0 + r) * LDP;
        qv_[q] = *(const u32x4v*)(pr + OFF_Q + h * 64 + cc * 8); kv_[q] = *(const u32x4v*)(pr + OFF_K + h * 64 + cc * 8); }
    if (tid < 256) gk = *(const u32x4v*)(p.PROJ + (size_t)(tok0 + (tid >> 1)) * LDP + OFF_GK + (tid & 1) * 8);
    float upf[16], upb[16];
#pragma unroll
    for (int r = 0; r < 16; ++r) { upf[r] = p.gk_up_f[l * 16 * 256 + r * 256 + h * 64 + k]; upb[r] = p.gk_up_b[l * 16 * 256 + r * 256 + h * 64 + k]; }
    const float biasf = p.gk_bias_f[l * 256 + h * 64 + k], biasb = p.gk_bias_b[l * 256 + h * 64 + k];
    __syncthreads();
#pragma unroll
    for (int q = 0; q < 2; ++q) { const int c = tid + q * NTHR, r = c >> 3, cc = c & 7; *(LDSP u32x4v*)(QT + r * LD64 + cc * 8) = qv_[q]; *(LDSP u32x4v*)(KT + r * LD64 + cc * 8) = kv_[q]; }
    if (tid < 256) { float v[8]; unpack8(gk, v); LDSP f32x4v* d = (LDSP f32x4v*)(GKL + (tid >> 1) * 20 + (tid & 1) * 8); d[0] = mkf4(v[0], v[1], v[2], v[3]); d[1] = mkf4(v[4], v[5], v[6], v[7]); }
    __syncthreads();
    float gf[16], gb[16];
#pragma unroll
    for (int s = 0; s < 16; ++s) { LDSP const f32x4v* gl = (LDSP const f32x4v*)(GKL + (8 * s + seg) * 20)  ; float af = biasf, ab = biasb;
#pragma unroll
        for (int q = 0; q < 4; ++q) { const f32x4v v = gl[q];
#pragma unroll
            for (int j = 0; j < 4; ++j) { af += v[j] * upf[4 * q + j]; ab += v[j] * upb[4 * q + j]; } }
        gf[s] = fast_logsigmoid(af) * (1.0f / 16.0f); gb[s] = fast_logsigmoid(ab) * (1.0f / 16.0f); }
    float totf = 0.f, totb = 0.f;
#pragma unroll
    for (int s = 0; s < 16; ++s) { float x = gf[s];
        float t = shl(x, lane - 1); if (seg >= 1) x += t; t = shl(x, lane - 2); if (seg >= 2) x += t; t = shl(x, lane - 4); if (seg >= 4) x += t;
        gf[s] = totf + x; totf += shl(x, base + 7); }
#pragma unroll
    for (int s = 15; s >= 0; --s) { float x = gb[s];
        float t = shl(x, lane + 1); if (seg <= 6) x += t; t = shl(x, lane + 2); if (seg <= 5) x += t; t = shl(x, lane + 4); if (seg <= 3) x += t;
        gb[s] = totb + x; totb += shl(x, base); }
#pragma unroll
    for (int s = 0; s < 16; ++s) { const int j = 8 * s + seg; const float qv = bf2f(QT[j * LD64 + k]) * 0.125f, kv = bf2f(KT[j * LD64 + k]);
        const float bf = gf[s], bb = gb[s]; LDSP bf16_t* o = O4 + j * LD64 + k;
        o[0] = f2bf(qv * __expf(bf)); o[128 * LD64] = f2bf(kv * __expf(-bf)); o[2 * 128 * LD64] = f2bf(qv * __expf(bb)); o[3 * 128 * LD64] = f2bf(kv * __expf(-bb)); }
    LDSP float* DEC = GKL;
    __syncthreads();
    if (seg == 0) { const float df = __expf(totf), db = __expf(totb); p.GDEC[(size_t)((tl * 4 + h) * 2 + 0) * 64 + k] = df; p.GDEC[(size_t)((tl * 4 + h) * 2 + 1) * 64 + k] = db; DEC[k] = df; DEC[64 + k] = db; }
    LDSP bf16_t* VT = QT;
#pragma unroll
    for (int q = 0; q < 4; ++q) { const int c = tid + q * NTHR, r = c >> 4, cc = c & 15; *(LDSP u32x4v*)(VT + r * LD128 + cc * 8) = vv_[q]; }
#pragma unroll
    for (int q = 0; q < 8; ++q) { const int c = tid + q * NTHR, a4 = c >> 10, r = (c >> 3) & 127, cc = c & 7;
        *(u32x4v*)(p.QKB + (size_t)(tok0 + r) * 1024 + a4 * 256 + h * 64 + cc * 8) = *(LDSP const u32x4v*)(O4 + (a4 * 128 + r) * LD64 + cc * 8); }
    __syncthreads();
    { const int w = __builtin_amdgcn_readfirstlane(tid >> 6), dir = w >> 2, ut = w & 3; LDSP const bf16_t* KE = O4 + (dir ? 3 : 1) * 128 * LD64;
      f32x4v acc[8];
#pragma unroll
      for (int q = 0; q < 8; ++q) acc[q] = (f32x4v){0.f, 0.f, 0.f, 0.f};
#pragma unroll
      for (int ks = 0; ks < 4; ++ks) { const bf16x8v u = frag_col(KE, LD64, 16 * ut, 32 * ks, lane);
#pragma unroll
          for (int q = 0; q < 8; ++q) acc[q] = mfma16(u, frag_col(VT, LD128, 16 * q, 32 * ks, lane), acc[q]); }
      const f32x4v dec = *(LDSP const f32x4v*)(DEC + dir * 64 + 16 * ut + 4 * (lane >> 4));
      bf16_t* dst = p.GS + ((size_t)((tl * 4 + h) * 2 + dir) * 128) * 64;
#pragma unroll
      for (int q = 0; q < 8; ++q) *(u32x2v*)(dst + (size_t)(16 * q + (lane & 15)) * 64 + 16 * ut + 4 * (lane >> 4)) = pack4(acc[q] * dec); }
}
constexpr int NPREP_A = (T / 32) * 2, NPREP_B = NTILE * 8;
DI void ph_prep(const P& p, int l, LDSP unsigned char* lds) {
    const int tid_ = ltid(), lane = tid_ & 63, gw = blockIdx.x * NWV + (tid_ >> 6), NW = gridDim.x * NWV;
    for (int it = gw; it < NPREP_A + NPREP_B; it += NW) {
        if (it < NPREP_A) prep_conv_item(p, l, it, lane); else prep_ssd_item(p, l, it - NPREP_A, lane);
    }
    for (int it = blockIdx.x; it < NTILE * 4; it += gridDim.x) prep_gla_block(p, l, it >> 2, it & 3, lds);
}

DI void s1_ssd(const P& p, int tl, int h, LDSP unsigned char* lds) {
    const int tid = ltid(), lane = tid & 63, w = __builtin_amdgcn_readfirstlane(tid >> 6);
    const int tok0 = tile_tok0(tl), g = h >> 2; const XbcSrc xs = xbc_src(p, tok0);
    LDSP bf16_t* XWF = (LDSP bf16_t*)lds; LDSP bf16_t* XWB = XWF + 128 * LD64; LDSP bf16_t* BG = XWB + 128 * LD64;
    const int j = tid >> 2, cq = tid & 3;
    const bf16_t* row = xs.base + (size_t)j * xs.ld;
    const u32x4v x0 = *(const u32x4v*)(row + h * 64 + cq * 16), x1 = *(const u32x4v*)(row + h * 64 + cq * 16 + 8);
    const u32x4v b0 = *(const u32x4v*)(row + 512 + g * 64 + cq * 16), b1 = *(const u32x4v*)(row + 512 + g * 64 + cq * 16 + 8);
    const f32x4v sc = *((const f32x4v*)p.SSC + (size_t)(tok0 + j) * 8 + h);
    const float wf = __builtin_amdgcn_exp2f(p.STOT[(tl * 8 + h) * 2 + 0] - sc.y), wb = __builtin_amdgcn_exp2f(p.STOT[(tl * 8 + h) * 2 + 1] - sc.w);
    float xv[16], of[16], ob[16]; unpack8(x0, xv); unpack8(x1, xv + 8);
#pragma unroll
    for (int c = 0; c < 16; ++c) { of[c] = xv[c] * wf; ob[c] = xv[c] * wb; }
    __syncthreads();
    *(LDSP u32x4v*)(XWF + j * LD64 + cq * 16) = pack8(of); *(LDSP u32x4v*)(XWF + j * LD64 + cq * 16 + 8) = pack8(of + 8);
    *(LDSP u32x4v*)(XWB + j * LD64 + cq * 16) = pack8(ob); *(LDSP u32x4v*)(XWB + j * LD64 + cq * 16 + 8) = pack8(ob + 8);
    *(LDSP u32x4v*)(BG + j * LD64 + cq * 16) = b0; *(LDSP u32x4v*)(BG + j * LD64 + cq * 16 + 8) = b1;
    __syncthreads();
    const int dir = w >> 2, ut = w & 3; LDSP const bf16_t* XW = dir ? XWB : XWF;
    f32x4v acc[4];
#pragma unroll
    for (int q = 0; q < 4; ++q) acc[q] = (f32x4v){0.f, 0.f, 0.f, 0.f};
#pragma unroll
    for (int ks = 0; ks < 4; ++ks) { const bf16x8v u = frag_col(BG, LD64, 16 * ut, 32 * ks, lane);
#pragma unroll
        for (int q = 0; q < 4; ++q) acc[q] = mfma16(u, frag_col(XW, LD64, 16 * q, 32 * ks, lane), acc[q]); }
    bf16_t* dst = p.SS + ((size_t)((tl * 8 + h) * 2 + dir) * 64) * 64;
#pragma unroll
    for (int q = 0; q < 4; ++q) *(u32x2v*)(dst + (size_t)(16 * q + (lane & 15)) * 64 + 16 * ut + 4 * (lane >> 4)) = pack4(acc[q]);
}
DI void ph_s1(const P& p, int l, LDSP unsigned char* lds) {
    for (int it = blockIdx.x; it < NTILE * 8; it += gridDim.x) s1_ssd(p, it >> 3, it & 7, lds);
}

DI int s2_chunk(int dir, int s) { return dir == 0 ? s : (s < 2 ? 1 - s : 35 - s); }
DI void ph_s2(const P& p) {
    const int g = blockIdx.x * NTHR + ltid();
    for (int v = g; v < 131072; v += gridDim.x * NTHR) {
        const bool gla = v >= 65536; const int r = v & 65535;
        int b, h, dir, vi;
        if (!gla) { vi = r & 511; dir = (r >> 9) & 1; h = (r >> 10) & 7; b = r >> 13; } else { vi = r & 1023; dir = (r >> 10) & 1; h = (r >> 11) & 3; b = r >> 13; }
        float st[8];
#pragma unroll
        for (int e = 0; e < 8; ++e) st[e] = 0.f;
        for (int s0 = 0; s0 < NCH; s0 += 6) {
            u32x4v sv[6]; float dsc[6]; f32x4v dv0[6], dv1[6];
#pragma unroll
            for (int u = 0; u < 6; ++u) { if (s0 + u >= NCH) continue; const int tl = b * NCH + s2_chunk(dir, s0 + u);
                if (!gla) { sv[u] = *(const u32x4v*)(p.SS + ((size_t)((tl * 8 + h) * 2 + dir) * 512 + vi) * 8); dsc[u] = p.SDEC[(tl * 8 + h) * 2 + dir]; }
                else { sv[u] = *(const u32x4v*)(p.GS + ((size_t)((tl * 4 + h) * 2 + dir) * 1024 + vi) * 8); const f32x4v* d = (const f32x4v*)(p.GDEC + (size_t)((tl * 4 + h) * 2 + dir) * 64 + (vi & 7) * 8); dv0[u] = d[0]; dv1[u] = d[1]; } }
#pragma unroll
            for (int u = 0; u < 6; ++u) { if (s0 + u >= NCH) continue; const int tl = b * NCH + s2_chunk(dir, s0 + u);
                float loc[8]; unpack8(sv[u], loc);
                const u32x4v hin = pack8(st);
                if (!gla) { *(u32x4v*)(p.SS + ((size_t)((tl * 8 + h) * 2 + dir) * 512 + vi) * 8) = hin;
#pragma unroll
                    for (int e = 0; e < 8; ++e) st[e] = dsc[u] * st[e] + loc[e]; }
                else { *(u32x4v*)(p.GS + ((size_t)((tl * 4 + h) * 2 + dir) * 1024 + vi) * 8) = hin;
                    const float dd[8] = {dv0[u].x, dv0[u].y, dv0[u].z, dv0[u].w, dv1[u].x, dv1[u].y, dv1[u].z, dv1[u].w};
#pragma unroll
                    for (int e = 0; e < 8; ++e) st[e] = dd[e] * st[e] + loc[e]; } }
        }
    }
}

DI int s3_tile(int l, int q) { return l == 0 ? q : (q >> 5) * NCH + 2 + (q & 31); }
struct SsdPre { u32x4v x0, x1, b0, b1, c0, c1, hf, hb; f32x4v sc; };
DI void s3_ssd_load(const P& p, int tl, int h, int tid, int i, int G, SsdPre& r) {
    const int tok0 = tile_tok0(tl), g = h >> 2; const XbcSrc xs = xbc_src(p, tok0);
    const int j = tid >> 2, cq = tid & 3; const bf16_t* row = xs.base + (size_t)j * xs.ld;
    r.x0 = *(const u32x4v*)(row + h * 64 + cq * 16); r.x1 = *(const u32x4v*)(row + h * 64 + cq * 16 + 8);
    r.b0 = *(const u32x4v*)(row + 512 + g * 64 + cq * 16); r.b1 = *(const u32x4v*)(row + 512 + g * 64 + cq * 16 + 8);
    r.c0 = *(const u32x4v*)(row + 640 + g * 64 + cq * 16); r.c1 = *(const u32x4v*)(row + 640 + g * 64 + cq * 16 + 8);
    const bf16_t* Hf = p.SS + (size_t)((tl * 8 + h) * 2 + 0) * 4096 + (tid >> 3) * 64 + (tid & 7) * 8;
    r.hf = *(const u32x4v*)Hf; r.hb = *(const u32x4v*)(Hf + 4096);
    r.sc = *((const f32x4v*)p.SSC + (size_t)(tok0 + (tid & 127)) * 8 + h);
}
DI void ph_s3_ssd(const P& p, int l, LDSP unsigned char* lds) {
    const int tid = ltid(), lane = tid & 63, w = __builtin_amdgcn_readfirstlane(tid >> 6), G = lane >> 4, li = lane & 15, i = 16 * w + li;
    LDSP bf16_t* XH = (LDSP bf16_t*)lds; LDSP bf16_t* BG = XH + 128 * LD64; LDSP bf16_t* CG = BG + 128 * LD64; LDSP bf16_t* MM = CG + 128 * LD64; LDSP f32x4v* SC = (LDSP f32x4v*)(MM + 128 * LD128);
    LDSP bf16_t* HF = (LDSP bf16_t*)(SC + 128); LDSP bf16_t* HB = HF + 64 * LD64;
    const int nit = (l == 0 ? NTILE : NB * 32) * 8, GS_ = gridDim.x;
    int it = ((int)blockIdx.x + (GS_ >> 1)) % GS_; SsdPre pre;
    if (it < nit) s3_ssd_load(p, s3_tile(l, it >> 3), it & 7, tid, i, G, pre);
    for (; it < nit; it += GS_) {
        const int tl = s3_tile(l, it >> 3), h = it & 7, tok0 = tile_tok0(tl);
        __syncthreads();
        { const int j = tid >> 2, cq = tid & 3;
          *(LDSP u32x4v*)(XH + j * LD64 + cq * 16) = pre.x0; *(LDSP u32x4v*)(XH + j * LD64 + cq * 16 + 8) = pre.x1;
          *(LDSP u32x4v*)(BG + j * LD64 + cq * 16) = pre.b0; *(LDSP u32x4v*)(BG + j * LD64 + cq * 16 + 8) = pre.b1;
          *(LDSP u32x4v*)(CG + j * LD64 + cq * 16) = pre.c0; *(LDSP u32x4v*)(CG + j * LD64 + cq * 16 + 8) = pre.c1;
          *(LDSP u32x4v*)(HF + (tid >> 3) * LD64 + (tid & 7) * 8) = pre.hf; *(LDSP u32x4v*)(HB + (tid >> 3) * LD64 + (tid & 7) * 8) = pre.hb;
          if (tid < 128) SC[tid] = pre.sc; }
        if (it + GS_ < nit) s3_ssd_load(p, s3_tile(l, (it + GS_) >> 3), (it + GS_) & 7, tid, i, G, pre);
        __syncthreads();
        u32x2v zr[4];
#pragma unroll
        for (int pt = 0; pt < 4; ++pt) zr[pt] = *(const u32x2v*)(p.PROJ + (size_t)(tok0 + i) * LDP + OFF_Z + h * 64 + 16 * pt + 4 * G);
        const f32x4v sci = SC[i];
        {
            f32x4v am[8];
#pragma unroll
            for (int ut = 0; ut < 8; ++ut) am[ut] = (f32x4v){0.f, 0.f, 0.f, 0.f};
#pragma unroll
            for (int ks = 0; ks < 2; ++ks) { const bf16x8v vfr = frag_row(CG, LD64, 16 * w, 32 * ks, lane);
#pragma unroll
                for (int ut = 0; ut < 8; ++ut) am[ut] = mfma16(frag_row(BG, LD64, 16 * ut, 32 * ks, lane), vfr, am[ut]); }
#pragma unroll
            for (int ut = 0; ut < 8; ++ut) { f32x4v m;
#pragma unroll
                for (int r = 0; r < 4; ++r) { const int jj = 16 * ut + 4 * G + r; const f32x4v scj = SC[jj];
                    const float Lf = jj <= i ? __builtin_amdgcn_exp2f(fminf(sci.x - scj.y, 30.f)) : 0.f, Lb = jj >= i ? __builtin_amdgcn_exp2f(fminf(sci.z - scj.w, 30.f)) : 0.f;
                    m[r] = am[ut][r] * (Lf + Lb); }
                *(LDSP u32x2v*)(MM + i * LD128 + 16 * ut + 4 * G) = pack4(m); }
        }
        asm volatile("s_waitcnt lgkmcnt(0)" ::: "memory");
        f32x4v ay[4], af_[4], ab_[4];
#pragma unroll
        for (int pt = 0; pt < 4; ++pt) { ay[pt] = (f32x4v){0.f, 0.f, 0.f, 0.f}; af_[pt] = ay[pt]; ab_[pt] = ay[pt]; }
#pragma unroll
        for (int ks = 0; ks < 2; ++ks) { const bf16x8v vfr = frag_row(CG, LD64, 16 * w, 32 * ks, lane);
#pragma unroll
            for (int pt = 0; pt < 4; ++pt) { af_[pt] = mfma16(frag_row(HF, LD64, 16 * pt, 32 * ks, lane), vfr, af_[pt]); ab_[pt] = mfma16(frag_row(HB, LD64, 16 * pt, 32 * ks, lane), vfr, ab_[pt]); } }
#pragma unroll
        for (int ks = 0; ks < 4; ++ks) { const bf16x8v vfr = frag_row(MM, LD128, 16 * w, 32 * ks, lane);
#pragma unroll
            for (int pt = 0; pt < 4; ++pt) ay[pt] = mfma16(frag_col(XH, LD64, 16 * pt, 32 * ks, lane), vfr, ay[pt]); }
        const float sf = __builtin_amdgcn_exp2f(sci.x), sb = __builtin_amdgcn_exp2f(sci.z), dsk = p.d_skip[l * 8 + h];
        float ssq = 0.f;
#pragma unroll
        for (int pt = 0; pt < 4; ++pt) { const int pc = 16 * pt + 4 * G;
            const u32x2v xr = *(LDSP const u32x2v*)(XH + i * LD64 + pc);
            const float xv[4] = {__uint_as_float(xr.x << 16), __uint_as_float(xr.x & 0xffff0000u), __uint_as_float(xr.y << 16), __uint_as_float(xr.y & 0xffff0000u)};
            const float zv[4] = {__uint_as_float(zr[pt].x << 16), __uint_as_float(zr[pt].x & 0xffff0000u), __uint_as_float(zr[pt].y << 16), __uint_as_float(zr[pt].y & 0xffff0000u)};
            float yv[4];
#pragma unroll
            for (int r = 0; r < 4; ++r) { yv[r] = (ay[pt][r] + sf * af_[pt][r] + sb * ab_[pt][r] + dsk * xv[r]) * siluf(zv[r]); yv[r] = bf2f(f2bf(yv[r])); ssq += yv[r] * yv[r]; }
            *(u32x2v*)(p.H + (size_t)(tok0 + i) * D + h * 64 + pc) = mk2(pk2(yv[0], yv[1]), pk2(yv[2], yv[3])); }
        ssq += shx(ssq, 16, lane); ssq += shx(ssq, 32, lane);
        if (G == 0) p.SSQ[(size_t)(tok0 + i) * 8 + h] = ssq;
    }
}
struct GlaPre { u32x4v qk[2][4], vv[4], sf[2], sb[2]; };
DI void s3_gla_load(const P& p, int tl, int h, int tid, int i, int G, GlaPre& r) {
    const int tok0 = tile_tok0(tl);
#pragma unroll
    for (int q = 0; q < 2; ++q) { const int c = tid + q * NTHR, rr = c >> 3, cc = c & 7; const bf16_t* qb = p.QKB + (size_t)(tok0 + rr) * 1024 + h * 64 + cc * 8;
        r.qk[q][0] = *(const u32x4v*)qb; r.qk[q][1] = *(const u32x4v*)(qb + 256);
        r.qk[q][2] = *(const u32x4v*)(qb + 512); r.qk[q][3] = *(const u32x4v*)(qb + 768);
        const bf16_t* Sg = p.GS + (size_t)((tl * 4 + h) * 2 + 0) * 8192 + (size_t)rr * 64 + cc * 8; r.sf[q] = *(const u32x4v*)Sg; r.sb[q] = *(const u32x4v*)(Sg + 8192); }
#pragma unroll
    for (int q = 0; q < 4; ++q) { const int c = tid + q * NTHR, rr = c >> 4, cc = c & 15; r.vv[q] = *(const u32x4v*)(p.PROJ + (size_t)(tok0 + rr) * LDP + OFF_V + h * 128 + cc * 8); }
}
DI void ph_s3_gla(const P& p, int l, LDSP unsigned char* lds) {
    const int tid = ltid(), lane = tid & 63, w = __builtin_amdgcn_readfirstlane(tid >> 6), G = lane >> 4, li = lane & 15, i = 16 * w + li;
    LDSP bf16_t* Q2 = (LDSP bf16_t*)lds;
    LDSP bf16_t* KF = Q2 + 8 * 2 * 16 * LD64; LDSP bf16_t* KB = KF + 128 * LD64; LDSP bf16_t* VT = KB + 128 * LD64; LDSP bf16_t* SF = VT + 128 * LD128; LDSP bf16_t* SB = SF + 128 * LD64;
    LDSP bf16_t* AMw = SF + w * 16 * LD128;
    const int nit = (l == 0 ? NTILE : NB * 32) * 4, GS_ = gridDim.x;
    int it = blockIdx.x; GlaPre pre;
    if (it < nit) s3_gla_load(p, s3_tile(l, it >> 2), it & 3, tid, i, G, pre);
    for (; it < nit; it += GS_) {
        const int tl = s3_tile(l, it >> 2), h = it & 3, tok0 = tile_tok0(tl);
        __syncthreads();
#pragma unroll
        for (int q = 0; q < 2; ++q) { const int c = tid + q * NTHR, rr = c >> 3, cc = c & 7; LDSP bf16_t* qrow = Q2 + (rr >> 4) * (2 * 16 * LD64) + (rr & 15) * LD64 + cc * 8;
            *(LDSP u32x4v*)qrow = pre.qk[q][0]; *(LDSP u32x4v*)(qrow + 16 * LD64) = pre.qk[q][2];
            *(LDSP u32x4v*)(KF + rr * LD64 + cc * 8) = pre.qk[q][1]; *(LDSP u32x4v*)(KB + rr * LD64 + cc * 8) = pre.qk[q][3];
            *(LDSP u32x4v*)(SF + rr * LD64 + cc * 8) = pre.sf[q]; *(LDSP u32x4v*)(SB + rr * LD64 + cc * 8) = pre.sb[q]; }
#pragma unroll
        for (int q = 0; q < 4; ++q) { const int c = tid + q * NTHR, rr = c >> 4, cc = c & 15; *(LDSP u32x4v*)(VT + rr * LD128 + cc * 8) = pre.vv[q]; }
        if (it + GS_ < nit) s3_gla_load(p, s3_tile(l, (it + GS_) >> 2), (it + GS_) & 3, tid, i, G, pre);
        __syncthreads();
        f32x4v ao[8];
#pragma unroll
        for (int q = 0; q < 8; ++q) ao[q] = (f32x4v){0.f, 0.f, 0.f, 0.f};
#pragma unroll
        for (int dir = 0; dir < 2; ++dir) {
            LDSP const bf16_t* QSw = Q2 + w * (2 * 16 * LD64) + dir * 16 * LD64; LDSP const bf16_t* SS_ = dir ? SB : SF;
#pragma unroll
            for (int ks = 0; ks < 2; ++ks) { const bf16x8v vfr = frag_row(QSw, LD64, 0, 32 * ks, lane);
#pragma unroll
                for (int vt = 0; vt < 8; ++vt) ao[vt] = mfma16(frag_row(SS_, LD64, 16 * vt, 32 * ks, lane), vfr, ao[vt]); }
        }
        __syncthreads();
#pragma unroll
        for (int uh = 0; uh < 4; ++uh) {
            f32x4v a2[2]; a2[0] = (f32x4v){0.f, 0.f, 0.f, 0.f}; a2[1] = a2[0];
#pragma unroll
            for (int dir = 0; dir < 2; ++dir) {
                LDSP const bf16_t* QSw = Q2 + w * (2 * 16 * LD64) + dir * 16 * LD64; LDSP const bf16_t* KS = dir ? KB : KF;
                f32x4v as[2]; as[0] = (f32x4v){0.f, 0.f, 0.f, 0.f}; as[1] = as[0];
#pragma unroll
                for (int ks = 0; ks < 2; ++ks) { const bf16x8v vfr = frag_row(QSw, LD64, 0, 32 * ks, lane);
#pragma unroll
                    for (int q = 0; q < 2; ++q) as[q] = mfma16(frag_row(KS, LD64, 16 * (2 * uh + q), 32 * ks, lane), vfr, as[q]); }
#pragma unroll
                for (int q = 0; q < 2; ++q)
#pragma unroll
                    for (int r = 0; r < 4; ++r) { const int jj = 16 * (2 * uh + q) + 4 * G + r; const bool keep = dir == 0 ? (jj <= i) : (jj >= i); a2[q][r] += keep ? as[q][r] : 0.f; }
            }
#pragma unroll
            for (int q = 0; q < 2; ++q) *(LDSP u32x2v*)(AMw + li * LD128 + 16 * (2 * uh + q) + 4 * G) = pack4(a2[q]);
        }
        u32x2v gr[8];
#pragma unroll
        for (int vt = 0; vt < 8; ++vt) gr[vt] = *(const u32x2v*)(p.PROJ + (size_t)(tok0 + i) * LDP + OFF_GO + h * 128 + 16 * vt + 4 * G);
        asm volatile("s_waitcnt lgkmcnt(0)" ::: "memory");
#pragma unroll
        for (int ks = 0; ks < 4; ++ks) { const bf16x8v vfr = frag_row(AMw, LD128, 0, 32 * ks, lane);
#pragma unroll
            for (int vt = 0; vt < 8; ++vt) ao[vt] = mfma16(frag_col(VT, LD128, 16 * vt, 32 * ks, lane), vfr, ao[vt]); }
        float so = 0.f;
#pragma unroll
        for (int vt = 0; vt < 8; ++vt)
#pragma unroll
            for (int r = 0; r < 4; ++r) so += ao[vt][r] * ao[vt][r];
        so += shx(so, 16, lane); so += shx(so, 32, lane);
        const float ro = rsqrtf(so * (1.0f / 128.0f) + 1e-6f);
#pragma unroll
        for (int vt = 0; vt < 8; ++vt) { const int vc = 16 * vt + 4 * G; const f32x4v gg = *(const f32x4v*)(p.gla_norm_g + l * 128 + vc);
            const float g0 = __uint_as_float(gr[vt].x << 16), g1 = __uint_as_float(gr[vt].x & 0xffff0000u), g2 = __uint_as_float(gr[vt].y << 16), g3 = __uint_as_float(gr[vt].y & 0xffff0000u);
            *(u32x2v*)(p.H + (size_t)(tok0 + i) * D + 512 + h * 128 + vc) = mk2(pk2(ao[vt][0] * ro * gg.x * siluf(g0), ao[vt][1] * ro * gg.y * siluf(g1)), pk2(ao[vt][2] * ro * gg.z * siluf(g2), ao[vt][3] * ro * gg.w * siluf(g3))); }
    }
}
DI void ph_s3(const P& p, int l, LDSP unsigned char* lds) { ph_s3_gla(p, l, lds); ph_s3_ssd(p, l, lds); }
DI void ph_normroute(const P& p, int l, int t0, LDSP unsigned char* lds) {
    const int tid_ = ltid(), lane = tid_ & 63, wv = tid_ >> 6, gw = blockIdx.x * NWV + wv, NW = gridDim.x * NWV, G = lane >> 4, li = lane & 15;
    const float* MODl = p.MOD + (size_t)l * 9 * 6144; int* counts = p.counts + l * 32 * 32;
    constexpr int LDW = 1032, LDT = 264;
    LDSP bf16_t* WR = (LDSP bf16_t*)lds;
    LDSP bf16_t* HT = WR + 32 * LDW + wv * 16 * LDT;
    { u32x4v wv_[8];
#pragma unroll
      for (int q = 0; q < 8; ++q) wv_[q] = *(const u32x4v*)(p.WRT + (size_t)(tid_ + q * NTHR) * 8);
#pragma unroll
      for (int q = 0; q < 8; ++q) { const int c = tid_ + q * NTHR; *(LDSP u32x4v*)(WR + (c >> 7) * LDW + (c & 127) * 8) = wv_[q]; } }
    __syncthreads();
    const int ntile = (T - t0) >> 4;
    const float* g2 = p.norm2_g + l * D;
    for (int tile = gw; tile < ntile; tile += NW) {
        const int tb = t0 + tile * 16;
        const float* mr = MODl + (size_t)tok_modrow(tb) * 6144;
        float rs[16];
        { const f32x4v* q = (const f32x4v*)(p.XSS + (size_t)(tb + li) * 16); const f32x4v a = q[0], b = q[1], c = q[2], d = q[3];
          const float ss = (((a.x + a.y) + (a.z + a.w)) + ((b.x + b.y) + (b.z + b.w))) + (((c.x + c.y) + (c.z + c.w)) + ((d.x + d.y) + (d.z + d.w)));
          const float r = rsqrtf(ss * (1.0f / D) + 1e-6f);
#pragma unroll
          for (int i = 0; i < 16; ++i) rs[i] = shl(r, i); }
        f32x4v acc[2]; acc[0] = (f32x4v){0.f, 0.f, 0.f, 0.f}; acc[1] = acc[0];
        u32x2v xq[16];
#pragma unroll
        for (int i = 0; i < 16; ++i) xq[i] = *(const u32x2v*)(xrow(p, tb + i) + lane * 4);
#pragma unroll
        for (int kc = 0; kc < 4; ++kc) {
            const int kk = kc * 256 + lane * 4;
            const f32x4v gg = *(const f32x4v*)(g2 + kk), sh = *(const f32x4v*)(mr + 3 * 1024 + kk), sc = *(const f32x4v*)(mr + 4 * 1024 + kk);
            f32x4v gs;
#pragma unroll
            for (int j = 0; j < 4; ++j) gs[j] = gg[j] * (1.f + sc[j]);
#pragma unroll
            for (int i = 0; i < 16; ++i) { const u32x2v r = xq[i];
                const f32x4v xv = mkf4(__uint_as_float(r.x << 16), __uint_as_float(r.x & 0xffff0000u), __uint_as_float(r.y << 16), __uint_as_float(r.y & 0xffff0000u));
                const f32x4v h = xv * rs[i] * gs + sh; const u32x2v hb = pack4(h);
                *(u32x2v*)(p.H + (size_t)(tb + i) * D + kk) = hb; *(LDSP u32x2v*)(HT + i * LDT + lane * 4) = hb; }
            if (kc < 3) {
#pragma unroll
                for (int i = 0; i < 16; ++i) xq[i] = *(const u32x2v*)(xrow(p, tb + i) + kk + 256); }
            asm volatile("s_waitcnt lgkmcnt(0)" ::: "memory");
#pragma unroll
            for (int ks = 0; ks < 8; ++ks) { const bf16x8v vfr = frag_row(HT, LDT, 0, 32 * ks, lane);
                acc[0] = mfma16(frag_row(WR, LDW, 0, kc * 256 + 32 * ks, lane), vfr, acc[0]);
                acc[1] = mfma16(frag_row(WR, LDW, 16, kc * 256 + 32 * ks, lane), vfr, acc[1]); }
            asm volatile("s_waitcnt lgkmcnt(0)" ::: "memory");
        }
        float bgs = -1e30f; int bgi = 0, e1 = 0, e2 = 0; float w1 = 0.f, w2 = 0.f;
#pragma unroll
        for (int ut = 0; ut < 2; ++ut) { const int gi = ut * 4 + G; float m1 = -1e30f, m2 = -1e30f, s1 = 0.f, s2 = 0.f; int i1 = 0, i2 = 0;
#pragma unroll
            for (int r = 0; r < 4; ++r) { const float sv = 1.0f / (1.0f + __expf(-acc[ut][r])), vv = sv + p.router_bias[gi * 4 + r];
                if (vv > m1) { m2 = m1; i2 = i1; s2 = s1; m1 = vv; i1 = gi * 4 + r; s1 = sv; } else if (vv > m2) { m2 = vv; i2 = gi * 4 + r; s2 = sv; } }
            if (m1 + m2 > bgs) { bgs = m1 + m2; bgi = gi; e1 = i1; e2 = i2; w1 = s1; w2 = s2; } }
#pragma unroll
        for (int o = 16; o <= 32; o <<= 1) {
            const float ogs = shx(bgs, o, lane), ow1 = shx(w1, o, lane), ow2 = shx(w2, o, lane); const int ogi = shxi(bgi, o, lane), oe1 = shxi(e1, o, lane), oe2 = shxi(e2, o, lane);
            if (ogs > bgs || (ogs == bgs && ogi < bgi)) { bgs = ogs; bgi = ogi; e1 = oe1; e2 = oe2; w1 = ow1; w2 = ow2; } }
        if (G == 0) {
            const int t = tb + li; const float inv = 1.0f / (w1 + w2);
            const int r1 = atomicAdd(&counts[e1 * 32], 1), r2 = atomicAdd(&counts[e2 * 32], 1);
            p.MAP[(size_t)e1 * T + r1] = t; p.MAP[(size_t)e2 * T + r2] = t;
            p.TOKSLOT[t * 4 + 0] = e1; p.TOKSLOT[t * 4 + 1] = r1; p.TOKSLOT[t * 4 + 2] = e2; p.TOKSLOT[t * 4 + 3] = r2;
            p.EW[t * 2 + 0] = w1 * inv; p.EW[t * 2 + 1] = w2 * inv;
        }
    }
}

DI void ph_combine(const P& p, int l, int t0, const unsigned char* Y  , LDSP int* ps  ) {
    const int tid_ = ltid(), lane = tid_ & 63, gw = blockIdx.x * NWV + (tid_ >> 6), NW = gridDim.x * NWV;
    const float* MODl = p.MOD + (size_t)l * 9 * 6144; const int* counts = p.counts + l * 32 * 32;
    if (tid_ < 64) { const int cnt = tid_ < 32 ? counts[tid_ * 32] : 0; int pc = cnt;
#pragma unroll
        for (int o = 1; o < 32; o <<= 1) { const int src = lane >= o ? lane - o : lane; const int a = shli(pc, src); if (lane >= o) pc += a; }
        if (tid_ < 32) ps[tid_] = pc - cnt; }
    __syncthreads();
    for (int t = t0 + 4 * gw; t < T; t += 4 * NW) {
        int4 sl[4]; float4 ew[2];
#pragma unroll
        for (int u = 0; u < 4; ++u) sl[u] = *(const int4*)(p.TOKSLOT + (size_t)(t + u) * 4);
        ew[0] = *(const float4*)(p.EW + (size_t)t * 2); ew[1] = *(const float4*)(p.EW + (size_t)(t + 2) * 2);
        unsigned yr[4][2][4];
#pragma unroll
        for (int u = 0; u < 4; ++u) { const unsigned char* y0 = Y + (size_t)(ps[sl[u].x] + sl[u].y) * D; const unsigned char* y1 = Y + (size_t)(ps[sl[u].z] + sl[u].w) * D;
#pragma unroll
            for (int i = 0; i < 4; ++i) { yr[u][0][i] = *(const unsigned*)(y0 + (i * 64 + lane) * 4); yr[u][1][i] = *(const unsigned*)(y1 + (i * 64 + lane) * 4); } }
        const float* mrow = MODl + (size_t)tok_modrow(t) * 6144; const float* g5 = mrow + 5 * 1024;
        const float* mr1 = p.MOD + (size_t)9 * 6144 + (size_t)tok_modrow(t) * 6144;
#pragma unroll
        for (int pr = 0; pr < 2; ++pr) {
            const float wgt[2][2] = {{ew[pr].x, ew[pr].y}, {ew[pr].z, ew[pr].w}};
            u32x2v xr[2][4];
#pragma unroll
            for (int u = 0; u < 2; ++u)
#pragma unroll
                for (int i = 0; i < 4; ++i) xr[u][i] = *(const u32x2v*)(xrow(p, t + 2 * pr + u) + (i * 64 + lane) * 4);
            float4 v[2][4];
#pragma unroll
            for (int i = 0; i < 4; ++i) { const int c = (i * 64 + lane) * 4; const float4 gg = *(const float4*)(g5 + c);
#pragma unroll
                for (int u = 0; u < 2; ++u) { const u32x2v x = xr[u][i]; const int a = (int)yr[2 * pr + u][0][i], b = (int)yr[2 * pr + u][1][i]; const float w1 = wgt[u][0], w2 = wgt[u][1];
                    v[u][i].x = __uint_as_float(x.x << 16) + gg.x * (w1 * __builtin_amdgcn_cvt_f32_fp8(a, 0) + w2 * __builtin_amdgcn_cvt_f32_fp8(b, 0));
                    v[u][i].y = __uint_as_float(x.x & 0xffff0000u) + gg.y * (w1 * __builtin_amdgcn_cvt_f32_fp8(a, 1) + w2 * __builtin_amdgcn_cvt_f32_fp8(b, 1));
                    v[u][i].z = __uint_as_float(x.y << 16) + gg.z * (w1 * __builtin_amdgcn_cvt_f32_fp8(a, 2) + w2 * __builtin_amdgcn_cvt_f32_fp8(b, 2));
                    v[u][i].w = __uint_as_float(x.y & 0xffff0000u) + gg.w * (w1 * __builtin_amdgcn_cvt_f32_fp8(a, 3) + w2 * __builtin_amdgcn_cvt_f32_fp8(b, 3));
                    if (l == 0) *(u32x2v*)(xrow(p, t + 2 * pr + u) + c) = mk2(pk2(v[u][i].x, v[u][i].y), pk2(v[u][i].z, v[u][i].w)); } }
            float rstd[2];
#pragma unroll
            for (int u = 0; u < 2; ++u) { float ss = 0.f;
#pragma unroll
                for (int i = 0; i < 4; ++i) ss += v[u][i].x * v[u][i].x + v[u][i].y * v[u][i].y + v[u][i].z * v[u][i].z + v[u][i].w * v[u][i].w;
                rstd[u] = rsqrtf(wave_sum(ss, lane) * (1.0f / D) + 1e-6f); }
            if (l == 0) {
#pragma unroll
                for (int i = 0; i < 4; ++i) { const int c = (i * 64 + lane) * 4;
                    const float4 gg = *(const float4*)(p.norm1_g + D + c), sh = *(const float4*)(mr1 + c), sc = *(const float4*)(mr1 + 1024 + c);
#pragma unroll
                    for (int u = 0; u < 2; ++u) { const float r = rstd[u];
                        *(u32x2v*)(p.H + (size_t)(t + 2 * pr + u) * D + c) = mk2(pk2(v[u][i].x * r * gg.x * (1.f + sc.x) + sh.x, v[u][i].y * r * gg.y * (1.f + sc.y) + sh.y), pk2(v[u][i].z * r * gg.z * (1.f + sc.z) + sh.z, v[u][i].w * r * gg.w * (1.f + sc.w) + sh.w)); } }
            } else {
#pragma unroll
                for (int u = 0; u < 2; ++u)
#pragma unroll
                    for (int i = 0; i < 4; ++i) { const float4 gg = ((const float4*)p.final_g)[i * 64 + lane]; const float r = rstd[u];
                        ((float4*)(p.out + (size_t)(t + 2 * pr + u - TC) * D))[i * 64 + lane] = make_float4(v[u][i].x * r * gg.x, v[u][i].y * r * gg.y, v[u][i].z * r * gg.z, v[u][i].w * r * gg.w); }
            }
        }
    }
}

#define XLAS __attribute__((address_space(3)))
#define XB_TMO      128
#define XB_XCNT(j)  (256  + 64 * (j))
#define XB_XSUB(j)  (1280 + 64 * (j))
#define XB_XGEN(j)  (2304 + 64 * (j))
#define XB_TOP      3328
#define XB_TOPGEN   3392
#define XCD_BAR_WORDS 3456
#define XB_SPIN_CAP (1u << 18)

__device__ __forceinline__ unsigned xb_ld(unsigned* p)              { return __hip_atomic_load(p, __ATOMIC_RELAXED, __HIP_MEMORY_SCOPE_AGENT); }
__device__ __forceinline__ unsigned xb_add(unsigned* p, unsigned v) { return __hip_atomic_fetch_add(p, v, __ATOMIC_RELAXED, __HIP_MEMORY_SCOPE_AGENT); }
__device__ __forceinline__ unsigned xb_xcc_id() { return (unsigned)__builtin_amdgcn_s_getreg((3 << 11) | 20) & 0xFu; }
#define XB_SPIN(cond, bar) do { unsigned _sp = 0; while (cond) { __builtin_amdgcn_s_sleep(1); \
    if ((++_sp & 255u) == 0u) { if (xb_ld(&(bar)[XB_TMO])) break; if (_sp > XB_SPIN_CAP) { atomicAdd(&(bar)[XB_TMO], 1u); break; } } } } while (0)

struct XcdBarrier {
    unsigned* bar; unsigned x;
    volatile XLAS unsigned* st;
};

__device__ __forceinline__ XcdBarrier xcd_barrier_post(unsigned* bar, volatile XLAS unsigned* st) {
    XcdBarrier b; b.bar = bar; b.x = xb_xcc_id(); b.st = st;
    if (ltid() == 0) (void)xb_add(&bar[XB_XCNT(b.x)], 1u);
    return b;
}
__device__ __forceinline__ void xcd_barrier_complete(unsigned* bar, unsigned x, unsigned& nloc, unsigned& nx) {
    const unsigned G = gridDim.x * gridDim.y * gridDim.z;
    unsigned sum, cnt, mine, sp = 0u;
    for (;;) {
        sum = 0u; cnt = 0u; mine = 0u;
#pragma unroll
        for (unsigned j = 0; j < 16; ++j) { const unsigned c = xb_ld(&bar[XB_XCNT(j)]); sum += c; cnt += (c > 0u) ? 1u : 0u; mine = (j == x) ? c : mine; }
        if (sum == G) break;
        __builtin_amdgcn_s_sleep(1);
        if ((++sp & 255u) == 0u) { if (xb_ld(&bar[XB_TMO])) break; if (sp > XB_SPIN_CAP) { atomicAdd(&bar[XB_TMO], 1u); break; } }
    }
    nloc = mine > 0u ? mine : 1u; nx = cnt > 0u ? cnt : 1u;
}

__device__ __forceinline__ void xcd_barrier(const XcdBarrier& b) {
    asm volatile("s_waitcnt vmcnt(0)" ::: "memory");
    __syncthreads();
    if (ltid() == 0) {
        unsigned* bar = b.bar;
        __builtin_amdgcn_s_waitcnt(0);
        unsigned nloc = b.st[0], nx = b.st[1];
        if (nloc == 0u) { xcd_barrier_complete(bar, b.x, nloc, nx); b.st[0] = nloc; b.st[1] = nx; }
        const unsigned old = xb_add(&bar[XB_XSUB(b.x)], 1u);
        const unsigned gen = old / nloc;
        if (old + 1u == (gen + 1u) * nloc) {
            __builtin_amdgcn_fence(__ATOMIC_RELEASE, "agent");
            asm volatile("s_waitcnt vmcnt(0)" ::: "memory");
            const unsigned og = xb_add(&bar[XB_TOP], 1u);
            const unsigned tg = og / nx;
            if (og + 1u == (tg + 1u) * nx) xb_add(&bar[XB_TOPGEN], 1u);
            else XB_SPIN(xb_ld(&bar[XB_TOPGEN]) == tg, bar);
            __builtin_amdgcn_fence(__ATOMIC_ACQUIRE, "agent");
            xb_add(&bar[XB_XGEN(b.x)], 1u);
            asm volatile("s_waitcnt vmcnt(0)" ::: "memory");
        } else {
            XB_SPIN(xb_ld(&bar[XB_XGEN(b.x)]) == gen, bar);
            __builtin_amdgcn_fence(__ATOMIC_ACQUIRE, "agent");
            asm volatile("s_waitcnt vmcnt(0)" ::: "memory");
        }
    }
    __syncthreads();
}

DI void moe_table(const P& p, int l, PG8_LAS int* tab) {
    const int tid_ = ltid();
    if (tid_ < 64) { const int cnt = tid_ < 32 ? p.counts[(l * 32 + tid_) * 32] : 0; const int nt = (cnt + 255) >> 8; int pt = nt, pc = cnt;
#pragma unroll
        for (int o = 1; o < 32; o <<= 1) { const int ln_ = tid_ & 63, src = ln_ >= o ? ln_ - o : ln_; const int a = shli(pt, src), b = shli(pc, src); if (ln_ >= o) { pt += a; pc += b; } }
        if (tid_ < 32) { tab[tid_ + 1] = pt; tab[33 + tid_] = cnt; tab[65 + tid_] = pc - cnt; if (tid_ == 0) tab[0] = 0; } }
    __syncthreads();
}
typedef const __attribute__((address_space(4))) P* PK;
DI PK lp(PK q) { asm volatile("" : "+s"(q)); return q; }
#define PHASE(...) do { const P p = *(const P*)lp(pk); __VA_ARGS__; } while (0)

template <int l> DI void layer(PK pk, unsigned char* smem, const XcdBarrier& xbar) {
    float* ldsf = (float*)smem; const int gw = 0, NW = 0, lane = 0;
    {
        constexpr int NG = l == 0 ? 234 : 204;
        constexpr int CV1 = l == 0 ? 10 * 768 : NE * 768;
        const int G = (int)gridDim.x == 256 ? NG : (int)gridDim.x;
        if ((int)blockIdx.x < G) PHASE({ pg8::Gemm g{p.H, p.WinT + (size_t)l * NPAD_IN * D, T, NPAD_IN, D}; pg8::StaticOrder S; S.init(T, NPAD_IN, G, (int)blockIdx.x);
            pg8::EpiProj E{p.PROJ, LDP, INDIM};
            pg8::gemm_phase<pg8::EpiProj, pg8::StaticOrder>((PG8_LAS unsigned char*)smem, g, S, E, nullptr); });
        else PHASE(ph_convert_experts(p, l, ldsf, G, (int)gridDim.x - G, 0, CV1));
        if ((int)gridDim.x != 256) PHASE(ph_convert_experts(p, l, ldsf, 0, (int)gridDim.x, 0, CV1));
    }
    xcd_barrier(xbar);
    PHASE(ph_prep(p, l, (LDSP unsigned char*)smem));
    xcd_barrier(xbar);
    PHASE(ph_s1(p, l, (LDSP unsigned char*)smem));
    xcd_barrier(xbar);
    PHASE(ph_s2(p));
    xcd_barrier(xbar);
    PHASE(ph_s3(p, l, (LDSP unsigned char*)smem));
    xcd_barrier(xbar);
    {
        constexpr int ro = l == 0 ? 0 : TC;
        constexpr int NG = l == 0 ? 182 : 256;
        const int G = (int)gridDim.x == 256 ? NG : (int)gridDim.x;
        if ((int)blockIdx.x < G) PHASE({ pg8::Gemm g{p.H + (size_t)ro * D, p.WoutT + (size_t)l * D * D, T - ro, D, D}; pg8::StaticOrder S; S.init(T - ro, D, G, (int)blockIdx.x);
            pg8::EpiResGate<l != 0> E{p.SSQ, p.ctx, p.x, p.XB, p.MOD + (size_t)l * 9 * 6144 + 2 * 1024, p.XSS, ro};
            pg8::gemm_phase<pg8::EpiResGate<l != 0>, pg8::StaticOrder>((PG8_LAS unsigned char*)smem, g, S, E, nullptr); });
        else if (l == 0) PHASE(ph_convert_experts(p, l, ldsf, G, (int)gridDim.x - G, 10 * 768, NE * 768));
        if (l == 0 && (int)gridDim.x != 256) PHASE(ph_convert_experts(p, l, ldsf, 0, (int)gridDim.x, 10 * 768, NE * 768));
    }
    xcd_barrier(xbar);
    const int t0 = l == 0 ? 0 : TC;
    PHASE(ph_normroute(p, l, t0, (LDSP unsigned char*)smem));
    xcd_barrier(xbar);
    PG8_LAS int* tab = (PG8_LAS int*)((PG8_LAS unsigned char*)smem + pg8::STAGE_BYTES);
#pragma unroll
    for (int ph = 0; ph < 2; ++ph) {
        PHASE(moe_table(p, l, tab));
        const int U = __builtin_amdgcn_readfirstlane(tab[32]) * 4;
        if (ph == 0) PHASE({ pg8::Gemm g{p.H, p.WguT, T, D, D}; pg8::MoeSched S{tab, p.MAP, U, (int)gridDim.x, (int)blockIdx.x, 4, 1, (size_t)D * D * 2};
            pg8::EpiAct E{p.SS}; pg8::gemm_phase_moe<pg8::EpiAct, pg8::MoeSched>((PG8_LAS unsigned char*)smem, g, S, E, nullptr); });
        else PHASE({ pg8::Gemm g{p.SS, p.WdT, T, D, 512}; pg8::MoeSched S{tab, p.MAP, U, (int)gridDim.x, (int)blockIdx.x, 4, 0, (size_t)D * 512 * 2};
            pg8::EpiY E{(unsigned char*)p.PROJ}; pg8::gemm_phase_moe<pg8::EpiY, pg8::MoeSched>((PG8_LAS unsigned char*)smem, g, S, E, nullptr); });
        xcd_barrier(xbar);
    }
    PHASE(ph_combine(p, l, t0, (const unsigned char*)p.PROJ, (LDSP int*)smem));
    xcd_barrier(xbar);
}

__global__ void __launch_bounds__(NTHR) mega(P p_arg) {
    extern __shared__ __attribute__((aligned(16))) unsigned char smem[];
    cg::grid_group grid = cg::this_grid();
    PK pk = (PK)__builtin_amdgcn_kernarg_segment_ptr();
    const int lane = 0, gw = 0, NW = 0;
    float* ldsf = (float*)smem;
    volatile XLAS unsigned* bst = (volatile XLAS unsigned*)((XLAS unsigned char*)smem + LDS_BYTES - 16);
    { const int t_ = ltid(); if (t_ < 2) bst[t_] = 0u; }
    __syncthreads();
    const XcdBarrier xbar = xcd_barrier_post(pk->BAR, bst);
    PHASE(ph_init(p)); PHASE(ph_mod(p, ldsf)); PHASE(ph_convert_small(p, ldsf, gw, NW, lane));
    grid.sync();
    PHASE(ph_normmod1(p, 0, gw, NW, lane));
    xcd_barrier(xbar);
    layer<0>(pk, smem, xbar);
    layer<1>(pk, smem, xbar);
}

static inline size_t al(size_t x) { return (x + 255) & ~(size_t)255; }

extern "C" void kernel_launch(void* const* d_in, const int* in_sizes, int n_in, void* d_out, int out_size, void* d_ws, size_t ws_size, hipStream_t stream) {
    static int grid_blocks = 0;
    if (grid_blocks == 0) {
        int dev = 0, cus = 0, per_cu = 0;
        if (hipFuncSetAttribute((const void*)mega, hipFuncAttributeMaxDynamicSharedMemorySize, LDS_BYTES) != hipSuccess) { fprintf(stderr, "hipFuncSetAttribute failed\n"); grid_blocks = -1; return; }
        (void)hipGetDevice(&dev); (void)hipDeviceGetAttribute(&cus, hipDeviceAttributeMultiprocessorCount, dev);
        if (hipOccupancyMaxActiveBlocksPerMultiprocessor(&per_cu, (const void*)mega, NTHR, LDS_BYTES) != hipSuccess || per_cu < 1) { fprintf(stderr, "occupancy query: %d blocks/CU\n", per_cu); grid_blocks = -1; return; }
        grid_blocks = cus;
    }
    if (grid_blocks < 0) return;
    P p{};
    const float** pin = (const float**)&p;
    for (int i = 0; i < 29; ++i) pin[i] = (const float*)d_in[i];
    p.out = (float*)d_out;
    char* ws = (char*)d_ws; size_t off = 0;
    auto take = [&](size_t bytes) { char* q = ws + off; off += al(bytes); return q; };
    p.XB = (bf16_t*)take((size_t)T * D * 2);
    p.H = (bf16_t*)take((size_t)T * D * 2);
    p.PROJ = (bf16_t*)take((size_t)T * LDP * 2);
    p.SS = (bf16_t*)take((size_t)NTILE * 8 * 2 * 4096 * 2);
    p.GS = (bf16_t*)take((size_t)NTILE * 4 * 2 * 8192 * 2);
    p.SDEC = (float*)take((size_t)NTILE * 8 * 2 * 4);
    p.GDEC = (float*)take((size_t)NTILE * 4 * 2 * 64 * 4);
    p.MOD = (float*)take((size_t)2 * 9 * 6144 * 4);
    p.counts = (int*)take(64 * 32 * 4);
    p.TOKSLOT = (int*)take((size_t)T * 4 * 4);
    p.EW = (float*)take((size_t)T * 2 * 4);
    p.MAP = (int*)take((size_t)NE * T * 4);
    p.WinT = (bf16_t*)take((size_t)2 * NPAD_IN * D * 2);
    p.WoutT = (bf16_t*)take((size_t)2 * D * D * 2);
    p.WguT = (bf16_t*)take((size_t)NE * D * D * 2);
    p.WdT = (bf16_t*)take((size_t)NE * D * 512 * 2);
    p.WRT = (bf16_t*)take((size_t)32 * 1024 * 2);
    p.BAR = (unsigned*)take(XCD_BAR_WORDS * 4);
    p.XBCC = (bf16_t*)d_out;
    p.QKB = (bf16_t*)d_out + (size_t)T * 768;
    p.SSC = (float*)take((size_t)T * 8 * 4 * 4);
    p.STOT = (float*)take((size_t)NTILE * 8 * 2 * 4);
    p.SSQ = (float*)take((size_t)T * 8 * 4);
    p.XSS = (float*)take((size_t)T * 16 * 4);
    if (off > ws_size) { fprintf(stderr, "workspace too small: need %zu have %zu\n", off, ws_size); return; }
    if (hipMemsetAsync(p.BAR, 0, XCD_BAR_WORDS * 4, stream) != hipSuccess) { fprintf(stderr, "memset of barrier words failed\n"); return; }
    void* args[] = {&p};
    hipError_t e = hipLaunchCooperativeKernel((void*)mega, dim3(grid_blocks), dim3(NTHR), args, LDS_BYTES, stream);
    if (e != hipSuccess) fprintf(stderr, "cooperative launch failed: %s (grid %d)\n", hipGetErrorString(e), grid_blocks);
}
```

```cpp
#include <hip/hip_runtime.h>
#include <hip/hip_cooperative_groups.h>
#include <stdint.h>
#include <cstdio>
namespace cg = cooperative_groups;

typedef unsigned short bf16_t;
#define DI __device__ __forceinline__

constexpr int D = 1024, NB = 8, SEQ = 4096, CTXL = 256, TC = NB * CTXL, TL = NB * SEQ, T = TC + TL;
constexpr int INDIM = 2840, LDP = 2848;
constexpr int OFF_Z = 0, OFF_XBC = 512, OFF_DT = 1280, OFF_Q = 1288, OFF_K = 1544, OFF_V = 1800, OFF_GO = 2312, OFF_GK = 2824;
constexpr int NE = 32;

DI float bf2f(bf16_t v) { return __uint_as_float(((unsigned)v) << 16); }
typedef float f32x2v_ __attribute__((ext_vector_type(2)));
typedef __bf16 bf16x2v_ __attribute__((ext_vector_type(2)));
DI bf16_t f2bf(float f) { return __builtin_bit_cast(unsigned short, (__bf16)f); }
DI float siluf(float x) { return x * __builtin_amdgcn_rcpf(1.0f + __builtin_amdgcn_exp2f(-1.4426950408889634f * x)); }
DI float softplusf(float x) { return fmaxf(x, 0.f) + log1pf(__expf(-fabsf(x))); }
DI float logsigmoidf(float x) { return -softplusf(-x); }
DI float shx(float v, int o, int lane) { return __int_as_float(__builtin_amdgcn_ds_bpermute((lane ^ o) << 2, __float_as_int(v))); }
DI int shxi(int v, int o, int lane) { return __builtin_amdgcn_ds_bpermute((lane ^ o) << 2, v); }
DI float shl(float v, int src) { return __int_as_float(__builtin_amdgcn_ds_bpermute(src << 2, __float_as_int(v))); }
DI int shli(int v, int src) { return __builtin_amdgcn_ds_bpermute(src << 2, v); }
DI float wave_sum(float v, int lane) {
#pragma unroll
    for (int o = 32; o >= 1; o >>= 1) v += shx(v, o, lane);
    return v;
}
DI int ltid() { const int wv = __builtin_amdgcn_readfirstlane(threadIdx.x >> 6);
    int t = wv * 64 + (int)__builtin_amdgcn_mbcnt_hi(~0u, __builtin_amdgcn_mbcnt_lo(~0u, 0u)); asm volatile("" : "+v"(t)); return t; }
DI int tok_modrow(int t) { return t < TC ? 8 : ((t - TC) >> 12); }
template <class PT> DI bf16_t* xrow(const PT& p, int t) { return p.XB + (size_t)t * D; }


#ifndef PG8_SP2
#define PG8_SP2 true
#endif
namespace pg8 {
#define PG8_LAS __attribute__((address_space(3)))
typedef unsigned short bf16_t;
typedef short bf16x8 __attribute__((ext_vector_type(8)));
typedef float f32x4 __attribute__((ext_vector_type(4)));
typedef unsigned u32x4 __attribute__((ext_vector_type(4)));
constexpr int BM = 256, BK = 64, HALF = 128, HTB = HALF * BK * 2  , STAGE_BYTES = 8 * HTB, NXCD = 8, WGM = 8;

__host__ __device__ __forceinline__ int lds_byte(int r, int c) { const int st = (r >> 4) * 2 + (c >> 5), rr = r & 15, cc = c & 31, ob = rr * 64 + cc * 2; return st * 1024 + (ob ^ (((ob >> 9) & 1) << 5)); }
__host__ __device__ __forceinline__ void stage_rc(int b, int& R, int& C) { const int st = b / 1024, sb = b % 1024, swz = sb ^ (((sb >> 9) & 1) << 5); R = (st >> 1) * 16 + swz / 64; C = (st & 1) * 32 + (swz % 64) / 2; }
__host__ __device__ __forceinline__ int perm32(int rho) { const int n = rho >> 4, i = rho & 15; return 8 * (i >> 2) + 4 * n + (i & 3); }

struct Unit { int pm, pn; };
struct Gemm { const bf16_t* A; const bf16_t* Bt; int M, N, K; };

struct StaticOrder {
    int nM, nN, nwg, G, c;
    __host__ __device__ void init(int M, int N, int G_, int c_) { nM = M / BM; nN = N / BM; nwg = nM * nN; G = G_; c = c_; }
    __host__ __device__ bool next(int i, Unit& u) const {
        const long L = (long)i * G + c; if (L >= nwg) return false;
        int wgid = (int)L; { const int q = nwg / NXCD, r = nwg % NXCD, xcd = wgid % NXCD, off = wgid / NXCD; wgid = (xcd < r ? xcd * (q + 1) : r * (q + 1) + (xcd - r) * q) + off; }
        const int nig = WGM * nN, gid = wgid / nig, fm = gid * WGM, gsz = (nM - fm) < WGM ? (nM - fm) : WGM;
        u.pm = fm + ((wgid % nig) % gsz); u.pn = (wgid % nig) / gsz; return true;
    }
    __device__ __forceinline__ void a_ready(const Unit&) const {}
    __device__ __forceinline__ void done(const Unit&) const {}
};
__device__ __forceinline__ unsigned cvt_pk_bf16(float lo, float hi) { unsigned r; asm volatile("v_cvt_pk_bf16_f32 %0, %1, %2" : "=v"(r) : "v"(lo), "v"(hi)); return r; }
typedef float f32x2 __attribute__((ext_vector_type(2)));

struct EpiProj {
    static constexpr bool PERM = true, AFTER_DRAIN = false, MIDK = false;
    bf16_t* O; int ldc; int ncols;
    __device__ __forceinline__ void operator()(const f32x4 (&acc)[2][2][4][2], const Unit& u, int wr, int wc, int fr, int fq) const {
        const int row0 = u.pm * BM + wr * 64 + fr, col0 = u.pn * BM + wc * 32 + 8 * fq;
#pragma unroll
        for (int ai = 0; ai < 2; ++ai)
#pragma unroll
            for (int m = 0; m < 4; ++m) { bf16_t* rowp = O + (size_t)(row0 + ai * HALF + m * 16) * ldc + col0;
#pragma unroll
                for (int bj = 0; bj < 2; ++bj) { const f32x4 v0 = acc[ai][bj][m][0], v1 = acc[ai][bj][m][1];
                    u32x4 w; w.x = cvt_pk_bf16(v0[0], v0[1]); w.y = cvt_pk_bf16(v0[2], v0[3]); w.z = cvt_pk_bf16(v1[0], v1[1]); w.w = cvt_pk_bf16(v1[2], v1[3]);
                    if (col0 + bj * HALF + 8 <= ncols) *(u32x4*)(rowp + bj * HALF) = w; } }
    }
};
template <bool SRC_BF16> struct EpiResGate {
    static constexpr bool PERM = true, AFTER_DRAIN = false, MIDK = true;
    const float* ssq;
    const float* Sc; const float* Sl;
    bf16_t* XB;
    const float* gate_rows; float* xss; int rowoff;
    __device__ __forceinline__ void midk(f32x4 (&acc)[2][2][4][2], const Unit& u, int wr, int fr) const {
        int fr_ = fr; asm volatile("" : "+v"(fr_));
        const int row0 = rowoff + u.pm * BM + wr * 64 + fr_;
#pragma unroll
        for (int ai = 0; ai < 2; ++ai)
#pragma unroll
            for (int m = 0; m < 4; ++m) { const f32x4* q = (const f32x4*)(ssq + (size_t)(row0 + ai * HALF + m * 16) * 8); const f32x4 a = q[0], b = q[1];
                const float rs = __builtin_amdgcn_rsqf((((a[0] + a[1]) + (a[2] + a[3])) + ((b[0] + b[1]) + (b[2] + b[3]))) * (1.0f / 512.0f) + 1e-6f);
#pragma unroll
                for (int bj = 0; bj < 2; ++bj)
#pragma unroll
                    for (int n = 0; n < 2; ++n) acc[ai][bj][m][n] *= rs;
                asm volatile("" ::: "memory"); }
    }
    __device__ __forceinline__ void operator()(const f32x4 (&acc)[2][2][4][2], const Unit& u, int wr, int wc, int fr, int fq) const {
        const int row0 = rowoff + u.pm * BM + wr * 64 + fr, col0 = u.pn * BM + wc * 32 + 8 * fq;
        const int t0 = rowoff + u.pm * BM; const int mrow = t0 < 2048 ? 8 : ((t0 - 2048) >> 12);
        const float* gr = gate_rows + (size_t)mrow * 6144 + col0;
        f32x4 gv[2][2];
#pragma unroll
        for (int bj = 0; bj < 2; ++bj)
#pragma unroll
            for (int n = 0; n < 2; ++n) gv[bj][n] = *(const f32x4*)(gr + bj * HALF + n * 4);
#pragma unroll
        for (int ai = 0; ai < 2; ++ai)
#pragma unroll
            for (int m = 0; m < 4; ++m) { const int rr = row0 + ai * HALF + m * 16;
                const float* sp = (rr < 2048 ? Sc + (size_t)rr * 1024 : Sl + (size_t)(rr - 2048) * 1024) + col0; bf16_t* dp = XB + (size_t)rr * 1024 + col0; float ss = 0.f;
#pragma unroll
                for (int bj = 0; bj < 2; ++bj) { f32x4 x0, x1;
                    if (SRC_BF16) { const u32x4 r = *(const u32x4*)(dp + bj * HALF);
                        x0 = (f32x4){__uint_as_float(r.x << 16), __uint_as_float(r.x & 0xffff0000u), __uint_as_float(r.y << 16), __uint_as_float(r.y & 0xffff0000u)};
                        x1 = (f32x4){__uint_as_float(r.z << 16), __uint_as_float(r.z & 0xffff0000u), __uint_as_float(r.w << 16), __uint_as_float(r.w & 0xffff0000u)}; }
                    else { x0 = *(const f32x4*)(sp + bj * HALF); x1 = *(const f32x4*)(sp + bj * HALF + 4); }
                    const f32x4 v0 = x0 + gv[bj][0] * acc[ai][bj][m][0], v1 = x1 + gv[bj][1] * acc[ai][bj][m][1];
                    u32x4 w; w.x = cvt_pk_bf16(v0[0], v0[1]); w.y = cvt_pk_bf16(v0[2], v0[3]); w.z = cvt_pk_bf16(v1[0], v1[1]); w.w = cvt_pk_bf16(v1[2], v1[3]);
                    *(u32x4*)(dp + bj * HALF) = w;
#pragma unroll
                    for (int j = 0; j < 4; ++j) { const float lo = __uint_as_float(w[j] << 16), hi = __uint_as_float(w[j] & 0xffff0000u); ss += lo * lo + hi * hi; } }
                { const int ln_ = fq * 16 + fr; ss += __int_as_float(__builtin_amdgcn_ds_bpermute((ln_ ^ 16) << 2, __float_as_int(ss))); ss += __int_as_float(__builtin_amdgcn_ds_bpermute((ln_ ^ 32) << 2, __float_as_int(ss))); }
                if (fq == 0) xss[(size_t)rr * 16 + u.pn * 4 + wc] = ss; }
    }
};
template <class Epi, class Sched, bool STAMP = false, bool SP2 = PG8_SP2>
__device__ __forceinline__ void gemm_phase(PG8_LAS unsigned char* lds, const Gemm g, const Sched& S, const Epi& E, unsigned long long* stamps) {
    int tid_l = __builtin_amdgcn_readfirstlane(threadIdx.x >> 6) * 64 + (int)__builtin_amdgcn_mbcnt_hi(~0u, __builtin_amdgcn_mbcnt_lo(~0u, 0u)); asm volatile("" : "+v"(tid_l));
    const int tid = tid_l, wid = __builtin_amdgcn_readfirstlane(tid >> 6), lane = tid & 63, wr = wid >> 2, wc = wid & 3, fr = lane & 15, fq = lane >> 4;
    const int K = g.K, nt = K / BK;
    int ts_lo = 0, ts_hi = 0, nts = 0; const unsigned long long rt_entry = STAMP ? (unsigned long long)wall_clock64() : 0ull;
#define PG8_STAMP() do { if (STAMP && wid == 0 && nts < 64) { const unsigned long long _c = (unsigned long long)clock64(); \
        ts_lo = (lane == nts) ? (int)(unsigned)_c : ts_lo; ts_hi = (lane == nts) ? (int)(unsigned)(_c >> 32) : ts_hi; ++nts; } } while (0)
    PG8_STAMP();
    unsigned voffA[2], voffB[2];
#pragma unroll
    for (int i = 0; i < 2; ++i) { int R, C; stage_rc(tid * 16 + i * 8192, R, C); const int Rb = Epi::PERM ? ((R & ~31) + perm32(R & 31)) : R;
        voffA[i] = (unsigned)(R * K + C) * 2u; voffB[i] = (unsigned)(Rb * K + C) * 2u; }
    const size_t kstep = (size_t)(BK * 2);
    const size_t hstep = (size_t)HALF * K * 2;
    const size_t tstep = 2 * hstep;
    const unsigned ldsw = (unsigned)wid * 1024u;
    const int aoff = lds_byte(wr * 64 + fr, fq * 8), boff = lds_byte(wc * 32 + fr, fq * 8);
#define PG8_SA(b, h) (((b) * 2 + (h)) * HTB)
#define PG8_SB(b, h) ((4 + (b) * 2 + (h)) * HTB)
#define PG8_STAGE(bufoff, gbase, voff) do { _Pragma("unroll") for (int _i = 0; _i < 2; ++_i) \
        __builtin_amdgcn_global_load_lds((const unsigned*)((const char*)(gbase) + (voff)[_i]), (PG8_LAS unsigned*)(lds + (bufoff) + ldsw + _i * 8192), 16, 0, 0); } while (0)
#define PG8_LDA(dst, b, h) do { _Pragma("unroll") for (int m = 0; m < 4; ++m) _Pragma("unroll") for (int k = 0; k < 2; ++k) dst[m][k] = *(const PG8_LAS bf16x8*)(lds + PG8_SA(b, h) + aoff + m * 2048 + k * 1024); } while (0)
#define PG8_LDB(dst, b, h) do { _Pragma("unroll") for (int n = 0; n < 2; ++n) _Pragma("unroll") for (int k = 0; k < 2; ++k) dst[n][k] = *(const PG8_LAS bf16x8*)(lds + PG8_SB(b, h) + boff + n * 2048 + k * 1024); } while (0)
#define PG8_MMA(ai, bj, At, Bt) do { __builtin_amdgcn_s_setprio(1); _Pragma("unroll") for (int m = 0; m < 4; ++m) _Pragma("unroll") for (int n = 0; n < 2; ++n) _Pragma("unroll") for (int k = 0; k < 2; ++k) \
        acc[ai][bj][m][n] = __builtin_amdgcn_mfma_f32_16x16x32_bf16(Bt[n][k], At[m][k], acc[ai][bj][m][n], 0, 0, 0); __builtin_amdgcn_s_setprio(0); } while (0)
#define PG8_WAIT_V(n) asm volatile("s_waitcnt vmcnt(" #n ")" ::: "memory")
#define PG8_WAIT_L(n) asm volatile("s_waitcnt lgkmcnt(" #n ")" ::: "memory")
#define PG8_BAR __builtin_amdgcn_s_barrier()
#define PG8_SCHED __builtin_amdgcn_sched_barrier(0)
    Unit cur, nxt; int ui = 0;
    if (!S.next(0, cur)) return;
    f32x4 acc[2][2][4][2];
#pragma unroll
    for (int a = 0; a < 2; ++a)
#pragma unroll
        for (int b = 0; b < 2; ++b)
#pragma unroll
            for (int m = 0; m < 4; ++m)
#pragma unroll
                for (int n = 0; n < 2; ++n) acc[a][b][m][n] = (f32x4){0.f, 0.f, 0.f, 0.f};
    bf16x8 At[4][2], B0[2][2], B1[2][2];
    const char* cA = (const char*)g.A + (size_t)cur.pm * tstep; const char* cB = (const char*)g.Bt + (size_t)cur.pn * tstep;
    S.a_ready(cur);
    if constexpr (SP2) {
        PG8_STAGE(PG8_SB(0, 0), cB, voffB); PG8_STAGE(PG8_SB(0, 1), cB + hstep, voffB); PG8_STAGE(PG8_SA(0, 0), cA, voffA); PG8_STAGE(PG8_SA(0, 1), cA + hstep, voffA);
        if (wr == 1) PG8_BAR;
        PG8_WAIT_V(2); PG8_BAR;
        PG8_STAGE(PG8_SB(1, 0), cB + kstep, voffB); PG8_STAGE(PG8_SA(1, 0), cA + kstep, voffA); PG8_STAGE(PG8_SB(1, 1), cB + hstep + kstep, voffB);
        PG8_WAIT_V(6); PG8_BAR;
    } else {
    PG8_STAGE(PG8_SB(0, 0), cB, voffB); PG8_STAGE(PG8_SA(0, 0), cA, voffA); PG8_STAGE(PG8_SB(0, 1), cB + hstep, voffB); PG8_STAGE(PG8_SA(0, 1), cA + hstep, voffA);
    if (wr == 1) PG8_BAR;
    PG8_WAIT_V(4); PG8_BAR;
    PG8_STAGE(PG8_SB(1, 0), cB + kstep, voffB); PG8_STAGE(PG8_SA(1, 0), cA + kstep, voffA); PG8_STAGE(PG8_SB(1, 1), cB + hstep + kstep, voffB);
    PG8_WAIT_V(6); PG8_BAR;
    }
    PG8_STAMP();
    for (;;) {
        const bool has_next = S.next(ui + 1, nxt);
        const char* nA = has_next ? (const char*)g.A + (size_t)nxt.pm * tstep : cA; const char* nB = has_next ? (const char*)g.Bt + (size_t)nxt.pn * tstep : cB;
        for (int t = 0; t < nt; t += 2) {
            const bool last = (t == nt - 2);
            const char* a1 = cA + (size_t)(t + 1) * kstep;
            const char* a2 = last ? nA : cA + (size_t)(t + 2) * kstep; const char* b2 = last ? nB : cB + (size_t)(t + 2) * kstep;
            const char* a3 = a2 + kstep; const char* b3 = b2 + kstep;
            if (last && has_next) S.a_ready(nxt);
            if constexpr (SP2) {
            PG8_LDB(B0, 0, 0); PG8_LDB(B1, 0, 1); PG8_SCHED; PG8_LDA(At, 0, 0); PG8_STAGE(PG8_SA(1, 1), a1 + hstep, voffA);
            PG8_WAIT_V(8); PG8_WAIT_L(0); PG8_BAR; PG8_MMA(0, 0, At, B0); PG8_MMA(0, 1, At, B1); PG8_BAR; PG8_SCHED;
            PG8_LDA(At, 0, 1); PG8_STAGE(PG8_SB(0, 0), b2, voffB); PG8_STAGE(PG8_SB(0, 1), b2 + hstep, voffB); PG8_STAGE(PG8_SA(0, 0), a2, voffA);
            PG8_WAIT_V(8); PG8_WAIT_L(0); PG8_BAR; PG8_MMA(1, 0, At, B0); PG8_MMA(1, 1, At, B1); PG8_BAR; PG8_SCHED;
            PG8_LDB(B0, 1, 0); PG8_LDB(B1, 1, 1); PG8_SCHED; PG8_LDA(At, 1, 0); PG8_STAGE(PG8_SA(0, 1), a2 + hstep, voffA);
            PG8_WAIT_V(8); PG8_WAIT_L(0); PG8_BAR; PG8_MMA(0, 0, At, B0); PG8_MMA(0, 1, At, B1); PG8_BAR; PG8_SCHED;
            PG8_LDA(At, 1, 1); PG8_STAGE(PG8_SB(1, 0), b3, voffB); PG8_STAGE(PG8_SB(1, 1), b3 + hstep, voffB); PG8_STAGE(PG8_SA(1, 0), a3, voffA);
            PG8_WAIT_V(8); PG8_WAIT_L(0); PG8_BAR; PG8_MMA(1, 0, At, B0); PG8_MMA(1, 1, At, B1); PG8_BAR; PG8_SCHED;
            } else {
            PG8_LDB(B0, 0, 0); PG8_SCHED; PG8_LDA(At, 0, 0); PG8_STAGE(PG8_SA(1, 1), a1 + hstep, voffA);
            PG8_WAIT_L(8); PG8_BAR; PG8_WAIT_L(0); PG8_MMA(0, 0, At, B0); PG8_BAR; PG8_SCHED;
            PG8_LDB(B1, 0, 1); PG8_STAGE(PG8_SB(0, 0), b2, voffB);
            PG8_BAR; PG8_WAIT_L(0); PG8_MMA(0, 1, At, B1); PG8_BAR;
            PG8_LDA(At, 0, 1); PG8_STAGE(PG8_SA(0, 0), a2, voffA);
            PG8_BAR; PG8_WAIT_L(0); PG8_MMA(1, 0, At, B0); PG8_BAR; PG8_SCHED;
            PG8_STAGE(PG8_SB(0, 1), b2 + hstep, voffB);
            PG8_WAIT_V(6); PG8_BAR; PG8_MMA(1, 1, At, B1); PG8_BAR;
            PG8_LDB(B0, 1, 0); PG8_SCHED; PG8_LDA(At, 1, 0); PG8_STAGE(PG8_SA(0, 1), a2 + hstep, voffA);
            PG8_WAIT_L(8); PG8_BAR; PG8_WAIT_L(0); PG8_MMA(0, 0, At, B0); PG8_BAR; PG8_SCHED;
            PG8_LDB(B1, 1, 1); PG8_STAGE(PG8_SB(1, 0), b3, voffB);
            PG8_BAR; PG8_WAIT_L(0); PG8_MMA(0, 1, At, B1); PG8_BAR;
            PG8_LDA(At, 1, 1); PG8_STAGE(PG8_SA(1, 0), a3, voffA);
            PG8_BAR; PG8_WAIT_L(0); PG8_MMA(1, 0, At, B0); PG8_BAR; PG8_SCHED;
            PG8_STAGE(PG8_SB(1, 1), b3 + hstep, voffB);
            PG8_WAIT_V(6); PG8_BAR; PG8_MMA(1, 1, At, B1); PG8_BAR;
            }
            if constexpr (Epi::MIDK) { if (t + 2 == nt / 2) E.midk(acc, cur, wr, fr); }
        }
        PG8_STAMP();
        if (wr == 0) PG8_BAR;
        if constexpr (!Epi::AFTER_DRAIN) { E(acc, cur, wr, wc, fr, fq); S.done(cur); }
        PG8_STAMP();
        if (!has_next) break;
#pragma unroll
        for (int a = 0; a < 2; ++a)
#pragma unroll
            for (int b = 0; b < 2; ++b)
#pragma unroll
                for (int m = 0; m < 4; ++m)
#pragma unroll
                    for (int n = 0; n < 2; ++n) acc[a][b][m][n] = (f32x4){0.f, 0.f, 0.f, 0.f};
        cur = nxt; cA = nA; cB = nB; ++ui;
        if (wr == 1) PG8_BAR;
    }
    PG8_WAIT_V(0);
    PG8_BAR;
    if constexpr (Epi::AFTER_DRAIN) { E.fused(acc, cur, wr, wc, fr, fq, lds, wid, lane); S.done(cur); }
    PG8_STAMP();
    if (STAMP && wid == 0) { stamps[lane] = lane < nts ? (((unsigned long long)(unsigned)ts_hi << 32) | (unsigned)ts_lo) : 0ull;
        if (lane == 62) stamps[62] = rt_entry; if (lane == 63) stamps[63] = (unsigned long long)wall_clock64(); }
#undef PG8_STAMP
#undef PG8_SA
#undef PG8_SB
#undef PG8_STAGE
#undef PG8_LDA
#undef PG8_LDB
#undef PG8_MMA
#undef PG8_WAIT_V
#undef PG8_WAIT_L
#undef PG8_BAR
#undef PG8_SCHED
}

struct MoeUnit { int e, mt, pn, cnt, pstart; };
struct MoeSched {
    typedef MoeUnit UnitT;
    PG8_LAS const int* tab; const int* map; int U, G, c, npn, gather; size_t bstride;
    __device__ __forceinline__ bool next(int i, MoeUnit& u) const {
        const long L = (long)i * G + c; if (L >= U) return false;
        int idx = (int)L; { const int q = U / NXCD, r = U % NXCD, xcd = idx % NXCD, off = idx / NXCD; idx = (xcd < r ? xcd * (q + 1) : r * (q + 1) + (xcd - r) * q) + off; }
        const int tau = idx / npn; u.pn = idx - tau * npn;
        int e = 0;
#pragma unroll
        for (int st = 16; st >= 1; st >>= 1) { if (__builtin_amdgcn_readfirstlane(tab[e + st]) <= tau) e += st; }
        u.e = e; u.mt = tau - __builtin_amdgcn_readfirstlane(tab[e]); u.cnt = __builtin_amdgcn_readfirstlane(tab[33 + e]); u.pstart = __builtin_amdgcn_readfirstlane(tab[65 + e]);
        return true;
    }
    __device__ __forceinline__ const char* bbase(const Gemm& g, const MoeUnit& u) const { return (const char*)g.Bt + (size_t)u.e * bstride + (size_t)u.pn * BM * g.K * 2; }
    __device__ __forceinline__ void a_offsets(const Gemm& g, const MoeUnit& u, int tid, unsigned (&va)[2][2]) const {
        int tl = tid; asm volatile("" : "+v"(tl));
        int RA[2], CA[2];
#pragma unroll
        for (int i = 0; i < 2; ++i) { int R, C; stage_rc(tl * 16 + i * 8192, R, C); RA[i] = R; CA[i] = C * 2; }
#pragma unroll
        for (int hf = 0; hf < 2; ++hf)
#pragma unroll
            for (int i = 0; i < 2; ++i) { int rl = u.mt * BM + hf * HALF + RA[i]; rl = rl < u.cnt ? rl : u.cnt - 1;
                const unsigned row = gather ? (unsigned)map[(size_t)u.e * 34816 + rl] : (unsigned)(u.pstart + rl);
                va[hf][i] = row * (unsigned)(g.K * 2) + (unsigned)CA[i]; }
    }
};
struct EpiAct {
    static constexpr bool PERM = true, AFTER_DRAIN = false;
    bf16_t* O;
    __device__ __forceinline__ void operator()(const f32x4 (&acc)[2][2][4][2], const MoeUnit& u, int wr, int wc, int fr, int fq) const {
        const int rl0 = u.mt * BM + wr * 64 + fr, col0 = u.pn * HALF + wc * 32 + 8 * fq;
#pragma unroll
        for (int ai = 0; ai < 2; ++ai)
#pragma unroll
            for (int m = 0; m < 4; ++m) { const int rl = rl0 + ai * HALF + m * 16;
                if (rl < u.cnt) { float o[8];
#pragma unroll
                    for (int n = 0; n < 2; ++n)
#pragma unroll
                        for (int j = 0; j < 4; ++j) { const float gv = acc[ai][0][m][n][j]; o[4 * n + j] = gv * __builtin_amdgcn_rcpf(1.0f + __builtin_amdgcn_exp2f(-1.4426950408889634f * gv)) * acc[ai][1][m][n][j]; }
                    u32x4 w; w.x = cvt_pk_bf16(o[0], o[1]); w.y = cvt_pk_bf16(o[2], o[3]); w.z = cvt_pk_bf16(o[4], o[5]); w.w = cvt_pk_bf16(o[6], o[7]);
                    *(u32x4*)(O + (size_t)(u.pstart + rl) * 512 + col0) = w; } }
    }
};
struct EpiY {
    static constexpr bool PERM = true, AFTER_DRAIN = false;
    unsigned char* O;
    static __device__ __forceinline__ unsigned pk4(const f32x4 v) { const float lim = 440.f;
        int w = __builtin_amdgcn_cvt_pk_fp8_f32(fminf(fmaxf(v[0], -lim), lim), fminf(fmaxf(v[1], -lim), lim), 0, false);
        return (unsigned)__builtin_amdgcn_cvt_pk_fp8_f32(fminf(fmaxf(v[2], -lim), lim), fminf(fmaxf(v[3], -lim), lim), w, true); }
    __device__ __forceinline__ void operator()(const f32x4 (&acc)[2][2][4][2], const MoeUnit& u, int wr, int wc, int fr, int fq) const {
        typedef unsigned u32x2 __attribute__((ext_vector_type(2)));
        const int rl0 = u.mt * BM + wr * 64 + fr, col0 = u.pn * BM + wc * 32 + 8 * fq;
#pragma unroll
        for (int ai = 0; ai < 2; ++ai)
#pragma unroll
            for (int m = 0; m < 4; ++m) { const int rl = rl0 + ai * HALF + m * 16;
                if (rl < u.cnt) { unsigned char* rowp = O + (size_t)(u.pstart + rl) * 1024 + col0;
#pragma unroll
                    for (int bj = 0; bj < 2; ++bj) *(u32x2*)(rowp + bj * HALF) = (u32x2){pk4(acc[ai][bj][m][0]), pk4(acc[ai][bj][m][1])}; } }
    }
};
template <class Epi, class Sched, bool STAMP = false, bool SP2 = PG8_SP2>
__device__ __forceinline__ void gemm_phase_moe(PG8_LAS unsigned char* lds, const Gemm g, const Sched& S, const Epi& E, unsigned long long* stamps) {
    int tid_l = __builtin_amdgcn_readfirstlane(threadIdx.x >> 6) * 64 + (int)__builtin_amdgcn_mbcnt_hi(~0u, __builtin_amdgcn_mbcnt_lo(~0u, 0u)); asm volatile("" : "+v"(tid_l));
    const int tid = tid_l, wid = __builtin_amdgcn_readfirstlane(tid >> 6), lane = tid & 63, wr = wid >> 2, wc = wid & 3, fr = lane & 15, fq = lane >> 4;
    const int K = g.K, nt = K / BK;
    int ts_lo = 0, ts_hi = 0, nts = 0; const unsigned long long rt_entry = STAMP ? (unsigned long long)wall_clock64() : 0ull;
#define PG8_STAMP() do { if (STAMP && wid == 0 && nts < 64) { const unsigned long long _c = (unsigned long long)clock64(); \
        ts_lo = (lane == nts) ? (int)(unsigned)_c : ts_lo; ts_hi = (lane == nts) ? (int)(unsigned)(_c >> 32) : ts_hi; ++nts; } } while (0)
    PG8_STAMP();
    unsigned voffB[2];
#pragma unroll
    for (int i = 0; i < 2; ++i) { int R, C; stage_rc(tid * 16 + i * 8192, R, C); const int Rb = Epi::PERM ? ((R & ~31) + perm32(R & 31)) : R;
        voffB[i] = (unsigned)(Rb * K + C) * 2u; }
    unsigned vaC[2][2];
    PG8_LAS unsigned* vtab = (PG8_LAS unsigned*)(lds + STAGE_BYTES + 1024) + tid;
    const size_t kstep = (size_t)(BK * 2);
    const size_t hstep = (size_t)HALF * K * 2;
    const size_t tstep = 2 * hstep;
    const unsigned ldsw = (unsigned)wid * 1024u;
    const int aoff = lds_byte(wr * 64 + fr, fq * 8), boff = lds_byte(wc * 32 + fr, fq * 8);
#define PG8_SA(b, h) (((b) * 2 + (h)) * HTB)
#define PG8_SB(b, h) ((4 + (b) * 2 + (h)) * HTB)
#define PG8_STAGE(bufoff, gbase, voff) do { _Pragma("unroll") for (int _i = 0; _i < 2; ++_i) \
        __builtin_amdgcn_global_load_lds((const unsigned*)((const char*)(gbase) + (voff)[_i]), (PG8_LAS unsigned*)(lds + (bufoff) + ldsw + _i * 8192), 16, 0, 0); } while (0)
#define PG8_STAGEA(bufoff, kbyte, va) do { _Pragma("unroll") for (int _i = 0; _i < 2; ++_i) \
        __builtin_amdgcn_global_load_lds((const unsigned*)((const char*)g.A + (kbyte) + (va)[_i]), (PG8_LAS unsigned*)(lds + (bufoff) + ldsw + _i * 8192), 16, 0, 0); } while (0)
#define PG8_LDA(dst, b, h) do { _Pragma("unroll") for (int m = 0; m < 4; ++m) _Pragma("unroll") for (int k = 0; k < 2; ++k) dst[m][k] = *(const PG8_LAS bf16x8*)(lds + PG8_SA(b, h) + aoff + m * 2048 + k * 1024); } while (0)
#define PG8_LDB(dst, b, h) do { _Pragma("unroll") for (int n = 0; n < 2; ++n) _Pragma("unroll") for (int k = 0; k < 2; ++k) dst[n][k] = *(const PG8_LAS bf16x8*)(lds + PG8_SB(b, h) + boff + n * 2048 + k * 1024); } while (0)
#define PG8_MMA(ai, bj, At, Bt) do { __builtin_amdgcn_s_setprio(1); _Pragma("unroll") for (int m = 0; m < 4; ++m) _Pragma("unroll") for (int n = 0; n < 2; ++n) _Pragma("unroll") for (int k = 0; k < 2; ++k) \
        acc[ai][bj][m][n] = __builtin_amdgcn_mfma_f32_16x16x32_bf16(Bt[n][k], At[m][k], acc[ai][bj][m][n], 0, 0, 0); __builtin_amdgcn_s_setprio(0); } while (0)
#define PG8_WAIT_V(n) asm volatile("s_waitcnt vmcnt(" #n ")" ::: "memory")
#define PG8_WAIT_L(n) asm volatile("s_waitcnt lgkmcnt(" #n ")" ::: "memory")
#define PG8_BAR __builtin_amdgcn_s_barrier()
#define PG8_SCHED __builtin_amdgcn_sched_barrier(0)
    typename Sched::UnitT cur, nxt; int ui = 0;
    if (!S.next(0, cur)) return;
    f32x4 acc[2][2][4][2];
#pragma unroll
    for (int a = 0; a < 2; ++a)
#pragma unroll
        for (int b = 0; b < 2; ++b)
#pragma unroll
            for (int m = 0; m < 4; ++m)
#pragma unroll
                for (int n = 0; n < 2; ++n) acc[a][b][m][n] = (f32x4){0.f, 0.f, 0.f, 0.f};
    bf16x8 At[4][2], B0[2][2], B1[2][2];
    const char* cB = S.bbase(g, cur); S.a_offsets(g, cur, tid, vaC);
    if constexpr (SP2) {
        PG8_STAGE(PG8_SB(0, 0), cB, voffB); PG8_STAGE(PG8_SB(0, 1), cB + hstep, voffB); PG8_STAGEA(PG8_SA(0, 0), 0, vaC[0]); PG8_STAGEA(PG8_SA(0, 1), 0, vaC[1]);
        if (wr == 1) PG8_BAR;
        PG8_WAIT_V(2); PG8_BAR;
        PG8_STAGE(PG8_SB(1, 0), cB + kstep, voffB); PG8_STAGEA(PG8_SA(1, 0), kstep, vaC[0]); PG8_STAGE(PG8_SB(1, 1), cB + hstep + kstep, voffB);
        PG8_WAIT_V(6); PG8_BAR;
    } else {
    PG8_STAGE(PG8_SB(0, 0), cB, voffB); PG8_STAGEA(PG8_SA(0, 0), 0, vaC[0]); PG8_STAGE(PG8_SB(0, 1), cB + hstep, voffB); PG8_STAGEA(PG8_SA(0, 1), 0, vaC[1]);
    if (wr == 1) PG8_BAR;
    PG8_WAIT_V(4); PG8_BAR;
    PG8_STAGE(PG8_SB(1, 0), cB + kstep, voffB); PG8_STAGEA(PG8_SA(1, 0), kstep, vaC[0]); PG8_STAGE(PG8_SB(1, 1), cB + hstep + kstep, voffB);
    PG8_WAIT_V(6); PG8_BAR;
    }
    PG8_STAMP();
    for (;;) {
        const bool has_next = S.next(ui + 1, nxt);
        const char* nB = has_next ? S.bbase(g, nxt) : cB;
        { unsigned vaN[2][2];
          if (has_next) S.a_offsets(g, nxt, tid, vaN); else {
#pragma unroll
            for (int hf = 0; hf < 2; ++hf)
#pragma unroll
                for (int i = 0; i < 2; ++i) vaN[hf][i] = vaC[hf][i]; }
#pragma unroll
          for (int hf = 0; hf < 2; ++hf)
#pragma unroll
              for (int i = 0; i < 2; ++i) vtab[(hf * 2 + i) * 512] = vaN[hf][i]; }
        unsigned v2[2][2];
        for (int t = 0; t < nt; t += 2) {
            const bool last = (t == nt - 2);
            const size_t k1 = (size_t)(t + 1) * kstep, k2 = last ? (size_t)0 : (size_t)(t + 2) * kstep, k3 = k2 + kstep;
            const char* b2 = last ? nB : cB + (size_t)(t + 2) * kstep; const char* b3 = b2 + kstep;
#pragma unroll
            for (int hf = 0; hf < 2; ++hf)
#pragma unroll
                for (int i = 0; i < 2; ++i) v2[hf][i] = last ? vtab[(hf * 2 + i) * 512] : vaC[hf][i];
            if constexpr (SP2) {
            PG8_LDB(B0, 0, 0); PG8_LDB(B1, 0, 1); PG8_SCHED; PG8_LDA(At, 0, 0); PG8_STAGEA(PG8_SA(1, 1), k1, vaC[1]);
            PG8_WAIT_V(8); PG8_WAIT_L(0); PG8_BAR; PG8_MMA(0, 0, At, B0); PG8_MMA(0, 1, At, B1); PG8_BAR; PG8_SCHED;
            PG8_LDA(At, 0, 1); PG8_STAGE(PG8_SB(0, 0), b2, voffB); PG8_STAGE(PG8_SB(0, 1), b2 + hstep, voffB); PG8_STAGEA(PG8_SA(0, 0), k2, v2[0]);
            PG8_WAIT_V(8); PG8_WAIT_L(0); PG8_BAR; PG8_MMA(1, 0, At, B0); PG8_MMA(1, 1, At, B1); PG8_BAR; PG8_SCHED;
            PG8_LDB(B0, 1, 0); PG8_LDB(B1, 1, 1); PG8_SCHED; PG8_LDA(At, 1, 0); PG8_STAGEA(PG8_SA(0, 1), k2, v2[1]);
            PG8_WAIT_V(8); PG8_WAIT_L(0); PG8_BAR; PG8_MMA(0, 0, At, B0); PG8_MMA(0, 1, At, B1); PG8_BAR; PG8_SCHED;
            PG8_LDA(At, 1, 1); PG8_STAGE(PG8_SB(1, 0), b3, voffB); PG8_STAGE(PG8_SB(1, 1), b3 + hstep, voffB); PG8_STAGEA(PG8_SA(1, 0), k3, v2[0]);
            PG8_WAIT_V(8); PG8_WAIT_L(0); PG8_BAR; PG8_MMA(1, 0, At, B0); PG8_MMA(1, 1, At, B1); PG8_BAR; PG8_SCHED;
            } else {
            PG8_LDB(B0, 0, 0); PG8_SCHED; PG8_LDA(At, 0, 0); PG8_STAGEA(PG8_SA(1, 1), k1, vaC[1]);
            PG8_WAIT_L(8); PG8_BAR; PG8_WAIT_L(0); PG8_MMA(0, 0, At, B0); PG8_BAR; PG8_SCHED;
            PG8_LDB(B1, 0, 1); PG8_STAGE(PG8_SB(0, 0), b2, voffB);
            PG8_BAR; PG8_WAIT_L(0); PG8_MMA(0, 1, At, B1); PG8_BAR;
            PG8_LDA(At, 0, 1); PG8_STAGEA(PG8_SA(0, 0), k2, v2[0]);
            PG8_BAR; PG8_WAIT_L(0); PG8_MMA(1, 0, At, B0); PG8_BAR; PG8_SCHED;
            PG8_STAGE(PG8_SB(0, 1), b2 + hstep, voffB);
            PG8_WAIT_V(6); PG8_BAR; PG8_MMA(1, 1, At, B1); PG8_BAR;
            PG8_LDB(B0, 1, 0); PG8_SCHED; PG8_LDA(At, 1, 0); PG8_STAGEA(PG8_SA(0, 1), k2, v2[1]);
            PG8_WAIT_L(8); PG8_BAR; PG8_WAIT_L(0); PG8_MMA(0, 0, At, B0); PG8_BAR; PG8_SCHED;
            PG8_LDB(B1, 1, 1); PG8_STAGE(PG8_SB(1, 0), b3, voffB);
            PG8_BAR; PG8_WAIT_L(0); PG8_MMA(0, 1, At, B1); PG8_BAR;
            PG8_LDA(At, 1, 1); PG8_STAGEA(PG8_SA(1, 0), k3, v2[0]);
            PG8_BAR; PG8_WAIT_L(0); PG8_MMA(1, 0, At, B0); PG8_BAR; PG8_SCHED;
            PG8_STAGE(PG8_SB(1, 1), b3 + hstep, voffB);
            PG8_WAIT_V(6); PG8_BAR; PG8_MMA(1, 1, At, B1); PG8_BAR;
            }
        }
        PG8_STAMP();
        if (wr == 0) PG8_BAR;
        E(acc, cur, wr, wc, fr, fq);
        PG8_STAMP();
        if (!has_next) break;
#pragma unroll
        for (int a = 0; a < 2; ++a)
#pragma unroll
            for (int b = 0; b < 2; ++b)
#pragma unroll
                for (int m = 0; m < 4; ++m)
#pragma unroll
                    for (int n = 0; n < 2; ++n) acc[a][b][m][n] = (f32x4){0.f, 0.f, 0.f, 0.f};
        cur = nxt; cB = nB; ++ui;
#pragma unroll
        for (int hf = 0; hf < 2; ++hf)
#pragma unroll
            for (int i = 0; i < 2; ++i) vaC[hf][i] = v2[hf][i];
        if (wr == 1) PG8_BAR;
    }
    PG8_WAIT_V(0);
    PG8_BAR;
    PG8_STAMP();
    if (STAMP && wid == 0) { stamps[lane] = lane < nts ? (((unsigned long long)(unsigned)ts_hi << 32) | (unsigned)ts_lo) : 0ull;
        if (lane == 62) stamps[62] = rt_entry; if (lane == 63) stamps[63] = (unsigned long long)wall_clock64(); }
#undef PG8_STAMP
#undef PG8_SA
#undef PG8_SB
#undef PG8_STAGE
#undef PG8_STAGEA
#undef PG8_LDA
#undef PG8_LDB
#undef PG8_MMA
#undef PG8_WAIT_V
#undef PG8_WAIT_L
#undef PG8_BAR
#undef PG8_SCHED
}
}

constexpr int NTHR = 512, NWV = 8, LDS_BYTES = 147456;

struct P {
    const float *x, *c, *ctx, *c_ctx, *w_mod, *b_mod, *norm1_g, *norm2_g, *w_in, *conv_w, *conv_b, *dt_bias_f, *dt_bias_b, *a_log_f, *a_log_b, *d_skip, *ssd_norm_g,
        *gk_up_f, *gk_bias_f, *gk_up_b, *gk_bias_b, *gla_norm_g, *w_out, *w_router, *router_bias, *w_gate, *w_up, *w_down, *final_g;
    float* out; bf16_t* XB; bf16_t* H; bf16_t* PROJ; bf16_t* SS; bf16_t* GS; float* SDEC; float* GDEC; float* MOD; int* counts; int* TOKSLOT; float* EW; int* MAP; bf16_t* WinT; bf16_t* WoutT; bf16_t* WguT; bf16_t* WdT; bf16_t* WRT; unsigned* BAR; bf16_t* XBCC; bf16_t* QKB; float* SSC; float* STOT; float* SSQ; float* XSS;
};

DI void ph_init(const P& p) { const size_t i = (size_t)blockIdx.x * NTHR + ltid(); if (i < 64) p.counts[i * 32] = 0; }

DI void ph_mod(const P& p, float* s  ) {
    const int tid_ = ltid(), lane = tid_ & 63, w = tid_ >> 6;
    if (blockIdx.x >= 192) return;
    float* part = s + 9 * 1024;
    { float cv[18];
#pragma unroll
      for (int q = 0; q < 18; ++q) { const int i = tid_ + q * NTHR, r = i >> 10, k = i & 1023; cv[q] = r < 8 ? p.c[r * 1024 + k] : p.c_ctx[k]; }
#pragma unroll
      for (int q = 0; q < 18; ++q) s[tid_ + q * NTHR] = siluf(cv[q]); }
    __syncthreads();
    for (int vb = blockIdx.x; vb < 192; vb += gridDim.x) {
        const int l = vb / 96, n = (vb % 96) * 64 + lane;
        float acc[9];
#pragma unroll
        for (int r = 0; r < 9; ++r) acc[r] = 0.f;
        const float* wp = p.w_mod + (size_t)l * 1024 * 6144 + (size_t)(128 * w) * 6144 + n;
#pragma unroll 8
        for (int k = 0; k < 128; ++k) { const float wv = wp[(size_t)k * 6144];
#pragma unroll
            for (int r = 0; r < 9; ++r) acc[r] += s[r * 1024 + 128 * w + k] * wv; }
#pragma unroll
        for (int r = 0; r < 9; ++r) part[(w * 9 + r) * 64 + lane] = acc[r];
        __syncthreads();
        for (int o = tid_; o < 9 * 64; o += NTHR) { const int r = o >> 6, c = o & 63; float a = p.b_mod[l * 6144 + (vb % 96) * 64 + c];
#pragma unroll
            for (int q = 0; q < 8; ++q) a += part[(q * 9 + r) * 64 + c];
            p.MOD[((size_t)l * 9 + r) * 6144 + (vb % 96) * 64 + c] = a; }
        __syncthreads();
    }
}

DI unsigned pk2(float lo, float hi) { return __builtin_bit_cast(unsigned, __builtin_convertvector((f32x2v_){lo, hi}, bf16x2v_)); }
DI void transpose_item(const float* W, int K, int N, bf16_t* WT, float* scr, int item, int lane, int gu = -1, const float* kscale = nullptr) {
    const int nblk = (N + 31) / 32, kb = item / nblk, nb = item % nblk, k0 = 64 * kb, n0 = 32 * nb;
    const int d0 = gu < 0 ? n0 : 256 * (n0 >> 7) + (n0 & 127) + 128 * gu;
    const bool nok = n0 + (lane & 31) < N;
    float wv_[32];
#pragma unroll
    for (int i = 0; i < 32; ++i) { const int kk = 2 * i + (lane >> 5); wv_[i] = nok ? __builtin_nontemporal_load(W + (size_t)(k0 + kk) * N + n0 + (lane & 31)) : 0.f; }
#pragma unroll
    for (int i = 0; i < 32; ++i) { const int kk = 2 * i + (lane >> 5); scr[kk * 33 + (lane & 31)] = wv_[i] * (kscale ? kscale[k0 + kk] : 1.0f); }
    const int c = lane & 7;
#pragma unroll
    for (int j = 0; j < 4; ++j) { const int n = (lane >> 3) + 8 * j; const float* q = scr + (8 * c) * 33 + n;
        uint4 o; o.x = pk2(q[0 * 33], q[1 * 33]); o.y = pk2(q[2 * 33], q[3 * 33]); o.z = pk2(q[4 * 33], q[5 * 33]); o.w = pk2(q[6 * 33], q[7 * 33]);
        if (n0 + n < N) { typedef unsigned u32x4nt __attribute__((ext_vector_type(4))); __builtin_nontemporal_store((u32x4nt){o.x, o.y, o.z, o.w}, (u32x4nt*)(WT + (size_t)(d0 + n) * K + k0 + 8 * c)); } }
}

DI void ph_convert_experts(const P& p, int l, float* ldsf, int wk0, int nwk, int it0 = 0, int it1 = NE * 768) {
    const int tid_ = ltid(), lane = tid_ & 63, gw = ((int)blockIdx.x - wk0) * NWV + (tid_ >> 6), NW = nwk * NWV;
    float* scr = ldsf + 14 * 1024 + (tid_ >> 6) * (64 * 33 + 16);
    for (int it = it0 + gw; it < it1; it += NW) {
        const int e = it / 768, r = it - e * 768;
        if (r < 512) { const int gu = r >> 8; const float* W = (gu ? p.w_up : p.w_gate) + (size_t)(l * NE + e) * D * 512;
            transpose_item(W, D, 512, p.WguT + (size_t)e * D * D, scr, r & 255, lane, gu); }
        else transpose_item(p.w_down + (size_t)(l * NE + e) * 512 * D, 512, D, p.WdT + (size_t)e * D * 512, scr, r - 512, lane);
    }
}
constexpr int NPAD_IN = 3072;
DI void ph_convert_small(const P& p, float* ldsf, int, int, int) {
    const int tid_ = ltid(), lane = tid_ & 63, gw = blockIdx.x * NWV + (tid_ >> 6), NW = gridDim.x * NWV;
    float* scr = ldsf + 14 * 1024 + (tid_ >> 6) * (64 * 33 + 16);
    constexpr int I_IN = 16 * 89, I_OUT = 16 * 32;
    for (int it = gw; it < 2 * (I_IN + I_OUT); it += NW) {
        const int l = it / (I_IN + I_OUT), r = it % (I_IN + I_OUT);
        if (r < I_IN) transpose_item(p.w_in + (size_t)l * D * INDIM, D, INDIM, p.WinT + (size_t)l * NPAD_IN * D, scr, r, lane);
        else { const int kb = (r - I_IN) / 32;
            transpose_item(p.w_out + (size_t)l * D * D, D, D, p.WoutT + (size_t)l * D * D, scr, r - I_IN, lane, -1, kb < 8 ? p.ssd_norm_g + l * 512 : nullptr); }
    }
    for (int idx = blockIdx.x * NTHR + tid_; idx < 32 * 1024; idx += gridDim.x * NTHR) { const int e = idx >> 10, k = idx & 1023; p.WRT[idx] = f2bf(p.w_router[k * 32 + e]); }
    const size_t nz16 = (size_t)(NPAD_IN - INDIM) * D * 2 / 16;
    for (size_t i = (size_t)blockIdx.x * NTHR + tid_; i < 2 * nz16; i += (size_t)gridDim.x * NTHR) {
        const size_t l = i / nz16, j = i % nz16;
        ((uint4*)(p.WinT + (l * NPAD_IN + INDIM) * D))[j] = make_uint4(0u, 0u, 0u, 0u);
    }
}

DI void row_normmod(float4 (&v)[4], const float* g, const float* mr, int shift_idx, int scale_idx, int lane) {
    float ss = 0.f;
#pragma unroll
    for (int i = 0; i < 4; ++i) ss += v[i].x * v[i].x + v[i].y * v[i].y + v[i].z * v[i].z + v[i].w * v[i].w;
    ss = wave_sum(ss, lane);
    const float rstd = rsqrtf(ss * (1.0f / D) + 1e-6f);
#pragma unroll
    for (int i = 0; i < 4; ++i) {
        const int c = (i * 64 + lane) * 4;
        const float4 gg = *(const float4*)(g + c), sh = *(const float4*)(mr + shift_idx * 1024 + c), sc = *(const float4*)(mr + scale_idx * 1024 + c);
        v[i].x = v[i].x * rstd * gg.x * (1.f + sc.x) + sh.x; v[i].y = v[i].y * rstd * gg.y * (1.f + sc.y) + sh.y;
        v[i].z = v[i].z * rstd * gg.z * (1.f + sc.z) + sh.z; v[i].w = v[i].w * rstd * gg.w * (1.f + sc.w) + sh.w;
    }
}
DI void row_store_bf16(bf16_t* hrow, float4 (&v)[4], int lane) {
#pragma unroll
    for (int i = 0; i < 4; ++i) { ushort4 o; o.x = f2bf(v[i].x); o.y = f2bf(v[i].y); o.z = f2bf(v[i].z); o.w = f2bf(v[i].w);
        *(ushort4*)(hrow + (i * 64 + lane) * 4) = o; v[i] = make_float4(bf2f(o.x), bf2f(o.y), bf2f(o.z), bf2f(o.w)); }
}

DI void ph_normmod1(const P& p, int l, int, int, int) {
    const int tid_ = ltid(), lane = tid_ & 63, gw = blockIdx.x * NWV + (tid_ >> 6), NW = gridDim.x * NWV;
    const float* MODl = p.MOD + (size_t)l * 9 * 6144;
    for (int t = gw; t < T; t += NW) {
        float4 v[4];
#pragma unroll
        for (int i = 0; i < 4; ++i) v[i] = ((const float4*)(t < TC ? p.ctx + (size_t)t * D : p.x + (size_t)(t - TC) * D))[i * 64 + lane];
        row_normmod(v, p.norm1_g + l * D, MODl + (size_t)tok_modrow(t) * 6144, 0, 1, lane);
        row_store_bf16(p.H + (size_t)t * D, v, lane);
    }
}

typedef short s16x4 __attribute__((ext_vector_type(4)));
typedef short bf16x8v __attribute__((ext_vector_type(8)));
typedef float f32x4v __attribute__((ext_vector_type(4)));
typedef unsigned u32x4v __attribute__((ext_vector_type(4)));
typedef unsigned u32x2v __attribute__((ext_vector_type(2)));
DI u32x4v mk4(unsigned a, unsigned b, unsigned c, unsigned d) { return (u32x4v){a, b, c, d}; }
DI u32x2v mk2(unsigned a, unsigned b) { return (u32x2v){a, b}; }
DI f32x4v mkf4(float a, float b, float c, float d) { return (f32x4v){a, b, c, d}; }
#define LDSP __attribute__((address_space(3)))
constexpr int NCH = 34, NTILE = NB * NCH;
constexpr int LD64 = 72, LD128 = 136;
constexpr float LOG2E = 1.4426950408889634f;

DI int tile_tok0(int tl) { const int b = tl / NCH, cs = tl - b * NCH; return cs < 2 ? b * CTXL + cs * 128 : TC + b * SEQ + (cs - 2) * 128; }
DI f32x4v mfma16(bf16x8v a, bf16x8v b, f32x4v c) { return __builtin_amdgcn_mfma_f32_16x16x32_bf16(a, b, c, 0, 0, 0); }
DI bf16x8v frag_row(LDSP const bf16_t* base, int ld, int r0, int k0, int lane) { return *(LDSP const bf16x8v*)(base + (r0 + (lane & 15)) * ld + k0 + 8 * (lane >> 4)); }
DI bf16x8v frag_row_g(const bf16_t* base, int ld, int r0, int k0, int lane) { return *(const bf16x8v*)(base + (size_t)(r0 + (lane & 15)) * ld + k0 + 8 * (lane >> 4)); }
DI bf16x8v frag_col(LDSP const bf16_t* base, int ld, int r0, int k0, int lane) {
    const int G = lane >> 4, i = lane & 15;
    LDSP const bf16_t* a = base + (k0 + 8 * G + (i >> 2)) * ld + r0 + 4 * (i & 3);
    const s16x4 lo = __builtin_bit_cast(s16x4, __builtin_amdgcn_ds_read_tr16_b64_v4i16((LDSP s16x4*)a));
    const s16x4 hi = __builtin_bit_cast(s16x4, __builtin_amdgcn_ds_read_tr16_b64_v4i16((LDSP s16x4*)(a + 4 * ld)));
    return (bf16x8v){lo[0], lo[1], lo[2], lo[3], hi[0], hi[1], hi[2], hi[3]};
}
DI u32x2v pack4(f32x4v v) { return mk2(pk2(v[0], v[1]), pk2(v[2], v[3])); }
DI void unpack8(u32x4v v, float* o) { o[0] = __uint_as_float(v.x << 16); o[1] = __uint_as_float(v.x & 0xffff0000u); o[2] = __uint_as_float(v.y << 16); o[3] = __uint_as_float(v.y & 0xffff0000u);
    o[4] = __uint_as_float(v.z << 16); o[5] = __uint_as_float(v.z & 0xffff0000u); o[6] = __uint_as_float(v.w << 16); o[7] = __uint_as_float(v.w & 0xffff0000u); }
DI u32x4v pack8(const float* o) { return mk4(pk2(o[0], o[1]), pk2(o[2], o[3]), pk2(o[4], o[5]), pk2(o[6], o[7])); }

DI float fast_logsigmoid(float x) { return -(fmaxf(-x, 0.f) + __logf(1.0f + __expf(-fabsf(x)))); }
DI float fast_softplus(float x) { return fmaxf(x, 0.f) + __logf(1.0f + __expf(-fabsf(x))); }
struct XbcSrc { const bf16_t* base; int ld; };
DI XbcSrc xbc_src(const P& p, int tok0) { XbcSrc r; r.base = p.XBCC + (size_t)tok0 * 768; r.ld = 768; return r; }

DI void prep_conv_item(const P& p, int l, int item, int lane) {
    const int piece = item >> 1, part = item & 1, ch = part * 512 + lane * 8;
    if (ch >= 768) return;
    const int t0 = piece * 32; int lo, hi; bf16_t* dst; int dld;
    if (t0 < TC) { lo = t0 & ~(CTXL - 1); hi = lo + CTXL - 1; } else { lo = TC + ((t0 - TC) & ~63); hi = lo + 63; }
    dst = p.XBCC + ch; dld = 768;
    const bf16_t* src = p.PROJ + OFF_XBC + ch;
    float wgt[5][8], bias[8];
#pragma unroll
    for (int k = 0; k < 5; ++k) { const f32x4v a = *(const f32x4v*)(p.conv_w + l * 5 * 768 + k * 768 + ch), c = *(const f32x4v*)(p.conv_w + l * 5 * 768 + k * 768 + ch + 4);
#pragma unroll
        for (int j = 0; j < 4; ++j) { wgt[k][j] = a[j]; wgt[k][4 + j] = c[j]; } }
    { const f32x4v a = *(const f32x4v*)(p.conv_b + l * 768 + ch), c = *(const f32x4v*)(p.conv_b + l * 768 + ch + 4);
#pragma unroll
      for (int j = 0; j < 4; ++j) { bias[j] = a[j]; bias[4 + j] = c[j]; } }
    const u32x4v zero4 = mk4(0u, 0u, 0u, 0u);
    u32x4v rw[13];
#pragma unroll
    for (int i = 0; i < 5; ++i) { const int tt = t0 - 2 + i; rw[i] = (tt >= lo && tt <= hi) ? *(const u32x4v*)(src + (size_t)tt * LDP) : zero4; }
    for (int s0 = 0; s0 < 32; s0 += 8) {
        const int t = t0 + s0;
#pragma unroll
        for (int i = 0; i < 8; ++i) { const int tt = t + 3 + i; rw[5 + i] = (tt <= hi) ? *(const u32x4v*)(src + (size_t)tt * LDP) : zero4; }
#pragma unroll
        for (int i = 0; i < 8; ++i) {
            float o[8];
#pragma unroll
            for (int c = 0; c < 8; ++c) o[c] = bias[c];
#pragma unroll
            for (int k = 0; k < 5; ++k) { float v[8]; unpack8(rw[i + k], v);
#pragma unroll
                for (int c = 0; c < 8; ++c) o[c] += wgt[k][c] * v[c]; }
#pragma unroll
            for (int c = 0; c < 8; ++c) o[c] = siluf(o[c]);
            *(u32x4v*)(dst + (size_t)(t + i) * dld) = pack8(o);
        }
#pragma unroll
        for (int i = 0; i < 5; ++i) rw[i] = rw[i + 8];
    }
}
DI void prep_ssd_item(const P& p, int l, int item, int lane) {
    const int tl = item >> 3, h = item & 7, tok0 = tile_tok0(tl);
    const float bsf = p.dt_bias_f[l * 8 + h], bsb = p.dt_bias_b[l * 8 + h];
    const float r0 = bf2f(p.PROJ[(size_t)(tok0 + 2 * lane) * LDP + OFF_DT + h]), r1 = bf2f(p.PROJ[(size_t)(tok0 + 2 * lane + 1) * LDP + OFF_DT + h]);
    const float f0 = fast_softplus(r0 + bsf), f1 = fast_softplus(r1 + bsf), b0 = fast_softplus(r0 + bsb), b1 = fast_softplus(r1 + bsb);
    float pf = f0 + f1, sb = b0 + b1;
#pragma unroll
    for (int o = 1; o < 64; o <<= 1) { const float t = shl(pf, lane >= o ? lane - o : lane); if (lane >= o) pf += t; }
#pragma unroll
    for (int o = 1; o < 64; o <<= 1) { const float t = shl(sb, lane + o < 64 ? lane + o : lane); if (lane + o < 64) sb += t; }
    const float Af = -__expf(p.a_log_f[l * 8 + h]) * LOG2E, Ab = -__expf(p.a_log_b[l * 8 + h]) * LOG2E;
    const float af0 = Af * (pf - f1), af1 = Af * pf, ab0 = Ab * sb, ab1 = Ab * (sb - b0);
    f32x4v* dst = (f32x4v*)p.SSC + (size_t)(tok0 + 2 * lane) * 8 + h;
    dst[0] = mkf4(af0, af0 - __log2f(f0), ab0, ab0 - __log2f(b0));
    dst[8] = mkf4(af1, af1 - __log2f(f1), ab1, ab1 - __log2f(b1));
    if (lane == 63) { p.STOT[(tl * 8 + h) * 2 + 0] = af1; p.SDEC[(tl * 8 + h) * 2 + 0] = __builtin_amdgcn_exp2f(af1); }
    if (lane == 0) { p.STOT[(tl * 8 + h) * 2 + 1] = ab0; p.SDEC[(tl * 8 + h) * 2 + 1] = __builtin_amdgcn_exp2f(ab0); }
}
DI void prep_gla_block(const P& p, int l, int tl, int h, LDSP unsigned char* lds) {
    const int tid = ltid(), lane = tid & 63, k = tid >> 3, seg = tid & 7, base = lane & ~7, tok0 = tile_tok0(tl);
    LDSP bf16_t* QT = (LDSP bf16_t*)lds; LDSP bf16_t* KT = QT + 128 * LD64; LDSP bf16_t* O4 = KT + 128 * LD64; LDSP float* GKL = (LDSP float*)(O4 + 4 * 128 * LD64);
    u32x4v qv_[2], kv_[2], vv_[4]; u32x4v gk = mk4(0u, 0u, 0u, 0u);
#pragma unroll
    for (int q = 0; q < 4; ++q) { const int c = tid + q * NTHR, r = c >> 4, cc = c & 15; vv_[q] = *(const u32x4v*)(p.PROJ + (size_t)(tok0 + r) * LDP + OFF_V + h * 128 + cc * 8); }
#pragma unroll
    for (int q = 0; q < 2; ++q) { const int c = tid + q * NTHR, r = c >> 3, cc = c & 7; const bf16_t* pr = p.PROJ + (size_t)(tok0 + r) * LDP;
        qv_[q] = *(const u32x4v*)(pr + OFF_Q + h * 64 + cc * 8); kv_[q] = *(const u32x4v*)(pr + OFF_K + h * 64 + cc * 8); }
    if (tid < 256) gk = *(const u32x4v*)(p.PROJ + (size_t)(tok0 + (tid >> 1)) * LDP + OFF_GK + (tid & 1) * 8);
    float upf[16], upb[16];
#pragma unroll
    for (int r = 0; r < 16; ++r) { upf[r] = p.gk_up_f[l * 16 * 256 + r * 256 + h * 64 + k]; upb[r] = p.gk_up_b[l * 16 * 256 + r * 256 + h * 64 + k]; }
    const float biasf = p.gk_bias_f[l * 256 + h * 64 + k], biasb = p.gk_bias_b[l * 256 + h * 64 + k];
    __syncthreads();
#pragma unroll
    for (int q = 0; q < 2; ++q) { const int c = tid + q * NTHR, r = c >> 3, cc = c & 7; *(LDSP u32x4v*)(QT + r * LD64 + cc * 8) = qv_[q]; *(LDSP u32x4v*)(KT + r * LD64 + cc * 8) = kv_[q]; }
    if (tid < 256) { float v[8]; unpack8(gk, v); LDSP f32x4v* d = (LDSP f32x4v*)(GKL + (tid >> 1) * 20 + (tid & 1) * 8); d[0] = mkf4(v[0], v[1], v[2], v[3]); d[1] = mkf4(v[4], v[5], v[6], v[7]); }
    __syncthreads();
    float gf[16], gb[16];
#pragma unroll
    for (int s = 0; s < 16; ++s) { LDSP const f32x4v* gl = (LDSP const f32x4v*)(GKL + (8 * s + seg) * 20)  ; float af = biasf, ab = biasb;
#pragma unroll
        for (int q = 0; q < 4; ++q) { const f32x4v v = gl[q];
#pragma unroll
            for (int j = 0; j < 4; ++j) { af += v[j] * upf[4 * q + j]; ab += v[j] * upb[4 * q + j]; } }
        gf[s] = fast_logsigmoid(af) * (1.0f / 16.0f); gb[s] = fast_logsigmoid(ab) * (1.0f / 16.0f); }
    float totf = 0.f, totb = 0.f;
#pragma unroll
    for (int s = 0; s < 16; ++s) { float x = gf[s];
        float t = shl(x, lane - 1); if (seg >= 1) x += t; t = shl(x, lane - 2); if (seg >= 2) x += t; t = shl(x, lane - 4); if (seg >= 4) x += t;
        gf[s] = totf + x; totf += shl(x, base + 7); }
#pragma unroll
    for (int s = 15; s >= 0; --s) { float x = gb[s];
        float t = shl(x, lane + 1); if (seg <= 6) x += t; t = shl(x, lane + 2); if (seg <= 5) x += t; t = shl(x, lane + 4); if (seg <= 3) x += t;
        gb[s] = totb + x; totb += shl(x, base); }
#pragma unroll
    for (int s = 0; s < 16; ++s) { const int j = 8 * s + seg; const float qv = bf2f(QT[j * LD64 + k]) * 0.125f, kv = bf2f(KT[j * LD64 + k]);
        const float bf = gf[s], bb = gb[s]; LDSP bf16_t* o = O4 + j * LD64 + k;
        o[0] = f2bf(qv * __expf(bf)); o[128 * LD64] = f2bf(kv * __expf(-bf)); o[2 * 128 * LD64] = f2bf(qv * __expf(bb)); o[3 * 128 * LD64] = f2bf(kv * __expf(-bb)); }
    LDSP float* DEC = GKL;
    __syncthreads();
    if (seg == 0) { const float df = __expf(totf), db = __expf(totb); p.GDEC[(size_t)((tl * 4 + h) * 2 + 0) * 64 + k] = df; p.GDEC[(size_t)((tl * 4 + h) * 2 + 1) * 64 + k] = db; DEC[k] = df; DEC[64 + k] = db; }
    LDSP bf16_t* VT = QT;
#pragma unroll
    for (int q = 0; q < 4; ++q) { const int c = tid + q * NTHR, r = c >> 4, cc = c & 15; *(LDSP u32x4v*)(VT + r * LD128 + cc * 8) = vv_[q]; }
#pragma unroll
    for (int q = 0; q < 8; ++q) { const int c = tid + q * NTHR, a4 = c >> 10, r = (c >> 3) & 127, cc = c & 7;
        *(u32x4v*)(p.QKB + (size_t)(tok0 + r) * 1024 + a4 * 256 + h * 64 + cc * 8) = *(LDSP const u32x4v*)(O4 + (a4 * 128 + r) * LD64 + cc * 8); }
    __syncthreads();
    { const int w = __builtin_amdgcn_readfirstlane(tid >> 6), dir = w >> 2, ut = w & 3; LDSP const bf16_t* KE = O4 + (dir ? 3 : 1) * 128 * LD64;
      f32x4v acc[8];
#pragma unroll
      for (int q = 0; q < 8; ++q) acc[q] = (f32x4v){0.f, 0.f, 0.f, 0.f};
#pragma unroll
      for (int ks = 0; ks < 4; ++ks) { const bf16x8v u = frag_col(KE, LD64, 16 * ut, 32 * ks, lane);
#pragma unroll
          for (int q = 0; q < 8; ++q) acc[q] = mfma16(u, frag_col(VT, LD128, 16 * q, 32 * ks, lane), acc[q]); }
      const f32x4v dec = *(LDSP const f32x4v*)(DEC + dir * 64 + 16 * ut + 4 * (lane >> 4));
      bf16_t* dst = p.GS + ((size_t)((tl * 4 + h) * 2 + dir) * 128) * 64;
#pragma unroll
      for (int q = 0; q < 8; ++q) *(u32x2v*)(dst + (size_t)(16 * q + (lane & 15)) * 64 + 16 * ut + 4 * (lane >> 4)) = pack4(acc[q] * dec); }
}
constexpr int NPREP_A = (T / 32) * 2, NPREP_B = NTILE * 8;
DI void ph_prep(const P& p, int l, LDSP unsigned char* lds) {
    const int tid_ = ltid(), lane = tid_ & 63, gw = blockIdx.x * NWV + (tid_ >> 6), NW = gridDim.x * NWV;
    for (int it = gw; it < NPREP_A + NPREP_B; it += NW) {
        if (it < NPREP_A) prep_conv_item(p, l, it, lane); else prep_ssd_item(p, l, it - NPREP_A, lane);
    }
    for (int it = blockIdx.x; it < NTILE * 4; it += gridDim.x) prep_gla_block(p, l, it >> 2, it & 3, lds);
}

DI void s1_ssd(const P& p, int tl, int h, LDSP unsigned char* lds) {
    const int tid = ltid(), lane = tid & 63, w = __builtin_amdgcn_readfirstlane(tid >> 6);
    const int tok0 = tile_tok0(tl), g = h >> 2; const XbcSrc xs = xbc_src(p, tok0);
    LDSP bf16_t* XWF = (LDSP bf16_t*)lds; LDSP bf16_t* XWB = XWF + 128 * LD64; LDSP bf16_t* BG = XWB + 128 * LD64;
    const int j = tid >> 2, cq = tid & 3;
    const bf16_t* row = xs.base + (size_t)j * xs.ld;
    const u32x4v x0 = *(const u32x4v*)(row + h * 64 + cq * 16), x1 = *(const u32x4v*)(row + h * 64 + cq * 16 + 8);
    const u32x4v b0 = *(const u32x4v*)(row + 512 + g * 64 + cq * 16), b1 = *(const u32x4v*)(row + 512 + g * 64 + cq * 16 + 8);
    const f32x4v sc = *((const f32x4v*)p.SSC + (size_t)(tok0 + j) * 8 + h);
    const float wf = __builtin_amdgcn_exp2f(p.STOT[(tl * 8 + h) * 2 + 0] - sc.y), wb = __builtin_amdgcn_exp2f(p.STOT[(tl * 8 + h) * 2 + 1] - sc.w);
    float xv[16], of[16], ob[16]; unpack8(x0, xv); unpack8(x1, xv + 8);
#pragma unroll
    for (int c = 0; c < 16; ++c) { of[c] = xv[c] * wf; ob[c] = xv[c] * wb; }
    __syncthreads();
    *(LDSP u32x4v*)(XWF + j * LD64 + cq * 16) = pack8(of); *(LDSP u32x4v*)(XWF + j * LD64 + cq * 16 + 8) = pack8(of + 8);
    *(LDSP u32x4v*)(XWB + j * LD64 + cq * 16) = pack8(ob); *(LDSP u32x4v*)(XWB + j * LD64 + cq * 16 + 8) = pack8(ob + 8);
    *(LDSP u32x4v*)(BG + j * LD64 + cq * 16) = b0; *(LDSP u32x4v*)(BG + j * LD64 + cq * 16 + 8) = b1;
    __syncthreads();
    const int dir = w >> 2, ut = w & 3; LDSP const bf16_t* XW = dir ? XWB : XWF;
    f32x4v acc[4];
#pragma unroll
    for (int q = 0; q < 4; ++q) acc[q] = (f32x4v){0.f, 0.f, 0.f, 0.f};
#pragma unroll
    for (int ks = 0; ks < 4; ++ks) { const bf16x8v u = frag_col(BG, LD64, 16 * ut, 32 * ks, lane);
#pragma unroll
        for (int q = 0; q < 4; ++q) acc[q] = mfma16(u, frag_col(XW, LD64, 16 * q, 32 * ks, lane), acc[q]); }
    bf16_t* dst = p.SS + ((size_t)((tl * 8 + h) * 2 + dir) * 64) * 64;
#pragma unroll
    for (int q = 0; q < 4; ++q) *(u32x2v*)(dst + (size_t)(16 * q + (lane & 15)) * 64 + 16 * ut + 4 * (lane >> 4)) = pack4(acc[q]);
}
DI void ph_s1(const P& p, int l, LDSP unsigned char* lds) {
    for (int it = blockIdx.x; it < NTILE * 8; it += gridDim.x) s1_ssd(p, it >> 3, it & 7, lds);
}

DI int s2_chunk(int dir, int s) { return dir == 0 ? s : (s < 2 ? 1 - s : 35 - s); }
DI void ph_s2(const P& p) {
    const int g = blockIdx.x * NTHR + ltid();
    for (int v = g; v < 131072; v += gridDim.x * NTHR) {
        const bool gla = v >= 65536; const int r = v & 65535;
        int b, h, dir, vi;
        if (!gla) { vi = r & 511; dir = (r >> 9) & 1; h = (r >> 10) & 7; b = r >> 13; } else { vi = r & 1023; dir = (r >> 10) & 1; h = (r >> 11) & 3; b = r >> 13; }
        float st[8];
#pragma unroll
        for (int e = 0; e < 8; ++e) st[e] = 0.f;
        for (int s0 = 0; s0 < NCH; s0 += 6) {
            u32x4v sv[6]; float dsc[6]; f32x4v dv0[6], dv1[6];
#pragma unroll
            for (int u = 0; u < 6; ++u) { if (s0 + u >= NCH) continue; const int tl = b * NCH + s2_chunk(dir, s0 + u);
                if (!gla) { sv[u] = *(const u32x4v*)(p.SS + ((size_t)((tl * 8 + h) * 2 + dir) * 512 + vi) * 8); dsc[u] = p.SDEC[(tl * 8 + h) * 2 + dir]; }
                else { sv[u] = *(const u32x4v*)(p.GS + ((size_t)((tl * 4 + h) * 2 + dir) * 1024 + vi) * 8); const f32x4v* d = (const f32x4v*)(p.GDEC + (size_t)((tl * 4 + h) * 2 + dir) * 64 + (vi & 7) * 8); dv0[u] = d[0]; dv1[u] = d[1]; } }
#pragma unroll
            for (int u = 0; u < 6; ++u) { if (s0 + u >= NCH) continue; const int tl = b * NCH + s2_chunk(dir, s0 + u);
                float loc[8]; unpack8(sv[u], loc);
                const u32x4v hin = pack8(st);
                if (!gla) { *(u32x4v*)(p.SS + ((size_t)((tl * 8 + h) * 2 + dir) * 512 + vi) * 8) = hin;
#pragma unroll
                    for (int e = 0; e < 8; ++e) st[e] = dsc[u] * st[e] + loc[e]; }
                else { *(u32x4v*)(p.GS + ((size_t)((tl * 4 + h) * 2 + dir) * 1024 + vi) * 8) = hin;
                    const float dd[8] = {dv0[u].x, dv0[u].y, dv0[u].z, dv0[u].w, dv1[u].x, dv1[u].y, dv1[u].z, dv1[u].w};
#pragma unroll
                    for (int e = 0; e < 8; ++e) st[e] = dd[e] * st[e] + loc[e]; } }
        }
    }
}

DI int s3_tile(int l, int q) { return l == 0 ? q : (q >> 5) * NCH + 2 + (q & 31); }
struct SsdPre { u32x4v x0, x1, b0, b1, c0, c1, hf, hb; f32x4v sc; };
DI void s3_ssd_load(const P& p, int tl, int h, int tid, int i, int G, SsdPre& r) {
    const int tok0 = tile_tok0(tl), g = h >> 2; const XbcSrc xs = xbc_src(p, tok0);
    const int j = tid >> 2, cq = tid & 3; const bf16_t* row = xs.base + (size_t)j * xs.ld;
    r.x0 = *(const u32x4v*)(row + h * 64 + cq * 16); r.x1 = *(const u32x4v*)(row + h * 64 + cq * 16 + 8);
    r.b0 = *(const u32x4v*)(row + 512 + g * 64 + cq * 16); r.b1 = *(const u32x4v*)(row + 512 + g * 64 + cq * 16 + 8);
    r.c0 = *(const u32x4v*)(row + 640 + g * 64 + cq * 16); r.c1 = *(const u32x4v*)(row + 640 + g * 64 + cq * 16 + 8);
    const bf16_t* Hf = p.SS + (size_t)((tl * 8 + h) * 2 + 0) * 4096 + (tid >> 3) * 64 + (tid & 7) * 8;
    r.hf = *(const u32x4v*)Hf; r.hb = *(const u32x4v*)(Hf + 4096);
    r.sc = *((const f32x4v*)p.SSC + (size_t)(tok0 + (tid & 127)) * 8 + h);
}
DI void ph_s3_ssd(const P& p, int l, LDSP unsigned char* lds) {
    const int tid = ltid(), lane = tid & 63, w = __builtin_amdgcn_readfirstlane(tid >> 6), G = lane >> 4, li = lane & 15, i = 16 * w + li;
    LDSP bf16_t* XH = (LDSP bf16_t*)lds; LDSP bf16_t* BG = XH + 128 * LD64; LDSP bf16_t* CG = BG + 128 * LD64; LDSP bf16_t* MM = CG + 128 * LD64; LDSP f32x4v* SC = (LDSP f32x4v*)(MM + 128 * LD128);
    LDSP bf16_t* HF = (LDSP bf16_t*)(SC + 128); LDSP bf16_t* HB = HF + 64 * LD64;
    const int nit = (l == 0 ? NTILE : NB * 32) * 8, GS_ = gridDim.x;
    int it = ((int)blockIdx.x + (GS_ >> 1)) % GS_; SsdPre pre;
    if (it < nit) s3_ssd_load(p, s3_tile(l, it >> 3), it & 7, tid, i, G, pre);
    for (; it < nit; it += GS_) {
        const int tl = s3_tile(l, it >> 3), h = it & 7, tok0 = tile_tok0(tl);
        __syncthreads();
        { const int j = tid >> 2, cq = tid & 3;
          *(LDSP u32x4v*)(XH + j * LD64 + cq * 16) = pre.x0; *(LDSP u32x4v*)(XH + j * LD64 + cq * 16 + 8) = pre.x1;
          *(LDSP u32x4v*)(BG + j * LD64 + cq * 16) = pre.b0; *(LDSP u32x4v*)(BG + j * LD64 + cq * 16 + 8) = pre.b1;
          *(LDSP u32x4v*)(CG + j * LD64 + cq * 16) = pre.c0; *(LDSP u32x4v*)(CG + j * LD64 + cq * 16 + 8) = pre.c1;
          *(LDSP u32x4v*)(HF + (tid >> 3) * LD64 + (tid & 7) * 8) = pre.hf; *(LDSP u32x4v*)(HB + (tid >> 3) * LD64 + (tid & 7) * 8) = pre.hb;
          if (tid < 128) SC[tid] = pre.sc; }
        if (it + GS_ < nit) s3_ssd_load(p, s3_tile(l, (it + GS_) >> 3), (it + GS_) & 7, tid, i, G, pre);
        __syncthreads();
        u32x2v zr[4];
#pragma unroll
        for (int pt = 0; pt < 4; ++pt) zr[pt] = *(const u32x2v*)(p.PROJ + (size_t)(tok0 + i) * LDP + OFF_Z + h * 64 + 16 * pt + 4 * G);
        const f32x4v sci = SC[i];
        {
            f32x4v am[8];
#pragma unroll
            for (int ut = 0; ut < 8; ++ut) am[ut] = (f32x4v){0.f, 0.f, 0.f, 0.f};
#pragma unroll
            for (int ks = 0; ks < 2; ++ks) { const bf16x8v vfr = frag_row(CG, LD64, 16 * w, 32 * ks, lane);
#pragma unroll
                for (int ut = 0; ut < 8; ++ut) am[ut] = mfma16(frag_row(BG, LD64, 16 * ut, 32 * ks, lane), vfr, am[ut]); }
#pragma unroll
            for (int ut = 0; ut < 8; ++ut) { f32x4v m;
#pragma unroll
                for (int r = 0; r < 4; ++r) { const int jj = 16 * ut + 4 * G + r; const f32x4v scj = SC[jj];
                    const float Lf = jj <= i ? __builtin_amdgcn_exp2f(fminf(sci.x - scj.y, 30.f)) : 0.f, Lb = jj >= i ? __builtin_amdgcn_exp2f(fminf(sci.z - scj.w, 30.f)) : 0.f;
                    m[r] = am[ut][r] * (Lf + Lb); }
                *(LDSP u32x2v*)(MM + i * LD128 + 16 * ut + 4 * G) = pack4(m); }
        }
        asm volatile("s_waitcnt lgkmcnt(0)" ::: "memory");
        f32x4v ay[4], af_[4], ab_[4];
#pragma unroll
        for (int pt = 0; pt < 4; ++pt) { ay[pt] = (f32x4v){0.f, 0.f, 0.f, 0.f}; af_[pt] = ay[pt]; ab_[pt] = ay[pt]; }
#pragma unroll
        for (int ks = 0; ks < 2; ++ks) { const bf16x8v vfr = frag_row(CG, LD64, 16 * w, 32 * ks, lane);
#pragma unroll
            for (int pt = 0; pt < 4; ++pt) { af_[pt] = mfma16(frag_row(HF, LD64, 16 * pt, 32 * ks, lane), vfr, af_[pt]); ab_[pt] = mfma16(frag_row(HB, LD64, 16 * pt, 32 * ks, lane), vfr, ab_[pt]); } }
#pragma unroll
        for (int ks = 0; ks < 4; ++ks) { const bf16x8v vfr = frag_row(MM, LD128, 16 * w, 32 * ks, lane);
#pragma unroll
            for (int pt = 0; pt < 4; ++pt) ay[pt] = mfma16(frag_col(XH, LD64, 16 * pt, 32 * ks, lane), vfr, ay[pt]); }
        const float sf = __builtin_amdgcn_exp2f(sci.x), sb = __builtin_amdgcn_exp2f(sci.z), dsk = p.d_skip[l * 8 + h];
        float ssq = 0.f;
#pragma unroll
        for (int pt = 0; pt < 4; ++pt) { const int pc = 16 * pt + 4 * G;
            const u32x2v xr = *(LDSP const u32x2v*)(XH + i * LD64 + pc);
            const float xv[4] = {__uint_as_float(xr.x << 16), __uint_as_float(xr.x & 0xffff0000u), __uint_as_float(xr.y << 16), __uint_as_float(xr.y & 0xffff0000u)};
            const float zv[4] = {__uint_as_float(zr[pt].x << 16), __uint_as_float(zr[pt].x & 0xffff0000u), __uint_as_float(zr[pt].y << 16), __uint_as_float(zr[pt].y & 0xffff0000u)};
            float yv[4];
#pragma unroll
            for (int r = 0; r < 4; ++r) { yv[r] = (ay[pt][r] + sf * af_[pt][r] + sb * ab_[pt][r] + dsk * xv[r]) * siluf(zv[r]); yv[r] = bf2f(f2bf(yv[r])); ssq += yv[r] * yv[r]; }
            *(u32x2v*)(p.H + (size_t)(tok0 + i) * D + h * 64 + pc) = mk2(pk2(yv[0], yv[1]), pk2(yv[2], yv[3])); }
        ssq += shx(ssq, 16, lane); ssq += shx(ssq, 32, lane);
        if (G == 0) p.SSQ[(size_t)(tok0 + i) * 8 + h] = ssq;
    }
}
struct GlaPre { u32x4v qk[2][4], vv[4], sf[2], sb[2]; };
DI void s3_gla_load(const P& p, int tl, int h, int tid, int i, int G, GlaPre& r) {
    const int tok0 = tile_tok0(tl);
#pragma unroll
    for (int q = 0; q < 2; ++q) { const int c = tid + q * NTHR, rr = c >> 3, cc = c & 7; const bf16_t* qb = p.QKB + (size_t)(tok0 + rr) * 1024 + h * 64 + cc * 8;
        r.qk[q][0] = *(const u32x4v*)qb; r.qk[q][1] = *(const u32x4v*)(qb + 256);
        r.qk[q][2] = *(const u32x4v*)(qb + 512); r.qk[q][3] = *(const u32x4v*)(qb + 768);
        const bf16_t* Sg = p.GS + (size_t)((tl * 4 + h) * 2 + 0) * 8192 + (size_t)rr * 64 + cc * 8; r.sf[q] = *(const u32x4v*)Sg; r.sb[q] = *(const u32x4v*)(Sg + 8192); }
#pragma unroll
    for (int q = 0; q < 4; ++q) { const int c = tid + q * NTHR, rr = c >> 4, cc = c & 15; r.vv[q] = *(const u32x4v*)(p.PROJ + (size_t)(tok0 + rr) * LDP + OFF_V + h * 128 + cc * 8); }
}
DI void ph_s3_gla(const P& p, int l, LDSP unsigned char* lds) {
    const int tid = ltid(), lane = tid & 63, w = __builtin_amdgcn_readfirstlane(tid >> 6), G = lane >> 4, li = lane & 15, i = 16 * w + li;
    LDSP bf16_t* Q2 = (LDSP bf16_t*)lds;
    LDSP bf16_t* KF = Q2 + 8 * 2 * 16 * LD64; LDSP bf16_t* KB = KF + 128 * LD64; LDSP bf16_t* VT = KB + 128 * LD64; LDSP bf16_t* SF = VT + 128 * LD128; LDSP bf16_t* SB = SF + 128 * LD64;
    LDSP bf16_t* AMw = SF + w * 16 * LD128;
    const int nit = (l == 0 ? NTILE : NB * 32) * 4, GS_ = gridDim.x;
    int it = blockIdx.x; GlaPre pre;
    if (it < nit) s3_gla_load(p, s3_tile(l, it >> 2), it & 3, tid, i, G, pre);
    for (; it < nit; it += GS_) {
        const int tl = s3_tile(l, it >> 2), h = it & 3, tok0 = tile_tok0(tl);
        __syncthreads();
#pragma unroll
        for (int q = 0; q < 2; ++q) { const int c = tid + q * NTHR, rr = c >> 3, cc = c & 7; LDSP bf16_t* qrow = Q2 + (rr >> 4) * (2 * 16 * LD64) + (rr & 15) * LD64 + cc * 8;
            *(LDSP u32x4v*)qrow = pre.qk[q][0]; *(LDSP u32x4v*)(qrow + 16 * LD64) = pre.qk[q][2];
            *(LDSP u32x4v*)(KF + rr * LD64 + cc * 8) = pre.qk[q][1]; *(LDSP u32x4v*)(KB + rr * LD64 + cc * 8) = pre.qk[q][3];
            *(LDSP u32x4v*)(SF + rr * LD64 + cc * 8) = pre.sf[q]; *(LDSP u32x4v*)(SB + rr * LD64 + cc * 8) = pre.sb[q]; }
#pragma unroll
        for (int q = 0; q < 4; ++q) { const int c = tid + q * NTHR, rr = c >> 4, cc = c & 15; *(LDSP u32x4v*)(VT + rr * LD128 + cc * 8) = pre.vv[q]; }
        if (it + GS_ < nit) s3_gla_load(p, s3_tile(l, (it + GS_) >> 2), (it + GS_) & 3, tid, i, G, pre);
        __syncthreads();
        f32x4v ao[8];
#pragma unroll
        for (int q = 0; q < 8; ++q) ao[q] = (f32x4v){0.f, 0.f, 0.f, 0.f};
        bf16x8v qfr[2][2];
#pragma unroll
        for (int dir = 0; dir < 2; ++dir)
#pragma unroll
            for (int ks = 0; ks < 2; ++ks) qfr[dir][ks] = frag_row(Q2 + w * (2 * 16 * LD64) + dir * 16 * LD64, LD64, 0, 32 * ks, lane);
#pragma unroll
        for (int dir = 0; dir < 2; ++dir) {
            LDSP const bf16_t* SS_ = dir ? SB : SF;
#pragma unroll
            for (int ks = 0; ks < 2; ++ks) {
#pragma unroll
                for (int vt = 0; vt < 8; ++vt) ao[vt] = mfma16(frag_row(SS_, LD64, 16 * vt, 32 * ks, lane), qfr[dir][ks], ao[vt]); }
        }
        __syncthreads();
#pragma unroll
        for (int uh = 0; uh < 4; ++uh) {
            f32x4v a2[2]; a2[0] = (f32x4v){0.f, 0.f, 0.f, 0.f}; a2[1] = a2[0];
#pragma unroll
            for (int dir = 0; dir < 2; ++dir) {
                LDSP const bf16_t* KS = dir ? KB : KF;
                f32x4v as[2]; as[0] = (f32x4v){0.f, 0.f, 0.f, 0.f}; as[1] = as[0];
#pragma unroll
                for (int ks = 0; ks < 2; ++ks) {
#pragma unroll
                    for (int q = 0; q < 2; ++q) as[q] = mfma16(frag_row(KS, LD64, 16 * (2 * uh + q), 32 * ks, lane), qfr[dir][ks], as[q]); }
#pragma unroll
                for (int q = 0; q < 2; ++q)
#pragma unroll
                    for (int r = 0; r < 4; ++r) { const int jj = 16 * (2 * uh + q) + 4 * G + r; const bool keep = dir == 0 ? (jj <= i) : (jj >= i); a2[q][r] += keep ? as[q][r] : 0.f; }
            }
#pragma unroll
            for (int q = 0; q < 2; ++q) *(LDSP u32x2v*)(AMw + li * LD128 + 16 * (2 * uh + q) + 4 * G) = pack4(a2[q]);
        }
        u32x2v gr[8];
#pragma unroll
        for (int vt = 0; vt < 8; ++vt) gr[vt] = *(const u32x2v*)(p.PROJ + (size_t)(tok0 + i) * LDP + OFF_GO + h * 128 + 16 * vt + 4 * G);
        asm volatile("s_waitcnt lgkmcnt(0)" ::: "memory");
#pragma unroll
        for (int ks = 0; ks < 4; ++ks) { const bf16x8v vfr = frag_row(AMw, LD128, 0, 32 * ks, lane);
#pragma unroll
            for (int vt = 0; vt < 8; ++vt) ao[vt] = mfma16(frag_col(VT, LD128, 16 * vt, 32 * ks, lane), vfr, ao[vt]); }
        float so = 0.f;
#pragma unroll
        for (int vt = 0; vt < 8; ++vt)
#pragma unroll
            for (int r = 0; r < 4; ++r) so += ao[vt][r] * ao[vt][r];
        so += shx(so, 16, lane); so += shx(so, 32, lane);
        const float ro = rsqrtf(so * (1.0f / 128.0f) + 1e-6f);
#pragma unroll
        for (int vt = 0; vt < 8; ++vt) { const int vc = 16 * vt + 4 * G; const f32x4v gg = *(const f32x4v*)(p.gla_norm_g + l * 128 + vc);
            const float g0 = __uint_as_float(gr[vt].x << 16), g1 = __uint_as_float(gr[vt].x & 0xffff0000u), g2 = __uint_as_float(gr[vt].y << 16), g3 = __uint_as_float(gr[vt].y & 0xffff0000u);
            *(u32x2v*)(p.H + (size_t)(tok0 + i) * D + 512 + h * 128 + vc) = mk2(pk2(ao[vt][0] * ro * gg.x * siluf(g0), ao[vt][1] * ro * gg.y * siluf(g1)), pk2(ao[vt][2] * ro * gg.z * siluf(g2), ao[vt][3] * ro * gg.w * siluf(g3))); }
    }
}
DI void ph_s3(const P& p, int l, LDSP unsigned char* lds) { ph_s3_gla(p, l, lds); ph_s3_ssd(p, l, lds); }
DI void ph_normroute(const P& p, int l, int t0, LDSP unsigned char* lds) {
    const int tid_ = ltid(), lane = tid_ & 63, wv = tid_ >> 6, gw = blockIdx.x * NWV + wv, NW = gridDim.x * NWV, G = lane >> 4, li = lane & 15;
    const float* MODl = p.MOD + (size_t)l * 9 * 6144; int* counts = p.counts + l * 32 * 32;
    constexpr int LDW = 1032, LDT = 264;
    LDSP bf16_t* WR = (LDSP bf16_t*)lds;
    LDSP bf16_t* HT = WR + 32 * LDW + wv * 16 * LDT;
    { u32x4v wv_[8];
#pragma unroll
      for (int q = 0; q < 8; ++q) wv_[q] = *(const u32x4v*)(p.WRT + (size_t)(tid_ + q * NTHR) * 8);
#pragma unroll
      for (int q = 0; q < 8; ++q) { const int c = tid_ + q * NTHR; *(LDSP u32x4v*)(WR + (c >> 7) * LDW + (c & 127) * 8) = wv_[q]; } }
    __syncthreads();
    const int ntile = (T - t0) >> 4;
    const float* g2 = p.norm2_g + l * D;
    for (int tile = gw; tile < ntile; tile += NW) {
        const int tb = t0 + tile * 16;
        const float* mr = MODl + (size_t)tok_modrow(tb) * 6144;
        float rs[16];
        { const f32x4v* q = (const f32x4v*)(p.XSS + (size_t)(tb + li) * 16); const f32x4v a = q[0], b = q[1], c = q[2], d = q[3];
          const float ss = (((a.x + a.y) + (a.z + a.w)) + ((b.x + b.y) + (b.z + b.w))) + (((c.x + c.y) + (c.z + c.w)) + ((d.x + d.y) + (d.z + d.w)));
          const float r = rsqrtf(ss * (1.0f / D) + 1e-6f);
#pragma unroll
          for (int i = 0; i < 16; ++i) rs[i] = shl(r, i); }
        f32x4v acc[2]; acc[0] = (f32x4v){0.f, 0.f, 0.f, 0.f}; acc[1] = acc[0];
        u32x2v xq[16];
#pragma unroll
        for (int i = 0; i < 16; ++i) xq[i] = *(const u32x2v*)(xrow(p, tb + i) + lane * 4);
#pragma unroll
        for (int kc = 0; kc < 4; ++kc) {
            const int kk = kc * 256 + lane * 4;
            const f32x4v gg = *(const f32x4v*)(g2 + kk), sh = *(const f32x4v*)(mr + 3 * 1024 + kk), sc = *(const f32x4v*)(mr + 4 * 1024 + kk);
            f32x4v gs;
#pragma unroll
            for (int j = 0; j < 4; ++j) gs[j] = gg[j] * (1.f + sc[j]);
#pragma unroll
            for (int i = 0; i < 16; ++i) { const u32x2v r = xq[i];
                const f32x4v xv = mkf4(__uint_as_float(r.x << 16), __uint_as_float(r.x & 0xffff0000u), __uint_as_float(r.y << 16), __uint_as_float(r.y & 0xffff0000u));
                const f32x4v h = xv * rs[i] * gs + sh; const u32x2v hb = pack4(h);
                *(u32x2v*)(p.H + (size_t)(tb + i) * D + kk) = hb; *(LDSP u32x2v*)(HT + i * LDT + lane * 4) = hb; }
            if (kc < 3) {
#pragma unroll
                for (int i = 0; i < 16; ++i) xq[i] = *(const u32x2v*)(xrow(p, tb + i) + kk + 256); }
            asm volatile("s_waitcnt lgkmcnt(0)" ::: "memory");
#pragma unroll
            for (int ks = 0; ks < 8; ++ks) { const bf16x8v vfr = frag_row(HT, LDT, 0, 32 * ks, lane);
                acc[0] = mfma16(frag_row(WR, LDW, 0, kc * 256 + 32 * ks, lane), vfr, acc[0]);
                acc[1] = mfma16(frag_row(WR, LDW, 16, kc * 256 + 32 * ks, lane), vfr, acc[1]); }
            asm volatile("s_waitcnt lgkmcnt(0)" ::: "memory");
        }
        float bgs = -1e30f; int bgi = 0, e1 = 0, e2 = 0; float w1 = 0.f, w2 = 0.f;
#pragma unroll
        for (int ut = 0; ut < 2; ++ut) { const int gi = ut * 4 + G; float m1 = -1e30f, m2 = -1e30f, s1 = 0.f, s2 = 0.f; int i1 = 0, i2 = 0;
#pragma unroll
            for (int r = 0; r < 4; ++r) { const float sv = 1.0f / (1.0f + __expf(-acc[ut][r])), vv = sv + p.router_bias[gi * 4 + r];
                if (vv > m1) { m2 = m1; i2 = i1; s2 = s1; m1 = vv; i1 = gi * 4 + r; s1 = sv; } else if (vv > m2) { m2 = vv; i2 = gi * 4 + r; s2 = sv; } }
            if (m1 + m2 > bgs) { bgs = m1 + m2; bgi = gi; e1 = i1; e2 = i2; w1 = s1; w2 = s2; } }
#pragma unroll
        for (int o = 16; o <= 32; o <<= 1) {
            const float ogs = shx(bgs, o, lane), ow1 = shx(w1, o, lane), ow2 = shx(w2, o, lane); const int ogi = shxi(bgi, o, lane), oe1 = shxi(e1, o, lane), oe2 = shxi(e2, o, lane);
            if (ogs > bgs || (ogs == bgs && ogi < bgi)) { bgs = ogs; bgi = ogi; e1 = oe1; e2 = oe2; w1 = ow1; w2 = ow2; } }
        if (G == 0) {
            const int t = tb + li; const float inv = 1.0f / (w1 + w2);
            const int r1 = atomicAdd(&counts[e1 * 32], 1), r2 = atomicAdd(&counts[e2 * 32], 1);
            p.MAP[(size_t)e1 * T + r1] = t; p.MAP[(size_t)e2 * T + r2] = t;
            p.TOKSLOT[t * 4 + 0] = e1; p.TOKSLOT[t * 4 + 1] = r1; p.TOKSLOT[t * 4 + 2] = e2; p.TOKSLOT[t * 4 + 3] = r2;
            p.EW[t * 2 + 0] = w1 * inv; p.EW[t * 2 + 1] = w2 * inv;
        }
    }
}

DI void ph_combine(const P& p, int l, int t0, const unsigned char* Y  , LDSP int* ps  ) {
    const int tid_ = ltid(), lane = tid_ & 63, gw = blockIdx.x * NWV + (tid_ >> 6), NW = gridDim.x * NWV;
    const float* MODl = p.MOD + (size_t)l * 9 * 6144; const int* counts = p.counts + l * 32 * 32;
    if (tid_ < 64) { const int cnt = tid_ < 32 ? counts[tid_ * 32] : 0; int pc = cnt;
#pragma unroll
        for (int o = 1; o < 32; o <<= 1) { const int src = lane >= o ? lane - o : lane; const int a = shli(pc, src); if (lane >= o) pc += a; }
        if (tid_ < 32) ps[tid_] = pc - cnt; }
    __syncthreads();
    for (int t = t0 + 4 * gw; t < T; t += 4 * NW) {
        int4 sl[4]; float4 ew[2];
#pragma unroll
        for (int u = 0; u < 4; ++u) sl[u] = *(const int4*)(p.TOKSLOT + (size_t)(t + u) * 4);
        ew[0] = *(const float4*)(p.EW + (size_t)t * 2); ew[1] = *(const float4*)(p.EW + (size_t)(t + 2) * 2);
        unsigned yr[4][2][4];
#pragma unroll
        for (int u = 0; u < 4; ++u) { const unsigned char* y0 = Y + (size_t)(ps[sl[u].x] + sl[u].y) * D; const unsigned char* y1 = Y + (size_t)(ps[sl[u].z] + sl[u].w) * D;
#pragma unroll
            for (int i = 0; i < 4; ++i) { yr[u][0][i] = *(const unsigned*)(y0 + (i * 64 + lane) * 4); yr[u][1][i] = *(const unsigned*)(y1 + (i * 64 + lane) * 4); } }
        const float* mrow = MODl + (size_t)tok_modrow(t) * 6144; const float* g5 = mrow + 5 * 1024;
        const float* mr1 = p.MOD + (size_t)9 * 6144 + (size_t)tok_modrow(t) * 6144;
#pragma unroll
        for (int pr = 0; pr < 2; ++pr) {
            const float wgt[2][2] = {{ew[pr].x, ew[pr].y}, {ew[pr].z, ew[pr].w}};
            u32x2v xr[2][4];
#pragma unroll
            for (int u = 0; u < 2; ++u)
#pragma unroll
                for (int i = 0; i < 4; ++i) xr[u][i] = *(const u32x2v*)(xrow(p, t + 2 * pr + u) + (i * 64 + lane) * 4);
            float4 v[2][4];
#pragma unroll
            for (int i = 0; i < 4; ++i) { const int c = (i * 64 + lane) * 4; const float4 gg = *(const float4*)(g5 + c);
#pragma unroll
                for (int u = 0; u < 2; ++u) { const u32x2v x = xr[u][i]; const int a = (int)yr[2 * pr + u][0][i], b = (int)yr[2 * pr + u][1][i]; const float w1 = wgt[u][0], w2 = wgt[u][1];
                    v[u][i].x = __uint_as_float(x.x << 16) + gg.x * (w1 * __builtin_amdgcn_cvt_f32_fp8(a, 0) + w2 * __builtin_amdgcn_cvt_f32_fp8(b, 0));
                    v[u][i].y = __uint_as_float(x.x & 0xffff0000u) + gg.y * (w1 * __builtin_amdgcn_cvt_f32_fp8(a, 1) + w2 * __builtin_amdgcn_cvt_f32_fp8(b, 1));
                    v[u][i].z = __uint_as_float(x.y << 16) + gg.z * (w1 * __builtin_amdgcn_cvt_f32_fp8(a, 2) + w2 * __builtin_amdgcn_cvt_f32_fp8(b, 2));
                    v[u][i].w = __uint_as_float(x.y & 0xffff0000u) + gg.w * (w1 * __builtin_amdgcn_cvt_f32_fp8(a, 3) + w2 * __builtin_amdgcn_cvt_f32_fp8(b, 3));
                    if (l == 0) *(u32x2v*)(xrow(p, t + 2 * pr + u) + c) = mk2(pk2(v[u][i].x, v[u][i].y), pk2(v[u][i].z, v[u][i].w)); } }
            float rstd[2];
#pragma unroll
            for (int u = 0; u < 2; ++u) { float ss = 0.f;
#pragma unroll
                for (int i = 0; i < 4; ++i) ss += v[u][i].x * v[u][i].x + v[u][i].y * v[u][i].y + v[u][i].z * v[u][i].z + v[u][i].w * v[u][i].w;
                rstd[u] = rsqrtf(wave_sum(ss, lane) * (1.0f / D) + 1e-6f); }
            if (l == 0) {
#pragma unroll
                for (int i = 0; i < 4; ++i) { const int c = (i * 64 + lane) * 4;
                    const float4 gg = *(const float4*)(p.norm1_g + D + c), sh = *(const float4*)(mr1 + c), sc = *(const float4*)(mr1 + 1024 + c);
#pragma unroll
                    for (int u = 0; u < 2; ++u) { const float r = rstd[u];
                        *(u32x2v*)(p.H + (size_t)(t + 2 * pr + u) * D + c) = mk2(pk2(v[u][i].x * r * gg.x * (1.f + sc.x) + sh.x, v[u][i].y * r * gg.y * (1.f + sc.y) + sh.y), pk2(v[u][i].z * r * gg.z * (1.f + sc.z) + sh.z, v[u][i].w * r * gg.w * (1.f + sc.w) + sh.w)); } }
            } else {
#pragma unroll
                for (int u = 0; u < 2; ++u)
#pragma unroll
                    for (int i = 0; i < 4; ++i) { const float4 gg = ((const float4*)p.final_g)[i * 64 + lane]; const float r = rstd[u];
                        ((float4*)(p.out + (size_t)(t + 2 * pr + u - TC) * D))[i * 64 + lane] = make_float4(v[u][i].x * r * gg.x, v[u][i].y * r * gg.y, v[u][i].z * r * gg.z, v[u][i].w * r * gg.w); }
            }
        }
    }
}

#define XLAS __attribute__((address_space(3)))
#define XB_TMO      128
#define XB_XCNT(j)  (256  + 64 * (j))
#define XB_XSUB(j)  (1280 + 64 * (j))
#define XB_XGEN(j)  (2304 + 64 * (j))
#define XB_TOP      3328
#define XB_TOPGEN   3392
#define XCD_BAR_WORDS 3456
#define XB_SPIN_CAP (1u << 18)

__device__ __forceinline__ unsigned xb_ld(unsigned* p)              { return __hip_atomic_load(p, __ATOMIC_RELAXED, __HIP_MEMORY_SCOPE_AGENT); }
__device__ __forceinline__ unsigned xb_add(unsigned* p, unsigned v) { return __hip_atomic_fetch_add(p, v, __ATOMIC_RELAXED, __HIP_MEMORY_SCOPE_AGENT); }
__device__ __forceinline__ unsigned xb_xcc_id() { return (unsigned)__builtin_amdgcn_s_getreg((3 << 11) | 20) & 0xFu; }
#define XB_SPIN(cond, bar) do { unsigned _sp = 0; while (cond) { __builtin_amdgcn_s_sleep(1); \
    if ((++_sp & 255u) == 0u) { if (xb_ld(&(bar)[XB_TMO])) break; if (_sp > XB_SPIN_CAP) { atomicAdd(&(bar)[XB_TMO], 1u); break; } } } } while (0)

struct XcdBarrier {
    unsigned* bar; unsigned x;
    volatile XLAS unsigned* st;
};

__device__ __forceinline__ XcdBarrier xcd_barrier_post(unsigned* bar, volatile XLAS unsigned* st) {
    XcdBarrier b; b.bar = bar; b.x = xb_xcc_id(); b.st = st;
    if (ltid() == 0) (void)xb_add(&bar[XB_XCNT(b.x)], 1u);
    return b;
}
__device__ __forceinline__ void xcd_barrier_complete(unsigned* bar, unsigned x, unsigned& nloc, unsigned& nx) {
    const unsigned G = gridDim.x * gridDim.y * gridDim.z;
    unsigned sum, cnt, mine, sp = 0u;
    for (;;) {
        sum = 0u; cnt = 0u; mine = 0u;
#pragma unroll
        for (unsigned j = 0; j < 16; ++j) { const unsigned c = xb_ld(&bar[XB_XCNT(j)]); sum += c; cnt += (c > 0u) ? 1u : 0u; mine = (j == x) ? c : mine; }
        if (sum == G) break;
        __builtin_amdgcn_s_sleep(1);
        if ((++sp & 255u) == 0u) { if (xb_ld(&bar[XB_TMO])) break; if (sp > XB_SPIN_CAP) { atomicAdd(&bar[XB_TMO], 1u); break; } }
    }
    nloc = mine > 0u ? mine : 1u; nx = cnt > 0u ? cnt : 1u;
}

__device__ __forceinline__ void xcd_barrier(const XcdBarrier& b) {
    asm volatile("s_waitcnt vmcnt(0)" ::: "memory");
    __syncthreads();
    if (ltid() == 0) {
        unsigned* bar = b.bar;
        __builtin_amdgcn_s_waitcnt(0);
        unsigned nloc = b.st[0], nx = b.st[1];
        if (nloc == 0u) { xcd_barrier_complete(bar, b.x, nloc, nx); b.st[0] = nloc; b.st[1] = nx; }
        const unsigned old = xb_add(&bar[XB_XSUB(b.x)], 1u);
        const unsigned gen = old / nloc;
        if (old + 1u == (gen + 1u) * nloc) {
            __builtin_amdgcn_fence(__ATOMIC_RELEASE, "agent");
            asm volatile("s_waitcnt vmcnt(0)" ::: "memory");
            const unsigned og = xb_add(&bar[XB_TOP], 1u);
            const unsigned tg = og / nx;
            if (og + 1u == (tg + 1u) * nx) xb_add(&bar[XB_TOPGEN], 1u);
            else XB_SPIN(xb_ld(&bar[XB_TOPGEN]) == tg, bar);
            __builtin_amdgcn_fence(__ATOMIC_ACQUIRE, "agent");
            xb_add(&bar[XB_XGEN(b.x)], 1u);
            asm volatile("s_waitcnt vmcnt(0)" ::: "memory");
        } else {
            XB_SPIN(xb_ld(&bar[XB_XGEN(b.x)]) == gen, bar);
            __builtin_amdgcn_fence(__ATOMIC_ACQUIRE, "agent");
            asm volatile("s_waitcnt vmcnt(0)" ::: "memory");
        }
    }
    __syncthreads();
}

DI void moe_table(const P& p, int l, PG8_LAS int* tab) {
    const int tid_ = ltid();
    if (tid_ < 64) { const int cnt = tid_ < 32 ? p.counts[(l * 32 + tid_) * 32] : 0; const int nt = (cnt + 255) >> 8; int pt = nt, pc = cnt;
#pragma unroll
        for (int o = 1; o < 32; o <<= 1) { const int ln_ = tid_ & 63, src = ln_ >= o ? ln_ - o : ln_; const int a = shli(pt, src), b = shli(pc, src); if (ln_ >= o) { pt += a; pc += b; } }
        if (tid_ < 32) { tab[tid_ + 1] = pt; tab[33 + tid_] = cnt; tab[65 + tid_] = pc - cnt; if (tid_ == 0) tab[0] = 0; } }
    __syncthreads();
}
typedef const __attribute__((address_space(4))) P* PK;
DI PK lp(PK q) { asm volatile("" : "+s"(q)); return q; }
#define PHASE(...) do { const P p = *(const P*)lp(pk); __VA_ARGS__; } while (0)

template <int l> DI void layer(PK pk, unsigned char* smem, const XcdBarrier& xbar) {
    float* ldsf = (float*)smem; const int gw = 0, NW = 0, lane = 0;
    {
        constexpr int NG = l == 0 ? 234 : 204;
        constexpr int CV1 = l == 0 ? 10 * 768 : NE * 768;
        const int G = (int)gridDim.x == 256 ? NG : (int)gridDim.x;
        if ((int)blockIdx.x < G) PHASE({ pg8::Gemm g{p.H, p.WinT + (size_t)l * NPAD_IN * D, T, NPAD_IN, D}; pg8::StaticOrder S; S.init(T, NPAD_IN, G, (int)blockIdx.x);
            pg8::EpiProj E{p.PROJ, LDP, INDIM};
            pg8::gemm_phase<pg8::EpiProj, pg8::StaticOrder>((PG8_LAS unsigned char*)smem, g, S, E, nullptr); });
        else PHASE(ph_convert_experts(p, l, ldsf, G, (int)gridDim.x - G, 0, CV1));
        if ((int)gridDim.x != 256) PHASE(ph_convert_experts(p, l, ldsf, 0, (int)gridDim.x, 0, CV1));
    }
    xcd_barrier(xbar);
    PHASE(ph_prep(p, l, (LDSP unsigned char*)smem));
    xcd_barrier(xbar);
    PHASE(ph_s1(p, l, (LDSP unsigned char*)smem));
    xcd_barrier(xbar);
    PHASE(ph_s2(p));
    xcd_barrier(xbar);
    PHASE(ph_s3(p, l, (LDSP unsigned char*)smem));
    xcd_barrier(xbar);
    {
        constexpr int ro = l == 0 ? 0 : TC;
        constexpr int NG = l == 0 ? 182 : 256;
        const int G = (int)gridDim.x == 256 ? NG : (int)gridDim.x;
        if ((int)blockIdx.x < G) PHASE({ pg8::Gemm g{p.H + (size_t)ro * D, p.WoutT + (size_t)l * D * D, T - ro, D, D}; pg8::StaticOrder S; S.init(T - ro, D, G, (int)blockIdx.x);
            pg8::EpiResGate<l != 0> E{p.SSQ, p.ctx, p.x, p.XB, p.MOD + (size_t)l * 9 * 6144 + 2 * 1024, p.XSS, ro};
            pg8::gemm_phase<pg8::EpiResGate<l != 0>, pg8::StaticOrder>((PG8_LAS unsigned char*)smem, g, S, E, nullptr); });
        else if (l == 0) PHASE(ph_convert_experts(p, l, ldsf, G, (int)gridDim.x - G, 10 * 768, NE * 768));
        if (l == 0 && (int)gridDim.x != 256) PHASE(ph_convert_experts(p, l, ldsf, 0, (int)gridDim.x, 10 * 768, NE * 768));
    }
    xcd_barrier(xbar);
    const int t0 = l == 0 ? 0 : TC;
    PHASE(ph_normroute(p, l, t0, (LDSP unsigned char*)smem));
    xcd_barrier(xbar);
    PG8_LAS int* tab = (PG8_LAS int*)((PG8_LAS unsigned char*)smem + pg8::STAGE_BYTES);
#pragma unroll
    for (int ph = 0; ph < 2; ++ph) {
        PHASE(moe_table(p, l, tab));
        const int U = __builtin_amdgcn_readfirstlane(tab[32]) * 4;
        if (ph == 0) PHASE({ pg8::Gemm g{p.H, p.WguT, T, D, D}; pg8::MoeSched S{tab, p.MAP, U, (int)gridDim.x, (int)blockIdx.x, 4, 1, (size_t)D * D * 2};
            pg8::EpiAct E{p.SS}; pg8::gemm_phase_moe<pg8::EpiAct, pg8::MoeSched>((PG8_LAS unsigned char*)smem, g, S, E, nullptr); });
        else PHASE({ pg8::Gemm g{p.SS, p.WdT, T, D, 512}; pg8::MoeSched S{tab, p.MAP, U, (int)gridDim.x, (int)blockIdx.x, 4, 0, (size_t)D * 512 * 2};
            pg8::EpiY E{(unsigned char*)p.PROJ}; pg8::gemm_phase_moe<pg8::EpiY, pg8::MoeSched>((PG8_LAS unsigned char*)smem, g, S, E, nullptr); });
        xcd_barrier(xbar);
    }
    PHASE(ph_combine(p, l, t0, (const unsigned char*)p.PROJ, (LDSP int*)smem));
    xcd_barrier(xbar);
}

__global__ void __launch_bounds__(NTHR) mega(P p_arg) {
    extern __shared__ __attribute__((aligned(16))) unsigned char smem[];
    cg::grid_group grid = cg::this_grid();
    PK pk = (PK)__builtin_amdgcn_kernarg_segment_ptr();
    const int lane = 0, gw = 0, NW = 0;
    float* ldsf = (float*)smem;
    volatile XLAS unsigned* bst = (volatile XLAS unsigned*)((XLAS unsigned char*)smem + LDS_BYTES - 16);
    { const int t_ = ltid(); if (t_ < 2) bst[t_] = 0u; }
    __syncthreads();
    const XcdBarrier xbar = xcd_barrier_post(pk->BAR, bst);
    PHASE(ph_init(p)); PHASE(ph_mod(p, ldsf)); PHASE(ph_convert_small(p, ldsf, gw, NW, lane));
    grid.sync();
    PHASE(ph_normmod1(p, 0, gw, NW, lane));
    xcd_barrier(xbar);
    layer<0>(pk, smem, xbar);
    layer<1>(pk, smem, xbar);
}

static inline size_t al(size_t x) { return (x + 255) & ~(size_t)255; }

extern "C" void kernel_launch(void* const* d_in, const int* in_sizes, int n_in, void* d_out, int out_size, void* d_ws, size_t ws_size, hipStream_t stream) {
    static int grid_blocks = 0;
    if (grid_blocks == 0) {
        int dev = 0, cus = 0, per_cu = 0;
        if (hipFuncSetAttribute((const void*)mega, hipFuncAttributeMaxDynamicSharedMemorySize, LDS_BYTES) != hipSuccess) { fprintf(stderr, "hipFuncSetAttribute failed\n"); grid_blocks = -1; return; }
        (void)hipGetDevice(&dev); (void)hipDeviceGetAttribute(&cus, hipDeviceAttributeMultiprocessorCount, dev);
        if (hipOccupancyMaxActiveBlocksPerMultiprocessor(&per_cu, (const void*)mega, NTHR, LDS_BYTES) != hipSuccess || per_cu < 1) { fprintf(stderr, "occupancy query: %d blocks/CU\n", per_cu); grid_blocks = -1; return; }
        grid_blocks = cus;
    }
    if (grid_blocks < 0) return;
    P p{};
    const float** pin = (const float**)&p;
    for (int i = 0; i < 29; ++i) pin[i] = (const float*)d_in[i];
    p.out = (float*)d_out;
    char* ws = (char*)d_ws; size_t off = 0;
    auto take = [&](size_t bytes) { char* q = ws + off; off += al(bytes); return q; };
    p.XB = (bf16_t*)take((size_t)T * D * 2);
    p.H = (bf16_t*)take((size_t)T * D * 2);
    p.PROJ = (bf16_t*)take((size_t)T * LDP * 2);
    p.SS = (bf16_t*)take((size_t)NTILE * 8 * 2 * 4096 * 2);
    p.GS = (bf16_t*)take((size_t)NTILE * 4 * 2 * 8192 * 2);
    p.SDEC = (float*)take((size_t)NTILE * 8 * 2 * 4);
    p.GDEC = (float*)take((size_t)NTILE * 4 * 2 * 64 * 4);
    p.MOD = (float*)take((size_t)2 * 9 * 6144 * 4);
    p.counts = (int*)take(64 * 32 * 4);
    p.TOKSLOT = (int*)take((size_t)T * 4 * 4);
    p.EW = (float*)take((size_t)T * 2 * 4);
    p.MAP = (int*)take((size_t)NE * T * 4);
    p.WinT = (bf16_t*)take((size_t)2 * NPAD_IN * D * 2);
    p.WoutT = (bf16_t*)take((size_t)2 * D * D * 2);
    p.WguT = (bf16_t*)take((size_t)NE * D * D * 2);
    p.WdT = (bf16_t*)take((size_t)NE * D * 512 * 2);
    p.WRT = (bf16_t*)take((size_t)32 * 1024 * 2);
    p.BAR = (unsigned*)take(XCD_BAR_WORDS * 4);
    p.XBCC = (bf16_t*)d_out;
    p.QKB = (bf16_t*)d_out + (size_t)T * 768;
    p.SSC = (float*)take((size_t)T * 8 * 4 * 4);
    p.STOT = (float*)take((size_t)NTILE * 8 * 2 * 4);
    p.SSQ = (float*)take((size_t)T * 8 * 4);
    p.XSS = (float*)take((size_t)T * 16 * 4);
    if (off > ws_size) { fprintf(stderr, "workspace too small: need %zu have %zu\n", off, ws_size); return; }
    if (hipMemsetAsync(p.BAR, 0, XCD_BAR_WORDS * 4, stream) != hipSuccess) { fprintf(stderr, "memset of barrier words failed\n"); return; }
    void* args[] = {&p};
    hipError_t e = hipLaunchCooperativeKernel((void*)mega, dim3(grid_blocks), dim3(NTHR), args, LDS_BYTES, stream);
    if (e != hipSuccess) fprintf(stderr, "cooperative launch failed: %s (grid %d)\n", hipGetErrorString(e), grid_blocks);
}
```

```cpp
#include <hip/hip_runtime.h>
#include <hip/hip_cooperative_groups.h>
#include <stdint.h>
#include <cstdio>
namespace cg = cooperative_groups;

typedef unsigned short bf16_t;
#define DI __device__ __forceinline__

constexpr int D = 1024, NB = 8, SEQ = 4096, CTXL = 256, TC = NB * CTXL, TL = NB * SEQ, T = TC + TL;
constexpr int INDIM = 2840, LDP = 2848;
constexpr int OFF_Z = 0, OFF_XBC = 512, OFF_DT = 1280, OFF_Q = 1288, OFF_K = 1544, OFF_V = 1800, OFF_GO = 2312, OFF_GK = 2824;
constexpr int NE = 32;

DI float bf2f(bf16_t v) { return __uint_as_float(((unsigned)v) << 16); }
typedef float f32x2v_ __attribute__((ext_vector_type(2)));
typedef __bf16 bf16x2v_ __attribute__((ext_vector_type(2)));
DI bf16_t f2bf(float f) { return __builtin_bit_cast(unsigned short, (__bf16)f); }
DI float siluf(float x) { return x * __builtin_amdgcn_rcpf(1.0f + __builtin_amdgcn_exp2f(-1.4426950408889634f * x)); }
DI float softplusf(float x) { return fmaxf(x, 0.f) + log1pf(__expf(-fabsf(x))); }
DI float logsigmoidf(float x) { return -softplusf(-x); }
DI float shx(float v, int o, int lane) { return __int_as_float(__builtin_amdgcn_ds_bpermute((lane ^ o) << 2, __float_as_int(v))); }
DI int shxi(int v, int o, int lane) { return __builtin_amdgcn_ds_bpermute((lane ^ o) << 2, v); }
DI float shl(float v, int src) { return __int_as_float(__builtin_amdgcn_ds_bpermute(src << 2, __float_as_int(v))); }
DI int shli(int v, int src) { return __builtin_amdgcn_ds_bpermute(src << 2, v); }
DI float wave_sum(float v, int lane) {
#pragma unroll
    for (int o = 32; o >= 1; o >>= 1) v += shx(v, o, lane);
    return v;
}
DI int ltid() { const int wv = __builtin_amdgcn_readfirstlane(threadIdx.x >> 6);
    int t = wv * 64 + (int)__builtin_amdgcn_mbcnt_hi(~0u, __builtin_amdgcn_mbcnt_lo(~0u, 0u)); asm volatile("" : "+v"(t)); return t; }
DI int tok_modrow(int t) { return t < TC ? 8 : ((t - TC) >> 12); }
template <class PT> DI bf16_t* xrow(const PT& p, int t) { return p.XB + (size_t)t * D; }


#ifndef PG8_SP2
#define PG8_SP2 true
#endif
namespace pg8 {
#define PG8_LAS __attribute__((address_space(3)))
typedef unsigned short bf16_t;
typedef short bf16x8 __attribute__((ext_vector_type(8)));
typedef float f32x4 __attribute__((ext_vector_type(4)));
typedef unsigned u32x4 __attribute__((ext_vector_type(4)));
constexpr int BM = 256, BK = 64, HALF = 128, HTB = HALF * BK * 2  , STAGE_BYTES = 8 * HTB, NXCD = 8, WGM = 8;

__host__ __device__ __forceinline__ int lds_byte(int r, int c) { const int st = (r >> 4) * 2 + (c >> 5), rr = r & 15, cc = c & 31, ob = rr * 64 + cc * 2; return st * 1024 + (ob ^ (((ob >> 9) & 1) << 5)); }
__host__ __device__ __forceinline__ void stage_rc(int b, int& R, int& C) { const int st = b / 1024, sb = b % 1024, swz = sb ^ (((sb >> 9) & 1) << 5); R = (st >> 1) * 16 + swz / 64; C = (st & 1) * 32 + (swz % 64) / 2; }
__host__ __device__ __forceinline__ int perm32(int rho) { const int n = rho >> 4, i = rho & 15; return 8 * (i >> 2) + 4 * n + (i & 3); }

struct Unit { int pm, pn; };
struct Gemm { const bf16_t* A; const bf16_t* Bt; int M, N, K; };

struct StaticOrder {
    int nM, nN, nwg, G, c;
    __host__ __device__ void init(int M, int N, int G_, int c_) { nM = M / BM; nN = N / BM; nwg = nM * nN; G = G_; c = c_; }
    __host__ __device__ bool next(int i, Unit& u) const {
        const long L = (long)i * G + c; if (L >= nwg) return false;
        int wgid = (int)L; { const int q = nwg / NXCD, r = nwg % NXCD, xcd = wgid % NXCD, off = wgid / NXCD; wgid = (xcd < r ? xcd * (q + 1) : r * (q + 1) + (xcd - r) * q) + off; }
        const int nig = WGM * nN, gid = wgid / nig, fm = gid * WGM, gsz = (nM - fm) < WGM ? (nM - fm) : WGM;
        u.pm = fm + ((wgid % nig) % gsz); u.pn = (wgid % nig) / gsz; return true;
    }
    __device__ __forceinline__ void a_ready(const Unit&) const {}
    __device__ __forceinline__ void done(const Unit&) const {}
};
__device__ __forceinline__ unsigned cvt_pk_bf16(float lo, float hi) { unsigned r; asm volatile("v_cvt_pk_bf16_f32 %0, %1, %2" : "=v"(r) : "v"(lo), "v"(hi)); return r; }
typedef float f32x2 __attribute__((ext_vector_type(2)));

struct EpiProj {
    static constexpr bool PERM = true, AFTER_DRAIN = false, MIDK = false;
    bf16_t* O; int ldc; int ncols;
    __device__ __forceinline__ void operator()(const f32x4 (&acc)[2][2][4][2], const Unit& u, int wr, int wc, int fr, int fq) const {
        const int row0 = u.pm * BM + wr * 64 + fr, col0 = u.pn * BM + wc * 32 + 8 * fq;
#pragma unroll
        for (int ai = 0; ai < 2; ++ai)
#pragma unroll
            for (int m = 0; m < 4; ++m) { bf16_t* rowp = O + (size_t)(row0 + ai * HALF + m * 16) * ldc + col0;
#pragma unroll
                for (int bj = 0; bj < 2; ++bj) { const f32x4 v0 = acc[ai][bj][m][0], v1 = acc[ai][bj][m][1];
                    u32x4 w; w.x = cvt_pk_bf16(v0[0], v0[1]); w.y = cvt_pk_bf16(v0[2], v0[3]); w.z = cvt_pk_bf16(v1[0], v1[1]); w.w = cvt_pk_bf16(v1[2], v1[3]);
                    if (col0 + bj * HALF + 8 <= ncols) *(u32x4*)(rowp + bj * HALF) = w; } }
    }
};
template <bool SRC_BF16> struct EpiResGate {
    static constexpr bool PERM = true, AFTER_DRAIN = false, MIDK = true;
    const float* ssq;
    const float* Sc; const float* Sl;
    bf16_t* XB;
    const float* gate_rows; float* xss; int rowoff;
    __device__ __forceinline__ void midk(f32x4 (&acc)[2][2][4][2], const Unit& u, int wr, int fr) const {
        int fr_ = fr; asm volatile("" : "+v"(fr_));
        const int row0 = rowoff + u.pm * BM + wr * 64 + fr_;
#pragma unroll
        for (int ai = 0; ai < 2; ++ai)
#pragma unroll
            for (int m = 0; m < 4; ++m) { const f32x4* q = (const f32x4*)(ssq + (size_t)(row0 + ai * HALF + m * 16) * 8); const f32x4 a = q[0], b = q[1];
                const float rs = __builtin_amdgcn_rsqf((((a[0] + a[1]) + (a[2] + a[3])) + ((b[0] + b[1]) + (b[2] + b[3]))) * (1.0f / 512.0f) + 1e-6f);
#pragma unroll
                for (int bj = 0; bj < 2; ++bj)
#pragma unroll
                    for (int n = 0; n < 2; ++n) acc[ai][bj][m][n] *= rs;
                asm volatile("" ::: "memory"); }
    }
    __device__ __forceinline__ void operator()(const f32x4 (&acc)[2][2][4][2], const Unit& u, int wr, int wc, int fr, int fq) const {
        const int row0 = rowoff + u.pm * BM + wr * 64 + fr, col0 = u.pn * BM + wc * 32 + 8 * fq;
        const int t0 = rowoff + u.pm * BM; const int mrow = t0 < 2048 ? 8 : ((t0 - 2048) >> 12);
        const float* gr = gate_rows + (size_t)mrow * 6144 + col0;
        f32x4 gv[2][2];
#pragma unroll
        for (int bj = 0; bj < 2; ++bj)
#pragma unroll
            for (int n = 0; n < 2; ++n) gv[bj][n] = *(const f32x4*)(gr + bj * HALF + n * 4);
#pragma unroll
        for (int ai = 0; ai < 2; ++ai)
#pragma unroll
            for (int m = 0; m < 4; ++m) { const int rr = row0 + ai * HALF + m * 16;
                const float* sp = (rr < 2048 ? Sc + (size_t)rr * 1024 : Sl + (size_t)(rr - 2048) * 1024) + col0; bf16_t* dp = XB + (size_t)rr * 1024 + col0; float ss = 0.f;
#pragma unroll
                for (int bj = 0; bj < 2; ++bj) { f32x4 x0, x1;
                    if (SRC_BF16) { const u32x4 r = *(const u32x4*)(dp + bj * HALF);
                        x0 = (f32x4){__uint_as_float(r.x << 16), __uint_as_float(r.x & 0xffff0000u), __uint_as_float(r.y << 16), __uint_as_float(r.y & 0xffff0000u)};
                        x1 = (f32x4){__uint_as_float(r.z << 16), __uint_as_float(r.z & 0xffff0000u), __uint_as_float(r.w << 16), __uint_as_float(r.w & 0xffff0000u)}; }
                    else { x0 = *(const f32x4*)(sp + bj * HALF); x1 = *(const f32x4*)(sp + bj * HALF + 4); }
                    const f32x4 v0 = x0 + gv[bj][0] * acc[ai][bj][m][0], v1 = x1 + gv[bj][1] * acc[ai][bj][m][1];
                    u32x4 w; w.x = cvt_pk_bf16(v0[0], v0[1]); w.y = cvt_pk_bf16(v0[2], v0[3]); w.z = cvt_pk_bf16(v1[0], v1[1]); w.w = cvt_pk_bf16(v1[2], v1[3]);
                    *(u32x4*)(dp + bj * HALF) = w;
#pragma unroll
                    for (int j = 0; j < 4; ++j) { const float lo = __uint_as_float(w[j] << 16), hi = __uint_as_float(w[j] & 0xffff0000u); ss += lo * lo + hi * hi; } }
                { const int ln_ = fq * 16 + fr; ss += __int_as_float(__builtin_amdgcn_ds_bpermute((ln_ ^ 16) << 2, __float_as_int(ss))); ss += __int_as_float(__builtin_amdgcn_ds_bpermute((ln_ ^ 32) << 2, __float_as_int(ss))); }
                if (fq == 0) xss[(size_t)rr * 16 + u.pn * 4 + wc] = ss; }
    }
};
template <class Epi, class Sched, bool STAMP = false, bool SP2 = PG8_SP2>
__device__ __forceinline__ void gemm_phase(PG8_LAS unsigned char* lds, const Gemm g, const Sched& S, const Epi& E, unsigned long long* stamps) {
    int tid_l = __builtin_amdgcn_readfirstlane(threadIdx.x >> 6) * 64 + (int)__builtin_amdgcn_mbcnt_hi(~0u, __builtin_amdgcn_mbcnt_lo(~0u, 0u)); asm volatile("" : "+v"(tid_l));
    const int tid = tid_l, wid = __builtin_amdgcn_readfirstlane(tid >> 6), lane = tid & 63, wr = wid >> 2, wc = wid & 3, fr = lane & 15, fq = lane >> 4;
    const int K = g.K, nt = K / BK;
    int ts_lo = 0, ts_hi = 0, nts = 0; const unsigned long long rt_entry = STAMP ? (unsigned long long)wall_clock64() : 0ull;
#define PG8_STAMP() do { if (STAMP && wid == 0 && nts < 64) { const unsigned long long _c = (unsigned long long)clock64(); \
        ts_lo = (lane == nts) ? (int)(unsigned)_c : ts_lo; ts_hi = (lane == nts) ? (int)(unsigned)(_c >> 32) : ts_hi; ++nts; } } while (0)
    PG8_STAMP();
    unsigned voffA[2], voffB[2];
#pragma unroll
    for (int i = 0; i < 2; ++i) { int R, C; stage_rc(tid * 16 + i * 8192, R, C); const int Rb = Epi::PERM ? ((R & ~31) + perm32(R & 31)) : R;
        voffA[i] = (unsigned)(R * K + C) * 2u; voffB[i] = (unsigned)(Rb * K + C) * 2u; }
    const size_t kstep = (size_t)(BK * 2);
    const size_t hstep = (size_t)HALF * K * 2;
    const size_t tstep = 2 * hstep;
    const unsigned ldsw = (unsigned)wid * 1024u;
    const int aoff = lds_byte(wr * 64 + fr, fq * 8), boff = lds_byte(wc * 32 + fr, fq * 8);
#define PG8_SA(b, h) (((b) * 2 + (h)) * HTB)
#define PG8_SB(b, h) ((4 + (b) * 2 + (h)) * HTB)
#define PG8_STAGE(bufoff, gbase, voff) do { _Pragma("unroll") for (int _i = 0; _i < 2; ++_i) \
        __builtin_amdgcn_global_load_lds((const unsigned*)((const char*)(gbase) + (voff)[_i]), (PG8_LAS unsigned*)(lds + (bufoff) + ldsw + _i * 8192), 16, 0, 0); } while (0)
#define PG8_LDA(dst, b, h) do { _Pragma("unroll") for (int m = 0; m < 4; ++m) _Pragma("unroll") for (int k = 0; k < 2; ++k) dst[m][k] = *(const PG8_LAS bf16x8*)(lds + PG8_SA(b, h) + aoff + m * 2048 + k * 1024); } while (0)
#define PG8_LDB(dst, b, h) do { _Pragma("unroll") for (int n = 0; n < 2; ++n) _Pragma("unroll") for (int k = 0; k < 2; ++k) dst[n][k] = *(const PG8_LAS bf16x8*)(lds + PG8_SB(b, h) + boff + n * 2048 + k * 1024); } while (0)
#define PG8_MMA(ai, bj, At, Bt) do { __builtin_amdgcn_s_setprio(1); _Pragma("unroll") for (int m = 0; m < 4; ++m) _Pragma("unroll") for (int n = 0; n < 2; ++n) _Pragma("unroll") for (int k = 0; k < 2; ++k) \
        acc[ai][bj][m][n] = __builtin_amdgcn_mfma_f32_16x16x32_bf16(Bt[n][k], At[m][k], acc[ai][bj][m][n], 0, 0, 0); __builtin_amdgcn_s_setprio(0); } while (0)
#define PG8_WAIT_V(n) asm volatile("s_waitcnt vmcnt(" #n ")" ::: "memory")
#define PG8_WAIT_L(n) asm volatile("s_waitcnt lgkmcnt(" #n ")" ::: "memory")
#define PG8_BAR __builtin_amdgcn_s_barrier()
#define PG8_SCHED __builtin_amdgcn_sched_barrier(0)
    Unit cur, nxt; int ui = 0;
    if (!S.next(0, cur)) return;
    f32x4 acc[2][2][4][2];
#pragma unroll
    for (int a = 0; a < 2; ++a)
#pragma unroll
        for (int b = 0; b < 2; ++b)
#pragma unroll
            for (int m = 0; m < 4; ++m)
#pragma unroll
                for (int n = 0; n < 2; ++n) acc[a][b][m][n] = (f32x4){0.f, 0.f, 0.f, 0.f};
    bf16x8 At[4][2], B0[2][2], B1[2][2];
    const char* cA = (const char*)g.A + (size_t)cur.pm * tstep; const char* cB = (const char*)g.Bt + (size_t)cur.pn * tstep;
    S.a_ready(cur);
    if constexpr (SP2) {
        PG8_STAGE(PG8_SB(0, 0), cB, voffB); PG8_STAGE(PG8_SB(0, 1), cB + hstep, voffB); PG8_STAGE(PG8_SA(0, 0), cA, voffA); PG8_STAGE(PG8_SA(0, 1), cA + hstep, voffA);
        if (wr == 1) PG8_BAR;
        PG8_WAIT_V(2); PG8_BAR;
        PG8_STAGE(PG8_SB(1, 0), cB + kstep, voffB); PG8_STAGE(PG8_SA(1, 0), cA + kstep, voffA); PG8_STAGE(PG8_SB(1, 1), cB + hstep + kstep, voffB);
        PG8_WAIT_V(6); PG8_BAR;
    } else {
    PG8_STAGE(PG8_SB(0, 0), cB, voffB); PG8_STAGE(PG8_SA(0, 0), cA, voffA); PG8_STAGE(PG8_SB(0, 1), cB + hstep, voffB); PG8_STAGE(PG8_SA(0, 1), cA + hstep, voffA);
    if (wr == 1) PG8_BAR;
    PG8_WAIT_V(4); PG8_BAR;
    PG8_STAGE(PG8_SB(1, 0), cB + kstep, voffB); PG8_STAGE(PG8_SA(1, 0), cA + kstep, voffA); PG8_STAGE(PG8_SB(1, 1), cB + hstep + kstep, voffB);
    PG8_WAIT_V(6); PG8_BAR;
    }
    PG8_STAMP();
    for (;;) {
        const bool has_next = S.next(ui + 1, nxt);
        const char* nA = has_next ? (const char*)g.A + (size_t)nxt.pm * tstep : cA; const char* nB = has_next ? (const char*)g.Bt + (size_t)nxt.pn * tstep : cB;
        for (int t = 0; t < nt; t += 2) {
            const bool last = (t == nt - 2);
            const char* a1 = cA + (size_t)(t + 1) * kstep;
            const char* a2 = last ? nA : cA + (size_t)(t + 2) * kstep; const char* b2 = last ? nB : cB + (size_t)(t + 2) * kstep;
            const char* a3 = a2 + kstep; const char* b3 = b2 + kstep;
            if (last && has_next) S.a_ready(nxt);
            if constexpr (SP2) {
            PG8_LDB(B0, 0, 0); PG8_LDB(B1, 0, 1); PG8_SCHED; PG8_LDA(At, 0, 0); PG8_STAGE(PG8_SA(1, 1), a1 + hstep, voffA);
            PG8_WAIT_V(8); PG8_WAIT_L(0); PG8_BAR; PG8_MMA(0, 0, At, B0); PG8_MMA(0, 1, At, B1); PG8_BAR; PG8_SCHED;
            PG8_LDA(At, 0, 1); PG8_STAGE(PG8_SB(0, 0), b2, voffB); PG8_STAGE(PG8_SB(0, 1), b2 + hstep, voffB); PG8_STAGE(PG8_SA(0, 0), a2, voffA);
            PG8_WAIT_V(8); PG8_WAIT_L(0); PG8_BAR; PG8_MMA(1, 0, At, B0); PG8_MMA(1, 1, At, B1); PG8_BAR; PG8_SCHED;
            PG8_LDB(B0, 1, 0); PG8_LDB(B1, 1, 1); PG8_SCHED; PG8_LDA(At, 1, 0); PG8_STAGE(PG8_SA(0, 1), a2 + hstep, voffA);
            PG8_WAIT_V(8); PG8_WAIT_L(0); PG8_BAR; PG8_MMA(0, 0, At, B0); PG8_MMA(0, 1, At, B1); PG8_BAR; PG8_SCHED;
            PG8_LDA(At, 1, 1); PG8_STAGE(PG8_SB(1, 0), b3, voffB); PG8_STAGE(PG8_SB(1, 1), b3 + hstep, voffB); PG8_STAGE(PG8_SA(1, 0), a3, voffA);
            PG8_WAIT_V(8); PG8_WAIT_L(0); PG8_BAR; PG8_MMA(1, 0, At, B0); PG8_MMA(1, 1, At, B1); PG8_BAR; PG8_SCHED;
            } else {
            PG8_LDB(B0, 0, 0); PG8_SCHED; PG8_LDA(At, 0, 0); PG8_STAGE(PG8_SA(1, 1), a1 + hstep, voffA);
            PG8_WAIT_L(8); PG8_BAR; PG8_WAIT_L(0); PG8_MMA(0, 0, At, B0); PG8_BAR; PG8_SCHED;
            PG8_LDB(B1, 0, 1); PG8_STAGE(PG8_SB(0, 0), b2, voffB);
            PG8_BAR; PG8_WAIT_L(0); PG8_MMA(0, 1, At, B1); PG8_BAR;
            PG8_LDA(At, 0, 1); PG8_STAGE(PG8_SA(0, 0), a2, voffA);
            PG8_BAR; PG8_WAIT_L(0); PG8_MMA(1, 0, At, B0); PG8_BAR; PG8_SCHED;
            PG8_STAGE(PG8_SB(0, 1), b2 + hstep, voffB);
            PG8_WAIT_V(6); PG8_BAR; PG8_MMA(1, 1, At, B1); PG8_BAR;
            PG8_LDB(B0, 1, 0); PG8_SCHED; PG8_LDA(At, 1, 0); PG8_STAGE(PG8_SA(0, 1), a2 + hstep, voffA);
            PG8_WAIT_L(8); PG8_BAR; PG8_WAIT_L(0); PG8_MMA(0, 0, At, B0); PG8_BAR; PG8_SCHED;
            PG8_LDB(B1, 1, 1); PG8_STAGE(PG8_SB(1, 0), b3, voffB);
            PG8_BAR; PG8_WAIT_L(0); PG8_MMA(0, 1, At, B1); PG8_BAR;
            PG8_LDA(At, 1, 1); PG8_STAGE(PG8_SA(1, 0), a3, voffA);
            PG8_BAR; PG8_WAIT_L(0); PG8_MMA(1, 0, At, B0); PG8_BAR; PG8_SCHED;
            PG8_STAGE(PG8_SB(1, 1), b3 + hstep, voffB);
            PG8_WAIT_V(6); PG8_BAR; PG8_MMA(1, 1, At, B1); PG8_BAR;
            }
            if constexpr (Epi::MIDK) { if (t + 2 == nt / 2) E.midk(acc, cur, wr, fr); }
        }
        PG8_STAMP();
        if (wr == 0) PG8_BAR;
        if constexpr (!Epi::AFTER_DRAIN) { E(acc, cur, wr, wc, fr, fq); S.done(cur); }
        PG8_STAMP();
        if (!has_next) break;
#pragma unroll
        for (int a = 0; a < 2; ++a)
#pragma unroll
            for (int b = 0; b < 2; ++b)
#pragma unroll
                for (int m = 0; m < 4; ++m)
#pragma unroll
                    for (int n = 0; n < 2; ++n) acc[a][b][m][n] = (f32x4){0.f, 0.f, 0.f, 0.f};
        cur = nxt; cA = nA; cB = nB; ++ui;
        if (wr == 1) PG8_BAR;
    }
    PG8_WAIT_V(0);
    PG8_BAR;
    if constexpr (Epi::AFTER_DRAIN) { E.fused(acc, cur, wr, wc, fr, fq, lds, wid, lane); S.done(cur); }
    PG8_STAMP();
    if (STAMP && wid == 0) { stamps[lane] = lane < nts ? (((unsigned long long)(unsigned)ts_hi << 32) | (unsigned)ts_lo) : 0ull;
        if (lane == 62) stamps[62] = rt_entry; if (lane == 63) stamps[63] = (unsigned long long)wall_clock64(); }
#undef PG8_STAMP
#undef PG8_SA
#undef PG8_SB
#undef PG8_STAGE
#undef PG8_LDA
#undef PG8_LDB
#undef PG8_MMA
#undef PG8_WAIT_V
#undef PG8_WAIT_L
#undef PG8_BAR
#undef PG8_SCHED
}

struct MoeUnit { int e, mt, pn, cnt, pstart; };
struct MoeSched {
    typedef MoeUnit UnitT;
    PG8_LAS const int* tab; const int* map; int U, G, c, npn, gather; size_t bstride;
    __device__ __forceinline__ bool next(int i, MoeUnit& u) const {
        const long L = (long)i * G + c; if (L >= U) return false;
        int idx = (int)L; { const int q = U / NXCD, r = U % NXCD, xcd = idx % NXCD, off = idx / NXCD; idx = (xcd < r ? xcd * (q + 1) : r * (q + 1) + (xcd - r) * q) + off; }
        const int tau = idx / npn; u.pn = idx - tau * npn;
        int e = 0;
#pragma unroll
        for (int st = 16; st >= 1; st >>= 1) { if (__builtin_amdgcn_readfirstlane(tab[e + st]) <= tau) e += st; }
        u.e = e; u.mt = tau - __builtin_amdgcn_readfirstlane(tab[e]); u.cnt = __builtin_amdgcn_readfirstlane(tab[33 + e]); u.pstart = __builtin_amdgcn_readfirstlane(tab[65 + e]);
        return true;
    }
    __device__ __forceinline__ const char* bbase(const Gemm& g, const MoeUnit& u) const { return (const char*)g.Bt + (size_t)u.e * bstride + (size_t)u.pn * BM * g.K * 2; }
    __device__ __forceinline__ void a_offsets(const Gemm& g, const MoeUnit& u, int tid, unsigned (&va)[2][2]) const {
        int tl = tid; asm volatile("" : "+v"(tl));
        int RA[2], CA[2];
#pragma unroll
        for (int i = 0; i < 2; ++i) { int R, C; stage_rc(tl * 16 + i * 8192, R, C); RA[i] = R; CA[i] = C * 2; }
#pragma unroll
        for (int hf = 0; hf < 2; ++hf)
#pragma unroll
            for (int i = 0; i < 2; ++i) { int rl = u.mt * BM + hf * HALF + RA[i]; rl = rl < u.cnt ? rl : u.cnt - 1;
                const unsigned row = gather ? (unsigned)map[(size_t)u.e * 34816 + rl] : (unsigned)(u.pstart + rl);
                va[hf][i] = row * (unsigned)(g.K * 2) + (unsigned)CA[i]; }
    }
};
struct EpiAct {
    static constexpr bool PERM = true, AFTER_DRAIN = false;
    bf16_t* O;
    __device__ __forceinline__ void operator()(const f32x4 (&acc)[2][2][4][2], const MoeUnit& u, int wr, int wc, int fr, int fq) const {
        const int rl0 = u.mt * BM + wr * 64 + fr, col0 = u.pn * HALF + wc * 32 + 8 * fq;
#pragma unroll
        for (int ai = 0; ai < 2; ++ai)
#pragma unroll
            for (int m = 0; m < 4; ++m) { const int rl = rl0 + ai * HALF + m * 16;
                if (rl < u.cnt) { float o[8];
#pragma unroll
                    for (int n = 0; n < 2; ++n)
#pragma unroll
                        for (int j = 0; j < 4; ++j) { const float gv = acc[ai][0][m][n][j]; o[4 * n + j] = gv * __builtin_amdgcn_rcpf(1.0f + __builtin_amdgcn_exp2f(-1.4426950408889634f * gv)) * acc[ai][1][m][n][j]; }
                    u32x4 w; w.x = cvt_pk_bf16(o[0], o[1]); w.y = cvt_pk_bf16(o[2], o[3]); w.z = cvt_pk_bf16(o[4], o[5]); w.w = cvt_pk_bf16(o[6], o[7]);
                    *(u32x4*)(O + (size_t)(u.pstart + rl) * 512 + col0) = w; } }
    }
};
struct EpiY {
    static constexpr bool PERM = true, AFTER_DRAIN = false;
    unsigned char* O;
    static __device__ __forceinline__ unsigned pk4(const f32x4 v) { const float lim = 440.f;
        int w = __builtin_amdgcn_cvt_pk_fp8_f32(fminf(fmaxf(v[0], -lim), lim), fminf(fmaxf(v[1], -lim), lim), 0, false);
        return (unsigned)__builtin_amdgcn_cvt_pk_fp8_f32(fminf(fmaxf(v[2], -lim), lim), fminf(fmaxf(v[3], -lim), lim), w, true); }
    __device__ __forceinline__ void operator()(const f32x4 (&acc)[2][2][4][2], const MoeUnit& u, int wr, int wc, int fr, int fq) const {
        typedef unsigned u32x2 __attribute__((ext_vector_type(2)));
        const int rl0 = u.mt * BM + wr * 64 + fr, col0 = u.pn * BM + wc * 32 + 8 * fq;
#pragma unroll
        for (int ai = 0; ai < 2; ++ai)
#pragma unroll
            for (int m = 0; m < 4; ++m) { const int rl = rl0 + ai * HALF + m * 16;
                if (rl < u.cnt) { unsigned char* rowp = O + (size_t)(u.pstart + rl) * 1024 + col0;
#pragma unroll
                    for (int bj = 0; bj < 2; ++bj) *(u32x2*)(rowp + bj * HALF) = (u32x2){pk4(acc[ai][bj][m][0]), pk4(acc[ai][bj][m][1])}; } }
    }
};
template <class Epi, class Sched, bool STAMP = false, bool SP2 = PG8_SP2>
__device__ __forceinline__ void gemm_phase_moe(PG8_LAS unsigned char* lds, const Gemm g, const Sched& S, const Epi& E, unsigned long long* stamps) {
    int tid_l = __builtin_amdgcn_readfirstlane(threadIdx.x >> 6) * 64 + (int)__builtin_amdgcn_mbcnt_hi(~0u, __builtin_amdgcn_mbcnt_lo(~0u, 0u)); asm volatile("" : "+v"(tid_l));
    const int tid = tid_l, wid = __builtin_amdgcn_readfirstlane(tid >> 6), lane = tid & 63, wr = wid >> 2, wc = wid & 3, fr = lane & 15, fq = lane >> 4;
    const int K = g.K, nt = K / BK;
    int ts_lo = 0, ts_hi = 0, nts = 0; const unsigned long long rt_entry = STAMP ? (unsigned long long)wall_clock64() : 0ull;
#define PG8_STAMP() do { if (STAMP && wid == 0 && nts < 64) { const unsigned long long _c = (unsigned long long)clock64(); \
        ts_lo = (lane == nts) ? (int)(unsigned)_c : ts_lo; ts_hi = (lane == nts) ? (int)(unsigned)(_c >> 32) : ts_hi; ++nts; } } while (0)
    PG8_STAMP();
    unsigned voffB[2];
#pragma unroll
    for (int i = 0; i < 2; ++i) { int R, C; stage_rc(tid * 16 + i * 8192, R, C); const int Rb = Epi::PERM ? ((R & ~31) + perm32(R & 31)) : R;
        voffB[i] = (unsigned)(Rb * K + C) * 2u; }
    unsigned vaC[2][2];
    PG8_LAS unsigned* vtab = (PG8_LAS unsigned*)(lds + STAGE_BYTES + 1024) + tid;
    const size_t kstep = (size_t)(BK * 2);
    const size_t hstep = (size_t)HALF * K * 2;
    const size_t tstep = 2 * hstep;
    const unsigned ldsw = (unsigned)wid * 1024u;
    const int aoff = lds_byte(wr * 64 + fr, fq * 8), boff = lds_byte(wc * 32 + fr, fq * 8);
#define PG8_SA(b, h) (((b) * 2 + (h)) * HTB)
#define PG8_SB(b, h) ((4 + (b) * 2 + (h)) * HTB)
#define PG8_STAGE(bufoff, gbase, voff) do { _Pragma("unroll") for (int _i = 0; _i < 2; ++_i) \
        __builtin_amdgcn_global_load_lds((const unsigned*)((const char*)(gbase) + (voff)[_i]), (PG8_LAS unsigned*)(lds + (bufoff) + ldsw + _i * 8192), 16, 0, 0); } while (0)
#define PG8_STAGEA(bufoff, kbyte, va) do { _Pragma("unroll") for (int _i = 0; _i < 2; ++_i) \
        __builtin_amdgcn_global_load_lds((const unsigned*)((const char*)g.A + (kbyte) + (va)[_i]), (PG8_LAS unsigned*)(lds + (bufoff) + ldsw + _i * 8192), 16, 0, 0); } while (0)
#define PG8_LDA(dst, b, h) do { _Pragma("unroll") for (int m = 0; m < 4; ++m) _Pragma("unroll") for (int k = 0; k < 2; ++k) dst[m][k] = *(const PG8_LAS bf16x8*)(lds + PG8_SA(b, h) + aoff + m * 2048 + k * 1024); } while (0)
#define PG8_LDB(dst, b, h) do { _Pragma("unroll") for (int n = 0; n < 2; ++n) _Pragma("unroll") for (int k = 0; k < 2; ++k) dst[n][k] = *(const PG8_LAS bf16x8*)(lds + PG8_SB(b, h) + boff + n * 2048 + k * 1024); } while (0)
#define PG8_MMA(ai, bj, At, Bt) do { __builtin_amdgcn_s_setprio(1); _Pragma("unroll") for (int m = 0; m < 4; ++m) _Pragma("unroll") for (int n = 0; n < 2; ++n) _Pragma("unroll") for (int k = 0; k < 2; ++k) \
        acc[ai][bj][m][n] = __builtin_amdgcn_mfma_f32_16x16x32_bf16(Bt[n][k], At[m][k], acc[ai][bj][m][n], 0, 0, 0); __builtin_amdgcn_s_setprio(0); } while (0)
#define PG8_WAIT_V(n) asm volatile("s_waitcnt vmcnt(" #n ")" ::: "memory")
#define PG8_WAIT_L(n) asm volatile("s_waitcnt lgkmcnt(" #n ")" ::: "memory")
#define PG8_BAR __builtin_amdgcn_s_barrier()
#define PG8_SCHED __builtin_amdgcn_sched_barrier(0)
    typename Sched::UnitT cur, nxt; int ui = 0;
    if (!S.next(0, cur)) return;
    f32x4 acc[2][2][4][2];
#pragma unroll
    for (int a = 0; a < 2; ++a)
#pragma unroll
        for (int b = 0; b < 2; ++b)
#pragma unroll
            for (int m = 0; m < 4; ++m)
#pragma unroll
                for (int n = 0; n < 2; ++n) acc[a][b][m][n] = (f32x4){0.f, 0.f, 0.f, 0.f};
    bf16x8 At[4][2], B0[2][2], B1[2][2];
    const char* cB = S.bbase(g, cur); S.a_offsets(g, cur, tid, vaC);
    if constexpr (SP2) {
        PG8_STAGE(PG8_SB(0, 0), cB, voffB); PG8_STAGE(PG8_SB(0, 1), cB + hstep, voffB); PG8_STAGEA(PG8_SA(0, 0), 0, vaC[0]); PG8_STAGEA(PG8_SA(0, 1), 0, vaC[1]);
        if (wr == 1) PG8_BAR;
        PG8_WAIT_V(2); PG8_BAR;
        PG8_STAGE(PG8_SB(1, 0), cB + kstep, voffB); PG8_STAGEA(PG8_SA(1, 0), kstep, vaC[0]); PG8_STAGE(PG8_SB(1, 1), cB + hstep + kstep, voffB);
        PG8_WAIT_V(6); PG8_BAR;
    } else {
    PG8_STAGE(PG8_SB(0, 0), cB, voffB); PG8_STAGEA(PG8_SA(0, 0), 0, vaC[0]); PG8_STAGE(PG8_SB(0, 1), cB + hstep, voffB); PG8_STAGEA(PG8_SA(0, 1), 0, vaC[1]);
    if (wr == 1) PG8_BAR;
    PG8_WAIT_V(4); PG8_BAR;
    PG8_STAGE(PG8_SB(1, 0), cB + kstep, voffB); PG8_STAGEA(PG8_SA(1, 0), kstep, vaC[0]); PG8_STAGE(PG8_SB(1, 1), cB + hstep + kstep, voffB);
    PG8_WAIT_V(6); PG8_BAR;
    }
    PG8_STAMP();
    for (;;) {
        const bool has_next = S.next(ui + 1, nxt);
        const char* nB = has_next ? S.bbase(g, nxt) : cB;
        { unsigned vaN[2][2];
          if (has_next) S.a_offsets(g, nxt, tid, vaN); else {
#pragma unroll
            for (int hf = 0; hf < 2; ++hf)
#pragma unroll
                for (int i = 0; i < 2; ++i) vaN[hf][i] = vaC[hf][i]; }
#pragma unroll
          for (int hf = 0; hf < 2; ++hf)
#pragma unroll
              for (int i = 0; i < 2; ++i) vtab[(hf * 2 + i) * 512] = vaN[hf][i]; }
        unsigned v2[2][2];
        for (int t = 0; t < nt; t += 2) {
            const bool last = (t == nt - 2);
            const size_t k1 = (size_t)(t + 1) * kstep, k2 = last ? (size_t)0 : (size_t)(t + 2) * kstep, k3 = k2 + kstep;
            const char* b2 = last ? nB : cB + (size_t)(t + 2) * kstep; const char* b3 = b2 + kstep;
#pragma unroll
            for (int hf = 0; hf < 2; ++hf)
#pragma unroll
                for (int i = 0; i < 2; ++i) v2[hf][i] = last ? vtab[(hf * 2 + i) * 512] : vaC[hf][i];
            if constexpr (SP2) {
            PG8_LDB(B0, 0, 0); PG8_LDB(B1, 0, 1); PG8_SCHED; PG8_LDA(At, 0, 0); PG8_STAGEA(PG8_SA(1, 1), k1, vaC[1]);
            PG8_WAIT_V(8); PG8_WAIT_L(0); PG8_BAR; PG8_MMA(0, 0, At, B0); PG8_MMA(0, 1, At, B1); PG8_BAR; PG8_SCHED;
            PG8_LDA(At, 0, 1); PG8_STAGE(PG8_SB(0, 0), b2, voffB); PG8_STAGE(PG8_SB(0, 1), b2 + hstep, voffB); PG8_STAGEA(PG8_SA(0, 0), k2, v2[0]);
            PG8_WAIT_V(8); PG8_WAIT_L(0); PG8_BAR; PG8_MMA(1, 0, At, B0); PG8_MMA(1, 1, At, B1); PG8_BAR; PG8_SCHED;
            PG8_LDB(B0, 1, 0); PG8_LDB(B1, 1, 1); PG8_SCHED; PG8_LDA(At, 1, 0); PG8_STAGEA(PG8_SA(0, 1), k2, v2[1]);
            PG8_WAIT_V(8); PG8_WAIT_L(0); PG8_BAR; PG8_MMA(0, 0, At, B0); PG8_MMA(0, 1, At, B1); PG8_BAR; PG8_SCHED;
            PG8_LDA(At, 1, 1); PG8_STAGE(PG8_SB(1, 0), b3, voffB); PG8_STAGE(PG8_SB(1, 1), b3 + hstep, voffB); PG8_STAGEA(PG8_SA(1, 0), k3, v2[0]);
            PG8_WAIT_V(8); PG8_WAIT_L(0); PG8_BAR; PG8_MMA(1, 0, At, B0); PG8_MMA(1, 1, At, B1); PG8_BAR; PG8_SCHED;
            } else {
            PG8_LDB(B0, 0, 0); PG8_SCHED; PG8_LDA(At, 0, 0); PG8_STAGEA(PG8_SA(1, 1), k1, vaC[1]);
            PG8_WAIT_L(8); PG8_BAR; PG8_WAIT_L(0); PG8_MMA(0, 0, At, B0); PG8_BAR; PG8_SCHED;
            PG8_LDB(B1, 0, 1); PG8_STAGE(PG8_SB(0, 0), b2, voffB);
            PG8_BAR; PG8_WAIT_L(0); PG8_MMA(0, 1, At, B1); PG8_BAR;
            PG8_LDA(At, 0, 1); PG8_STAGEA(PG8_SA(0, 0), k2, v2[0]);
            PG8_BAR; PG8_WAIT_L(0); PG8_MMA(1, 0, At, B0); PG8_BAR; PG8_SCHED;
            PG8_STAGE(PG8_SB(0, 1), b2 + hstep, voffB);
            PG8_WAIT_V(6); PG8_BAR; PG8_MMA(1, 1, At, B1); PG8_BAR;
            PG8_LDB(B0, 1, 0); PG8_SCHED; PG8_LDA(At, 1, 0); PG8_STAGEA(PG8_SA(0, 1), k2, v2[1]);
            PG8_WAIT_L(8); PG8_BAR; PG8_WAIT_L(0); PG8_MMA(0, 0, At, B0); PG8_BAR; PG8_SCHED;
            PG8_LDB(B1, 1, 1); PG8_STAGE(PG8_SB(1, 0), b3, voffB);
            PG8_BAR; PG8_WAIT_L(0); PG8_MMA(0, 1, At, B1); PG8_BAR;
            PG8_LDA(At, 1, 1); PG8_STAGEA(PG8_SA(1, 0), k3, v2[0]);
            PG8_BAR; PG8_WAIT_L(0); PG8_MMA(1, 0, At, B0); PG8_BAR; PG8_SCHED;
            PG8_STAGE(PG8_SB(1, 1), b3 + hstep, voffB);
            PG8_WAIT_V(6); PG8_BAR; PG8_MMA(1, 1, At, B1); PG8_BAR;
            }
        }
        PG8_STAMP();
        if (wr == 0) PG8_BAR;
        E(acc, cur, wr, wc, fr, fq);
        PG8_STAMP();
        if (!has_next) break;
#pragma unroll
        for (int a = 0; a < 2; ++a)
#pragma unroll
            for (int b = 0; b < 2; ++b)
#pragma unroll
                for (int m = 0; m < 4; ++m)
#pragma unroll
                    for (int n = 0; n < 2; ++n) acc[a][b][m][n] = (f32x4){0.f, 0.f, 0.f, 0.f};
        cur = nxt; cB = nB; ++ui;
#pragma unroll
        for (int hf = 0; hf < 2; ++hf)
#pragma unroll
            for (int i = 0; i < 2; ++i) vaC[hf][i] = v2[hf][i];
        if (wr == 1) PG8_BAR;
    }
    PG8_WAIT_V(0);
    PG8_BAR;
    PG8_STAMP();
    if (STAMP && wid == 0) { stamps[lane] = lane < nts ? (((unsigned long long)(unsigned)ts_hi << 32) | (unsigned)ts_lo) : 0ull;
        if (lane == 62) stamps[62] = rt_entry; if (lane == 63) stamps[63] = (unsigned long long)wall_clock64(); }
#undef PG8_STAMP
#undef PG8_SA
#undef PG8_SB
#undef PG8_STAGE
#undef PG8_STAGEA
#undef PG8_LDA
#undef PG8_LDB
#undef PG8_MMA
#undef PG8_WAIT_V
#undef PG8_WAIT_L
#undef PG8_BAR
#undef PG8_SCHED
}
}

constexpr int NTHR = 512, NWV = 8, LDS_BYTES = 147456;

struct P {
    const float *x, *c, *ctx, *c_ctx, *w_mod, *b_mod, *norm1_g, *norm2_g, *w_in, *conv_w, *conv_b, *dt_bias_f, *dt_bias_b, *a_log_f, *a_log_b, *d_skip, *ssd_norm_g,
        *gk_up_f, *gk_bias_f, *gk_up_b, *gk_bias_b, *gla_norm_g, *w_out, *w_router, *router_bias, *w_gate, *w_up, *w_down, *final_g;
    float* out; bf16_t* XB; bf16_t* H; bf16_t* PROJ; bf16_t* SS; bf16_t* GS; float* SDEC; float* GDEC; float* MOD; int* counts; int* TOKSLOT; float* EW; int* MAP; bf16_t* WinT; bf16_t* WoutT; bf16_t* WguT; bf16_t* WdT; bf16_t* WRT; unsigned* BAR; bf16_t* XBCC; bf16_t* QKB; float* SSC; float* STOT; float* SSQ; float* XSS;
};

DI void ph_init(const P& p) { const size_t i = (size_t)blockIdx.x * NTHR + ltid(); if (i < 64) p.counts[i * 32] = 0; }

DI void ph_mod(const P& p, float* s  ) {
    const int tid_ = ltid(), lane = tid_ & 63, w = tid_ >> 6;
    if (blockIdx.x >= 192) return;
    float* part = s + 9 * 1024;
    { float cv[18];
#pragma unroll
      for (int q = 0; q < 18; ++q) { const int i = tid_ + q * NTHR, r = i >> 10, k = i & 1023; cv[q] = r < 8 ? p.c[r * 1024 + k] : p.c_ctx[k]; }
#pragma unroll
      for (int q = 0; q < 18; ++q) s[tid_ + q * NTHR] = siluf(cv[q]); }
    __syncthreads();
    for (int vb = blockIdx.x; vb < 192; vb += gridDim.x) {
        const int l = vb / 96, n = (vb % 96) * 64 + lane;
        float acc[9];
#pragma unroll
        for (int r = 0; r < 9; ++r) acc[r] = 0.f;
        const float* wp = p.w_mod + (size_t)l * 1024 * 6144 + (size_t)(128 * w) * 6144 + n;
#pragma unroll 8
        for (int k = 0; k < 128; ++k) { const float wv = wp[(size_t)k * 6144];
#pragma unroll
            for (int r = 0; r < 9; ++r) acc[r] += s[r * 1024 + 128 * w + k] * wv; }
#pragma unroll
        for (int r = 0; r < 9; ++r) part[(w * 9 + r) * 64 + lane] = acc[r];
        __syncthreads();
        for (int o = tid_; o < 9 * 64; o += NTHR) { const int r = o >> 6, c = o & 63; float a = p.b_mod[l * 6144 + (vb % 96) * 64 + c];
#pragma unroll
            for (int q = 0; q < 8; ++q) a += part[(q * 9 + r) * 64 + c];
            p.MOD[((size_t)l * 9 + r) * 6144 + (vb % 96) * 64 + c] = a; }
        __syncthreads();
    }
}

DI unsigned pk2(float lo, float hi) { return __builtin_bit_cast(unsigned, __builtin_convertvector((f32x2v_){lo, hi}, bf16x2v_)); }
DI void transpose_item(const float* W, int K, int N, bf16_t* WT, float* scr, int item, int lane, int gu = -1, const float* kscale = nullptr) {
    const int nblk = (N + 31) / 32, kb = item / nblk, nb = item % nblk, k0 = 64 * kb, n0 = 32 * nb;
    const int d0 = gu < 0 ? n0 : 256 * (n0 >> 7) + (n0 & 127) + 128 * gu;
    const bool nok = n0 + (lane & 31) < N;
    float wv_[32];
#pragma unroll
    for (int i = 0; i < 32; ++i) { const int kk = 2 * i + (lane >> 5); wv_[i] = nok ? __builtin_nontemporal_load(W + (size_t)(k0 + kk) * N + n0 + (lane & 31)) : 0.f; }
#pragma unroll
    for (int i = 0; i < 32; ++i) { const int kk = 2 * i + (lane >> 5); scr[kk * 33 + (lane & 31)] = wv_[i] * (kscale ? kscale[k0 + kk] : 1.0f); }
    const int c = lane & 7;
#pragma unroll
    for (int j = 0; j < 4; ++j) { const int n = (lane >> 3) + 8 * j; const float* q = scr + (8 * c) * 33 + n;
        uint4 o; o.x = pk2(q[0 * 33], q[1 * 33]); o.y = pk2(q[2 * 33], q[3 * 33]); o.z = pk2(q[4 * 33], q[5 * 33]); o.w = pk2(q[6 * 33], q[7 * 33]);
        if (n0 + n < N) { typedef unsigned u32x4nt __attribute__((ext_vector_type(4))); __builtin_nontemporal_store((u32x4nt){o.x, o.y, o.z, o.w}, (u32x4nt*)(WT + (size_t)(d0 + n) * K + k0 + 8 * c)); } }
}

DI void ph_convert_experts(const P& p, int l, float* ldsf, int wk0, int nwk, int it0 = 0, int it1 = NE * 768) {
    const int tid_ = ltid(), lane = tid_ & 63, gw = ((int)blockIdx.x - wk0) * NWV + (tid_ >> 6), NW = nwk * NWV;
    float* scr = ldsf + 14 * 1024 + (tid_ >> 6) * (64 * 33 + 16);
    for (int it = it0 + gw; it < it1; it += NW) {
        const int e = it / 768, r = it - e * 768;
        if (r < 512) { const int gu = r >> 8; const float* W = (gu ? p.w_up : p.w_gate) + (size_t)(l * NE + e) * D * 512;
            transpose_item(W, D, 512, p.WguT + (size_t)e * D * D, scr, r & 255, lane, gu); }
        else transpose_item(p.w_down + (size_t)(l * NE + e) * 512 * D, 512, D, p.WdT + (size_t)e * D * 512, scr, r - 512, lane);
    }
}
constexpr int NPAD_IN = 3072;
DI void ph_convert_small(const P& p, float* ldsf, int, int, int) {
    const int tid_ = ltid(), lane = tid_ & 63, gw = blockIdx.x * NWV + (tid_ >> 6), NW = gridDim.x * NWV;
    float* scr = ldsf + 14 * 1024 + (tid_ >> 6) * (64 * 33 + 16);
    constexpr int I_IN = 16 * 89, I_OUT = 16 * 32;
    for (int it = gw; it < 2 * (I_IN + I_OUT); it += NW) {
        const int l = it / (I_IN + I_OUT), r = it % (I_IN + I_OUT);
        if (r < I_IN) transpose_item(p.w_in + (size_t)l * D * INDIM, D, INDIM, p.WinT + (size_t)l * NPAD_IN * D, scr, r, lane);
        else { const int kb = (r - I_IN) / 32;
            transpose_item(p.w_out + (size_t)l * D * D, D, D, p.WoutT + (size_t)l * D * D, scr, r - I_IN, lane, -1, kb < 8 ? p.ssd_norm_g + l * 512 : nullptr); }
    }
    for (int idx = blockIdx.x * NTHR + tid_; idx < 32 * 1024; idx += gridDim.x * NTHR) { const int e = idx >> 10, k = idx & 1023; p.WRT[idx] = f2bf(p.w_router[k * 32 + e]); }
    const size_t nz16 = (size_t)(NPAD_IN - INDIM) * D * 2 / 16;
    for (size_t i = (size_t)blockIdx.x * NTHR + tid_; i < 2 * nz16; i += (size_t)gridDim.x * NTHR) {
        const size_t l = i / nz16, j = i % nz16;
        ((uint4*)(p.WinT + (l * NPAD_IN + INDIM) * D))[j] = make_uint4(0u, 0u, 0u, 0u);
    }
}

DI void row_normmod(float4 (&v)[4], const float* g, const float* mr, int shift_idx, int scale_idx, int lane) {
    float ss = 0.f;
#pragma unroll
    for (int i = 0; i < 4; ++i) ss += v[i].x * v[i].x + v[i].y * v[i].y + v[i].z * v[i].z + v[i].w * v[i].w;
    ss = wave_sum(ss, lane);
    const float rstd = rsqrtf(ss * (1.0f / D) + 1e-6f);
#pragma unroll
    for (int i = 0; i < 4; ++i) {
        const int c = (i * 64 + lane) * 4;
        const float4 gg = *(const float4*)(g + c), sh = *(const float4*)(mr + shift_idx * 1024 + c), sc = *(const float4*)(mr + scale_idx * 1024 + c);
        v[i].x = v[i].x * rstd * gg.x * (1.f + sc.x) + sh.x; v[i].y = v[i].y * rstd * gg.y * (1.f + sc.y) + sh.y;
        v[i].z = v[i].z * rstd * gg.z * (1.f + sc.z) + sh.z; v[i].w = v[i].w * rstd * gg.w * (1.f + sc.w) + sh.w;
    }
}
DI void row_store_bf16(bf16_t* hrow, float4 (&v)[4], int lane) {
#pragma unroll
    for (int i = 0; i < 4; ++i) { ushort4 o; o.x = f2bf(v[i].x); o.y = f2bf(v[i].y); o.z = f2bf(v[i].z); o.w = f2bf(v[i].w);
        *(ushort4*)(hrow + (i * 64 + lane) * 4) = o; v[i] = make_float4(bf2f(o.x), bf2f(o.y), bf2f(o.z), bf2f(o.w)); }
}

DI void ph_normmod1(const P& p, int l, int, int, int) {
    const int tid_ = ltid(), lane = tid_ & 63, gw = blockIdx.x * NWV + (tid_ >> 6), NW = gridDim.x * NWV;
    const float* MODl = p.MOD + (size_t)l * 9 * 6144;
    for (int t = gw; t < T; t += NW) {
        float4 v[4];
#pragma unroll
        for (int i = 0; i < 4; ++i) v[i] = ((const float4*)(t < TC ? p.ctx + (size_t)t * D : p.x + (size_t)(t - TC) * D))[i * 64 + lane];
        row_normmod(v, p.norm1_g + l * D, MODl + (size_t)tok_modrow(t) * 6144, 0, 1, lane);
        row_store_bf16(p.H + (size_t)t * D, v, lane);
    }
}

typedef short s16x4 __attribute__((ext_vector_type(4)));
typedef short bf16x8v __attribute__((ext_vector_type(8)));
typedef float f32x4v __attribute__((ext_vector_type(4)));
typedef unsigned u32x4v __attribute__((ext_vector_type(4)));
typedef unsigned u32x2v __attribute__((ext_vector_type(2)));
DI u32x4v mk4(unsigned a, unsigned b, unsigned c, unsigned d) { return (u32x4v){a, b, c, d}; }
DI u32x2v mk2(unsigned a, unsigned b) { return (u32x2v){a, b}; }
DI f32x4v mkf4(float a, float b, float c, float d) { return (f32x4v){a, b, c, d}; }
#define LDSP __attribute__((address_space(3)))
constexpr int NCH = 34, NTILE = NB * NCH;
constexpr int LD64 = 72, LD128 = 136;
constexpr float LOG2E = 1.4426950408889634f;

DI int tile_tok0(int tl) { const int b = tl / NCH, cs = tl - b * NCH; return cs < 2 ? b * CTXL + cs * 128 : TC + b * SEQ + (cs - 2) * 128; }
DI f32x4v mfma16(bf16x8v a, bf16x8v b, f32x4v c) { return __builtin_amdgcn_mfma_f32_16x16x32_bf16(a, b, c, 0, 0, 0); }
DI bf16x8v frag_row(LDSP const bf16_t* base, int ld, int r0, int k0, int lane) { return *(LDSP const bf16x8v*)(base + (r0 + (lane & 15)) * ld + k0 + 8 * (lane >> 4)); }
DI bf16x8v frag_row_g(const bf16_t* base, int ld, int r0, int k0, int lane) { return *(const bf16x8v*)(base + (size_t)(r0 + (lane & 15)) * ld + k0 + 8 * (lane >> 4)); }
DI bf16x8v frag_col(LDSP const bf16_t* base, int ld, int r0, int k0, int lane) {
    const int G = lane >> 4, i = lane & 15;
    LDSP const bf16_t* a = base + (k0 + 8 * G + (i >> 2)) * ld + r0 + 4 * (i & 3);
    const s16x4 lo = __builtin_bit_cast(s16x4, __builtin_amdgcn_ds_read_tr16_b64_v4i16((LDSP s16x4*)a));
    const s16x4 hi = __builtin_bit_cast(s16x4, __builtin_amdgcn_ds_read_tr16_b64_v4i16((LDSP s16x4*)(a + 4 * ld)));
    return (bf16x8v){lo[0], lo[1], lo[2], lo[3], hi[0], hi[1], hi[2], hi[3]};
}
DI u32x2v pack4(f32x4v v) { return mk2(pk2(v[0], v[1]), pk2(v[2], v[3])); }
DI void unpack8(u32x4v v, float* o) { o[0] = __uint_as_float(v.x << 16); o[1] = __uint_as_float(v.x & 0xffff0000u); o[2] = __uint_as_float(v.y << 16); o[3] = __uint_as_float(v.y & 0xffff0000u);
    o[4] = __uint_as_float(v.z << 16); o[5] = __uint_as_float(v.z & 0xffff0000u); o[6] = __uint_as_float(v.w << 16); o[7] = __uint_as_float(v.w & 0xffff0000u); }
DI u32x4v pack8(const float* o) { return mk4(pk2(o[0], o[1]), pk2(o[2], o[3]), pk2(o[4], o[5]), pk2(o[6], o[7])); }

DI float fast_logsigmoid(float x) { return -(fmaxf(-x, 0.f) + __logf(1.0f + __expf(-fabsf(x)))); }
DI float fast_softplus(float x) { return fmaxf(x, 0.f) + __logf(1.0f + __expf(-fabsf(x))); }
struct XbcSrc { const bf16_t* base; int ld; };
DI XbcSrc xbc_src(const P& p, int tok0) { XbcSrc r; r.base = p.XBCC + (size_t)tok0 * 768; r.ld = 768; return r; }

DI void prep_conv_item(const P& p, int l, int item, int lane) {
    int piece, ch;
    if (item < T / 32) { piece = item; ch = lane * 8; } else { piece = 2 * (item - T / 32) + (lane >> 5); ch = 512 + (lane & 31) * 8; }
    const int t0 = piece * 32; int lo, hi; bf16_t* dst; int dld;
    if (t0 < TC) { lo = t0 & ~(CTXL - 1); hi = lo + CTXL - 1; } else { lo = TC + ((t0 - TC) & ~63); hi = lo + 63; }
    dst = p.XBCC + ch; dld = 768;
    const bf16_t* src = p.PROJ + OFF_XBC + ch;
    float wgt[5][8], bias[8];
#pragma unroll
    for (int k = 0; k < 5; ++k) { const f32x4v a = *(const f32x4v*)(p.conv_w + l * 5 * 768 + k * 768 + ch), c = *(const f32x4v*)(p.conv_w + l * 5 * 768 + k * 768 + ch + 4);
#pragma unroll
        for (int j = 0; j < 4; ++j) { wgt[k][j] = a[j]; wgt[k][4 + j] = c[j]; } }
    { const f32x4v a = *(const f32x4v*)(p.conv_b + l * 768 + ch), c = *(const f32x4v*)(p.conv_b + l * 768 + ch + 4);
#pragma unroll
      for (int j = 0; j < 4; ++j) { bias[j] = a[j]; bias[4 + j] = c[j]; } }
    const u32x4v zero4 = mk4(0u, 0u, 0u, 0u);
    u32x4v rw[13];
#pragma unroll
    for (int i = 0; i < 5; ++i) { const int tt = t0 - 2 + i; rw[i] = (tt >= lo && tt <= hi) ? *(const u32x4v*)(src + (size_t)tt * LDP) : zero4; }
    for (int s0 = 0; s0 < 32; s0 += 8) {
        const int t = t0 + s0;
#pragma unroll
        for (int i = 0; i < 8; ++i) { const int tt = t + 3 + i; rw[5 + i] = (tt <= hi) ? *(const u32x4v*)(src + (size_t)tt * LDP) : zero4; }
#pragma unroll
        for (int i = 0; i < 8; ++i) {
            float o[8];
#pragma unroll
            for (int c = 0; c < 8; ++c) o[c] = bias[c];
#pragma unroll
            for (int k = 0; k < 5; ++k) { float v[8]; unpack8(rw[i + k], v);
#pragma unroll
                for (int c = 0; c < 8; ++c) o[c] += wgt[k][c] * v[c]; }
#pragma unroll
            for (int c = 0; c < 8; ++c) o[c] = siluf(o[c]);
            *(u32x4v*)(dst + (size_t)(t + i) * dld) = pack8(o);
        }
#pragma unroll
        for (int i = 0; i < 5; ++i) rw[i] = rw[i + 8];
    }
}
DI void prep_ssd_item(const P& p, int l, int item, int lane) {
    const int tl = item >> 3, h = item & 7, tok0 = tile_tok0(tl);
    const float bsf = p.dt_bias_f[l * 8 + h], bsb = p.dt_bias_b[l * 8 + h];
    const float r0 = bf2f(p.PROJ[(size_t)(tok0 + 2 * lane) * LDP + OFF_DT + h]), r1 = bf2f(p.PROJ[(size_t)(tok0 + 2 * lane + 1) * LDP + OFF_DT + h]);
    const float f0 = fast_softplus(r0 + bsf), f1 = fast_softplus(r1 + bsf), b0 = fast_softplus(r0 + bsb), b1 = fast_softplus(r1 + bsb);
    float pf = f0 + f1, sb = b0 + b1;
#pragma unroll
    for (int o = 1; o < 64; o <<= 1) { const float t = shl(pf, lane >= o ? lane - o : lane); if (lane >= o) pf += t; }
#pragma unroll
    for (int o = 1; o < 64; o <<= 1) { const float t = shl(sb, lane + o < 64 ? lane + o : lane); if (lane + o < 64) sb += t; }
    const float Af = -__expf(p.a_log_f[l * 8 + h]) * LOG2E, Ab = -__expf(p.a_log_b[l * 8 + h]) * LOG2E;
    const float af0 = Af * (pf - f1), af1 = Af * pf, ab0 = Ab * sb, ab1 = Ab * (sb - b0);
    f32x4v* dst = (f32x4v*)p.SSC + (size_t)(tok0 + 2 * lane) * 8 + h;
    dst[0] = mkf4(af0, af0 - __log2f(f0), ab0, ab0 - __log2f(b0));
    dst[8] = mkf4(af1, af1 - __log2f(f1), ab1, ab1 - __log2f(b1));
    if (lane == 63) { p.STOT[(tl * 8 + h) * 2 + 0] = af1; p.SDEC[(tl * 8 + h) * 2 + 0] = __builtin_amdgcn_exp2f(af1); }
    if (lane == 0) { p.STOT[(tl * 8 + h) * 2 + 1] = ab0; p.SDEC[(tl * 8 + h) * 2 + 1] = __builtin_amdgcn_exp2f(ab0); }
}
template <int CTRL> DI float dppz(float x) { return __builtin_bit_cast(float, __builtin_amdgcn_update_dpp(0, __builtin_bit_cast(int, x), CTRL, 0xf, 0xf, true)); }
DI float row_total(float s) { s += dppz<0xB1>(s); s += dppz<0x4E>(s); s += dppz<0x141>(s); s += dppz<0x140>(s); return s; }
struct GlaPL { u32x4v qv_[2], kv_[2], vv_[4]; bf16x8v gkf[8]; float uw[8]; f32x4v bias; };
DI void prep_gla_load(const P& p, int l, int it, GlaPL& L) {
    const int tl = it >> 2, h = it & 3;
    const int tid = ltid(), lane = tid & 63, w = __builtin_amdgcn_readfirstlane(tid >> 6), kt = w & 3, dir = w >> 2, G = lane >> 4, c = lane & 15, tok0 = tile_tok0(tl);
#pragma unroll
    for (int nt = 0; nt < 8; ++nt) L.gkf[nt] = *(const bf16x8v*)(p.PROJ + (size_t)(tok0 + 16 * nt + c) * LDP + OFF_GK + (G & 1) * 8);
    { const float* up = (dir ? p.gk_up_b : p.gk_up_f) + l * 16 * 256 + (G & 1) * 8 * 256 + h * 64 + 16 * kt + c;
#pragma unroll
      for (int e = 0; e < 8; ++e) L.uw[e] = up[e * 256]; }
    L.bias = *(const f32x4v*)((dir ? p.gk_bias_b : p.gk_bias_f) + l * 256 + h * 64 + 16 * kt + 4 * G);
#pragma unroll
    for (int q = 0; q < 4; ++q) { const int cc_ = tid + q * NTHR, r = cc_ >> 4, cc = cc_ & 15; L.vv_[q] = *(const u32x4v*)(p.PROJ + (size_t)(tok0 + r) * LDP + OFF_V + h * 128 + cc * 8); }
#pragma unroll
    for (int q = 0; q < 2; ++q) { const int cc_ = tid + q * NTHR, r = cc_ >> 3, cc = cc_ & 7; const bf16_t* pr = p.PROJ + (size_t)(tok0 + r) * LDP;
        L.qv_[q] = *(const u32x4v*)(pr + OFF_Q + h * 64 + cc * 8); L.kv_[q] = *(const u32x4v*)(pr + OFF_K + h * 64 + cc * 8); }
}
DI void prep_gla_block(const P& p, int l, int it, int it_next, GlaPL& L, LDSP unsigned char* lds) {
    const int tl = it >> 2, h = it & 3;
    const int tid = ltid(), lane = tid & 63, w = __builtin_amdgcn_readfirstlane(tid >> 6), kt = w & 3, dir = w >> 2, G = lane >> 4, c = lane & 15, tok0 = tile_tok0(tl);
    LDSP bf16_t* QT = (LDSP bf16_t*)lds; LDSP bf16_t* KT = QT + 128 * LD64; LDSP bf16_t* O4 = KT + 128 * LD64; LDSP bf16_t* VT = O4 + 4 * 128 * LD64; LDSP float* DEC = (LDSP float*)(VT + 128 * LD128);
    f32x4v g[8];
    { bf16x8v af;
#pragma unroll
      for (int e = 0; e < 8; ++e) { const bf16_t hi = f2bf(L.uw[e]); const bf16_t lo = f2bf(L.uw[e] - bf2f(hi)); af[e] = (short)(G < 2 ? hi : lo); }
#pragma unroll
      for (int nt = 0; nt < 8; ++nt) g[nt] = mfma16(af, L.gkf[nt], (f32x4v){0.f, 0.f, 0.f, 0.f}); }
#pragma unroll
    for (int nt = 0; nt < 8; ++nt)
#pragma unroll
        for (int r = 0; r < 4; ++r) { const float x = (g[nt][r] + L.bias[r]) * LOG2E;
            g[nt][r] = -(fmaxf(-x, 0.f) + __log2f(1.0f + __builtin_amdgcn_exp2f(-fabsf(x)))) * (1.0f / 16.0f); }
    f32x4v tot = (f32x4v){0.f, 0.f, 0.f, 0.f};
    if (dir == 0) {
#pragma unroll
        for (int nt = 0; nt < 8; ++nt)
#pragma unroll
            for (int r = 0; r < 4; ++r) { const float s = row_total(g[nt][r]); float x = g[nt][r];
                x += dppz<0x111>(x); x += dppz<0x112>(x); x += dppz<0x114>(x); x += dppz<0x118>(x);
                g[nt][r] = tot[r] + x; tot[r] += s; }
    } else {
#pragma unroll
        for (int nt = 7; nt >= 0; --nt)
#pragma unroll
            for (int r = 0; r < 4; ++r) { const float s = row_total(g[nt][r]); float x = g[nt][r];
                x += dppz<0x101>(x); x += dppz<0x102>(x); x += dppz<0x104>(x); x += dppz<0x108>(x);
                g[nt][r] = tot[r] + x; tot[r] += s; }
    }
    __syncthreads();
#pragma unroll
    for (int q = 0; q < 2; ++q) { const int cc_ = tid + q * NTHR, r = cc_ >> 3, cc = cc_ & 7; *(LDSP u32x4v*)(QT + r * LD64 + cc * 8) = L.qv_[q]; *(LDSP u32x4v*)(KT + r * LD64 + cc * 8) = L.kv_[q]; }
#pragma unroll
    for (int q = 0; q < 4; ++q) { const int cc_ = tid + q * NTHR, r = cc_ >> 4, cc = cc_ & 15; *(LDSP u32x4v*)(VT + r * LD128 + cc * 8) = L.vv_[q]; }
    __syncthreads();
    { LDSP bf16_t* OQ = O4 + (2 * dir) * 128 * LD64; LDSP bf16_t* OK = OQ + 128 * LD64;
#pragma unroll
      for (int nt = 0; nt < 8; ++nt) { const int o = (16 * nt + c) * LD64 + 16 * kt + 4 * G;
          const u32x2v q2 = *(LDSP const u32x2v*)(QT + o), k2 = *(LDSP const u32x2v*)(KT + o);
          float eq[4], ek[4];
#pragma unroll
          for (int r = 0; r < 4; ++r) { eq[r] = __builtin_amdgcn_exp2f(g[nt][r] - 3.0f); ek[r] = __builtin_amdgcn_exp2f(-g[nt][r]); }
          *(LDSP u32x2v*)(OQ + o) = mk2(pk2(__uint_as_float(q2.x << 16) * eq[0], __uint_as_float(q2.x & 0xffff0000u) * eq[1]), pk2(__uint_as_float(q2.y << 16) * eq[2], __uint_as_float(q2.y & 0xffff0000u) * eq[3]));
          *(LDSP u32x2v*)(OK + o) = mk2(pk2(__uint_as_float(k2.x << 16) * ek[0], __uint_as_float(k2.x & 0xffff0000u) * ek[1]), pk2(__uint_as_float(k2.y << 16) * ek[2], __uint_as_float(k2.y & 0xffff0000u) * ek[3])); }
      if (c == 0) { const f32x4v d = mkf4(__builtin_amdgcn_exp2f(tot[0]), __builtin_amdgcn_exp2f(tot[1]), __builtin_amdgcn_exp2f(tot[2]), __builtin_amdgcn_exp2f(tot[3]));
          *(f32x4v*)(p.GDEC + (size_t)((tl * 4 + h) * 2 + dir) * 64 + 16 * kt + 4 * G) = d; *(LDSP f32x4v*)(DEC + dir * 64 + 16 * kt + 4 * G) = d; } }
    __syncthreads();
    if (it_next >= 0) prep_gla_load(p, l, it_next, L);
#pragma unroll
    for (int q = 0; q < 8; ++q) { const int cc_ = tid + q * NTHR, a4 = cc_ >> 10, r = (cc_ >> 3) & 127, cc = cc_ & 7;
        *(u32x4v*)(p.QKB + (size_t)(tok0 + r) * 1024 + a4 * 256 + h * 64 + cc * 8) = *(LDSP const u32x4v*)(O4 + (a4 * 128 + r) * LD64 + cc * 8); }
    { const int ut = kt; LDSP const bf16_t* KE = O4 + (dir ? 3 : 1) * 128 * LD64;
      f32x4v acc[8];
#pragma unroll
      for (int q = 0; q < 8; ++q) acc[q] = (f32x4v){0.f, 0.f, 0.f, 0.f};
#pragma unroll
      for (int ks = 0; ks < 4; ++ks) { const bf16x8v u = frag_col(KE, LD64, 16 * ut, 32 * ks, lane);
#pragma unroll
          for (int q = 0; q < 8; ++q) acc[q] = mfma16(u, frag_col(VT, LD128, 16 * q, 32 * ks, lane), acc[q]); }
      const f32x4v dec = *(LDSP const f32x4v*)(DEC + dir * 64 + 16 * ut + 4 * (lane >> 4));
      bf16_t* dst = p.GS + ((size_t)((tl * 4 + h) * 2 + dir) * 128) * 64;
#pragma unroll
      for (int q = 0; q < 8; ++q) *(u32x2v*)(dst + (size_t)(16 * q + (lane & 15)) * 64 + 16 * ut + 4 * (lane >> 4)) = pack4(acc[q] * dec); }
}
constexpr int NPREP_A = T / 32 + T / 64, NPREP_B = NTILE * 8;
DI void ph_prep(const P& p, int l, LDSP unsigned char* lds) {
    const int tid_ = ltid(), lane = tid_ & 63, gw = blockIdx.x * NWV + (tid_ >> 6), NW = gridDim.x * NWV;
    for (int it = gw; it < NPREP_A + NPREP_B; it += NW) {
        if (it < NPREP_A) prep_conv_item(p, l, it, lane); else prep_ssd_item(p, l, it - NPREP_A, lane);
    }
    { const int G_ = gridDim.x; int it = G_ - 1 - (int)blockIdx.x;
      GlaPL L; if (it < NTILE * 4) prep_gla_load(p, l, it, L);
      for (; it < NTILE * 4; it += G_) prep_gla_block(p, l, it, it + G_ < NTILE * 4 ? it + G_ : -1, L, lds); }
}

DI void s1_ssd(const P& p, int tl, int h, LDSP unsigned char* lds) {
    const int tid = ltid(), lane = tid & 63, w = __builtin_amdgcn_readfirstlane(tid >> 6);
    const int tok0 = tile_tok0(tl), g = h >> 2; const XbcSrc xs = xbc_src(p, tok0);
    LDSP bf16_t* XWF = (LDSP bf16_t*)lds; LDSP bf16_t* XWB = XWF + 128 * LD64; LDSP bf16_t* BG = XWB + 128 * LD64;
    const int j = tid >> 2, cq = tid & 3;
    const bf16_t* row = xs.base + (size_t)j * xs.ld;
    const u32x4v x0 = *(const u32x4v*)(row + h * 64 + cq * 16), x1 = *(const u32x4v*)(row + h * 64 + cq * 16 + 8);
    const u32x4v b0 = *(const u32x4v*)(row + 512 + g * 64 + cq * 16), b1 = *(const u32x4v*)(row + 512 + g * 64 + cq * 16 + 8);
    const f32x4v sc = *((const f32x4v*)p.SSC + (size_t)(tok0 + j) * 8 + h);
    const float wf = __builtin_amdgcn_exp2f(p.STOT[(tl * 8 + h) * 2 + 0] - sc.y), wb = __builtin_amdgcn_exp2f(p.STOT[(tl * 8 + h) * 2 + 1] - sc.w);
    float xv[16], of[16], ob[16]; unpack8(x0, xv); unpack8(x1, xv + 8);
#pragma unroll
    for (int c = 0; c < 16; ++c) { of[c] = xv[c] * wf; ob[c] = xv[c] * wb; }
    __syncthreads();
    *(LDSP u32x4v*)(XWF + j * LD64 + cq * 16) = pack8(of); *(LDSP u32x4v*)(XWF + j * LD64 + cq * 16 + 8) = pack8(of + 8);
    *(LDSP u32x4v*)(XWB + j * LD64 + cq * 16) = pack8(ob); *(LDSP u32x4v*)(XWB + j * LD64 + cq * 16 + 8) = pack8(ob + 8);
    *(LDSP u32x4v*)(BG + j * LD64 + cq * 16) = b0; *(LDSP u32x4v*)(BG + j * LD64 + cq * 16 + 8) = b1;
    __syncthreads();
    const int dir = w >> 2, ut = w & 3; LDSP const bf16_t* XW = dir ? XWB : XWF;
    f32x4v acc[4];
#pragma unroll
    for (int q = 0; q < 4; ++q) acc[q] = (f32x4v){0.f, 0.f, 0.f, 0.f};
#pragma unroll
    for (int ks = 0; ks < 4; ++ks) { const bf16x8v u = frag_col(BG, LD64, 16 * ut, 32 * ks, lane);
#pragma unroll
        for (int q = 0; q < 4; ++q) acc[q] = mfma16(u, frag_col(XW, LD64, 16 * q, 32 * ks, lane), acc[q]); }
    bf16_t* dst = p.SS + ((size_t)((tl * 8 + h) * 2 + dir) * 64) * 64;
#pragma unroll
    for (int q = 0; q < 4; ++q) *(u32x2v*)(dst + (size_t)(16 * q + (lane & 15)) * 64 + 16 * ut + 4 * (lane >> 4)) = pack4(acc[q]);
}
DI void ph_s1(const P& p, int l, LDSP unsigned char* lds) {
    for (int it = blockIdx.x; it < NTILE * 8; it += gridDim.x) s1_ssd(p, it >> 3, it & 7, lds);
}

DI int s2_chunk(int dir, int s) { return dir == 0 ? s : (s < 2 ? 1 - s : 35 - s); }
DI void ph_s2(const P& p) {
    const int g = blockIdx.x * NTHR + ltid();
    for (int v = g; v < 131072; v += gridDim.x * NTHR) {
        const bool gla = v >= 65536; const int r = v & 65535;
        int b, h, dir, vi;
        if (!gla) { vi = r & 511; dir = (r >> 9) & 1; h = (r >> 10) & 7; b = r >> 13; } else { vi = r & 1023; dir = (r >> 10) & 1; h = (r >> 11) & 3; b = r >> 13; }
        float st[8];
#pragma unroll
        for (int e = 0; e < 8; ++e) st[e] = 0.f;
        for (int s0 = 0; s0 < NCH; s0 += 6) {
            u32x4v sv[6]; float dsc[6]; f32x4v dv0[6], dv1[6];
#pragma unroll
            for (int u = 0; u < 6; ++u) { if (s0 + u >= NCH) continue; const int tl = b * NCH + s2_chunk(dir, s0 + u);
                if (!gla) { sv[u] = *(const u32x4v*)(p.SS + ((size_t)((tl * 8 + h) * 2 + dir) * 512 + vi) * 8); dsc[u] = p.SDEC[(tl * 8 + h) * 2 + dir]; }
                else { sv[u] = *(const u32x4v*)(p.GS + ((size_t)((tl * 4 + h) * 2 + dir) * 1024 + vi) * 8); const f32x4v* d = (const f32x4v*)(p.GDEC + (size_t)((tl * 4 + h) * 2 + dir) * 64 + (vi & 7) * 8); dv0[u] = d[0]; dv1[u] = d[1]; } }
#pragma unroll
            for (int u = 0; u < 6; ++u) { if (s0 + u >= NCH) continue; const int tl = b * NCH + s2_chunk(dir, s0 + u);
                float loc[8]; unpack8(sv[u], loc);
                const u32x4v hin = pack8(st);
                if (!gla) { *(u32x4v*)(p.SS + ((size_t)((tl * 8 + h) * 2 + dir) * 512 + vi) * 8) = hin;
#pragma unroll
                    for (int e = 0; e < 8; ++e) st[e] = dsc[u] * st[e] + loc[e]; }
                else { *(u32x4v*)(p.GS + ((size_t)((tl * 4 + h) * 2 + dir) * 1024 + vi) * 8) = hin;
                    const float dd[8] = {dv0[u].x, dv0[u].y, dv0[u].z, dv0[u].w, dv1[u].x, dv1[u].y, dv1[u].z, dv1[u].w};
#pragma unroll
                    for (int e = 0; e < 8; ++e) st[e] = dd[e] * st[e] + loc[e]; } }
        }
    }
}

DI int s3_tile(int l, int q) { return l == 0 ? q : (q >> 5) * NCH + 2 + (q & 31); }
struct SsdPre { u32x4v x0, x1, b0, b1, c0, c1, hf, hb; f32x4v sc; };
DI void s3_ssd_load(const P& p, int tl, int h, int tid, int i, int G, SsdPre& r) {
    const int tok0 = tile_tok0(tl), g = h >> 2; const XbcSrc xs = xbc_src(p, tok0);
    const int j = tid >> 2, cq = tid & 3; const bf16_t* row = xs.base + (size_t)j * xs.ld;
    r.x0 = *(const u32x4v*)(row + h * 64 + cq * 16); r.x1 = *(const u32x4v*)(row + h * 64 + cq * 16 + 8);
    r.b0 = *(const u32x4v*)(row + 512 + g * 64 + cq * 16); r.b1 = *(const u32x4v*)(row + 512 + g * 64 + cq * 16 + 8);
    r.c0 = *(const u32x4v*)(row + 640 + g * 64 + cq * 16); r.c1 = *(const u32x4v*)(row + 640 + g * 64 + cq * 16 + 8);
    const bf16_t* Hf = p.SS + (size_t)((tl * 8 + h) * 2 + 0) * 4096 + (tid >> 3) * 64 + (tid & 7) * 8;
    r.hf = *(const u32x4v*)Hf; r.hb = *(const u32x4v*)(Hf + 4096);
    r.sc = *((const f32x4v*)p.SSC + (size_t)(tok0 + (tid & 127)) * 8 + h);
}
DI void ph_s3_ssd(const P& p, int l, LDSP unsigned char* lds) {
    const int tid = ltid(), lane = tid & 63, w = __builtin_amdgcn_readfirstlane(tid >> 6), G = lane >> 4, li = lane & 15, i = 16 * w + li;
    LDSP bf16_t* XH = (LDSP bf16_t*)lds; LDSP bf16_t* BG = XH + 128 * LD64; LDSP bf16_t* CG = BG + 128 * LD64; LDSP bf16_t* MM = CG + 128 * LD64; LDSP f32x4v* SC = (LDSP f32x4v*)(MM + 128 * LD128);
    LDSP bf16_t* HF = (LDSP bf16_t*)(SC + 128); LDSP bf16_t* HB = HF + 64 * LD64;
    const int nit = (l == 0 ? NTILE : NB * 32) * 8, GS_ = gridDim.x;
    int it = ((int)blockIdx.x + (GS_ >> 1)) % GS_; SsdPre pre;
    if (it < nit) s3_ssd_load(p, s3_tile(l, it >> 3), it & 7, tid, i, G, pre);
    for (; it < nit; it += GS_) {
        const int tl = s3_tile(l, it >> 3), h = it & 7, tok0 = tile_tok0(tl);
        __syncthreads();
        { const int j = tid >> 2, cq = tid & 3;
          *(LDSP u32x4v*)(XH + j * LD64 + cq * 16) = pre.x0; *(LDSP u32x4v*)(XH + j * LD64 + cq * 16 + 8) = pre.x1;
          *(LDSP u32x4v*)(BG + j * LD64 + cq * 16) = pre.b0; *(LDSP u32x4v*)(BG + j * LD64 + cq * 16 + 8) = pre.b1;
          *(LDSP u32x4v*)(CG + j * LD64 + cq * 16) = pre.c0; *(LDSP u32x4v*)(CG + j * LD64 + cq * 16 + 8) = pre.c1;
          *(LDSP u32x4v*)(HF + (tid >> 3) * LD64 + (tid & 7) * 8) = pre.hf; *(LDSP u32x4v*)(HB + (tid >> 3) * LD64 + (tid & 7) * 8) = pre.hb;
          if (tid < 128) SC[tid] = pre.sc; }
        if (it + GS_ < nit) s3_ssd_load(p, s3_tile(l, (it + GS_) >> 3), (it + GS_) & 7, tid, i, G, pre);
        __syncthreads();
        u32x2v zr[4];
#pragma unroll
        for (int pt = 0; pt < 4; ++pt) zr[pt] = *(const u32x2v*)(p.PROJ + (size_t)(tok0 + i) * LDP + OFF_Z + h * 64 + 16 * pt + 4 * G);
        const f32x4v sci = SC[i];
        {
            f32x4v am[8];
#pragma unroll
            for (int ut = 0; ut < 8; ++ut) am[ut] = (f32x4v){0.f, 0.f, 0.f, 0.f};
#pragma unroll
            for (int ks = 0; ks < 2; ++ks) { const bf16x8v vfr = frag_row(CG, LD64, 16 * w, 32 * ks, lane);
#pragma unroll
                for (int ut = 0; ut < 8; ++ut) am[ut] = mfma16(frag_row(BG, LD64, 16 * ut, 32 * ks, lane), vfr, am[ut]); }
#pragma unroll
            for (int ut = 0; ut < 8; ++ut) { f32x4v m;
#pragma unroll
                for (int r = 0; r < 4; ++r) { const int jj = 16 * ut + 4 * G + r; const f32x4v scj = SC[jj];
                    const float Lf = jj <= i ? __builtin_amdgcn_exp2f(fminf(sci.x - scj.y, 30.f)) : 0.f, Lb = jj >= i ? __builtin_amdgcn_exp2f(fminf(sci.z - scj.w, 30.f)) : 0.f;
                    m[r] = am[ut][r] * (Lf + Lb); }
                *(LDSP u32x2v*)(MM + i * LD128 + 16 * ut + 4 * G) = pack4(m); }
        }
        asm volatile("s_waitcnt lgkmcnt(0)" ::: "memory");
        f32x4v ay[4], af_[4], ab_[4];
#pragma unroll
        for (int pt = 0; pt < 4; ++pt) { ay[pt] = (f32x4v){0.f, 0.f, 0.f, 0.f}; af_[pt] = ay[pt]; ab_[pt] = ay[pt]; }
#pragma unroll
        for (int ks = 0; ks < 2; ++ks) { const bf16x8v vfr = frag_row(CG, LD64, 16 * w, 32 * ks, lane);
#pragma unroll
            for (int pt = 0; pt < 4; ++pt) { af_[pt] = mfma16(frag_row(HF, LD64, 16 * pt, 32 * ks, lane), vfr, af_[pt]); ab_[pt] = mfma16(frag_row(HB, LD64, 16 * pt, 32 * ks, lane), vfr, ab_[pt]); } }
#pragma unroll
        for (int ks = 0; ks < 4; ++ks) { const bf16x8v vfr = frag_row(MM, LD128, 16 * w, 32 * ks, lane);
#pragma unroll
            for (int pt = 0; pt < 4; ++pt) ay[pt] = mfma16(frag_col(XH, LD64, 16 * pt, 32 * ks, lane), vfr, ay[pt]); }
        const float sf = __builtin_amdgcn_exp2f(sci.x), sb = __builtin_amdgcn_exp2f(sci.z), dsk = p.d_skip[l * 8 + h];
        float ssq = 0.f;
#pragma unroll
        for (int pt = 0; pt < 4; ++pt) { const int pc = 16 * pt + 4 * G;
            const u32x2v xr = *(LDSP const u32x2v*)(XH + i * LD64 + pc);
            const float xv[4] = {__uint_as_float(xr.x << 16), __uint_as_float(xr.x & 0xffff0000u), __uint_as_float(xr.y << 16), __uint_as_float(xr.y & 0xffff0000u)};
            const float zv[4] = {__uint_as_float(zr[pt].x << 16), __uint_as_float(zr[pt].x & 0xffff0000u), __uint_as_float(zr[pt].y << 16), __uint_as_float(zr[pt].y & 0xffff0000u)};
            float yv[4];
#pragma unroll
            for (int r = 0; r < 4; ++r) { yv[r] = (ay[pt][r] + sf * af_[pt][r] + sb * ab_[pt][r] + dsk * xv[r]) * siluf(zv[r]); yv[r] = bf2f(f2bf(yv[r])); ssq += yv[r] * yv[r]; }
            *(u32x2v*)(p.H + (size_t)(tok0 + i) * D + h * 64 + pc) = mk2(pk2(yv[0], yv[1]), pk2(yv[2], yv[3])); }
        ssq += shx(ssq, 16, lane); ssq += shx(ssq, 32, lane);
        if (G == 0) p.SSQ[(size_t)(tok0 + i) * 8 + h] = ssq;
    }
}
struct GlaPre { u32x4v qk[2][4], vv[4], sf[2], sb[2]; };
DI void s3_gla_load(const P& p, int tl, int h, int tid, int i, int G, GlaPre& r) {
    const int tok0 = tile_tok0(tl);
#pragma unroll
    for (int q = 0; q < 2; ++q) { const int c = tid + q * NTHR, rr = c >> 3, cc = c & 7; const bf16_t* qb = p.QKB + (size_t)(tok0 + rr) * 1024 + h * 64 + cc * 8;
        r.qk[q][0] = *(const u32x4v*)qb; r.qk[q][1] = *(const u32x4v*)(qb + 256);
        r.qk[q][2] = *(const u32x4v*)(qb + 512); r.qk[q][3] = *(const u32x4v*)(qb + 768);
        const bf16_t* Sg = p.GS + (size_t)((tl * 4 + h) * 2 + 0) * 8192 + (size_t)rr * 64 + cc * 8; r.sf[q] = *(const u32x4v*)Sg; r.sb[q] = *(const u32x4v*)(Sg + 8192); }
#pragma unroll
    for (int q = 0; q < 4; ++q) { const int c = tid + q * NTHR, rr = c >> 4, cc = c & 15; r.vv[q] = *(const u32x4v*)(p.PROJ + (size_t)(tok0 + rr) * LDP + OFF_V + h * 128 + cc * 8); }
}
DI void ph_s3_gla(const P& p, int l, LDSP unsigned char* lds) {
    const int tid = ltid(), lane = tid & 63, w = __builtin_amdgcn_readfirstlane(tid >> 6), G = lane >> 4, li = lane & 15, i = 16 * w + li;
    LDSP bf16_t* Q2 = (LDSP bf16_t*)lds;
    LDSP bf16_t* KF = Q2 + 8 * 2 * 16 * LD64; LDSP bf16_t* KB = KF + 128 * LD64; LDSP bf16_t* VT = KB + 128 * LD64; LDSP bf16_t* SF = VT + 128 * LD128; LDSP bf16_t* SB = SF + 128 * LD64;
    LDSP bf16_t* AMw = SF + w * 16 * LD128;
    const int nit = (l == 0 ? NTILE : NB * 32) * 4, GS_ = gridDim.x;
    int it = blockIdx.x; GlaPre pre;
    if (it < nit) s3_gla_load(p, s3_tile(l, it >> 2), it & 3, tid, i, G, pre);
    for (; it < nit; it += GS_) {
        const int tl = s3_tile(l, it >> 2), h = it & 3, tok0 = tile_tok0(tl);
        __syncthreads();
#pragma unroll
        for (int q = 0; q < 2; ++q) { const int c = tid + q * NTHR, rr = c >> 3, cc = c & 7; LDSP bf16_t* qrow = Q2 + (rr >> 4) * (2 * 16 * LD64) + (rr & 15) * LD64 + cc * 8;
            *(LDSP u32x4v*)qrow = pre.qk[q][0]; *(LDSP u32x4v*)(qrow + 16 * LD64) = pre.qk[q][2];
            *(LDSP u32x4v*)(KF + rr * LD64 + cc * 8) = pre.qk[q][1]; *(LDSP u32x4v*)(KB + rr * LD64 + cc * 8) = pre.qk[q][3];
            *(LDSP u32x4v*)(SF + rr * LD64 + cc * 8) = pre.sf[q]; *(LDSP u32x4v*)(SB + rr * LD64 + cc * 8) = pre.sb[q]; }
#pragma unroll
        for (int q = 0; q < 4; ++q) { const int c = tid + q * NTHR, rr = c >> 4, cc = c & 15; *(LDSP u32x4v*)(VT + rr * LD128 + cc * 8) = pre.vv[q]; }
        if (it + GS_ < nit) s3_gla_load(p, s3_tile(l, (it + GS_) >> 2), (it + GS_) & 3, tid, i, G, pre);
        __syncthreads();
        f32x4v ao[8];
#pragma unroll
        for (int q = 0; q < 8; ++q) ao[q] = (f32x4v){0.f, 0.f, 0.f, 0.f};
        bf16x8v qfr[2][2];
#pragma unroll
        for (int dir = 0; dir < 2; ++dir)
#pragma unroll
            for (int ks = 0; ks < 2; ++ks) qfr[dir][ks] = frag_row(Q2 + w * (2 * 16 * LD64) + dir * 16 * LD64, LD64, 0, 32 * ks, lane);
#pragma unroll
        for (int dir = 0; dir < 2; ++dir) {
            LDSP const bf16_t* SS_ = dir ? SB : SF;
#pragma unroll
            for (int ks = 0; ks < 2; ++ks) {
#pragma unroll
                for (int vt = 0; vt < 8; ++vt) ao[vt] = mfma16(frag_row(SS_, LD64, 16 * vt, 32 * ks, lane), qfr[dir][ks], ao[vt]); }
        }
        __syncthreads();
#pragma unroll
        for (int uh = 0; uh < 4; ++uh) {
            f32x4v a2[2]; a2[0] = (f32x4v){0.f, 0.f, 0.f, 0.f}; a2[1] = a2[0];
#pragma unroll
            for (int dir = 0; dir < 2; ++dir) {
                LDSP const bf16_t* KS = dir ? KB : KF;
                f32x4v as[2]; as[0] = (f32x4v){0.f, 0.f, 0.f, 0.f}; as[1] = as[0];
#pragma unroll
                for (int ks = 0; ks < 2; ++ks) {
#pragma unroll
                    for (int q = 0; q < 2; ++q) as[q] = mfma16(frag_row(KS, LD64, 16 * (2 * uh + q), 32 * ks, lane), qfr[dir][ks], as[q]); }
#pragma unroll
                for (int q = 0; q < 2; ++q)
#pragma unroll
                    for (int r = 0; r < 4; ++r) { const int jj = 16 * (2 * uh + q) + 4 * G + r; const bool keep = dir == 0 ? (jj <= i) : (jj >= i); a2[q][r] += keep ? as[q][r] : 0.f; }
            }
#pragma unroll
            for (int q = 0; q < 2; ++q) *(LDSP u32x2v*)(AMw + li * LD128 + 16 * (2 * uh + q) + 4 * G) = pack4(a2[q]);
        }
        u32x2v gr[8];
#pragma unroll
        for (int vt = 0; vt < 8; ++vt) gr[vt] = *(const u32x2v*)(p.PROJ + (size_t)(tok0 + i) * LDP + OFF_GO + h * 128 + 16 * vt + 4 * G);
        asm volatile("s_waitcnt lgkmcnt(0)" ::: "memory");
#pragma unroll
        for (int ks = 0; ks < 4; ++ks) { const bf16x8v vfr = frag_row(AMw, LD128, 0, 32 * ks, lane);
#pragma unroll
            for (int vt = 0; vt < 8; ++vt) ao[vt] = mfma16(frag_col(VT, LD128, 16 * vt, 32 * ks, lane), vfr, ao[vt]); }
        float so = 0.f;
#pragma unroll
        for (int vt = 0; vt < 8; ++vt)
#pragma unroll
            for (int r = 0; r < 4; ++r) so += ao[vt][r] * ao[vt][r];
        so += shx(so, 16, lane); so += shx(so, 32, lane);
        const float ro = rsqrtf(so * (1.0f / 128.0f) + 1e-6f);
#pragma unroll
        for (int vt = 0; vt < 8; ++vt) { const int vc = 16 * vt + 4 * G; const f32x4v gg = *(const f32x4v*)(p.gla_norm_g + l * 128 + vc);
            const float g0 = __uint_as_float(gr[vt].x << 16), g1 = __uint_as_float(gr[vt].x & 0xffff0000u), g2 = __uint_as_float(gr[vt].y << 16), g3 = __uint_as_float(gr[vt].y & 0xffff0000u);
            *(u32x2v*)(p.H + (size_t)(tok0 + i) * D + 512 + h * 128 + vc) = mk2(pk2(ao[vt][0] * ro * gg.x * siluf(g0), ao[vt][1] * ro * gg.y * siluf(g1)), pk2(ao[vt][2] * ro * gg.z * siluf(g2), ao[vt][3] * ro * gg.w * siluf(g3))); }
    }
}
DI void ph_s3(const P& p, int l, LDSP unsigned char* lds) { ph_s3_gla(p, l, lds); ph_s3_ssd(p, l, lds); }
DI void ph_normroute(const P& p, int l, int t0, LDSP unsigned char* lds) {
    const int tid_ = ltid(), lane = tid_ & 63, wv = tid_ >> 6, gw = blockIdx.x * NWV + wv, NW = gridDim.x * NWV, G = lane >> 4, li = lane & 15;
    const float* MODl = p.MOD + (size_t)l * 9 * 6144; int* counts = p.counts + l * 32 * 32;
    constexpr int LDW = 1032, LDT = 264;
    LDSP bf16_t* WR = (LDSP bf16_t*)lds;
    LDSP bf16_t* HT = WR + 32 * LDW + wv * 16 * LDT;
    { u32x4v wv_[8];
#pragma unroll
      for (int q = 0; q < 8; ++q) wv_[q] = *(const u32x4v*)(p.WRT + (size_t)(tid_ + q * NTHR) * 8);
#pragma unroll
      for (int q = 0; q < 8; ++q) { const int c = tid_ + q * NTHR; *(LDSP u32x4v*)(WR + (c >> 7) * LDW + (c & 127) * 8) = wv_[q]; } }
    __syncthreads();
    const int ntile = (T - t0) >> 4;
    const float* g2 = p.norm2_g + l * D;
    for (int tile = gw; tile < ntile; tile += NW) {
        const int tb = t0 + tile * 16;
        const float* mr = MODl + (size_t)tok_modrow(tb) * 6144;
        float rs[16];
        { const f32x4v* q = (const f32x4v*)(p.XSS + (size_t)(tb + li) * 16); const f32x4v a = q[0], b = q[1], c = q[2], d = q[3];
          const float ss = (((a.x + a.y) + (a.z + a.w)) + ((b.x + b.y) + (b.z + b.w))) + (((c.x + c.y) + (c.z + c.w)) + ((d.x + d.y) + (d.z + d.w)));
          const float r = rsqrtf(ss * (1.0f / D) + 1e-6f);
#pragma unroll
          for (int i = 0; i < 16; ++i) rs[i] = shl(r, i); }
        f32x4v acc[2]; acc[0] = (f32x4v){0.f, 0.f, 0.f, 0.f}; acc[1] = acc[0];
        u32x2v xq[16];
#pragma unroll
        for (int i = 0; i < 16; ++i) xq[i] = *(const u32x2v*)(xrow(p, tb + i) + lane * 4);
#pragma unroll
        for (int kc = 0; kc < 4; ++kc) {
            const int kk = kc * 256 + lane * 4;
            const f32x4v gg = *(const f32x4v*)(g2 + kk), sh = *(const f32x4v*)(mr + 3 * 1024 + kk), sc = *(const f32x4v*)(mr + 4 * 1024 + kk);
            f32x4v gs;
#pragma unroll
            for (int j = 0; j < 4; ++j) gs[j] = gg[j] * (1.f + sc[j]);
#pragma unroll
            for (int i = 0; i < 16; ++i) { const u32x2v r = xq[i];
                const f32x4v xv = mkf4(__uint_as_float(r.x << 16), __uint_as_float(r.x & 0xffff0000u), __uint_as_float(r.y << 16), __uint_as_float(r.y & 0xffff0000u));
                const f32x4v h = xv * rs[i] * gs + sh; const u32x2v hb = pack4(h);
                *(u32x2v*)(p.H + (size_t)(tb + i) * D + kk) = hb; *(LDSP u32x2v*)(HT + i * LDT + lane * 4) = hb; }
            if (kc < 3) {
#pragma unroll
                for (int i = 0; i < 16; ++i) xq[i] = *(const u32x2v*)(xrow(p, tb + i) + kk + 256); }
            asm volatile("s_waitcnt lgkmcnt(0)" ::: "memory");
#pragma unroll
            for (int ks = 0; ks < 8; ++ks) { const bf16x8v vfr = frag_row(HT, LDT, 0, 32 * ks, lane);
                acc[0] = mfma16(frag_row(WR, LDW, 0, kc * 256 + 32 * ks, lane), vfr, acc[0]);
                acc[1] = mfma16(frag_row(WR, LDW, 16, kc * 256 + 32 * ks, lane), vfr, acc[1]); }
            asm volatile("s_waitcnt lgkmcnt(0)" ::: "memory");
        }
        float bgs = -1e30f; int bgi = 0, e1 = 0, e2 = 0; float w1 = 0.f, w2 = 0.f;
#pragma unroll
        for (int ut = 0; ut < 2; ++ut) { const int gi = ut * 4 + G; float m1 = -1e30f, m2 = -1e30f, s1 = 0.f, s2 = 0.f; int i1 = 0, i2 = 0;
#pragma unroll
            for (int r = 0; r < 4; ++r) { const float sv = 1.0f / (1.0f + __expf(-acc[ut][r])), vv = sv + p.router_bias[gi * 4 + r];
                if (vv > m1) { m2 = m1; i2 = i1; s2 = s1; m1 = vv; i1 = gi * 4 + r; s1 = sv; } else if (vv > m2) { m2 = vv; i2 = gi * 4 + r; s2 = sv; } }
            if (m1 + m2 > bgs) { bgs = m1 + m2; bgi = gi; e1 = i1; e2 = i2; w1 = s1; w2 = s2; } }
#pragma unroll
        for (int o = 16; o <= 32; o <<= 1) {
            const float ogs = shx(bgs, o, lane), ow1 = shx(w1, o, lane), ow2 = shx(w2, o, lane); const int ogi = shxi(bgi, o, lane), oe1 = shxi(e1, o, lane), oe2 = shxi(e2, o, lane);
            if (ogs > bgs || (ogs == bgs && ogi < bgi)) { bgs = ogs; bgi = ogi; e1 = oe1; e2 = oe2; w1 = ow1; w2 = ow2; } }
        if (G == 0) {
            const int t = tb + li; const float inv = 1.0f / (w1 + w2);
            const int r1 = atomicAdd(&counts[e1 * 32], 1), r2 = atomicAdd(&counts[e2 * 32], 1);
            p.MAP[(size_t)e1 * T + r1] = t; p.MAP[(size_t)e2 * T + r2] = t;
            p.TOKSLOT[t * 4 + 0] = e1; p.TOKSLOT[t * 4 + 1] = r1; p.TOKSLOT[t * 4 + 2] = e2; p.TOKSLOT[t * 4 + 3] = r2;
            p.EW[t * 2 + 0] = w1 * inv; p.EW[t * 2 + 1] = w2 * inv;
        }
    }
}

DI void ph_combine(const P& p, int l, int t0, const unsigned char* Y  , LDSP int* ps  ) {
    const int tid_ = ltid(), lane = tid_ & 63, gw = blockIdx.x * NWV + (tid_ >> 6), NW = gridDim.x * NWV;
    const float* MODl = p.MOD + (size_t)l * 9 * 6144; const int* counts = p.counts + l * 32 * 32;
    if (tid_ < 64) { const int cnt = tid_ < 32 ? counts[tid_ * 32] : 0; int pc = cnt;
#pragma unroll
        for (int o = 1; o < 32; o <<= 1) { const int src = lane >= o ? lane - o : lane; const int a = shli(pc, src); if (lane >= o) pc += a; }
        if (tid_ < 32) ps[tid_] = pc - cnt; }
    __syncthreads();
    for (int t = t0 + 4 * gw; t < T; t += 4 * NW) {
        int4 sl[4]; float4 ew[2];
#pragma unroll
        for (int u = 0; u < 4; ++u) sl[u] = *(const int4*)(p.TOKSLOT + (size_t)(t + u) * 4);
        ew[0] = *(const float4*)(p.EW + (size_t)t * 2); ew[1] = *(const float4*)(p.EW + (size_t)(t + 2) * 2);
        unsigned yr[4][2][4];
#pragma unroll
        for (int u = 0; u < 4; ++u) { const unsigned char* y0 = Y + (size_t)(ps[sl[u].x] + sl[u].y) * D; const unsigned char* y1 = Y + (size_t)(ps[sl[u].z] + sl[u].w) * D;
#pragma unroll
            for (int i = 0; i < 4; ++i) { yr[u][0][i] = *(const unsigned*)(y0 + (i * 64 + lane) * 4); yr[u][1][i] = *(const unsigned*)(y1 + (i * 64 + lane) * 4); } }
        const float* mrow = MODl + (size_t)tok_modrow(t) * 6144; const float* g5 = mrow + 5 * 1024;
        const float* mr1 = p.MOD + (size_t)9 * 6144 + (size_t)tok_modrow(t) * 6144;
#pragma unroll
        for (int pr = 0; pr < 2; ++pr) {
            const float wgt[2][2] = {{ew[pr].x, ew[pr].y}, {ew[pr].z, ew[pr].w}};
            u32x2v xr[2][4];
#pragma unroll
            for (int u = 0; u < 2; ++u)
#pragma unroll
                for (int i = 0; i < 4; ++i) xr[u][i] = *(const u32x2v*)(xrow(p, t + 2 * pr + u) + (i * 64 + lane) * 4);
            float4 v[2][4];
#pragma unroll
            for (int i = 0; i < 4; ++i) { const int c = (i * 64 + lane) * 4; const float4 gg = *(const float4*)(g5 + c);
#pragma unroll
                for (int u = 0; u < 2; ++u) { const u32x2v x = xr[u][i]; const int a = (int)yr[2 * pr + u][0][i], b = (int)yr[2 * pr + u][1][i]; const float w1 = wgt[u][0], w2 = wgt[u][1];
                    v[u][i].x = __uint_as_float(x.x << 16) + gg.x * (w1 * __builtin_amdgcn_cvt_f32_fp8(a, 0) + w2 * __builtin_amdgcn_cvt_f32_fp8(b, 0));
                    v[u][i].y = __uint_as_float(x.x & 0xffff0000u) + gg.y * (w1 * __builtin_amdgcn_cvt_f32_fp8(a, 1) + w2 * __builtin_amdgcn_cvt_f32_fp8(b, 1));
                    v[u][i].z = __uint_as_float(x.y << 16) + gg.z * (w1 * __builtin_amdgcn_cvt_f32_fp8(a, 2) + w2 * __builtin_amdgcn_cvt_f32_fp8(b, 2));
                    v[u][i].w = __uint_as_float(x.y & 0xffff0000u) + gg.w * (w1 * __builtin_amdgcn_cvt_f32_fp8(a, 3) + w2 * __builtin_amdgcn_cvt_f32_fp8(b, 3));
                    if (l == 0) *(u32x2v*)(xrow(p, t + 2 * pr + u) + c) = mk2(pk2(v[u][i].x, v[u][i].y), pk2(v[u][i].z, v[u][i].w)); } }
            float rstd[2];
#pragma unroll
            for (int u = 0; u < 2; ++u) { float ss = 0.f;
#pragma unroll
                for (int i = 0; i < 4; ++i) ss += v[u][i].x * v[u][i].x + v[u][i].y * v[u][i].y + v[u][i].z * v[u][i].z + v[u][i].w * v[u][i].w;
                rstd[u] = rsqrtf(wave_sum(ss, lane) * (1.0f / D) + 1e-6f); }
            if (l == 0) {
#pragma unroll
                for (int i = 0; i < 4; ++i) { const int c = (i * 64 + lane) * 4;
                    const float4 gg = *(const float4*)(p.norm1_g + D + c), sh = *(const float4*)(mr1 + c), sc = *(const float4*)(mr1 + 1024 + c);
#pragma unroll
                    for (int u = 0; u < 2; ++u) { const float r = rstd[u];
                        *(u32x2v*)(p.H + (size_t)(t + 2 * pr + u) * D + c) = mk2(pk2(v[u][i].x * r * gg.x * (1.f + sc.x) + sh.x, v[u][i].y * r * gg.y * (1.f + sc.y) + sh.y), pk2(v[u][i].z * r * gg.z * (1.f + sc.z) + sh.z, v[u][i].w * r * gg.w * (1.f + sc.w) + sh.w)); } }
            } else {
#pragma unroll
                for (int u = 0; u < 2; ++u)
#pragma unroll
                    for (int i = 0; i < 4; ++i) { const float4 gg = ((const float4*)p.final_g)[i * 64 + lane]; const float r = rstd[u];
                        ((float4*)(p.out + (size_t)(t + 2 * pr + u - TC) * D))[i * 64 + lane] = make_float4(v[u][i].x * r * gg.x, v[u][i].y * r * gg.y, v[u][i].z * r * gg.z, v[u][i].w * r * gg.w); }
            }
        }
    }
}

#define XLAS __attribute__((address_space(3)))
#define XB_TMO      128
#define XB_XCNT(j)  (256  + 64 * (j))
#define XB_XSUB(j)  (1280 + 64 * (j))
#define XB_XGEN(j)  (2304 + 64 * (j))
#define XB_TOP      3328
#define XB_TOPGEN   3392
#define XCD_BAR_WORDS 3456
#define XB_SPIN_CAP (1u << 18)

__device__ __forceinline__ unsigned xb_ld(unsigned* p)              { return __hip_atomic_load(p, __ATOMIC_RELAXED, __HIP_MEMORY_SCOPE_AGENT); }
__device__ __forceinline__ unsigned xb_add(unsigned* p, unsigned v) { return __hip_atomic_fetch_add(p, v, __ATOMIC_RELAXED, __HIP_MEMORY_SCOPE_AGENT); }
__device__ __forceinline__ unsigned xb_xcc_id() { return (unsigned)__builtin_amdgcn_s_getreg((3 << 11) | 20) & 0xFu; }
#define XB_SPIN(cond, bar) do { unsigned _sp = 0; while (cond) { __builtin_amdgcn_s_sleep(1); \
    if ((++_sp & 255u) == 0u) { if (xb_ld(&(bar)[XB_TMO])) break; if (_sp > XB_SPIN_CAP) { atomicAdd(&(bar)[XB_TMO], 1u); break; } } } } while (0)

struct XcdBarrier {
    unsigned* bar; unsigned x;
    volatile XLAS unsigned* st;
};

__device__ __forceinline__ XcdBarrier xcd_barrier_post(unsigned* bar, volatile XLAS unsigned* st) {
    XcdBarrier b; b.bar = bar; b.x = xb_xcc_id(); b.st = st;
    if (ltid() == 0) (void)xb_add(&bar[XB_XCNT(b.x)], 1u);
    return b;
}
__device__ __forceinline__ void xcd_barrier_complete(unsigned* bar, unsigned x, unsigned& nloc, unsigned& nx) {
    const unsigned G = gridDim.x * gridDim.y * gridDim.z;
    unsigned sum, cnt, mine, sp = 0u;
    for (;;) {
        sum = 0u; cnt = 0u; mine = 0u;
#pragma unroll
        for (unsigned j = 0; j < 16; ++j) { const unsigned c = xb_ld(&bar[XB_XCNT(j)]); sum += c; cnt += (c > 0u) ? 1u : 0u; mine = (j == x) ? c : mine; }
        if (sum == G) break;
        __builtin_amdgcn_s_sleep(1);
        if ((++sp & 255u) == 0u) { if (xb_ld(&bar[XB_TMO])) break; if (sp > XB_SPIN_CAP) { atomicAdd(&bar[XB_TMO], 1u); break; } }
    }
    nloc = mine > 0u ? mine : 1u; nx = cnt > 0u ? cnt : 1u;
}

__device__ __forceinline__ void xcd_barrier(const XcdBarrier& b) {
    asm volatile("s_waitcnt vmcnt(0)" ::: "memory");
    __syncthreads();
    if (ltid() == 0) {
        unsigned* bar = b.bar;
        __builtin_amdgcn_s_waitcnt(0);
        unsigned nloc = b.st[0], nx = b.st[1];
        if (nloc == 0u) { xcd_barrier_complete(bar, b.x, nloc, nx); b.st[0] = nloc; b.st[1] = nx; }
        const unsigned old = xb_add(&bar[XB_XSUB(b.x)], 1u);
        const unsigned gen = old / nloc;
        if (old + 1u == (gen + 1u) * nloc) {
            __builtin_amdgcn_fence(__ATOMIC_RELEASE, "agent");
            asm volatile("s_waitcnt vmcnt(0)" ::: "memory");
            const unsigned og = xb_add(&bar[XB_TOP], 1u);
            const unsigned tg = og / nx;
            if (og + 1u == (tg + 1u) * nx) xb_add(&bar[XB_TOPGEN], 1u);
            else XB_SPIN(xb_ld(&bar[XB_TOPGEN]) == tg, bar);
            __builtin_amdgcn_fence(__ATOMIC_ACQUIRE, "agent");
            xb_add(&bar[XB_XGEN(b.x)], 1u);
            asm volatile("s_waitcnt vmcnt(0)" ::: "memory");
        } else {
            XB_SPIN(xb_ld(&bar[XB_XGEN(b.x)]) == gen, bar);
            __builtin_amdgcn_fence(__ATOMIC_ACQUIRE, "agent");
            asm volatile("s_waitcnt vmcnt(0)" ::: "memory");
        }
    }
    __syncthreads();
}

DI void moe_table(const P& p, int l, PG8_LAS int* tab) {
    const int tid_ = ltid();
    if (tid_ < 64) { const int cnt = tid_ < 32 ? p.counts[(l * 32 + tid_) * 32] : 0; const int nt = (cnt + 255) >> 8; int pt = nt, pc = cnt;
#pragma unroll
        for (int o = 1; o < 32; o <<= 1) { const int ln_ = tid_ & 63, src = ln_ >= o ? ln_ - o : ln_; const int a = shli(pt, src), b = shli(pc, src); if (ln_ >= o) { pt += a; pc += b; } }
        if (tid_ < 32) { tab[tid_ + 1] = pt; tab[33 + tid_] = cnt; tab[65 + tid_] = pc - cnt; if (tid_ == 0) tab[0] = 0; } }
    __syncthreads();
}
typedef const __attribute__((address_space(4))) P* PK;
DI PK lp(PK q) { asm volatile("" : "+s"(q)); return q; }
#define PHASE(...) do { const P p = *(const P*)lp(pk); __VA_ARGS__; } while (0)

template <int l> DI void layer(PK pk, unsigned char* smem, const XcdBarrier& xbar) {
    float* ldsf = (float*)smem; const int gw = 0, NW = 0, lane = 0;
    {
        constexpr int NG = l == 0 ? 234 : 204;
        constexpr int CV1 = l == 0 ? 10 * 768 : NE * 768;
        const int G = (int)gridDim.x == 256 ? NG : (int)gridDim.x;
        if ((int)blockIdx.x < G) PHASE({ pg8::Gemm g{p.H, p.WinT + (size_t)l * NPAD_IN * D, T, NPAD_IN, D}; pg8::StaticOrder S; S.init(T, NPAD_IN, G, (int)blockIdx.x);
            pg8::EpiProj E{p.PROJ, LDP, INDIM};
            pg8::gemm_phase<pg8::EpiProj, pg8::StaticOrder>((PG8_LAS unsigned char*)smem, g, S, E, nullptr); });
        else PHASE(ph_convert_experts(p, l, ldsf, G, (int)gridDim.x - G, 0, CV1));
        if ((int)gridDim.x != 256) PHASE(ph_convert_experts(p, l, ldsf, 0, (int)gridDim.x, 0, CV1));
    }
    xcd_barrier(xbar);
    PHASE(ph_prep(p, l, (LDSP unsigned char*)smem));
    xcd_barrier(xbar);
    PHASE(ph_s1(p, l, (LDSP unsigned char*)smem));
    xcd_barrier(xbar);
    PHASE(ph_s2(p));
    xcd_barrier(xbar);
    PHASE(ph_s3(p, l, (LDSP unsigned char*)smem));
    xcd_barrier(xbar);
    {
        constexpr int ro = l == 0 ? 0 : TC;
        constexpr int NG = l == 0 ? 182 : 256;
        const int G = (int)gridDim.x == 256 ? NG : (int)gridDim.x;
        if ((int)blockIdx.x < G) PHASE({ pg8::Gemm g{p.H + (size_t)ro * D, p.WoutT + (size_t)l * D * D, T - ro, D, D}; pg8::StaticOrder S; S.init(T - ro, D, G, (int)blockIdx.x);
            pg8::EpiResGate<l != 0> E{p.SSQ, p.ctx, p.x, p.XB, p.MOD + (size_t)l * 9 * 6144 + 2 * 1024, p.XSS, ro};
            pg8::gemm_phase<pg8::EpiResGate<l != 0>, pg8::StaticOrder>((PG8_LAS unsigned char*)smem, g, S, E, nullptr); });
        else if (l == 0) PHASE(ph_convert_experts(p, l, ldsf, G, (int)gridDim.x - G, 10 * 768, NE * 768));
        if (l == 0 && (int)gridDim.x != 256) PHASE(ph_convert_experts(p, l, ldsf, 0, (int)gridDim.x, 10 * 768, NE * 768));
    }
    xcd_barrier(xbar);
    const int t0 = l == 0 ? 0 : TC;
    PHASE(ph_normroute(p, l, t0, (LDSP unsigned char*)smem));
    xcd_barrier(xbar);
    PG8_LAS int* tab = (PG8_LAS int*)((PG8_LAS unsigned char*)smem + pg8::STAGE_BYTES);
#pragma unroll
    for (int ph = 0; ph < 2; ++ph) {
        PHASE(moe_table(p, l, tab));
        const int U = __builtin_amdgcn_readfirstlane(tab[32]) * 4;
        if (ph == 0) PHASE({ pg8::Gemm g{p.H, p.WguT, T, D, D}; pg8::MoeSched S{tab, p.MAP, U, (int)gridDim.x, (int)blockIdx.x, 4, 1, (size_t)D * D * 2};
            pg8::EpiAct E{p.SS}; pg8::gemm_phase_moe<pg8::EpiAct, pg8::MoeSched>((PG8_LAS unsigned char*)smem, g, S, E, nullptr); });
        else PHASE({ pg8::Gemm g{p.SS, p.WdT, T, D, 512}; pg8::MoeSched S{tab, p.MAP, U, (int)gridDim.x, (int)blockIdx.x, 4, 0, (size_t)D * 512 * 2};
            pg8::EpiY E{(unsigned char*)p.PROJ}; pg8::gemm_phase_moe<pg8::EpiY, pg8::MoeSched>((PG8_LAS unsigned char*)smem, g, S, E, nullptr); });
        xcd_barrier(xbar);
    }
    PHASE(ph_combine(p, l, t0, (const unsigned char*)p.PROJ, (LDSP int*)smem));
    xcd_barrier(xbar);
}

__global__ void __launch_bounds__(NTHR) mega(P p_arg) {
    extern __shared__ __attribute__((aligned(16))) unsigned char smem[];
    cg::grid_group grid = cg::this_grid();
    PK pk = (PK)__builtin_amdgcn_kernarg_segment_ptr();
    const int lane = 0, gw = 0, NW = 0;
    float* ldsf = (float*)smem;
    volatile XLAS unsigned* bst = (volatile XLAS unsigned*)((XLAS unsigned char*)smem + LDS_BYTES - 16);
    { const int t_ = ltid(); if (t_ < 2) bst[t_] = 0u; }
    __syncthreads();
    const XcdBarrier xbar = xcd_barrier_post(pk->BAR, bst);
    PHASE(ph_init(p)); PHASE(ph_mod(p, ldsf)); PHASE(ph_convert_small(p, ldsf, gw, NW, lane));
    grid.sync();
    PHASE(ph_normmod1(p, 0, gw, NW, lane));
    xcd_barrier(xbar);
    layer<0>(pk, smem, xbar);
    layer<1>(pk, smem, xbar);
}

static inline size_t al(size_t x) { return (x + 255) & ~(size_t)255; }

extern "C" void kernel_launch(void* const* d_in, const int* in_sizes, int n_in, void* d_out, int out_size, void* d_ws, size_t ws_size, hipStream_t stream) {
    static int grid_blocks = 0;
    if (grid_blocks == 0) {
        int dev = 0, cus = 0, per_cu = 0;
        if (hipFuncSetAttribute((const void*)mega, hipFuncAttributeMaxDynamicSharedMemorySize, LDS_BYTES) != hipSuccess) { fprintf(stderr, "hipFuncSetAttribute failed\n"); grid_blocks = -1; return; }
        (void)hipGetDevice(&dev); (void)hipDeviceGetAttribute(&cus, hipDeviceAttributeMultiprocessorCount, dev);
        if (hipOccupancyMaxActiveBlocksPerMultiprocessor(&per_cu, (const void*)mega, NTHR, LDS_BYTES) != hipSuccess || per_cu < 1) { fprintf(stderr, "occupancy query: %d blocks/CU\n", per_cu); grid_blocks = -1; return; }
        grid_blocks = cus;
    }
    if (grid_blocks < 0) return;
    P p{};
    const float** pin = (const float**)&p;
    for (int i = 0; i < 29; ++i) pin[i] = (const float*)d_in[i];
    p.out = (float*)d_out;
    char* ws = (char*)d_ws; size_t off = 0;
    auto take = [&](size_t bytes) { char* q = ws + off; off += al(bytes); return q; };
    p.XB = (bf16_t*)take((size_t)T * D * 2);
    p.H = (bf16_t*)take((size_t)T * D * 2);
    p.PROJ = (bf16_t*)take((size_t)T * LDP * 2);
    p.SS = (bf16_t*)take((size_t)NTILE * 8 * 2 * 4096 * 2);
    p.GS = (bf16_t*)take((size_t)NTILE * 4 * 2 * 8192 * 2);
    p.SDEC = (float*)take((size_t)NTILE * 8 * 2 * 4);
    p.GDEC = (float*)take((size_t)NTILE * 4 * 2 * 64 * 4);
    p.MOD = (float*)take((size_t)2 * 9 * 6144 * 4);
    p.counts = (int*)take(64 * 32 * 4);
    p.TOKSLOT = (int*)take((size_t)T * 4 * 4);
    p.EW = (float*)take((size_t)T * 2 * 4);
    p.MAP = (int*)take((size_t)NE * T * 4);
    p.WinT = (bf16_t*)take((size_t)2 * NPAD_IN * D * 2);
    p.WoutT = (bf16_t*)take((size_t)2 * D * D * 2);
    p.WguT = (bf16_t*)take((size_t)NE * D * D * 2);
    p.WdT = (bf16_t*)take((size_t)NE * D * 512 * 2);
    p.WRT = (bf16_t*)take((size_t)32 * 1024 * 2);
    p.BAR = (unsigned*)take(XCD_BAR_WORDS * 4);
    p.XBCC = (bf16_t*)d_out;
    p.QKB = (bf16_t*)d_out + (size_t)T * 768;
    p.SSC = (float*)take((size_t)T * 8 * 4 * 4);
    p.STOT = (float*)take((size_t)NTILE * 8 * 2 * 4);
    p.SSQ = (float*)take((size_t)T * 8 * 4);
    p.XSS = (float*)take((size_t)T * 16 * 4);
    if (off > ws_size) { fprintf(stderr, "workspace too small: need %zu have %zu\n", off, ws_size); return; }
    if (hipMemsetAsync(p.BAR, 0, XCD_BAR_WORDS * 4, stream) != hipSuccess) { fprintf(stderr, "memset of barrier words failed\n"); return; }
    void* args[] = {&p};
    hipError_t e = hipLaunchCooperativeKernel((void*)mega, dim3(grid_blocks), dim3(NTHR), args, LDS_BYTES, stream);
    if (e != hipSuccess) fprintf(stderr, "cooperative launch failed: %s (grid %d)\n", hipGetErrorString(e), grid_blocks);
}
```

```cpp
#include <hip/hip_runtime.h>
#include <hip/hip_cooperative_groups.h>
#include <stdint.h>
#include <cstdio>
namespace cg = cooperative_groups;

typedef unsigned short bf16_t;
#define DI __device__ __forceinline__

constexpr int D = 1024, NB = 8, SEQ = 4096, CTXL = 256, TC = NB * CTXL, TL = NB * SEQ, T = TC + TL;
constexpr int INDIM = 2840, LDP = 2848;
constexpr int OFF_Z = 0, OFF_XBC = 512, OFF_DT = 1280, OFF_Q = 1288, OFF_K = 1544, OFF_V = 1800, OFF_GO = 2312, OFF_GK = 2824;
constexpr int NE = 32;

DI float bf2f(bf16_t v) { return __uint_as_float(((unsigned)v) << 16); }
typedef float f32x2v_ __attribute__((ext_vector_type(2)));
typedef __bf16 bf16x2v_ __attribute__((ext_vector_type(2)));
DI bf16_t f2bf(float f) { return __builtin_bit_cast(unsigned short, (__bf16)f); }
DI float siluf(float x) { return x * __builtin_amdgcn_rcpf(1.0f + __builtin_amdgcn_exp2f(-1.4426950408889634f * x)); }
DI float softplusf(float x) { return fmaxf(x, 0.f) + log1pf(__expf(-fabsf(x))); }
DI float logsigmoidf(float x) { return -softplusf(-x); }
DI float shx(float v, int o, int lane) { return __int_as_float(__builtin_amdgcn_ds_bpermute((lane ^ o) << 2, __float_as_int(v))); }
DI int shxi(int v, int o, int lane) { return __builtin_amdgcn_ds_bpermute((lane ^ o) << 2, v); }
DI float shl(float v, int src) { return __int_as_float(__builtin_amdgcn_ds_bpermute(src << 2, __float_as_int(v))); }
DI int shli(int v, int src) { return __builtin_amdgcn_ds_bpermute(src << 2, v); }
DI float wave_sum(float v, int lane) {
#pragma unroll
    for (int o = 32; o >= 1; o >>= 1) v += shx(v, o, lane);
    return v;
}
DI int ltid() { const int wv = __builtin_amdgcn_readfirstlane(threadIdx.x >> 6);
    int t = wv * 64 + (int)__builtin_amdgcn_mbcnt_hi(~0u, __builtin_amdgcn_mbcnt_lo(~0u, 0u)); asm volatile("" : "+v"(t)); return t; }
DI int tok_modrow(int t) { return t < TC ? 8 : ((t - TC) >> 12); }
template <class PT> DI bf16_t* xrow(const PT& p, int t) { return p.XB + (size_t)t * D; }


#ifndef PG8_SP2
#define PG8_SP2 true
#endif
namespace pg8 {
#define PG8_LAS __attribute__((address_space(3)))
typedef unsigned short bf16_t;
typedef short bf16x8 __attribute__((ext_vector_type(8)));
typedef float f32x4 __attribute__((ext_vector_type(4)));
typedef unsigned u32x4 __attribute__((ext_vector_type(4)));
constexpr int BM = 256, BK = 64, HALF = 128, HTB = HALF * BK * 2  , STAGE_BYTES = 8 * HTB, NXCD = 8, WGM = 8;

__host__ __device__ __forceinline__ int lds_byte(int r, int c) { const int st = (r >> 4) * 2 + (c >> 5), rr = r & 15, cc = c & 31, ob = rr * 64 + cc * 2; return st * 1024 + (ob ^ (((ob >> 9) & 1) << 5)); }
__host__ __device__ __forceinline__ void stage_rc(int b, int& R, int& C) { const int st = b / 1024, sb = b % 1024, swz = sb ^ (((sb >> 9) & 1) << 5); R = (st >> 1) * 16 + swz / 64; C = (st & 1) * 32 + (swz % 64) / 2; }
__host__ __device__ __forceinline__ int perm32(int rho) { const int n = rho >> 4, i = rho & 15; return 8 * (i >> 2) + 4 * n + (i & 3); }

struct Unit { int pm, pn; };
struct Gemm { const bf16_t* A; const bf16_t* Bt; int M, N, K; };

struct StaticOrder {
    int nM, nN, nwg, G, c;
    __host__ __device__ void init(int M, int N, int G_, int c_) { nM = M / BM; nN = N / BM; nwg = nM * nN; G = G_; c = c_; }
    __host__ __device__ bool next(int i, Unit& u) const {
        const long L = (long)i * G + c; if (L >= nwg) return false;
        int wgid = (int)L; { const int q = nwg / NXCD, r = nwg % NXCD, xcd = wgid % NXCD, off = wgid / NXCD; wgid = (xcd < r ? xcd * (q + 1) : r * (q + 1) + (xcd - r) * q) + off; }
        const int nig = WGM * nN, gid = wgid / nig, fm = gid * WGM, gsz = (nM - fm) < WGM ? (nM - fm) : WGM;
        u.pm = fm + ((wgid % nig) % gsz); u.pn = (wgid % nig) / gsz; return true;
    }
    __device__ __forceinline__ void a_ready(const Unit&) const {}
    __device__ __forceinline__ void done(const Unit&) const {}
};
__device__ __forceinline__ unsigned cvt_pk_bf16(float lo, float hi) { unsigned r; asm volatile("v_cvt_pk_bf16_f32 %0, %1, %2" : "=v"(r) : "v"(lo), "v"(hi)); return r; }
typedef float f32x2 __attribute__((ext_vector_type(2)));

struct EpiProj {
    static constexpr bool PERM = true, AFTER_DRAIN = false, MIDK = false;
    bf16_t* O; int ldc; int ncols;
    __device__ __forceinline__ void operator()(const f32x4 (&acc)[2][2][4][2], const Unit& u, int wr, int wc, int fr, int fq) const {
        const int row0 = u.pm * BM + wr * 64 + fr, col0 = u.pn * BM + wc * 32 + 8 * fq;
#pragma unroll
        for (int ai = 0; ai < 2; ++ai)
#pragma unroll
            for (int m = 0; m < 4; ++m) { bf16_t* rowp = O + (size_t)(row0 + ai * HALF + m * 16) * ldc + col0;
#pragma unroll
                for (int bj = 0; bj < 2; ++bj) { const f32x4 v0 = acc[ai][bj][m][0], v1 = acc[ai][bj][m][1];
                    u32x4 w; w.x = cvt_pk_bf16(v0[0], v0[1]); w.y = cvt_pk_bf16(v0[2], v0[3]); w.z = cvt_pk_bf16(v1[0], v1[1]); w.w = cvt_pk_bf16(v1[2], v1[3]);
                    if (col0 + bj * HALF + 8 <= ncols) *(u32x4*)(rowp + bj * HALF) = w; } }
    }
};
template <bool SRC_BF16> struct EpiResGate {
    static constexpr bool PERM = true, AFTER_DRAIN = false, MIDK = true;
    const float* ssq;
    const float* Sc; const float* Sl;
    bf16_t* XB;
    const float* gate_rows; float* xss; int rowoff;
    template <class Sched> __device__ __forceinline__ void prep(PG8_LAS unsigned char* lds, const Sched& S, int tid) const {
        PG8_LAS float* RS = (PG8_LAS float*)(lds + STAGE_BYTES);
        const int r = tid & 255, i0 = tid >> 8;
        for (int i = i0; ; i += 2) { Unit u; if (!S.next(i, u)) break;
            const f32x4* q = (const f32x4*)(ssq + (size_t)(rowoff + u.pm * BM + r) * 8); const f32x4 a = q[0], b = q[1];
            RS[i * 256 + r] = __builtin_amdgcn_rsqf((((a[0] + a[1]) + (a[2] + a[3])) + ((b[0] + b[1]) + (b[2] + b[3]))) * (1.0f / 512.0f) + 1e-6f); }
    }
    __device__ __forceinline__ void midk(f32x4 (&acc)[2][2][4][2], PG8_LAS unsigned char* lds, int ui, int wr, int fr) const {
        int fr_ = fr; asm volatile("" : "+v"(fr_));
        PG8_LAS const float* RS = (PG8_LAS const float*)(lds + STAGE_BYTES) + ui * 256 + wr * 64 + fr_;
#pragma unroll
        for (int ai = 0; ai < 2; ++ai)
#pragma unroll
            for (int m = 0; m < 4; ++m) { const float rs = RS[ai * HALF + m * 16];
#pragma unroll
                for (int bj = 0; bj < 2; ++bj)
#pragma unroll
                    for (int n = 0; n < 2; ++n) acc[ai][bj][m][n] *= rs; }
    }
    __device__ __forceinline__ void operator()(const f32x4 (&acc)[2][2][4][2], const Unit& u, int wr, int wc, int fr, int fq) const {
        const int row0 = rowoff + u.pm * BM + wr * 64 + fr, col0 = u.pn * BM + wc * 32 + 8 * fq;
        const int t0 = rowoff + u.pm * BM; const int mrow = t0 < 2048 ? 8 : ((t0 - 2048) >> 12);
        const float* gr = gate_rows + (size_t)mrow * 6144 + col0;
        f32x4 gv[2][2];
#pragma unroll
        for (int bj = 0; bj < 2; ++bj)
#pragma unroll
            for (int n = 0; n < 2; ++n) gv[bj][n] = *(const f32x4*)(gr + bj * HALF + n * 4);
#pragma unroll
        for (int ai = 0; ai < 2; ++ai) {
            u32x4 rb[4][2]; f32x4 xf[SRC_BF16 ? 1 : 4][2][2];
#pragma unroll
            for (int m = 0; m < 4; ++m) { const int rr = row0 + ai * HALF + m * 16;
                const float* sp = (rr < 2048 ? Sc + (size_t)rr * 1024 : Sl + (size_t)(rr - 2048) * 1024) + col0; const bf16_t* dp = XB + (size_t)rr * 1024 + col0;
#pragma unroll
                for (int bj = 0; bj < 2; ++bj) {
                    if (SRC_BF16) rb[m][bj] = *(const u32x4*)(dp + bj * HALF);
                    else { xf[SRC_BF16 ? 0 : m][bj][0] = *(const f32x4*)(sp + bj * HALF); xf[SRC_BF16 ? 0 : m][bj][1] = *(const f32x4*)(sp + bj * HALF + 4); } } }
#pragma unroll
            for (int m = 0; m < 4; ++m) { const int rr = row0 + ai * HALF + m * 16;
                bf16_t* dp = XB + (size_t)rr * 1024 + col0; float ss = 0.f;
#pragma unroll
                for (int bj = 0; bj < 2; ++bj) { f32x4 x0, x1;
                    if (SRC_BF16) { const u32x4 r = rb[m][bj];
                        x0 = (f32x4){__uint_as_float(r.x << 16), __uint_as_float(r.x & 0xffff0000u), __uint_as_float(r.y << 16), __uint_as_float(r.y & 0xffff0000u)};
                        x1 = (f32x4){__uint_as_float(r.z << 16), __uint_as_float(r.z & 0xffff0000u), __uint_as_float(r.w << 16), __uint_as_float(r.w & 0xffff0000u)}; }
                    else { x0 = xf[SRC_BF16 ? 0 : m][bj][0]; x1 = xf[SRC_BF16 ? 0 : m][bj][1]; }
                    const f32x4 v0 = x0 + gv[bj][0] * acc[ai][bj][m][0], v1 = x1 + gv[bj][1] * acc[ai][bj][m][1];
                    u32x4 w; w.x = cvt_pk_bf16(v0[0], v0[1]); w.y = cvt_pk_bf16(v0[2], v0[3]); w.z = cvt_pk_bf16(v1[0], v1[1]); w.w = cvt_pk_bf16(v1[2], v1[3]);
                    *(u32x4*)(dp + bj * HALF) = w;
#pragma unroll
                    for (int j = 0; j < 4; ++j) { const float lo = __uint_as_float(w[j] << 16), hi = __uint_as_float(w[j] & 0xffff0000u); ss += lo * lo + hi * hi; } }
                { const int ln_ = fq * 16 + fr; ss += __int_as_float(__builtin_amdgcn_ds_bpermute((ln_ ^ 16) << 2, __float_as_int(ss))); ss += __int_as_float(__builtin_amdgcn_ds_bpermute((ln_ ^ 32) << 2, __float_as_int(ss))); }
                if (fq == 0) xss[(size_t)rr * 16 + u.pn * 4 + wc] = ss; }
        }
    }
};
template <class Epi, class Sched, bool STAMP = false, bool SP2 = PG8_SP2>
__device__ __forceinline__ void gemm_phase(PG8_LAS unsigned char* lds, const Gemm g, const Sched& S, const Epi& E, unsigned long long* stamps) {
    int tid_l = __builtin_amdgcn_readfirstlane(threadIdx.x >> 6) * 64 + (int)__builtin_amdgcn_mbcnt_hi(~0u, __builtin_amdgcn_mbcnt_lo(~0u, 0u)); asm volatile("" : "+v"(tid_l));
    const int tid = tid_l, wid = __builtin_amdgcn_readfirstlane(tid >> 6), lane = tid & 63, wr = wid >> 2, wc = wid & 3, fr = lane & 15, fq = lane >> 4;
    const int K = g.K, nt = K / BK;
    int ts_lo = 0, ts_hi = 0, nts = 0; const unsigned long long rt_entry = STAMP ? (unsigned long long)wall_clock64() : 0ull;
#define PG8_STAMP() do { if (STAMP && wid == 0 && nts < 64) { const unsigned long long _c = (unsigned long long)clock64(); \
        ts_lo = (lane == nts) ? (int)(unsigned)_c : ts_lo; ts_hi = (lane == nts) ? (int)(unsigned)(_c >> 32) : ts_hi; ++nts; } } while (0)
    PG8_STAMP();
    unsigned voffA[2], voffB[2];
#pragma unroll
    for (int i = 0; i < 2; ++i) { int R, C; stage_rc(tid * 16 + i * 8192, R, C); const int Rb = Epi::PERM ? ((R & ~31) + perm32(R & 31)) : R;
        voffA[i] = (unsigned)(R * K + C) * 2u; voffB[i] = (unsigned)(Rb * K + C) * 2u; }
    const size_t kstep = (size_t)(BK * 2);
    const size_t hstep = (size_t)HALF * K * 2;
    const size_t tstep = 2 * hstep;
    const unsigned ldsw = (unsigned)wid * 1024u;
    const int aoff = lds_byte(wr * 64 + fr, fq * 8), boff = lds_byte(wc * 32 + fr, fq * 8);
#define PG8_SA(b, h) (((b) * 2 + (h)) * HTB)
#define PG8_SB(b, h) ((4 + (b) * 2 + (h)) * HTB)
#define PG8_STAGE(bufoff, gbase, voff) do { _Pragma("unroll") for (int _i = 0; _i < 2; ++_i) \
        __builtin_amdgcn_global_load_lds((const unsigned*)((const char*)(gbase) + (voff)[_i]), (PG8_LAS unsigned*)(lds + (bufoff) + ldsw + _i * 8192), 16, 0, 0); } while (0)
#define PG8_LDA(dst, b, h) do { _Pragma("unroll") for (int m = 0; m < 4; ++m) _Pragma("unroll") for (int k = 0; k < 2; ++k) dst[m][k] = *(const PG8_LAS bf16x8*)(lds + PG8_SA(b, h) + aoff + m * 2048 + k * 1024); } while (0)
#define PG8_LDB(dst, b, h) do { _Pragma("unroll") for (int n = 0; n < 2; ++n) _Pragma("unroll") for (int k = 0; k < 2; ++k) dst[n][k] = *(const PG8_LAS bf16x8*)(lds + PG8_SB(b, h) + boff + n * 2048 + k * 1024); } while (0)
#define PG8_MMA(ai, bj, At, Bt) do { __builtin_amdgcn_s_setprio(1); _Pragma("unroll") for (int m = 0; m < 4; ++m) _Pragma("unroll") for (int n = 0; n < 2; ++n) _Pragma("unroll") for (int k = 0; k < 2; ++k) \
        acc[ai][bj][m][n] = __builtin_amdgcn_mfma_f32_16x16x32_bf16(Bt[n][k], At[m][k], acc[ai][bj][m][n], 0, 0, 0); __builtin_amdgcn_s_setprio(0); } while (0)
#define PG8_WAIT_V(n) asm volatile("s_waitcnt vmcnt(" #n ")" ::: "memory")
#define PG8_WAIT_L(n) asm volatile("s_waitcnt lgkmcnt(" #n ")" ::: "memory")
#define PG8_BAR __builtin_amdgcn_s_barrier()
#define PG8_SCHED __builtin_amdgcn_sched_barrier(0)
    Unit cur, nxt; int ui = 0;
    if (!S.next(0, cur)) return;
    f32x4 acc[2][2][4][2];
#pragma unroll
    for (int a = 0; a < 2; ++a)
#pragma unroll
        for (int b = 0; b < 2; ++b)
#pragma unroll
            for (int m = 0; m < 4; ++m)
#pragma unroll
                for (int n = 0; n < 2; ++n) acc[a][b][m][n] = (f32x4){0.f, 0.f, 0.f, 0.f};
    bf16x8 At[4][2], B0[2][2], B1[2][2];
    const char* cA = (const char*)g.A + (size_t)cur.pm * tstep; const char* cB = (const char*)g.Bt + (size_t)cur.pn * tstep;
    S.a_ready(cur);
    if constexpr (Epi::MIDK) E.prep(lds, S, tid);
    if constexpr (SP2) {
        PG8_STAGE(PG8_SB(0, 0), cB, voffB); PG8_STAGE(PG8_SB(0, 1), cB + hstep, voffB); PG8_STAGE(PG8_SA(0, 0), cA, voffA); PG8_STAGE(PG8_SA(0, 1), cA + hstep, voffA);
        if (wr == 1) PG8_BAR;
        PG8_WAIT_V(2); PG8_BAR;
        PG8_STAGE(PG8_SB(1, 0), cB + kstep, voffB); PG8_STAGE(PG8_SA(1, 0), cA + kstep, voffA); PG8_STAGE(PG8_SB(1, 1), cB + hstep + kstep, voffB);
        PG8_WAIT_V(6); PG8_BAR;
    } else {
    PG8_STAGE(PG8_SB(0, 0), cB, voffB); PG8_STAGE(PG8_SA(0, 0), cA, voffA); PG8_STAGE(PG8_SB(0, 1), cB + hstep, voffB); PG8_STAGE(PG8_SA(0, 1), cA + hstep, voffA);
    if (wr == 1) PG8_BAR;
    PG8_WAIT_V(4); PG8_BAR;
    PG8_STAGE(PG8_SB(1, 0), cB + kstep, voffB); PG8_STAGE(PG8_SA(1, 0), cA + kstep, voffA); PG8_STAGE(PG8_SB(1, 1), cB + hstep + kstep, voffB);
    PG8_WAIT_V(6); PG8_BAR;
    }
    PG8_STAMP();
    for (;;) {
        const bool has_next = S.next(ui + 1, nxt);
        const char* nA = has_next ? (const char*)g.A + (size_t)nxt.pm * tstep : cA; const char* nB = has_next ? (const char*)g.Bt + (size_t)nxt.pn * tstep : cB;
        for (int t = 0; t < nt; t += 2) {
            const bool last = (t == nt - 2);
            const char* a1 = cA + (size_t)(t + 1) * kstep;
            const char* a2 = last ? nA : cA + (size_t)(t + 2) * kstep; const char* b2 = last ? nB : cB + (size_t)(t + 2) * kstep;
            const char* a3 = a2 + kstep; const char* b3 = b2 + kstep;
            if (last && has_next) S.a_ready(nxt);
            if constexpr (SP2) {
            PG8_LDB(B0, 0, 0); PG8_LDB(B1, 0, 1); PG8_SCHED; PG8_LDA(At, 0, 0); PG8_STAGE(PG8_SA(1, 1), a1 + hstep, voffA);
            PG8_WAIT_V(8); PG8_WAIT_L(0); PG8_BAR; PG8_MMA(0, 0, At, B0); PG8_MMA(0, 1, At, B1); PG8_BAR; PG8_SCHED;
            PG8_LDA(At, 0, 1); PG8_STAGE(PG8_SB(0, 0), b2, voffB); PG8_STAGE(PG8_SB(0, 1), b2 + hstep, voffB); PG8_STAGE(PG8_SA(0, 0), a2, voffA);
            PG8_WAIT_V(8); PG8_WAIT_L(0); PG8_BAR; PG8_MMA(1, 0, At, B0); PG8_MMA(1, 1, At, B1); PG8_BAR; PG8_SCHED;
            PG8_LDB(B0, 1, 0); PG8_LDB(B1, 1, 1); PG8_SCHED; PG8_LDA(At, 1, 0); PG8_STAGE(PG8_SA(0, 1), a2 + hstep, voffA);
            PG8_WAIT_V(8); PG8_WAIT_L(0); PG8_BAR; PG8_MMA(0, 0, At, B0); PG8_MMA(0, 1, At, B1); PG8_BAR; PG8_SCHED;
            PG8_LDA(At, 1, 1); PG8_STAGE(PG8_SB(1, 0), b3, voffB); PG8_STAGE(PG8_SB(1, 1), b3 + hstep, voffB); PG8_STAGE(PG8_SA(1, 0), a3, voffA);
            PG8_WAIT_V(8); PG8_WAIT_L(0); PG8_BAR; PG8_MMA(1, 0, At, B0); PG8_MMA(1, 1, At, B1); PG8_BAR; PG8_SCHED;
            } else {
            PG8_LDB(B0, 0, 0); PG8_SCHED; PG8_LDA(At, 0, 0); PG8_STAGE(PG8_SA(1, 1), a1 + hstep, voffA);
            PG8_WAIT_L(8); PG8_BAR; PG8_WAIT_L(0); PG8_MMA(0, 0, At, B0); PG8_BAR; PG8_SCHED;
            PG8_LDB(B1, 0, 1); PG8_STAGE(PG8_SB(0, 0), b2, voffB);
            PG8_BAR; PG8_WAIT_L(0); PG8_MMA(0, 1, At, B1); PG8_BAR;
            PG8_LDA(At, 0, 1); PG8_STAGE(PG8_SA(0, 0), a2, voffA);
            PG8_BAR; PG8_WAIT_L(0); PG8_MMA(1, 0, At, B0); PG8_BAR; PG8_SCHED;
            PG8_STAGE(PG8_SB(0, 1), b2 + hstep, voffB);
            PG8_WAIT_V(6); PG8_BAR; PG8_MMA(1, 1, At, B1); PG8_BAR;
            PG8_LDB(B0, 1, 0); PG8_SCHED; PG8_LDA(At, 1, 0); PG8_STAGE(PG8_SA(0, 1), a2 + hstep, voffA);
            PG8_WAIT_L(8); PG8_BAR; PG8_WAIT_L(0); PG8_MMA(0, 0, At, B0); PG8_BAR; PG8_SCHED;
            PG8_LDB(B1, 1, 1); PG8_STAGE(PG8_SB(1, 0), b3, voffB);
            PG8_BAR; PG8_WAIT_L(0); PG8_MMA(0, 1, At, B1); PG8_BAR;
            PG8_LDA(At, 1, 1); PG8_STAGE(PG8_SA(1, 0), a3, voffA);
            PG8_BAR; PG8_WAIT_L(0); PG8_MMA(1, 0, At, B0); PG8_BAR; PG8_SCHED;
            PG8_STAGE(PG8_SB(1, 1), b3 + hstep, voffB);
            PG8_WAIT_V(6); PG8_BAR; PG8_MMA(1, 1, At, B1); PG8_BAR;
            }
            if constexpr (Epi::MIDK) { if (t + 2 == nt / 2) E.midk(acc, lds, ui, wr, fr); }
        }
        PG8_STAMP();
        if (wr == 0) PG8_BAR;
        if constexpr (!Epi::AFTER_DRAIN) { E(acc, cur, wr, wc, fr, fq); S.done(cur); }
        PG8_STAMP();
        if (!has_next) break;
#pragma unroll
        for (int a = 0; a < 2; ++a)
#pragma unroll
            for (int b = 0; b < 2; ++b)
#pragma unroll
                for (int m = 0; m < 4; ++m)
#pragma unroll
                    for (int n = 0; n < 2; ++n) acc[a][b][m][n] = (f32x4){0.f, 0.f, 0.f, 0.f};
        cur = nxt; cA = nA; cB = nB; ++ui;
        if (wr == 1) PG8_BAR;
    }
    PG8_WAIT_V(0);
    PG8_BAR;
    if constexpr (Epi::AFTER_DRAIN) { E.fused(acc, cur, wr, wc, fr, fq, lds, wid, lane); S.done(cur); }
    PG8_STAMP();
    if (STAMP && wid == 0) { stamps[lane] = lane < nts ? (((unsigned long long)(unsigned)ts_hi << 32) | (unsigned)ts_lo) : 0ull;
        if (lane == 62) stamps[62] = rt_entry; if (lane == 63) stamps[63] = (unsigned long long)wall_clock64(); }
#undef PG8_STAMP
#undef PG8_SA
#undef PG8_SB
#undef PG8_STAGE
#undef PG8_LDA
#undef PG8_LDB
#undef PG8_MMA
#undef PG8_WAIT_V
#undef PG8_WAIT_L
#undef PG8_BAR
#undef PG8_SCHED
}

struct MoeUnit { int e, mt, pn, cnt, pstart; };
struct MoeSched {
    typedef MoeUnit UnitT;
    PG8_LAS const int* tab; const int* map; int U, G, c, npn, gather; size_t bstride;
    __device__ __forceinline__ bool next(int i, MoeUnit& u) const {
        const long L = (long)i * G + c; if (L >= U) return false;
        int idx = (int)L; { const int q = U / NXCD, r = U % NXCD, xcd = idx % NXCD, off = idx / NXCD; idx = (xcd < r ? xcd * (q + 1) : r * (q + 1) + (xcd - r) * q) + off; }
        const int tau = idx / npn; u.pn = idx - tau * npn;
        int e = 0;
#pragma unroll
        for (int st = 16; st >= 1; st >>= 1) { if (__builtin_amdgcn_readfirstlane(tab[e + st]) <= tau) e += st; }
        u.e = e; u.mt = tau - __builtin_amdgcn_readfirstlane(tab[e]); u.cnt = __builtin_amdgcn_readfirstlane(tab[33 + e]); u.pstart = __builtin_amdgcn_readfirstlane(tab[65 + e]);
        return true;
    }
    __device__ __forceinline__ const char* bbase(const Gemm& g, const MoeUnit& u) const { return (const char*)g.Bt + (size_t)u.e * bstride + (size_t)u.pn * BM * g.K * 2; }
    __device__ __forceinline__ void a_offsets(const Gemm& g, const MoeUnit& u, int tid, unsigned (&va)[2][2]) const {
        int tl = tid; asm volatile("" : "+v"(tl));
        int RA[2], CA[2];
#pragma unroll
        for (int i = 0; i < 2; ++i) { int R, C; stage_rc(tl * 16 + i * 8192, R, C); RA[i] = R; CA[i] = C * 2; }
#pragma unroll
        for (int hf = 0; hf < 2; ++hf)
#pragma unroll
            for (int i = 0; i < 2; ++i) { int rl = u.mt * BM + hf * HALF + RA[i]; rl = rl < u.cnt ? rl : u.cnt - 1;
                const unsigned row = gather ? (unsigned)map[(size_t)u.e * 34816 + rl] : (unsigned)(u.pstart + rl);
                va[hf][i] = row * (unsigned)(g.K * 2) + (unsigned)CA[i]; }
    }
};
struct EpiAct {
    static constexpr bool PERM = true, AFTER_DRAIN = false;
    bf16_t* O;
    __device__ __forceinline__ void operator()(const f32x4 (&acc)[2][2][4][2], const MoeUnit& u, int wr, int wc, int fr, int fq) const {
        const int rl0 = u.mt * BM + wr * 64 + fr, col0 = u.pn * HALF + wc * 32 + 8 * fq;
#pragma unroll
        for (int ai = 0; ai < 2; ++ai)
#pragma unroll
            for (int m = 0; m < 4; ++m) { const int rl = rl0 + ai * HALF + m * 16;
                if (rl < u.cnt) { float o[8];
#pragma unroll
                    for (int n = 0; n < 2; ++n)
#pragma unroll
                        for (int j = 0; j < 4; ++j) { const float gv = acc[ai][0][m][n][j]; o[4 * n + j] = gv * __builtin_amdgcn_rcpf(1.0f + __builtin_amdgcn_exp2f(-1.4426950408889634f * gv)) * acc[ai][1][m][n][j]; }
                    u32x4 w; w.x = cvt_pk_bf16(o[0], o[1]); w.y = cvt_pk_bf16(o[2], o[3]); w.z = cvt_pk_bf16(o[4], o[5]); w.w = cvt_pk_bf16(o[6], o[7]);
                    *(u32x4*)(O + (size_t)(u.pstart + rl) * 512 + col0) = w; } }
    }
};
struct EpiY {
    static constexpr bool PERM = true, AFTER_DRAIN = false;
    unsigned char* O;
    static __device__ __forceinline__ unsigned pk4(const f32x4 v) { const float lim = 440.f;
        int w = __builtin_amdgcn_cvt_pk_fp8_f32(fminf(fmaxf(v[0], -lim), lim), fminf(fmaxf(v[1], -lim), lim), 0, false);
        return (unsigned)__builtin_amdgcn_cvt_pk_fp8_f32(fminf(fmaxf(v[2], -lim), lim), fminf(fmaxf(v[3], -lim), lim), w, true); }
    __device__ __forceinline__ void operator()(const f32x4 (&acc)[2][2][4][2], const MoeUnit& u, int wr, int wc, int fr, int fq) const {
        typedef unsigned u32x2 __attribute__((ext_vector_type(2)));
        const int rl0 = u.mt * BM + wr * 64 + fr, col0 = u.pn * BM + wc * 32 + 8 * fq;
#pragma unroll
        for (int ai = 0; ai < 2; ++ai)
#pragma unroll
            for (int m = 0; m < 4; ++m) { const int rl = rl0 + ai * HALF + m * 16;
                if (rl < u.cnt) { unsigned char* rowp = O + (size_t)(u.pstart + rl) * 1024 + col0;
#pragma unroll
                    for (int bj = 0; bj < 2; ++bj) *(u32x2*)(rowp + bj * HALF) = (u32x2){pk4(acc[ai][bj][m][0]), pk4(acc[ai][bj][m][1])}; } }
    }
};
template <class Epi, class Sched, bool STAMP = false, bool SP2 = PG8_SP2>
__device__ __forceinline__ void gemm_phase_moe(PG8_LAS unsigned char* lds, const Gemm g, const Sched& S, const Epi& E, unsigned long long* stamps) {
    int tid_l = __builtin_amdgcn_readfirstlane(threadIdx.x >> 6) * 64 + (int)__builtin_amdgcn_mbcnt_hi(~0u, __builtin_amdgcn_mbcnt_lo(~0u, 0u)); asm volatile("" : "+v"(tid_l));
    const int tid = tid_l, wid = __builtin_amdgcn_readfirstlane(tid >> 6), lane = tid & 63, wr = wid >> 2, wc = wid & 3, fr = lane & 15, fq = lane >> 4;
    const int K = g.K, nt = K / BK;
    int ts_lo = 0, ts_hi = 0, nts = 0; const unsigned long long rt_entry = STAMP ? (unsigned long long)wall_clock64() : 0ull;
#define PG8_STAMP() do { if (STAMP && wid == 0 && nts < 64) { const unsigned long long _c = (unsigned long long)clock64(); \
        ts_lo = (lane == nts) ? (int)(unsigned)_c : ts_lo; ts_hi = (lane == nts) ? (int)(unsigned)(_c >> 32) : ts_hi; ++nts; } } while (0)
    PG8_STAMP();
    unsigned voffB[2];
#pragma unroll
    for (int i = 0; i < 2; ++i) { int R, C; stage_rc(tid * 16 + i * 8192, R, C); const int Rb = Epi::PERM ? ((R & ~31) + perm32(R & 31)) : R;
        voffB[i] = (unsigned)(Rb * K + C) * 2u; }
    unsigned vaC[2][2];
    PG8_LAS unsigned* vtab = (PG8_LAS unsigned*)(lds + STAGE_BYTES + 1024) + tid;
    const size_t kstep = (size_t)(BK * 2);
    const size_t hstep = (size_t)HALF * K * 2;
    const size_t tstep = 2 * hstep;
    const unsigned ldsw = (unsigned)wid * 1024u;
    const int aoff = lds_byte(wr * 64 + fr, fq * 8), boff = lds_byte(wc * 32 + fr, fq * 8);
#define PG8_SA(b, h) (((b) * 2 + (h)) * HTB)
#define PG8_SB(b, h) ((4 + (b) * 2 + (h)) * HTB)
#define PG8_STAGE(bufoff, gbase, voff) do { _Pragma("unroll") for (int _i = 0; _i < 2; ++_i) \
        __builtin_amdgcn_global_load_lds((const unsigned*)((const char*)(gbase) + (voff)[_i]), (PG8_LAS unsigned*)(lds + (bufoff) + ldsw + _i * 8192), 16, 0, 0); } while (0)
#define PG8_STAGEA(bufoff, kbyte, va) do { _Pragma("unroll") for (int _i = 0; _i < 2; ++_i) \
        __builtin_amdgcn_global_load_lds((const unsigned*)((const char*)g.A + (kbyte) + (va)[_i]), (PG8_LAS unsigned*)(lds + (bufoff) + ldsw + _i * 8192), 16, 0, 0); } while (0)
#define PG8_LDA(dst, b, h) do { _Pragma("unroll") for (int m = 0; m < 4; ++m) _Pragma("unroll") for (int k = 0; k < 2; ++k) dst[m][k] = *(const PG8_LAS bf16x8*)(lds + PG8_SA(b, h) + aoff + m * 2048 + k * 1024); } while (0)
#define PG8_LDB(dst, b, h) do { _Pragma("unroll") for (int n = 0; n < 2; ++n) _Pragma("unroll") for (int k = 0; k < 2; ++k) dst[n][k] = *(const PG8_LAS bf16x8*)(lds + PG8_SB(b, h) + boff + n * 2048 + k * 1024); } while (0)
#define PG8_MMA(ai, bj, At, Bt) do { __builtin_amdgcn_s_setprio(1); _Pragma("unroll") for (int m = 0; m < 4; ++m) _Pragma("unroll") for (int n = 0; n < 2; ++n) _Pragma("unroll") for (int k = 0; k < 2; ++k) \
        acc[ai][bj][m][n] = __builtin_amdgcn_mfma_f32_16x16x32_bf16(Bt[n][k], At[m][k], acc[ai][bj][m][n], 0, 0, 0); __builtin_amdgcn_s_setprio(0); } while (0)
#define PG8_WAIT_V(n) asm volatile("s_waitcnt vmcnt(" #n ")" ::: "memory")
#define PG8_WAIT_L(n) asm volatile("s_waitcnt lgkmcnt(" #n ")" ::: "memory")
#define PG8_BAR __builtin_amdgcn_s_barrier()
#define PG8_SCHED __builtin_amdgcn_sched_barrier(0)
    typename Sched::UnitT cur, nxt; int ui = 0;
    if (!S.next(0, cur)) return;
    f32x4 acc[2][2][4][2];
#pragma unroll
    for (int a = 0; a < 2; ++a)
#pragma unroll
        for (int b = 0; b < 2; ++b)
#pragma unroll
            for (int m = 0; m < 4; ++m)
#pragma unroll
                for (int n = 0; n < 2; ++n) acc[a][b][m][n] = (f32x4){0.f, 0.f, 0.f, 0.f};
    bf16x8 At[4][2], B0[2][2], B1[2][2];
    const char* cB = S.bbase(g, cur); S.a_offsets(g, cur, tid, vaC);
    if constexpr (SP2) {
        PG8_STAGE(PG8_SB(0, 0), cB, voffB); PG8_STAGE(PG8_SB(0, 1), cB + hstep, voffB); PG8_STAGEA(PG8_SA(0, 0), 0, vaC[0]); PG8_STAGEA(PG8_SA(0, 1), 0, vaC[1]);
        if (wr == 1) PG8_BAR;
        PG8_WAIT_V(2); PG8_BAR;
        PG8_STAGE(PG8_SB(1, 0), cB + kstep, voffB); PG8_STAGEA(PG8_SA(1, 0), kstep, vaC[0]); PG8_STAGE(PG8_SB(1, 1), cB + hstep + kstep, voffB);
        PG8_WAIT_V(6); PG8_BAR;
    } else {
    PG8_STAGE(PG8_SB(0, 0), cB, voffB); PG8_STAGEA(PG8_SA(0, 0), 0, vaC[0]); PG8_STAGE(PG8_SB(0, 1), cB + hstep, voffB); PG8_STAGEA(PG8_SA(0, 1), 0, vaC[1]);
    if (wr == 1) PG8_BAR;
    PG8_WAIT_V(4); PG8_BAR;
    PG8_STAGE(PG8_SB(1, 0), cB + kstep, voffB); PG8_STAGEA(PG8_SA(1, 0), kstep, vaC[0]); PG8_STAGE(PG8_SB(1, 1), cB + hstep + kstep, voffB);
    PG8_WAIT_V(6); PG8_BAR;
    }
    PG8_STAMP();
    for (;;) {
        const bool has_next = S.next(ui + 1, nxt);
        const char* nB = has_next ? S.bbase(g, nxt) : cB;
        { unsigned vaN[2][2];
          if (has_next) S.a_offsets(g, nxt, tid, vaN); else {
#pragma unroll
            for (int hf = 0; hf < 2; ++hf)
#pragma unroll
                for (int i = 0; i < 2; ++i) vaN[hf][i] = vaC[hf][i]; }
#pragma unroll
          for (int hf = 0; hf < 2; ++hf)
#pragma unroll
              for (int i = 0; i < 2; ++i) vtab[(hf * 2 + i) * 512] = vaN[hf][i]; }
        unsigned v2[2][2];
        for (int t = 0; t < nt; t += 2) {
            const bool last = (t == nt - 2);
            const size_t k1 = (size_t)(t + 1) * kstep, k2 = last ? (size_t)0 : (size_t)(t + 2) * kstep, k3 = k2 + kstep;
            const char* b2 = last ? nB : cB + (size_t)(t + 2) * kstep; const char* b3 = b2 + kstep;
#pragma unroll
            for (int hf = 0; hf < 2; ++hf)
#pragma unroll
                for (int i = 0; i < 2; ++i) v2[hf][i] = last ? vtab[(hf * 2 + i) * 512] : vaC[hf][i];
            if constexpr (SP2) {
            PG8_LDB(B0, 0, 0); PG8_LDB(B1, 0, 1); PG8_SCHED; PG8_LDA(At, 0, 0); PG8_STAGEA(PG8_SA(1, 1), k1, vaC[1]);
            PG8_WAIT_V(8); PG8_WAIT_L(0); PG8_BAR; PG8_MMA(0, 0, At, B0); PG8_MMA(0, 1, At, B1); PG8_BAR; PG8_SCHED;
            PG8_LDA(At, 0, 1); PG8_STAGE(PG8_SB(0, 0), b2, voffB); PG8_STAGE(PG8_SB(0, 1), b2 + hstep, voffB); PG8_STAGEA(PG8_SA(0, 0), k2, v2[0]);
            PG8_WAIT_V(8); PG8_WAIT_L(0); PG8_BAR; PG8_MMA(1, 0, At, B0); PG8_MMA(1, 1, At, B1); PG8_BAR; PG8_SCHED;
            PG8_LDB(B0, 1, 0); PG8_LDB(B1, 1, 1); PG8_SCHED; PG8_LDA(At, 1, 0); PG8_STAGEA(PG8_SA(0, 1), k2, v2[1]);
            PG8_WAIT_V(8); PG8_WAIT_L(0); PG8_BAR; PG8_MMA(0, 0, At, B0); PG8_MMA(0, 1, At, B1); PG8_BAR; PG8_SCHED;
            PG8_LDA(At, 1, 1); PG8_STAGE(PG8_SB(1, 0), b3, voffB); PG8_STAGE(PG8_SB(1, 1), b3 + hstep, voffB); PG8_STAGEA(PG8_SA(1, 0), k3, v2[0]);
            PG8_WAIT_V(8); PG8_WAIT_L(0); PG8_BAR; PG8_MMA(1, 0, At, B0); PG8_MMA(1, 1, At, B1); PG8_BAR; PG8_SCHED;
            } else {
            PG8_LDB(B0, 0, 0); PG8_SCHED; PG8_LDA(At, 0, 0); PG8_STAGEA(PG8_SA(1, 1), k1, vaC[1]);
            PG8_WAIT_L(8); PG8_BAR; PG8_WAIT_L(0); PG8_MMA(0, 0, At, B0); PG8_BAR; PG8_SCHED;
            PG8_LDB(B1, 0, 1); PG8_STAGE(PG8_SB(0, 0), b2, voffB);
            PG8_BAR; PG8_WAIT_L(0); PG8_MMA(0, 1, At, B1); PG8_BAR;
            PG8_LDA(At, 0, 1); PG8_STAGEA(PG8_SA(0, 0), k2, v2[0]);
            PG8_BAR; PG8_WAIT_L(0); PG8_MMA(1, 0, At, B0); PG8_BAR; PG8_SCHED;
            PG8_STAGE(PG8_SB(0, 1), b2 + hstep, voffB);
            PG8_WAIT_V(6); PG8_BAR; PG8_MMA(1, 1, At, B1); PG8_BAR;
            PG8_LDB(B0, 1, 0); PG8_SCHED; PG8_LDA(At, 1, 0); PG8_STAGEA(PG8_SA(0, 1), k2, v2[1]);
            PG8_WAIT_L(8); PG8_BAR; PG8_WAIT_L(0); PG8_MMA(0, 0, At, B0); PG8_BAR; PG8_SCHED;
            PG8_LDB(B1, 1, 1); PG8_STAGE(PG8_SB(1, 0), b3, voffB);
            PG8_BAR; PG8_WAIT_L(0); PG8_MMA(0, 1, At, B1); PG8_BAR;
            PG8_LDA(At, 1, 1); PG8_STAGEA(PG8_SA(1, 0), k3, v2[0]);
            PG8_BAR; PG8_WAIT_L(0); PG8_MMA(1, 0, At, B0); PG8_BAR; PG8_SCHED;
            PG8_STAGE(PG8_SB(1, 1), b3 + hstep, voffB);
            PG8_WAIT_V(6); PG8_BAR; PG8_MMA(1, 1, At, B1); PG8_BAR;
            }
        }
        PG8_STAMP();
        if (wr == 0) PG8_BAR;
        E(acc, cur, wr, wc, fr, fq);
        PG8_STAMP();
        if (!has_next) break;
#pragma unroll
        for (int a = 0; a < 2; ++a)
#pragma unroll
            for (int b = 0; b < 2; ++b)
#pragma unroll
                for (int m = 0; m < 4; ++m)
#pragma unroll
                    for (int n = 0; n < 2; ++n) acc[a][b][m][n] = (f32x4){0.f, 0.f, 0.f, 0.f};
        cur = nxt; cB = nB; ++ui;
#pragma unroll
        for (int hf = 0; hf < 2; ++hf)
#pragma unroll
            for (int i = 0; i < 2; ++i) vaC[hf][i] = v2[hf][i];
        if (wr == 1) PG8_BAR;
    }
    PG8_WAIT_V(0);
    PG8_BAR;
    PG8_STAMP();
    if (STAMP && wid == 0) { stamps[lane] = lane < nts ? (((unsigned long long)(unsigned)ts_hi << 32) | (unsigned)ts_lo) : 0ull;
        if (lane == 62) stamps[62] = rt_entry; if (lane == 63) stamps[63] = (unsigned long long)wall_clock64(); }
#undef PG8_STAMP
#undef PG8_SA
#undef PG8_SB
#undef PG8_STAGE
#undef PG8_STAGEA
#undef PG8_LDA
#undef PG8_LDB
#undef PG8_MMA
#undef PG8_WAIT_V
#undef PG8_WAIT_L
#undef PG8_BAR
#undef PG8_SCHED
}
}

constexpr int NTHR = 512, NWV = 8, LDS_BYTES = 147456;

struct P {
    const float *x, *c, *ctx, *c_ctx, *w_mod, *b_mod, *norm1_g, *norm2_g, *w_in, *conv_w, *conv_b, *dt_bias_f, *dt_bias_b, *a_log_f, *a_log_b, *d_skip, *ssd_norm_g,
        *gk_up_f, *gk_bias_f, *gk_up_b, *gk_bias_b, *gla_norm_g, *w_out, *w_router, *router_bias, *w_gate, *w_up, *w_down, *final_g;
    float* out; bf16_t* XB; bf16_t* H; bf16_t* PROJ; bf16_t* SS; bf16_t* GS; float* SDEC; float* GDEC; float* MOD; int* counts; int* TOKSLOT; float* EW; int* MAP; bf16_t* WinT; bf16_t* WoutT; bf16_t* WguT; bf16_t* WdT; bf16_t* WRT; unsigned* BAR; bf16_t* XBCC; bf16_t* QKB; float* SSC; float* STOT; float* SSQ; float* XSS;
};

DI void ph_init(const P& p) { const size_t i = (size_t)blockIdx.x * NTHR + ltid(); if (i < 64) p.counts[i * 32] = 0; }

DI void ph_mod(const P& p, float* s  ) {
    const int tid_ = ltid(), lane = tid_ & 63, w = tid_ >> 6;
    if (blockIdx.x >= 192) return;
    float* part = s + 9 * 1024;
    { float cv[18];
#pragma unroll
      for (int q = 0; q < 18; ++q) { const int i = tid_ + q * NTHR, r = i >> 10, k = i & 1023; cv[q] = r < 8 ? p.c[r * 1024 + k] : p.c_ctx[k]; }
#pragma unroll
      for (int q = 0; q < 18; ++q) s[tid_ + q * NTHR] = siluf(cv[q]); }
    __syncthreads();
    for (int vb = blockIdx.x; vb < 192; vb += gridDim.x) {
        const int l = vb / 96, n = (vb % 96) * 64 + lane;
        float acc[9];
#pragma unroll
        for (int r = 0; r < 9; ++r) acc[r] = 0.f;
        const float* wp = p.w_mod + (size_t)l * 1024 * 6144 + (size_t)(128 * w) * 6144 + n;
#pragma unroll 8
        for (int k = 0; k < 128; ++k) { const float wv = wp[(size_t)k * 6144];
#pragma unroll
            for (int r = 0; r < 9; ++r) acc[r] += s[r * 1024 + 128 * w + k] * wv; }
#pragma unroll
        for (int r = 0; r < 9; ++r) part[(w * 9 + r) * 64 + lane] = acc[r];
        __syncthreads();
        for (int o = tid_; o < 9 * 64; o += NTHR) { const int r = o >> 6, c = o & 63; float a = p.b_mod[l * 6144 + (vb % 96) * 64 + c];
#pragma unroll
            for (int q = 0; q < 8; ++q) a += part[(q * 9 + r) * 64 + c];
            p.MOD[((size_t)l * 9 + r) * 6144 + (vb % 96) * 64 + c] = a; }
        __syncthreads();
    }
}

DI unsigned pk2(float lo, float hi) { return __builtin_bit_cast(unsigned, __builtin_convertvector((f32x2v_){lo, hi}, bf16x2v_)); }
DI void transpose_item(const float* W, int K, int N, bf16_t* WT, float* scr, int item, int lane, int gu = -1, const float* kscale = nullptr) {
    const int nblk = (N + 31) / 32, kb = item / nblk, nb = item % nblk, k0 = 64 * kb, n0 = 32 * nb;
    const int d0 = gu < 0 ? n0 : 256 * (n0 >> 7) + (n0 & 127) + 128 * gu;
    const bool nok = n0 + (lane & 31) < N;
    float wv_[32];
#pragma unroll
    for (int i = 0; i < 32; ++i) { const int kk = 2 * i + (lane >> 5); wv_[i] = nok ? __builtin_nontemporal_load(W + (size_t)(k0 + kk) * N + n0 + (lane & 31)) : 0.f; }
#pragma unroll
    for (int i = 0; i < 32; ++i) { const int kk = 2 * i + (lane >> 5); scr[kk * 33 + (lane & 31)] = wv_[i] * (kscale ? kscale[k0 + kk] : 1.0f); }
    const int c = lane & 7;
#pragma unroll
    for (int j = 0; j < 4; ++j) { const int n = (lane >> 3) + 8 * j; const float* q = scr + (8 * c) * 33 + n;
        uint4 o; o.x = pk2(q[0 * 33], q[1 * 33]); o.y = pk2(q[2 * 33], q[3 * 33]); o.z = pk2(q[4 * 33], q[5 * 33]); o.w = pk2(q[6 * 33], q[7 * 33]);
        if (n0 + n < N) { typedef unsigned u32x4nt __attribute__((ext_vector_type(4))); __builtin_nontemporal_store((u32x4nt){o.x, o.y, o.z, o.w}, (u32x4nt*)(WT + (size_t)(d0 + n) * K + k0 + 8 * c)); } }
}

DI void ph_convert_experts(const P& p, int l, float* ldsf, int wk0, int nwk, int it0 = 0, int it1 = NE * 768) {
    const int tid_ = ltid(), lane = tid_ & 63, gw = ((int)blockIdx.x - wk0) * NWV + (tid_ >> 6), NW = nwk * NWV;
    float* scr = ldsf + 14 * 1024 + (tid_ >> 6) * (64 * 33 + 16);
    for (int it = it0 + gw; it < it1; it += NW) {
        const int e = it / 768, r = it - e * 768;
        if (r < 512) { const int gu = r >> 8; const float* W = (gu ? p.w_up : p.w_gate) + (size_t)(l * NE + e) * D * 512;
            transpose_item(W, D, 512, p.WguT + (size_t)e * D * D, scr, r & 255, lane, gu); }
        else transpose_item(p.w_down + (size_t)(l * NE + e) * 512 * D, 512, D, p.WdT + (size_t)e * D * 512, scr, r - 512, lane);
    }
}
constexpr int NPAD_IN = 3072;
DI void ph_convert_small(const P& p, float* ldsf, int, int, int) {
    const int tid_ = ltid(), lane = tid_ & 63, gw = blockIdx.x * NWV + (tid_ >> 6), NW = gridDim.x * NWV;
    float* scr = ldsf + 14 * 1024 + (tid_ >> 6) * (64 * 33 + 16);
    constexpr int I_IN = 16 * 89, I_OUT = 16 * 32;
    for (int it = gw; it < 2 * (I_IN + I_OUT); it += NW) {
        const int l = it / (I_IN + I_OUT), r = it % (I_IN + I_OUT);
        if (r < I_IN) transpose_item(p.w_in + (size_t)l * D * INDIM, D, INDIM, p.WinT + (size_t)l * NPAD_IN * D, scr, r, lane);
        else { const int kb = (r - I_IN) / 32;
            transpose_item(p.w_out + (size_t)l * D * D, D, D, p.WoutT + (size_t)l * D * D, scr, r - I_IN, lane, -1, kb < 8 ? p.ssd_norm_g + l * 512 : nullptr); }
    }
    for (int idx = blockIdx.x * NTHR + tid_; idx < 32 * 1024; idx += gridDim.x * NTHR) { const int e = idx >> 10, k = idx & 1023; p.WRT[idx] = f2bf(p.w_router[k * 32 + e]); }
    const size_t nz16 = (size_t)(NPAD_IN - INDIM) * D * 2 / 16;
    for (size_t i = (size_t)blockIdx.x * NTHR + tid_; i < 2 * nz16; i += (size_t)gridDim.x * NTHR) {
        const size_t l = i / nz16, j = i % nz16;
        ((uint4*)(p.WinT + (l * NPAD_IN + INDIM) * D))[j] = make_uint4(0u, 0u, 0u, 0u);
    }
}

DI void row_normmod(float4 (&v)[4], const float* g, const float* mr, int shift_idx, int scale_idx, int lane) {
    float ss = 0.f;
#pragma unroll
    for (int i = 0; i < 4; ++i) ss += v[i].x * v[i].x + v[i].y * v[i].y + v[i].z * v[i].z + v[i].w * v[i].w;
    ss = wave_sum(ss, lane);
    const float rstd = rsqrtf(ss * (1.0f / D) + 1e-6f);
#pragma unroll
    for (int i = 0; i < 4; ++i) {
        const int c = (i * 64 + lane) * 4;
        const float4 gg = *(const float4*)(g + c), sh = *(const float4*)(mr + shift_idx * 1024 + c), sc = *(const float4*)(mr + scale_idx * 1024 + c);
        v[i].x = v[i].x * rstd * gg.x * (1.f + sc.x) + sh.x; v[i].y = v[i].y * rstd * gg.y * (1.f + sc.y) + sh.y;
        v[i].z = v[i].z * rstd * gg.z * (1.f + sc.z) + sh.z; v[i].w = v[i].w * rstd * gg.w * (1.f + sc.w) + sh.w;
    }
}
DI void row_store_bf16(bf16_t* hrow, float4 (&v)[4], int lane) {
#pragma unroll
    for (int i = 0; i < 4; ++i) { ushort4 o; o.x = f2bf(v[i].x); o.y = f2bf(v[i].y); o.z = f2bf(v[i].z); o.w = f2bf(v[i].w);
        *(ushort4*)(hrow + (i * 64 + lane) * 4) = o; v[i] = make_float4(bf2f(o.x), bf2f(o.y), bf2f(o.z), bf2f(o.w)); }
}

DI void ph_normmod1(const P& p, int l, int, int, int) {
    const int tid_ = ltid(), lane = tid_ & 63, gw = blockIdx.x * NWV + (tid_ >> 6), NW = gridDim.x * NWV;
    const float* MODl = p.MOD + (size_t)l * 9 * 6144;
    for (int t = gw; t < T; t += NW) {
        float4 v[4];
#pragma unroll
        for (int i = 0; i < 4; ++i) v[i] = ((const float4*)(t < TC ? p.ctx + (size_t)t * D : p.x + (size_t)(t - TC) * D))[i * 64 + lane];
        row_normmod(v, p.norm1_g + l * D, MODl + (size_t)tok_modrow(t) * 6144, 0, 1, lane);
        row_store_bf16(p.H + (size_t)t * D, v, lane);
    }
}

typedef short s16x4 __attribute__((ext_vector_type(4)));
typedef short bf16x8v __attribute__((ext_vector_type(8)));
typedef float f32x4v __attribute__((ext_vector_type(4)));
typedef unsigned u32x4v __attribute__((ext_vector_type(4)));
typedef unsigned u32x2v __attribute__((ext_vector_type(2)));
DI u32x4v mk4(unsigned a, unsigned b, unsigned c, unsigned d) { return (u32x4v){a, b, c, d}; }
DI u32x2v mk2(unsigned a, unsigned b) { return (u32x2v){a, b}; }
DI f32x4v mkf4(float a, float b, float c, float d) { return (f32x4v){a, b, c, d}; }
#define LDSP __attribute__((address_space(3)))
constexpr int NCH = 34, NTILE = NB * NCH;
constexpr int LD64 = 72, LD128 = 136;
constexpr float LOG2E = 1.4426950408889634f;

DI int tile_tok0(int tl) { const int b = tl / NCH, cs = tl - b * NCH; return cs < 2 ? b * CTXL + cs * 128 : TC + b * SEQ + (cs - 2) * 128; }
DI f32x4v mfma16(bf16x8v a, bf16x8v b, f32x4v c) { return __builtin_amdgcn_mfma_f32_16x16x32_bf16(a, b, c, 0, 0, 0); }
DI bf16x8v frag_row(LDSP const bf16_t* base, int ld, int r0, int k0, int lane) { return *(LDSP const bf16x8v*)(base + (r0 + (lane & 15)) * ld + k0 + 8 * (lane >> 4)); }
DI bf16x8v frag_row_g(const bf16_t* base, int ld, int r0, int k0, int lane) { return *(const bf16x8v*)(base + (size_t)(r0 + (lane & 15)) * ld + k0 + 8 * (lane >> 4)); }
DI bf16x8v frag_col(LDSP const bf16_t* base, int ld, int r0, int k0, int lane) {
    const int G = lane >> 4, i = lane & 15;
    LDSP const bf16_t* a = base + (k0 + 8 * G + (i >> 2)) * ld + r0 + 4 * (i & 3);
    const s16x4 lo = __builtin_bit_cast(s16x4, __builtin_amdgcn_ds_read_tr16_b64_v4i16((LDSP s16x4*)a));
    const s16x4 hi = __builtin_bit_cast(s16x4, __builtin_amdgcn_ds_read_tr16_b64_v4i16((LDSP s16x4*)(a + 4 * ld)));
    return (bf16x8v){lo[0], lo[1], lo[2], lo[3], hi[0], hi[1], hi[2], hi[3]};
}
DI u32x2v pack4(f32x4v v) { return mk2(pk2(v[0], v[1]), pk2(v[2], v[3])); }
DI void unpack8(u32x4v v, float* o) { o[0] = __uint_as_float(v.x << 16); o[1] = __uint_as_float(v.x & 0xffff0000u); o[2] = __uint_as_float(v.y << 16); o[3] = __uint_as_float(v.y & 0xffff0000u);
    o[4] = __uint_as_float(v.z << 16); o[5] = __uint_as_float(v.z & 0xffff0000u); o[6] = __uint_as_float(v.w << 16); o[7] = __uint_as_float(v.w & 0xffff0000u); }
DI u32x4v pack8(const float* o) { return mk4(pk2(o[0], o[1]), pk2(o[2], o[3]), pk2(o[4], o[5]), pk2(o[6], o[7])); }

DI float fast_logsigmoid(float x) { return -(fmaxf(-x, 0.f) + __logf(1.0f + __expf(-fabsf(x)))); }
DI float fast_softplus(float x) { return fmaxf(x, 0.f) + __logf(1.0f + __expf(-fabsf(x))); }
struct XbcSrc { const bf16_t* base; int ld; };
DI XbcSrc xbc_src(const P& p, int tok0) { XbcSrc r; r.base = p.XBCC + (size_t)tok0 * 768; r.ld = 768; return r; }

DI void prep_conv_item(const P& p, int l, int item, int lane) {
    int piece, ch;
    if (item < T / 32) { piece = item; ch = lane * 8; } else { piece = 2 * (item - T / 32) + (lane >> 5); ch = 512 + (lane & 31) * 8; }
    const int t0 = piece * 32; int lo, hi; bf16_t* dst; int dld;
    if (t0 < TC) { lo = t0 & ~(CTXL - 1); hi = lo + CTXL - 1; } else { lo = TC + ((t0 - TC) & ~63); hi = lo + 63; }
    dst = p.XBCC + ch; dld = 768;
    const bf16_t* src = p.PROJ + OFF_XBC + ch;
    float wgt[5][8], bias[8];
#pragma unroll
    for (int k = 0; k < 5; ++k) { const f32x4v a = *(const f32x4v*)(p.conv_w + l * 5 * 768 + k * 768 + ch), c = *(const f32x4v*)(p.conv_w + l * 5 * 768 + k * 768 + ch + 4);
#pragma unroll
        for (int j = 0; j < 4; ++j) { wgt[k][j] = a[j]; wgt[k][4 + j] = c[j]; } }
    { const f32x4v a = *(const f32x4v*)(p.conv_b + l * 768 + ch), c = *(const f32x4v*)(p.conv_b + l * 768 + ch + 4);
#pragma unroll
      for (int j = 0; j < 4; ++j) { bias[j] = a[j]; bias[4 + j] = c[j]; } }
    const u32x4v zero4 = mk4(0u, 0u, 0u, 0u);
    u32x4v rw[13];
#pragma unroll
    for (int i = 0; i < 5; ++i) { const int tt = t0 - 2 + i; rw[i] = (tt >= lo && tt <= hi) ? *(const u32x4v*)(src + (size_t)tt * LDP) : zero4; }
    for (int s0 = 0; s0 < 32; s0 += 8) {
        const int t = t0 + s0;
#pragma unroll
        for (int i = 0; i < 8; ++i) { const int tt = t + 3 + i; rw[5 + i] = (tt <= hi) ? *(const u32x4v*)(src + (size_t)tt * LDP) : zero4; }
#pragma unroll
        for (int i = 0; i < 8; ++i) {
            float o[8];
#pragma unroll
            for (int c = 0; c < 8; ++c) o[c] = bias[c];
#pragma unroll
            for (int k = 0; k < 5; ++k) { float v[8]; unpack8(rw[i + k], v);
#pragma unroll
                for (int c = 0; c < 8; ++c) o[c] += wgt[k][c] * v[c]; }
#pragma unroll
            for (int c = 0; c < 8; ++c) o[c] = siluf(o[c]);
            *(u32x4v*)(dst + (size_t)(t + i) * dld) = pack8(o);
        }
#pragma unroll
        for (int i = 0; i < 5; ++i) rw[i] = rw[i + 8];
    }
}
DI void prep_ssd_item(const P& p, int l, int item, int lane) {
    const int tl = item >> 3, h = item & 7, tok0 = tile_tok0(tl);
    const float bsf = p.dt_bias_f[l * 8 + h], bsb = p.dt_bias_b[l * 8 + h];
    const float r0 = bf2f(p.PROJ[(size_t)(tok0 + 2 * lane) * LDP + OFF_DT + h]), r1 = bf2f(p.PROJ[(size_t)(tok0 + 2 * lane + 1) * LDP + OFF_DT + h]);
    const float f0 = fast_softplus(r0 + bsf), f1 = fast_softplus(r1 + bsf), b0 = fast_softplus(r0 + bsb), b1 = fast_softplus(r1 + bsb);
    float pf = f0 + f1, sb = b0 + b1;
#pragma unroll
    for (int o = 1; o < 64; o <<= 1) { const float t = shl(pf, lane >= o ? lane - o : lane); if (lane >= o) pf += t; }
#pragma unroll
    for (int o = 1; o < 64; o <<= 1) { const float t = shl(sb, lane + o < 64 ? lane + o : lane); if (lane + o < 64) sb += t; }
    const float Af = -__expf(p.a_log_f[l * 8 + h]) * LOG2E, Ab = -__expf(p.a_log_b[l * 8 + h]) * LOG2E;
    const float af0 = Af * (pf - f1), af1 = Af * pf, ab0 = Ab * sb, ab1 = Ab * (sb - b0);
    f32x4v* dst = (f32x4v*)p.SSC + (size_t)(tok0 + 2 * lane) * 8 + h;
    dst[0] = mkf4(af0, af0 - __log2f(f0), ab0, ab0 - __log2f(b0));
    dst[8] = mkf4(af1, af1 - __log2f(f1), ab1, ab1 - __log2f(b1));
    if (lane == 63) { p.STOT[(tl * 8 + h) * 2 + 0] = af1; p.SDEC[(tl * 8 + h) * 2 + 0] = __builtin_amdgcn_exp2f(af1); }
    if (lane == 0) { p.STOT[(tl * 8 + h) * 2 + 1] = ab0; p.SDEC[(tl * 8 + h) * 2 + 1] = __builtin_amdgcn_exp2f(ab0); }
}
template <int CTRL> DI float dppz(float x) { return __builtin_bit_cast(float, __builtin_amdgcn_update_dpp(0, __builtin_bit_cast(int, x), CTRL, 0xf, 0xf, true)); }
DI float row_total(float s) { s += dppz<0xB1>(s); s += dppz<0x4E>(s); s += dppz<0x141>(s); s += dppz<0x140>(s); return s; }
struct GlaPL { u32x4v qv_[2], kv_[2], vv_[4]; bf16x8v gkf[8]; float uw[8]; f32x4v bias; };
DI void prep_gla_load(const P& p, int l, int it, GlaPL& L) {
    const int tl = it >> 2, h = it & 3;
    const int tid = ltid(), lane = tid & 63, w = __builtin_amdgcn_readfirstlane(tid >> 6), kt = w & 3, dir = w >> 2, G = lane >> 4, c = lane & 15, tok0 = tile_tok0(tl);
#pragma unroll
    for (int nt = 0; nt < 8; ++nt) L.gkf[nt] = *(const bf16x8v*)(p.PROJ + (size_t)(tok0 + 16 * nt + c) * LDP + OFF_GK + (G & 1) * 8);
    { const float* up = (dir ? p.gk_up_b : p.gk_up_f) + l * 16 * 256 + (G & 1) * 8 * 256 + h * 64 + 16 * kt + c;
#pragma unroll
      for (int e = 0; e < 8; ++e) L.uw[e] = up[e * 256]; }
    L.bias = *(const f32x4v*)((dir ? p.gk_bias_b : p.gk_bias_f) + l * 256 + h * 64 + 16 * kt + 4 * G);
#pragma unroll
    for (int q = 0; q < 4; ++q) { const int cc_ = tid + q * NTHR, r = cc_ >> 4, cc = cc_ & 15; L.vv_[q] = *(const u32x4v*)(p.PROJ + (size_t)(tok0 + r) * LDP + OFF_V + h * 128 + cc * 8); }
#pragma unroll
    for (int q = 0; q < 2; ++q) { const int cc_ = tid + q * NTHR, r = cc_ >> 3, cc = cc_ & 7; const bf16_t* pr = p.PROJ + (size_t)(tok0 + r) * LDP;
        L.qv_[q] = *(const u32x4v*)(pr + OFF_Q + h * 64 + cc * 8); L.kv_[q] = *(const u32x4v*)(pr + OFF_K + h * 64 + cc * 8); }
}
DI void prep_gla_block(const P& p, int l, int it, int it_next, GlaPL& L, LDSP unsigned char* lds) {
    const int tl = it >> 2, h = it & 3;
    const int tid = ltid(), lane = tid & 63, w = __builtin_amdgcn_readfirstlane(tid >> 6), kt = w & 3, dir = w >> 2, G = lane >> 4, c = lane & 15, tok0 = tile_tok0(tl);
    LDSP bf16_t* QT = (LDSP bf16_t*)lds; LDSP bf16_t* KT = QT + 128 * LD64; LDSP bf16_t* O4 = KT + 128 * LD64; LDSP bf16_t* VT = O4 + 4 * 128 * LD64; LDSP float* DEC = (LDSP float*)(VT + 128 * LD128);
    f32x4v g[8];
    { bf16x8v af;
#pragma unroll
      for (int e = 0; e < 8; ++e) { const bf16_t hi = f2bf(L.uw[e]); const bf16_t lo = f2bf(L.uw[e] - bf2f(hi)); af[e] = (short)(G < 2 ? hi : lo); }
#pragma unroll
      for (int nt = 0; nt < 8; ++nt) g[nt] = mfma16(af, L.gkf[nt], (f32x4v){0.f, 0.f, 0.f, 0.f}); }
#pragma unroll
    for (int nt = 0; nt < 8; ++nt)
#pragma unroll
        for (int r = 0; r < 4; ++r) { const float x = (g[nt][r] + L.bias[r]) * LOG2E;
            g[nt][r] = -(fmaxf(-x, 0.f) + __log2f(1.0f + __builtin_amdgcn_exp2f(-fabsf(x)))) * (1.0f / 16.0f); }
    f32x4v tot = (f32x4v){0.f, 0.f, 0.f, 0.f};
    if (dir == 0) {
#pragma unroll
        for (int nt = 0; nt < 8; ++nt)
#pragma unroll
            for (int r = 0; r < 4; ++r) { const float s = row_total(g[nt][r]); float x = g[nt][r];
                x += dppz<0x111>(x); x += dppz<0x112>(x); x += dppz<0x114>(x); x += dppz<0x118>(x);
                g[nt][r] = tot[r] + x; tot[r] += s; }
    } else {
#pragma unroll
        for (int nt = 7; nt >= 0; --nt)
#pragma unroll
            for (int r = 0; r < 4; ++r) { const float s = row_total(g[nt][r]); float x = g[nt][r];
                x += dppz<0x101>(x); x += dppz<0x102>(x); x += dppz<0x104>(x); x += dppz<0x108>(x);
                g[nt][r] = tot[r] + x; tot[r] += s; }
    }
    __syncthreads();
#pragma unroll
    for (int q = 0; q < 2; ++q) { const int cc_ = tid + q * NTHR, r = cc_ >> 3, cc = cc_ & 7; *(LDSP u32x4v*)(QT + r * LD64 + cc * 8) = L.qv_[q]; *(LDSP u32x4v*)(KT + r * LD64 + cc * 8) = L.kv_[q]; }
#pragma unroll
    for (int q = 0; q < 4; ++q) { const int cc_ = tid + q * NTHR, r = cc_ >> 4, cc = cc_ & 15; *(LDSP u32x4v*)(VT + r * LD128 + cc * 8) = L.vv_[q]; }
    __syncthreads();
    { LDSP bf16_t* OQ = O4 + (2 * dir) * 128 * LD64; LDSP bf16_t* OK = OQ + 128 * LD64;
#pragma unroll
      for (int nt = 0; nt < 8; ++nt) { const int o = (16 * nt + c) * LD64 + 16 * kt + 4 * G;
          const u32x2v q2 = *(LDSP const u32x2v*)(QT + o), k2 = *(LDSP const u32x2v*)(KT + o);
          float eq[4], ek[4];
#pragma unroll
          for (int r = 0; r < 4; ++r) { eq[r] = __builtin_amdgcn_exp2f(g[nt][r] - 3.0f); ek[r] = __builtin_amdgcn_exp2f(-g[nt][r]); }
          *(LDSP u32x2v*)(OQ + o) = mk2(pk2(__uint_as_float(q2.x << 16) * eq[0], __uint_as_float(q2.x & 0xffff0000u) * eq[1]), pk2(__uint_as_float(q2.y << 16) * eq[2], __uint_as_float(q2.y & 0xffff0000u) * eq[3]));
          *(LDSP u32x2v*)(OK + o) = mk2(pk2(__uint_as_float(k2.x << 16) * ek[0], __uint_as_float(k2.x & 0xffff0000u) * ek[1]), pk2(__uint_as_float(k2.y << 16) * ek[2], __uint_as_float(k2.y & 0xffff0000u) * ek[3])); }
      if (c == 0) { const f32x4v d = mkf4(__builtin_amdgcn_exp2f(tot[0]), __builtin_amdgcn_exp2f(tot[1]), __builtin_amdgcn_exp2f(tot[2]), __builtin_amdgcn_exp2f(tot[3]));
          *(f32x4v*)(p.GDEC + (size_t)((tl * 4 + h) * 2 + dir) * 64 + 16 * kt + 4 * G) = d; *(LDSP f32x4v*)(DEC + dir * 64 + 16 * kt + 4 * G) = d; } }
    __syncthreads();
    if (it_next >= 0) prep_gla_load(p, l, it_next, L);
#pragma unroll
    for (int q = 0; q < 8; ++q) { const int cc_ = tid + q * NTHR, a4 = cc_ >> 10, r = (cc_ >> 3) & 127, cc = cc_ & 7;
        *(u32x4v*)(p.QKB + (size_t)(tok0 + r) * 1024 + a4 * 256 + h * 64 + cc * 8) = *(LDSP const u32x4v*)(O4 + (a4 * 128 + r) * LD64 + cc * 8); }
    { const int ut = kt; LDSP const bf16_t* KE = O4 + (dir ? 3 : 1) * 128 * LD64;
      f32x4v acc[8];
#pragma unroll
      for (int q = 0; q < 8; ++q) acc[q] = (f32x4v){0.f, 0.f, 0.f, 0.f};
#pragma unroll
      for (int ks = 0; ks < 4; ++ks) { const bf16x8v u = frag_col(KE, LD64, 16 * ut, 32 * ks, lane);
#pragma unroll
          for (int q = 0; q < 8; ++q) acc[q] = mfma16(u, frag_col(VT, LD128, 16 * q, 32 * ks, lane), acc[q]); }
      const f32x4v dec = *(LDSP const f32x4v*)(DEC + dir * 64 + 16 * ut + 4 * (lane >> 4));
      bf16_t* dst = p.GS + ((size_t)((tl * 4 + h) * 2 + dir) * 128) * 64;
#pragma unroll
      for (int q = 0; q < 8; ++q) *(u32x2v*)(dst + (size_t)(16 * q + (lane & 15)) * 64 + 16 * ut + 4 * (lane >> 4)) = pack4(acc[q] * dec); }
}
constexpr int NPREP_A = T / 32 + T / 64, NPREP_B = NTILE * 8;
DI void ph_prep(const P& p, int l, LDSP unsigned char* lds) {
    const int tid_ = ltid(), lane = tid_ & 63, gw = blockIdx.x * NWV + (tid_ >> 6), NW = gridDim.x * NWV;
    for (int it = gw; it < NPREP_A + NPREP_B; it += NW) {
        if (it < NPREP_A) prep_conv_item(p, l, it, lane); else prep_ssd_item(p, l, it - NPREP_A, lane);
    }
    { const int G_ = gridDim.x; int it = G_ - 1 - (int)blockIdx.x;
      GlaPL L; if (it < NTILE * 4) prep_gla_load(p, l, it, L);
      for (; it < NTILE * 4; it += G_) prep_gla_block(p, l, it, it + G_ < NTILE * 4 ? it + G_ : -1, L, lds); }
}

DI void s1_ssd(const P& p, int tl, int h, LDSP unsigned char* lds) {
    const int tid = ltid(), lane = tid & 63, w = __builtin_amdgcn_readfirstlane(tid >> 6);
    const int tok0 = tile_tok0(tl), g = h >> 2; const XbcSrc xs = xbc_src(p, tok0);
    LDSP bf16_t* XWF = (LDSP bf16_t*)lds; LDSP bf16_t* XWB = XWF + 128 * LD64; LDSP bf16_t* BG = XWB + 128 * LD64;
    const int j = tid >> 2, cq = tid & 3;
    const bf16_t* row = xs.base + (size_t)j * xs.ld;
    const u32x4v x0 = *(const u32x4v*)(row + h * 64 + cq * 16), x1 = *(const u32x4v*)(row + h * 64 + cq * 16 + 8);
    const u32x4v b0 = *(const u32x4v*)(row + 512 + g * 64 + cq * 16), b1 = *(const u32x4v*)(row + 512 + g * 64 + cq * 16 + 8);
    const f32x4v sc = *((const f32x4v*)p.SSC + (size_t)(tok0 + j) * 8 + h);
    const float wf = __builtin_amdgcn_exp2f(p.STOT[(tl * 8 + h) * 2 + 0] - sc.y), wb = __builtin_amdgcn_exp2f(p.STOT[(tl * 8 + h) * 2 + 1] - sc.w);
    float xv[16], of[16], ob[16]; unpack8(x0, xv); unpack8(x1, xv + 8);
#pragma unroll
    for (int c = 0; c < 16; ++c) { of[c] = xv[c] * wf; ob[c] = xv[c] * wb; }
    __syncthreads();
    *(LDSP u32x4v*)(XWF + j * LD64 + cq * 16) = pack8(of); *(LDSP u32x4v*)(XWF + j * LD64 + cq * 16 + 8) = pack8(of + 8);
    *(LDSP u32x4v*)(XWB + j * LD64 + cq * 16) = pack8(ob); *(LDSP u32x4v*)(XWB + j * LD64 + cq * 16 + 8) = pack8(ob + 8);
    *(LDSP u32x4v*)(BG + j * LD64 + cq * 16) = b0; *(LDSP u32x4v*)(BG + j * LD64 + cq * 16 + 8) = b1;
    __syncthreads();
    const int dir = w >> 2, ut = w & 3; LDSP const bf16_t* XW = dir ? XWB : XWF;
    f32x4v acc[4];
#pragma unroll
    for (int q = 0; q < 4; ++q) acc[q] = (f32x4v){0.f, 0.f, 0.f, 0.f};
#pragma unroll
    for (int ks = 0; ks < 4; ++ks) { const bf16x8v u = frag_col(BG, LD64, 16 * ut, 32 * ks, lane);
#pragma unroll
        for (int q = 0; q < 4; ++q) acc[q] = mfma16(u, frag_col(XW, LD64, 16 * q, 32 * ks, lane), acc[q]); }
    bf16_t* dst = p.SS + ((size_t)((tl * 8 + h) * 2 + dir) * 64) * 64;
#pragma unroll
    for (int q = 0; q < 4; ++q) *(u32x2v*)(dst + (size_t)(16 * q + (lane & 15)) * 64 + 16 * ut + 4 * (lane >> 4)) = pack4(acc[q]);
}
DI void ph_s1(const P& p, int l, LDSP unsigned char* lds) {
    for (int it = blockIdx.x; it < NTILE * 8; it += gridDim.x) s1_ssd(p, it >> 3, it & 7, lds);
}

DI int s2_chunk(int dir, int s) { return dir == 0 ? s : (s < 2 ? 1 - s : 35 - s); }
DI void ph_s2(const P& p) {
    const int g = blockIdx.x * NTHR + ltid();
    for (int v = g; v < 131072; v += gridDim.x * NTHR) {
        const bool gla = v >= 65536; const int r = v & 65535;
        int b, h, dir, vi;
        if (!gla) { vi = r & 511; dir = (r >> 9) & 1; h = (r >> 10) & 7; b = r >> 13; } else { vi = r & 1023; dir = (r >> 10) & 1; h = (r >> 11) & 3; b = r >> 13; }
        float st[8];
#pragma unroll
        for (int e = 0; e < 8; ++e) st[e] = 0.f;
        for (int s0 = 0; s0 < NCH; s0 += 6) {
            u32x4v sv[6]; float dsc[6]; f32x4v dv0[6], dv1[6];
#pragma unroll
            for (int u = 0; u < 6; ++u) { if (s0 + u >= NCH) continue; const int tl = b * NCH + s2_chunk(dir, s0 + u);
                if (!gla) { sv[u] = *(const u32x4v*)(p.SS + ((size_t)((tl * 8 + h) * 2 + dir) * 512 + vi) * 8); dsc[u] = p.SDEC[(tl * 8 + h) * 2 + dir]; }
                else { sv[u] = *(const u32x4v*)(p.GS + ((size_t)((tl * 4 + h) * 2 + dir) * 1024 + vi) * 8); const f32x4v* d = (const f32x4v*)(p.GDEC + (size_t)((tl * 4 + h) * 2 + dir) * 64 + (vi & 7) * 8); dv0[u] = d[0]; dv1[u] = d[1]; } }
#pragma unroll
            for (int u = 0; u < 6; ++u) { if (s0 + u >= NCH) continue; const int tl = b * NCH + s2_chunk(dir, s0 + u);
                float loc[8]; unpack8(sv[u], loc);
                const u32x4v hin = pack8(st);
                if (!gla) { *(u32x4v*)(p.SS + ((size_t)((tl * 8 + h) * 2 + dir) * 512 + vi) * 8) = hin;
#pragma unroll
                    for (int e = 0; e < 8; ++e) st[e] = dsc[u] * st[e] + loc[e]; }
                else { *(u32x4v*)(p.GS + ((size_t)((tl * 4 + h) * 2 + dir) * 1024 + vi) * 8) = hin;
                    const float dd[8] = {dv0[u].x, dv0[u].y, dv0[u].z, dv0[u].w, dv1[u].x, dv1[u].y, dv1[u].z, dv1[u].w};
#pragma unroll
                    for (int e = 0; e < 8; ++e) st[e] = dd[e] * st[e] + loc[e]; } }
        }
    }
}

DI int s3_tile(int l, int q) { return l == 0 ? q : (q >> 5) * NCH + 2 + (q & 31); }
struct SsdPre { u32x4v x0, x1, b0, b1, c0, c1, hf, hb; f32x4v sc; };
DI void s3_ssd_load(const P& p, int tl, int h, int tid, int i, int G, SsdPre& r) {
    const int tok0 = tile_tok0(tl), g = h >> 2; const XbcSrc xs = xbc_src(p, tok0);
    const int j = tid >> 2, cq = tid & 3; const bf16_t* row = xs.base + (size_t)j * xs.ld;
    r.x0 = *(const u32x4v*)(row + h * 64 + cq * 16); r.x1 = *(const u32x4v*)(row + h * 64 + cq * 16 + 8);
    r.b0 = *(const u32x4v*)(row + 512 + g * 64 + cq * 16); r.b1 = *(const u32x4v*)(row + 512 + g * 64 + cq * 16 + 8);
    r.c0 = *(const u32x4v*)(row + 640 + g * 64 + cq * 16); r.c1 = *(const u32x4v*)(row + 640 + g * 64 + cq * 16 + 8);
    const bf16_t* Hf = p.SS + (size_t)((tl * 8 + h) * 2 + 0) * 4096 + (tid >> 3) * 64 + (tid & 7) * 8;
    r.hf = *(const u32x4v*)Hf; r.hb = *(const u32x4v*)(Hf + 4096);
    r.sc = *((const f32x4v*)p.SSC + (size_t)(tok0 + (tid & 127)) * 8 + h);
}
DI void ph_s3_ssd(const P& p, int l, LDSP unsigned char* lds) {
    const int tid = ltid(), lane = tid & 63, w = __builtin_amdgcn_readfirstlane(tid >> 6), G = lane >> 4, li = lane & 15, i = 16 * w + li;
    LDSP bf16_t* XH = (LDSP bf16_t*)lds; LDSP bf16_t* BG = XH + 128 * LD64; LDSP bf16_t* CG = BG + 128 * LD64; LDSP bf16_t* MM = CG + 128 * LD64; LDSP f32x4v* SC = (LDSP f32x4v*)(MM + 128 * LD128);
    LDSP bf16_t* HF = (LDSP bf16_t*)(SC + 128); LDSP bf16_t* HB = HF + 64 * LD64;
    const int nit = (l == 0 ? NTILE : NB * 32) * 8, GS_ = gridDim.x;
    int it = ((int)blockIdx.x + (GS_ >> 1)) % GS_; SsdPre pre;
    if (it < nit) s3_ssd_load(p, s3_tile(l, it >> 3), it & 7, tid, i, G, pre);
    for (; it < nit; it += GS_) {
        const int tl = s3_tile(l, it >> 3), h = it & 7, tok0 = tile_tok0(tl);
        __syncthreads();
        { const int j = tid >> 2, cq = tid & 3;
          *(LDSP u32x4v*)(XH + j * LD64 + cq * 16) = pre.x0; *(LDSP u32x4v*)(XH + j * LD64 + cq * 16 + 8) = pre.x1;
          *(LDSP u32x4v*)(BG + j * LD64 + cq * 16) = pre.b0; *(LDSP u32x4v*)(BG + j * LD64 + cq * 16 + 8) = pre.b1;
          *(LDSP u32x4v*)(CG + j * LD64 + cq * 16) = pre.c0; *(LDSP u32x4v*)(CG + j * LD64 + cq * 16 + 8) = pre.c1;
          *(LDSP u32x4v*)(HF + (tid >> 3) * LD64 + (tid & 7) * 8) = pre.hf; *(LDSP u32x4v*)(HB + (tid >> 3) * LD64 + (tid & 7) * 8) = pre.hb;
          if (tid < 128) SC[tid] = pre.sc; }
        if (it + GS_ < nit) s3_ssd_load(p, s3_tile(l, (it + GS_) >> 3), (it + GS_) & 7, tid, i, G, pre);
        __syncthreads();
        u32x2v zr[4];
#pragma unroll
        for (int pt = 0; pt < 4; ++pt) zr[pt] = *(const u32x2v*)(p.PROJ + (size_t)(tok0 + i) * LDP + OFF_Z + h * 64 + 16 * pt + 4 * G);
        const f32x4v sci = SC[i];
        {
            f32x4v am[8];
#pragma unroll
            for (int ut = 0; ut < 8; ++ut) am[ut] = (f32x4v){0.f, 0.f, 0.f, 0.f};
#pragma unroll
            for (int ks = 0; ks < 2; ++ks) { const bf16x8v vfr = frag_row(CG, LD64, 16 * w, 32 * ks, lane);
#pragma unroll
                for (int ut = 0; ut < 8; ++ut) am[ut] = mfma16(frag_row(BG, LD64, 16 * ut, 32 * ks, lane), vfr, am[ut]); }
#pragma unroll
            for (int ut = 0; ut < 8; ++ut) { f32x4v m;
#pragma unroll
                for (int r = 0; r < 4; ++r) { const int jj = 16 * ut + 4 * G + r; const f32x4v scj = SC[jj];
                    const float Lf = jj <= i ? __builtin_amdgcn_exp2f(fminf(sci.x - scj.y, 30.f)) : 0.f, Lb = jj >= i ? __builtin_amdgcn_exp2f(fminf(sci.z - scj.w, 30.f)) : 0.f;
                    m[r] = am[ut][r] * (Lf + Lb); }
                *(LDSP u32x2v*)(MM + i * LD128 + 16 * ut + 4 * G) = pack4(m); }
        }
        asm volatile("s_waitcnt lgkmcnt(0)" ::: "memory");
        f32x4v ay[4], af_[4], ab_[4];
#pragma unroll
        for (int pt = 0; pt < 4; ++pt) { ay[pt] = (f32x4v){0.f, 0.f, 0.f, 0.f}; af_[pt] = ay[pt]; ab_[pt] = ay[pt]; }
#pragma unroll
        for (int ks = 0; ks < 2; ++ks) { const bf16x8v vfr = frag_row(CG, LD64, 16 * w, 32 * ks, lane);
#pragma unroll
            for (int pt = 0; pt < 4; ++pt) { af_[pt] = mfma16(frag_row(HF, LD64, 16 * pt, 32 * ks, lane), vfr, af_[pt]); ab_[pt] = mfma16(frag_row(HB, LD64, 16 * pt, 32 * ks, lane), vfr, ab_[pt]); } }
#pragma unroll
        for (int ks = 0; ks < 4; ++ks) { const bf16x8v vfr = frag_row(MM, LD128, 16 * w, 32 * ks, lane);
#pragma unroll
            for (int pt = 0; pt < 4; ++pt) ay[pt] = mfma16(frag_col(XH, LD64, 16 * pt, 32 * ks, lane), vfr, ay[pt]); }
        const float sf = __builtin_amdgcn_exp2f(sci.x), sb = __builtin_amdgcn_exp2f(sci.z), dsk = p.d_skip[l * 8 + h];
        float ssq = 0.f;
#pragma unroll
        for (int pt = 0; pt < 4; ++pt) { const int pc = 16 * pt + 4 * G;
            const u32x2v xr = *(LDSP const u32x2v*)(XH + i * LD64 + pc);
            const float xv[4] = {__uint_as_float(xr.x << 16), __uint_as_float(xr.x & 0xffff0000u), __uint_as_float(xr.y << 16), __uint_as_float(xr.y & 0xffff0000u)};
            const float zv[4] = {__uint_as_float(zr[pt].x << 16), __uint_as_float(zr[pt].x & 0xffff0000u), __uint_as_float(zr[pt].y << 16), __uint_as_float(zr[pt].y & 0xffff0000u)};
            float yv[4];
#pragma unroll
            for (int r = 0; r < 4; ++r) { yv[r] = (ay[pt][r] + sf * af_[pt][r] + sb * ab_[pt][r] + dsk * xv[r]) * siluf(zv[r]); yv[r] = bf2f(f2bf(yv[r])); ssq += yv[r] * yv[r]; }
            *(u32x2v*)(p.H + (size_t)(tok0 + i) * D + h * 64 + pc) = mk2(pk2(yv[0], yv[1]), pk2(yv[2], yv[3])); }
        ssq += shx(ssq, 16, lane); ssq += shx(ssq, 32, lane);
        if (G == 0) p.SSQ[(size_t)(tok0 + i) * 8 + h] = ssq;
    }
}
struct GlaPre { u32x4v qk[2][4], vv[4], sf[2], sb[2]; };
DI void s3_gla_load(const P& p, int tl, int h, int tid, int i, int G, GlaPre& r) {
    const int tok0 = tile_tok0(tl);
#pragma unroll
    for (int q = 0; q < 2; ++q) { const int c = tid + q * NTHR, rr = c >> 3, cc = c & 7; const bf16_t* qb = p.QKB + (size_t)(tok0 + rr) * 1024 + h * 64 + cc * 8;
        r.qk[q][0] = *(const u32x4v*)qb; r.qk[q][1] = *(const u32x4v*)(qb + 256);
        r.qk[q][2] = *(const u32x4v*)(qb + 512); r.qk[q][3] = *(const u32x4v*)(qb + 768);
        const bf16_t* Sg = p.GS + (size_t)((tl * 4 + h) * 2 + 0) * 8192 + (size_t)rr * 64 + cc * 8; r.sf[q] = *(const u32x4v*)Sg; r.sb[q] = *(const u32x4v*)(Sg + 8192); }
#pragma unroll
    for (int q = 0; q < 4; ++q) { const int c = tid + q * NTHR, rr = c >> 4, cc = c & 15; r.vv[q] = *(const u32x4v*)(p.PROJ + (size_t)(tok0 + rr) * LDP + OFF_V + h * 128 + cc * 8); }
}
DI void ph_s3_gla(const P& p, int l, LDSP unsigned char* lds) {
    const int tid = ltid(), lane = tid & 63, w = __builtin_amdgcn_readfirstlane(tid >> 6), G = lane >> 4, li = lane & 15, i = 16 * w + li;
    LDSP bf16_t* Q2 = (LDSP bf16_t*)lds;
    LDSP bf16_t* KF = Q2 + 8 * 2 * 16 * LD64; LDSP bf16_t* KB = KF + 128 * LD64; LDSP bf16_t* VT = KB + 128 * LD64; LDSP bf16_t* SF = VT + 128 * LD128; LDSP bf16_t* SB = SF + 128 * LD64;
    LDSP bf16_t* AMw = SF + w * 16 * LD128;
    const int nit = (l == 0 ? NTILE : NB * 32) * 4, GS_ = gridDim.x;
    int it = blockIdx.x; GlaPre pre;
    if (it < nit) s3_gla_load(p, s3_tile(l, it >> 2), it & 3, tid, i, G, pre);
    for (; it < nit; it += GS_) {
        const int tl = s3_tile(l, it >> 2), h = it & 3, tok0 = tile_tok0(tl);
        __syncthreads();
#pragma unroll
        for (int q = 0; q < 2; ++q) { const int c = tid + q * NTHR, rr = c >> 3, cc = c & 7; LDSP bf16_t* qrow = Q2 + (rr >> 4) * (2 * 16 * LD64) + (rr & 15) * LD64 + cc * 8;
            *(LDSP u32x4v*)qrow = pre.qk[q][0]; *(LDSP u32x4v*)(qrow + 16 * LD64) = pre.qk[q][2];
            *(LDSP u32x4v*)(KF + rr * LD64 + cc * 8) = pre.qk[q][1]; *(LDSP u32x4v*)(KB + rr * LD64 + cc * 8) = pre.qk[q][3];
            *(LDSP u32x4v*)(SF + rr * LD64 + cc * 8) = pre.sf[q]; *(LDSP u32x4v*)(SB + rr * LD64 + cc * 8) = pre.sb[q]; }
#pragma unroll
        for (int q = 0; q < 4; ++q) { const int c = tid + q * NTHR, rr = c >> 4, cc = c & 15; *(LDSP u32x4v*)(VT + rr * LD128 + cc * 8) = pre.vv[q]; }
        if (it + GS_ < nit) s3_gla_load(p, s3_tile(l, (it + GS_) >> 2), (it + GS_) & 3, tid, i, G, pre);
        __syncthreads();
        f32x4v ao[8];
#pragma unroll
        for (int q = 0; q < 8; ++q) ao[q] = (f32x4v){0.f, 0.f, 0.f, 0.f};
        bf16x8v qfr[2][2];
#pragma unroll
        for (int dir = 0; dir < 2; ++dir)
#pragma unroll
            for (int ks = 0; ks < 2; ++ks) qfr[dir][ks] = frag_row(Q2 + w * (2 * 16 * LD64) + dir * 16 * LD64, LD64, 0, 32 * ks, lane);
#pragma unroll
        for (int dir = 0; dir < 2; ++dir) {
            LDSP const bf16_t* SS_ = dir ? SB : SF;
#pragma unroll
            for (int ks = 0; ks < 2; ++ks) {
#pragma unroll
                for (int vt = 0; vt < 8; ++vt) ao[vt] = mfma16(frag_row(SS_, LD64, 16 * vt, 32 * ks, lane), qfr[dir][ks], ao[vt]); }
        }
        __syncthreads();
#pragma unroll
        for (int uh = 0; uh < 4; ++uh) {
            f32x4v a2[2]; a2[0] = (f32x4v){0.f, 0.f, 0.f, 0.f}; a2[1] = a2[0];
#pragma unroll
            for (int dir = 0; dir < 2; ++dir) {
                LDSP const bf16_t* KS = dir ? KB : KF;
                f32x4v as[2]; as[0] = (f32x4v){0.f, 0.f, 0.f, 0.f}; as[1] = as[0];
#pragma unroll
                for (int ks = 0; ks < 2; ++ks) {
#pragma unroll
                    for (int q = 0; q < 2; ++q) as[q] = mfma16(frag_row(KS, LD64, 16 * (2 * uh + q), 32 * ks, lane), qfr[dir][ks], as[q]); }
#pragma unroll
                for (int q = 0; q < 2; ++q)
#pragma unroll
                    for (int r = 0; r < 4; ++r) { const int jj = 16 * (2 * uh + q) + 4 * G + r; const bool keep = dir == 0 ? (jj <= i) : (jj >= i); a2[q][r] += keep ? as[q][r] : 0.f; }
            }
#pragma unroll
            for (int q = 0; q < 2; ++q) *(LDSP u32x2v*)(AMw + li * LD128 + 16 * (2 * uh + q) + 4 * G) = pack4(a2[q]);
        }
        u32x2v gr[8];
#pragma unroll
        for (int vt = 0; vt < 8; ++vt) gr[vt] = *(const u32x2v*)(p.PROJ + (size_t)(tok0 + i) * LDP + OFF_GO + h * 128 + 16 * vt + 4 * G);
        asm volatile("s_waitcnt lgkmcnt(0)" ::: "memory");
#pragma unroll
        for (int ks = 0; ks < 4; ++ks) { const bf16x8v vfr = frag_row(AMw, LD128, 0, 32 * ks, lane);
#pragma unroll
            for (int vt = 0; vt < 8; ++vt) ao[vt] = mfma16(frag_col(VT, LD128, 16 * vt, 32 * ks, lane), vfr, ao[vt]); }
        float so = 0.f;
#pragma unroll
        for (int vt = 0; vt < 8; ++vt)
#pragma unroll
            for (int r = 0; r < 4; ++r) so += ao[vt][r] * ao[vt][r];
        so += shx(so, 16, lane); so += shx(so, 32, lane);
        const float ro = rsqrtf(so * (1.0f / 128.0f) + 1e-6f);
#pragma unroll
        for (int vt = 0; vt < 8; ++vt) { const int vc = 16 * vt + 4 * G; const f32x4v gg = *(const f32x4v*)(p.gla_norm_g + l * 128 + vc);
            const float g0 = __uint_as_float(gr[vt].x << 16), g1 = __uint_as_float(gr[vt].x & 0xffff0000u), g2 = __uint_as_float(gr[vt].y << 16), g3 = __uint_as_float(gr[vt].y & 0xffff0000u);
            *(u32x2v*)(p.H + (size_t)(tok0 + i) * D + 512 + h * 128 + vc) = mk2(pk2(ao[vt][0] * ro * gg.x * siluf(g0), ao[vt][1] * ro * gg.y * siluf(g1)), pk2(ao[vt][2] * ro * gg.z * siluf(g2), ao[vt][3] * ro * gg.w * siluf(g3))); }
    }
}
DI void ph_s3(const P& p, int l, LDSP unsigned char* lds) { ph_s3_gla(p, l, lds); ph_s3_ssd(p, l, lds); }
DI void ph_normroute(const P& p, int l, int t0, LDSP unsigned char* lds) {
    const int tid_ = ltid(), lane = tid_ & 63, wv = tid_ >> 6, gw = blockIdx.x * NWV + wv, NW = gridDim.x * NWV, G = lane >> 4, li = lane & 15;
    const float* MODl = p.MOD + (size_t)l * 9 * 6144; int* counts = p.counts + l * 32 * 32;
    constexpr int LDW = 1032, LDT = 264;
    LDSP bf16_t* WR = (LDSP bf16_t*)lds;
    LDSP bf16_t* HT = WR + 32 * LDW + wv * 16 * LDT;
    { u32x4v wv_[8];
#pragma unroll
      for (int q = 0; q < 8; ++q) wv_[q] = *(const u32x4v*)(p.WRT + (size_t)(tid_ + q * NTHR) * 8);
#pragma unroll
      for (int q = 0; q < 8; ++q) { const int c = tid_ + q * NTHR; *(LDSP u32x4v*)(WR + (c >> 7) * LDW + (c & 127) * 8) = wv_[q]; } }
    __syncthreads();
    const int ntile = (T - t0) >> 4;
    const float* g2 = p.norm2_g + l * D;
    for (int tile = gw; tile < ntile; tile += NW) {
        const int tb = t0 + tile * 16;
        const float* mr = MODl + (size_t)tok_modrow(tb) * 6144;
        float rs[16];
        { const f32x4v* q = (const f32x4v*)(p.XSS + (size_t)(tb + li) * 16); const f32x4v a = q[0], b = q[1], c = q[2], d = q[3];
          const float ss = (((a.x + a.y) + (a.z + a.w)) + ((b.x + b.y) + (b.z + b.w))) + (((c.x + c.y) + (c.z + c.w)) + ((d.x + d.y) + (d.z + d.w)));
          const float r = rsqrtf(ss * (1.0f / D) + 1e-6f);
#pragma unroll
          for (int i = 0; i < 16; ++i) rs[i] = shl(r, i); }
        f32x4v acc[2]; acc[0] = (f32x4v){0.f, 0.f, 0.f, 0.f}; acc[1] = acc[0];
        u32x2v xq[16];
#pragma unroll
        for (int i = 0; i < 16; ++i) xq[i] = *(const u32x2v*)(xrow(p, tb + i) + lane * 4);
#pragma unroll
        for (int kc = 0; kc < 4; ++kc) {
            const int kk = kc * 256 + lane * 4;
            const f32x4v gg = *(const f32x4v*)(g2 + kk), sh = *(const f32x4v*)(mr + 3 * 1024 + kk), sc = *(const f32x4v*)(mr + 4 * 1024 + kk);
            f32x4v gs;
#pragma unroll
            for (int j = 0; j < 4; ++j) gs[j] = gg[j] * (1.f + sc[j]);
#pragma unroll
            for (int i = 0; i < 16; ++i) { const u32x2v r = xq[i];
                const f32x4v xv = mkf4(__uint_as_float(r.x << 16), __uint_as_float(r.x & 0xffff0000u), __uint_as_float(r.y << 16), __uint_as_float(r.y & 0xffff0000u));
                const f32x4v h = xv * rs[i] * gs + sh; const u32x2v hb = pack4(h);
                *(u32x2v*)(p.H + (size_t)(tb + i) * D + kk) = hb; *(LDSP u32x2v*)(HT + i * LDT + lane * 4) = hb; }
            if (kc < 3) {
#pragma unroll
                for (int i = 0; i < 16; ++i) xq[i] = *(const u32x2v*)(xrow(p, tb + i) + kk + 256); }
            asm volatile("s_waitcnt lgkmcnt(0)" ::: "memory");
#pragma unroll
            for (int ks = 0; ks < 8; ++ks) { const bf16x8v vfr = frag_row(HT, LDT, 0, 32 * ks, lane);
                acc[0] = mfma16(frag_row(WR, LDW, 0, kc * 256 + 32 * ks, lane), vfr, acc[0]);
                acc[1] = mfma16(frag_row(WR, LDW, 16, kc * 256 + 32 * ks, lane), vfr, acc[1]); }
            asm volatile("s_waitcnt lgkmcnt(0)" ::: "memory");
        }
        float bgs = -1e30f; int bgi = 0, e1 = 0, e2 = 0; float w1 = 0.f, w2 = 0.f;
#pragma unroll
        for (int ut = 0; ut < 2; ++ut) { const int gi = ut * 4 + G; float m1 = -1e30f, m2 = -1e30f, s1 = 0.f, s2 = 0.f; int i1 = 0, i2 = 0;
#pragma unroll
            for (int r = 0; r < 4; ++r) { const float sv = 1.0f / (1.0f + __expf(-acc[ut][r])), vv = sv + p.router_bias[gi * 4 + r];
                if (vv > m1) { m2 = m1; i2 = i1; s2 = s1; m1 = vv; i1 = gi * 4 + r; s1 = sv; } else if (vv > m2) { m2 = vv; i2 = gi * 4 + r; s2 = sv; } }
            if (m1 + m2 > bgs) { bgs = m1 + m2; bgi = gi; e1 = i1; e2 = i2; w1 = s1; w2 = s2; } }
#pragma unroll
        for (int o = 16; o <= 32; o <<= 1) {
            const float ogs = shx(bgs, o, lane), ow1 = shx(w1, o, lane), ow2 = shx(w2, o, lane); const int ogi = shxi(bgi, o, lane), oe1 = shxi(e1, o, lane), oe2 = shxi(e2, o, lane);
            if (ogs > bgs || (ogs == bgs && ogi < bgi)) { bgs = ogs; bgi = ogi; e1 = oe1; e2 = oe2; w1 = ow1; w2 = ow2; } }
        if (G == 0) {
            const int t = tb + li; const float inv = 1.0f / (w1 + w2);
            const int r1 = atomicAdd(&counts[e1 * 32], 1), r2 = atomicAdd(&counts[e2 * 32], 1);
            p.MAP[(size_t)e1 * T + r1] = t; p.MAP[(size_t)e2 * T + r2] = t;
            p.TOKSLOT[t * 4 + 0] = e1; p.TOKSLOT[t * 4 + 1] = r1; p.TOKSLOT[t * 4 + 2] = e2; p.TOKSLOT[t * 4 + 3] = r2;
            p.EW[t * 2 + 0] = w1 * inv; p.EW[t * 2 + 1] = w2 * inv;
        }
    }
}

DI void ph_combine(const P& p, int l, int t0, const unsigned char* Y  , LDSP int* ps  ) {
    const int tid_ = ltid(), lane = tid_ & 63, gw = blockIdx.x * NWV + (tid_ >> 6), NW = gridDim.x * NWV;
    const float* MODl = p.MOD + (size_t)l * 9 * 6144; const int* counts = p.counts + l * 32 * 32;
    if (tid_ < 64) { const int cnt = tid_ < 32 ? counts[tid_ * 32] : 0; int pc = cnt;
#pragma unroll
        for (int o = 1; o < 32; o <<= 1) { const int src = lane >= o ? lane - o : lane; const int a = shli(pc, src); if (lane >= o) pc += a; }
        if (tid_ < 32) ps[tid_] = pc - cnt; }
    __syncthreads();
    for (int t = t0 + 4 * gw; t < T; t += 4 * NW) {
        int4 sl[4]; float4 ew[2];
#pragma unroll
        for (int u = 0; u < 4; ++u) sl[u] = *(const int4*)(p.TOKSLOT + (size_t)(t + u) * 4);
        ew[0] = *(const float4*)(p.EW + (size_t)t * 2); ew[1] = *(const float4*)(p.EW + (size_t)(t + 2) * 2);
        unsigned yr[4][2][4];
#pragma unroll
        for (int u = 0; u < 4; ++u) { const unsigned char* y0 = Y + (size_t)(ps[sl[u].x] + sl[u].y) * D; const unsigned char* y1 = Y + (size_t)(ps[sl[u].z] + sl[u].w) * D;
#pragma unroll
            for (int i = 0; i < 4; ++i) { yr[u][0][i] = *(const unsigned*)(y0 + (i * 64 + lane) * 4); yr[u][1][i] = *(const unsigned*)(y1 + (i * 64 + lane) * 4); } }
        const float* mrow = MODl + (size_t)tok_modrow(t) * 6144; const float* g5 = mrow + 5 * 1024;
        const float* mr1 = p.MOD + (size_t)9 * 6144 + (size_t)tok_modrow(t) * 6144;
#pragma unroll
        for (int pr = 0; pr < 2; ++pr) {
            const float wgt[2][2] = {{ew[pr].x, ew[pr].y}, {ew[pr].z, ew[pr].w}};
            u32x2v xr[2][4];
#pragma unroll
            for (int u = 0; u < 2; ++u)
#pragma unroll
                for (int i = 0; i < 4; ++i) xr[u][i] = *(const u32x2v*)(xrow(p, t + 2 * pr + u) + (i * 64 + lane) * 4);
            float4 v[2][4];
#pragma unroll
            for (int i = 0; i < 4; ++i) { const int c = (i * 64 + lane) * 4; const float4 gg = *(const float4*)(g5 + c);
#pragma unroll
                for (int u = 0; u < 2; ++u) { const u32x2v x = xr[u][i]; const int a = (int)yr[2 * pr + u][0][i], b = (int)yr[2 * pr + u][1][i]; const float w1 = wgt[u][0], w2 = wgt[u][1];
                    v[u][i].x = __uint_as_float(x.x << 16) + gg.x * (w1 * __builtin_amdgcn_cvt_f32_fp8(a, 0) + w2 * __builtin_amdgcn_cvt_f32_fp8(b, 0));
                    v[u][i].y = __uint_as_float(x.x & 0xffff0000u) + gg.y * (w1 * __builtin_amdgcn_cvt_f32_fp8(a, 1) + w2 * __builtin_amdgcn_cvt_f32_fp8(b, 1));
                    v[u][i].z = __uint_as_float(x.y << 16) + gg.z * (w1 * __builtin_amdgcn_cvt_f32_fp8(a, 2) + w2 * __builtin_amdgcn_cvt_f32_fp8(b, 2));
                    v[u][i].w = __uint_as_float(x.y & 0xffff0000u) + gg.w * (w1 * __builtin_amdgcn_cvt_f32_fp8(a, 3) + w2 * __builtin_amdgcn_cvt_f32_fp8(b, 3));
                    if (l == 0) *(u32x2v*)(xrow(p, t + 2 * pr + u) + c) = mk2(pk2(v[u][i].x, v[u][i].y), pk2(v[u][i].z, v[u][i].w)); } }
            float rstd[2];
#pragma unroll
            for (int u = 0; u < 2; ++u) { float ss = 0.f;
#pragma unroll
                for (int i = 0; i < 4; ++i) ss += v[u][i].x * v[u][i].x + v[u][i].y * v[u][i].y + v[u][i].z * v[u][i].z + v[u][i].w * v[u][i].w;
                rstd[u] = rsqrtf(wave_sum(ss, lane) * (1.0f / D) + 1e-6f); }
            if (l == 0) {
#pragma unroll
                for (int i = 0; i < 4; ++i) { const int c = (i * 64 + lane) * 4;
                    const float4 gg = *(const float4*)(p.norm1_g + D + c), sh = *(const float4*)(mr1 + c), sc = *(const float4*)(mr1 + 1024 + c);
#pragma unroll
                    for (int u = 0; u < 2; ++u) { const float r = rstd[u];
                        *(u32x2v*)(p.H + (size_t)(t + 2 * pr + u) * D + c) = mk2(pk2(v[u][i].x * r * gg.x * (1.f + sc.x) + sh.x, v[u][i].y * r * gg.y * (1.f + sc.y) + sh.y), pk2(v[u][i].z * r * gg.z * (1.f + sc.z) + sh.z, v[u][i].w * r * gg.w * (1.f + sc.w) + sh.w)); } }
            } else {
#pragma unroll
                for (int u = 0; u < 2; ++u)
#pragma unroll
                    for (int i = 0; i < 4; ++i) { const float4 gg = ((const float4*)p.final_g)[i * 64 + lane]; const float r = rstd[u];
                        ((float4*)(p.out + (size_t)(t + 2 * pr + u - TC) * D))[i * 64 + lane] = make_float4(v[u][i].x * r * gg.x, v[u][i].y * r * gg.y, v[u][i].z * r * gg.z, v[u][i].w * r * gg.w); }
            }
        }
    }
}

#define XLAS __attribute__((address_space(3)))
#define XB_TMO      128
#define XB_XCNT(j)  (256  + 64 * (j))
#define XB_XSUB(j)  (1280 + 64 * (j))
#define XB_XGEN(j)  (2304 + 64 * (j))
#define XB_TOP      3328
#define XB_TOPGEN   3392
#define XCD_BAR_WORDS 3456
#define XB_SPIN_CAP (1u << 18)

__device__ __forceinline__ unsigned xb_ld(unsigned* p)              { return __hip_atomic_load(p, __ATOMIC_RELAXED, __HIP_MEMORY_SCOPE_AGENT); }
__device__ __forceinline__ unsigned xb_add(unsigned* p, unsigned v) { return __hip_atomic_fetch_add(p, v, __ATOMIC_RELAXED, __HIP_MEMORY_SCOPE_AGENT); }
__device__ __forceinline__ unsigned xb_xcc_id() { return (unsigned)__builtin_amdgcn_s_getreg((3 << 11) | 20) & 0xFu; }
#define XB_SPIN(cond, bar) do { unsigned _sp = 0; while (cond) { __builtin_amdgcn_s_sleep(1); \
    if ((++_sp & 255u) == 0u) { if (xb_ld(&(bar)[XB_TMO])) break; if (_sp > XB_SPIN_CAP) { atomicAdd(&(bar)[XB_TMO], 1u); break; } } } } while (0)

struct XcdBarrier {
    unsigned* bar; unsigned x;
    volatile XLAS unsigned* st;
};

__device__ __forceinline__ XcdBarrier xcd_barrier_post(unsigned* bar, volatile XLAS unsigned* st) {
    XcdBarrier b; b.bar = bar; b.x = xb_xcc_id(); b.st = st;
    if (ltid() == 0) (void)xb_add(&bar[XB_XCNT(b.x)], 1u);
    return b;
}
__device__ __forceinline__ void xcd_barrier_complete(unsigned* bar, unsigned x, unsigned& nloc, unsigned& nx) {
    const unsigned G = gridDim.x * gridDim.y * gridDim.z;
    unsigned sum, cnt, mine, sp = 0u;
    for (;;) {
        sum = 0u; cnt = 0u; mine = 0u;
#pragma unroll
        for (unsigned j = 0; j < 16; ++j) { const unsigned c = xb_ld(&bar[XB_XCNT(j)]); sum += c; cnt += (c > 0u) ? 1u : 0u; mine = (j == x) ? c : mine; }
        if (sum == G) break;
        __builtin_amdgcn_s_sleep(1);
        if ((++sp & 255u) == 0u) { if (xb_ld(&bar[XB_TMO])) break; if (sp > XB_SPIN_CAP) { atomicAdd(&bar[XB_TMO], 1u); break; } }
    }
    nloc = mine > 0u ? mine : 1u; nx = cnt > 0u ? cnt : 1u;
}

__device__ __forceinline__ void xcd_barrier(const XcdBarrier& b) {
    asm volatile("s_waitcnt vmcnt(0)" ::: "memory");
    __syncthreads();
    if (ltid() == 0) {
        unsigned* bar = b.bar;
        __builtin_amdgcn_s_waitcnt(0);
        unsigned nloc = b.st[0], nx = b.st[1];
        if (nloc == 0u) { xcd_barrier_complete(bar, b.x, nloc, nx); b.st[0] = nloc; b.st[1] = nx; }
        const unsigned old = xb_add(&bar[XB_XSUB(b.x)], 1u);
        const unsigned gen = old / nloc;
        if (old + 1u == (gen + 1u) * nloc) {
            __builtin_amdgcn_fence(__ATOMIC_RELEASE, "agent");
            asm volatile("s_waitcnt vmcnt(0)" ::: "memory");
            const unsigned og = xb_add(&bar[XB_TOP], 1u);
            const unsigned tg = og / nx;
            if (og + 1u == (tg + 1u) * nx) xb_add(&bar[XB_TOPGEN], 1u);
            else XB_SPIN(xb_ld(&bar[XB_TOPGEN]) == tg, bar);
            __builtin_amdgcn_fence(__ATOMIC_ACQUIRE, "agent");
            xb_add(&bar[XB_XGEN(b.x)], 1u);
            asm volatile("s_waitcnt vmcnt(0)" ::: "memory");
        } else {
            XB_SPIN(xb_ld(&bar[XB_XGEN(b.x)]) == gen, bar);
            __builtin_amdgcn_fence(__ATOMIC_ACQUIRE, "agent");
            asm volatile("s_waitcnt vmcnt(0)" ::: "memory");
        }
    }
    __syncthreads();
}

DI void moe_table(const P& p, int l, PG8_LAS int* tab) {
    const int tid_ = ltid();
    if (tid_ < 64) { const int cnt = tid_ < 32 ? p.counts[(l * 32 + tid_) * 32] : 0; const int nt = (cnt + 255) >> 8; int pt = nt, pc = cnt;
#pragma unroll
        for (int o = 1; o < 32; o <<= 1) { const int ln_ = tid_ & 63, src = ln_ >= o ? ln_ - o : ln_; const int a = shli(pt, src), b = shli(pc, src); if (ln_ >= o) { pt += a; pc += b; } }
        if (tid_ < 32) { tab[tid_ + 1] = pt; tab[33 + tid_] = cnt; tab[65 + tid_] = pc - cnt; if (tid_ == 0) tab[0] = 0; } }
    __syncthreads();
}
typedef const __attribute__((address_space(4))) P* PK;
DI PK lp(PK q) { asm volatile("" : "+s"(q)); return q; }
#define PHASE(...) do { const P p = *(const P*)lp(pk); __VA_ARGS__; } while (0)

template <int l> DI void layer(PK pk, unsigned char* smem, const XcdBarrier& xbar) {
    float* ldsf = (float*)smem; const int gw = 0, NW = 0, lane = 0;
    {
        constexpr int NG = l == 0 ? 234 : 204;
        constexpr int CV1 = l == 0 ? 10 * 768 : NE * 768;
        const int G = (int)gridDim.x == 256 ? NG : (int)gridDim.x;
        if ((int)blockIdx.x < G) PHASE({ pg8::Gemm g{p.H, p.WinT + (size_t)l * NPAD_IN * D, T, NPAD_IN, D}; pg8::StaticOrder S; S.init(T, NPAD_IN, G, (int)blockIdx.x);
            pg8::EpiProj E{p.PROJ, LDP, INDIM};
            pg8::gemm_phase<pg8::EpiProj, pg8::StaticOrder>((PG8_LAS unsigned char*)smem, g, S, E, nullptr); });
        else PHASE(ph_convert_experts(p, l, ldsf, G, (int)gridDim.x - G, 0, CV1));
        if ((int)gridDim.x != 256) PHASE(ph_convert_experts(p, l, ldsf, 0, (int)gridDim.x, 0, CV1));
    }
    xcd_barrier(xbar);
    PHASE(ph_prep(p, l, (LDSP unsigned char*)smem));
    xcd_barrier(xbar);
    PHASE(ph_s1(p, l, (LDSP unsigned char*)smem));
    xcd_barrier(xbar);
    PHASE(ph_s2(p));
    xcd_barrier(xbar);
    PHASE(ph_s3(p, l, (LDSP unsigned char*)smem));
    xcd_barrier(xbar);
    {
        constexpr int ro = l == 0 ? 0 : TC;
        constexpr int NG = l == 0 ? 182 : 256;
        const int G = (int)gridDim.x == 256 ? NG : (int)gridDim.x;
        if ((int)blockIdx.x < G) PHASE({ pg8::Gemm g{p.H + (size_t)ro * D, p.WoutT + (size_t)l * D * D, T - ro, D, D}; pg8::StaticOrder S; S.init(T - ro, D, G, (int)blockIdx.x);
            pg8::EpiResGate<l != 0> E{p.SSQ, p.ctx, p.x, p.XB, p.MOD + (size_t)l * 9 * 6144 + 2 * 1024, p.XSS, ro};
            pg8::gemm_phase<pg8::EpiResGate<l != 0>, pg8::StaticOrder>((PG8_LAS unsigned char*)smem, g, S, E, nullptr); });
        else if (l == 0) PHASE(ph_convert_experts(p, l, ldsf, G, (int)gridDim.x - G, 10 * 768, NE * 768));
        if (l == 0 && (int)gridDim.x != 256) PHASE(ph_convert_experts(p, l, ldsf, 0, (int)gridDim.x, 10 * 768, NE * 768));
    }
    xcd_barrier(xbar);
    const int t0 = l == 0 ? 0 : TC;
    PHASE(ph_normroute(p, l, t0, (LDSP unsigned char*)smem));
    xcd_barrier(xbar);
    PG8_LAS int* tab = (PG8_LAS int*)((PG8_LAS unsigned char*)smem + pg8::STAGE_BYTES);
#pragma unroll
    for (int ph = 0; ph < 2; ++ph) {
        PHASE(moe_table(p, l, tab));
        const int U = __builtin_amdgcn_readfirstlane(tab[32]) * 4;
        if (ph == 0) PHASE({ pg8::Gemm g{p.H, p.WguT, T, D, D}; pg8::MoeSched S{tab, p.MAP, U, (int)gridDim.x, (int)blockIdx.x, 4, 1, (size_t)D * D * 2};
            pg8::EpiAct E{p.SS}; pg8::gemm_phase_moe<pg8::EpiAct, pg8::MoeSched>((PG8_LAS unsigned char*)smem, g, S, E, nullptr); });
        else PHASE({ pg8::Gemm g{p.SS, p.WdT, T, D, 512}; pg8::MoeSched S{tab, p.MAP, U, (int)gridDim.x, (int)blockIdx.x, 4, 0, (size_t)D * 512 * 2};
            pg8::EpiY E{(unsigned char*)p.PROJ}; pg8::gemm_phase_moe<pg8::EpiY, pg8::MoeSched>((PG8_LAS unsigned char*)smem, g, S, E, nullptr); });
        xcd_barrier(xbar);
    }
    PHASE(ph_combine(p, l, t0, (const unsigned char*)p.PROJ, (LDSP int*)smem));
    xcd_barrier(xbar);
}

__global__ void __launch_bounds__(NTHR) mega(P p_arg) {
    extern __shared__ __attribute__((aligned(16))) unsigned char smem[];
    cg::grid_group grid = cg::this_grid();
    PK pk = (PK)__builtin_amdgcn_kernarg_segment_ptr();
    const int lane = 0, gw = 0, NW = 0;
    float* ldsf = (float*)smem;
    volatile XLAS unsigned* bst = (volatile XLAS unsigned*)((XLAS unsigned char*)smem + LDS_BYTES - 16);
    { const int t_ = ltid(); if (t_ < 2) bst[t_] = 0u; }
    __syncthreads();
    const XcdBarrier xbar = xcd_barrier_post(pk->BAR, bst);
    PHASE(ph_init(p)); PHASE(ph_mod(p, ldsf)); PHASE(ph_convert_small(p, ldsf, gw, NW, lane));
    grid.sync();
    PHASE(ph_normmod1(p, 0, gw, NW, lane));
    xcd_barrier(xbar);
    layer<0>(pk, smem, xbar);
    layer<1>(pk, smem, xbar);
}

static inline size_t al(size_t x) { return (x + 255) & ~(size_t)255; }

extern "C" void kernel_launch(void* const* d_in, const int* in_sizes, int n_in, void* d_out, int out_size, void* d_ws, size_t ws_size, hipStream_t stream) {
    static int grid_blocks = 0;
    if (grid_blocks == 0) {
        int dev = 0, cus = 0, per_cu = 0;
        if (hipFuncSetAttribute((const void*)mega, hipFuncAttributeMaxDynamicSharedMemorySize, LDS_BYTES) != hipSuccess) { fprintf(stderr, "hipFuncSetAttribute failed\n"); grid_blocks = -1; return; }
        (void)hipGetDevice(&dev); (void)hipDeviceGetAttribute(&cus, hipDeviceAttributeMultiprocessorCount, dev);
        if (hipOccupancyMaxActiveBlocksPerMultiprocessor(&per_cu, (const void*)mega, NTHR, LDS_BYTES) != hipSuccess || per_cu < 1) { fprintf(stderr, "occupancy query: %d blocks/CU\n", per_cu); grid_blocks = -1; return; }
        grid_blocks = cus;
    }
    if (grid_blocks < 0) return;
    P p{};
    const float** pin = (const float**)&p;
    for (int i = 0; i < 29; ++i) pin[i] = (const float*)d_in[i];
    p.out = (float*)d_out;
    char* ws = (char*)d_ws; size_t off = 0;
    auto take = [&](size_t bytes) { char* q = ws + off; off += al(bytes); return q; };
    p.XB = (bf16_t*)take((size_t)T * D * 2);
    p.H = (bf16_t*)take((size_t)T * D * 2);
    p.PROJ = (bf16_t*)take((size_t)T * LDP * 2);
    p.SS = (bf16_t*)take((size_t)NTILE * 8 * 2 * 4096 * 2);
    p.GS = (bf16_t*)take((size_t)NTILE * 4 * 2 * 8192 * 2);
    p.SDEC = (float*)take((size_t)NTILE * 8 * 2 * 4);
    p.GDEC = (float*)take((size_t)NTILE * 4 * 2 * 64 * 4);
    p.MOD = (float*)take((size_t)2 * 9 * 6144 * 4);
    p.counts = (int*)take(64 * 32 * 4);
    p.TOKSLOT = (int*)take((size_t)T * 4 * 4);
    p.EW = (float*)take((size_t)T * 2 * 4);
    p.MAP = (int*)take((size_t)NE * T * 4);
    p.WinT = (bf16_t*)take((size_t)2 * NPAD_IN * D * 2);
    p.WoutT = (bf16_t*)take((size_t)2 * D * D * 2);
    p.WguT = (bf16_t*)take((size_t)NE * D * D * 2);
    p.WdT = (bf16_t*)take((size_t)NE * D * 512 * 2);
    p.WRT = (bf16_t*)take((size_t)32 * 1024 * 2);
    p.BAR = (unsigned*)take(XCD_BAR_WORDS * 4);
    p.XBCC = (bf16_t*)d_out;
    p.QKB = (bf16_t*)d_out + (size_t)T * 768;
    p.SSC = (float*)take((size_t)T * 8 * 4 * 4);
    p.STOT = (float*)take((size_t)NTILE * 8 * 2 * 4);
    p.SSQ = (float*)take((size_t)T * 8 * 4);
    p.XSS = (float*)take((size_t)T * 16 * 4);
    if (off > ws_size) { fprintf(stderr, "workspace too small: need %zu have %zu\n", off, ws_size); return; }
    if (hipMemsetAsync(p.BAR, 0, XCD_BAR_WORDS * 4, stream) != hipSuccess) { fprintf(stderr, "memset of barrier words failed\n"); return; }
    void* args[] = {&p};
    hipError_t e = hipLaunchCooperativeKernel((void*)mega, dim3(grid_blocks), dim3(NTHR), args, LDS_BYTES, stream);
    if (e != hipSuccess) fprintf(stderr, "cooperative launch failed: %s (grid %d)\n", hipGetErrorString(e), grid_blocks);
}
```

```cpp
#include <hip/hip_runtime.h>
#include <hip/hip_cooperative_groups.h>
#include <stdint.h>
#include <cstdio>
namespace cg = cooperative_groups;

typedef unsigned short bf16_t;
#define DI __device__ __forceinline__

constexpr int D = 1024, NB = 8, SEQ = 4096, CTXL = 256, TC = NB * CTXL, TL = NB * SEQ, T = TC + TL;
constexpr int INDIM = 2840, LDP = 2848;
constexpr int OFF_Z = 0, OFF_XBC = 512, OFF_DT = 1280, OFF_Q = 1288, OFF_K = 1544, OFF_V = 1800, OFF_GO = 2312, OFF_GK = 2824;
constexpr int NE = 32;

DI float bf2f(bf16_t v) { return __uint_as_float(((unsigned)v) << 16); }
typedef float f32x2v_ __attribute__((ext_vector_type(2)));
typedef __bf16 bf16x2v_ __attribute__((ext_vector_type(2)));
DI bf16_t f2bf(float f) { return __builtin_bit_cast(unsigned short, (__bf16)f); }
DI float siluf(float x) { return x * __builtin_amdgcn_rcpf(1.0f + __builtin_amdgcn_exp2f(-1.4426950408889634f * x)); }
DI float softplusf(float x) { return fmaxf(x, 0.f) + log1pf(__expf(-fabsf(x))); }
DI float logsigmoidf(float x) { return -softplusf(-x); }
DI float shx(float v, int o, int lane) { return __int_as_float(__builtin_amdgcn_ds_bpermute((lane ^ o) << 2, __float_as_int(v))); }
DI int shxi(int v, int o, int lane) { return __builtin_amdgcn_ds_bpermute((lane ^ o) << 2, v); }
DI float shl(float v, int src) { return __int_as_float(__builtin_amdgcn_ds_bpermute(src << 2, __float_as_int(v))); }
DI int shli(int v, int src) { return __builtin_amdgcn_ds_bpermute(src << 2, v); }
DI float wave_sum(float v, int lane) {
#pragma unroll
    for (int o = 32; o >= 1; o >>= 1) v += shx(v, o, lane);
    return v;
}
DI int ltid() { const int wv = __builtin_amdgcn_readfirstlane(threadIdx.x >> 6);
    int t = wv * 64 + (int)__builtin_amdgcn_mbcnt_hi(~0u, __builtin_amdgcn_mbcnt_lo(~0u, 0u)); asm volatile("" : "+v"(t)); return t; }
DI int tok_modrow(int t) { return t < TC ? 8 : ((t - TC) >> 12); }
template <class PT> DI bf16_t* xrow(const PT& p, int t) { return p.XB + (size_t)t * D; }


#ifndef PG8_SP2
#define PG8_SP2 true
#endif
namespace pg8 {
#define PG8_LAS __attribute__((address_space(3)))
typedef unsigned short bf16_t;
typedef short bf16x8 __attribute__((ext_vector_type(8)));
typedef float f32x4 __attribute__((ext_vector_type(4)));
typedef unsigned u32x4 __attribute__((ext_vector_type(4)));
constexpr int BM = 256, BK = 64, HALF = 128, HTB = HALF * BK * 2  , STAGE_BYTES = 8 * HTB, NXCD = 8, WGM = 8;

__host__ __device__ __forceinline__ int lds_byte(int r, int c) { const int st = (r >> 4) * 2 + (c >> 5), rr = r & 15, cc = c & 31, ob = rr * 64 + cc * 2; return st * 1024 + (ob ^ (((ob >> 9) & 1) << 5)); }
__host__ __device__ __forceinline__ void stage_rc(int b, int& R, int& C) { const int st = b / 1024, sb = b % 1024, swz = sb ^ (((sb >> 9) & 1) << 5); R = (st >> 1) * 16 + swz / 64; C = (st & 1) * 32 + (swz % 64) / 2; }
__host__ __device__ __forceinline__ int perm32(int rho) { const int n = rho >> 4, i = rho & 15; return 8 * (i >> 2) + 4 * n + (i & 3); }

struct Unit { int pm, pn; };
struct Gemm { const bf16_t* A; const bf16_t* Bt; int M, N, K; };

struct StaticOrder {
    int nM, nN, nwg, G, c;
    __host__ __device__ void init(int M, int N, int G_, int c_) { nM = M / BM; nN = N / BM; nwg = nM * nN; G = G_; c = c_; }
    __host__ __device__ bool next(int i, Unit& u) const {
        const long L = (long)i * G + c; if (L >= nwg) return false;
        int wgid = (int)L; { const int q = nwg / NXCD, r = nwg % NXCD, xcd = wgid % NXCD, off = wgid / NXCD; wgid = (xcd < r ? xcd * (q + 1) : r * (q + 1) + (xcd - r) * q) + off; }
        const int nig = WGM * nN, gid = wgid / nig, fm = gid * WGM, gsz = (nM - fm) < WGM ? (nM - fm) : WGM;
        u.pm = fm + ((wgid % nig) % gsz); u.pn = (wgid % nig) / gsz; return true;
    }
    __device__ __forceinline__ void a_ready(const Unit&) const {}
    __device__ __forceinline__ void done(const Unit&) const {}
};
__device__ __forceinline__ unsigned cvt_pk_bf16(float lo, float hi) { unsigned r; asm volatile("v_cvt_pk_bf16_f32 %0, %1, %2" : "=v"(r) : "v"(lo), "v"(hi)); return r; }
typedef float f32x2 __attribute__((ext_vector_type(2)));

struct EpiProj {
    static constexpr bool PERM = true, AFTER_DRAIN = false, MIDK = false;
    bf16_t* O; int ldc; int ncols;
    __device__ __forceinline__ void operator()(const f32x4 (&acc)[2][2][4][2], const Unit& u, int wr, int wc, int fr, int fq) const {
        const int row0 = u.pm * BM + wr * 64 + fr, col0 = u.pn * BM + wc * 32 + 8 * fq;
#pragma unroll
        for (int ai = 0; ai < 2; ++ai)
#pragma unroll
            for (int m = 0; m < 4; ++m) { bf16_t* rowp = O + (size_t)(row0 + ai * HALF + m * 16) * ldc + col0;
#pragma unroll
                for (int bj = 0; bj < 2; ++bj) { const f32x4 v0 = acc[ai][bj][m][0], v1 = acc[ai][bj][m][1];
                    u32x4 w; w.x = cvt_pk_bf16(v0[0], v0[1]); w.y = cvt_pk_bf16(v0[2], v0[3]); w.z = cvt_pk_bf16(v1[0], v1[1]); w.w = cvt_pk_bf16(v1[2], v1[3]);
                    if (col0 + bj * HALF + 8 <= ncols) *(u32x4*)(rowp + bj * HALF) = w; } }
    }
};
template <bool SRC_BF16> struct EpiResGate {
    static constexpr bool PERM = true, AFTER_DRAIN = false, MIDK = true;
    const float* ssq;
    const float* Sc; const float* Sl;
    bf16_t* XB;
    const float* gate_rows; float* xss; int rowoff;
    template <class Sched> __device__ __forceinline__ void prep(PG8_LAS unsigned char* lds, const Sched& S, int tid) const {
        PG8_LAS float* RS = (PG8_LAS float*)(lds + STAGE_BYTES);
        const int r = tid & 255, i0 = tid >> 8;
        for (int i = i0; ; i += 2) { Unit u; if (!S.next(i, u)) break;
            const f32x4* q = (const f32x4*)(ssq + (size_t)(rowoff + u.pm * BM + r) * 8); const f32x4 a = q[0], b = q[1];
            RS[i * 256 + r] = __builtin_amdgcn_rsqf((((a[0] + a[1]) + (a[2] + a[3])) + ((b[0] + b[1]) + (b[2] + b[3]))) * (1.0f / 512.0f) + 1e-6f); }
    }
    __device__ __forceinline__ void midk(f32x4 (&acc)[2][2][4][2], PG8_LAS unsigned char* lds, int ui, int wr, int fr) const {
        int fr_ = fr; asm volatile("" : "+v"(fr_));
        PG8_LAS const float* RS = (PG8_LAS const float*)(lds + STAGE_BYTES) + ui * 256 + wr * 64 + fr_;
#pragma unroll
        for (int ai = 0; ai < 2; ++ai)
#pragma unroll
            for (int m = 0; m < 4; ++m) { const float rs = RS[ai * HALF + m * 16];
#pragma unroll
                for (int bj = 0; bj < 2; ++bj)
#pragma unroll
                    for (int n = 0; n < 2; ++n) acc[ai][bj][m][n] *= rs; }
    }
    __device__ __forceinline__ void operator()(const f32x4 (&acc)[2][2][4][2], const Unit& u, int wr, int wc, int fr, int fq) const {
        const int row0 = rowoff + u.pm * BM + wr * 64 + fr, col0 = u.pn * BM + wc * 32 + 8 * fq;
        const int t0 = rowoff + u.pm * BM; const int mrow = t0 < 2048 ? 8 : ((t0 - 2048) >> 12);
        const float* gr = gate_rows + (size_t)mrow * 6144 + col0;
        f32x4 gv[2][2];
#pragma unroll
        for (int bj = 0; bj < 2; ++bj)
#pragma unroll
            for (int n = 0; n < 2; ++n) gv[bj][n] = *(const f32x4*)(gr + bj * HALF + n * 4);
#pragma unroll
        for (int ai = 0; ai < 2; ++ai) {
            u32x4 rb[4][2]; f32x4 xf[SRC_BF16 ? 1 : 4][2][2];
#pragma unroll
            for (int m = 0; m < 4; ++m) { const int rr = row0 + ai * HALF + m * 16;
                const float* sp = (rr < 2048 ? Sc + (size_t)rr * 1024 : Sl + (size_t)(rr - 2048) * 1024) + col0; const bf16_t* dp = XB + (size_t)rr * 1024 + col0;
#pragma unroll
                for (int bj = 0; bj < 2; ++bj) {
                    if (SRC_BF16) rb[m][bj] = *(const u32x4*)(dp + bj * HALF);
                    else { xf[SRC_BF16 ? 0 : m][bj][0] = *(const f32x4*)(sp + bj * HALF); xf[SRC_BF16 ? 0 : m][bj][1] = *(const f32x4*)(sp + bj * HALF + 4); } } }
#pragma unroll
            for (int m = 0; m < 4; ++m) { const int rr = row0 + ai * HALF + m * 16;
                bf16_t* dp = XB + (size_t)rr * 1024 + col0; float ss = 0.f;
#pragma unroll
                for (int bj = 0; bj < 2; ++bj) { f32x4 x0, x1;
                    if (SRC_BF16) { const u32x4 r = rb[m][bj];
                        x0 = (f32x4){__uint_as_float(r.x << 16), __uint_as_float(r.x & 0xffff0000u), __uint_as_float(r.y << 16), __uint_as_float(r.y & 0xffff0000u)};
                        x1 = (f32x4){__uint_as_float(r.z << 16), __uint_as_float(r.z & 0xffff0000u), __uint_as_float(r.w << 16), __uint_as_float(r.w & 0xffff0000u)}; }
                    else { x0 = xf[SRC_BF16 ? 0 : m][bj][0]; x1 = xf[SRC_BF16 ? 0 : m][bj][1]; }
                    const f32x4 v0 = x0 + gv[bj][0] * acc[ai][bj][m][0], v1 = x1 + gv[bj][1] * acc[ai][bj][m][1];
                    u32x4 w; w.x = cvt_pk_bf16(v0[0], v0[1]); w.y = cvt_pk_bf16(v0[2], v0[3]); w.z = cvt_pk_bf16(v1[0], v1[1]); w.w = cvt_pk_bf16(v1[2], v1[3]);
                    *(u32x4*)(dp + bj * HALF) = w;
#pragma unroll
                    for (int j = 0; j < 4; ++j) { const float lo = __uint_as_float(w[j] << 16), hi = __uint_as_float(w[j] & 0xffff0000u); ss += lo * lo + hi * hi; } }
                { const int ln_ = fq * 16 + fr; ss += __int_as_float(__builtin_amdgcn_ds_bpermute((ln_ ^ 16) << 2, __float_as_int(ss))); ss += __int_as_float(__builtin_amdgcn_ds_bpermute((ln_ ^ 32) << 2, __float_as_int(ss))); }
                if (fq == 0) xss[(size_t)rr * 16 + u.pn * 4 + wc] = ss; }
        }
    }
};
template <class Epi, class Sched, bool STAMP = false, bool SP2 = PG8_SP2>
__device__ __forceinline__ void gemm_phase(PG8_LAS unsigned char* lds, const Gemm g, const Sched& S, const Epi& E, unsigned long long* stamps) {
    int tid_l = __builtin_amdgcn_readfirstlane(threadIdx.x >> 6) * 64 + (int)__builtin_amdgcn_mbcnt_hi(~0u, __builtin_amdgcn_mbcnt_lo(~0u, 0u)); asm volatile("" : "+v"(tid_l));
    const int tid = tid_l, wid = __builtin_amdgcn_readfirstlane(tid >> 6), lane = tid & 63, wr = wid >> 2, wc = wid & 3, fr = lane & 15, fq = lane >> 4;
    const int K = g.K, nt = K / BK;
    int ts_lo = 0, ts_hi = 0, nts = 0; const unsigned long long rt_entry = STAMP ? (unsigned long long)wall_clock64() : 0ull;
#define PG8_STAMP() do { if (STAMP && wid == 0 && nts < 64) { const unsigned long long _c = (unsigned long long)clock64(); \
        ts_lo = (lane == nts) ? (int)(unsigned)_c : ts_lo; ts_hi = (lane == nts) ? (int)(unsigned)(_c >> 32) : ts_hi; ++nts; } } while (0)
    PG8_STAMP();
    unsigned voffA[2], voffB[2];
#pragma unroll
    for (int i = 0; i < 2; ++i) { int R, C; stage_rc(tid * 16 + i * 8192, R, C); const int Rb = Epi::PERM ? ((R & ~31) + perm32(R & 31)) : R;
        voffA[i] = (unsigned)(R * K + C) * 2u; voffB[i] = (unsigned)(Rb * K + C) * 2u; }
    const size_t kstep = (size_t)(BK * 2);
    const size_t hstep = (size_t)HALF * K * 2;
    const size_t tstep = 2 * hstep;
    const unsigned ldsw = (unsigned)wid * 1024u;
    const int aoff = lds_byte(wr * 64 + fr, fq * 8), boff = lds_byte(wc * 32 + fr, fq * 8);
#define PG8_SA(b, h) (((b) * 2 + (h)) * HTB)
#define PG8_SB(b, h) ((4 + (b) * 2 + (h)) * HTB)
#define PG8_STAGE(bufoff, gbase, voff) do { _Pragma("unroll") for (int _i = 0; _i < 2; ++_i) \
        __builtin_amdgcn_global_load_lds((const unsigned*)((const char*)(gbase) + (voff)[_i]), (PG8_LAS unsigned*)(lds + (bufoff) + ldsw + _i * 8192), 16, 0, 0); } while (0)
#define PG8_LDA(dst, b, h) do { _Pragma("unroll") for (int m = 0; m < 4; ++m) _Pragma("unroll") for (int k = 0; k < 2; ++k) dst[m][k] = *(const PG8_LAS bf16x8*)(lds + PG8_SA(b, h) + aoff + m * 2048 + k * 1024); } while (0)
#define PG8_LDB(dst, b, h) do { _Pragma("unroll") for (int n = 0; n < 2; ++n) _Pragma("unroll") for (int k = 0; k < 2; ++k) dst[n][k] = *(const PG8_LAS bf16x8*)(lds + PG8_SB(b, h) + boff + n * 2048 + k * 1024); } while (0)
#define PG8_MMA(ai, bj, At, Bt) do { __builtin_amdgcn_s_setprio(1); _Pragma("unroll") for (int m = 0; m < 4; ++m) _Pragma("unroll") for (int n = 0; n < 2; ++n) _Pragma("unroll") for (int k = 0; k < 2; ++k) \
        acc[ai][bj][m][n] = __builtin_amdgcn_mfma_f32_16x16x32_bf16(Bt[n][k], At[m][k], acc[ai][bj][m][n], 0, 0, 0); __builtin_amdgcn_s_setprio(0); } while (0)
#define PG8_WAIT_V(n) asm volatile("s_waitcnt vmcnt(" #n ")" ::: "memory")
#define PG8_WAIT_L(n) asm volatile("s_waitcnt lgkmcnt(" #n ")" ::: "memory")
#define PG8_BAR __builtin_amdgcn_s_barrier()
#define PG8_SCHED __builtin_amdgcn_sched_barrier(0)
    Unit cur, nxt; int ui = 0;
    if (!S.next(0, cur)) return;
    f32x4 acc[2][2][4][2];
#pragma unroll
    for (int a = 0; a < 2; ++a)
#pragma unroll
        for (int b = 0; b < 2; ++b)
#pragma unroll
            for (int m = 0; m < 4; ++m)
#pragma unroll
                for (int n = 0; n < 2; ++n) acc[a][b][m][n] = (f32x4){0.f, 0.f, 0.f, 0.f};
    bf16x8 At[4][2], B0[2][2], B1[2][2];
    const char* cA = (const char*)g.A + (size_t)cur.pm * tstep; const char* cB = (const char*)g.Bt + (size_t)cur.pn * tstep;
    S.a_ready(cur);
    if constexpr (Epi::MIDK) E.prep(lds, S, tid);
    if constexpr (SP2) {
        PG8_STAGE(PG8_SB(0, 0), cB, voffB); PG8_STAGE(PG8_SB(0, 1), cB + hstep, voffB); PG8_STAGE(PG8_SA(0, 0), cA, voffA); PG8_STAGE(PG8_SA(0, 1), cA + hstep, voffA);
        if (wr == 1) PG8_BAR;
        PG8_WAIT_V(2); PG8_BAR;
        PG8_STAGE(PG8_SB(1, 0), cB + kstep, voffB); PG8_STAGE(PG8_SA(1, 0), cA + kstep, voffA); PG8_STAGE(PG8_SB(1, 1), cB + hstep + kstep, voffB);
        PG8_WAIT_V(6); PG8_BAR;
    } else {
    PG8_STAGE(PG8_SB(0, 0), cB, voffB); PG8_STAGE(PG8_SA(0, 0), cA, voffA); PG8_STAGE(PG8_SB(0, 1), cB + hstep, voffB); PG8_STAGE(PG8_SA(0, 1), cA + hstep, voffA);
    if (wr == 1) PG8_BAR;
    PG8_WAIT_V(4); PG8_BAR;
    PG8_STAGE(PG8_SB(1, 0), cB + kstep, voffB); PG8_STAGE(PG8_SA(1, 0), cA + kstep, voffA); PG8_STAGE(PG8_SB(1, 1), cB + hstep + kstep, voffB);
    PG8_WAIT_V(6); PG8_BAR;
    }
    PG8_STAMP();
    for (;;) {
        const bool has_next = S.next(ui + 1, nxt);
        const char* nA = has_next ? (const char*)g.A + (size_t)nxt.pm * tstep : cA; const char* nB = has_next ? (const char*)g.Bt + (size_t)nxt.pn * tstep : cB;
        for (int t = 0; t < nt; t += 2) {
            const bool last = (t == nt - 2);
            const char* a1 = cA + (size_t)(t + 1) * kstep;
            const char* a2 = last ? nA : cA + (size_t)(t + 2) * kstep; const char* b2 = last ? nB : cB + (size_t)(t + 2) * kstep;
            const char* a3 = a2 + kstep; const char* b3 = b2 + kstep;
            if (last && has_next) S.a_ready(nxt);
            if constexpr (SP2) {
            PG8_LDB(B0, 0, 0); PG8_LDB(B1, 0, 1); PG8_SCHED; PG8_LDA(At, 0, 0); PG8_STAGE(PG8_SA(1, 1), a1 + hstep, voffA);
            PG8_WAIT_V(8); PG8_WAIT_L(0); PG8_BAR; PG8_MMA(0, 0, At, B0); PG8_MMA(0, 1, At, B1); PG8_BAR; PG8_SCHED;
            PG8_LDA(At, 0, 1); PG8_STAGE(PG8_SB(0, 0), b2, voffB); PG8_STAGE(PG8_SB(0, 1), b2 + hstep, voffB); PG8_STAGE(PG8_SA(0, 0), a2, voffA);
            PG8_WAIT_V(8); PG8_WAIT_L(0); PG8_BAR; PG8_MMA(1, 0, At, B0); PG8_MMA(1, 1, At, B1); PG8_BAR; PG8_SCHED;
            PG8_LDB(B0, 1, 0); PG8_LDB(B1, 1, 1); PG8_SCHED; PG8_LDA(At, 1, 0); PG8_STAGE(PG8_SA(0, 1), a2 + hstep, voffA);
            PG8_WAIT_V(8); PG8_WAIT_L(0); PG8_BAR; PG8_MMA(0, 0, At, B0); PG8_MMA(0, 1, At, B1); PG8_BAR; PG8_SCHED;
            PG8_LDA(At, 1, 1); PG8_STAGE(PG8_SB(1, 0), b3, voffB); PG8_STAGE(PG8_SB(1, 1), b3 + hstep, voffB); PG8_STAGE(PG8_SA(1, 0), a3, voffA);
            PG8_WAIT_V(8); PG8_WAIT_L(0); PG8_BAR; PG8_MMA(1, 0, At, B0); PG8_MMA(1, 1, At, B1); PG8_BAR; PG8_SCHED;
            } else {
            PG8_LDB(B0, 0, 0); PG8_SCHED; PG8_LDA(At, 0, 0); PG8_STAGE(PG8_SA(1, 1), a1 + hstep, voffA);
            PG8_WAIT_L(8); PG8_BAR; PG8_WAIT_L(0); PG8_MMA(0, 0, At, B0); PG8_BAR; PG8_SCHED;
            PG8_LDB(B1, 0, 1); PG8_STAGE(PG8_SB(0, 0), b2, voffB);
            PG8_BAR; PG8_WAIT_L(0); PG8_MMA(0, 1, At, B1); PG8_BAR;
            PG8_LDA(At, 0, 1); PG8_STAGE(PG8_SA(0, 0), a2, voffA);
            PG8_BAR; PG8_WAIT_L(0); PG8_MMA(1, 0, At, B0); PG8_BAR; PG8_SCHED;
            PG8_STAGE(PG8_SB(0, 1), b2 + hstep, voffB);
            PG8_WAIT_V(6); PG8_BAR; PG8_MMA(1, 1, At, B1); PG8_BAR;
            PG8_LDB(B0, 1, 0); PG8_SCHED; PG8_LDA(At, 1, 0); PG8_STAGE(PG8_SA(0, 1), a2 + hstep, voffA);
            PG8_WAIT_L(8); PG8_BAR; PG8_WAIT_L(0); PG8_MMA(0, 0, At, B0); PG8_BAR; PG8_SCHED;
            PG8_LDB(B1, 1, 1); PG8_STAGE(PG8_SB(1, 0), b3, voffB);
            PG8_BAR; PG8_WAIT_L(0); PG8_MMA(0, 1, At, B1); PG8_BAR;
            PG8_LDA(At, 1, 1); PG8_STAGE(PG8_SA(1, 0), a3, voffA);
            PG8_BAR; PG8_WAIT_L(0); PG8_MMA(1, 0, At, B0); PG8_BAR; PG8_SCHED;
            PG8_STAGE(PG8_SB(1, 1), b3 + hstep, voffB);
            PG8_WAIT_V(6); PG8_BAR; PG8_MMA(1, 1, At, B1); PG8_BAR;
            }
            if constexpr (Epi::MIDK) { if (t + 2 == nt / 2) E.midk(acc, lds, ui, wr, fr); }
        }
        PG8_STAMP();
        if (wr == 0) PG8_BAR;
        if constexpr (!Epi::AFTER_DRAIN) { E(acc, cur, wr, wc, fr, fq); S.done(cur); }
        PG8_STAMP();
        if (!has_next) break;
#pragma unroll
        for (int a = 0; a < 2; ++a)
#pragma unroll
            for (int b = 0; b < 2; ++b)
#pragma unroll
                for (int m = 0; m < 4; ++m)
#pragma unroll
                    for (int n = 0; n < 2; ++n) acc[a][b][m][n] = (f32x4){0.f, 0.f, 0.f, 0.f};
        cur = nxt; cA = nA; cB = nB; ++ui;
        if (wr == 1) PG8_BAR;
    }
    PG8_WAIT_V(0);
    PG8_BAR;
    if constexpr (Epi::AFTER_DRAIN) { E.fused(acc, cur, wr, wc, fr, fq, lds, wid, lane); S.done(cur); }
    PG8_STAMP();
    if (STAMP && wid == 0) { stamps[lane] = lane < nts ? (((unsigned long long)(unsigned)ts_hi << 32) | (unsigned)ts_lo) : 0ull;
        if (lane == 62) stamps[62] = rt_entry; if (lane == 63) stamps[63] = (unsigned long long)wall_clock64(); }
#undef PG8_STAMP
#undef PG8_SA
#undef PG8_SB
#undef PG8_STAGE
#undef PG8_LDA
#undef PG8_LDB
#undef PG8_MMA
#undef PG8_WAIT_V
#undef PG8_WAIT_L
#undef PG8_BAR
#undef PG8_SCHED
}

typedef int i32x4 __attribute__((ext_vector_type(4)));
typedef int i32x8 __attribute__((ext_vector_type(8)));
__device__ __forceinline__ i32x8 cat8(bf16x8 a, bf16x8 b) { return __builtin_shufflevector(__builtin_bit_cast(i32x4, a), __builtin_bit_cast(i32x4, b), 0, 1, 2, 3, 4, 5, 6, 7); }
__device__ __forceinline__ void mfma8(f32x4& c, i32x8 a, i32x8 b) { asm volatile("v_mfma_f32_16x16x128_f8f6f4 %0, %1, %2, %0" : "+v"(c) : "v"(a), "v"(b)); }
__device__ __forceinline__ unsigned pk4_fp8(const f32x4 v) { const float lim = 440.f;
    int w = __builtin_amdgcn_cvt_pk_fp8_f32(fminf(fmaxf(v[0], -lim), lim), fminf(fmaxf(v[1], -lim), lim), 0, false);
    return (unsigned)__builtin_amdgcn_cvt_pk_fp8_f32(fminf(fmaxf(v[2], -lim), lim), fminf(fmaxf(v[3], -lim), lim), w, true); }
struct MoeUnit { int e, mt, pn, cnt, pstart; };
struct MoeSched {
    typedef MoeUnit UnitT;
    PG8_LAS const int* tab; const int* map; int U, G, c, npn, gather; size_t bstride;
    __device__ __forceinline__ bool next(int i, MoeUnit& u) const {
        const long L = (long)i * G + c; if (L >= U) return false;
        int idx = (int)L; { const int q = U / NXCD, r = U % NXCD, xcd = idx % NXCD, off = idx / NXCD; idx = (xcd < r ? xcd * (q + 1) : r * (q + 1) + (xcd - r) * q) + off; }
        const int tau = idx / npn; u.pn = idx - tau * npn;
        int e = 0;
#pragma unroll
        for (int st = 16; st >= 1; st >>= 1) { if (__builtin_amdgcn_readfirstlane(tab[e + st]) <= tau) e += st; }
        u.e = e; u.mt = tau - __builtin_amdgcn_readfirstlane(tab[e]); u.cnt = __builtin_amdgcn_readfirstlane(tab[33 + e]); u.pstart = __builtin_amdgcn_readfirstlane(tab[65 + e]);
        return true;
    }
    __device__ __forceinline__ const char* bbase(const Gemm& g, const MoeUnit& u) const { return (const char*)g.Bt + (size_t)u.e * bstride + (size_t)u.pn * BM * g.K * 2; }
    __device__ __forceinline__ void a_offsets(const Gemm& g, const MoeUnit& u, int tid, unsigned (&va)[2][2]) const {
        int tl = tid; asm volatile("" : "+v"(tl));
        int RA[2], CA[2];
#pragma unroll
        for (int i = 0; i < 2; ++i) { int R, C; stage_rc(tl * 16 + i * 8192, R, C); RA[i] = R; CA[i] = C * 2; }
#pragma unroll
        for (int hf = 0; hf < 2; ++hf)
#pragma unroll
            for (int i = 0; i < 2; ++i) { int rl = u.mt * BM + hf * HALF + RA[i]; rl = rl < u.cnt ? rl : u.cnt - 1;
                const unsigned row = gather ? (unsigned)map[(size_t)u.e * 34816 + rl] : (unsigned)(u.pstart + rl);
                va[hf][i] = row * (unsigned)(g.K * 2) + (unsigned)CA[i]; }
    }
};
struct EpiAct {
    static constexpr bool PERM = true, AFTER_DRAIN = false;
    unsigned char* O;
    __device__ __forceinline__ void operator()(const f32x4 (&acc)[2][2][4][2], const MoeUnit& u, int wr, int wc, int fr, int fq) const {
        typedef unsigned u32x2 __attribute__((ext_vector_type(2)));
        const int rl0 = u.mt * BM + wr * 64 + fr, col0 = u.pn * HALF + wc * 32 + 8 * fq;
#pragma unroll
        for (int ai = 0; ai < 2; ++ai)
#pragma unroll
            for (int m = 0; m < 4; ++m) { const int rl = rl0 + ai * HALF + m * 16;
                if (rl < u.cnt) { f32x4 o[2];
#pragma unroll
                    for (int n = 0; n < 2; ++n)
#pragma unroll
                        for (int j = 0; j < 4; ++j) { const float gv = acc[ai][0][m][n][j] * (1.0f / 64.0f)  ; o[n][j] = gv * __builtin_amdgcn_rcpf(1.0f + __builtin_amdgcn_exp2f(-1.4426950408889634f * gv)) * (acc[ai][1][m][n][j] * 0.125f)  ; }
                    *(u32x2*)(O + (size_t)(u.pstart + rl) * 512 + col0) = (u32x2){pk4_fp8(o[0]), pk4_fp8(o[1])}; } }
    }
};
struct EpiY {
    static constexpr bool PERM = true, AFTER_DRAIN = false;
    unsigned char* O;
    static __device__ __forceinline__ unsigned pk4(const f32x4 v) { const float lim = 440.f;
        int w = __builtin_amdgcn_cvt_pk_fp8_f32(fminf(fmaxf(v[0], -lim), lim), fminf(fmaxf(v[1], -lim), lim), 0, false);
        return (unsigned)__builtin_amdgcn_cvt_pk_fp8_f32(fminf(fmaxf(v[2], -lim), lim), fminf(fmaxf(v[3], -lim), lim), w, true); }
    __device__ __forceinline__ void operator()(const f32x4 (&acc)[2][2][4][2], const MoeUnit& u, int wr, int wc, int fr, int fq) const {
        typedef unsigned u32x2 __attribute__((ext_vector_type(2)));
        const int rl0 = u.mt * BM + wr * 64 + fr, col0 = u.pn * BM + wc * 32 + 8 * fq;
#pragma unroll
        for (int ai = 0; ai < 2; ++ai)
#pragma unroll
            for (int m = 0; m < 4; ++m) { const int rl = rl0 + ai * HALF + m * 16;
                if (rl < u.cnt) { unsigned char* rowp = O + (size_t)(u.pstart + rl) * 1024 + col0;
#pragma unroll
                    for (int bj = 0; bj < 2; ++bj) *(u32x2*)(rowp + bj * HALF) = (u32x2){pk4(acc[ai][bj][m][0] * (1.0f / 512.0f)), pk4(acc[ai][bj][m][1] * (1.0f / 512.0f))}; } }
    }
};
template <class Epi, class Sched, bool STAMP = false, bool SP2 = PG8_SP2, int SCW = -1, int SCA = 127>
__device__ __forceinline__ void gemm_phase_moe(PG8_LAS unsigned char* lds, const Gemm g, const Sched& S, const Epi& E, unsigned long long* stamps) {
    int tid_l = __builtin_amdgcn_readfirstlane(threadIdx.x >> 6) * 64 + (int)__builtin_amdgcn_mbcnt_hi(~0u, __builtin_amdgcn_mbcnt_lo(~0u, 0u)); asm volatile("" : "+v"(tid_l));
    const int tid = tid_l, wid = __builtin_amdgcn_readfirstlane(tid >> 6), lane = tid & 63, wr = wid >> 2, wc = wid & 3, fr = lane & 15, fq = lane >> 4;
    const int K = g.K, nt = K / BK;
    int ts_lo = 0, ts_hi = 0, nts = 0; const unsigned long long rt_entry = STAMP ? (unsigned long long)wall_clock64() : 0ull;
#define PG8_STAMP() do { if (STAMP && wid == 0 && nts < 64) { const unsigned long long _c = (unsigned long long)clock64(); \
        ts_lo = (lane == nts) ? (int)(unsigned)_c : ts_lo; ts_hi = (lane == nts) ? (int)(unsigned)(_c >> 32) : ts_hi; ++nts; } } while (0)
    PG8_STAMP();
    unsigned voffB[2];
#pragma unroll
    for (int i = 0; i < 2; ++i) { int R, C; stage_rc(tid * 16 + i * 8192, R, C); const int Rb = Epi::PERM ? ((R & ~31) + perm32(R & 31)) : R;
        voffB[i] = (unsigned)(Rb * K + C) * 2u; }
    unsigned vaC[2][2];
    PG8_LAS unsigned* vtab = (PG8_LAS unsigned*)(lds + STAGE_BYTES + 1024) + tid;
    const size_t kstep = (size_t)(BK * 2);
    const size_t hstep = (size_t)HALF * K * 2;
    const size_t tstep = 2 * hstep;
    const unsigned ldsw = (unsigned)wid * 1024u;
    const int aoff = lds_byte(wr * 64 + fr, fq * 8), boff = lds_byte(wc * 32 + fr, fq * 8);
#define PG8_SA(b, h) (((b) * 2 + (h)) * HTB)
#define PG8_SB(b, h) ((4 + (b) * 2 + (h)) * HTB)
#define PG8_STAGE(bufoff, gbase, voff) do { _Pragma("unroll") for (int _i = 0; _i < 2; ++_i) \
        __builtin_amdgcn_global_load_lds((const unsigned*)((const char*)(gbase) + (voff)[_i]), (PG8_LAS unsigned*)(lds + (bufoff) + ldsw + _i * 8192), 16, 0, 0); } while (0)
#define PG8_STAGEA(bufoff, kbyte, va) do { _Pragma("unroll") for (int _i = 0; _i < 2; ++_i) \
        __builtin_amdgcn_global_load_lds((const unsigned*)((const char*)g.A + (kbyte) + (va)[_i]), (PG8_LAS unsigned*)(lds + (bufoff) + ldsw + _i * 8192), 16, 0, 0); } while (0)
#define PG8_LDA(dst, b, h) do { _Pragma("unroll") for (int m = 0; m < 4; ++m) _Pragma("unroll") for (int k = 0; k < 2; ++k) dst[m][k] = *(const PG8_LAS bf16x8*)(lds + PG8_SA(b, h) + aoff + m * 2048 + k * 1024); } while (0)
#define PG8_LDB(dst, b, h) do { _Pragma("unroll") for (int n = 0; n < 2; ++n) _Pragma("unroll") for (int k = 0; k < 2; ++k) dst[n][k] = *(const PG8_LAS bf16x8*)(lds + PG8_SB(b, h) + boff + n * 2048 + k * 1024); } while (0)
#define PG8_MMA(ai, bj, At, Bt) do { __builtin_amdgcn_s_setprio(1); _Pragma("unroll") for (int m = 0; m < 4; ++m) _Pragma("unroll") for (int n = 0; n < 2; ++n) { \
        if constexpr (SCW >= 0) mfma8(acc[ai][bj][m][n], cat8(Bt[n][0], Bt[n][1]), cat8(At[m][0], At[m][1])); \
        else { _Pragma("unroll") for (int k = 0; k < 2; ++k) acc[ai][bj][m][n] = __builtin_amdgcn_mfma_f32_16x16x32_bf16(Bt[n][k], At[m][k], acc[ai][bj][m][n], 0, 0, 0); } } __builtin_amdgcn_s_setprio(0); } while (0)
#define PG8_WAIT_V(n) asm volatile("s_waitcnt vmcnt(" #n ")" ::: "memory")
#define PG8_WAIT_L(n) asm volatile("s_waitcnt lgkmcnt(" #n ")" ::: "memory")
#define PG8_BAR __builtin_amdgcn_s_barrier()
#define PG8_SCHED __builtin_amdgcn_sched_barrier(0)
    typename Sched::UnitT cur, nxt; int ui = 0;
    if (!S.next(0, cur)) return;
    f32x4 acc[2][2][4][2];
#pragma unroll
    for (int a = 0; a < 2; ++a)
#pragma unroll
        for (int b = 0; b < 2; ++b)
#pragma unroll
            for (int m = 0; m < 4; ++m)
#pragma unroll
                for (int n = 0; n < 2; ++n) acc[a][b][m][n] = (f32x4){0.f, 0.f, 0.f, 0.f};
    bf16x8 At[4][2], B0[2][2], B1[2][2];
    const char* cB = S.bbase(g, cur); S.a_offsets(g, cur, tid, vaC);
    if constexpr (SP2) {
        PG8_STAGE(PG8_SB(0, 0), cB, voffB); PG8_STAGE(PG8_SB(0, 1), cB + hstep, voffB); PG8_STAGEA(PG8_SA(0, 0), 0, vaC[0]); PG8_STAGEA(PG8_SA(0, 1), 0, vaC[1]);
        if (wr == 1) PG8_BAR;
        PG8_WAIT_V(2); PG8_BAR;
        PG8_STAGE(PG8_SB(1, 0), cB + kstep, voffB); PG8_STAGEA(PG8_SA(1, 0), kstep, vaC[0]); PG8_STAGE(PG8_SB(1, 1), cB + hstep + kstep, voffB);
        PG8_WAIT_V(6); PG8_BAR;
    } else {
    PG8_STAGE(PG8_SB(0, 0), cB, voffB); PG8_STAGEA(PG8_SA(0, 0), 0, vaC[0]); PG8_STAGE(PG8_SB(0, 1), cB + hstep, voffB); PG8_STAGEA(PG8_SA(0, 1), 0, vaC[1]);
    if (wr == 1) PG8_BAR;
    PG8_WAIT_V(4); PG8_BAR;
    PG8_STAGE(PG8_SB(1, 0), cB + kstep, voffB); PG8_STAGEA(PG8_SA(1, 0), kstep, vaC[0]); PG8_STAGE(PG8_SB(1, 1), cB + hstep + kstep, voffB);
    PG8_WAIT_V(6); PG8_BAR;
    }
    PG8_STAMP();
    for (;;) {
        const bool has_next = S.next(ui + 1, nxt);
        const char* nB = has_next ? S.bbase(g, nxt) : cB;
        { unsigned vaN[2][2];
          if (has_next) S.a_offsets(g, nxt, tid, vaN); else {
#pragma unroll
            for (int hf = 0; hf < 2; ++hf)
#pragma unroll
                for (int i = 0; i < 2; ++i) vaN[hf][i] = vaC[hf][i]; }
#pragma unroll
          for (int hf = 0; hf < 2; ++hf)
#pragma unroll
              for (int i = 0; i < 2; ++i) vtab[(hf * 2 + i) * 512] = vaN[hf][i]; }
        unsigned v2[2][2];
        for (int t = 0; t < nt; t += 2) {
            const bool last = (t == nt - 2);
            const size_t k1 = (size_t)(t + 1) * kstep, k2 = last ? (size_t)0 : (size_t)(t + 2) * kstep, k3 = k2 + kstep;
            const char* b2 = last ? nB : cB + (size_t)(t + 2) * kstep; const char* b3 = b2 + kstep;
#pragma unroll
            for (int hf = 0; hf < 2; ++hf)
#pragma unroll
                for (int i = 0; i < 2; ++i) v2[hf][i] = last ? vtab[(hf * 2 + i) * 512] : vaC[hf][i];
            if constexpr (SP2) {
            PG8_LDB(B0, 0, 0); PG8_LDB(B1, 0, 1); PG8_SCHED; PG8_LDA(At, 0, 0); PG8_STAGEA(PG8_SA(1, 1), k1, vaC[1]);
            PG8_WAIT_V(8); PG8_WAIT_L(0); PG8_BAR; PG8_MMA(0, 0, At, B0); PG8_MMA(0, 1, At, B1); PG8_BAR; PG8_SCHED;
            PG8_LDA(At, 0, 1); PG8_STAGE(PG8_SB(0, 0), b2, voffB); PG8_STAGE(PG8_SB(0, 1), b2 + hstep, voffB); PG8_STAGEA(PG8_SA(0, 0), k2, v2[0]);
            PG8_WAIT_V(8); PG8_WAIT_L(0); PG8_BAR; PG8_MMA(1, 0, At, B0); PG8_MMA(1, 1, At, B1); PG8_BAR; PG8_SCHED;
            PG8_LDB(B0, 1, 0); PG8_LDB(B1, 1, 1); PG8_SCHED; PG8_LDA(At, 1, 0); PG8_STAGEA(PG8_SA(0, 1), k2, v2[1]);
            PG8_WAIT_V(8); PG8_WAIT_L(0); PG8_BAR; PG8_MMA(0, 0, At, B0); PG8_MMA(0, 1, At, B1); PG8_BAR; PG8_SCHED;
            PG8_LDA(At, 1, 1); PG8_STAGE(PG8_SB(1, 0), b3, voffB); PG8_STAGE(PG8_SB(1, 1), b3 + hstep, voffB); PG8_STAGEA(PG8_SA(1, 0), k3, v2[0]);
            PG8_WAIT_V(8); PG8_WAIT_L(0); PG8_BAR; PG8_MMA(1, 0, At, B0); PG8_MMA(1, 1, At, B1); PG8_BAR; PG8_SCHED;
            } else {
            PG8_LDB(B0, 0, 0); PG8_SCHED; PG8_LDA(At, 0, 0); PG8_STAGEA(PG8_SA(1, 1), k1, vaC[1]);
            PG8_WAIT_L(8); PG8_BAR; PG8_WAIT_L(0); PG8_MMA(0, 0, At, B0); PG8_BAR; PG8_SCHED;
            PG8_LDB(B1, 0, 1); PG8_STAGE(PG8_SB(0, 0), b2, voffB);
            PG8_BAR; PG8_WAIT_L(0); PG8_MMA(0, 1, At, B1); PG8_BAR;
            PG8_LDA(At, 0, 1); PG8_STAGEA(PG8_SA(0, 0), k2, v2[0]);
            PG8_BAR; PG8_WAIT_L(0); PG8_MMA(1, 0, At, B0); PG8_BAR; PG8_SCHED;
            PG8_STAGE(PG8_SB(0, 1), b2 + hstep, voffB);
            PG8_WAIT_V(6); PG8_BAR; PG8_MMA(1, 1, At, B1); PG8_BAR;
            PG8_LDB(B0, 1, 0); PG8_SCHED; PG8_LDA(At, 1, 0); PG8_STAGEA(PG8_SA(0, 1), k2, v2[1]);
            PG8_WAIT_L(8); PG8_BAR; PG8_WAIT_L(0); PG8_MMA(0, 0, At, B0); PG8_BAR; PG8_SCHED;
            PG8_LDB(B1, 1, 1); PG8_STAGE(PG8_SB(1, 0), b3, voffB);
            PG8_BAR; PG8_WAIT_L(0); PG8_MMA(0, 1, At, B1); PG8_BAR;
            PG8_LDA(At, 1, 1); PG8_STAGEA(PG8_SA(1, 0), k3, v2[0]);
            PG8_BAR; PG8_WAIT_L(0); PG8_MMA(1, 0, At, B0); PG8_BAR; PG8_SCHED;
            PG8_STAGE(PG8_SB(1, 1), b3 + hstep, voffB);
            PG8_WAIT_V(6); PG8_BAR; PG8_MMA(1, 1, At, B1); PG8_BAR;
            }
        }
        PG8_STAMP();
        if (wr == 0) PG8_BAR;
        if constexpr (SCW >= 0) asm volatile("s_nop 15\n\ts_nop 15" ::: "memory");
        E(acc, cur, wr, wc, fr, fq);
        PG8_STAMP();
        if (!has_next) break;
#pragma unroll
        for (int a = 0; a < 2; ++a)
#pragma unroll
            for (int b = 0; b < 2; ++b)
#pragma unroll
                for (int m = 0; m < 4; ++m)
#pragma unroll
                    for (int n = 0; n < 2; ++n) acc[a][b][m][n] = (f32x4){0.f, 0.f, 0.f, 0.f};
        cur = nxt; cB = nB; ++ui;
#pragma unroll
        for (int hf = 0; hf < 2; ++hf)
#pragma unroll
            for (int i = 0; i < 2; ++i) vaC[hf][i] = v2[hf][i];
        if (wr == 1) PG8_BAR;
    }
    PG8_WAIT_V(0);
    PG8_BAR;
    PG8_STAMP();
    if (STAMP && wid == 0) { stamps[lane] = lane < nts ? (((unsigned long long)(unsigned)ts_hi << 32) | (unsigned)ts_lo) : 0ull;
        if (lane == 62) stamps[62] = rt_entry; if (lane == 63) stamps[63] = (unsigned long long)wall_clock64(); }
#undef PG8_STAMP
#undef PG8_SA
#undef PG8_SB
#undef PG8_STAGE
#undef PG8_STAGEA
#undef PG8_LDA
#undef PG8_LDB
#undef PG8_MMA
#undef PG8_WAIT_V
#undef PG8_WAIT_L
#undef PG8_BAR
#undef PG8_SCHED
}
}

constexpr int NTHR = 512, NWV = 8, LDS_BYTES = 147456;

struct P {
    const float *x, *c, *ctx, *c_ctx, *w_mod, *b_mod, *norm1_g, *norm2_g, *w_in, *conv_w, *conv_b, *dt_bias_f, *dt_bias_b, *a_log_f, *a_log_b, *d_skip, *ssd_norm_g,
        *gk_up_f, *gk_bias_f, *gk_up_b, *gk_bias_b, *gla_norm_g, *w_out, *w_router, *router_bias, *w_gate, *w_up, *w_down, *final_g;
    float* out; bf16_t* XB; bf16_t* H; bf16_t* PROJ; bf16_t* SS; bf16_t* GS; float* SDEC; float* GDEC; float* MOD; int* counts; int* TOKSLOT; float* EW; int* MAP; bf16_t* WinT; bf16_t* WoutT; bf16_t* WguT; bf16_t* WdT; bf16_t* WRT; unsigned* BAR; bf16_t* XBCC; bf16_t* QKB; float* SSC; float* STOT; float* SSQ; float* XSS;
};

DI void ph_init(const P& p) { const size_t i = (size_t)blockIdx.x * NTHR + ltid(); if (i < 64) p.counts[i * 32] = 0; }

DI void ph_mod(const P& p, float* s  ) {
    const int tid_ = ltid(), lane = tid_ & 63, w = tid_ >> 6;
    if (blockIdx.x >= 192) return;
    float* part = s + 9 * 1024;
    { float cv[18];
#pragma unroll
      for (int q = 0; q < 18; ++q) { const int i = tid_ + q * NTHR, r = i >> 10, k = i & 1023; cv[q] = r < 8 ? p.c[r * 1024 + k] : p.c_ctx[k]; }
#pragma unroll
      for (int q = 0; q < 18; ++q) s[tid_ + q * NTHR] = siluf(cv[q]); }
    __syncthreads();
    for (int vb = blockIdx.x; vb < 192; vb += gridDim.x) {
        const int l = vb / 96, n = (vb % 96) * 64 + lane;
        float acc[9];
#pragma unroll
        for (int r = 0; r < 9; ++r) acc[r] = 0.f;
        const float* wp = p.w_mod + (size_t)l * 1024 * 6144 + (size_t)(128 * w) * 6144 + n;
#pragma unroll 8
        for (int k = 0; k < 128; ++k) { const float wv = wp[(size_t)k * 6144];
#pragma unroll
            for (int r = 0; r < 9; ++r) acc[r] += s[r * 1024 + 128 * w + k] * wv; }
#pragma unroll
        for (int r = 0; r < 9; ++r) part[(w * 9 + r) * 64 + lane] = acc[r];
        __syncthreads();
        for (int o = tid_; o < 9 * 64; o += NTHR) { const int r = o >> 6, c = o & 63; float a = p.b_mod[l * 6144 + (vb % 96) * 64 + c];
#pragma unroll
            for (int q = 0; q < 8; ++q) a += part[(q * 9 + r) * 64 + c];
            p.MOD[((size_t)l * 9 + r) * 6144 + (vb % 96) * 64 + c] = a; }
        __syncthreads();
    }
}

DI unsigned pk2(float lo, float hi) { return __builtin_bit_cast(unsigned, __builtin_convertvector((f32x2v_){lo, hi}, bf16x2v_)); }
template <bool F8 = false> DI void transpose_item(const float* W, int K, int N, bf16_t* WT, float* scr, int item, int lane, int gu = -1, const float* kscale = nullptr) {
    const int nblk = (N + 31) / 32, kb = item / nblk, nb = item % nblk, k0 = 64 * kb, n0 = 32 * nb;
    const int d0 = gu < 0 ? n0 : 256 * (n0 >> 7) + (n0 & 127) + 128 * gu;
    const bool nok = n0 + (lane & 31) < N;
    float wv_[32];
#pragma unroll
    for (int i = 0; i < 32; ++i) { const int kk = 2 * i + (lane >> 5); wv_[i] = nok ? __builtin_nontemporal_load(W + (size_t)(k0 + kk) * N + n0 + (lane & 31)) : 0.f; }
#pragma unroll
    for (int i = 0; i < 32; ++i) { const int kk = 2 * i + (lane >> 5); scr[kk * 33 + (lane & 31)] = wv_[i] * (kscale ? kscale[k0 + kk] : 1.0f); }
    const int c = lane & 7;
#pragma unroll
    for (int j = 0; j < 4; ++j) { const int n = (lane >> 3) + 8 * j; const float* q = scr + (8 * c) * 33 + n;
        if constexpr (F8) { typedef unsigned u32x2nt __attribute__((ext_vector_type(2)));
            const u32x2nt o = {pg8::pk4_fp8((pg8::f32x4){q[0 * 33], q[1 * 33], q[2 * 33], q[3 * 33]} * 64.0f), pg8::pk4_fp8((pg8::f32x4){q[4 * 33], q[5 * 33], q[6 * 33], q[7 * 33]} * 64.0f)};
            if (n0 + n < N) __builtin_nontemporal_store(o, (u32x2nt*)((unsigned char*)WT + (size_t)(d0 + n) * K + k0 + 8 * c)); }
        else {
        uint4 o; o.x = pk2(q[0 * 33], q[1 * 33]); o.y = pk2(q[2 * 33], q[3 * 33]); o.z = pk2(q[4 * 33], q[5 * 33]); o.w = pk2(q[6 * 33], q[7 * 33]);
        if (n0 + n < N) { typedef unsigned u32x4nt __attribute__((ext_vector_type(4))); __builtin_nontemporal_store((u32x4nt){o.x, o.y, o.z, o.w}, (u32x4nt*)(WT + (size_t)(d0 + n) * K + k0 + 8 * c)); } } }
}

DI void ph_convert_experts(const P& p, int l, float* ldsf, int wk0, int nwk, int it0 = 0, int it1 = NE * 768) {
    const int tid_ = ltid(), lane = tid_ & 63, gw = ((int)blockIdx.x - wk0) * NWV + (tid_ >> 6), NW = nwk * NWV;
    float* scr = ldsf + 14 * 1024 + (tid_ >> 6) * (64 * 33 + 16);
    for (int it = it0 + gw; it < it1; it += NW) {
        const int e = it / 768, r = it - e * 768;
        if (r < 512) { const int gu = r >> 8; const float* W = (gu ? p.w_up : p.w_gate) + (size_t)(l * NE + e) * D * 512;
            transpose_item<true>(W, D, 512, (bf16_t*)((unsigned char*)p.WguT + (size_t)e * D * D), scr, r & 255, lane, gu); }
        else transpose_item<true>(p.w_down + (size_t)(l * NE + e) * 512 * D, 512, D, (bf16_t*)((unsigned char*)p.WdT + (size_t)e * D * 512), scr, r - 512, lane);
    }
}
constexpr int NPAD_IN = 3072;
DI void ph_convert_small(const P& p, float* ldsf, int, int, int) {
    const int tid_ = ltid(), lane = tid_ & 63, gw = blockIdx.x * NWV + (tid_ >> 6), NW = gridDim.x * NWV;
    float* scr = ldsf + 14 * 1024 + (tid_ >> 6) * (64 * 33 + 16);
    constexpr int I_IN = 16 * 89, I_OUT = 16 * 32;
    for (int it = gw; it < 2 * (I_IN + I_OUT); it += NW) {
        const int l = it / (I_IN + I_OUT), r = it % (I_IN + I_OUT);
        if (r < I_IN) transpose_item(p.w_in + (size_t)l * D * INDIM, D, INDIM, p.WinT + (size_t)l * NPAD_IN * D, scr, r, lane);
        else { const int kb = (r - I_IN) / 32;
            transpose_item(p.w_out + (size_t)l * D * D, D, D, p.WoutT + (size_t)l * D * D, scr, r - I_IN, lane, -1, kb < 8 ? p.ssd_norm_g + l * 512 : nullptr); }
    }
    for (int idx = blockIdx.x * NTHR + tid_; idx < 32 * 1024; idx += gridDim.x * NTHR) { const int e = idx >> 10, k = idx & 1023; p.WRT[idx] = f2bf(p.w_router[k * 32 + e]); }
    const size_t nz16 = (size_t)(NPAD_IN - INDIM) * D * 2 / 16;
    for (size_t i = (size_t)blockIdx.x * NTHR + tid_; i < 2 * nz16; i += (size_t)gridDim.x * NTHR) {
        const size_t l = i / nz16, j = i % nz16;
        ((uint4*)(p.WinT + (l * NPAD_IN + INDIM) * D))[j] = make_uint4(0u, 0u, 0u, 0u);
    }
}

DI void row_normmod(float4 (&v)[4], const float* g, const float* mr, int shift_idx, int scale_idx, int lane) {
    float ss = 0.f;
#pragma unroll
    for (int i = 0; i < 4; ++i) ss += v[i].x * v[i].x + v[i].y * v[i].y + v[i].z * v[i].z + v[i].w * v[i].w;
    ss = wave_sum(ss, lane);
    const float rstd = rsqrtf(ss * (1.0f / D) + 1e-6f);
#pragma unroll
    for (int i = 0; i < 4; ++i) {
        const int c = (i * 64 + lane) * 4;
        const float4 gg = *(const float4*)(g + c), sh = *(const float4*)(mr + shift_idx * 1024 + c), sc = *(const float4*)(mr + scale_idx * 1024 + c);
        v[i].x = v[i].x * rstd * gg.x * (1.f + sc.x) + sh.x; v[i].y = v[i].y * rstd * gg.y * (1.f + sc.y) + sh.y;
        v[i].z = v[i].z * rstd * gg.z * (1.f + sc.z) + sh.z; v[i].w = v[i].w * rstd * gg.w * (1.f + sc.w) + sh.w;
    }
}
DI void row_store_bf16(bf16_t* hrow, float4 (&v)[4], int lane) {
#pragma unroll
    for (int i = 0; i < 4; ++i) { ushort4 o; o.x = f2bf(v[i].x); o.y = f2bf(v[i].y); o.z = f2bf(v[i].z); o.w = f2bf(v[i].w);
        *(ushort4*)(hrow + (i * 64 + lane) * 4) = o; v[i] = make_float4(bf2f(o.x), bf2f(o.y), bf2f(o.z), bf2f(o.w)); }
}

DI void ph_normmod1(const P& p, int l, int, int, int) {
    const int tid_ = ltid(), lane = tid_ & 63, gw = blockIdx.x * NWV + (tid_ >> 6), NW = gridDim.x * NWV;
    const float* MODl = p.MOD + (size_t)l * 9 * 6144;
    for (int t = gw; t < T; t += NW) {
        float4 v[4];
#pragma unroll
        for (int i = 0; i < 4; ++i) v[i] = ((const float4*)(t < TC ? p.ctx + (size_t)t * D : p.x + (size_t)(t - TC) * D))[i * 64 + lane];
        row_normmod(v, p.norm1_g + l * D, MODl + (size_t)tok_modrow(t) * 6144, 0, 1, lane);
        row_store_bf16(p.H + (size_t)t * D, v, lane);
    }
}

typedef short s16x4 __attribute__((ext_vector_type(4)));
typedef short bf16x8v __attribute__((ext_vector_type(8)));
typedef float f32x4v __attribute__((ext_vector_type(4)));
typedef unsigned u32x4v __attribute__((ext_vector_type(4)));
typedef unsigned u32x2v __attribute__((ext_vector_type(2)));
DI u32x4v mk4(unsigned a, unsigned b, unsigned c, unsigned d) { return (u32x4v){a, b, c, d}; }
DI u32x2v mk2(unsigned a, unsigned b) { return (u32x2v){a, b}; }
DI f32x4v mkf4(float a, float b, float c, float d) { return (f32x4v){a, b, c, d}; }
#define LDSP __attribute__((address_space(3)))
constexpr int NCH = 34, NTILE = NB * NCH;
constexpr int LD64 = 72, LD128 = 136;
constexpr float LOG2E = 1.4426950408889634f;

DI int tile_tok0(int tl) { const int b = tl / NCH, cs = tl - b * NCH; return cs < 2 ? b * CTXL + cs * 128 : TC + b * SEQ + (cs - 2) * 128; }
DI f32x4v mfma16(bf16x8v a, bf16x8v b, f32x4v c) { return __builtin_amdgcn_mfma_f32_16x16x32_bf16(a, b, c, 0, 0, 0); }
DI bf16x8v frag_row(LDSP const bf16_t* base, int ld, int r0, int k0, int lane) { return *(LDSP const bf16x8v*)(base + (r0 + (lane & 15)) * ld + k0 + 8 * (lane >> 4)); }
DI bf16x8v frag_row_g(const bf16_t* base, int ld, int r0, int k0, int lane) { return *(const bf16x8v*)(base + (size_t)(r0 + (lane & 15)) * ld + k0 + 8 * (lane >> 4)); }
DI bf16x8v frag_col(LDSP const bf16_t* base, int ld, int r0, int k0, int lane) {
    const int G = lane >> 4, i = lane & 15;
    LDSP const bf16_t* a = base + (k0 + 8 * G + (i >> 2)) * ld + r0 + 4 * (i & 3);
    const s16x4 lo = __builtin_bit_cast(s16x4, __builtin_amdgcn_ds_read_tr16_b64_v4i16((LDSP s16x4*)a));
    const s16x4 hi = __builtin_bit_cast(s16x4, __builtin_amdgcn_ds_read_tr16_b64_v4i16((LDSP s16x4*)(a + 4 * ld)));
    return (bf16x8v){lo[0], lo[1], lo[2], lo[3], hi[0], hi[1], hi[2], hi[3]};
}
DI u32x2v pack4(f32x4v v) { return mk2(pk2(v[0], v[1]), pk2(v[2], v[3])); }
DI void unpack8(u32x4v v, float* o) { o[0] = __uint_as_float(v.x << 16); o[1] = __uint_as_float(v.x & 0xffff0000u); o[2] = __uint_as_float(v.y << 16); o[3] = __uint_as_float(v.y & 0xffff0000u);
    o[4] = __uint_as_float(v.z << 16); o[5] = __uint_as_float(v.z & 0xffff0000u); o[6] = __uint_as_float(v.w << 16); o[7] = __uint_as_float(v.w & 0xffff0000u); }
DI u32x4v pack8(const float* o) { return mk4(pk2(o[0], o[1]), pk2(o[2], o[3]), pk2(o[4], o[5]), pk2(o[6], o[7])); }

DI float fast_logsigmoid(float x) { return -(fmaxf(-x, 0.f) + __logf(1.0f + __expf(-fabsf(x)))); }
DI float fast_softplus(float x) { return fmaxf(x, 0.f) + __logf(1.0f + __expf(-fabsf(x))); }
struct XbcSrc { const bf16_t* base; int ld; };
DI XbcSrc xbc_src(const P& p, int tok0) { XbcSrc r; r.base = p.XBCC + (size_t)tok0 * 768; r.ld = 768; return r; }

DI void prep_conv_item(const P& p, int l, int item, int lane) {
    int piece, ch;
    if (item < T / 32) { piece = item; ch = lane * 8; } else { piece = 2 * (item - T / 32) + (lane >> 5); ch = 512 + (lane & 31) * 8; }
    const int t0 = piece * 32; int lo, hi; bf16_t* dst; int dld;
    if (t0 < TC) { lo = t0 & ~(CTXL - 1); hi = lo + CTXL - 1; } else { lo = TC + ((t0 - TC) & ~63); hi = lo + 63; }
    dst = p.XBCC + ch; dld = 768;
    const bf16_t* src = p.PROJ + OFF_XBC + ch;
    float wgt[5][8], bias[8];
#pragma unroll
    for (int k = 0; k < 5; ++k) { const f32x4v a = *(const f32x4v*)(p.conv_w + l * 5 * 768 + k * 768 + ch), c = *(const f32x4v*)(p.conv_w + l * 5 * 768 + k * 768 + ch + 4);
#pragma unroll
        for (int j = 0; j < 4; ++j) { wgt[k][j] = a[j]; wgt[k][4 + j] = c[j]; } }
    { const f32x4v a = *(const f32x4v*)(p.conv_b + l * 768 + ch), c = *(const f32x4v*)(p.conv_b + l * 768 + ch + 4);
#pragma unroll
      for (int j = 0; j < 4; ++j) { bias[j] = a[j]; bias[4 + j] = c[j]; } }
    const u32x4v zero4 = mk4(0u, 0u, 0u, 0u);
    u32x4v rw[13];
#pragma unroll
    for (int i = 0; i < 5; ++i) { const int tt = t0 - 2 + i; rw[i] = (tt >= lo && tt <= hi) ? *(const u32x4v*)(src + (size_t)tt * LDP) : zero4; }
    for (int s0 = 0; s0 < 32; s0 += 8) {
        const int t = t0 + s0;
#pragma unroll
        for (int i = 0; i < 8; ++i) { const int tt = t + 3 + i; rw[5 + i] = (tt <= hi) ? *(const u32x4v*)(src + (size_t)tt * LDP) : zero4; }
#pragma unroll
        for (int i = 0; i < 8; ++i) {
            float o[8];
#pragma unroll
            for (int c = 0; c < 8; ++c) o[c] = bias[c];
#pragma unroll
            for (int k = 0; k < 5; ++k) { float v[8]; unpack8(rw[i + k], v);
#pragma unroll
                for (int c = 0; c < 8; ++c) o[c] += wgt[k][c] * v[c]; }
#pragma unroll
            for (int c = 0; c < 8; ++c) o[c] = siluf(o[c]);
            *(u32x4v*)(dst + (size_t)(t + i) * dld) = pack8(o);
        }
#pragma unroll
        for (int i = 0; i < 5; ++i) rw[i] = rw[i + 8];
    }
}
DI void prep_ssd_item(const P& p, int l, int item, int lane) {
    const int tl = item >> 3, h = item & 7, tok0 = tile_tok0(tl);
    const float bsf = p.dt_bias_f[l * 8 + h], bsb = p.dt_bias_b[l * 8 + h];
    const float r0 = bf2f(p.PROJ[(size_t)(tok0 + 2 * lane) * LDP + OFF_DT + h]), r1 = bf2f(p.PROJ[(size_t)(tok0 + 2 * lane + 1) * LDP + OFF_DT + h]);
    const float f0 = fast_softplus(r0 + bsf), f1 = fast_softplus(r1 + bsf), b0 = fast_softplus(r0 + bsb), b1 = fast_softplus(r1 + bsb);
    float pf = f0 + f1, sb = b0 + b1;
#pragma unroll
    for (int o = 1; o < 64; o <<= 1) { const float t = shl(pf, lane >= o ? lane - o : lane); if (lane >= o) pf += t; }
#pragma unroll
    for (int o = 1; o < 64; o <<= 1) { const float t = shl(sb, lane + o < 64 ? lane + o : lane); if (lane + o < 64) sb += t; }
    const float Af = -__expf(p.a_log_f[l * 8 + h]) * LOG2E, Ab = -__expf(p.a_log_b[l * 8 + h]) * LOG2E;
    const float af0 = Af * (pf - f1), af1 = Af * pf, ab0 = Ab * sb, ab1 = Ab * (sb - b0);
    f32x4v* dst = (f32x4v*)p.SSC + (size_t)(tok0 + 2 * lane) * 8 + h;
    dst[0] = mkf4(af0, af0 - __log2f(f0), ab0, ab0 - __log2f(b0));
    dst[8] = mkf4(af1, af1 - __log2f(f1), ab1, ab1 - __log2f(b1));
    if (lane == 63) { p.STOT[(tl * 8 + h) * 2 + 0] = af1; p.SDEC[(tl * 8 + h) * 2 + 0] = __builtin_amdgcn_exp2f(af1); }
    if (lane == 0) { p.STOT[(tl * 8 + h) * 2 + 1] = ab0; p.SDEC[(tl * 8 + h) * 2 + 1] = __builtin_amdgcn_exp2f(ab0); }
}
template <int CTRL> DI float dppz(float x) { return __builtin_bit_cast(float, __builtin_amdgcn_update_dpp(0, __builtin_bit_cast(int, x), CTRL, 0xf, 0xf, true)); }
DI float row_total(float s) { s += dppz<0xB1>(s); s += dppz<0x4E>(s); s += dppz<0x141>(s); s += dppz<0x140>(s); return s; }
struct GlaPL { u32x4v qv_[2], kv_[2], vv_[4]; bf16x8v gkf[8]; float uw[8]; f32x4v bias; };
DI void prep_gla_load(const P& p, int l, int it, GlaPL& L) {
    const int tl = it >> 2, h = it & 3;
    const int tid = ltid(), lane = tid & 63, w = __builtin_amdgcn_readfirstlane(tid >> 6), kt = w & 3, dir = w >> 2, G = lane >> 4, c = lane & 15, tok0 = tile_tok0(tl);
#pragma unroll
    for (int nt = 0; nt < 8; ++nt) L.gkf[nt] = *(const bf16x8v*)(p.PROJ + (size_t)(tok0 + 16 * nt + c) * LDP + OFF_GK + (G & 1) * 8);
    { const float* up = (dir ? p.gk_up_b : p.gk_up_f) + l * 16 * 256 + (G & 1) * 8 * 256 + h * 64 + 16 * kt + c;
#pragma unroll
      for (int e = 0; e < 8; ++e) L.uw[e] = up[e * 256]; }
    L.bias = *(const f32x4v*)((dir ? p.gk_bias_b : p.gk_bias_f) + l * 256 + h * 64 + 16 * kt + 4 * G);
#pragma unroll
    for (int q = 0; q < 4; ++q) { const int cc_ = tid + q * NTHR, r = cc_ >> 4, cc = cc_ & 15; L.vv_[q] = *(const u32x4v*)(p.PROJ + (size_t)(tok0 + r) * LDP + OFF_V + h * 128 + cc * 8); }
#pragma unroll
    for (int q = 0; q < 2; ++q) { const int cc_ = tid + q * NTHR, r = cc_ >> 3, cc = cc_ & 7; const bf16_t* pr = p.PROJ + (size_t)(tok0 + r) * LDP;
        L.qv_[q] = *(const u32x4v*)(pr + OFF_Q + h * 64 + cc * 8); L.kv_[q] = *(const u32x4v*)(pr + OFF_K + h * 64 + cc * 8); }
}
DI void prep_gla_block(const P& p, int l, int it, int it_next, GlaPL& L, LDSP unsigned char* lds) {
    const int tl = it >> 2, h = it & 3;
    const int tid = ltid(), lane = tid & 63, w = __builtin_amdgcn_readfirstlane(tid >> 6), kt = w & 3, dir = w >> 2, G = lane >> 4, c = lane & 15, tok0 = tile_tok0(tl);
    LDSP bf16_t* QT = (LDSP bf16_t*)lds; LDSP bf16_t* KT = QT + 128 * LD64; LDSP bf16_t* O4 = KT + 128 * LD64; LDSP bf16_t* VT = O4 + 4 * 128 * LD64; LDSP float* DEC = (LDSP float*)(VT + 128 * LD128);
    f32x4v g[8];
    { bf16x8v af;
#pragma unroll
      for (int e = 0; e < 8; ++e) { const bf16_t hi = f2bf(L.uw[e]); const bf16_t lo = f2bf(L.uw[e] - bf2f(hi)); af[e] = (short)(G < 2 ? hi : lo); }
#pragma unroll
      for (int nt = 0; nt < 8; ++nt) g[nt] = mfma16(af, L.gkf[nt], (f32x4v){0.f, 0.f, 0.f, 0.f}); }
#pragma unroll
    for (int nt = 0; nt < 8; ++nt)
#pragma unroll
        for (int r = 0; r < 4; ++r) { const float x = (g[nt][r] + L.bias[r]) * LOG2E;
            g[nt][r] = -(fmaxf(-x, 0.f) + __log2f(1.0f + __builtin_amdgcn_exp2f(-fabsf(x)))) * (1.0f / 16.0f); }
    f32x4v tot = (f32x4v){0.f, 0.f, 0.f, 0.f};
    if (dir == 0) {
#pragma unroll
        for (int nt = 0; nt < 8; ++nt)
#pragma unroll
            for (int r = 0; r < 4; ++r) { const float s = row_total(g[nt][r]); float x = g[nt][r];
                x += dppz<0x111>(x); x += dppz<0x112>(x); x += dppz<0x114>(x); x += dppz<0x118>(x);
                g[nt][r] = tot[r] + x; tot[r] += s; }
    } else {
#pragma unroll
        for (int nt = 7; nt >= 0; --nt)
#pragma unroll
            for (int r = 0; r < 4; ++r) { const float s = row_total(g[nt][r]); float x = g[nt][r];
                x += dppz<0x101>(x); x += dppz<0x102>(x); x += dppz<0x104>(x); x += dppz<0x108>(x);
                g[nt][r] = tot[r] + x; tot[r] += s; }
    }
    __syncthreads();
#pragma unroll
    for (int q = 0; q < 2; ++q) { const int cc_ = tid + q * NTHR, r = cc_ >> 3, cc = cc_ & 7; *(LDSP u32x4v*)(QT + r * LD64 + cc * 8) = L.qv_[q]; *(LDSP u32x4v*)(KT + r * LD64 + cc * 8) = L.kv_[q]; }
#pragma unroll
    for (int q = 0; q < 4; ++q) { const int cc_ = tid + q * NTHR, r = cc_ >> 4, cc = cc_ & 15; *(LDSP u32x4v*)(VT + r * LD128 + cc * 8) = L.vv_[q]; }
    __syncthreads();
    { LDSP bf16_t* OQ = O4 + (2 * dir) * 128 * LD64; LDSP bf16_t* OK = OQ + 128 * LD64;
#pragma unroll
      for (int nt = 0; nt < 8; ++nt) { const int o = (16 * nt + c) * LD64 + 16 * kt + 4 * G;
          const u32x2v q2 = *(LDSP const u32x2v*)(QT + o), k2 = *(LDSP const u32x2v*)(KT + o);
          float eq[4], ek[4];
#pragma unroll
          for (int r = 0; r < 4; ++r) { eq[r] = __builtin_amdgcn_exp2f(g[nt][r] - 3.0f); ek[r] = __builtin_amdgcn_exp2f(-g[nt][r]); }
          *(LDSP u32x2v*)(OQ + o) = mk2(pk2(__uint_as_float(q2.x << 16) * eq[0], __uint_as_float(q2.x & 0xffff0000u) * eq[1]), pk2(__uint_as_float(q2.y << 16) * eq[2], __uint_as_float(q2.y & 0xffff0000u) * eq[3]));
          *(LDSP u32x2v*)(OK + o) = mk2(pk2(__uint_as_float(k2.x << 16) * ek[0], __uint_as_float(k2.x & 0xffff0000u) * ek[1]), pk2(__uint_as_float(k2.y << 16) * ek[2], __uint_as_float(k2.y & 0xffff0000u) * ek[3])); }
      if (c == 0) { const f32x4v d = mkf4(__builtin_amdgcn_exp2f(tot[0]), __builtin_amdgcn_exp2f(tot[1]), __builtin_amdgcn_exp2f(tot[2]), __builtin_amdgcn_exp2f(tot[3]));
          *(f32x4v*)(p.GDEC + (size_t)((tl * 4 + h) * 2 + dir) * 64 + 16 * kt + 4 * G) = d; *(LDSP f32x4v*)(DEC + dir * 64 + 16 * kt + 4 * G) = d; } }
    __syncthreads();
    if (it_next >= 0) prep_gla_load(p, l, it_next, L);
#pragma unroll
    for (int q = 0; q < 8; ++q) { const int cc_ = tid + q * NTHR, a4 = cc_ >> 10, r = (cc_ >> 3) & 127, cc = cc_ & 7;
        *(u32x4v*)(p.QKB + (size_t)(tok0 + r) * 1024 + a4 * 256 + h * 64 + cc * 8) = *(LDSP const u32x4v*)(O4 + (a4 * 128 + r) * LD64 + cc * 8); }
    { const int ut = kt; LDSP const bf16_t* KE = O4 + (dir ? 3 : 1) * 128 * LD64;
      f32x4v acc[8];
#pragma unroll
      for (int q = 0; q < 8; ++q) acc[q] = (f32x4v){0.f, 0.f, 0.f, 0.f};
#pragma unroll
      for (int ks = 0; ks < 4; ++ks) { const bf16x8v u = frag_col(KE, LD64, 16 * ut, 32 * ks, lane);
#pragma unroll
          for (int q = 0; q < 8; ++q) acc[q] = mfma16(u, frag_col(VT, LD128, 16 * q, 32 * ks, lane), acc[q]); }
      const f32x4v dec = *(LDSP const f32x4v*)(DEC + dir * 64 + 16 * ut + 4 * (lane >> 4));
      bf16_t* dst = p.GS + ((size_t)((tl * 4 + h) * 2 + dir) * 128) * 64;
#pragma unroll
      for (int q = 0; q < 8; ++q) *(u32x2v*)(dst + (size_t)(16 * q + (lane & 15)) * 64 + 16 * ut + 4 * (lane >> 4)) = pack4(acc[q] * dec); }
}
constexpr int NPREP_A = T / 32 + T / 64, NPREP_B = NTILE * 8;
DI void ph_prep(const P& p, int l, LDSP unsigned char* lds) {
    const int tid_ = ltid(), lane = tid_ & 63, gw = blockIdx.x * NWV + (tid_ >> 6), NW = gridDim.x * NWV;
    for (int it = gw; it < NPREP_A + NPREP_B; it += NW) {
        if (it < NPREP_A) prep_conv_item(p, l, it, lane); else prep_ssd_item(p, l, it - NPREP_A, lane);
    }
    { const int G_ = gridDim.x; int it = G_ - 1 - (int)blockIdx.x;
      GlaPL L; if (it < NTILE * 4) prep_gla_load(p, l, it, L);
      for (; it < NTILE * 4; it += G_) prep_gla_block(p, l, it, it + G_ < NTILE * 4 ? it + G_ : -1, L, lds); }
}

DI void s1_ssd(const P& p, int tl, int h, LDSP unsigned char* lds) {
    const int tid = ltid(), lane = tid & 63, w = __builtin_amdgcn_readfirstlane(tid >> 6);
    const int tok0 = tile_tok0(tl), g = h >> 2; const XbcSrc xs = xbc_src(p, tok0);
    LDSP bf16_t* XWF = (LDSP bf16_t*)lds; LDSP bf16_t* XWB = XWF + 128 * LD64; LDSP bf16_t* BG = XWB + 128 * LD64;
    const int j = tid >> 2, cq = tid & 3;
    const bf16_t* row = xs.base + (size_t)j * xs.ld;
    const u32x4v x0 = *(const u32x4v*)(row + h * 64 + cq * 16), x1 = *(const u32x4v*)(row + h * 64 + cq * 16 + 8);
    const u32x4v b0 = *(const u32x4v*)(row + 512 + g * 64 + cq * 16), b1 = *(const u32x4v*)(row + 512 + g * 64 + cq * 16 + 8);
    const f32x4v sc = *((const f32x4v*)p.SSC + (size_t)(tok0 + j) * 8 + h);
    const float wf = __builtin_amdgcn_exp2f(p.STOT[(tl * 8 + h) * 2 + 0] - sc.y), wb = __builtin_amdgcn_exp2f(p.STOT[(tl * 8 + h) * 2 + 1] - sc.w);
    float xv[16], of[16], ob[16]; unpack8(x0, xv); unpack8(x1, xv + 8);
#pragma unroll
    for (int c = 0; c < 16; ++c) { of[c] = xv[c] * wf; ob[c] = xv[c] * wb; }
    __syncthreads();
    *(LDSP u32x4v*)(XWF + j * LD64 + cq * 16) = pack8(of); *(LDSP u32x4v*)(XWF + j * LD64 + cq * 16 + 8) = pack8(of + 8);
    *(LDSP u32x4v*)(XWB + j * LD64 + cq * 16) = pack8(ob); *(LDSP u32x4v*)(XWB + j * LD64 + cq * 16 + 8) = pack8(ob + 8);
    *(LDSP u32x4v*)(BG + j * LD64 + cq * 16) = b0; *(LDSP u32x4v*)(BG + j * LD64 + cq * 16 + 8) = b1;
    __syncthreads();
    const int dir = w >> 2, ut = w & 3; LDSP const bf16_t* XW = dir ? XWB : XWF;
    f32x4v acc[4];
#pragma unroll
    for (int q = 0; q < 4; ++q) acc[q] = (f32x4v){0.f, 0.f, 0.f, 0.f};
#pragma unroll
    for (int ks = 0; ks < 4; ++ks) { const bf16x8v u = frag_col(BG, LD64, 16 * ut, 32 * ks, lane);
#pragma unroll
        for (int q = 0; q < 4; ++q) acc[q] = mfma16(u, frag_col(XW, LD64, 16 * q, 32 * ks, lane), acc[q]); }
    bf16_t* dst = p.SS + ((size_t)((tl * 8 + h) * 2 + dir) * 64) * 64;
#pragma unroll
    for (int q = 0; q < 4; ++q) *(u32x2v*)(dst + (size_t)(16 * q + (lane & 15)) * 64 + 16 * ut + 4 * (lane >> 4)) = pack4(acc[q]);
}
DI void ph_s1(const P& p, int l, LDSP unsigned char* lds) {
    for (int it = blockIdx.x; it < NTILE * 8; it += gridDim.x) s1_ssd(p, it >> 3, it & 7, lds);
}

DI int s2_chunk(int dir, int s) { return dir == 0 ? s : (s < 2 ? 1 - s : 35 - s); }
DI void ph_s2(const P& p) {
    const int g = blockIdx.x * NTHR + ltid();
    for (int v = g; v < 131072; v += gridDim.x * NTHR) {
        const bool gla = v >= 65536; const int r = v & 65535;
        int b, h, dir, vi;
        if (!gla) { vi = r & 511; dir = (r >> 9) & 1; h = (r >> 10) & 7; b = r >> 13; } else { vi = r & 1023; dir = (r >> 10) & 1; h = (r >> 11) & 3; b = r >> 13; }
        float st[8];
#pragma unroll
        for (int e = 0; e < 8; ++e) st[e] = 0.f;
        for (int s0 = 0; s0 < NCH; s0 += 6) {
            u32x4v sv[6]; float dsc[6]; f32x4v dv0[6], dv1[6];
#pragma unroll
            for (int u = 0; u < 6; ++u) { if (s0 + u >= NCH) continue; const int tl = b * NCH + s2_chunk(dir, s0 + u);
                if (!gla) { sv[u] = *(const u32x4v*)(p.SS + ((size_t)((tl * 8 + h) * 2 + dir) * 512 + vi) * 8); dsc[u] = p.SDEC[(tl * 8 + h) * 2 + dir]; }
                else { sv[u] = *(const u32x4v*)(p.GS + ((size_t)((tl * 4 + h) * 2 + dir) * 1024 + vi) * 8); const f32x4v* d = (const f32x4v*)(p.GDEC + (size_t)((tl * 4 + h) * 2 + dir) * 64 + (vi & 7) * 8); dv0[u] = d[0]; dv1[u] = d[1]; } }
#pragma unroll
            for (int u = 0; u < 6; ++u) { if (s0 + u >= NCH) continue; const int tl = b * NCH + s2_chunk(dir, s0 + u);
                float loc[8]; unpack8(sv[u], loc);
                const u32x4v hin = pack8(st);
                if (!gla) { *(u32x4v*)(p.SS + ((size_t)((tl * 8 + h) * 2 + dir) * 512 + vi) * 8) = hin;
#pragma unroll
                    for (int e = 0; e < 8; ++e) st[e] = dsc[u] * st[e] + loc[e]; }
                else { *(u32x4v*)(p.GS + ((size_t)((tl * 4 + h) * 2 + dir) * 1024 + vi) * 8) = hin;
                    const float dd[8] = {dv0[u].x, dv0[u].y, dv0[u].z, dv0[u].w, dv1[u].x, dv1[u].y, dv1[u].z, dv1[u].w};
#pragma unroll
                    for (int e = 0; e < 8; ++e) st[e] = dd[e] * st[e] + loc[e]; } }
        }
    }
}

DI int s3_tile(int l, int q) { return l == 0 ? q : (q >> 5) * NCH + 2 + (q & 31); }
struct SsdPre { u32x4v x0, x1, b0, b1, c0, c1, hf, hb; f32x4v sc; };
DI void s3_ssd_load(const P& p, int tl, int h, int tid, int i, int G, SsdPre& r) {
    const int tok0 = tile_tok0(tl), g = h >> 2; const XbcSrc xs = xbc_src(p, tok0);
    const int j = tid >> 2, cq = tid & 3; const bf16_t* row = xs.base + (size_t)j * xs.ld;
    r.x0 = *(const u32x4v*)(row + h * 64 + cq * 16); r.x1 = *(const u32x4v*)(row + h * 64 + cq * 16 + 8);
    r.b0 = *(const u32x4v*)(row + 512 + g * 64 + cq * 16); r.b1 = *(const u32x4v*)(row + 512 + g * 64 + cq * 16 + 8);
    r.c0 = *(const u32x4v*)(row + 640 + g * 64 + cq * 16); r.c1 = *(const u32x4v*)(row + 640 + g * 64 + cq * 16 + 8);
    const bf16_t* Hf = p.SS + (size_t)((tl * 8 + h) * 2 + 0) * 4096 + (tid >> 3) * 64 + (tid & 7) * 8;
    r.hf = *(const u32x4v*)Hf; r.hb = *(const u32x4v*)(Hf + 4096);
    r.sc = *((const f32x4v*)p.SSC + (size_t)(tok0 + (tid & 127)) * 8 + h);
}
DI void ph_s3_ssd(const P& p, int l, LDSP unsigned char* lds) {
    const int tid = ltid(), lane = tid & 63, w = __builtin_amdgcn_readfirstlane(tid >> 6), G = lane >> 4, li = lane & 15, i = 16 * w + li;
    LDSP bf16_t* XH = (LDSP bf16_t*)lds; LDSP bf16_t* BG = XH + 128 * LD64; LDSP bf16_t* CG = BG + 128 * LD64; LDSP bf16_t* MM = CG + 128 * LD64; LDSP f32x4v* SC = (LDSP f32x4v*)(MM + 128 * LD128);
    LDSP bf16_t* HF = (LDSP bf16_t*)(SC + 128); LDSP bf16_t* HB = HF + 64 * LD64;
    const int nit = (l == 0 ? NTILE : NB * 32) * 8, GS_ = gridDim.x;
    int it = ((int)blockIdx.x + (GS_ >> 1)) % GS_; SsdPre pre;
    if (it < nit) s3_ssd_load(p, s3_tile(l, it >> 3), it & 7, tid, i, G, pre);
    for (; it < nit; it += GS_) {
        const int tl = s3_tile(l, it >> 3), h = it & 7, tok0 = tile_tok0(tl);
        __syncthreads();
        { const int j = tid >> 2, cq = tid & 3;
          *(LDSP u32x4v*)(XH + j * LD64 + cq * 16) = pre.x0; *(LDSP u32x4v*)(XH + j * LD64 + cq * 16 + 8) = pre.x1;
          *(LDSP u32x4v*)(BG + j * LD64 + cq * 16) = pre.b0; *(LDSP u32x4v*)(BG + j * LD64 + cq * 16 + 8) = pre.b1;
          *(LDSP u32x4v*)(CG + j * LD64 + cq * 16) = pre.c0; *(LDSP u32x4v*)(CG + j * LD64 + cq * 16 + 8) = pre.c1;
          *(LDSP u32x4v*)(HF + (tid >> 3) * LD64 + (tid & 7) * 8) = pre.hf; *(LDSP u32x4v*)(HB + (tid >> 3) * LD64 + (tid & 7) * 8) = pre.hb;
          if (tid < 128) SC[tid] = pre.sc; }
        if (it + GS_ < nit) s3_ssd_load(p, s3_tile(l, (it + GS_) >> 3), (it + GS_) & 7, tid, i, G, pre);
        __syncthreads();
        u32x2v zr[4];
#pragma unroll
        for (int pt = 0; pt < 4; ++pt) zr[pt] = *(const u32x2v*)(p.PROJ + (size_t)(tok0 + i) * LDP + OFF_Z + h * 64 + 16 * pt + 4 * G);
        const f32x4v sci = SC[i];
        {
            f32x4v am[8];
#pragma unroll
            for (int ut = 0; ut < 8; ++ut) am[ut] = (f32x4v){0.f, 0.f, 0.f, 0.f};
#pragma unroll
            for (int ks = 0; ks < 2; ++ks) { const bf16x8v vfr = frag_row(CG, LD64, 16 * w, 32 * ks, lane);
#pragma unroll
                for (int ut = 0; ut < 8; ++ut) am[ut] = mfma16(frag_row(BG, LD64, 16 * ut, 32 * ks, lane), vfr, am[ut]); }
#pragma unroll
            for (int ut = 0; ut < 8; ++ut) { f32x4v m;
#pragma unroll
                for (int r = 0; r < 4; ++r) { const int jj = 16 * ut + 4 * G + r; const f32x4v scj = SC[jj];
                    const float Lf = jj <= i ? __builtin_amdgcn_exp2f(fminf(sci.x - scj.y, 30.f)) : 0.f, Lb = jj >= i ? __builtin_amdgcn_exp2f(fminf(sci.z - scj.w, 30.f)) : 0.f;
                    m[r] = am[ut][r] * (Lf + Lb); }
                *(LDSP u32x2v*)(MM + i * LD128 + 16 * ut + 4 * G) = pack4(m); }
        }
        asm volatile("s_waitcnt lgkmcnt(0)" ::: "memory");
        f32x4v ay[4], af_[4], ab_[4];
#pragma unroll
        for (int pt = 0; pt < 4; ++pt) { ay[pt] = (f32x4v){0.f, 0.f, 0.f, 0.f}; af_[pt] = ay[pt]; ab_[pt] = ay[pt]; }
#pragma unroll
        for (int ks = 0; ks < 2; ++ks) { const bf16x8v vfr = frag_row(CG, LD64, 16 * w, 32 * ks, lane);
#pragma unroll
            for (int pt = 0; pt < 4; ++pt) { af_[pt] = mfma16(frag_row(HF, LD64, 16 * pt, 32 * ks, lane), vfr, af_[pt]); ab_[pt] = mfma16(frag_row(HB, LD64, 16 * pt, 32 * ks, lane), vfr, ab_[pt]); } }
#pragma unroll
        for (int ks = 0; ks < 4; ++ks) { const bf16x8v vfr = frag_row(MM, LD128, 16 * w, 32 * ks, lane);
#pragma unroll
            for (int pt = 0; pt < 4; ++pt) ay[pt] = mfma16(frag_col(XH, LD64, 16 * pt, 32 * ks, lane), vfr, ay[pt]); }
        const float sf = __builtin_amdgcn_exp2f(sci.x), sb = __builtin_amdgcn_exp2f(sci.z), dsk = p.d_skip[l * 8 + h];
        float ssq = 0.f;
#pragma unroll
        for (int pt = 0; pt < 4; ++pt) { const int pc = 16 * pt + 4 * G;
            const u32x2v xr = *(LDSP const u32x2v*)(XH + i * LD64 + pc);
            const float xv[4] = {__uint_as_float(xr.x << 16), __uint_as_float(xr.x & 0xffff0000u), __uint_as_float(xr.y << 16), __uint_as_float(xr.y & 0xffff0000u)};
            const float zv[4] = {__uint_as_float(zr[pt].x << 16), __uint_as_float(zr[pt].x & 0xffff0000u), __uint_as_float(zr[pt].y << 16), __uint_as_float(zr[pt].y & 0xffff0000u)};
            float yv[4];
#pragma unroll
            for (int r = 0; r < 4; ++r) { yv[r] = (ay[pt][r] + sf * af_[pt][r] + sb * ab_[pt][r] + dsk * xv[r]) * siluf(zv[r]); yv[r] = bf2f(f2bf(yv[r])); ssq += yv[r] * yv[r]; }
            *(u32x2v*)(p.H + (size_t)(tok0 + i) * D + h * 64 + pc) = mk2(pk2(yv[0], yv[1]), pk2(yv[2], yv[3])); }
        ssq += shx(ssq, 16, lane); ssq += shx(ssq, 32, lane);
        if (G == 0) p.SSQ[(size_t)(tok0 + i) * 8 + h] = ssq;
    }
}
struct GlaPre { u32x4v qk[2][4], vv[4], sf[2], sb[2]; };
DI void s3_gla_load(const P& p, int tl, int h, int tid, int i, int G, GlaPre& r) {
    const int tok0 = tile_tok0(tl);
#pragma unroll
    for (int q = 0; q < 2; ++q) { const int c = tid + q * NTHR, rr = c >> 3, cc = c & 7; const bf16_t* qb = p.QKB + (size_t)(tok0 + rr) * 1024 + h * 64 + cc * 8;
        r.qk[q][0] = *(const u32x4v*)qb; r.qk[q][1] = *(const u32x4v*)(qb + 256);
        r.qk[q][2] = *(const u32x4v*)(qb + 512); r.qk[q][3] = *(const u32x4v*)(qb + 768);
        const bf16_t* Sg = p.GS + (size_t)((tl * 4 + h) * 2 + 0) * 8192 + (size_t)rr * 64 + cc * 8; r.sf[q] = *(const u32x4v*)Sg; r.sb[q] = *(const u32x4v*)(Sg + 8192); }
#pragma unroll
    for (int q = 0; q < 4; ++q) { const int c = tid + q * NTHR, rr = c >> 4, cc = c & 15; r.vv[q] = *(const u32x4v*)(p.PROJ + (size_t)(tok0 + rr) * LDP + OFF_V + h * 128 + cc * 8); }
}
DI void ph_s3_gla(const P& p, int l, LDSP unsigned char* lds) {
    const int tid = ltid(), lane = tid & 63, w = __builtin_amdgcn_readfirstlane(tid >> 6), G = lane >> 4, li = lane & 15, i = 16 * w + li;
    LDSP bf16_t* Q2 = (LDSP bf16_t*)lds;
    LDSP bf16_t* KF = Q2 + 8 * 2 * 16 * LD64; LDSP bf16_t* KB = KF + 128 * LD64; LDSP bf16_t* VT = KB + 128 * LD64; LDSP bf16_t* SF = VT + 128 * LD128; LDSP bf16_t* SB = SF + 128 * LD64;
    LDSP bf16_t* AMw = SF + w * 16 * LD128;
    const int nit = (l == 0 ? NTILE : NB * 32) * 4, GS_ = gridDim.x;
    int it = blockIdx.x; GlaPre pre;
    if (it < nit) s3_gla_load(p, s3_tile(l, it >> 2), it & 3, tid, i, G, pre);
    for (; it < nit; it += GS_) {
        const int tl = s3_tile(l, it >> 2), h = it & 3, tok0 = tile_tok0(tl);
        __syncthreads();
#pragma unroll
        for (int q = 0; q < 2; ++q) { const int c = tid + q * NTHR, rr = c >> 3, cc = c & 7; LDSP bf16_t* qrow = Q2 + (rr >> 4) * (2 * 16 * LD64) + (rr & 15) * LD64 + cc * 8;
            *(LDSP u32x4v*)qrow = pre.qk[q][0]; *(LDSP u32x4v*)(qrow + 16 * LD64) = pre.qk[q][2];
            *(LDSP u32x4v*)(KF + rr * LD64 + cc * 8) = pre.qk[q][1]; *(LDSP u32x4v*)(KB + rr * LD64 + cc * 8) = pre.qk[q][3];
            *(LDSP u32x4v*)(SF + rr * LD64 + cc * 8) = pre.sf[q]; *(LDSP u32x4v*)(SB + rr * LD64 + cc * 8) = pre.sb[q]; }
#pragma unroll
        for (int q = 0; q < 4; ++q) { const int c = tid + q * NTHR, rr = c >> 4, cc = c & 15; *(LDSP u32x4v*)(VT + rr * LD128 + cc * 8) = pre.vv[q]; }
        if (it + GS_ < nit) s3_gla_load(p, s3_tile(l, (it + GS_) >> 2), (it + GS_) & 3, tid, i, G, pre);
        __syncthreads();
        f32x4v ao[8];
#pragma unroll
        for (int q = 0; q < 8; ++q) ao[q] = (f32x4v){0.f, 0.f, 0.f, 0.f};
        bf16x8v qfr[2][2];
#pragma unroll
        for (int dir = 0; dir < 2; ++dir)
#pragma unroll
            for (int ks = 0; ks < 2; ++ks) qfr[dir][ks] = frag_row(Q2 + w * (2 * 16 * LD64) + dir * 16 * LD64, LD64, 0, 32 * ks, lane);
#pragma unroll
        for (int dir = 0; dir < 2; ++dir) {
            LDSP const bf16_t* SS_ = dir ? SB : SF;
#pragma unroll
            for (int ks = 0; ks < 2; ++ks) {
#pragma unroll
                for (int vt = 0; vt < 8; ++vt) ao[vt] = mfma16(frag_row(SS_, LD64, 16 * vt, 32 * ks, lane), qfr[dir][ks], ao[vt]); }
        }
        __syncthreads();
#pragma unroll
        for (int uh = 0; uh < 4; ++uh) {
            f32x4v a2[2]; a2[0] = (f32x4v){0.f, 0.f, 0.f, 0.f}; a2[1] = a2[0];
#pragma unroll
            for (int dir = 0; dir < 2; ++dir) {
                LDSP const bf16_t* KS = dir ? KB : KF;
                f32x4v as[2]; as[0] = (f32x4v){0.f, 0.f, 0.f, 0.f}; as[1] = as[0];
#pragma unroll
                for (int ks = 0; ks < 2; ++ks) {
#pragma unroll
                    for (int q = 0; q < 2; ++q) as[q] = mfma16(frag_row(KS, LD64, 16 * (2 * uh + q), 32 * ks, lane), qfr[dir][ks], as[q]); }
#pragma unroll
                for (int q = 0; q < 2; ++q)
#pragma unroll
                    for (int r = 0; r < 4; ++r) { const int jj = 16 * (2 * uh + q) + 4 * G + r; const bool keep = dir == 0 ? (jj <= i) : (jj >= i); a2[q][r] += keep ? as[q][r] : 0.f; }
            }
#pragma unroll
            for (int q = 0; q < 2; ++q) *(LDSP u32x2v*)(AMw + li * LD128 + 16 * (2 * uh + q) + 4 * G) = pack4(a2[q]);
        }
        u32x2v gr[8];
#pragma unroll
        for (int vt = 0; vt < 8; ++vt) gr[vt] = *(const u32x2v*)(p.PROJ + (size_t)(tok0 + i) * LDP + OFF_GO + h * 128 + 16 * vt + 4 * G);
        asm volatile("s_waitcnt lgkmcnt(0)" ::: "memory");
#pragma unroll
        for (int ks = 0; ks < 4; ++ks) { const bf16x8v vfr = frag_row(AMw, LD128, 0, 32 * ks, lane);
#pragma unroll
            for (int vt = 0; vt < 8; ++vt) ao[vt] = mfma16(frag_col(VT, LD128, 16 * vt, 32 * ks, lane), vfr, ao[vt]); }
        float so = 0.f;
#pragma unroll
        for (int vt = 0; vt < 8; ++vt)
#pragma unroll
            for (int r = 0; r < 4; ++r) so += ao[vt][r] * ao[vt][r];
        so += shx(so, 16, lane); so += shx(so, 32, lane);
        const float ro = rsqrtf(so * (1.0f / 128.0f) + 1e-6f);
#pragma unroll
        for (int vt = 0; vt < 8; ++vt) { const int vc = 16 * vt + 4 * G; const f32x4v gg = *(const f32x4v*)(p.gla_norm_g + l * 128 + vc);
            const float g0 = __uint_as_float(gr[vt].x << 16), g1 = __uint_as_float(gr[vt].x & 0xffff0000u), g2 = __uint_as_float(gr[vt].y << 16), g3 = __uint_as_float(gr[vt].y & 0xffff0000u);
            *(u32x2v*)(p.H + (size_t)(tok0 + i) * D + 512 + h * 128 + vc) = mk2(pk2(ao[vt][0] * ro * gg.x * siluf(g0), ao[vt][1] * ro * gg.y * siluf(g1)), pk2(ao[vt][2] * ro * gg.z * siluf(g2), ao[vt][3] * ro * gg.w * siluf(g3))); }
    }
}
DI void ph_s3(const P& p, int l, LDSP unsigned char* lds) { ph_s3_gla(p, l, lds); ph_s3_ssd(p, l, lds); }
DI void ph_normroute(const P& p, int l, int t0, LDSP unsigned char* lds) {
    const int tid_ = ltid(), lane = tid_ & 63, wv = tid_ >> 6, gw = blockIdx.x * NWV + wv, NW = gridDim.x * NWV, G = lane >> 4, li = lane & 15;
    const float* MODl = p.MOD + (size_t)l * 9 * 6144; int* counts = p.counts + l * 32 * 32;
    constexpr int LDW = 1032, LDT = 264;
    LDSP bf16_t* WR = (LDSP bf16_t*)lds;
    LDSP bf16_t* HT = WR + 32 * LDW + wv * 16 * LDT;
    { u32x4v wv_[8];
#pragma unroll
      for (int q = 0; q < 8; ++q) wv_[q] = *(const u32x4v*)(p.WRT + (size_t)(tid_ + q * NTHR) * 8);
#pragma unroll
      for (int q = 0; q < 8; ++q) { const int c = tid_ + q * NTHR; *(LDSP u32x4v*)(WR + (c >> 7) * LDW + (c & 127) * 8) = wv_[q]; } }
    __syncthreads();
    const int ntile = (T - t0) >> 4;
    const float* g2 = p.norm2_g + l * D;
    for (int tile = gw; tile < ntile; tile += NW) {
        const int tb = t0 + tile * 16;
        const float* mr = MODl + (size_t)tok_modrow(tb) * 6144;
        float rs[16];
        { const f32x4v* q = (const f32x4v*)(p.XSS + (size_t)(tb + li) * 16); const f32x4v a = q[0], b = q[1], c = q[2], d = q[3];
          const float ss = (((a.x + a.y) + (a.z + a.w)) + ((b.x + b.y) + (b.z + b.w))) + (((c.x + c.y) + (c.z + c.w)) + ((d.x + d.y) + (d.z + d.w)));
          const float r = rsqrtf(ss * (1.0f / D) + 1e-6f);
#pragma unroll
          for (int i = 0; i < 16; ++i) rs[i] = shl(r, i); }
        f32x4v acc[2]; acc[0] = (f32x4v){0.f, 0.f, 0.f, 0.f}; acc[1] = acc[0];
        u32x2v xq[16];
#pragma unroll
        for (int i = 0; i < 16; ++i) xq[i] = *(const u32x2v*)(xrow(p, tb + i) + lane * 4);
#pragma unroll
        for (int kc = 0; kc < 4; ++kc) {
            const int kk = kc * 256 + lane * 4;
            const f32x4v gg = *(const f32x4v*)(g2 + kk), sh = *(const f32x4v*)(mr + 3 * 1024 + kk), sc = *(const f32x4v*)(mr + 4 * 1024 + kk);
            f32x4v gs;
#pragma unroll
            for (int j = 0; j < 4; ++j) gs[j] = gg[j] * (1.f + sc[j]);
#pragma unroll
            for (int i = 0; i < 16; ++i) { const u32x2v r = xq[i];
                const f32x4v xv = mkf4(__uint_as_float(r.x << 16), __uint_as_float(r.x & 0xffff0000u), __uint_as_float(r.y << 16), __uint_as_float(r.y & 0xffff0000u));
                const f32x4v h = xv * rs[i] * gs + sh; const u32x2v hb = pack4(h);
                *(unsigned*)((unsigned char*)p.H + (size_t)(tb + i) * D + kk) = pg8::pk4_fp8(h);
                *(LDSP u32x2v*)(HT + i * LDT + lane * 4) = hb; }
            if (kc < 3) {
#pragma unroll
                for (int i = 0; i < 16; ++i) xq[i] = *(const u32x2v*)(xrow(p, tb + i) + kk + 256); }
            asm volatile("s_waitcnt lgkmcnt(0)" ::: "memory");
#pragma unroll
            for (int ks = 0; ks < 8; ++ks) { const bf16x8v vfr = frag_row(HT, LDT, 0, 32 * ks, lane);
                acc[0] = mfma16(frag_row(WR, LDW, 0, kc * 256 + 32 * ks, lane), vfr, acc[0]);
                acc[1] = mfma16(frag_row(WR, LDW, 16, kc * 256 + 32 * ks, lane), vfr, acc[1]); }
            asm volatile("s_waitcnt lgkmcnt(0)" ::: "memory");
        }
        float bgs = -1e30f; int bgi = 0, e1 = 0, e2 = 0; float w1 = 0.f, w2 = 0.f;
#pragma unroll
        for (int ut = 0; ut < 2; ++ut) { const int gi = ut * 4 + G; float m1 = -1e30f, m2 = -1e30f, s1 = 0.f, s2 = 0.f; int i1 = 0, i2 = 0;
#pragma unroll
            for (int r = 0; r < 4; ++r) { const float sv = 1.0f / (1.0f + __expf(-acc[ut][r])), vv = sv + p.router_bias[gi * 4 + r];
                if (vv > m1) { m2 = m1; i2 = i1; s2 = s1; m1 = vv; i1 = gi * 4 + r; s1 = sv; } else if (vv > m2) { m2 = vv; i2 = gi * 4 + r; s2 = sv; } }
            if (m1 + m2 > bgs) { bgs = m1 + m2; bgi = gi; e1 = i1; e2 = i2; w1 = s1; w2 = s2; } }
#pragma unroll
        for (int o = 16; o <= 32; o <<= 1) {
            const float ogs = shx(bgs, o, lane), ow1 = shx(w1, o, lane), ow2 = shx(w2, o, lane); const int ogi = shxi(bgi, o, lane), oe1 = shxi(e1, o, lane), oe2 = shxi(e2, o, lane);
            if (ogs > bgs || (ogs == bgs && ogi < bgi)) { bgs = ogs; bgi = ogi; e1 = oe1; e2 = oe2; w1 = ow1; w2 = ow2; } }
        if (G == 0) {
            const int t = tb + li; const float inv = 1.0f / (w1 + w2);
            const int r1 = atomicAdd(&counts[e1 * 32], 1), r2 = atomicAdd(&counts[e2 * 32], 1);
            p.MAP[(size_t)e1 * T + r1] = t; p.MAP[(size_t)e2 * T + r2] = t;
            p.TOKSLOT[t * 4 + 0] = e1; p.TOKSLOT[t * 4 + 1] = r1; p.TOKSLOT[t * 4 + 2] = e2; p.TOKSLOT[t * 4 + 3] = r2;
            p.EW[t * 2 + 0] = w1 * inv; p.EW[t * 2 + 1] = w2 * inv;
        }
    }
}

DI void ph_combine(const P& p, int l, int t0, const unsigned char* Y  , LDSP int* ps  ) {
    const int tid_ = ltid(), lane = tid_ & 63, gw = blockIdx.x * NWV + (tid_ >> 6), NW = gridDim.x * NWV;
    const float* MODl = p.MOD + (size_t)l * 9 * 6144; const int* counts = p.counts + l * 32 * 32;
    if (tid_ < 64) { const int cnt = tid_ < 32 ? counts[tid_ * 32] : 0; int pc = cnt;
#pragma unroll
        for (int o = 1; o < 32; o <<= 1) { const int src = lane >= o ? lane - o : lane; const int a = shli(pc, src); if (lane >= o) pc += a; }
        if (tid_ < 32) ps[tid_] = pc - cnt; }
    __syncthreads();
    for (int t = t0 + 4 * gw; t < T; t += 4 * NW) {
        int4 sl[4]; float4 ew[2];
#pragma unroll
        for (int u = 0; u < 4; ++u) sl[u] = *(const int4*)(p.TOKSLOT + (size_t)(t + u) * 4);
        ew[0] = *(const float4*)(p.EW + (size_t)t * 2); ew[1] = *(const float4*)(p.EW + (size_t)(t + 2) * 2);
        unsigned yr[4][2][4];
#pragma unroll
        for (int u = 0; u < 4; ++u) { const unsigned char* y0 = Y + (size_t)(ps[sl[u].x] + sl[u].y) * D; const unsigned char* y1 = Y + (size_t)(ps[sl[u].z] + sl[u].w) * D;
#pragma unroll
            for (int i = 0; i < 4; ++i) { yr[u][0][i] = *(const unsigned*)(y0 + (i * 64 + lane) * 4); yr[u][1][i] = *(const unsigned*)(y1 + (i * 64 + lane) * 4); } }
        const float* mrow = MODl + (size_t)tok_modrow(t) * 6144; const float* g5 = mrow + 5 * 1024;
        const float* mr1 = p.MOD + (size_t)9 * 6144 + (size_t)tok_modrow(t) * 6144;
#pragma unroll
        for (int pr = 0; pr < 2; ++pr) {
            const float wgt[2][2] = {{ew[pr].x, ew[pr].y}, {ew[pr].z, ew[pr].w}};
            u32x2v xr[2][4];
#pragma unroll
            for (int u = 0; u < 2; ++u)
#pragma unroll
                for (int i = 0; i < 4; ++i) xr[u][i] = *(const u32x2v*)(xrow(p, t + 2 * pr + u) + (i * 64 + lane) * 4);
            float4 v[2][4];
#pragma unroll
            for (int i = 0; i < 4; ++i) { const int c = (i * 64 + lane) * 4; const float4 gg = *(const float4*)(g5 + c);
#pragma unroll
                for (int u = 0; u < 2; ++u) { const u32x2v x = xr[u][i]; const int a = (int)yr[2 * pr + u][0][i], b = (int)yr[2 * pr + u][1][i]; const float w1 = wgt[u][0], w2 = wgt[u][1];
                    v[u][i].x = __uint_as_float(x.x << 16) + gg.x * (w1 * __builtin_amdgcn_cvt_f32_fp8(a, 0) + w2 * __builtin_amdgcn_cvt_f32_fp8(b, 0));
                    v[u][i].y = __uint_as_float(x.x & 0xffff0000u) + gg.y * (w1 * __builtin_amdgcn_cvt_f32_fp8(a, 1) + w2 * __builtin_amdgcn_cvt_f32_fp8(b, 1));
                    v[u][i].z = __uint_as_float(x.y << 16) + gg.z * (w1 * __builtin_amdgcn_cvt_f32_fp8(a, 2) + w2 * __builtin_amdgcn_cvt_f32_fp8(b, 2));
                    v[u][i].w = __uint_as_float(x.y & 0xffff0000u) + gg.w * (w1 * __builtin_amdgcn_cvt_f32_fp8(a, 3) + w2 * __builtin_amdgcn_cvt_f32_fp8(b, 3));
                    if (l == 0) *(u32x2v*)(xrow(p, t + 2 * pr + u) + c) = mk2(pk2(v[u][i].x, v[u][i].y), pk2(v[u][i].z, v[u][i].w)); } }
            float rstd[2];
#pragma unroll
            for (int u = 0; u < 2; ++u) { float ss = 0.f;
#pragma unroll
                for (int i = 0; i < 4; ++i) ss += v[u][i].x * v[u][i].x + v[u][i].y * v[u][i].y + v[u][i].z * v[u][i].z + v[u][i].w * v[u][i].w;
                rstd[u] = rsqrtf(wave_sum(ss, lane) * (1.0f / D) + 1e-6f); }
            if (l == 0) {
#pragma unroll
                for (int i = 0; i < 4; ++i) { const int c = (i * 64 + lane) * 4;
                    const float4 gg = *(const float4*)(p.norm1_g + D + c), sh = *(const float4*)(mr1 + c), sc = *(const float4*)(mr1 + 1024 + c);
#pragma unroll
                    for (int u = 0; u < 2; ++u) { const float r = rstd[u];
                        *(u32x2v*)(p.H + (size_t)(t + 2 * pr + u) * D + c) = mk2(pk2(v[u][i].x * r * gg.x * (1.f + sc.x) + sh.x, v[u][i].y * r * gg.y * (1.f + sc.y) + sh.y), pk2(v[u][i].z * r * gg.z * (1.f + sc.z) + sh.z, v[u][i].w * r * gg.w * (1.f + sc.w) + sh.w)); } }
            } else {
#pragma unroll
                for (int u = 0; u < 2; ++u)
#pragma unroll
                    for (int i = 0; i < 4; ++i) { const float4 gg = ((const float4*)p.final_g)[i * 64 + lane]; const float r = rstd[u];
                        ((float4*)(p.out + (size_t)(t + 2 * pr + u - TC) * D))[i * 64 + lane] = make_float4(v[u][i].x * r * gg.x, v[u][i].y * r * gg.y, v[u][i].z * r * gg.z, v[u][i].w * r * gg.w); }
            }
        }
    }
}

#define XLAS __attribute__((address_space(3)))
#define XB_TMO      128
#define XB_XCNT(j)  (256  + 64 * (j))
#define XB_XSUB(j)  (1280 + 64 * (j))
#define XB_XGEN(j)  (2304 + 64 * (j))
#define XB_TOP      3328
#define XB_TOPGEN   3392
#define XCD_BAR_WORDS 3456
#define XB_SPIN_CAP (1u << 18)

__device__ __forceinline__ unsigned xb_ld(unsigned* p)              { return __hip_atomic_load(p, __ATOMIC_RELAXED, __HIP_MEMORY_SCOPE_AGENT); }
__device__ __forceinline__ unsigned xb_add(unsigned* p, unsigned v) { return __hip_atomic_fetch_add(p, v, __ATOMIC_RELAXED, __HIP_MEMORY_SCOPE_AGENT); }
__device__ __forceinline__ unsigned xb_xcc_id() { return (unsigned)__builtin_amdgcn_s_getreg((3 << 11) | 20) & 0xFu; }
#define XB_SPIN(cond, bar) do { unsigned _sp = 0; while (cond) { __builtin_amdgcn_s_sleep(1); \
    if ((++_sp & 255u) == 0u) { if (xb_ld(&(bar)[XB_TMO])) break; if (_sp > XB_SPIN_CAP) { atomicAdd(&(bar)[XB_TMO], 1u); break; } } } } while (0)

struct XcdBarrier {
    unsigned* bar; unsigned x;
    volatile XLAS unsigned* st;
};

__device__ __forceinline__ XcdBarrier xcd_barrier_post(unsigned* bar, volatile XLAS unsigned* st) {
    XcdBarrier b; b.bar = bar; b.x = xb_xcc_id(); b.st = st;
    if (ltid() == 0) (void)xb_add(&bar[XB_XCNT(b.x)], 1u);
    return b;
}
__device__ __forceinline__ void xcd_barrier_complete(unsigned* bar, unsigned x, unsigned& nloc, unsigned& nx) {
    const unsigned G = gridDim.x * gridDim.y * gridDim.z;
    unsigned sum, cnt, mine, sp = 0u;
    for (;;) {
        sum = 0u; cnt = 0u; mine = 0u;
#pragma unroll
        for (unsigned j = 0; j < 16; ++j) { const unsigned c = xb_ld(&bar[XB_XCNT(j)]); sum += c; cnt += (c > 0u) ? 1u : 0u; mine = (j == x) ? c : mine; }
        if (sum == G) break;
        __builtin_amdgcn_s_sleep(1);
        if ((++sp & 255u) == 0u) { if (xb_ld(&bar[XB_TMO])) break; if (sp > XB_SPIN_CAP) { atomicAdd(&bar[XB_TMO], 1u); break; } }
    }
    nloc = mine > 0u ? mine : 1u; nx = cnt > 0u ? cnt : 1u;
}

__device__ __forceinline__ void xcd_barrier(const XcdBarrier& b) {
    asm volatile("s_waitcnt vmcnt(0)" ::: "memory");
    __syncthreads();
    if (ltid() == 0) {
        unsigned* bar = b.bar;
        __builtin_amdgcn_s_waitcnt(0);
        unsigned nloc = b.st[0], nx = b.st[1];
        if (nloc == 0u) { xcd_barrier_complete(bar, b.x, nloc, nx); b.st[0] = nloc; b.st[1] = nx; }
        const unsigned old = xb_add(&bar[XB_XSUB(b.x)], 1u);
        const unsigned gen = old / nloc;
        if (old + 1u == (gen + 1u) * nloc) {
            __builtin_amdgcn_fence(__ATOMIC_RELEASE, "agent");
            asm volatile("s_waitcnt vmcnt(0)" ::: "memory");
            const unsigned og = xb_add(&bar[XB_TOP], 1u);
            const unsigned tg = og / nx;
            if (og + 1u == (tg + 1u) * nx) xb_add(&bar[XB_TOPGEN], 1u);
            else XB_SPIN(xb_ld(&bar[XB_TOPGEN]) == tg, bar);
            __builtin_amdgcn_fence(__ATOMIC_ACQUIRE, "agent");
            xb_add(&bar[XB_XGEN(b.x)], 1u);
            asm volatile("s_waitcnt vmcnt(0)" ::: "memory");
        } else {
            XB_SPIN(xb_ld(&bar[XB_XGEN(b.x)]) == gen, bar);
            __builtin_amdgcn_fence(__ATOMIC_ACQUIRE, "agent");
            asm volatile("s_waitcnt vmcnt(0)" ::: "memory");
        }
    }
    __syncthreads();
}

DI void moe_table(const P& p, int l, PG8_LAS int* tab) {
    const int tid_ = ltid();
    if (tid_ < 64) { const int cnt = tid_ < 32 ? p.counts[(l * 32 + tid_) * 32] : 0; const int nt = (cnt + 255) >> 8; int pt = nt, pc = cnt;
#pragma unroll
        for (int o = 1; o < 32; o <<= 1) { const int ln_ = tid_ & 63, src = ln_ >= o ? ln_ - o : ln_; const int a = shli(pt, src), b = shli(pc, src); if (ln_ >= o) { pt += a; pc += b; } }
        if (tid_ < 32) { tab[tid_ + 1] = pt; tab[33 + tid_] = cnt; tab[65 + tid_] = pc - cnt; if (tid_ == 0) tab[0] = 0; } }
    __syncthreads();
}
typedef const __attribute__((address_space(4))) P* PK;
DI PK lp(PK q) { asm volatile("" : "+s"(q)); return q; }
#define PHASE(...) do { const P p = *(const P*)lp(pk); __VA_ARGS__; } while (0)

template <int l> DI void layer(PK pk, unsigned char* smem, const XcdBarrier& xbar) {
    float* ldsf = (float*)smem; const int gw = 0, NW = 0, lane = 0;
    {
        constexpr int NG = l == 0 ? 234 : 204;
        constexpr int CV1 = l == 0 ? 10 * 768 : NE * 768;
        const int G = (int)gridDim.x == 256 ? NG : (int)gridDim.x;
        if ((int)blockIdx.x < G) PHASE({ pg8::Gemm g{p.H, p.WinT + (size_t)l * NPAD_IN * D, T, NPAD_IN, D}; pg8::StaticOrder S; S.init(T, NPAD_IN, G, (int)blockIdx.x);
            pg8::EpiProj E{p.PROJ, LDP, INDIM};
            pg8::gemm_phase<pg8::EpiProj, pg8::StaticOrder>((PG8_LAS unsigned char*)smem, g, S, E, nullptr); });
        else PHASE(ph_convert_experts(p, l, ldsf, G, (int)gridDim.x - G, 0, CV1));
        if ((int)gridDim.x != 256) PHASE(ph_convert_experts(p, l, ldsf, 0, (int)gridDim.x, 0, CV1));
    }
    xcd_barrier(xbar);
    PHASE(ph_prep(p, l, (LDSP unsigned char*)smem));
    xcd_barrier(xbar);
    PHASE(ph_s1(p, l, (LDSP unsigned char*)smem));
    xcd_barrier(xbar);
    PHASE(ph_s2(p));
    xcd_barrier(xbar);
    PHASE(ph_s3(p, l, (LDSP unsigned char*)smem));
    xcd_barrier(xbar);
    {
        constexpr int ro = l == 0 ? 0 : TC;
        constexpr int NG = l == 0 ? 182 : 256;
        const int G = (int)gridDim.x == 256 ? NG : (int)gridDim.x;
        if ((int)blockIdx.x < G) PHASE({ pg8::Gemm g{p.H + (size_t)ro * D, p.WoutT + (size_t)l * D * D, T - ro, D, D}; pg8::StaticOrder S; S.init(T - ro, D, G, (int)blockIdx.x);
            pg8::EpiResGate<l != 0> E{p.SSQ, p.ctx, p.x, p.XB, p.MOD + (size_t)l * 9 * 6144 + 2 * 1024, p.XSS, ro};
            pg8::gemm_phase<pg8::EpiResGate<l != 0>, pg8::StaticOrder>((PG8_LAS unsigned char*)smem, g, S, E, nullptr); });
        else if (l == 0) PHASE(ph_convert_experts(p, l, ldsf, G, (int)gridDim.x - G, 10 * 768, NE * 768));
        if (l == 0 && (int)gridDim.x != 256) PHASE(ph_convert_experts(p, l, ldsf, 0, (int)gridDim.x, 10 * 768, NE * 768));
    }
    xcd_barrier(xbar);
    const int t0 = l == 0 ? 0 : TC;
    PHASE(ph_normroute(p, l, t0, (LDSP unsigned char*)smem));
    xcd_barrier(xbar);
    PG8_LAS int* tab = (PG8_LAS int*)((PG8_LAS unsigned char*)smem + pg8::STAGE_BYTES);
#pragma unroll
    for (int ph = 0; ph < 2; ++ph) {
        PHASE(moe_table(p, l, tab));
        const int U = __builtin_amdgcn_readfirstlane(tab[32]) * 4;
        if (ph == 0) PHASE({ pg8::Gemm g{p.H, p.WguT, T, D, D / 2}; pg8::MoeSched S{tab, p.MAP, U, (int)gridDim.x, (int)blockIdx.x, 4, 1, (size_t)D * D};
            pg8::EpiAct E{(unsigned char*)p.SS}; pg8::gemm_phase_moe<pg8::EpiAct, pg8::MoeSched, false, PG8_SP2, 1>((PG8_LAS unsigned char*)smem, g, S, E, nullptr); });
        else PHASE({ pg8::Gemm g{p.SS, p.WdT, T, D, 256}; pg8::MoeSched S{tab, p.MAP, U, (int)gridDim.x, (int)blockIdx.x, 4, 0, (size_t)D * 512};
            pg8::EpiY E{(unsigned char*)p.PROJ}; pg8::gemm_phase_moe<pg8::EpiY, pg8::MoeSched, false, PG8_SP2, 1>((PG8_LAS unsigned char*)smem, g, S, E, nullptr); });
        xcd_barrier(xbar);
    }
    PHASE(ph_combine(p, l, t0, (const unsigned char*)p.PROJ, (LDSP int*)smem));
    xcd_barrier(xbar);
}

__global__ void __launch_bounds__(NTHR) mega(P p_arg) {
    extern __shared__ __attribute__((aligned(16))) unsigned char smem[];
    cg::grid_group grid = cg::this_grid();
    PK pk = (PK)__builtin_amdgcn_kernarg_segment_ptr();
    const int lane = 0, gw = 0, NW = 0;
    float* ldsf = (float*)smem;
    volatile XLAS unsigned* bst = (volatile XLAS unsigned*)((XLAS unsigned char*)smem + LDS_BYTES - 16);
    { const int t_ = ltid(); if (t_ < 2) bst[t_] = 0u; }
    __syncthreads();
    const XcdBarrier xbar = xcd_barrier_post(pk->BAR, bst);
    PHASE(ph_init(p)); PHASE(ph_mod(p, ldsf)); PHASE(ph_convert_small(p, ldsf, gw, NW, lane));
    grid.sync();
    PHASE(ph_normmod1(p, 0, gw, NW, lane));
    xcd_barrier(xbar);
    layer<0>(pk, smem, xbar);
    layer<1>(pk, smem, xbar);
}

static inline size_t al(size_t x) { return (x + 255) & ~(size_t)255; }

extern "C" void kernel_launch(void* const* d_in, const int* in_sizes, int n_in, void* d_out, int out_size, void* d_ws, size_t ws_size, hipStream_t stream) {
    static int grid_blocks = 0;
    if (grid_blocks == 0) {
        int dev = 0, cus = 0, per_cu = 0;
        if (hipFuncSetAttribute((const void*)mega, hipFuncAttributeMaxDynamicSharedMemorySize, LDS_BYTES) != hipSuccess) { fprintf(stderr, "hipFuncSetAttribute failed\n"); grid_blocks = -1; return; }
        (void)hipGetDevice(&dev); (void)hipDeviceGetAttribute(&cus, hipDeviceAttributeMultiprocessorCount, dev);
        if (hipOccupancyMaxActiveBlocksPerMultiprocessor(&per_cu, (const void*)mega, NTHR, LDS_BYTES) != hipSuccess || per_cu < 1) { fprintf(stderr, "occupancy query: %d blocks/CU\n", per_cu); grid_blocks = -1; return; }
        grid_blocks = cus;
    }
    if (grid_blocks < 0) return;
    P p{};
    const float** pin = (const float**)&p;
    for (int i = 0; i < 29; ++i) pin[i] = (const float*)d_in[i];
    p.out = (float*)d_out;
    char* ws = (char*)d_ws; size_t off = 0;
    auto take = [&](size_t bytes) { char* q = ws + off; off += al(bytes); return q; };
    p.XB = (bf16_t*)take((size_t)T * D * 2);
    p.H = (bf16_t*)take((size_t)T * D * 2);
    p.PROJ = (bf16_t*)take((size_t)T * LDP * 2);
    p.SS = (bf16_t*)take((size_t)NTILE * 8 * 2 * 4096 * 2);
    p.GS = (bf16_t*)take((size_t)NTILE * 4 * 2 * 8192 * 2);
    p.SDEC = (float*)take((size_t)NTILE * 8 * 2 * 4);
    p.GDEC = (float*)take((size_t)NTILE * 4 * 2 * 64 * 4);
    p.MOD = (float*)take((size_t)2 * 9 * 6144 * 4);
    p.counts = (int*)take(64 * 32 * 4);
    p.TOKSLOT = (int*)take((size_t)T * 4 * 4);
    p.EW = (float*)take((size_t)T * 2 * 4);
    p.MAP = (int*)take((size_t)NE * T * 4);
    p.WinT = (bf16_t*)take((size_t)2 * NPAD_IN * D * 2);
    p.WoutT = (bf16_t*)take((size_t)2 * D * D * 2);
    p.WguT = (bf16_t*)take((size_t)NE * D * D * 2);
    p.WdT = (bf16_t*)take((size_t)NE * D * 512 * 2);
    p.WRT = (bf16_t*)take((size_t)32 * 1024 * 2);
    p.BAR = (unsigned*)take(XCD_BAR_WORDS * 4);
    p.XBCC = (bf16_t*)d_out;
    p.QKB = (bf16_t*)d_out + (size_t)T * 768;
    p.SSC = (float*)take((size_t)T * 8 * 4 * 4);
    p.STOT = (float*)take((size_t)NTILE * 8 * 2 * 4);
    p.SSQ = (float*)take((size_t)T * 8 * 4);
    p.XSS = (float*)take((size_t)T * 16 * 4);
    if (off > ws_size) { fprintf(stderr, "workspace too small: need %zu have %zu\n", off, ws_size); return; }
    if (hipMemsetAsync(p.BAR, 0, XCD_BAR_WORDS * 4, stream) != hipSuccess) { fprintf(stderr, "memset of barrier words failed\n"); return; }
    void* args[] = {&p};
    hipError_t e = hipLaunchCooperativeKernel((void*)mega, dim3(grid_blocks), dim3(NTHR), args, LDS_BYTES, stream);
    if (e != hipSuccess) fprintf(stderr, "cooperative launch failed: %s (grid %d)\n", hipGetErrorString(e), grid_blocks);
}
```

```cpp
#include <hip/hip_runtime.h>
#include <hip/hip_cooperative_groups.h>
#include <stdint.h>
#include <cstdio>
namespace cg = cooperative_groups;

typedef unsigned short bf16_t;
#define DI __device__ __forceinline__

constexpr int D = 1024, NB = 8, SEQ = 4096, CTXL = 256, TC = NB * CTXL, TL = NB * SEQ, T = TC + TL;
constexpr int INDIM = 2840, LDP = 2848;
constexpr int OFF_Z = 0, OFF_XBC = 512, OFF_DT = 1280, OFF_Q = 1288, OFF_K = 1544, OFF_V = 1800, OFF_GO = 2312, OFF_GK = 2824;
constexpr int NE = 32;

DI float bf2f(bf16_t v) { return __uint_as_float(((unsigned)v) << 16); }
typedef float f32x2v_ __attribute__((ext_vector_type(2)));
typedef __bf16 bf16x2v_ __attribute__((ext_vector_type(2)));
DI bf16_t f2bf(float f) { return __builtin_bit_cast(unsigned short, (__bf16)f); }
DI float siluf(float x) { return x * __builtin_amdgcn_rcpf(1.0f + __builtin_amdgcn_exp2f(-1.4426950408889634f * x)); }
DI float softplusf(float x) { return fmaxf(x, 0.f) + log1pf(__expf(-fabsf(x))); }
DI float logsigmoidf(float x) { return -softplusf(-x); }
DI float shx(float v, int o, int lane) { return __int_as_float(__builtin_amdgcn_ds_bpermute((lane ^ o) << 2, __float_as_int(v))); }
DI int shxi(int v, int o, int lane) { return __builtin_amdgcn_ds_bpermute((lane ^ o) << 2, v); }
DI float shl(float v, int src) { return __int_as_float(__builtin_amdgcn_ds_bpermute(src << 2, __float_as_int(v))); }
DI int shli(int v, int src) { return __builtin_amdgcn_ds_bpermute(src << 2, v); }
DI float wave_sum(float v, int lane) {
#pragma unroll
    for (int o = 32; o >= 1; o >>= 1) v += shx(v, o, lane);
    return v;
}
DI int ltid() { const int wv = __builtin_amdgcn_readfirstlane(threadIdx.x >> 6);
    int ln; asm volatile("v_mbcnt_lo_u32_b32 %0, -1, 0\n\tv_mbcnt_hi_u32_b32 %0, -1, %0" : "=v"(ln));
    return wv * 64 + ln; }
DI int tok_modrow(int t) { return t < TC ? 8 : ((t - TC) >> 12); }
template <class PT> DI bf16_t* xrow(const PT& p, int t) { return p.XB + (size_t)t * D; }


#ifndef PG8_SP2
#define PG8_SP2 true
#endif
namespace pg8 {
#define PG8_LAS __attribute__((address_space(3)))
typedef unsigned short bf16_t;
typedef short bf16x8 __attribute__((ext_vector_type(8)));
typedef float f32x4 __attribute__((ext_vector_type(4)));
typedef unsigned u32x4 __attribute__((ext_vector_type(4)));
constexpr int BM = 256, BK = 64, HALF = 128, HTB = HALF * BK * 2  , STAGE_BYTES = 8 * HTB, NXCD = 8, WGM = 8;

__host__ __device__ __forceinline__ int lds_byte(int r, int c) { const int st = (r >> 4) * 2 + (c >> 5), rr = r & 15, cc = c & 31, ob = rr * 64 + cc * 2; return st * 1024 + (ob ^ (((ob >> 9) & 1) << 5)); }
__host__ __device__ __forceinline__ void stage_rc(int b, int& R, int& C) { const int st = b / 1024, sb = b % 1024, swz = sb ^ (((sb >> 9) & 1) << 5); R = (st >> 1) * 16 + swz / 64; C = (st & 1) * 32 + (swz % 64) / 2; }
__host__ __device__ __forceinline__ int perm32(int rho) { const int n = rho >> 4, i = rho & 15; return 8 * (i >> 2) + 4 * n + (i & 3); }

struct Unit { int pm, pn; };
struct Gemm { const bf16_t* A; const bf16_t* Bt; int M, N, K; };

struct StaticOrder {
    int nM, nN, nwg, G, c;
    __host__ __device__ void init(int M, int N, int G_, int c_) { nM = M / BM; nN = N / BM; nwg = nM * nN; G = G_; c = c_; }
    __host__ __device__ bool next(int i, Unit& u) const {
        const long L = (long)i * G + c; if (L >= nwg) return false;
        int wgid = (int)L; { const int q = nwg / NXCD, r = nwg % NXCD, xcd = wgid % NXCD, off = wgid / NXCD; wgid = (xcd < r ? xcd * (q + 1) : r * (q + 1) + (xcd - r) * q) + off; }
        const int nig = WGM * nN, gid = wgid / nig, fm = gid * WGM, gsz = (nM - fm) < WGM ? (nM - fm) : WGM;
        u.pm = fm + ((wgid % nig) % gsz); u.pn = (wgid % nig) / gsz; return true;
    }
    __device__ __forceinline__ void a_ready(const Unit&) const {}
    __device__ __forceinline__ void done(const Unit&) const {}
};
__device__ __forceinline__ unsigned cvt_pk_bf16(float lo, float hi) { unsigned r; asm volatile("v_cvt_pk_bf16_f32 %0, %1, %2" : "=v"(r) : "v"(lo), "v"(hi)); return r; }
typedef float f32x2 __attribute__((ext_vector_type(2)));

typedef int i32x4 __attribute__((ext_vector_type(4)));
typedef int i32x8 __attribute__((ext_vector_type(8)));
__device__ __forceinline__ i32x8 cat8(bf16x8 a, bf16x8 b) { return __builtin_shufflevector(__builtin_bit_cast(i32x4, a), __builtin_bit_cast(i32x4, b), 0, 1, 2, 3, 4, 5, 6, 7); }
__device__ __forceinline__ void mfma8(f32x4& c, i32x8 a, i32x8 b) { asm volatile("v_mfma_f32_16x16x128_f8f6f4 %0, %1, %2, %0" : "+v"(c) : "v"(a), "v"(b)); }
__device__ __forceinline__ unsigned pk4_fp8(const f32x4 v) { const float lim = 440.f;
    int w = __builtin_amdgcn_cvt_pk_fp8_f32(__builtin_amdgcn_fmed3f(v[0], -lim, lim), __builtin_amdgcn_fmed3f(v[1], -lim, lim), 0, false);
    return (unsigned)__builtin_amdgcn_cvt_pk_fp8_f32(__builtin_amdgcn_fmed3f(v[2], -lim, lim), __builtin_amdgcn_fmed3f(v[3], -lim, lim), w, true); }
struct EpiProj {
    static constexpr bool PERM = true, AFTER_DRAIN = false, MIDK = false;
    bf16_t* O; int ldc; int ncols; float osc;
    __device__ __forceinline__ void operator()(const f32x4 (&acc)[2][2][4][2], const Unit& u, int wr, int wc, int fr, int fq) const {
        const int row0 = u.pm * BM + wr * 64 + fr, col0 = u.pn * BM + wc * 32 + 8 * fq;
#pragma unroll
        for (int ai = 0; ai < 2; ++ai)
#pragma unroll
            for (int m = 0; m < 4; ++m) { bf16_t* rowp = O + (size_t)(row0 + ai * HALF + m * 16) * ldc + col0;
#pragma unroll
                for (int bj = 0; bj < 2; ++bj) { const f32x4 v0 = acc[ai][bj][m][0] * osc, v1 = acc[ai][bj][m][1] * osc;
                    u32x4 w; w.x = cvt_pk_bf16(v0[0], v0[1]); w.y = cvt_pk_bf16(v0[2], v0[3]); w.z = cvt_pk_bf16(v1[0], v1[1]); w.w = cvt_pk_bf16(v1[2], v1[3]);
                    if (col0 + bj * HALF + 8 <= ncols) *(u32x4*)(rowp + bj * HALF) = w; } }
    }
};
template <bool SRC_BF16> struct EpiResGate {
    static constexpr bool PERM = true, AFTER_DRAIN = false, MIDK = true;
    const float* ssq;
    const float* Sc; const float* Sl;
    bf16_t* XB;
    const float* gate_rows; float* xss; int rowoff;
    template <class Sched> __device__ __forceinline__ void prep(PG8_LAS unsigned char* lds, const Sched& S, int tid) const {
        PG8_LAS float* RS = (PG8_LAS float*)(lds + STAGE_BYTES);
        const int r = tid & 255, i0 = tid >> 8;
        for (int i = i0; ; i += 2) { Unit u; if (!S.next(i, u)) break;
            const f32x4* q = (const f32x4*)(ssq + (size_t)(rowoff + u.pm * BM + r) * 8); const f32x4 a = q[0], b = q[1];
            RS[i * 256 + r] = __builtin_amdgcn_rsqf((((a[0] + a[1]) + (a[2] + a[3])) + ((b[0] + b[1]) + (b[2] + b[3]))) * (1.0f / 512.0f) + 1e-6f); }
    }
    __device__ __forceinline__ void midk(f32x4 (&acc)[2][2][4][2], PG8_LAS unsigned char* lds, int ui, int wr, int fr) const {
        int fr_ = fr; asm volatile("" : "+v"(fr_));
        PG8_LAS const float* RS = (PG8_LAS const float*)(lds + STAGE_BYTES) + ui * 256 + wr * 64 + fr_;
#pragma unroll
        for (int ai = 0; ai < 2; ++ai)
#pragma unroll
            for (int m = 0; m < 4; ++m) { const float rs = RS[ai * HALF + m * 16];
#pragma unroll
                for (int bj = 0; bj < 2; ++bj)
#pragma unroll
                    for (int n = 0; n < 2; ++n) acc[ai][bj][m][n] *= rs; }
    }
    __device__ __forceinline__ void operator()(const f32x4 (&acc)[2][2][4][2], const Unit& u, int wr, int wc, int fr, int fq) const {
        const int row0 = rowoff + u.pm * BM + wr * 64 + fr, col0 = u.pn * BM + wc * 32 + 8 * fq;
        const int t0 = rowoff + u.pm * BM; const int mrow = t0 < 2048 ? 8 : ((t0 - 2048) >> 12);
        const float* gr = gate_rows + (size_t)mrow * 6144 + col0;
        f32x4 gv[2][2];
#pragma unroll
        for (int bj = 0; bj < 2; ++bj)
#pragma unroll
            for (int n = 0; n < 2; ++n) gv[bj][n] = *(const f32x4*)(gr + bj * HALF + n * 4);
#pragma unroll
        for (int ai = 0; ai < 2; ++ai) {
            u32x4 rb[4][2]; f32x4 xf[SRC_BF16 ? 1 : 4][2][2];
#pragma unroll
            for (int m = 0; m < 4; ++m) { const int rr = row0 + ai * HALF + m * 16;
                const float* sp = (rr < 2048 ? Sc + (size_t)rr * 1024 : Sl + (size_t)(rr - 2048) * 1024) + col0; const bf16_t* dp = XB + (size_t)rr * 1024 + col0;
#pragma unroll
                for (int bj = 0; bj < 2; ++bj) {
                    if (SRC_BF16) rb[m][bj] = *(const u32x4*)(dp + bj * HALF);
                    else { xf[SRC_BF16 ? 0 : m][bj][0] = *(const f32x4*)(sp + bj * HALF); xf[SRC_BF16 ? 0 : m][bj][1] = *(const f32x4*)(sp + bj * HALF + 4); } } }
#pragma unroll
            for (int m = 0; m < 4; ++m) { const int rr = row0 + ai * HALF + m * 16;
                bf16_t* dp = XB + (size_t)rr * 1024 + col0; float ss = 0.f;
#pragma unroll
                for (int bj = 0; bj < 2; ++bj) { f32x4 x0, x1;
                    if (SRC_BF16) { const u32x4 r = rb[m][bj];
                        x0 = (f32x4){__uint_as_float(r.x << 16), __uint_as_float(r.x & 0xffff0000u), __uint_as_float(r.y << 16), __uint_as_float(r.y & 0xffff0000u)};
                        x1 = (f32x4){__uint_as_float(r.z << 16), __uint_as_float(r.z & 0xffff0000u), __uint_as_float(r.w << 16), __uint_as_float(r.w & 0xffff0000u)}; }
                    else { x0 = xf[SRC_BF16 ? 0 : m][bj][0]; x1 = xf[SRC_BF16 ? 0 : m][bj][1]; }
                    const f32x4 v0 = x0 + gv[bj][0] * acc[ai][bj][m][0], v1 = x1 + gv[bj][1] * acc[ai][bj][m][1];
                    u32x4 w; w.x = cvt_pk_bf16(v0[0], v0[1]); w.y = cvt_pk_bf16(v0[2], v0[3]); w.z = cvt_pk_bf16(v1[0], v1[1]); w.w = cvt_pk_bf16(v1[2], v1[3]);
                    *(u32x4*)(dp + bj * HALF) = w;
#pragma unroll
                    for (int j = 0; j < 4; ++j) { const float lo = __uint_as_float(w[j] << 16), hi = __uint_as_float(w[j] & 0xffff0000u); ss += lo * lo + hi * hi; } }
                { const int ln_ = fq * 16 + fr; ss += __int_as_float(__builtin_amdgcn_ds_bpermute((ln_ ^ 16) << 2, __float_as_int(ss))); ss += __int_as_float(__builtin_amdgcn_ds_bpermute((ln_ ^ 32) << 2, __float_as_int(ss))); }
                if (fq == 0) xss[(size_t)rr * 16 + u.pn * 4 + wc] = ss; }
        }
    }
};
template <class Epi, class Sched, bool STAMP = false, bool SP2 = PG8_SP2, int SCW = -1>
__device__ __forceinline__ void gemm_phase(PG8_LAS unsigned char* lds, const Gemm g, const Sched& S, const Epi& E, unsigned long long* stamps) {
    int tid_l = __builtin_amdgcn_readfirstlane(threadIdx.x >> 6) * 64 + (int)__builtin_amdgcn_mbcnt_hi(~0u, __builtin_amdgcn_mbcnt_lo(~0u, 0u)); asm volatile("" : "+v"(tid_l));
    const int tid = tid_l, wid = __builtin_amdgcn_readfirstlane(tid >> 6), lane = tid & 63, wr = wid >> 2, wc = wid & 3, fr = lane & 15, fq = lane >> 4;
    const int K = g.K, nt = K / BK;
    int ts_lo = 0, ts_hi = 0, nts = 0; const unsigned long long rt_entry = STAMP ? (unsigned long long)wall_clock64() : 0ull;
#define PG8_STAMP() do { if (STAMP && wid == 0 && nts < 64) { const unsigned long long _c = (unsigned long long)clock64(); \
        ts_lo = (lane == nts) ? (int)(unsigned)_c : ts_lo; ts_hi = (lane == nts) ? (int)(unsigned)(_c >> 32) : ts_hi; ++nts; } } while (0)
    PG8_STAMP();
    unsigned voffA[2], voffB[2];
#pragma unroll
    for (int i = 0; i < 2; ++i) { int R, C; stage_rc(tid * 16 + i * 8192, R, C); const int Rb = Epi::PERM ? ((R & ~31) + perm32(R & 31)) : R;
        voffA[i] = (unsigned)(R * K + C) * 2u; voffB[i] = (unsigned)(Rb * K + C) * 2u; }
    const size_t kstep = (size_t)(BK * 2);
    const size_t hstep = (size_t)HALF * K * 2;
    const size_t tstep = 2 * hstep;
    const unsigned ldsw = (unsigned)wid * 1024u;
    const int aoff = lds_byte(wr * 64 + fr, fq * 8), boff = lds_byte(wc * 32 + fr, fq * 8);
#define PG8_SA(b, h) (((b) * 2 + (h)) * HTB)
#define PG8_SB(b, h) ((4 + (b) * 2 + (h)) * HTB)
#define PG8_STAGE(bufoff, gbase, voff) do { _Pragma("unroll") for (int _i = 0; _i < 2; ++_i) \
        __builtin_amdgcn_global_load_lds((const unsigned*)((const char*)(gbase) + (voff)[_i]), (PG8_LAS unsigned*)(lds + (bufoff) + ldsw + _i * 8192), 16, 0, 0); } while (0)
#define PG8_LDA(dst, b, h) do { _Pragma("unroll") for (int m = 0; m < 4; ++m) _Pragma("unroll") for (int k = 0; k < 2; ++k) dst[m][k] = *(const PG8_LAS bf16x8*)(lds + PG8_SA(b, h) + aoff + m * 2048 + k * 1024); } while (0)
#define PG8_LDB(dst, b, h) do { _Pragma("unroll") for (int n = 0; n < 2; ++n) _Pragma("unroll") for (int k = 0; k < 2; ++k) dst[n][k] = *(const PG8_LAS bf16x8*)(lds + PG8_SB(b, h) + boff + n * 2048 + k * 1024); } while (0)
#define PG8_MMA(ai, bj, At, Bt) do { __builtin_amdgcn_s_setprio(1); _Pragma("unroll") for (int m = 0; m < 4; ++m) _Pragma("unroll") for (int n = 0; n < 2; ++n) { \
        if constexpr (SCW >= 0) mfma8(acc[ai][bj][m][n], cat8(Bt[n][0], Bt[n][1]), cat8(At[m][0], At[m][1])); \
        else { _Pragma("unroll") for (int k = 0; k < 2; ++k) acc[ai][bj][m][n] = __builtin_amdgcn_mfma_f32_16x16x32_bf16(Bt[n][k], At[m][k], acc[ai][bj][m][n], 0, 0, 0); } } __builtin_amdgcn_s_setprio(0); } while (0)
#define PG8_WAIT_V(n) asm volatile("s_waitcnt vmcnt(" #n ")" ::: "memory")
#define PG8_WAIT_L(n) asm volatile("s_waitcnt lgkmcnt(" #n ")" ::: "memory")
#define PG8_BAR __builtin_amdgcn_s_barrier()
#define PG8_SCHED __builtin_amdgcn_sched_barrier(0)
    Unit cur, nxt; int ui = 0;
    if (!S.next(0, cur)) return;
    f32x4 acc[2][2][4][2];
#pragma unroll
    for (int a = 0; a < 2; ++a)
#pragma unroll
        for (int b = 0; b < 2; ++b)
#pragma unroll
            for (int m = 0; m < 4; ++m)
#pragma unroll
                for (int n = 0; n < 2; ++n) acc[a][b][m][n] = (f32x4){0.f, 0.f, 0.f, 0.f};
    bf16x8 At[4][2], B0[2][2], B1[2][2];
    const char* cA = (const char*)g.A + (size_t)cur.pm * tstep; const char* cB = (const char*)g.Bt + (size_t)cur.pn * tstep;
    S.a_ready(cur);
    if constexpr (Epi::MIDK) E.prep(lds, S, tid);
    if constexpr (SP2) {
        PG8_STAGE(PG8_SB(0, 0), cB, voffB); PG8_STAGE(PG8_SB(0, 1), cB + hstep, voffB); PG8_STAGE(PG8_SA(0, 0), cA, voffA); PG8_STAGE(PG8_SA(0, 1), cA + hstep, voffA);
        if (wr == 1) PG8_BAR;
        PG8_WAIT_V(2); PG8_BAR;
        PG8_STAGE(PG8_SB(1, 0), cB + kstep, voffB); PG8_STAGE(PG8_SA(1, 0), cA + kstep, voffA); PG8_STAGE(PG8_SB(1, 1), cB + hstep + kstep, voffB);
        PG8_WAIT_V(6); PG8_BAR;
    } else {
    PG8_STAGE(PG8_SB(0, 0), cB, voffB); PG8_STAGE(PG8_SA(0, 0), cA, voffA); PG8_STAGE(PG8_SB(0, 1), cB + hstep, voffB); PG8_STAGE(PG8_SA(0, 1), cA + hstep, voffA);
    if (wr == 1) PG8_BAR;
    PG8_WAIT_V(4); PG8_BAR;
    PG8_STAGE(PG8_SB(1, 0), cB + kstep, voffB); PG8_STAGE(PG8_SA(1, 0), cA + kstep, voffA); PG8_STAGE(PG8_SB(1, 1), cB + hstep + kstep, voffB);
    PG8_WAIT_V(6); PG8_BAR;
    }
    PG8_STAMP();
    for (;;) {
        const bool has_next = S.next(ui + 1, nxt);
        const char* nA = has_next ? (const char*)g.A + (size_t)nxt.pm * tstep : cA; const char* nB = has_next ? (const char*)g.Bt + (size_t)nxt.pn * tstep : cB;
        for (int t = 0; t < nt; t += 2) {
            const bool last = (t == nt - 2);
            const char* a1 = cA + (size_t)(t + 1) * kstep;
            const char* a2 = last ? nA : cA + (size_t)(t + 2) * kstep; const char* b2 = last ? nB : cB + (size_t)(t + 2) * kstep;
            const char* a3 = a2 + kstep; const char* b3 = b2 + kstep;
            if (last && has_next) S.a_ready(nxt);
            if constexpr (SP2) {
            PG8_LDB(B0, 0, 0); PG8_LDB(B1, 0, 1); PG8_SCHED; PG8_LDA(At, 0, 0); PG8_STAGE(PG8_SA(1, 1), a1 + hstep, voffA);
            PG8_WAIT_V(8); PG8_WAIT_L(0); PG8_BAR; PG8_MMA(0, 0, At, B0); PG8_MMA(0, 1, At, B1); PG8_BAR; PG8_SCHED;
            PG8_LDA(At, 0, 1); PG8_STAGE(PG8_SB(0, 0), b2, voffB); PG8_STAGE(PG8_SB(0, 1), b2 + hstep, voffB); PG8_STAGE(PG8_SA(0, 0), a2, voffA);
            PG8_WAIT_V(8); PG8_WAIT_L(0); PG8_BAR; PG8_MMA(1, 0, At, B0); PG8_MMA(1, 1, At, B1); PG8_BAR; PG8_SCHED;
            PG8_LDB(B0, 1, 0); PG8_LDB(B1, 1, 1); PG8_SCHED; PG8_LDA(At, 1, 0); PG8_STAGE(PG8_SA(0, 1), a2 + hstep, voffA);
            PG8_WAIT_V(8); PG8_WAIT_L(0); PG8_BAR; PG8_MMA(0, 0, At, B0); PG8_MMA(0, 1, At, B1); PG8_BAR; PG8_SCHED;
            PG8_LDA(At, 1, 1); PG8_STAGE(PG8_SB(1, 0), b3, voffB); PG8_STAGE(PG8_SB(1, 1), b3 + hstep, voffB); PG8_STAGE(PG8_SA(1, 0), a3, voffA);
            PG8_WAIT_V(8); PG8_WAIT_L(0); PG8_BAR; PG8_MMA(1, 0, At, B0); PG8_MMA(1, 1, At, B1); PG8_BAR; PG8_SCHED;
            } else {
            PG8_LDB(B0, 0, 0); PG8_SCHED; PG8_LDA(At, 0, 0); PG8_STAGE(PG8_SA(1, 1), a1 + hstep, voffA);
            PG8_WAIT_L(8); PG8_BAR; PG8_WAIT_L(0); PG8_MMA(0, 0, At, B0); PG8_BAR; PG8_SCHED;
            PG8_LDB(B1, 0, 1); PG8_STAGE(PG8_SB(0, 0), b2, voffB);
            PG8_BAR; PG8_WAIT_L(0); PG8_MMA(0, 1, At, B1); PG8_BAR;
            PG8_LDA(At, 0, 1); PG8_STAGE(PG8_SA(0, 0), a2, voffA);
            PG8_BAR; PG8_WAIT_L(0); PG8_MMA(1, 0, At, B0); PG8_BAR; PG8_SCHED;
            PG8_STAGE(PG8_SB(0, 1), b2 + hstep, voffB);
            PG8_WAIT_V(6); PG8_BAR; PG8_MMA(1, 1, At, B1); PG8_BAR;
            PG8_LDB(B0, 1, 0); PG8_SCHED; PG8_LDA(At, 1, 0); PG8_STAGE(PG8_SA(0, 1), a2 + hstep, voffA);
            PG8_WAIT_L(8); PG8_BAR; PG8_WAIT_L(0); PG8_MMA(0, 0, At, B0); PG8_BAR; PG8_SCHED;
            PG8_LDB(B1, 1, 1); PG8_STAGE(PG8_SB(1, 0), b3, voffB);
            PG8_BAR; PG8_WAIT_L(0); PG8_MMA(0, 1, At, B1); PG8_BAR;
            PG8_LDA(At, 1, 1); PG8_STAGE(PG8_SA(1, 0), a3, voffA);
            PG8_BAR; PG8_WAIT_L(0); PG8_MMA(1, 0, At, B0); PG8_BAR; PG8_SCHED;
            PG8_STAGE(PG8_SB(1, 1), b3 + hstep, voffB);
            PG8_WAIT_V(6); PG8_BAR; PG8_MMA(1, 1, At, B1); PG8_BAR;
            }
            if constexpr (Epi::MIDK) { if (t + 2 == nt / 2) E.midk(acc, lds, ui, wr, fr); }
        }
        PG8_STAMP();
        if (wr == 0) PG8_BAR;
        if constexpr (SCW >= 0) asm volatile("s_nop 15\n\ts_nop 15" ::: "memory");
        if constexpr (!Epi::AFTER_DRAIN) { E(acc, cur, wr, wc, fr, fq); S.done(cur); }
        PG8_STAMP();
        if (!has_next) break;
#pragma unroll
        for (int a = 0; a < 2; ++a)
#pragma unroll
            for (int b = 0; b < 2; ++b)
#pragma unroll
                for (int m = 0; m < 4; ++m)
#pragma unroll
                    for (int n = 0; n < 2; ++n) acc[a][b][m][n] = (f32x4){0.f, 0.f, 0.f, 0.f};
        cur = nxt; cA = nA; cB = nB; ++ui;
        if (wr == 1) PG8_BAR;
    }
    PG8_WAIT_V(0);
    PG8_BAR;
    if constexpr (Epi::AFTER_DRAIN) { E.fused(acc, cur, wr, wc, fr, fq, lds, wid, lane); S.done(cur); }
    PG8_STAMP();
    if (STAMP && wid == 0) { stamps[lane] = lane < nts ? (((unsigned long long)(unsigned)ts_hi << 32) | (unsigned)ts_lo) : 0ull;
        if (lane == 62) stamps[62] = rt_entry; if (lane == 63) stamps[63] = (unsigned long long)wall_clock64(); }
#undef PG8_STAMP
#undef PG8_SA
#undef PG8_SB
#undef PG8_STAGE
#undef PG8_LDA
#undef PG8_LDB
#undef PG8_MMA
#undef PG8_WAIT_V
#undef PG8_WAIT_L
#undef PG8_BAR
#undef PG8_SCHED
}

struct MoeUnit { int e, mt, pn, cnt, pstart; };
struct MoeSched {
    typedef MoeUnit UnitT;
    PG8_LAS const int* tab; const int* map; int U, G, c, npn, gather; size_t bstride;
    __device__ __forceinline__ bool next(int i, MoeUnit& u) const {
        const long L = (long)i * G + c; if (L >= U) return false;
        int idx = (int)L; { const int q = U / NXCD, r = U % NXCD, xcd = idx % NXCD, off = idx / NXCD; idx = (xcd < r ? xcd * (q + 1) : r * (q + 1) + (xcd - r) * q) + off; }
        const int tau = idx / npn; u.pn = idx - tau * npn;
        int e = 0;
#pragma unroll
        for (int st = 16; st >= 1; st >>= 1) { if (__builtin_amdgcn_readfirstlane(tab[e + st]) <= tau) e += st; }
        u.e = e; u.mt = tau - __builtin_amdgcn_readfirstlane(tab[e]); u.cnt = __builtin_amdgcn_readfirstlane(tab[33 + e]); u.pstart = __builtin_amdgcn_readfirstlane(tab[65 + e]);
        return true;
    }
    __device__ __forceinline__ const char* bbase(const Gemm& g, const MoeUnit& u) const { return (const char*)g.Bt + (size_t)u.e * bstride + (size_t)u.pn * BM * g.K * 2; }
    __device__ __forceinline__ void a_offsets(const Gemm& g, const MoeUnit& u, int tid, unsigned (&va)[2][2]) const {
        int tl = tid; asm volatile("" : "+v"(tl));
        int RA[2], CA[2];
#pragma unroll
        for (int i = 0; i < 2; ++i) { int R, C; stage_rc(tl * 16 + i * 8192, R, C); RA[i] = R; CA[i] = C * 2; }
#pragma unroll
        for (int hf = 0; hf < 2; ++hf)
#pragma unroll
            for (int i = 0; i < 2; ++i) { int rl = u.mt * BM + hf * HALF + RA[i]; rl = rl < u.cnt ? rl : u.cnt - 1;
                const unsigned row = gather ? (unsigned)map[(size_t)u.e * 34816 + rl] : (unsigned)(u.pstart + rl);
                va[hf][i] = row * (unsigned)(g.K * 2) + (unsigned)CA[i]; }
    }
};
struct EpiAct {
    static constexpr bool PERM = true, AFTER_DRAIN = false;
    unsigned char* O;
    __device__ __forceinline__ void operator()(const f32x4 (&acc)[2][2][4][2], const MoeUnit& u, int wr, int wc, int fr, int fq) const {
        typedef unsigned u32x2 __attribute__((ext_vector_type(2)));
        const int rl0 = u.mt * BM + wr * 64 + fr, col0 = u.pn * HALF + wc * 32 + 8 * fq;
#pragma unroll
        for (int ai = 0; ai < 2; ++ai)
#pragma unroll
            for (int m = 0; m < 4; ++m) { const int rl = rl0 + ai * HALF + m * 16;
                if (rl < u.cnt) { f32x4 o[2];
#pragma unroll
                    for (int n = 0; n < 2; ++n)
#pragma unroll
                        for (int j = 0; j < 4; ++j) { const float gv = acc[ai][0][m][n][j] * (1.0f / 64.0f)  ; o[n][j] = gv * __builtin_amdgcn_rcpf(1.0f + __builtin_amdgcn_exp2f(-1.4426950408889634f * gv)) * (acc[ai][1][m][n][j] * 0.125f)  ; }
                    *(u32x2*)(O + (size_t)(u.pstart + rl) * 512 + col0) = (u32x2){pk4_fp8(o[0]), pk4_fp8(o[1])}; } }
    }
};
struct EpiY {
    static constexpr bool PERM = true, AFTER_DRAIN = false;
    unsigned char* O;
    static __device__ __forceinline__ unsigned pk4(const f32x4 v) { const float lim = 440.f;
        int w = __builtin_amdgcn_cvt_pk_fp8_f32(fminf(fmaxf(v[0], -lim), lim), fminf(fmaxf(v[1], -lim), lim), 0, false);
        return (unsigned)__builtin_amdgcn_cvt_pk_fp8_f32(fminf(fmaxf(v[2], -lim), lim), fminf(fmaxf(v[3], -lim), lim), w, true); }
    __device__ __forceinline__ void operator()(const f32x4 (&acc)[2][2][4][2], const MoeUnit& u, int wr, int wc, int fr, int fq) const {
        typedef unsigned u32x2 __attribute__((ext_vector_type(2)));
        const int rl0 = u.mt * BM + wr * 64 + fr, col0 = u.pn * BM + wc * 32 + 8 * fq;
#pragma unroll
        for (int ai = 0; ai < 2; ++ai)
#pragma unroll
            for (int m = 0; m < 4; ++m) { const int rl = rl0 + ai * HALF + m * 16;
                if (rl < u.cnt) { unsigned char* rowp = O + (size_t)(u.pstart + rl) * 1024 + col0;
#pragma unroll
                    for (int bj = 0; bj < 2; ++bj) *(u32x2*)(rowp + bj * HALF) = (u32x2){pk4(acc[ai][bj][m][0] * (1.0f / 512.0f)), pk4(acc[ai][bj][m][1] * (1.0f / 512.0f))}; } }
    }
};
template <class Epi, class Sched, bool STAMP = false, bool SP2 = PG8_SP2, int SCW = -1, int SCA = 127>
__device__ __forceinline__ void gemm_phase_moe(PG8_LAS unsigned char* lds, const Gemm g, const Sched& S, const Epi& E, unsigned long long* stamps) {
    int tid_l = __builtin_amdgcn_readfirstlane(threadIdx.x >> 6) * 64 + (int)__builtin_amdgcn_mbcnt_hi(~0u, __builtin_amdgcn_mbcnt_lo(~0u, 0u)); asm volatile("" : "+v"(tid_l));
    const int tid = tid_l, wid = __builtin_amdgcn_readfirstlane(tid >> 6), lane = tid & 63, wr = wid >> 2, wc = wid & 3, fr = lane & 15, fq = lane >> 4;
    const int K = g.K, nt = K / BK;
    int ts_lo = 0, ts_hi = 0, nts = 0; const unsigned long long rt_entry = STAMP ? (unsigned long long)wall_clock64() : 0ull;
#define PG8_STAMP() do { if (STAMP && wid == 0 && nts < 64) { const unsigned long long _c = (unsigned long long)clock64(); \
        ts_lo = (lane == nts) ? (int)(unsigned)_c : ts_lo; ts_hi = (lane == nts) ? (int)(unsigned)(_c >> 32) : ts_hi; ++nts; } } while (0)
    PG8_STAMP();
    unsigned voffB[2];
#pragma unroll
    for (int i = 0; i < 2; ++i) { int R, C; stage_rc(tid * 16 + i * 8192, R, C); const int Rb = Epi::PERM ? ((R & ~31) + perm32(R & 31)) : R;
        voffB[i] = (unsigned)(Rb * K + C) * 2u; }
    unsigned vaC[2][2];
    PG8_LAS unsigned* vtab = (PG8_LAS unsigned*)(lds + STAGE_BYTES + 1024) + tid;
    const size_t kstep = (size_t)(BK * 2);
    const size_t hstep = (size_t)HALF * K * 2;
    const size_t tstep = 2 * hstep;
    const unsigned ldsw = (unsigned)wid * 1024u;
    const int aoff = lds_byte(wr * 64 + fr, fq * 8), boff = lds_byte(wc * 32 + fr, fq * 8);
#define PG8_SA(b, h) (((b) * 2 + (h)) * HTB)
#define PG8_SB(b, h) ((4 + (b) * 2 + (h)) * HTB)
#define PG8_STAGE(bufoff, gbase, voff) do { _Pragma("unroll") for (int _i = 0; _i < 2; ++_i) \
        __builtin_amdgcn_global_load_lds((const unsigned*)((const char*)(gbase) + (voff)[_i]), (PG8_LAS unsigned*)(lds + (bufoff) + ldsw + _i * 8192), 16, 0, 0); } while (0)
#define PG8_STAGEA(bufoff, kbyte, va) do { _Pragma("unroll") for (int _i = 0; _i < 2; ++_i) \
        __builtin_amdgcn_global_load_lds((const unsigned*)((const char*)g.A + (kbyte) + (va)[_i]), (PG8_LAS unsigned*)(lds + (bufoff) + ldsw + _i * 8192), 16, 0, 0); } while (0)
#define PG8_LDA(dst, b, h) do { _Pragma("unroll") for (int m = 0; m < 4; ++m) _Pragma("unroll") for (int k = 0; k < 2; ++k) dst[m][k] = *(const PG8_LAS bf16x8*)(lds + PG8_SA(b, h) + aoff + m * 2048 + k * 1024); } while (0)
#define PG8_LDB(dst, b, h) do { _Pragma("unroll") for (int n = 0; n < 2; ++n) _Pragma("unroll") for (int k = 0; k < 2; ++k) dst[n][k] = *(const PG8_LAS bf16x8*)(lds + PG8_SB(b, h) + boff + n * 2048 + k * 1024); } while (0)
#define PG8_MMA(ai, bj, At, Bt) do { __builtin_amdgcn_s_setprio(1); _Pragma("unroll") for (int m = 0; m < 4; ++m) _Pragma("unroll") for (int n = 0; n < 2; ++n) { \
        if constexpr (SCW >= 0) mfma8(acc[ai][bj][m][n], cat8(Bt[n][0], Bt[n][1]), cat8(At[m][0], At[m][1])); \
        else { _Pragma("unroll") for (int k = 0; k < 2; ++k) acc[ai][bj][m][n] = __builtin_amdgcn_mfma_f32_16x16x32_bf16(Bt[n][k], At[m][k], acc[ai][bj][m][n], 0, 0, 0); } } __builtin_amdgcn_s_setprio(0); } while (0)
#define PG8_WAIT_V(n) asm volatile("s_waitcnt vmcnt(" #n ")" ::: "memory")
#define PG8_WAIT_L(n) asm volatile("s_waitcnt lgkmcnt(" #n ")" ::: "memory")
#define PG8_BAR __builtin_amdgcn_s_barrier()
#define PG8_SCHED __builtin_amdgcn_sched_barrier(0)
    typename Sched::UnitT cur, nxt; int ui = 0;
    if (!S.next(0, cur)) return;
    f32x4 acc[2][2][4][2];
#pragma unroll
    for (int a = 0; a < 2; ++a)
#pragma unroll
        for (int b = 0; b < 2; ++b)
#pragma unroll
            for (int m = 0; m < 4; ++m)
#pragma unroll
                for (int n = 0; n < 2; ++n) acc[a][b][m][n] = (f32x4){0.f, 0.f, 0.f, 0.f};
    bf16x8 At[4][2], B0[2][2], B1[2][2];
    const char* cB = S.bbase(g, cur); S.a_offsets(g, cur, tid, vaC);
    if constexpr (SP2) {
        PG8_STAGE(PG8_SB(0, 0), cB, voffB); PG8_STAGE(PG8_SB(0, 1), cB + hstep, voffB); PG8_STAGEA(PG8_SA(0, 0), 0, vaC[0]); PG8_STAGEA(PG8_SA(0, 1), 0, vaC[1]);
        if (wr == 1) PG8_BAR;
        PG8_WAIT_V(2); PG8_BAR;
        PG8_STAGE(PG8_SB(1, 0), cB + kstep, voffB); PG8_STAGEA(PG8_SA(1, 0), kstep, vaC[0]); PG8_STAGE(PG8_SB(1, 1), cB + hstep + kstep, voffB);
        PG8_WAIT_V(6); PG8_BAR;
    } else {
    PG8_STAGE(PG8_SB(0, 0), cB, voffB); PG8_STAGEA(PG8_SA(0, 0), 0, vaC[0]); PG8_STAGE(PG8_SB(0, 1), cB + hstep, voffB); PG8_STAGEA(PG8_SA(0, 1), 0, vaC[1]);
    if (wr == 1) PG8_BAR;
    PG8_WAIT_V(4); PG8_BAR;
    PG8_STAGE(PG8_SB(1, 0), cB + kstep, voffB); PG8_STAGEA(PG8_SA(1, 0), kstep, vaC[0]); PG8_STAGE(PG8_SB(1, 1), cB + hstep + kstep, voffB);
    PG8_WAIT_V(6); PG8_BAR;
    }
    PG8_STAMP();
    for (;;) {
        const bool has_next = S.next(ui + 1, nxt);
        const char* nB = has_next ? S.bbase(g, nxt) : cB;
        { unsigned vaN[2][2];
          if (has_next) S.a_offsets(g, nxt, tid, vaN); else {
#pragma unroll
            for (int hf = 0; hf < 2; ++hf)
#pragma unroll
                for (int i = 0; i < 2; ++i) vaN[hf][i] = vaC[hf][i]; }
#pragma unroll
          for (int hf = 0; hf < 2; ++hf)
#pragma unroll
              for (int i = 0; i < 2; ++i) vtab[(hf * 2 + i) * 512] = vaN[hf][i]; }
        unsigned v2[2][2];
        for (int t = 0; t < nt; t += 2) {
            const bool last = (t == nt - 2);
            const size_t k1 = (size_t)(t + 1) * kstep, k2 = last ? (size_t)0 : (size_t)(t + 2) * kstep, k3 = k2 + kstep;
            const char* b2 = last ? nB : cB + (size_t)(t + 2) * kstep; const char* b3 = b2 + kstep;
#pragma unroll
            for (int hf = 0; hf < 2; ++hf)
#pragma unroll
                for (int i = 0; i < 2; ++i) v2[hf][i] = last ? vtab[(hf * 2 + i) * 512] : vaC[hf][i];
            if constexpr (SP2) {
            PG8_LDB(B0, 0, 0); PG8_LDB(B1, 0, 1); PG8_SCHED; PG8_LDA(At, 0, 0); PG8_STAGEA(PG8_SA(1, 1), k1, vaC[1]);
            PG8_WAIT_V(8); PG8_WAIT_L(0); PG8_BAR; PG8_MMA(0, 0, At, B0); PG8_MMA(0, 1, At, B1); PG8_BAR; PG8_SCHED;
            PG8_LDA(At, 0, 1); PG8_STAGE(PG8_SB(0, 0), b2, voffB); PG8_STAGE(PG8_SB(0, 1), b2 + hstep, voffB); PG8_STAGEA(PG8_SA(0, 0), k2, v2[0]);
            PG8_WAIT_V(8); PG8_WAIT_L(0); PG8_BAR; PG8_MMA(1, 0, At, B0); PG8_MMA(1, 1, At, B1); PG8_BAR; PG8_SCHED;
            PG8_LDB(B0, 1, 0); PG8_LDB(B1, 1, 1); PG8_SCHED; PG8_LDA(At, 1, 0); PG8_STAGEA(PG8_SA(0, 1), k2, v2[1]);
            PG8_WAIT_V(8); PG8_WAIT_L(0); PG8_BAR; PG8_MMA(0, 0, At, B0); PG8_MMA(0, 1, At, B1); PG8_BAR; PG8_SCHED;
            PG8_LDA(At, 1, 1); PG8_STAGE(PG8_SB(1, 0), b3, voffB); PG8_STAGE(PG8_SB(1, 1), b3 + hstep, voffB); PG8_STAGEA(PG8_SA(1, 0), k3, v2[0]);
            PG8_WAIT_V(8); PG8_WAIT_L(0); PG8_BAR; PG8_MMA(1, 0, At, B0); PG8_MMA(1, 1, At, B1); PG8_BAR; PG8_SCHED;
            } else {
            PG8_LDB(B0, 0, 0); PG8_SCHED; PG8_LDA(At, 0, 0); PG8_STAGEA(PG8_SA(1, 1), k1, vaC[1]);
            PG8_WAIT_L(8); PG8_BAR; PG8_WAIT_L(0); PG8_MMA(0, 0, At, B0); PG8_BAR; PG8_SCHED;
            PG8_LDB(B1, 0, 1); PG8_STAGE(PG8_SB(0, 0), b2, voffB);
            PG8_BAR; PG8_WAIT_L(0); PG8_MMA(0, 1, At, B1); PG8_BAR;
            PG8_LDA(At, 0, 1); PG8_STAGEA(PG8_SA(0, 0), k2, v2[0]);
            PG8_BAR; PG8_WAIT_L(0); PG8_MMA(1, 0, At, B0); PG8_BAR; PG8_SCHED;
            PG8_STAGE(PG8_SB(0, 1), b2 + hstep, voffB);
            PG8_WAIT_V(6); PG8_BAR; PG8_MMA(1, 1, At, B1); PG8_BAR;
            PG8_LDB(B0, 1, 0); PG8_SCHED; PG8_LDA(At, 1, 0); PG8_STAGEA(PG8_SA(0, 1), k2, v2[1]);
            PG8_WAIT_L(8); PG8_BAR; PG8_WAIT_L(0); PG8_MMA(0, 0, At, B0); PG8_BAR; PG8_SCHED;
            PG8_LDB(B1, 1, 1); PG8_STAGE(PG8_SB(1, 0), b3, voffB);
            PG8_BAR; PG8_WAIT_L(0); PG8_MMA(0, 1, At, B1); PG8_BAR;
            PG8_LDA(At, 1, 1); PG8_STAGEA(PG8_SA(1, 0), k3, v2[0]);
            PG8_BAR; PG8_WAIT_L(0); PG8_MMA(1, 0, At, B0); PG8_BAR; PG8_SCHED;
            PG8_STAGE(PG8_SB(1, 1), b3 + hstep, voffB);
            PG8_WAIT_V(6); PG8_BAR; PG8_MMA(1, 1, At, B1); PG8_BAR;
            }
        }
        PG8_STAMP();
        if (wr == 0) PG8_BAR;
        if constexpr (SCW >= 0) asm volatile("s_nop 15\n\ts_nop 15" ::: "memory");
        E(acc, cur, wr, wc, fr, fq);
        PG8_STAMP();
        if (!has_next) break;
#pragma unroll
        for (int a = 0; a < 2; ++a)
#pragma unroll
            for (int b = 0; b < 2; ++b)
#pragma unroll
                for (int m = 0; m < 4; ++m)
#pragma unroll
                    for (int n = 0; n < 2; ++n) acc[a][b][m][n] = (f32x4){0.f, 0.f, 0.f, 0.f};
        cur = nxt; cB = nB; ++ui;
#pragma unroll
        for (int hf = 0; hf < 2; ++hf)
#pragma unroll
            for (int i = 0; i < 2; ++i) vaC[hf][i] = v2[hf][i];
        if (wr == 1) PG8_BAR;
    }
    PG8_WAIT_V(0);
    PG8_BAR;
    PG8_STAMP();
    if (STAMP && wid == 0) { stamps[lane] = lane < nts ? (((unsigned long long)(unsigned)ts_hi << 32) | (unsigned)ts_lo) : 0ull;
        if (lane == 62) stamps[62] = rt_entry; if (lane == 63) stamps[63] = (unsigned long long)wall_clock64(); }
#undef PG8_STAMP
#undef PG8_SA
#undef PG8_SB
#undef PG8_STAGE
#undef PG8_STAGEA
#undef PG8_LDA
#undef PG8_LDB
#undef PG8_MMA
#undef PG8_WAIT_V
#undef PG8_WAIT_L
#undef PG8_BAR
#undef PG8_SCHED
}
}

constexpr int NTHR = 512, NWV = 8, LDS_BYTES = 147456;

struct P {
    const float *x, *c, *ctx, *c_ctx, *w_mod, *b_mod, *norm1_g, *norm2_g, *w_in, *conv_w, *conv_b, *dt_bias_f, *dt_bias_b, *a_log_f, *a_log_b, *d_skip, *ssd_norm_g,
        *gk_up_f, *gk_bias_f, *gk_up_b, *gk_bias_b, *gla_norm_g, *w_out, *w_router, *router_bias, *w_gate, *w_up, *w_down, *final_g;
    float* out; bf16_t* XB; bf16_t* H; bf16_t* PROJ; bf16_t* SS; bf16_t* GS; float* SDEC; float* GDEC; float* MOD; int* counts; int* TOKSLOT; float* EW; int* MAP; bf16_t* WinT; bf16_t* WoutT; bf16_t* WguT; bf16_t* WdT; bf16_t* WRT; unsigned* BAR; bf16_t* XBCC; bf16_t* QKB; float* SSC; float* STOT; float* SSQ; float* XSS;
};

DI void ph_init(const P& p) { const size_t i = (size_t)blockIdx.x * NTHR + ltid(); if (i < 64) p.counts[i * 32] = 0; }

DI void ph_mod(const P& p, float* s  ) {
    const int tid_ = ltid(), lane = tid_ & 63, w = tid_ >> 6;
    if (blockIdx.x >= 192) return;
    float* part = s + 9 * 1024;
    { float cv[18];
#pragma unroll
      for (int q = 0; q < 18; ++q) { const int i = tid_ + q * NTHR, r = i >> 10, k = i & 1023; cv[q] = r < 8 ? p.c[r * 1024 + k] : p.c_ctx[k]; }
#pragma unroll
      for (int q = 0; q < 18; ++q) s[tid_ + q * NTHR] = siluf(cv[q]); }
    __syncthreads();
    for (int vb = blockIdx.x; vb < 192; vb += gridDim.x) {
        const int l = vb / 96, n = (vb % 96) * 64 + lane;
        float acc[9];
#pragma unroll
        for (int r = 0; r < 9; ++r) acc[r] = 0.f;
        const float* wp = p.w_mod + (size_t)l * 1024 * 6144 + (size_t)(128 * w) * 6144 + n;
#pragma unroll 8
        for (int k = 0; k < 128; ++k) { const float wv = wp[(size_t)k * 6144];
#pragma unroll
            for (int r = 0; r < 9; ++r) acc[r] += s[r * 1024 + 128 * w + k] * wv; }
#pragma unroll
        for (int r = 0; r < 9; ++r) part[(w * 9 + r) * 64 + lane] = acc[r];
        __syncthreads();
        for (int o = tid_; o < 9 * 64; o += NTHR) { const int r = o >> 6, c = o & 63; float a = p.b_mod[l * 6144 + (vb % 96) * 64 + c];
#pragma unroll
            for (int q = 0; q < 8; ++q) a += part[(q * 9 + r) * 64 + c];
            p.MOD[((size_t)l * 9 + r) * 6144 + (vb % 96) * 64 + c] = a; }
        __syncthreads();
    }
}

DI unsigned pk2(float lo, float hi) { return __builtin_bit_cast(unsigned, __builtin_convertvector((f32x2v_){lo, hi}, bf16x2v_)); }
template <bool F8 = false> DI void transpose_item(const float* W, int K, int N, bf16_t* WT, float* scr, int item, int lane, int gu = -1, const float* kscale = nullptr) {
    const int nblk = (N + 31) / 32, kb = item / nblk, nb = item % nblk, k0 = 64 * kb, n0 = 32 * nb;
    const int d0 = gu < 0 ? n0 : 256 * (n0 >> 7) + (n0 & 127) + 128 * gu;
    const bool nok = n0 + (lane & 31) < N;
    float wv_[32];
#pragma unroll
    for (int i = 0; i < 32; ++i) { const int kk = 2 * i + (lane >> 5); wv_[i] = nok ? __builtin_nontemporal_load(W + (size_t)(k0 + kk) * N + n0 + (lane & 31)) : 0.f; }
#pragma unroll
    for (int i = 0; i < 32; ++i) { const int kk = 2 * i + (lane >> 5); scr[kk * 33 + (lane & 31)] = wv_[i] * (kscale ? kscale[k0 + kk] : 1.0f); }
    const int c = lane & 7;
#pragma unroll
    for (int j = 0; j < 4; ++j) { const int n = (lane >> 3) + 8 * j; const float* q = scr + (8 * c) * 33 + n;
        if constexpr (F8) { typedef unsigned u32x2nt __attribute__((ext_vector_type(2)));
            const u32x2nt o = {pg8::pk4_fp8((pg8::f32x4){q[0 * 33], q[1 * 33], q[2 * 33], q[3 * 33]} * 64.0f), pg8::pk4_fp8((pg8::f32x4){q[4 * 33], q[5 * 33], q[6 * 33], q[7 * 33]} * 64.0f)};
            if (n0 + n < N) __builtin_nontemporal_store(o, (u32x2nt*)((unsigned char*)WT + (size_t)(d0 + n) * K + k0 + 8 * c)); }
        else {
        uint4 o; o.x = pk2(q[0 * 33], q[1 * 33]); o.y = pk2(q[2 * 33], q[3 * 33]); o.z = pk2(q[4 * 33], q[5 * 33]); o.w = pk2(q[6 * 33], q[7 * 33]);
        if (n0 + n < N) { typedef unsigned u32x4nt __attribute__((ext_vector_type(4))); __builtin_nontemporal_store((u32x4nt){o.x, o.y, o.z, o.w}, (u32x4nt*)(WT + (size_t)(d0 + n) * K + k0 + 8 * c)); } } }
}

DI void ph_convert_experts(const P& p, int l, float* ldsf, int wk0, int nwk, int it0 = 0, int it1 = NE * 768) {
    const int tid_ = ltid(), lane = tid_ & 63, gw = ((int)blockIdx.x - wk0) * NWV + (tid_ >> 6), NW = nwk * NWV;
    float* scr = ldsf + 14 * 1024 + (tid_ >> 6) * (64 * 33 + 16);
    for (int it = it0 + gw; it < it1; it += NW) {
        const int e = it / 768, r = it - e * 768;
        if (r < 512) { const int gu = r >> 8; const float* W = (gu ? p.w_up : p.w_gate) + (size_t)(l * NE + e) * D * 512;
            transpose_item<true>(W, D, 512, (bf16_t*)((unsigned char*)p.WguT + (size_t)e * D * D), scr, r & 255, lane, gu); }
        else transpose_item<true>(p.w_down + (size_t)(l * NE + e) * 512 * D, 512, D, (bf16_t*)((unsigned char*)p.WdT + (size_t)e * D * 512), scr, r - 512, lane);
    }
}
constexpr int NPAD_IN = 3072;
DI void ph_convert_small(const P& p, float* ldsf, int, int, int) {
    const int tid_ = ltid(), lane = tid_ & 63, gw = blockIdx.x * NWV + (tid_ >> 6), NW = gridDim.x * NWV;
    float* scr = ldsf + 14 * 1024 + (tid_ >> 6) * (64 * 33 + 16);
    constexpr int I_IN = 16 * 89, I_OUT = 16 * 32;
    for (int it = gw; it < 2 * (I_IN + I_OUT); it += NW) {
        const int l = it / (I_IN + I_OUT), r = it % (I_IN + I_OUT);
        if (r < I_IN) transpose_item<true>(p.w_in + (size_t)l * D * INDIM, D, INDIM, (bf16_t*)((unsigned char*)p.WinT + (size_t)l * NPAD_IN * D), scr, r, lane);
        else { const int kb = (r - I_IN) / 32;
            transpose_item(p.w_out + (size_t)l * D * D, D, D, p.WoutT + (size_t)l * D * D, scr, r - I_IN, lane, -1, kb < 8 ? p.ssd_norm_g + l * 512 : nullptr); }
    }
    for (int idx = blockIdx.x * NTHR + tid_; idx < 32 * 1024; idx += gridDim.x * NTHR) { const int e = idx >> 10, k = idx & 1023; p.WRT[idx] = f2bf(p.w_router[k * 32 + e]); }
    const size_t nz16 = (size_t)(NPAD_IN - INDIM) * D / 16;
    for (size_t i = (size_t)blockIdx.x * NTHR + tid_; i < 2 * nz16; i += (size_t)gridDim.x * NTHR) {
        const size_t l = i / nz16, j = i % nz16;
        ((uint4*)((unsigned char*)p.WinT + (l * NPAD_IN + INDIM) * D))[j] = make_uint4(0u, 0u, 0u, 0u);
    }
}

DI void row_normmod(float4 (&v)[4], const float* g, const float* mr, int shift_idx, int scale_idx, int lane) {
    float ss = 0.f;
#pragma unroll
    for (int i = 0; i < 4; ++i) ss += v[i].x * v[i].x + v[i].y * v[i].y + v[i].z * v[i].z + v[i].w * v[i].w;
    ss = wave_sum(ss, lane);
    const float rstd = rsqrtf(ss * (1.0f / D) + 1e-6f);
#pragma unroll
    for (int i = 0; i < 4; ++i) {
        const int c = (i * 64 + lane) * 4;
        const float4 gg = *(const float4*)(g + c), sh = *(const float4*)(mr + shift_idx * 1024 + c), sc = *(const float4*)(mr + scale_idx * 1024 + c);
        v[i].x = v[i].x * rstd * gg.x * (1.f + sc.x) + sh.x; v[i].y = v[i].y * rstd * gg.y * (1.f + sc.y) + sh.y;
        v[i].z = v[i].z * rstd * gg.z * (1.f + sc.z) + sh.z; v[i].w = v[i].w * rstd * gg.w * (1.f + sc.w) + sh.w;
    }
}
DI void row_store_bf16(bf16_t* hrow, float4 (&v)[4], int lane) {
#pragma unroll
    for (int i = 0; i < 4; ++i) { ushort4 o; o.x = f2bf(v[i].x); o.y = f2bf(v[i].y); o.z = f2bf(v[i].z); o.w = f2bf(v[i].w);
        *(ushort4*)(hrow + (i * 64 + lane) * 4) = o; v[i] = make_float4(bf2f(o.x), bf2f(o.y), bf2f(o.z), bf2f(o.w)); }
}

DI void ph_normmod1(const P& p, int l, int, int, int) {
    const int tid_ = ltid(), lane = tid_ & 63, gw = blockIdx.x * NWV + (tid_ >> 6), NW = gridDim.x * NWV;
    const float* MODl = p.MOD + (size_t)l * 9 * 6144;
    for (int t = gw; t < T; t += NW) {
        float4 v[4];
#pragma unroll
        for (int i = 0; i < 4; ++i) v[i] = ((const float4*)(t < TC ? p.ctx + (size_t)t * D : p.x + (size_t)(t - TC) * D))[i * 64 + lane];
        row_normmod(v, p.norm1_g + l * D, MODl + (size_t)tok_modrow(t) * 6144, 0, 1, lane);
#pragma unroll
        for (int i = 0; i < 4; ++i) *(unsigned*)((unsigned char*)p.H + (size_t)t * D + (i * 64 + lane) * 4) = pg8::pk4_fp8((pg8::f32x4){v[i].x, v[i].y, v[i].z, v[i].w});
    }
}

typedef short s16x4 __attribute__((ext_vector_type(4)));
typedef short bf16x8v __attribute__((ext_vector_type(8)));
typedef float f32x4v __attribute__((ext_vector_type(4)));
typedef unsigned u32x4v __attribute__((ext_vector_type(4)));
typedef unsigned u32x2v __attribute__((ext_vector_type(2)));
DI u32x4v mk4(unsigned a, unsigned b, unsigned c, unsigned d) { return (u32x4v){a, b, c, d}; }
DI u32x2v mk2(unsigned a, unsigned b) { return (u32x2v){a, b}; }
DI f32x4v mkf4(float a, float b, float c, float d) { return (f32x4v){a, b, c, d}; }
#define LDSP __attribute__((address_space(3)))
constexpr int NCH = 34, NTILE = NB * NCH;
constexpr int LD64 = 72, LD128 = 136;
constexpr float LOG2E = 1.4426950408889634f;

DI int tile_tok0(int tl) { const int b = tl / NCH, cs = tl - b * NCH; return cs < 2 ? b * CTXL + cs * 128 : TC + b * SEQ + (cs - 2) * 128; }
DI f32x4v mfma16(bf16x8v a, bf16x8v b, f32x4v c) { return __builtin_amdgcn_mfma_f32_16x16x32_bf16(a, b, c, 0, 0, 0); }
DI bf16x8v frag_row(LDSP const bf16_t* base, int ld, int r0, int k0, int lane) { return *(LDSP const bf16x8v*)(base + (r0 + (lane & 15)) * ld + k0 + 8 * (lane >> 4)); }
DI bf16x8v frag_row_g(const bf16_t* base, int ld, int r0, int k0, int lane) { return *(const bf16x8v*)(base + (size_t)(r0 + (lane & 15)) * ld + k0 + 8 * (lane >> 4)); }
DI bf16x8v frag_col(LDSP const bf16_t* base, int ld, int r0, int k0, int lane) {
    const int G = lane >> 4, i = lane & 15;
    LDSP const bf16_t* a = base + (k0 + 8 * G + (i >> 2)) * ld + r0 + 4 * (i & 3);
    const s16x4 lo = __builtin_bit_cast(s16x4, __builtin_amdgcn_ds_read_tr16_b64_v4i16((LDSP s16x4*)a));
    const s16x4 hi = __builtin_bit_cast(s16x4, __builtin_amdgcn_ds_read_tr16_b64_v4i16((LDSP s16x4*)(a + 4 * ld)));
    return (bf16x8v){lo[0], lo[1], lo[2], lo[3], hi[0], hi[1], hi[2], hi[3]};
}
DI u32x2v pack4(f32x4v v) { return mk2(pk2(v[0], v[1]), pk2(v[2], v[3])); }
DI void unpack8(u32x4v v, float* o) { o[0] = __uint_as_float(v.x << 16); o[1] = __uint_as_float(v.x & 0xffff0000u); o[2] = __uint_as_float(v.y << 16); o[3] = __uint_as_float(v.y & 0xffff0000u);
    o[4] = __uint_as_float(v.z << 16); o[5] = __uint_as_float(v.z & 0xffff0000u); o[6] = __uint_as_float(v.w << 16); o[7] = __uint_as_float(v.w & 0xffff0000u); }
DI u32x4v pack8(const float* o) { return mk4(pk2(o[0], o[1]), pk2(o[2], o[3]), pk2(o[4], o[5]), pk2(o[6], o[7])); }

DI float fast_logsigmoid(float x) { return -(fmaxf(-x, 0.f) + __logf(1.0f + __expf(-fabsf(x)))); }
DI float fast_softplus(float x) { return fmaxf(x, 0.f) + __logf(1.0f + __expf(-fabsf(x))); }
struct XbcSrc { const bf16_t* base; int ld; };
DI XbcSrc xbc_src(const P& p, int tok0) { XbcSrc r; r.base = p.XBCC + (size_t)tok0 * 768; r.ld = 768; return r; }

DI void prep_conv_item(const P& p, int l, int item, int lane) {
    int piece, ch;
    if (item < T / 32) { piece = item; ch = lane * 8; } else { piece = 2 * (item - T / 32) + (lane >> 5); ch = 512 + (lane & 31) * 8; }
    const int t0 = piece * 32; int lo, hi; bf16_t* dst; int dld;
    if (t0 < TC) { lo = t0 & ~(CTXL - 1); hi = lo + CTXL - 1; } else { lo = TC + ((t0 - TC) & ~63); hi = lo + 63; }
    dst = p.XBCC + ch; dld = 768;
    const bf16_t* src = p.PROJ + OFF_XBC + ch;
    float wgt[5][8], bias[8];
#pragma unroll
    for (int k = 0; k < 5; ++k) { const f32x4v a = *(const f32x4v*)(p.conv_w + l * 5 * 768 + k * 768 + ch), c = *(const f32x4v*)(p.conv_w + l * 5 * 768 + k * 768 + ch + 4);
#pragma unroll
        for (int j = 0; j < 4; ++j) { wgt[k][j] = a[j]; wgt[k][4 + j] = c[j]; } }
    { const f32x4v a = *(const f32x4v*)(p.conv_b + l * 768 + ch), c = *(const f32x4v*)(p.conv_b + l * 768 + ch + 4);
#pragma unroll
      for (int j = 0; j < 4; ++j) { bias[j] = a[j]; bias[4 + j] = c[j]; } }
    const u32x4v zero4 = mk4(0u, 0u, 0u, 0u);
    u32x4v rw[13];
#pragma unroll
    for (int i = 0; i < 5; ++i) { const int tt = t0 - 2 + i; rw[i] = (tt >= lo && tt <= hi) ? *(const u32x4v*)(src + (size_t)tt * LDP) : zero4; }
    for (int s0 = 0; s0 < 32; s0 += 8) {
        const int t = t0 + s0;
#pragma unroll
        for (int i = 0; i < 8; ++i) { const int tt = t + 3 + i; rw[5 + i] = (tt <= hi) ? *(const u32x4v*)(src + (size_t)tt * LDP) : zero4; }
#pragma unroll
        for (int i = 0; i < 8; ++i) {
            float o[8];
#pragma unroll
            for (int c = 0; c < 8; ++c) o[c] = bias[c];
#pragma unroll
            for (int k = 0; k < 5; ++k) { float v[8]; unpack8(rw[i + k], v);
#pragma unroll
                for (int c = 0; c < 8; ++c) o[c] += wgt[k][c] * v[c]; }
#pragma unroll
            for (int c = 0; c < 8; ++c) o[c] = siluf(o[c]);
            *(u32x4v*)(dst + (size_t)(t + i) * dld) = pack8(o);
        }
#pragma unroll
        for (int i = 0; i < 5; ++i) rw[i] = rw[i + 8];
    }
}
DI void prep_ssd_item(const P& p, int l, int item, int lane) {
    const int tl = item >> 3, h = item & 7, tok0 = tile_tok0(tl);
    const float bsf = p.dt_bias_f[l * 8 + h], bsb = p.dt_bias_b[l * 8 + h];
    const float r0 = bf2f(p.PROJ[(size_t)(tok0 + 2 * lane) * LDP + OFF_DT + h]), r1 = bf2f(p.PROJ[(size_t)(tok0 + 2 * lane + 1) * LDP + OFF_DT + h]);
    const float f0 = fast_softplus(r0 + bsf), f1 = fast_softplus(r1 + bsf), b0 = fast_softplus(r0 + bsb), b1 = fast_softplus(r1 + bsb);
    float pf = f0 + f1, sb = b0 + b1;
#pragma unroll
    for (int o = 1; o < 64; o <<= 1) { const float t = shl(pf, lane >= o ? lane - o : lane); if (lane >= o) pf += t; }
#pragma unroll
    for (int o = 1; o < 64; o <<= 1) { const float t = shl(sb, lane + o < 64 ? lane + o : lane); if (lane + o < 64) sb += t; }
    const float Af = -__expf(p.a_log_f[l * 8 + h]) * LOG2E, Ab = -__expf(p.a_log_b[l * 8 + h]) * LOG2E;
    const float af0 = Af * (pf - f1), af1 = Af * pf, ab0 = Ab * sb, ab1 = Ab * (sb - b0);
    f32x4v* dst = (f32x4v*)p.SSC + (size_t)(tok0 + 2 * lane) * 8 + h;
    dst[0] = mkf4(af0, af0 - __log2f(f0), ab0, ab0 - __log2f(b0));
    dst[8] = mkf4(af1, af1 - __log2f(f1), ab1, ab1 - __log2f(b1));
    if (lane == 63) { p.STOT[(tl * 8 + h) * 2 + 0] = af1; p.SDEC[(tl * 8 + h) * 2 + 0] = __builtin_amdgcn_exp2f(af1); }
    if (lane == 0) { p.STOT[(tl * 8 + h) * 2 + 1] = ab0; p.SDEC[(tl * 8 + h) * 2 + 1] = __builtin_amdgcn_exp2f(ab0); }
}
template <int CTRL> DI float dppz(float x) { return __builtin_bit_cast(float, __builtin_amdgcn_update_dpp(0, __builtin_bit_cast(int, x), CTRL, 0xf, 0xf, true)); }
DI float row_total(float s) { s += dppz<0xB1>(s); s += dppz<0x4E>(s); s += dppz<0x141>(s); s += dppz<0x140>(s); return s; }
struct GlaPL { u32x4v qv_[2], kv_[2], vv_[4]; bf16x8v gkf[8]; float uw[8]; f32x4v bias; };
DI void prep_gla_load(const P& p, int l, int it, GlaPL& L) {
    const int tl = it >> 2, h = it & 3;
    const int tid = ltid(), lane = tid & 63, w = __builtin_amdgcn_readfirstlane(tid >> 6), kt = w & 3, dir = w >> 2, G = lane >> 4, c = lane & 15, tok0 = tile_tok0(tl);
#pragma unroll
    for (int nt = 0; nt < 8; ++nt) L.gkf[nt] = *(const bf16x8v*)(p.PROJ + (size_t)(tok0 + 16 * nt + c) * LDP + OFF_GK + (G & 1) * 8);
    { const float* up = (dir ? p.gk_up_b : p.gk_up_f) + l * 16 * 256 + (G & 1) * 8 * 256 + h * 64 + 16 * kt + c;
#pragma unroll
      for (int e = 0; e < 8; ++e) L.uw[e] = up[e * 256]; }
    L.bias = *(const f32x4v*)((dir ? p.gk_bias_b : p.gk_bias_f) + l * 256 + h * 64 + 16 * kt + 4 * G);
#pragma unroll
    for (int q = 0; q < 4; ++q) { const int cc_ = tid + q * NTHR, r = cc_ >> 4, cc = cc_ & 15; L.vv_[q] = *(const u32x4v*)(p.PROJ + (size_t)(tok0 + r) * LDP + OFF_V + h * 128 + cc * 8); }
#pragma unroll
    for (int q = 0; q < 2; ++q) { const int cc_ = tid + q * NTHR, r = cc_ >> 3, cc = cc_ & 7; const bf16_t* pr = p.PROJ + (size_t)(tok0 + r) * LDP;
        L.qv_[q] = *(const u32x4v*)(pr + OFF_Q + h * 64 + cc * 8); L.kv_[q] = *(const u32x4v*)(pr + OFF_K + h * 64 + cc * 8); }
}
DI void prep_gla_block(const P& p, int l, int it, int it_next, GlaPL& L, LDSP unsigned char* lds) {
    const int tl = it >> 2, h = it & 3;
    const int tid = ltid(), lane = tid & 63, w = __builtin_amdgcn_readfirstlane(tid >> 6), kt = w & 3, dir = w >> 2, G = lane >> 4, c = lane & 15, tok0 = tile_tok0(tl);
    LDSP bf16_t* QT = (LDSP bf16_t*)lds; LDSP bf16_t* KT = QT + 128 * LD64; LDSP bf16_t* O4 = KT + 128 * LD64; LDSP bf16_t* VT = O4 + 4 * 128 * LD64; LDSP float* DEC = (LDSP float*)(VT + 128 * LD128);
    f32x4v g[8];
    { bf16x8v af;
#pragma unroll
      for (int e = 0; e < 8; ++e) { const bf16_t hi = f2bf(L.uw[e]); const bf16_t lo = f2bf(L.uw[e] - bf2f(hi)); af[e] = (short)(G < 2 ? hi : lo); }
#pragma unroll
      for (int nt = 0; nt < 8; ++nt) g[nt] = mfma16(af, L.gkf[nt], (f32x4v){0.f, 0.f, 0.f, 0.f}); }
#pragma unroll
    for (int nt = 0; nt < 8; ++nt)
#pragma unroll
        for (int r = 0; r < 4; ++r) { const float x = (g[nt][r] + L.bias[r]) * LOG2E;
            g[nt][r] = -(fmaxf(-x, 0.f) + __log2f(1.0f + __builtin_amdgcn_exp2f(-fabsf(x)))) * (1.0f / 16.0f); }
    f32x4v tot = (f32x4v){0.f, 0.f, 0.f, 0.f};
    if (dir == 0) {
#pragma unroll
        for (int nt = 0; nt < 8; ++nt)
#pragma unroll
            for (int r = 0; r < 4; ++r) { const float s = row_total(g[nt][r]); float x = g[nt][r];
                x += dppz<0x111>(x); x += dppz<0x112>(x); x += dppz<0x114>(x); x += dppz<0x118>(x);
                g[nt][r] = tot[r] + x; tot[r] += s; }
    } else {
#pragma unroll
        for (int nt = 7; nt >= 0; --nt)
#pragma unroll
            for (int r = 0; r < 4; ++r) { const float s = row_total(g[nt][r]); float x = g[nt][r];
                x += dppz<0x101>(x); x += dppz<0x102>(x); x += dppz<0x104>(x); x += dppz<0x108>(x);
                g[nt][r] = tot[r] + x; tot[r] += s; }
    }
    __syncthreads();
#pragma unroll
    for (int q = 0; q < 2; ++q) { const int cc_ = tid + q * NTHR, r = cc_ >> 3, cc = cc_ & 7; *(LDSP u32x4v*)(QT + r * LD64 + cc * 8) = L.qv_[q]; *(LDSP u32x4v*)(KT + r * LD64 + cc * 8) = L.kv_[q]; }
#pragma unroll
    for (int q = 0; q < 4; ++q) { const int cc_ = tid + q * NTHR, r = cc_ >> 4, cc = cc_ & 15; *(LDSP u32x4v*)(VT + r * LD128 + cc * 8) = L.vv_[q]; }
    __syncthreads();
    { LDSP bf16_t* OQ = O4 + (2 * dir) * 128 * LD64; LDSP bf16_t* OK = OQ + 128 * LD64;
#pragma unroll
      for (int nt = 0; nt < 8; ++nt) { const int o = (16 * nt + c) * LD64 + 16 * kt + 4 * G;
          const u32x2v q2 = *(LDSP const u32x2v*)(QT + o), k2 = *(LDSP const u32x2v*)(KT + o);
          float eq[4], ek[4];
#pragma unroll
          for (int r = 0; r < 4; ++r) { eq[r] = __builtin_amdgcn_exp2f(g[nt][r] - 3.0f); ek[r] = __builtin_amdgcn_exp2f(-g[nt][r]); }
          *(LDSP u32x2v*)(OQ + o) = mk2(pk2(__uint_as_float(q2.x << 16) * eq[0], __uint_as_float(q2.x & 0xffff0000u) * eq[1]), pk2(__uint_as_float(q2.y << 16) * eq[2], __uint_as_float(q2.y & 0xffff0000u) * eq[3]));
          *(LDSP u32x2v*)(OK + o) = mk2(pk2(__uint_as_float(k2.x << 16) * ek[0], __uint_as_float(k2.x & 0xffff0000u) * ek[1]), pk2(__uint_as_float(k2.y << 16) * ek[2], __uint_as_float(k2.y & 0xffff0000u) * ek[3])); }
      if (c == 0) { const f32x4v d = mkf4(__builtin_amdgcn_exp2f(tot[0]), __builtin_amdgcn_exp2f(tot[1]), __builtin_amdgcn_exp2f(tot[2]), __builtin_amdgcn_exp2f(tot[3]));
          *(f32x4v*)(p.GDEC + (size_t)((tl * 4 + h) * 2 + dir) * 64 + 16 * kt + 4 * G) = d; *(LDSP f32x4v*)(DEC + dir * 64 + 16 * kt + 4 * G) = d; } }
    __syncthreads();
    if (it_next >= 0) prep_gla_load(p, l, it_next, L);
#pragma unroll
    for (int q = 0; q < 8; ++q) { const int cc_ = tid + q * NTHR, a4 = cc_ >> 10, r = (cc_ >> 3) & 127, cc = cc_ & 7;
        *(u32x4v*)(p.QKB + (size_t)(tok0 + r) * 1024 + a4 * 256 + h * 64 + cc * 8) = *(LDSP const u32x4v*)(O4 + (a4 * 128 + r) * LD64 + cc * 8); }
    { const int ut = kt; LDSP const bf16_t* KE = O4 + (dir ? 3 : 1) * 128 * LD64;
      f32x4v acc[8];
#pragma unroll
      for (int q = 0; q < 8; ++q) acc[q] = (f32x4v){0.f, 0.f, 0.f, 0.f};
#pragma unroll
      for (int ks = 0; ks < 4; ++ks) { const bf16x8v u = frag_col(KE, LD64, 16 * ut, 32 * ks, lane);
#pragma unroll
          for (int q = 0; q < 8; ++q) acc[q] = mfma16(u, frag_col(VT, LD128, 16 * q, 32 * ks, lane), acc[q]); }
      const f32x4v dec = *(LDSP const f32x4v*)(DEC + dir * 64 + 16 * ut + 4 * (lane >> 4));
      bf16_t* dst = p.GS + ((size_t)((tl * 4 + h) * 2 + dir) * 128) * 64;
#pragma unroll
      for (int q = 0; q < 8; ++q) *(u32x2v*)(dst + (size_t)(16 * q + (lane & 15)) * 64 + 16 * ut + 4 * (lane >> 4)) = pack4(acc[q] * dec); }
}
constexpr int NPREP_A = T / 32 + T / 64, NPREP_B = NTILE * 8;
DI void ph_prep(const P& p, int l, LDSP unsigned char* lds) {
    const int tid_ = ltid(), lane = tid_ & 63, gw = blockIdx.x * NWV + (tid_ >> 6), NW = gridDim.x * NWV;
    for (int it = gw; it < NPREP_A + NPREP_B; it += NW) {
        if (it < NPREP_A) prep_conv_item(p, l, it, lane); else prep_ssd_item(p, l, it - NPREP_A, lane);
    }
    { const int G_ = gridDim.x; int it = G_ - 1 - (int)blockIdx.x;
      GlaPL L; if (it < NTILE * 4) prep_gla_load(p, l, it, L);
      for (; it < NTILE * 4; it += G_) prep_gla_block(p, l, it, it + G_ < NTILE * 4 ? it + G_ : -1, L, lds); }
}

DI void s1_ssd(const P& p, int tl, int h, LDSP unsigned char* lds) {
    const int tid = ltid(), lane = tid & 63, w = __builtin_amdgcn_readfirstlane(tid >> 6);
    const int tok0 = tile_tok0(tl), g = h >> 2; const XbcSrc xs = xbc_src(p, tok0);
    LDSP bf16_t* XWF = (LDSP bf16_t*)lds; LDSP bf16_t* XWB = XWF + 128 * LD64; LDSP bf16_t* BG = XWB + 128 * LD64;
    const int j = tid >> 2, cq = tid & 3;
    const bf16_t* row = xs.base + (size_t)j * xs.ld;
    const u32x4v x0 = *(const u32x4v*)(row + h * 64 + cq * 16), x1 = *(const u32x4v*)(row + h * 64 + cq * 16 + 8);
    const u32x4v b0 = *(const u32x4v*)(row + 512 + g * 64 + cq * 16), b1 = *(const u32x4v*)(row + 512 + g * 64 + cq * 16 + 8);
    const f32x4v sc = *((const f32x4v*)p.SSC + (size_t)(tok0 + j) * 8 + h);
    const float wf = __builtin_amdgcn_exp2f(p.STOT[(tl * 8 + h) * 2 + 0] - sc.y), wb = __builtin_amdgcn_exp2f(p.STOT[(tl * 8 + h) * 2 + 1] - sc.w);
    float xv[16], of[16], ob[16]; unpack8(x0, xv); unpack8(x1, xv + 8);
#pragma unroll
    for (int c = 0; c < 16; ++c) { of[c] = xv[c] * wf; ob[c] = xv[c] * wb; }
    __syncthreads();
    *(LDSP u32x4v*)(XWF + j * LD64 + cq * 16) = pack8(of); *(LDSP u32x4v*)(XWF + j * LD64 + cq * 16 + 8) = pack8(of + 8);
    *(LDSP u32x4v*)(XWB + j * LD64 + cq * 16) = pack8(ob); *(LDSP u32x4v*)(XWB + j * LD64 + cq * 16 + 8) = pack8(ob + 8);
    *(LDSP u32x4v*)(BG + j * LD64 + cq * 16) = b0; *(LDSP u32x4v*)(BG + j * LD64 + cq * 16 + 8) = b1;
    __syncthreads();
    const int dir = w >> 2, ut = w & 3; LDSP const bf16_t* XW = dir ? XWB : XWF;
    f32x4v acc[4];
#pragma unroll
    for (int q = 0; q < 4; ++q) acc[q] = (f32x4v){0.f, 0.f, 0.f, 0.f};
#pragma unroll
    for (int ks = 0; ks < 4; ++ks) { const bf16x8v u = frag_col(BG, LD64, 16 * ut, 32 * ks, lane);
#pragma unroll
        for (int q = 0; q < 4; ++q) acc[q] = mfma16(u, frag_col(XW, LD64, 16 * q, 32 * ks, lane), acc[q]); }
    bf16_t* dst = p.SS + ((size_t)((tl * 8 + h) * 2 + dir) * 64) * 64;
#pragma unroll
    for (int q = 0; q < 4; ++q) *(u32x2v*)(dst + (size_t)(16 * q + (lane & 15)) * 64 + 16 * ut + 4 * (lane >> 4)) = pack4(acc[q]);
}
DI void ph_s1(const P& p, int l, LDSP unsigned char* lds) {
    for (int it = blockIdx.x; it < NTILE * 8; it += gridDim.x) s1_ssd(p, it >> 3, it & 7, lds);
}

DI int s2_chunk(int dir, int s) { return dir == 0 ? s : (s < 2 ? 1 - s : 35 - s); }
DI void ph_s2(const P& p) {
    const int g = blockIdx.x * NTHR + ltid();
    for (int v = g; v < 131072; v += gridDim.x * NTHR) {
        const bool gla = v >= 65536; const int r = v & 65535;
        int b, h, dir, vi;
        if (!gla) { vi = r & 511; dir = (r >> 9) & 1; h = (r >> 10) & 7; b = r >> 13; } else { vi = r & 1023; dir = (r >> 10) & 1; h = (r >> 11) & 3; b = r >> 13; }
        float st[8];
#pragma unroll
        for (int e = 0; e < 8; ++e) st[e] = 0.f;
        for (int s0 = 0; s0 < NCH; s0 += 6) {
            u32x4v sv[6]; float dsc[6]; f32x4v dv0[6], dv1[6];
#pragma unroll
            for (int u = 0; u < 6; ++u) { if (s0 + u >= NCH) continue; const int tl = b * NCH + s2_chunk(dir, s0 + u);
                if (!gla) { sv[u] = *(const u32x4v*)(p.SS + ((size_t)((tl * 8 + h) * 2 + dir) * 512 + vi) * 8); dsc[u] = p.SDEC[(tl * 8 + h) * 2 + dir]; }
                else { sv[u] = *(const u32x4v*)(p.GS + ((size_t)((tl * 4 + h) * 2 + dir) * 1024 + vi) * 8); const f32x4v* d = (const f32x4v*)(p.GDEC + (size_t)((tl * 4 + h) * 2 + dir) * 64 + (vi & 7) * 8); dv0[u] = d[0]; dv1[u] = d[1]; } }
#pragma unroll
            for (int u = 0; u < 6; ++u) { if (s0 + u >= NCH) continue; const int tl = b * NCH + s2_chunk(dir, s0 + u);
                float loc[8]; unpack8(sv[u], loc);
                const u32x4v hin = pack8(st);
                if (!gla) { *(u32x4v*)(p.SS + ((size_t)((tl * 8 + h) * 2 + dir) * 512 + vi) * 8) = hin;
#pragma unroll
                    for (int e = 0; e < 8; ++e) st[e] = dsc[u] * st[e] + loc[e]; }
                else { *(u32x4v*)(p.GS + ((size_t)((tl * 4 + h) * 2 + dir) * 1024 + vi) * 8) = hin;
                    const float dd[8] = {dv0[u].x, dv0[u].y, dv0[u].z, dv0[u].w, dv1[u].x, dv1[u].y, dv1[u].z, dv1[u].w};
#pragma unroll
                    for (int e = 0; e < 8; ++e) st[e] = dd[e] * st[e] + loc[e]; } }
        }
    }
}

DI int s3_tile(int l, int q) { return l == 0 ? q : (q >> 5) * NCH + 2 + (q & 31); }
struct SsdPre { u32x4v x0, x1, b0, b1, c0, c1, hf, hb; f32x4v sc; };
DI void s3_ssd_load(const P& p, int tl, int h, int tid, int i, int G, SsdPre& r) {
    const int tok0 = tile_tok0(tl), g = h >> 2; const XbcSrc xs = xbc_src(p, tok0);
    const int j = tid >> 2, cq = tid & 3; const bf16_t* row = xs.base + (size_t)j * xs.ld;
    r.x0 = *(const u32x4v*)(row + h * 64 + cq * 16); r.x1 = *(const u32x4v*)(row + h * 64 + cq * 16 + 8);
    r.b0 = *(const u32x4v*)(row + 512 + g * 64 + cq * 16); r.b1 = *(const u32x4v*)(row + 512 + g * 64 + cq * 16 + 8);
    r.c0 = *(const u32x4v*)(row + 640 + g * 64 + cq * 16); r.c1 = *(const u32x4v*)(row + 640 + g * 64 + cq * 16 + 8);
    const bf16_t* Hf = p.SS + (size_t)((tl * 8 + h) * 2 + 0) * 4096 + (tid >> 3) * 64 + (tid & 7) * 8;
    r.hf = *(const u32x4v*)Hf; r.hb = *(const u32x4v*)(Hf + 4096);
    r.sc = *((const f32x4v*)p.SSC + (size_t)(tok0 + (tid & 127)) * 8 + h);
}
DI void ph_s3_ssd(const P& p, int l, LDSP unsigned char* lds) {
    const int tid = ltid(), lane = tid & 63, w = __builtin_amdgcn_readfirstlane(tid >> 6), G = lane >> 4, li = lane & 15, i = 16 * w + li;
    LDSP bf16_t* XH = (LDSP bf16_t*)lds; LDSP bf16_t* BG = XH + 128 * LD64; LDSP bf16_t* CG = BG + 128 * LD64; LDSP bf16_t* MM = CG + 128 * LD64; LDSP f32x4v* SC = (LDSP f32x4v*)(MM + 128 * LD128);
    LDSP bf16_t* HF = (LDSP bf16_t*)(SC + 128); LDSP bf16_t* HB = HF + 64 * LD64;
    const int nit = (l == 0 ? NTILE : NB * 32) * 8, GS_ = gridDim.x;
    int it = ((int)blockIdx.x + (GS_ >> 1)) % GS_; SsdPre pre;
    if (it < nit) s3_ssd_load(p, s3_tile(l, it >> 3), it & 7, tid, i, G, pre);
    for (; it < nit; it += GS_) {
        const int tl = s3_tile(l, it >> 3), h = it & 7, tok0 = tile_tok0(tl);
        __syncthreads();
        { const int j = tid >> 2, cq = tid & 3;
          *(LDSP u32x4v*)(XH + j * LD64 + cq * 16) = pre.x0; *(LDSP u32x4v*)(XH + j * LD64 + cq * 16 + 8) = pre.x1;
          *(LDSP u32x4v*)(BG + j * LD64 + cq * 16) = pre.b0; *(LDSP u32x4v*)(BG + j * LD64 + cq * 16 + 8) = pre.b1;
          *(LDSP u32x4v*)(CG + j * LD64 + cq * 16) = pre.c0; *(LDSP u32x4v*)(CG + j * LD64 + cq * 16 + 8) = pre.c1;
          *(LDSP u32x4v*)(HF + (tid >> 3) * LD64 + (tid & 7) * 8) = pre.hf; *(LDSP u32x4v*)(HB + (tid >> 3) * LD64 + (tid & 7) * 8) = pre.hb;
          if (tid < 128) SC[tid] = pre.sc; }
        if (it + GS_ < nit) s3_ssd_load(p, s3_tile(l, (it + GS_) >> 3), (it + GS_) & 7, tid, i, G, pre);
        __syncthreads();
        u32x2v zr[4];
#pragma unroll
        for (int pt = 0; pt < 4; ++pt) zr[pt] = *(const u32x2v*)(p.PROJ + (size_t)(tok0 + i) * LDP + OFF_Z + h * 64 + 16 * pt + 4 * G);
        const f32x4v sci = SC[i];
        {
            f32x4v am[8];
#pragma unroll
            for (int ut = 0; ut < 8; ++ut) am[ut] = (f32x4v){0.f, 0.f, 0.f, 0.f};
#pragma unroll
            for (int ks = 0; ks < 2; ++ks) { const bf16x8v vfr = frag_row(CG, LD64, 16 * w, 32 * ks, lane);
#pragma unroll
                for (int ut = 0; ut < 8; ++ut) am[ut] = mfma16(frag_row(BG, LD64, 16 * ut, 32 * ks, lane), vfr, am[ut]); }
#pragma unroll
            for (int ut = 0; ut < 8; ++ut) { f32x4v m;
#pragma unroll
                for (int r = 0; r < 4; ++r) { const int jj = 16 * ut + 4 * G + r; const f32x4v scj = SC[jj];
                    const float Lf = jj <= i ? __builtin_amdgcn_exp2f(fminf(sci.x - scj.y, 30.f)) : 0.f, Lb = jj >= i ? __builtin_amdgcn_exp2f(fminf(sci.z - scj.w, 30.f)) : 0.f;
                    m[r] = am[ut][r] * (Lf + Lb); }
                *(LDSP u32x2v*)(MM + i * LD128 + 16 * ut + 4 * G) = pack4(m); }
        }
        asm volatile("s_waitcnt lgkmcnt(0)" ::: "memory");
        f32x4v ay[4], af_[4], ab_[4];
#pragma unroll
        for (int pt = 0; pt < 4; ++pt) { ay[pt] = (f32x4v){0.f, 0.f, 0.f, 0.f}; af_[pt] = ay[pt]; ab_[pt] = ay[pt]; }
#pragma unroll
        for (int ks = 0; ks < 2; ++ks) { const bf16x8v vfr = frag_row(CG, LD64, 16 * w, 32 * ks, lane);
#pragma unroll
            for (int pt = 0; pt < 4; ++pt) { af_[pt] = mfma16(frag_row(HF, LD64, 16 * pt, 32 * ks, lane), vfr, af_[pt]); ab_[pt] = mfma16(frag_row(HB, LD64, 16 * pt, 32 * ks, lane), vfr, ab_[pt]); } }
#pragma unroll
        for (int ks = 0; ks < 4; ++ks) { const bf16x8v vfr = frag_row(MM, LD128, 16 * w, 32 * ks, lane);
#pragma unroll
            for (int pt = 0; pt < 4; ++pt) ay[pt] = mfma16(frag_col(XH, LD64, 16 * pt, 32 * ks, lane), vfr, ay[pt]); }
        const float sf = __builtin_amdgcn_exp2f(sci.x), sb = __builtin_amdgcn_exp2f(sci.z), dsk = p.d_skip[l * 8 + h];
        float ssq = 0.f;
#pragma unroll
        for (int pt = 0; pt < 4; ++pt) { const int pc = 16 * pt + 4 * G;
            const u32x2v xr = *(LDSP const u32x2v*)(XH + i * LD64 + pc);
            const float xv[4] = {__uint_as_float(xr.x << 16), __uint_as_float(xr.x & 0xffff0000u), __uint_as_float(xr.y << 16), __uint_as_float(xr.y & 0xffff0000u)};
            const float zv[4] = {__uint_as_float(zr[pt].x << 16), __uint_as_float(zr[pt].x & 0xffff0000u), __uint_as_float(zr[pt].y << 16), __uint_as_float(zr[pt].y & 0xffff0000u)};
            float yv[4];
#pragma unroll
            for (int r = 0; r < 4; ++r) { yv[r] = (ay[pt][r] + sf * af_[pt][r] + sb * ab_[pt][r] + dsk * xv[r]) * siluf(zv[r]); yv[r] = bf2f(f2bf(yv[r])); ssq += yv[r] * yv[r]; }
            *(u32x2v*)(p.H + (size_t)(tok0 + i) * D + h * 64 + pc) = mk2(pk2(yv[0], yv[1]), pk2(yv[2], yv[3])); }
        ssq += shx(ssq, 16, lane); ssq += shx(ssq, 32, lane);
        if (G == 0) p.SSQ[(size_t)(tok0 + i) * 8 + h] = ssq;
    }
}
struct GlaPre { u32x4v qk[2][4], vv[4], sf[2], sb[2]; };
DI void s3_gla_load(const P& p, int tl, int h, int tid, int i, int G, GlaPre& r) {
    const int tok0 = tile_tok0(tl);
#pragma unroll
    for (int q = 0; q < 2; ++q) { const int c = tid + q * NTHR, rr = c >> 3, cc = c & 7; const bf16_t* qb = p.QKB + (size_t)(tok0 + rr) * 1024 + h * 64 + cc * 8;
        r.qk[q][0] = *(const u32x4v*)qb; r.qk[q][1] = *(const u32x4v*)(qb + 256);
        r.qk[q][2] = *(const u32x4v*)(qb + 512); r.qk[q][3] = *(const u32x4v*)(qb + 768);
        const bf16_t* Sg = p.GS + (size_t)((tl * 4 + h) * 2 + 0) * 8192 + (size_t)rr * 64 + cc * 8; r.sf[q] = *(const u32x4v*)Sg; r.sb[q] = *(const u32x4v*)(Sg + 8192); }
#pragma unroll
    for (int q = 0; q < 4; ++q) { const int c = tid + q * NTHR, rr = c >> 4, cc = c & 15; r.vv[q] = *(const u32x4v*)(p.PROJ + (size_t)(tok0 + rr) * LDP + OFF_V + h * 128 + cc * 8); }
}
DI void ph_s3_gla(const P& p, int l, LDSP unsigned char* lds) {
    const int tid = ltid(), lane = tid & 63, w = __builtin_amdgcn_readfirstlane(tid >> 6), G = lane >> 4, li = lane & 15, i = 16 * w + li;
    LDSP bf16_t* Q2 = (LDSP bf16_t*)lds;
    LDSP bf16_t* KF = Q2 + 8 * 2 * 16 * LD64; LDSP bf16_t* KB = KF + 128 * LD64; LDSP bf16_t* VT = KB + 128 * LD64; LDSP bf16_t* SF = VT + 128 * LD128; LDSP bf16_t* SB = SF + 128 * LD64;
    LDSP bf16_t* AMw = SF + w * 16 * LD128;
    const int nit = (l == 0 ? NTILE : NB * 32) * 4, GS_ = gridDim.x;
    int it = blockIdx.x; GlaPre pre;
    if (it < nit) s3_gla_load(p, s3_tile(l, it >> 2), it & 3, tid, i, G, pre);
    for (; it < nit; it += GS_) {
        const int tl = s3_tile(l, it >> 2), h = it & 3, tok0 = tile_tok0(tl);
        __syncthreads();
#pragma unroll
        for (int q = 0; q < 2; ++q) { const int c = tid + q * NTHR, rr = c >> 3, cc = c & 7; LDSP bf16_t* qrow = Q2 + (rr >> 4) * (2 * 16 * LD64) + (rr & 15) * LD64 + cc * 8;
            *(LDSP u32x4v*)qrow = pre.qk[q][0]; *(LDSP u32x4v*)(qrow + 16 * LD64) = pre.qk[q][2];
            *(LDSP u32x4v*)(KF + rr * LD64 + cc * 8) = pre.qk[q][1]; *(LDSP u32x4v*)(KB + rr * LD64 + cc * 8) = pre.qk[q][3];
            *(LDSP u32x4v*)(SF + rr * LD64 + cc * 8) = pre.sf[q]; *(LDSP u32x4v*)(SB + rr * LD64 + cc * 8) = pre.sb[q]; }
#pragma unroll
        for (int q = 0; q < 4; ++q) { const int c = tid + q * NTHR, rr = c >> 4, cc = c & 15; *(LDSP u32x4v*)(VT + rr * LD128 + cc * 8) = pre.vv[q]; }
        if (it + GS_ < nit) s3_gla_load(p, s3_tile(l, (it + GS_) >> 2), (it + GS_) & 3, tid, i, G, pre);
        __syncthreads();
        f32x4v ao[8];
#pragma unroll
        for (int q = 0; q < 8; ++q) ao[q] = (f32x4v){0.f, 0.f, 0.f, 0.f};
        bf16x8v qfr[2][2];
#pragma unroll
        for (int dir = 0; dir < 2; ++dir)
#pragma unroll
            for (int ks = 0; ks < 2; ++ks) qfr[dir][ks] = frag_row(Q2 + w * (2 * 16 * LD64) + dir * 16 * LD64, LD64, 0, 32 * ks, lane);
#pragma unroll
        for (int dir = 0; dir < 2; ++dir) {
            LDSP const bf16_t* SS_ = dir ? SB : SF;
#pragma unroll
            for (int ks = 0; ks < 2; ++ks) {
#pragma unroll
                for (int vt = 0; vt < 8; ++vt) ao[vt] = mfma16(frag_row(SS_, LD64, 16 * vt, 32 * ks, lane), qfr[dir][ks], ao[vt]); }
        }
        __syncthreads();
#pragma unroll
        for (int uh = 0; uh < 4; ++uh) {
            f32x4v a2[2]; a2[0] = (f32x4v){0.f, 0.f, 0.f, 0.f}; a2[1] = a2[0];
#pragma unroll
            for (int dir = 0; dir < 2; ++dir) {
                LDSP const bf16_t* KS = dir ? KB : KF;
                f32x4v as[2]; as[0] = (f32x4v){0.f, 0.f, 0.f, 0.f}; as[1] = as[0];
#pragma unroll
                for (int ks = 0; ks < 2; ++ks) {
#pragma unroll
                    for (int q = 0; q < 2; ++q) as[q] = mfma16(frag_row(KS, LD64, 16 * (2 * uh + q), 32 * ks, lane), qfr[dir][ks], as[q]); }
#pragma unroll
                for (int q = 0; q < 2; ++q)
#pragma unroll
                    for (int r = 0; r < 4; ++r) { const int jj = 16 * (2 * uh + q) + 4 * G + r; const bool keep = dir == 0 ? (jj <= i) : (jj >= i); a2[q][r] += keep ? as[q][r] : 0.f; }
            }
#pragma unroll
            for (int q = 0; q < 2; ++q) *(LDSP u32x2v*)(AMw + li * LD128 + 16 * (2 * uh + q) + 4 * G) = pack4(a2[q]);
        }
        u32x2v gr[8];
#pragma unroll
        for (int vt = 0; vt < 8; ++vt) gr[vt] = *(const u32x2v*)(p.PROJ + (size_t)(tok0 + i) * LDP + OFF_GO + h * 128 + 16 * vt + 4 * G);
        asm volatile("s_waitcnt lgkmcnt(0)" ::: "memory");
#pragma unroll
        for (int ks = 0; ks < 4; ++ks) { const bf16x8v vfr = frag_row(AMw, LD128, 0, 32 * ks, lane);
#pragma unroll
            for (int vt = 0; vt < 8; ++vt) ao[vt] = mfma16(frag_col(VT, LD128, 16 * vt, 32 * ks, lane), vfr, ao[vt]); }
        float so = 0.f;
#pragma unroll
        for (int vt = 0; vt < 8; ++vt)
#pragma unroll
            for (int r = 0; r < 4; ++r) so += ao[vt][r] * ao[vt][r];
        so += shx(so, 16, lane); so += shx(so, 32, lane);
        const float ro = rsqrtf(so * (1.0f / 128.0f) + 1e-6f);
#pragma unroll
        for (int vt = 0; vt < 8; ++vt) { const int vc = 16 * vt + 4 * G; const f32x4v gg = *(const f32x4v*)(p.gla_norm_g + l * 128 + vc);
            const float g0 = __uint_as_float(gr[vt].x << 16), g1 = __uint_as_float(gr[vt].x & 0xffff0000u), g2 = __uint_as_float(gr[vt].y << 16), g3 = __uint_as_float(gr[vt].y & 0xffff0000u);
            *(u32x2v*)(p.H + (size_t)(tok0 + i) * D + 512 + h * 128 + vc) = mk2(pk2(ao[vt][0] * ro * gg.x * siluf(g0), ao[vt][1] * ro * gg.y * siluf(g1)), pk2(ao[vt][2] * ro * gg.z * siluf(g2), ao[vt][3] * ro * gg.w * siluf(g3))); }
    }
}
DI void ph_s3(const P& p, int l, LDSP unsigned char* lds) { ph_s3_gla(p, l, lds); ph_s3_ssd(p, l, lds); }
DI void ph_normroute(const P& p, int l, int t0, LDSP unsigned char* lds) {
    const int tid_ = ltid(), lane = tid_ & 63, wv = tid_ >> 6, gw = blockIdx.x * NWV + wv, NW = gridDim.x * NWV, G = lane >> 4, li = lane & 15;
    const float* MODl = p.MOD + (size_t)l * 9 * 6144; int* counts = p.counts + l * 32 * 32;
    constexpr int LDW = 1032, LDT = 264;
    LDSP bf16_t* WR = (LDSP bf16_t*)lds;
    LDSP bf16_t* HT = WR + 32 * LDW + wv * 16 * LDT;
    { u32x4v wv_[8];
#pragma unroll
      for (int q = 0; q < 8; ++q) wv_[q] = *(const u32x4v*)(p.WRT + (size_t)(tid_ + q * NTHR) * 8);
#pragma unroll
      for (int q = 0; q < 8; ++q) { const int c = tid_ + q * NTHR; *(LDSP u32x4v*)(WR + (c >> 7) * LDW + (c & 127) * 8) = wv_[q]; } }
    __syncthreads();
    const int ntile = (T - t0) >> 4;
    const float* g2 = p.norm2_g + l * D;
    for (int tile = gw; tile < ntile; tile += NW) {
        const int tb = t0 + tile * 16;
        const float* mr = MODl + (size_t)tok_modrow(tb) * 6144;
        float rs[16];
        { const f32x4v* q = (const f32x4v*)(p.XSS + (size_t)(tb + li) * 16); const f32x4v a = q[0], b = q[1], c = q[2], d = q[3];
          const float ss = (((a.x + a.y) + (a.z + a.w)) + ((b.x + b.y) + (b.z + b.w))) + (((c.x + c.y) + (c.z + c.w)) + ((d.x + d.y) + (d.z + d.w)));
          const float r = rsqrtf(ss * (1.0f / D) + 1e-6f);
#pragma unroll
          for (int i = 0; i < 16; ++i) rs[i] = shl(r, i); }
        f32x4v acc[2]; acc[0] = (f32x4v){0.f, 0.f, 0.f, 0.f}; acc[1] = acc[0];
        u32x2v xq[16];
#pragma unroll
        for (int i = 0; i < 16; ++i) xq[i] = *(const u32x2v*)(xrow(p, tb + i) + lane * 4);
#pragma unroll
        for (int kc = 0; kc < 4; ++kc) {
            const int kk = kc * 256 + lane * 4;
            const f32x4v gg = *(const f32x4v*)(g2 + kk), sh = *(const f32x4v*)(mr + 3 * 1024 + kk), sc = *(const f32x4v*)(mr + 4 * 1024 + kk);
            f32x4v gs;
#pragma unroll
            for (int j = 0; j < 4; ++j) gs[j] = gg[j] * (1.f + sc[j]);
#pragma unroll
            for (int i = 0; i < 16; ++i) { const u32x2v r = xq[i];
                const f32x4v xv = mkf4(__uint_as_float(r.x << 16), __uint_as_float(r.x & 0xffff0000u), __uint_as_float(r.y << 16), __uint_as_float(r.y & 0xffff0000u));
                const f32x4v h = xv * rs[i] * gs + sh; const u32x2v hb = pack4(h);
                *(unsigned*)((unsigned char*)p.H + (size_t)(tb + i) * D + kk) = pg8::pk4_fp8(h);
                *(LDSP u32x2v*)(HT + i * LDT + lane * 4) = hb; }
            if (kc < 3) {
#pragma unroll
                for (int i = 0; i < 16; ++i) xq[i] = *(const u32x2v*)(xrow(p, tb + i) + kk + 256); }
            asm volatile("s_waitcnt lgkmcnt(0)" ::: "memory");
#pragma unroll
            for (int ks = 0; ks < 8; ++ks) { const bf16x8v vfr = frag_row(HT, LDT, 0, 32 * ks, lane);
                acc[0] = mfma16(frag_row(WR, LDW, 0, kc * 256 + 32 * ks, lane), vfr, acc[0]);
                acc[1] = mfma16(frag_row(WR, LDW, 16, kc * 256 + 32 * ks, lane), vfr, acc[1]); }
            asm volatile("s_waitcnt lgkmcnt(0)" ::: "memory");
        }
        float bgs = -1e30f; int bgi = 0, e1 = 0, e2 = 0; float w1 = 0.f, w2 = 0.f;
#pragma unroll
        for (int ut = 0; ut < 2; ++ut) { const int gi = ut * 4 + G; float m1 = -1e30f, m2 = -1e30f, s1 = 0.f, s2 = 0.f; int i1 = 0, i2 = 0;
#pragma unroll
            for (int r = 0; r < 4; ++r) { const float sv = 1.0f / (1.0f + __expf(-acc[ut][r])), vv = sv + p.router_bias[gi * 4 + r];
                if (vv > m1) { m2 = m1; i2 = i1; s2 = s1; m1 = vv; i1 = gi * 4 + r; s1 = sv; } else if (vv > m2) { m2 = vv; i2 = gi * 4 + r; s2 = sv; } }
            if (m1 + m2 > bgs) { bgs = m1 + m2; bgi = gi; e1 = i1; e2 = i2; w1 = s1; w2 = s2; } }
#pragma unroll
        for (int o = 16; o <= 32; o <<= 1) {
            const float ogs = shx(bgs, o, lane), ow1 = shx(w1, o, lane), ow2 = shx(w2, o, lane); const int ogi = shxi(bgi, o, lane), oe1 = shxi(e1, o, lane), oe2 = shxi(e2, o, lane);
            if (ogs > bgs || (ogs == bgs && ogi < bgi)) { bgs = ogs; bgi = ogi; e1 = oe1; e2 = oe2; w1 = ow1; w2 = ow2; } }
        if (G == 0) {
            const int t = tb + li; const float inv = 1.0f / (w1 + w2);
            const int r1 = atomicAdd(&counts[e1 * 32], 1), r2 = atomicAdd(&counts[e2 * 32], 1);
            p.MAP[(size_t)e1 * T + r1] = t; p.MAP[(size_t)e2 * T + r2] = t;
            p.TOKSLOT[t * 4 + 0] = e1; p.TOKSLOT[t * 4 + 1] = r1; p.TOKSLOT[t * 4 + 2] = e2; p.TOKSLOT[t * 4 + 3] = r2;
            p.EW[t * 2 + 0] = w1 * inv; p.EW[t * 2 + 1] = w2 * inv;
        }
    }
}

DI void ph_combine(const P& p, int l, int t0, const unsigned char* Y  , LDSP int* ps  ) {
    const int tid_ = ltid(), lane = tid_ & 63, gw = blockIdx.x * NWV + __builtin_amdgcn_readfirstlane(tid_ >> 6)  , NW = gridDim.x * NWV;
    const float* MODl = p.MOD + (size_t)l * 9 * 6144; const int* counts = p.counts + l * 32 * 32;
    if (tid_ < 64) { const int cnt = tid_ < 32 ? counts[tid_ * 32] : 0; int pc = cnt;
#pragma unroll
        for (int o = 1; o < 32; o <<= 1) { const int src = lane >= o ? lane - o : lane; const int a = shli(pc, src); if (lane >= o) pc += a; }
        if (tid_ < 32) ps[tid_] = pc - cnt; }
    __syncthreads();
    for (int t = t0 + 4 * gw; t < T; t += 4 * NW) {
        int4 sl[4]; float4 ew[2];
#pragma unroll
        for (int u = 0; u < 4; ++u) sl[u] = *(const int4*)(p.TOKSLOT + (size_t)(t + u) * 4);
        ew[0] = *(const float4*)(p.EW + (size_t)t * 2); ew[1] = *(const float4*)(p.EW + (size_t)(t + 2) * 2);
        unsigned yr[4][2][4];
#pragma unroll
        for (int u = 0; u < 4; ++u) { const unsigned char* y0 = Y + (size_t)__builtin_amdgcn_readfirstlane(ps[sl[u].x] + sl[u].y) * D; const unsigned char* y1 = Y + (size_t)__builtin_amdgcn_readfirstlane(ps[sl[u].z] + sl[u].w) * D;
#pragma unroll
            for (int i = 0; i < 4; ++i) { yr[u][0][i] = *(const unsigned*)(y0 + (i * 64 + lane) * 4); yr[u][1][i] = *(const unsigned*)(y1 + (i * 64 + lane) * 4); } }
        const float* mrow = MODl + (size_t)tok_modrow(t) * 6144; const float* g5 = mrow + 5 * 1024;
        const float* mr1 = p.MOD + (size_t)9 * 6144 + (size_t)tok_modrow(t) * 6144;
#pragma unroll
        for (int pr = 0; pr < 2; ++pr) {
            const float wgt[2][2] = {{ew[pr].x, ew[pr].y}, {ew[pr].z, ew[pr].w}};
            u32x2v xr[2][4];
#pragma unroll
            for (int u = 0; u < 2; ++u)
#pragma unroll
                for (int i = 0; i < 4; ++i) xr[u][i] = *(const u32x2v*)(xrow(p, t + 2 * pr + u) + (i * 64 + lane) * 4);
            float4 v[2][4];
#pragma unroll
            for (int i = 0; i < 4; ++i) { const int c = (i * 64 + lane) * 4; const float4 gg = *(const float4*)(g5 + c);
#pragma unroll
                for (int u = 0; u < 2; ++u) { const u32x2v x = xr[u][i]; const int a = (int)yr[2 * pr + u][0][i], b = (int)yr[2 * pr + u][1][i]; const float w1 = wgt[u][0], w2 = wgt[u][1];
                    v[u][i].x = __uint_as_float(x.x << 16) + gg.x * (w1 * __builtin_amdgcn_cvt_f32_fp8(a, 0) + w2 * __builtin_amdgcn_cvt_f32_fp8(b, 0));
                    v[u][i].y = __uint_as_float(x.x & 0xffff0000u) + gg.y * (w1 * __builtin_amdgcn_cvt_f32_fp8(a, 1) + w2 * __builtin_amdgcn_cvt_f32_fp8(b, 1));
                    v[u][i].z = __uint_as_float(x.y << 16) + gg.z * (w1 * __builtin_amdgcn_cvt_f32_fp8(a, 2) + w2 * __builtin_amdgcn_cvt_f32_fp8(b, 2));
                    v[u][i].w = __uint_as_float(x.y & 0xffff0000u) + gg.w * (w1 * __builtin_amdgcn_cvt_f32_fp8(a, 3) + w2 * __builtin_amdgcn_cvt_f32_fp8(b, 3));
                    if (l == 0) *(u32x2v*)(xrow(p, t + 2 * pr + u) + c) = mk2(pk2(v[u][i].x, v[u][i].y), pk2(v[u][i].z, v[u][i].w)); } }
            float rstd[2];
#pragma unroll
            for (int u = 0; u < 2; ++u) { float ss = 0.f;
#pragma unroll
                for (int i = 0; i < 4; ++i) ss += v[u][i].x * v[u][i].x + v[u][i].y * v[u][i].y + v[u][i].z * v[u][i].z + v[u][i].w * v[u][i].w;
                rstd[u] = rsqrtf(wave_sum(ss, lane) * (1.0f / D) + 1e-6f); }
            if (l == 0) {
#pragma unroll
                for (int i = 0; i < 4; ++i) { const int c = (i * 64 + lane) * 4;
                    const float4 gg = *(const float4*)(p.norm1_g + D + c), sh = *(const float4*)(mr1 + c), sc = *(const float4*)(mr1 + 1024 + c);
#pragma unroll
                    for (int u = 0; u < 2; ++u) { const float r = rstd[u];
                        *(unsigned*)((unsigned char*)p.H + (size_t)(t + 2 * pr + u) * D + c) = pg8::pk4_fp8((pg8::f32x4){v[u][i].x * r * gg.x * (1.f + sc.x) + sh.x, v[u][i].y * r * gg.y * (1.f + sc.y) + sh.y, v[u][i].z * r * gg.z * (1.f + sc.z) + sh.z, v[u][i].w * r * gg.w * (1.f + sc.w) + sh.w}); } }
            } else {
#pragma unroll
                for (int u = 0; u < 2; ++u)
#pragma unroll
                    for (int i = 0; i < 4; ++i) { const float4 gg = ((const float4*)p.final_g)[i * 64 + lane]; const float r = rstd[u];
                        ((float4*)(p.out + (size_t)(t + 2 * pr + u - TC) * D))[i * 64 + lane] = make_float4(v[u][i].x * r * gg.x, v[u][i].y * r * gg.y, v[u][i].z * r * gg.z, v[u][i].w * r * gg.w); }
            }
        }
    }
}

#define XLAS __attribute__((address_space(3)))
#define XB_TMO      128
#define XB_XCNT(j)  (256  + 64 * (j))
#define XB_XSUB(j)  (1280 + 64 * (j))
#define XB_XGEN(j)  (2304 + 64 * (j))
#define XB_TOP      3328
#define XB_TOPGEN   3392
#define XCD_BAR_WORDS 3456
#define XB_SPIN_CAP (1u << 18)

__device__ __forceinline__ unsigned xb_ld(unsigned* p)              { return __hip_atomic_load(p, __ATOMIC_RELAXED, __HIP_MEMORY_SCOPE_AGENT); }
__device__ __forceinline__ unsigned xb_add(unsigned* p, unsigned v) { return __hip_atomic_fetch_add(p, v, __ATOMIC_RELAXED, __HIP_MEMORY_SCOPE_AGENT); }
__device__ __forceinline__ unsigned xb_xcc_id() { return (unsigned)__builtin_amdgcn_s_getreg((3 << 11) | 20) & 0xFu; }
#define XB_SPIN(cond, bar) do { unsigned _sp = 0; while (cond) { __builtin_amdgcn_s_sleep(1); \
    if ((++_sp & 255u) == 0u) { if (xb_ld(&(bar)[XB_TMO])) break; if (_sp > XB_SPIN_CAP) { atomicAdd(&(bar)[XB_TMO], 1u); break; } } } } while (0)

struct XcdBarrier {
    unsigned* bar; unsigned x;
    volatile XLAS unsigned* st;
};

__device__ __forceinline__ XcdBarrier xcd_barrier_post(unsigned* bar, volatile XLAS unsigned* st) {
    XcdBarrier b; b.bar = bar; b.x = xb_xcc_id(); b.st = st;
    if (ltid() == 0) (void)xb_add(&bar[XB_XCNT(b.x)], 1u);
    return b;
}
__device__ __forceinline__ void xcd_barrier_complete(unsigned* bar, unsigned x, unsigned& nloc, unsigned& nx) {
    const unsigned G = gridDim.x * gridDim.y * gridDim.z;
    unsigned sum, cnt, mine, sp = 0u;
    for (;;) {
        sum = 0u; cnt = 0u; mine = 0u;
#pragma unroll
        for (unsigned j = 0; j < 16; ++j) { const unsigned c = xb_ld(&bar[XB_XCNT(j)]); sum += c; cnt += (c > 0u) ? 1u : 0u; mine = (j == x) ? c : mine; }
        if (sum == G) break;
        __builtin_amdgcn_s_sleep(1);
        if ((++sp & 255u) == 0u) { if (xb_ld(&bar[XB_TMO])) break; if (sp > XB_SPIN_CAP) { atomicAdd(&bar[XB_TMO], 1u); break; } }
    }
    nloc = mine > 0u ? mine : 1u; nx = cnt > 0u ? cnt : 1u;
}

__device__ __forceinline__ void xcd_barrier(const XcdBarrier& b) {
    asm volatile("s_waitcnt vmcnt(0)" ::: "memory");
    __syncthreads();
    if (ltid() == 0) {
        unsigned* bar = b.bar;
        __builtin_amdgcn_s_waitcnt(0);
        unsigned nloc = b.st[0], nx = b.st[1];
        if (nloc == 0u) { xcd_barrier_complete(bar, b.x, nloc, nx); b.st[0] = nloc; b.st[1] = nx; }
        const unsigned old = xb_add(&bar[XB_XSUB(b.x)], 1u);
        const unsigned gen = old / nloc;
        if (old + 1u == (gen + 1u) * nloc) {
            __builtin_amdgcn_fence(__ATOMIC_RELEASE, "agent");
            asm volatile("s_waitcnt vmcnt(0)" ::: "memory");
            const unsigned og = xb_add(&bar[XB_TOP], 1u);
            const unsigned tg = og / nx;
            if (og + 1u == (tg + 1u) * nx) xb_add(&bar[XB_TOPGEN], 1u);
            else XB_SPIN(xb_ld(&bar[XB_TOPGEN]) == tg, bar);
            __builtin_amdgcn_fence(__ATOMIC_ACQUIRE, "agent");
            xb_add(&bar[XB_XGEN(b.x)], 1u);
            asm volatile("s_waitcnt vmcnt(0)" ::: "memory");
        } else {
            XB_SPIN(xb_ld(&bar[XB_XGEN(b.x)]) == gen, bar);
            __builtin_amdgcn_fence(__ATOMIC_ACQUIRE, "agent");
            asm volatile("s_waitcnt vmcnt(0)" ::: "memory");
        }
    }
    __syncthreads();
}

DI void moe_table(const P& p, int l, PG8_LAS int* tab) {
    const int tid_ = ltid();
    if (tid_ < 64) { const int cnt = tid_ < 32 ? p.counts[(l * 32 + tid_) * 32] : 0; const int nt = (cnt + 255) >> 8; int pt = nt, pc = cnt;
#pragma unroll
        for (int o = 1; o < 32; o <<= 1) { const int ln_ = tid_ & 63, src = ln_ >= o ? ln_ - o : ln_; const int a = shli(pt, src), b = shli(pc, src); if (ln_ >= o) { pt += a; pc += b; } }
        if (tid_ < 32) { tab[tid_ + 1] = pt; tab[33 + tid_] = cnt; tab[65 + tid_] = pc - cnt; if (tid_ == 0) tab[0] = 0; } }
    __syncthreads();
}
typedef const __attribute__((address_space(4))) P* PK;
DI PK lp(PK q) { asm volatile("" : "+s"(q)); return q; }
#define PHASE(...) do { const P p = *(const P*)lp(pk); __VA_ARGS__; } while (0)

template <int l> DI void layer(PK pk, unsigned char* smem, const XcdBarrier& xbar) {
    float* ldsf = (float*)smem; const int gw = 0, NW = 0, lane = 0;
    {
        constexpr int NG = l == 0 ? 234 : 204;
        constexpr int CV1 = l == 0 ? 10 * 768 : NE * 768;
        const int G = (int)gridDim.x == 256 ? NG : (int)gridDim.x;
        if ((int)blockIdx.x < G) PHASE({ pg8::Gemm g{p.H, (const bf16_t*)((const unsigned char*)p.WinT + (size_t)l * NPAD_IN * D), T, NPAD_IN, D / 2}; pg8::StaticOrder S; S.init(T, NPAD_IN, G, (int)blockIdx.x);
            pg8::EpiProj E{p.PROJ, LDP, INDIM, 1.0f / 64.0f};
            pg8::gemm_phase<pg8::EpiProj, pg8::StaticOrder, false, PG8_SP2, 1>((PG8_LAS unsigned char*)smem, g, S, E, nullptr); });
        else PHASE(ph_convert_experts(p, l, ldsf, G, (int)gridDim.x - G, 0, CV1));
        if ((int)gridDim.x != 256) PHASE(ph_convert_experts(p, l, ldsf, 0, (int)gridDim.x, 0, CV1));
    }
    xcd_barrier(xbar);
    PHASE(ph_prep(p, l, (LDSP unsigned char*)smem));
    xcd_barrier(xbar);
    PHASE(ph_s1(p, l, (LDSP unsigned char*)smem));
    xcd_barrier(xbar);
    PHASE(ph_s2(p));
    xcd_barrier(xbar);
    PHASE(ph_s3(p, l, (LDSP unsigned char*)smem));
    xcd_barrier(xbar);
    {
        constexpr int ro = l == 0 ? 0 : TC;
        constexpr int NG = l == 0 ? 182 : 256;
        const int G = (int)gridDim.x == 256 ? NG : (int)gridDim.x;
        if ((int)blockIdx.x < G) PHASE({ pg8::Gemm g{p.H + (size_t)ro * D, p.WoutT + (size_t)l * D * D, T - ro, D, D}; pg8::StaticOrder S; S.init(T - ro, D, G, (int)blockIdx.x);
            pg8::EpiResGate<l != 0> E{p.SSQ, p.ctx, p.x, p.XB, p.MOD + (size_t)l * 9 * 6144 + 2 * 1024, p.XSS, ro};
            pg8::gemm_phase<pg8::EpiResGate<l != 0>, pg8::StaticOrder>((PG8_LAS unsigned char*)smem, g, S, E, nullptr); });
        else if (l == 0) PHASE(ph_convert_experts(p, l, ldsf, G, (int)gridDim.x - G, 10 * 768, NE * 768));
        if (l == 0 && (int)gridDim.x != 256) PHASE(ph_convert_experts(p, l, ldsf, 0, (int)gridDim.x, 10 * 768, NE * 768));
    }
    xcd_barrier(xbar);
    const int t0 = l == 0 ? 0 : TC;
    PHASE(ph_normroute(p, l, t0, (LDSP unsigned char*)smem));
    xcd_barrier(xbar);
    PG8_LAS int* tab = (PG8_LAS int*)((PG8_LAS unsigned char*)smem + pg8::STAGE_BYTES);
#pragma unroll
    for (int ph = 0; ph < 2; ++ph) {
        PHASE(moe_table(p, l, tab));
        const int U = __builtin_amdgcn_readfirstlane(tab[32]) * 4;
        if (ph == 0) PHASE({ pg8::Gemm g{p.H, p.WguT, T, D, D / 2}; pg8::MoeSched S{tab, p.MAP, U, (int)gridDim.x, (int)blockIdx.x, 4, 1, (size_t)D * D};
            pg8::EpiAct E{(unsigned char*)p.SS}; pg8::gemm_phase_moe<pg8::EpiAct, pg8::MoeSched, false, PG8_SP2, 1>((PG8_LAS unsigned char*)smem, g, S, E, nullptr); });
        else PHASE({ pg8::Gemm g{p.SS, p.WdT, T, D, 256}; pg8::MoeSched S{tab, p.MAP, U, (int)gridDim.x, (int)blockIdx.x, 4, 0, (size_t)D * 512};
            pg8::EpiY E{(unsigned char*)p.PROJ}; pg8::gemm_phase_moe<pg8::EpiY, pg8::MoeSched, false, PG8_SP2, 1>((PG8_LAS unsigned char*)smem, g, S, E, nullptr); });
        xcd_barrier(xbar);
    }
    PHASE(ph_combine(p, l, t0, (const unsigned char*)p.PROJ, (LDSP int*)smem));
    xcd_barrier(xbar);
}

__global__ void __launch_bounds__(NTHR) mega(P p_arg) {
    extern __shared__ __attribute__((aligned(16))) unsigned char smem[];
    cg::grid_group grid = cg::this_grid();
    PK pk = (PK)__builtin_amdgcn_kernarg_segment_ptr();
    const int lane = 0, gw = 0, NW = 0;
    float* ldsf = (float*)smem;
    volatile XLAS unsigned* bst = (volatile XLAS unsigned*)((XLAS unsigned char*)smem + LDS_BYTES - 16);
    { const int t_ = ltid(); if (t_ < 2) bst[t_] = 0u; }
    __syncthreads();
    const XcdBarrier xbar = xcd_barrier_post(pk->BAR, bst);
    PHASE(ph_init(p)); PHASE(ph_mod(p, ldsf)); PHASE(ph_convert_small(p, ldsf, gw, NW, lane));
    grid.sync();
    PHASE(ph_normmod1(p, 0, gw, NW, lane));
    xcd_barrier(xbar);
    layer<0>(pk, smem, xbar);
    layer<1>(pk, smem, xbar);
}

static inline size_t al(size_t x) { return (x + 255) & ~(size_t)255; }

extern "C" void kernel_launch(void* const* d_in, const int* in_sizes, int n_in, void* d_out, int out_size, void* d_ws, size_t ws_size, hipStream_t stream) {
    static int grid_blocks = 0;
    if (grid_blocks == 0) {
        int dev = 0, cus = 0, per_cu = 0;
        if (hipFuncSetAttribute((const void*)mega, hipFuncAttributeMaxDynamicSharedMemorySize, LDS_BYTES) != hipSuccess) { fprintf(stderr, "hipFuncSetAttribute failed\n"); grid_blocks = -1; return; }
        (void)hipGetDevice(&dev); (void)hipDeviceGetAttribute(&cus, hipDeviceAttributeMultiprocessorCount, dev);
        if (hipOccupancyMaxActiveBlocksPerMultiprocessor(&per_cu, (const void*)mega, NTHR, LDS_BYTES) != hipSuccess || per_cu < 1) { fprintf(stderr, "occupancy query: %d blocks/CU\n", per_cu); grid_blocks = -1; return; }
        grid_blocks = cus;
    }
    if (grid_blocks < 0) return;
    P p{};
    const float** pin = (const float**)&p;
    for (int i = 0; i < 29; ++i) pin[i] = (const float*)d_in[i];
    p.out = (float*)d_out;
    char* ws = (char*)d_ws; size_t off = 0;
    auto take = [&](size_t bytes) { char* q = ws + off; off += al(bytes); return q; };
    p.XB = (bf16_t*)take((size_t)T * D * 2);
    p.H = (bf16_t*)take((size_t)T * D * 2);
    p.PROJ = (bf16_t*)take((size_t)T * LDP * 2);
    p.SS = (bf16_t*)take((size_t)NTILE * 8 * 2 * 4096 * 2);
    p.GS = (bf16_t*)take((size_t)NTILE * 4 * 2 * 8192 * 2);
    p.SDEC = (float*)take((size_t)NTILE * 8 * 2 * 4);
    p.GDEC = (float*)take((size_t)NTILE * 4 * 2 * 64 * 4);
    p.MOD = (float*)take((size_t)2 * 9 * 6144 * 4);
    p.counts = (int*)take(64 * 32 * 4);
    p.TOKSLOT = (int*)take((size_t)T * 4 * 4);
    p.EW = (float*)take((size_t)T * 2 * 4);
    p.MAP = (int*)take((size_t)NE * T * 4);
    p.WinT = (bf16_t*)take((size_t)2 * NPAD_IN * D * 2);
    p.WoutT = (bf16_t*)take((size_t)2 * D * D * 2);
    p.WguT = (bf16_t*)take((size_t)NE * D * D * 2);
    p.WdT = (bf16_t*)take((size_t)NE * D * 512 * 2);
    p.WRT = (bf16_t*)take((size_t)32 * 1024 * 2);
    p.BAR = (unsigned*)take(XCD_BAR_WORDS * 4);
    p.XBCC = (bf16_t*)d_out;
    p.QKB = (bf16_t*)d_out + (size_t)T * 768;
    p.SSC = (float*)take((size_t)T * 8 * 4 * 4);
    p.STOT = (float*)take((size_t)NTILE * 8 * 2 * 4);
    p.SSQ = (float*)take((size_t)T * 8 * 4);
    p.XSS = (float*)take((size_t)T * 16 * 4);
    if (off > ws_size) { fprintf(stderr, "workspace too small: need %zu have %zu\n", off, ws_size); return; }
    if (hipMemsetAsync(p.BAR, 0, XCD_BAR_WORDS * 4, stream) != hipSuccess) { fprintf(stderr, "memset of barrier words failed\n"); return; }
    void* args[] = {&p};
    hipError_t e = hipLaunchCooperativeKernel((void*)mega, dim3(grid_blocks), dim3(NTHR), args, LDS_BYTES, stream);
    if (e != hipSuccess) fprintf(stderr, "cooperative launch failed: %s (grid %d)\n", hipGetErrorString(e), grid_blocks);
}
```

```cpp
#include <hip/hip_runtime.h>
#include <hip/hip_cooperative_groups.h>
#include <stdint.h>
#include <cstdio>
namespace cg = cooperative_groups;

typedef unsigned short bf16_t;
#define DI __device__ __forceinline__

constexpr int D = 1024, NB = 8, SEQ = 4096, CTXL = 256, TC = NB * CTXL, TL = NB * SEQ, T = TC + TL;
constexpr int INDIM = 2840, LDP = 2848;
constexpr int OFF_Z = 0, OFF_XBC = 512, OFF_DT = 1280, OFF_Q = 1288, OFF_K = 1544, OFF_V = 1800, OFF_GO = 2312, OFF_GK = 2824;
constexpr int NE = 32;

DI float bf2f(bf16_t v) { return __uint_as_float(((unsigned)v) << 16); }
typedef float f32x2v_ __attribute__((ext_vector_type(2)));
typedef __bf16 bf16x2v_ __attribute__((ext_vector_type(2)));
DI bf16_t f2bf(float f) { return __builtin_bit_cast(unsigned short, (__bf16)f); }
DI float siluf(float x) { return x * __builtin_amdgcn_rcpf(1.0f + __builtin_amdgcn_exp2f(-1.4426950408889634f * x)); }
DI float softplusf(float x) { return fmaxf(x, 0.f) + log1pf(__expf(-fabsf(x))); }
DI float logsigmoidf(float x) { return -softplusf(-x); }
DI float shx(float v, int o, int lane) { return __int_as_float(__builtin_amdgcn_ds_bpermute((lane ^ o) << 2, __float_as_int(v))); }
DI int shxi(int v, int o, int lane) { return __builtin_amdgcn_ds_bpermute((lane ^ o) << 2, v); }
DI float shl(float v, int src) { return __int_as_float(__builtin_amdgcn_ds_bpermute(src << 2, __float_as_int(v))); }
DI int shli(int v, int src) { return __builtin_amdgcn_ds_bpermute(src << 2, v); }
DI float wave_sum(float v, int lane) {
#pragma unroll
    for (int o = 32; o >= 1; o >>= 1) v += shx(v, o, lane);
    return v;
}
DI int ltid() { const int wv = __builtin_amdgcn_readfirstlane(threadIdx.x >> 6);
    int ln; asm volatile("v_mbcnt_lo_u32_b32 %0, -1, 0\n\tv_mbcnt_hi_u32_b32 %0, -1, %0" : "=v"(ln));
    return wv * 64 + ln; }
DI int tok_modrow(int t) { return t < TC ? 8 : ((t - TC) >> 12); }
template <class PT> DI bf16_t* xrow(const PT& p, int t) { return p.XB + (size_t)t * D; }


#ifndef PG8_SP2
#define PG8_SP2 true
#endif
namespace pg8 {
#define PG8_LAS __attribute__((address_space(3)))
typedef unsigned short bf16_t;
typedef short bf16x8 __attribute__((ext_vector_type(8)));
typedef float f32x4 __attribute__((ext_vector_type(4)));
typedef unsigned u32x4 __attribute__((ext_vector_type(4)));
constexpr int BM = 256, BK = 64, HALF = 128, HTB = HALF * BK * 2  , STAGE_BYTES = 8 * HTB, NXCD = 8, WGM = 8;

__host__ __device__ __forceinline__ int lds_byte(int r, int c) { const int st = (r >> 4) * 2 + (c >> 5), rr = r & 15, cc = c & 31, ob = rr * 64 + cc * 2; return st * 1024 + (ob ^ (((ob >> 9) & 1) << 5)); }
__host__ __device__ __forceinline__ void stage_rc(int b, int& R, int& C) { const int st = b / 1024, sb = b % 1024, swz = sb ^ (((sb >> 9) & 1) << 5); R = (st >> 1) * 16 + swz / 64; C = (st & 1) * 32 + (swz % 64) / 2; }
__host__ __device__ __forceinline__ int perm32(int rho) { const int n = rho >> 4, i = rho & 15; return 8 * (i >> 2) + 4 * n + (i & 3); }

struct Unit { int pm, pn; };
struct Gemm { const bf16_t* A; const bf16_t* Bt; int M, N, K; };

struct StaticOrder {
    int nM, nN, nwg, G, c;
    __host__ __device__ void init(int M, int N, int G_, int c_) { nM = M / BM; nN = N / BM; nwg = nM * nN; G = G_; c = c_; }
    __host__ __device__ bool next(int i, Unit& u) const {
        const long L = (long)i * G + c; if (L >= nwg) return false;
        int wgid = (int)L; { const int q = nwg / NXCD, r = nwg % NXCD, xcd = wgid % NXCD, off = wgid / NXCD; wgid = (xcd < r ? xcd * (q + 1) : r * (q + 1) + (xcd - r) * q) + off; }
        const int nig = WGM * nN, gid = wgid / nig, fm = gid * WGM, gsz = (nM - fm) < WGM ? (nM - fm) : WGM;
        u.pm = fm + ((wgid % nig) % gsz); u.pn = (wgid % nig) / gsz; return true;
    }
    __device__ __forceinline__ void a_ready(const Unit&) const {}
    __device__ __forceinline__ void done(const Unit&) const {}
};
__device__ __forceinline__ unsigned cvt_pk_bf16(float lo, float hi) { unsigned r; asm volatile("v_cvt_pk_bf16_f32 %0, %1, %2" : "=v"(r) : "v"(lo), "v"(hi)); return r; }
typedef float f32x2 __attribute__((ext_vector_type(2)));

typedef int i32x4 __attribute__((ext_vector_type(4)));
typedef int i32x8 __attribute__((ext_vector_type(8)));
__device__ __forceinline__ i32x8 cat8(bf16x8 a, bf16x8 b) { return __builtin_shufflevector(__builtin_bit_cast(i32x4, a), __builtin_bit_cast(i32x4, b), 0, 1, 2, 3, 4, 5, 6, 7); }
__device__ __forceinline__ void mfma8(f32x4& c, i32x8 a, i32x8 b) { asm volatile("v_mfma_f32_16x16x128_f8f6f4 %0, %1, %2, %0" : "+v"(c) : "v"(a), "v"(b)); }
__device__ __forceinline__ unsigned pk4_fp8(const f32x4 v) { const float lim = 440.f;
    int w = __builtin_amdgcn_cvt_pk_fp8_f32(__builtin_amdgcn_fmed3f(v[0], -lim, lim), __builtin_amdgcn_fmed3f(v[1], -lim, lim), 0, false);
    return (unsigned)__builtin_amdgcn_cvt_pk_fp8_f32(__builtin_amdgcn_fmed3f(v[2], -lim, lim), __builtin_amdgcn_fmed3f(v[3], -lim, lim), w, true); }
struct EpiProj {
    static constexpr bool PERM = true, AFTER_DRAIN = false, MIDK = false;
    bf16_t* O; int ldc; int ncols; float osc;
    __device__ __forceinline__ void operator()(const f32x4 (&acc)[2][2][4][2], const Unit& u, int wr, int wc, int fr, int fq) const {
        const int row0 = u.pm * BM + wr * 64 + fr, col0 = u.pn * BM + wc * 32 + 8 * fq;
#pragma unroll
        for (int ai = 0; ai < 2; ++ai)
#pragma unroll
            for (int m = 0; m < 4; ++m) { bf16_t* rowp = O + (size_t)(row0 + ai * HALF + m * 16) * ldc + col0;
#pragma unroll
                for (int bj = 0; bj < 2; ++bj) { const f32x4 v0 = acc[ai][bj][m][0] * osc, v1 = acc[ai][bj][m][1] * osc;
                    u32x4 w; w.x = cvt_pk_bf16(v0[0], v0[1]); w.y = cvt_pk_bf16(v0[2], v0[3]); w.z = cvt_pk_bf16(v1[0], v1[1]); w.w = cvt_pk_bf16(v1[2], v1[3]);
                    if (col0 + bj * HALF + 8 <= ncols) *(u32x4*)(rowp + bj * HALF) = w; } }
    }
};
template <bool SRC_BF16> struct EpiResGate {
    static constexpr bool PERM = true, AFTER_DRAIN = false, MIDK = true;
    const float* ssq;
    const float* Sc; const float* Sl;
    bf16_t* XB;
    const float* gate_rows; float* xss; int rowoff;
    template <class Sched> __device__ __forceinline__ void prep(PG8_LAS unsigned char* lds, const Sched& S, int tid) const {
        PG8_LAS float* RS = (PG8_LAS float*)(lds + STAGE_BYTES);
        const int r = tid & 255, i0 = tid >> 8;
        for (int i = i0; ; i += 2) { Unit u; if (!S.next(i, u)) break;
            const f32x4* q = (const f32x4*)(ssq + (size_t)(rowoff + u.pm * BM + r) * 8); const f32x4 a = q[0], b = q[1];
            RS[i * 256 + r] = __builtin_amdgcn_rsqf((((a[0] + a[1]) + (a[2] + a[3])) + ((b[0] + b[1]) + (b[2] + b[3]))) * (1.0f / 512.0f) + 1e-6f); }
    }
    __device__ __forceinline__ void midk(f32x4 (&acc)[2][2][4][2], PG8_LAS unsigned char* lds, int ui, int wr, int fr) const {
        int fr_ = fr; asm volatile("" : "+v"(fr_));
        PG8_LAS const float* RS = (PG8_LAS const float*)(lds + STAGE_BYTES) + ui * 256 + wr * 64 + fr_;
#pragma unroll
        for (int ai = 0; ai < 2; ++ai)
#pragma unroll
            for (int m = 0; m < 4; ++m) { const float rs = RS[ai * HALF + m * 16];
#pragma unroll
                for (int bj = 0; bj < 2; ++bj)
#pragma unroll
                    for (int n = 0; n < 2; ++n) acc[ai][bj][m][n] *= rs; }
    }
    __device__ __forceinline__ void operator()(const f32x4 (&acc)[2][2][4][2], const Unit& u, int wr, int wc, int fr, int fq) const {
        const int row0 = rowoff + u.pm * BM + wr * 64 + fr, col0 = u.pn * BM + wc * 32 + 8 * fq;
        const int t0 = rowoff + u.pm * BM; const int mrow = t0 < 2048 ? 8 : ((t0 - 2048) >> 12);
        const float* gr = gate_rows + (size_t)mrow * 6144 + col0;
        f32x4 gv[2][2];
#pragma unroll
        for (int bj = 0; bj < 2; ++bj)
#pragma unroll
            for (int n = 0; n < 2; ++n) gv[bj][n] = *(const f32x4*)(gr + bj * HALF + n * 4);
#pragma unroll
        for (int ai = 0; ai < 2; ++ai) {
            u32x4 rb[4][2]; f32x4 xf[SRC_BF16 ? 1 : 4][2][2];
#pragma unroll
            for (int m = 0; m < 4; ++m) { const int rr = row0 + ai * HALF + m * 16;
                const float* sp = (rr < 2048 ? Sc + (size_t)rr * 1024 : Sl + (size_t)(rr - 2048) * 1024) + col0; const bf16_t* dp = XB + (size_t)rr * 1024 + col0;
#pragma unroll
                for (int bj = 0; bj < 2; ++bj) {
                    if (SRC_BF16) rb[m][bj] = *(const u32x4*)(dp + bj * HALF);
                    else { xf[SRC_BF16 ? 0 : m][bj][0] = *(const f32x4*)(sp + bj * HALF); xf[SRC_BF16 ? 0 : m][bj][1] = *(const f32x4*)(sp + bj * HALF + 4); } } }
#pragma unroll
            for (int m = 0; m < 4; ++m) { const int rr = row0 + ai * HALF + m * 16;
                bf16_t* dp = XB + (size_t)rr * 1024 + col0; float ss = 0.f;
#pragma unroll
                for (int bj = 0; bj < 2; ++bj) { f32x4 x0, x1;
                    if (SRC_BF16) { const u32x4 r = rb[m][bj];
                        x0 = (f32x4){__uint_as_float(r.x << 16), __uint_as_float(r.x & 0xffff0000u), __uint_as_float(r.y << 16), __uint_as_float(r.y & 0xffff0000u)};
                        x1 = (f32x4){__uint_as_float(r.z << 16), __uint_as_float(r.z & 0xffff0000u), __uint_as_float(r.w << 16), __uint_as_float(r.w & 0xffff0000u)}; }
                    else { x0 = xf[SRC_BF16 ? 0 : m][bj][0]; x1 = xf[SRC_BF16 ? 0 : m][bj][1]; }
                    const f32x4 v0 = x0 + gv[bj][0] * acc[ai][bj][m][0], v1 = x1 + gv[bj][1] * acc[ai][bj][m][1];
                    u32x4 w; w.x = cvt_pk_bf16(v0[0], v0[1]); w.y = cvt_pk_bf16(v0[2], v0[3]); w.z = cvt_pk_bf16(v1[0], v1[1]); w.w = cvt_pk_bf16(v1[2], v1[3]);
                    *(u32x4*)(dp + bj * HALF) = w;
#pragma unroll
                    for (int j = 0; j < 4; ++j) { const float lo = __uint_as_float(w[j] << 16), hi = __uint_as_float(w[j] & 0xffff0000u); ss += lo * lo + hi * hi; } }
                { const int ln_ = fq * 16 + fr; ss += __int_as_float(__builtin_amdgcn_ds_bpermute((ln_ ^ 16) << 2, __float_as_int(ss))); ss += __int_as_float(__builtin_amdgcn_ds_bpermute((ln_ ^ 32) << 2, __float_as_int(ss))); }
                if (fq == 0) xss[(size_t)rr * 16 + u.pn * 4 + wc] = ss; }
        }
    }
};
template <class Epi, class Sched, bool STAMP = false, bool SP2 = PG8_SP2, int SCW = -1>
__device__ __forceinline__ void gemm_phase(PG8_LAS unsigned char* lds, const Gemm g, const Sched& S, const Epi& E, unsigned long long* stamps) {
    int tid_l = __builtin_amdgcn_readfirstlane(threadIdx.x >> 6) * 64 + (int)__builtin_amdgcn_mbcnt_hi(~0u, __builtin_amdgcn_mbcnt_lo(~0u, 0u)); asm volatile("" : "+v"(tid_l));
    const int tid = tid_l, wid = __builtin_amdgcn_readfirstlane(tid >> 6), lane = tid & 63, wr = wid >> 2, wc = wid & 3, fr = lane & 15, fq = lane >> 4;
    const int K = g.K, nt = K / BK;
    int ts_lo = 0, ts_hi = 0, nts = 0; const unsigned long long rt_entry = STAMP ? (unsigned long long)wall_clock64() : 0ull;
#define PG8_STAMP() do { if (STAMP && wid == 0 && nts < 64) { const unsigned long long _c = (unsigned long long)clock64(); \
        ts_lo = (lane == nts) ? (int)(unsigned)_c : ts_lo; ts_hi = (lane == nts) ? (int)(unsigned)(_c >> 32) : ts_hi; ++nts; } } while (0)
    PG8_STAMP();
    unsigned voffA[2], voffB[2];
#pragma unroll
    for (int i = 0; i < 2; ++i) { int R, C; stage_rc(tid * 16 + i * 8192, R, C); const int Rb = Epi::PERM ? ((R & ~31) + perm32(R & 31)) : R;
        voffA[i] = (unsigned)(R * K + C) * 2u; voffB[i] = (unsigned)(Rb * K + C) * 2u; }
    const size_t kstep = (size_t)(BK * 2);
    const size_t hstep = (size_t)HALF * K * 2;
    const size_t tstep = 2 * hstep;
    const unsigned ldsw = (unsigned)wid * 1024u;
    const int aoff = lds_byte(wr * 64 + fr, fq * 8), boff = lds_byte(wc * 32 + fr, fq * 8);
#define PG8_SA(b, h) (((b) * 2 + (h)) * HTB)
#define PG8_SB(b, h) ((4 + (b) * 2 + (h)) * HTB)
#define PG8_STAGE(bufoff, gbase, voff) do { _Pragma("unroll") for (int _i = 0; _i < 2; ++_i) \
        __builtin_amdgcn_global_load_lds((const unsigned*)((const char*)(gbase) + (voff)[_i]), (PG8_LAS unsigned*)(lds + (bufoff) + ldsw + _i * 8192), 16, 0, 0); } while (0)
#define PG8_LDA(dst, b, h) do { _Pragma("unroll") for (int m = 0; m < 4; ++m) _Pragma("unroll") for (int k = 0; k < 2; ++k) dst[m][k] = *(const PG8_LAS bf16x8*)(lds + PG8_SA(b, h) + aoff + m * 2048 + k * 1024); } while (0)
#define PG8_LDB(dst, b, h) do { _Pragma("unroll") for (int n = 0; n < 2; ++n) _Pragma("unroll") for (int k = 0; k < 2; ++k) dst[n][k] = *(const PG8_LAS bf16x8*)(lds + PG8_SB(b, h) + boff + n * 2048 + k * 1024); } while (0)
#define PG8_MMA(ai, bj, At, Bt) do { __builtin_amdgcn_s_setprio(1); _Pragma("unroll") for (int m = 0; m < 4; ++m) _Pragma("unroll") for (int n = 0; n < 2; ++n) { \
        if constexpr (SCW >= 0) mfma8(acc[ai][bj][m][n], cat8(Bt[n][0], Bt[n][1]), cat8(At[m][0], At[m][1])); \
        else { _Pragma("unroll") for (int k = 0; k < 2; ++k) acc[ai][bj][m][n] = __builtin_amdgcn_mfma_f32_16x16x32_bf16(Bt[n][k], At[m][k], acc[ai][bj][m][n], 0, 0, 0); } } __builtin_amdgcn_s_setprio(0); } while (0)
#define PG8_WAIT_V(n) asm volatile("s_waitcnt vmcnt(" #n ")" ::: "memory")
#define PG8_WAIT_L(n) asm volatile("s_waitcnt lgkmcnt(" #n ")" ::: "memory")
#define PG8_BAR __builtin_amdgcn_s_barrier()
#define PG8_SCHED __builtin_amdgcn_sched_barrier(0)
    Unit cur, nxt; int ui = 0;
    if (!S.next(0, cur)) return;
    f32x4 acc[2][2][4][2];
#pragma unroll
    for (int a = 0; a < 2; ++a)
#pragma unroll
        for (int b = 0; b < 2; ++b)
#pragma unroll
            for (int m = 0; m < 4; ++m)
#pragma unroll
                for (int n = 0; n < 2; ++n) acc[a][b][m][n] = (f32x4){0.f, 0.f, 0.f, 0.f};
    bf16x8 At[4][2], B0[2][2], B1[2][2];
    const char* cA = (const char*)g.A + (size_t)cur.pm * tstep; const char* cB = (const char*)g.Bt + (size_t)cur.pn * tstep;
    S.a_ready(cur);
    if constexpr (Epi::MIDK) E.prep(lds, S, tid);
    if constexpr (SP2) {
        PG8_STAGE(PG8_SB(0, 0), cB, voffB); PG8_STAGE(PG8_SB(0, 1), cB + hstep, voffB); PG8_STAGE(PG8_SA(0, 0), cA, voffA); PG8_STAGE(PG8_SA(0, 1), cA + hstep, voffA);
        if (wr == 1) PG8_BAR;
        PG8_WAIT_V(2); PG8_BAR;
        PG8_STAGE(PG8_SB(1, 0), cB + kstep, voffB); PG8_STAGE(PG8_SA(1, 0), cA + kstep, voffA); PG8_STAGE(PG8_SB(1, 1), cB + hstep + kstep, voffB);
        PG8_WAIT_V(6); PG8_BAR;
    } else {
    PG8_STAGE(PG8_SB(0, 0), cB, voffB); PG8_STAGE(PG8_SA(0, 0), cA, voffA); PG8_STAGE(PG8_SB(0, 1), cB + hstep, voffB); PG8_STAGE(PG8_SA(0, 1), cA + hstep, voffA);
    if (wr == 1) PG8_BAR;
    PG8_WAIT_V(4); PG8_BAR;
    PG8_STAGE(PG8_SB(1, 0), cB + kstep, voffB); PG8_STAGE(PG8_SA(1, 0), cA + kstep, voffA); PG8_STAGE(PG8_SB(1, 1), cB + hstep + kstep, voffB);
    PG8_WAIT_V(6); PG8_BAR;
    }
    PG8_STAMP();
    for (;;) {
        const bool has_next = S.next(ui + 1, nxt);
        const char* nA = has_next ? (const char*)g.A + (size_t)nxt.pm * tstep : cA; const char* nB = has_next ? (const char*)g.Bt + (size_t)nxt.pn * tstep : cB;
        for (int t = 0; t < nt; t += 2) {
            const bool last = (t == nt - 2);
            const char* a1 = cA + (size_t)(t + 1) * kstep;
            const char* a2 = last ? nA : cA + (size_t)(t + 2) * kstep; const char* b2 = last ? nB : cB + (size_t)(t + 2) * kstep;
            const char* a3 = a2 + kstep; const char* b3 = b2 + kstep;
            if (last && has_next) S.a_ready(nxt);
            if constexpr (SP2) {
            PG8_LDB(B0, 0, 0); PG8_LDB(B1, 0, 1); PG8_SCHED; PG8_LDA(At, 0, 0); PG8_STAGE(PG8_SA(1, 1), a1 + hstep, voffA);
            PG8_WAIT_V(8); PG8_WAIT_L(0); PG8_BAR; PG8_MMA(0, 0, At, B0); PG8_MMA(0, 1, At, B1); PG8_BAR; PG8_SCHED;
            PG8_LDA(At, 0, 1); PG8_STAGE(PG8_SB(0, 0), b2, voffB); PG8_STAGE(PG8_SB(0, 1), b2 + hstep, voffB); PG8_STAGE(PG8_SA(0, 0), a2, voffA);
            PG8_WAIT_V(8); PG8_WAIT_L(0); PG8_BAR; PG8_MMA(1, 0, At, B0); PG8_MMA(1, 1, At, B1); PG8_BAR; PG8_SCHED;
            PG8_LDB(B0, 1, 0); PG8_LDB(B1, 1, 1); PG8_SCHED; PG8_LDA(At, 1, 0); PG8_STAGE(PG8_SA(0, 1), a2 + hstep, voffA);
            PG8_WAIT_V(8); PG8_WAIT_L(0); PG8_BAR; PG8_MMA(0, 0, At, B0); PG8_MMA(0, 1, At, B1); PG8_BAR; PG8_SCHED;
            PG8_LDA(At, 1, 1); PG8_STAGE(PG8_SB(1, 0), b3, voffB); PG8_STAGE(PG8_SB(1, 1), b3 + hstep, voffB); PG8_STAGE(PG8_SA(1, 0), a3, voffA);
            PG8_WAIT_V(8); PG8_WAIT_L(0); PG8_BAR; PG8_MMA(1, 0, At, B0); PG8_MMA(1, 1, At, B1); PG8_BAR; PG8_SCHED;
            } else {
            PG8_LDB(B0, 0, 0); PG8_SCHED; PG8_LDA(At, 0, 0); PG8_STAGE(PG8_SA(1, 1), a1 + hstep, voffA);
            PG8_WAIT_L(8); PG8_BAR; PG8_WAIT_L(0); PG8_MMA(0, 0, At, B0); PG8_BAR; PG8_SCHED;
            PG8_LDB(B1, 0, 1); PG8_STAGE(PG8_SB(0, 0), b2, voffB);
            PG8_BAR; PG8_WAIT_L(0); PG8_MMA(0, 1, At, B1); PG8_BAR;
            PG8_LDA(At, 0, 1); PG8_STAGE(PG8_SA(0, 0), a2, voffA);
            PG8_BAR; PG8_WAIT_L(0); PG8_MMA(1, 0, At, B0); PG8_BAR; PG8_SCHED;
            PG8_STAGE(PG8_SB(0, 1), b2 + hstep, voffB);
            PG8_WAIT_V(6); PG8_BAR; PG8_MMA(1, 1, At, B1); PG8_BAR;
            PG8_LDB(B0, 1, 0); PG8_SCHED; PG8_LDA(At, 1, 0); PG8_STAGE(PG8_SA(0, 1), a2 + hstep, voffA);
            PG8_WAIT_L(8); PG8_BAR; PG8_WAIT_L(0); PG8_MMA(0, 0, At, B0); PG8_BAR; PG8_SCHED;
            PG8_LDB(B1, 1, 1); PG8_STAGE(PG8_SB(1, 0), b3, voffB);
            PG8_BAR; PG8_WAIT_L(0); PG8_MMA(0, 1, At, B1); PG8_BAR;
            PG8_LDA(At, 1, 1); PG8_STAGE(PG8_SA(1, 0), a3, voffA);
            PG8_BAR; PG8_WAIT_L(0); PG8_MMA(1, 0, At, B0); PG8_BAR; PG8_SCHED;
            PG8_STAGE(PG8_SB(1, 1), b3 + hstep, voffB);
            PG8_WAIT_V(6); PG8_BAR; PG8_MMA(1, 1, At, B1); PG8_BAR;
            }
            if constexpr (Epi::MIDK) { if (t + 2 == nt / 2) E.midk(acc, lds, ui, wr, fr); }
        }
        PG8_STAMP();
        if (wr == 0) PG8_BAR;
        if constexpr (SCW >= 0) asm volatile("s_nop 15\n\ts_nop 15" ::: "memory");
        if constexpr (!Epi::AFTER_DRAIN) { E(acc, cur, wr, wc, fr, fq); S.done(cur); }
        PG8_STAMP();
        if (!has_next) break;
#pragma unroll
        for (int a = 0; a < 2; ++a)
#pragma unroll
            for (int b = 0; b < 2; ++b)
#pragma unroll
                for (int m = 0; m < 4; ++m)
#pragma unroll
                    for (int n = 0; n < 2; ++n) acc[a][b][m][n] = (f32x4){0.f, 0.f, 0.f, 0.f};
        cur = nxt; cA = nA; cB = nB; ++ui;
        if (wr == 1) PG8_BAR;
    }
    PG8_WAIT_V(0);
    PG8_BAR;
    if constexpr (Epi::AFTER_DRAIN) { E.fused(acc, cur, wr, wc, fr, fq, lds, wid, lane); S.done(cur); }
    PG8_STAMP();
    if (STAMP && wid == 0) { stamps[lane] = lane < nts ? (((unsigned long long)(unsigned)ts_hi << 32) | (unsigned)ts_lo) : 0ull;
        if (lane == 62) stamps[62] = rt_entry; if (lane == 63) stamps[63] = (unsigned long long)wall_clock64(); }
#undef PG8_STAMP
#undef PG8_SA
#undef PG8_SB
#undef PG8_STAGE
#undef PG8_LDA
#undef PG8_LDB
#undef PG8_MMA
#undef PG8_WAIT_V
#undef PG8_WAIT_L
#undef PG8_BAR
#undef PG8_SCHED
}

struct MoeUnit { int e, mt, pn, cnt, pstart; };
struct MoeSched {
    typedef MoeUnit UnitT;
    PG8_LAS const int* tab; const int* map; int U, G, c, npn, gather; size_t bstride;
    __device__ __forceinline__ bool next(int i, MoeUnit& u) const {
        const long L = (long)i * G + c; if (L >= U) return false;
        int idx = (int)L; { const int q = U / NXCD, r = U % NXCD, xcd = idx % NXCD, off = idx / NXCD; idx = (xcd < r ? xcd * (q + 1) : r * (q + 1) + (xcd - r) * q) + off; }
        const int tau = idx / npn; u.pn = idx - tau * npn;
        int e = 0;
#pragma unroll
        for (int st = 16; st >= 1; st >>= 1) { if (__builtin_amdgcn_readfirstlane(tab[e + st]) <= tau) e += st; }
        u.e = e; u.mt = tau - __builtin_amdgcn_readfirstlane(tab[e]); u.cnt = __builtin_amdgcn_readfirstlane(tab[33 + e]); u.pstart = __builtin_amdgcn_readfirstlane(tab[65 + e]);
        return true;
    }
    __device__ __forceinline__ const char* bbase(const Gemm& g, const MoeUnit& u) const { return (const char*)g.Bt + (size_t)u.e * bstride + (size_t)u.pn * BM * g.K * 2; }
    __device__ __forceinline__ void a_offsets(const Gemm& g, const MoeUnit& u, int tid, unsigned (&va)[2][2]) const {
        int tl = tid; asm volatile("" : "+v"(tl));
        int RA[2], CA[2];
#pragma unroll
        for (int i = 0; i < 2; ++i) { int R, C; stage_rc(tl * 16 + i * 8192, R, C); RA[i] = R; CA[i] = C * 2; }
#pragma unroll
        for (int hf = 0; hf < 2; ++hf)
#pragma unroll
            for (int i = 0; i < 2; ++i) { int rl = u.mt * BM + hf * HALF + RA[i]; rl = rl < u.cnt ? rl : u.cnt - 1;
                const unsigned row = gather ? (unsigned)map[(size_t)u.e * 34816 + rl] : (unsigned)(u.pstart + rl);
                va[hf][i] = row * (unsigned)(g.K * 2) + (unsigned)CA[i]; }
    }
};
struct EpiAct {
    static constexpr bool PERM = true, AFTER_DRAIN = false;
    unsigned char* O;
    __device__ __forceinline__ void operator()(const f32x4 (&acc)[2][2][4][2], const MoeUnit& u, int wr, int wc, int fr, int fq) const {
        typedef unsigned u32x2 __attribute__((ext_vector_type(2)));
        const int rl0 = u.mt * BM + wr * 64 + fr, col0 = u.pn * HALF + wc * 32 + 8 * fq;
#pragma unroll
        for (int ai = 0; ai < 2; ++ai)
#pragma unroll
            for (int m = 0; m < 4; ++m) { const int rl = rl0 + ai * HALF + m * 16;
                if (rl < u.cnt) { f32x4 o[2];
#pragma unroll
                    for (int n = 0; n < 2; ++n)
#pragma unroll
                        for (int j = 0; j < 4; ++j) { const float gv = acc[ai][0][m][n][j] * (1.0f / 64.0f)  ; o[n][j] = gv * __builtin_amdgcn_rcpf(1.0f + __builtin_amdgcn_exp2f(-1.4426950408889634f * gv)) * (acc[ai][1][m][n][j] * 0.125f)  ; }
                    *(u32x2*)(O + (size_t)(u.pstart + rl) * 512 + col0) = (u32x2){pk4_fp8(o[0]), pk4_fp8(o[1])}; } }
    }
};
struct EpiY {
    static constexpr bool PERM = true, AFTER_DRAIN = false;
    unsigned char* O;
    static __device__ __forceinline__ unsigned pk4(const f32x4 v) { const float lim = 440.f;
        int w = __builtin_amdgcn_cvt_pk_fp8_f32(fminf(fmaxf(v[0], -lim), lim), fminf(fmaxf(v[1], -lim), lim), 0, false);
        return (unsigned)__builtin_amdgcn_cvt_pk_fp8_f32(fminf(fmaxf(v[2], -lim), lim), fminf(fmaxf(v[3], -lim), lim), w, true); }
    __device__ __forceinline__ void operator()(const f32x4 (&acc)[2][2][4][2], const MoeUnit& u, int wr, int wc, int fr, int fq) const {
        typedef unsigned u32x2 __attribute__((ext_vector_type(2)));
        const int rl0 = u.mt * BM + wr * 64 + fr, col0 = u.pn * BM + wc * 32 + 8 * fq;
#pragma unroll
        for (int ai = 0; ai < 2; ++ai)
#pragma unroll
            for (int m = 0; m < 4; ++m) { const int rl = rl0 + ai * HALF + m * 16;
                if (rl < u.cnt) { unsigned char* rowp = O + (size_t)(u.pstart + rl) * 1024 + col0;
#pragma unroll
                    for (int bj = 0; bj < 2; ++bj) *(u32x2*)(rowp + bj * HALF) = (u32x2){pk4(acc[ai][bj][m][0] * (1.0f / 512.0f)), pk4(acc[ai][bj][m][1] * (1.0f / 512.0f))}; } }
    }
};
template <class Epi, class Sched, bool STAMP = false, bool SP2 = PG8_SP2, int SCW = -1, int SCA = 127>
__device__ __forceinline__ void gemm_phase_moe(PG8_LAS unsigned char* lds, const Gemm g, const Sched& S, const Epi& E, unsigned long long* stamps) {
    int tid_l = __builtin_amdgcn_readfirstlane(threadIdx.x >> 6) * 64 + (int)__builtin_amdgcn_mbcnt_hi(~0u, __builtin_amdgcn_mbcnt_lo(~0u, 0u)); asm volatile("" : "+v"(tid_l));
    const int tid = tid_l, wid = __builtin_amdgcn_readfirstlane(tid >> 6), lane = tid & 63, wr = wid >> 2, wc = wid & 3, fr = lane & 15, fq = lane >> 4;
    const int K = g.K, nt = K / BK;
    int ts_lo = 0, ts_hi = 0, nts = 0; const unsigned long long rt_entry = STAMP ? (unsigned long long)wall_clock64() : 0ull;
#define PG8_STAMP() do { if (STAMP && wid == 0 && nts < 64) { const unsigned long long _c = (unsigned long long)clock64(); \
        ts_lo = (lane == nts) ? (int)(unsigned)_c : ts_lo; ts_hi = (lane == nts) ? (int)(unsigned)(_c >> 32) : ts_hi; ++nts; } } while (0)
    PG8_STAMP();
    unsigned voffB[2];
#pragma unroll
    for (int i = 0; i < 2; ++i) { int R, C; stage_rc(tid * 16 + i * 8192, R, C); const int Rb = Epi::PERM ? ((R & ~31) + perm32(R & 31)) : R;
        voffB[i] = (unsigned)(Rb * K + C) * 2u; }
    unsigned vaC[2][2];
    PG8_LAS unsigned* vtab = (PG8_LAS unsigned*)(lds + STAGE_BYTES + 1024) + tid;
    const size_t kstep = (size_t)(BK * 2);
    const size_t hstep = (size_t)HALF * K * 2;
    const size_t tstep = 2 * hstep;
    const unsigned ldsw = (unsigned)wid * 1024u;
    const int aoff = lds_byte(wr * 64 + fr, fq * 8), boff = lds_byte(wc * 32 + fr, fq * 8);
#define PG8_SA(b, h) (((b) * 2 + (h)) * HTB)
#define PG8_SB(b, h) ((4 + (b) * 2 + (h)) * HTB)
#define PG8_STAGE(bufoff, gbase, voff) do { _Pragma("unroll") for (int _i = 0; _i < 2; ++_i) \
        __builtin_amdgcn_global_load_lds((const unsigned*)((const char*)(gbase) + (voff)[_i]), (PG8_LAS unsigned*)(lds + (bufoff) + ldsw + _i * 8192), 16, 0, 0); } while (0)
#define PG8_STAGEA(bufoff, kbyte, va) do { _Pragma("unroll") for (int _i = 0; _i < 2; ++_i) \
        __builtin_amdgcn_global_load_lds((const unsigned*)((const char*)g.A + (kbyte) + (va)[_i]), (PG8_LAS unsigned*)(lds + (bufoff) + ldsw + _i * 8192), 16, 0, 0); } while (0)
#define PG8_LDA(dst, b, h) do { _Pragma("unroll") for (int m = 0; m < 4; ++m) _Pragma("unroll") for (int k = 0; k < 2; ++k) dst[m][k] = *(const PG8_LAS bf16x8*)(lds + PG8_SA(b, h) + aoff + m * 2048 + k * 1024); } while (0)
#define PG8_LDB(dst, b, h) do { _Pragma("unroll") for (int n = 0; n < 2; ++n) _Pragma("unroll") for (int k = 0; k < 2; ++k) dst[n][k] = *(const PG8_LAS bf16x8*)(lds + PG8_SB(b, h) + boff + n * 2048 + k * 1024); } while (0)
#define PG8_MMA(ai, bj, At, Bt) do { __builtin_amdgcn_s_setprio(1); _Pragma("unroll") for (int m = 0; m < 4; ++m) _Pragma("unroll") for (int n = 0; n < 2; ++n) { \
        if constexpr (SCW >= 0) mfma8(acc[ai][bj][m][n], cat8(Bt[n][0], Bt[n][1]), cat8(At[m][0], At[m][1])); \
        else { _Pragma("unroll") for (int k = 0; k < 2; ++k) acc[ai][bj][m][n] = __builtin_amdgcn_mfma_f32_16x16x32_bf16(Bt[n][k], At[m][k], acc[ai][bj][m][n], 0, 0, 0); } } __builtin_amdgcn_s_setprio(0); } while (0)
#define PG8_WAIT_V(n) asm volatile("s_waitcnt vmcnt(" #n ")" ::: "memory")
#define PG8_WAIT_L(n) asm volatile("s_waitcnt lgkmcnt(" #n ")" ::: "memory")
#define PG8_BAR __builtin_amdgcn_s_barrier()
#define PG8_SCHED __builtin_amdgcn_sched_barrier(0)
    typename Sched::UnitT cur, nxt; int ui = 0;
    if (!S.next(0, cur)) return;
    f32x4 acc[2][2][4][2];
#pragma unroll
    for (int a = 0; a < 2; ++a)
#pragma unroll
        for (int b = 0; b < 2; ++b)
#pragma unroll
            for (int m = 0; m < 4; ++m)
#pragma unroll
                for (int n = 0; n < 2; ++n) acc[a][b][m][n] = (f32x4){0.f, 0.f, 0.f, 0.f};
    bf16x8 At[4][2], B0[2][2], B1[2][2];
    const char* cB = S.bbase(g, cur); S.a_offsets(g, cur, tid, vaC);
    if constexpr (SP2) {
        PG8_STAGE(PG8_SB(0, 0), cB, voffB); PG8_STAGE(PG8_SB(0, 1), cB + hstep, voffB); PG8_STAGEA(PG8_SA(0, 0), 0, vaC[0]); PG8_STAGEA(PG8_SA(0, 1), 0, vaC[1]);
        if (wr == 1) PG8_BAR;
        PG8_WAIT_V(2); PG8_BAR;
        PG8_STAGE(PG8_SB(1, 0), cB + kstep, voffB); PG8_STAGEA(PG8_SA(1, 0), kstep, vaC[0]); PG8_STAGE(PG8_SB(1, 1), cB + hstep + kstep, voffB);
        PG8_WAIT_V(6); PG8_BAR;
    } else {
    PG8_STAGE(PG8_SB(0, 0), cB, voffB); PG8_STAGEA(PG8_SA(0, 0), 0, vaC[0]); PG8_STAGE(PG8_SB(0, 1), cB + hstep, voffB); PG8_STAGEA(PG8_SA(0, 1), 0, vaC[1]);
    if (wr == 1) PG8_BAR;
    PG8_WAIT_V(4); PG8_BAR;
    PG8_STAGE(PG8_SB(1, 0), cB + kstep, voffB); PG8_STAGEA(PG8_SA(1, 0), kstep, vaC[0]); PG8_STAGE(PG8_SB(1, 1), cB + hstep + kstep, voffB);
    PG8_WAIT_V(6); PG8_BAR;
    }
    PG8_STAMP();
    for (;;) {
        const bool has_next = S.next(ui + 1, nxt);
        const char* nB = has_next ? S.bbase(g, nxt) : cB;
        { unsigned vaN[2][2];
          if (has_next) S.a_offsets(g, nxt, tid, vaN); else {
#pragma unroll
            for (int hf = 0; hf < 2; ++hf)
#pragma unroll
                for (int i = 0; i < 2; ++i) vaN[hf][i] = vaC[hf][i]; }
#pragma unroll
          for (int hf = 0; hf < 2; ++hf)
#pragma unroll
              for (int i = 0; i < 2; ++i) vtab[(hf * 2 + i) * 512] = vaN[hf][i]; }
        unsigned v2[2][2];
        for (int t = 0; t < nt; t += 2) {
            const bool last = (t == nt - 2);
            const size_t k1 = (size_t)(t + 1) * kstep, k2 = last ? (size_t)0 : (size_t)(t + 2) * kstep, k3 = k2 + kstep;
            const char* b2 = last ? nB : cB + (size_t)(t + 2) * kstep; const char* b3 = b2 + kstep;
#pragma unroll
            for (int hf = 0; hf < 2; ++hf)
#pragma unroll
                for (int i = 0; i < 2; ++i) v2[hf][i] = last ? vtab[(hf * 2 + i) * 512] : vaC[hf][i];
            if constexpr (SP2) {
            PG8_LDB(B0, 0, 0); PG8_LDB(B1, 0, 1); PG8_SCHED; PG8_LDA(At, 0, 0); PG8_STAGEA(PG8_SA(1, 1), k1, vaC[1]);
            PG8_WAIT_V(8); PG8_WAIT_L(0); PG8_BAR; PG8_MMA(0, 0, At, B0); PG8_MMA(0, 1, At, B1); PG8_BAR; PG8_SCHED;
            PG8_LDA(At, 0, 1); PG8_STAGE(PG8_SB(0, 0), b2, voffB); PG8_STAGE(PG8_SB(0, 1), b2 + hstep, voffB); PG8_STAGEA(PG8_SA(0, 0), k2, v2[0]);
            PG8_WAIT_V(8); PG8_WAIT_L(0); PG8_BAR; PG8_MMA(1, 0, At, B0); PG8_MMA(1, 1, At, B1); PG8_BAR; PG8_SCHED;
            PG8_LDB(B0, 1, 0); PG8_LDB(B1, 1, 1); PG8_SCHED; PG8_LDA(At, 1, 0); PG8_STAGEA(PG8_SA(0, 1), k2, v2[1]);
            PG8_WAIT_V(8); PG8_WAIT_L(0); PG8_BAR; PG8_MMA(0, 0, At, B0); PG8_MMA(0, 1, At, B1); PG8_BAR; PG8_SCHED;
            PG8_LDA(At, 1, 1); PG8_STAGE(PG8_SB(1, 0), b3, voffB); PG8_STAGE(PG8_SB(1, 1), b3 + hstep, voffB); PG8_STAGEA(PG8_SA(1, 0), k3, v2[0]);
            PG8_WAIT_V(8); PG8_WAIT_L(0); PG8_BAR; PG8_MMA(1, 0, At, B0); PG8_MMA(1, 1, At, B1); PG8_BAR; PG8_SCHED;
            } else {
            PG8_LDB(B0, 0, 0); PG8_SCHED; PG8_LDA(At, 0, 0); PG8_STAGEA(PG8_SA(1, 1), k1, vaC[1]);
            PG8_WAIT_L(8); PG8_BAR; PG8_WAIT_L(0); PG8_MMA(0, 0, At, B0); PG8_BAR; PG8_SCHED;
            PG8_LDB(B1, 0, 1); PG8_STAGE(PG8_SB(0, 0), b2, voffB);
            PG8_BAR; PG8_WAIT_L(0); PG8_MMA(0, 1, At, B1); PG8_BAR;
            PG8_LDA(At, 0, 1); PG8_STAGEA(PG8_SA(0, 0), k2, v2[0]);
            PG8_BAR; PG8_WAIT_L(0); PG8_MMA(1, 0, At, B0); PG8_BAR; PG8_SCHED;
            PG8_STAGE(PG8_SB(0, 1), b2 + hstep, voffB);
            PG8_WAIT_V(6); PG8_BAR; PG8_MMA(1, 1, At, B1); PG8_BAR;
            PG8_LDB(B0, 1, 0); PG8_SCHED; PG8_LDA(At, 1, 0); PG8_STAGEA(PG8_SA(0, 1), k2, v2[1]);
            PG8_WAIT_L(8); PG8_BAR; PG8_WAIT_L(0); PG8_MMA(0, 0, At, B0); PG8_BAR; PG8_SCHED;
            PG8_LDB(B1, 1, 1); PG8_STAGE(PG8_SB(1, 0), b3, voffB);
            PG8_BAR; PG8_WAIT_L(0); PG8_MMA(0, 1, At, B1); PG8_BAR;
            PG8_LDA(At, 1, 1); PG8_STAGEA(PG8_SA(1, 0), k3, v2[0]);
            PG8_BAR; PG8_WAIT_L(0); PG8_MMA(1, 0, At, B0); PG8_BAR; PG8_SCHED;
            PG8_STAGE(PG8_SB(1, 1), b3 + hstep, voffB);
            PG8_WAIT_V(6); PG8_BAR; PG8_MMA(1, 1, At, B1); PG8_BAR;
            }
        }
        PG8_STAMP();
        if (wr == 0) PG8_BAR;
        if constexpr (SCW >= 0) asm volatile("s_nop 15\n\ts_nop 15" ::: "memory");
        E(acc, cur, wr, wc, fr, fq);
        PG8_STAMP();
        if (!has_next) break;
#pragma unroll
        for (int a = 0; a < 2; ++a)
#pragma unroll
            for (int b = 0; b < 2; ++b)
#pragma unroll
                for (int m = 0; m < 4; ++m)
#pragma unroll
                    for (int n = 0; n < 2; ++n) acc[a][b][m][n] = (f32x4){0.f, 0.f, 0.f, 0.f};
        cur = nxt; cB = nB; ++ui;
#pragma unroll
        for (int hf = 0; hf < 2; ++hf)
#pragma unroll
            for (int i = 0; i < 2; ++i) vaC[hf][i] = v2[hf][i];
        if (wr == 1) PG8_BAR;
    }
    PG8_WAIT_V(0);
    PG8_BAR;
    PG8_STAMP();
    if (STAMP && wid == 0) { stamps[lane] = lane < nts ? (((unsigned long long)(unsigned)ts_hi << 32) | (unsigned)ts_lo) : 0ull;
        if (lane == 62) stamps[62] = rt_entry; if (lane == 63) stamps[63] = (unsigned long long)wall_clock64(); }
#undef PG8_STAMP
#undef PG8_SA
#undef PG8_SB
#undef PG8_STAGE
#undef PG8_STAGEA
#undef PG8_LDA
#undef PG8_LDB
#undef PG8_MMA
#undef PG8_WAIT_V
#undef PG8_WAIT_L
#undef PG8_BAR
#undef PG8_SCHED
}
}

constexpr int NTHR = 512, NWV = 8, LDS_BYTES = 147456;

struct P {
    const float *x, *c, *ctx, *c_ctx, *w_mod, *b_mod, *norm1_g, *norm2_g, *w_in, *conv_w, *conv_b, *dt_bias_f, *dt_bias_b, *a_log_f, *a_log_b, *d_skip, *ssd_norm_g,
        *gk_up_f, *gk_bias_f, *gk_up_b, *gk_bias_b, *gla_norm_g, *w_out, *w_router, *router_bias, *w_gate, *w_up, *w_down, *final_g;
    float* out; bf16_t* XB; bf16_t* H; bf16_t* PROJ; bf16_t* SS; bf16_t* GS; float* SDEC; float* GDEC; float* MOD; int* counts; int* TOKSLOT; float* EW; int* MAP; bf16_t* WinT; bf16_t* WoutT; bf16_t* WguT; bf16_t* WdT; bf16_t* WRT; unsigned* BAR; bf16_t* XBCC; bf16_t* QKB; float* SSC; float* STOT; float* SSQ; float* XSS;
};

DI void ph_init(const P& p) { const size_t i = (size_t)blockIdx.x * NTHR + ltid(); if (i < 64) p.counts[i * 32] = 0; }

DI void ph_mod(const P& p, float* s  ) {
    const int tid_ = ltid(), lane = tid_ & 63, w = tid_ >> 6;
    if (blockIdx.x >= 192) return;
    float* part = s + 9 * 1024;
    { float cv[18];
#pragma unroll
      for (int q = 0; q < 18; ++q) { const int i = tid_ + q * NTHR, r = i >> 10, k = i & 1023; cv[q] = r < 8 ? p.c[r * 1024 + k] : p.c_ctx[k]; }
#pragma unroll
      for (int q = 0; q < 18; ++q) s[tid_ + q * NTHR] = siluf(cv[q]); }
    __syncthreads();
    for (int vb = blockIdx.x; vb < 192; vb += gridDim.x) {
        const int l = vb / 96, n = (vb % 96) * 64 + lane;
        float acc[9];
#pragma unroll
        for (int r = 0; r < 9; ++r) acc[r] = 0.f;
        const float* wp = p.w_mod + (size_t)l * 1024 * 6144 + (size_t)(128 * w) * 6144 + n;
#pragma unroll 8
        for (int k = 0; k < 128; ++k) { const float wv = wp[(size_t)k * 6144];
#pragma unroll
            for (int r = 0; r < 9; ++r) acc[r] += s[r * 1024 + 128 * w + k] * wv; }
#pragma unroll
        for (int r = 0; r < 9; ++r) part[(w * 9 + r) * 64 + lane] = acc[r];
        __syncthreads();
        for (int o = tid_; o < 9 * 64; o += NTHR) { const int r = o >> 6, c = o & 63; float a = p.b_mod[l * 6144 + (vb % 96) * 64 + c];
#pragma unroll
            for (int q = 0; q < 8; ++q) a += part[(q * 9 + r) * 64 + c];
            p.MOD[((size_t)l * 9 + r) * 6144 + (vb % 96) * 64 + c] = a; }
        __syncthreads();
    }
}

DI unsigned pk2(float lo, float hi) { return __builtin_bit_cast(unsigned, __builtin_convertvector((f32x2v_){lo, hi}, bf16x2v_)); }
template <bool F8 = false> DI void transpose_item(const float* W, int K, int N, bf16_t* WT, float* scr, int item, int lane, int gu = -1, const float* kscale = nullptr) {
    const int nblk = (N + 31) / 32, kb = item / nblk, nb = item % nblk, k0 = 64 * kb, n0 = 32 * nb;
    const int d0 = gu < 0 ? n0 : 256 * (n0 >> 7) + (n0 & 127) + 128 * gu;
    const bool nok = n0 + (lane & 31) < N;
    float wv_[32];
#pragma unroll
    for (int i = 0; i < 32; ++i) { const int kk = 2 * i + (lane >> 5); wv_[i] = nok ? __builtin_nontemporal_load(W + (size_t)(k0 + kk) * N + n0 + (lane & 31)) : 0.f; }
#pragma unroll
    for (int i = 0; i < 32; ++i) { const int kk = 2 * i + (lane >> 5); scr[kk * 33 + (lane & 31)] = wv_[i] * (kscale ? kscale[k0 + kk] : 1.0f); }
    const int c = lane & 7;
#pragma unroll
    for (int j = 0; j < 4; ++j) { const int n = (lane >> 3) + 8 * j; const float* q = scr + (8 * c) * 33 + n;
        if constexpr (F8) { typedef unsigned u32x2nt __attribute__((ext_vector_type(2)));
            const u32x2nt o = {pg8::pk4_fp8((pg8::f32x4){q[0 * 33], q[1 * 33], q[2 * 33], q[3 * 33]} * 64.0f), pg8::pk4_fp8((pg8::f32x4){q[4 * 33], q[5 * 33], q[6 * 33], q[7 * 33]} * 64.0f)};
            if (n0 + n < N) __builtin_nontemporal_store(o, (u32x2nt*)((unsigned char*)WT + (size_t)(d0 + n) * K + k0 + 8 * c)); }
        else {
        uint4 o; o.x = pk2(q[0 * 33], q[1 * 33]); o.y = pk2(q[2 * 33], q[3 * 33]); o.z = pk2(q[4 * 33], q[5 * 33]); o.w = pk2(q[6 * 33], q[7 * 33]);
        if (n0 + n < N) { typedef unsigned u32x4nt __attribute__((ext_vector_type(4))); __builtin_nontemporal_store((u32x4nt){o.x, o.y, o.z, o.w}, (u32x4nt*)(WT + (size_t)(d0 + n) * K + k0 + 8 * c)); } } }
}

struct TrD { const float* src; unsigned char* dst; int N, K; bool ok; };
DI TrD tr_desc(const P& p, int l, int it, int it1, int lane) {
    TrD d; d.ok = it < it1; const int itc = d.ok ? it : it1 - 1;
    const int e = itc / 768, r = itc - e * 768;
    const float* W; unsigned char* WT; int K, N, item, gu;
    if (r < 512) { gu = r >> 8; W = (gu ? p.w_up : p.w_gate) + (size_t)(l * NE + e) * D * 512; K = D; N = 512; WT = (unsigned char*)p.WguT + (size_t)e * D * D; item = r & 255; }
    else { gu = -1; W = p.w_down + (size_t)(l * NE + e) * 512 * D; K = 512; N = D; WT = (unsigned char*)p.WdT + (size_t)e * D * 512; item = r - 512; }
    const int nblk = N / 32, kb = item / nblk, nb = item % nblk, k0 = 64 * kb, n0 = 32 * nb;
    const int d0 = gu < 0 ? n0 : 256 * (n0 >> 7) + (n0 & 127) + 128 * gu;
    d.src = W + (size_t)(k0 + (lane >> 5)) * N + n0 + (lane & 31); d.dst = WT + (size_t)d0 * K + k0; d.N = N; d.K = K;
    return d;
}
DI void tr_load(const TrD& d, float (&v)[32]) {
#pragma unroll
    for (int i = 0; i < 32; ++i) v[i] = __builtin_nontemporal_load(d.src + (size_t)(2 * i) * d.N);
}
DI void tr_finish(const TrD& d, const float (&v)[32], float* scr, int lane) {
#pragma unroll
    for (int i = 0; i < 32; ++i) { const int kk = 2 * i + (lane >> 5); scr[kk * 33 + (lane & 31)] = v[i]; }
    const int c = lane & 7;
#pragma unroll
    for (int j = 0; j < 4; ++j) { const int n = (lane >> 3) + 8 * j; const float* q = scr + (8 * c) * 33 + n;
        typedef unsigned u32x2nt __attribute__((ext_vector_type(2)));
        const u32x2nt o = {pg8::pk4_fp8((pg8::f32x4){q[0 * 33], q[1 * 33], q[2 * 33], q[3 * 33]} * 64.0f), pg8::pk4_fp8((pg8::f32x4){q[4 * 33], q[5 * 33], q[6 * 33], q[7 * 33]} * 64.0f)};
        if (d.ok) __builtin_nontemporal_store(o, (u32x2nt*)(d.dst + (size_t)n * d.K + 8 * c)); }
}
#ifndef TR_NI
#define TR_NI 4
#endif
DI void ph_convert_experts(const P& p, int l, float* ldsf, int wk0, int nwk, int it0 = 0, int it1 = NE * 768) {
    const int tid_ = ltid(), lane = tid_ & 63, gw = ((int)blockIdx.x - wk0) * NWV + (tid_ >> 6), NW = nwk * NWV;
    float* scr = ldsf + 14 * 1024 + (tid_ >> 6) * (64 * 33 + 16);
    for (int it = it0 + gw; it < it1; it += TR_NI * NW) {
        float v[TR_NI][32]; TrD d[TR_NI];
#pragma unroll
        for (int j = 0; j < TR_NI; ++j) { d[j] = tr_desc(p, l, it + j * NW, it1, lane); tr_load(d[j], v[j]); }
#pragma unroll
        for (int j = 0; j < TR_NI; ++j) tr_finish(d[j], v[j], scr, lane);
    }
}
constexpr int NPAD_IN = 3072;
DI void ph_convert_small(const P& p, float* ldsf, int, int, int) {
    const int tid_ = ltid(), lane = tid_ & 63, gw = blockIdx.x * NWV + (tid_ >> 6), NW = gridDim.x * NWV;
    float* scr = ldsf + 14 * 1024 + (tid_ >> 6) * (64 * 33 + 16);
    constexpr int I_IN = 16 * 89, I_OUT = 16 * 32;
    for (int it = gw; it < 2 * (I_IN + I_OUT); it += NW) {
        const int l = it / (I_IN + I_OUT), r = it % (I_IN + I_OUT);
        if (r < I_IN) transpose_item<true>(p.w_in + (size_t)l * D * INDIM, D, INDIM, (bf16_t*)((unsigned char*)p.WinT + (size_t)l * NPAD_IN * D), scr, r, lane);
        else { const int kb = (r - I_IN) / 32;
            transpose_item(p.w_out + (size_t)l * D * D, D, D, p.WoutT + (size_t)l * D * D, scr, r - I_IN, lane, -1, kb < 8 ? p.ssd_norm_g + l * 512 : nullptr); }
    }
    for (int idx = blockIdx.x * NTHR + tid_; idx < 32 * 1024; idx += gridDim.x * NTHR) { const int e = idx >> 10, k = idx & 1023; p.WRT[idx] = f2bf(p.w_router[k * 32 + e]); }
    const size_t nz16 = (size_t)(NPAD_IN - INDIM) * D / 16;
    for (size_t i = (size_t)blockIdx.x * NTHR + tid_; i < 2 * nz16; i += (size_t)gridDim.x * NTHR) {
        const size_t l = i / nz16, j = i % nz16;
        ((uint4*)((unsigned char*)p.WinT + (l * NPAD_IN + INDIM) * D))[j] = make_uint4(0u, 0u, 0u, 0u);
    }
}

DI void row_normmod(float4 (&v)[4], const float* g, const float* mr, int shift_idx, int scale_idx, int lane) {
    float ss = 0.f;
#pragma unroll
    for (int i = 0; i < 4; ++i) ss += v[i].x * v[i].x + v[i].y * v[i].y + v[i].z * v[i].z + v[i].w * v[i].w;
    ss = wave_sum(ss, lane);
    const float rstd = rsqrtf(ss * (1.0f / D) + 1e-6f);
#pragma unroll
    for (int i = 0; i < 4; ++i) {
        const int c = (i * 64 + lane) * 4;
        const float4 gg = *(const float4*)(g + c), sh = *(const float4*)(mr + shift_idx * 1024 + c), sc = *(const float4*)(mr + scale_idx * 1024 + c);
        v[i].x = v[i].x * rstd * gg.x * (1.f + sc.x) + sh.x; v[i].y = v[i].y * rstd * gg.y * (1.f + sc.y) + sh.y;
        v[i].z = v[i].z * rstd * gg.z * (1.f + sc.z) + sh.z; v[i].w = v[i].w * rstd * gg.w * (1.f + sc.w) + sh.w;
    }
}
DI void row_store_bf16(bf16_t* hrow, float4 (&v)[4], int lane) {
#pragma unroll
    for (int i = 0; i < 4; ++i) { ushort4 o; o.x = f2bf(v[i].x); o.y = f2bf(v[i].y); o.z = f2bf(v[i].z); o.w = f2bf(v[i].w);
        *(ushort4*)(hrow + (i * 64 + lane) * 4) = o; v[i] = make_float4(bf2f(o.x), bf2f(o.y), bf2f(o.z), bf2f(o.w)); }
}

DI void ph_normmod1(const P& p, int l, int, int, int) {
    const int tid_ = ltid(), lane = tid_ & 63, gw = blockIdx.x * NWV + (tid_ >> 6), NW = gridDim.x * NWV;
    const float* MODl = p.MOD + (size_t)l * 9 * 6144;
    for (int t = gw; t < T; t += NW) {
        float4 v[4];
#pragma unroll
        for (int i = 0; i < 4; ++i) v[i] = ((const float4*)(t < TC ? p.ctx + (size_t)t * D : p.x + (size_t)(t - TC) * D))[i * 64 + lane];
        row_normmod(v, p.norm1_g + l * D, MODl + (size_t)tok_modrow(t) * 6144, 0, 1, lane);
#pragma unroll
        for (int i = 0; i < 4; ++i) *(unsigned*)((unsigned char*)p.H + (size_t)t * D + (i * 64 + lane) * 4) = pg8::pk4_fp8((pg8::f32x4){v[i].x, v[i].y, v[i].z, v[i].w});
    }
}

typedef short s16x4 __attribute__((ext_vector_type(4)));
typedef short bf16x8v __attribute__((ext_vector_type(8)));
typedef float f32x4v __attribute__((ext_vector_type(4)));
typedef unsigned u32x4v __attribute__((ext_vector_type(4)));
typedef unsigned u32x2v __attribute__((ext_vector_type(2)));
DI u32x4v mk4(unsigned a, unsigned b, unsigned c, unsigned d) { return (u32x4v){a, b, c, d}; }
DI u32x2v mk2(unsigned a, unsigned b) { return (u32x2v){a, b}; }
DI f32x4v mkf4(float a, float b, float c, float d) { return (f32x4v){a, b, c, d}; }
#define LDSP __attribute__((address_space(3)))
constexpr int NCH = 34, NTILE = NB * NCH;
constexpr int LD64 = 72, LD128 = 136;
constexpr float LOG2E = 1.4426950408889634f;

DI int tile_tok0(int tl) { const int b = tl / NCH, cs = tl - b * NCH; return cs < 2 ? b * CTXL + cs * 128 : TC + b * SEQ + (cs - 2) * 128; }
DI f32x4v mfma16(bf16x8v a, bf16x8v b, f32x4v c) { return __builtin_amdgcn_mfma_f32_16x16x32_bf16(a, b, c, 0, 0, 0); }
DI bf16x8v frag_row(LDSP const bf16_t* base, int ld, int r0, int k0, int lane) { return *(LDSP const bf16x8v*)(base + (r0 + (lane & 15)) * ld + k0 + 8 * (lane >> 4)); }
DI bf16x8v frag_row_g(const bf16_t* base, int ld, int r0, int k0, int lane) { return *(const bf16x8v*)(base + (size_t)(r0 + (lane & 15)) * ld + k0 + 8 * (lane >> 4)); }
DI bf16x8v frag_col(LDSP const bf16_t* base, int ld, int r0, int k0, int lane) {
    const int G = lane >> 4, i = lane & 15;
    LDSP const bf16_t* a = base + (k0 + 8 * G + (i >> 2)) * ld + r0 + 4 * (i & 3);
    const s16x4 lo = __builtin_bit_cast(s16x4, __builtin_amdgcn_ds_read_tr16_b64_v4i16((LDSP s16x4*)a));
    const s16x4 hi = __builtin_bit_cast(s16x4, __builtin_amdgcn_ds_read_tr16_b64_v4i16((LDSP s16x4*)(a + 4 * ld)));
    return (bf16x8v){lo[0], lo[1], lo[2], lo[3], hi[0], hi[1], hi[2], hi[3]};
}
DI u32x2v pack4(f32x4v v) { return mk2(pk2(v[0], v[1]), pk2(v[2], v[3])); }
DI void unpack8(u32x4v v, float* o) { o[0] = __uint_as_float(v.x << 16); o[1] = __uint_as_float(v.x & 0xffff0000u); o[2] = __uint_as_float(v.y << 16); o[3] = __uint_as_float(v.y & 0xffff0000u);
    o[4] = __uint_as_float(v.z << 16); o[5] = __uint_as_float(v.z & 0xffff0000u); o[6] = __uint_as_float(v.w << 16); o[7] = __uint_as_float(v.w & 0xffff0000u); }
DI u32x4v pack8(const float* o) { return mk4(pk2(o[0], o[1]), pk2(o[2], o[3]), pk2(o[4], o[5]), pk2(o[6], o[7])); }

DI float fast_logsigmoid(float x) { return -(fmaxf(-x, 0.f) + __logf(1.0f + __expf(-fabsf(x)))); }
DI float fast_softplus(float x) { return fmaxf(x, 0.f) + __logf(1.0f + __expf(-fabsf(x))); }
struct XbcSrc { const bf16_t* base; int ld; };
DI XbcSrc xbc_src(const P& p, int tok0) { XbcSrc r; r.base = p.XBCC + (size_t)tok0 * 768; r.ld = 768; return r; }

DI void prep_conv_item(const P& p, int l, int item, int lane) {
    int piece, ch;
    if (item < T / 32) { piece = item; ch = lane * 8; } else { piece = 2 * (item - T / 32) + (lane >> 5); ch = 512 + (lane & 31) * 8; }
    const int t0 = piece * 32; int lo, hi; bf16_t* dst; int dld;
    if (t0 < TC) { lo = t0 & ~(CTXL - 1); hi = lo + CTXL - 1; } else { lo = TC + ((t0 - TC) & ~63); hi = lo + 63; }
    dst = p.XBCC + ch; dld = 768;
    const bf16_t* src = p.PROJ + OFF_XBC + ch;
    float wgt[5][8], bias[8];
#pragma unroll
    for (int k = 0; k < 5; ++k) { const f32x4v a = *(const f32x4v*)(p.conv_w + l * 5 * 768 + k * 768 + ch), c = *(const f32x4v*)(p.conv_w + l * 5 * 768 + k * 768 + ch + 4);
#pragma unroll
        for (int j = 0; j < 4; ++j) { wgt[k][j] = a[j]; wgt[k][4 + j] = c[j]; } }
    { const f32x4v a = *(const f32x4v*)(p.conv_b + l * 768 + ch), c = *(const f32x4v*)(p.conv_b + l * 768 + ch + 4);
#pragma unroll
      for (int j = 0; j < 4; ++j) { bias[j] = a[j]; bias[4 + j] = c[j]; } }
    const u32x4v zero4 = mk4(0u, 0u, 0u, 0u);
    u32x4v rw[13];
#pragma unroll
    for (int i = 0; i < 5; ++i) { const int tt = t0 - 2 + i; rw[i] = (tt >= lo && tt <= hi) ? *(const u32x4v*)(src + (size_t)tt * LDP) : zero4; }
    for (int s0 = 0; s0 < 32; s0 += 8) {
        const int t = t0 + s0;
#pragma unroll
        for (int i = 0; i < 8; ++i) { const int tt = t + 3 + i; rw[5 + i] = (tt <= hi) ? *(const u32x4v*)(src + (size_t)tt * LDP) : zero4; }
#pragma unroll
        for (int i = 0; i < 8; ++i) {
            float o[8];
#pragma unroll
            for (int c = 0; c < 8; ++c) o[c] = bias[c];
#pragma unroll
            for (int k = 0; k < 5; ++k) { float v[8]; unpack8(rw[i + k], v);
#pragma unroll
                for (int c = 0; c < 8; ++c) o[c] += wgt[k][c] * v[c]; }
#pragma unroll
            for (int c = 0; c < 8; ++c) o[c] = siluf(o[c]);
            *(u32x4v*)(dst + (size_t)(t + i) * dld) = pack8(o);
        }
#pragma unroll
        for (int i = 0; i < 5; ++i) rw[i] = rw[i + 8];
    }
}
DI void prep_ssd_item(const P& p, int l, int item, int lane) {
    const int tl = item >> 3, h = item & 7, tok0 = tile_tok0(tl);
    const float bsf = p.dt_bias_f[l * 8 + h], bsb = p.dt_bias_b[l * 8 + h];
    const float r0 = bf2f(p.PROJ[(size_t)(tok0 + 2 * lane) * LDP + OFF_DT + h]), r1 = bf2f(p.PROJ[(size_t)(tok0 + 2 * lane + 1) * LDP + OFF_DT + h]);
    const float f0 = fast_softplus(r0 + bsf), f1 = fast_softplus(r1 + bsf), b0 = fast_softplus(r0 + bsb), b1 = fast_softplus(r1 + bsb);
    float pf = f0 + f1, sb = b0 + b1;
#pragma unroll
    for (int o = 1; o < 64; o <<= 1) { const float t = shl(pf, lane >= o ? lane - o : lane); if (lane >= o) pf += t; }
#pragma unroll
    for (int o = 1; o < 64; o <<= 1) { const float t = shl(sb, lane + o < 64 ? lane + o : lane); if (lane + o < 64) sb += t; }
    const float Af = -__expf(p.a_log_f[l * 8 + h]) * LOG2E, Ab = -__expf(p.a_log_b[l * 8 + h]) * LOG2E;
    const float af0 = Af * (pf - f1), af1 = Af * pf, ab0 = Ab * sb, ab1 = Ab * (sb - b0);
    f32x4v* dst = (f32x4v*)p.SSC + (size_t)(tok0 + 2 * lane) * 8 + h;
    dst[0] = mkf4(af0, af0 - __log2f(f0), ab0, ab0 - __log2f(b0));
    dst[8] = mkf4(af1, af1 - __log2f(f1), ab1, ab1 - __log2f(b1));
    if (lane == 63) { p.STOT[(tl * 8 + h) * 2 + 0] = af1; p.SDEC[(tl * 8 + h) * 2 + 0] = __builtin_amdgcn_exp2f(af1); }
    if (lane == 0) { p.STOT[(tl * 8 + h) * 2 + 1] = ab0; p.SDEC[(tl * 8 + h) * 2 + 1] = __builtin_amdgcn_exp2f(ab0); }
}
template <int CTRL> DI float dppz(float x) { return __builtin_bit_cast(float, __builtin_amdgcn_update_dpp(0, __builtin_bit_cast(int, x), CTRL, 0xf, 0xf, true)); }
DI float row_total(float s) { s += dppz<0xB1>(s); s += dppz<0x4E>(s); s += dppz<0x141>(s); s += dppz<0x140>(s); return s; }
struct GlaPL { u32x4v qv_[2], kv_[2], vv_[4]; bf16x8v gkf[8]; float uw[8]; f32x4v bias; };
DI void prep_gla_load(const P& p, int l, int it, GlaPL& L) {
    const int tl = it >> 2, h = it & 3;
    const int tid = ltid(), lane = tid & 63, w = __builtin_amdgcn_readfirstlane(tid >> 6), kt = w & 3, dir = w >> 2, G = lane >> 4, c = lane & 15, tok0 = tile_tok0(tl);
#pragma unroll
    for (int nt = 0; nt < 8; ++nt) L.gkf[nt] = *(const bf16x8v*)(p.PROJ + (size_t)(tok0 + 16 * nt + c) * LDP + OFF_GK + (G & 1) * 8);
    { const float* up = (dir ? p.gk_up_b : p.gk_up_f) + l * 16 * 256 + (G & 1) * 8 * 256 + h * 64 + 16 * kt + c;
#pragma unroll
      for (int e = 0; e < 8; ++e) L.uw[e] = up[e * 256]; }
    L.bias = *(const f32x4v*)((dir ? p.gk_bias_b : p.gk_bias_f) + l * 256 + h * 64 + 16 * kt + 4 * G);
#pragma unroll
    for (int q = 0; q < 4; ++q) { const int cc_ = tid + q * NTHR, r = cc_ >> 4, cc = cc_ & 15; L.vv_[q] = *(const u32x4v*)(p.PROJ + (size_t)(tok0 + r) * LDP + OFF_V + h * 128 + cc * 8); }
#pragma unroll
    for (int q = 0; q < 2; ++q) { const int cc_ = tid + q * NTHR, r = cc_ >> 3, cc = cc_ & 7; const bf16_t* pr = p.PROJ + (size_t)(tok0 + r) * LDP;
        L.qv_[q] = *(const u32x4v*)(pr + OFF_Q + h * 64 + cc * 8); L.kv_[q] = *(const u32x4v*)(pr + OFF_K + h * 64 + cc * 8); }
}
DI void prep_gla_block(const P& p, int l, int it, int it_next, GlaPL& L, LDSP unsigned char* lds) {
    const int tl = it >> 2, h = it & 3;
    const int tid = ltid(), lane = tid & 63, w = __builtin_amdgcn_readfirstlane(tid >> 6), kt = w & 3, dir = w >> 2, G = lane >> 4, c = lane & 15, tok0 = tile_tok0(tl);
    LDSP bf16_t* QT = (LDSP bf16_t*)lds; LDSP bf16_t* KT = QT + 128 * LD64; LDSP bf16_t* O4 = KT + 128 * LD64; LDSP bf16_t* VT = O4 + 4 * 128 * LD64; LDSP float* DEC = (LDSP float*)(VT + 128 * LD128);
    f32x4v g[8];
    { bf16x8v af;
#pragma unroll
      for (int e = 0; e < 8; ++e) { const bf16_t hi = f2bf(L.uw[e]); const bf16_t lo = f2bf(L.uw[e] - bf2f(hi)); af[e] = (short)(G < 2 ? hi : lo); }
#pragma unroll
      for (int nt = 0; nt < 8; ++nt) g[nt] = mfma16(af, L.gkf[nt], (f32x4v){0.f, 0.f, 0.f, 0.f}); }
#pragma unroll
    for (int nt = 0; nt < 8; ++nt)
#pragma unroll
        for (int r = 0; r < 4; ++r) { const float x = (g[nt][r] + L.bias[r]) * LOG2E;
            g[nt][r] = -(fmaxf(-x, 0.f) + __log2f(1.0f + __builtin_amdgcn_exp2f(-fabsf(x)))) * (1.0f / 16.0f); }
    f32x4v tot = (f32x4v){0.f, 0.f, 0.f, 0.f};
    if (dir == 0) {
#pragma unroll
        for (int nt = 0; nt < 8; ++nt)
#pragma unroll
            for (int r = 0; r < 4; ++r) { const float s = row_total(g[nt][r]); float x = g[nt][r];
                x += dppz<0x111>(x); x += dppz<0x112>(x); x += dppz<0x114>(x); x += dppz<0x118>(x);
                g[nt][r] = tot[r] + x; tot[r] += s; }
    } else {
#pragma unroll
        for (int nt = 7; nt >= 0; --nt)
#pragma unroll
            for (int r = 0; r < 4; ++r) { const float s = row_total(g[nt][r]); float x = g[nt][r];
                x += dppz<0x101>(x); x += dppz<0x102>(x); x += dppz<0x104>(x); x += dppz<0x108>(x);
                g[nt][r] = tot[r] + x; tot[r] += s; }
    }
    __syncthreads();
#pragma unroll
    for (int q = 0; q < 2; ++q) { const int cc_ = tid + q * NTHR, r = cc_ >> 3, cc = cc_ & 7; *(LDSP u32x4v*)(QT + r * LD64 + cc * 8) = L.qv_[q]; *(LDSP u32x4v*)(KT + r * LD64 + cc * 8) = L.kv_[q]; }
#pragma unroll
    for (int q = 0; q < 4; ++q) { const int cc_ = tid + q * NTHR, r = cc_ >> 4, cc = cc_ & 15; *(LDSP u32x4v*)(VT + r * LD128 + cc * 8) = L.vv_[q]; }
    __syncthreads();
    { LDSP bf16_t* OQ = O4 + (2 * dir) * 128 * LD64; LDSP bf16_t* OK = OQ + 128 * LD64;
#pragma unroll
      for (int nt = 0; nt < 8; ++nt) { const int o = (16 * nt + c) * LD64 + 16 * kt + 4 * G;
          const u32x2v q2 = *(LDSP const u32x2v*)(QT + o), k2 = *(LDSP const u32x2v*)(KT + o);
          float eq[4], ek[4];
#pragma unroll
          for (int r = 0; r < 4; ++r) { eq[r] = __builtin_amdgcn_exp2f(g[nt][r] - 3.0f); ek[r] = __builtin_amdgcn_exp2f(-g[nt][r]); }
          *(LDSP u32x2v*)(OQ + o) = mk2(pk2(__uint_as_float(q2.x << 16) * eq[0], __uint_as_float(q2.x & 0xffff0000u) * eq[1]), pk2(__uint_as_float(q2.y << 16) * eq[2], __uint_as_float(q2.y & 0xffff0000u) * eq[3]));
          *(LDSP u32x2v*)(OK + o) = mk2(pk2(__uint_as_float(k2.x << 16) * ek[0], __uint_as_float(k2.x & 0xffff0000u) * ek[1]), pk2(__uint_as_float(k2.y << 16) * ek[2], __uint_as_float(k2.y & 0xffff0000u) * ek[3])); }
      if (c == 0) { const f32x4v d = mkf4(__builtin_amdgcn_exp2f(tot[0]), __builtin_amdgcn_exp2f(tot[1]), __builtin_amdgcn_exp2f(tot[2]), __builtin_amdgcn_exp2f(tot[3]));
          *(f32x4v*)(p.GDEC + (size_t)((tl * 4 + h) * 2 + dir) * 64 + 16 * kt + 4 * G) = d; *(LDSP f32x4v*)(DEC + dir * 64 + 16 * kt + 4 * G) = d; } }
    __syncthreads();
    if (it_next >= 0) prep_gla_load(p, l, it_next, L);
#pragma unroll
    for (int q = 0; q < 8; ++q) { const int cc_ = tid + q * NTHR, a4 = cc_ >> 10, r = (cc_ >> 3) & 127, cc = cc_ & 7;
        *(u32x4v*)(p.QKB + (size_t)(tok0 + r) * 1024 + a4 * 256 + h * 64 + cc * 8) = *(LDSP const u32x4v*)(O4 + (a4 * 128 + r) * LD64 + cc * 8); }
    { const int ut = kt; LDSP const bf16_t* KE = O4 + (dir ? 3 : 1) * 128 * LD64;
      f32x4v acc[8];
#pragma unroll
      for (int q = 0; q < 8; ++q) acc[q] = (f32x4v){0.f, 0.f, 0.f, 0.f};
#pragma unroll
      for (int ks = 0; ks < 4; ++ks) { const bf16x8v u = frag_col(KE, LD64, 16 * ut, 32 * ks, lane);
#pragma unroll
          for (int q = 0; q < 8; ++q) acc[q] = mfma16(u, frag_col(VT, LD128, 16 * q, 32 * ks, lane), acc[q]); }
      const f32x4v dec = *(LDSP const f32x4v*)(DEC + dir * 64 + 16 * ut + 4 * (lane >> 4));
      bf16_t* dst = p.GS + ((size_t)((tl * 4 + h) * 2 + dir) * 128) * 64;
#pragma unroll
      for (int q = 0; q < 8; ++q) *(u32x2v*)(dst + (size_t)(16 * q + (lane & 15)) * 64 + 16 * ut + 4 * (lane >> 4)) = pack4(acc[q] * dec); }
}
constexpr int NPREP_A = T / 32 + T / 64, NPREP_B = NTILE * 8;
DI void ph_prep(const P& p, int l, LDSP unsigned char* lds) {
    const int tid_ = ltid(), lane = tid_ & 63, gw = blockIdx.x * NWV + (tid_ >> 6), NW = gridDim.x * NWV;
    for (int it = gw; it < NPREP_A + NPREP_B; it += NW) {
        if (it < NPREP_A) prep_conv_item(p, l, it, lane); else prep_ssd_item(p, l, it - NPREP_A, lane);
    }
    { const int G_ = gridDim.x; int it = G_ - 1 - (int)blockIdx.x;
      GlaPL L; if (it < NTILE * 4) prep_gla_load(p, l, it, L);
      for (; it < NTILE * 4; it += G_) prep_gla_block(p, l, it, it + G_ < NTILE * 4 ? it + G_ : -1, L, lds); }
}

DI void s1_ssd(const P& p, int tl, int h, LDSP unsigned char* lds) {
    const int tid = ltid(), lane = tid & 63, w = __builtin_amdgcn_readfirstlane(tid >> 6);
    const int tok0 = tile_tok0(tl), g = h >> 2; const XbcSrc xs = xbc_src(p, tok0);
    LDSP bf16_t* XWF = (LDSP bf16_t*)lds; LDSP bf16_t* XWB = XWF + 128 * LD64; LDSP bf16_t* BG = XWB + 128 * LD64;
    const int j = tid >> 2, cq = tid & 3;
    const bf16_t* row = xs.base + (size_t)j * xs.ld;
    const u32x4v x0 = *(const u32x4v*)(row + h * 64 + cq * 16), x1 = *(const u32x4v*)(row + h * 64 + cq * 16 + 8);
    const u32x4v b0 = *(const u32x4v*)(row + 512 + g * 64 + cq * 16), b1 = *(const u32x4v*)(row + 512 + g * 64 + cq * 16 + 8);
    const f32x4v sc = *((const f32x4v*)p.SSC + (size_t)(tok0 + j) * 8 + h);
    const float wf = __builtin_amdgcn_exp2f(p.STOT[(tl * 8 + h) * 2 + 0] - sc.y), wb = __builtin_amdgcn_exp2f(p.STOT[(tl * 8 + h) * 2 + 1] - sc.w);
    float xv[16], of[16], ob[16]; unpack8(x0, xv); unpack8(x1, xv + 8);
#pragma unroll
    for (int c = 0; c < 16; ++c) { of[c] = xv[c] * wf; ob[c] = xv[c] * wb; }
    __syncthreads();
    *(LDSP u32x4v*)(XWF + j * LD64 + cq * 16) = pack8(of); *(LDSP u32x4v*)(XWF + j * LD64 + cq * 16 + 8) = pack8(of + 8);
    *(LDSP u32x4v*)(XWB + j * LD64 + cq * 16) = pack8(ob); *(LDSP u32x4v*)(XWB + j * LD64 + cq * 16 + 8) = pack8(ob + 8);
    *(LDSP u32x4v*)(BG + j * LD64 + cq * 16) = b0; *(LDSP u32x4v*)(BG + j * LD64 + cq * 16 + 8) = b1;
    __syncthreads();
    const int dir = w >> 2, ut = w & 3; LDSP const bf16_t* XW = dir ? XWB : XWF;
    f32x4v acc[4];
#pragma unroll
    for (int q = 0; q < 4; ++q) acc[q] = (f32x4v){0.f, 0.f, 0.f, 0.f};
#pragma unroll
    for (int ks = 0; ks < 4; ++ks) { const bf16x8v u = frag_col(BG, LD64, 16 * ut, 32 * ks, lane);
#pragma unroll
        for (int q = 0; q < 4; ++q) acc[q] = mfma16(u, frag_col(XW, LD64, 16 * q, 32 * ks, lane), acc[q]); }
    bf16_t* dst = p.SS + ((size_t)((tl * 8 + h) * 2 + dir) * 64) * 64;
#pragma unroll
    for (int q = 0; q < 4; ++q) *(u32x2v*)(dst + (size_t)(16 * q + (lane & 15)) * 64 + 16 * ut + 4 * (lane >> 4)) = pack4(acc[q]);
}
DI void ph_s1(const P& p, int l, LDSP unsigned char* lds) {
    for (int it = blockIdx.x; it < NTILE * 8; it += gridDim.x) s1_ssd(p, it >> 3, it & 7, lds);
}

DI int s2_chunk(int dir, int s) { return dir == 0 ? s : (s < 2 ? 1 - s : 35 - s); }
DI void ph_s2(const P& p) {
    const int g = blockIdx.x * NTHR + ltid();
    for (int v = g; v < 131072; v += gridDim.x * NTHR) {
        const bool gla = v >= 65536; const int r = v & 65535;
        int b, h, dir, vi;
        if (!gla) { vi = r & 511; dir = (r >> 9) & 1; h = (r >> 10) & 7; b = r >> 13; } else { vi = r & 1023; dir = (r >> 10) & 1; h = (r >> 11) & 3; b = r >> 13; }
        float st[8];
#pragma unroll
        for (int e = 0; e < 8; ++e) st[e] = 0.f;
        for (int s0 = 0; s0 < NCH; s0 += 6) {
            u32x4v sv[6]; float dsc[6]; f32x4v dv0[6], dv1[6];
#pragma unroll
            for (int u = 0; u < 6; ++u) { if (s0 + u >= NCH) continue; const int tl = b * NCH + s2_chunk(dir, s0 + u);
                if (!gla) { sv[u] = *(const u32x4v*)(p.SS + ((size_t)((tl * 8 + h) * 2 + dir) * 512 + vi) * 8); dsc[u] = p.SDEC[(tl * 8 + h) * 2 + dir]; }
                else { sv[u] = *(const u32x4v*)(p.GS + ((size_t)((tl * 4 + h) * 2 + dir) * 1024 + vi) * 8); const f32x4v* d = (const f32x4v*)(p.GDEC + (size_t)((tl * 4 + h) * 2 + dir) * 64 + (vi & 7) * 8); dv0[u] = d[0]; dv1[u] = d[1]; } }
#pragma unroll
            for (int u = 0; u < 6; ++u) { if (s0 + u >= NCH) continue; const int tl = b * NCH + s2_chunk(dir, s0 + u);
                float loc[8]; unpack8(sv[u], loc);
                const u32x4v hin = pack8(st);
                if (!gla) { *(u32x4v*)(p.SS + ((size_t)((tl * 8 + h) * 2 + dir) * 512 + vi) * 8) = hin;
#pragma unroll
                    for (int e = 0; e < 8; ++e) st[e] = dsc[u] * st[e] + loc[e]; }
                else { *(u32x4v*)(p.GS + ((size_t)((tl * 4 + h) * 2 + dir) * 1024 + vi) * 8) = hin;
                    const float dd[8] = {dv0[u].x, dv0[u].y, dv0[u].z, dv0[u].w, dv1[u].x, dv1[u].y, dv1[u].z, dv1[u].w};
#pragma unroll
                    for (int e = 0; e < 8; ++e) st[e] = dd[e] * st[e] + loc[e]; } }
        }
    }
}

DI int s3_tile(int l, int q) { return l == 0 ? q : (q >> 5) * NCH + 2 + (q & 31); }
struct SsdPre { u32x4v x0, x1, b0, b1, c0, c1, hf, hb; f32x4v sc; };
DI void s3_ssd_load(const P& p, int tl, int h, int tid, int i, int G, SsdPre& r) {
    const int tok0 = tile_tok0(tl), g = h >> 2; const XbcSrc xs = xbc_src(p, tok0);
    const int j = tid >> 2, cq = tid & 3; const bf16_t* row = xs.base + (size_t)j * xs.ld;
    r.x0 = *(const u32x4v*)(row + h * 64 + cq * 16); r.x1 = *(const u32x4v*)(row + h * 64 + cq * 16 + 8);
    r.b0 = *(const u32x4v*)(row + 512 + g * 64 + cq * 16); r.b1 = *(const u32x4v*)(row + 512 + g * 64 + cq * 16 + 8);
    r.c0 = *(const u32x4v*)(row + 640 + g * 64 + cq * 16); r.c1 = *(const u32x4v*)(row + 640 + g * 64 + cq * 16 + 8);
    const bf16_t* Hf = p.SS + (size_t)((tl * 8 + h) * 2 + 0) * 4096 + (tid >> 3) * 64 + (tid & 7) * 8;
    r.hf = *(const u32x4v*)Hf; r.hb = *(const u32x4v*)(Hf + 4096);
    r.sc = *((const f32x4v*)p.SSC + (size_t)(tok0 + (tid & 127)) * 8 + h);
}
DI void ph_s3_ssd(const P& p, int l, LDSP unsigned char* lds) {
    const int tid = ltid(), lane = tid & 63, w = __builtin_amdgcn_readfirstlane(tid >> 6), G = lane >> 4, li = lane & 15, i = 16 * w + li;
    LDSP bf16_t* XH = (LDSP bf16_t*)lds; LDSP bf16_t* BG = XH + 128 * LD64; LDSP bf16_t* CG = BG + 128 * LD64; LDSP bf16_t* MM = CG + 128 * LD64; LDSP f32x4v* SC = (LDSP f32x4v*)(MM + 128 * LD128);
    LDSP bf16_t* HF = (LDSP bf16_t*)(SC + 128); LDSP bf16_t* HB = HF + 64 * LD64;
    const int nit = (l == 0 ? NTILE : NB * 32) * 8, GS_ = gridDim.x;
    int it = ((int)blockIdx.x + (GS_ >> 1)) % GS_; SsdPre pre;
    if (it < nit) s3_ssd_load(p, s3_tile(l, it >> 3), it & 7, tid, i, G, pre);
    for (; it < nit; it += GS_) {
        const int tl = s3_tile(l, it >> 3), h = it & 7, tok0 = tile_tok0(tl);
        __syncthreads();
        { const int j = tid >> 2, cq = tid & 3;
          *(LDSP u32x4v*)(XH + j * LD64 + cq * 16) = pre.x0; *(LDSP u32x4v*)(XH + j * LD64 + cq * 16 + 8) = pre.x1;
          *(LDSP u32x4v*)(BG + j * LD64 + cq * 16) = pre.b0; *(LDSP u32x4v*)(BG + j * LD64 + cq * 16 + 8) = pre.b1;
          *(LDSP u32x4v*)(CG + j * LD64 + cq * 16) = pre.c0; *(LDSP u32x4v*)(CG + j * LD64 + cq * 16 + 8) = pre.c1;
          *(LDSP u32x4v*)(HF + (tid >> 3) * LD64 + (tid & 7) * 8) = pre.hf; *(LDSP u32x4v*)(HB + (tid >> 3) * LD64 + (tid & 7) * 8) = pre.hb;
          if (tid < 128) SC[tid] = pre.sc; }
        if (it + GS_ < nit) s3_ssd_load(p, s3_tile(l, (it + GS_) >> 3), (it + GS_) & 7, tid, i, G, pre);
        __syncthreads();
        u32x2v zr[4];
#pragma unroll
        for (int pt = 0; pt < 4; ++pt) zr[pt] = *(const u32x2v*)(p.PROJ + (size_t)(tok0 + i) * LDP + OFF_Z + h * 64 + 16 * pt + 4 * G);
        const f32x4v sci = SC[i];
        {
            f32x4v am[8];
#pragma unroll
            for (int ut = 0; ut < 8; ++ut) am[ut] = (f32x4v){0.f, 0.f, 0.f, 0.f};
#pragma unroll
            for (int ks = 0; ks < 2; ++ks) { const bf16x8v vfr = frag_row(CG, LD64, 16 * w, 32 * ks, lane);
#pragma unroll
                for (int ut = 0; ut < 8; ++ut) am[ut] = mfma16(frag_row(BG, LD64, 16 * ut, 32 * ks, lane), vfr, am[ut]); }
#pragma unroll
            for (int ut = 0; ut < 8; ++ut) { f32x4v m;
#pragma unroll
                for (int r = 0; r < 4; ++r) { const int jj = 16 * ut + 4 * G + r; const f32x4v scj = SC[jj];
                    const float Lf = jj <= i ? __builtin_amdgcn_exp2f(fminf(sci.x - scj.y, 30.f)) : 0.f, Lb = jj >= i ? __builtin_amdgcn_exp2f(fminf(sci.z - scj.w, 30.f)) : 0.f;
                    m[r] = am[ut][r] * (Lf + Lb); }
                *(LDSP u32x2v*)(MM + i * LD128 + 16 * ut + 4 * G) = pack4(m); }
        }
        asm volatile("s_waitcnt lgkmcnt(0)" ::: "memory");
        f32x4v ay[4], af_[4], ab_[4];
#pragma unroll
        for (int pt = 0; pt < 4; ++pt) { ay[pt] = (f32x4v){0.f, 0.f, 0.f, 0.f}; af_[pt] = ay[pt]; ab_[pt] = ay[pt]; }
#pragma unroll
        for (int ks = 0; ks < 2; ++ks) { const bf16x8v vfr = frag_row(CG, LD64, 16 * w, 32 * ks, lane);
#pragma unroll
            for (int pt = 0; pt < 4; ++pt) { af_[pt] = mfma16(frag_row(HF, LD64, 16 * pt, 32 * ks, lane), vfr, af_[pt]); ab_[pt] = mfma16(frag_row(HB, LD64, 16 * pt, 32 * ks, lane), vfr, ab_[pt]); } }
#pragma unroll
        for (int ks = 0; ks < 4; ++ks) { const bf16x8v vfr = frag_row(MM, LD128, 16 * w, 32 * ks, lane);
#pragma unroll
            for (int pt = 0; pt < 4; ++pt) ay[pt] = mfma16(frag_col(XH, LD64, 16 * pt, 32 * ks, lane), vfr, ay[pt]); }
        const float sf = __builtin_amdgcn_exp2f(sci.x), sb = __builtin_amdgcn_exp2f(sci.z), dsk = p.d_skip[l * 8 + h];
        float ssq = 0.f;
#pragma unroll
        for (int pt = 0; pt < 4; ++pt) { const int pc = 16 * pt + 4 * G;
            const u32x2v xr = *(LDSP const u32x2v*)(XH + i * LD64 + pc);
            const float xv[4] = {__uint_as_float(xr.x << 16), __uint_as_float(xr.x & 0xffff0000u), __uint_as_float(xr.y << 16), __uint_as_float(xr.y & 0xffff0000u)};
            const float zv[4] = {__uint_as_float(zr[pt].x << 16), __uint_as_float(zr[pt].x & 0xffff0000u), __uint_as_float(zr[pt].y << 16), __uint_as_float(zr[pt].y & 0xffff0000u)};
            float yv[4];
#pragma unroll
            for (int r = 0; r < 4; ++r) { yv[r] = (ay[pt][r] + sf * af_[pt][r] + sb * ab_[pt][r] + dsk * xv[r]) * siluf(zv[r]); yv[r] = bf2f(f2bf(yv[r])); ssq += yv[r] * yv[r]; }
            *(u32x2v*)(p.H + (size_t)(tok0 + i) * D + h * 64 + pc) = mk2(pk2(yv[0], yv[1]), pk2(yv[2], yv[3])); }
        ssq += shx(ssq, 16, lane); ssq += shx(ssq, 32, lane);
        if (G == 0) p.SSQ[(size_t)(tok0 + i) * 8 + h] = ssq;
    }
}
struct GlaPre { u32x4v qk[2][4], vv[4], sf[2], sb[2]; };
DI void s3_gla_load(const P& p, int tl, int h, int tid, int i, int G, GlaPre& r) {
    const int tok0 = tile_tok0(tl);
#pragma unroll
    for (int q = 0; q < 2; ++q) { const int c = tid + q * NTHR, rr = c >> 3, cc = c & 7; const bf16_t* qb = p.QKB + (size_t)(tok0 + rr) * 1024 + h * 64 + cc * 8;
        r.qk[q][0] = *(const u32x4v*)qb; r.qk[q][1] = *(const u32x4v*)(qb + 256);
        r.qk[q][2] = *(const u32x4v*)(qb + 512); r.qk[q][3] = *(const u32x4v*)(qb + 768);
        const bf16_t* Sg = p.GS + (size_t)((tl * 4 + h) * 2 + 0) * 8192 + (size_t)rr * 64 + cc * 8; r.sf[q] = *(const u32x4v*)Sg; r.sb[q] = *(const u32x4v*)(Sg + 8192); }
#pragma unroll
    for (int q = 0; q < 4; ++q) { const int c = tid + q * NTHR, rr = c >> 4, cc = c & 15; r.vv[q] = *(const u32x4v*)(p.PROJ + (size_t)(tok0 + rr) * LDP + OFF_V + h * 128 + cc * 8); }
}
DI void ph_s3_gla(const P& p, int l, LDSP unsigned char* lds) {
    const int tid = ltid(), lane = tid & 63, w = __builtin_amdgcn_readfirstlane(tid >> 6), G = lane >> 4, li = lane & 15, i = 16 * w + li;
    LDSP bf16_t* Q2 = (LDSP bf16_t*)lds;
    LDSP bf16_t* KF = Q2 + 8 * 2 * 16 * LD64; LDSP bf16_t* KB = KF + 128 * LD64; LDSP bf16_t* VT = KB + 128 * LD64; LDSP bf16_t* SF = VT + 128 * LD128; LDSP bf16_t* SB = SF + 128 * LD64;
    LDSP bf16_t* AMw = SF + w * 16 * LD128;
    const int nit = (l == 0 ? NTILE : NB * 32) * 4, GS_ = gridDim.x;
    int it = blockIdx.x; GlaPre pre;
    if (it < nit) s3_gla_load(p, s3_tile(l, it >> 2), it & 3, tid, i, G, pre);
    for (; it < nit; it += GS_) {
        const int tl = s3_tile(l, it >> 2), h = it & 3, tok0 = tile_tok0(tl);
        __syncthreads();
#pragma unroll
        for (int q = 0; q < 2; ++q) { const int c = tid + q * NTHR, rr = c >> 3, cc = c & 7; LDSP bf16_t* qrow = Q2 + (rr >> 4) * (2 * 16 * LD64) + (rr & 15) * LD64 + cc * 8;
            *(LDSP u32x4v*)qrow = pre.qk[q][0]; *(LDSP u32x4v*)(qrow + 16 * LD64) = pre.qk[q][2];
            *(LDSP u32x4v*)(KF + rr * LD64 + cc * 8) = pre.qk[q][1]; *(LDSP u32x4v*)(KB + rr * LD64 + cc * 8) = pre.qk[q][3];
            *(LDSP u32x4v*)(SF + rr * LD64 + cc * 8) = pre.sf[q]; *(LDSP u32x4v*)(SB + rr * LD64 + cc * 8) = pre.sb[q]; }
#pragma unroll
        for (int q = 0; q < 4; ++q) { const int c = tid + q * NTHR, rr = c >> 4, cc = c & 15; *(LDSP u32x4v*)(VT + rr * LD128 + cc * 8) = pre.vv[q]; }
        if (it + GS_ < nit) s3_gla_load(p, s3_tile(l, (it + GS_) >> 2), (it + GS_) & 3, tid, i, G, pre);
        __syncthreads();
        f32x4v ao[8];
#pragma unroll
        for (int q = 0; q < 8; ++q) ao[q] = (f32x4v){0.f, 0.f, 0.f, 0.f};
        bf16x8v qfr[2][2];
#pragma unroll
        for (int dir = 0; dir < 2; ++dir)
#pragma unroll
            for (int ks = 0; ks < 2; ++ks) qfr[dir][ks] = frag_row(Q2 + w * (2 * 16 * LD64) + dir * 16 * LD64, LD64, 0, 32 * ks, lane);
#pragma unroll
        for (int dir = 0; dir < 2; ++dir) {
            LDSP const bf16_t* SS_ = dir ? SB : SF;
#pragma unroll
            for (int ks = 0; ks < 2; ++ks) {
#pragma unroll
                for (int vt = 0; vt < 8; ++vt) ao[vt] = mfma16(frag_row(SS_, LD64, 16 * vt, 32 * ks, lane), qfr[dir][ks], ao[vt]); }
        }
        __syncthreads();
#pragma unroll
        for (int uh = 0; uh < 4; ++uh) {
            f32x4v a2[2]; a2[0] = (f32x4v){0.f, 0.f, 0.f, 0.f}; a2[1] = a2[0];
#pragma unroll
            for (int dir = 0; dir < 2; ++dir) {
                LDSP const bf16_t* KS = dir ? KB : KF;
                f32x4v as[2]; as[0] = (f32x4v){0.f, 0.f, 0.f, 0.f}; as[1] = as[0];
#pragma unroll
                for (int ks = 0; ks < 2; ++ks) {
#pragma unroll
                    for (int q = 0; q < 2; ++q) as[q] = mfma16(frag_row(KS, LD64, 16 * (2 * uh + q), 32 * ks, lane), qfr[dir][ks], as[q]); }
#pragma unroll
                for (int q = 0; q < 2; ++q)
#pragma unroll
                    for (int r = 0; r < 4; ++r) { const int jj = 16 * (2 * uh + q) + 4 * G + r; const bool keep = dir == 0 ? (jj <= i) : (jj >= i); a2[q][r] += keep ? as[q][r] : 0.f; }
            }
#pragma unroll
            for (int q = 0; q < 2; ++q) *(LDSP u32x2v*)(AMw + li * LD128 + 16 * (2 * uh + q) + 4 * G) = pack4(a2[q]);
        }
        u32x2v gr[8];
#pragma unroll
        for (int vt = 0; vt < 8; ++vt) gr[vt] = *(const u32x2v*)(p.PROJ + (size_t)(tok0 + i) * LDP + OFF_GO + h * 128 + 16 * vt + 4 * G);
        asm volatile("s_waitcnt lgkmcnt(0)" ::: "memory");
#pragma unroll
        for (int ks = 0; ks < 4; ++ks) { const bf16x8v vfr = frag_row(AMw, LD128, 0, 32 * ks, lane);
#pragma unroll
            for (int vt = 0; vt < 8; ++vt) ao[vt] = mfma16(frag_col(VT, LD128, 16 * vt, 32 * ks, lane), vfr, ao[vt]); }
        float so = 0.f;
#pragma unroll
        for (int vt = 0; vt < 8; ++vt)
#pragma unroll
            for (int r = 0; r < 4; ++r) so += ao[vt][r] * ao[vt][r];
        so += shx(so, 16, lane); so += shx(so, 32, lane);
        const float ro = rsqrtf(so * (1.0f / 128.0f) + 1e-6f);
#pragma unroll
        for (int vt = 0; vt < 8; ++vt) { const int vc = 16 * vt + 4 * G; const f32x4v gg = *(const f32x4v*)(p.gla_norm_g + l * 128 + vc);
            const float g0 = __uint_as_float(gr[vt].x << 16), g1 = __uint_as_float(gr[vt].x & 0xffff0000u), g2 = __uint_as_float(gr[vt].y << 16), g3 = __uint_as_float(gr[vt].y & 0xffff0000u);
            *(u32x2v*)(p.H + (size_t)(tok0 + i) * D + 512 + h * 128 + vc) = mk2(pk2(ao[vt][0] * ro * gg.x * siluf(g0), ao[vt][1] * ro * gg.y * siluf(g1)), pk2(ao[vt][2] * ro * gg.z * siluf(g2), ao[vt][3] * ro * gg.w * siluf(g3))); }
    }
}
DI void ph_s3(const P& p, int l, LDSP unsigned char* lds) { ph_s3_gla(p, l, lds); ph_s3_ssd(p, l, lds); }
DI void ph_normroute(const P& p, int l, int t0, LDSP unsigned char* lds) {
    const int tid_ = ltid(), lane = tid_ & 63, wv = tid_ >> 6, gw = blockIdx.x * NWV + wv, NW = gridDim.x * NWV, G = lane >> 4, li = lane & 15;
    const float* MODl = p.MOD + (size_t)l * 9 * 6144; int* counts = p.counts + l * 32 * 32;
    constexpr int LDW = 1032, LDT = 264;
    LDSP bf16_t* WR = (LDSP bf16_t*)lds;
    LDSP bf16_t* HT = WR + 32 * LDW + wv * 16 * LDT;
    { u32x4v wv_[8];
#pragma unroll
      for (int q = 0; q < 8; ++q) wv_[q] = *(const u32x4v*)(p.WRT + (size_t)(tid_ + q * NTHR) * 8);
#pragma unroll
      for (int q = 0; q < 8; ++q) { const int c = tid_ + q * NTHR; *(LDSP u32x4v*)(WR + (c >> 7) * LDW + (c & 127) * 8) = wv_[q]; } }
    __syncthreads();
    const int ntile = (T - t0) >> 4;
    const float* g2 = p.norm2_g + l * D;
    for (int tile = gw; tile < ntile; tile += NW) {
        const int tb = t0 + tile * 16;
        const float* mr = MODl + (size_t)tok_modrow(tb) * 6144;
        float rs[16];
        { const f32x4v* q = (const f32x4v*)(p.XSS + (size_t)(tb + li) * 16); const f32x4v a = q[0], b = q[1], c = q[2], d = q[3];
          const float ss = (((a.x + a.y) + (a.z + a.w)) + ((b.x + b.y) + (b.z + b.w))) + (((c.x + c.y) + (c.z + c.w)) + ((d.x + d.y) + (d.z + d.w)));
          const float r = rsqrtf(ss * (1.0f / D) + 1e-6f);
#pragma unroll
          for (int i = 0; i < 16; ++i) rs[i] = shl(r, i); }
        f32x4v acc[2]; acc[0] = (f32x4v){0.f, 0.f, 0.f, 0.f}; acc[1] = acc[0];
        u32x2v xq[16];
#pragma unroll
        for (int i = 0; i < 16; ++i) xq[i] = *(const u32x2v*)(xrow(p, tb + i) + lane * 4);
#pragma unroll
        for (int kc = 0; kc < 4; ++kc) {
            const int kk = kc * 256 + lane * 4;
            const f32x4v gg = *(const f32x4v*)(g2 + kk), sh = *(const f32x4v*)(mr + 3 * 1024 + kk), sc = *(const f32x4v*)(mr + 4 * 1024 + kk);
            f32x4v gs;
#pragma unroll
            for (int j = 0; j < 4; ++j) gs[j] = gg[j] * (1.f + sc[j]);
#pragma unroll
            for (int i = 0; i < 16; ++i) { const u32x2v r = xq[i];
                const f32x4v xv = mkf4(__uint_as_float(r.x << 16), __uint_as_float(r.x & 0xffff0000u), __uint_as_float(r.y << 16), __uint_as_float(r.y & 0xffff0000u));
                const f32x4v h = xv * rs[i] * gs + sh; const u32x2v hb = pack4(h);
                *(unsigned*)((unsigned char*)p.H + (size_t)(tb + i) * D + kk) = pg8::pk4_fp8(h);
                *(LDSP u32x2v*)(HT + i * LDT + lane * 4) = hb; }
            if (kc < 3) {
#pragma unroll
                for (int i = 0; i < 16; ++i) xq[i] = *(const u32x2v*)(xrow(p, tb + i) + kk + 256); }
            asm volatile("s_waitcnt lgkmcnt(0)" ::: "memory");
#pragma unroll
            for (int ks = 0; ks < 8; ++ks) { const bf16x8v vfr = frag_row(HT, LDT, 0, 32 * ks, lane);
                acc[0] = mfma16(frag_row(WR, LDW, 0, kc * 256 + 32 * ks, lane), vfr, acc[0]);
                acc[1] = mfma16(frag_row(WR, LDW, 16, kc * 256 + 32 * ks, lane), vfr, acc[1]); }
            asm volatile("s_waitcnt lgkmcnt(0)" ::: "memory");
        }
        float bgs = -1e30f; int bgi = 0, e1 = 0, e2 = 0; float w1 = 0.f, w2 = 0.f;
#pragma unroll
        for (int ut = 0; ut < 2; ++ut) { const int gi = ut * 4 + G; float m1 = -1e30f, m2 = -1e30f, s1 = 0.f, s2 = 0.f; int i1 = 0, i2 = 0;
#pragma unroll
            for (int r = 0; r < 4; ++r) { const float sv = 1.0f / (1.0f + __expf(-acc[ut][r])), vv = sv + p.router_bias[gi * 4 + r];
                if (vv > m1) { m2 = m1; i2 = i1; s2 = s1; m1 = vv; i1 = gi * 4 + r; s1 = sv; } else if (vv > m2) { m2 = vv; i2 = gi * 4 + r; s2 = sv; } }
            if (m1 + m2 > bgs) { bgs = m1 + m2; bgi = gi; e1 = i1; e2 = i2; w1 = s1; w2 = s2; } }
#pragma unroll
        for (int o = 16; o <= 32; o <<= 1) {
            const float ogs = shx(bgs, o, lane), ow1 = shx(w1, o, lane), ow2 = shx(w2, o, lane); const int ogi = shxi(bgi, o, lane), oe1 = shxi(e1, o, lane), oe2 = shxi(e2, o, lane);
            if (ogs > bgs || (ogs == bgs && ogi < bgi)) { bgs = ogs; bgi = ogi; e1 = oe1; e2 = oe2; w1 = ow1; w2 = ow2; } }
        if (G == 0) {
            const int t = tb + li; const float inv = 1.0f / (w1 + w2);
            const int r1 = atomicAdd(&counts[e1 * 32], 1), r2 = atomicAdd(&counts[e2 * 32], 1);
            p.MAP[(size_t)e1 * T + r1] = t; p.MAP[(size_t)e2 * T + r2] = t;
            p.TOKSLOT[t * 4 + 0] = e1; p.TOKSLOT[t * 4 + 1] = r1; p.TOKSLOT[t * 4 + 2] = e2; p.TOKSLOT[t * 4 + 3] = r2;
            p.EW[t * 2 + 0] = w1 * inv; p.EW[t * 2 + 1] = w2 * inv;
        }
    }
}

DI void ph_combine(const P& p, int l, int t0, const unsigned char* Y  , LDSP int* ps  ) {
    const int tid_ = ltid(), lane = tid_ & 63, gw = blockIdx.x * NWV + __builtin_amdgcn_readfirstlane(tid_ >> 6)  , NW = gridDim.x * NWV;
    const float* MODl = p.MOD + (size_t)l * 9 * 6144; const int* counts = p.counts + l * 32 * 32;
    if (tid_ < 64) { const int cnt = tid_ < 32 ? counts[tid_ * 32] : 0; int pc = cnt;
#pragma unroll
        for (int o = 1; o < 32; o <<= 1) { const int src = lane >= o ? lane - o : lane; const int a = shli(pc, src); if (lane >= o) pc += a; }
        if (tid_ < 32) ps[tid_] = pc - cnt; }
    __syncthreads();
    for (int t = t0 + 4 * gw; t < T; t += 4 * NW) {
        int4 sl[4]; float4 ew[2];
#pragma unroll
        for (int u = 0; u < 4; ++u) sl[u] = *(const int4*)(p.TOKSLOT + (size_t)(t + u) * 4);
        ew[0] = *(const float4*)(p.EW + (size_t)t * 2); ew[1] = *(const float4*)(p.EW + (size_t)(t + 2) * 2);
        unsigned yr[4][2][4];
#pragma unroll
        for (int u = 0; u < 4; ++u) { const unsigned char* y0 = Y + (size_t)__builtin_amdgcn_readfirstlane(ps[sl[u].x] + sl[u].y) * D; const unsigned char* y1 = Y + (size_t)__builtin_amdgcn_readfirstlane(ps[sl[u].z] + sl[u].w) * D;
#pragma unroll
            for (int i = 0; i < 4; ++i) { yr[u][0][i] = *(const unsigned*)(y0 + (i * 64 + lane) * 4); yr[u][1][i] = *(const unsigned*)(y1 + (i * 64 + lane) * 4); } }
        const float* mrow = MODl + (size_t)tok_modrow(t) * 6144; const float* g5 = mrow + 5 * 1024;
        const float* mr1 = p.MOD + (size_t)9 * 6144 + (size_t)tok_modrow(t) * 6144;
#pragma unroll
        for (int pr = 0; pr < 2; ++pr) {
            const float wgt[2][2] = {{ew[pr].x, ew[pr].y}, {ew[pr].z, ew[pr].w}};
            u32x2v xr[2][4];
#pragma unroll
            for (int u = 0; u < 2; ++u)
#pragma unroll
                for (int i = 0; i < 4; ++i) xr[u][i] = *(const u32x2v*)(xrow(p, t + 2 * pr + u) + (i * 64 + lane) * 4);
            float4 v[2][4];
#pragma unroll
            for (int i = 0; i < 4; ++i) { const int c = (i * 64 + lane) * 4; const float4 gg = *(const float4*)(g5 + c);
#pragma unroll
                for (int u = 0; u < 2; ++u) { const u32x2v x = xr[u][i]; const int a = (int)yr[2 * pr + u][0][i], b = (int)yr[2 * pr + u][1][i]; const float w1 = wgt[u][0], w2 = wgt[u][1];
                    v[u][i].x = __uint_as_float(x.x << 16) + gg.x * (w1 * __builtin_amdgcn_cvt_f32_fp8(a, 0) + w2 * __builtin_amdgcn_cvt_f32_fp8(b, 0));
                    v[u][i].y = __uint_as_float(x.x & 0xffff0000u) + gg.y * (w1 * __builtin_amdgcn_cvt_f32_fp8(a, 1) + w2 * __builtin_amdgcn_cvt_f32_fp8(b, 1));
                    v[u][i].z = __uint_as_float(x.y << 16) + gg.z * (w1 * __builtin_amdgcn_cvt_f32_fp8(a, 2) + w2 * __builtin_amdgcn_cvt_f32_fp8(b, 2));
                    v[u][i].w = __uint_as_float(x.y & 0xffff0000u) + gg.w * (w1 * __builtin_amdgcn_cvt_f32_fp8(a, 3) + w2 * __builtin_amdgcn_cvt_f32_fp8(b, 3));
                    if (l == 0) *(u32x2v*)(xrow(p, t + 2 * pr + u) + c) = mk2(pk2(v[u][i].x, v[u][i].y), pk2(v[u][i].z, v[u][i].w)); } }
            float rstd[2];
#pragma unroll
            for (int u = 0; u < 2; ++u) { float ss = 0.f;
#pragma unroll
                for (int i = 0; i < 4; ++i) ss += v[u][i].x * v[u][i].x + v[u][i].y * v[u][i].y + v[u][i].z * v[u][i].z + v[u][i].w * v[u][i].w;
                rstd[u] = rsqrtf(wave_sum(ss, lane) * (1.0f / D) + 1e-6f); }
            if (l == 0) {
#pragma unroll
                for (int i = 0; i < 4; ++i) { const int c = (i * 64 + lane) * 4;
                    const float4 gg = *(const float4*)(p.norm1_g + D + c), sh = *(const float4*)(mr1 + c), sc = *(const float4*)(mr1 + 1024 + c);
#pragma unroll
                    for (int u = 0; u < 2; ++u) { const float r = rstd[u];
                        *(unsigned*)((unsigned char*)p.H + (size_t)(t + 2 * pr + u) * D + c) = pg8::pk4_fp8((pg8::f32x4){v[u][i].x * r * gg.x * (1.f + sc.x) + sh.x, v[u][i].y * r * gg.y * (1.f + sc.y) + sh.y, v[u][i].z * r * gg.z * (1.f + sc.z) + sh.z, v[u][i].w * r * gg.w * (1.f + sc.w) + sh.w}); } }
            } else {
#pragma unroll
                for (int u = 0; u < 2; ++u)
#pragma unroll
                    for (int i = 0; i < 4; ++i) { const float4 gg = ((const float4*)p.final_g)[i * 64 + lane]; const float r = rstd[u];
                        ((float4*)(p.out + (size_t)(t + 2 * pr + u - TC) * D))[i * 64 + lane] = make_float4(v[u][i].x * r * gg.x, v[u][i].y * r * gg.y, v[u][i].z * r * gg.z, v[u][i].w * r * gg.w); }
            }
        }
    }
}

#define XLAS __attribute__((address_space(3)))
#define XB_TMO      128
#define XB_XCNT(j)  (256  + 64 * (j))
#define XB_XSUB(j)  (1280 + 64 * (j))
#define XB_XGEN(j)  (2304 + 64 * (j))
#define XB_TOP      3328
#define XB_TOPGEN   3392
#define XCD_BAR_WORDS 3456
#define XB_SPIN_CAP (1u << 18)

__device__ __forceinline__ unsigned xb_ld(unsigned* p)              { return __hip_atomic_load(p, __ATOMIC_RELAXED, __HIP_MEMORY_SCOPE_AGENT); }
__device__ __forceinline__ unsigned xb_add(unsigned* p, unsigned v) { return __hip_atomic_fetch_add(p, v, __ATOMIC_RELAXED, __HIP_MEMORY_SCOPE_AGENT); }
__device__ __forceinline__ unsigned xb_xcc_id() { return (unsigned)__builtin_amdgcn_s_getreg((3 << 11) | 20) & 0xFu; }
#define XB_SPIN(cond, bar) do { unsigned _sp = 0; while (cond) { __builtin_amdgcn_s_sleep(1); \
    if ((++_sp & 255u) == 0u) { if (xb_ld(&(bar)[XB_TMO])) break; if (_sp > XB_SPIN_CAP) { atomicAdd(&(bar)[XB_TMO], 1u); break; } } } } while (0)

struct XcdBarrier {
    unsigned* bar; unsigned x;
    volatile XLAS unsigned* st;
};

__device__ __forceinline__ XcdBarrier xcd_barrier_post(unsigned* bar, volatile XLAS unsigned* st) {
    XcdBarrier b; b.bar = bar; b.x = xb_xcc_id(); b.st = st;
    if (ltid() == 0) (void)xb_add(&bar[XB_XCNT(b.x)], 1u);
    return b;
}
__device__ __forceinline__ void xcd_barrier_complete(unsigned* bar, unsigned x, unsigned& nloc, unsigned& nx) {
    const unsigned G = gridDim.x * gridDim.y * gridDim.z;
    unsigned sum, cnt, mine, sp = 0u;
    for (;;) {
        sum = 0u; cnt = 0u; mine = 0u;
#pragma unroll
        for (unsigned j = 0; j < 16; ++j) { const unsigned c = xb_ld(&bar[XB_XCNT(j)]); sum += c; cnt += (c > 0u) ? 1u : 0u; mine = (j == x) ? c : mine; }
        if (sum == G) break;
        __builtin_amdgcn_s_sleep(1);
        if ((++sp & 255u) == 0u) { if (xb_ld(&bar[XB_TMO])) break; if (sp > XB_SPIN_CAP) { atomicAdd(&bar[XB_TMO], 1u); break; } }
    }
    nloc = mine > 0u ? mine : 1u; nx = cnt > 0u ? cnt : 1u;
}

__device__ __forceinline__ void xcd_barrier(const XcdBarrier& b) {
    asm volatile("s_waitcnt vmcnt(0)" ::: "memory");
    __syncthreads();
    if (ltid() == 0) {
        unsigned* bar = b.bar;
        __builtin_amdgcn_s_waitcnt(0);
        unsigned nloc = b.st[0], nx = b.st[1];
        if (nloc == 0u) { xcd_barrier_complete(bar, b.x, nloc, nx); b.st[0] = nloc; b.st[1] = nx; }
        const unsigned old = xb_add(&bar[XB_XSUB(b.x)], 1u);
        const unsigned gen = old / nloc;
        if (old + 1u == (gen + 1u) * nloc) {
            __builtin_amdgcn_fence(__ATOMIC_RELEASE, "agent");
            asm volatile("s_waitcnt vmcnt(0)" ::: "memory");
            const unsigned og = xb_add(&bar[XB_TOP], 1u);
            const unsigned tg = og / nx;
            if (og + 1u == (tg + 1u) * nx) xb_add(&bar[XB_TOPGEN], 1u);
            else XB_SPIN(xb_ld(&bar[XB_TOPGEN]) == tg, bar);
            __builtin_amdgcn_fence(__ATOMIC_ACQUIRE, "agent");
            xb_add(&bar[XB_XGEN(b.x)], 1u);
            asm volatile("s_waitcnt vmcnt(0)" ::: "memory");
        } else {
            XB_SPIN(xb_ld(&bar[XB_XGEN(b.x)]) == gen, bar);
            __builtin_amdgcn_fence(__ATOMIC_ACQUIRE, "agent");
            asm volatile("s_waitcnt vmcnt(0)" ::: "memory");
        }
    }
    __syncthreads();
}

DI void moe_table(const P& p, int l, PG8_LAS int* tab) {
    const int tid_ = ltid();
    if (tid_ < 64) { const int cnt = tid_ < 32 ? p.counts[(l * 32 + tid_) * 32] : 0; const int nt = (cnt + 255) >> 8; int pt = nt, pc = cnt;
#pragma unroll
        for (int o = 1; o < 32; o <<= 1) { const int ln_ = tid_ & 63, src = ln_ >= o ? ln_ - o : ln_; const int a = shli(pt, src), b = shli(pc, src); if (ln_ >= o) { pt += a; pc += b; } }
        if (tid_ < 32) { tab[tid_ + 1] = pt; tab[33 + tid_] = cnt; tab[65 + tid_] = pc - cnt; if (tid_ == 0) tab[0] = 0; } }
    __syncthreads();
}
typedef const __attribute__((address_space(4))) P* PK;
DI PK lp(PK q) { asm volatile("" : "+s"(q)); return q; }
#define PHASE(...) do { const P p = *(const P*)lp(pk); __VA_ARGS__; } while (0)

#ifndef CV_L0
#define CV_L0 7
#endif
template <int l> DI void layer(PK pk, unsigned char* smem, const XcdBarrier& xbar) {
    float* ldsf = (float*)smem; const int gw = 0, NW = 0, lane = 0;
    {
        constexpr int NG = l == 0 ? 234 : 182;
        constexpr int CV1 = l == 0 ? CV_L0 * 768 : NE * 768;
        const int G = (int)gridDim.x == 256 ? NG : (int)gridDim.x;
        if ((int)blockIdx.x < G) PHASE({ pg8::Gemm g{p.H, (const bf16_t*)((const unsigned char*)p.WinT + (size_t)l * NPAD_IN * D), T, NPAD_IN, D / 2}; pg8::StaticOrder S; S.init(T, NPAD_IN, G, (int)blockIdx.x);
            pg8::EpiProj E{p.PROJ, LDP, INDIM, 1.0f / 64.0f};
            pg8::gemm_phase<pg8::EpiProj, pg8::StaticOrder, false, PG8_SP2, 1>((PG8_LAS unsigned char*)smem, g, S, E, nullptr); });
        else PHASE(ph_convert_experts(p, l, ldsf, G, (int)gridDim.x - G, 0, CV1));
        if ((int)gridDim.x != 256) PHASE(ph_convert_experts(p, l, ldsf, 0, (int)gridDim.x, 0, CV1));
    }
    xcd_barrier(xbar);
    PHASE(ph_prep(p, l, (LDSP unsigned char*)smem));
    xcd_barrier(xbar);
    PHASE(ph_s1(p, l, (LDSP unsigned char*)smem));
    xcd_barrier(xbar);
    PHASE(ph_s2(p));
    xcd_barrier(xbar);
    PHASE(ph_s3(p, l, (LDSP unsigned char*)smem));
    xcd_barrier(xbar);
    {
        constexpr int ro = l == 0 ? 0 : TC;
        constexpr int NG = l == 0 ? 182 : 256;
        const int G = (int)gridDim.x == 256 ? NG : (int)gridDim.x;
        if ((int)blockIdx.x < G) PHASE({ pg8::Gemm g{p.H + (size_t)ro * D, p.WoutT + (size_t)l * D * D, T - ro, D, D}; pg8::StaticOrder S; S.init(T - ro, D, G, (int)blockIdx.x);
            pg8::EpiResGate<l != 0> E{p.SSQ, p.ctx, p.x, p.XB, p.MOD + (size_t)l * 9 * 6144 + 2 * 1024, p.XSS, ro};
            pg8::gemm_phase<pg8::EpiResGate<l != 0>, pg8::StaticOrder>((PG8_LAS unsigned char*)smem, g, S, E, nullptr); });
        else if (l == 0) PHASE(ph_convert_experts(p, l, ldsf, G, (int)gridDim.x - G, CV_L0 * 768, NE * 768));
        if (l == 0 && (int)gridDim.x != 256) PHASE(ph_convert_experts(p, l, ldsf, 0, (int)gridDim.x, CV_L0 * 768, NE * 768));
    }
    xcd_barrier(xbar);
    const int t0 = l == 0 ? 0 : TC;
    PHASE(ph_normroute(p, l, t0, (LDSP unsigned char*)smem));
    xcd_barrier(xbar);
    PG8_LAS int* tab = (PG8_LAS int*)((PG8_LAS unsigned char*)smem + pg8::STAGE_BYTES);
#pragma unroll
    for (int ph = 0; ph < 2; ++ph) {
        PHASE(moe_table(p, l, tab));
        const int U = __builtin_amdgcn_readfirstlane(tab[32]) * 4;
        if (ph == 0) PHASE({ pg8::Gemm g{p.H, p.WguT, T, D, D / 2}; pg8::MoeSched S{tab, p.MAP, U, (int)gridDim.x, (int)blockIdx.x, 4, 1, (size_t)D * D};
            pg8::EpiAct E{(unsigned char*)p.SS}; pg8::gemm_phase_moe<pg8::EpiAct, pg8::MoeSched, false, PG8_SP2, 1>((PG8_LAS unsigned char*)smem, g, S, E, nullptr); });
        else PHASE({ pg8::Gemm g{p.SS, p.WdT, T, D, 256}; pg8::MoeSched S{tab, p.MAP, U, (int)gridDim.x, (int)blockIdx.x, 4, 0, (size_t)D * 512};
            pg8::EpiY E{(unsigned char*)p.PROJ}; pg8::gemm_phase_moe<pg8::EpiY, pg8::MoeSched, false, PG8_SP2, 1>((PG8_LAS unsigned char*)smem, g, S, E, nullptr); });
        xcd_barrier(xbar);
    }
    PHASE(ph_combine(p, l, t0, (const unsigned char*)p.PROJ, (LDSP int*)smem));
    xcd_barrier(xbar);
}

__global__ void __launch_bounds__(NTHR) mega(P p_arg) {
    extern __shared__ __attribute__((aligned(16))) unsigned char smem[];
    cg::grid_group grid = cg::this_grid();
    PK pk = (PK)__builtin_amdgcn_kernarg_segment_ptr();
    const int lane = 0, gw = 0, NW = 0;
    float* ldsf = (float*)smem;
    volatile XLAS unsigned* bst = (volatile XLAS unsigned*)((XLAS unsigned char*)smem + LDS_BYTES - 16);
    { const int t_ = ltid(); if (t_ < 2) bst[t_] = 0u; }
    __syncthreads();
    const XcdBarrier xbar = xcd_barrier_post(pk->BAR, bst);
    PHASE(ph_init(p)); PHASE(ph_mod(p, ldsf)); PHASE(ph_convert_small(p, ldsf, gw, NW, lane));
    grid.sync();
    PHASE(ph_normmod1(p, 0, gw, NW, lane));
    xcd_barrier(xbar);
    layer<0>(pk, smem, xbar);
    layer<1>(pk, smem, xbar);
}

static inline size_t al(size_t x) { return (x + 255) & ~(size_t)255; }

extern "C" void kernel_launch(void* const* d_in, const int* in_sizes, int n_in, void* d_out, int out_size, void* d_ws, size_t ws_size, hipStream_t stream) {
    static int grid_blocks = 0;
    if (grid_blocks == 0) {
        int dev = 0, cus = 0, per_cu = 0;
        if (hipFuncSetAttribute((const void*)mega, hipFuncAttributeMaxDynamicSharedMemorySize, LDS_BYTES) != hipSuccess) { fprintf(stderr, "hipFuncSetAttribute failed\n"); grid_blocks = -1; return; }
        (void)hipGetDevice(&dev); (void)hipDeviceGetAttribute(&cus, hipDeviceAttributeMultiprocessorCount, dev);
        if (hipOccupancyMaxActiveBlocksPerMultiprocessor(&per_cu, (const void*)mega, NTHR, LDS_BYTES) != hipSuccess || per_cu < 1) { fprintf(stderr, "occupancy query: %d blocks/CU\n", per_cu); grid_blocks = -1; return; }
        grid_blocks = cus;
    }
    if (grid_blocks < 0) return;
    P p{};
    const float** pin = (const float**)&p;
    for (int i = 0; i < 29; ++i) pin[i] = (const float*)d_in[i];
    p.out = (float*)d_out;
    char* ws = (char*)d_ws; size_t off = 0;
    auto take = [&](size_t bytes) { char* q = ws + off; off += al(bytes); return q; };
    p.XB = (bf16_t*)take((size_t)T * D * 2);
    p.H = (bf16_t*)take((size_t)T * D * 2);
    p.PROJ = (bf16_t*)take((size_t)T * LDP * 2);
    p.SS = (bf16_t*)take((size_t)NTILE * 8 * 2 * 4096 * 2);
    p.GS = (bf16_t*)take((size_t)NTILE * 4 * 2 * 8192 * 2);
    p.SDEC = (float*)take((size_t)NTILE * 8 * 2 * 4);
    p.GDEC = (float*)take((size_t)NTILE * 4 * 2 * 64 * 4);
    p.MOD = (float*)take((size_t)2 * 9 * 6144 * 4);
    p.counts = (int*)take(64 * 32 * 4);
    p.TOKSLOT = (int*)take((size_t)T * 4 * 4);
    p.EW = (float*)take((size_t)T * 2 * 4);
    p.MAP = (int*)take((size_t)NE * T * 4);
    p.WinT = (bf16_t*)take((size_t)2 * NPAD_IN * D * 2);
    p.WoutT = (bf16_t*)take((size_t)2 * D * D * 2);
    p.WguT = (bf16_t*)take((size_t)NE * D * D * 2);
    p.WdT = (bf16_t*)take((size_t)NE * D * 512 * 2);
    p.WRT = (bf16_t*)take((size_t)32 * 1024 * 2);
    p.BAR = (unsigned*)take(XCD_BAR_WORDS * 4);
    p.XBCC = (bf16_t*)d_out;
    p.QKB = (bf16_t*)d_out + (size_t)T * 768;
    p.SSC = (float*)take((size_t)T * 8 * 4 * 4);
    p.STOT = (float*)take((size_t)NTILE * 8 * 2 * 4);
    p.SSQ = (float*)take((size_t)T * 8 * 4);
    p.XSS = (float*)take((size_t)T * 16 * 4);
    if (off > ws_size) { fprintf(stderr, "workspace too small: need %zu have %zu\n", off, ws_size); return; }
    if (hipMemsetAsync(p.BAR, 0, XCD_BAR_WORDS * 4, stream) != hipSuccess) { fprintf(stderr, "memset of barrier words failed\n"); return; }
    void* args[] = {&p};
    hipError_t e = hipLaunchCooperativeKernel((void*)mega, dim3(grid_blocks), dim3(NTHR), args, LDS_BYTES, stream);
    if (e != hipSuccess) fprintf(stderr, "cooperative launch failed: %s (grid %d)\n", hipGetErrorString(e), grid_blocks);
}
```

```cpp
#include <hip/hip_runtime.h>
#include <hip/hip_cooperative_groups.h>
#include <stdint.h>
#include <cstdio>
namespace cg = cooperative_groups;

typedef unsigned short bf16_t;
#define DI __device__ __forceinline__

constexpr int D = 1024, NB = 8, SEQ = 4096, CTXL = 256, TC = NB * CTXL, TL = NB * SEQ, T = TC + TL;
constexpr int INDIM = 2840, LDP = 2848;
constexpr int OFF_Z = 0, OFF_XBC = 512, OFF_DT = 1280, OFF_Q = 1288, OFF_K = 1544, OFF_V = 1800, OFF_GO = 2312, OFF_GK = 2824;
constexpr int NE = 32;

DI float bf2f(bf16_t v) { return __uint_as_float(((unsigned)v) << 16); }
typedef float f32x2v_ __attribute__((ext_vector_type(2)));
typedef __bf16 bf16x2v_ __attribute__((ext_vector_type(2)));
DI bf16_t f2bf(float f) { return __builtin_bit_cast(unsigned short, (__bf16)f); }
DI float siluf(float x) { return x * __builtin_amdgcn_rcpf(1.0f + __builtin_amdgcn_exp2f(-1.4426950408889634f * x)); }
DI float softplusf(float x) { return fmaxf(x, 0.f) + log1pf(__expf(-fabsf(x))); }
DI float logsigmoidf(float x) { return -softplusf(-x); }
DI float shx(float v, int o, int lane) { return __int_as_float(__builtin_amdgcn_ds_bpermute((lane ^ o) << 2, __float_as_int(v))); }
DI int shxi(int v, int o, int lane) { return __builtin_amdgcn_ds_bpermute((lane ^ o) << 2, v); }
DI float shl(float v, int src) { return __int_as_float(__builtin_amdgcn_ds_bpermute(src << 2, __float_as_int(v))); }
DI int shli(int v, int src) { return __builtin_amdgcn_ds_bpermute(src << 2, v); }
DI float wave_sum(float v, int lane) {
#pragma unroll
    for (int o = 32; o >= 1; o >>= 1) v += shx(v, o, lane);
    return v;
}
DI int ltid() { const int wv = __builtin_amdgcn_readfirstlane(threadIdx.x >> 6);
    int ln; asm volatile("v_mbcnt_lo_u32_b32 %0, -1, 0\n\tv_mbcnt_hi_u32_b32 %0, -1, %0" : "=v"(ln));
    return wv * 64 + ln; }
DI int tok_modrow(int t) { return t < TC ? 8 : ((t - TC) >> 12); }
template <class PT> DI bf16_t* xrow(const PT& p, int t) { return p.XB + (size_t)t * D; }


#ifndef PG8_SP2
#define PG8_SP2 true
#endif
namespace pg8 {
#define PG8_LAS __attribute__((address_space(3)))
typedef unsigned short bf16_t;
typedef short bf16x8 __attribute__((ext_vector_type(8)));
typedef float f32x4 __attribute__((ext_vector_type(4)));
typedef unsigned u32x4 __attribute__((ext_vector_type(4)));
constexpr int BM = 256, BK = 64, HALF = 128, HTB = HALF * BK * 2  , STAGE_BYTES = 8 * HTB, NXCD = 8, WGM = 8;

__host__ __device__ __forceinline__ int lds_byte(int r, int c) { const int st = (r >> 4) * 2 + (c >> 5), rr = r & 15, cc = c & 31, ob = rr * 64 + cc * 2; return st * 1024 + (ob ^ (((ob >> 9) & 1) << 5)); }
__host__ __device__ __forceinline__ void stage_rc(int b, int& R, int& C) { const int st = b / 1024, sb = b % 1024, swz = sb ^ (((sb >> 9) & 1) << 5); R = (st >> 1) * 16 + swz / 64; C = (st & 1) * 32 + (swz % 64) / 2; }
__host__ __device__ __forceinline__ int perm32(int rho) { const int n = rho >> 4, i = rho & 15; return 8 * (i >> 2) + 4 * n + (i & 3); }

struct Unit { int pm, pn; };
struct Gemm { const bf16_t* A; const bf16_t* Bt; int M, N, K; };

struct StaticOrder {
    int nM, nN, nwg, G, c;
    __host__ __device__ void init(int M, int N, int G_, int c_) { nM = M / BM; nN = N / BM; nwg = nM * nN; G = G_; c = c_; }
    __host__ __device__ bool next(int i, Unit& u) const {
        const long L = (long)i * G + c; if (L >= nwg) return false;
        int wgid = (int)L; { const int q = nwg / NXCD, r = nwg % NXCD, xcd = wgid % NXCD, off = wgid / NXCD; wgid = (xcd < r ? xcd * (q + 1) : r * (q + 1) + (xcd - r) * q) + off; }
        const int nig = WGM * nN, gid = wgid / nig, fm = gid * WGM, gsz = (nM - fm) < WGM ? (nM - fm) : WGM;
        u.pm = fm + ((wgid % nig) % gsz); u.pn = (wgid % nig) / gsz; return true;
    }
    __device__ __forceinline__ void a_ready(const Unit&) const {}
    __device__ __forceinline__ void done(const Unit&) const {}
};
__device__ __forceinline__ unsigned cvt_pk_bf16(float lo, float hi) { unsigned r; asm volatile("v_cvt_pk_bf16_f32 %0, %1, %2" : "=v"(r) : "v"(lo), "v"(hi)); return r; }
typedef float f32x2 __attribute__((ext_vector_type(2)));

typedef int i32x4 __attribute__((ext_vector_type(4)));
typedef int i32x8 __attribute__((ext_vector_type(8)));
__device__ __forceinline__ i32x8 cat8(bf16x8 a, bf16x8 b) { return __builtin_shufflevector(__builtin_bit_cast(i32x4, a), __builtin_bit_cast(i32x4, b), 0, 1, 2, 3, 4, 5, 6, 7); }
__device__ __forceinline__ void mfma8(f32x4& c, i32x8 a, i32x8 b) { asm volatile("v_mfma_f32_16x16x128_f8f6f4 %0, %1, %2, %0" : "+v"(c) : "v"(a), "v"(b)); }
__device__ __forceinline__ unsigned pk4_fp8(const f32x4 v) { const float lim = 440.f;
    int w = __builtin_amdgcn_cvt_pk_fp8_f32(__builtin_amdgcn_fmed3f(v[0], -lim, lim), __builtin_amdgcn_fmed3f(v[1], -lim, lim), 0, false);
    return (unsigned)__builtin_amdgcn_cvt_pk_fp8_f32(__builtin_amdgcn_fmed3f(v[2], -lim, lim), __builtin_amdgcn_fmed3f(v[3], -lim, lim), w, true); }
struct EpiProj {
    static constexpr bool PERM = true, AFTER_DRAIN = false, MIDK = false;
    bf16_t* O; int ldc; int ncols; float osc;
    __device__ __forceinline__ void operator()(const f32x4 (&acc)[2][2][4][2], const Unit& u, int wr, int wc, int fr, int fq) const {
        const int row0 = u.pm * BM + wr * 64 + fr, col0 = u.pn * BM + wc * 32 + 8 * fq;
#pragma unroll
        for (int ai = 0; ai < 2; ++ai)
#pragma unroll
            for (int m = 0; m < 4; ++m) { bf16_t* rowp = O + (size_t)(row0 + ai * HALF + m * 16) * ldc + col0;
#pragma unroll
                for (int bj = 0; bj < 2; ++bj) { const f32x4 v0 = acc[ai][bj][m][0] * osc, v1 = acc[ai][bj][m][1] * osc;
                    u32x4 w; w.x = cvt_pk_bf16(v0[0], v0[1]); w.y = cvt_pk_bf16(v0[2], v0[3]); w.z = cvt_pk_bf16(v1[0], v1[1]); w.w = cvt_pk_bf16(v1[2], v1[3]);
                    if (col0 + bj * HALF + 8 <= ncols) *(u32x4*)(rowp + bj * HALF) = w; } }
    }
};
template <bool SRC_BF16> struct EpiResGate {
    static constexpr bool PERM = true, AFTER_DRAIN = false, MIDK = true;
    const float* ssq;
    const float* Sc; const float* Sl;
    bf16_t* XB;
    const float* gate_rows; float* xss; int rowoff;
    template <class Sched> __device__ __forceinline__ void prep(PG8_LAS unsigned char* lds, const Sched& S, int tid) const {
        PG8_LAS float* RS = (PG8_LAS float*)(lds + STAGE_BYTES);
        const int r = tid & 255, i0 = tid >> 8;
        for (int i = i0; ; i += 2) { Unit u; if (!S.next(i, u)) break;
            const f32x4* q = (const f32x4*)(ssq + (size_t)(rowoff + u.pm * BM + r) * 8); const f32x4 a = q[0], b = q[1];
            RS[i * 256 + r] = __builtin_amdgcn_rsqf((((a[0] + a[1]) + (a[2] + a[3])) + ((b[0] + b[1]) + (b[2] + b[3]))) * (1.0f / 512.0f) + 1e-6f); }
    }
    __device__ __forceinline__ void midk(f32x4 (&acc)[2][2][4][2], PG8_LAS unsigned char* lds, int ui, int wr, int fr) const {
        int fr_ = fr; asm volatile("" : "+v"(fr_));
        PG8_LAS const float* RS = (PG8_LAS const float*)(lds + STAGE_BYTES) + ui * 256 + wr * 64 + fr_;
#pragma unroll
        for (int ai = 0; ai < 2; ++ai)
#pragma unroll
            for (int m = 0; m < 4; ++m) { const float rs = RS[ai * HALF + m * 16];
#pragma unroll
                for (int bj = 0; bj < 2; ++bj)
#pragma unroll
                    for (int n = 0; n < 2; ++n) acc[ai][bj][m][n] *= rs; }
    }
    __device__ __forceinline__ void operator()(const f32x4 (&acc)[2][2][4][2], const Unit& u, int wr, int wc, int fr, int fq) const {
        const int row0 = rowoff + u.pm * BM + wr * 64 + fr, col0 = u.pn * BM + wc * 32 + 8 * fq;
        const int t0 = rowoff + u.pm * BM; const int mrow = t0 < 2048 ? 8 : ((t0 - 2048) >> 12);
        const float* gr = gate_rows + (size_t)mrow * 6144 + col0;
        f32x4 gv[2][2];
#pragma unroll
        for (int bj = 0; bj < 2; ++bj)
#pragma unroll
            for (int n = 0; n < 2; ++n) gv[bj][n] = *(const f32x4*)(gr + bj * HALF + n * 4);
#pragma unroll
        for (int ai = 0; ai < 2; ++ai) {
            u32x4 rb[4][2]; f32x4 xf[SRC_BF16 ? 1 : 4][2][2];
#pragma unroll
            for (int m = 0; m < 4; ++m) { const int rr = row0 + ai * HALF + m * 16;
                const float* sp = (rr < 2048 ? Sc + (size_t)rr * 1024 : Sl + (size_t)(rr - 2048) * 1024) + col0; const bf16_t* dp = XB + (size_t)rr * 1024 + col0;
#pragma unroll
                for (int bj = 0; bj < 2; ++bj) {
                    if (SRC_BF16) rb[m][bj] = *(const u32x4*)(dp + bj * HALF);
                    else { xf[SRC_BF16 ? 0 : m][bj][0] = *(const f32x4*)(sp + bj * HALF); xf[SRC_BF16 ? 0 : m][bj][1] = *(const f32x4*)(sp + bj * HALF + 4); } } }
#pragma unroll
            for (int m = 0; m < 4; ++m) { const int rr = row0 + ai * HALF + m * 16;
                bf16_t* dp = XB + (size_t)rr * 1024 + col0; float ss = 0.f;
#pragma unroll
                for (int bj = 0; bj < 2; ++bj) { f32x4 x0, x1;
                    if (SRC_BF16) { const u32x4 r = rb[m][bj];
                        x0 = (f32x4){__uint_as_float(r.x << 16), __uint_as_float(r.x & 0xffff0000u), __uint_as_float(r.y << 16), __uint_as_float(r.y & 0xffff0000u)};
                        x1 = (f32x4){__uint_as_float(r.z << 16), __uint_as_float(r.z & 0xffff0000u), __uint_as_float(r.w << 16), __uint_as_float(r.w & 0xffff0000u)}; }
                    else { x0 = xf[SRC_BF16 ? 0 : m][bj][0]; x1 = xf[SRC_BF16 ? 0 : m][bj][1]; }
                    const f32x4 v0 = x0 + gv[bj][0] * acc[ai][bj][m][0], v1 = x1 + gv[bj][1] * acc[ai][bj][m][1];
                    u32x4 w; w.x = cvt_pk_bf16(v0[0], v0[1]); w.y = cvt_pk_bf16(v0[2], v0[3]); w.z = cvt_pk_bf16(v1[0], v1[1]); w.w = cvt_pk_bf16(v1[2], v1[3]);
                    *(u32x4*)(dp + bj * HALF) = w;
#pragma unroll
                    for (int j = 0; j < 4; ++j) { const float lo = __uint_as_float(w[j] << 16), hi = __uint_as_float(w[j] & 0xffff0000u); ss += lo * lo + hi * hi; } }
                { const int ln_ = fq * 16 + fr; ss += __int_as_float(__builtin_amdgcn_ds_bpermute((ln_ ^ 16) << 2, __float_as_int(ss))); ss += __int_as_float(__builtin_amdgcn_ds_bpermute((ln_ ^ 32) << 2, __float_as_int(ss))); }
                if (fq == 0) xss[(size_t)rr * 16 + u.pn * 4 + wc] = ss; }
        }
    }
};
template <class Epi, class Sched, bool STAMP = false, bool SP2 = PG8_SP2, int SCW = -1>
__device__ __forceinline__ void gemm_phase(PG8_LAS unsigned char* lds, const Gemm g, const Sched& S, const Epi& E, unsigned long long* stamps) {
    int tid_l = __builtin_amdgcn_readfirstlane(threadIdx.x >> 6) * 64 + (int)__builtin_amdgcn_mbcnt_hi(~0u, __builtin_amdgcn_mbcnt_lo(~0u, 0u)); asm volatile("" : "+v"(tid_l));
    const int tid = tid_l, wid = __builtin_amdgcn_readfirstlane(tid >> 6), lane = tid & 63, wr = wid >> 2, wc = wid & 3, fr = lane & 15, fq = lane >> 4;
    const int K = g.K, nt = K / BK;
    int ts_lo = 0, ts_hi = 0, nts = 0; const unsigned long long rt_entry = STAMP ? (unsigned long long)wall_clock64() : 0ull;
#define PG8_STAMP() do { if (STAMP && wid == 0 && nts < 64) { const unsigned long long _c = (unsigned long long)clock64(); \
        ts_lo = (lane == nts) ? (int)(unsigned)_c : ts_lo; ts_hi = (lane == nts) ? (int)(unsigned)(_c >> 32) : ts_hi; ++nts; } } while (0)
    PG8_STAMP();
    unsigned voffA[2], voffB[2];
#pragma unroll
    for (int i = 0; i < 2; ++i) { int R, C; stage_rc(tid * 16 + i * 8192, R, C); const int Rb = Epi::PERM ? ((R & ~31) + perm32(R & 31)) : R;
        voffA[i] = (unsigned)(R * K + C) * 2u; voffB[i] = (unsigned)(Rb * K + C) * 2u; }
    const size_t kstep = (size_t)(BK * 2);
    const size_t hstep = (size_t)HALF * K * 2;
    const size_t tstep = 2 * hstep;
    const unsigned ldsw = (unsigned)wid * 1024u;
    const int aoff = lds_byte(wr * 64 + fr, fq * 8), boff = lds_byte(wc * 32 + fr, fq * 8);
#define PG8_SA(b, h) (((b) * 2 + (h)) * HTB)
#define PG8_SB(b, h) ((4 + (b) * 2 + (h)) * HTB)
#define PG8_STAGE(bufoff, gbase, voff) do { _Pragma("unroll") for (int _i = 0; _i < 2; ++_i) \
        __builtin_amdgcn_global_load_lds((const unsigned*)((const char*)(gbase) + (voff)[_i]), (PG8_LAS unsigned*)(lds + (bufoff) + ldsw + _i * 8192), 16, 0, 0); } while (0)
#define PG8_LDA(dst, b, h) do { _Pragma("unroll") for (int m = 0; m < 4; ++m) _Pragma("unroll") for (int k = 0; k < 2; ++k) dst[m][k] = *(const PG8_LAS bf16x8*)(lds + PG8_SA(b, h) + aoff + m * 2048 + k * 1024); } while (0)
#define PG8_LDB(dst, b, h) do { _Pragma("unroll") for (int n = 0; n < 2; ++n) _Pragma("unroll") for (int k = 0; k < 2; ++k) dst[n][k] = *(const PG8_LAS bf16x8*)(lds + PG8_SB(b, h) + boff + n * 2048 + k * 1024); } while (0)
#define PG8_MMA(ai, bj, At, Bt) do { __builtin_amdgcn_s_setprio(1); _Pragma("unroll") for (int m = 0; m < 4; ++m) _Pragma("unroll") for (int n = 0; n < 2; ++n) { \
        if constexpr (SCW >= 0) mfma8(acc[ai][bj][m][n], cat8(Bt[n][0], Bt[n][1]), cat8(At[m][0], At[m][1])); \
        else { _Pragma("unroll") for (int k = 0; k < 2; ++k) acc[ai][bj][m][n] = __builtin_amdgcn_mfma_f32_16x16x32_bf16(Bt[n][k], At[m][k], acc[ai][bj][m][n], 0, 0, 0); } } __builtin_amdgcn_s_setprio(0); } while (0)
#define PG8_WAIT_V(n) asm volatile("s_waitcnt vmcnt(" #n ")" ::: "memory")
#define PG8_WAIT_L(n) asm volatile("s_waitcnt lgkmcnt(" #n ")" ::: "memory")
#define PG8_BAR __builtin_amdgcn_s_barrier()
#define PG8_SCHED __builtin_amdgcn_sched_barrier(0)
    Unit cur, nxt; int ui = 0;
    if (!S.next(0, cur)) return;
    f32x4 acc[2][2][4][2];
#pragma unroll
    for (int a = 0; a < 2; ++a)
#pragma unroll
        for (int b = 0; b < 2; ++b)
#pragma unroll
            for (int m = 0; m < 4; ++m)
#pragma unroll
                for (int n = 0; n < 2; ++n) acc[a][b][m][n] = (f32x4){0.f, 0.f, 0.f, 0.f};
    bf16x8 At[4][2], B0[2][2], B1[2][2];
    const char* cA = (const char*)g.A + (size_t)cur.pm * tstep; const char* cB = (const char*)g.Bt + (size_t)cur.pn * tstep;
    S.a_ready(cur);
    if constexpr (Epi::MIDK) E.prep(lds, S, tid);
    if constexpr (SP2) {
        PG8_STAGE(PG8_SB(0, 0), cB, voffB); PG8_STAGE(PG8_SB(0, 1), cB + hstep, voffB); PG8_STAGE(PG8_SA(0, 0), cA, voffA); PG8_STAGE(PG8_SA(0, 1), cA + hstep, voffA);
        if (wr == 1) PG8_BAR;
        PG8_WAIT_V(2); PG8_BAR;
        PG8_STAGE(PG8_SB(1, 0), cB + kstep, voffB); PG8_STAGE(PG8_SA(1, 0), cA + kstep, voffA); PG8_STAGE(PG8_SB(1, 1), cB + hstep + kstep, voffB);
        PG8_WAIT_V(6); PG8_BAR;
    } else {
    PG8_STAGE(PG8_SB(0, 0), cB, voffB); PG8_STAGE(PG8_SA(0, 0), cA, voffA); PG8_STAGE(PG8_SB(0, 1), cB + hstep, voffB); PG8_STAGE(PG8_SA(0, 1), cA + hstep, voffA);
    if (wr == 1) PG8_BAR;
    PG8_WAIT_V(4); PG8_BAR;
    PG8_STAGE(PG8_SB(1, 0), cB + kstep, voffB); PG8_STAGE(PG8_SA(1, 0), cA + kstep, voffA); PG8_STAGE(PG8_SB(1, 1), cB + hstep + kstep, voffB);
    PG8_WAIT_V(6); PG8_BAR;
    }
    PG8_STAMP();
    for (;;) {
        const bool has_next = S.next(ui + 1, nxt);
        const char* nA = has_next ? (const char*)g.A + (size_t)nxt.pm * tstep : cA; const char* nB = has_next ? (const char*)g.Bt + (size_t)nxt.pn * tstep : cB;
        for (int t = 0; t < nt; t += 2) {
            const bool last = (t == nt - 2);
            const char* a1 = cA + (size_t)(t + 1) * kstep;
            const char* a2 = last ? nA : cA + (size_t)(t + 2) * kstep; const char* b2 = last ? nB : cB + (size_t)(t + 2) * kstep;
            const char* a3 = a2 + kstep; const char* b3 = b2 + kstep;
            if (last && has_next) S.a_ready(nxt);
            if constexpr (SP2) {
            PG8_LDB(B0, 0, 0); PG8_LDB(B1, 0, 1); PG8_SCHED; PG8_LDA(At, 0, 0); PG8_STAGE(PG8_SA(1, 1), a1 + hstep, voffA);
            PG8_WAIT_V(8); PG8_WAIT_L(0); PG8_BAR; PG8_MMA(0, 0, At, B0); PG8_MMA(0, 1, At, B1); PG8_BAR; PG8_SCHED;
            PG8_LDA(At, 0, 1); PG8_STAGE(PG8_SB(0, 0), b2, voffB); PG8_STAGE(PG8_SB(0, 1), b2 + hstep, voffB); PG8_STAGE(PG8_SA(0, 0), a2, voffA);
            PG8_WAIT_V(8); PG8_WAIT_L(0); PG8_BAR; PG8_MMA(1, 0, At, B0); PG8_MMA(1, 1, At, B1); PG8_BAR; PG8_SCHED;
            PG8_LDB(B0, 1, 0); PG8_LDB(B1, 1, 1); PG8_SCHED; PG8_LDA(At, 1, 0); PG8_STAGE(PG8_SA(0, 1), a2 + hstep, voffA);
            PG8_WAIT_V(8); PG8_WAIT_L(0); PG8_BAR; PG8_MMA(0, 0, At, B0); PG8_MMA(0, 1, At, B1); PG8_BAR; PG8_SCHED;
            PG8_LDA(At, 1, 1); PG8_STAGE(PG8_SB(1, 0), b3, voffB); PG8_STAGE(PG8_SB(1, 1), b3 + hstep, voffB); PG8_STAGE(PG8_SA(1, 0), a3, voffA);
            PG8_WAIT_V(8); PG8_WAIT_L(0); PG8_BAR; PG8_MMA(1, 0, At, B0); PG8_MMA(1, 1, At, B1); PG8_BAR; PG8_SCHED;
            } else {
            PG8_LDB(B0, 0, 0); PG8_SCHED; PG8_LDA(At, 0, 0); PG8_STAGE(PG8_SA(1, 1), a1 + hstep, voffA);
            PG8_WAIT_L(8); PG8_BAR; PG8_WAIT_L(0); PG8_MMA(0, 0, At, B0); PG8_BAR; PG8_SCHED;
            PG8_LDB(B1, 0, 1); PG8_STAGE(PG8_SB(0, 0), b2, voffB);
            PG8_BAR; PG8_WAIT_L(0); PG8_MMA(0, 1, At, B1); PG8_BAR;
            PG8_LDA(At, 0, 1); PG8_STAGE(PG8_SA(0, 0), a2, voffA);
            PG8_BAR; PG8_WAIT_L(0); PG8_MMA(1, 0, At, B0); PG8_BAR; PG8_SCHED;
            PG8_STAGE(PG8_SB(0, 1), b2 + hstep, voffB);
            PG8_WAIT_V(6); PG8_BAR; PG8_MMA(1, 1, At, B1); PG8_BAR;
            PG8_LDB(B0, 1, 0); PG8_SCHED; PG8_LDA(At, 1, 0); PG8_STAGE(PG8_SA(0, 1), a2 + hstep, voffA);
            PG8_WAIT_L(8); PG8_BAR; PG8_WAIT_L(0); PG8_MMA(0, 0, At, B0); PG8_BAR; PG8_SCHED;
            PG8_LDB(B1, 1, 1); PG8_STAGE(PG8_SB(1, 0), b3, voffB);
            PG8_BAR; PG8_WAIT_L(0); PG8_MMA(0, 1, At, B1); PG8_BAR;
            PG8_LDA(At, 1, 1); PG8_STAGE(PG8_SA(1, 0), a3, voffA);
            PG8_BAR; PG8_WAIT_L(0); PG8_MMA(1, 0, At, B0); PG8_BAR; PG8_SCHED;
            PG8_STAGE(PG8_SB(1, 1), b3 + hstep, voffB);
            PG8_WAIT_V(6); PG8_BAR; PG8_MMA(1, 1, At, B1); PG8_BAR;
            }
            if constexpr (Epi::MIDK) { if (t + 2 == nt / 2) E.midk(acc, lds, ui, wr, fr); }
        }
        PG8_STAMP();
        if (wr == 0) PG8_BAR;
        if constexpr (SCW >= 0) asm volatile("s_nop 15\n\ts_nop 15" ::: "memory");
        if constexpr (!Epi::AFTER_DRAIN) { E(acc, cur, wr, wc, fr, fq); S.done(cur); }
        PG8_STAMP();
        if (!has_next) break;
#pragma unroll
        for (int a = 0; a < 2; ++a)
#pragma unroll
            for (int b = 0; b < 2; ++b)
#pragma unroll
                for (int m = 0; m < 4; ++m)
#pragma unroll
                    for (int n = 0; n < 2; ++n) acc[a][b][m][n] = (f32x4){0.f, 0.f, 0.f, 0.f};
        cur = nxt; cA = nA; cB = nB; ++ui;
        if (wr == 1) PG8_BAR;
    }
    PG8_WAIT_V(0);
    PG8_BAR;
    if constexpr (Epi::AFTER_DRAIN) { E.fused(acc, cur, wr, wc, fr, fq, lds, wid, lane); S.done(cur); }
    PG8_STAMP();
    if (STAMP && wid == 0) { stamps[lane] = lane < nts ? (((unsigned long long)(unsigned)ts_hi << 32) | (unsigned)ts_lo) : 0ull;
        if (lane == 62) stamps[62] = rt_entry; if (lane == 63) stamps[63] = (unsigned long long)wall_clock64(); }
#undef PG8_STAMP
#undef PG8_SA
#undef PG8_SB
#undef PG8_STAGE
#undef PG8_LDA
#undef PG8_LDB
#undef PG8_MMA
#undef PG8_WAIT_V
#undef PG8_WAIT_L
#undef PG8_BAR
#undef PG8_SCHED
}

struct MoeUnit { int e, mt, pn, cnt, pstart; };
struct MoeSched {
    typedef MoeUnit UnitT;
    PG8_LAS const int* tab; const int* map; int U, G, c, npn, gather; size_t bstride;
    __device__ __forceinline__ bool next(int i, MoeUnit& u) const {
        const long L = (long)i * G + c; if (L >= U) return false;
        int idx = (int)L; { const int q = U / NXCD, r = U % NXCD, xcd = idx % NXCD, off = idx / NXCD; idx = (xcd < r ? xcd * (q + 1) : r * (q + 1) + (xcd - r) * q) + off; }
        const int tau = idx / npn; u.pn = idx - tau * npn;
        int e = 0;
#pragma unroll
        for (int st = 16; st >= 1; st >>= 1) { if (__builtin_amdgcn_readfirstlane(tab[e + st]) <= tau) e += st; }
        u.e = e; u.mt = tau - __builtin_amdgcn_readfirstlane(tab[e]); u.cnt = __builtin_amdgcn_readfirstlane(tab[33 + e]); u.pstart = __builtin_amdgcn_readfirstlane(tab[65 + e]);
        return true;
    }
    __device__ __forceinline__ const char* bbase(const Gemm& g, const MoeUnit& u) const { return (const char*)g.Bt + (size_t)u.e * bstride + (size_t)u.pn * BM * g.K * 2; }
    __device__ __forceinline__ void a_offsets(const Gemm& g, const MoeUnit& u, int tid, unsigned (&va)[2][2]) const {
        int tl = tid; asm volatile("" : "+v"(tl));
        int RA[2], CA[2];
#pragma unroll
        for (int i = 0; i < 2; ++i) { int R, C; stage_rc(tl * 16 + i * 8192, R, C); RA[i] = R; CA[i] = C * 2; }
#pragma unroll
        for (int hf = 0; hf < 2; ++hf)
#pragma unroll
            for (int i = 0; i < 2; ++i) { int rl = u.mt * BM + hf * HALF + RA[i]; rl = rl < u.cnt ? rl : u.cnt - 1;
                const unsigned row = gather ? (unsigned)map[(size_t)u.e * 34816 + rl] : (unsigned)(u.pstart + rl);
                va[hf][i] = row * (unsigned)(g.K * 2) + (unsigned)CA[i]; }
    }
};
struct EpiAct {
    static constexpr bool PERM = true, AFTER_DRAIN = false;
    unsigned char* O;
    __device__ __forceinline__ void operator()(const f32x4 (&acc)[2][2][4][2], const MoeUnit& u, int wr, int wc, int fr, int fq) const {
        typedef unsigned u32x2 __attribute__((ext_vector_type(2)));
        const int rl0 = u.mt * BM + wr * 64 + fr, col0 = u.pn * HALF + wc * 32 + 8 * fq;
#pragma unroll
        for (int ai = 0; ai < 2; ++ai)
#pragma unroll
            for (int m = 0; m < 4; ++m) { const int rl = rl0 + ai * HALF + m * 16;
                if (rl < u.cnt) { f32x4 o[2];
#pragma unroll
                    for (int n = 0; n < 2; ++n)
#pragma unroll
                        for (int j = 0; j < 4; ++j) { const float gv = acc[ai][0][m][n][j] * (1.0f / 64.0f)  ; o[n][j] = gv * __builtin_amdgcn_rcpf(1.0f + __builtin_amdgcn_exp2f(-1.4426950408889634f * gv)) * (acc[ai][1][m][n][j] * 0.125f)  ; }
                    *(u32x2*)(O + (size_t)(u.pstart + rl) * 512 + col0) = (u32x2){pk4_fp8(o[0]), pk4_fp8(o[1])}; } }
    }
};
struct EpiY {
    static constexpr bool PERM = true, AFTER_DRAIN = false;
    unsigned char* O;
    static __device__ __forceinline__ unsigned pk4(const f32x4 v) { const float lim = 440.f;
        int w = __builtin_amdgcn_cvt_pk_fp8_f32(fminf(fmaxf(v[0], -lim), lim), fminf(fmaxf(v[1], -lim), lim), 0, false);
        return (unsigned)__builtin_amdgcn_cvt_pk_fp8_f32(fminf(fmaxf(v[2], -lim), lim), fminf(fmaxf(v[3], -lim), lim), w, true); }
    __device__ __forceinline__ void operator()(const f32x4 (&acc)[2][2][4][2], const MoeUnit& u, int wr, int wc, int fr, int fq) const {
        typedef unsigned u32x2 __attribute__((ext_vector_type(2)));
        const int rl0 = u.mt * BM + wr * 64 + fr, col0 = u.pn * BM + wc * 32 + 8 * fq;
#pragma unroll
        for (int ai = 0; ai < 2; ++ai)
#pragma unroll
            for (int m = 0; m < 4; ++m) { const int rl = rl0 + ai * HALF + m * 16;
                if (rl < u.cnt) { unsigned char* rowp = O + (size_t)(u.pstart + rl) * 1024 + col0;
#pragma unroll
                    for (int bj = 0; bj < 2; ++bj) *(u32x2*)(rowp + bj * HALF) = (u32x2){pk4(acc[ai][bj][m][0] * (1.0f / 512.0f)), pk4(acc[ai][bj][m][1] * (1.0f / 512.0f))}; } }
    }
};
template <class Epi, class Sched, bool STAMP = false, bool SP2 = PG8_SP2, int SCW = -1, int SCA = 127>
__device__ __forceinline__ void gemm_phase_moe(PG8_LAS unsigned char* lds, const Gemm g, const Sched& S, const Epi& E, unsigned long long* stamps) {
    int tid_l = __builtin_amdgcn_readfirstlane(threadIdx.x >> 6) * 64 + (int)__builtin_amdgcn_mbcnt_hi(~0u, __builtin_amdgcn_mbcnt_lo(~0u, 0u)); asm volatile("" : "+v"(tid_l));
    const int tid = tid_l, wid = __builtin_amdgcn_readfirstlane(tid >> 6), lane = tid & 63, wr = wid >> 2, wc = wid & 3, fr = lane & 15, fq = lane >> 4;
    const int K = g.K, nt = K / BK;
    int ts_lo = 0, ts_hi = 0, nts = 0; const unsigned long long rt_entry = STAMP ? (unsigned long long)wall_clock64() : 0ull;
#define PG8_STAMP() do { if (STAMP && wid == 0 && nts < 64) { const unsigned long long _c = (unsigned long long)clock64(); \
        ts_lo = (lane == nts) ? (int)(unsigned)_c : ts_lo; ts_hi = (lane == nts) ? (int)(unsigned)(_c >> 32) : ts_hi; ++nts; } } while (0)
    PG8_STAMP();
    unsigned voffB[2];
#pragma unroll
    for (int i = 0; i < 2; ++i) { int R, C; stage_rc(tid * 16 + i * 8192, R, C); const int Rb = Epi::PERM ? ((R & ~31) + perm32(R & 31)) : R;
        voffB[i] = (unsigned)(Rb * K + C) * 2u; }
    unsigned vaC[2][2];
    PG8_LAS unsigned* vtab = (PG8_LAS unsigned*)(lds + STAGE_BYTES + 1024) + tid;
    const size_t kstep = (size_t)(BK * 2);
    const size_t hstep = (size_t)HALF * K * 2;
    const size_t tstep = 2 * hstep;
    const unsigned ldsw = (unsigned)wid * 1024u;
    const int aoff = lds_byte(wr * 64 + fr, fq * 8), boff = lds_byte(wc * 32 + fr, fq * 8);
#define PG8_SA(b, h) (((b) * 2 + (h)) * HTB)
#define PG8_SB(b, h) ((4 + (b) * 2 + (h)) * HTB)
#define PG8_STAGE(bufoff, gbase, voff) do { _Pragma("unroll") for (int _i = 0; _i < 2; ++_i) \
        __builtin_amdgcn_global_load_lds((const unsigned*)((const char*)(gbase) + (voff)[_i]), (PG8_LAS unsigned*)(lds + (bufoff) + ldsw + _i * 8192), 16, 0, 0); } while (0)
#define PG8_STAGEA(bufoff, kbyte, va) do { _Pragma("unroll") for (int _i = 0; _i < 2; ++_i) \
        __builtin_amdgcn_global_load_lds((const unsigned*)((const char*)g.A + (kbyte) + (va)[_i]), (PG8_LAS unsigned*)(lds + (bufoff) + ldsw + _i * 8192), 16, 0, 0); } while (0)
#define PG8_LDA(dst, b, h) do { _Pragma("unroll") for (int m = 0; m < 4; ++m) _Pragma("unroll") for (int k = 0; k < 2; ++k) dst[m][k] = *(const PG8_LAS bf16x8*)(lds + PG8_SA(b, h) + aoff + m * 2048 + k * 1024); } while (0)
#define PG8_LDB(dst, b, h) do { _Pragma("unroll") for (int n = 0; n < 2; ++n) _Pragma("unroll") for (int k = 0; k < 2; ++k) dst[n][k] = *(const PG8_LAS bf16x8*)(lds + PG8_SB(b, h) + boff + n * 2048 + k * 1024); } while (0)
#define PG8_MMA(ai, bj, At, Bt) do { __builtin_amdgcn_s_setprio(1); _Pragma("unroll") for (int m = 0; m < 4; ++m) _Pragma("unroll") for (int n = 0; n < 2; ++n) { \
        if constexpr (SCW >= 0) mfma8(acc[ai][bj][m][n], cat8(Bt[n][0], Bt[n][1]), cat8(At[m][0], At[m][1])); \
        else { _Pragma("unroll") for (int k = 0; k < 2; ++k) acc[ai][bj][m][n] = __builtin_amdgcn_mfma_f32_16x16x32_bf16(Bt[n][k], At[m][k], acc[ai][bj][m][n], 0, 0, 0); } } __builtin_amdgcn_s_setprio(0); } while (0)
#define PG8_WAIT_V(n) asm volatile("s_waitcnt vmcnt(" #n ")" ::: "memory")
#define PG8_WAIT_L(n) asm volatile("s_waitcnt lgkmcnt(" #n ")" ::: "memory")
#define PG8_BAR __builtin_amdgcn_s_barrier()
#define PG8_SCHED __builtin_amdgcn_sched_barrier(0)
    typename Sched::UnitT cur, nxt; int ui = 0;
    if (!S.next(0, cur)) return;
    f32x4 acc[2][2][4][2];
#pragma unroll
    for (int a = 0; a < 2; ++a)
#pragma unroll
        for (int b = 0; b < 2; ++b)
#pragma unroll
            for (int m = 0; m < 4; ++m)
#pragma unroll
                for (int n = 0; n < 2; ++n) acc[a][b][m][n] = (f32x4){0.f, 0.f, 0.f, 0.f};
    bf16x8 At[4][2], B0[2][2], B1[2][2];
    const char* cB = S.bbase(g, cur); S.a_offsets(g, cur, tid, vaC);
    if constexpr (SP2) {
        PG8_STAGE(PG8_SB(0, 0), cB, voffB); PG8_STAGE(PG8_SB(0, 1), cB + hstep, voffB); PG8_STAGEA(PG8_SA(0, 0), 0, vaC[0]); PG8_STAGEA(PG8_SA(0, 1), 0, vaC[1]);
        if (wr == 1) PG8_BAR;
        PG8_WAIT_V(2); PG8_BAR;
        PG8_STAGE(PG8_SB(1, 0), cB + kstep, voffB); PG8_STAGEA(PG8_SA(1, 0), kstep, vaC[0]); PG8_STAGE(PG8_SB(1, 1), cB + hstep + kstep, voffB);
        PG8_WAIT_V(6); PG8_BAR;
    } else {
    PG8_STAGE(PG8_SB(0, 0), cB, voffB); PG8_STAGEA(PG8_SA(0, 0), 0, vaC[0]); PG8_STAGE(PG8_SB(0, 1), cB + hstep, voffB); PG8_STAGEA(PG8_SA(0, 1), 0, vaC[1]);
    if (wr == 1) PG8_BAR;
    PG8_WAIT_V(4); PG8_BAR;
    PG8_STAGE(PG8_SB(1, 0), cB + kstep, voffB); PG8_STAGEA(PG8_SA(1, 0), kstep, vaC[0]); PG8_STAGE(PG8_SB(1, 1), cB + hstep + kstep, voffB);
    PG8_WAIT_V(6); PG8_BAR;
    }
    PG8_STAMP();
    for (;;) {
        const bool has_next = S.next(ui + 1, nxt);
        const char* nB = has_next ? S.bbase(g, nxt) : cB;
        { unsigned vaN[2][2];
          if (has_next) S.a_offsets(g, nxt, tid, vaN); else {
#pragma unroll
            for (int hf = 0; hf < 2; ++hf)
#pragma unroll
                for (int i = 0; i < 2; ++i) vaN[hf][i] = vaC[hf][i]; }
#pragma unroll
          for (int hf = 0; hf < 2; ++hf)
#pragma unroll
              for (int i = 0; i < 2; ++i) vtab[(hf * 2 + i) * 512] = vaN[hf][i]; }
        unsigned v2[2][2];
        for (int t = 0; t < nt; t += 2) {
            const bool last = (t == nt - 2);
            const size_t k1 = (size_t)(t + 1) * kstep, k2 = last ? (size_t)0 : (size_t)(t + 2) * kstep, k3 = k2 + kstep;
            const char* b2 = last ? nB : cB + (size_t)(t + 2) * kstep; const char* b3 = b2 + kstep;
#pragma unroll
            for (int hf = 0; hf < 2; ++hf)
#pragma unroll
                for (int i = 0; i < 2; ++i) v2[hf][i] = last ? vtab[(hf * 2 + i) * 512] : vaC[hf][i];
            if constexpr (SP2) {
            PG8_LDB(B0, 0, 0); PG8_LDB(B1, 0, 1); PG8_SCHED; PG8_LDA(At, 0, 0); PG8_STAGEA(PG8_SA(1, 1), k1, vaC[1]);
            PG8_WAIT_V(8); PG8_WAIT_L(0); PG8_BAR; PG8_MMA(0, 0, At, B0); PG8_MMA(0, 1, At, B1); PG8_BAR; PG8_SCHED;
            PG8_LDA(At, 0, 1); PG8_STAGE(PG8_SB(0, 0), b2, voffB); PG8_STAGE(PG8_SB(0, 1), b2 + hstep, voffB); PG8_STAGEA(PG8_SA(0, 0), k2, v2[0]);
            PG8_WAIT_V(8); PG8_WAIT_L(0); PG8_BAR; PG8_MMA(1, 0, At, B0); PG8_MMA(1, 1, At, B1); PG8_BAR; PG8_SCHED;
            PG8_LDB(B0, 1, 0); PG8_LDB(B1, 1, 1); PG8_SCHED; PG8_LDA(At, 1, 0); PG8_STAGEA(PG8_SA(0, 1), k2, v2[1]);
            PG8_WAIT_V(8); PG8_WAIT_L(0); PG8_BAR; PG8_MMA(0, 0, At, B0); PG8_MMA(0, 1, At, B1); PG8_BAR; PG8_SCHED;
            PG8_LDA(At, 1, 1); PG8_STAGE(PG8_SB(1, 0), b3, voffB); PG8_STAGE(PG8_SB(1, 1), b3 + hstep, voffB); PG8_STAGEA(PG8_SA(1, 0), k3, v2[0]);
            PG8_WAIT_V(8); PG8_WAIT_L(0); PG8_BAR; PG8_MMA(1, 0, At, B0); PG8_MMA(1, 1, At, B1); PG8_BAR; PG8_SCHED;
            } else {
            PG8_LDB(B0, 0, 0); PG8_SCHED; PG8_LDA(At, 0, 0); PG8_STAGEA(PG8_SA(1, 1), k1, vaC[1]);
            PG8_WAIT_L(8); PG8_BAR; PG8_WAIT_L(0); PG8_MMA(0, 0, At, B0); PG8_BAR; PG8_SCHED;
            PG8_LDB(B1, 0, 1); PG8_STAGE(PG8_SB(0, 0), b2, voffB);
            PG8_BAR; PG8_WAIT_L(0); PG8_MMA(0, 1, At, B1); PG8_BAR;
            PG8_LDA(At, 0, 1); PG8_STAGEA(PG8_SA(0, 0), k2, v2[0]);
            PG8_BAR; PG8_WAIT_L(0); PG8_MMA(1, 0, At, B0); PG8_BAR; PG8_SCHED;
            PG8_STAGE(PG8_SB(0, 1), b2 + hstep, voffB);
            PG8_WAIT_V(6); PG8_BAR; PG8_MMA(1, 1, At, B1); PG8_BAR;
            PG8_LDB(B0, 1, 0); PG8_SCHED; PG8_LDA(At, 1, 0); PG8_STAGEA(PG8_SA(0, 1), k2, v2[1]);
            PG8_WAIT_L(8); PG8_BAR; PG8_WAIT_L(0); PG8_MMA(0, 0, At, B0); PG8_BAR; PG8_SCHED;
            PG8_LDB(B1, 1, 1); PG8_STAGE(PG8_SB(1, 0), b3, voffB);
            PG8_BAR; PG8_WAIT_L(0); PG8_MMA(0, 1, At, B1); PG8_BAR;
            PG8_LDA(At, 1, 1); PG8_STAGEA(PG8_SA(1, 0), k3, v2[0]);
            PG8_BAR; PG8_WAIT_L(0); PG8_MMA(1, 0, At, B0); PG8_BAR; PG8_SCHED;
            PG8_STAGE(PG8_SB(1, 1), b3 + hstep, voffB);
            PG8_WAIT_V(6); PG8_BAR; PG8_MMA(1, 1, At, B1); PG8_BAR;
            }
        }
        PG8_STAMP();
        if (wr == 0) PG8_BAR;
        if constexpr (SCW >= 0) asm volatile("s_nop 15\n\ts_nop 15" ::: "memory");
        E(acc, cur, wr, wc, fr, fq);
        PG8_STAMP();
        if (!has_next) break;
#pragma unroll
        for (int a = 0; a < 2; ++a)
#pragma unroll
            for (int b = 0; b < 2; ++b)
#pragma unroll
                for (int m = 0; m < 4; ++m)
#pragma unroll
                    for (int n = 0; n < 2; ++n) acc[a][b][m][n] = (f32x4){0.f, 0.f, 0.f, 0.f};
        cur = nxt; cB = nB; ++ui;
#pragma unroll
        for (int hf = 0; hf < 2; ++hf)
#pragma unroll
            for (int i = 0; i < 2; ++i) vaC[hf][i] = v2[hf][i];
        if (wr == 1) PG8_BAR;
    }
    PG8_WAIT_V(0);
    PG8_BAR;
    PG8_STAMP();
    if (STAMP && wid == 0) { stamps[lane] = lane < nts ? (((unsigned long long)(unsigned)ts_hi << 32) | (unsigned)ts_lo) : 0ull;
        if (lane == 62) stamps[62] = rt_entry; if (lane == 63) stamps[63] = (unsigned long long)wall_clock64(); }
#undef PG8_STAMP
#undef PG8_SA
#undef PG8_SB
#undef PG8_STAGE
#undef PG8_STAGEA
#undef PG8_LDA
#undef PG8_LDB
#undef PG8_MMA
#undef PG8_WAIT_V
#undef PG8_WAIT_L
#undef PG8_BAR
#undef PG8_SCHED
}
}

constexpr int NTHR = 512, NWV = 8, LDS_BYTES = 147456;

struct P {
    const float *x, *c, *ctx, *c_ctx, *w_mod, *b_mod, *norm1_g, *norm2_g, *w_in, *conv_w, *conv_b, *dt_bias_f, *dt_bias_b, *a_log_f, *a_log_b, *d_skip, *ssd_norm_g,
        *gk_up_f, *gk_bias_f, *gk_up_b, *gk_bias_b, *gla_norm_g, *w_out, *w_router, *router_bias, *w_gate, *w_up, *w_down, *final_g;
    float* out; bf16_t* XB; bf16_t* H; bf16_t* PROJ; bf16_t* SS; bf16_t* GS; float* SDEC; float* GDEC; float* MOD; int* counts; int* TOKSLOT; float* EW; int* MAP; bf16_t* WinT; bf16_t* WoutT; bf16_t* WguT; bf16_t* WdT; bf16_t* WRT; unsigned* BAR; bf16_t* XBCC; bf16_t* QKB; float* SSC; float* STOT; float* SSQ; float* XSS;
};

DI void ph_init(const P& p) { const size_t i = (size_t)blockIdx.x * NTHR + ltid(); if (i < 64) p.counts[i * 32] = 0; }

DI void ph_mod(const P& p, float* s  ) {
    const int tid_ = ltid(), lane = tid_ & 63, w = tid_ >> 6;
    if (blockIdx.x >= 192) return;
    float* part = s + 9 * 1024;
    { float cv[18];
#pragma unroll
      for (int q = 0; q < 18; ++q) { const int i = tid_ + q * NTHR, r = i >> 10, k = i & 1023; cv[q] = r < 8 ? p.c[r * 1024 + k] : p.c_ctx[k]; }
#pragma unroll
      for (int q = 0; q < 18; ++q) s[tid_ + q * NTHR] = siluf(cv[q]); }
    __syncthreads();
    for (int vb = blockIdx.x; vb < 192; vb += gridDim.x) {
        const int l = vb / 96, n = (vb % 96) * 64 + lane;
        float acc[9];
#pragma unroll
        for (int r = 0; r < 9; ++r) acc[r] = 0.f;
        const float* wp = p.w_mod + (size_t)l * 1024 * 6144 + (size_t)(128 * w) * 6144 + n;
#pragma unroll 8
        for (int k = 0; k < 128; ++k) { const float wv = wp[(size_t)k * 6144];
#pragma unroll
            for (int r = 0; r < 9; ++r) acc[r] += s[r * 1024 + 128 * w + k] * wv; }
#pragma unroll
        for (int r = 0; r < 9; ++r) part[(w * 9 + r) * 64 + lane] = acc[r];
        __syncthreads();
        for (int o = tid_; o < 9 * 64; o += NTHR) { const int r = o >> 6, c = o & 63; float a = p.b_mod[l * 6144 + (vb % 96) * 64 + c];
#pragma unroll
            for (int q = 0; q < 8; ++q) a += part[(q * 9 + r) * 64 + c];
            p.MOD[((size_t)l * 9 + r) * 6144 + (vb % 96) * 64 + c] = a; }
        __syncthreads();
    }
}

DI unsigned pk2(float lo, float hi) { return __builtin_bit_cast(unsigned, __builtin_convertvector((f32x2v_){lo, hi}, bf16x2v_)); }
template <bool F8 = false> DI void transpose_item(const float* W, int K, int N, bf16_t* WT, float* scr, int item, int lane, int gu = -1, const float* kscale = nullptr) {
    const int nblk = (N + 31) / 32, kb = item / nblk, nb = item % nblk, k0 = 64 * kb, n0 = 32 * nb;
    const int d0 = gu < 0 ? n0 : 256 * (n0 >> 7) + (n0 & 127) + 128 * gu;
    const bool nok = n0 + (lane & 31) < N;
    float wv_[32];
#pragma unroll
    for (int i = 0; i < 32; ++i) { const int kk = 2 * i + (lane >> 5); wv_[i] = nok ? __builtin_nontemporal_load(W + (size_t)(k0 + kk) * N + n0 + (lane & 31)) : 0.f; }
#pragma unroll
    for (int i = 0; i < 32; ++i) { const int kk = 2 * i + (lane >> 5); scr[kk * 33 + (lane & 31)] = wv_[i] * (kscale ? kscale[k0 + kk] : 1.0f); }
    const int c = lane & 7;
#pragma unroll
    for (int j = 0; j < 4; ++j) { const int n = (lane >> 3) + 8 * j; const float* q = scr + (8 * c) * 33 + n;
        if constexpr (F8) { typedef unsigned u32x2nt __attribute__((ext_vector_type(2)));
            const u32x2nt o = {pg8::pk4_fp8((pg8::f32x4){q[0 * 33], q[1 * 33], q[2 * 33], q[3 * 33]} * 64.0f), pg8::pk4_fp8((pg8::f32x4){q[4 * 33], q[5 * 33], q[6 * 33], q[7 * 33]} * 64.0f)};
            if (n0 + n < N) __builtin_nontemporal_store(o, (u32x2nt*)((unsigned char*)WT + (size_t)(d0 + n) * K + k0 + 8 * c)); }
        else {
        uint4 o; o.x = pk2(q[0 * 33], q[1 * 33]); o.y = pk2(q[2 * 33], q[3 * 33]); o.z = pk2(q[4 * 33], q[5 * 33]); o.w = pk2(q[6 * 33], q[7 * 33]);
        if (n0 + n < N) { typedef unsigned u32x4nt __attribute__((ext_vector_type(4))); __builtin_nontemporal_store((u32x4nt){o.x, o.y, o.z, o.w}, (u32x4nt*)(WT + (size_t)(d0 + n) * K + k0 + 8 * c)); } } }
}

struct TrD { const float* src; unsigned char* dst; int N, K; bool ok; };
DI TrD tr_desc(const P& p, int l, int it, int it1, int lane) {
    TrD d; d.ok = it < it1; const int itc = d.ok ? it : it1 - 1;
    const int e = itc / 768, r = itc - e * 768;
    const float* W; unsigned char* WT; int K, N, item, gu;
    if (r < 512) { gu = r >> 8; W = (gu ? p.w_up : p.w_gate) + (size_t)(l * NE + e) * D * 512; K = D; N = 512; WT = (unsigned char*)p.WguT + (size_t)e * D * D; item = r & 255; }
    else { gu = -1; W = p.w_down + (size_t)(l * NE + e) * 512 * D; K = 512; N = D; WT = (unsigned char*)p.WdT + (size_t)e * D * 512; item = r - 512; }
    const int nblk = N / 32, kb = item / nblk, nb = item % nblk, k0 = 64 * kb, n0 = 32 * nb;
    const int d0 = gu < 0 ? n0 : 256 * (n0 >> 7) + (n0 & 127) + 128 * gu;
    d.src = W + (size_t)(k0 + (lane >> 5)) * N + n0 + (lane & 31); d.dst = WT + (size_t)d0 * K + k0; d.N = N; d.K = K;
    return d;
}
DI void tr_load(const TrD& d, float (&v)[32]) {
#pragma unroll
    for (int i = 0; i < 32; ++i) v[i] = __builtin_nontemporal_load(d.src + (size_t)(2 * i) * d.N);
}
DI void tr_finish(const TrD& d, const float (&v)[32], float* scr, int lane) {
#pragma unroll
    for (int i = 0; i < 32; ++i) { const int kk = 2 * i + (lane >> 5); scr[kk * 33 + (lane & 31)] = v[i]; }
    const int c = lane & 7;
#pragma unroll
    for (int j = 0; j < 4; ++j) { const int n = (lane >> 3) + 8 * j; const float* q = scr + (8 * c) * 33 + n;
        typedef unsigned u32x2nt __attribute__((ext_vector_type(2)));
        const u32x2nt o = {pg8::pk4_fp8((pg8::f32x4){q[0 * 33], q[1 * 33], q[2 * 33], q[3 * 33]} * 64.0f), pg8::pk4_fp8((pg8::f32x4){q[4 * 33], q[5 * 33], q[6 * 33], q[7 * 33]} * 64.0f)};
        if (d.ok) __builtin_nontemporal_store(o, (u32x2nt*)(d.dst + (size_t)n * d.K + 8 * c)); }
}
#ifndef TR_NI
#define TR_NI 4
#endif
DI void ph_convert_experts(const P& p, int l, float* ldsf, int wk0, int nwk, int it0 = 0, int it1 = NE * 768) {
    const int tid_ = ltid(), lane = tid_ & 63, gw = ((int)blockIdx.x - wk0) * NWV + (tid_ >> 6), NW = nwk * NWV;
    float* scr = ldsf + 14 * 1024 + (tid_ >> 6) * (64 * 33 + 16);
    for (int it = it0 + gw; it < it1; it += TR_NI * NW) {
        float v[TR_NI][32]; TrD d[TR_NI];
#pragma unroll
        for (int j = 0; j < TR_NI; ++j) { d[j] = tr_desc(p, l, it + j * NW, it1, lane); tr_load(d[j], v[j]); }
#pragma unroll
        for (int j = 0; j < TR_NI; ++j) tr_finish(d[j], v[j], scr, lane);
    }
}
constexpr int NPAD_IN = 3072;
DI void ph_convert_small(const P& p, float* ldsf, int, int, int) {
    const int tid_ = ltid(), lane = tid_ & 63, gw = blockIdx.x * NWV + (tid_ >> 6), NW = gridDim.x * NWV;
    float* scr = ldsf + 14 * 1024 + (tid_ >> 6) * (64 * 33 + 16);
    constexpr int I_IN = 16 * 89, I_OUT = 16 * 32;
    for (int it = gw; it < 2 * (I_IN + I_OUT); it += NW) {
        const int l = it / (I_IN + I_OUT), r = it % (I_IN + I_OUT);
        if (r < I_IN) transpose_item<true>(p.w_in + (size_t)l * D * INDIM, D, INDIM, (bf16_t*)((unsigned char*)p.WinT + (size_t)l * NPAD_IN * D), scr, r, lane);
        else { const int kb = (r - I_IN) / 32;
            transpose_item(p.w_out + (size_t)l * D * D, D, D, p.WoutT + (size_t)l * D * D, scr, r - I_IN, lane, -1, kb < 8 ? p.ssd_norm_g + l * 512 : nullptr); }
    }
    for (int idx = blockIdx.x * NTHR + tid_; idx < 32 * 1024; idx += gridDim.x * NTHR) { const int e = idx >> 10, k = idx & 1023; p.WRT[idx] = f2bf(p.w_router[k * 32 + e]); }
    const size_t nz16 = (size_t)(NPAD_IN - INDIM) * D / 16;
    for (size_t i = (size_t)blockIdx.x * NTHR + tid_; i < 2 * nz16; i += (size_t)gridDim.x * NTHR) {
        const size_t l = i / nz16, j = i % nz16;
        ((uint4*)((unsigned char*)p.WinT + (l * NPAD_IN + INDIM) * D))[j] = make_uint4(0u, 0u, 0u, 0u);
    }
}

DI void row_normmod(float4 (&v)[4], const float* g, const float* mr, int shift_idx, int scale_idx, int lane) {
    float ss = 0.f;
#pragma unroll
    for (int i = 0; i < 4; ++i) ss += v[i].x * v[i].x + v[i].y * v[i].y + v[i].z * v[i].z + v[i].w * v[i].w;
    ss = wave_sum(ss, lane);
    const float rstd = rsqrtf(ss * (1.0f / D) + 1e-6f);
#pragma unroll
    for (int i = 0; i < 4; ++i) {
        const int c = (i * 64 + lane) * 4;
        const float4 gg = *(const float4*)(g + c), sh = *(const float4*)(mr + shift_idx * 1024 + c), sc = *(const float4*)(mr + scale_idx * 1024 + c);
        v[i].x = v[i].x * rstd * gg.x * (1.f + sc.x) + sh.x; v[i].y = v[i].y * rstd * gg.y * (1.f + sc.y) + sh.y;
        v[i].z = v[i].z * rstd * gg.z * (1.f + sc.z) + sh.z; v[i].w = v[i].w * rstd * gg.w * (1.f + sc.w) + sh.w;
    }
}
DI void row_store_bf16(bf16_t* hrow, float4 (&v)[4], int lane) {
#pragma unroll
    for (int i = 0; i < 4; ++i) { ushort4 o; o.x = f2bf(v[i].x); o.y = f2bf(v[i].y); o.z = f2bf(v[i].z); o.w = f2bf(v[i].w);
        *(ushort4*)(hrow + (i * 64 + lane) * 4) = o; v[i] = make_float4(bf2f(o.x), bf2f(o.y), bf2f(o.z), bf2f(o.w)); }
}

DI void ph_normmod1(const P& p, int l, int, int, int) {
    const int tid_ = ltid(), lane = tid_ & 63, gw = blockIdx.x * NWV + (tid_ >> 6), NW = gridDim.x * NWV;
    const float* MODl = p.MOD + (size_t)l * 9 * 6144;
    for (int t = gw; t < T; t += NW) {
        float4 v[4];
#pragma unroll
        for (int i = 0; i < 4; ++i) v[i] = ((const float4*)(t < TC ? p.ctx + (size_t)t * D : p.x + (size_t)(t - TC) * D))[i * 64 + lane];
        row_normmod(v, p.norm1_g + l * D, MODl + (size_t)tok_modrow(t) * 6144, 0, 1, lane);
#pragma unroll
        for (int i = 0; i < 4; ++i) *(unsigned*)((unsigned char*)p.H + (size_t)t * D + (i * 64 + lane) * 4) = pg8::pk4_fp8((pg8::f32x4){v[i].x, v[i].y, v[i].z, v[i].w});
    }
}

typedef short s16x4 __attribute__((ext_vector_type(4)));
typedef short bf16x8v __attribute__((ext_vector_type(8)));
typedef float f32x4v __attribute__((ext_vector_type(4)));
typedef unsigned u32x4v __attribute__((ext_vector_type(4)));
typedef unsigned u32x2v __attribute__((ext_vector_type(2)));
DI u32x4v mk4(unsigned a, unsigned b, unsigned c, unsigned d) { return (u32x4v){a, b, c, d}; }
DI u32x2v mk2(unsigned a, unsigned b) { return (u32x2v){a, b}; }
DI f32x4v mkf4(float a, float b, float c, float d) { return (f32x4v){a, b, c, d}; }
#define LDSP __attribute__((address_space(3)))
constexpr int NCH = 34, NTILE = NB * NCH;
constexpr int LD64 = 72, LD128 = 136;
constexpr float LOG2E = 1.4426950408889634f;

DI int tile_tok0(int tl) { const int b = tl / NCH, cs = tl - b * NCH; return cs < 2 ? b * CTXL + cs * 128 : TC + b * SEQ + (cs - 2) * 128; }
DI f32x4v mfma16(bf16x8v a, bf16x8v b, f32x4v c) { return __builtin_amdgcn_mfma_f32_16x16x32_bf16(a, b, c, 0, 0, 0); }
DI bf16x8v frag_row(LDSP const bf16_t* base, int ld, int r0, int k0, int lane) { return *(LDSP const bf16x8v*)(base + (r0 + (lane & 15)) * ld + k0 + 8 * (lane >> 4)); }
DI bf16x8v frag_row_g(const bf16_t* base, int ld, int r0, int k0, int lane) { return *(const bf16x8v*)(base + (size_t)(r0 + (lane & 15)) * ld + k0 + 8 * (lane >> 4)); }
DI bf16x8v frag_col(LDSP const bf16_t* base, int ld, int r0, int k0, int lane) {
    const int G = lane >> 4, i = lane & 15;
    LDSP const bf16_t* a = base + (k0 + 8 * G + (i >> 2)) * ld + r0 + 4 * (i & 3);
    const s16x4 lo = __builtin_bit_cast(s16x4, __builtin_amdgcn_ds_read_tr16_b64_v4i16((LDSP s16x4*)a));
    const s16x4 hi = __builtin_bit_cast(s16x4, __builtin_amdgcn_ds_read_tr16_b64_v4i16((LDSP s16x4*)(a + 4 * ld)));
    return (bf16x8v){lo[0], lo[1], lo[2], lo[3], hi[0], hi[1], hi[2], hi[3]};
}
DI u32x2v pack4(f32x4v v) { return mk2(pk2(v[0], v[1]), pk2(v[2], v[3])); }
DI void unpack8(u32x4v v, float* o) { o[0] = __uint_as_float(v.x << 16); o[1] = __uint_as_float(v.x & 0xffff0000u); o[2] = __uint_as_float(v.y << 16); o[3] = __uint_as_float(v.y & 0xffff0000u);
    o[4] = __uint_as_float(v.z << 16); o[5] = __uint_as_float(v.z & 0xffff0000u); o[6] = __uint_as_float(v.w << 16); o[7] = __uint_as_float(v.w & 0xffff0000u); }
DI u32x4v pack8(const float* o) { return mk4(pk2(o[0], o[1]), pk2(o[2], o[3]), pk2(o[4], o[5]), pk2(o[6], o[7])); }

DI float fast_logsigmoid(float x) { return -(fmaxf(-x, 0.f) + __logf(1.0f + __expf(-fabsf(x)))); }
DI float fast_softplus(float x) { return fmaxf(x, 0.f) + __logf(1.0f + __expf(-fabsf(x))); }
struct XbcSrc { const bf16_t* base; int ld; };
DI XbcSrc xbc_src(const P& p, int tok0) { XbcSrc r; r.base = p.XBCC + (size_t)tok0 * 768; r.ld = 768; return r; }

DI void prep_conv_item(const P& p, int l, int item, int lane) {
    int piece, ch;
    if (item < T / 32) { piece = item; ch = lane * 8; } else { piece = 2 * (item - T / 32) + (lane >> 5); ch = 512 + (lane & 31) * 8; }
    const int t0 = piece * 32; int lo, hi; bf16_t* dst; int dld;
    if (t0 < TC) { lo = t0 & ~(CTXL - 1); hi = lo + CTXL - 1; } else { lo = TC + ((t0 - TC) & ~63); hi = lo + 63; }
    dst = p.XBCC + ch; dld = 768;
    const bf16_t* src = p.PROJ + OFF_XBC + ch;
    float wgt[5][8], bias[8];
#pragma unroll
    for (int k = 0; k < 5; ++k) { const f32x4v a = *(const f32x4v*)(p.conv_w + l * 5 * 768 + k * 768 + ch), c = *(const f32x4v*)(p.conv_w + l * 5 * 768 + k * 768 + ch + 4);
#pragma unroll
        for (int j = 0; j < 4; ++j) { wgt[k][j] = a[j]; wgt[k][4 + j] = c[j]; } }
    { const f32x4v a = *(const f32x4v*)(p.conv_b + l * 768 + ch), c = *(const f32x4v*)(p.conv_b + l * 768 + ch + 4);
#pragma unroll
      for (int j = 0; j < 4; ++j) { bias[j] = a[j]; bias[4 + j] = c[j]; } }
    const u32x4v zero4 = mk4(0u, 0u, 0u, 0u);
    u32x4v rw[13];
#pragma unroll
    for (int i = 0; i < 5; ++i) { const int tt = t0 - 2 + i; rw[i] = (tt >= lo && tt <= hi) ? *(const u32x4v*)(src + (size_t)tt * LDP) : zero4; }
    for (int s0 = 0; s0 < 32; s0 += 8) {
        const int t = t0 + s0;
#pragma unroll
        for (int i = 0; i < 8; ++i) { const int tt = t + 3 + i; rw[5 + i] = (tt <= hi) ? *(const u32x4v*)(src + (size_t)tt * LDP) : zero4; }
#pragma unroll
        for (int i = 0; i < 8; ++i) {
            float o[8];
#pragma unroll
            for (int c = 0; c < 8; ++c) o[c] = bias[c];
#pragma unroll
            for (int k = 0; k < 5; ++k) { float v[8]; unpack8(rw[i + k], v);
#pragma unroll
                for (int c = 0; c < 8; ++c) o[c] += wgt[k][c] * v[c]; }
#pragma unroll
            for (int c = 0; c < 8; ++c) o[c] = siluf(o[c]);
            *(u32x4v*)(dst + (size_t)(t + i) * dld) = pack8(o);
        }
#pragma unroll
        for (int i = 0; i < 5; ++i) rw[i] = rw[i + 8];
    }
}
DI void prep_ssd_item(const P& p, int l, int item, int lane) {
    const int tl = item >> 3, h = item & 7, tok0 = tile_tok0(tl);
    const float bsf = p.dt_bias_f[l * 8 + h], bsb = p.dt_bias_b[l * 8 + h];
    const float r0 = bf2f(p.PROJ[(size_t)(tok0 + 2 * lane) * LDP + OFF_DT + h]), r1 = bf2f(p.PROJ[(size_t)(tok0 + 2 * lane + 1) * LDP + OFF_DT + h]);
    const float f0 = fast_softplus(r0 + bsf), f1 = fast_softplus(r1 + bsf), b0 = fast_softplus(r0 + bsb), b1 = fast_softplus(r1 + bsb);
    float pf = f0 + f1, sb = b0 + b1;
#pragma unroll
    for (int o = 1; o < 64; o <<= 1) { const float t = shl(pf, lane >= o ? lane - o : lane); if (lane >= o) pf += t; }
#pragma unroll
    for (int o = 1; o < 64; o <<= 1) { const float t = shl(sb, lane + o < 64 ? lane + o : lane); if (lane + o < 64) sb += t; }
    const float Af = -__expf(p.a_log_f[l * 8 + h]) * LOG2E, Ab = -__expf(p.a_log_b[l * 8 + h]) * LOG2E;
    const float af0 = Af * (pf - f1), af1 = Af * pf, ab0 = Ab * sb, ab1 = Ab * (sb - b0);
    f32x4v* dst = (f32x4v*)p.SSC + (size_t)(tok0 + 2 * lane) * 8 + h;
    dst[0] = mkf4(af0, af0 - __log2f(f0), ab0, ab0 - __log2f(b0));
    dst[8] = mkf4(af1, af1 - __log2f(f1), ab1, ab1 - __log2f(b1));
    if (lane == 63) { p.STOT[(tl * 8 + h) * 2 + 0] = af1; p.SDEC[(tl * 8 + h) * 2 + 0] = __builtin_amdgcn_exp2f(af1); }
    if (lane == 0) { p.STOT[(tl * 8 + h) * 2 + 1] = ab0; p.SDEC[(tl * 8 + h) * 2 + 1] = __builtin_amdgcn_exp2f(ab0); }
}
template <int CTRL> DI float dppz(float x) { return __builtin_bit_cast(float, __builtin_amdgcn_update_dpp(0, __builtin_bit_cast(int, x), CTRL, 0xf, 0xf, true)); }
DI float row_total(float s) { s += dppz<0xB1>(s); s += dppz<0x4E>(s); s += dppz<0x141>(s); s += dppz<0x140>(s); return s; }
struct GlaPL { u32x4v qv_[2], kv_[2], vv_[4]; bf16x8v gkf[8]; float uw[8]; f32x4v bias; };
DI void prep_gla_load(const P& p, int l, int it, GlaPL& L) {
    const int tl = it >> 2, h = it & 3;
    const int tid = ltid(), lane = tid & 63, w = __builtin_amdgcn_readfirstlane(tid >> 6), kt = w & 3, dir = w >> 2, G = lane >> 4, c = lane & 15, tok0 = tile_tok0(tl);
#pragma unroll
    for (int nt = 0; nt < 8; ++nt) L.gkf[nt] = *(const bf16x8v*)(p.PROJ + (size_t)(tok0 + 16 * nt + c) * LDP + OFF_GK + (G & 1) * 8);
    { const float* up = (dir ? p.gk_up_b : p.gk_up_f) + l * 16 * 256 + (G & 1) * 8 * 256 + h * 64 + 16 * kt + c;
#pragma unroll
      for (int e = 0; e < 8; ++e) L.uw[e] = up[e * 256]; }
    L.bias = *(const f32x4v*)((dir ? p.gk_bias_b : p.gk_bias_f) + l * 256 + h * 64 + 16 * kt + 4 * G);
#pragma unroll
    for (int q = 0; q < 4; ++q) { const int cc_ = tid + q * NTHR, r = cc_ >> 4, cc = cc_ & 15; L.vv_[q] = *(const u32x4v*)(p.PROJ + (size_t)(tok0 + r) * LDP + OFF_V + h * 128 + cc * 8); }
#pragma unroll
    for (int q = 0; q < 2; ++q) { const int cc_ = tid + q * NTHR, r = cc_ >> 3, cc = cc_ & 7; const bf16_t* pr = p.PROJ + (size_t)(tok0 + r) * LDP;
        L.qv_[q] = *(const u32x4v*)(pr + OFF_Q + h * 64 + cc * 8); L.kv_[q] = *(const u32x4v*)(pr + OFF_K + h * 64 + cc * 8); }
}
DI void prep_gla_block(const P& p, int l, int it, int it_next, GlaPL& L, LDSP unsigned char* lds) {
    const int tl = it >> 2, h = it & 3;
    const int tid = ltid(), lane = tid & 63, w = __builtin_amdgcn_readfirstlane(tid >> 6), kt = w & 3, dir = w >> 2, G = lane >> 4, c = lane & 15, tok0 = tile_tok0(tl);
    LDSP bf16_t* QT = (LDSP bf16_t*)lds; LDSP bf16_t* KT = QT + 128 * LD64; LDSP bf16_t* O4 = KT + 128 * LD64; LDSP bf16_t* VT = O4 + 4 * 128 * LD64; LDSP float* DEC = (LDSP float*)(VT + 128 * LD128);
    f32x4v g[8];
    { bf16x8v af;
#pragma unroll
      for (int e = 0; e < 8; ++e) { const bf16_t hi = f2bf(L.uw[e]); const bf16_t lo = f2bf(L.uw[e] - bf2f(hi)); af[e] = (short)(G < 2 ? hi : lo); }
#pragma unroll
      for (int nt = 0; nt < 8; ++nt) g[nt] = mfma16(af, L.gkf[nt], (f32x4v){0.f, 0.f, 0.f, 0.f}); }
#pragma unroll
    for (int nt = 0; nt < 8; ++nt)
#pragma unroll
        for (int r = 0; r < 4; ++r) { const float x = (g[nt][r] + L.bias[r]) * LOG2E;
            g[nt][r] = -(fmaxf(-x, 0.f) + __log2f(1.0f + __builtin_amdgcn_exp2f(-fabsf(x)))) * (1.0f / 16.0f); }
    f32x4v tot = (f32x4v){0.f, 0.f, 0.f, 0.f};
    if (dir == 0) {
#pragma unroll
        for (int nt = 0; nt < 8; ++nt)
#pragma unroll
            for (int r = 0; r < 4; ++r) { const float s = row_total(g[nt][r]); float x = g[nt][r];
                x += dppz<0x111>(x); x += dppz<0x112>(x); x += dppz<0x114>(x); x += dppz<0x118>(x);
                g[nt][r] = tot[r] + x; tot[r] += s; }
    } else {
#pragma unroll
        for (int nt = 7; nt >= 0; --nt)
#pragma unroll
            for (int r = 0; r < 4; ++r) { const float s = row_total(g[nt][r]); float x = g[nt][r];
                x += dppz<0x101>(x); x += dppz<0x102>(x); x += dppz<0x104>(x); x += dppz<0x108>(x);
                g[nt][r] = tot[r] + x; tot[r] += s; }
    }
    __syncthreads();
#pragma unroll
    for (int q = 0; q < 2; ++q) { const int cc_ = tid + q * NTHR, r = cc_ >> 3, cc = cc_ & 7; *(LDSP u32x4v*)(QT + r * LD64 + cc * 8) = L.qv_[q]; *(LDSP u32x4v*)(KT + r * LD64 + cc * 8) = L.kv_[q]; }
#pragma unroll
    for (int q = 0; q < 4; ++q) { const int cc_ = tid + q * NTHR, r = cc_ >> 4, cc = cc_ & 15; *(LDSP u32x4v*)(VT + r * LD128 + cc * 8) = L.vv_[q]; }
    __syncthreads();
    { LDSP bf16_t* OQ = O4 + (2 * dir) * 128 * LD64; LDSP bf16_t* OK = OQ + 128 * LD64;
#pragma unroll
      for (int nt = 0; nt < 8; ++nt) { const int o = (16 * nt + c) * LD64 + 16 * kt + 4 * G;
          const u32x2v q2 = *(LDSP const u32x2v*)(QT + o), k2 = *(LDSP const u32x2v*)(KT + o);
          float eq[4], ek[4];
#pragma unroll
          for (int r = 0; r < 4; ++r) { eq[r] = __builtin_amdgcn_exp2f(g[nt][r] - 3.0f); ek[r] = __builtin_amdgcn_exp2f(-g[nt][r]); }
          *(LDSP u32x2v*)(OQ + o) = mk2(pk2(__uint_as_float(q2.x << 16) * eq[0], __uint_as_float(q2.x & 0xffff0000u) * eq[1]), pk2(__uint_as_float(q2.y << 16) * eq[2], __uint_as_float(q2.y & 0xffff0000u) * eq[3]));
          *(LDSP u32x2v*)(OK + o) = mk2(pk2(__uint_as_float(k2.x << 16) * ek[0], __uint_as_float(k2.x & 0xffff0000u) * ek[1]), pk2(__uint_as_float(k2.y << 16) * ek[2], __uint_as_float(k2.y & 0xffff0000u) * ek[3])); }
      if (c == 0) { const f32x4v d = mkf4(__builtin_amdgcn_exp2f(tot[0]), __builtin_amdgcn_exp2f(tot[1]), __builtin_amdgcn_exp2f(tot[2]), __builtin_amdgcn_exp2f(tot[3]));
          *(f32x4v*)(p.GDEC + (size_t)((tl * 4 + h) * 2 + dir) * 64 + 16 * kt + 4 * G) = d; *(LDSP f32x4v*)(DEC + dir * 64 + 16 * kt + 4 * G) = d; } }
    __syncthreads();
    if (it_next >= 0) prep_gla_load(p, l, it_next, L);
#pragma unroll
    for (int q = 0; q < 8; ++q) { const int cc_ = tid + q * NTHR, a4 = cc_ >> 10, r = (cc_ >> 3) & 127, cc = cc_ & 7;
        *(u32x4v*)(p.QKB + (size_t)(tok0 + r) * 1024 + a4 * 256 + h * 64 + cc * 8) = *(LDSP const u32x4v*)(O4 + (a4 * 128 + r) * LD64 + cc * 8); }
    { const int ut = kt; LDSP const bf16_t* KE = O4 + (dir ? 3 : 1) * 128 * LD64;
      f32x4v acc[8];
#pragma unroll
      for (int q = 0; q < 8; ++q) acc[q] = (f32x4v){0.f, 0.f, 0.f, 0.f};
#pragma unroll
      for (int ks = 0; ks < 4; ++ks) { const bf16x8v u = frag_col(KE, LD64, 16 * ut, 32 * ks, lane);
#pragma unroll
          for (int q = 0; q < 8; ++q) acc[q] = mfma16(u, frag_col(VT, LD128, 16 * q, 32 * ks, lane), acc[q]); }
      const f32x4v dec = *(LDSP const f32x4v*)(DEC + dir * 64 + 16 * ut + 4 * (lane >> 4));
      bf16_t* dst = p.GS + ((size_t)((tl * 4 + h) * 2 + dir) * 128) * 64;
#pragma unroll
      for (int q = 0; q < 8; ++q) *(u32x2v*)(dst + (size_t)(16 * q + (lane & 15)) * 64 + 16 * ut + 4 * (lane >> 4)) = pack4(acc[q] * dec); }
}
constexpr int NPREP_A = T / 32 + T / 64, NPREP_B = NTILE * 8;
DI void ph_prep(const P& p, int l, LDSP unsigned char* lds) {
    const int tid_ = ltid(), lane = tid_ & 63, gw = blockIdx.x * NWV + (tid_ >> 6), NW = gridDim.x * NWV;
    for (int it = gw; it < NPREP_A + NPREP_B; it += NW) {
        if (it < NPREP_A) prep_conv_item(p, l, it, lane); else prep_ssd_item(p, l, it - NPREP_A, lane);
    }
    { const int G_ = gridDim.x; int it = G_ - 1 - (int)blockIdx.x;
      GlaPL L; if (it < NTILE * 4) prep_gla_load(p, l, it, L);
      for (; it < NTILE * 4; it += G_) prep_gla_block(p, l, it, it + G_ < NTILE * 4 ? it + G_ : -1, L, lds); }
}

DI void s1_ssd(const P& p, int tl, int h, LDSP unsigned char* lds) {
    const int tid = ltid(), lane = tid & 63, w = __builtin_amdgcn_readfirstlane(tid >> 6);
    const int tok0 = tile_tok0(tl), g = h >> 2; const XbcSrc xs = xbc_src(p, tok0);
    LDSP bf16_t* XWF = (LDSP bf16_t*)lds; LDSP bf16_t* XWB = XWF + 128 * LD64; LDSP bf16_t* BG = XWB + 128 * LD64;
    const int j = tid >> 2, cq = tid & 3;
    const bf16_t* row = xs.base + (size_t)j * xs.ld;
    const u32x4v x0 = *(const u32x4v*)(row + h * 64 + cq * 16), x1 = *(const u32x4v*)(row + h * 64 + cq * 16 + 8);
    const u32x4v b0 = *(const u32x4v*)(row + 512 + g * 64 + cq * 16), b1 = *(const u32x4v*)(row + 512 + g * 64 + cq * 16 + 8);
    const f32x4v sc = *((const f32x4v*)p.SSC + (size_t)(tok0 + j) * 8 + h);
    const float wf = __builtin_amdgcn_exp2f(p.STOT[(tl * 8 + h) * 2 + 0] - sc.y), wb = __builtin_amdgcn_exp2f(p.STOT[(tl * 8 + h) * 2 + 1] - sc.w);
    float xv[16], of[16], ob[16]; unpack8(x0, xv); unpack8(x1, xv + 8);
#pragma unroll
    for (int c = 0; c < 16; ++c) { of[c] = xv[c] * wf; ob[c] = xv[c] * wb; }
    __syncthreads();
    *(LDSP u32x4v*)(XWF + j * LD64 + cq * 16) = pack8(of); *(LDSP u32x4v*)(XWF + j * LD64 + cq * 16 + 8) = pack8(of + 8);
    *(LDSP u32x4v*)(XWB + j * LD64 + cq * 16) = pack8(ob); *(LDSP u32x4v*)(XWB + j * LD64 + cq * 16 + 8) = pack8(ob + 8);
    *(LDSP u32x4v*)(BG + j * LD64 + cq * 16) = b0; *(LDSP u32x4v*)(BG + j * LD64 + cq * 16 + 8) = b1;
    __syncthreads();
    const int dir = w >> 2, ut = w & 3; LDSP const bf16_t* XW = dir ? XWB : XWF;
    f32x4v acc[4];
#pragma unroll
    for (int q = 0; q < 4; ++q) acc[q] = (f32x4v){0.f, 0.f, 0.f, 0.f};
#pragma unroll
    for (int ks = 0; ks < 4; ++ks) { const bf16x8v u = frag_col(BG, LD64, 16 * ut, 32 * ks, lane);
#pragma unroll
        for (int q = 0; q < 4; ++q) acc[q] = mfma16(u, frag_col(XW, LD64, 16 * q, 32 * ks, lane), acc[q]); }
    bf16_t* dst = p.SS + ((size_t)((tl * 8 + h) * 2 + dir) * 64) * 64;
#pragma unroll
    for (int q = 0; q < 4; ++q) *(u32x2v*)(dst + (size_t)(16 * q + (lane & 15)) * 64 + 16 * ut + 4 * (lane >> 4)) = pack4(acc[q]);
}
DI void ph_s1(const P& p, int l, LDSP unsigned char* lds) {
    for (int it = blockIdx.x; it < NTILE * 8; it += gridDim.x) s1_ssd(p, it >> 3, it & 7, lds);
}

DI int s2_chunk(int dir, int s) { return dir == 0 ? s : (s < 2 ? 1 - s : 35 - s); }
DI void ph_s2(const P& p) {
    const int g = blockIdx.x * NTHR + ltid();
    for (int v = g; v < 131072; v += gridDim.x * NTHR) {
        const bool gla = v >= 65536; const int r = v & 65535;
        int b, h, dir, vi;
        if (!gla) { vi = r & 511; dir = (r >> 9) & 1; h = (r >> 10) & 7; b = r >> 13; } else { vi = r & 1023; dir = (r >> 10) & 1; h = (r >> 11) & 3; b = r >> 13; }
        float st[8];
#pragma unroll
        for (int e = 0; e < 8; ++e) st[e] = 0.f;
        for (int s0 = 0; s0 < NCH; s0 += 6) {
            u32x4v sv[6]; float dsc[6]; f32x4v dv0[6], dv1[6];
#pragma unroll
            for (int u = 0; u < 6; ++u) { if (s0 + u >= NCH) continue; const int tl = b * NCH + s2_chunk(dir, s0 + u);
                if (!gla) { sv[u] = *(const u32x4v*)(p.SS + ((size_t)((tl * 8 + h) * 2 + dir) * 512 + vi) * 8); dsc[u] = p.SDEC[(tl * 8 + h) * 2 + dir]; }
                else { sv[u] = *(const u32x4v*)(p.GS + ((size_t)((tl * 4 + h) * 2 + dir) * 1024 + vi) * 8); const f32x4v* d = (const f32x4v*)(p.GDEC + (size_t)((tl * 4 + h) * 2 + dir) * 64 + (vi & 7) * 8); dv0[u] = d[0]; dv1[u] = d[1]; } }
#pragma unroll
            for (int u = 0; u < 6; ++u) { if (s0 + u >= NCH) continue; const int tl = b * NCH + s2_chunk(dir, s0 + u);
                float loc[8]; unpack8(sv[u], loc);
                const u32x4v hin = pack8(st);
                if (!gla) { *(u32x4v*)(p.SS + ((size_t)((tl * 8 + h) * 2 + dir) * 512 + vi) * 8) = hin;
#pragma unroll
                    for (int e = 0; e < 8; ++e) st[e] = dsc[u] * st[e] + loc[e]; }
                else { *(u32x4v*)(p.GS + ((size_t)((tl * 4 + h) * 2 + dir) * 1024 + vi) * 8) = hin;
                    const float dd[8] = {dv0[u].x, dv0[u].y, dv0[u].z, dv0[u].w, dv1[u].x, dv1[u].y, dv1[u].z, dv1[u].w};
#pragma unroll
                    for (int e = 0; e < 8; ++e) st[e] = dd[e] * st[e] + loc[e]; } }
        }
    }
}

DI int s3_tile(int l, int q) { return l == 0 ? q : (q >> 5) * NCH + 2 + (q & 31); }
struct SsdPre { u32x4v x0, x1, b0, b1, c0, c1, hf, hb; f32x4v sc; };
DI void s3_ssd_load(const P& p, int tl, int h, int tid, int i, int G, SsdPre& r) {
    const int tok0 = tile_tok0(tl), g = h >> 2; const XbcSrc xs = xbc_src(p, tok0);
    const int j = tid >> 2, cq = tid & 3; const bf16_t* row = xs.base + (size_t)j * xs.ld;
    r.x0 = *(const u32x4v*)(row + h * 64 + cq * 16); r.x1 = *(const u32x4v*)(row + h * 64 + cq * 16 + 8);
    r.b0 = *(const u32x4v*)(row + 512 + g * 64 + cq * 16); r.b1 = *(const u32x4v*)(row + 512 + g * 64 + cq * 16 + 8);
    r.c0 = *(const u32x4v*)(row + 640 + g * 64 + cq * 16); r.c1 = *(const u32x4v*)(row + 640 + g * 64 + cq * 16 + 8);
    const bf16_t* Hf = p.SS + (size_t)((tl * 8 + h) * 2 + 0) * 4096 + (tid >> 3) * 64 + (tid & 7) * 8;
    r.hf = *(const u32x4v*)Hf; r.hb = *(const u32x4v*)(Hf + 4096);
    r.sc = *((const f32x4v*)p.SSC + (size_t)(tok0 + (tid & 127)) * 8 + h);
}
DI void ph_s3_ssd(const P& p, int l, LDSP unsigned char* lds) {
    const int tid = ltid(), lane = tid & 63, w = __builtin_amdgcn_readfirstlane(tid >> 6), G = lane >> 4, li = lane & 15, i = 16 * w + li;
    LDSP bf16_t* XH = (LDSP bf16_t*)lds; LDSP bf16_t* BG = XH + 128 * LD64; LDSP bf16_t* CG = BG + 128 * LD64; LDSP bf16_t* MM = CG + 128 * LD64; LDSP f32x4v* SC = (LDSP f32x4v*)(MM + 128 * LD128);
    LDSP bf16_t* HF = (LDSP bf16_t*)(SC + 128); LDSP bf16_t* HB = HF + 64 * LD64;
    const int nit = (l == 0 ? NTILE : NB * 32) * 8, GS_ = gridDim.x;
    int it = ((int)blockIdx.x + (GS_ >> 1)) % GS_; SsdPre pre;
    if (it < nit) s3_ssd_load(p, s3_tile(l, it >> 3), it & 7, tid, i, G, pre);
    for (; it < nit; it += GS_) {
        const int tl = s3_tile(l, it >> 3), h = it & 7, tok0 = tile_tok0(tl);
        __syncthreads();
        { const int j = tid >> 2, cq = tid & 3;
          *(LDSP u32x4v*)(XH + j * LD64 + cq * 16) = pre.x0; *(LDSP u32x4v*)(XH + j * LD64 + cq * 16 + 8) = pre.x1;
          *(LDSP u32x4v*)(BG + j * LD64 + cq * 16) = pre.b0; *(LDSP u32x4v*)(BG + j * LD64 + cq * 16 + 8) = pre.b1;
          *(LDSP u32x4v*)(CG + j * LD64 + cq * 16) = pre.c0; *(LDSP u32x4v*)(CG + j * LD64 + cq * 16 + 8) = pre.c1;
          *(LDSP u32x4v*)(HF + (tid >> 3) * LD64 + (tid & 7) * 8) = pre.hf; *(LDSP u32x4v*)(HB + (tid >> 3) * LD64 + (tid & 7) * 8) = pre.hb;
          if (tid < 128) SC[tid] = pre.sc; }
        if (it + GS_ < nit) s3_ssd_load(p, s3_tile(l, (it + GS_) >> 3), (it + GS_) & 7, tid, i, G, pre);
        __syncthreads();
        u32x2v zr[4];
#pragma unroll
        for (int pt = 0; pt < 4; ++pt) zr[pt] = *(const u32x2v*)(p.PROJ + (size_t)(tok0 + i) * LDP + OFF_Z + h * 64 + 16 * pt + 4 * G);
        const f32x4v sci = SC[i];
        {
            f32x4v am[8];
#pragma unroll
            for (int ut = 0; ut < 8; ++ut) am[ut] = (f32x4v){0.f, 0.f, 0.f, 0.f};
#pragma unroll
            for (int ks = 0; ks < 2; ++ks) { const bf16x8v vfr = frag_row(CG, LD64, 16 * w, 32 * ks, lane);
#pragma unroll
                for (int ut = 0; ut < 8; ++ut) am[ut] = mfma16(frag_row(BG, LD64, 16 * ut, 32 * ks, lane), vfr, am[ut]); }
#pragma unroll
            for (int ut = 0; ut < 8; ++ut) { f32x4v m;
#pragma unroll
                for (int r = 0; r < 4; ++r) { const int jj = 16 * ut + 4 * G + r; const f32x4v scj = SC[jj];
                    const float Lf = jj <= i ? __builtin_amdgcn_exp2f(fminf(sci.x - scj.y, 30.f)) : 0.f, Lb = jj >= i ? __builtin_amdgcn_exp2f(fminf(sci.z - scj.w, 30.f)) : 0.f;
                    m[r] = am[ut][r] * (Lf + Lb); }
                *(LDSP u32x2v*)(MM + i * LD128 + 16 * ut + 4 * G) = pack4(m); }
        }
        asm volatile("s_waitcnt lgkmcnt(0)" ::: "memory");
        f32x4v ay[4], af_[4], ab_[4];
#pragma unroll
        for (int pt = 0; pt < 4; ++pt) { ay[pt] = (f32x4v){0.f, 0.f, 0.f, 0.f}; af_[pt] = ay[pt]; ab_[pt] = ay[pt]; }
#pragma unroll
        for (int ks = 0; ks < 2; ++ks) { const bf16x8v vfr = frag_row(CG, LD64, 16 * w, 32 * ks, lane);
#pragma unroll
            for (int pt = 0; pt < 4; ++pt) { af_[pt] = mfma16(frag_row(HF, LD64, 16 * pt, 32 * ks, lane), vfr, af_[pt]); ab_[pt] = mfma16(frag_row(HB, LD64, 16 * pt, 32 * ks, lane), vfr, ab_[pt]); } }
#pragma unroll
        for (int ks = 0; ks < 4; ++ks) { const bf16x8v vfr = frag_row(MM, LD128, 16 * w, 32 * ks, lane);
#pragma unroll
            for (int pt = 0; pt < 4; ++pt) ay[pt] = mfma16(frag_col(XH, LD64, 16 * pt, 32 * ks, lane), vfr, ay[pt]); }
        const float sf = __builtin_amdgcn_exp2f(sci.x), sb = __builtin_amdgcn_exp2f(sci.z), dsk = p.d_skip[l * 8 + h];
        float ssq = 0.f;
#pragma unroll
        for (int pt = 0; pt < 4; ++pt) { const int pc = 16 * pt + 4 * G;
            const u32x2v xr = *(LDSP const u32x2v*)(XH + i * LD64 + pc);
            const float xv[4] = {__uint_as_float(xr.x << 16), __uint_as_float(xr.x & 0xffff0000u), __uint_as_float(xr.y << 16), __uint_as_float(xr.y & 0xffff0000u)};
            const float zv[4] = {__uint_as_float(zr[pt].x << 16), __uint_as_float(zr[pt].x & 0xffff0000u), __uint_as_float(zr[pt].y << 16), __uint_as_float(zr[pt].y & 0xffff0000u)};
            float yv[4];
#pragma unroll
            for (int r = 0; r < 4; ++r) { yv[r] = (ay[pt][r] + sf * af_[pt][r] + sb * ab_[pt][r] + dsk * xv[r]) * siluf(zv[r]); yv[r] = bf2f(f2bf(yv[r])); ssq += yv[r] * yv[r]; }
            *(u32x2v*)(p.H + (size_t)(tok0 + i) * D + h * 64 + pc) = mk2(pk2(yv[0], yv[1]), pk2(yv[2], yv[3])); }
        ssq += shx(ssq, 16, lane); ssq += shx(ssq, 32, lane);
        if (G == 0) p.SSQ[(size_t)(tok0 + i) * 8 + h] = ssq;
    }
}
struct GlaPre { u32x4v qk[2][4], vv[4], sf[2], sb[2]; };
DI void s3_gla_load(const P& p, int tl, int h, int tid, int i, int G, GlaPre& r) {
    const int tok0 = tile_tok0(tl);
#pragma unroll
    for (int q = 0; q < 2; ++q) { const int c = tid + q * NTHR, rr = c >> 3, cc = c & 7; const bf16_t* qb = p.QKB + (size_t)(tok0 + rr) * 1024 + h * 64 + cc * 8;
        r.qk[q][0] = *(const u32x4v*)qb; r.qk[q][1] = *(const u32x4v*)(qb + 256);
        r.qk[q][2] = *(const u32x4v*)(qb + 512); r.qk[q][3] = *(const u32x4v*)(qb + 768);
        const bf16_t* Sg = p.GS + (size_t)((tl * 4 + h) * 2 + 0) * 8192 + (size_t)rr * 64 + cc * 8; r.sf[q] = *(const u32x4v*)Sg; r.sb[q] = *(const u32x4v*)(Sg + 8192); }
#pragma unroll
    for (int q = 0; q < 4; ++q) { const int c = tid + q * NTHR, rr = c >> 4, cc = c & 15; r.vv[q] = *(const u32x4v*)(p.PROJ + (size_t)(tok0 + rr) * LDP + OFF_V + h * 128 + cc * 8); }
}
DI void ph_s3_gla(const P& p, int l, LDSP unsigned char* lds) {
    const int tid = ltid(), lane = tid & 63, w = __builtin_amdgcn_readfirstlane(tid >> 6), G = lane >> 4, li = lane & 15, i = 16 * w + li;
    LDSP bf16_t* Q2 = (LDSP bf16_t*)lds;
    LDSP bf16_t* KF = Q2 + 8 * 2 * 16 * LD64; LDSP bf16_t* KB = KF + 128 * LD64; LDSP bf16_t* VT = KB + 128 * LD64; LDSP bf16_t* SF = VT + 128 * LD128; LDSP bf16_t* SB = SF + 128 * LD64;
    LDSP bf16_t* AMw = SF + w * 16 * LD128;
    const int nit = (l == 0 ? NTILE : NB * 32) * 4, GS_ = gridDim.x;
    int it = blockIdx.x; GlaPre pre;
    if (it < nit) s3_gla_load(p, s3_tile(l, it >> 2), it & 3, tid, i, G, pre);
    for (; it < nit; it += GS_) {
        const int tl = s3_tile(l, it >> 2), h = it & 3, tok0 = tile_tok0(tl);
        __syncthreads();
#pragma unroll
        for (int q = 0; q < 2; ++q) { const int c = tid + q * NTHR, rr = c >> 3, cc = c & 7; LDSP bf16_t* qrow = Q2 + (rr >> 4) * (2 * 16 * LD64) + (rr & 15) * LD64 + cc * 8;
            *(LDSP u32x4v*)qrow = pre.qk[q][0]; *(LDSP u32x4v*)(qrow + 16 * LD64) = pre.qk[q][2];
            *(LDSP u32x4v*)(KF + rr * LD64 + cc * 8) = pre.qk[q][1]; *(LDSP u32x4v*)(KB + rr * LD64 + cc * 8) = pre.qk[q][3];
            *(LDSP u32x4v*)(SF + rr * LD64 + cc * 8) = pre.sf[q]; *(LDSP u32x4v*)(SB + rr * LD64 + cc * 8) = pre.sb[q]; }
#pragma unroll
        for (int q = 0; q < 4; ++q) { const int c = tid + q * NTHR, rr = c >> 4, cc = c & 15; *(LDSP u32x4v*)(VT + rr * LD128 + cc * 8) = pre.vv[q]; }
        if (it + GS_ < nit) s3_gla_load(p, s3_tile(l, (it + GS_) >> 2), (it + GS_) & 3, tid, i, G, pre);
        __syncthreads();
        f32x4v ao[8];
#pragma unroll
        for (int q = 0; q < 8; ++q) ao[q] = (f32x4v){0.f, 0.f, 0.f, 0.f};
        bf16x8v qfr[2][2];
#pragma unroll
        for (int dir = 0; dir < 2; ++dir)
#pragma unroll
            for (int ks = 0; ks < 2; ++ks) qfr[dir][ks] = frag_row(Q2 + w * (2 * 16 * LD64) + dir * 16 * LD64, LD64, 0, 32 * ks, lane);
#pragma unroll
        for (int dir = 0; dir < 2; ++dir) {
            LDSP const bf16_t* SS_ = dir ? SB : SF;
#pragma unroll
            for (int ks = 0; ks < 2; ++ks) {
#pragma unroll
                for (int vt = 0; vt < 8; ++vt) ao[vt] = mfma16(frag_row(SS_, LD64, 16 * vt, 32 * ks, lane), qfr[dir][ks], ao[vt]); }
        }
        __syncthreads();
#pragma unroll
        for (int uh = 0; uh < 4; ++uh) {
            f32x4v a2[2]; a2[0] = (f32x4v){0.f, 0.f, 0.f, 0.f}; a2[1] = a2[0];
#pragma unroll
            for (int dir = 0; dir < 2; ++dir) {
                LDSP const bf16_t* KS = dir ? KB : KF;
                f32x4v as[2]; as[0] = (f32x4v){0.f, 0.f, 0.f, 0.f}; as[1] = as[0];
#pragma unroll
                for (int ks = 0; ks < 2; ++ks) {
#pragma unroll
                    for (int q = 0; q < 2; ++q) as[q] = mfma16(frag_row(KS, LD64, 16 * (2 * uh + q), 32 * ks, lane), qfr[dir][ks], as[q]); }
#pragma unroll
                for (int q = 0; q < 2; ++q)
#pragma unroll
                    for (int r = 0; r < 4; ++r) { const int jj = 16 * (2 * uh + q) + 4 * G + r; const bool keep = dir == 0 ? (jj <= i) : (jj >= i); a2[q][r] += keep ? as[q][r] : 0.f; }
            }
#pragma unroll
            for (int q = 0; q < 2; ++q) *(LDSP u32x2v*)(AMw + li * LD128 + 16 * (2 * uh + q) + 4 * G) = pack4(a2[q]);
        }
        u32x2v gr[8];
#pragma unroll
        for (int vt = 0; vt < 8; ++vt) gr[vt] = *(const u32x2v*)(p.PROJ + (size_t)(tok0 + i) * LDP + OFF_GO + h * 128 + 16 * vt + 4 * G);
        asm volatile("s_waitcnt lgkmcnt(0)" ::: "memory");
#pragma unroll
        for (int ks = 0; ks < 4; ++ks) { const bf16x8v vfr = frag_row(AMw, LD128, 0, 32 * ks, lane);
#pragma unroll
            for (int vt = 0; vt < 8; ++vt) ao[vt] = mfma16(frag_col(VT, LD128, 16 * vt, 32 * ks, lane), vfr, ao[vt]); }
        float so = 0.f;
#pragma unroll
        for (int vt = 0; vt < 8; ++vt)
#pragma unroll
            for (int r = 0; r < 4; ++r) so += ao[vt][r] * ao[vt][r];
        so += shx(so, 16, lane); so += shx(so, 32, lane);
        const float ro = rsqrtf(so * (1.0f / 128.0f) + 1e-6f);
#pragma unroll
        for (int vt = 0; vt < 8; ++vt) { const int vc = 16 * vt + 4 * G; const f32x4v gg = *(const f32x4v*)(p.gla_norm_g + l * 128 + vc);
            const float g0 = __uint_as_float(gr[vt].x << 16), g1 = __uint_as_float(gr[vt].x & 0xffff0000u), g2 = __uint_as_float(gr[vt].y << 16), g3 = __uint_as_float(gr[vt].y & 0xffff0000u);
            *(u32x2v*)(p.H + (size_t)(tok0 + i) * D + 512 + h * 128 + vc) = mk2(pk2(ao[vt][0] * ro * gg.x * siluf(g0), ao[vt][1] * ro * gg.y * siluf(g1)), pk2(ao[vt][2] * ro * gg.z * siluf(g2), ao[vt][3] * ro * gg.w * siluf(g3))); }
    }
}
DI void ph_s3(const P& p, int l, LDSP unsigned char* lds) { ph_s3_gla(p, l, lds); ph_s3_ssd(p, l, lds); }
template <int NR> DI void normroute_tile(const P& p, int tb, const float* MODl, int* counts, const float* g2, LDSP bf16_t* WR, LDSP bf16_t* HT, int lane, int G, int li) {
    constexpr int LDW = 1032, LDT = 264;
        const float* mr = MODl + (size_t)tok_modrow(tb) * 6144;
        float rs[NR];
        { const f32x4v* q = (const f32x4v*)(p.XSS + (size_t)(tb + (li < NR ? li : 0)) * 16); const f32x4v a = q[0], b = q[1], c = q[2], d = q[3];
          const float ss = (((a.x + a.y) + (a.z + a.w)) + ((b.x + b.y) + (b.z + b.w))) + (((c.x + c.y) + (c.z + c.w)) + ((d.x + d.y) + (d.z + d.w)));
          const float r = rsqrtf(ss * (1.0f / D) + 1e-6f);
#pragma unroll
          for (int i = 0; i < NR; ++i) rs[i] = shl(r, i); }
        f32x4v acc[2]; acc[0] = (f32x4v){0.f, 0.f, 0.f, 0.f}; acc[1] = acc[0];
        u32x2v xq[NR];
#pragma unroll
        for (int i = 0; i < NR; ++i) xq[i] = *(const u32x2v*)(xrow(p, tb + i) + lane * 4);
#pragma unroll
        for (int kc = 0; kc < 4; ++kc) {
            const int kk = kc * 256 + lane * 4;
            const f32x4v gg = *(const f32x4v*)(g2 + kk), sh = *(const f32x4v*)(mr + 3 * 1024 + kk), sc = *(const f32x4v*)(mr + 4 * 1024 + kk);
            f32x4v gs;
#pragma unroll
            for (int j = 0; j < 4; ++j) gs[j] = gg[j] * (1.f + sc[j]);
#pragma unroll
            for (int i = 0; i < NR; ++i) { const u32x2v r = xq[i];
                const f32x4v xv = mkf4(__uint_as_float(r.x << 16), __uint_as_float(r.x & 0xffff0000u), __uint_as_float(r.y << 16), __uint_as_float(r.y & 0xffff0000u));
                const f32x4v h = xv * rs[i] * gs + sh; const u32x2v hb = pack4(h);
                *(unsigned*)((unsigned char*)p.H + (size_t)(tb + i) * D + kk) = pg8::pk4_fp8(h);
                *(LDSP u32x2v*)(HT + i * LDT + lane * 4) = hb; }
            if (kc < 3) {
#pragma unroll
                for (int i = 0; i < NR; ++i) xq[i] = *(const u32x2v*)(xrow(p, tb + i) + kk + 256); }
            asm volatile("s_waitcnt lgkmcnt(0)" ::: "memory");
#pragma unroll
            for (int ks = 0; ks < 8; ++ks) { const bf16x8v vfr = frag_row(HT, LDT, 0, 32 * ks, lane);
                acc[0] = mfma16(frag_row(WR, LDW, 0, kc * 256 + 32 * ks, lane), vfr, acc[0]);
                acc[1] = mfma16(frag_row(WR, LDW, 16, kc * 256 + 32 * ks, lane), vfr, acc[1]); }
            asm volatile("s_waitcnt lgkmcnt(0)" ::: "memory");
        }
        float bgs = -1e30f; int bgi = 0, e1 = 0, e2 = 0; float w1 = 0.f, w2 = 0.f;
#pragma unroll
        for (int ut = 0; ut < 2; ++ut) { const int gi = ut * 4 + G; float m1 = -1e30f, m2 = -1e30f, s1 = 0.f, s2 = 0.f; int i1 = 0, i2 = 0;
#pragma unroll
            for (int r = 0; r < 4; ++r) { const float sv = 1.0f / (1.0f + __expf(-acc[ut][r])), vv = sv + p.router_bias[gi * 4 + r];
                if (vv > m1) { m2 = m1; i2 = i1; s2 = s1; m1 = vv; i1 = gi * 4 + r; s1 = sv; } else if (vv > m2) { m2 = vv; i2 = gi * 4 + r; s2 = sv; } }
            if (m1 + m2 > bgs) { bgs = m1 + m2; bgi = gi; e1 = i1; e2 = i2; w1 = s1; w2 = s2; } }
#pragma unroll
        for (int o = 16; o <= 32; o <<= 1) {
            const float ogs = shx(bgs, o, lane), ow1 = shx(w1, o, lane), ow2 = shx(w2, o, lane); const int ogi = shxi(bgi, o, lane), oe1 = shxi(e1, o, lane), oe2 = shxi(e2, o, lane);
            if (ogs > bgs || (ogs == bgs && ogi < bgi)) { bgs = ogs; bgi = ogi; e1 = oe1; e2 = oe2; w1 = ow1; w2 = ow2; } }
        if (G == 0 && li < NR) {
            const int t = tb + li; const float inv = 1.0f / (w1 + w2);
            const int r1 = atomicAdd(&counts[e1 * 32], 1), r2 = atomicAdd(&counts[e2 * 32], 1);
            p.MAP[(size_t)e1 * T + r1] = t; p.MAP[(size_t)e2 * T + r2] = t;
            p.TOKSLOT[t * 4 + 0] = e1; p.TOKSLOT[t * 4 + 1] = r1; p.TOKSLOT[t * 4 + 2] = e2; p.TOKSLOT[t * 4 + 3] = r2;
            p.EW[t * 2 + 0] = w1 * inv; p.EW[t * 2 + 1] = w2 * inv;
        }
}
DI void ph_normroute(const P& p, int l, int t0, LDSP unsigned char* lds) {
    const int tid_ = ltid(), lane = tid_ & 63, wv = tid_ >> 6, gw = blockIdx.x * NWV + wv, NW = gridDim.x * NWV, G = lane >> 4, li = lane & 15;
    const float* MODl = p.MOD + (size_t)l * 9 * 6144; int* counts = p.counts + l * 32 * 32;
    constexpr int LDW = 1032, LDT = 264;
    LDSP bf16_t* WR = (LDSP bf16_t*)lds;
    LDSP bf16_t* HT = WR + 32 * LDW + wv * 16 * LDT;
    { u32x4v wv_[8];
#pragma unroll
      for (int q = 0; q < 8; ++q) wv_[q] = *(const u32x4v*)(p.WRT + (size_t)(tid_ + q * NTHR) * 8);
#pragma unroll
      for (int q = 0; q < 8; ++q) { const int c = tid_ + q * NTHR; *(LDSP u32x4v*)(WR + (c >> 7) * LDW + (c & 127) * 8) = wv_[q]; } }
    __syncthreads();
    const float* g2 = p.norm2_g + l * D;
    const int ntok = T - t0, nfull = (ntok >> 4) / NW * NW, nrem = ntok - nfull * 16;
    for (int tile = gw; tile < nfull; tile += NW) normroute_tile<16>(p, t0 + tile * 16, MODl, counts, g2, WR, HT, lane, G, li);
    for (int e = gw; e < nrem; e += NW) normroute_tile<1>(p, t0 + nfull * 16 + e, MODl, counts, g2, WR, HT, lane, G, li);
}

DI void ph_combine(const P& p, int l, int t0, const unsigned char* Y  , LDSP int* ps  ) {
    const int tid_ = ltid(), lane = tid_ & 63, gw = blockIdx.x * NWV + __builtin_amdgcn_readfirstlane(tid_ >> 6)  , NW = gridDim.x * NWV;
    const float* MODl = p.MOD + (size_t)l * 9 * 6144; const int* counts = p.counts + l * 32 * 32;
    if (tid_ < 64) { const int cnt = tid_ < 32 ? counts[tid_ * 32] : 0; int pc = cnt;
#pragma unroll
        for (int o = 1; o < 32; o <<= 1) { const int src = lane >= o ? lane - o : lane; const int a = shli(pc, src); if (lane >= o) pc += a; }
        if (tid_ < 32) ps[tid_] = pc - cnt; }
    __syncthreads();
    for (int t = t0 + 4 * gw; t < T; t += 4 * NW) {
        int4 sl[4]; float4 ew[2];
#pragma unroll
        for (int u = 0; u < 4; ++u) sl[u] = *(const int4*)(p.TOKSLOT + (size_t)(t + u) * 4);
        ew[0] = *(const float4*)(p.EW + (size_t)t * 2); ew[1] = *(const float4*)(p.EW + (size_t)(t + 2) * 2);
        unsigned yr[4][2][4];
#pragma unroll
        for (int u = 0; u < 4; ++u) { const unsigned char* y0 = Y + (size_t)__builtin_amdgcn_readfirstlane(ps[sl[u].x] + sl[u].y) * D; const unsigned char* y1 = Y + (size_t)__builtin_amdgcn_readfirstlane(ps[sl[u].z] + sl[u].w) * D;
#pragma unroll
            for (int i = 0; i < 4; ++i) { yr[u][0][i] = *(const unsigned*)(y0 + (i * 64 + lane) * 4); yr[u][1][i] = *(const unsigned*)(y1 + (i * 64 + lane) * 4); } }
        const float* mrow = MODl + (size_t)tok_modrow(t) * 6144; const float* g5 = mrow + 5 * 1024;
        const float* mr1 = p.MOD + (size_t)9 * 6144 + (size_t)tok_modrow(t) * 6144;
#pragma unroll
        for (int pr = 0; pr < 2; ++pr) {
            const float wgt[2][2] = {{ew[pr].x, ew[pr].y}, {ew[pr].z, ew[pr].w}};
            u32x2v xr[2][4];
#pragma unroll
            for (int u = 0; u < 2; ++u)
#pragma unroll
                for (int i = 0; i < 4; ++i) xr[u][i] = *(const u32x2v*)(xrow(p, t + 2 * pr + u) + (i * 64 + lane) * 4);
            float4 v[2][4];
#pragma unroll
            for (int i = 0; i < 4; ++i) { const int c = (i * 64 + lane) * 4; const float4 gg = *(const float4*)(g5 + c);
#pragma unroll
                for (int u = 0; u < 2; ++u) { const u32x2v x = xr[u][i]; const int a = (int)yr[2 * pr + u][0][i], b = (int)yr[2 * pr + u][1][i]; const float w1 = wgt[u][0], w2 = wgt[u][1];
                    v[u][i].x = __uint_as_float(x.x << 16) + gg.x * (w1 * __builtin_amdgcn_cvt_f32_fp8(a, 0) + w2 * __builtin_amdgcn_cvt_f32_fp8(b, 0));
                    v[u][i].y = __uint_as_float(x.x & 0xffff0000u) + gg.y * (w1 * __builtin_amdgcn_cvt_f32_fp8(a, 1) + w2 * __builtin_amdgcn_cvt_f32_fp8(b, 1));
                    v[u][i].z = __uint_as_float(x.y << 16) + gg.z * (w1 * __builtin_amdgcn_cvt_f32_fp8(a, 2) + w2 * __builtin_amdgcn_cvt_f32_fp8(b, 2));
                    v[u][i].w = __uint_as_float(x.y & 0xffff0000u) + gg.w * (w1 * __builtin_amdgcn_cvt_f32_fp8(a, 3) + w2 * __builtin_amdgcn_cvt_f32_fp8(b, 3));
                    if (l == 0) *(u32x2v*)(xrow(p, t + 2 * pr + u) + c) = mk2(pk2(v[u][i].x, v[u][i].y), pk2(v[u][i].z, v[u][i].w)); } }
            float rstd[2];
#pragma unroll
            for (int u = 0; u < 2; ++u) { float ss = 0.f;
#pragma unroll
                for (int i = 0; i < 4; ++i) ss += v[u][i].x * v[u][i].x + v[u][i].y * v[u][i].y + v[u][i].z * v[u][i].z + v[u][i].w * v[u][i].w;
                rstd[u] = rsqrtf(wave_sum(ss, lane) * (1.0f / D) + 1e-6f); }
            if (l == 0) {
#pragma unroll
                for (int i = 0; i < 4; ++i) { const int c = (i * 64 + lane) * 4;
                    const float4 gg = *(const float4*)(p.norm1_g + D + c), sh = *(const float4*)(mr1 + c), sc = *(const float4*)(mr1 + 1024 + c);
#pragma unroll
                    for (int u = 0; u < 2; ++u) { const float r = rstd[u];
                        *(unsigned*)((unsigned char*)p.H + (size_t)(t + 2 * pr + u) * D + c) = pg8::pk4_fp8((pg8::f32x4){v[u][i].x * r * gg.x * (1.f + sc.x) + sh.x, v[u][i].y * r * gg.y * (1.f + sc.y) + sh.y, v[u][i].z * r * gg.z * (1.f + sc.z) + sh.z, v[u][i].w * r * gg.w * (1.f + sc.w) + sh.w}); } }
            } else {
#pragma unroll
                for (int u = 0; u < 2; ++u)
#pragma unroll
                    for (int i = 0; i < 4; ++i) { const float4 gg = ((const float4*)p.final_g)[i * 64 + lane]; const float r = rstd[u];
                        ((float4*)(p.out + (size_t)(t + 2 * pr + u - TC) * D))[i * 64 + lane] = make_float4(v[u][i].x * r * gg.x, v[u][i].y * r * gg.y, v[u][i].z * r * gg.z, v[u][i].w * r * gg.w); }
            }
        }
    }
}

#define XLAS __attribute__((address_space(3)))
#define XB_TMO      128
#define XB_XCNT(j)  (256  + 64 * (j))
#define XB_XSUB(j)  (1280 + 64 * (j))
#define XB_XGEN(j)  (2304 + 64 * (j))
#define XB_TOP      3328
#define XB_TOPGEN   3392
#define XCD_BAR_WORDS 3456
#define XB_SPIN_CAP (1u << 18)

__device__ __forceinline__ unsigned xb_ld(unsigned* p)              { return __hip_atomic_load(p, __ATOMIC_RELAXED, __HIP_MEMORY_SCOPE_AGENT); }
__device__ __forceinline__ unsigned xb_add(unsigned* p, unsigned v) { return __hip_atomic_fetch_add(p, v, __ATOMIC_RELAXED, __HIP_MEMORY_SCOPE_AGENT); }
__device__ __forceinline__ unsigned xb_xcc_id() { return (unsigned)__builtin_amdgcn_s_getreg((3 << 11) | 20) & 0xFu; }
#define XB_SPIN(cond, bar) do { unsigned _sp = 0; while (cond) { __builtin_amdgcn_s_sleep(1); \
    if ((++_sp & 255u) == 0u) { if (xb_ld(&(bar)[XB_TMO])) break; if (_sp > XB_SPIN_CAP) { atomicAdd(&(bar)[XB_TMO], 1u); break; } } } } while (0)

struct XcdBarrier {
    unsigned* bar; unsigned x;
    volatile XLAS unsigned* st;
};

__device__ __forceinline__ XcdBarrier xcd_barrier_post(unsigned* bar, volatile XLAS unsigned* st) {
    XcdBarrier b; b.bar = bar; b.x = xb_xcc_id(); b.st = st;
    if (ltid() == 0) (void)xb_add(&bar[XB_XCNT(b.x)], 1u);
    return b;
}
__device__ __forceinline__ void xcd_barrier_complete(unsigned* bar, unsigned x, unsigned& nloc, unsigned& nx) {
    const unsigned G = gridDim.x * gridDim.y * gridDim.z;
    unsigned sum, cnt, mine, sp = 0u;
    for (;;) {
        sum = 0u; cnt = 0u; mine = 0u;
#pragma unroll
        for (unsigned j = 0; j < 16; ++j) { const unsigned c = xb_ld(&bar[XB_XCNT(j)]); sum += c; cnt += (c > 0u) ? 1u : 0u; mine = (j == x) ? c : mine; }
        if (sum == G) break;
        __builtin_amdgcn_s_sleep(1);
        if ((++sp & 255u) == 0u) { if (xb_ld(&bar[XB_TMO])) break; if (sp > XB_SPIN_CAP) { atomicAdd(&bar[XB_TMO], 1u); break; } }
    }
    nloc = mine > 0u ? mine : 1u; nx = cnt > 0u ? cnt : 1u;
}

__device__ __forceinline__ void xcd_barrier(const XcdBarrier& b) {
    asm volatile("s_waitcnt vmcnt(0)" ::: "memory");
    __syncthreads();
    if (ltid() == 0) {
        unsigned* bar = b.bar;
        __builtin_amdgcn_s_waitcnt(0);
        unsigned nloc = b.st[0], nx = b.st[1];
        if (nloc == 0u) { xcd_barrier_complete(bar, b.x, nloc, nx); b.st[0] = nloc; b.st[1] = nx; }
        const unsigned old = xb_add(&bar[XB_XSUB(b.x)], 1u);
        const unsigned gen = old / nloc;
        if (old + 1u == (gen + 1u) * nloc) {
            __builtin_amdgcn_fence(__ATOMIC_RELEASE, "agent");
            asm volatile("s_waitcnt vmcnt(0)" ::: "memory");
            const unsigned og = xb_add(&bar[XB_TOP], 1u);
            const unsigned tg = og / nx;
            if (og + 1u == (tg + 1u) * nx) xb_add(&bar[XB_TOPGEN], 1u);
            else XB_SPIN(xb_ld(&bar[XB_TOPGEN]) == tg, bar);
            __builtin_amdgcn_fence(__ATOMIC_ACQUIRE, "agent");
            xb_add(&bar[XB_XGEN(b.x)], 1u);
            asm volatile("s_waitcnt vmcnt(0)" ::: "memory");
        } else {
            XB_SPIN(xb_ld(&bar[XB_XGEN(b.x)]) == gen, bar);
            __builtin_amdgcn_fence(__ATOMIC_ACQUIRE, "agent");
            asm volatile("s_waitcnt vmcnt(0)" ::: "memory");
        }
    }
    __syncthreads();
}

DI void moe_table(const P& p, int l, PG8_LAS int* tab) {
    const int tid_ = ltid();
    if (tid_ < 64) { const int cnt = tid_ < 32 ? p.counts[(l * 32 + tid_) * 32] : 0; const int nt = (cnt + 255) >> 8; int pt = nt, pc = cnt;
#pragma unroll
        for (int o = 1; o < 32; o <<= 1) { const int ln_ = tid_ & 63, src = ln_ >= o ? ln_ - o : ln_; const int a = shli(pt, src), b = shli(pc, src); if (ln_ >= o) { pt += a; pc += b; } }
        if (tid_ < 32) { tab[tid_ + 1] = pt; tab[33 + tid_] = cnt; tab[65 + tid_] = pc - cnt; if (tid_ == 0) tab[0] = 0; } }
    __syncthreads();
}
typedef const __attribute__((address_space(4))) P* PK;
DI PK lp(PK q) { asm volatile("" : "+s"(q)); return q; }
#define PHASE(...) do { const P p = *(const P*)lp(pk); __VA_ARGS__; } while (0)

#ifndef CV_L0
#define CV_L0 7
#endif
template <int l> DI void layer(PK pk, unsigned char* smem, const XcdBarrier& xbar) {
    float* ldsf = (float*)smem; const int gw = 0, NW = 0, lane = 0;
    {
        constexpr int NG = l == 0 ? 234 : 182;
        constexpr int CV1 = l == 0 ? CV_L0 * 768 : NE * 768;
        const int G = (int)gridDim.x == 256 ? NG : (int)gridDim.x;
        if ((int)blockIdx.x < G) PHASE({ pg8::Gemm g{p.H, (const bf16_t*)((const unsigned char*)p.WinT + (size_t)l * NPAD_IN * D), T, NPAD_IN, D / 2}; pg8::StaticOrder S; S.init(T, NPAD_IN, G, (int)blockIdx.x);
            pg8::EpiProj E{p.PROJ, LDP, INDIM, 1.0f / 64.0f};
            pg8::gemm_phase<pg8::EpiProj, pg8::StaticOrder, false, PG8_SP2, 1>((PG8_LAS unsigned char*)smem, g, S, E, nullptr); });
        else PHASE(ph_convert_experts(p, l, ldsf, G, (int)gridDim.x - G, 0, CV1));
        if ((int)gridDim.x != 256) PHASE(ph_convert_experts(p, l, ldsf, 0, (int)gridDim.x, 0, CV1));
    }
    xcd_barrier(xbar);
    PHASE(ph_prep(p, l, (LDSP unsigned char*)smem));
    xcd_barrier(xbar);
    PHASE(ph_s1(p, l, (LDSP unsigned char*)smem));
    xcd_barrier(xbar);
    PHASE(ph_s2(p));
    xcd_barrier(xbar);
    PHASE(ph_s3(p, l, (LDSP unsigned char*)smem));
    xcd_barrier(xbar);
    {
        constexpr int ro = l == 0 ? 0 : TC;
        constexpr int NG = l == 0 ? 182 : 256;
        const int G = (int)gridDim.x == 256 ? NG : (int)gridDim.x;
        if ((int)blockIdx.x < G) PHASE({ pg8::Gemm g{p.H + (size_t)ro * D, p.WoutT + (size_t)l * D * D, T - ro, D, D}; pg8::StaticOrder S; S.init(T - ro, D, G, (int)blockIdx.x);
            pg8::EpiResGate<l != 0> E{p.SSQ, p.ctx, p.x, p.XB, p.MOD + (size_t)l * 9 * 6144 + 2 * 1024, p.XSS, ro};
            pg8::gemm_phase<pg8::EpiResGate<l != 0>, pg8::StaticOrder>((PG8_LAS unsigned char*)smem, g, S, E, nullptr); });
        else if (l == 0) PHASE(ph_convert_experts(p, l, ldsf, G, (int)gridDim.x - G, CV_L0 * 768, NE * 768));
        if (l == 0 && (int)gridDim.x != 256) PHASE(ph_convert_experts(p, l, ldsf, 0, (int)gridDim.x, CV_L0 * 768, NE * 768));
    }
    xcd_barrier(xbar);
    const int t0 = l == 0 ? 0 : TC;
    PHASE(ph_normroute(p, l, t0, (LDSP unsigned char*)smem));
    xcd_barrier(xbar);
    PG8_LAS int* tab = (PG8_LAS int*)((PG8_LAS unsigned char*)smem + pg8::STAGE_BYTES);
#pragma unroll
    for (int ph = 0; ph < 2; ++ph) {
        PHASE(moe_table(p, l, tab));
        const int U = __builtin_amdgcn_readfirstlane(tab[32]) * 4;
        if (ph == 0) PHASE({ pg8::Gemm g{p.H, p.WguT, T, D, D / 2}; pg8::MoeSched S{tab, p.MAP, U, (int)gridDim.x, (int)blockIdx.x, 4, 1, (size_t)D * D};
            pg8::EpiAct E{(unsigned char*)p.SS}; pg8::gemm_phase_moe<pg8::EpiAct, pg8::MoeSched, false, PG8_SP2, 1>((PG8_LAS unsigned char*)smem, g, S, E, nullptr); });
        else PHASE({ pg8::Gemm g{p.SS, p.WdT, T, D, 256}; pg8::MoeSched S{tab, p.MAP, U, (int)gridDim.x, (int)blockIdx.x, 4, 0, (size_t)D * 512};
            pg8::EpiY E{(unsigned char*)p.PROJ}; pg8::gemm_phase_moe<pg8::EpiY, pg8::MoeSched, false, PG8_SP2, 1>((PG8_LAS unsigned char*)smem, g, S, E, nullptr); });
        xcd_barrier(xbar);
    }
    PHASE(ph_combine(p, l, t0, (const unsigned char*)p.PROJ, (LDSP int*)smem));
    xcd_barrier(xbar);
}

__global__ void __launch_bounds__(NTHR) mega(P p_arg) {
    extern __shared__ __attribute__((aligned(16))) unsigned char smem[];
    cg::grid_group grid = cg::this_grid();
    PK pk = (PK)__builtin_amdgcn_kernarg_segment_ptr();
    const int lane = 0, gw = 0, NW = 0;
    float* ldsf = (float*)smem;
    volatile XLAS unsigned* bst = (volatile XLAS unsigned*)((XLAS unsigned char*)smem + LDS_BYTES - 16);
    { const int t_ = ltid(); if (t_ < 2) bst[t_] = 0u; }
    __syncthreads();
    const XcdBarrier xbar = xcd_barrier_post(pk->BAR, bst);
    PHASE(ph_init(p)); PHASE(ph_mod(p, ldsf)); PHASE(ph_convert_small(p, ldsf, gw, NW, lane));
    grid.sync();
    PHASE(ph_normmod1(p, 0, gw, NW, lane));
    xcd_barrier(xbar);
    layer<0>(pk, smem, xbar);
    layer<1>(pk, smem, xbar);
}

static inline size_t al(size_t x) { return (x + 255) & ~(size_t)255; }

extern "C" void kernel_launch(void* const* d_in, const int* in_sizes, int n_in, void* d_out, int out_size, void* d_ws, size_t ws_size, hipStream_t stream) {
    static int grid_blocks = 0;
    if (grid_blocks == 0) {
        int dev = 0, cus = 0, per_cu = 0;
        if (hipFuncSetAttribute((const void*)mega, hipFuncAttributeMaxDynamicSharedMemorySize, LDS_BYTES) != hipSuccess) { fprintf(stderr, "hipFuncSetAttribute failed\n"); grid_blocks = -1; return; }
        (void)hipGetDevice(&dev); (void)hipDeviceGetAttribute(&cus, hipDeviceAttributeMultiprocessorCount, dev);
        if (hipOccupancyMaxActiveBlocksPerMultiprocessor(&per_cu, (const void*)mega, NTHR, LDS_BYTES) != hipSuccess || per_cu < 1) { fprintf(stderr, "occupancy query: %d blocks/CU\n", per_cu); grid_blocks = -1; return; }
        grid_blocks = cus;
    }
    if (grid_blocks < 0) return;
    P p{};
    const float** pin = (const float**)&p;
    for (int i = 0; i < 29; ++i) pin[i] = (const float*)d_in[i];
    p.out = (float*)d_out;
    char* ws = (char*)d_ws; size_t off = 0;
    auto take = [&](size_t bytes) { char* q = ws + off; off += al(bytes); return q; };
    p.XB = (bf16_t*)take((size_t)T * D * 2);
    p.H = (bf16_t*)take((size_t)T * D * 2);
    p.PROJ = (bf16_t*)take((size_t)T * LDP * 2);
    p.SS = (bf16_t*)take((size_t)NTILE * 8 * 2 * 4096 * 2);
    p.GS = (bf16_t*)take((size_t)NTILE * 4 * 2 * 8192 * 2);
    p.SDEC = (float*)take((size_t)NTILE * 8 * 2 * 4);
    p.GDEC = (float*)take((size_t)NTILE * 4 * 2 * 64 * 4);
    p.MOD = (float*)take((size_t)2 * 9 * 6144 * 4);
    p.counts = (int*)take(64 * 32 * 4);
    p.TOKSLOT = (int*)take((size_t)T * 4 * 4);
    p.EW = (float*)take((size_t)T * 2 * 4);
    p.MAP = (int*)take((size_t)NE * T * 4);
    p.WinT = (bf16_t*)take((size_t)2 * NPAD_IN * D * 2);
    p.WoutT = (bf16_t*)take((size_t)2 * D * D * 2);
    p.WguT = (bf16_t*)take((size_t)NE * D * D * 2);
    p.WdT = (bf16_t*)take((size_t)NE * D * 512 * 2);
    p.WRT = (bf16_t*)take((size_t)32 * 1024 * 2);
    p.BAR = (unsigned*)take(XCD_BAR_WORDS * 4);
    p.XBCC = (bf16_t*)d_out;
    p.QKB = (bf16_t*)d_out + (size_t)T * 768;
    p.SSC = (float*)take((size_t)T * 8 * 4 * 4);
    p.STOT = (float*)take((size_t)NTILE * 8 * 2 * 4);
    p.SSQ = (float*)take((size_t)T * 8 * 4);
    p.XSS = (float*)take((size_t)T * 16 * 4);
    if (off > ws_size) { fprintf(stderr, "workspace too small: need %zu have %zu\n", off, ws_size); return; }
    if (hipMemsetAsync(p.BAR, 0, XCD_BAR_WORDS * 4, stream) != hipSuccess) { fprintf(stderr, "memset of barrier words failed\n"); return; }
    void* args[] = {&p};
    hipError_t e = hipLaunchCooperativeKernel((void*)mega, dim3(grid_blocks), dim3(NTHR), args, LDS_BYTES, stream);
    if (e != hipSuccess) fprintf(stderr, "cooperative launch failed: %s (grid %d)\n", hipGetErrorString(e), grid_blocks);
}
```

```cpp
#include <hip/hip_runtime.h>
#include <hip/hip_cooperative_groups.h>
#include <stdint.h>
#include <cstdio>
namespace cg = cooperative_groups;

typedef unsigned short bf16_t;
#define DI __device__ __forceinline__

constexpr int D = 1024, NB = 8, SEQ = 4096, CTXL = 256, TC = NB * CTXL, TL = NB * SEQ, T = TC + TL;
constexpr int INDIM = 2840, LDP = 2848;
constexpr int OFF_Z = 0, OFF_XBC = 512, OFF_DT = 1280, OFF_Q = 1288, OFF_K = 1544, OFF_V = 1800, OFF_GO = 2312, OFF_GK = 2824;
constexpr int NE = 32;

DI float bf2f(bf16_t v) { return __uint_as_float(((unsigned)v) << 16); }
typedef float f32x2v_ __attribute__((ext_vector_type(2)));
typedef __bf16 bf16x2v_ __attribute__((ext_vector_type(2)));
DI bf16_t f2bf(float f) { return __builtin_bit_cast(unsigned short, (__bf16)f); }
DI float siluf(float x) { return x * __builtin_amdgcn_rcpf(1.0f + __builtin_amdgcn_exp2f(-1.4426950408889634f * x)); }
DI float softplusf(float x) { return fmaxf(x, 0.f) + log1pf(__expf(-fabsf(x))); }
DI float logsigmoidf(float x) { return -softplusf(-x); }
DI float shx(float v, int o, int lane) { return __int_as_float(__builtin_amdgcn_ds_bpermute((lane ^ o) << 2, __float_as_int(v))); }
DI int shxi(int v, int o, int lane) { return __builtin_amdgcn_ds_bpermute((lane ^ o) << 2, v); }
DI float shl(float v, int src) { return __int_as_float(__builtin_amdgcn_ds_bpermute(src << 2, __float_as_int(v))); }
DI int shli(int v, int src) { return __builtin_amdgcn_ds_bpermute(src << 2, v); }
DI float wave_sum(float v, int lane) {
#pragma unroll
    for (int o = 32; o >= 1; o >>= 1) v += shx(v, o, lane);
    return v;
}
DI int ltid() { const int wv = __builtin_amdgcn_readfirstlane(threadIdx.x >> 6);
    int ln; asm volatile("v_mbcnt_lo_u32_b32 %0, -1, 0\n\tv_mbcnt_hi_u32_b32 %0, -1, %0" : "=v"(ln));
    return wv * 64 + ln; }
DI int tok_modrow(int t) { return t < TC ? 8 : ((t - TC) >> 12); }
template <class PT> DI bf16_t* xrow(const PT& p, int t) { return p.XB + (size_t)t * D; }


#ifndef PG8_SP2
#define PG8_SP2 true
#endif
namespace pg8 {
#define PG8_LAS __attribute__((address_space(3)))
typedef unsigned short bf16_t;
typedef short bf16x8 __attribute__((ext_vector_type(8)));
typedef float f32x4 __attribute__((ext_vector_type(4)));
typedef unsigned u32x4 __attribute__((ext_vector_type(4)));
constexpr int BM = 256, BK = 64, HALF = 128, HTB = HALF * BK * 2  , STAGE_BYTES = 8 * HTB, NXCD = 8, WGM = 8;

__host__ __device__ __forceinline__ int lds_byte(int r, int c) { const int st = (r >> 4) * 2 + (c >> 5), rr = r & 15, cc = c & 31, ob = rr * 64 + cc * 2; return st * 1024 + (ob ^ (((ob >> 9) & 1) << 5)); }
__host__ __device__ __forceinline__ void stage_rc(int b, int& R, int& C) { const int st = b / 1024, sb = b % 1024, swz = sb ^ (((sb >> 9) & 1) << 5); R = (st >> 1) * 16 + swz / 64; C = (st & 1) * 32 + (swz % 64) / 2; }
__host__ __device__ __forceinline__ int perm32(int rho) { const int n = rho >> 4, i = rho & 15; return 8 * (i >> 2) + 4 * n + (i & 3); }

struct Unit { int pm, pn; };
struct Gemm { const bf16_t* A; const bf16_t* Bt; int M, N, K; };

struct StaticOrder {
    int nM, nN, nwg, G, c;
    __host__ __device__ void init(int M, int N, int G_, int c_) { nM = M / BM; nN = N / BM; nwg = nM * nN; G = G_; c = c_; }
    __host__ __device__ bool next(int i, Unit& u) const {
        const long L = (long)i * G + c; if (L >= nwg) return false;
        int wgid = (int)L; { const int q = nwg / NXCD, r = nwg % NXCD, xcd = wgid % NXCD, off = wgid / NXCD; wgid = (xcd < r ? xcd * (q + 1) : r * (q + 1) + (xcd - r) * q) + off; }
        const int nig = WGM * nN, gid = wgid / nig, fm = gid * WGM, gsz = (nM - fm) < WGM ? (nM - fm) : WGM;
        u.pm = fm + ((wgid % nig) % gsz); u.pn = (wgid % nig) / gsz; return true;
    }
    __device__ __forceinline__ void a_ready(const Unit&) const {}
    __device__ __forceinline__ void done(const Unit&) const {}
};
__device__ __forceinline__ unsigned cvt_pk_bf16(float lo, float hi) { unsigned r; asm volatile("v_cvt_pk_bf16_f32 %0, %1, %2" : "=v"(r) : "v"(lo), "v"(hi)); return r; }
typedef float f32x2 __attribute__((ext_vector_type(2)));

typedef int i32x4 __attribute__((ext_vector_type(4)));
typedef int i32x8 __attribute__((ext_vector_type(8)));
__device__ __forceinline__ i32x8 cat8(bf16x8 a, bf16x8 b) { return __builtin_shufflevector(__builtin_bit_cast(i32x4, a), __builtin_bit_cast(i32x4, b), 0, 1, 2, 3, 4, 5, 6, 7); }
__device__ __forceinline__ void mfma8(f32x4& c, i32x8 a, i32x8 b) { asm volatile("v_mfma_f32_16x16x128_f8f6f4 %0, %1, %2, %0" : "+v"(c) : "v"(a), "v"(b)); }
__device__ __forceinline__ unsigned pk4_fp8(const f32x4 v) { const float lim = 440.f;
    int w = __builtin_amdgcn_cvt_pk_fp8_f32(__builtin_amdgcn_fmed3f(v[0], -lim, lim), __builtin_amdgcn_fmed3f(v[1], -lim, lim), 0, false);
    return (unsigned)__builtin_amdgcn_cvt_pk_fp8_f32(__builtin_amdgcn_fmed3f(v[2], -lim, lim), __builtin_amdgcn_fmed3f(v[3], -lim, lim), w, true); }
struct EpiProj {
    static constexpr bool PERM = true, AFTER_DRAIN = false, MIDK = false;
    bf16_t* O; int ldc; int ncols; float osc;
    __device__ __forceinline__ void operator()(const f32x4 (&acc)[2][2][4][2], const Unit& u, int wr, int wc, int fr, int fq) const {
        const int row0 = u.pm * BM + wr * 64 + fr, col0 = u.pn * BM + wc * 32 + 8 * fq;
#pragma unroll
        for (int ai = 0; ai < 2; ++ai)
#pragma unroll
            for (int m = 0; m < 4; ++m) { bf16_t* rowp = O + (size_t)(row0 + ai * HALF + m * 16) * ldc + col0;
#pragma unroll
                for (int bj = 0; bj < 2; ++bj) { const f32x4 v0 = acc[ai][bj][m][0] * osc, v1 = acc[ai][bj][m][1] * osc;
                    u32x4 w; w.x = cvt_pk_bf16(v0[0], v0[1]); w.y = cvt_pk_bf16(v0[2], v0[3]); w.z = cvt_pk_bf16(v1[0], v1[1]); w.w = cvt_pk_bf16(v1[2], v1[3]);
                    if (col0 + bj * HALF + 8 <= ncols) *(u32x4*)(rowp + bj * HALF) = w; } }
    }
};
template <bool SRC_BF16> struct EpiResGate {
    static constexpr bool PERM = true, AFTER_DRAIN = false, MIDK = true;
    const float* ssq;
    const float* Sc; const float* Sl;
    bf16_t* XB;
    const float* gate_rows; float* xss; int rowoff;
    template <class Sched> __device__ __forceinline__ void prep(PG8_LAS unsigned char* lds, const Sched& S, int tid) const {
        PG8_LAS float* RS = (PG8_LAS float*)(lds + STAGE_BYTES);
        const int r = tid & 255, i0 = tid >> 8;
        for (int i = i0; ; i += 2) { Unit u; if (!S.next(i, u)) break;
            const f32x4* q = (const f32x4*)(ssq + (size_t)(rowoff + u.pm * BM + r) * 8); const f32x4 a = q[0], b = q[1];
            RS[i * 256 + r] = __builtin_amdgcn_rsqf((((a[0] + a[1]) + (a[2] + a[3])) + ((b[0] + b[1]) + (b[2] + b[3]))) * (1.0f / 512.0f) + 1e-6f); }
    }
    __device__ __forceinline__ void midk(f32x4 (&acc)[2][2][4][2], PG8_LAS unsigned char* lds, int ui, int wr, int fr) const {
        int fr_ = fr; asm volatile("" : "+v"(fr_));
        PG8_LAS const float* RS = (PG8_LAS const float*)(lds + STAGE_BYTES) + ui * 256 + wr * 64 + fr_;
#pragma unroll
        for (int ai = 0; ai < 2; ++ai)
#pragma unroll
            for (int m = 0; m < 4; ++m) { const float rs = RS[ai * HALF + m * 16];
#pragma unroll
                for (int bj = 0; bj < 2; ++bj)
#pragma unroll
                    for (int n = 0; n < 2; ++n) acc[ai][bj][m][n] *= rs; }
    }
    __device__ __forceinline__ void operator()(const f32x4 (&acc)[2][2][4][2], const Unit& u, int wr, int wc, int fr, int fq) const {
        const int row0 = rowoff + u.pm * BM + wr * 64 + fr, col0 = u.pn * BM + wc * 32 + 8 * fq;
        const int t0 = rowoff + u.pm * BM; const int mrow = t0 < 2048 ? 8 : ((t0 - 2048) >> 12);
        const float* gr = gate_rows + (size_t)mrow * 6144 + col0;
        f32x4 gv[2][2];
#pragma unroll
        for (int bj = 0; bj < 2; ++bj)
#pragma unroll
            for (int n = 0; n < 2; ++n) gv[bj][n] = *(const f32x4*)(gr + bj * HALF + n * 4);
#pragma unroll
        for (int ai = 0; ai < 2; ++ai) {
            u32x4 rb[4][2]; f32x4 xf[SRC_BF16 ? 1 : 4][2][2];
#pragma unroll
            for (int m = 0; m < 4; ++m) { const int rr = row0 + ai * HALF + m * 16;
                const float* sp = (rr < 2048 ? Sc + (size_t)rr * 1024 : Sl + (size_t)(rr - 2048) * 1024) + col0; const bf16_t* dp = XB + (size_t)rr * 1024 + col0;
#pragma unroll
                for (int bj = 0; bj < 2; ++bj) {
                    if (SRC_BF16) rb[m][bj] = *(const u32x4*)(dp + bj * HALF);
                    else { xf[SRC_BF16 ? 0 : m][bj][0] = *(const f32x4*)(sp + bj * HALF); xf[SRC_BF16 ? 0 : m][bj][1] = *(const f32x4*)(sp + bj * HALF + 4); } } }
#pragma unroll
            for (int m = 0; m < 4; ++m) { const int rr = row0 + ai * HALF + m * 16;
                bf16_t* dp = XB + (size_t)rr * 1024 + col0; float ss = 0.f;
#pragma unroll
                for (int bj = 0; bj < 2; ++bj) { f32x4 x0, x1;
                    if (SRC_BF16) { const u32x4 r = rb[m][bj];
                        x0 = (f32x4){__uint_as_float(r.x << 16), __uint_as_float(r.x & 0xffff0000u), __uint_as_float(r.y << 16), __uint_as_float(r.y & 0xffff0000u)};
                        x1 = (f32x4){__uint_as_float(r.z << 16), __uint_as_float(r.z & 0xffff0000u), __uint_as_float(r.w << 16), __uint_as_float(r.w & 0xffff0000u)}; }
                    else { x0 = xf[SRC_BF16 ? 0 : m][bj][0]; x1 = xf[SRC_BF16 ? 0 : m][bj][1]; }
                    const f32x4 v0 = x0 + gv[bj][0] * acc[ai][bj][m][0], v1 = x1 + gv[bj][1] * acc[ai][bj][m][1];
                    u32x4 w; w.x = cvt_pk_bf16(v0[0], v0[1]); w.y = cvt_pk_bf16(v0[2], v0[3]); w.z = cvt_pk_bf16(v1[0], v1[1]); w.w = cvt_pk_bf16(v1[2], v1[3]);
                    *(u32x4*)(dp + bj * HALF) = w;
#pragma unroll
                    for (int j = 0; j < 4; ++j) { const float lo = __uint_as_float(w[j] << 16), hi = __uint_as_float(w[j] & 0xffff0000u); ss += lo * lo + hi * hi; } }
                { const int ln_ = fq * 16 + fr; ss += __int_as_float(__builtin_amdgcn_ds_bpermute((ln_ ^ 16) << 2, __float_as_int(ss))); ss += __int_as_float(__builtin_amdgcn_ds_bpermute((ln_ ^ 32) << 2, __float_as_int(ss))); }
                if (fq == 0) xss[(size_t)rr * 16 + u.pn * 4 + wc] = ss; }
        }
    }
};
template <class Epi, class Sched, bool STAMP = false, bool SP2 = PG8_SP2, int SCW = -1>
__device__ __forceinline__ void gemm_phase(PG8_LAS unsigned char* lds, const Gemm g, const Sched& S, const Epi& E, unsigned long long* stamps) {
    int tid_l = __builtin_amdgcn_readfirstlane(threadIdx.x >> 6) * 64 + (int)__builtin_amdgcn_mbcnt_hi(~0u, __builtin_amdgcn_mbcnt_lo(~0u, 0u)); asm volatile("" : "+v"(tid_l));
    const int tid = tid_l, wid = __builtin_amdgcn_readfirstlane(tid >> 6), lane = tid & 63, wr = wid >> 2, wc = wid & 3, fr = lane & 15, fq = lane >> 4;
    const int K = g.K, nt = K / BK;
    int ts_lo = 0, ts_hi = 0, nts = 0; const unsigned long long rt_entry = STAMP ? (unsigned long long)wall_clock64() : 0ull;
#define PG8_STAMP() do { if (STAMP && wid == 0 && nts < 64) { const unsigned long long _c = (unsigned long long)clock64(); \
        ts_lo = (lane == nts) ? (int)(unsigned)_c : ts_lo; ts_hi = (lane == nts) ? (int)(unsigned)(_c >> 32) : ts_hi; ++nts; } } while (0)
    PG8_STAMP();
    unsigned voffA[2], voffB[2];
#pragma unroll
    for (int i = 0; i < 2; ++i) { int R, C; stage_rc(tid * 16 + i * 8192, R, C); const int Rb = Epi::PERM ? ((R & ~31) + perm32(R & 31)) : R;
        voffA[i] = (unsigned)(R * K + C) * 2u; voffB[i] = (unsigned)(Rb * K + C) * 2u; }
    const size_t kstep = (size_t)(BK * 2);
    const size_t hstep = (size_t)HALF * K * 2;
    const size_t tstep = 2 * hstep;
    const unsigned ldsw = (unsigned)wid * 1024u;
    const int aoff = lds_byte(wr * 64 + fr, fq * 8), boff = lds_byte(wc * 32 + fr, fq * 8);
#define PG8_SA(b, h) (((b) * 2 + (h)) * HTB)
#define PG8_SB(b, h) ((4 + (b) * 2 + (h)) * HTB)
#define PG8_STAGE(bufoff, gbase, voff) do { _Pragma("unroll") for (int _i = 0; _i < 2; ++_i) \
        __builtin_amdgcn_global_load_lds((const unsigned*)((const char*)(gbase) + (voff)[_i]), (PG8_LAS unsigned*)(lds + (bufoff) + ldsw + _i * 8192), 16, 0, 0); } while (0)
#define PG8_LDA(dst, b, h) do { _Pragma("unroll") for (int m = 0; m < 4; ++m) _Pragma("unroll") for (int k = 0; k < 2; ++k) dst[m][k] = *(const PG8_LAS bf16x8*)(lds + PG8_SA(b, h) + aoff + m * 2048 + k * 1024); } while (0)
#define PG8_LDB(dst, b, h) do { _Pragma("unroll") for (int n = 0; n < 2; ++n) _Pragma("unroll") for (int k = 0; k < 2; ++k) dst[n][k] = *(const PG8_LAS bf16x8*)(lds + PG8_SB(b, h) + boff + n * 2048 + k * 1024); } while (0)
#define PG8_MMA(ai, bj, At, Bt) do { __builtin_amdgcn_s_setprio(1); _Pragma("unroll") for (int m = 0; m < 4; ++m) _Pragma("unroll") for (int n = 0; n < 2; ++n) { \
        if constexpr (SCW >= 0) mfma8(acc[ai][bj][m][n], cat8(Bt[n][0], Bt[n][1]), cat8(At[m][0], At[m][1])); \
        else { _Pragma("unroll") for (int k = 0; k < 2; ++k) acc[ai][bj][m][n] = __builtin_amdgcn_mfma_f32_16x16x32_bf16(Bt[n][k], At[m][k], acc[ai][bj][m][n], 0, 0, 0); } } __builtin_amdgcn_s_setprio(0); } while (0)
#define PG8_WAIT_V(n) asm volatile("s_waitcnt vmcnt(" #n ")" ::: "memory")
#define PG8_WAIT_L(n) asm volatile("s_waitcnt lgkmcnt(" #n ")" ::: "memory")
#define PG8_BAR __builtin_amdgcn_s_barrier()
#define PG8_SCHED __builtin_amdgcn_sched_barrier(0)
    Unit cur, nxt; int ui = 0;
    if (!S.next(0, cur)) return;
    f32x4 acc[2][2][4][2];
#pragma unroll
    for (int a = 0; a < 2; ++a)
#pragma unroll
        for (int b = 0; b < 2; ++b)
#pragma unroll
            for (int m = 0; m < 4; ++m)
#pragma unroll
                for (int n = 0; n < 2; ++n) acc[a][b][m][n] = (f32x4){0.f, 0.f, 0.f, 0.f};
    bf16x8 At[4][2], B0[2][2], B1[2][2];
    const char* cA = (const char*)g.A + (size_t)cur.pm * tstep; const char* cB = (const char*)g.Bt + (size_t)cur.pn * tstep;
    S.a_ready(cur);
    if constexpr (Epi::MIDK) E.prep(lds, S, tid);
    if constexpr (SP2) {
        PG8_STAGE(PG8_SB(0, 0), cB, voffB); PG8_STAGE(PG8_SB(0, 1), cB + hstep, voffB); PG8_STAGE(PG8_SA(0, 0), cA, voffA); PG8_STAGE(PG8_SA(0, 1), cA + hstep, voffA);
        if (wr == 1) PG8_BAR;
        PG8_WAIT_V(2); PG8_BAR;
        PG8_STAGE(PG8_SB(1, 0), cB + kstep, voffB); PG8_STAGE(PG8_SA(1, 0), cA + kstep, voffA); PG8_STAGE(PG8_SB(1, 1), cB + hstep + kstep, voffB);
        PG8_WAIT_V(6); PG8_BAR;
    } else {
    PG8_STAGE(PG8_SB(0, 0), cB, voffB); PG8_STAGE(PG8_SA(0, 0), cA, voffA); PG8_STAGE(PG8_SB(0, 1), cB + hstep, voffB); PG8_STAGE(PG8_SA(0, 1), cA + hstep, voffA);
    if (wr == 1) PG8_BAR;
    PG8_WAIT_V(4); PG8_BAR;
    PG8_STAGE(PG8_SB(1, 0), cB + kstep, voffB); PG8_STAGE(PG8_SA(1, 0), cA + kstep, voffA); PG8_STAGE(PG8_SB(1, 1), cB + hstep + kstep, voffB);
    PG8_WAIT_V(6); PG8_BAR;
    }
    PG8_STAMP();
    for (;;) {
        const bool has_next = S.next(ui + 1, nxt);
        const char* nA = has_next ? (const char*)g.A + (size_t)nxt.pm * tstep : cA; const char* nB = has_next ? (const char*)g.Bt + (size_t)nxt.pn * tstep : cB;
        for (int t = 0; t < nt; t += 2) {
            const bool last = (t == nt - 2);
            const char* a1 = cA + (size_t)(t + 1) * kstep;
            const char* a2 = last ? nA : cA + (size_t)(t + 2) * kstep; const char* b2 = last ? nB : cB + (size_t)(t + 2) * kstep;
            const char* a3 = a2 + kstep; const char* b3 = b2 + kstep;
            if (last && has_next) S.a_ready(nxt);
            if constexpr (SP2) {
            PG8_LDB(B0, 0, 0); PG8_LDB(B1, 0, 1); PG8_SCHED; PG8_LDA(At, 0, 0); PG8_STAGE(PG8_SA(1, 1), a1 + hstep, voffA);
            PG8_WAIT_V(8); PG8_WAIT_L(0); PG8_BAR; PG8_MMA(0, 0, At, B0); PG8_MMA(0, 1, At, B1); PG8_BAR; PG8_SCHED;
            PG8_LDA(At, 0, 1); PG8_STAGE(PG8_SB(0, 0), b2, voffB); PG8_STAGE(PG8_SB(0, 1), b2 + hstep, voffB); PG8_STAGE(PG8_SA(0, 0), a2, voffA);
            PG8_WAIT_V(8); PG8_WAIT_L(0); PG8_BAR; PG8_MMA(1, 0, At, B0); PG8_MMA(1, 1, At, B1); PG8_BAR; PG8_SCHED;
            PG8_LDB(B0, 1, 0); PG8_LDB(B1, 1, 1); PG8_SCHED; PG8_LDA(At, 1, 0); PG8_STAGE(PG8_SA(0, 1), a2 + hstep, voffA);
            PG8_WAIT_V(8); PG8_WAIT_L(0); PG8_BAR; PG8_MMA(0, 0, At, B0); PG8_MMA(0, 1, At, B1); PG8_BAR; PG8_SCHED;
            PG8_LDA(At, 1, 1); PG8_STAGE(PG8_SB(1, 0), b3, voffB); PG8_STAGE(PG8_SB(1, 1), b3 + hstep, voffB); PG8_STAGE(PG8_SA(1, 0), a3, voffA);
            PG8_WAIT_V(8); PG8_WAIT_L(0); PG8_BAR; PG8_MMA(1, 0, At, B0); PG8_MMA(1, 1, At, B1); PG8_BAR; PG8_SCHED;
            } else {
            PG8_LDB(B0, 0, 0); PG8_SCHED; PG8_LDA(At, 0, 0); PG8_STAGE(PG8_SA(1, 1), a1 + hstep, voffA);
            PG8_WAIT_L(8); PG8_BAR; PG8_WAIT_L(0); PG8_MMA(0, 0, At, B0); PG8_BAR; PG8_SCHED;
            PG8_LDB(B1, 0, 1); PG8_STAGE(PG8_SB(0, 0), b2, voffB);
            PG8_BAR; PG8_WAIT_L(0); PG8_MMA(0, 1, At, B1); PG8_BAR;
            PG8_LDA(At, 0, 1); PG8_STAGE(PG8_SA(0, 0), a2, voffA);
            PG8_BAR; PG8_WAIT_L(0); PG8_MMA(1, 0, At, B0); PG8_BAR; PG8_SCHED;
            PG8_STAGE(PG8_SB(0, 1), b2 + hstep, voffB);
            PG8_WAIT_V(6); PG8_BAR; PG8_MMA(1, 1, At, B1); PG8_BAR;
            PG8_LDB(B0, 1, 0); PG8_SCHED; PG8_LDA(At, 1, 0); PG8_STAGE(PG8_SA(0, 1), a2 + hstep, voffA);
            PG8_WAIT_L(8); PG8_BAR; PG8_WAIT_L(0); PG8_MMA(0, 0, At, B0); PG8_BAR; PG8_SCHED;
            PG8_LDB(B1, 1, 1); PG8_STAGE(PG8_SB(1, 0), b3, voffB);
            PG8_BAR; PG8_WAIT_L(0); PG8_MMA(0, 1, At, B1); PG8_BAR;
            PG8_LDA(At, 1, 1); PG8_STAGE(PG8_SA(1, 0), a3, voffA);
            PG8_BAR; PG8_WAIT_L(0); PG8_MMA(1, 0, At, B0); PG8_BAR; PG8_SCHED;
            PG8_STAGE(PG8_SB(1, 1), b3 + hstep, voffB);
            PG8_WAIT_V(6); PG8_BAR; PG8_MMA(1, 1, At, B1); PG8_BAR;
            }
            if constexpr (Epi::MIDK) { if (t + 2 == nt / 2) E.midk(acc, lds, ui, wr, fr); }
        }
        PG8_STAMP();
        if (wr == 0) PG8_BAR;
        if constexpr (SCW >= 0) asm volatile("s_nop 15\n\ts_nop 15" ::: "memory");
        if constexpr (!Epi::AFTER_DRAIN) { E(acc, cur, wr, wc, fr, fq); S.done(cur); }
        PG8_STAMP();
        if (!has_next) break;
#pragma unroll
        for (int a = 0; a < 2; ++a)
#pragma unroll
            for (int b = 0; b < 2; ++b)
#pragma unroll
                for (int m = 0; m < 4; ++m)
#pragma unroll
                    for (int n = 0; n < 2; ++n) acc[a][b][m][n] = (f32x4){0.f, 0.f, 0.f, 0.f};
        cur = nxt; cA = nA; cB = nB; ++ui;
        if (wr == 1) PG8_BAR;
    }
    PG8_WAIT_V(0);
    PG8_BAR;
    if constexpr (Epi::AFTER_DRAIN) { E.fused(acc, cur, wr, wc, fr, fq, lds, wid, lane); S.done(cur); }
    PG8_STAMP();
    if (STAMP && wid == 0) { stamps[lane] = lane < nts ? (((unsigned long long)(unsigned)ts_hi << 32) | (unsigned)ts_lo) : 0ull;
        if (lane == 62) stamps[62] = rt_entry; if (lane == 63) stamps[63] = (unsigned long long)wall_clock64(); }
#undef PG8_STAMP
#undef PG8_SA
#undef PG8_SB
#undef PG8_STAGE
#undef PG8_LDA
#undef PG8_LDB
#undef PG8_MMA
#undef PG8_WAIT_V
#undef PG8_WAIT_L
#undef PG8_BAR
#undef PG8_SCHED
}

struct MoeUnit { int e, mt, pn, cnt, pstart; };
struct MoeSched {
    typedef MoeUnit UnitT;
    PG8_LAS const int* tab; const int* map; int U, G, c, npn, gather; size_t bstride;
    __device__ __forceinline__ bool next(int i, MoeUnit& u) const {
        const long L = (long)i * G + c; if (L >= U) return false;
        int idx = (int)L; { const int q = U / NXCD, r = U % NXCD, xcd = idx % NXCD, off = idx / NXCD; idx = (xcd < r ? xcd * (q + 1) : r * (q + 1) + (xcd - r) * q) + off; }
        const int tau = idx / npn; u.pn = idx - tau * npn;
        int e = 0;
#pragma unroll
        for (int st = 16; st >= 1; st >>= 1) { if (__builtin_amdgcn_readfirstlane(tab[e + st]) <= tau) e += st; }
        u.e = e; u.mt = tau - __builtin_amdgcn_readfirstlane(tab[e]); u.cnt = __builtin_amdgcn_readfirstlane(tab[33 + e]); u.pstart = __builtin_amdgcn_readfirstlane(tab[65 + e]);
        return true;
    }
    __device__ __forceinline__ const char* bbase(const Gemm& g, const MoeUnit& u) const { return (const char*)g.Bt + (size_t)u.e * bstride + (size_t)u.pn * BM * g.K * 2; }
    __device__ __forceinline__ void a_offsets(const Gemm& g, const MoeUnit& u, int tid, unsigned (&va)[2][2]) const {
        int tl = tid; asm volatile("" : "+v"(tl));
        int RA[2], CA[2];
#pragma unroll
        for (int i = 0; i < 2; ++i) { int R, C; stage_rc(tl * 16 + i * 8192, R, C); RA[i] = R; CA[i] = C * 2; }
#pragma unroll
        for (int hf = 0; hf < 2; ++hf)
#pragma unroll
            for (int i = 0; i < 2; ++i) { int rl = u.mt * BM + hf * HALF + RA[i]; rl = rl < u.cnt ? rl : u.cnt - 1;
                const unsigned row = gather ? (unsigned)map[(size_t)u.e * 34816 + rl] : (unsigned)(u.pstart + rl);
                va[hf][i] = row * (unsigned)(g.K * 2) + (unsigned)CA[i]; }
    }
};
struct EpiAct {
    static constexpr bool PERM = true, AFTER_DRAIN = false;
    unsigned char* O;
    __device__ __forceinline__ void operator()(const f32x4 (&acc)[2][2][4][2], const MoeUnit& u, int wr, int wc, int fr, int fq) const {
        typedef unsigned u32x2 __attribute__((ext_vector_type(2)));
        const int rl0 = u.mt * BM + wr * 64 + fr, col0 = u.pn * HALF + wc * 32 + 8 * fq;
#pragma unroll
        for (int ai = 0; ai < 2; ++ai)
#pragma unroll
            for (int m = 0; m < 4; ++m) { const int rl = rl0 + ai * HALF + m * 16;
                if (rl < u.cnt) { f32x4 o[2];
#pragma unroll
                    for (int n = 0; n < 2; ++n)
#pragma unroll
                        for (int j = 0; j < 4; ++j) { const float gv = acc[ai][0][m][n][j] * (1.0f / 64.0f)  ; o[n][j] = gv * __builtin_amdgcn_rcpf(1.0f + __builtin_amdgcn_exp2f(-1.4426950408889634f * gv)) * (acc[ai][1][m][n][j] * 0.125f)  ; }
                    *(u32x2*)(O + (size_t)(u.pstart + rl) * 512 + col0) = (u32x2){pk4_fp8(o[0]), pk4_fp8(o[1])}; } }
    }
};
struct EpiY {
    static constexpr bool PERM = true, AFTER_DRAIN = false;
    unsigned char* O;
    static __device__ __forceinline__ unsigned pk4(const f32x4 v) { const float lim = 440.f;
        int w = __builtin_amdgcn_cvt_pk_fp8_f32(fminf(fmaxf(v[0], -lim), lim), fminf(fmaxf(v[1], -lim), lim), 0, false);
        return (unsigned)__builtin_amdgcn_cvt_pk_fp8_f32(fminf(fmaxf(v[2], -lim), lim), fminf(fmaxf(v[3], -lim), lim), w, true); }
    __device__ __forceinline__ void operator()(const f32x4 (&acc)[2][2][4][2], const MoeUnit& u, int wr, int wc, int fr, int fq) const {
        typedef unsigned u32x2 __attribute__((ext_vector_type(2)));
        const int rl0 = u.mt * BM + wr * 64 + fr, col0 = u.pn * BM + wc * 32 + 8 * fq;
#pragma unroll
        for (int ai = 0; ai < 2; ++ai)
#pragma unroll
            for (int m = 0; m < 4; ++m) { const int rl = rl0 + ai * HALF + m * 16;
                if (rl < u.cnt) { unsigned char* rowp = O + (size_t)(u.pstart + rl) * 1024 + col0;
#pragma unroll
                    for (int bj = 0; bj < 2; ++bj) *(u32x2*)(rowp + bj * HALF) = (u32x2){pk4(acc[ai][bj][m][0] * (1.0f / 512.0f)), pk4(acc[ai][bj][m][1] * (1.0f / 512.0f))}; } }
    }
};
template <class Epi, class Sched, bool STAMP = false, bool SP2 = PG8_SP2, int SCW = -1, int SCA = 127>
__device__ __forceinline__ void gemm_phase_moe(PG8_LAS unsigned char* lds, const Gemm g, const Sched& S, const Epi& E, unsigned long long* stamps) {
    int tid_l = __builtin_amdgcn_readfirstlane(threadIdx.x >> 6) * 64 + (int)__builtin_amdgcn_mbcnt_hi(~0u, __builtin_amdgcn_mbcnt_lo(~0u, 0u)); asm volatile("" : "+v"(tid_l));
    const int tid = tid_l, wid = __builtin_amdgcn_readfirstlane(tid >> 6), lane = tid & 63, wr = wid >> 2, wc = wid & 3, fr = lane & 15, fq = lane >> 4;
    const int K = g.K, nt = K / BK;
    int ts_lo = 0, ts_hi = 0, nts = 0; const unsigned long long rt_entry = STAMP ? (unsigned long long)wall_clock64() : 0ull;
#define PG8_STAMP() do { if (STAMP && wid == 0 && nts < 64) { const unsigned long long _c = (unsigned long long)clock64(); \
        ts_lo = (lane == nts) ? (int)(unsigned)_c : ts_lo; ts_hi = (lane == nts) ? (int)(unsigned)(_c >> 32) : ts_hi; ++nts; } } while (0)
    PG8_STAMP();
    unsigned voffB[2];
#pragma unroll
    for (int i = 0; i < 2; ++i) { int R, C; stage_rc(tid * 16 + i * 8192, R, C); const int Rb = Epi::PERM ? ((R & ~31) + perm32(R & 31)) : R;
        voffB[i] = (unsigned)(Rb * K + C) * 2u; }
    unsigned vaC[2][2];
    PG8_LAS unsigned* vtab = (PG8_LAS unsigned*)(lds + STAGE_BYTES + 1024) + tid;
    const size_t kstep = (size_t)(BK * 2);
    const size_t hstep = (size_t)HALF * K * 2;
    const size_t tstep = 2 * hstep;
    const unsigned ldsw = (unsigned)wid * 1024u;
    const int aoff = lds_byte(wr * 64 + fr, fq * 8), boff = lds_byte(wc * 32 + fr, fq * 8);
#define PG8_SA(b, h) (((b) * 2 + (h)) * HTB)
#define PG8_SB(b, h) ((4 + (b) * 2 + (h)) * HTB)
#define PG8_STAGE(bufoff, gbase, voff) do { _Pragma("unroll") for (int _i = 0; _i < 2; ++_i) \
        __builtin_amdgcn_global_load_lds((const unsigned*)((const char*)(gbase) + (voff)[_i]), (PG8_LAS unsigned*)(lds + (bufoff) + ldsw + _i * 8192), 16, 0, 0); } while (0)
#define PG8_STAGEA(bufoff, kbyte, va) do { _Pragma("unroll") for (int _i = 0; _i < 2; ++_i) \
        __builtin_amdgcn_global_load_lds((const unsigned*)((const char*)g.A + (kbyte) + (va)[_i]), (PG8_LAS unsigned*)(lds + (bufoff) + ldsw + _i * 8192), 16, 0, 0); } while (0)
#define PG8_LDA(dst, b, h) do { _Pragma("unroll") for (int m = 0; m < 4; ++m) _Pragma("unroll") for (int k = 0; k < 2; ++k) dst[m][k] = *(const PG8_LAS bf16x8*)(lds + PG8_SA(b, h) + aoff + m * 2048 + k * 1024); } while (0)
#define PG8_LDB(dst, b, h) do { _Pragma("unroll") for (int n = 0; n < 2; ++n) _Pragma("unroll") for (int k = 0; k < 2; ++k) dst[n][k] = *(const PG8_LAS bf16x8*)(lds + PG8_SB(b, h) + boff + n * 2048 + k * 1024); } while (0)
#define PG8_MMA(ai, bj, At, Bt) do { __builtin_amdgcn_s_setprio(1); _Pragma("unroll") for (int m = 0; m < 4; ++m) _Pragma("unroll") for (int n = 0; n < 2; ++n) { \
        if constexpr (SCW >= 0) mfma8(acc[ai][bj][m][n], cat8(Bt[n][0], Bt[n][1]), cat8(At[m][0], At[m][1])); \
        else { _Pragma("unroll") for (int k = 0; k < 2; ++k) acc[ai][bj][m][n] = __builtin_amdgcn_mfma_f32_16x16x32_bf16(Bt[n][k], At[m][k], acc[ai][bj][m][n], 0, 0, 0); } } __builtin_amdgcn_s_setprio(0); } while (0)
#define PG8_WAIT_V(n) asm volatile("s_waitcnt vmcnt(" #n ")" ::: "memory")
#define PG8_WAIT_L(n) asm volatile("s_waitcnt lgkmcnt(" #n ")" ::: "memory")
#define PG8_BAR __builtin_amdgcn_s_barrier()
#define PG8_SCHED __builtin_amdgcn_sched_barrier(0)
    typename Sched::UnitT cur, nxt; int ui = 0;
    if (!S.next(0, cur)) return;
    f32x4 acc[2][2][4][2];
#pragma unroll
    for (int a = 0; a < 2; ++a)
#pragma unroll
        for (int b = 0; b < 2; ++b)
#pragma unroll
            for (int m = 0; m < 4; ++m)
#pragma unroll
                for (int n = 0; n < 2; ++n) acc[a][b][m][n] = (f32x4){0.f, 0.f, 0.f, 0.f};
    bf16x8 At[4][2], B0[2][2], B1[2][2];
    const char* cB = S.bbase(g, cur); S.a_offsets(g, cur, tid, vaC);
    if constexpr (SP2) {
        PG8_STAGE(PG8_SB(0, 0), cB, voffB); PG8_STAGE(PG8_SB(0, 1), cB + hstep, voffB); PG8_STAGEA(PG8_SA(0, 0), 0, vaC[0]); PG8_STAGEA(PG8_SA(0, 1), 0, vaC[1]);
        if (wr == 1) PG8_BAR;
        PG8_WAIT_V(2); PG8_BAR;
        PG8_STAGE(PG8_SB(1, 0), cB + kstep, voffB); PG8_STAGEA(PG8_SA(1, 0), kstep, vaC[0]); PG8_STAGE(PG8_SB(1, 1), cB + hstep + kstep, voffB);
        PG8_WAIT_V(6); PG8_BAR;
    } else {
    PG8_STAGE(PG8_SB(0, 0), cB, voffB); PG8_STAGEA(PG8_SA(0, 0), 0, vaC[0]); PG8_STAGE(PG8_SB(0, 1), cB + hstep, voffB); PG8_STAGEA(PG8_SA(0, 1), 0, vaC[1]);
    if (wr == 1) PG8_BAR;
    PG8_WAIT_V(4); PG8_BAR;
    PG8_STAGE(PG8_SB(1, 0), cB + kstep, voffB); PG8_STAGEA(PG8_SA(1, 0), kstep, vaC[0]); PG8_STAGE(PG8_SB(1, 1), cB + hstep + kstep, voffB);
    PG8_WAIT_V(6); PG8_BAR;
    }
    PG8_STAMP();
    for (;;) {
        const bool has_next = S.next(ui + 1, nxt);
        const char* nB = has_next ? S.bbase(g, nxt) : cB;
        { unsigned vaN[2][2];
          if (has_next) S.a_offsets(g, nxt, tid, vaN); else {
#pragma unroll
            for (int hf = 0; hf < 2; ++hf)
#pragma unroll
                for (int i = 0; i < 2; ++i) vaN[hf][i] = vaC[hf][i]; }
#pragma unroll
          for (int hf = 0; hf < 2; ++hf)
#pragma unroll
              for (int i = 0; i < 2; ++i) vtab[(hf * 2 + i) * 512] = vaN[hf][i]; }
        unsigned v2[2][2];
        for (int t = 0; t < nt; t += 2) {
            const bool last = (t == nt - 2);
            const size_t k1 = (size_t)(t + 1) * kstep, k2 = last ? (size_t)0 : (size_t)(t + 2) * kstep, k3 = k2 + kstep;
            const char* b2 = last ? nB : cB + (size_t)(t + 2) * kstep; const char* b3 = b2 + kstep;
#pragma unroll
            for (int hf = 0; hf < 2; ++hf)
#pragma unroll
                for (int i = 0; i < 2; ++i) v2[hf][i] = last ? vtab[(hf * 2 + i) * 512] : vaC[hf][i];
            if constexpr (SP2) {
            PG8_LDB(B0, 0, 0); PG8_LDB(B1, 0, 1); PG8_SCHED; PG8_LDA(At, 0, 0); PG8_STAGEA(PG8_SA(1, 1), k1, vaC[1]);
            PG8_WAIT_V(8); PG8_WAIT_L(0); PG8_BAR; PG8_MMA(0, 0, At, B0); PG8_MMA(0, 1, At, B1); PG8_BAR; PG8_SCHED;
            PG8_LDA(At, 0, 1); PG8_STAGE(PG8_SB(0, 0), b2, voffB); PG8_STAGE(PG8_SB(0, 1), b2 + hstep, voffB); PG8_STAGEA(PG8_SA(0, 0), k2, v2[0]);
            PG8_WAIT_V(8); PG8_WAIT_L(0); PG8_BAR; PG8_MMA(1, 0, At, B0); PG8_MMA(1, 1, At, B1); PG8_BAR; PG8_SCHED;
            PG8_LDB(B0, 1, 0); PG8_LDB(B1, 1, 1); PG8_SCHED; PG8_LDA(At, 1, 0); PG8_STAGEA(PG8_SA(0, 1), k2, v2[1]);
            PG8_WAIT_V(8); PG8_WAIT_L(0); PG8_BAR; PG8_MMA(0, 0, At, B0); PG8_MMA(0, 1, At, B1); PG8_BAR; PG8_SCHED;
            PG8_LDA(At, 1, 1); PG8_STAGE(PG8_SB(1, 0), b3, voffB); PG8_STAGE(PG8_SB(1, 1), b3 + hstep, voffB); PG8_STAGEA(PG8_SA(1, 0), k3, v2[0]);
            PG8_WAIT_V(8); PG8_WAIT_L(0); PG8_BAR; PG8_MMA(1, 0, At, B0); PG8_MMA(1, 1, At, B1); PG8_BAR; PG8_SCHED;
            } else {
            PG8_LDB(B0, 0, 0); PG8_SCHED; PG8_LDA(At, 0, 0); PG8_STAGEA(PG8_SA(1, 1), k1, vaC[1]);
            PG8_WAIT_L(8); PG8_BAR; PG8_WAIT_L(0); PG8_MMA(0, 0, At, B0); PG8_BAR; PG8_SCHED;
            PG8_LDB(B1, 0, 1); PG8_STAGE(PG8_SB(0, 0), b2, voffB);
            PG8_BAR; PG8_WAIT_L(0); PG8_MMA(0, 1, At, B1); PG8_BAR;
            PG8_LDA(At, 0, 1); PG8_STAGEA(PG8_SA(0, 0), k2, v2[0]);
            PG8_BAR; PG8_WAIT_L(0); PG8_MMA(1, 0, At, B0); PG8_BAR; PG8_SCHED;
            PG8_STAGE(PG8_SB(0, 1), b2 + hstep, voffB);
            PG8_WAIT_V(6); PG8_BAR; PG8_MMA(1, 1, At, B1); PG8_BAR;
            PG8_LDB(B0, 1, 0); PG8_SCHED; PG8_LDA(At, 1, 0); PG8_STAGEA(PG8_SA(0, 1), k2, v2[1]);
            PG8_WAIT_L(8); PG8_BAR; PG8_WAIT_L(0); PG8_MMA(0, 0, At, B0); PG8_BAR; PG8_SCHED;
            PG8_LDB(B1, 1, 1); PG8_STAGE(PG8_SB(1, 0), b3, voffB);
            PG8_BAR; PG8_WAIT_L(0); PG8_MMA(0, 1, At, B1); PG8_BAR;
            PG8_LDA(At, 1, 1); PG8_STAGEA(PG8_SA(1, 0), k3, v2[0]);
            PG8_BAR; PG8_WAIT_L(0); PG8_MMA(1, 0, At, B0); PG8_BAR; PG8_SCHED;
            PG8_STAGE(PG8_SB(1, 1), b3 + hstep, voffB);
            PG8_WAIT_V(6); PG8_BAR; PG8_MMA(1, 1, At, B1); PG8_BAR;
            }
        }
        PG8_STAMP();
        if (wr == 0) PG8_BAR;
        if constexpr (SCW >= 0) asm volatile("s_nop 15\n\ts_nop 15" ::: "memory");
        E(acc, cur, wr, wc, fr, fq);
        PG8_STAMP();
        if (!has_next) break;
#pragma unroll
        for (int a = 0; a < 2; ++a)
#pragma unroll
            for (int b = 0; b < 2; ++b)
#pragma unroll
                for (int m = 0; m < 4; ++m)
#pragma unroll
                    for (int n = 0; n < 2; ++n) acc[a][b][m][n] = (f32x4){0.f, 0.f, 0.f, 0.f};
        cur = nxt; cB = nB; ++ui;
#pragma unroll
        for (int hf = 0; hf < 2; ++hf)
#pragma unroll
            for (int i = 0; i < 2; ++i) vaC[hf][i] = v2[hf][i];
        if (wr == 1) PG8_BAR;
    }
    PG8_WAIT_V(0);
    PG8_BAR;
    PG8_STAMP();
    if (STAMP && wid == 0) { stamps[lane] = lane < nts ? (((unsigned long long)(unsigned)ts_hi << 32) | (unsigned)ts_lo) : 0ull;
        if (lane == 62) stamps[62] = rt_entry; if (lane == 63) stamps[63] = (unsigned long long)wall_clock64(); }
#undef PG8_STAMP
#undef PG8_SA
#undef PG8_SB
#undef PG8_STAGE
#undef PG8_STAGEA
#undef PG8_LDA
#undef PG8_LDB
#undef PG8_MMA
#undef PG8_WAIT_V
#undef PG8_WAIT_L
#undef PG8_BAR
#undef PG8_SCHED
}
}

constexpr int NTHR = 512, NWV = 8, LDS_BYTES = 147456;

struct P {
    const float *x, *c, *ctx, *c_ctx, *w_mod, *b_mod, *norm1_g, *norm2_g, *w_in, *conv_w, *conv_b, *dt_bias_f, *dt_bias_b, *a_log_f, *a_log_b, *d_skip, *ssd_norm_g,
        *gk_up_f, *gk_bias_f, *gk_up_b, *gk_bias_b, *gla_norm_g, *w_out, *w_router, *router_bias, *w_gate, *w_up, *w_down, *final_g;
    float* out; bf16_t* XB; bf16_t* H; bf16_t* PROJ; bf16_t* SS; bf16_t* GS; float* SDEC; float* GDEC; float* MOD; int* counts; int* TOKSLOT; float* EW; int* MAP; bf16_t* WinT; bf16_t* WoutT; bf16_t* WguT; bf16_t* WdT; bf16_t* WRT; unsigned* BAR; bf16_t* XBCC; bf16_t* QKB; float* SSC; float* STOT; float* SSQ; float* XSS;
};

DI void ph_init(const P& p) { const size_t i = (size_t)blockIdx.x * NTHR + ltid(); if (i < 64) p.counts[i * 32] = 0; }

DI void ph_mod(const P& p, float* s  ) {
    const int tid_ = ltid(), lane = tid_ & 63, w = tid_ >> 6;
    if (blockIdx.x >= 192) return;
    float* part = s + 9 * 1024;
    { float cv[18];
#pragma unroll
      for (int q = 0; q < 18; ++q) { const int i = tid_ + q * NTHR, r = i >> 10, k = i & 1023; cv[q] = r < 8 ? p.c[r * 1024 + k] : p.c_ctx[k]; }
#pragma unroll
      for (int q = 0; q < 18; ++q) s[tid_ + q * NTHR] = siluf(cv[q]); }
    __syncthreads();
    for (int vb = blockIdx.x; vb < 192; vb += gridDim.x) {
        const int l = vb / 96, n = (vb % 96) * 64 + lane;
        float acc[9];
#pragma unroll
        for (int r = 0; r < 9; ++r) acc[r] = 0.f;
        const float* wp = p.w_mod + (size_t)l * 1024 * 6144 + (size_t)(128 * w) * 6144 + n;
#pragma unroll 8
        for (int k = 0; k < 128; ++k) { const float wv = wp[(size_t)k * 6144];
#pragma unroll
            for (int r = 0; r < 9; ++r) acc[r] += s[r * 1024 + 128 * w + k] * wv; }
#pragma unroll
        for (int r = 0; r < 9; ++r) part[(w * 9 + r) * 64 + lane] = acc[r];
        __syncthreads();
        for (int o = tid_; o < 9 * 64; o += NTHR) { const int r = o >> 6, c = o & 63; float a = p.b_mod[l * 6144 + (vb % 96) * 64 + c];
#pragma unroll
            for (int q = 0; q < 8; ++q) a += part[(q * 9 + r) * 64 + c];
            p.MOD[((size_t)l * 9 + r) * 6144 + (vb % 96) * 64 + c] = a; }
        __syncthreads();
    }
}

DI unsigned pk2(float lo, float hi) { return __builtin_bit_cast(unsigned, __builtin_convertvector((f32x2v_){lo, hi}, bf16x2v_)); }
template <bool F8 = false> DI void transpose_item(const float* W, int K, int N, bf16_t* WT, float* scr, int item, int lane, int gu = -1, const float* kscale = nullptr) {
    const int nblk = (N + 31) / 32, kb = item / nblk, nb = item % nblk, k0 = 64 * kb, n0 = 32 * nb;
    const int d0 = gu < 0 ? n0 : 256 * (n0 >> 7) + (n0 & 127) + 128 * gu;
    const bool nok = n0 + (lane & 31) < N;
    float wv_[32];
#pragma unroll
    for (int i = 0; i < 32; ++i) { const int kk = 2 * i + (lane >> 5); wv_[i] = nok ? __builtin_nontemporal_load(W + (size_t)(k0 + kk) * N + n0 + (lane & 31)) : 0.f; }
#pragma unroll
    for (int i = 0; i < 32; ++i) { const int kk = 2 * i + (lane >> 5); scr[kk * 33 + (lane & 31)] = wv_[i] * (kscale ? kscale[k0 + kk] : 1.0f); }
    const int c = lane & 7;
#pragma unroll
    for (int j = 0; j < 4; ++j) { const int n = (lane >> 3) + 8 * j; const float* q = scr + (8 * c) * 33 + n;
        if constexpr (F8) { typedef unsigned u32x2nt __attribute__((ext_vector_type(2)));
            const u32x2nt o = {pg8::pk4_fp8((pg8::f32x4){q[0 * 33], q[1 * 33], q[2 * 33], q[3 * 33]} * 64.0f), pg8::pk4_fp8((pg8::f32x4){q[4 * 33], q[5 * 33], q[6 * 33], q[7 * 33]} * 64.0f)};
            if (n0 + n < N) __builtin_nontemporal_store(o, (u32x2nt*)((unsigned char*)WT + (size_t)(d0 + n) * K + k0 + 8 * c)); }
        else {
        uint4 o; o.x = pk2(q[0 * 33], q[1 * 33]); o.y = pk2(q[2 * 33], q[3 * 33]); o.z = pk2(q[4 * 33], q[5 * 33]); o.w = pk2(q[6 * 33], q[7 * 33]);
        if (n0 + n < N) { typedef unsigned u32x4nt __attribute__((ext_vector_type(4))); __builtin_nontemporal_store((u32x4nt){o.x, o.y, o.z, o.w}, (u32x4nt*)(WT + (size_t)(d0 + n) * K + k0 + 8 * c)); } } }
}

struct TrD { const float* src; unsigned char* dst; int N, K; bool ok; };
DI TrD tr_desc(const P& p, int l, int it, int it1, int lane) {
    TrD d; d.ok = it < it1; const int itc = d.ok ? it : it1 - 1;
    const int e = itc / 768, r = itc - e * 768;
    const float* W; unsigned char* WT; int K, N, item, gu;
    if (r < 512) { gu = r >> 8; W = (gu ? p.w_up : p.w_gate) + (size_t)(l * NE + e) * D * 512; K = D; N = 512; WT = (unsigned char*)p.WguT + (size_t)e * D * D; item = r & 255; }
    else { gu = -1; W = p.w_down + (size_t)(l * NE + e) * 512 * D; K = 512; N = D; WT = (unsigned char*)p.WdT + (size_t)e * D * 512; item = r - 512; }
    const int nblk = N / 32, kb = item / nblk, nb = item % nblk, k0 = 64 * kb, n0 = 32 * nb;
    const int d0 = gu < 0 ? n0 : 256 * (n0 >> 7) + (n0 & 127) + 128 * gu;
    d.src = W + (size_t)(k0 + (lane >> 5)) * N + n0 + (lane & 31); d.dst = WT + (size_t)d0 * K + k0; d.N = N; d.K = K;
    return d;
}
DI void tr_load(const TrD& d, float (&v)[32]) {
#pragma unroll
    for (int i = 0; i < 32; ++i) v[i] = __builtin_nontemporal_load(d.src + (size_t)(2 * i) * d.N);
}
DI void tr_finish(const TrD& d, const float (&v)[32], float* scr, int lane) {
#pragma unroll
    for (int i = 0; i < 32; ++i) { const int kk = 2 * i + (lane >> 5); scr[kk * 33 + (lane & 31)] = v[i]; }
    const int c = lane & 7;
#pragma unroll
    for (int j = 0; j < 4; ++j) { const int n = (lane >> 3) + 8 * j; const float* q = scr + (8 * c) * 33 + n;
        typedef unsigned u32x2nt __attribute__((ext_vector_type(2)));
        const u32x2nt o = {pg8::pk4_fp8((pg8::f32x4){q[0 * 33], q[1 * 33], q[2 * 33], q[3 * 33]} * 64.0f), pg8::pk4_fp8((pg8::f32x4){q[4 * 33], q[5 * 33], q[6 * 33], q[7 * 33]} * 64.0f)};
        if (d.ok) __builtin_nontemporal_store(o, (u32x2nt*)(d.dst + (size_t)n * d.K + 8 * c)); }
}
#ifndef TR_NI
#define TR_NI 4
#endif
DI void ph_convert_experts(const P& p, int l, float* ldsf, int wk0, int nwk, int it0 = 0, int it1 = NE * 768) {
    const int tid_ = ltid(), lane = tid_ & 63, gw = ((int)blockIdx.x - wk0) * NWV + (tid_ >> 6), NW = nwk * NWV;
    float* scr = ldsf + 14 * 1024 + (tid_ >> 6) * (64 * 33 + 16);
    for (int it = it0 + gw; it < it1; it += TR_NI * NW) {
        float v[TR_NI][32]; TrD d[TR_NI];
#pragma unroll
        for (int j = 0; j < TR_NI; ++j) { d[j] = tr_desc(p, l, it + j * NW, it1, lane); tr_load(d[j], v[j]); }
#pragma unroll
        for (int j = 0; j < TR_NI; ++j) tr_finish(d[j], v[j], scr, lane);
    }
}
constexpr int NPAD_IN = 3072;
DI void ph_convert_small(const P& p, float* ldsf, int, int, int) {
    const int tid_ = ltid(), lane = tid_ & 63, gw = blockIdx.x * NWV + (tid_ >> 6), NW = gridDim.x * NWV;
    float* scr = ldsf + 14 * 1024 + (tid_ >> 6) * (64 * 33 + 16);
    constexpr int I_IN = 16 * 89, I_OUT = 16 * 32;
    for (int it = gw; it < 2 * (I_IN + I_OUT); it += NW) {
        const int l = it / (I_IN + I_OUT), r = it % (I_IN + I_OUT);
        if (r < I_IN) transpose_item<true>(p.w_in + (size_t)l * D * INDIM, D, INDIM, (bf16_t*)((unsigned char*)p.WinT + (size_t)l * NPAD_IN * D), scr, r, lane);
        else { const int kb = (r - I_IN) / 32;
            transpose_item(p.w_out + (size_t)l * D * D, D, D, p.WoutT + (size_t)l * D * D, scr, r - I_IN, lane, -1, kb < 8 ? p.ssd_norm_g + l * 512 : nullptr); }
    }
    for (int idx = blockIdx.x * NTHR + tid_; idx < 32 * 1024; idx += gridDim.x * NTHR) { const int e = idx >> 10, k = idx & 1023; p.WRT[idx] = f2bf(p.w_router[k * 32 + e]); }
    const size_t nz16 = (size_t)(NPAD_IN - INDIM) * D / 16;
    for (size_t i = (size_t)blockIdx.x * NTHR + tid_; i < 2 * nz16; i += (size_t)gridDim.x * NTHR) {
        const size_t l = i / nz16, j = i % nz16;
        ((uint4*)((unsigned char*)p.WinT + (l * NPAD_IN + INDIM) * D))[j] = make_uint4(0u, 0u, 0u, 0u);
    }
}

DI void row_normmod(float4 (&v)[4], const float* g, const float* mr, int shift_idx, int scale_idx, int lane) {
    float ss = 0.f;
#pragma unroll
    for (int i = 0; i < 4; ++i) ss += v[i].x * v[i].x + v[i].y * v[i].y + v[i].z * v[i].z + v[i].w * v[i].w;
    ss = wave_sum(ss, lane);
    const float rstd = rsqrtf(ss * (1.0f / D) + 1e-6f);
#pragma unroll
    for (int i = 0; i < 4; ++i) {
        const int c = (i * 64 + lane) * 4;
        const float4 gg = *(const float4*)(g + c), sh = *(const float4*)(mr + shift_idx * 1024 + c), sc = *(const float4*)(mr + scale_idx * 1024 + c);
        v[i].x = v[i].x * rstd * gg.x * (1.f + sc.x) + sh.x; v[i].y = v[i].y * rstd * gg.y * (1.f + sc.y) + sh.y;
        v[i].z = v[i].z * rstd * gg.z * (1.f + sc.z) + sh.z; v[i].w = v[i].w * rstd * gg.w * (1.f + sc.w) + sh.w;
    }
}
DI void row_store_bf16(bf16_t* hrow, float4 (&v)[4], int lane) {
#pragma unroll
    for (int i = 0; i < 4; ++i) { ushort4 o; o.x = f2bf(v[i].x); o.y = f2bf(v[i].y); o.z = f2bf(v[i].z); o.w = f2bf(v[i].w);
        *(ushort4*)(hrow + (i * 64 + lane) * 4) = o; v[i] = make_float4(bf2f(o.x), bf2f(o.y), bf2f(o.z), bf2f(o.w)); }
}

DI void ph_normmod1(const P& p, int l, int, int, int) {
    const int tid_ = ltid(), lane = tid_ & 63, gw = blockIdx.x * NWV + (tid_ >> 6), NW = gridDim.x * NWV;
    const float* MODl = p.MOD + (size_t)l * 9 * 6144;
    for (int t = gw; t < T; t += NW) {
        float4 v[4];
#pragma unroll
        for (int i = 0; i < 4; ++i) v[i] = ((const float4*)(t < TC ? p.ctx + (size_t)t * D : p.x + (size_t)(t - TC) * D))[i * 64 + lane];
        row_normmod(v, p.norm1_g + l * D, MODl + (size_t)tok_modrow(t) * 6144, 0, 1, lane);
#pragma unroll
        for (int i = 0; i < 4; ++i) *(unsigned*)((unsigned char*)p.H + (size_t)t * D + (i * 64 + lane) * 4) = pg8::pk4_fp8((pg8::f32x4){v[i].x, v[i].y, v[i].z, v[i].w});
    }
}

typedef short s16x4 __attribute__((ext_vector_type(4)));
typedef short bf16x8v __attribute__((ext_vector_type(8)));
typedef float f32x4v __attribute__((ext_vector_type(4)));
typedef unsigned u32x4v __attribute__((ext_vector_type(4)));
typedef unsigned u32x2v __attribute__((ext_vector_type(2)));
DI u32x4v mk4(unsigned a, unsigned b, unsigned c, unsigned d) { return (u32x4v){a, b, c, d}; }
DI u32x2v mk2(unsigned a, unsigned b) { return (u32x2v){a, b}; }
DI f32x4v mkf4(float a, float b, float c, float d) { return (f32x4v){a, b, c, d}; }
#define LDSP __attribute__((address_space(3)))
constexpr int NCH = 34, NTILE = NB * NCH;
constexpr int LD64 = 72, LD128 = 136;
constexpr float LOG2E = 1.4426950408889634f;

DI int tile_tok0(int tl) { const int b = tl / NCH, cs = tl - b * NCH; return cs < 2 ? b * CTXL + cs * 128 : TC + b * SEQ + (cs - 2) * 128; }
DI f32x4v mfma16(bf16x8v a, bf16x8v b, f32x4v c) { return __builtin_amdgcn_mfma_f32_16x16x32_bf16(a, b, c, 0, 0, 0); }
DI bf16x8v frag_row(LDSP const bf16_t* base, int ld, int r0, int k0, int lane) { return *(LDSP const bf16x8v*)(base + (r0 + (lane & 15)) * ld + k0 + 8 * (lane >> 4)); }
DI bf16x8v frag_row_g(const bf16_t* base, int ld, int r0, int k0, int lane) { return *(const bf16x8v*)(base + (size_t)(r0 + (lane & 15)) * ld + k0 + 8 * (lane >> 4)); }
DI bf16x8v frag_col(LDSP const bf16_t* base, int ld, int r0, int k0, int lane) {
    const int G = lane >> 4, i = lane & 15;
    LDSP const bf16_t* a = base + (k0 + 8 * G + (i >> 2)) * ld + r0 + 4 * (i & 3);
    const s16x4 lo = __builtin_bit_cast(s16x4, __builtin_amdgcn_ds_read_tr16_b64_v4i16((LDSP s16x4*)a));
    const s16x4 hi = __builtin_bit_cast(s16x4, __builtin_amdgcn_ds_read_tr16_b64_v4i16((LDSP s16x4*)(a + 4 * ld)));
    return (bf16x8v){lo[0], lo[1], lo[2], lo[3], hi[0], hi[1], hi[2], hi[3]};
}
DI u32x2v pack4(f32x4v v) { return mk2(pk2(v[0], v[1]), pk2(v[2], v[3])); }
DI void unpack8(u32x4v v, float* o) { o[0] = __uint_as_float(v.x << 16); o[1] = __uint_as_float(v.x & 0xffff0000u); o[2] = __uint_as_float(v.y << 16); o[3] = __uint_as_float(v.y & 0xffff0000u);
    o[4] = __uint_as_float(v.z << 16); o[5] = __uint_as_float(v.z & 0xffff0000u); o[6] = __uint_as_float(v.w << 16); o[7] = __uint_as_float(v.w & 0xffff0000u); }
DI u32x4v pack8(const float* o) { return mk4(pk2(o[0], o[1]), pk2(o[2], o[3]), pk2(o[4], o[5]), pk2(o[6], o[7])); }

DI float fast_logsigmoid(float x) { return -(fmaxf(-x, 0.f) + __logf(1.0f + __expf(-fabsf(x)))); }
DI float fast_softplus(float x) { return fmaxf(x, 0.f) + __logf(1.0f + __expf(-fabsf(x))); }
struct XbcSrc { const bf16_t* base; int ld; };
DI XbcSrc xbc_src(const P& p, int tok0) { XbcSrc r; r.base = p.XBCC + (size_t)tok0 * 768; r.ld = 768; return r; }

DI void prep_conv_item(const P& p, int l, int item, int lane) {
    int piece, ch;
    if (item < T / 32) { piece = item; ch = lane * 8; } else { piece = 2 * (item - T / 32) + (lane >> 5); ch = 512 + (lane & 31) * 8; }
    const int t0 = piece * 32; int lo, hi; bf16_t* dst; int dld;
    if (t0 < TC) { lo = t0 & ~(CTXL - 1); hi = lo + CTXL - 1; } else { lo = TC + ((t0 - TC) & ~63); hi = lo + 63; }
    dst = p.XBCC + ch; dld = 768;
    const bf16_t* src = p.PROJ + OFF_XBC + ch;
    float wgt[5][8], bias[8];
#pragma unroll
    for (int k = 0; k < 5; ++k) { const f32x4v a = *(const f32x4v*)(p.conv_w + l * 5 * 768 + k * 768 + ch), c = *(const f32x4v*)(p.conv_w + l * 5 * 768 + k * 768 + ch + 4);
#pragma unroll
        for (int j = 0; j < 4; ++j) { wgt[k][j] = a[j]; wgt[k][4 + j] = c[j]; } }
    { const f32x4v a = *(const f32x4v*)(p.conv_b + l * 768 + ch), c = *(const f32x4v*)(p.conv_b + l * 768 + ch + 4);
#pragma unroll
      for (int j = 0; j < 4; ++j) { bias[j] = a[j]; bias[4 + j] = c[j]; } }
    const u32x4v zero4 = mk4(0u, 0u, 0u, 0u);
    u32x4v rw[13];
#pragma unroll
    for (int i = 0; i < 5; ++i) { const int tt = t0 - 2 + i; rw[i] = (tt >= lo && tt <= hi) ? *(const u32x4v*)(src + (size_t)tt * LDP) : zero4; }
    for (int s0 = 0; s0 < 32; s0 += 8) {
        const int t = t0 + s0;
#pragma unroll
        for (int i = 0; i < 8; ++i) { const int tt = t + 3 + i; rw[5 + i] = (tt <= hi) ? *(const u32x4v*)(src + (size_t)tt * LDP) : zero4; }
#pragma unroll
        for (int i = 0; i < 8; ++i) {
            float o[8];
#pragma unroll
            for (int c = 0; c < 8; ++c) o[c] = bias[c];
#pragma unroll
            for (int k = 0; k < 5; ++k) { float v[8]; unpack8(rw[i + k], v);
#pragma unroll
                for (int c = 0; c < 8; ++c) o[c] += wgt[k][c] * v[c]; }
#pragma unroll
            for (int c = 0; c < 8; ++c) o[c] = siluf(o[c]);
            *(u32x4v*)(dst + (size_t)(t + i) * dld) = pack8(o);
        }
#pragma unroll
        for (int i = 0; i < 5; ++i) rw[i] = rw[i + 8];
    }
}
DI void prep_ssd_item(const P& p, int l, int item, int lane) {
    const int tl = item >> 3, h = item & 7, tok0 = tile_tok0(tl);
    const float bsf = p.dt_bias_f[l * 8 + h], bsb = p.dt_bias_b[l * 8 + h];
    const float r0 = bf2f(p.PROJ[(size_t)(tok0 + 2 * lane) * LDP + OFF_DT + h]), r1 = bf2f(p.PROJ[(size_t)(tok0 + 2 * lane + 1) * LDP + OFF_DT + h]);
    const float f0 = fast_softplus(r0 + bsf), f1 = fast_softplus(r1 + bsf), b0 = fast_softplus(r0 + bsb), b1 = fast_softplus(r1 + bsb);
    float pf = f0 + f1, sb = b0 + b1;
#pragma unroll
    for (int o = 1; o < 64; o <<= 1) { const float t = shl(pf, lane >= o ? lane - o : lane); if (lane >= o) pf += t; }
#pragma unroll
    for (int o = 1; o < 64; o <<= 1) { const float t = shl(sb, lane + o < 64 ? lane + o : lane); if (lane + o < 64) sb += t; }
    const float Af = -__expf(p.a_log_f[l * 8 + h]) * LOG2E, Ab = -__expf(p.a_log_b[l * 8 + h]) * LOG2E;
    const float af0 = Af * (pf - f1), af1 = Af * pf, ab0 = Ab * sb, ab1 = Ab * (sb - b0);
    f32x4v* dst = (f32x4v*)p.SSC + (size_t)(tok0 + 2 * lane) * 8 + h;
    dst[0] = mkf4(af0, af0 - __log2f(f0), ab0, ab0 - __log2f(b0));
    dst[8] = mkf4(af1, af1 - __log2f(f1), ab1, ab1 - __log2f(b1));
    if (lane == 63) { p.STOT[(tl * 8 + h) * 2 + 0] = af1; p.SDEC[(tl * 8 + h) * 2 + 0] = __builtin_amdgcn_exp2f(af1); }
    if (lane == 0) { p.STOT[(tl * 8 + h) * 2 + 1] = ab0; p.SDEC[(tl * 8 + h) * 2 + 1] = __builtin_amdgcn_exp2f(ab0); }
}
template <int CTRL> DI float dppz(float x) { return __builtin_bit_cast(float, __builtin_amdgcn_update_dpp(0, __builtin_bit_cast(int, x), CTRL, 0xf, 0xf, true)); }
DI float row_total(float s) { s += dppz<0xB1>(s); s += dppz<0x4E>(s); s += dppz<0x141>(s); s += dppz<0x140>(s); return s; }
struct GlaPL { u32x4v qv_[2], kv_[2], vv_[4]; bf16x8v gkf[8]; float uw[8]; f32x4v bias; };
DI void prep_gla_load(const P& p, int l, int it, GlaPL& L) {
    const int tl = it >> 2, h = it & 3;
    const int tid = ltid(), lane = tid & 63, w = __builtin_amdgcn_readfirstlane(tid >> 6), kt = w & 3, dir = w >> 2, G = lane >> 4, c = lane & 15, tok0 = tile_tok0(tl);
#pragma unroll
    for (int nt = 0; nt < 8; ++nt) L.gkf[nt] = *(const bf16x8v*)(p.PROJ + (size_t)(tok0 + 16 * nt + c) * LDP + OFF_GK + (G & 1) * 8);
    { const float* up = (dir ? p.gk_up_b : p.gk_up_f) + l * 16 * 256 + (G & 1) * 8 * 256 + h * 64 + 16 * kt + c;
#pragma unroll
      for (int e = 0; e < 8; ++e) L.uw[e] = up[e * 256]; }
    L.bias = *(const f32x4v*)((dir ? p.gk_bias_b : p.gk_bias_f) + l * 256 + h * 64 + 16 * kt + 4 * G);
#pragma unroll
    for (int q = 0; q < 4; ++q) { const int cc_ = tid + q * NTHR, r = cc_ >> 4, cc = cc_ & 15; L.vv_[q] = *(const u32x4v*)(p.PROJ + (size_t)(tok0 + r) * LDP + OFF_V + h * 128 + cc * 8); }
#pragma unroll
    for (int q = 0; q < 2; ++q) { const int cc_ = tid + q * NTHR, r = cc_ >> 3, cc = cc_ & 7; const bf16_t* pr = p.PROJ + (size_t)(tok0 + r) * LDP;
        L.qv_[q] = *(const u32x4v*)(pr + OFF_Q + h * 64 + cc * 8); L.kv_[q] = *(const u32x4v*)(pr + OFF_K + h * 64 + cc * 8); }
}
DI void prep_gla_block(const P& p, int l, int it, int it_next, GlaPL& L, LDSP unsigned char* lds) {
    const int tl = it >> 2, h = it & 3;
    const int tid = ltid(), lane = tid & 63, w = __builtin_amdgcn_readfirstlane(tid >> 6), kt = w & 3, dir = w >> 2, G = lane >> 4, c = lane & 15, tok0 = tile_tok0(tl);
    LDSP bf16_t* QT = (LDSP bf16_t*)lds; LDSP bf16_t* KT = QT + 128 * LD64; LDSP bf16_t* O4 = KT + 128 * LD64; LDSP bf16_t* VT = O4 + 4 * 128 * LD64; LDSP float* DEC = (LDSP float*)(VT + 128 * LD128);
    f32x4v g[8];
    { bf16x8v af;
#pragma unroll
      for (int e = 0; e < 8; ++e) { const bf16_t hi = f2bf(L.uw[e]); const bf16_t lo = f2bf(L.uw[e] - bf2f(hi)); af[e] = (short)(G < 2 ? hi : lo); }
#pragma unroll
      for (int nt = 0; nt < 8; ++nt) g[nt] = mfma16(af, L.gkf[nt], (f32x4v){0.f, 0.f, 0.f, 0.f}); }
#pragma unroll
    for (int nt = 0; nt < 8; ++nt)
#pragma unroll
        for (int r = 0; r < 4; ++r) { const float x = (g[nt][r] + L.bias[r]) * LOG2E;
            g[nt][r] = -(fmaxf(-x, 0.f) + __log2f(1.0f + __builtin_amdgcn_exp2f(-fabsf(x)))) * (1.0f / 16.0f); }
    f32x4v tot = (f32x4v){0.f, 0.f, 0.f, 0.f};
    if (dir == 0) {
#pragma unroll
        for (int nt = 0; nt < 8; ++nt)
#pragma unroll
            for (int r = 0; r < 4; ++r) { const float s = row_total(g[nt][r]); float x = g[nt][r];
                x += dppz<0x111>(x); x += dppz<0x112>(x); x += dppz<0x114>(x); x += dppz<0x118>(x);
                g[nt][r] = tot[r] + x; tot[r] += s; }
    } else {
#pragma unroll
        for (int nt = 7; nt >= 0; --nt)
#pragma unroll
            for (int r = 0; r < 4; ++r) { const float s = row_total(g[nt][r]); float x = g[nt][r];
                x += dppz<0x101>(x); x += dppz<0x102>(x); x += dppz<0x104>(x); x += dppz<0x108>(x);
                g[nt][r] = tot[r] + x; tot[r] += s; }
    }
    __syncthreads();
#pragma unroll
    for (int q = 0; q < 2; ++q) { const int cc_ = tid + q * NTHR, r = cc_ >> 3, cc = cc_ & 7; *(LDSP u32x4v*)(QT + r * LD64 + cc * 8) = L.qv_[q]; *(LDSP u32x4v*)(KT + r * LD64 + cc * 8) = L.kv_[q]; }
#pragma unroll
    for (int q = 0; q < 4; ++q) { const int cc_ = tid + q * NTHR, r = cc_ >> 4, cc = cc_ & 15; *(LDSP u32x4v*)(VT + r * LD128 + cc * 8) = L.vv_[q]; }
    __syncthreads();
    { LDSP bf16_t* OQ = O4 + (2 * dir) * 128 * LD64; LDSP bf16_t* OK = OQ + 128 * LD64;
#pragma unroll
      for (int nt = 0; nt < 8; ++nt) { const int o = (16 * nt + c) * LD64 + 16 * kt + 4 * G;
          const u32x2v q2 = *(LDSP const u32x2v*)(QT + o), k2 = *(LDSP const u32x2v*)(KT + o);
          float eq[4], ek[4];
#pragma unroll
          for (int r = 0; r < 4; ++r) { eq[r] = __builtin_amdgcn_exp2f(g[nt][r] - 3.0f); ek[r] = __builtin_amdgcn_exp2f(-g[nt][r]); }
          *(LDSP u32x2v*)(OQ + o) = mk2(pk2(__uint_as_float(q2.x << 16) * eq[0], __uint_as_float(q2.x & 0xffff0000u) * eq[1]), pk2(__uint_as_float(q2.y << 16) * eq[2], __uint_as_float(q2.y & 0xffff0000u) * eq[3]));
          *(LDSP u32x2v*)(OK + o) = mk2(pk2(__uint_as_float(k2.x << 16) * ek[0], __uint_as_float(k2.x & 0xffff0000u) * ek[1]), pk2(__uint_as_float(k2.y << 16) * ek[2], __uint_as_float(k2.y & 0xffff0000u) * ek[3])); }
      if (c == 0) { const f32x4v d = mkf4(__builtin_amdgcn_exp2f(tot[0]), __builtin_amdgcn_exp2f(tot[1]), __builtin_amdgcn_exp2f(tot[2]), __builtin_amdgcn_exp2f(tot[3]));
          *(f32x4v*)(p.GDEC + (size_t)((tl * 4 + h) * 2 + dir) * 64 + 16 * kt + 4 * G) = d; *(LDSP f32x4v*)(DEC + dir * 64 + 16 * kt + 4 * G) = d; } }
    __syncthreads();
    if (it_next >= 0) prep_gla_load(p, l, it_next, L);
#pragma unroll
    for (int q = 0; q < 8; ++q) { const int cc_ = tid + q * NTHR, a4 = cc_ >> 10, r = (cc_ >> 3) & 127, cc = cc_ & 7;
        *(u32x4v*)(p.QKB + (size_t)(tok0 + r) * 1024 + a4 * 256 + h * 64 + cc * 8) = *(LDSP const u32x4v*)(O4 + (a4 * 128 + r) * LD64 + cc * 8); }
    { const int ut = kt; LDSP const bf16_t* KE = O4 + (dir ? 3 : 1) * 128 * LD64;
      f32x4v acc[8];
#pragma unroll
      for (int q = 0; q < 8; ++q) acc[q] = (f32x4v){0.f, 0.f, 0.f, 0.f};
#pragma unroll
      for (int ks = 0; ks < 4; ++ks) { const bf16x8v u = frag_col(KE, LD64, 16 * ut, 32 * ks, lane);
#pragma unroll
          for (int q = 0; q < 8; ++q) acc[q] = mfma16(u, frag_col(VT, LD128, 16 * q, 32 * ks, lane), acc[q]); }
      const f32x4v dec = *(LDSP const f32x4v*)(DEC + dir * 64 + 16 * ut + 4 * (lane >> 4));
      bf16_t* dst = p.GS + ((size_t)((tl * 4 + h) * 2 + dir) * 128) * 64;
#pragma unroll
      for (int q = 0; q < 8; ++q) *(u32x2v*)(dst + (size_t)(16 * q + (lane & 15)) * 64 + 16 * ut + 4 * (lane >> 4)) = pack4(acc[q] * dec); }
}
constexpr int NPREP_A = T / 32 + T / 64, NPREP_B = NTILE * 8;
DI void ph_prep(const P& p, int l, LDSP unsigned char* lds) {
    const int tid_ = ltid(), lane = tid_ & 63, gw = blockIdx.x * NWV + (tid_ >> 6), NW = gridDim.x * NWV;
    for (int it = gw; it < NPREP_A + NPREP_B; it += NW) {
        if (it < NPREP_A) prep_conv_item(p, l, it, lane); else prep_ssd_item(p, l, it - NPREP_A, lane);
    }
    { const int G_ = gridDim.x; int it = G_ - 1 - (int)blockIdx.x;
      GlaPL L; if (it < NTILE * 4) prep_gla_load(p, l, it, L);
      for (; it < NTILE * 4; it += G_) prep_gla_block(p, l, it, it + G_ < NTILE * 4 ? it + G_ : -1, L, lds); }
}

DI void s1_ssd(const P& p, int tl, int h, LDSP unsigned char* lds) {
    const int tid = ltid(), lane = tid & 63, w = __builtin_amdgcn_readfirstlane(tid >> 6);
    const int tok0 = tile_tok0(tl), g = h >> 2; const XbcSrc xs = xbc_src(p, tok0);
    LDSP bf16_t* XWF = (LDSP bf16_t*)lds; LDSP bf16_t* XWB = XWF + 128 * LD64; LDSP bf16_t* BG = XWB + 128 * LD64;
    const int j = tid >> 2, cq = tid & 3;
    const bf16_t* row = xs.base + (size_t)j * xs.ld;
    const u32x4v x0 = *(const u32x4v*)(row + h * 64 + cq * 16), x1 = *(const u32x4v*)(row + h * 64 + cq * 16 + 8);
    const u32x4v b0 = *(const u32x4v*)(row + 512 + g * 64 + cq * 16), b1 = *(const u32x4v*)(row + 512 + g * 64 + cq * 16 + 8);
    const f32x4v sc = *((const f32x4v*)p.SSC + (size_t)(tok0 + j) * 8 + h);
    const float wf = __builtin_amdgcn_exp2f(p.STOT[(tl * 8 + h) * 2 + 0] - sc.y), wb = __builtin_amdgcn_exp2f(p.STOT[(tl * 8 + h) * 2 + 1] - sc.w);
    float xv[16], of[16], ob[16]; unpack8(x0, xv); unpack8(x1, xv + 8);
#pragma unroll
    for (int c = 0; c < 16; ++c) { of[c] = xv[c] * wf; ob[c] = xv[c] * wb; }
    __syncthreads();
    *(LDSP u32x4v*)(XWF + j * LD64 + cq * 16) = pack8(of); *(LDSP u32x4v*)(XWF + j * LD64 + cq * 16 + 8) = pack8(of + 8);
    *(LDSP u32x4v*)(XWB + j * LD64 + cq * 16) = pack8(ob); *(LDSP u32x4v*)(XWB + j * LD64 + cq * 16 + 8) = pack8(ob + 8);
    *(LDSP u32x4v*)(BG + j * LD64 + cq * 16) = b0; *(LDSP u32x4v*)(BG + j * LD64 + cq * 16 + 8) = b1;
    __syncthreads();
    const int dir = w >> 2, ut = w & 3; LDSP const bf16_t* XW = dir ? XWB : XWF;
    f32x4v acc[4];
#pragma unroll
    for (int q = 0; q < 4; ++q) acc[q] = (f32x4v){0.f, 0.f, 0.f, 0.f};
#pragma unroll
    for (int ks = 0; ks < 4; ++ks) { const bf16x8v u = frag_col(BG, LD64, 16 * ut, 32 * ks, lane);
#pragma unroll
        for (int q = 0; q < 4; ++q) acc[q] = mfma16(u, frag_col(XW, LD64, 16 * q, 32 * ks, lane), acc[q]); }
    bf16_t* dst = p.SS + ((size_t)((tl * 8 + h) * 2 + dir) * 64) * 64;
#pragma unroll
    for (int q = 0; q < 4; ++q) *(u32x2v*)(dst + (size_t)(16 * q + (lane & 15)) * 64 + 16 * ut + 4 * (lane >> 4)) = pack4(acc[q]);
}
DI void ph_s1(const P& p, int l, LDSP unsigned char* lds) {
    for (int it = blockIdx.x; it < NTILE * 8; it += gridDim.x) s1_ssd(p, it >> 3, it & 7, lds);
}

DI int s2_chunk(int dir, int s) { return dir == 0 ? s : (s < 2 ? 1 - s : 35 - s); }
DI void ph_s2(const P& p) {
    const int g = blockIdx.x * NTHR + ltid();
    for (int v = g; v < 131072; v += gridDim.x * NTHR) {
        const bool gla = v >= 65536; const int r = v & 65535;
        int b, h, dir, vi;
        if (!gla) { vi = r & 511; dir = (r >> 9) & 1; h = (r >> 10) & 7; b = r >> 13; } else { vi = r & 1023; dir = (r >> 10) & 1; h = (r >> 11) & 3; b = r >> 13; }
        float st[8];
#pragma unroll
        for (int e = 0; e < 8; ++e) st[e] = 0.f;
        for (int s0 = 0; s0 < NCH; s0 += 6) {
            u32x4v sv[6]; float dsc[6]; f32x4v dv0[6], dv1[6];
#pragma unroll
            for (int u = 0; u < 6; ++u) { if (s0 + u >= NCH) continue; const int tl = b * NCH + s2_chunk(dir, s0 + u);
                if (!gla) { sv[u] = *(const u32x4v*)(p.SS + ((size_t)((tl * 8 + h) * 2 + dir) * 512 + vi) * 8); dsc[u] = p.SDEC[(tl * 8 + h) * 2 + dir]; }
                else { sv[u] = *(const u32x4v*)(p.GS + ((size_t)((tl * 4 + h) * 2 + dir) * 1024 + vi) * 8); const f32x4v* d = (const f32x4v*)(p.GDEC + (size_t)((tl * 4 + h) * 2 + dir) * 64 + (vi & 7) * 8); dv0[u] = d[0]; dv1[u] = d[1]; } }
#pragma unroll
            for (int u = 0; u < 6; ++u) { if (s0 + u >= NCH) continue; const int tl = b * NCH + s2_chunk(dir, s0 + u);
                float loc[8]; unpack8(sv[u], loc);
                const u32x4v hin = pack8(st);
                if (!gla) { *(u32x4v*)(p.SS + ((size_t)((tl * 8 + h) * 2 + dir) * 512 + vi) * 8) = hin;
#pragma unroll
                    for (int e = 0; e < 8; ++e) st[e] = dsc[u] * st[e] + loc[e]; }
                else { *(u32x4v*)(p.GS + ((size_t)((tl * 4 + h) * 2 + dir) * 1024 + vi) * 8) = hin;
                    const float dd[8] = {dv0[u].x, dv0[u].y, dv0[u].z, dv0[u].w, dv1[u].x, dv1[u].y, dv1[u].z, dv1[u].w};
#pragma unroll
                    for (int e = 0; e < 8; ++e) st[e] = dd[e] * st[e] + loc[e]; } }
        }
    }
}

DI int s3_tile(int l, int q) { return l == 0 ? q : (q >> 5) * NCH + 2 + (q & 31); }
struct SsdPre { u32x4v x0, x1, b0, b1, c0, c1, hf, hb; f32x4v sc; };
DI void s3_ssd_load(const P& p, int tl, int h, int tid, int i, int G, SsdPre& r) {
    const int tok0 = tile_tok0(tl), g = h >> 2; const XbcSrc xs = xbc_src(p, tok0);
    const int j = tid >> 2, cq = tid & 3; const bf16_t* row = xs.base + (size_t)j * xs.ld;
    r.x0 = *(const u32x4v*)(row + h * 64 + cq * 16); r.x1 = *(const u32x4v*)(row + h * 64 + cq * 16 + 8);
    r.b0 = *(const u32x4v*)(row + 512 + g * 64 + cq * 16); r.b1 = *(const u32x4v*)(row + 512 + g * 64 + cq * 16 + 8);
    r.c0 = *(const u32x4v*)(row + 640 + g * 64 + cq * 16); r.c1 = *(const u32x4v*)(row + 640 + g * 64 + cq * 16 + 8);
    const bf16_t* Hf = p.SS + (size_t)((tl * 8 + h) * 2 + 0) * 4096 + (tid >> 3) * 64 + (tid & 7) * 8;
    r.hf = *(const u32x4v*)Hf; r.hb = *(const u32x4v*)(Hf + 4096);
    r.sc = *((const f32x4v*)p.SSC + (size_t)(tok0 + (tid & 127)) * 8 + h);
}
DI void ph_s3_ssd(const P& p, int l, LDSP unsigned char* lds) {
    const int tid = ltid(), lane = tid & 63, w = __builtin_amdgcn_readfirstlane(tid >> 6), G = lane >> 4, li = lane & 15, i = 16 * w + li;
    LDSP bf16_t* XH = (LDSP bf16_t*)lds; LDSP bf16_t* BG = XH + 128 * LD64; LDSP bf16_t* CG = BG + 128 * LD64; LDSP bf16_t* MM = CG + 128 * LD64; LDSP f32x4v* SC = (LDSP f32x4v*)(MM + 128 * LD128);
    LDSP bf16_t* HF = (LDSP bf16_t*)(SC + 128); LDSP bf16_t* HB = HF + 64 * LD64;
    const int nit = (l == 0 ? NTILE : NB * 32) * 8, GS_ = gridDim.x;
    int it = ((int)blockIdx.x + (GS_ >> 1)) % GS_; SsdPre pre;
    if (it < nit) s3_ssd_load(p, s3_tile(l, it >> 3), it & 7, tid, i, G, pre);
    for (; it < nit; it += GS_) {
        const int tl = s3_tile(l, it >> 3), h = it & 7, tok0 = tile_tok0(tl);
        __syncthreads();
        { const int j = tid >> 2, cq = tid & 3;
          *(LDSP u32x4v*)(XH + j * LD64 + cq * 16) = pre.x0; *(LDSP u32x4v*)(XH + j * LD64 + cq * 16 + 8) = pre.x1;
          *(LDSP u32x4v*)(BG + j * LD64 + cq * 16) = pre.b0; *(LDSP u32x4v*)(BG + j * LD64 + cq * 16 + 8) = pre.b1;
          *(LDSP u32x4v*)(CG + j * LD64 + cq * 16) = pre.c0; *(LDSP u32x4v*)(CG + j * LD64 + cq * 16 + 8) = pre.c1;
          *(LDSP u32x4v*)(HF + (tid >> 3) * LD64 + (tid & 7) * 8) = pre.hf; *(LDSP u32x4v*)(HB + (tid >> 3) * LD64 + (tid & 7) * 8) = pre.hb;
          if (tid < 128) SC[tid] = pre.sc; }
        if (it + GS_ < nit) s3_ssd_load(p, s3_tile(l, (it + GS_) >> 3), (it + GS_) & 7, tid, i, G, pre);
        __syncthreads();
        u32x2v zr[4];
#pragma unroll
        for (int pt = 0; pt < 4; ++pt) zr[pt] = *(const u32x2v*)(p.PROJ + (size_t)(tok0 + i) * LDP + OFF_Z + h * 64 + 16 * pt + 4 * G);
        const f32x4v sci = SC[i];
        {
            f32x4v am[8];
#pragma unroll
            for (int ut = 0; ut < 8; ++ut) am[ut] = (f32x4v){0.f, 0.f, 0.f, 0.f};
#pragma unroll
            for (int ks = 0; ks < 2; ++ks) { const bf16x8v vfr = frag_row(CG, LD64, 16 * w, 32 * ks, lane);
#pragma unroll
                for (int ut = 0; ut < 8; ++ut) am[ut] = mfma16(frag_row(BG, LD64, 16 * ut, 32 * ks, lane), vfr, am[ut]); }
#pragma unroll
            for (int ut = 0; ut < 8; ++ut) { f32x4v m;
#pragma unroll
                for (int r = 0; r < 4; ++r) { const int jj = 16 * ut + 4 * G + r; const f32x4v scj = SC[jj];
                    const float Lf = jj <= i ? __builtin_amdgcn_exp2f(fminf(sci.x - scj.y, 30.f)) : 0.f, Lb = jj >= i ? __builtin_amdgcn_exp2f(fminf(sci.z - scj.w, 30.f)) : 0.f;
                    m[r] = am[ut][r] * (Lf + Lb); }
                *(LDSP u32x2v*)(MM + i * LD128 + 16 * ut + 4 * G) = pack4(m); }
        }
        asm volatile("s_waitcnt lgkmcnt(0)" ::: "memory");
        f32x4v ay[4], af_[4], ab_[4];
#pragma unroll
        for (int pt = 0; pt < 4; ++pt) { ay[pt] = (f32x4v){0.f, 0.f, 0.f, 0.f}; af_[pt] = ay[pt]; ab_[pt] = ay[pt]; }
#pragma unroll
        for (int ks = 0; ks < 2; ++ks) { const bf16x8v vfr = frag_row(CG, LD64, 16 * w, 32 * ks, lane);
#pragma unroll
            for (int pt = 0; pt < 4; ++pt) { af_[pt] = mfma16(frag_row(HF, LD64, 16 * pt, 32 * ks, lane), vfr, af_[pt]); ab_[pt] = mfma16(frag_row(HB, LD64, 16 * pt, 32 * ks, lane), vfr, ab_[pt]); } }
#pragma unroll
        for (int ks = 0; ks < 4; ++ks) { const bf16x8v vfr = frag_row(MM, LD128, 16 * w, 32 * ks, lane);
#pragma unroll
            for (int pt = 0; pt < 4; ++pt) ay[pt] = mfma16(frag_col(XH, LD64, 16 * pt, 32 * ks, lane), vfr, ay[pt]); }
        const float sf = __builtin_amdgcn_exp2f(sci.x), sb = __builtin_amdgcn_exp2f(sci.z), dsk = p.d_skip[l * 8 + h];
        float ssq = 0.f;
#pragma unroll
        for (int pt = 0; pt < 4; ++pt) { const int pc = 16 * pt + 4 * G;
            const u32x2v xr = *(LDSP const u32x2v*)(XH + i * LD64 + pc);
            const float xv[4] = {__uint_as_float(xr.x << 16), __uint_as_float(xr.x & 0xffff0000u), __uint_as_float(xr.y << 16), __uint_as_float(xr.y & 0xffff0000u)};
            const float zv[4] = {__uint_as_float(zr[pt].x << 16), __uint_as_float(zr[pt].x & 0xffff0000u), __uint_as_float(zr[pt].y << 16), __uint_as_float(zr[pt].y & 0xffff0000u)};
            float yv[4];
#pragma unroll
            for (int r = 0; r < 4; ++r) { yv[r] = (ay[pt][r] + sf * af_[pt][r] + sb * ab_[pt][r] + dsk * xv[r]) * siluf(zv[r]); yv[r] = bf2f(f2bf(yv[r])); ssq += yv[r] * yv[r]; }
            *(u32x2v*)(p.H + (size_t)(tok0 + i) * D + h * 64 + pc) = mk2(pk2(yv[0], yv[1]), pk2(yv[2], yv[3])); }
        ssq += shx(ssq, 16, lane); ssq += shx(ssq, 32, lane);
        if (G == 0) p.SSQ[(size_t)(tok0 + i) * 8 + h] = ssq;
    }
}
struct GlaPre { u32x4v qk[2][4], vv[4], sf[2], sb[2]; };
DI void s3_gla_load(const P& p, int tl, int h, int tid, int i, int G, GlaPre& r) {
    const int tok0 = tile_tok0(tl);
#pragma unroll
    for (int q = 0; q < 2; ++q) { const int c = tid + q * NTHR, rr = c >> 3, cc = c & 7; const bf16_t* qb = p.QKB + (size_t)(tok0 + rr) * 1024 + h * 64 + cc * 8;
        r.qk[q][0] = *(const u32x4v*)qb; r.qk[q][1] = *(const u32x4v*)(qb + 256);
        r.qk[q][2] = *(const u32x4v*)(qb + 512); r.qk[q][3] = *(const u32x4v*)(qb + 768);
        const bf16_t* Sg = p.GS + (size_t)((tl * 4 + h) * 2 + 0) * 8192 + (size_t)rr * 64 + cc * 8; r.sf[q] = *(const u32x4v*)Sg; r.sb[q] = *(const u32x4v*)(Sg + 8192); }
#pragma unroll
    for (int q = 0; q < 4; ++q) { const int c = tid + q * NTHR, rr = c >> 4, cc = c & 15; r.vv[q] = *(const u32x4v*)(p.PROJ + (size_t)(tok0 + rr) * LDP + OFF_V + h * 128 + cc * 8); }
}
DI void ph_s3_gla(const P& p, int l, LDSP unsigned char* lds) {
    const int tid = ltid(), lane = tid & 63, w = __builtin_amdgcn_readfirstlane(tid >> 6), G = lane >> 4, li = lane & 15, i = 16 * w + li;
    LDSP bf16_t* Q2 = (LDSP bf16_t*)lds;
    LDSP bf16_t* KF = Q2 + 8 * 2 * 16 * LD64; LDSP bf16_t* KB = KF + 128 * LD64; LDSP bf16_t* VT = KB + 128 * LD64; LDSP bf16_t* SF = VT + 128 * LD128; LDSP bf16_t* SB = SF + 128 * LD64;
    LDSP bf16_t* AMw = SF + w * 16 * LD128;
    const int nit = (l == 0 ? NTILE : NB * 32) * 4, GS_ = gridDim.x;
    int it = blockIdx.x; GlaPre pre;
    if (it < nit) s3_gla_load(p, s3_tile(l, it >> 2), it & 3, tid, i, G, pre);
    for (; it < nit; it += GS_) {
        const int tl = s3_tile(l, it >> 2), h = it & 3, tok0 = tile_tok0(tl);
        __syncthreads();
#pragma unroll
        for (int q = 0; q < 2; ++q) { const int c = tid + q * NTHR, rr = c >> 3, cc = c & 7; LDSP bf16_t* qrow = Q2 + (rr >> 4) * (2 * 16 * LD64) + (rr & 15) * LD64 + cc * 8;
            *(LDSP u32x4v*)qrow = pre.qk[q][0]; *(LDSP u32x4v*)(qrow + 16 * LD64) = pre.qk[q][2];
            *(LDSP u32x4v*)(KF + rr * LD64 + cc * 8) = pre.qk[q][1]; *(LDSP u32x4v*)(KB + rr * LD64 + cc * 8) = pre.qk[q][3];
            *(LDSP u32x4v*)(SF + rr * LD64 + cc * 8) = pre.sf[q]; *(LDSP u32x4v*)(SB + rr * LD64 + cc * 8) = pre.sb[q]; }
#pragma unroll
        for (int q = 0; q < 4; ++q) { const int c = tid + q * NTHR, rr = c >> 4, cc = c & 15; *(LDSP u32x4v*)(VT + rr * LD128 + cc * 8) = pre.vv[q]; }
        if (it + GS_ < nit) s3_gla_load(p, s3_tile(l, (it + GS_) >> 2), (it + GS_) & 3, tid, i, G, pre);
        __syncthreads();
        f32x4v ao[8];
#pragma unroll
        for (int q = 0; q < 8; ++q) ao[q] = (f32x4v){0.f, 0.f, 0.f, 0.f};
        bf16x8v qfr[2][2];
#pragma unroll
        for (int dir = 0; dir < 2; ++dir)
#pragma unroll
            for (int ks = 0; ks < 2; ++ks) qfr[dir][ks] = frag_row(Q2 + w * (2 * 16 * LD64) + dir * 16 * LD64, LD64, 0, 32 * ks, lane);
#pragma unroll
        for (int dir = 0; dir < 2; ++dir) {
            LDSP const bf16_t* SS_ = dir ? SB : SF;
#pragma unroll
            for (int ks = 0; ks < 2; ++ks) {
#pragma unroll
                for (int vt = 0; vt < 8; ++vt) ao[vt] = mfma16(frag_row(SS_, LD64, 16 * vt, 32 * ks, lane), qfr[dir][ks], ao[vt]); }
        }
        __syncthreads();
#pragma unroll
        for (int uh = 0; uh < 4; ++uh) {
            f32x4v a2[2]; a2[0] = (f32x4v){0.f, 0.f, 0.f, 0.f}; a2[1] = a2[0];
#pragma unroll
            for (int dir = 0; dir < 2; ++dir) {
                LDSP const bf16_t* KS = dir ? KB : KF;
                f32x4v as[2]; as[0] = (f32x4v){0.f, 0.f, 0.f, 0.f}; as[1] = as[0];
#pragma unroll
                for (int ks = 0; ks < 2; ++ks) {
#pragma unroll
                    for (int q = 0; q < 2; ++q) as[q] = mfma16(frag_row(KS, LD64, 16 * (2 * uh + q), 32 * ks, lane), qfr[dir][ks], as[q]); }
#pragma unroll
                for (int q = 0; q < 2; ++q)
#pragma unroll
                    for (int r = 0; r < 4; ++r) { const int jj = 16 * (2 * uh + q) + 4 * G + r; const bool keep = dir == 0 ? (jj <= i) : (jj >= i); a2[q][r] += keep ? as[q][r] : 0.f; }
            }
#pragma unroll
            for (int q = 0; q < 2; ++q) *(LDSP u32x2v*)(AMw + li * LD128 + 16 * (2 * uh + q) + 4 * G) = pack4(a2[q]);
        }
        u32x2v gr[8];
#pragma unroll
        for (int vt = 0; vt < 8; ++vt) gr[vt] = *(const u32x2v*)(p.PROJ + (size_t)(tok0 + i) * LDP + OFF_GO + h * 128 + 16 * vt + 4 * G);
        asm volatile("s_waitcnt lgkmcnt(0)" ::: "memory");
#pragma unroll
        for (int ks = 0; ks < 4; ++ks) { const bf16x8v vfr = frag_row(AMw, LD128, 0, 32 * ks, lane);
#pragma unroll
            for (int vt = 0; vt < 8; ++vt) ao[vt] = mfma16(frag_col(VT, LD128, 16 * vt, 32 * ks, lane), vfr, ao[vt]); }
        float so = 0.f;
#pragma unroll
        for (int vt = 0; vt < 8; ++vt)
#pragma unroll
            for (int r = 0; r < 4; ++r) so += ao[vt][r] * ao[vt][r];
        so += shx(so, 16, lane); so += shx(so, 32, lane);
        const float ro = rsqrtf(so * (1.0f / 128.0f) + 1e-6f);
#pragma unroll
        for (int vt = 0; vt < 8; ++vt) { const int vc = 16 * vt + 4 * G; const f32x4v gg = *(const f32x4v*)(p.gla_norm_g + l * 128 + vc);
            const float g0 = __uint_as_float(gr[vt].x << 16), g1 = __uint_as_float(gr[vt].x & 0xffff0000u), g2 = __uint_as_float(gr[vt].y << 16), g3 = __uint_as_float(gr[vt].y & 0xffff0000u);
            *(u32x2v*)(p.H + (size_t)(tok0 + i) * D + 512 + h * 128 + vc) = mk2(pk2(ao[vt][0] * ro * gg.x * siluf(g0), ao[vt][1] * ro * gg.y * siluf(g1)), pk2(ao[vt][2] * ro * gg.z * siluf(g2), ao[vt][3] * ro * gg.w * siluf(g3))); }
    }
}
DI void ph_s3(const P& p, int l, LDSP unsigned char* lds) { ph_s3_gla(p, l, lds); ph_s3_ssd(p, l, lds); }
struct RouteR { bool own; int t, e1, e2, r1, r2; };
template <int NR> DI void normroute_tile(const P& p, int tb, const float* MODl, LDSP int* lcnt, const float* g2, LDSP bf16_t* WR, LDSP bf16_t* HT, int lane, int G, int li, RouteR& R) {
    constexpr int LDW = 1032, LDT = 264;
        const float* mr = MODl + (size_t)tok_modrow(tb) * 6144;
        float rs[NR];
        { const f32x4v* q = (const f32x4v*)(p.XSS + (size_t)(tb + (li < NR ? li : 0)) * 16); const f32x4v a = q[0], b = q[1], c = q[2], d = q[3];
          const float ss = (((a.x + a.y) + (a.z + a.w)) + ((b.x + b.y) + (b.z + b.w))) + (((c.x + c.y) + (c.z + c.w)) + ((d.x + d.y) + (d.z + d.w)));
          const float r = rsqrtf(ss * (1.0f / D) + 1e-6f);
#pragma unroll
          for (int i = 0; i < NR; ++i) rs[i] = shl(r, i); }
        f32x4v acc[2]; acc[0] = (f32x4v){0.f, 0.f, 0.f, 0.f}; acc[1] = acc[0];
        u32x2v xq[NR];
#pragma unroll
        for (int i = 0; i < NR; ++i) xq[i] = *(const u32x2v*)(xrow(p, tb + i) + lane * 4);
#pragma unroll
        for (int kc = 0; kc < 4; ++kc) {
            const int kk = kc * 256 + lane * 4;
            const f32x4v gg = *(const f32x4v*)(g2 + kk), sh = *(const f32x4v*)(mr + 3 * 1024 + kk), sc = *(const f32x4v*)(mr + 4 * 1024 + kk);
            f32x4v gs;
#pragma unroll
            for (int j = 0; j < 4; ++j) gs[j] = gg[j] * (1.f + sc[j]);
#pragma unroll
            for (int i = 0; i < NR; ++i) { const u32x2v r = xq[i];
                const f32x4v xv = mkf4(__uint_as_float(r.x << 16), __uint_as_float(r.x & 0xffff0000u), __uint_as_float(r.y << 16), __uint_as_float(r.y & 0xffff0000u));
                const f32x4v h = xv * rs[i] * gs + sh; const u32x2v hb = pack4(h);
                *(unsigned*)((unsigned char*)p.H + (size_t)(tb + i) * D + kk) = pg8::pk4_fp8(h);
                *(LDSP u32x2v*)(HT + i * LDT + lane * 4) = hb; }
            if (kc < 3) {
#pragma unroll
                for (int i = 0; i < NR; ++i) xq[i] = *(const u32x2v*)(xrow(p, tb + i) + kk + 256); }
            asm volatile("s_waitcnt lgkmcnt(0)" ::: "memory");
#pragma unroll
            for (int ks = 0; ks < 8; ++ks) { const bf16x8v vfr = frag_row(HT, LDT, 0, 32 * ks, lane);
                acc[0] = mfma16(frag_row(WR, LDW, 0, kc * 256 + 32 * ks, lane), vfr, acc[0]);
                acc[1] = mfma16(frag_row(WR, LDW, 16, kc * 256 + 32 * ks, lane), vfr, acc[1]); }
            asm volatile("s_waitcnt lgkmcnt(0)" ::: "memory");
        }
        float bgs = -1e30f; int bgi = 0, e1 = 0, e2 = 0; float w1 = 0.f, w2 = 0.f;
#pragma unroll
        for (int ut = 0; ut < 2; ++ut) { const int gi = ut * 4 + G; float m1 = -1e30f, m2 = -1e30f, s1 = 0.f, s2 = 0.f; int i1 = 0, i2 = 0;
#pragma unroll
            for (int r = 0; r < 4; ++r) { const float sv = 1.0f / (1.0f + __expf(-acc[ut][r])), vv = sv + p.router_bias[gi * 4 + r];
                if (vv > m1) { m2 = m1; i2 = i1; s2 = s1; m1 = vv; i1 = gi * 4 + r; s1 = sv; } else if (vv > m2) { m2 = vv; i2 = gi * 4 + r; s2 = sv; } }
            if (m1 + m2 > bgs) { bgs = m1 + m2; bgi = gi; e1 = i1; e2 = i2; w1 = s1; w2 = s2; } }
#pragma unroll
        for (int o = 16; o <= 32; o <<= 1) {
            const float ogs = shx(bgs, o, lane), ow1 = shx(w1, o, lane), ow2 = shx(w2, o, lane); const int ogi = shxi(bgi, o, lane), oe1 = shxi(e1, o, lane), oe2 = shxi(e2, o, lane);
            if (ogs > bgs || (ogs == bgs && ogi < bgi)) { bgs = ogs; bgi = ogi; e1 = oe1; e2 = oe2; w1 = ow1; w2 = ow2; } }
        R.own = (G == 0 && li < NR); R.t = tb + li; R.e1 = e1; R.e2 = e2;
        if (R.own) { const float inv = 1.0f / (w1 + w2); p.EW[R.t * 2 + 0] = w1 * inv; p.EW[R.t * 2 + 1] = w2 * inv;
            R.r1 = __hip_atomic_fetch_add(&lcnt[e1], 1, __ATOMIC_RELAXED, __HIP_MEMORY_SCOPE_WORKGROUP); R.r2 = __hip_atomic_fetch_add(&lcnt[e2], 1, __ATOMIC_RELAXED, __HIP_MEMORY_SCOPE_WORKGROUP); }
}
DI void ph_normroute(const P& p, int l, int t0, LDSP unsigned char* lds) {
    const int tid_ = ltid(), lane = tid_ & 63, wv = tid_ >> 6, gw = blockIdx.x * NWV + wv, NW = gridDim.x * NWV, G = lane >> 4, li = lane & 15;
    const float* MODl = p.MOD + (size_t)l * 9 * 6144; int* counts = p.counts + l * 32 * 32;
    constexpr int LDW = 1032, LDT = 264;
    LDSP bf16_t* WR = (LDSP bf16_t*)lds;
    LDSP bf16_t* HT = WR + 32 * LDW + wv * 16 * LDT;
    { u32x4v wv_[8];
#pragma unroll
      for (int q = 0; q < 8; ++q) wv_[q] = *(const u32x4v*)(p.WRT + (size_t)(tid_ + q * NTHR) * 8);
#pragma unroll
      for (int q = 0; q < 8; ++q) { const int c = tid_ + q * NTHR; *(LDSP u32x4v*)(WR + (c >> 7) * LDW + (c & 127) * 8) = wv_[q]; } }
    __syncthreads();
    const float* g2 = p.norm2_g + l * D;
    const int ntok = T - t0, nfull = (ntok >> 4) / NW * NW, nrem = ntok - nfull * 16;
    LDSP int* lcnt = (LDSP int*)(WR + 32 * LDW + NWV * 16 * LDT);
    LDSP int* lbase = lcnt + 32;
    const int rf = (nfull + NW - 1) / NW, rr = (nrem + NW - 1) / NW;
    for (int rd = 0; rd < rf + rr; ++rd) {
        if (tid_ < 32) lcnt[tid_] = 0;
        __syncthreads();
        RouteR R; R.own = false; R.t = 0; R.e1 = 0; R.e2 = 0; R.r1 = 0; R.r2 = 0;
        if (rd < rf) { const int tile = rd * NW + gw; if (tile < nfull) normroute_tile<16>(p, t0 + tile * 16, MODl, lcnt, g2, WR, HT, lane, G, li, R); }
        else { const int e = (rd - rf) * NW + gw; if (e < nrem) normroute_tile<1>(p, t0 + nfull * 16 + e, MODl, lcnt, g2, WR, HT, lane, G, li, R); }
        __syncthreads();
        if (tid_ < 32) { const int c = lcnt[tid_]; lbase[tid_] = c > 0 ? atomicAdd(&counts[tid_ * 32], c) : 0; }
        __syncthreads();
        if (R.own) { const int r1 = lbase[R.e1] + R.r1, r2 = lbase[R.e2] + R.r2;
            p.MAP[(size_t)R.e1 * T + r1] = R.t; p.MAP[(size_t)R.e2 * T + r2] = R.t;
            *(int4*)(p.TOKSLOT + (size_t)R.t * 4) = make_int4(R.e1, r1, R.e2, r2); }
    }
}

DI void ph_combine(const P& p, int l, int t0, const unsigned char* Y  , LDSP int* ps  ) {
    const int tid_ = ltid(), lane = tid_ & 63, gw = blockIdx.x * NWV + __builtin_amdgcn_readfirstlane(tid_ >> 6)  , NW = gridDim.x * NWV;
    const float* MODl = p.MOD + (size_t)l * 9 * 6144; const int* counts = p.counts + l * 32 * 32;
    if (tid_ < 64) { const int cnt = tid_ < 32 ? counts[tid_ * 32] : 0; int pc = cnt;
#pragma unroll
        for (int o = 1; o < 32; o <<= 1) { const int src = lane >= o ? lane - o : lane; const int a = shli(pc, src); if (lane >= o) pc += a; }
        if (tid_ < 32) ps[tid_] = pc - cnt; }
    __syncthreads();
    for (int t = t0 + 4 * gw; t < T; t += 4 * NW) {
        int4 sl[4]; float4 ew[2];
#pragma unroll
        for (int u = 0; u < 4; ++u) sl[u] = *(const int4*)(p.TOKSLOT + (size_t)(t + u) * 4);
        ew[0] = *(const float4*)(p.EW + (size_t)t * 2); ew[1] = *(const float4*)(p.EW + (size_t)(t + 2) * 2);
        unsigned yr[4][2][4];
#pragma unroll
        for (int u = 0; u < 4; ++u) { const unsigned char* y0 = Y + (size_t)__builtin_amdgcn_readfirstlane(ps[sl[u].x] + sl[u].y) * D; const unsigned char* y1 = Y + (size_t)__builtin_amdgcn_readfirstlane(ps[sl[u].z] + sl[u].w) * D;
#pragma unroll
            for (int i = 0; i < 4; ++i) { yr[u][0][i] = *(const unsigned*)(y0 + (i * 64 + lane) * 4); yr[u][1][i] = *(const unsigned*)(y1 + (i * 64 + lane) * 4); } }
        const float* mrow = MODl + (size_t)tok_modrow(t) * 6144; const float* g5 = mrow + 5 * 1024;
        const float* mr1 = p.MOD + (size_t)9 * 6144 + (size_t)tok_modrow(t) * 6144;
#pragma unroll
        for (int pr = 0; pr < 2; ++pr) {
            const float wgt[2][2] = {{ew[pr].x, ew[pr].y}, {ew[pr].z, ew[pr].w}};
            u32x2v xr[2][4];
#pragma unroll
            for (int u = 0; u < 2; ++u)
#pragma unroll
                for (int i = 0; i < 4; ++i) xr[u][i] = *(const u32x2v*)(xrow(p, t + 2 * pr + u) + (i * 64 + lane) * 4);
            float4 v[2][4];
#pragma unroll
            for (int i = 0; i < 4; ++i) { const int c = (i * 64 + lane) * 4; const float4 gg = *(const float4*)(g5 + c);
#pragma unroll
                for (int u = 0; u < 2; ++u) { const u32x2v x = xr[u][i]; const int a = (int)yr[2 * pr + u][0][i], b = (int)yr[2 * pr + u][1][i]; const float w1 = wgt[u][0], w2 = wgt[u][1];
                    v[u][i].x = __uint_as_float(x.x << 16) + gg.x * (w1 * __builtin_amdgcn_cvt_f32_fp8(a, 0) + w2 * __builtin_amdgcn_cvt_f32_fp8(b, 0));
                    v[u][i].y = __uint_as_float(x.x & 0xffff0000u) + gg.y * (w1 * __builtin_amdgcn_cvt_f32_fp8(a, 1) + w2 * __builtin_amdgcn_cvt_f32_fp8(b, 1));
                    v[u][i].z = __uint_as_float(x.y << 16) + gg.z * (w1 * __builtin_amdgcn_cvt_f32_fp8(a, 2) + w2 * __builtin_amdgcn_cvt_f32_fp8(b, 2));
                    v[u][i].w = __uint_as_float(x.y & 0xffff0000u) + gg.w * (w1 * __builtin_amdgcn_cvt_f32_fp8(a, 3) + w2 * __builtin_amdgcn_cvt_f32_fp8(b, 3));
                    if (l == 0) *(u32x2v*)(xrow(p, t + 2 * pr + u) + c) = mk2(pk2(v[u][i].x, v[u][i].y), pk2(v[u][i].z, v[u][i].w)); } }
            float rstd[2];
#pragma unroll
            for (int u = 0; u < 2; ++u) { float ss = 0.f;
#pragma unroll
                for (int i = 0; i < 4; ++i) ss += v[u][i].x * v[u][i].x + v[u][i].y * v[u][i].y + v[u][i].z * v[u][i].z + v[u][i].w * v[u][i].w;
                rstd[u] = rsqrtf(wave_sum(ss, lane) * (1.0f / D) + 1e-6f); }
            if (l == 0) {
#pragma unroll
                for (int i = 0; i < 4; ++i) { const int c = (i * 64 + lane) * 4;
                    const float4 gg = *(const float4*)(p.norm1_g + D + c), sh = *(const float4*)(mr1 + c), sc = *(const float4*)(mr1 + 1024 + c);
#pragma unroll
                    for (int u = 0; u < 2; ++u) { const float r = rstd[u];
                        *(unsigned*)((unsigned char*)p.H + (size_t)(t + 2 * pr + u) * D + c) = pg8::pk4_fp8((pg8::f32x4){v[u][i].x * r * gg.x * (1.f + sc.x) + sh.x, v[u][i].y * r * gg.y * (1.f + sc.y) + sh.y, v[u][i].z * r * gg.z * (1.f + sc.z) + sh.z, v[u][i].w * r * gg.w * (1.f + sc.w) + sh.w}); } }
            } else {
#pragma unroll
                for (int u = 0; u < 2; ++u)
#pragma unroll
                    for (int i = 0; i < 4; ++i) { const float4 gg = ((const float4*)p.final_g)[i * 64 + lane]; const float r = rstd[u];
                        ((float4*)(p.out + (size_t)(t + 2 * pr + u - TC) * D))[i * 64 + lane] = make_float4(v[u][i].x * r * gg.x, v[u][i].y * r * gg.y, v[u][i].z * r * gg.z, v[u][i].w * r * gg.w); }
            }
        }
    }
}

#define XLAS __attribute__((address_space(3)))
#define XB_TMO      128
#define XB_XCNT(j)  (256  + 64 * (j))
#define XB_XSUB(j)  (1280 + 64 * (j))
#define XB_XGEN(j)  (2304 + 64 * (j))
#define XB_TOP      3328
#define XB_TOPGEN   3392
#define XCD_BAR_WORDS 3456
#define XB_SPIN_CAP (1u << 18)

__device__ __forceinline__ unsigned xb_ld(unsigned* p)              { return __hip_atomic_load(p, __ATOMIC_RELAXED, __HIP_MEMORY_SCOPE_AGENT); }
__device__ __forceinline__ unsigned xb_add(unsigned* p, unsigned v) { return __hip_atomic_fetch_add(p, v, __ATOMIC_RELAXED, __HIP_MEMORY_SCOPE_AGENT); }
__device__ __forceinline__ unsigned xb_xcc_id() { return (unsigned)__builtin_amdgcn_s_getreg((3 << 11) | 20) & 0xFu; }
#define XB_SPIN(cond, bar) do { unsigned _sp = 0; while (cond) { __builtin_amdgcn_s_sleep(1); \
    if ((++_sp & 255u) == 0u) { if (xb_ld(&(bar)[XB_TMO])) break; if (_sp > XB_SPIN_CAP) { atomicAdd(&(bar)[XB_TMO], 1u); break; } } } } while (0)

struct XcdBarrier {
    unsigned* bar; unsigned x;
    volatile XLAS unsigned* st;
};

__device__ __forceinline__ XcdBarrier xcd_barrier_post(unsigned* bar, volatile XLAS unsigned* st) {
    XcdBarrier b; b.bar = bar; b.x = xb_xcc_id(); b.st = st;
    if (ltid() == 0) (void)xb_add(&bar[XB_XCNT(b.x)], 1u);
    return b;
}
__device__ __forceinline__ void xcd_barrier_complete(unsigned* bar, unsigned x, unsigned& nloc, unsigned& nx) {
    const unsigned G = gridDim.x * gridDim.y * gridDim.z;
    unsigned sum, cnt, mine, sp = 0u;
    for (;;) {
        sum = 0u; cnt = 0u; mine = 0u;
#pragma unroll
        for (unsigned j = 0; j < 16; ++j) { const unsigned c = xb_ld(&bar[XB_XCNT(j)]); sum += c; cnt += (c > 0u) ? 1u : 0u; mine = (j == x) ? c : mine; }
        if (sum == G) break;
        __builtin_amdgcn_s_sleep(1);
        if ((++sp & 255u) == 0u) { if (xb_ld(&bar[XB_TMO])) break; if (sp > XB_SPIN_CAP) { atomicAdd(&bar[XB_TMO], 1u); break; } }
    }
    nloc = mine > 0u ? mine : 1u; nx = cnt > 0u ? cnt : 1u;
}

__device__ __forceinline__ void xcd_barrier(const XcdBarrier& b) {
    asm volatile("s_waitcnt vmcnt(0)" ::: "memory");
    __syncthreads();
    if (ltid() == 0) {
        unsigned* bar = b.bar;
        __builtin_amdgcn_s_waitcnt(0);
        unsigned nloc = b.st[0], nx = b.st[1];
        if (nloc == 0u) { xcd_barrier_complete(bar, b.x, nloc, nx); b.st[0] = nloc; b.st[1] = nx; }
        const unsigned old = xb_add(&bar[XB_XSUB(b.x)], 1u);
        const unsigned gen = old / nloc;
        if (old + 1u == (gen + 1u) * nloc) {
            __builtin_amdgcn_fence(__ATOMIC_RELEASE, "agent");
            asm volatile("s_waitcnt vmcnt(0)" ::: "memory");
            const unsigned og = xb_add(&bar[XB_TOP], 1u);
            const unsigned tg = og / nx;
            if (og + 1u == (tg + 1u) * nx) xb_add(&bar[XB_TOPGEN], 1u);
            else XB_SPIN(xb_ld(&bar[XB_TOPGEN]) == tg, bar);
            __builtin_amdgcn_fence(__ATOMIC_ACQUIRE, "agent");
            xb_add(&bar[XB_XGEN(b.x)], 1u);
            asm volatile("s_waitcnt vmcnt(0)" ::: "memory");
        } else {
            XB_SPIN(xb_ld(&bar[XB_XGEN(b.x)]) == gen, bar);
            __builtin_amdgcn_fence(__ATOMIC_ACQUIRE, "agent");
            asm volatile("s_waitcnt vmcnt(0)" ::: "memory");
        }
    }
    __syncthreads();
}

DI void moe_table(const P& p, int l, PG8_LAS int* tab) {
    const int tid_ = ltid();
    if (tid_ < 64) { const int cnt = tid_ < 32 ? p.counts[(l * 32 + tid_) * 32] : 0; const int nt = (cnt + 255) >> 8; int pt = nt, pc = cnt;
#pragma unroll
        for (int o = 1; o < 32; o <<= 1) { const int ln_ = tid_ & 63, src = ln_ >= o ? ln_ - o : ln_; const int a = shli(pt, src), b = shli(pc, src); if (ln_ >= o) { pt += a; pc += b; } }
        if (tid_ < 32) { tab[tid_ + 1] = pt; tab[33 + tid_] = cnt; tab[65 + tid_] = pc - cnt; if (tid_ == 0) tab[0] = 0; } }
    __syncthreads();
}
typedef const __attribute__((address_space(4))) P* PK;
DI PK lp(PK q) { asm volatile("" : "+s"(q)); return q; }
#define PHASE(...) do { const P p = *(const P*)lp(pk); __VA_ARGS__; } while (0)

#ifndef CV_L0
#define CV_L0 7
#endif
template <int l> DI void layer(PK pk, unsigned char* smem, const XcdBarrier& xbar) {
    float* ldsf = (float*)smem; const int gw = 0, NW = 0, lane = 0;
    {
        constexpr int NG = l == 0 ? 234 : 182;
        constexpr int CV1 = l == 0 ? CV_L0 * 768 : NE * 768;
        const int G = (int)gridDim.x == 256 ? NG : (int)gridDim.x;
        if ((int)blockIdx.x < G) PHASE({ pg8::Gemm g{p.H, (const bf16_t*)((const unsigned char*)p.WinT + (size_t)l * NPAD_IN * D), T, NPAD_IN, D / 2}; pg8::StaticOrder S; S.init(T, NPAD_IN, G, (int)blockIdx.x);
            pg8::EpiProj E{p.PROJ, LDP, INDIM, 1.0f / 64.0f};
            pg8::gemm_phase<pg8::EpiProj, pg8::StaticOrder, false, PG8_SP2, 1>((PG8_LAS unsigned char*)smem, g, S, E, nullptr); });
        else PHASE(ph_convert_experts(p, l, ldsf, G, (int)gridDim.x - G, 0, CV1));
        if ((int)gridDim.x != 256) PHASE(ph_convert_experts(p, l, ldsf, 0, (int)gridDim.x, 0, CV1));
    }
    xcd_barrier(xbar);
    PHASE(ph_prep(p, l, (LDSP unsigned char*)smem));
    xcd_barrier(xbar);
    PHASE(ph_s1(p, l, (LDSP unsigned char*)smem));
    xcd_barrier(xbar);
    PHASE(ph_s2(p));
    xcd_barrier(xbar);
    PHASE(ph_s3(p, l, (LDSP unsigned char*)smem));
    xcd_barrier(xbar);
    {
        constexpr int ro = l == 0 ? 0 : TC;
        constexpr int NG = l == 0 ? 182 : 256;
        const int G = (int)gridDim.x == 256 ? NG : (int)gridDim.x;
        if ((int)blockIdx.x < G) PHASE({ pg8::Gemm g{p.H + (size_t)ro * D, p.WoutT + (size_t)l * D * D, T - ro, D, D}; pg8::StaticOrder S; S.init(T - ro, D, G, (int)blockIdx.x);
            pg8::EpiResGate<l != 0> E{p.SSQ, p.ctx, p.x, p.XB, p.MOD + (size_t)l * 9 * 6144 + 2 * 1024, p.XSS, ro};
            pg8::gemm_phase<pg8::EpiResGate<l != 0>, pg8::StaticOrder>((PG8_LAS unsigned char*)smem, g, S, E, nullptr); });
        else if (l == 0) PHASE(ph_convert_experts(p, l, ldsf, G, (int)gridDim.x - G, CV_L0 * 768, NE * 768));
        if (l == 0 && (int)gridDim.x != 256) PHASE(ph_convert_experts(p, l, ldsf, 0, (int)gridDim.x, CV_L0 * 768, NE * 768));
    }
    xcd_barrier(xbar);
    const int t0 = l == 0 ? 0 : TC;
    PHASE(ph_normroute(p, l, t0, (LDSP unsigned char*)smem));
    xcd_barrier(xbar);
    PG8_LAS int* tab = (PG8_LAS int*)((PG8_LAS unsigned char*)smem + pg8::STAGE_BYTES);
#pragma unroll
    for (int ph = 0; ph < 2; ++ph) {
        PHASE(moe_table(p, l, tab));
        const int U = __builtin_amdgcn_readfirstlane(tab[32]) * 4;
        if (ph == 0) PHASE({ pg8::Gemm g{p.H, p.WguT, T, D, D / 2}; pg8::MoeSched S{tab, p.MAP, U, (int)gridDim.x, (int)blockIdx.x, 4, 1, (size_t)D * D};
            pg8::EpiAct E{(unsigned char*)p.SS}; pg8::gemm_phase_moe<pg8::EpiAct, pg8::MoeSched, false, PG8_SP2, 1>((PG8_LAS unsigned char*)smem, g, S, E, nullptr); });
        else PHASE({ pg8::Gemm g{p.SS, p.WdT, T, D, 256}; pg8::MoeSched S{tab, p.MAP, U, (int)gridDim.x, (int)blockIdx.x, 4, 0, (size_t)D * 512};
            pg8::EpiY E{(unsigned char*)p.PROJ}; pg8::gemm_phase_moe<pg8::EpiY, pg8::MoeSched, false, PG8_SP2, 1>((PG8_LAS unsigned char*)smem, g, S, E, nullptr); });
        xcd_barrier(xbar);
    }
    PHASE(ph_combine(p, l, t0, (const unsigned char*)p.PROJ, (LDSP int*)smem));
    xcd_barrier(xbar);
}

__global__ void __launch_bounds__(NTHR) mega(P p_arg) {
    extern __shared__ __attribute__((aligned(16))) unsigned char smem[];
    cg::grid_group grid = cg::this_grid();
    PK pk = (PK)__builtin_amdgcn_kernarg_segment_ptr();
    const int lane = 0, gw = 0, NW = 0;
    float* ldsf = (float*)smem;
    volatile XLAS unsigned* bst = (volatile XLAS unsigned*)((XLAS unsigned char*)smem + LDS_BYTES - 16);
    { const int t_ = ltid(); if (t_ < 2) bst[t_] = 0u; }
    __syncthreads();
    const XcdBarrier xbar = xcd_barrier_post(pk->BAR, bst);
    PHASE(ph_init(p)); PHASE(ph_mod(p, ldsf)); PHASE(ph_convert_small(p, ldsf, gw, NW, lane));
    grid.sync();
    PHASE(ph_normmod1(p, 0, gw, NW, lane));
    xcd_barrier(xbar);
    layer<0>(pk, smem, xbar);
    layer<1>(pk, smem, xbar);
}

static inline size_t al(size_t x) { return (x + 255) & ~(size_t)255; }

extern "C" void kernel_launch(void* const* d_in, const int* in_sizes, int n_in, void* d_out, int out_size, void* d_ws, size_t ws_size, hipStream_t stream) {
    static int grid_blocks = 0;
    if (grid_blocks == 0) {
        int dev = 0, cus = 0, per_cu = 0;
        if (hipFuncSetAttribute((const void*)mega, hipFuncAttributeMaxDynamicSharedMemorySize, LDS_BYTES) != hipSuccess) { fprintf(stderr, "hipFuncSetAttribute failed\n"); grid_blocks = -1; return; }
        (void)hipGetDevice(&dev); (void)hipDeviceGetAttribute(&cus, hipDeviceAttributeMultiprocessorCount, dev);
        if (hipOccupancyMaxActiveBlocksPerMultiprocessor(&per_cu, (const void*)mega, NTHR, LDS_BYTES) != hipSuccess || per_cu < 1) { fprintf(stderr, "occupancy query: %d blocks/CU\n", per_cu); grid_blocks = -1; return; }
        grid_blocks = cus;
    }
    if (grid_blocks < 0) return;
    P p{};
    const float** pin = (const float**)&p;
    for (int i = 0; i < 29; ++i) pin[i] = (const float*)d_in[i];
    p.out = (float*)d_out;
    char* ws = (char*)d_ws; size_t off = 0;
    auto take = [&](size_t bytes) { char* q = ws + off; off += al(bytes); return q; };
    p.XB = (bf16_t*)take((size_t)T * D * 2);
    p.H = (bf16_t*)take((size_t)T * D * 2);
    p.PROJ = (bf16_t*)take((size_t)T * LDP * 2);
    p.SS = (bf16_t*)take((size_t)NTILE * 8 * 2 * 4096 * 2);
    p.GS = (bf16_t*)take((size_t)NTILE * 4 * 2 * 8192 * 2);
    p.SDEC = (float*)take((size_t)NTILE * 8 * 2 * 4);
    p.GDEC = (float*)take((size_t)NTILE * 4 * 2 * 64 * 4);
    p.MOD = (float*)take((size_t)2 * 9 * 6144 * 4);
    p.counts = (int*)take(64 * 32 * 4);
    p.TOKSLOT = (int*)take((size_t)T * 4 * 4);
    p.EW = (float*)take((size_t)T * 2 * 4);
    p.MAP = (int*)take((size_t)NE * T * 4);
    p.WinT = (bf16_t*)take((size_t)2 * NPAD_IN * D * 2);
    p.WoutT = (bf16_t*)take((size_t)2 * D * D * 2);
    p.WguT = (bf16_t*)take((size_t)NE * D * D * 2);
    p.WdT = (bf16_t*)take((size_t)NE * D * 512 * 2);
    p.WRT = (bf16_t*)take((size_t)32 * 1024 * 2);
    p.BAR = (unsigned*)take(XCD_BAR_WORDS * 4);
    p.XBCC = (bf16_t*)d_out;
    p.QKB = (bf16_t*)d_out + (size_t)T * 768;
    p.SSC = (float*)take((size_t)T * 8 * 4 * 4);
    p.STOT = (float*)take((size_t)NTILE * 8 * 2 * 4);
    p.SSQ = (float*)take((size_t)T * 8 * 4);
    p.XSS = (float*)take((size_t)T * 16 * 4);
    if (off > ws_size) { fprintf(stderr, "workspace too small: need %zu have %zu\n", off, ws_size); return; }
    if (hipMemsetAsync(p.BAR, 0, XCD_BAR_WORDS * 4, stream) != hipSuccess) { fprintf(stderr, "memset of barrier words failed\n"); return; }
    void* args[] = {&p};
    hipError_t e = hipLaunchCooperativeKernel((void*)mega, dim3(grid_blocks), dim3(NTHR), args, LDS_BYTES, stream);
    if (e != hipSuccess) fprintf(stderr, "cooperative launch failed: %s (grid %d)\n", hipGetErrorString(e), grid_blocks);
}
```

```cpp
#include <hip/hip_runtime.h>
#include <hip/hip_cooperative_groups.h>
#include <stdint.h>
#include <cstdio>
namespace cg = cooperative_groups;

typedef unsigned short bf16_t;
#define DI __device__ __forceinline__

constexpr int D = 1024, NB = 8, SEQ = 4096, CTXL = 256, TC = NB * CTXL, TL = NB * SEQ, T = TC + TL;
constexpr int INDIM = 2840, LDP = 2848;
constexpr int OFF_Z = 0, OFF_XBC = 512, OFF_DT = 1280, OFF_Q = 1288, OFF_K = 1544, OFF_V = 1800, OFF_GO = 2312, OFF_GK = 2824;
constexpr int NE = 32;

DI float bf2f(bf16_t v) { return __uint_as_float(((unsigned)v) << 16); }
typedef float f32x2v_ __attribute__((ext_vector_type(2)));
typedef __bf16 bf16x2v_ __attribute__((ext_vector_type(2)));
DI bf16_t f2bf(float f) { return __builtin_bit_cast(unsigned short, (__bf16)f); }
DI float siluf(float x) { return x * __builtin_amdgcn_rcpf(1.0f + __builtin_amdgcn_exp2f(-1.4426950408889634f * x)); }
DI float softplusf(float x) { return fmaxf(x, 0.f) + log1pf(__expf(-fabsf(x))); }
DI float logsigmoidf(float x) { return -softplusf(-x); }
DI float shx(float v, int o, int lane) { return __int_as_float(__builtin_amdgcn_ds_bpermute((lane ^ o) << 2, __float_as_int(v))); }
DI int shxi(int v, int o, int lane) { return __builtin_amdgcn_ds_bpermute((lane ^ o) << 2, v); }
DI float shl(float v, int src) { return __int_as_float(__builtin_amdgcn_ds_bpermute(src << 2, __float_as_int(v))); }
DI int shli(int v, int src) { return __builtin_amdgcn_ds_bpermute(src << 2, v); }
DI float wave_sum(float v, int lane) {
#pragma unroll
    for (int o = 32; o >= 1; o >>= 1) v += shx(v, o, lane);
    return v;
}
DI int ltid() { const int wv = __builtin_amdgcn_readfirstlane(threadIdx.x >> 6);
    int ln; asm volatile("v_mbcnt_lo_u32_b32 %0, -1, 0\n\tv_mbcnt_hi_u32_b32 %0, -1, %0" : "=v"(ln));
    return wv * 64 + ln; }
DI int tok_modrow(int t) { return t < TC ? 8 : ((t - TC) >> 12); }
template <class PT> DI bf16_t* xrow(const PT& p, int t) { return p.XB + (size_t)t * D; }


#ifndef PG8_SP2
#define PG8_SP2 true
#endif
namespace pg8 {
#define PG8_LAS __attribute__((address_space(3)))
typedef unsigned short bf16_t;
typedef short bf16x8 __attribute__((ext_vector_type(8)));
typedef float f32x4 __attribute__((ext_vector_type(4)));
typedef unsigned u32x4 __attribute__((ext_vector_type(4)));
constexpr int BM = 256, BK = 64, HALF = 128, HTB = HALF * BK * 2  , STAGE_BYTES = 8 * HTB, NXCD = 8, WGM = 8;

__host__ __device__ __forceinline__ int lds_byte(int r, int c) { const int st = (r >> 4) * 2 + (c >> 5), rr = r & 15, cc = c & 31, ob = rr * 64 + cc * 2; return st * 1024 + (ob ^ (((ob >> 9) & 1) << 5)); }
__host__ __device__ __forceinline__ void stage_rc(int b, int& R, int& C) { const int st = b / 1024, sb = b % 1024, swz = sb ^ (((sb >> 9) & 1) << 5); R = (st >> 1) * 16 + swz / 64; C = (st & 1) * 32 + (swz % 64) / 2; }
__host__ __device__ __forceinline__ int perm32(int rho) { const int n = rho >> 4, i = rho & 15; return 8 * (i >> 2) + 4 * n + (i & 3); }

struct Unit { int pm, pn; };
struct Gemm { const bf16_t* A; const bf16_t* Bt; int M, N, K; };

struct StaticOrder {
    int nM, nN, nwg, G, c;
    __host__ __device__ void init(int M, int N, int G_, int c_) { nM = M / BM; nN = N / BM; nwg = nM * nN; G = G_; c = c_; }
    __host__ __device__ bool next(int i, Unit& u) const {
        const long L = (long)i * G + c; if (L >= nwg) return false;
        int wgid = (int)L; { const int q = nwg / NXCD, r = nwg % NXCD, xcd = wgid % NXCD, off = wgid / NXCD; wgid = (xcd < r ? xcd * (q + 1) : r * (q + 1) + (xcd - r) * q) + off; }
        const int nig = WGM * nN, gid = wgid / nig, fm = gid * WGM, gsz = (nM - fm) < WGM ? (nM - fm) : WGM;
        u.pm = fm + ((wgid % nig) % gsz); u.pn = (wgid % nig) / gsz; return true;
    }
    __device__ __forceinline__ void a_ready(const Unit&) const {}
    __device__ __forceinline__ void done(const Unit&) const {}
};
__device__ __forceinline__ unsigned cvt_pk_bf16(float lo, float hi) { unsigned r; asm volatile("v_cvt_pk_bf16_f32 %0, %1, %2" : "=v"(r) : "v"(lo), "v"(hi)); return r; }
typedef float f32x2 __attribute__((ext_vector_type(2)));

typedef int i32x4 __attribute__((ext_vector_type(4)));
typedef int i32x8 __attribute__((ext_vector_type(8)));
__device__ __forceinline__ i32x8 cat8(bf16x8 a, bf16x8 b) { return __builtin_shufflevector(__builtin_bit_cast(i32x4, a), __builtin_bit_cast(i32x4, b), 0, 1, 2, 3, 4, 5, 6, 7); }
__device__ __forceinline__ void mfma8(f32x4& c, i32x8 a, i32x8 b) { asm volatile("v_mfma_f32_16x16x128_f8f6f4 %0, %1, %2, %0" : "+v"(c) : "v"(a), "v"(b)); }
__device__ __forceinline__ unsigned pk4_fp8(const f32x4 v) { const float lim = 440.f;
    int w = __builtin_amdgcn_cvt_pk_fp8_f32(__builtin_amdgcn_fmed3f(v[0], -lim, lim), __builtin_amdgcn_fmed3f(v[1], -lim, lim), 0, false);
    return (unsigned)__builtin_amdgcn_cvt_pk_fp8_f32(__builtin_amdgcn_fmed3f(v[2], -lim, lim), __builtin_amdgcn_fmed3f(v[3], -lim, lim), w, true); }
struct EpiProj {
    static constexpr bool PERM = true, AFTER_DRAIN = false, MIDK = false;
    bf16_t* O; int ldc; int ncols; float osc;
    __device__ __forceinline__ void operator()(const f32x4 (&acc)[2][2][4][2], const Unit& u, int wr, int wc, int fr, int fq) const {
        const int row0 = u.pm * BM + wr * 64 + fr, col0 = u.pn * BM + wc * 32 + 8 * fq;
#pragma unroll
        for (int ai = 0; ai < 2; ++ai)
#pragma unroll
            for (int m = 0; m < 4; ++m) { bf16_t* rowp = O + (size_t)(row0 + ai * HALF + m * 16) * ldc + col0;
#pragma unroll
                for (int bj = 0; bj < 2; ++bj) { const f32x4 v0 = acc[ai][bj][m][0] * osc, v1 = acc[ai][bj][m][1] * osc;
                    u32x4 w; w.x = cvt_pk_bf16(v0[0], v0[1]); w.y = cvt_pk_bf16(v0[2], v0[3]); w.z = cvt_pk_bf16(v1[0], v1[1]); w.w = cvt_pk_bf16(v1[2], v1[3]);
                    if (col0 + bj * HALF + 8 <= ncols) *(u32x4*)(rowp + bj * HALF) = w; } }
    }
};
template <bool SRC_BF16> struct EpiResGate {
    static constexpr bool PERM = true, AFTER_DRAIN = false, MIDK = true;
    const float* ssq;
    const float* Sc; const float* Sl;
    bf16_t* XB;
    const float* gate_rows; float* xss; int rowoff;
    template <class Sched> __device__ __forceinline__ void prep(PG8_LAS unsigned char* lds, const Sched& S, int tid) const {
        PG8_LAS float* RS = (PG8_LAS float*)(lds + STAGE_BYTES);
        const int r = tid & 255, i0 = tid >> 8;
        for (int i = i0; ; i += 2) { Unit u; if (!S.next(i, u)) break;
            const f32x4* q = (const f32x4*)(ssq + (size_t)(rowoff + u.pm * BM + r) * 8); const f32x4 a = q[0], b = q[1];
            RS[i * 256 + r] = __builtin_amdgcn_rsqf((((a[0] + a[1]) + (a[2] + a[3])) + ((b[0] + b[1]) + (b[2] + b[3]))) * (1.0f / 512.0f) + 1e-6f); }
    }
    __device__ __forceinline__ void midk(f32x4 (&acc)[2][2][4][2], PG8_LAS unsigned char* lds, int ui, int wr, int fr) const {
        int fr_ = fr; asm volatile("" : "+v"(fr_));
        PG8_LAS const float* RS = (PG8_LAS const float*)(lds + STAGE_BYTES) + ui * 256 + wr * 64 + fr_;
#pragma unroll
        for (int ai = 0; ai < 2; ++ai)
#pragma unroll
            for (int m = 0; m < 4; ++m) { const float rs = RS[ai * HALF + m * 16];
#pragma unroll
                for (int bj = 0; bj < 2; ++bj)
#pragma unroll
                    for (int n = 0; n < 2; ++n) acc[ai][bj][m][n] *= rs; }
    }
    __device__ __forceinline__ void operator()(const f32x4 (&acc)[2][2][4][2], const Unit& u, int wr, int wc, int fr, int fq) const {
        const int row0 = rowoff + u.pm * BM + wr * 64 + fr, col0 = u.pn * BM + wc * 32 + 8 * fq;
        const int t0 = rowoff + u.pm * BM; const int mrow = t0 < 2048 ? 8 : ((t0 - 2048) >> 12);
        const float* gr = gate_rows + (size_t)mrow * 6144 + col0;
        f32x4 gv[2][2];
#pragma unroll
        for (int bj = 0; bj < 2; ++bj)
#pragma unroll
            for (int n = 0; n < 2; ++n) gv[bj][n] = *(const f32x4*)(gr + bj * HALF + n * 4);
#pragma unroll
        for (int ai = 0; ai < 2; ++ai) {
            u32x4 rb[4][2]; f32x4 xf[SRC_BF16 ? 1 : 4][2][2];
#pragma unroll
            for (int m = 0; m < 4; ++m) { const int rr = row0 + ai * HALF + m * 16;
                const float* sp = (rr < 2048 ? Sc + (size_t)rr * 1024 : Sl + (size_t)(rr - 2048) * 1024) + col0; const bf16_t* dp = XB + (size_t)rr * 1024 + col0;
#pragma unroll
                for (int bj = 0; bj < 2; ++bj) {
                    if (SRC_BF16) rb[m][bj] = *(const u32x4*)(dp + bj * HALF);
                    else { xf[SRC_BF16 ? 0 : m][bj][0] = *(const f32x4*)(sp + bj * HALF); xf[SRC_BF16 ? 0 : m][bj][1] = *(const f32x4*)(sp + bj * HALF + 4); } } }
#pragma unroll
            for (int m = 0; m < 4; ++m) { const int rr = row0 + ai * HALF + m * 16;
                bf16_t* dp = XB + (size_t)rr * 1024 + col0; float ss = 0.f;
#pragma unroll
                for (int bj = 0; bj < 2; ++bj) { f32x4 x0, x1;
                    if (SRC_BF16) { const u32x4 r = rb[m][bj];
                        x0 = (f32x4){__uint_as_float(r.x << 16), __uint_as_float(r.x & 0xffff0000u), __uint_as_float(r.y << 16), __uint_as_float(r.y & 0xffff0000u)};
                        x1 = (f32x4){__uint_as_float(r.z << 16), __uint_as_float(r.z & 0xffff0000u), __uint_as_float(r.w << 16), __uint_as_float(r.w & 0xffff0000u)}; }
                    else { x0 = xf[SRC_BF16 ? 0 : m][bj][0]; x1 = xf[SRC_BF16 ? 0 : m][bj][1]; }
                    const f32x4 v0 = x0 + gv[bj][0] * acc[ai][bj][m][0], v1 = x1 + gv[bj][1] * acc[ai][bj][m][1];
                    u32x4 w; w.x = cvt_pk_bf16(v0[0], v0[1]); w.y = cvt_pk_bf16(v0[2], v0[3]); w.z = cvt_pk_bf16(v1[0], v1[1]); w.w = cvt_pk_bf16(v1[2], v1[3]);
                    *(u32x4*)(dp + bj * HALF) = w;
#pragma unroll
                    for (int j = 0; j < 4; ++j) { const float lo = __uint_as_float(w[j] << 16), hi = __uint_as_float(w[j] & 0xffff0000u); ss += lo * lo + hi * hi; } }
                { const int ln_ = fq * 16 + fr; ss += __int_as_float(__builtin_amdgcn_ds_bpermute((ln_ ^ 16) << 2, __float_as_int(ss))); ss += __int_as_float(__builtin_amdgcn_ds_bpermute((ln_ ^ 32) << 2, __float_as_int(ss))); }
                if (fq == 0) xss[(size_t)rr * 16 + u.pn * 4 + wc] = ss; }
        }
    }
};
template <class Epi, class Sched, bool STAMP = false, bool SP2 = PG8_SP2, int SCW = -1>
__device__ __forceinline__ void gemm_phase(PG8_LAS unsigned char* lds, const Gemm g, const Sched& S, const Epi& E, unsigned long long* stamps) {
    int tid_l = __builtin_amdgcn_readfirstlane(threadIdx.x >> 6) * 64 + (int)__builtin_amdgcn_mbcnt_hi(~0u, __builtin_amdgcn_mbcnt_lo(~0u, 0u)); asm volatile("" : "+v"(tid_l));
    const int tid = tid_l, wid = __builtin_amdgcn_readfirstlane(tid >> 6), lane = tid & 63, wr = wid >> 2, wc = wid & 3, fr = lane & 15, fq = lane >> 4;
    const int K = g.K, nt = K / BK;
    int ts_lo = 0, ts_hi = 0, nts = 0; const unsigned long long rt_entry = STAMP ? (unsigned long long)wall_clock64() : 0ull;
#define PG8_STAMP() do { if (STAMP && wid == 0 && nts < 64) { const unsigned long long _c = (unsigned long long)clock64(); \
        ts_lo = (lane == nts) ? (int)(unsigned)_c : ts_lo; ts_hi = (lane == nts) ? (int)(unsigned)(_c >> 32) : ts_hi; ++nts; } } while (0)
    PG8_STAMP();
    unsigned voffA[2], voffB[2];
#pragma unroll
    for (int i = 0; i < 2; ++i) { int R, C; stage_rc(tid * 16 + i * 8192, R, C); const int Rb = Epi::PERM ? ((R & ~31) + perm32(R & 31)) : R;
        voffA[i] = (unsigned)(R * K + C) * 2u; voffB[i] = (unsigned)(Rb * K + C) * 2u; }
    const size_t kstep = (size_t)(BK * 2);
    const size_t hstep = (size_t)HALF * K * 2;
    const size_t tstep = 2 * hstep;
    const unsigned ldsw = (unsigned)wid * 1024u;
    const int aoff = lds_byte(wr * 64 + fr, fq * 8), boff = lds_byte(wc * 32 + fr, fq * 8);
#define PG8_SA(b, h) (((b) * 2 + (h)) * HTB)
#define PG8_SB(b, h) ((4 + (b) * 2 + (h)) * HTB)
#define PG8_STAGE(bufoff, gbase, voff) do { _Pragma("unroll") for (int _i = 0; _i < 2; ++_i) \
        __builtin_amdgcn_global_load_lds((const unsigned*)((const char*)(gbase) + (voff)[_i]), (PG8_LAS unsigned*)(lds + (bufoff) + ldsw + _i * 8192), 16, 0, 0); } while (0)
#define PG8_LDA(dst, b, h) do { _Pragma("unroll") for (int m = 0; m < 4; ++m) _Pragma("unroll") for (int k = 0; k < 2; ++k) dst[m][k] = *(const PG8_LAS bf16x8*)(lds + PG8_SA(b, h) + aoff + m * 2048 + k * 1024); } while (0)
#define PG8_LDB(dst, b, h) do { _Pragma("unroll") for (int n = 0; n < 2; ++n) _Pragma("unroll") for (int k = 0; k < 2; ++k) dst[n][k] = *(const PG8_LAS bf16x8*)(lds + PG8_SB(b, h) + boff + n * 2048 + k * 1024); } while (0)
#define PG8_MMA(ai, bj, At, Bt) do { __builtin_amdgcn_s_setprio(1); _Pragma("unroll") for (int m = 0; m < 4; ++m) _Pragma("unroll") for (int n = 0; n < 2; ++n) { \
        if constexpr (SCW >= 0) mfma8(acc[ai][bj][m][n], cat8(Bt[n][0], Bt[n][1]), cat8(At[m][0], At[m][1])); \
        else { _Pragma("unroll") for (int k = 0; k < 2; ++k) acc[ai][bj][m][n] = __builtin_amdgcn_mfma_f32_16x16x32_bf16(Bt[n][k], At[m][k], acc[ai][bj][m][n], 0, 0, 0); } } __builtin_amdgcn_s_setprio(0); } while (0)
#define PG8_WAIT_V(n) asm volatile("s_waitcnt vmcnt(" #n ")" ::: "memory")
#define PG8_WAIT_L(n) asm volatile("s_waitcnt lgkmcnt(" #n ")" ::: "memory")
#define PG8_BAR __builtin_amdgcn_s_barrier()
#define PG8_SCHED __builtin_amdgcn_sched_barrier(0)
    Unit cur, nxt; int ui = 0;
    if (!S.next(0, cur)) return;
    f32x4 acc[2][2][4][2];
#pragma unroll
    for (int a = 0; a < 2; ++a)
#pragma unroll
        for (int b = 0; b < 2; ++b)
#pragma unroll
            for (int m = 0; m < 4; ++m)
#pragma unroll
                for (int n = 0; n < 2; ++n) acc[a][b][m][n] = (f32x4){0.f, 0.f, 0.f, 0.f};
    bf16x8 At[4][2], B0[2][2], B1[2][2];
    const char* cA = (const char*)g.A + (size_t)cur.pm * tstep; const char* cB = (const char*)g.Bt + (size_t)cur.pn * tstep;
    S.a_ready(cur);
    if constexpr (Epi::MIDK) E.prep(lds, S, tid);
    if constexpr (SP2) {
        PG8_STAGE(PG8_SB(0, 0), cB, voffB); PG8_STAGE(PG8_SB(0, 1), cB + hstep, voffB); PG8_STAGE(PG8_SA(0, 0), cA, voffA); PG8_STAGE(PG8_SA(0, 1), cA + hstep, voffA);
        if (wr == 1) PG8_BAR;
        PG8_WAIT_V(2); PG8_BAR;
        PG8_STAGE(PG8_SB(1, 0), cB + kstep, voffB); PG8_STAGE(PG8_SA(1, 0), cA + kstep, voffA); PG8_STAGE(PG8_SB(1, 1), cB + hstep + kstep, voffB);
        PG8_WAIT_V(6); PG8_BAR;
    } else {
    PG8_STAGE(PG8_SB(0, 0), cB, voffB); PG8_STAGE(PG8_SA(0, 0), cA, voffA); PG8_STAGE(PG8_SB(0, 1), cB + hstep, voffB); PG8_STAGE(PG8_SA(0, 1), cA + hstep, voffA);
    if (wr == 1) PG8_BAR;
    PG8_WAIT_V(4); PG8_BAR;
    PG8_STAGE(PG8_SB(1, 0), cB + kstep, voffB); PG8_STAGE(PG8_SA(1, 0), cA + kstep, voffA); PG8_STAGE(PG8_SB(1, 1), cB + hstep + kstep, voffB);
    PG8_WAIT_V(6); PG8_BAR;
    }
    PG8_STAMP();
    for (;;) {
        const bool has_next = S.next(ui + 1, nxt);
        const char* nA = has_next ? (const char*)g.A + (size_t)nxt.pm * tstep : cA; const char* nB = has_next ? (const char*)g.Bt + (size_t)nxt.pn * tstep : cB;
        for (int t = 0; t < nt; t += 2) {
            const bool last = (t == nt - 2);
            const char* a1 = cA + (size_t)(t + 1) * kstep;
            const char* a2 = last ? nA : cA + (size_t)(t + 2) * kstep; const char* b2 = last ? nB : cB + (size_t)(t + 2) * kstep;
            const char* a3 = a2 + kstep; const char* b3 = b2 + kstep;
            if (last && has_next) S.a_ready(nxt);
            if constexpr (SP2) {
            PG8_LDB(B0, 0, 0); PG8_LDB(B1, 0, 1); PG8_SCHED; PG8_LDA(At, 0, 0); PG8_STAGE(PG8_SA(1, 1), a1 + hstep, voffA);
            PG8_WAIT_V(8); PG8_WAIT_L(0); PG8_BAR; PG8_MMA(0, 0, At, B0); PG8_MMA(0, 1, At, B1); PG8_BAR; PG8_SCHED;
            PG8_LDA(At, 0, 1); PG8_STAGE(PG8_SB(0, 0), b2, voffB); PG8_STAGE(PG8_SB(0, 1), b2 + hstep, voffB); PG8_STAGE(PG8_SA(0, 0), a2, voffA);
            PG8_WAIT_V(8); PG8_WAIT_L(0); PG8_BAR; PG8_MMA(1, 0, At, B0); PG8_MMA(1, 1, At, B1); PG8_BAR; PG8_SCHED;
            PG8_LDB(B0, 1, 0); PG8_LDB(B1, 1, 1); PG8_SCHED; PG8_LDA(At, 1, 0); PG8_STAGE(PG8_SA(0, 1), a2 + hstep, voffA);
            PG8_WAIT_V(8); PG8_WAIT_L(0); PG8_BAR; PG8_MMA(0, 0, At, B0); PG8_MMA(0, 1, At, B1); PG8_BAR; PG8_SCHED;
            PG8_LDA(At, 1, 1); PG8_STAGE(PG8_SB(1, 0), b3, voffB); PG8_STAGE(PG8_SB(1, 1), b3 + hstep, voffB); PG8_STAGE(PG8_SA(1, 0), a3, voffA);
            PG8_WAIT_V(8); PG8_WAIT_L(0); PG8_BAR; PG8_MMA(1, 0, At, B0); PG8_MMA(1, 1, At, B1); PG8_BAR; PG8_SCHED;
            } else {
            PG8_LDB(B0, 0, 0); PG8_SCHED; PG8_LDA(At, 0, 0); PG8_STAGE(PG8_SA(1, 1), a1 + hstep, voffA);
            PG8_WAIT_L(8); PG8_BAR; PG8_WAIT_L(0); PG8_MMA(0, 0, At, B0); PG8_BAR; PG8_SCHED;
            PG8_LDB(B1, 0, 1); PG8_STAGE(PG8_SB(0, 0), b2, voffB);
            PG8_BAR; PG8_WAIT_L(0); PG8_MMA(0, 1, At, B1); PG8_BAR;
            PG8_LDA(At, 0, 1); PG8_STAGE(PG8_SA(0, 0), a2, voffA);
            PG8_BAR; PG8_WAIT_L(0); PG8_MMA(1, 0, At, B0); PG8_BAR; PG8_SCHED;
            PG8_STAGE(PG8_SB(0, 1), b2 + hstep, voffB);
            PG8_WAIT_V(6); PG8_BAR; PG8_MMA(1, 1, At, B1); PG8_BAR;
            PG8_LDB(B0, 1, 0); PG8_SCHED; PG8_LDA(At, 1, 0); PG8_STAGE(PG8_SA(0, 1), a2 + hstep, voffA);
            PG8_WAIT_L(8); PG8_BAR; PG8_WAIT_L(0); PG8_MMA(0, 0, At, B0); PG8_BAR; PG8_SCHED;
            PG8_LDB(B1, 1, 1); PG8_STAGE(PG8_SB(1, 0), b3, voffB);
            PG8_BAR; PG8_WAIT_L(0); PG8_MMA(0, 1, At, B1); PG8_BAR;
            PG8_LDA(At, 1, 1); PG8_STAGE(PG8_SA(1, 0), a3, voffA);
            PG8_BAR; PG8_WAIT_L(0); PG8_MMA(1, 0, At, B0); PG8_BAR; PG8_SCHED;
            PG8_STAGE(PG8_SB(1, 1), b3 + hstep, voffB);
            PG8_WAIT_V(6); PG8_BAR; PG8_MMA(1, 1, At, B1); PG8_BAR;
            }
            if constexpr (Epi::MIDK) { if (t + 2 == nt / 2) E.midk(acc, lds, ui, wr, fr); }
        }
        PG8_STAMP();
        if (wr == 0) PG8_BAR;
        if constexpr (SCW >= 0) asm volatile("s_nop 15\n\ts_nop 15" ::: "memory");
        if constexpr (!Epi::AFTER_DRAIN) { E(acc, cur, wr, wc, fr, fq); S.done(cur); }
        PG8_STAMP();
        if (!has_next) break;
#pragma unroll
        for (int a = 0; a < 2; ++a)
#pragma unroll
            for (int b = 0; b < 2; ++b)
#pragma unroll
                for (int m = 0; m < 4; ++m)
#pragma unroll
                    for (int n = 0; n < 2; ++n) acc[a][b][m][n] = (f32x4){0.f, 0.f, 0.f, 0.f};
        cur = nxt; cA = nA; cB = nB; ++ui;
        if (wr == 1) PG8_BAR;
    }
    PG8_WAIT_V(0);
    PG8_BAR;
    if constexpr (Epi::AFTER_DRAIN) { E.fused(acc, cur, wr, wc, fr, fq, lds, wid, lane); S.done(cur); }
    PG8_STAMP();
    if (STAMP && wid == 0) { stamps[lane] = lane < nts ? (((unsigned long long)(unsigned)ts_hi << 32) | (unsigned)ts_lo) : 0ull;
        if (lane == 62) stamps[62] = rt_entry; if (lane == 63) stamps[63] = (unsigned long long)wall_clock64(); }
#undef PG8_STAMP
#undef PG8_SA
#undef PG8_SB
#undef PG8_STAGE
#undef PG8_LDA
#undef PG8_LDB
#undef PG8_MMA
#undef PG8_WAIT_V
#undef PG8_WAIT_L
#undef PG8_BAR
#undef PG8_SCHED
}

struct MoeUnit { int e, mt, pn, cnt, pstart; };
struct MoeSched {
    typedef MoeUnit UnitT;
    PG8_LAS const int* tab; const int* map; int U, G, c, npn, gather; size_t bstride;
    __device__ __forceinline__ bool next(int i, MoeUnit& u) const {
        const long L = (long)i * G + c; if (L >= U) return false;
        int idx = (int)L; { const int q = U / NXCD, r = U % NXCD, xcd = idx % NXCD, off = idx / NXCD; idx = (xcd < r ? xcd * (q + 1) : r * (q + 1) + (xcd - r) * q) + off; }
        const int tau = idx / npn; u.pn = idx - tau * npn;
        int e = 0;
#pragma unroll
        for (int st = 16; st >= 1; st >>= 1) { if (__builtin_amdgcn_readfirstlane(tab[e + st]) <= tau) e += st; }
        u.e = e; u.mt = tau - __builtin_amdgcn_readfirstlane(tab[e]); u.cnt = __builtin_amdgcn_readfirstlane(tab[33 + e]); u.pstart = __builtin_amdgcn_readfirstlane(tab[65 + e]);
        return true;
    }
    __device__ __forceinline__ const char* bbase(const Gemm& g, const MoeUnit& u) const { return (const char*)g.Bt + (size_t)u.e * bstride + (size_t)u.pn * BM * g.K * 2; }
    __device__ __forceinline__ void a_offsets(const Gemm& g, const MoeUnit& u, int tid, unsigned (&va)[2][2]) const {
        int tl = tid; asm volatile("" : "+v"(tl));
        int RA[2], CA[2];
#pragma unroll
        for (int i = 0; i < 2; ++i) { int R, C; stage_rc(tl * 16 + i * 8192, R, C); RA[i] = R; CA[i] = C * 2; }
#pragma unroll
        for (int hf = 0; hf < 2; ++hf)
#pragma unroll
            for (int i = 0; i < 2; ++i) { int rl = u.mt * BM + hf * HALF + RA[i]; rl = rl < u.cnt ? rl : u.cnt - 1;
                const unsigned row = gather ? (unsigned)map[(size_t)u.e * 34816 + rl] : (unsigned)(u.pstart + rl);
                va[hf][i] = row * (unsigned)(g.K * 2) + (unsigned)CA[i]; }
    }
};
struct EpiAct {
    static constexpr bool PERM = true, AFTER_DRAIN = false;
    unsigned char* O;
    __device__ __forceinline__ void operator()(const f32x4 (&acc)[2][2][4][2], const MoeUnit& u, int wr, int wc, int fr, int fq) const {
        typedef unsigned u32x2 __attribute__((ext_vector_type(2)));
        const int rl0 = u.mt * BM + wr * 64 + fr, col0 = u.pn * HALF + wc * 32 + 8 * fq;
#pragma unroll
        for (int ai = 0; ai < 2; ++ai)
#pragma unroll
            for (int m = 0; m < 4; ++m) { const int rl = rl0 + ai * HALF + m * 16;
                if (rl < u.cnt) { f32x4 o[2];
#pragma unroll
                    for (int n = 0; n < 2; ++n)
#pragma unroll
                        for (int j = 0; j < 4; ++j) { const float gv = acc[ai][0][m][n][j] * (1.0f / 64.0f)  ; o[n][j] = gv * __builtin_amdgcn_rcpf(1.0f + __builtin_amdgcn_exp2f(-1.4426950408889634f * gv)) * (acc[ai][1][m][n][j] * 0.125f)  ; }
                    *(u32x2*)(O + (size_t)(u.pstart + rl) * 512 + col0) = (u32x2){pk4_fp8(o[0]), pk4_fp8(o[1])}; } }
    }
};
struct EpiY {
    static constexpr bool PERM = true, AFTER_DRAIN = false;
    unsigned char* O;
    static __device__ __forceinline__ unsigned pk4(const f32x4 v) { const float lim = 440.f;
        int w = __builtin_amdgcn_cvt_pk_fp8_f32(fminf(fmaxf(v[0], -lim), lim), fminf(fmaxf(v[1], -lim), lim), 0, false);
        return (unsigned)__builtin_amdgcn_cvt_pk_fp8_f32(fminf(fmaxf(v[2], -lim), lim), fminf(fmaxf(v[3], -lim), lim), w, true); }
    __device__ __forceinline__ void operator()(const f32x4 (&acc)[2][2][4][2], const MoeUnit& u, int wr, int wc, int fr, int fq) const {
        typedef unsigned u32x2 __attribute__((ext_vector_type(2)));
        const int rl0 = u.mt * BM + wr * 64 + fr, col0 = u.pn * BM + wc * 32 + 8 * fq;
#pragma unroll
        for (int ai = 0; ai < 2; ++ai)
#pragma unroll
            for (int m = 0; m < 4; ++m) { const int rl = rl0 + ai * HALF + m * 16;
                if (rl < u.cnt) { unsigned char* rowp = O + (size_t)(u.pstart + rl) * 1024 + col0;
#pragma unroll
                    for (int bj = 0; bj < 2; ++bj) *(u32x2*)(rowp + bj * HALF) = (u32x2){pk4(acc[ai][bj][m][0] * (1.0f / 512.0f)), pk4(acc[ai][bj][m][1] * (1.0f / 512.0f))}; } }
    }
};
template <class Epi, class Sched, bool STAMP = false, bool SP2 = PG8_SP2, int SCW = -1, int SCA = 127>
__device__ __forceinline__ void gemm_phase_moe(PG8_LAS unsigned char* lds, const Gemm g, const Sched& S, const Epi& E, unsigned long long* stamps) {
    int tid_l = __builtin_amdgcn_readfirstlane(threadIdx.x >> 6) * 64 + (int)__builtin_amdgcn_mbcnt_hi(~0u, __builtin_amdgcn_mbcnt_lo(~0u, 0u)); asm volatile("" : "+v"(tid_l));
    const int tid = tid_l, wid = __builtin_amdgcn_readfirstlane(tid >> 6), lane = tid & 63, wr = wid >> 2, wc = wid & 3, fr = lane & 15, fq = lane >> 4;
    const int K = g.K, nt = K / BK;
    int ts_lo = 0, ts_hi = 0, nts = 0; const unsigned long long rt_entry = STAMP ? (unsigned long long)wall_clock64() : 0ull;
#define PG8_STAMP() do { if (STAMP && wid == 0 && nts < 64) { const unsigned long long _c = (unsigned long long)clock64(); \
        ts_lo = (lane == nts) ? (int)(unsigned)_c : ts_lo; ts_hi = (lane == nts) ? (int)(unsigned)(_c >> 32) : ts_hi; ++nts; } } while (0)
    PG8_STAMP();
    unsigned voffB[2];
#pragma unroll
    for (int i = 0; i < 2; ++i) { int R, C; stage_rc(tid * 16 + i * 8192, R, C); const int Rb = Epi::PERM ? ((R & ~31) + perm32(R & 31)) : R;
        voffB[i] = (unsigned)(Rb * K + C) * 2u; }
    unsigned vaC[2][2];
    PG8_LAS unsigned* vtab = (PG8_LAS unsigned*)(lds + STAGE_BYTES + 1024) + tid;
    const size_t kstep = (size_t)(BK * 2);
    const size_t hstep = (size_t)HALF * K * 2;
    const size_t tstep = 2 * hstep;
    const unsigned ldsw = (unsigned)wid * 1024u;
    const int aoff = lds_byte(wr * 64 + fr, fq * 8), boff = lds_byte(wc * 32 + fr, fq * 8);
#define PG8_SA(b, h) (((b) * 2 + (h)) * HTB)
#define PG8_SB(b, h) ((4 + (b) * 2 + (h)) * HTB)
#define PG8_STAGE(bufoff, gbase, voff) do { _Pragma("unroll") for (int _i = 0; _i < 2; ++_i) \
        __builtin_amdgcn_global_load_lds((const unsigned*)((const char*)(gbase) + (voff)[_i]), (PG8_LAS unsigned*)(lds + (bufoff) + ldsw + _i * 8192), 16, 0, 0); } while (0)
#define PG8_STAGEA(bufoff, kbyte, va) do { _Pragma("unroll") for (int _i = 0; _i < 2; ++_i) \
        __builtin_amdgcn_global_load_lds((const unsigned*)((const char*)g.A + (kbyte) + (va)[_i]), (PG8_LAS unsigned*)(lds + (bufoff) + ldsw + _i * 8192), 16, 0, 0); } while (0)
#define PG8_LDA(dst, b, h) do { _Pragma("unroll") for (int m = 0; m < 4; ++m) _Pragma("unroll") for (int k = 0; k < 2; ++k) dst[m][k] = *(const PG8_LAS bf16x8*)(lds + PG8_SA(b, h) + aoff + m * 2048 + k * 1024); } while (0)
#define PG8_LDB(dst, b, h) do { _Pragma("unroll") for (int n = 0; n < 2; ++n) _Pragma("unroll") for (int k = 0; k < 2; ++k) dst[n][k] = *(const PG8_LAS bf16x8*)(lds + PG8_SB(b, h) + boff + n * 2048 + k * 1024); } while (0)
#define PG8_MMA(ai, bj, At, Bt) do { __builtin_amdgcn_s_setprio(1); _Pragma("unroll") for (int m = 0; m < 4; ++m) _Pragma("unroll") for (int n = 0; n < 2; ++n) { \
        if constexpr (SCW >= 0) mfma8(acc[ai][bj][m][n], cat8(Bt[n][0], Bt[n][1]), cat8(At[m][0], At[m][1])); \
        else { _Pragma("unroll") for (int k = 0; k < 2; ++k) acc[ai][bj][m][n] = __builtin_amdgcn_mfma_f32_16x16x32_bf16(Bt[n][k], At[m][k], acc[ai][bj][m][n], 0, 0, 0); } } __builtin_amdgcn_s_setprio(0); } while (0)
#define PG8_WAIT_V(n) asm volatile("s_waitcnt vmcnt(" #n ")" ::: "memory")
#define PG8_WAIT_L(n) asm volatile("s_waitcnt lgkmcnt(" #n ")" ::: "memory")
#define PG8_BAR __builtin_amdgcn_s_barrier()
#define PG8_SCHED __builtin_amdgcn_sched_barrier(0)
    typename Sched::UnitT cur, nxt; int ui = 0;
    if (!S.next(0, cur)) return;
    f32x4 acc[2][2][4][2];
#pragma unroll
    for (int a = 0; a < 2; ++a)
#pragma unroll
        for (int b = 0; b < 2; ++b)
#pragma unroll
            for (int m = 0; m < 4; ++m)
#pragma unroll
                for (int n = 0; n < 2; ++n) acc[a][b][m][n] = (f32x4){0.f, 0.f, 0.f, 0.f};
    bf16x8 At[4][2], B0[2][2], B1[2][2];
    const char* cB = S.bbase(g, cur); S.a_offsets(g, cur, tid, vaC);
    if constexpr (SP2) {
        PG8_STAGE(PG8_SB(0, 0), cB, voffB); PG8_STAGE(PG8_SB(0, 1), cB + hstep, voffB); PG8_STAGEA(PG8_SA(0, 0), 0, vaC[0]); PG8_STAGEA(PG8_SA(0, 1), 0, vaC[1]);
        if (wr == 1) PG8_BAR;
        PG8_WAIT_V(2); PG8_BAR;
        PG8_STAGE(PG8_SB(1, 0), cB + kstep, voffB); PG8_STAGEA(PG8_SA(1, 0), kstep, vaC[0]); PG8_STAGE(PG8_SB(1, 1), cB + hstep + kstep, voffB);
        PG8_WAIT_V(6); PG8_BAR;
    } else {
    PG8_STAGE(PG8_SB(0, 0), cB, voffB); PG8_STAGEA(PG8_SA(0, 0), 0, vaC[0]); PG8_STAGE(PG8_SB(0, 1), cB + hstep, voffB); PG8_STAGEA(PG8_SA(0, 1), 0, vaC[1]);
    if (wr == 1) PG8_BAR;
    PG8_WAIT_V(4); PG8_BAR;
    PG8_STAGE(PG8_SB(1, 0), cB + kstep, voffB); PG8_STAGEA(PG8_SA(1, 0), kstep, vaC[0]); PG8_STAGE(PG8_SB(1, 1), cB + hstep + kstep, voffB);
    PG8_WAIT_V(6); PG8_BAR;
    }
    PG8_STAMP();
    for (;;) {
        const bool has_next = S.next(ui + 1, nxt);
        const char* nB = has_next ? S.bbase(g, nxt) : cB;
        { unsigned vaN[2][2];
          if (has_next) S.a_offsets(g, nxt, tid, vaN); else {
#pragma unroll
            for (int hf = 0; hf < 2; ++hf)
#pragma unroll
                for (int i = 0; i < 2; ++i) vaN[hf][i] = vaC[hf][i]; }
#pragma unroll
          for (int hf = 0; hf < 2; ++hf)
#pragma unroll
              for (int i = 0; i < 2; ++i) vtab[(hf * 2 + i) * 512] = vaN[hf][i]; }
        unsigned v2[2][2];
        for (int t = 0; t < nt; t += 2) {
            const bool last = (t == nt - 2);
            const size_t k1 = (size_t)(t + 1) * kstep, k2 = last ? (size_t)0 : (size_t)(t + 2) * kstep, k3 = k2 + kstep;
            const char* b2 = last ? nB : cB + (size_t)(t + 2) * kstep; const char* b3 = b2 + kstep;
#pragma unroll
            for (int hf = 0; hf < 2; ++hf)
#pragma unroll
                for (int i = 0; i < 2; ++i) v2[hf][i] = last ? vtab[(hf * 2 + i) * 512] : vaC[hf][i];
            if constexpr (SP2) {
            PG8_LDB(B0, 0, 0); PG8_LDB(B1, 0, 1); PG8_SCHED; PG8_LDA(At, 0, 0); PG8_STAGEA(PG8_SA(1, 1), k1, vaC[1]);
            PG8_WAIT_V(8); PG8_WAIT_L(0); PG8_BAR; PG8_MMA(0, 0, At, B0); PG8_MMA(0, 1, At, B1); PG8_BAR; PG8_SCHED;
            PG8_LDA(At, 0, 1); PG8_STAGE(PG8_SB(0, 0), b2, voffB); PG8_STAGE(PG8_SB(0, 1), b2 + hstep, voffB); PG8_STAGEA(PG8_SA(0, 0), k2, v2[0]);
            PG8_WAIT_V(8); PG8_WAIT_L(0); PG8_BAR; PG8_MMA(1, 0, At, B0); PG8_MMA(1, 1, At, B1); PG8_BAR; PG8_SCHED;
            PG8_LDB(B0, 1, 0); PG8_LDB(B1, 1, 1); PG8_SCHED; PG8_LDA(At, 1, 0); PG8_STAGEA(PG8_SA(0, 1), k2, v2[1]);
            PG8_WAIT_V(8); PG8_WAIT_L(0); PG8_BAR; PG8_MMA(0, 0, At, B0); PG8_MMA(0, 1, At, B1); PG8_BAR; PG8_SCHED;
            PG8_LDA(At, 1, 1); PG8_STAGE(PG8_SB(1, 0), b3, voffB); PG8_STAGE(PG8_SB(1, 1), b3 + hstep, voffB); PG8_STAGEA(PG8_SA(1, 0), k3, v2[0]);
            PG8_WAIT_V(8); PG8_WAIT_L(0); PG8_BAR; PG8_MMA(1, 0, At, B0); PG8_MMA(1, 1, At, B1); PG8_BAR; PG8_SCHED;
            } else {
            PG8_LDB(B0, 0, 0); PG8_SCHED; PG8_LDA(At, 0, 0); PG8_STAGEA(PG8_SA(1, 1), k1, vaC[1]);
            PG8_WAIT_L(8); PG8_BAR; PG8_WAIT_L(0); PG8_MMA(0, 0, At, B0); PG8_BAR; PG8_SCHED;
            PG8_LDB(B1, 0, 1); PG8_STAGE(PG8_SB(0, 0), b2, voffB);
            PG8_BAR; PG8_WAIT_L(0); PG8_MMA(0, 1, At, B1); PG8_BAR;
            PG8_LDA(At, 0, 1); PG8_STAGEA(PG8_SA(0, 0), k2, v2[0]);
            PG8_BAR; PG8_WAIT_L(0); PG8_MMA(1, 0, At, B0); PG8_BAR; PG8_SCHED;
            PG8_STAGE(PG8_SB(0, 1), b2 + hstep, voffB);
            PG8_WAIT_V(6); PG8_BAR; PG8_MMA(1, 1, At, B1); PG8_BAR;
            PG8_LDB(B0, 1, 0); PG8_SCHED; PG8_LDA(At, 1, 0); PG8_STAGEA(PG8_SA(0, 1), k2, v2[1]);
            PG8_WAIT_L(8); PG8_BAR; PG8_WAIT_L(0); PG8_MMA(0, 0, At, B0); PG8_BAR; PG8_SCHED;
            PG8_LDB(B1, 1, 1); PG8_STAGE(PG8_SB(1, 0), b3, voffB);
            PG8_BAR; PG8_WAIT_L(0); PG8_MMA(0, 1, At, B1); PG8_BAR;
            PG8_LDA(At, 1, 1); PG8_STAGEA(PG8_SA(1, 0), k3, v2[0]);
            PG8_BAR; PG8_WAIT_L(0); PG8_MMA(1, 0, At, B0); PG8_BAR; PG8_SCHED;
            PG8_STAGE(PG8_SB(1, 1), b3 + hstep, voffB);
            PG8_WAIT_V(6); PG8_BAR; PG8_MMA(1, 1, At, B1); PG8_BAR;
            }
        }
        PG8_STAMP();
        if (wr == 0) PG8_BAR;
        if constexpr (SCW >= 0) asm volatile("s_nop 15\n\ts_nop 15" ::: "memory");
        E(acc, cur, wr, wc, fr, fq);
        PG8_STAMP();
        if (!has_next) break;
#pragma unroll
        for (int a = 0; a < 2; ++a)
#pragma unroll
            for (int b = 0; b < 2; ++b)
#pragma unroll
                for (int m = 0; m < 4; ++m)
#pragma unroll
                    for (int n = 0; n < 2; ++n) acc[a][b][m][n] = (f32x4){0.f, 0.f, 0.f, 0.f};
        cur = nxt; cB = nB; ++ui;
#pragma unroll
        for (int hf = 0; hf < 2; ++hf)
#pragma unroll
            for (int i = 0; i < 2; ++i) vaC[hf][i] = v2[hf][i];
        if (wr == 1) PG8_BAR;
    }
    PG8_WAIT_V(0);
    PG8_BAR;
    PG8_STAMP();
    if (STAMP && wid == 0) { stamps[lane] = lane < nts ? (((unsigned long long)(unsigned)ts_hi << 32) | (unsigned)ts_lo) : 0ull;
        if (lane == 62) stamps[62] = rt_entry; if (lane == 63) stamps[63] = (unsigned long long)wall_clock64(); }
#undef PG8_STAMP
#undef PG8_SA
#undef PG8_SB
#undef PG8_STAGE
#undef PG8_STAGEA
#undef PG8_LDA
#undef PG8_LDB
#undef PG8_MMA
#undef PG8_WAIT_V
#undef PG8_WAIT_L
#undef PG8_BAR
#undef PG8_SCHED
}
}

constexpr int NTHR = 512, NWV = 8, LDS_BYTES = 147456;

struct P {
    const float *x, *c, *ctx, *c_ctx, *w_mod, *b_mod, *norm1_g, *norm2_g, *w_in, *conv_w, *conv_b, *dt_bias_f, *dt_bias_b, *a_log_f, *a_log_b, *d_skip, *ssd_norm_g,
        *gk_up_f, *gk_bias_f, *gk_up_b, *gk_bias_b, *gla_norm_g, *w_out, *w_router, *router_bias, *w_gate, *w_up, *w_down, *final_g;
    float* out; bf16_t* XB; bf16_t* H; bf16_t* PROJ; bf16_t* SS; bf16_t* GS; float* SDEC; float* GDEC; float* MOD; int* counts; int* TOKSLOT; float* EW; int* MAP; bf16_t* WinT; bf16_t* WoutT; bf16_t* WguT; bf16_t* WdT; bf16_t* WRT; unsigned* BAR; bf16_t* XBCC; bf16_t* QKB; float* SSC; float* STOT; float* SSQ; float* XSS;
};

DI void ph_init(const P& p) { const size_t i = (size_t)blockIdx.x * NTHR + ltid(); if (i < 64) p.counts[i * 32] = 0; }

DI void ph_mod(const P& p, float* s  ) {
    const int tid_ = ltid(), lane = tid_ & 63, w = tid_ >> 6;
    if (blockIdx.x >= 192) return;
    float* part = s + 9 * 1024;
    { float cv[18];
#pragma unroll
      for (int q = 0; q < 18; ++q) { const int i = tid_ + q * NTHR, r = i >> 10, k = i & 1023; cv[q] = r < 8 ? p.c[r * 1024 + k] : p.c_ctx[k]; }
#pragma unroll
      for (int q = 0; q < 18; ++q) s[tid_ + q * NTHR] = siluf(cv[q]); }
    __syncthreads();
    for (int vb = blockIdx.x; vb < 192; vb += gridDim.x) {
        const int l = vb / 96, n = (vb % 96) * 64 + lane;
        float acc[9];
#pragma unroll
        for (int r = 0; r < 9; ++r) acc[r] = 0.f;
        const float* wp = p.w_mod + (size_t)l * 1024 * 6144 + (size_t)(128 * w) * 6144 + n;
#pragma unroll 8
        for (int k = 0; k < 128; ++k) { const float wv = wp[(size_t)k * 6144];
#pragma unroll
            for (int r = 0; r < 9; ++r) acc[r] += s[r * 1024 + 128 * w + k] * wv; }
#pragma unroll
        for (int r = 0; r < 9; ++r) part[(w * 9 + r) * 64 + lane] = acc[r];
        __syncthreads();
        for (int o = tid_; o < 9 * 64; o += NTHR) { const int r = o >> 6, c = o & 63; float a = p.b_mod[l * 6144 + (vb % 96) * 64 + c];
#pragma unroll
            for (int q = 0; q < 8; ++q) a += part[(q * 9 + r) * 64 + c];
            p.MOD[((size_t)l * 9 + r) * 6144 + (vb % 96) * 64 + c] = a; }
        __syncthreads();
    }
}

DI unsigned pk2(float lo, float hi) { return __builtin_bit_cast(unsigned, __builtin_convertvector((f32x2v_){lo, hi}, bf16x2v_)); }
template <bool F8 = false> DI void transpose_item(const float* W, int K, int N, bf16_t* WT, float* scr, int item, int lane, int gu = -1, const float* kscale = nullptr) {
    const int nblk = (N + 31) / 32, kb = item / nblk, nb = item % nblk, k0 = 64 * kb, n0 = 32 * nb;
    const int d0 = gu < 0 ? n0 : 256 * (n0 >> 7) + (n0 & 127) + 128 * gu;
    const int ncl = n0 + (lane & 31) < N ? n0 + (lane & 31) : N - 1;
    float wv_[32];
#pragma unroll
    for (int i = 0; i < 32; ++i) { const int kk = 2 * i + (lane >> 5); wv_[i] = __builtin_nontemporal_load(W + (size_t)(k0 + kk) * N + ncl); }
#pragma unroll
    for (int i = 0; i < 32; ++i) { const int kk = 2 * i + (lane >> 5); scr[kk * 33 + (lane & 31)] = wv_[i] * (kscale ? kscale[k0 + kk] : 1.0f); }
    const int c = lane & 7;
#pragma unroll
    for (int j = 0; j < 4; ++j) { const int n = (lane >> 3) + 8 * j; const float* q = scr + (8 * c) * 33 + n;
        if constexpr (F8) { typedef unsigned u32x2nt __attribute__((ext_vector_type(2)));
            const u32x2nt o = {pg8::pk4_fp8((pg8::f32x4){q[0 * 33], q[1 * 33], q[2 * 33], q[3 * 33]} * 64.0f), pg8::pk4_fp8((pg8::f32x4){q[4 * 33], q[5 * 33], q[6 * 33], q[7 * 33]} * 64.0f)};
            if (n0 + n < N) __builtin_nontemporal_store(o, (u32x2nt*)((unsigned char*)WT + (size_t)(d0 + n) * K + k0 + 8 * c)); }
        else {
        uint4 o; o.x = pk2(q[0 * 33], q[1 * 33]); o.y = pk2(q[2 * 33], q[3 * 33]); o.z = pk2(q[4 * 33], q[5 * 33]); o.w = pk2(q[6 * 33], q[7 * 33]);
        if (n0 + n < N) { typedef unsigned u32x4nt __attribute__((ext_vector_type(4))); __builtin_nontemporal_store((u32x4nt){o.x, o.y, o.z, o.w}, (u32x4nt*)(WT + (size_t)(d0 + n) * K + k0 + 8 * c)); } } }
}

struct TrD { const float* src; unsigned char* dst; int N, K; bool ok; };
DI TrD tr_desc(const P& p, int l, int it, int it1, int lane) {
    TrD d; d.ok = it < it1; const int itc = d.ok ? it : it1 - 1;
    const int e = itc / 768, r = itc - e * 768;
    const float* W; unsigned char* WT; int K, N, item, gu;
    if (r < 512) { gu = r >> 8; W = (gu ? p.w_up : p.w_gate) + (size_t)(l * NE + e) * D * 512; K = D; N = 512; WT = (unsigned char*)p.WguT + (size_t)e * D * D; item = r & 255; }
    else { gu = -1; W = p.w_down + (size_t)(l * NE + e) * 512 * D; K = 512; N = D; WT = (unsigned char*)p.WdT + (size_t)e * D * 512; item = r - 512; }
    const int nblk = N / 32, kb = item / nblk, nb = item % nblk, k0 = 64 * kb, n0 = 32 * nb;
    const int d0 = gu < 0 ? n0 : 256 * (n0 >> 7) + (n0 & 127) + 128 * gu;
    d.src = W + (size_t)(k0 + (lane >> 5)) * N + n0 + (lane & 31); d.dst = WT + (size_t)d0 * K + k0; d.N = N; d.K = K;
    return d;
}
DI void tr_load(const TrD& d, float (&v)[32]) {
#pragma unroll
    for (int i = 0; i < 32; ++i) v[i] = __builtin_nontemporal_load(d.src + (size_t)(2 * i) * d.N);
}
DI void tr_finish(const TrD& d, const float (&v)[32], float* scr, int lane) {
#pragma unroll
    for (int i = 0; i < 32; ++i) { const int kk = 2 * i + (lane >> 5); scr[kk * 33 + (lane & 31)] = v[i]; }
    const int c = lane & 7;
#pragma unroll
    for (int j = 0; j < 4; ++j) { const int n = (lane >> 3) + 8 * j; const float* q = scr + (8 * c) * 33 + n;
        typedef unsigned u32x2nt __attribute__((ext_vector_type(2)));
        const u32x2nt o = {pg8::pk4_fp8((pg8::f32x4){q[0 * 33], q[1 * 33], q[2 * 33], q[3 * 33]} * 64.0f), pg8::pk4_fp8((pg8::f32x4){q[4 * 33], q[5 * 33], q[6 * 33], q[7 * 33]} * 64.0f)};
        if (d.ok) __builtin_nontemporal_store(o, (u32x2nt*)(d.dst + (size_t)n * d.K + 8 * c)); }
}
#ifndef TR_NI
#define TR_NI 4
#endif
DI void ph_convert_experts(const P& p, int l, float* ldsf, int wk0, int nwk, int it0 = 0, int it1 = NE * 768) {
    const int tid_ = ltid(), lane = tid_ & 63, gw = ((int)blockIdx.x - wk0) * NWV + (tid_ >> 6), NW = nwk * NWV;
    float* scr = ldsf + 14 * 1024 + (tid_ >> 6) * (64 * 33 + 16);
    for (int it = it0 + gw; it < it1; it += TR_NI * NW) {
        float v[TR_NI][32]; TrD d[TR_NI];
#pragma unroll
        for (int j = 0; j < TR_NI; ++j) { d[j] = tr_desc(p, l, it + j * NW, it1, lane); tr_load(d[j], v[j]); }
#pragma unroll
        for (int j = 0; j < TR_NI; ++j) tr_finish(d[j], v[j], scr, lane);
    }
}
constexpr int NPAD_IN = 3072;
DI void ph_convert_small(const P& p, float* ldsf, int, int, int) {
    const int tid_ = ltid(), lane = tid_ & 63, gw = blockIdx.x * NWV + (tid_ >> 6), NW = gridDim.x * NWV;
    float* scr = ldsf + 14 * 1024 + (tid_ >> 6) * (64 * 33 + 16);
    constexpr int I_IN = 16 * 89, I_OUT = 16 * 32;
    for (int it = gw; it < 2 * (I_IN + I_OUT); it += NW) {
        const int l = it / (I_IN + I_OUT), r = it % (I_IN + I_OUT);
        if (r < I_IN) transpose_item<true>(p.w_in + (size_t)l * D * INDIM, D, INDIM, (bf16_t*)((unsigned char*)p.WinT + (size_t)l * NPAD_IN * D), scr, r, lane);
        else { const int kb = (r - I_IN) / 32;
            transpose_item(p.w_out + (size_t)l * D * D, D, D, p.WoutT + (size_t)l * D * D, scr, r - I_IN, lane, -1, kb < 8 ? p.ssd_norm_g + l * 512 : nullptr); }
    }
    for (int idx = blockIdx.x * NTHR + tid_; idx < 32 * 1024; idx += gridDim.x * NTHR) { const int e = idx >> 10, k = idx & 1023; p.WRT[idx] = f2bf(p.w_router[k * 32 + e]); }
    const size_t nz16 = (size_t)(NPAD_IN - INDIM) * D / 16;
    for (size_t i = (size_t)blockIdx.x * NTHR + tid_; i < 2 * nz16; i += (size_t)gridDim.x * NTHR) {
        const size_t l = i / nz16, j = i % nz16;
        ((uint4*)((unsigned char*)p.WinT + (l * NPAD_IN + INDIM) * D))[j] = make_uint4(0u, 0u, 0u, 0u);
    }
}

DI void row_normmod(float4 (&v)[4], const float* g, const float* mr, int shift_idx, int scale_idx, int lane) {
    float ss = 0.f;
#pragma unroll
    for (int i = 0; i < 4; ++i) ss += v[i].x * v[i].x + v[i].y * v[i].y + v[i].z * v[i].z + v[i].w * v[i].w;
    ss = wave_sum(ss, lane);
    const float rstd = rsqrtf(ss * (1.0f / D) + 1e-6f);
#pragma unroll
    for (int i = 0; i < 4; ++i) {
        const int c = (i * 64 + lane) * 4;
        const float4 gg = *(const float4*)(g + c), sh = *(const float4*)(mr + shift_idx * 1024 + c), sc = *(const float4*)(mr + scale_idx * 1024 + c);
        v[i].x = v[i].x * rstd * gg.x * (1.f + sc.x) + sh.x; v[i].y = v[i].y * rstd * gg.y * (1.f + sc.y) + sh.y;
        v[i].z = v[i].z * rstd * gg.z * (1.f + sc.z) + sh.z; v[i].w = v[i].w * rstd * gg.w * (1.f + sc.w) + sh.w;
    }
}
DI void row_store_bf16(bf16_t* hrow, float4 (&v)[4], int lane) {
#pragma unroll
    for (int i = 0; i < 4; ++i) { ushort4 o; o.x = f2bf(v[i].x); o.y = f2bf(v[i].y); o.z = f2bf(v[i].z); o.w = f2bf(v[i].w);
        *(ushort4*)(hrow + (i * 64 + lane) * 4) = o; v[i] = make_float4(bf2f(o.x), bf2f(o.y), bf2f(o.z), bf2f(o.w)); }
}

DI void ph_normmod1(const P& p, int l, int, int, int) {
    const int tid_ = ltid(), lane = tid_ & 63, gw = blockIdx.x * NWV + (tid_ >> 6), NW = gridDim.x * NWV;
    const float* MODl = p.MOD + (size_t)l * 9 * 6144;
    for (int t = gw; t < T; t += NW) {
        float4 v[4];
#pragma unroll
        for (int i = 0; i < 4; ++i) v[i] = ((const float4*)(t < TC ? p.ctx + (size_t)t * D : p.x + (size_t)(t - TC) * D))[i * 64 + lane];
        row_normmod(v, p.norm1_g + l * D, MODl + (size_t)tok_modrow(t) * 6144, 0, 1, lane);
#pragma unroll
        for (int i = 0; i < 4; ++i) *(unsigned*)((unsigned char*)p.H + (size_t)t * D + (i * 64 + lane) * 4) = pg8::pk4_fp8((pg8::f32x4){v[i].x, v[i].y, v[i].z, v[i].w});
    }
}

typedef short s16x4 __attribute__((ext_vector_type(4)));
typedef short bf16x8v __attribute__((ext_vector_type(8)));
typedef float f32x4v __attribute__((ext_vector_type(4)));
typedef unsigned u32x4v __attribute__((ext_vector_type(4)));
typedef unsigned u32x2v __attribute__((ext_vector_type(2)));
DI u32x4v mk4(unsigned a, unsigned b, unsigned c, unsigned d) { return (u32x4v){a, b, c, d}; }
DI u32x2v mk2(unsigned a, unsigned b) { return (u32x2v){a, b}; }
DI f32x4v mkf4(float a, float b, float c, float d) { return (f32x4v){a, b, c, d}; }
#define LDSP __attribute__((address_space(3)))
constexpr int NCH = 34, NTILE = NB * NCH;
constexpr int LD64 = 72, LD128 = 136;
constexpr float LOG2E = 1.4426950408889634f;

DI int tile_tok0(int tl) { const int b = tl / NCH, cs = tl - b * NCH; return cs < 2 ? b * CTXL + cs * 128 : TC + b * SEQ + (cs - 2) * 128; }
DI f32x4v mfma16(bf16x8v a, bf16x8v b, f32x4v c) { return __builtin_amdgcn_mfma_f32_16x16x32_bf16(a, b, c, 0, 0, 0); }
DI bf16x8v frag_row(LDSP const bf16_t* base, int ld, int r0, int k0, int lane) { return *(LDSP const bf16x8v*)(base + (r0 + (lane & 15)) * ld + k0 + 8 * (lane >> 4)); }
DI bf16x8v frag_row_g(const bf16_t* base, int ld, int r0, int k0, int lane) { return *(const bf16x8v*)(base + (size_t)(r0 + (lane & 15)) * ld + k0 + 8 * (lane >> 4)); }
DI bf16x8v frag_col(LDSP const bf16_t* base, int ld, int r0, int k0, int lane) {
    const int G = lane >> 4, i = lane & 15;
    LDSP const bf16_t* a = base + (k0 + 8 * G + (i >> 2)) * ld + r0 + 4 * (i & 3);
    const s16x4 lo = __builtin_bit_cast(s16x4, __builtin_amdgcn_ds_read_tr16_b64_v4i16((LDSP s16x4*)a));
    const s16x4 hi = __builtin_bit_cast(s16x4, __builtin_amdgcn_ds_read_tr16_b64_v4i16((LDSP s16x4*)(a + 4 * ld)));
    return (bf16x8v){lo[0], lo[1], lo[2], lo[3], hi[0], hi[1], hi[2], hi[3]};
}
DI u32x2v pack4(f32x4v v) { return mk2(pk2(v[0], v[1]), pk2(v[2], v[3])); }
DI void unpack8(u32x4v v, float* o) { o[0] = __uint_as_float(v.x << 16); o[1] = __uint_as_float(v.x & 0xffff0000u); o[2] = __uint_as_float(v.y << 16); o[3] = __uint_as_float(v.y & 0xffff0000u);
    o[4] = __uint_as_float(v.z << 16); o[5] = __uint_as_float(v.z & 0xffff0000u); o[6] = __uint_as_float(v.w << 16); o[7] = __uint_as_float(v.w & 0xffff0000u); }
DI u32x4v pack8(const float* o) { return mk4(pk2(o[0], o[1]), pk2(o[2], o[3]), pk2(o[4], o[5]), pk2(o[6], o[7])); }

DI float fast_logsigmoid(float x) { return -(fmaxf(-x, 0.f) + __logf(1.0f + __expf(-fabsf(x)))); }
DI float fast_softplus(float x) { return fmaxf(x, 0.f) + __logf(1.0f + __expf(-fabsf(x))); }
struct XbcSrc { const bf16_t* base; int ld; };
DI XbcSrc xbc_src(const P& p, int tok0) { XbcSrc r; r.base = p.XBCC + (size_t)tok0 * 768; r.ld = 768; return r; }

DI void prep_conv_item(const P& p, int l, int item, int lane) {
    int piece, ch;
    if (item < T / 32) { piece = item; ch = lane * 8; } else { piece = 2 * (item - T / 32) + (lane >> 5); ch = 512 + (lane & 31) * 8; }
    const int t0 = piece * 32; int lo, hi; bf16_t* dst; int dld;
    if (t0 < TC) { lo = t0 & ~(CTXL - 1); hi = lo + CTXL - 1; } else { lo = TC + ((t0 - TC) & ~63); hi = lo + 63; }
    dst = p.XBCC + ch; dld = 768;
    const bf16_t* src = p.PROJ + OFF_XBC + ch;
    float wgt[5][8], bias[8];
#pragma unroll
    for (int k = 0; k < 5; ++k) { const f32x4v a = *(const f32x4v*)(p.conv_w + l * 5 * 768 + k * 768 + ch), c = *(const f32x4v*)(p.conv_w + l * 5 * 768 + k * 768 + ch + 4);
#pragma unroll
        for (int j = 0; j < 4; ++j) { wgt[k][j] = a[j]; wgt[k][4 + j] = c[j]; } }
    { const f32x4v a = *(const f32x4v*)(p.conv_b + l * 768 + ch), c = *(const f32x4v*)(p.conv_b + l * 768 + ch + 4);
#pragma unroll
      for (int j = 0; j < 4; ++j) { bias[j] = a[j]; bias[4 + j] = c[j]; } }
    const u32x4v zero4 = mk4(0u, 0u, 0u, 0u);
    u32x4v rw[13];
#pragma unroll
    for (int i = 0; i < 5; ++i) { const int tt = t0 - 2 + i; rw[i] = (tt >= lo && tt <= hi) ? *(const u32x4v*)(src + (size_t)tt * LDP) : zero4; }
    for (int s0 = 0; s0 < 32; s0 += 8) {
        const int t = t0 + s0;
#pragma unroll
        for (int i = 0; i < 8; ++i) { const int tt = t + 3 + i; rw[5 + i] = (tt <= hi) ? *(const u32x4v*)(src + (size_t)tt * LDP) : zero4; }
#pragma unroll
        for (int i = 0; i < 8; ++i) {
            float o[8];
#pragma unroll
            for (int c = 0; c < 8; ++c) o[c] = bias[c];
#pragma unroll
            for (int k = 0; k < 5; ++k) { float v[8]; unpack8(rw[i + k], v);
#pragma unroll
                for (int c = 0; c < 8; ++c) o[c] += wgt[k][c] * v[c]; }
#pragma unroll
            for (int c = 0; c < 8; ++c) o[c] = siluf(o[c]);
            *(u32x4v*)(dst + (size_t)(t + i) * dld) = pack8(o);
        }
#pragma unroll
        for (int i = 0; i < 5; ++i) rw[i] = rw[i + 8];
    }
}
DI void prep_ssd_item(const P& p, int l, int item, int lane) {
    const int tl = item >> 3, h = item & 7, tok0 = tile_tok0(tl);
    const float bsf = p.dt_bias_f[l * 8 + h], bsb = p.dt_bias_b[l * 8 + h];
    const float r0 = bf2f(p.PROJ[(size_t)(tok0 + 2 * lane) * LDP + OFF_DT + h]), r1 = bf2f(p.PROJ[(size_t)(tok0 + 2 * lane + 1) * LDP + OFF_DT + h]);
    const float f0 = fast_softplus(r0 + bsf), f1 = fast_softplus(r1 + bsf), b0 = fast_softplus(r0 + bsb), b1 = fast_softplus(r1 + bsb);
    float pf = f0 + f1, sb = b0 + b1;
#pragma unroll
    for (int o = 1; o < 64; o <<= 1) { const float t = shl(pf, lane >= o ? lane - o : lane); if (lane >= o) pf += t; }
#pragma unroll
    for (int o = 1; o < 64; o <<= 1) { const float t = shl(sb, lane + o < 64 ? lane + o : lane); if (lane + o < 64) sb += t; }
    const float Af = -__expf(p.a_log_f[l * 8 + h]) * LOG2E, Ab = -__expf(p.a_log_b[l * 8 + h]) * LOG2E;
    const float af0 = Af * (pf - f1), af1 = Af * pf, ab0 = Ab * sb, ab1 = Ab * (sb - b0);
    f32x4v* dst = (f32x4v*)p.SSC + (size_t)(tok0 + 2 * lane) * 8 + h;
    dst[0] = mkf4(af0, af0 - __log2f(f0), ab0, ab0 - __log2f(b0));
    dst[8] = mkf4(af1, af1 - __log2f(f1), ab1, ab1 - __log2f(b1));
    if (lane == 63) { p.STOT[(tl * 8 + h) * 2 + 0] = af1; p.SDEC[(tl * 8 + h) * 2 + 0] = __builtin_amdgcn_exp2f(af1); }
    if (lane == 0) { p.STOT[(tl * 8 + h) * 2 + 1] = ab0; p.SDEC[(tl * 8 + h) * 2 + 1] = __builtin_amdgcn_exp2f(ab0); }
}
template <int CTRL> DI float dppz(float x) { return __builtin_bit_cast(float, __builtin_amdgcn_update_dpp(0, __builtin_bit_cast(int, x), CTRL, 0xf, 0xf, true)); }
DI float row_total(float s) { s += dppz<0xB1>(s); s += dppz<0x4E>(s); s += dppz<0x141>(s); s += dppz<0x140>(s); return s; }
struct GlaPL { u32x4v qv_[2], kv_[2], vv_[4]; bf16x8v gkf[8]; float uw[8]; f32x4v bias; };
DI void prep_gla_load(const P& p, int l, int it, GlaPL& L) {
    const int tl = it >> 2, h = it & 3;
    const int tid = ltid(), lane = tid & 63, w = __builtin_amdgcn_readfirstlane(tid >> 6), kt = w & 3, dir = w >> 2, G = lane >> 4, c = lane & 15, tok0 = tile_tok0(tl);
#pragma unroll
    for (int nt = 0; nt < 8; ++nt) L.gkf[nt] = *(const bf16x8v*)(p.PROJ + (size_t)(tok0 + 16 * nt + c) * LDP + OFF_GK + (G & 1) * 8);
    { const float* up = (dir ? p.gk_up_b : p.gk_up_f) + l * 16 * 256 + (G & 1) * 8 * 256 + h * 64 + 16 * kt + c;
#pragma unroll
      for (int e = 0; e < 8; ++e) L.uw[e] = up[e * 256]; }
    L.bias = *(const f32x4v*)((dir ? p.gk_bias_b : p.gk_bias_f) + l * 256 + h * 64 + 16 * kt + 4 * G);
#pragma unroll
    for (int q = 0; q < 4; ++q) { const int cc_ = tid + q * NTHR, r = cc_ >> 4, cc = cc_ & 15; L.vv_[q] = *(const u32x4v*)(p.PROJ + (size_t)(tok0 + r) * LDP + OFF_V + h * 128 + cc * 8); }
#pragma unroll
    for (int q = 0; q < 2; ++q) { const int cc_ = tid + q * NTHR, r = cc_ >> 3, cc = cc_ & 7; const bf16_t* pr = p.PROJ + (size_t)(tok0 + r) * LDP;
        L.qv_[q] = *(const u32x4v*)(pr + OFF_Q + h * 64 + cc * 8); L.kv_[q] = *(const u32x4v*)(pr + OFF_K + h * 64 + cc * 8); }
}
DI void prep_gla_block(const P& p, int l, int it, int it_next, GlaPL& L, LDSP unsigned char* lds) {
    const int tl = it >> 2, h = it & 3;
    const int tid = ltid(), lane = tid & 63, w = __builtin_amdgcn_readfirstlane(tid >> 6), kt = w & 3, dir = w >> 2, G = lane >> 4, c = lane & 15, tok0 = tile_tok0(tl);
    LDSP bf16_t* QT = (LDSP bf16_t*)lds; LDSP bf16_t* KT = QT + 128 * LD64; LDSP bf16_t* O4 = KT + 128 * LD64; LDSP bf16_t* VT = O4 + 4 * 128 * LD64; LDSP float* DEC = (LDSP float*)(VT + 128 * LD128);
    f32x4v g[8];
    { bf16x8v af;
#pragma unroll
      for (int e = 0; e < 8; ++e) { const bf16_t hi = f2bf(L.uw[e]); const bf16_t lo = f2bf(L.uw[e] - bf2f(hi)); af[e] = (short)(G < 2 ? hi : lo); }
#pragma unroll
      for (int nt = 0; nt < 8; ++nt) g[nt] = mfma16(af, L.gkf[nt], (f32x4v){0.f, 0.f, 0.f, 0.f}); }
#pragma unroll
    for (int nt = 0; nt < 8; ++nt)
#pragma unroll
        for (int r = 0; r < 4; ++r) { const float x = (g[nt][r] + L.bias[r]) * LOG2E;
            g[nt][r] = -(fmaxf(-x, 0.f) + __log2f(1.0f + __builtin_amdgcn_exp2f(-fabsf(x)))) * (1.0f / 16.0f); }
    f32x4v tot = (f32x4v){0.f, 0.f, 0.f, 0.f};
    if (dir == 0) {
#pragma unroll
        for (int nt = 0; nt < 8; ++nt)
#pragma unroll
            for (int r = 0; r < 4; ++r) { const float s = row_total(g[nt][r]); float x = g[nt][r];
                x += dppz<0x111>(x); x += dppz<0x112>(x); x += dppz<0x114>(x); x += dppz<0x118>(x);
                g[nt][r] = tot[r] + x; tot[r] += s; }
    } else {
#pragma unroll
        for (int nt = 7; nt >= 0; --nt)
#pragma unroll
            for (int r = 0; r < 4; ++r) { const float s = row_total(g[nt][r]); float x = g[nt][r];
                x += dppz<0x101>(x); x += dppz<0x102>(x); x += dppz<0x104>(x); x += dppz<0x108>(x);
                g[nt][r] = tot[r] + x; tot[r] += s; }
    }
    __syncthreads();
#pragma unroll
    for (int q = 0; q < 2; ++q) { const int cc_ = tid + q * NTHR, r = cc_ >> 3, cc = cc_ & 7; *(LDSP u32x4v*)(QT + r * LD64 + cc * 8) = L.qv_[q]; *(LDSP u32x4v*)(KT + r * LD64 + cc * 8) = L.kv_[q]; }
#pragma unroll
    for (int q = 0; q < 4; ++q) { const int cc_ = tid + q * NTHR, r = cc_ >> 4, cc = cc_ & 15; *(LDSP u32x4v*)(VT + r * LD128 + cc * 8) = L.vv_[q]; }
    __syncthreads();
    { LDSP bf16_t* OQ = O4 + (2 * dir) * 128 * LD64; LDSP bf16_t* OK = OQ + 128 * LD64;
#pragma unroll
      for (int nt = 0; nt < 8; ++nt) { const int o = (16 * nt + c) * LD64 + 16 * kt + 4 * G;
          const u32x2v q2 = *(LDSP const u32x2v*)(QT + o), k2 = *(LDSP const u32x2v*)(KT + o);
          float eq[4], ek[4];
#pragma unroll
          for (int r = 0; r < 4; ++r) { eq[r] = __builtin_amdgcn_exp2f(g[nt][r] - 3.0f); ek[r] = __builtin_amdgcn_exp2f(-g[nt][r]); }
          *(LDSP u32x2v*)(OQ + o) = mk2(pk2(__uint_as_float(q2.x << 16) * eq[0], __uint_as_float(q2.x & 0xffff0000u) * eq[1]), pk2(__uint_as_float(q2.y << 16) * eq[2], __uint_as_float(q2.y & 0xffff0000u) * eq[3]));
          *(LDSP u32x2v*)(OK + o) = mk2(pk2(__uint_as_float(k2.x << 16) * ek[0], __uint_as_float(k2.x & 0xffff0000u) * ek[1]), pk2(__uint_as_float(k2.y << 16) * ek[2], __uint_as_float(k2.y & 0xffff0000u) * ek[3])); }
      if (c == 0) { const f32x4v d = mkf4(__builtin_amdgcn_exp2f(tot[0]), __builtin_amdgcn_exp2f(tot[1]), __builtin_amdgcn_exp2f(tot[2]), __builtin_amdgcn_exp2f(tot[3]));
          *(f32x4v*)(p.GDEC + (size_t)((tl * 4 + h) * 2 + dir) * 64 + 16 * kt + 4 * G) = d; *(LDSP f32x4v*)(DEC + dir * 64 + 16 * kt + 4 * G) = d; } }
    __syncthreads();
    if (it_next >= 0) prep_gla_load(p, l, it_next, L);
#pragma unroll
    for (int q = 0; q < 8; ++q) { const int cc_ = tid + q * NTHR, a4 = cc_ >> 10, r = (cc_ >> 3) & 127, cc = cc_ & 7;
        *(u32x4v*)(p.QKB + (size_t)(tok0 + r) * 1024 + a4 * 256 + h * 64 + cc * 8) = *(LDSP const u32x4v*)(O4 + (a4 * 128 + r) * LD64 + cc * 8); }
    { const int ut = kt; LDSP const bf16_t* KE = O4 + (dir ? 3 : 1) * 128 * LD64;
      f32x4v acc[8];
#pragma unroll
      for (int q = 0; q < 8; ++q) acc[q] = (f32x4v){0.f, 0.f, 0.f, 0.f};
#pragma unroll
      for (int ks = 0; ks < 4; ++ks) { const bf16x8v u = frag_col(KE, LD64, 16 * ut, 32 * ks, lane);
#pragma unroll
          for (int q = 0; q < 8; ++q) acc[q] = mfma16(u, frag_col(VT, LD128, 16 * q, 32 * ks, lane), acc[q]); }
      const f32x4v dec = *(LDSP const f32x4v*)(DEC + dir * 64 + 16 * ut + 4 * (lane >> 4));
      bf16_t* dst = p.GS + ((size_t)((tl * 4 + h) * 2 + dir) * 128) * 64;
#pragma unroll
      for (int q = 0; q < 8; ++q) *(u32x2v*)(dst + (size_t)(16 * q + (lane & 15)) * 64 + 16 * ut + 4 * (lane >> 4)) = pack4(acc[q] * dec); }
}
constexpr int NPREP_A = T / 32 + T / 64, NPREP_B = NTILE * 8;
DI void ph_prep(const P& p, int l, LDSP unsigned char* lds) {
    const int tid_ = ltid(), lane = tid_ & 63, gw = blockIdx.x * NWV + (tid_ >> 6), NW = gridDim.x * NWV;
    for (int it = gw; it < NPREP_A + NPREP_B; it += NW) {
        if (it < NPREP_A) prep_conv_item(p, l, it, lane); else prep_ssd_item(p, l, it - NPREP_A, lane);
    }
    { const int G_ = gridDim.x; int it = G_ - 1 - (int)blockIdx.x;
      GlaPL L; if (it < NTILE * 4) prep_gla_load(p, l, it, L);
      for (; it < NTILE * 4; it += G_) prep_gla_block(p, l, it, it + G_ < NTILE * 4 ? it + G_ : -1, L, lds); }
}

DI void s1_ssd(const P& p, int tl, int h, LDSP unsigned char* lds) {
    const int tid = ltid(), lane = tid & 63, w = __builtin_amdgcn_readfirstlane(tid >> 6);
    const int tok0 = tile_tok0(tl), g = h >> 2; const XbcSrc xs = xbc_src(p, tok0);
    LDSP bf16_t* XWF = (LDSP bf16_t*)lds; LDSP bf16_t* XWB = XWF + 128 * LD64; LDSP bf16_t* BG = XWB + 128 * LD64;
    const int j = tid >> 2, cq = tid & 3;
    const bf16_t* row = xs.base + (size_t)j * xs.ld;
    const u32x4v x0 = *(const u32x4v*)(row + h * 64 + cq * 16), x1 = *(const u32x4v*)(row + h * 64 + cq * 16 + 8);
    const u32x4v b0 = *(const u32x4v*)(row + 512 + g * 64 + cq * 16), b1 = *(const u32x4v*)(row + 512 + g * 64 + cq * 16 + 8);
    const f32x4v sc = *((const f32x4v*)p.SSC + (size_t)(tok0 + j) * 8 + h);
    const float wf = __builtin_amdgcn_exp2f(p.STOT[(tl * 8 + h) * 2 + 0] - sc.y), wb = __builtin_amdgcn_exp2f(p.STOT[(tl * 8 + h) * 2 + 1] - sc.w);
    float xv[16], of[16], ob[16]; unpack8(x0, xv); unpack8(x1, xv + 8);
#pragma unroll
    for (int c = 0; c < 16; ++c) { of[c] = xv[c] * wf; ob[c] = xv[c] * wb; }
    __syncthreads();
    *(LDSP u32x4v*)(XWF + j * LD64 + cq * 16) = pack8(of); *(LDSP u32x4v*)(XWF + j * LD64 + cq * 16 + 8) = pack8(of + 8);
    *(LDSP u32x4v*)(XWB + j * LD64 + cq * 16) = pack8(ob); *(LDSP u32x4v*)(XWB + j * LD64 + cq * 16 + 8) = pack8(ob + 8);
    *(LDSP u32x4v*)(BG + j * LD64 + cq * 16) = b0; *(LDSP u32x4v*)(BG + j * LD64 + cq * 16 + 8) = b1;
    __syncthreads();
    const int dir = w >> 2, ut = w & 3; LDSP const bf16_t* XW = dir ? XWB : XWF;
    f32x4v acc[4];
#pragma unroll
    for (int q = 0; q < 4; ++q) acc[q] = (f32x4v){0.f, 0.f, 0.f, 0.f};
#pragma unroll
    for (int ks = 0; ks < 4; ++ks) { const bf16x8v u = frag_col(BG, LD64, 16 * ut, 32 * ks, lane);
#pragma unroll
        for (int q = 0; q < 4; ++q) acc[q] = mfma16(u, frag_col(XW, LD64, 16 * q, 32 * ks, lane), acc[q]); }
    bf16_t* dst = p.SS + ((size_t)((tl * 8 + h) * 2 + dir) * 64) * 64;
#pragma unroll
    for (int q = 0; q < 4; ++q) *(u32x2v*)(dst + (size_t)(16 * q + (lane & 15)) * 64 + 16 * ut + 4 * (lane >> 4)) = pack4(acc[q]);
}
DI void ph_s1(const P& p, int l, LDSP unsigned char* lds) {
    for (int it = blockIdx.x; it < NTILE * 8; it += gridDim.x) s1_ssd(p, it >> 3, it & 7, lds);
}

DI int s2_chunk(int dir, int s) { return dir == 0 ? s : (s < 2 ? 1 - s : 35 - s); }
DI void ph_s2(const P& p) {
    const int g = blockIdx.x * NTHR + ltid();
    for (int v = g; v < 131072; v += gridDim.x * NTHR) {
        const bool gla = v >= 65536; const int r = v & 65535;
        int b, h, dir, vi;
        if (!gla) { vi = r & 511; dir = (r >> 9) & 1; h = (r >> 10) & 7; b = r >> 13; } else { vi = r & 1023; dir = (r >> 10) & 1; h = (r >> 11) & 3; b = r >> 13; }
        float st[8];
#pragma unroll
        for (int e = 0; e < 8; ++e) st[e] = 0.f;
        for (int s0 = 0; s0 < NCH; s0 += 6) {
            u32x4v sv[6]; float dsc[6]; f32x4v dv0[6], dv1[6];
#pragma unroll
            for (int u = 0; u < 6; ++u) { if (s0 + u >= NCH) continue; const int tl = b * NCH + s2_chunk(dir, s0 + u);
                if (!gla) { sv[u] = *(const u32x4v*)(p.SS + ((size_t)((tl * 8 + h) * 2 + dir) * 512 + vi) * 8); dsc[u] = p.SDEC[(tl * 8 + h) * 2 + dir]; }
                else { sv[u] = *(const u32x4v*)(p.GS + ((size_t)((tl * 4 + h) * 2 + dir) * 1024 + vi) * 8); const f32x4v* d = (const f32x4v*)(p.GDEC + (size_t)((tl * 4 + h) * 2 + dir) * 64 + (vi & 7) * 8); dv0[u] = d[0]; dv1[u] = d[1]; } }
#pragma unroll
            for (int u = 0; u < 6; ++u) { if (s0 + u >= NCH) continue; const int tl = b * NCH + s2_chunk(dir, s0 + u);
                float loc[8]; unpack8(sv[u], loc);
                const u32x4v hin = pack8(st);
                if (!gla) { *(u32x4v*)(p.SS + ((size_t)((tl * 8 + h) * 2 + dir) * 512 + vi) * 8) = hin;
#pragma unroll
                    for (int e = 0; e < 8; ++e) st[e] = dsc[u] * st[e] + loc[e]; }
                else { *(u32x4v*)(p.GS + ((size_t)((tl * 4 + h) * 2 + dir) * 1024 + vi) * 8) = hin;
                    const float dd[8] = {dv0[u].x, dv0[u].y, dv0[u].z, dv0[u].w, dv1[u].x, dv1[u].y, dv1[u].z, dv1[u].w};
#pragma unroll
                    for (int e = 0; e < 8; ++e) st[e] = dd[e] * st[e] + loc[e]; } }
        }
    }
}

DI int s3_tile(int l, int q) { return l == 0 ? q : (q >> 5) * NCH + 2 + (q & 31); }
struct SsdPre { u32x4v x0, x1, b0, b1, c0, c1, hf, hb; f32x4v sc; };
DI void s3_ssd_load(const P& p, int tl, int h, int tid, int i, int G, SsdPre& r) {
    const int tok0 = tile_tok0(tl), g = h >> 2; const XbcSrc xs = xbc_src(p, tok0);
    const int j = tid >> 2, cq = tid & 3; const bf16_t* row = xs.base + (size_t)j * xs.ld;
    r.x0 = *(const u32x4v*)(row + h * 64 + cq * 16); r.x1 = *(const u32x4v*)(row + h * 64 + cq * 16 + 8);
    r.b0 = *(const u32x4v*)(row + 512 + g * 64 + cq * 16); r.b1 = *(const u32x4v*)(row + 512 + g * 64 + cq * 16 + 8);
    r.c0 = *(const u32x4v*)(row + 640 + g * 64 + cq * 16); r.c1 = *(const u32x4v*)(row + 640 + g * 64 + cq * 16 + 8);
    const bf16_t* Hf = p.SS + (size_t)((tl * 8 + h) * 2 + 0) * 4096 + (tid >> 3) * 64 + (tid & 7) * 8;
    r.hf = *(const u32x4v*)Hf; r.hb = *(const u32x4v*)(Hf + 4096);
    r.sc = *((const f32x4v*)p.SSC + (size_t)(tok0 + (tid & 127)) * 8 + h);
}
DI void ph_s3_ssd(const P& p, int l, LDSP unsigned char* lds) {
    const int tid = ltid(), lane = tid & 63, w = __builtin_amdgcn_readfirstlane(tid >> 6), G = lane >> 4, li = lane & 15, i = 16 * w + li;
    LDSP bf16_t* XH = (LDSP bf16_t*)lds; LDSP bf16_t* BG = XH + 128 * LD64; LDSP bf16_t* CG = BG + 128 * LD64; LDSP bf16_t* MM = CG + 128 * LD64; LDSP f32x4v* SC = (LDSP f32x4v*)(MM + 128 * LD128);
    LDSP bf16_t* HF = (LDSP bf16_t*)(SC + 128); LDSP bf16_t* HB = HF + 64 * LD64;
    const int nit = (l == 0 ? NTILE : NB * 32) * 8, GS_ = gridDim.x;
    int it = ((int)blockIdx.x + (GS_ >> 1)) % GS_; SsdPre pre;
    if (it < nit) s3_ssd_load(p, s3_tile(l, it >> 3), it & 7, tid, i, G, pre);
    for (; it < nit; it += GS_) {
        const int tl = s3_tile(l, it >> 3), h = it & 7, tok0 = tile_tok0(tl);
        __syncthreads();
        { const int j = tid >> 2, cq = tid & 3;
          *(LDSP u32x4v*)(XH + j * LD64 + cq * 16) = pre.x0; *(LDSP u32x4v*)(XH + j * LD64 + cq * 16 + 8) = pre.x1;
          *(LDSP u32x4v*)(BG + j * LD64 + cq * 16) = pre.b0; *(LDSP u32x4v*)(BG + j * LD64 + cq * 16 + 8) = pre.b1;
          *(LDSP u32x4v*)(CG + j * LD64 + cq * 16) = pre.c0; *(LDSP u32x4v*)(CG + j * LD64 + cq * 16 + 8) = pre.c1;
          *(LDSP u32x4v*)(HF + (tid >> 3) * LD64 + (tid & 7) * 8) = pre.hf; *(LDSP u32x4v*)(HB + (tid >> 3) * LD64 + (tid & 7) * 8) = pre.hb;
          if (tid < 128) SC[tid] = pre.sc; }
        if (it + GS_ < nit) s3_ssd_load(p, s3_tile(l, (it + GS_) >> 3), (it + GS_) & 7, tid, i, G, pre);
        __syncthreads();
        u32x2v zr[4];
#pragma unroll
        for (int pt = 0; pt < 4; ++pt) zr[pt] = *(const u32x2v*)(p.PROJ + (size_t)(tok0 + i) * LDP + OFF_Z + h * 64 + 16 * pt + 4 * G);
        const f32x4v sci = SC[i];
        {
            f32x4v am[8];
#pragma unroll
            for (int ut = 0; ut < 8; ++ut) am[ut] = (f32x4v){0.f, 0.f, 0.f, 0.f};
#pragma unroll
            for (int ks = 0; ks < 2; ++ks) { const bf16x8v vfr = frag_row(CG, LD64, 16 * w, 32 * ks, lane);
#pragma unroll
                for (int ut = 0; ut < 8; ++ut) am[ut] = mfma16(frag_row(BG, LD64, 16 * ut, 32 * ks, lane), vfr, am[ut]); }
#pragma unroll
            for (int ut = 0; ut < 8; ++ut) { f32x4v m;
#pragma unroll
                for (int r = 0; r < 4; ++r) { const int jj = 16 * ut + 4 * G + r; const f32x4v scj = SC[jj];
                    const float Lf = jj <= i ? __builtin_amdgcn_exp2f(fminf(sci.x - scj.y, 30.f)) : 0.f, Lb = jj >= i ? __builtin_amdgcn_exp2f(fminf(sci.z - scj.w, 30.f)) : 0.f;
                    m[r] = am[ut][r] * (Lf + Lb); }
                *(LDSP u32x2v*)(MM + i * LD128 + 16 * ut + 4 * G) = pack4(m); }
        }
        asm volatile("s_waitcnt lgkmcnt(0)" ::: "memory");
        f32x4v ay[4], af_[4], ab_[4];
#pragma unroll
        for (int pt = 0; pt < 4; ++pt) { ay[pt] = (f32x4v){0.f, 0.f, 0.f, 0.f}; af_[pt] = ay[pt]; ab_[pt] = ay[pt]; }
#pragma unroll
        for (int ks = 0; ks < 2; ++ks) { const bf16x8v vfr = frag_row(CG, LD64, 16 * w, 32 * ks, lane);
#pragma unroll
            for (int pt = 0; pt < 4; ++pt) { af_[pt] = mfma16(frag_row(HF, LD64, 16 * pt, 32 * ks, lane), vfr, af_[pt]); ab_[pt] = mfma16(frag_row(HB, LD64, 16 * pt, 32 * ks, lane), vfr, ab_[pt]); } }
#pragma unroll
        for (int ks = 0; ks < 4; ++ks) { const bf16x8v vfr = frag_row(MM, LD128, 16 * w, 32 * ks, lane);
#pragma unroll
            for (int pt = 0; pt < 4; ++pt) ay[pt] = mfma16(frag_col(XH, LD64, 16 * pt, 32 * ks, lane), vfr, ay[pt]); }
        const float sf = __builtin_amdgcn_exp2f(sci.x), sb = __builtin_amdgcn_exp2f(sci.z), dsk = p.d_skip[l * 8 + h];
        float ssq = 0.f;
#pragma unroll
        for (int pt = 0; pt < 4; ++pt) { const int pc = 16 * pt + 4 * G;
            const u32x2v xr = *(LDSP const u32x2v*)(XH + i * LD64 + pc);
            const float xv[4] = {__uint_as_float(xr.x << 16), __uint_as_float(xr.x & 0xffff0000u), __uint_as_float(xr.y << 16), __uint_as_float(xr.y & 0xffff0000u)};
            const float zv[4] = {__uint_as_float(zr[pt].x << 16), __uint_as_float(zr[pt].x & 0xffff0000u), __uint_as_float(zr[pt].y << 16), __uint_as_float(zr[pt].y & 0xffff0000u)};
            float yv[4];
#pragma unroll
            for (int r = 0; r < 4; ++r) { yv[r] = (ay[pt][r] + sf * af_[pt][r] + sb * ab_[pt][r] + dsk * xv[r]) * siluf(zv[r]); yv[r] = bf2f(f2bf(yv[r])); ssq += yv[r] * yv[r]; }
            *(u32x2v*)(p.H + (size_t)(tok0 + i) * D + h * 64 + pc) = mk2(pk2(yv[0], yv[1]), pk2(yv[2], yv[3])); }
        ssq += shx(ssq, 16, lane); ssq += shx(ssq, 32, lane);
        if (G == 0) p.SSQ[(size_t)(tok0 + i) * 8 + h] = ssq;
    }
}
struct GlaPre { u32x4v qk[2][4], vv[4], sf[2], sb[2]; };
DI void s3_gla_load(const P& p, int tl, int h, int tid, int i, int G, GlaPre& r) {
    const int tok0 = tile_tok0(tl);
#pragma unroll
    for (int q = 0; q < 2; ++q) { const int c = tid + q * NTHR, rr = c >> 3, cc = c & 7; const bf16_t* qb = p.QKB + (size_t)(tok0 + rr) * 1024 + h * 64 + cc * 8;
        r.qk[q][0] = *(const u32x4v*)qb; r.qk[q][1] = *(const u32x4v*)(qb + 256);
        r.qk[q][2] = *(const u32x4v*)(qb + 512); r.qk[q][3] = *(const u32x4v*)(qb + 768);
        const bf16_t* Sg = p.GS + (size_t)((tl * 4 + h) * 2 + 0) * 8192 + (size_t)rr * 64 + cc * 8; r.sf[q] = *(const u32x4v*)Sg; r.sb[q] = *(const u32x4v*)(Sg + 8192); }
#pragma unroll
    for (int q = 0; q < 4; ++q) { const int c = tid + q * NTHR, rr = c >> 4, cc = c & 15; r.vv[q] = *(const u32x4v*)(p.PROJ + (size_t)(tok0 + rr) * LDP + OFF_V + h * 128 + cc * 8); }
}
DI void ph_s3_gla(const P& p, int l, LDSP unsigned char* lds) {
    const int tid = ltid(), lane = tid & 63, w = __builtin_amdgcn_readfirstlane(tid >> 6), G = lane >> 4, li = lane & 15, i = 16 * w + li;
    LDSP bf16_t* Q2 = (LDSP bf16_t*)lds;
    LDSP bf16_t* KF = Q2 + 8 * 2 * 16 * LD64; LDSP bf16_t* KB = KF + 128 * LD64; LDSP bf16_t* VT = KB + 128 * LD64; LDSP bf16_t* SF = VT + 128 * LD128; LDSP bf16_t* SB = SF + 128 * LD64;
    LDSP bf16_t* AMw = SF + w * 16 * LD128;
    const int nit = (l == 0 ? NTILE : NB * 32) * 4, GS_ = gridDim.x;
    int it = blockIdx.x; GlaPre pre;
    if (it < nit) s3_gla_load(p, s3_tile(l, it >> 2), it & 3, tid, i, G, pre);
    for (; it < nit; it += GS_) {
        const int tl = s3_tile(l, it >> 2), h = it & 3, tok0 = tile_tok0(tl);
        __syncthreads();
#pragma unroll
        for (int q = 0; q < 2; ++q) { const int c = tid + q * NTHR, rr = c >> 3, cc = c & 7; LDSP bf16_t* qrow = Q2 + (rr >> 4) * (2 * 16 * LD64) + (rr & 15) * LD64 + cc * 8;
            *(LDSP u32x4v*)qrow = pre.qk[q][0]; *(LDSP u32x4v*)(qrow + 16 * LD64) = pre.qk[q][2];
            *(LDSP u32x4v*)(KF + rr * LD64 + cc * 8) = pre.qk[q][1]; *(LDSP u32x4v*)(KB + rr * LD64 + cc * 8) = pre.qk[q][3];
            *(LDSP u32x4v*)(SF + rr * LD64 + cc * 8) = pre.sf[q]; *(LDSP u32x4v*)(SB + rr * LD64 + cc * 8) = pre.sb[q]; }
#pragma unroll
        for (int q = 0; q < 4; ++q) { const int c = tid + q * NTHR, rr = c >> 4, cc = c & 15; *(LDSP u32x4v*)(VT + rr * LD128 + cc * 8) = pre.vv[q]; }
        if (it + GS_ < nit) s3_gla_load(p, s3_tile(l, (it + GS_) >> 2), (it + GS_) & 3, tid, i, G, pre);
        __syncthreads();
        f32x4v ao[8];
#pragma unroll
        for (int q = 0; q < 8; ++q) ao[q] = (f32x4v){0.f, 0.f, 0.f, 0.f};
        bf16x8v qfr[2][2];
#pragma unroll
        for (int dir = 0; dir < 2; ++dir)
#pragma unroll
            for (int ks = 0; ks < 2; ++ks) qfr[dir][ks] = frag_row(Q2 + w * (2 * 16 * LD64) + dir * 16 * LD64, LD64, 0, 32 * ks, lane);
#pragma unroll
        for (int dir = 0; dir < 2; ++dir) {
            LDSP const bf16_t* SS_ = dir ? SB : SF;
#pragma unroll
            for (int ks = 0; ks < 2; ++ks) {
#pragma unroll
                for (int vt = 0; vt < 8; ++vt) ao[vt] = mfma16(frag_row(SS_, LD64, 16 * vt, 32 * ks, lane), qfr[dir][ks], ao[vt]); }
        }
        __syncthreads();
#pragma unroll
        for (int uh = 0; uh < 4; ++uh) {
            f32x4v a2[2]; a2[0] = (f32x4v){0.f, 0.f, 0.f, 0.f}; a2[1] = a2[0];
#pragma unroll
            for (int dir = 0; dir < 2; ++dir) {
                LDSP const bf16_t* KS = dir ? KB : KF;
                f32x4v as[2]; as[0] = (f32x4v){0.f, 0.f, 0.f, 0.f}; as[1] = as[0];
#pragma unroll
                for (int ks = 0; ks < 2; ++ks) {
#pragma unroll
                    for (int q = 0; q < 2; ++q) as[q] = mfma16(frag_row(KS, LD64, 16 * (2 * uh + q), 32 * ks, lane), qfr[dir][ks], as[q]); }
#pragma unroll
                for (int q = 0; q < 2; ++q)
#pragma unroll
                    for (int r = 0; r < 4; ++r) { const int jj = 16 * (2 * uh + q) + 4 * G + r; const bool keep = dir == 0 ? (jj <= i) : (jj >= i); a2[q][r] += keep ? as[q][r] : 0.f; }
            }
#pragma unroll
            for (int q = 0; q < 2; ++q) *(LDSP u32x2v*)(AMw + li * LD128 + 16 * (2 * uh + q) + 4 * G) = pack4(a2[q]);
        }
        u32x2v gr[8];
#pragma unroll
        for (int vt = 0; vt < 8; ++vt) gr[vt] = *(const u32x2v*)(p.PROJ + (size_t)(tok0 + i) * LDP + OFF_GO + h * 128 + 16 * vt + 4 * G);
        asm volatile("s_waitcnt lgkmcnt(0)" ::: "memory");
#pragma unroll
        for (int ks = 0; ks < 4; ++ks) { const bf16x8v vfr = frag_row(AMw, LD128, 0, 32 * ks, lane);
#pragma unroll
            for (int vt = 0; vt < 8; ++vt) ao[vt] = mfma16(frag_col(VT, LD128, 16 * vt, 32 * ks, lane), vfr, ao[vt]); }
        float so = 0.f;
#pragma unroll
        for (int vt = 0; vt < 8; ++vt)
#pragma unroll
            for (int r = 0; r < 4; ++r) so += ao[vt][r] * ao[vt][r];
        so += shx(so, 16, lane); so += shx(so, 32, lane);
        const float ro = rsqrtf(so * (1.0f / 128.0f) + 1e-6f);
#pragma unroll
        for (int vt = 0; vt < 8; ++vt) { const int vc = 16 * vt + 4 * G; const f32x4v gg = *(const f32x4v*)(p.gla_norm_g + l * 128 + vc);
            const float g0 = __uint_as_float(gr[vt].x << 16), g1 = __uint_as_float(gr[vt].x & 0xffff0000u), g2 = __uint_as_float(gr[vt].y << 16), g3 = __uint_as_float(gr[vt].y & 0xffff0000u);
            *(u32x2v*)(p.H + (size_t)(tok0 + i) * D + 512 + h * 128 + vc) = mk2(pk2(ao[vt][0] * ro * gg.x * siluf(g0), ao[vt][1] * ro * gg.y * siluf(g1)), pk2(ao[vt][2] * ro * gg.z * siluf(g2), ao[vt][3] * ro * gg.w * siluf(g3))); }
    }
}
DI void ph_s3(const P& p, int l, LDSP unsigned char* lds) { ph_s3_gla(p, l, lds); ph_s3_ssd(p, l, lds); }
struct RouteR { bool own; int t, e1, e2, r1, r2; };
template <int NR> DI void normroute_tile(const P& p, int tb, const float* MODl, LDSP int* lcnt, const float* g2, LDSP bf16_t* WR, LDSP bf16_t* HT, int lane, int G, int li, RouteR& R) {
    constexpr int LDW = 1032, LDT = 264;
        const float* mr = MODl + (size_t)tok_modrow(tb) * 6144;
        float rs[NR];
        { const f32x4v* q = (const f32x4v*)(p.XSS + (size_t)(tb + (li < NR ? li : 0)) * 16); const f32x4v a = q[0], b = q[1], c = q[2], d = q[3];
          const float ss = (((a.x + a.y) + (a.z + a.w)) + ((b.x + b.y) + (b.z + b.w))) + (((c.x + c.y) + (c.z + c.w)) + ((d.x + d.y) + (d.z + d.w)));
          const float r = rsqrtf(ss * (1.0f / D) + 1e-6f);
#pragma unroll
          for (int i = 0; i < NR; ++i) rs[i] = shl(r, i); }
        f32x4v acc[2]; acc[0] = (f32x4v){0.f, 0.f, 0.f, 0.f}; acc[1] = acc[0];
        u32x2v xq[NR];
#pragma unroll
        for (int i = 0; i < NR; ++i) xq[i] = *(const u32x2v*)(xrow(p, tb + i) + lane * 4);
#pragma unroll
        for (int kc = 0; kc < 4; ++kc) {
            const int kk = kc * 256 + lane * 4;
            const f32x4v gg = *(const f32x4v*)(g2 + kk), sh = *(const f32x4v*)(mr + 3 * 1024 + kk), sc = *(const f32x4v*)(mr + 4 * 1024 + kk);
            f32x4v gs;
#pragma unroll
            for (int j = 0; j < 4; ++j) gs[j] = gg[j] * (1.f + sc[j]);
#pragma unroll
            for (int i = 0; i < NR; ++i) { const u32x2v r = xq[i];
                const f32x4v xv = mkf4(__uint_as_float(r.x << 16), __uint_as_float(r.x & 0xffff0000u), __uint_as_float(r.y << 16), __uint_as_float(r.y & 0xffff0000u));
                const f32x4v h = xv * rs[i] * gs + sh; const u32x2v hb = pack4(h);
                *(unsigned*)((unsigned char*)p.H + (size_t)(tb + i) * D + kk) = pg8::pk4_fp8(h);
                *(LDSP u32x2v*)(HT + i * LDT + lane * 4) = hb; }
            if (kc < 3) {
#pragma unroll
                for (int i = 0; i < NR; ++i) xq[i] = *(const u32x2v*)(xrow(p, tb + i) + kk + 256); }
            asm volatile("s_waitcnt lgkmcnt(0)" ::: "memory");
#pragma unroll
            for (int ks = 0; ks < 8; ++ks) { const bf16x8v vfr = frag_row(HT, LDT, 0, 32 * ks, lane);
                acc[0] = mfma16(frag_row(WR, LDW, 0, kc * 256 + 32 * ks, lane), vfr, acc[0]);
                acc[1] = mfma16(frag_row(WR, LDW, 16, kc * 256 + 32 * ks, lane), vfr, acc[1]); }
            asm volatile("s_waitcnt lgkmcnt(0)" ::: "memory");
        }
        float bgs = -1e30f; int bgi = 0, e1 = 0, e2 = 0; float w1 = 0.f, w2 = 0.f;
#pragma unroll
        for (int ut = 0; ut < 2; ++ut) { const int gi = ut * 4 + G; float m1 = -1e30f, m2 = -1e30f, s1 = 0.f, s2 = 0.f; int i1 = 0, i2 = 0;
#pragma unroll
            for (int r = 0; r < 4; ++r) { const float sv = 1.0f / (1.0f + __expf(-acc[ut][r])), vv = sv + p.router_bias[gi * 4 + r];
                if (vv > m1) { m2 = m1; i2 = i1; s2 = s1; m1 = vv; i1 = gi * 4 + r; s1 = sv; } else if (vv > m2) { m2 = vv; i2 = gi * 4 + r; s2 = sv; } }
            if (m1 + m2 > bgs) { bgs = m1 + m2; bgi = gi; e1 = i1; e2 = i2; w1 = s1; w2 = s2; } }
#pragma unroll
        for (int o = 16; o <= 32; o <<= 1) {
            const float ogs = shx(bgs, o, lane), ow1 = shx(w1, o, lane), ow2 = shx(w2, o, lane); const int ogi = shxi(bgi, o, lane), oe1 = shxi(e1, o, lane), oe2 = shxi(e2, o, lane);
            if (ogs > bgs || (ogs == bgs && ogi < bgi)) { bgs = ogs; bgi = ogi; e1 = oe1; e2 = oe2; w1 = ow1; w2 = ow2; } }
        R.own = (G == 0 && li < NR); R.t = tb + li; R.e1 = e1; R.e2 = e2;
        if (R.own) { const float inv = 1.0f / (w1 + w2); p.EW[R.t * 2 + 0] = w1 * inv; p.EW[R.t * 2 + 1] = w2 * inv;
            R.r1 = __hip_atomic_fetch_add(&lcnt[e1], 1, __ATOMIC_RELAXED, __HIP_MEMORY_SCOPE_WORKGROUP); R.r2 = __hip_atomic_fetch_add(&lcnt[e2], 1, __ATOMIC_RELAXED, __HIP_MEMORY_SCOPE_WORKGROUP); }
}
DI void ph_normroute(const P& p, int l, int t0, LDSP unsigned char* lds) {
    const int tid_ = ltid(), lane = tid_ & 63, wv = tid_ >> 6, gw = blockIdx.x * NWV + wv, NW = gridDim.x * NWV, G = lane >> 4, li = lane & 15;
    const float* MODl = p.MOD + (size_t)l * 9 * 6144; int* counts = p.counts + l * 32 * 32;
    constexpr int LDW = 1032, LDT = 264;
    LDSP bf16_t* WR = (LDSP bf16_t*)lds;
    LDSP bf16_t* HT = WR + 32 * LDW + wv * 16 * LDT;
    { u32x4v wv_[8];
#pragma unroll
      for (int q = 0; q < 8; ++q) wv_[q] = *(const u32x4v*)(p.WRT + (size_t)(tid_ + q * NTHR) * 8);
#pragma unroll
      for (int q = 0; q < 8; ++q) { const int c = tid_ + q * NTHR; *(LDSP u32x4v*)(WR + (c >> 7) * LDW + (c & 127) * 8) = wv_[q]; } }
    __syncthreads();
    const float* g2 = p.norm2_g + l * D;
    const int ntok = T - t0, nfull = (ntok >> 4) / NW * NW, nrem = ntok - nfull * 16;
    LDSP int* lcnt = (LDSP int*)(WR + 32 * LDW + NWV * 16 * LDT);
    LDSP int* lbase = lcnt + 32;
    const int rf = (nfull + NW - 1) / NW, rr = (nrem + NW - 1) / NW;
    for (int rd = 0; rd < rf + rr; ++rd) {
        if (tid_ < 32) lcnt[tid_] = 0;
        __syncthreads();
        RouteR R; R.own = false; R.t = 0; R.e1 = 0; R.e2 = 0; R.r1 = 0; R.r2 = 0;
        if (rd < rf) { const int tile = rd * NW + gw; if (tile < nfull) normroute_tile<16>(p, t0 + tile * 16, MODl, lcnt, g2, WR, HT, lane, G, li, R); }
        else { const int e = (rd - rf) * NW + gw; if (e < nrem) normroute_tile<1>(p, t0 + nfull * 16 + e, MODl, lcnt, g2, WR, HT, lane, G, li, R); }
        __syncthreads();
        if (tid_ < 32) { const int c = lcnt[tid_]; lbase[tid_] = c > 0 ? atomicAdd(&counts[tid_ * 32], c) : 0; }
        __syncthreads();
        if (R.own) { const int r1 = lbase[R.e1] + R.r1, r2 = lbase[R.e2] + R.r2;
            p.MAP[(size_t)R.e1 * T + r1] = R.t; p.MAP[(size_t)R.e2 * T + r2] = R.t;
            *(int4*)(p.TOKSLOT + (size_t)R.t * 4) = make_int4(R.e1, r1, R.e2, r2); }
    }
}

DI void ph_combine(const P& p, int l, int t0, const unsigned char* Y  , LDSP int* ps  ) {
    const int tid_ = ltid(), lane = tid_ & 63, gw = blockIdx.x * NWV + __builtin_amdgcn_readfirstlane(tid_ >> 6)  , NW = gridDim.x * NWV;
    const float* MODl = p.MOD + (size_t)l * 9 * 6144; const int* counts = p.counts + l * 32 * 32;
    if (tid_ < 64) { const int cnt = tid_ < 32 ? counts[tid_ * 32] : 0; int pc = cnt;
#pragma unroll
        for (int o = 1; o < 32; o <<= 1) { const int src = lane >= o ? lane - o : lane; const int a = shli(pc, src); if (lane >= o) pc += a; }
        if (tid_ < 32) ps[tid_] = pc - cnt; }
    __syncthreads();
    for (int t = t0 + 4 * gw; t < T; t += 4 * NW) {
        int4 sl[4]; float4 ew[2];
#pragma unroll
        for (int u = 0; u < 4; ++u) sl[u] = *(const int4*)(p.TOKSLOT + (size_t)(t + u) * 4);
        ew[0] = *(const float4*)(p.EW + (size_t)t * 2); ew[1] = *(const float4*)(p.EW + (size_t)(t + 2) * 2);
        unsigned yr[4][2][4];
#pragma unroll
        for (int u = 0; u < 4; ++u) { const unsigned char* y0 = Y + (size_t)__builtin_amdgcn_readfirstlane(ps[sl[u].x] + sl[u].y) * D; const unsigned char* y1 = Y + (size_t)__builtin_amdgcn_readfirstlane(ps[sl[u].z] + sl[u].w) * D;
#pragma unroll
            for (int i = 0; i < 4; ++i) { yr[u][0][i] = *(const unsigned*)(y0 + (i * 64 + lane) * 4); yr[u][1][i] = *(const unsigned*)(y1 + (i * 64 + lane) * 4); } }
        const float* mrow = MODl + (size_t)tok_modrow(t) * 6144; const float* g5 = mrow + 5 * 1024;
        const float* mr1 = p.MOD + (size_t)9 * 6144 + (size_t)tok_modrow(t) * 6144;
#pragma unroll
        for (int pr = 0; pr < 2; ++pr) {
            const float wgt[2][2] = {{ew[pr].x, ew[pr].y}, {ew[pr].z, ew[pr].w}};
            u32x2v xr[2][4];
#pragma unroll
            for (int u = 0; u < 2; ++u)
#pragma unroll
                for (int i = 0; i < 4; ++i) xr[u][i] = *(const u32x2v*)(xrow(p, t + 2 * pr + u) + (i * 64 + lane) * 4);
            float4 v[2][4];
#pragma unroll
            for (int i = 0; i < 4; ++i) { const int c = (i * 64 + lane) * 4; const float4 gg = *(const float4*)(g5 + c);
#pragma unroll
                for (int u = 0; u < 2; ++u) { const u32x2v x = xr[u][i]; const int a = (int)yr[2 * pr + u][0][i], b = (int)yr[2 * pr + u][1][i]; const float w1 = wgt[u][0], w2 = wgt[u][1];
                    v[u][i].x = __uint_as_float(x.x << 16) + gg.x * (w1 * __builtin_amdgcn_cvt_f32_fp8(a, 0) + w2 * __builtin_amdgcn_cvt_f32_fp8(b, 0));
                    v[u][i].y = __uint_as_float(x.x & 0xffff0000u) + gg.y * (w1 * __builtin_amdgcn_cvt_f32_fp8(a, 1) + w2 * __builtin_amdgcn_cvt_f32_fp8(b, 1));
                    v[u][i].z = __uint_as_float(x.y << 16) + gg.z * (w1 * __builtin_amdgcn_cvt_f32_fp8(a, 2) + w2 * __builtin_amdgcn_cvt_f32_fp8(b, 2));
                    v[u][i].w = __uint_as_float(x.y & 0xffff0000u) + gg.w * (w1 * __builtin_amdgcn_cvt_f32_fp8(a, 3) + w2 * __builtin_amdgcn_cvt_f32_fp8(b, 3));
                    if (l == 0) *(u32x2v*)(xrow(p, t + 2 * pr + u) + c) = mk2(pk2(v[u][i].x, v[u][i].y), pk2(v[u][i].z, v[u][i].w)); } }
            float rstd[2];
#pragma unroll
            for (int u = 0; u < 2; ++u) { float ss = 0.f;
#pragma unroll
                for (int i = 0; i < 4; ++i) ss += v[u][i].x * v[u][i].x + v[u][i].y * v[u][i].y + v[u][i].z * v[u][i].z + v[u][i].w * v[u][i].w;
                rstd[u] = rsqrtf(wave_sum(ss, lane) * (1.0f / D) + 1e-6f); }
            if (l == 0) {
#pragma unroll
                for (int i = 0; i < 4; ++i) { const int c = (i * 64 + lane) * 4;
                    const float4 gg = *(const float4*)(p.norm1_g + D + c), sh = *(const float4*)(mr1 + c), sc = *(const float4*)(mr1 + 1024 + c);
#pragma unroll
                    for (int u = 0; u < 2; ++u) { const float r = rstd[u];
                        *(unsigned*)((unsigned char*)p.H + (size_t)(t + 2 * pr + u) * D + c) = pg8::pk4_fp8((pg8::f32x4){v[u][i].x * r * gg.x * (1.f + sc.x) + sh.x, v[u][i].y * r * gg.y * (1.f + sc.y) + sh.y, v[u][i].z * r * gg.z * (1.f + sc.z) + sh.z, v[u][i].w * r * gg.w * (1.f + sc.w) + sh.w}); } }
            } else {
#pragma unroll
                for (int u = 0; u < 2; ++u)
#pragma unroll
                    for (int i = 0; i < 4; ++i) { const float4 gg = ((const float4*)p.final_g)[i * 64 + lane]; const float r = rstd[u];
                        ((float4*)(p.out + (size_t)(t + 2 * pr + u - TC) * D))[i * 64 + lane] = make_float4(v[u][i].x * r * gg.x, v[u][i].y * r * gg.y, v[u][i].z * r * gg.z, v[u][i].w * r * gg.w); }
            }
        }
    }
}

#define XLAS __attribute__((address_space(3)))
#define XB_TMO      128
#define XB_XCNT(j)  (256  + 64 * (j))
#define XB_XSUB(j)  (1280 + 64 * (j))
#define XB_XGEN(j)  (2304 + 64 * (j))
#define XB_TOP      3328
#define XB_TOPGEN   3392
#define XCD_BAR_WORDS 3456
#define XB_SPIN_CAP (1u << 18)

__device__ __forceinline__ unsigned xb_ld(unsigned* p)              { return __hip_atomic_load(p, __ATOMIC_RELAXED, __HIP_MEMORY_SCOPE_AGENT); }
__device__ __forceinline__ unsigned xb_add(unsigned* p, unsigned v) { return __hip_atomic_fetch_add(p, v, __ATOMIC_RELAXED, __HIP_MEMORY_SCOPE_AGENT); }
__device__ __forceinline__ unsigned xb_xcc_id() { return (unsigned)__builtin_amdgcn_s_getreg((3 << 11) | 20) & 0xFu; }
#define XB_SPIN(cond, bar) do { unsigned _sp = 0; while (cond) { __builtin_amdgcn_s_sleep(1); \
    if ((++_sp & 255u) == 0u) { if (xb_ld(&(bar)[XB_TMO])) break; if (_sp > XB_SPIN_CAP) { atomicAdd(&(bar)[XB_TMO], 1u); break; } } } } while (0)

struct XcdBarrier {
    unsigned* bar; unsigned x;
    volatile XLAS unsigned* st;
};

__device__ __forceinline__ XcdBarrier xcd_barrier_post(unsigned* bar, volatile XLAS unsigned* st) {
    XcdBarrier b; b.bar = bar; b.x = xb_xcc_id(); b.st = st;
    if (ltid() == 0) (void)xb_add(&bar[XB_XCNT(b.x)], 1u);
    return b;
}
__device__ __forceinline__ void xcd_barrier_complete(unsigned* bar, unsigned x, unsigned& nloc, unsigned& nx) {
    const unsigned G = gridDim.x * gridDim.y * gridDim.z;
    unsigned sum, cnt, mine, sp = 0u;
    for (;;) {
        sum = 0u; cnt = 0u; mine = 0u;
#pragma unroll
        for (unsigned j = 0; j < 16; ++j) { const unsigned c = xb_ld(&bar[XB_XCNT(j)]); sum += c; cnt += (c > 0u) ? 1u : 0u; mine = (j == x) ? c : mine; }
        if (sum == G) break;
        __builtin_amdgcn_s_sleep(1);
        if ((++sp & 255u) == 0u) { if (xb_ld(&bar[XB_TMO])) break; if (sp > XB_SPIN_CAP) { atomicAdd(&bar[XB_TMO], 1u); break; } }
    }
    nloc = mine > 0u ? mine : 1u; nx = cnt > 0u ? cnt : 1u;
}

__device__ __forceinline__ void xcd_barrier(const XcdBarrier& b) {
    asm volatile("s_waitcnt vmcnt(0)" ::: "memory");
    __syncthreads();
    if (ltid() == 0) {
        unsigned* bar = b.bar;
        __builtin_amdgcn_s_waitcnt(0);
        unsigned nloc = b.st[0], nx = b.st[1];
        if (nloc == 0u) { xcd_barrier_complete(bar, b.x, nloc, nx); b.st[0] = nloc; b.st[1] = nx; }
        const unsigned old = xb_add(&bar[XB_XSUB(b.x)], 1u);
        const unsigned gen = old / nloc;
        if (old + 1u == (gen + 1u) * nloc) {
            __builtin_amdgcn_fence(__ATOMIC_RELEASE, "agent");
            asm volatile("s_waitcnt vmcnt(0)" ::: "memory");
            const unsigned og = xb_add(&bar[XB_TOP], 1u);
            const unsigned tg = og / nx;
            if (og + 1u == (tg + 1u) * nx) xb_add(&bar[XB_TOPGEN], 1u);
            else XB_SPIN(xb_ld(&bar[XB_TOPGEN]) == tg, bar);
            __builtin_amdgcn_fence(__ATOMIC_ACQUIRE, "agent");
            xb_add(&bar[XB_XGEN(b.x)], 1u);
            asm volatile("s_waitcnt vmcnt(0)" ::: "memory");
        } else {
            XB_SPIN(xb_ld(&bar[XB_XGEN(b.x)]) == gen, bar);
            __builtin_amdgcn_fence(__ATOMIC_ACQUIRE, "agent");
            asm volatile("s_waitcnt vmcnt(0)" ::: "memory");
        }
    }
    __syncthreads();
}

DI void moe_table(const P& p, int l, PG8_LAS int* tab) {
    const int tid_ = ltid();
    if (tid_ < 64) { const int cnt = tid_ < 32 ? p.counts[(l * 32 + tid_) * 32] : 0; const int nt = (cnt + 255) >> 8; int pt = nt, pc = cnt;
#pragma unroll
        for (int o = 1; o < 32; o <<= 1) { const int ln_ = tid_ & 63, src = ln_ >= o ? ln_ - o : ln_; const int a = shli(pt, src), b = shli(pc, src); if (ln_ >= o) { pt += a; pc += b; } }
        if (tid_ < 32) { tab[tid_ + 1] = pt; tab[33 + tid_] = cnt; tab[65 + tid_] = pc - cnt; if (tid_ == 0) tab[0] = 0; } }
    __syncthreads();
}
typedef const __attribute__((address_space(4))) P* PK;
DI PK lp(PK q) { asm volatile("" : "+s"(q)); return q; }
#define PHASE(...) do { const P p = *(const P*)lp(pk); __VA_ARGS__; } while (0)

#ifndef CV_L0
#define CV_L0 7
#endif
template <int l> DI void layer(PK pk, unsigned char* smem, const XcdBarrier& xbar) {
    float* ldsf = (float*)smem; const int gw = 0, NW = 0, lane = 0;
    {
        constexpr int NG = l == 0 ? 234 : 182;
        constexpr int CV1 = l == 0 ? CV_L0 * 768 : NE * 768;
        const int G = (int)gridDim.x == 256 ? NG : (int)gridDim.x;
        if ((int)blockIdx.x < G) PHASE({ pg8::Gemm g{p.H, (const bf16_t*)((const unsigned char*)p.WinT + (size_t)l * NPAD_IN * D), T, NPAD_IN, D / 2}; pg8::StaticOrder S; S.init(T, NPAD_IN, G, (int)blockIdx.x);
            pg8::EpiProj E{p.PROJ, LDP, INDIM, 1.0f / 64.0f};
            pg8::gemm_phase<pg8::EpiProj, pg8::StaticOrder, false, PG8_SP2, 1>((PG8_LAS unsigned char*)smem, g, S, E, nullptr); });
        else PHASE(ph_convert_experts(p, l, ldsf, G, (int)gridDim.x - G, 0, CV1));
        if ((int)gridDim.x != 256) PHASE(ph_convert_experts(p, l, ldsf, 0, (int)gridDim.x, 0, CV1));
    }
    xcd_barrier(xbar);
    PHASE(ph_prep(p, l, (LDSP unsigned char*)smem));
    xcd_barrier(xbar);
    PHASE(ph_s1(p, l, (LDSP unsigned char*)smem));
    xcd_barrier(xbar);
    PHASE(ph_s2(p));
    xcd_barrier(xbar);
    PHASE(ph_s3(p, l, (LDSP unsigned char*)smem));
    xcd_barrier(xbar);
    {
        constexpr int ro = l == 0 ? 0 : TC;
        constexpr int NG = l == 0 ? 182 : 256;
        const int G = (int)gridDim.x == 256 ? NG : (int)gridDim.x;
        if ((int)blockIdx.x < G) PHASE({ pg8::Gemm g{p.H + (size_t)ro * D, p.WoutT + (size_t)l * D * D, T - ro, D, D}; pg8::StaticOrder S; S.init(T - ro, D, G, (int)blockIdx.x);
            pg8::EpiResGate<l != 0> E{p.SSQ, p.ctx, p.x, p.XB, p.MOD + (size_t)l * 9 * 6144 + 2 * 1024, p.XSS, ro};
            pg8::gemm_phase<pg8::EpiResGate<l != 0>, pg8::StaticOrder>((PG8_LAS unsigned char*)smem, g, S, E, nullptr); });
        else if (l == 0) PHASE(ph_convert_experts(p, l, ldsf, G, (int)gridDim.x - G, CV_L0 * 768, NE * 768));
        if (l == 0 && (int)gridDim.x != 256) PHASE(ph_convert_experts(p, l, ldsf, 0, (int)gridDim.x, CV_L0 * 768, NE * 768));
    }
    xcd_barrier(xbar);
    const int t0 = l == 0 ? 0 : TC;
    PHASE(ph_normroute(p, l, t0, (LDSP unsigned char*)smem));
    xcd_barrier(xbar);
    PG8_LAS int* tab = (PG8_LAS int*)((PG8_LAS unsigned char*)smem + pg8::STAGE_BYTES);
#pragma unroll
    for (int ph = 0; ph < 2; ++ph) {
        PHASE(moe_table(p, l, tab));
        const int U = __builtin_amdgcn_readfirstlane(tab[32]) * 4;
        if (ph == 0) PHASE({ pg8::Gemm g{p.H, p.WguT, T, D, D / 2}; pg8::MoeSched S{tab, p.MAP, U, (int)gridDim.x, (int)blockIdx.x, 4, 1, (size_t)D * D};
            pg8::EpiAct E{(unsigned char*)p.SS}; pg8::gemm_phase_moe<pg8::EpiAct, pg8::MoeSched, false, PG8_SP2, 1>((PG8_LAS unsigned char*)smem, g, S, E, nullptr); });
        else PHASE({ pg8::Gemm g{p.SS, p.WdT, T, D, 256}; pg8::MoeSched S{tab, p.MAP, U, (int)gridDim.x, (int)blockIdx.x, 4, 0, (size_t)D * 512};
            pg8::EpiY E{(unsigned char*)p.PROJ}; pg8::gemm_phase_moe<pg8::EpiY, pg8::MoeSched, false, PG8_SP2, 1>((PG8_LAS unsigned char*)smem, g, S, E, nullptr); });
        xcd_barrier(xbar);
    }
    PHASE(ph_combine(p, l, t0, (const unsigned char*)p.PROJ, (LDSP int*)smem));
    xcd_barrier(xbar);
}

__global__ void __launch_bounds__(NTHR) mega(P p_arg) {
    extern __shared__ __attribute__((aligned(16))) unsigned char smem[];
    cg::grid_group grid = cg::this_grid();
    PK pk = (PK)__builtin_amdgcn_kernarg_segment_ptr();
    const int lane = 0, gw = 0, NW = 0;
    float* ldsf = (float*)smem;
    volatile XLAS unsigned* bst = (volatile XLAS unsigned*)((XLAS unsigned char*)smem + LDS_BYTES - 16);
    { const int t_ = ltid(); if (t_ < 2) bst[t_] = 0u; }
    __syncthreads();
    const XcdBarrier xbar = xcd_barrier_post(pk->BAR, bst);
    PHASE(ph_init(p)); PHASE(ph_mod(p, ldsf)); PHASE(ph_convert_small(p, ldsf, gw, NW, lane));
    if (__builtin_expect(pk->BAR == nullptr, 0)) grid.sync();
    xcd_barrier(xbar);
    PHASE(ph_normmod1(p, 0, gw, NW, lane));
    xcd_barrier(xbar);
    layer<0>(pk, smem, xbar);
    layer<1>(pk, smem, xbar);
}

static inline size_t al(size_t x) { return (x + 255) & ~(size_t)255; }

extern "C" void kernel_launch(void* const* d_in, const int* in_sizes, int n_in, void* d_out, int out_size, void* d_ws, size_t ws_size, hipStream_t stream) {
    static int grid_blocks = 0;
    if (grid_blocks == 0) {
        int dev = 0, cus = 0, per_cu = 0;
        if (hipFuncSetAttribute((const void*)mega, hipFuncAttributeMaxDynamicSharedMemorySize, LDS_BYTES) != hipSuccess) { fprintf(stderr, "hipFuncSetAttribute failed\n"); grid_blocks = -1; return; }
        (void)hipGetDevice(&dev); (void)hipDeviceGetAttribute(&cus, hipDeviceAttributeMultiprocessorCount, dev);
        if (hipOccupancyMaxActiveBlocksPerMultiprocessor(&per_cu, (const void*)mega, NTHR, LDS_BYTES) != hipSuccess || per_cu < 1) { fprintf(stderr, "occupancy query: %d blocks/CU\n", per_cu); grid_blocks = -1; return; }
        grid_blocks = cus;
    }
    if (grid_blocks < 0) return;
    P p{};
    const float** pin = (const float**)&p;
    for (int i = 0; i < 29; ++i) pin[i] = (const float*)d_in[i];
    p.out = (float*)d_out;
    char* ws = (char*)d_ws; size_t off = 0;
    auto take = [&](size_t bytes) { char* q = ws + off; off += al(bytes); return q; };
    p.XB = (bf16_t*)take((size_t)T * D * 2);
    p.H = (bf16_t*)take((size_t)T * D * 2);
    p.PROJ = (bf16_t*)take((size_t)T * LDP * 2);
    p.SS = (bf16_t*)take((size_t)NTILE * 8 * 2 * 4096 * 2);
    p.GS = (bf16_t*)take((size_t)NTILE * 4 * 2 * 8192 * 2);
    p.SDEC = (float*)take((size_t)NTILE * 8 * 2 * 4);
    p.GDEC = (float*)take((size_t)NTILE * 4 * 2 * 64 * 4);
    p.MOD = (float*)take((size_t)2 * 9 * 6144 * 4);
    p.counts = (int*)take(64 * 32 * 4);
    p.TOKSLOT = (int*)take((size_t)T * 4 * 4);
    p.EW = (float*)take((size_t)T * 2 * 4);
    p.MAP = (int*)take((size_t)NE * T * 4);
    p.WinT = (bf16_t*)take((size_t)2 * NPAD_IN * D * 2);
    p.WoutT = (bf16_t*)take((size_t)2 * D * D * 2);
    p.WguT = (bf16_t*)take((size_t)NE * D * D * 2);
    p.WdT = (bf16_t*)take((size_t)NE * D * 512 * 2);
    p.WRT = (bf16_t*)take((size_t)32 * 1024 * 2);
    p.BAR = (unsigned*)take(XCD_BAR_WORDS * 4);
    p.XBCC = (bf16_t*)d_out;
    p.QKB = (bf16_t*)d_out + (size_t)T * 768;
    p.SSC = (float*)take((size_t)T * 8 * 4 * 4);
    p.STOT = (float*)take((size_t)NTILE * 8 * 2 * 4);
    p.SSQ = (float*)take((size_t)T * 8 * 4);
    p.XSS = (float*)take((size_t)T * 16 * 4);
    if (off > ws_size) { fprintf(stderr, "workspace too small: need %zu have %zu\n", off, ws_size); return; }
    if (hipMemsetAsync(p.BAR, 0, XCD_BAR_WORDS * 4, stream) != hipSuccess) { fprintf(stderr, "memset of barrier words failed\n"); return; }
    void* args[] = {&p};
    hipError_t e = hipLaunchCooperativeKernel((void*)mega, dim3(grid_blocks), dim3(NTHR), args, LDS_BYTES, stream);
    if (e != hipSuccess) fprintf(stderr, "cooperative launch failed: %s (grid %d)\n", hipGetErrorString(e), grid_blocks);
}
```

```cpp
#include <hip/hip_runtime.h>
#include <hip/hip_cooperative_groups.h>
#include <stdint.h>
#include <cstdio>
namespace cg = cooperative_groups;

typedef unsigned short bf16_t;
#define DI __device__ __forceinline__

constexpr int D = 1024, NB = 8, SEQ = 4096, CTXL = 256, TC = NB * CTXL, TL = NB * SEQ, T = TC + TL;
constexpr int INDIM = 2840, LDP = 2848;
constexpr int OFF_Z = 0, OFF_XBC = 512, OFF_DT = 1280, OFF_Q = 1288, OFF_K = 1544, OFF_V = 1800, OFF_GO = 2312, OFF_GK = 2824;
constexpr int NE = 32;

DI float bf2f(bf16_t v) { return __uint_as_float(((unsigned)v) << 16); }
typedef float f32x2v_ __attribute__((ext_vector_type(2)));
typedef __bf16 bf16x2v_ __attribute__((ext_vector_type(2)));
DI bf16_t f2bf(float f) { return __builtin_bit_cast(unsigned short, (__bf16)f); }
DI float siluf(float x) { return x * __builtin_amdgcn_rcpf(1.0f + __builtin_amdgcn_exp2f(-1.4426950408889634f * x)); }
DI float softplusf(float x) { return fmaxf(x, 0.f) + log1pf(__expf(-fabsf(x))); }
DI float logsigmoidf(float x) { return -softplusf(-x); }
DI float shx(float v, int o, int lane) { return __int_as_float(__builtin_amdgcn_ds_bpermute((lane ^ o) << 2, __float_as_int(v))); }
DI int shxi(int v, int o, int lane) { return __builtin_amdgcn_ds_bpermute((lane ^ o) << 2, v); }
DI float shl(float v, int src) { return __int_as_float(__builtin_amdgcn_ds_bpermute(src << 2, __float_as_int(v))); }
DI int shli(int v, int src) { return __builtin_amdgcn_ds_bpermute(src << 2, v); }
DI float wave_sum(float v, int lane) {
#pragma unroll
    for (int o = 32; o >= 1; o >>= 1) v += shx(v, o, lane);
    return v;
}
DI int ltid() { const int wv = __builtin_amdgcn_readfirstlane(threadIdx.x >> 6);
    int ln; asm volatile("v_mbcnt_lo_u32_b32 %0, -1, 0\n\tv_mbcnt_hi_u32_b32 %0, -1, %0" : "=v"(ln));
    return wv * 64 + ln; }
DI int tok_modrow(int t) { return t < TC ? 8 : ((t - TC) >> 12); }
template <class PT> DI bf16_t* xrow(const PT& p, int t) { return p.XB + (size_t)t * D; }


#ifndef PG8_SP2
#define PG8_SP2 true
#endif
namespace pg8 {
#define PG8_LAS __attribute__((address_space(3)))
typedef unsigned short bf16_t;
typedef short bf16x8 __attribute__((ext_vector_type(8)));
typedef float f32x4 __attribute__((ext_vector_type(4)));
typedef unsigned u32x4 __attribute__((ext_vector_type(4)));
constexpr int BM = 256, BK = 64, HALF = 128, HTB = HALF * BK * 2  , STAGE_BYTES = 8 * HTB, NXCD = 8, WGM = 8;

__host__ __device__ __forceinline__ int lds_byte(int r, int c) { const int st = (r >> 4) * 2 + (c >> 5), rr = r & 15, cc = c & 31, ob = rr * 64 + cc * 2; return st * 1024 + (ob ^ (((ob >> 9) & 1) << 5)); }
__host__ __device__ __forceinline__ void stage_rc(int b, int& R, int& C) { const int st = b / 1024, sb = b % 1024, swz = sb ^ (((sb >> 9) & 1) << 5); R = (st >> 1) * 16 + swz / 64; C = (st & 1) * 32 + (swz % 64) / 2; }
__host__ __device__ __forceinline__ int perm32(int rho) { const int n = rho >> 4, i = rho & 15; return 8 * (i >> 2) + 4 * n + (i & 3); }

struct Unit { int pm, pn; };
struct Gemm { const bf16_t* A; const bf16_t* Bt; int M, N, K; };

struct StaticOrder {
    int nM, nN, nwg, G, c;
    __host__ __device__ void init(int M, int N, int G_, int c_) { nM = M / BM; nN = N / BM; nwg = nM * nN; G = G_; c = c_; }
    __host__ __device__ bool next(int i, Unit& u) const {
        const long L = (long)i * G + c; if (L >= nwg) return false;
        int wgid = (int)L; { const int q = nwg / NXCD, r = nwg % NXCD, xcd = wgid % NXCD, off = wgid / NXCD; wgid = (xcd < r ? xcd * (q + 1) : r * (q + 1) + (xcd - r) * q) + off; }
        const int nig = WGM * nN, gid = wgid / nig, fm = gid * WGM, gsz = (nM - fm) < WGM ? (nM - fm) : WGM;
        u.pm = fm + ((wgid % nig) % gsz); u.pn = (wgid % nig) / gsz; return true;
    }
    __device__ __forceinline__ void a_ready(const Unit&) const {}
    __device__ __forceinline__ void done(const Unit&) const {}
};
__device__ __forceinline__ unsigned cvt_pk_bf16(float lo, float hi) { unsigned r; asm volatile("v_cvt_pk_bf16_f32 %0, %1, %2" : "=v"(r) : "v"(lo), "v"(hi)); return r; }
typedef float f32x2 __attribute__((ext_vector_type(2)));

typedef int i32x4 __attribute__((ext_vector_type(4)));
typedef int i32x8 __attribute__((ext_vector_type(8)));
__device__ __forceinline__ i32x8 cat8(bf16x8 a, bf16x8 b) { return __builtin_shufflevector(__builtin_bit_cast(i32x4, a), __builtin_bit_cast(i32x4, b), 0, 1, 2, 3, 4, 5, 6, 7); }
__device__ __forceinline__ void mfma8(f32x4& c, i32x8 a, i32x8 b) { asm volatile("v_mfma_f32_16x16x128_f8f6f4 %0, %1, %2, %0" : "+v"(c) : "v"(a), "v"(b)); }
__device__ __forceinline__ unsigned pk4_fp8(const f32x4 v) { const float lim = 440.f;
    int w = __builtin_amdgcn_cvt_pk_fp8_f32(__builtin_amdgcn_fmed3f(v[0], -lim, lim), __builtin_amdgcn_fmed3f(v[1], -lim, lim), 0, false);
    return (unsigned)__builtin_amdgcn_cvt_pk_fp8_f32(__builtin_amdgcn_fmed3f(v[2], -lim, lim), __builtin_amdgcn_fmed3f(v[3], -lim, lim), w, true); }
struct EpiProj {
    static constexpr bool PERM = true, AFTER_DRAIN = false, MIDK = false;
    bf16_t* O; int ldc; int ncols; float osc;
    __device__ __forceinline__ void operator()(const f32x4 (&acc)[2][2][4][2], const Unit& u, int wr, int wc, int fr, int fq) const {
        const int row0 = u.pm * BM + wr * 64 + fr, col0 = u.pn * BM + wc * 32 + 8 * fq;
#pragma unroll
        for (int ai = 0; ai < 2; ++ai)
#pragma unroll
            for (int m = 0; m < 4; ++m) { bf16_t* rowp = O + (size_t)(row0 + ai * HALF + m * 16) * ldc + col0;
#pragma unroll
                for (int bj = 0; bj < 2; ++bj) { const f32x4 v0 = acc[ai][bj][m][0] * osc, v1 = acc[ai][bj][m][1] * osc;
                    u32x4 w; w.x = cvt_pk_bf16(v0[0], v0[1]); w.y = cvt_pk_bf16(v0[2], v0[3]); w.z = cvt_pk_bf16(v1[0], v1[1]); w.w = cvt_pk_bf16(v1[2], v1[3]);
                    if (col0 + bj * HALF + 8 <= ncols) *(u32x4*)(rowp + bj * HALF) = w; } }
    }
};
template <bool SRC_BF16> struct EpiResGate {
    static constexpr bool PERM = true, AFTER_DRAIN = false, MIDK = true;
    const float* ssq;
    const float* Sc; const float* Sl;
    bf16_t* XB;
    const float* gate_rows; float* xss; int rowoff;
    template <class Sched> __device__ __forceinline__ void prep(PG8_LAS unsigned char* lds, const Sched& S, int tid) const {
        PG8_LAS float* RS = (PG8_LAS float*)(lds + STAGE_BYTES);
        const int r = tid & 255, i0 = tid >> 8;
        for (int i = i0; ; i += 2) { Unit u; if (!S.next(i, u)) break;
            const f32x4* q = (const f32x4*)(ssq + (size_t)(rowoff + u.pm * BM + r) * 8); const f32x4 a = q[0], b = q[1];
            RS[i * 256 + r] = __builtin_amdgcn_rsqf((((a[0] + a[1]) + (a[2] + a[3])) + ((b[0] + b[1]) + (b[2] + b[3]))) * (1.0f / 512.0f) + 1e-6f); }
    }
    __device__ __forceinline__ void midk(f32x4 (&acc)[2][2][4][2], PG8_LAS unsigned char* lds, int ui, int wr, int fr) const {
        int fr_ = fr; asm volatile("" : "+v"(fr_));
        PG8_LAS const float* RS = (PG8_LAS const float*)(lds + STAGE_BYTES) + ui * 256 + wr * 64 + fr_;
#pragma unroll
        for (int ai = 0; ai < 2; ++ai)
#pragma unroll
            for (int m = 0; m < 4; ++m) { const float rs = RS[ai * HALF + m * 16];
#pragma unroll
                for (int bj = 0; bj < 2; ++bj)
#pragma unroll
                    for (int n = 0; n < 2; ++n) acc[ai][bj][m][n] *= rs; }
    }
    __device__ __forceinline__ void operator()(const f32x4 (&acc)[2][2][4][2], const Unit& u, int wr, int wc, int fr, int fq) const {
        const int row0 = rowoff + u.pm * BM + wr * 64 + fr, col0 = u.pn * BM + wc * 32 + 8 * fq;
        const int t0 = rowoff + u.pm * BM; const int mrow = t0 < 2048 ? 8 : ((t0 - 2048) >> 12);
        const float* gr = gate_rows + (size_t)mrow * 6144 + col0;
        f32x4 gv[2][2];
#pragma unroll
        for (int bj = 0; bj < 2; ++bj)
#pragma unroll
            for (int n = 0; n < 2; ++n) gv[bj][n] = *(const f32x4*)(gr + bj * HALF + n * 4);
#pragma unroll
        for (int ai = 0; ai < 2; ++ai) {
            u32x4 rb[4][2]; f32x4 xf[SRC_BF16 ? 1 : 4][2][2];
#pragma unroll
            for (int m = 0; m < 4; ++m) { const int rr = row0 + ai * HALF + m * 16;
                const float* sp = (rr < 2048 ? Sc + (size_t)rr * 1024 : Sl + (size_t)(rr - 2048) * 1024) + col0; const bf16_t* dp = XB + (size_t)rr * 1024 + col0;
#pragma unroll
                for (int bj = 0; bj < 2; ++bj) {
                    if (SRC_BF16) rb[m][bj] = *(const u32x4*)(dp + bj * HALF);
                    else { xf[SRC_BF16 ? 0 : m][bj][0] = *(const f32x4*)(sp + bj * HALF); xf[SRC_BF16 ? 0 : m][bj][1] = *(const f32x4*)(sp + bj * HALF + 4); } } }
#pragma unroll
            for (int m = 0; m < 4; ++m) { const int rr = row0 + ai * HALF + m * 16;
                bf16_t* dp = XB + (size_t)rr * 1024 + col0; float ss = 0.f;
#pragma unroll
                for (int bj = 0; bj < 2; ++bj) { f32x4 x0, x1;
                    if (SRC_BF16) { const u32x4 r = rb[m][bj];
                        x0 = (f32x4){__uint_as_float(r.x << 16), __uint_as_float(r.x & 0xffff0000u), __uint_as_float(r.y << 16), __uint_as_float(r.y & 0xffff0000u)};
                        x1 = (f32x4){__uint_as_float(r.z << 16), __uint_as_float(r.z & 0xffff0000u), __uint_as_float(r.w << 16), __uint_as_float(r.w & 0xffff0000u)}; }
                    else { x0 = xf[SRC_BF16 ? 0 : m][bj][0]; x1 = xf[SRC_BF16 ? 0 : m][bj][1]; }
                    const f32x4 v0 = x0 + gv[bj][0] * acc[ai][bj][m][0], v1 = x1 + gv[bj][1] * acc[ai][bj][m][1];
                    u32x4 w; w.x = cvt_pk_bf16(v0[0], v0[1]); w.y = cvt_pk_bf16(v0[2], v0[3]); w.z = cvt_pk_bf16(v1[0], v1[1]); w.w = cvt_pk_bf16(v1[2], v1[3]);
                    *(u32x4*)(dp + bj * HALF) = w;
#pragma unroll
                    for (int j = 0; j < 4; ++j) { const float lo = __uint_as_float(w[j] << 16), hi = __uint_as_float(w[j] & 0xffff0000u); ss += lo * lo + hi * hi; } }
                { const int ln_ = fq * 16 + fr; ss += __int_as_float(__builtin_amdgcn_ds_bpermute((ln_ ^ 16) << 2, __float_as_int(ss))); ss += __int_as_float(__builtin_amdgcn_ds_bpermute((ln_ ^ 32) << 2, __float_as_int(ss))); }
                if (fq == 0) xss[(size_t)rr * 16 + u.pn * 4 + wc] = ss; }
        }
    }
};
template <class Epi, class Sched, bool STAMP = false, bool SP2 = PG8_SP2, int SCW = -1>
__device__ __forceinline__ void gemm_phase(PG8_LAS unsigned char* lds, const Gemm g, const Sched& S, const Epi& E, unsigned long long* stamps) {
    int tid_l = __builtin_amdgcn_readfirstlane(threadIdx.x >> 6) * 64 + (int)__builtin_amdgcn_mbcnt_hi(~0u, __builtin_amdgcn_mbcnt_lo(~0u, 0u)); asm volatile("" : "+v"(tid_l));
    const int tid = tid_l, wid = __builtin_amdgcn_readfirstlane(tid >> 6), lane = tid & 63, wr = wid >> 2, wc = wid & 3, fr = lane & 15, fq = lane >> 4;
    const int K = g.K, nt = K / BK;
    int ts_lo = 0, ts_hi = 0, nts = 0; const unsigned long long rt_entry = STAMP ? (unsigned long long)wall_clock64() : 0ull;
#define PG8_STAMP() do { if (STAMP && wid == 0 && nts < 64) { const unsigned long long _c = (unsigned long long)clock64(); \
        ts_lo = (lane == nts) ? (int)(unsigned)_c : ts_lo; ts_hi = (lane == nts) ? (int)(unsigned)(_c >> 32) : ts_hi; ++nts; } } while (0)
    PG8_STAMP();
    unsigned voffA[2], voffB[2];
#pragma unroll
    for (int i = 0; i < 2; ++i) { int R, C; stage_rc(tid * 16 + i * 8192, R, C); const int Rb = Epi::PERM ? ((R & ~31) + perm32(R & 31)) : R;
        voffA[i] = (unsigned)(R * K + C) * 2u; voffB[i] = (unsigned)(Rb * K + C) * 2u; }
    const size_t kstep = (size_t)(BK * 2);
    const size_t hstep = (size_t)HALF * K * 2;
    const size_t tstep = 2 * hstep;
    const unsigned ldsw = (unsigned)wid * 1024u;
    const int aoff = lds_byte(wr * 64 + fr, fq * 8), boff = lds_byte(wc * 32 + fr, fq * 8);
#define PG8_SA(b, h) (((b) * 2 + (h)) * HTB)
#define PG8_SB(b, h) ((4 + (b) * 2 + (h)) * HTB)
#define PG8_STAGE(bufoff, gbase, voff) do { _Pragma("unroll") for (int _i = 0; _i < 2; ++_i) \
        __builtin_amdgcn_global_load_lds((const unsigned*)((const char*)(gbase) + (voff)[_i]), (PG8_LAS unsigned*)(lds + (bufoff) + ldsw + _i * 8192), 16, 0, 0); } while (0)
#define PG8_LDA(dst, b, h) do { _Pragma("unroll") for (int m = 0; m < 4; ++m) _Pragma("unroll") for (int k = 0; k < 2; ++k) dst[m][k] = *(const PG8_LAS bf16x8*)(lds + PG8_SA(b, h) + aoff + m * 2048 + k * 1024); } while (0)
#define PG8_LDB(dst, b, h) do { _Pragma("unroll") for (int n = 0; n < 2; ++n) _Pragma("unroll") for (int k = 0; k < 2; ++k) dst[n][k] = *(const PG8_LAS bf16x8*)(lds + PG8_SB(b, h) + boff + n * 2048 + k * 1024); } while (0)
#define PG8_MMA(ai, bj, At, Bt) do { __builtin_amdgcn_s_setprio(1); _Pragma("unroll") for (int m = 0; m < 4; ++m) _Pragma("unroll") for (int n = 0; n < 2; ++n) { \
        if constexpr (SCW >= 0) mfma8(acc[ai][bj][m][n], cat8(Bt[n][0], Bt[n][1]), cat8(At[m][0], At[m][1])); \
        else { _Pragma("unroll") for (int k = 0; k < 2; ++k) acc[ai][bj][m][n] = __builtin_amdgcn_mfma_f32_16x16x32_bf16(Bt[n][k], At[m][k], acc[ai][bj][m][n], 0, 0, 0); } } __builtin_amdgcn_s_setprio(0); } while (0)
#define PG8_WAIT_V(n) asm volatile("s_waitcnt vmcnt(" #n ")" ::: "memory")
#define PG8_WAIT_L(n) asm volatile("s_waitcnt lgkmcnt(" #n ")" ::: "memory")
#define PG8_BAR __builtin_amdgcn_s_barrier()
#define PG8_SCHED __builtin_amdgcn_sched_barrier(0)
    Unit cur, nxt; int ui = 0;
    if (!S.next(0, cur)) return;
    f32x4 acc[2][2][4][2];
#pragma unroll
    for (int a = 0; a < 2; ++a)
#pragma unroll
        for (int b = 0; b < 2; ++b)
#pragma unroll
            for (int m = 0; m < 4; ++m)
#pragma unroll
                for (int n = 0; n < 2; ++n) acc[a][b][m][n] = (f32x4){0.f, 0.f, 0.f, 0.f};
    bf16x8 At[4][2], B0[2][2], B1[2][2];
    const char* cA = (const char*)g.A + (size_t)cur.pm * tstep; const char* cB = (const char*)g.Bt + (size_t)cur.pn * tstep;
    S.a_ready(cur);
    if constexpr (Epi::MIDK) E.prep(lds, S, tid);
    if constexpr (SP2) {
        PG8_STAGE(PG8_SB(0, 0), cB, voffB); PG8_STAGE(PG8_SB(0, 1), cB + hstep, voffB); PG8_STAGE(PG8_SA(0, 0), cA, voffA); PG8_STAGE(PG8_SA(0, 1), cA + hstep, voffA);
        if (wr == 1) PG8_BAR;
        PG8_WAIT_V(2); PG8_BAR;
        PG8_STAGE(PG8_SB(1, 0), cB + kstep, voffB); PG8_STAGE(PG8_SA(1, 0), cA + kstep, voffA); PG8_STAGE(PG8_SB(1, 1), cB + hstep + kstep, voffB);
        PG8_WAIT_V(6); PG8_BAR;
    } else {
    PG8_STAGE(PG8_SB(0, 0), cB, voffB); PG8_STAGE(PG8_SA(0, 0), cA, voffA); PG8_STAGE(PG8_SB(0, 1), cB + hstep, voffB); PG8_STAGE(PG8_SA(0, 1), cA + hstep, voffA);
    if (wr == 1) PG8_BAR;
    PG8_WAIT_V(4); PG8_BAR;
    PG8_STAGE(PG8_SB(1, 0), cB + kstep, voffB); PG8_STAGE(PG8_SA(1, 0), cA + kstep, voffA); PG8_STAGE(PG8_SB(1, 1), cB + hstep + kstep, voffB);
    PG8_WAIT_V(6); PG8_BAR;
    }
    PG8_STAMP();
    for (;;) {
        const bool has_next = S.next(ui + 1, nxt);
        const char* nA = has_next ? (const char*)g.A + (size_t)nxt.pm * tstep : cA; const char* nB = has_next ? (const char*)g.Bt + (size_t)nxt.pn * tstep : cB;
        for (int t = 0; t < nt; t += 2) {
            const bool last = (t == nt - 2);
            const char* a1 = cA + (size_t)(t + 1) * kstep;
            const char* a2 = last ? nA : cA + (size_t)(t + 2) * kstep; const char* b2 = last ? nB : cB + (size_t)(t + 2) * kstep;
            const char* a3 = a2 + kstep; const char* b3 = b2 + kstep;
            if (last && has_next) S.a_ready(nxt);
            if constexpr (SP2) {
            PG8_LDB(B0, 0, 0); PG8_LDB(B1, 0, 1); PG8_SCHED; PG8_LDA(At, 0, 0); PG8_STAGE(PG8_SA(1, 1), a1 + hstep, voffA);
            PG8_WAIT_V(8); PG8_WAIT_L(0); PG8_BAR; PG8_MMA(0, 0, At, B0); PG8_MMA(0, 1, At, B1); PG8_BAR; PG8_SCHED;
            PG8_LDA(At, 0, 1); PG8_STAGE(PG8_SB(0, 0), b2, voffB); PG8_STAGE(PG8_SB(0, 1), b2 + hstep, voffB); PG8_STAGE(PG8_SA(0, 0), a2, voffA);
            PG8_WAIT_V(8); PG8_WAIT_L(0); PG8_BAR; PG8_MMA(1, 0, At, B0); PG8_MMA(1, 1, At, B1); PG8_BAR; PG8_SCHED;
            PG8_LDB(B0, 1, 0); PG8_LDB(B1, 1, 1); PG8_SCHED; PG8_LDA(At, 1, 0); PG8_STAGE(PG8_SA(0, 1), a2 + hstep, voffA);
            PG8_WAIT_V(8); PG8_WAIT_L(0); PG8_BAR; PG8_MMA(0, 0, At, B0); PG8_MMA(0, 1, At, B1); PG8_BAR; PG8_SCHED;
            PG8_LDA(At, 1, 1); PG8_STAGE(PG8_SB(1, 0), b3, voffB); PG8_STAGE(PG8_SB(1, 1), b3 + hstep, voffB); PG8_STAGE(PG8_SA(1, 0), a3, voffA);
            PG8_WAIT_V(8); PG8_WAIT_L(0); PG8_BAR; PG8_MMA(1, 0, At, B0); PG8_MMA(1, 1, At, B1); PG8_BAR; PG8_SCHED;
            } else {
            PG8_LDB(B0, 0, 0); PG8_SCHED; PG8_LDA(At, 0, 0); PG8_STAGE(PG8_SA(1, 1), a1 + hstep, voffA);
            PG8_WAIT_L(8); PG8_BAR; PG8_WAIT_L(0); PG8_MMA(0, 0, At, B0); PG8_BAR; PG8_SCHED;
            PG8_LDB(B1, 0, 1); PG8_STAGE(PG8_SB(0, 0), b2, voffB);
            PG8_BAR; PG8_WAIT_L(0); PG8_MMA(0, 1, At, B1); PG8_BAR;
            PG8_LDA(At, 0, 1); PG8_STAGE(PG8_SA(0, 0), a2, voffA);
            PG8_BAR; PG8_WAIT_L(0); PG8_MMA(1, 0, At, B0); PG8_BAR; PG8_SCHED;
            PG8_STAGE(PG8_SB(0, 1), b2 + hstep, voffB);
            PG8_WAIT_V(6); PG8_BAR; PG8_MMA(1, 1, At, B1); PG8_BAR;
            PG8_LDB(B0, 1, 0); PG8_SCHED; PG8_LDA(At, 1, 0); PG8_STAGE(PG8_SA(0, 1), a2 + hstep, voffA);
            PG8_WAIT_L(8); PG8_BAR; PG8_WAIT_L(0); PG8_MMA(0, 0, At, B0); PG8_BAR; PG8_SCHED;
            PG8_LDB(B1, 1, 1); PG8_STAGE(PG8_SB(1, 0), b3, voffB);
            PG8_BAR; PG8_WAIT_L(0); PG8_MMA(0, 1, At, B1); PG8_BAR;
            PG8_LDA(At, 1, 1); PG8_STAGE(PG8_SA(1, 0), a3, voffA);
            PG8_BAR; PG8_WAIT_L(0); PG8_MMA(1, 0, At, B0); PG8_BAR; PG8_SCHED;
            PG8_STAGE(PG8_SB(1, 1), b3 + hstep, voffB);
            PG8_WAIT_V(6); PG8_BAR; PG8_MMA(1, 1, At, B1); PG8_BAR;
            }
            if constexpr (Epi::MIDK) { if (t + 2 == nt / 2) E.midk(acc, lds, ui, wr, fr); }
        }
        PG8_STAMP();
        if (wr == 0) PG8_BAR;
        if constexpr (SCW >= 0) asm volatile("s_nop 15\n\ts_nop 15" ::: "memory");
        if constexpr (!Epi::AFTER_DRAIN) { E(acc, cur, wr, wc, fr, fq); S.done(cur); }
        PG8_STAMP();
        if (!has_next) break;
#pragma unroll
        for (int a = 0; a < 2; ++a)
#pragma unroll
            for (int b = 0; b < 2; ++b)
#pragma unroll
                for (int m = 0; m < 4; ++m)
#pragma unroll
                    for (int n = 0; n < 2; ++n) acc[a][b][m][n] = (f32x4){0.f, 0.f, 0.f, 0.f};
        cur = nxt; cA = nA; cB = nB; ++ui;
        if (wr == 1) PG8_BAR;
    }
    PG8_WAIT_V(0);
    PG8_BAR;
    if constexpr (Epi::AFTER_DRAIN) { E.fused(acc, cur, wr, wc, fr, fq, lds, wid, lane); S.done(cur); }
    PG8_STAMP();
    if (STAMP && wid == 0) { stamps[lane] = lane < nts ? (((unsigned long long)(unsigned)ts_hi << 32) | (unsigned)ts_lo) : 0ull;
        if (lane == 62) stamps[62] = rt_entry; if (lane == 63) stamps[63] = (unsigned long long)wall_clock64(); }
#undef PG8_STAMP
#undef PG8_SA
#undef PG8_SB
#undef PG8_STAGE
#undef PG8_LDA
#undef PG8_LDB
#undef PG8_MMA
#undef PG8_WAIT_V
#undef PG8_WAIT_L
#undef PG8_BAR
#undef PG8_SCHED
}

struct MoeUnit { int e, mt, pn, cnt, pstart; };
struct MoeSched {
    typedef MoeUnit UnitT;
    PG8_LAS const int* tab; const int* map; int U, G, c, npn, gather; size_t bstride;
    __device__ __forceinline__ bool next(int i, MoeUnit& u) const {
        const long L = (long)i * G + c; if (L >= U) return false;
        int idx = (int)L; { const int q = U / NXCD, r = U % NXCD, xcd = idx % NXCD, off = idx / NXCD; idx = (xcd < r ? xcd * (q + 1) : r * (q + 1) + (xcd - r) * q) + off; }
        const int tau = idx / npn; u.pn = idx - tau * npn;
        int e = 0;
#pragma unroll
        for (int st = 16; st >= 1; st >>= 1) { if (__builtin_amdgcn_readfirstlane(tab[e + st]) <= tau) e += st; }
        u.e = e; u.mt = tau - __builtin_amdgcn_readfirstlane(tab[e]); u.cnt = __builtin_amdgcn_readfirstlane(tab[33 + e]); u.pstart = __builtin_amdgcn_readfirstlane(tab[65 + e]);
        return true;
    }
    __device__ __forceinline__ const char* bbase(const Gemm& g, const MoeUnit& u) const { return (const char*)g.Bt + (size_t)u.e * bstride + (size_t)u.pn * BM * g.K * 2; }
    __device__ __forceinline__ void a_offsets(const Gemm& g, const MoeUnit& u, int tid, unsigned (&va)[2][2]) const {
        int tl = tid; asm volatile("" : "+v"(tl));
        int RA[2], CA[2];
#pragma unroll
        for (int i = 0; i < 2; ++i) { int R, C; stage_rc(tl * 16 + i * 8192, R, C); RA[i] = R; CA[i] = C * 2; }
#pragma unroll
        for (int hf = 0; hf < 2; ++hf)
#pragma unroll
            for (int i = 0; i < 2; ++i) { int rl = u.mt * BM + hf * HALF + RA[i]; rl = rl < u.cnt ? rl : u.cnt - 1;
                const unsigned row = gather ? (unsigned)map[(size_t)u.e * 34816 + rl] : (unsigned)(u.pstart + rl);
                va[hf][i] = row * (unsigned)(g.K * 2) + (unsigned)CA[i]; }
    }
};
struct EpiAct {
    static constexpr bool PERM = true, AFTER_DRAIN = false;
    unsigned char* O;
    __device__ __forceinline__ void operator()(const f32x4 (&acc)[2][2][4][2], const MoeUnit& u, int wr, int wc, int fr, int fq) const {
        typedef unsigned u32x2 __attribute__((ext_vector_type(2)));
        const int rl0 = u.mt * BM + wr * 64 + fr, col0 = u.pn * HALF + wc * 32 + 8 * fq;
#pragma unroll
        for (int ai = 0; ai < 2; ++ai)
#pragma unroll
            for (int m = 0; m < 4; ++m) { const int rl = rl0 + ai * HALF + m * 16;
                if (rl < u.cnt) { f32x4 o[2];
#pragma unroll
                    for (int n = 0; n < 2; ++n)
#pragma unroll
                        for (int j = 0; j < 4; ++j) { const float gv = acc[ai][0][m][n][j] * (1.0f / 64.0f)  ; o[n][j] = gv * __builtin_amdgcn_rcpf(1.0f + __builtin_amdgcn_exp2f(-1.4426950408889634f * gv)) * (acc[ai][1][m][n][j] * 0.125f)  ; }
                    *(u32x2*)(O + (size_t)(u.pstart + rl) * 512 + col0) = (u32x2){pk4_fp8(o[0]), pk4_fp8(o[1])}; } }
    }
};
struct EpiY {
    static constexpr bool PERM = true, AFTER_DRAIN = false;
    unsigned char* O;
    static __device__ __forceinline__ unsigned pk4(const f32x4 v) { const float lim = 440.f;
        int w = __builtin_amdgcn_cvt_pk_fp8_f32(fminf(fmaxf(v[0], -lim), lim), fminf(fmaxf(v[1], -lim), lim), 0, false);
        return (unsigned)__builtin_amdgcn_cvt_pk_fp8_f32(fminf(fmaxf(v[2], -lim), lim), fminf(fmaxf(v[3], -lim), lim), w, true); }
    __device__ __forceinline__ void operator()(const f32x4 (&acc)[2][2][4][2], const MoeUnit& u, int wr, int wc, int fr, int fq) const {
        typedef unsigned u32x2 __attribute__((ext_vector_type(2)));
        const int rl0 = u.mt * BM + wr * 64 + fr, col0 = u.pn * BM + wc * 32 + 8 * fq;
#pragma unroll
        for (int ai = 0; ai < 2; ++ai)
#pragma unroll
            for (int m = 0; m < 4; ++m) { const int rl = rl0 + ai * HALF + m * 16;
                if (rl < u.cnt) { unsigned char* rowp = O + (size_t)(u.pstart + rl) * 1024 + col0;
#pragma unroll
                    for (int bj = 0; bj < 2; ++bj) *(u32x2*)(rowp + bj * HALF) = (u32x2){pk4(acc[ai][bj][m][0] * (1.0f / 512.0f)), pk4(acc[ai][bj][m][1] * (1.0f / 512.0f))}; } }
    }
};
template <class Epi, class Sched, bool STAMP = false, bool SP2 = PG8_SP2, int SCW = -1, int SCA = 127>
__device__ __forceinline__ void gemm_phase_moe(PG8_LAS unsigned char* lds, const Gemm g, const Sched& S, const Epi& E, unsigned long long* stamps) {
    int tid_l = __builtin_amdgcn_readfirstlane(threadIdx.x >> 6) * 64 + (int)__builtin_amdgcn_mbcnt_hi(~0u, __builtin_amdgcn_mbcnt_lo(~0u, 0u)); asm volatile("" : "+v"(tid_l));
    const int tid = tid_l, wid = __builtin_amdgcn_readfirstlane(tid >> 6), lane = tid & 63, wr = wid >> 2, wc = wid & 3, fr = lane & 15, fq = lane >> 4;
    const int K = g.K, nt = K / BK;
    int ts_lo = 0, ts_hi = 0, nts = 0; const unsigned long long rt_entry = STAMP ? (unsigned long long)wall_clock64() : 0ull;
#define PG8_STAMP() do { if (STAMP && wid == 0 && nts < 64) { const unsigned long long _c = (unsigned long long)clock64(); \
        ts_lo = (lane == nts) ? (int)(unsigned)_c : ts_lo; ts_hi = (lane == nts) ? (int)(unsigned)(_c >> 32) : ts_hi; ++nts; } } while (0)
    PG8_STAMP();
    unsigned voffB[2];
#pragma unroll
    for (int i = 0; i < 2; ++i) { int R, C; stage_rc(tid * 16 + i * 8192, R, C); const int Rb = Epi::PERM ? ((R & ~31) + perm32(R & 31)) : R;
        voffB[i] = (unsigned)(Rb * K + C) * 2u; }
    unsigned vaC[2][2];
    PG8_LAS unsigned* vtab = (PG8_LAS unsigned*)(lds + STAGE_BYTES + 1024) + tid;
    const size_t kstep = (size_t)(BK * 2);
    const size_t hstep = (size_t)HALF * K * 2;
    const size_t tstep = 2 * hstep;
    const unsigned ldsw = (unsigned)wid * 1024u;
    const int aoff = lds_byte(wr * 64 + fr, fq * 8), boff = lds_byte(wc * 32 + fr, fq * 8);
#define PG8_SA(b, h) (((b) * 2 + (h)) * HTB)
#define PG8_SB(b, h) ((4 + (b) * 2 + (h)) * HTB)
#define PG8_STAGE(bufoff, gbase, voff) do { _Pragma("unroll") for (int _i = 0; _i < 2; ++_i) \
        __builtin_amdgcn_global_load_lds((const unsigned*)((const char*)(gbase) + (voff)[_i]), (PG8_LAS unsigned*)(lds + (bufoff) + ldsw + _i * 8192), 16, 0, 0); } while (0)
#define PG8_STAGEA(bufoff, kbyte, va) do { _Pragma("unroll") for (int _i = 0; _i < 2; ++_i) \
        __builtin_amdgcn_global_load_lds((const unsigned*)((const char*)g.A + (kbyte) + (va)[_i]), (PG8_LAS unsigned*)(lds + (bufoff) + ldsw + _i * 8192), 16, 0, 0); } while (0)
#define PG8_LDA(dst, b, h) do { _Pragma("unroll") for (int m = 0; m < 4; ++m) _Pragma("unroll") for (int k = 0; k < 2; ++k) dst[m][k] = *(const PG8_LAS bf16x8*)(lds + PG8_SA(b, h) + aoff + m * 2048 + k * 1024); } while (0)
#define PG8_LDB(dst, b, h) do { _Pragma("unroll") for (int n = 0; n < 2; ++n) _Pragma("unroll") for (int k = 0; k < 2; ++k) dst[n][k] = *(const PG8_LAS bf16x8*)(lds + PG8_SB(b, h) + boff + n * 2048 + k * 1024); } while (0)
#define PG8_MMA(ai, bj, At, Bt) do { __builtin_amdgcn_s_setprio(1); _Pragma("unroll") for (int m = 0; m < 4; ++m) _Pragma("unroll") for (int n = 0; n < 2; ++n) { \
        if constexpr (SCW >= 0) mfma8(acc[ai][bj][m][n], cat8(Bt[n][0], Bt[n][1]), cat8(At[m][0], At[m][1])); \
        else { _Pragma("unroll") for (int k = 0; k < 2; ++k) acc[ai][bj][m][n] = __builtin_amdgcn_mfma_f32_16x16x32_bf16(Bt[n][k], At[m][k], acc[ai][bj][m][n], 0, 0, 0); } } __builtin_amdgcn_s_setprio(0); } while (0)
#define PG8_WAIT_V(n) asm volatile("s_waitcnt vmcnt(" #n ")" ::: "memory")
#define PG8_WAIT_L(n) asm volatile("s_waitcnt lgkmcnt(" #n ")" ::: "memory")
#define PG8_BAR __builtin_amdgcn_s_barrier()
#define PG8_SCHED __builtin_amdgcn_sched_barrier(0)
    typename Sched::UnitT cur, nxt; int ui = 0;
    if (!S.next(0, cur)) return;
    f32x4 acc[2][2][4][2];
#pragma unroll
    for (int a = 0; a < 2; ++a)
#pragma unroll
        for (int b = 0; b < 2; ++b)
#pragma unroll
            for (int m = 0; m < 4; ++m)
#pragma unroll
                for (int n = 0; n < 2; ++n) acc[a][b][m][n] = (f32x4){0.f, 0.f, 0.f, 0.f};
    bf16x8 At[4][2], B0[2][2], B1[2][2];
    const char* cB = S.bbase(g, cur); S.a_offsets(g, cur, tid, vaC);
    if constexpr (SP2) {
        PG8_STAGE(PG8_SB(0, 0), cB, voffB); PG8_STAGE(PG8_SB(0, 1), cB + hstep, voffB); PG8_STAGEA(PG8_SA(0, 0), 0, vaC[0]); PG8_STAGEA(PG8_SA(0, 1), 0, vaC[1]);
        if (wr == 1) PG8_BAR;
        PG8_WAIT_V(2); PG8_BAR;
        PG8_STAGE(PG8_SB(1, 0), cB + kstep, voffB); PG8_STAGEA(PG8_SA(1, 0), kstep, vaC[0]); PG8_STAGE(PG8_SB(1, 1), cB + hstep + kstep, voffB);
        PG8_WAIT_V(6); PG8_BAR;
    } else {
    PG8_STAGE(PG8_SB(0, 0), cB, voffB); PG8_STAGEA(PG8_SA(0, 0), 0, vaC[0]); PG8_STAGE(PG8_SB(0, 1), cB + hstep, voffB); PG8_STAGEA(PG8_SA(0, 1), 0, vaC[1]);
    if (wr == 1) PG8_BAR;
    PG8_WAIT_V(4); PG8_BAR;
    PG8_STAGE(PG8_SB(1, 0), cB + kstep, voffB); PG8_STAGEA(PG8_SA(1, 0), kstep, vaC[0]); PG8_STAGE(PG8_SB(1, 1), cB + hstep + kstep, voffB);
    PG8_WAIT_V(6); PG8_BAR;
    }
    PG8_STAMP();
    for (;;) {
        const bool has_next = S.next(ui + 1, nxt);
        const char* nB = has_next ? S.bbase(g, nxt) : cB;
        { unsigned vaN[2][2];
          if (has_next) S.a_offsets(g, nxt, tid, vaN); else {
#pragma unroll
            for (int hf = 0; hf < 2; ++hf)
#pragma unroll
                for (int i = 0; i < 2; ++i) vaN[hf][i] = vaC[hf][i]; }
#pragma unroll
          for (int hf = 0; hf < 2; ++hf)
#pragma unroll
              for (int i = 0; i < 2; ++i) vtab[(hf * 2 + i) * 512] = vaN[hf][i]; }
        unsigned v2[2][2];
        for (int t = 0; t < nt; t += 2) {
            const bool last = (t == nt - 2);
            const size_t k1 = (size_t)(t + 1) * kstep, k2 = last ? (size_t)0 : (size_t)(t + 2) * kstep, k3 = k2 + kstep;
            const char* b2 = last ? nB : cB + (size_t)(t + 2) * kstep; const char* b3 = b2 + kstep;
#pragma unroll
            for (int hf = 0; hf < 2; ++hf)
#pragma unroll
                for (int i = 0; i < 2; ++i) v2[hf][i] = last ? vtab[(hf * 2 + i) * 512] : vaC[hf][i];
            if constexpr (SP2) {
            PG8_LDB(B0, 0, 0); PG8_LDB(B1, 0, 1); PG8_SCHED; PG8_LDA(At, 0, 0); PG8_STAGEA(PG8_SA(1, 1), k1, vaC[1]);
            PG8_WAIT_V(8); PG8_WAIT_L(0); PG8_BAR; PG8_MMA(0, 0, At, B0); PG8_MMA(0, 1, At, B1); PG8_BAR; PG8_SCHED;
            PG8_LDA(At, 0, 1); PG8_STAGE(PG8_SB(0, 0), b2, voffB); PG8_STAGE(PG8_SB(0, 1), b2 + hstep, voffB); PG8_STAGEA(PG8_SA(0, 0), k2, v2[0]);
            PG8_WAIT_V(8); PG8_WAIT_L(0); PG8_BAR; PG8_MMA(1, 0, At, B0); PG8_MMA(1, 1, At, B1); PG8_BAR; PG8_SCHED;
            PG8_LDB(B0, 1, 0); PG8_LDB(B1, 1, 1); PG8_SCHED; PG8_LDA(At, 1, 0); PG8_STAGEA(PG8_SA(0, 1), k2, v2[1]);
            PG8_WAIT_V(8); PG8_WAIT_L(0); PG8_BAR; PG8_MMA(0, 0, At, B0); PG8_MMA(0, 1, At, B1); PG8_BAR; PG8_SCHED;
            PG8_LDA(At, 1, 1); PG8_STAGE(PG8_SB(1, 0), b3, voffB); PG8_STAGE(PG8_SB(1, 1), b3 + hstep, voffB); PG8_STAGEA(PG8_SA(1, 0), k3, v2[0]);
            PG8_WAIT_V(8); PG8_WAIT_L(0); PG8_BAR; PG8_MMA(1, 0, At, B0); PG8_MMA(1, 1, At, B1); PG8_BAR; PG8_SCHED;
            } else {
            PG8_LDB(B0, 0, 0); PG8_SCHED; PG8_LDA(At, 0, 0); PG8_STAGEA(PG8_SA(1, 1), k1, vaC[1]);
            PG8_WAIT_L(8); PG8_BAR; PG8_WAIT_L(0); PG8_MMA(0, 0, At, B0); PG8_BAR; PG8_SCHED;
            PG8_LDB(B1, 0, 1); PG8_STAGE(PG8_SB(0, 0), b2, voffB);
            PG8_BAR; PG8_WAIT_L(0); PG8_MMA(0, 1, At, B1); PG8_BAR;
            PG8_LDA(At, 0, 1); PG8_STAGEA(PG8_SA(0, 0), k2, v2[0]);
            PG8_BAR; PG8_WAIT_L(0); PG8_MMA(1, 0, At, B0); PG8_BAR; PG8_SCHED;
            PG8_STAGE(PG8_SB(0, 1), b2 + hstep, voffB);
            PG8_WAIT_V(6); PG8_BAR; PG8_MMA(1, 1, At, B1); PG8_BAR;
            PG8_LDB(B0, 1, 0); PG8_SCHED; PG8_LDA(At, 1, 0); PG8_STAGEA(PG8_SA(0, 1), k2, v2[1]);
            PG8_WAIT_L(8); PG8_BAR; PG8_WAIT_L(0); PG8_MMA(0, 0, At, B0); PG8_BAR; PG8_SCHED;
            PG8_LDB(B1, 1, 1); PG8_STAGE(PG8_SB(1, 0), b3, voffB);
            PG8_BAR; PG8_WAIT_L(0); PG8_MMA(0, 1, At, B1); PG8_BAR;
            PG8_LDA(At, 1, 1); PG8_STAGEA(PG8_SA(1, 0), k3, v2[0]);
            PG8_BAR; PG8_WAIT_L(0); PG8_MMA(1, 0, At, B0); PG8_BAR; PG8_SCHED;
            PG8_STAGE(PG8_SB(1, 1), b3 + hstep, voffB);
            PG8_WAIT_V(6); PG8_BAR; PG8_MMA(1, 1, At, B1); PG8_BAR;
            }
        }
        PG8_STAMP();
        if (wr == 0) PG8_BAR;
        if constexpr (SCW >= 0) asm volatile("s_nop 15\n\ts_nop 15" ::: "memory");
        E(acc, cur, wr, wc, fr, fq);
        PG8_STAMP();
        if (!has_next) break;
#pragma unroll
        for (int a = 0; a < 2; ++a)
#pragma unroll
            for (int b = 0; b < 2; ++b)
#pragma unroll
                for (int m = 0; m < 4; ++m)
#pragma unroll
                    for (int n = 0; n < 2; ++n) acc[a][b][m][n] = (f32x4){0.f, 0.f, 0.f, 0.f};
        cur = nxt; cB = nB; ++ui;
#pragma unroll
        for (int hf = 0; hf < 2; ++hf)
#pragma unroll
            for (int i = 0; i < 2; ++i) vaC[hf][i] = v2[hf][i];
        if (wr == 1) PG8_BAR;
    }
    PG8_WAIT_V(0);
    PG8_BAR;
    PG8_STAMP();
    if (STAMP && wid == 0) { stamps[lane] = lane < nts ? (((unsigned long long)(unsigned)ts_hi << 32) | (unsigned)ts_lo) : 0ull;
        if (lane == 62) stamps[62] = rt_entry; if (lane == 63) stamps[63] = (unsigned long long)wall_clock64(); }
#undef PG8_STAMP
#undef PG8_SA
#undef PG8_SB
#undef PG8_STAGE
#undef PG8_STAGEA
#undef PG8_LDA
#undef PG8_LDB
#undef PG8_MMA
#undef PG8_WAIT_V
#undef PG8_WAIT_L
#undef PG8_BAR
#undef PG8_SCHED
}
}

constexpr int NTHR = 512, NWV = 8, LDS_BYTES = 147456;

struct P {
    const float *x, *c, *ctx, *c_ctx, *w_mod, *b_mod, *norm1_g, *norm2_g, *w_in, *conv_w, *conv_b, *dt_bias_f, *dt_bias_b, *a_log_f, *a_log_b, *d_skip, *ssd_norm_g,
        *gk_up_f, *gk_bias_f, *gk_up_b, *gk_bias_b, *gla_norm_g, *w_out, *w_router, *router_bias, *w_gate, *w_up, *w_down, *final_g;
    float* out; bf16_t* XB; bf16_t* H; bf16_t* PROJ; bf16_t* SS; bf16_t* GS; float* SDEC; float* GDEC; float* MOD; int* counts; int* TOKSLOT; float* EW; int* MAP; bf16_t* WinT; bf16_t* WoutT; bf16_t* WguT; bf16_t* WdT; bf16_t* WRT; unsigned* BAR; bf16_t* XBCC; bf16_t* QKB; float* SSC; float* STOT; float* SSQ; float* XSS;
};

DI void ph_init(const P& p) { const size_t i = (size_t)blockIdx.x * NTHR + ltid(); if (i < 64) p.counts[i * 32] = 0; }

DI void ph_mod(const P& p, float* s  ) {
    const int tid_ = ltid(), lane = tid_ & 63, w = tid_ >> 6;
    if (blockIdx.x >= 192) return;
    float* part = s + 9 * 1024;
    { float cv[18];
#pragma unroll
      for (int q = 0; q < 18; ++q) { const int i = tid_ + q * NTHR, r = i >> 10, k = i & 1023; cv[q] = r < 8 ? p.c[r * 1024 + k] : p.c_ctx[k]; }
#pragma unroll
      for (int q = 0; q < 18; ++q) s[tid_ + q * NTHR] = siluf(cv[q]); }
    __syncthreads();
    for (int vb = blockIdx.x; vb < 192; vb += gridDim.x) {
        const int l = vb / 96, n = (vb % 96) * 64 + lane;
        float acc[9];
#pragma unroll
        for (int r = 0; r < 9; ++r) acc[r] = 0.f;
        const float* wp = p.w_mod + (size_t)l * 1024 * 6144 + (size_t)(128 * w) * 6144 + n;
#pragma unroll 8
        for (int k = 0; k < 128; ++k) { const float wv = wp[(size_t)k * 6144];
#pragma unroll
            for (int r = 0; r < 9; ++r) acc[r] += s[r * 1024 + 128 * w + k] * wv; }
#pragma unroll
        for (int r = 0; r < 9; ++r) part[(w * 9 + r) * 64 + lane] = acc[r];
        __syncthreads();
        for (int o = tid_; o < 9 * 64; o += NTHR) { const int r = o >> 6, c = o & 63; float a = p.b_mod[l * 6144 + (vb % 96) * 64 + c];
#pragma unroll
            for (int q = 0; q < 8; ++q) a += part[(q * 9 + r) * 64 + c];
            p.MOD[((size_t)l * 9 + r) * 6144 + (vb % 96) * 64 + c] = a; }
        __syncthreads();
    }
}

DI unsigned pk2(float lo, float hi) { return __builtin_bit_cast(unsigned, __builtin_convertvector((f32x2v_){lo, hi}, bf16x2v_)); }
template <bool F8 = false> DI void transpose_item(const float* W, int K, int N, bf16_t* WT, float* scr, int item, int lane, int gu = -1, const float* kscale = nullptr) {
    const int nblk = (N + 31) / 32, kb = item / nblk, nb = item % nblk, k0 = 64 * kb, n0 = 32 * nb;
    const int d0 = gu < 0 ? n0 : 256 * (n0 >> 7) + (n0 & 127) + 128 * gu;
    const int ncl = n0 + (lane & 31) < N ? n0 + (lane & 31) : N - 1;
    float wv_[32];
#pragma unroll
    for (int i = 0; i < 32; ++i) { const int kk = 2 * i + (lane >> 5); wv_[i] = __builtin_nontemporal_load(W + (size_t)(k0 + kk) * N + ncl); }
#pragma unroll
    for (int i = 0; i < 32; ++i) { const int kk = 2 * i + (lane >> 5); scr[kk * 33 + (lane & 31)] = wv_[i] * (kscale ? kscale[k0 + kk] : 1.0f); }
    const int c = lane & 7;
#pragma unroll
    for (int j = 0; j < 4; ++j) { const int n = (lane >> 3) + 8 * j; const float* q = scr + (8 * c) * 33 + n;
        if constexpr (F8) { typedef unsigned u32x2nt __attribute__((ext_vector_type(2)));
            const u32x2nt o = {pg8::pk4_fp8((pg8::f32x4){q[0 * 33], q[1 * 33], q[2 * 33], q[3 * 33]} * 64.0f), pg8::pk4_fp8((pg8::f32x4){q[4 * 33], q[5 * 33], q[6 * 33], q[7 * 33]} * 64.0f)};
            if (n0 + n < N) __builtin_nontemporal_store(o, (u32x2nt*)((unsigned char*)WT + (size_t)(d0 + n) * K + k0 + 8 * c)); }
        else {
        uint4 o; o.x = pk2(q[0 * 33], q[1 * 33]); o.y = pk2(q[2 * 33], q[3 * 33]); o.z = pk2(q[4 * 33], q[5 * 33]); o.w = pk2(q[6 * 33], q[7 * 33]);
        if (n0 + n < N) { typedef unsigned u32x4nt __attribute__((ext_vector_type(4))); __builtin_nontemporal_store((u32x4nt){o.x, o.y, o.z, o.w}, (u32x4nt*)(WT + (size_t)(d0 + n) * K + k0 + 8 * c)); } } }
}

struct TrD { const float* src; unsigned char* dst; int N, K; bool ok; };
DI TrD tr_desc(const P& p, int l, int it, int it1, int lane) {
    TrD d; d.ok = it < it1; const int itc = d.ok ? it : it1 - 1;
    const int e = itc / 768, r = itc - e * 768;
    const float* W; unsigned char* WT; int K, N, item, gu;
    if (r < 512) { gu = r >> 8; W = (gu ? p.w_up : p.w_gate) + (size_t)(l * NE + e) * D * 512; K = D; N = 512; WT = (unsigned char*)p.WguT + (size_t)e * D * D; item = r & 255; }
    else { gu = -1; W = p.w_down + (size_t)(l * NE + e) * 512 * D; K = 512; N = D; WT = (unsigned char*)p.WdT + (size_t)e * D * 512; item = r - 512; }
    const int nblk = N / 32, kb = item / nblk, nb = item % nblk, k0 = 64 * kb, n0 = 32 * nb;
    const int d0 = gu < 0 ? n0 : 256 * (n0 >> 7) + (n0 & 127) + 128 * gu;
    d.src = W + (size_t)(k0 + (lane >> 5)) * N + n0 + (lane & 31); d.dst = WT + (size_t)d0 * K + k0; d.N = N; d.K = K;
    return d;
}
DI void tr_load(const TrD& d, float (&v)[32]) {
#pragma unroll
    for (int i = 0; i < 32; ++i) v[i] = __builtin_nontemporal_load(d.src + (size_t)(2 * i) * d.N);
}
DI void tr_finish(const TrD& d, const float (&v)[32], float* scr, int lane) {
#pragma unroll
    for (int i = 0; i < 32; ++i) { const int kk = 2 * i + (lane >> 5); scr[kk * 33 + (lane & 31)] = v[i]; }
    const int c = lane & 7;
#pragma unroll
    for (int j = 0; j < 4; ++j) { const int n = (lane >> 3) + 8 * j; const float* q = scr + (8 * c) * 33 + n;
        typedef unsigned u32x2nt __attribute__((ext_vector_type(2)));
        const u32x2nt o = {pg8::pk4_fp8((pg8::f32x4){q[0 * 33], q[1 * 33], q[2 * 33], q[3 * 33]} * 64.0f), pg8::pk4_fp8((pg8::f32x4){q[4 * 33], q[5 * 33], q[6 * 33], q[7 * 33]} * 64.0f)};
        if (d.ok) __builtin_nontemporal_store(o, (u32x2nt*)(d.dst + (size_t)n * d.K + 8 * c)); }
}
#ifndef TR_NI
#define TR_NI 4
#endif
DI void ph_convert_experts(const P& p, int l, float* ldsf, int wk0, int nwk, int it0 = 0, int it1 = NE * 768) {
    const int tid_ = ltid(), lane = tid_ & 63, gw = ((int)blockIdx.x - wk0) * NWV + (tid_ >> 6), NW = nwk * NWV;
    float* scr = ldsf + 14 * 1024 + (tid_ >> 6) * (64 * 33 + 16);
    for (int it = it0 + gw; it < it1; it += TR_NI * NW) {
        float v[TR_NI][32]; TrD d[TR_NI];
#pragma unroll
        for (int j = 0; j < TR_NI; ++j) { d[j] = tr_desc(p, l, it + j * NW, it1, lane); tr_load(d[j], v[j]); }
#pragma unroll
        for (int j = 0; j < TR_NI; ++j) tr_finish(d[j], v[j], scr, lane);
    }
}
constexpr int NPAD_IN = 3072;
DI void ph_convert_small(const P& p, float* ldsf, int, int, int) {
    const int tid_ = ltid(), lane = tid_ & 63, gw = blockIdx.x * NWV + (tid_ >> 6), NW = gridDim.x * NWV;
    float* scr = ldsf + 14 * 1024 + (tid_ >> 6) * (64 * 33 + 16);
    constexpr int I_IN = 16 * 89, I_OUT = 16 * 32;
    for (int it = gw; it < 2 * (I_IN + I_OUT); it += NW) {
        const int l = it / (I_IN + I_OUT), r = it % (I_IN + I_OUT);
        if (r < I_IN) transpose_item<true>(p.w_in + (size_t)l * D * INDIM, D, INDIM, (bf16_t*)((unsigned char*)p.WinT + (size_t)l * NPAD_IN * D), scr, r, lane);
        else { const int kb = (r - I_IN) / 32;
            transpose_item(p.w_out + (size_t)l * D * D, D, D, p.WoutT + (size_t)l * D * D, scr, r - I_IN, lane, -1, kb < 8 ? p.ssd_norm_g + l * 512 : nullptr); }
    }
    for (int idx = blockIdx.x * NTHR + tid_; idx < 32 * 1024; idx += gridDim.x * NTHR) { const int e = idx >> 10, k = idx & 1023; p.WRT[idx] = f2bf(p.w_router[k * 32 + e]); }
    const size_t nz16 = (size_t)(NPAD_IN - INDIM) * D / 16;
    for (size_t i = (size_t)blockIdx.x * NTHR + tid_; i < 2 * nz16; i += (size_t)gridDim.x * NTHR) {
        const size_t l = i / nz16, j = i % nz16;
        ((uint4*)((unsigned char*)p.WinT + (l * NPAD_IN + INDIM) * D))[j] = make_uint4(0u, 0u, 0u, 0u);
    }
}

DI void row_normmod(float4 (&v)[4], const float* g, const float* mr, int shift_idx, int scale_idx, int lane) {
    float ss = 0.f;
#pragma unroll
    for (int i = 0; i < 4; ++i) ss += v[i].x * v[i].x + v[i].y * v[i].y + v[i].z * v[i].z + v[i].w * v[i].w;
    ss = wave_sum(ss, lane);
    const float rstd = rsqrtf(ss * (1.0f / D) + 1e-6f);
#pragma unroll
    for (int i = 0; i < 4; ++i) {
        const int c = (i * 64 + lane) * 4;
        const float4 gg = *(const float4*)(g + c), sh = *(const float4*)(mr + shift_idx * 1024 + c), sc = *(const float4*)(mr + scale_idx * 1024 + c);
        v[i].x = v[i].x * rstd * gg.x * (1.f + sc.x) + sh.x; v[i].y = v[i].y * rstd * gg.y * (1.f + sc.y) + sh.y;
        v[i].z = v[i].z * rstd * gg.z * (1.f + sc.z) + sh.z; v[i].w = v[i].w * rstd * gg.w * (1.f + sc.w) + sh.w;
    }
}
DI void row_store_bf16(bf16_t* hrow, float4 (&v)[4], int lane) {
#pragma unroll
    for (int i = 0; i < 4; ++i) { ushort4 o; o.x = f2bf(v[i].x); o.y = f2bf(v[i].y); o.z = f2bf(v[i].z); o.w = f2bf(v[i].w);
        *(ushort4*)(hrow + (i * 64 + lane) * 4) = o; v[i] = make_float4(bf2f(o.x), bf2f(o.y), bf2f(o.z), bf2f(o.w)); }
}

DI void ph_normmod1(const P& p, int l, int, int, int) {
    const int tid_ = ltid(), lane = tid_ & 63, gw = blockIdx.x * NWV + (tid_ >> 6), NW = gridDim.x * NWV;
    const float* MODl = p.MOD + (size_t)l * 9 * 6144;
    for (int t = gw; t < T; t += NW) {
        float4 v[4];
#pragma unroll
        for (int i = 0; i < 4; ++i) v[i] = ((const float4*)(t < TC ? p.ctx + (size_t)t * D : p.x + (size_t)(t - TC) * D))[i * 64 + lane];
        row_normmod(v, p.norm1_g + l * D, MODl + (size_t)tok_modrow(t) * 6144, 0, 1, lane);
#pragma unroll
        for (int i = 0; i < 4; ++i) *(unsigned*)((unsigned char*)p.H + (size_t)t * D + (i * 64 + lane) * 4) = pg8::pk4_fp8((pg8::f32x4){v[i].x, v[i].y, v[i].z, v[i].w});
    }
}

typedef short s16x4 __attribute__((ext_vector_type(4)));
typedef short bf16x8v __attribute__((ext_vector_type(8)));
typedef float f32x4v __attribute__((ext_vector_type(4)));
typedef unsigned u32x4v __attribute__((ext_vector_type(4)));
typedef unsigned u32x2v __attribute__((ext_vector_type(2)));
DI u32x4v mk4(unsigned a, unsigned b, unsigned c, unsigned d) { return (u32x4v){a, b, c, d}; }
DI u32x2v mk2(unsigned a, unsigned b) { return (u32x2v){a, b}; }
DI f32x4v mkf4(float a, float b, float c, float d) { return (f32x4v){a, b, c, d}; }
#define LDSP __attribute__((address_space(3)))
constexpr int NCH = 34, NTILE = NB * NCH;
constexpr int LD64 = 72, LD128 = 136;
constexpr float LOG2E = 1.4426950408889634f;

DI int tile_tok0(int tl) { const int b = tl / NCH, cs = tl - b * NCH; return cs < 2 ? b * CTXL + cs * 128 : TC + b * SEQ + (cs - 2) * 128; }
DI f32x4v mfma16(bf16x8v a, bf16x8v b, f32x4v c) { return __builtin_amdgcn_mfma_f32_16x16x32_bf16(a, b, c, 0, 0, 0); }
DI bf16x8v frag_row(LDSP const bf16_t* base, int ld, int r0, int k0, int lane) { return *(LDSP const bf16x8v*)(base + (r0 + (lane & 15)) * ld + k0 + 8 * (lane >> 4)); }
DI bf16x8v frag_row_g(const bf16_t* base, int ld, int r0, int k0, int lane) { return *(const bf16x8v*)(base + (size_t)(r0 + (lane & 15)) * ld + k0 + 8 * (lane >> 4)); }
DI bf16x8v frag_col(LDSP const bf16_t* base, int ld, int r0, int k0, int lane) {
    const int G = lane >> 4, i = lane & 15;
    LDSP const bf16_t* a = base + (k0 + 8 * G + (i >> 2)) * ld + r0 + 4 * (i & 3);
    const s16x4 lo = __builtin_bit_cast(s16x4, __builtin_amdgcn_ds_read_tr16_b64_v4i16((LDSP s16x4*)a));
    const s16x4 hi = __builtin_bit_cast(s16x4, __builtin_amdgcn_ds_read_tr16_b64_v4i16((LDSP s16x4*)(a + 4 * ld)));
    return (bf16x8v){lo[0], lo[1], lo[2], lo[3], hi[0], hi[1], hi[2], hi[3]};
}
DI u32x2v pack4(f32x4v v) { return mk2(pk2(v[0], v[1]), pk2(v[2], v[3])); }
DI void unpack8(u32x4v v, float* o) { o[0] = __uint_as_float(v.x << 16); o[1] = __uint_as_float(v.x & 0xffff0000u); o[2] = __uint_as_float(v.y << 16); o[3] = __uint_as_float(v.y & 0xffff0000u);
    o[4] = __uint_as_float(v.z << 16); o[5] = __uint_as_float(v.z & 0xffff0000u); o[6] = __uint_as_float(v.w << 16); o[7] = __uint_as_float(v.w & 0xffff0000u); }
DI u32x4v pack8(const float* o) { return mk4(pk2(o[0], o[1]), pk2(o[2], o[3]), pk2(o[4], o[5]), pk2(o[6], o[7])); }

DI float fast_logsigmoid(float x) { return -(fmaxf(-x, 0.f) + __logf(1.0f + __expf(-fabsf(x)))); }
DI float fast_softplus(float x) { return fmaxf(x, 0.f) + __logf(1.0f + __expf(-fabsf(x))); }
struct XbcSrc { const bf16_t* base; int ld; };
DI XbcSrc xbc_src(const P& p, int tok0) { XbcSrc r; r.base = p.XBCC + (size_t)tok0 * 768; r.ld = 768; return r; }

DI void prep_conv_item(const P& p, int l, int item, int lane) {
    int piece, ch;
    if (item < T / 32) { piece = item; ch = lane * 8; } else { piece = 2 * (item - T / 32) + (lane >> 5); ch = 512 + (lane & 31) * 8; }
    const int t0 = piece * 32; int lo, hi; bf16_t* dst; int dld;
    if (t0 < TC) { lo = t0 & ~(CTXL - 1); hi = lo + CTXL - 1; } else { lo = TC + ((t0 - TC) & ~63); hi = lo + 63; }
    dst = p.XBCC + ch; dld = 768;
    const bf16_t* src = p.PROJ + OFF_XBC + ch;
    float wgt[5][8], bias[8];
#pragma unroll
    for (int k = 0; k < 5; ++k) { const f32x4v a = *(const f32x4v*)(p.conv_w + l * 5 * 768 + k * 768 + ch), c = *(const f32x4v*)(p.conv_w + l * 5 * 768 + k * 768 + ch + 4);
#pragma unroll
        for (int j = 0; j < 4; ++j) { wgt[k][j] = a[j]; wgt[k][4 + j] = c[j]; } }
    { const f32x4v a = *(const f32x4v*)(p.conv_b + l * 768 + ch), c = *(const f32x4v*)(p.conv_b + l * 768 + ch + 4);
#pragma unroll
      for (int j = 0; j < 4; ++j) { bias[j] = a[j]; bias[4 + j] = c[j]; } }
    const u32x4v zero4 = mk4(0u, 0u, 0u, 0u);
    u32x4v rw[13];
#pragma unroll
    for (int i = 0; i < 5; ++i) { const int tt = t0 - 2 + i; rw[i] = (tt >= lo && tt <= hi) ? *(const u32x4v*)(src + (size_t)tt * LDP) : zero4; }
    for (int s0 = 0; s0 < 32; s0 += 8) {
        const int t = t0 + s0;
#pragma unroll
        for (int i = 0; i < 8; ++i) { const int tt = t + 3 + i; rw[5 + i] = (tt <= hi) ? *(const u32x4v*)(src + (size_t)tt * LDP) : zero4; }
#pragma unroll
        for (int i = 0; i < 8; ++i) {
            float o[8];
#pragma unroll
            for (int c = 0; c < 8; ++c) o[c] = bias[c];
#pragma unroll
            for (int k = 0; k < 5; ++k) { float v[8]; unpack8(rw[i + k], v);
#pragma unroll
                for (int c = 0; c < 8; ++c) o[c] += wgt[k][c] * v[c]; }
#pragma unroll
            for (int c = 0; c < 8; ++c) o[c] = siluf(o[c]);
            *(u32x4v*)(dst + (size_t)(t + i) * dld) = pack8(o);
        }
#pragma unroll
        for (int i = 0; i < 5; ++i) rw[i] = rw[i + 8];
    }
}
DI void prep_ssd_item(const P& p, int l, int item, int lane) {
    const int tl = item >> 3, h = item & 7, tok0 = tile_tok0(tl);
    const float bsf = p.dt_bias_f[l * 8 + h], bsb = p.dt_bias_b[l * 8 + h];
    const float r0 = bf2f(p.PROJ[(size_t)(tok0 + 2 * lane) * LDP + OFF_DT + h]), r1 = bf2f(p.PROJ[(size_t)(tok0 + 2 * lane + 1) * LDP + OFF_DT + h]);
    const float f0 = fast_softplus(r0 + bsf), f1 = fast_softplus(r1 + bsf), b0 = fast_softplus(r0 + bsb), b1 = fast_softplus(r1 + bsb);
    float pf = f0 + f1, sb = b0 + b1;
#pragma unroll
    for (int o = 1; o < 64; o <<= 1) { const float t = shl(pf, lane >= o ? lane - o : lane); if (lane >= o) pf += t; }
#pragma unroll
    for (int o = 1; o < 64; o <<= 1) { const float t = shl(sb, lane + o < 64 ? lane + o : lane); if (lane + o < 64) sb += t; }
    const float Af = -__expf(p.a_log_f[l * 8 + h]) * LOG2E, Ab = -__expf(p.a_log_b[l * 8 + h]) * LOG2E;
    const float af0 = Af * (pf - f1), af1 = Af * pf, ab0 = Ab * sb, ab1 = Ab * (sb - b0);
    f32x4v* dst = (f32x4v*)p.SSC + (size_t)(tok0 + 2 * lane) * 8 + h;
    dst[0] = mkf4(af0, af0 - __log2f(f0), ab0, ab0 - __log2f(b0));
    dst[8] = mkf4(af1, af1 - __log2f(f1), ab1, ab1 - __log2f(b1));
    if (lane == 63) { p.STOT[(tl * 8 + h) * 2 + 0] = af1; p.SDEC[(tl * 8 + h) * 2 + 0] = __builtin_amdgcn_exp2f(af1); }
    if (lane == 0) { p.STOT[(tl * 8 + h) * 2 + 1] = ab0; p.SDEC[(tl * 8 + h) * 2 + 1] = __builtin_amdgcn_exp2f(ab0); }
}
template <int CTRL> DI float dppz(float x) { return __builtin_bit_cast(float, __builtin_amdgcn_update_dpp(0, __builtin_bit_cast(int, x), CTRL, 0xf, 0xf, true)); }
DI float row_total(float s) { s += dppz<0xB1>(s); s += dppz<0x4E>(s); s += dppz<0x141>(s); s += dppz<0x140>(s); return s; }
struct GlaPL { u32x4v qv_[2], kv_[2], vv_[4]; bf16x8v gkf[8]; float uw[8]; f32x4v bias; };
DI void prep_gla_load(const P& p, int l, int it, GlaPL& L) {
    const int tl = it >> 2, h = it & 3;
    const int tid = ltid(), lane = tid & 63, w = __builtin_amdgcn_readfirstlane(tid >> 6), kt = w & 3, dir = w >> 2, G = lane >> 4, c = lane & 15, tok0 = tile_tok0(tl);
#pragma unroll
    for (int nt = 0; nt < 8; ++nt) L.gkf[nt] = *(const bf16x8v*)(p.PROJ + (size_t)(tok0 + 16 * nt + c) * LDP + OFF_GK + (G & 1) * 8);
    { const float* up = (dir ? p.gk_up_b : p.gk_up_f) + l * 16 * 256 + (G & 1) * 8 * 256 + h * 64 + 16 * kt + c;
#pragma unroll
      for (int e = 0; e < 8; ++e) L.uw[e] = up[e * 256]; }
    L.bias = *(const f32x4v*)((dir ? p.gk_bias_b : p.gk_bias_f) + l * 256 + h * 64 + 16 * kt + 4 * G);
#pragma unroll
    for (int q = 0; q < 4; ++q) { const int cc_ = tid + q * NTHR, r = cc_ >> 4, cc = cc_ & 15; L.vv_[q] = *(const u32x4v*)(p.PROJ + (size_t)(tok0 + r) * LDP + OFF_V + h * 128 + cc * 8); }
#pragma unroll
    for (int q = 0; q < 2; ++q) { const int cc_ = tid + q * NTHR, r = cc_ >> 3, cc = cc_ & 7; const bf16_t* pr = p.PROJ + (size_t)(tok0 + r) * LDP;
        L.qv_[q] = *(const u32x4v*)(pr + OFF_Q + h * 64 + cc * 8); L.kv_[q] = *(const u32x4v*)(pr + OFF_K + h * 64 + cc * 8); }
}
DI void prep_gla_block(const P& p, int l, int it, int it_next, GlaPL& L, LDSP unsigned char* lds) {
    const int tl = it >> 2, h = it & 3;
    const int tid = ltid(), lane = tid & 63, w = __builtin_amdgcn_readfirstlane(tid >> 6), kt = w & 3, dir = w >> 2, G = lane >> 4, c = lane & 15, tok0 = tile_tok0(tl);
    LDSP bf16_t* QT = (LDSP bf16_t*)lds; LDSP bf16_t* KT = QT + 128 * LD64; LDSP bf16_t* O4 = KT + 128 * LD64; LDSP bf16_t* VT = O4 + 4 * 128 * LD64; LDSP float* DEC = (LDSP float*)(VT + 128 * LD128);
    f32x4v g[8];
    { bf16x8v af;
#pragma unroll
      for (int e = 0; e < 8; ++e) { const bf16_t hi = f2bf(L.uw[e]); const bf16_t lo = f2bf(L.uw[e] - bf2f(hi)); af[e] = (short)(G < 2 ? hi : lo); }
#pragma unroll
      for (int nt = 0; nt < 8; ++nt) g[nt] = mfma16(af, L.gkf[nt], (f32x4v){0.f, 0.f, 0.f, 0.f}); }
#pragma unroll
    for (int nt = 0; nt < 8; ++nt)
#pragma unroll
        for (int r = 0; r < 4; ++r) { const float x = (g[nt][r] + L.bias[r]) * LOG2E;
            g[nt][r] = -(fmaxf(-x, 0.f) + __log2f(1.0f + __builtin_amdgcn_exp2f(-fabsf(x)))) * (1.0f / 16.0f); }
    f32x4v tot = (f32x4v){0.f, 0.f, 0.f, 0.f};
    if (dir == 0) {
#pragma unroll
        for (int nt = 0; nt < 8; ++nt)
#pragma unroll
            for (int r = 0; r < 4; ++r) { const float s = row_total(g[nt][r]); float x = g[nt][r];
                x += dppz<0x111>(x); x += dppz<0x112>(x); x += dppz<0x114>(x); x += dppz<0x118>(x);
                g[nt][r] = tot[r] + x; tot[r] += s; }
    } else {
#pragma unroll
        for (int nt = 7; nt >= 0; --nt)
#pragma unroll
            for (int r = 0; r < 4; ++r) { const float s = row_total(g[nt][r]); float x = g[nt][r];
                x += dppz<0x101>(x); x += dppz<0x102>(x); x += dppz<0x104>(x); x += dppz<0x108>(x);
                g[nt][r] = tot[r] + x; tot[r] += s; }
    }
    __syncthreads();
#pragma unroll
    for (int q = 0; q < 2; ++q) { const int cc_ = tid + q * NTHR, r = cc_ >> 3, cc = cc_ & 7; *(LDSP u32x4v*)(QT + r * LD64 + cc * 8) = L.qv_[q]; *(LDSP u32x4v*)(KT + r * LD64 + cc * 8) = L.kv_[q]; }
#pragma unroll
    for (int q = 0; q < 4; ++q) { const int cc_ = tid + q * NTHR, r = cc_ >> 4, cc = cc_ & 15; *(LDSP u32x4v*)(VT + r * LD128 + cc * 8) = L.vv_[q]; }
    __syncthreads();
    { LDSP bf16_t* OQ = O4 + (2 * dir) * 128 * LD64; LDSP bf16_t* OK = OQ + 128 * LD64;
#pragma unroll
      for (int nt = 0; nt < 8; ++nt) { const int o = (16 * nt + c) * LD64 + 16 * kt + 4 * G;
          const u32x2v q2 = *(LDSP const u32x2v*)(QT + o), k2 = *(LDSP const u32x2v*)(KT + o);
          float eq[4], ek[4];
#pragma unroll
          for (int r = 0; r < 4; ++r) { eq[r] = __builtin_amdgcn_exp2f(g[nt][r] - 3.0f); ek[r] = __builtin_amdgcn_exp2f(-g[nt][r]); }
          *(LDSP u32x2v*)(OQ + o) = mk2(pk2(__uint_as_float(q2.x << 16) * eq[0], __uint_as_float(q2.x & 0xffff0000u) * eq[1]), pk2(__uint_as_float(q2.y << 16) * eq[2], __uint_as_float(q2.y & 0xffff0000u) * eq[3]));
          *(LDSP u32x2v*)(OK + o) = mk2(pk2(__uint_as_float(k2.x << 16) * ek[0], __uint_as_float(k2.x & 0xffff0000u) * ek[1]), pk2(__uint_as_float(k2.y << 16) * ek[2], __uint_as_float(k2.y & 0xffff0000u) * ek[3])); }
      if (c == 0) { const f32x4v d = mkf4(__builtin_amdgcn_exp2f(tot[0]), __builtin_amdgcn_exp2f(tot[1]), __builtin_amdgcn_exp2f(tot[2]), __builtin_amdgcn_exp2f(tot[3]));
          *(f32x4v*)(p.GDEC + (size_t)((tl * 4 + h) * 2 + dir) * 64 + 16 * kt + 4 * G) = d; *(LDSP f32x4v*)(DEC + dir * 64 + 16 * kt + 4 * G) = d; } }
    __syncthreads();
    if (it_next >= 0) prep_gla_load(p, l, it_next, L);
#pragma unroll
    for (int q = 0; q < 8; ++q) { const int cc_ = tid + q * NTHR, a4 = cc_ >> 10, r = (cc_ >> 3) & 127, cc = cc_ & 7;
        *(u32x4v*)(p.QKB + (size_t)(tok0 + r) * 1024 + a4 * 256 + h * 64 + cc * 8) = *(LDSP const u32x4v*)(O4 + (a4 * 128 + r) * LD64 + cc * 8); }
    { const int ut = kt; LDSP const bf16_t* KE = O4 + (dir ? 3 : 1) * 128 * LD64;
      f32x4v acc[8];
#pragma unroll
      for (int q = 0; q < 8; ++q) acc[q] = (f32x4v){0.f, 0.f, 0.f, 0.f};
#pragma unroll
      for (int ks = 0; ks < 4; ++ks) { const bf16x8v u = frag_col(KE, LD64, 16 * ut, 32 * ks, lane);
#pragma unroll
          for (int q = 0; q < 8; ++q) acc[q] = mfma16(u, frag_col(VT, LD128, 16 * q, 32 * ks, lane), acc[q]); }
      const f32x4v dec = *(LDSP const f32x4v*)(DEC + dir * 64 + 16 * ut + 4 * (lane >> 4));
      bf16_t* dst = p.GS + ((size_t)((tl * 4 + h) * 2 + dir) * 128) * 64;
#pragma unroll
      for (int q = 0; q < 8; ++q) *(u32x2v*)(dst + (size_t)(16 * q + (lane & 15)) * 64 + 16 * ut + 4 * (lane >> 4)) = pack4(acc[q] * dec); }
}
constexpr int NPREP_A = T / 32 + T / 64, NPREP_B = NTILE * 8;
DI void ph_prep(const P& p, int l, LDSP unsigned char* lds) {
    const int tid_ = ltid(), lane = tid_ & 63, gw = blockIdx.x * NWV + (tid_ >> 6), NW = gridDim.x * NWV;
    for (int it = gw; it < NPREP_A + NPREP_B; it += NW) {
        if (it < NPREP_A) prep_conv_item(p, l, it, lane); else prep_ssd_item(p, l, it - NPREP_A, lane);
    }
    { const int G_ = gridDim.x; int it = G_ - 1 - (int)blockIdx.x;
      GlaPL L; if (it < NTILE * 4) prep_gla_load(p, l, it, L);
      for (; it < NTILE * 4; it += G_) prep_gla_block(p, l, it, it + G_ < NTILE * 4 ? it + G_ : -1, L, lds); }
}

DI int ssd_item(int k, int ntile) {
    const int G_ = gridDim.x, b = blockIdx.x;
    if (G_ != 256) { const int it = b + k * G_; return it < ntile * 8 ? it : -1; }
    const int xcd = b & 7, slot = b >> 3, pp = ((xcd + 4) & 7) * 8 + (slot >> 2), q = k * 32 + (pp >> 1);
    return q < ntile ? q * 8 + 4 * (pp & 1) + (slot & 3) : -1;
}
struct S1Pre { u32x4v x0, x1, b0, b1; f32x4v sc; float tf, tb; };
DI void s1_load(const P& p, int tl, int h, int tid, S1Pre& r) {
    const int tok0 = tile_tok0(tl), g = h >> 2; const XbcSrc xs = xbc_src(p, tok0);
    const int j = tid >> 2, cq = tid & 3;
    const bf16_t* row = xs.base + (size_t)j * xs.ld;
    r.x0 = *(const u32x4v*)(row + h * 64 + cq * 16); r.x1 = *(const u32x4v*)(row + h * 64 + cq * 16 + 8);
    r.b0 = *(const u32x4v*)(row + 512 + g * 64 + cq * 16); r.b1 = *(const u32x4v*)(row + 512 + g * 64 + cq * 16 + 8);
    r.sc = *((const f32x4v*)p.SSC + (size_t)(tok0 + j) * 8 + h);
    r.tf = p.STOT[(tl * 8 + h) * 2 + 0]; r.tb = p.STOT[(tl * 8 + h) * 2 + 1];
}
DI void s1_ssd(const P& p, int tl, int h, S1Pre& pre, int it_n, LDSP unsigned char* lds) {
    const int tid = ltid(), lane = tid & 63, w = __builtin_amdgcn_readfirstlane(tid >> 6);
    LDSP bf16_t* XWF = (LDSP bf16_t*)lds; LDSP bf16_t* XWB = XWF + 128 * LD64; LDSP bf16_t* BG = XWB + 128 * LD64;
    const int j = tid >> 2, cq = tid & 3;
    const float wf = __builtin_amdgcn_exp2f(pre.tf - pre.sc.y), wb = __builtin_amdgcn_exp2f(pre.tb - pre.sc.w);
    float xv[16], of[16], ob[16]; unpack8(pre.x0, xv); unpack8(pre.x1, xv + 8);
#pragma unroll
    for (int c = 0; c < 16; ++c) { of[c] = xv[c] * wf; ob[c] = xv[c] * wb; }
    __syncthreads();
    *(LDSP u32x4v*)(XWF + j * LD64 + cq * 16) = pack8(of); *(LDSP u32x4v*)(XWF + j * LD64 + cq * 16 + 8) = pack8(of + 8);
    *(LDSP u32x4v*)(XWB + j * LD64 + cq * 16) = pack8(ob); *(LDSP u32x4v*)(XWB + j * LD64 + cq * 16 + 8) = pack8(ob + 8);
    *(LDSP u32x4v*)(BG + j * LD64 + cq * 16) = pre.b0; *(LDSP u32x4v*)(BG + j * LD64 + cq * 16 + 8) = pre.b1;
    if (it_n >= 0) s1_load(p, it_n >> 3, it_n & 7, tid, pre);
    __syncthreads();
    const int dir = w >> 2, ut = w & 3; LDSP const bf16_t* XW = dir ? XWB : XWF;
    f32x4v acc[4];
#pragma unroll
    for (int q = 0; q < 4; ++q) acc[q] = (f32x4v){0.f, 0.f, 0.f, 0.f};
#pragma unroll
    for (int ks = 0; ks < 4; ++ks) { const bf16x8v u = frag_col(BG, LD64, 16 * ut, 32 * ks, lane);
#pragma unroll
        for (int q = 0; q < 4; ++q) acc[q] = mfma16(u, frag_col(XW, LD64, 16 * q, 32 * ks, lane), acc[q]); }
    bf16_t* dst = p.SS + ((size_t)((tl * 8 + h) * 2 + dir) * 64) * 64;
#pragma unroll
    for (int q = 0; q < 4; ++q) *(u32x2v*)(dst + (size_t)(16 * q + (lane & 15)) * 64 + 16 * ut + 4 * (lane >> 4)) = pack4(acc[q]);
}
DI void ph_s1(const P& p, int l, LDSP unsigned char* lds) {
    S1Pre pre; int it = ssd_item(0, NTILE);
    if (it >= 0) s1_load(p, it >> 3, it & 7, ltid(), pre);
    for (int k = 0; it >= 0; ++k) { const int nx = ssd_item(k + 1, NTILE); s1_ssd(p, it >> 3, it & 7, pre, nx, lds); it = nx; }
}

DI int s2_chunk(int dir, int s) { return dir == 0 ? s : (s < 2 ? 1 - s : 35 - s); }
DI void ph_s2(const P& p) {
    const int g = blockIdx.x * NTHR + ltid();
    for (int v = g; v < 131072; v += gridDim.x * NTHR) {
        const bool gla = v >= 65536; const int r = v & 65535;
        int b, h, dir, vi;
        if (!gla) { vi = r & 511; dir = (r >> 9) & 1; h = (r >> 10) & 7; b = r >> 13; } else { vi = r & 1023; dir = (r >> 10) & 1; h = (r >> 11) & 3; b = r >> 13; }
        float st[8];
#pragma unroll
        for (int e = 0; e < 8; ++e) st[e] = 0.f;
        for (int s0 = 0; s0 < NCH; s0 += 6) {
            u32x4v sv[6]; float dsc[6]; f32x4v dv0[6], dv1[6];
#pragma unroll
            for (int u = 0; u < 6; ++u) { if (s0 + u >= NCH) continue; const int tl = b * NCH + s2_chunk(dir, s0 + u);
                if (!gla) { sv[u] = *(const u32x4v*)(p.SS + ((size_t)((tl * 8 + h) * 2 + dir) * 512 + vi) * 8); dsc[u] = p.SDEC[(tl * 8 + h) * 2 + dir]; }
                else { sv[u] = *(const u32x4v*)(p.GS + ((size_t)((tl * 4 + h) * 2 + dir) * 1024 + vi) * 8); const f32x4v* d = (const f32x4v*)(p.GDEC + (size_t)((tl * 4 + h) * 2 + dir) * 64 + (vi & 7) * 8); dv0[u] = d[0]; dv1[u] = d[1]; } }
#pragma unroll
            for (int u = 0; u < 6; ++u) { if (s0 + u >= NCH) continue; const int tl = b * NCH + s2_chunk(dir, s0 + u);
                float loc[8]; unpack8(sv[u], loc);
                const u32x4v hin = pack8(st);
                if (!gla) { *(u32x4v*)(p.SS + ((size_t)((tl * 8 + h) * 2 + dir) * 512 + vi) * 8) = hin;
#pragma unroll
                    for (int e = 0; e < 8; ++e) st[e] = dsc[u] * st[e] + loc[e]; }
                else { *(u32x4v*)(p.GS + ((size_t)((tl * 4 + h) * 2 + dir) * 1024 + vi) * 8) = hin;
                    const float dd[8] = {dv0[u].x, dv0[u].y, dv0[u].z, dv0[u].w, dv1[u].x, dv1[u].y, dv1[u].z, dv1[u].w};
#pragma unroll
                    for (int e = 0; e < 8; ++e) st[e] = dd[e] * st[e] + loc[e]; } }
        }
    }
}

DI int s3_tile(int l, int q) { return l == 0 ? q : (q >> 5) * NCH + 2 + (q & 31); }
struct SsdPre { u32x4v x0, x1, b0, b1, c0, c1, hf, hb; f32x4v sc; };
DI void s3_ssd_load(const P& p, int tl, int h, int tid, int i, int G, SsdPre& r) {
    const int tok0 = tile_tok0(tl), g = h >> 2; const XbcSrc xs = xbc_src(p, tok0);
    const int j = tid >> 2, cq = tid & 3; const bf16_t* row = xs.base + (size_t)j * xs.ld;
    r.x0 = *(const u32x4v*)(row + h * 64 + cq * 16); r.x1 = *(const u32x4v*)(row + h * 64 + cq * 16 + 8);
    r.b0 = *(const u32x4v*)(row + 512 + g * 64 + cq * 16); r.b1 = *(const u32x4v*)(row + 512 + g * 64 + cq * 16 + 8);
    r.c0 = *(const u32x4v*)(row + 640 + g * 64 + cq * 16); r.c1 = *(const u32x4v*)(row + 640 + g * 64 + cq * 16 + 8);
    const bf16_t* Hf = p.SS + (size_t)((tl * 8 + h) * 2 + 0) * 4096 + (tid >> 3) * 64 + (tid & 7) * 8;
    r.hf = *(const u32x4v*)Hf; r.hb = *(const u32x4v*)(Hf + 4096);
    r.sc = *((const f32x4v*)p.SSC + (size_t)(tok0 + (tid & 127)) * 8 + h);
}
DI void ph_s3_ssd(const P& p, int l, LDSP unsigned char* lds) {
    const int tid = ltid(), lane = tid & 63, w = __builtin_amdgcn_readfirstlane(tid >> 6), G = lane >> 4, li = lane & 15, i = 16 * w + li;
    LDSP bf16_t* XH = (LDSP bf16_t*)lds; LDSP bf16_t* BG = XH + 128 * LD64; LDSP bf16_t* CG = BG + 128 * LD64; LDSP bf16_t* MM = CG + 128 * LD64; LDSP f32x4v* SC = (LDSP f32x4v*)(MM + 128 * LD128);
    LDSP bf16_t* HF = (LDSP bf16_t*)(SC + 128); LDSP bf16_t* HB = HF + 64 * LD64;
    const int ntl = l == 0 ? NTILE : NB * 32;
    int it = ssd_item(0, ntl); SsdPre pre;
    if (it >= 0) s3_ssd_load(p, s3_tile(l, it >> 3), it & 7, tid, i, G, pre);
    for (int k_ = 0; it >= 0; ++k_) {
        const int it_n = ssd_item(k_ + 1, ntl);
        const int tl = s3_tile(l, it >> 3), h = it & 7, tok0 = tile_tok0(tl);
        __syncthreads();
        { const int j = tid >> 2, cq = tid & 3;
          *(LDSP u32x4v*)(XH + j * LD64 + cq * 16) = pre.x0; *(LDSP u32x4v*)(XH + j * LD64 + cq * 16 + 8) = pre.x1;
          *(LDSP u32x4v*)(BG + j * LD64 + cq * 16) = pre.b0; *(LDSP u32x4v*)(BG + j * LD64 + cq * 16 + 8) = pre.b1;
          *(LDSP u32x4v*)(CG + j * LD64 + cq * 16) = pre.c0; *(LDSP u32x4v*)(CG + j * LD64 + cq * 16 + 8) = pre.c1;
          *(LDSP u32x4v*)(HF + (tid >> 3) * LD64 + (tid & 7) * 8) = pre.hf; *(LDSP u32x4v*)(HB + (tid >> 3) * LD64 + (tid & 7) * 8) = pre.hb;
          if (tid < 128) SC[tid] = pre.sc; }
        if (it_n >= 0) s3_ssd_load(p, s3_tile(l, it_n >> 3), it_n & 7, tid, i, G, pre);
        __syncthreads();
        u32x2v zr[4];
#pragma unroll
        for (int pt = 0; pt < 4; ++pt) zr[pt] = *(const u32x2v*)(p.PROJ + (size_t)(tok0 + i) * LDP + OFF_Z + h * 64 + 16 * pt + 4 * G);
        const f32x4v sci = SC[i];
        {
            f32x4v am[8];
#pragma unroll
            for (int ut = 0; ut < 8; ++ut) am[ut] = (f32x4v){0.f, 0.f, 0.f, 0.f};
#pragma unroll
            for (int ks = 0; ks < 2; ++ks) { const bf16x8v vfr = frag_row(CG, LD64, 16 * w, 32 * ks, lane);
#pragma unroll
                for (int ut = 0; ut < 8; ++ut) am[ut] = mfma16(frag_row(BG, LD64, 16 * ut, 32 * ks, lane), vfr, am[ut]); }
#pragma unroll
            for (int ut = 0; ut < 8; ++ut) { f32x4v m;
#pragma unroll
                for (int r = 0; r < 4; ++r) { const int jj = 16 * ut + 4 * G + r; const f32x4v scj = SC[jj];
                    const float Lf = jj <= i ? __builtin_amdgcn_exp2f(fminf(sci.x - scj.y, 30.f)) : 0.f, Lb = jj >= i ? __builtin_amdgcn_exp2f(fminf(sci.z - scj.w, 30.f)) : 0.f;
                    m[r] = am[ut][r] * (Lf + Lb); }
                *(LDSP u32x2v*)(MM + i * LD128 + 16 * ut + 4 * G) = pack4(m); }
        }
        asm volatile("s_waitcnt lgkmcnt(0)" ::: "memory");
        f32x4v ay[4], af_[4], ab_[4];
#pragma unroll
        for (int pt = 0; pt < 4; ++pt) { ay[pt] = (f32x4v){0.f, 0.f, 0.f, 0.f}; af_[pt] = ay[pt]; ab_[pt] = ay[pt]; }
#pragma unroll
        for (int ks = 0; ks < 2; ++ks) { const bf16x8v vfr = frag_row(CG, LD64, 16 * w, 32 * ks, lane);
#pragma unroll
            for (int pt = 0; pt < 4; ++pt) { af_[pt] = mfma16(frag_row(HF, LD64, 16 * pt, 32 * ks, lane), vfr, af_[pt]); ab_[pt] = mfma16(frag_row(HB, LD64, 16 * pt, 32 * ks, lane), vfr, ab_[pt]); } }
#pragma unroll
        for (int ks = 0; ks < 4; ++ks) { const bf16x8v vfr = frag_row(MM, LD128, 16 * w, 32 * ks, lane);
#pragma unroll
            for (int pt = 0; pt < 4; ++pt) ay[pt] = mfma16(frag_col(XH, LD64, 16 * pt, 32 * ks, lane), vfr, ay[pt]); }
        const float sf = __builtin_amdgcn_exp2f(sci.x), sb = __builtin_amdgcn_exp2f(sci.z), dsk = p.d_skip[l * 8 + h];
        float ssq = 0.f;
#pragma unroll
        for (int pt = 0; pt < 4; ++pt) { const int pc = 16 * pt + 4 * G;
            const u32x2v xr = *(LDSP const u32x2v*)(XH + i * LD64 + pc);
            const float xv[4] = {__uint_as_float(xr.x << 16), __uint_as_float(xr.x & 0xffff0000u), __uint_as_float(xr.y << 16), __uint_as_float(xr.y & 0xffff0000u)};
            const float zv[4] = {__uint_as_float(zr[pt].x << 16), __uint_as_float(zr[pt].x & 0xffff0000u), __uint_as_float(zr[pt].y << 16), __uint_as_float(zr[pt].y & 0xffff0000u)};
            float yv[4];
#pragma unroll
            for (int r = 0; r < 4; ++r) { yv[r] = (ay[pt][r] + sf * af_[pt][r] + sb * ab_[pt][r] + dsk * xv[r]) * siluf(zv[r]); yv[r] = bf2f(f2bf(yv[r])); ssq += yv[r] * yv[r]; }
            *(u32x2v*)(p.H + (size_t)(tok0 + i) * D + h * 64 + pc) = mk2(pk2(yv[0], yv[1]), pk2(yv[2], yv[3])); }
        ssq += shx(ssq, 16, lane); ssq += shx(ssq, 32, lane);
        if (G == 0) p.SSQ[(size_t)(tok0 + i) * 8 + h] = ssq;
        it = it_n;
    }
}
DI int gla_item(int k, int nit) {
    const int G_ = gridDim.x, b = blockIdx.x;
    if (G_ != 256) { const int it = b + k * G_; return it < nit ? it : -1; }
    const int full = nit >> 8;
    if (k < full) return b + (k << 8);
    if (k > full || (b & 7) >= 4) return -1;
    const int idx = (b >> 3) * 4 + (b & 7);
    return idx < (nit & 255) ? (full << 8) + idx : -1;
}
struct GlaPre { u32x4v qk[2][4], vv[4], sf[2], sb[2]; };
DI void s3_gla_load(const P& p, int tl, int h, int tid, int i, int G, GlaPre& r) {
    const int tok0 = tile_tok0(tl);
#pragma unroll
    for (int q = 0; q < 2; ++q) { const int c = tid + q * NTHR, rr = c >> 3, cc = c & 7; const bf16_t* qb = p.QKB + (size_t)(tok0 + rr) * 1024 + h * 64 + cc * 8;
        r.qk[q][0] = *(const u32x4v*)qb; r.qk[q][1] = *(const u32x4v*)(qb + 256);
        r.qk[q][2] = *(const u32x4v*)(qb + 512); r.qk[q][3] = *(const u32x4v*)(qb + 768);
        const bf16_t* Sg = p.GS + (size_t)((tl * 4 + h) * 2 + 0) * 8192 + (size_t)rr * 64 + cc * 8; r.sf[q] = *(const u32x4v*)Sg; r.sb[q] = *(const u32x4v*)(Sg + 8192); }
#pragma unroll
    for (int q = 0; q < 4; ++q) { const int c = tid + q * NTHR, rr = c >> 4, cc = c & 15; r.vv[q] = *(const u32x4v*)(p.PROJ + (size_t)(tok0 + rr) * LDP + OFF_V + h * 128 + cc * 8); }
}
DI void ph_s3_gla(const P& p, int l, LDSP unsigned char* lds) {
    const int tid = ltid(), lane = tid & 63, w = __builtin_amdgcn_readfirstlane(tid >> 6), G = lane >> 4, li = lane & 15, i = 16 * w + li;
    LDSP bf16_t* Q2 = (LDSP bf16_t*)lds;
    LDSP bf16_t* KF = Q2 + 8 * 2 * 16 * LD64; LDSP bf16_t* KB = KF + 128 * LD64; LDSP bf16_t* VT = KB + 128 * LD64; LDSP bf16_t* SF = VT + 128 * LD128; LDSP bf16_t* SB = SF + 128 * LD64;
    LDSP bf16_t* AMw = SF + w * 16 * LD128;
    const int nit = (l == 0 ? NTILE : NB * 32) * 4;
    int it = gla_item(0, nit); GlaPre pre;
    if (it >= 0) s3_gla_load(p, s3_tile(l, it >> 2), it & 3, tid, i, G, pre);
    for (int k_ = 0; it >= 0; ++k_) {
        const int it_n = gla_item(k_ + 1, nit);
        const int tl = s3_tile(l, it >> 2), h = it & 3, tok0 = tile_tok0(tl);
        __syncthreads();
#pragma unroll
        for (int q = 0; q < 2; ++q) { const int c = tid + q * NTHR, rr = c >> 3, cc = c & 7; LDSP bf16_t* qrow = Q2 + (rr >> 4) * (2 * 16 * LD64) + (rr & 15) * LD64 + cc * 8;
            *(LDSP u32x4v*)qrow = pre.qk[q][0]; *(LDSP u32x4v*)(qrow + 16 * LD64) = pre.qk[q][2];
            *(LDSP u32x4v*)(KF + rr * LD64 + cc * 8) = pre.qk[q][1]; *(LDSP u32x4v*)(KB + rr * LD64 + cc * 8) = pre.qk[q][3];
            *(LDSP u32x4v*)(SF + rr * LD64 + cc * 8) = pre.sf[q]; *(LDSP u32x4v*)(SB + rr * LD64 + cc * 8) = pre.sb[q]; }
#pragma unroll
        for (int q = 0; q < 4; ++q) { const int c = tid + q * NTHR, rr = c >> 4, cc = c & 15; *(LDSP u32x4v*)(VT + rr * LD128 + cc * 8) = pre.vv[q]; }
        if (it_n >= 0) s3_gla_load(p, s3_tile(l, it_n >> 2), it_n & 3, tid, i, G, pre);
        __syncthreads();
        f32x4v ao[8];
#pragma unroll
        for (int q = 0; q < 8; ++q) ao[q] = (f32x4v){0.f, 0.f, 0.f, 0.f};
        bf16x8v qfr[2][2];
#pragma unroll
        for (int dir = 0; dir < 2; ++dir)
#pragma unroll
            for (int ks = 0; ks < 2; ++ks) qfr[dir][ks] = frag_row(Q2 + w * (2 * 16 * LD64) + dir * 16 * LD64, LD64, 0, 32 * ks, lane);
#pragma unroll
        for (int dir = 0; dir < 2; ++dir) {
            LDSP const bf16_t* SS_ = dir ? SB : SF;
#pragma unroll
            for (int ks = 0; ks < 2; ++ks) {
#pragma unroll
                for (int vt = 0; vt < 8; ++vt) ao[vt] = mfma16(frag_row(SS_, LD64, 16 * vt, 32 * ks, lane), qfr[dir][ks], ao[vt]); }
        }
        __syncthreads();
#pragma unroll
        for (int uh = 0; uh < 4; ++uh) {
            f32x4v a2[2]; a2[0] = (f32x4v){0.f, 0.f, 0.f, 0.f}; a2[1] = a2[0];
#pragma unroll
            for (int dir = 0; dir < 2; ++dir) {
                LDSP const bf16_t* KS = dir ? KB : KF;
                f32x4v as[2]; as[0] = (f32x4v){0.f, 0.f, 0.f, 0.f}; as[1] = as[0];
#pragma unroll
                for (int ks = 0; ks < 2; ++ks) {
#pragma unroll
                    for (int q = 0; q < 2; ++q) as[q] = mfma16(frag_row(KS, LD64, 16 * (2 * uh + q), 32 * ks, lane), qfr[dir][ks], as[q]); }
#pragma unroll
                for (int q = 0; q < 2; ++q)
#pragma unroll
                    for (int r = 0; r < 4; ++r) { const int jj = 16 * (2 * uh + q) + 4 * G + r; const bool keep = dir == 0 ? (jj <= i) : (jj >= i); a2[q][r] += keep ? as[q][r] : 0.f; }
            }
#pragma unroll
            for (int q = 0; q < 2; ++q) *(LDSP u32x2v*)(AMw + li * LD128 + 16 * (2 * uh + q) + 4 * G) = pack4(a2[q]);
        }
        u32x2v gr[8];
#pragma unroll
        for (int vt = 0; vt < 8; ++vt) gr[vt] = *(const u32x2v*)(p.PROJ + (size_t)(tok0 + i) * LDP + OFF_GO + h * 128 + 16 * vt + 4 * G);
        asm volatile("s_waitcnt lgkmcnt(0)" ::: "memory");
#pragma unroll
        for (int ks = 0; ks < 4; ++ks) { const bf16x8v vfr = frag_row(AMw, LD128, 0, 32 * ks, lane);
#pragma unroll
            for (int vt = 0; vt < 8; ++vt) ao[vt] = mfma16(frag_col(VT, LD128, 16 * vt, 32 * ks, lane), vfr, ao[vt]); }
        float so = 0.f;
#pragma unroll
        for (int vt = 0; vt < 8; ++vt)
#pragma unroll
            for (int r = 0; r < 4; ++r) so += ao[vt][r] * ao[vt][r];
        so += shx(so, 16, lane); so += shx(so, 32, lane);
        const float ro = rsqrtf(so * (1.0f / 128.0f) + 1e-6f);
#pragma unroll
        for (int vt = 0; vt < 8; ++vt) { const int vc = 16 * vt + 4 * G; const f32x4v gg = *(const f32x4v*)(p.gla_norm_g + l * 128 + vc);
            const float g0 = __uint_as_float(gr[vt].x << 16), g1 = __uint_as_float(gr[vt].x & 0xffff0000u), g2 = __uint_as_float(gr[vt].y << 16), g3 = __uint_as_float(gr[vt].y & 0xffff0000u);
            *(u32x2v*)(p.H + (size_t)(tok0 + i) * D + 512 + h * 128 + vc) = mk2(pk2(ao[vt][0] * ro * gg.x * siluf(g0), ao[vt][1] * ro * gg.y * siluf(g1)), pk2(ao[vt][2] * ro * gg.z * siluf(g2), ao[vt][3] * ro * gg.w * siluf(g3))); }
        it = it_n;
    }
}
DI void ph_s3(const P& p, int l, LDSP unsigned char* lds) { ph_s3_gla(p, l, lds); ph_s3_ssd(p, l, lds); }
struct RouteR { bool own; int t, e1, e2, r1, r2; };
template <int NR> DI void normroute_tile(const P& p, int tb, const float* MODl, LDSP int* lcnt, const float* g2, LDSP bf16_t* WR, LDSP bf16_t* HT, int lane, int G, int li, RouteR& R) {
    constexpr int LDW = 1032, LDT = 264;
        const float* mr = MODl + (size_t)tok_modrow(tb) * 6144;
        float rs[NR];
        { const f32x4v* q = (const f32x4v*)(p.XSS + (size_t)(tb + (li < NR ? li : 0)) * 16); const f32x4v a = q[0], b = q[1], c = q[2], d = q[3];
          const float ss = (((a.x + a.y) + (a.z + a.w)) + ((b.x + b.y) + (b.z + b.w))) + (((c.x + c.y) + (c.z + c.w)) + ((d.x + d.y) + (d.z + d.w)));
          const float r = rsqrtf(ss * (1.0f / D) + 1e-6f);
#pragma unroll
          for (int i = 0; i < NR; ++i) rs[i] = shl(r, i); }
        f32x4v acc[2]; acc[0] = (f32x4v){0.f, 0.f, 0.f, 0.f}; acc[1] = acc[0];
        u32x2v xq[NR];
#pragma unroll
        for (int i = 0; i < NR; ++i) xq[i] = *(const u32x2v*)(xrow(p, tb + i) + lane * 4);
#pragma unroll
        for (int kc = 0; kc < 4; ++kc) {
            const int kk = kc * 256 + lane * 4;
            const f32x4v gg = *(const f32x4v*)(g2 + kk), sh = *(const f32x4v*)(mr + 3 * 1024 + kk), sc = *(const f32x4v*)(mr + 4 * 1024 + kk);
            f32x4v gs;
#pragma unroll
            for (int j = 0; j < 4; ++j) gs[j] = gg[j] * (1.f + sc[j]);
#pragma unroll
            for (int i = 0; i < NR; ++i) { const u32x2v r = xq[i];
                const f32x4v xv = mkf4(__uint_as_float(r.x << 16), __uint_as_float(r.x & 0xffff0000u), __uint_as_float(r.y << 16), __uint_as_float(r.y & 0xffff0000u));
                const f32x4v h = xv * rs[i] * gs + sh; const u32x2v hb = pack4(h);
                *(unsigned*)((unsigned char*)p.H + (size_t)(tb + i) * D + kk) = pg8::pk4_fp8(h);
                *(LDSP u32x2v*)(HT + i * LDT + lane * 4) = hb; }
            if (kc < 3) {
#pragma unroll
                for (int i = 0; i < NR; ++i) xq[i] = *(const u32x2v*)(xrow(p, tb + i) + kk + 256); }
            asm volatile("s_waitcnt lgkmcnt(0)" ::: "memory");
#pragma unroll
            for (int ks = 0; ks < 8; ++ks) { const bf16x8v vfr = frag_row(HT, LDT, 0, 32 * ks, lane);
                acc[0] = mfma16(frag_row(WR, LDW, 0, kc * 256 + 32 * ks, lane), vfr, acc[0]);
                acc[1] = mfma16(frag_row(WR, LDW, 16, kc * 256 + 32 * ks, lane), vfr, acc[1]); }
            asm volatile("s_waitcnt lgkmcnt(0)" ::: "memory");
        }
        float bgs = -1e30f; int bgi = 0, e1 = 0, e2 = 0; float w1 = 0.f, w2 = 0.f;
#pragma unroll
        for (int ut = 0; ut < 2; ++ut) { const int gi = ut * 4 + G; float m1 = -1e30f, m2 = -1e30f, s1 = 0.f, s2 = 0.f; int i1 = 0, i2 = 0;
#pragma unroll
            for (int r = 0; r < 4; ++r) { const float sv = 1.0f / (1.0f + __expf(-acc[ut][r])), vv = sv + p.router_bias[gi * 4 + r];
                if (vv > m1) { m2 = m1; i2 = i1; s2 = s1; m1 = vv; i1 = gi * 4 + r; s1 = sv; } else if (vv > m2) { m2 = vv; i2 = gi * 4 + r; s2 = sv; } }
            if (m1 + m2 > bgs) { bgs = m1 + m2; bgi = gi; e1 = i1; e2 = i2; w1 = s1; w2 = s2; } }
#pragma unroll
        for (int o = 16; o <= 32; o <<= 1) {
            const float ogs = shx(bgs, o, lane), ow1 = shx(w1, o, lane), ow2 = shx(w2, o, lane); const int ogi = shxi(bgi, o, lane), oe1 = shxi(e1, o, lane), oe2 = shxi(e2, o, lane);
            if (ogs > bgs || (ogs == bgs && ogi < bgi)) { bgs = ogs; bgi = ogi; e1 = oe1; e2 = oe2; w1 = ow1; w2 = ow2; } }
        R.own = (G == 0 && li < NR); R.t = tb + li; R.e1 = e1; R.e2 = e2;
        if (R.own) { const float inv = 1.0f / (w1 + w2); p.EW[R.t * 2 + 0] = w1 * inv; p.EW[R.t * 2 + 1] = w2 * inv;
            R.r1 = __hip_atomic_fetch_add(&lcnt[e1], 1, __ATOMIC_RELAXED, __HIP_MEMORY_SCOPE_WORKGROUP); R.r2 = __hip_atomic_fetch_add(&lcnt[e2], 1, __ATOMIC_RELAXED, __HIP_MEMORY_SCOPE_WORKGROUP); }
}
DI void ph_normroute(const P& p, int l, int t0, LDSP unsigned char* lds) {
    const int tid_ = ltid(), lane = tid_ & 63, wv = tid_ >> 6, gw = blockIdx.x * NWV + wv, NW = gridDim.x * NWV, G = lane >> 4, li = lane & 15;
    const float* MODl = p.MOD + (size_t)l * 9 * 6144; int* counts = p.counts + l * 32 * 32;
    constexpr int LDW = 1032, LDT = 264;
    LDSP bf16_t* WR = (LDSP bf16_t*)lds;
    LDSP bf16_t* HT = WR + 32 * LDW + wv * 16 * LDT;
    { u32x4v wv_[8];
#pragma unroll
      for (int q = 0; q < 8; ++q) wv_[q] = *(const u32x4v*)(p.WRT + (size_t)(tid_ + q * NTHR) * 8);
#pragma unroll
      for (int q = 0; q < 8; ++q) { const int c = tid_ + q * NTHR; *(LDSP u32x4v*)(WR + (c >> 7) * LDW + (c & 127) * 8) = wv_[q]; } }
    __syncthreads();
    const float* g2 = p.norm2_g + l * D;
    const int ntok = T - t0, nfull = (ntok >> 4) / NW * NW, nrem = ntok - nfull * 16;
    LDSP int* lcnt = (LDSP int*)(WR + 32 * LDW + NWV * 16 * LDT);
    LDSP int* lbase = lcnt + 32;
    const int rf = (nfull + NW - 1) / NW, rr = (nrem + NW - 1) / NW;
    for (int rd = 0; rd < rf + rr; ++rd) {
        if (tid_ < 32) lcnt[tid_] = 0;
        __syncthreads();
        RouteR R; R.own = false; R.t = 0; R.e1 = 0; R.e2 = 0; R.r1 = 0; R.r2 = 0;
        if (rd < rf) { const int tile = rd * NW + gw; if (tile < nfull) normroute_tile<16>(p, t0 + tile * 16, MODl, lcnt, g2, WR, HT, lane, G, li, R); }
        else { const int e = (rd - rf) * NW + gw; if (e < nrem) normroute_tile<1>(p, t0 + nfull * 16 + e, MODl, lcnt, g2, WR, HT, lane, G, li, R); }
        __syncthreads();
        if (tid_ < 32) { const int c = lcnt[tid_]; lbase[tid_] = c > 0 ? atomicAdd(&counts[tid_ * 32], c) : 0; }
        __syncthreads();
        if (R.own) { const int r1 = lbase[R.e1] + R.r1, r2 = lbase[R.e2] + R.r2;
            p.MAP[(size_t)R.e1 * T + r1] = R.t; p.MAP[(size_t)R.e2 * T + r2] = R.t;
            *(int4*)(p.TOKSLOT + (size_t)R.t * 4) = make_int4(R.e1, r1, R.e2, r2); }
    }
}

DI void ph_combine(const P& p, int l, int t0, const unsigned char* Y  , LDSP int* ps  ) {
    const int tid_ = ltid(), lane = tid_ & 63, gw = blockIdx.x * NWV + __builtin_amdgcn_readfirstlane(tid_ >> 6)  , NW = gridDim.x * NWV;
    const float* MODl = p.MOD + (size_t)l * 9 * 6144; const int* counts = p.counts + l * 32 * 32;
    if (tid_ < 64) { const int cnt = tid_ < 32 ? counts[tid_ * 32] : 0; int pc = cnt;
#pragma unroll
        for (int o = 1; o < 32; o <<= 1) { const int src = lane >= o ? lane - o : lane; const int a = shli(pc, src); if (lane >= o) pc += a; }
        if (tid_ < 32) ps[tid_] = pc - cnt; }
    __syncthreads();
    for (int t = t0 + 4 * gw; t < T; t += 4 * NW) {
        int4 sl[4]; float4 ew[2];
#pragma unroll
        for (int u = 0; u < 4; ++u) sl[u] = *(const int4*)(p.TOKSLOT + (size_t)(t + u) * 4);
        ew[0] = *(const float4*)(p.EW + (size_t)t * 2); ew[1] = *(const float4*)(p.EW + (size_t)(t + 2) * 2);
        unsigned yr[4][2][4];
#pragma unroll
        for (int u = 0; u < 4; ++u) { const unsigned char* y0 = Y + (size_t)__builtin_amdgcn_readfirstlane(ps[sl[u].x] + sl[u].y) * D; const unsigned char* y1 = Y + (size_t)__builtin_amdgcn_readfirstlane(ps[sl[u].z] + sl[u].w) * D;
#pragma unroll
            for (int i = 0; i < 4; ++i) { yr[u][0][i] = *(const unsigned*)(y0 + (i * 64 + lane) * 4); yr[u][1][i] = *(const unsigned*)(y1 + (i * 64 + lane) * 4); } }
        const float* mrow = MODl + (size_t)tok_modrow(t) * 6144; const float* g5 = mrow + 5 * 1024;
        const float* mr1 = p.MOD + (size_t)9 * 6144 + (size_t)tok_modrow(t) * 6144;
#pragma unroll
        for (int pr = 0; pr < 2; ++pr) {
            const float wgt[2][2] = {{ew[pr].x, ew[pr].y}, {ew[pr].z, ew[pr].w}};
            u32x2v xr[2][4];
#pragma unroll
            for (int u = 0; u < 2; ++u)
#pragma unroll
                for (int i = 0; i < 4; ++i) xr[u][i] = *(const u32x2v*)(xrow(p, t + 2 * pr + u) + (i * 64 + lane) * 4);
            float4 v[2][4];
#pragma unroll
            for (int i = 0; i < 4; ++i) { const int c = (i * 64 + lane) * 4; const float4 gg = *(const float4*)(g5 + c);
#pragma unroll
                for (int u = 0; u < 2; ++u) { const u32x2v x = xr[u][i]; const int a = (int)yr[2 * pr + u][0][i], b = (int)yr[2 * pr + u][1][i]; const float w1 = wgt[u][0], w2 = wgt[u][1];
                    v[u][i].x = __uint_as_float(x.x << 16) + gg.x * (w1 * __builtin_amdgcn_cvt_f32_fp8(a, 0) + w2 * __builtin_amdgcn_cvt_f32_fp8(b, 0));
                    v[u][i].y = __uint_as_float(x.x & 0xffff0000u) + gg.y * (w1 * __builtin_amdgcn_cvt_f32_fp8(a, 1) + w2 * __builtin_amdgcn_cvt_f32_fp8(b, 1));
                    v[u][i].z = __uint_as_float(x.y << 16) + gg.z * (w1 * __builtin_amdgcn_cvt_f32_fp8(a, 2) + w2 * __builtin_amdgcn_cvt_f32_fp8(b, 2));
                    v[u][i].w = __uint_as_float(x.y & 0xffff0000u) + gg.w * (w1 * __builtin_amdgcn_cvt_f32_fp8(a, 3) + w2 * __builtin_amdgcn_cvt_f32_fp8(b, 3));
                    if (l == 0) *(u32x2v*)(xrow(p, t + 2 * pr + u) + c) = mk2(pk2(v[u][i].x, v[u][i].y), pk2(v[u][i].z, v[u][i].w)); } }
            float rstd[2];
#pragma unroll
            for (int u = 0; u < 2; ++u) { float ss = 0.f;
#pragma unroll
                for (int i = 0; i < 4; ++i) ss += v[u][i].x * v[u][i].x + v[u][i].y * v[u][i].y + v[u][i].z * v[u][i].z + v[u][i].w * v[u][i].w;
                rstd[u] = rsqrtf(wave_sum(ss, lane) * (1.0f / D) + 1e-6f); }
            if (l == 0) {
#pragma unroll
                for (int i = 0; i < 4; ++i) { const int c = (i * 64 + lane) * 4;
                    const float4 gg = *(const float4*)(p.norm1_g + D + c), sh = *(const float4*)(mr1 + c), sc = *(const float4*)(mr1 + 1024 + c);
#pragma unroll
                    for (int u = 0; u < 2; ++u) { const float r = rstd[u];
                        *(unsigned*)((unsigned char*)p.H + (size_t)(t + 2 * pr + u) * D + c) = pg8::pk4_fp8((pg8::f32x4){v[u][i].x * r * gg.x * (1.f + sc.x) + sh.x, v[u][i].y * r * gg.y * (1.f + sc.y) + sh.y, v[u][i].z * r * gg.z * (1.f + sc.z) + sh.z, v[u][i].w * r * gg.w * (1.f + sc.w) + sh.w}); } }
            } else {
#pragma unroll
                for (int u = 0; u < 2; ++u)
#pragma unroll
                    for (int i = 0; i < 4; ++i) { const float4 gg = ((const float4*)p.final_g)[i * 64 + lane]; const float r = rstd[u];
                        ((float4*)(p.out + (size_t)(t + 2 * pr + u - TC) * D))[i * 64 + lane] = make_float4(v[u][i].x * r * gg.x, v[u][i].y * r * gg.y, v[u][i].z * r * gg.z, v[u][i].w * r * gg.w); }
            }
        }
    }
}

#define XLAS __attribute__((address_space(3)))
#define XB_TMO      128
#define XB_XCNT(j)  (256  + 64 * (j))
#define XB_XSUB(j)  (1280 + 64 * (j))
#define XB_XGEN(j)  (2304 + 64 * (j))
#define XB_TOP      3328
#define XB_TOPGEN   3392
#define XCD_BAR_WORDS 3456
#define XB_SPIN_CAP (1u << 18)

__device__ __forceinline__ unsigned xb_ld(unsigned* p)              { return __hip_atomic_load(p, __ATOMIC_RELAXED, __HIP_MEMORY_SCOPE_AGENT); }
__device__ __forceinline__ unsigned xb_add(unsigned* p, unsigned v) { return __hip_atomic_fetch_add(p, v, __ATOMIC_RELAXED, __HIP_MEMORY_SCOPE_AGENT); }
__device__ __forceinline__ unsigned xb_xcc_id() { return (unsigned)__builtin_amdgcn_s_getreg((3 << 11) | 20) & 0xFu; }
#define XB_SPIN(cond, bar) do { unsigned _sp = 0; while (cond) { __builtin_amdgcn_s_sleep(1); \
    if ((++_sp & 255u) == 0u) { if (xb_ld(&(bar)[XB_TMO])) break; if (_sp > XB_SPIN_CAP) { atomicAdd(&(bar)[XB_TMO], 1u); break; } } } } while (0)

struct XcdBarrier {
    unsigned* bar; unsigned x;
    volatile XLAS unsigned* st;
};

__device__ __forceinline__ XcdBarrier xcd_barrier_post(unsigned* bar, volatile XLAS unsigned* st) {
    XcdBarrier b; b.bar = bar; b.x = xb_xcc_id(); b.st = st;
    if (ltid() == 0) (void)xb_add(&bar[XB_XCNT(b.x)], 1u);
    return b;
}
__device__ __forceinline__ void xcd_barrier_complete(unsigned* bar, unsigned x, unsigned& nloc, unsigned& nx) {
    const unsigned G = gridDim.x * gridDim.y * gridDim.z;
    unsigned sum, cnt, mine, sp = 0u;
    for (;;) {
        sum = 0u; cnt = 0u; mine = 0u;
#pragma unroll
        for (unsigned j = 0; j < 16; ++j) { const unsigned c = xb_ld(&bar[XB_XCNT(j)]); sum += c; cnt += (c > 0u) ? 1u : 0u; mine = (j == x) ? c : mine; }
        if (sum == G) break;
        __builtin_amdgcn_s_sleep(1);
        if ((++sp & 255u) == 0u) { if (xb_ld(&bar[XB_TMO])) break; if (sp > XB_SPIN_CAP) { atomicAdd(&bar[XB_TMO], 1u); break; } }
    }
    nloc = mine > 0u ? mine : 1u; nx = cnt > 0u ? cnt : 1u;
}

__device__ __forceinline__ void xcd_barrier(const XcdBarrier& b) {
    asm volatile("s_waitcnt vmcnt(0)" ::: "memory");
    __syncthreads();
    if (ltid() == 0) {
        unsigned* bar = b.bar;
        __builtin_amdgcn_s_waitcnt(0);
        unsigned nloc = b.st[0], nx = b.st[1];
        if (nloc == 0u) { xcd_barrier_complete(bar, b.x, nloc, nx); b.st[0] = nloc; b.st[1] = nx; }
        const unsigned old = xb_add(&bar[XB_XSUB(b.x)], 1u);
        const unsigned gen = old / nloc;
        if (old + 1u == (gen + 1u) * nloc) {
            __builtin_amdgcn_fence(__ATOMIC_RELEASE, "agent");
            asm volatile("s_waitcnt vmcnt(0)" ::: "memory");
            const unsigned og = xb_add(&bar[XB_TOP], 1u);
            const unsigned tg = og / nx;
            if (og + 1u == (tg + 1u) * nx) xb_add(&bar[XB_TOPGEN], 1u);
            else XB_SPIN(xb_ld(&bar[XB_TOPGEN]) == tg, bar);
            __builtin_amdgcn_fence(__ATOMIC_ACQUIRE, "agent");
            xb_add(&bar[XB_XGEN(b.x)], 1u);
            asm volatile("s_waitcnt vmcnt(0)" ::: "memory");
        } else {
            XB_SPIN(xb_ld(&bar[XB_XGEN(b.x)]) == gen, bar);
            __builtin_amdgcn_fence(__ATOMIC_ACQUIRE, "agent");
            asm volatile("s_waitcnt vmcnt(0)" ::: "memory");
        }
    }
    __syncthreads();
}

DI void moe_table(const P& p, int l, PG8_LAS int* tab) {
    const int tid_ = ltid();
    if (tid_ < 64) { const int cnt = tid_ < 32 ? p.counts[(l * 32 + tid_) * 32] : 0; const int nt = (cnt + 255) >> 8; int pt = nt, pc = cnt;
#pragma unroll
        for (int o = 1; o < 32; o <<= 1) { const int ln_ = tid_ & 63, src = ln_ >= o ? ln_ - o : ln_; const int a = shli(pt, src), b = shli(pc, src); if (ln_ >= o) { pt += a; pc += b; } }
        if (tid_ < 32) { tab[tid_ + 1] = pt; tab[33 + tid_] = cnt; tab[65 + tid_] = pc - cnt; if (tid_ == 0) tab[0] = 0; } }
    __syncthreads();
}
typedef const __attribute__((address_space(4))) P* PK;
DI PK lp(PK q) { asm volatile("" : "+s"(q)); return q; }
#define PHASE(...) do { const P p = *(const P*)lp(pk); __VA_ARGS__; } while (0)

#ifndef CV_L0
#define CV_L0 7
#endif
template <int l> DI void layer(PK pk, unsigned char* smem, const XcdBarrier& xbar) {
    float* ldsf = (float*)smem; const int gw = 0, NW = 0, lane = 0;
    {
        constexpr int NG = l == 0 ? 234 : 182;
        constexpr int CV1 = l == 0 ? CV_L0 * 768 : NE * 768;
        const int G = (int)gridDim.x == 256 ? NG : (int)gridDim.x;
        if ((int)blockIdx.x < G) PHASE({ pg8::Gemm g{p.H, (const bf16_t*)((const unsigned char*)p.WinT + (size_t)l * NPAD_IN * D), T, NPAD_IN, D / 2}; pg8::StaticOrder S; S.init(T, NPAD_IN, G, (int)blockIdx.x);
            pg8::EpiProj E{p.PROJ, LDP, INDIM, 1.0f / 64.0f};
            pg8::gemm_phase<pg8::EpiProj, pg8::StaticOrder, false, PG8_SP2, 1>((PG8_LAS unsigned char*)smem, g, S, E, nullptr); });
        else PHASE(ph_convert_experts(p, l, ldsf, G, (int)gridDim.x - G, 0, CV1));
        if ((int)gridDim.x != 256) PHASE(ph_convert_experts(p, l, ldsf, 0, (int)gridDim.x, 0, CV1));
    }
    xcd_barrier(xbar);
    PHASE(ph_prep(p, l, (LDSP unsigned char*)smem));
    xcd_barrier(xbar);
    PHASE(ph_s1(p, l, (LDSP unsigned char*)smem));
    xcd_barrier(xbar);
    PHASE(ph_s2(p));
    xcd_barrier(xbar);
    PHASE(ph_s3(p, l, (LDSP unsigned char*)smem));
    xcd_barrier(xbar);
    {
        constexpr int ro = l == 0 ? 0 : TC;
        constexpr int NG = l == 0 ? 182 : 256;
        const int G = (int)gridDim.x == 256 ? NG : (int)gridDim.x;
        if ((int)blockIdx.x < G) PHASE({ pg8::Gemm g{p.H + (size_t)ro * D, p.WoutT + (size_t)l * D * D, T - ro, D, D}; pg8::StaticOrder S; S.init(T - ro, D, G, (int)blockIdx.x);
            pg8::EpiResGate<l != 0> E{p.SSQ, p.ctx, p.x, p.XB, p.MOD + (size_t)l * 9 * 6144 + 2 * 1024, p.XSS, ro};
            pg8::gemm_phase<pg8::EpiResGate<l != 0>, pg8::StaticOrder>((PG8_LAS unsigned char*)smem, g, S, E, nullptr); });
        else if (l == 0) PHASE(ph_convert_experts(p, l, ldsf, G, (int)gridDim.x - G, CV_L0 * 768, NE * 768));
        if (l == 0 && (int)gridDim.x != 256) PHASE(ph_convert_experts(p, l, ldsf, 0, (int)gridDim.x, CV_L0 * 768, NE * 768));
    }
    xcd_barrier(xbar);
    const int t0 = l == 0 ? 0 : TC;
    PHASE(ph_normroute(p, l, t0, (LDSP unsigned char*)smem));
    xcd_barrier(xbar);
    PG8_LAS int* tab = (PG8_LAS int*)((PG8_LAS unsigned char*)smem + pg8::STAGE_BYTES);
#pragma unroll
    for (int ph = 0; ph < 2; ++ph) {
        PHASE(moe_table(p, l, tab));
        const int U = __builtin_amdgcn_readfirstlane(tab[32]) * 4;
        if (ph == 0) PHASE({ pg8::Gemm g{p.H, p.WguT, T, D, D / 2}; pg8::MoeSched S{tab, p.MAP, U, (int)gridDim.x, (int)blockIdx.x, 4, 1, (size_t)D * D};
            pg8::EpiAct E{(unsigned char*)p.SS}; pg8::gemm_phase_moe<pg8::EpiAct, pg8::MoeSched, false, PG8_SP2, 1>((PG8_LAS unsigned char*)smem, g, S, E, nullptr); });
        else PHASE({ pg8::Gemm g{p.SS, p.WdT, T, D, 256}; pg8::MoeSched S{tab, p.MAP, U, (int)gridDim.x, (int)blockIdx.x, 4, 0, (size_t)D * 512};
            pg8::EpiY E{(unsigned char*)p.PROJ}; pg8::gemm_phase_moe<pg8::EpiY, pg8::MoeSched, false, PG8_SP2, 1>((PG8_LAS unsigned char*)smem, g, S, E, nullptr); });
        xcd_barrier(xbar);
    }
    PHASE(ph_combine(p, l, t0, (const unsigned char*)p.PROJ, (LDSP int*)smem));
    xcd_barrier(xbar);
}

__global__ void __launch_bounds__(NTHR) mega(P p_arg) {
    extern __shared__ __attribute__((aligned(16))) unsigned char smem[];
    cg::grid_group grid = cg::this_grid();
    PK pk = (PK)__builtin_amdgcn_kernarg_segment_ptr();
    const int lane = 0, gw = 0, NW = 0;
    float* ldsf = (float*)smem;
    volatile XLAS unsigned* bst = (volatile XLAS unsigned*)((XLAS unsigned char*)smem + LDS_BYTES - 16);
    { const int t_ = ltid(); if (t_ < 2) bst[t_] = 0u; }
    __syncthreads();
    const XcdBarrier xbar = xcd_barrier_post(pk->BAR, bst);
    PHASE(ph_init(p)); PHASE(ph_mod(p, ldsf)); PHASE(ph_convert_small(p, ldsf, gw, NW, lane));
    if (__builtin_expect(pk->BAR == nullptr, 0)) grid.sync();
    xcd_barrier(xbar);
    PHASE(ph_normmod1(p, 0, gw, NW, lane));
    xcd_barrier(xbar);
    layer<0>(pk, smem, xbar);
    layer<1>(pk, smem, xbar);
}

static inline size_t al(size_t x) { return (x + 255) & ~(size_t)255; }

extern "C" void kernel_launch(void* const* d_in, const int* in_sizes, int n_in, void* d_out, int out_size, void* d_ws, size_t ws_size, hipStream_t stream) {
    static int grid_blocks = 0;
    if (grid_blocks == 0) {
        int dev = 0, cus = 0, per_cu = 0;
        if (hipFuncSetAttribute((const void*)mega, hipFuncAttributeMaxDynamicSharedMemorySize, LDS_BYTES) != hipSuccess) { fprintf(stderr, "hipFuncSetAttribute failed\n"); grid_blocks = -1; return; }
        (void)hipGetDevice(&dev); (void)hipDeviceGetAttribute(&cus, hipDeviceAttributeMultiprocessorCount, dev);
        if (hipOccupancyMaxActiveBlocksPerMultiprocessor(&per_cu, (const void*)mega, NTHR, LDS_BYTES) != hipSuccess || per_cu < 1) { fprintf(stderr, "occupancy query: %d blocks/CU\n", per_cu); grid_blocks = -1; return; }
        grid_blocks = cus;
    }
    if (grid_blocks < 0) return;
    P p{};
    const float** pin = (const float**)&p;
    for (int i = 0; i < 29; ++i) pin[i] = (const float*)d_in[i];
    p.out = (float*)d_out;
    char* ws = (char*)d_ws; size_t off = 0;
    auto take = [&](size_t bytes) { char* q = ws + off; off += al(bytes); return q; };
    p.XB = (bf16_t*)take((size_t)T * D * 2);
    p.H = (bf16_t*)take((size_t)T * D * 2);
    p.PROJ = (bf16_t*)take((size_t)T * LDP * 2);
    p.SS = (bf16_t*)take((size_t)NTILE * 8 * 2 * 4096 * 2);
    p.GS = (bf16_t*)take((size_t)NTILE * 4 * 2 * 8192 * 2);
    p.SDEC = (float*)take((size_t)NTILE * 8 * 2 * 4);
    p.GDEC = (float*)take((size_t)NTILE * 4 * 2 * 64 * 4);
    p.MOD = (float*)take((size_t)2 * 9 * 6144 * 4);
    p.counts = (int*)take(64 * 32 * 4);
    p.TOKSLOT = (int*)take((size_t)T * 4 * 4);
    p.EW = (float*)take((size_t)T * 2 * 4);
    p.MAP = (int*)take((size_t)NE * T * 4);
    p.WinT = (bf16_t*)take((size_t)2 * NPAD_IN * D * 2);
    p.WoutT = (bf16_t*)take((size_t)2 * D * D * 2);
    p.WguT = (bf16_t*)take((size_t)NE * D * D * 2);
    p.WdT = (bf16_t*)take((size_t)NE * D * 512 * 2);
    p.WRT = (bf16_t*)take((size_t)32 * 1024 * 2);
    p.BAR = (unsigned*)take(XCD_BAR_WORDS * 4);
    p.XBCC = (bf16_t*)d_out;
    p.QKB = (bf16_t*)d_out + (size_t)T * 768;
    p.SSC = (float*)take((size_t)T * 8 * 4 * 4);
    p.STOT = (float*)take((size_t)NTILE * 8 * 2 * 4);
    p.SSQ = (float*)take((size_t)T * 8 * 4);
    p.XSS = (float*)take((size_t)T * 16 * 4);
    if (off > ws_size) { fprintf(stderr, "workspace too small: need %zu have %zu\n", off, ws_size); return; }
    if (hipMemsetAsync(p.BAR, 0, XCD_BAR_WORDS * 4, stream) != hipSuccess) { fprintf(stderr, "memset of barrier words failed\n"); return; }
    void* args[] = {&p};
    hipError_t e = hipLaunchCooperativeKernel((void*)mega, dim3(grid_blocks), dim3(NTHR), args, LDS_BYTES, stream);
    if (e != hipSuccess) fprintf(stderr, "cooperative launch failed: %s (grid %d)\n", hipGetErrorString(e), grid_blocks);
}
```

```cpp
#include <hip/hip_runtime.h>
#include <hip/hip_cooperative_groups.h>
#include <stdint.h>
#include <cstdio>
namespace cg = cooperative_groups;

typedef unsigned short bf16_t;
#define DI __device__ __forceinline__

constexpr int D = 1024, NB = 8, SEQ = 4096, CTXL = 256, TC = NB * CTXL, TL = NB * SEQ, T = TC + TL;
constexpr int INDIM = 2840, LDP = 2848;
constexpr int OFF_Z = 0, OFF_XBC = 512, OFF_DT = 1280, OFF_Q = 1288, OFF_K = 1544, OFF_V = 1800, OFF_GO = 2312, OFF_GK = 2824;
constexpr int NE = 32;

DI float bf2f(bf16_t v) { return __uint_as_float(((unsigned)v) << 16); }
typedef float f32x2v_ __attribute__((ext_vector_type(2)));
typedef __bf16 bf16x2v_ __attribute__((ext_vector_type(2)));
DI bf16_t f2bf(float f) { return __builtin_bit_cast(unsigned short, (__bf16)f); }
DI float siluf(float x) { return x * __builtin_amdgcn_rcpf(1.0f + __builtin_amdgcn_exp2f(-1.4426950408889634f * x)); }
DI float softplusf(float x) { return fmaxf(x, 0.f) + log1pf(__expf(-fabsf(x))); }
DI float logsigmoidf(float x) { return -softplusf(-x); }
DI float shx(float v, int o, int lane) { return __int_as_float(__builtin_amdgcn_ds_bpermute((lane ^ o) << 2, __float_as_int(v))); }
DI int shxi(int v, int o, int lane) { return __builtin_amdgcn_ds_bpermute((lane ^ o) << 2, v); }
DI float shl(float v, int src) { return __int_as_float(__builtin_amdgcn_ds_bpermute(src << 2, __float_as_int(v))); }
DI int shli(int v, int src) { return __builtin_amdgcn_ds_bpermute(src << 2, v); }
DI float wave_sum(float v, int lane) {
#pragma unroll
    for (int o = 32; o >= 1; o >>= 1) v += shx(v, o, lane);
    return v;
}
DI int ltid() { const int wv = __builtin_amdgcn_readfirstlane(threadIdx.x >> 6);
    int ln; asm volatile("v_mbcnt_lo_u32_b32 %0, -1, 0\n\tv_mbcnt_hi_u32_b32 %0, -1, %0" : "=v"(ln));
    return wv * 64 + ln; }
DI int tok_modrow(int t) { return t < TC ? 8 : ((t - TC) >> 12); }
template <class PT> DI bf16_t* xrow(const PT& p, int t) { return p.XB + (size_t)t * D; }


#ifndef PG8_SP2
#define PG8_SP2 true
#endif
namespace pg8 {
#define PG8_LAS __attribute__((address_space(3)))
typedef unsigned short bf16_t;
typedef short bf16x8 __attribute__((ext_vector_type(8)));
typedef float f32x4 __attribute__((ext_vector_type(4)));
typedef unsigned u32x4 __attribute__((ext_vector_type(4)));
constexpr int BM = 256, BK = 64, HALF = 128, HTB = HALF * BK * 2  , STAGE_BYTES = 8 * HTB, NXCD = 8, WGM = 8;

__host__ __device__ __forceinline__ int lds_byte(int r, int c) { const int st = (r >> 4) * 2 + (c >> 5), rr = r & 15, cc = c & 31, ob = rr * 64 + cc * 2; return st * 1024 + (ob ^ (((ob >> 9) & 1) << 5)); }
__host__ __device__ __forceinline__ void stage_rc(int b, int& R, int& C) { const int st = b / 1024, sb = b % 1024, swz = sb ^ (((sb >> 9) & 1) << 5); R = (st >> 1) * 16 + swz / 64; C = (st & 1) * 32 + (swz % 64) / 2; }
__host__ __device__ __forceinline__ int perm32(int rho) { const int n = rho >> 4, i = rho & 15; return 8 * (i >> 2) + 4 * n + (i & 3); }

struct Unit { int pm, pn; };
struct Gemm { const bf16_t* A; const bf16_t* Bt; int M, N, K; };

struct StaticOrder {
    int nM, nN, nwg, G, c;
    __host__ __device__ void init(int M, int N, int G_, int c_) { nM = M / BM; nN = N / BM; nwg = nM * nN; G = G_; c = c_; }
    __host__ __device__ bool next(int i, Unit& u) const {
        const long L = (long)i * G + c; if (L >= nwg) return false;
        int wgid = (int)L; { const int q = nwg / NXCD, r = nwg % NXCD, xcd = wgid % NXCD, off = wgid / NXCD; wgid = (xcd < r ? xcd * (q + 1) : r * (q + 1) + (xcd - r) * q) + off; }
        const int nig = WGM * nN, gid = wgid / nig, fm = gid * WGM, gsz = (nM - fm) < WGM ? (nM - fm) : WGM;
        u.pm = fm + ((wgid % nig) % gsz); u.pn = (wgid % nig) / gsz; return true;
    }
    __device__ __forceinline__ void a_ready(const Unit&) const {}
    __device__ __forceinline__ void done(const Unit&) const {}
};
__device__ __forceinline__ unsigned cvt_pk_bf16(float lo, float hi) { unsigned r; asm volatile("v_cvt_pk_bf16_f32 %0, %1, %2" : "=v"(r) : "v"(lo), "v"(hi)); return r; }
typedef float f32x2 __attribute__((ext_vector_type(2)));

typedef int i32x4 __attribute__((ext_vector_type(4)));
typedef int i32x8 __attribute__((ext_vector_type(8)));
__device__ __forceinline__ i32x8 cat8(bf16x8 a, bf16x8 b) { return __builtin_shufflevector(__builtin_bit_cast(i32x4, a), __builtin_bit_cast(i32x4, b), 0, 1, 2, 3, 4, 5, 6, 7); }
__device__ __forceinline__ void mfma8(f32x4& c, i32x8 a, i32x8 b) { asm volatile("v_mfma_f32_16x16x128_f8f6f4 %0, %1, %2, %0" : "+v"(c) : "v"(a), "v"(b)); }
__device__ __forceinline__ unsigned pk4_fp8(const f32x4 v) { const float lim = 440.f;
    int w = __builtin_amdgcn_cvt_pk_fp8_f32(__builtin_amdgcn_fmed3f(v[0], -lim, lim), __builtin_amdgcn_fmed3f(v[1], -lim, lim), 0, false);
    return (unsigned)__builtin_amdgcn_cvt_pk_fp8_f32(__builtin_amdgcn_fmed3f(v[2], -lim, lim), __builtin_amdgcn_fmed3f(v[3], -lim, lim), w, true); }
struct EpiProj {
    static constexpr bool PERM = true, AFTER_DRAIN = false, MIDK = false;
    bf16_t* O; int ldc; int ncols; float osc;
    __device__ __forceinline__ void operator()(const f32x4 (&acc)[2][2][4][2], const Unit& u, int wr, int wc, int fr, int fq) const {
        const int row0 = u.pm * BM + wr * 64 + fr, col0 = u.pn * BM + wc * 32 + 8 * fq;
#pragma unroll
        for (int ai = 0; ai < 2; ++ai)
#pragma unroll
            for (int m = 0; m < 4; ++m) { bf16_t* rowp = O + (size_t)(row0 + ai * HALF + m * 16) * ldc + col0;
#pragma unroll
                for (int bj = 0; bj < 2; ++bj) { const f32x4 v0 = acc[ai][bj][m][0] * osc, v1 = acc[ai][bj][m][1] * osc;
                    u32x4 w; w.x = cvt_pk_bf16(v0[0], v0[1]); w.y = cvt_pk_bf16(v0[2], v0[3]); w.z = cvt_pk_bf16(v1[0], v1[1]); w.w = cvt_pk_bf16(v1[2], v1[3]);
                    if (col0 + bj * HALF + 8 <= ncols) *(u32x4*)(rowp + bj * HALF) = w; } }
    }
};
template <bool SRC_BF16> struct EpiResGate {
    static constexpr bool PERM = true, AFTER_DRAIN = false, MIDK = true;
    const float* ssq;
    const float* Sc; const float* Sl;
    bf16_t* XB;
    const float* gate_rows; float* xss; int rowoff;
    template <class Sched> __device__ __forceinline__ void prep(PG8_LAS unsigned char* lds, const Sched& S, int tid) const {
        PG8_LAS float* RS = (PG8_LAS float*)(lds + STAGE_BYTES);
        const int r = tid & 255, i0 = tid >> 8;
        for (int i = i0; ; i += 2) { Unit u; if (!S.next(i, u)) break;
            const f32x4* q = (const f32x4*)(ssq + (size_t)(rowoff + u.pm * BM + r) * 8); const f32x4 a = q[0], b = q[1];
            RS[i * 256 + r] = 4.0f * __builtin_amdgcn_rsqf((((a[0] + a[1]) + (a[2] + a[3])) + ((b[0] + b[1]) + (b[2] + b[3]))) * (1.0f / 512.0f) + 1e-6f); }
    }
    __device__ __forceinline__ void midk(f32x4 (&acc)[2][2][4][2], PG8_LAS unsigned char* lds, int ui, int wr, int fr) const {
        int fr_ = fr; asm volatile("" : "+v"(fr_));
        PG8_LAS const float* RS = (PG8_LAS const float*)(lds + STAGE_BYTES) + ui * 256 + wr * 64 + fr_;
#pragma unroll
        for (int ai = 0; ai < 2; ++ai)
#pragma unroll
            for (int m = 0; m < 4; ++m) { const float rs = RS[ai * HALF + m * 16];
#pragma unroll
                for (int bj = 0; bj < 2; ++bj)
#pragma unroll
                    for (int n = 0; n < 2; ++n) acc[ai][bj][m][n] *= rs; }
    }
    __device__ __forceinline__ void operator()(const f32x4 (&acc)[2][2][4][2], const Unit& u, int wr, int wc, int fr, int fq) const {
        const int row0 = rowoff + u.pm * BM + wr * 64 + fr, col0 = u.pn * BM + wc * 32 + 8 * fq;
        const int t0 = rowoff + u.pm * BM; const int mrow = t0 < 2048 ? 8 : ((t0 - 2048) >> 12);
        const float* gr = gate_rows + (size_t)mrow * 6144 + col0;
        f32x4 gv[2][2];
#pragma unroll
        for (int bj = 0; bj < 2; ++bj)
#pragma unroll
            for (int n = 0; n < 2; ++n) gv[bj][n] = *(const f32x4*)(gr + bj * HALF + n * 4);
#pragma unroll
        for (int ai = 0; ai < 2; ++ai) {
            u32x4 rb[4][2]; f32x4 xf[SRC_BF16 ? 1 : 4][2][2];
#pragma unroll
            for (int m = 0; m < 4; ++m) { const int rr = row0 + ai * HALF + m * 16;
                const float* sp = (rr < 2048 ? Sc + (size_t)rr * 1024 : Sl + (size_t)(rr - 2048) * 1024) + col0; const bf16_t* dp = XB + (size_t)rr * 1024 + col0;
#pragma unroll
                for (int bj = 0; bj < 2; ++bj) {
                    if (SRC_BF16) rb[m][bj] = *(const u32x4*)(dp + bj * HALF);
                    else { xf[SRC_BF16 ? 0 : m][bj][0] = *(const f32x4*)(sp + bj * HALF); xf[SRC_BF16 ? 0 : m][bj][1] = *(const f32x4*)(sp + bj * HALF + 4); } } }
#pragma unroll
            for (int m = 0; m < 4; ++m) { const int rr = row0 + ai * HALF + m * 16;
                bf16_t* dp = XB + (size_t)rr * 1024 + col0; float ss = 0.f;
#pragma unroll
                for (int bj = 0; bj < 2; ++bj) { f32x4 x0, x1;
                    if (SRC_BF16) { const u32x4 r = rb[m][bj];
                        x0 = (f32x4){__uint_as_float(r.x << 16), __uint_as_float(r.x & 0xffff0000u), __uint_as_float(r.y << 16), __uint_as_float(r.y & 0xffff0000u)};
                        x1 = (f32x4){__uint_as_float(r.z << 16), __uint_as_float(r.z & 0xffff0000u), __uint_as_float(r.w << 16), __uint_as_float(r.w & 0xffff0000u)}; }
                    else { x0 = xf[SRC_BF16 ? 0 : m][bj][0]; x1 = xf[SRC_BF16 ? 0 : m][bj][1]; }
                    const f32x4 v0 = x0 + gv[bj][0] * (acc[ai][bj][m][0] * (1.0f / 512.0f)), v1 = x1 + gv[bj][1] * (acc[ai][bj][m][1] * (1.0f / 512.0f));
                    u32x4 w; w.x = cvt_pk_bf16(v0[0], v0[1]); w.y = cvt_pk_bf16(v0[2], v0[3]); w.z = cvt_pk_bf16(v1[0], v1[1]); w.w = cvt_pk_bf16(v1[2], v1[3]);
                    *(u32x4*)(dp + bj * HALF) = w;
#pragma unroll
                    for (int j = 0; j < 4; ++j) { const float lo = __uint_as_float(w[j] << 16), hi = __uint_as_float(w[j] & 0xffff0000u); ss += lo * lo + hi * hi; } }
                { const int ln_ = fq * 16 + fr; ss += __int_as_float(__builtin_amdgcn_ds_bpermute((ln_ ^ 16) << 2, __float_as_int(ss))); ss += __int_as_float(__builtin_amdgcn_ds_bpermute((ln_ ^ 32) << 2, __float_as_int(ss))); }
                if (fq == 0) xss[(size_t)rr * 16 + u.pn * 4 + wc] = ss; }
        }
    }
};
template <class Epi, class Sched, bool STAMP = false, bool SP2 = PG8_SP2, int SCW = -1>
__device__ __forceinline__ void gemm_phase(PG8_LAS unsigned char* lds, const Gemm g, const Sched& S, const Epi& E, unsigned long long* stamps) {
    int tid_l = __builtin_amdgcn_readfirstlane(threadIdx.x >> 6) * 64 + (int)__builtin_amdgcn_mbcnt_hi(~0u, __builtin_amdgcn_mbcnt_lo(~0u, 0u)); asm volatile("" : "+v"(tid_l));
    const int tid = tid_l, wid = __builtin_amdgcn_readfirstlane(tid >> 6), lane = tid & 63, wr = wid >> 2, wc = wid & 3, fr = lane & 15, fq = lane >> 4;
    const int K = g.K, nt = K / BK;
    int ts_lo = 0, ts_hi = 0, nts = 0; const unsigned long long rt_entry = STAMP ? (unsigned long long)wall_clock64() : 0ull;
#define PG8_STAMP() do { if (STAMP && wid == 0 && nts < 64) { const unsigned long long _c = (unsigned long long)clock64(); \
        ts_lo = (lane == nts) ? (int)(unsigned)_c : ts_lo; ts_hi = (lane == nts) ? (int)(unsigned)(_c >> 32) : ts_hi; ++nts; } } while (0)
    PG8_STAMP();
    unsigned voffA[2], voffB[2];
#pragma unroll
    for (int i = 0; i < 2; ++i) { int R, C; stage_rc(tid * 16 + i * 8192, R, C); const int Rb = Epi::PERM ? ((R & ~31) + perm32(R & 31)) : R;
        voffA[i] = (unsigned)(R * K + C) * 2u; voffB[i] = (unsigned)(Rb * K + C) * 2u; }
    const size_t kstep = (size_t)(BK * 2);
    const size_t hstep = (size_t)HALF * K * 2;
    const size_t tstep = 2 * hstep;
    const unsigned ldsw = (unsigned)wid * 1024u;
    const int aoff = lds_byte(wr * 64 + fr, fq * 8), boff = lds_byte(wc * 32 + fr, fq * 8);
#define PG8_SA(b, h) (((b) * 2 + (h)) * HTB)
#define PG8_SB(b, h) ((4 + (b) * 2 + (h)) * HTB)
#define PG8_STAGE(bufoff, gbase, voff) do { _Pragma("unroll") for (int _i = 0; _i < 2; ++_i) \
        __builtin_amdgcn_global_load_lds((const unsigned*)((const char*)(gbase) + (voff)[_i]), (PG8_LAS unsigned*)(lds + (bufoff) + ldsw + _i * 8192), 16, 0, 0); } while (0)
#define PG8_LDA(dst, b, h) do { _Pragma("unroll") for (int m = 0; m < 4; ++m) _Pragma("unroll") for (int k = 0; k < 2; ++k) dst[m][k] = *(const PG8_LAS bf16x8*)(lds + PG8_SA(b, h) + aoff + m * 2048 + k * 1024); } while (0)
#define PG8_LDB(dst, b, h) do { _Pragma("unroll") for (int n = 0; n < 2; ++n) _Pragma("unroll") for (int k = 0; k < 2; ++k) dst[n][k] = *(const PG8_LAS bf16x8*)(lds + PG8_SB(b, h) + boff + n * 2048 + k * 1024); } while (0)
#define PG8_MMA(ai, bj, At, Bt) do { __builtin_amdgcn_s_setprio(1); _Pragma("unroll") for (int m = 0; m < 4; ++m) _Pragma("unroll") for (int n = 0; n < 2; ++n) { \
        if constexpr (SCW >= 0) mfma8(acc[ai][bj][m][n], cat8(Bt[n][0], Bt[n][1]), cat8(At[m][0], At[m][1])); \
        else { _Pragma("unroll") for (int k = 0; k < 2; ++k) acc[ai][bj][m][n] = __builtin_amdgcn_mfma_f32_16x16x32_bf16(Bt[n][k], At[m][k], acc[ai][bj][m][n], 0, 0, 0); } } __builtin_amdgcn_s_setprio(0); } while (0)
#define PG8_WAIT_V(n) asm volatile("s_waitcnt vmcnt(" #n ")" ::: "memory")
#define PG8_WAIT_L(n) asm volatile("s_waitcnt lgkmcnt(" #n ")" ::: "memory")
#define PG8_BAR __builtin_amdgcn_s_barrier()
#define PG8_SCHED __builtin_amdgcn_sched_barrier(0)
    Unit cur, nxt; int ui = 0;
    if (!S.next(0, cur)) return;
    f32x4 acc[2][2][4][2];
#pragma unroll
    for (int a = 0; a < 2; ++a)
#pragma unroll
        for (int b = 0; b < 2; ++b)
#pragma unroll
            for (int m = 0; m < 4; ++m)
#pragma unroll
                for (int n = 0; n < 2; ++n) acc[a][b][m][n] = (f32x4){0.f, 0.f, 0.f, 0.f};
    bf16x8 At[4][2], B0[2][2], B1[2][2];
    const char* cA = (const char*)g.A + (size_t)cur.pm * tstep; const char* cB = (const char*)g.Bt + (size_t)cur.pn * tstep;
    S.a_ready(cur);
    if constexpr (Epi::MIDK) E.prep(lds, S, tid);
    if constexpr (SP2) {
        PG8_STAGE(PG8_SB(0, 0), cB, voffB); PG8_STAGE(PG8_SB(0, 1), cB + hstep, voffB); PG8_STAGE(PG8_SA(0, 0), cA, voffA); PG8_STAGE(PG8_SA(0, 1), cA + hstep, voffA);
        if (wr == 1) PG8_BAR;
        PG8_WAIT_V(2); PG8_BAR;
        PG8_STAGE(PG8_SB(1, 0), cB + kstep, voffB); PG8_STAGE(PG8_SA(1, 0), cA + kstep, voffA); PG8_STAGE(PG8_SB(1, 1), cB + hstep + kstep, voffB);
        PG8_WAIT_V(6); PG8_BAR;
    } else {
    PG8_STAGE(PG8_SB(0, 0), cB, voffB); PG8_STAGE(PG8_SA(0, 0), cA, voffA); PG8_STAGE(PG8_SB(0, 1), cB + hstep, voffB); PG8_STAGE(PG8_SA(0, 1), cA + hstep, voffA);
    if (wr == 1) PG8_BAR;
    PG8_WAIT_V(4); PG8_BAR;
    PG8_STAGE(PG8_SB(1, 0), cB + kstep, voffB); PG8_STAGE(PG8_SA(1, 0), cA + kstep, voffA); PG8_STAGE(PG8_SB(1, 1), cB + hstep + kstep, voffB);
    PG8_WAIT_V(6); PG8_BAR;
    }
    PG8_STAMP();
    for (;;) {
        const bool has_next = S.next(ui + 1, nxt);
        const char* nA = has_next ? (const char*)g.A + (size_t)nxt.pm * tstep : cA; const char* nB = has_next ? (const char*)g.Bt + (size_t)nxt.pn * tstep : cB;
        for (int t = 0; t < nt; t += 2) {
            const bool last = (t == nt - 2);
            const char* a1 = cA + (size_t)(t + 1) * kstep;
            const char* a2 = last ? nA : cA + (size_t)(t + 2) * kstep; const char* b2 = last ? nB : cB + (size_t)(t + 2) * kstep;
            const char* a3 = a2 + kstep; const char* b3 = b2 + kstep;
            if (last && has_next) S.a_ready(nxt);
            if constexpr (SP2) {
            PG8_LDB(B0, 0, 0); PG8_LDB(B1, 0, 1); PG8_SCHED; PG8_LDA(At, 0, 0); PG8_STAGE(PG8_SA(1, 1), a1 + hstep, voffA);
            PG8_WAIT_V(8); PG8_WAIT_L(0); PG8_BAR; PG8_MMA(0, 0, At, B0); PG8_MMA(0, 1, At, B1); PG8_BAR; PG8_SCHED;
            PG8_LDA(At, 0, 1); PG8_STAGE(PG8_SB(0, 0), b2, voffB); PG8_STAGE(PG8_SB(0, 1), b2 + hstep, voffB); PG8_STAGE(PG8_SA(0, 0), a2, voffA);
            PG8_WAIT_V(8); PG8_WAIT_L(0); PG8_BAR; PG8_MMA(1, 0, At, B0); PG8_MMA(1, 1, At, B1); PG8_BAR; PG8_SCHED;
            PG8_LDB(B0, 1, 0); PG8_LDB(B1, 1, 1); PG8_SCHED; PG8_LDA(At, 1, 0); PG8_STAGE(PG8_SA(0, 1), a2 + hstep, voffA);
            PG8_WAIT_V(8); PG8_WAIT_L(0); PG8_BAR; PG8_MMA(0, 0, At, B0); PG8_MMA(0, 1, At, B1); PG8_BAR; PG8_SCHED;
            PG8_LDA(At, 1, 1); PG8_STAGE(PG8_SB(1, 0), b3, voffB); PG8_STAGE(PG8_SB(1, 1), b3 + hstep, voffB); PG8_STAGE(PG8_SA(1, 0), a3, voffA);
            PG8_WAIT_V(8); PG8_WAIT_L(0); PG8_BAR; PG8_MMA(1, 0, At, B0); PG8_MMA(1, 1, At, B1); PG8_BAR; PG8_SCHED;
            } else {
            PG8_LDB(B0, 0, 0); PG8_SCHED; PG8_LDA(At, 0, 0); PG8_STAGE(PG8_SA(1, 1), a1 + hstep, voffA);
            PG8_WAIT_L(8); PG8_BAR; PG8_WAIT_L(0); PG8_MMA(0, 0, At, B0); PG8_BAR; PG8_SCHED;
            PG8_LDB(B1, 0, 1); PG8_STAGE(PG8_SB(0, 0), b2, voffB);
            PG8_BAR; PG8_WAIT_L(0); PG8_MMA(0, 1, At, B1); PG8_BAR;
            PG8_LDA(At, 0, 1); PG8_STAGE(PG8_SA(0, 0), a2, voffA);
            PG8_BAR; PG8_WAIT_L(0); PG8_MMA(1, 0, At, B0); PG8_BAR; PG8_SCHED;
            PG8_STAGE(PG8_SB(0, 1), b2 + hstep, voffB);
            PG8_WAIT_V(6); PG8_BAR; PG8_MMA(1, 1, At, B1); PG8_BAR;
            PG8_LDB(B0, 1, 0); PG8_SCHED; PG8_LDA(At, 1, 0); PG8_STAGE(PG8_SA(0, 1), a2 + hstep, voffA);
            PG8_WAIT_L(8); PG8_BAR; PG8_WAIT_L(0); PG8_MMA(0, 0, At, B0); PG8_BAR; PG8_SCHED;
            PG8_LDB(B1, 1, 1); PG8_STAGE(PG8_SB(1, 0), b3, voffB);
            PG8_BAR; PG8_WAIT_L(0); PG8_MMA(0, 1, At, B1); PG8_BAR;
            PG8_LDA(At, 1, 1); PG8_STAGE(PG8_SA(1, 0), a3, voffA);
            PG8_BAR; PG8_WAIT_L(0); PG8_MMA(1, 0, At, B0); PG8_BAR; PG8_SCHED;
            PG8_STAGE(PG8_SB(1, 1), b3 + hstep, voffB);
            PG8_WAIT_V(6); PG8_BAR; PG8_MMA(1, 1, At, B1); PG8_BAR;
            }
            if constexpr (Epi::MIDK) { if (t + 2 == nt / 2) { if constexpr (SCW >= 0) asm volatile("s_nop 15\n\ts_nop 15" ::: "memory");
                E.midk(acc, lds, ui, wr, fr); } }
        }
        PG8_STAMP();
        if (wr == 0) PG8_BAR;
        if constexpr (SCW >= 0) asm volatile("s_nop 15\n\ts_nop 15" ::: "memory");
        if constexpr (!Epi::AFTER_DRAIN) { E(acc, cur, wr, wc, fr, fq); S.done(cur); }
        PG8_STAMP();
        if (!has_next) break;
#pragma unroll
        for (int a = 0; a < 2; ++a)
#pragma unroll
            for (int b = 0; b < 2; ++b)
#pragma unroll
                for (int m = 0; m < 4; ++m)
#pragma unroll
                    for (int n = 0; n < 2; ++n) acc[a][b][m][n] = (f32x4){0.f, 0.f, 0.f, 0.f};
        cur = nxt; cA = nA; cB = nB; ++ui;
        if (wr == 1) PG8_BAR;
    }
    PG8_WAIT_V(0);
    PG8_BAR;
    if constexpr (Epi::AFTER_DRAIN) { E.fused(acc, cur, wr, wc, fr, fq, lds, wid, lane); S.done(cur); }
    PG8_STAMP();
    if (STAMP && wid == 0) { stamps[lane] = lane < nts ? (((unsigned long long)(unsigned)ts_hi << 32) | (unsigned)ts_lo) : 0ull;
        if (lane == 62) stamps[62] = rt_entry; if (lane == 63) stamps[63] = (unsigned long long)wall_clock64(); }
#undef PG8_STAMP
#undef PG8_SA
#undef PG8_SB
#undef PG8_STAGE
#undef PG8_LDA
#undef PG8_LDB
#undef PG8_MMA
#undef PG8_WAIT_V
#undef PG8_WAIT_L
#undef PG8_BAR
#undef PG8_SCHED
}

struct MoeUnit { int e, mt, pn, cnt, pstart; };
struct MoeSched {
    typedef MoeUnit UnitT;
    PG8_LAS const int* tab; const int* map; int U, G, c, npn, gather; size_t bstride;
    __device__ __forceinline__ bool next(int i, MoeUnit& u) const {
        const long L = (long)i * G + c; if (L >= U) return false;
        int idx = (int)L; { const int q = U / NXCD, r = U % NXCD, xcd = idx % NXCD, off = idx / NXCD; idx = (xcd < r ? xcd * (q + 1) : r * (q + 1) + (xcd - r) * q) + off; }
        const int tau = idx / npn; u.pn = idx - tau * npn;
        int e = 0;
#pragma unroll
        for (int st = 16; st >= 1; st >>= 1) { if (__builtin_amdgcn_readfirstlane(tab[e + st]) <= tau) e += st; }
        u.e = e; u.mt = tau - __builtin_amdgcn_readfirstlane(tab[e]); u.cnt = __builtin_amdgcn_readfirstlane(tab[33 + e]); u.pstart = __builtin_amdgcn_readfirstlane(tab[65 + e]);
        return true;
    }
    __device__ __forceinline__ const char* bbase(const Gemm& g, const MoeUnit& u) const { return (const char*)g.Bt + (size_t)u.e * bstride + (size_t)u.pn * BM * g.K * 2; }
    __device__ __forceinline__ void a_offsets(const Gemm& g, const MoeUnit& u, int tid, unsigned (&va)[2][2]) const {
        int tl = tid; asm volatile("" : "+v"(tl));
        int RA[2], CA[2];
#pragma unroll
        for (int i = 0; i < 2; ++i) { int R, C; stage_rc(tl * 16 + i * 8192, R, C); RA[i] = R; CA[i] = C * 2; }
#pragma unroll
        for (int hf = 0; hf < 2; ++hf)
#pragma unroll
            for (int i = 0; i < 2; ++i) { int rl = u.mt * BM + hf * HALF + RA[i]; rl = rl < u.cnt ? rl : u.cnt - 1;
                const unsigned row = gather ? (unsigned)map[(size_t)u.e * 34816 + rl] : (unsigned)(u.pstart + rl);
                va[hf][i] = row * (unsigned)(g.K * 2) + (unsigned)CA[i]; }
    }
};
struct EpiAct {
    static constexpr bool PERM = true, AFTER_DRAIN = false;
    unsigned char* O;
    __device__ __forceinline__ void operator()(const f32x4 (&acc)[2][2][4][2], const MoeUnit& u, int wr, int wc, int fr, int fq) const {
        typedef unsigned u32x2 __attribute__((ext_vector_type(2)));
        const int rl0 = u.mt * BM + wr * 64 + fr, col0 = u.pn * HALF + wc * 32 + 8 * fq;
#pragma unroll
        for (int ai = 0; ai < 2; ++ai)
#pragma unroll
            for (int m = 0; m < 4; ++m) { const int rl = rl0 + ai * HALF + m * 16;
                if (rl < u.cnt) { f32x4 o[2];
#pragma unroll
                    for (int n = 0; n < 2; ++n)
#pragma unroll
                        for (int j = 0; j < 4; ++j) { const float gv = acc[ai][0][m][n][j] * (1.0f / 64.0f)  ; o[n][j] = gv * __builtin_amdgcn_rcpf(1.0f + __builtin_amdgcn_exp2f(-1.4426950408889634f * gv)) * (acc[ai][1][m][n][j] * 0.125f)  ; }
                    *(u32x2*)(O + (size_t)(u.pstart + rl) * 512 + col0) = (u32x2){pk4_fp8(o[0]), pk4_fp8(o[1])}; } }
    }
};
struct EpiY {
    static constexpr bool PERM = true, AFTER_DRAIN = false;
    unsigned char* O;
    static __device__ __forceinline__ unsigned pk4(const f32x4 v) { const float lim = 440.f;
        int w = __builtin_amdgcn_cvt_pk_fp8_f32(fminf(fmaxf(v[0], -lim), lim), fminf(fmaxf(v[1], -lim), lim), 0, false);
        return (unsigned)__builtin_amdgcn_cvt_pk_fp8_f32(fminf(fmaxf(v[2], -lim), lim), fminf(fmaxf(v[3], -lim), lim), w, true); }
    __device__ __forceinline__ void operator()(const f32x4 (&acc)[2][2][4][2], const MoeUnit& u, int wr, int wc, int fr, int fq) const {
        typedef unsigned u32x2 __attribute__((ext_vector_type(2)));
        const int rl0 = u.mt * BM + wr * 64 + fr, col0 = u.pn * BM + wc * 32 + 8 * fq;
#pragma unroll
        for (int ai = 0; ai < 2; ++ai)
#pragma unroll
            for (int m = 0; m < 4; ++m) { const int rl = rl0 + ai * HALF + m * 16;
                if (rl < u.cnt) { unsigned char* rowp = O + (size_t)(u.pstart + rl) * 1024 + col0;
#pragma unroll
                    for (int bj = 0; bj < 2; ++bj) *(u32x2*)(rowp + bj * HALF) = (u32x2){pk4(acc[ai][bj][m][0] * (1.0f / 512.0f)), pk4(acc[ai][bj][m][1] * (1.0f / 512.0f))}; } }
    }
};
template <class Epi, class Sched, bool STAMP = false, bool SP2 = PG8_SP2, int SCW = -1, int SCA = 127>
__device__ __forceinline__ void gemm_phase_moe(PG8_LAS unsigned char* lds, const Gemm g, const Sched& S, const Epi& E, unsigned long long* stamps) {
    int tid_l = __builtin_amdgcn_readfirstlane(threadIdx.x >> 6) * 64 + (int)__builtin_amdgcn_mbcnt_hi(~0u, __builtin_amdgcn_mbcnt_lo(~0u, 0u)); asm volatile("" : "+v"(tid_l));
    const int tid = tid_l, wid = __builtin_amdgcn_readfirstlane(tid >> 6), lane = tid & 63, wr = wid >> 2, wc = wid & 3, fr = lane & 15, fq = lane >> 4;
    const int K = g.K, nt = K / BK;
    int ts_lo = 0, ts_hi = 0, nts = 0; const unsigned long long rt_entry = STAMP ? (unsigned long long)wall_clock64() : 0ull;
#define PG8_STAMP() do { if (STAMP && wid == 0 && nts < 64) { const unsigned long long _c = (unsigned long long)clock64(); \
        ts_lo = (lane == nts) ? (int)(unsigned)_c : ts_lo; ts_hi = (lane == nts) ? (int)(unsigned)(_c >> 32) : ts_hi; ++nts; } } while (0)
    PG8_STAMP();
    unsigned voffB[2];
#pragma unroll
    for (int i = 0; i < 2; ++i) { int R, C; stage_rc(tid * 16 + i * 8192, R, C); const int Rb = Epi::PERM ? ((R & ~31) + perm32(R & 31)) : R;
        voffB[i] = (unsigned)(Rb * K + C) * 2u; }
    unsigned vaC[2][2];
    PG8_LAS unsigned* vtab = (PG8_LAS unsigned*)(lds + STAGE_BYTES + 1024) + tid;
    const size_t kstep = (size_t)(BK * 2);
    const size_t hstep = (size_t)HALF * K * 2;
    const size_t tstep = 2 * hstep;
    const unsigned ldsw = (unsigned)wid * 1024u;
    const int aoff = lds_byte(wr * 64 + fr, fq * 8), boff = lds_byte(wc * 32 + fr, fq * 8);
#define PG8_SA(b, h) (((b) * 2 + (h)) * HTB)
#define PG8_SB(b, h) ((4 + (b) * 2 + (h)) * HTB)
#define PG8_STAGE(bufoff, gbase, voff) do { _Pragma("unroll") for (int _i = 0; _i < 2; ++_i) \
        __builtin_amdgcn_global_load_lds((const unsigned*)((const char*)(gbase) + (voff)[_i]), (PG8_LAS unsigned*)(lds + (bufoff) + ldsw + _i * 8192), 16, 0, 0); } while (0)
#define PG8_STAGEA(bufoff, kbyte, va) do { _Pragma("unroll") for (int _i = 0; _i < 2; ++_i) \
        __builtin_amdgcn_global_load_lds((const unsigned*)((const char*)g.A + (kbyte) + (va)[_i]), (PG8_LAS unsigned*)(lds + (bufoff) + ldsw + _i * 8192), 16, 0, 0); } while (0)
#define PG8_LDA(dst, b, h) do { _Pragma("unroll") for (int m = 0; m < 4; ++m) _Pragma("unroll") for (int k = 0; k < 2; ++k) dst[m][k] = *(const PG8_LAS bf16x8*)(lds + PG8_SA(b, h) + aoff + m * 2048 + k * 1024); } while (0)
#define PG8_LDB(dst, b, h) do { _Pragma("unroll") for (int n = 0; n < 2; ++n) _Pragma("unroll") for (int k = 0; k < 2; ++k) dst[n][k] = *(const PG8_LAS bf16x8*)(lds + PG8_SB(b, h) + boff + n * 2048 + k * 1024); } while (0)
#define PG8_MMA(ai, bj, At, Bt) do { __builtin_amdgcn_s_setprio(1); _Pragma("unroll") for (int m = 0; m < 4; ++m) _Pragma("unroll") for (int n = 0; n < 2; ++n) { \
        if constexpr (SCW >= 0) mfma8(acc[ai][bj][m][n], cat8(Bt[n][0], Bt[n][1]), cat8(At[m][0], At[m][1])); \
        else { _Pragma("unroll") for (int k = 0; k < 2; ++k) acc[ai][bj][m][n] = __builtin_amdgcn_mfma_f32_16x16x32_bf16(Bt[n][k], At[m][k], acc[ai][bj][m][n], 0, 0, 0); } } __builtin_amdgcn_s_setprio(0); } while (0)
#define PG8_WAIT_V(n) asm volatile("s_waitcnt vmcnt(" #n ")" ::: "memory")
#define PG8_WAIT_L(n) asm volatile("s_waitcnt lgkmcnt(" #n ")" ::: "memory")
#define PG8_BAR __builtin_amdgcn_s_barrier()
#define PG8_SCHED __builtin_amdgcn_sched_barrier(0)
    typename Sched::UnitT cur, nxt; int ui = 0;
    if (!S.next(0, cur)) return;
    f32x4 acc[2][2][4][2];
#pragma unroll
    for (int a = 0; a < 2; ++a)
#pragma unroll
        for (int b = 0; b < 2; ++b)
#pragma unroll
            for (int m = 0; m < 4; ++m)
#pragma unroll
                for (int n = 0; n < 2; ++n) acc[a][b][m][n] = (f32x4){0.f, 0.f, 0.f, 0.f};
    bf16x8 At[4][2], B0[2][2], B1[2][2];
    const char* cB = S.bbase(g, cur); S.a_offsets(g, cur, tid, vaC);
    if constexpr (SP2) {
        PG8_STAGE(PG8_SB(0, 0), cB, voffB); PG8_STAGE(PG8_SB(0, 1), cB + hstep, voffB); PG8_STAGEA(PG8_SA(0, 0), 0, vaC[0]); PG8_STAGEA(PG8_SA(0, 1), 0, vaC[1]);
        if (wr == 1) PG8_BAR;
        PG8_WAIT_V(2); PG8_BAR;
        PG8_STAGE(PG8_SB(1, 0), cB + kstep, voffB); PG8_STAGEA(PG8_SA(1, 0), kstep, vaC[0]); PG8_STAGE(PG8_SB(1, 1), cB + hstep + kstep, voffB);
        PG8_WAIT_V(6); PG8_BAR;
    } else {
    PG8_STAGE(PG8_SB(0, 0), cB, voffB); PG8_STAGEA(PG8_SA(0, 0), 0, vaC[0]); PG8_STAGE(PG8_SB(0, 1), cB + hstep, voffB); PG8_STAGEA(PG8_SA(0, 1), 0, vaC[1]);
    if (wr == 1) PG8_BAR;
    PG8_WAIT_V(4); PG8_BAR;
    PG8_STAGE(PG8_SB(1, 0), cB + kstep, voffB); PG8_STAGEA(PG8_SA(1, 0), kstep, vaC[0]); PG8_STAGE(PG8_SB(1, 1), cB + hstep + kstep, voffB);
    PG8_WAIT_V(6); PG8_BAR;
    }
    PG8_STAMP();
    for (;;) {
        const bool has_next = S.next(ui + 1, nxt);
        const char* nB = has_next ? S.bbase(g, nxt) : cB;
        { unsigned vaN[2][2];
          if (has_next) S.a_offsets(g, nxt, tid, vaN); else {
#pragma unroll
            for (int hf = 0; hf < 2; ++hf)
#pragma unroll
                for (int i = 0; i < 2; ++i) vaN[hf][i] = vaC[hf][i]; }
#pragma unroll
          for (int hf = 0; hf < 2; ++hf)
#pragma unroll
              for (int i = 0; i < 2; ++i) vtab[(hf * 2 + i) * 512] = vaN[hf][i]; }
        unsigned v2[2][2];
        for (int t = 0; t < nt; t += 2) {
            const bool last = (t == nt - 2);
            const size_t k1 = (size_t)(t + 1) * kstep, k2 = last ? (size_t)0 : (size_t)(t + 2) * kstep, k3 = k2 + kstep;
            const char* b2 = last ? nB : cB + (size_t)(t + 2) * kstep; const char* b3 = b2 + kstep;
#pragma unroll
            for (int hf = 0; hf < 2; ++hf)
#pragma unroll
                for (int i = 0; i < 2; ++i) v2[hf][i] = last ? vtab[(hf * 2 + i) * 512] : vaC[hf][i];
            if constexpr (SP2) {
            PG8_LDB(B0, 0, 0); PG8_LDB(B1, 0, 1); PG8_SCHED; PG8_LDA(At, 0, 0); PG8_STAGEA(PG8_SA(1, 1), k1, vaC[1]);
            PG8_WAIT_V(8); PG8_WAIT_L(0); PG8_BAR; PG8_MMA(0, 0, At, B0); PG8_MMA(0, 1, At, B1); PG8_BAR; PG8_SCHED;
            PG8_LDA(At, 0, 1); PG8_STAGE(PG8_SB(0, 0), b2, voffB); PG8_STAGE(PG8_SB(0, 1), b2 + hstep, voffB); PG8_STAGEA(PG8_SA(0, 0), k2, v2[0]);
            PG8_WAIT_V(8); PG8_WAIT_L(0); PG8_BAR; PG8_MMA(1, 0, At, B0); PG8_MMA(1, 1, At, B1); PG8_BAR; PG8_SCHED;
            PG8_LDB(B0, 1, 0); PG8_LDB(B1, 1, 1); PG8_SCHED; PG8_LDA(At, 1, 0); PG8_STAGEA(PG8_SA(0, 1), k2, v2[1]);
            PG8_WAIT_V(8); PG8_WAIT_L(0); PG8_BAR; PG8_MMA(0, 0, At, B0); PG8_MMA(0, 1, At, B1); PG8_BAR; PG8_SCHED;
            PG8_LDA(At, 1, 1); PG8_STAGE(PG8_SB(1, 0), b3, voffB); PG8_STAGE(PG8_SB(1, 1), b3 + hstep, voffB); PG8_STAGEA(PG8_SA(1, 0), k3, v2[0]);
            PG8_WAIT_V(8); PG8_WAIT_L(0); PG8_BAR; PG8_MMA(1, 0, At, B0); PG8_MMA(1, 1, At, B1); PG8_BAR; PG8_SCHED;
            } else {
            PG8_LDB(B0, 0, 0); PG8_SCHED; PG8_LDA(At, 0, 0); PG8_STAGEA(PG8_SA(1, 1), k1, vaC[1]);
            PG8_WAIT_L(8); PG8_BAR; PG8_WAIT_L(0); PG8_MMA(0, 0, At, B0); PG8_BAR; PG8_SCHED;
            PG8_LDB(B1, 0, 1); PG8_STAGE(PG8_SB(0, 0), b2, voffB);
            PG8_BAR; PG8_WAIT_L(0); PG8_MMA(0, 1, At, B1); PG8_BAR;
            PG8_LDA(At, 0, 1); PG8_STAGEA(PG8_SA(0, 0), k2, v2[0]);
            PG8_BAR; PG8_WAIT_L(0); PG8_MMA(1, 0, At, B0); PG8_BAR; PG8_SCHED;
            PG8_STAGE(PG8_SB(0, 1), b2 + hstep, voffB);
            PG8_WAIT_V(6); PG8_BAR; PG8_MMA(1, 1, At, B1); PG8_BAR;
            PG8_LDB(B0, 1, 0); PG8_SCHED; PG8_LDA(At, 1, 0); PG8_STAGEA(PG8_SA(0, 1), k2, v2[1]);
            PG8_WAIT_L(8); PG8_BAR; PG8_WAIT_L(0); PG8_MMA(0, 0, At, B0); PG8_BAR; PG8_SCHED;
            PG8_LDB(B1, 1, 1); PG8_STAGE(PG8_SB(1, 0), b3, voffB);
            PG8_BAR; PG8_WAIT_L(0); PG8_MMA(0, 1, At, B1); PG8_BAR;
            PG8_LDA(At, 1, 1); PG8_STAGEA(PG8_SA(1, 0), k3, v2[0]);
            PG8_BAR; PG8_WAIT_L(0); PG8_MMA(1, 0, At, B0); PG8_BAR; PG8_SCHED;
            PG8_STAGE(PG8_SB(1, 1), b3 + hstep, voffB);
            PG8_WAIT_V(6); PG8_BAR; PG8_MMA(1, 1, At, B1); PG8_BAR;
            }
        }
        PG8_STAMP();
        if (wr == 0) PG8_BAR;
        if constexpr (SCW >= 0) asm volatile("s_nop 15\n\ts_nop 15" ::: "memory");
        E(acc, cur, wr, wc, fr, fq);
        PG8_STAMP();
        if (!has_next) break;
#pragma unroll
        for (int a = 0; a < 2; ++a)
#pragma unroll
            for (int b = 0; b < 2; ++b)
#pragma unroll
                for (int m = 0; m < 4; ++m)
#pragma unroll
                    for (int n = 0; n < 2; ++n) acc[a][b][m][n] = (f32x4){0.f, 0.f, 0.f, 0.f};
        cur = nxt; cB = nB; ++ui;
#pragma unroll
        for (int hf = 0; hf < 2; ++hf)
#pragma unroll
            for (int i = 0; i < 2; ++i) vaC[hf][i] = v2[hf][i];
        if (wr == 1) PG8_BAR;
    }
    PG8_WAIT_V(0);
    PG8_BAR;
    PG8_STAMP();
    if (STAMP && wid == 0) { stamps[lane] = lane < nts ? (((unsigned long long)(unsigned)ts_hi << 32) | (unsigned)ts_lo) : 0ull;
        if (lane == 62) stamps[62] = rt_entry; if (lane == 63) stamps[63] = (unsigned long long)wall_clock64(); }
#undef PG8_STAMP
#undef PG8_SA
#undef PG8_SB
#undef PG8_STAGE
#undef PG8_STAGEA
#undef PG8_LDA
#undef PG8_LDB
#undef PG8_MMA
#undef PG8_WAIT_V
#undef PG8_WAIT_L
#undef PG8_BAR
#undef PG8_SCHED
}
}

constexpr int NTHR = 512, NWV = 8, LDS_BYTES = 147456;

struct P {
    const float *x, *c, *ctx, *c_ctx, *w_mod, *b_mod, *norm1_g, *norm2_g, *w_in, *conv_w, *conv_b, *dt_bias_f, *dt_bias_b, *a_log_f, *a_log_b, *d_skip, *ssd_norm_g,
        *gk_up_f, *gk_bias_f, *gk_up_b, *gk_bias_b, *gla_norm_g, *w_out, *w_router, *router_bias, *w_gate, *w_up, *w_down, *final_g;
    float* out; bf16_t* XB; bf16_t* H; bf16_t* PROJ; bf16_t* SS; bf16_t* GS; float* SDEC; float* GDEC; float* MOD; int* counts; int* TOKSLOT; float* EW; int* MAP; bf16_t* WinT; bf16_t* WoutT; bf16_t* WguT; bf16_t* WdT; bf16_t* WRT; unsigned* BAR; bf16_t* XBCC; bf16_t* QKB; float* SSC; float* STOT; float* SSQ; float* XSS;
};

DI void ph_init(const P& p) { const size_t i = (size_t)blockIdx.x * NTHR + ltid(); if (i < 64) p.counts[i * 32] = 0; }

DI void ph_mod(const P& p, float* s  ) {
    const int tid_ = ltid(), lane = tid_ & 63, w = tid_ >> 6;
    if (blockIdx.x >= 192) return;
    float* part = s + 9 * 1024;
    { float cv[18];
#pragma unroll
      for (int q = 0; q < 18; ++q) { const int i = tid_ + q * NTHR, r = i >> 10, k = i & 1023; cv[q] = r < 8 ? p.c[r * 1024 + k] : p.c_ctx[k]; }
#pragma unroll
      for (int q = 0; q < 18; ++q) s[tid_ + q * NTHR] = siluf(cv[q]); }
    __syncthreads();
    for (int vb = blockIdx.x; vb < 192; vb += gridDim.x) {
        const int l = vb / 96, n = (vb % 96) * 64 + lane;
        float acc[9];
#pragma unroll
        for (int r = 0; r < 9; ++r) acc[r] = 0.f;
        const float* wp = p.w_mod + (size_t)l * 1024 * 6144 + (size_t)(128 * w) * 6144 + n;
#pragma unroll 8
        for (int k = 0; k < 128; ++k) { const float wv = wp[(size_t)k * 6144];
#pragma unroll
            for (int r = 0; r < 9; ++r) acc[r] += s[r * 1024 + 128 * w + k] * wv; }
#pragma unroll
        for (int r = 0; r < 9; ++r) part[(w * 9 + r) * 64 + lane] = acc[r];
        __syncthreads();
        for (int o = tid_; o < 9 * 64; o += NTHR) { const int r = o >> 6, c = o & 63; float a = p.b_mod[l * 6144 + (vb % 96) * 64 + c];
#pragma unroll
            for (int q = 0; q < 8; ++q) a += part[(q * 9 + r) * 64 + c];
            p.MOD[((size_t)l * 9 + r) * 6144 + (vb % 96) * 64 + c] = a; }
        __syncthreads();
    }
}

DI unsigned pk2(float lo, float hi) { return __builtin_bit_cast(unsigned, __builtin_convertvector((f32x2v_){lo, hi}, bf16x2v_)); }
template <bool F8 = false> DI void transpose_item(const float* W, int K, int N, bf16_t* WT, float* scr, int item, int lane, int gu = -1, const float* kscale = nullptr) {
    const int nblk = (N + 31) / 32, kb = item / nblk, nb = item % nblk, k0 = 64 * kb, n0 = 32 * nb;
    const int d0 = gu < 0 ? n0 : 256 * (n0 >> 7) + (n0 & 127) + 128 * gu;
    const int ncl = n0 + (lane & 31) < N ? n0 + (lane & 31) : N - 1;
    float wv_[32];
#pragma unroll
    for (int i = 0; i < 32; ++i) { const int kk = 2 * i + (lane >> 5); wv_[i] = __builtin_nontemporal_load(W + (size_t)(k0 + kk) * N + ncl); }
#pragma unroll
    for (int i = 0; i < 32; ++i) { const int kk = 2 * i + (lane >> 5); scr[kk * 33 + (lane & 31)] = wv_[i] * (kscale ? kscale[k0 + kk] : 1.0f); }
    const int c = lane & 7;
#pragma unroll
    for (int j = 0; j < 4; ++j) { const int n = (lane >> 3) + 8 * j; const float* q = scr + (8 * c) * 33 + n;
        if constexpr (F8) { typedef unsigned u32x2nt __attribute__((ext_vector_type(2)));
            const u32x2nt o = {pg8::pk4_fp8((pg8::f32x4){q[0 * 33], q[1 * 33], q[2 * 33], q[3 * 33]} * 64.0f), pg8::pk4_fp8((pg8::f32x4){q[4 * 33], q[5 * 33], q[6 * 33], q[7 * 33]} * 64.0f)};
            if (n0 + n < N) __builtin_nontemporal_store(o, (u32x2nt*)((unsigned char*)WT + (size_t)(d0 + n) * K + k0 + 8 * c)); }
        else {
        uint4 o; o.x = pk2(q[0 * 33], q[1 * 33]); o.y = pk2(q[2 * 33], q[3 * 33]); o.z = pk2(q[4 * 33], q[5 * 33]); o.w = pk2(q[6 * 33], q[7 * 33]);
        if (n0 + n < N) { typedef unsigned u32x4nt __attribute__((ext_vector_type(4))); __builtin_nontemporal_store((u32x4nt){o.x, o.y, o.z, o.w}, (u32x4nt*)(WT + (size_t)(d0 + n) * K + k0 + 8 * c)); } } }
}

struct TrD { const float* src; unsigned char* dst; int N, K; bool ok; };
DI TrD tr_desc(const P& p, int l, int it, int it1, int lane) {
    TrD d; d.ok = it < it1; const int itc = d.ok ? it : it1 - 1;
    const int e = itc / 768, r = itc - e * 768;
    const float* W; unsigned char* WT; int K, N, item, gu;
    if (r < 512) { gu = r >> 8; W = (gu ? p.w_up : p.w_gate) + (size_t)(l * NE + e) * D * 512; K = D; N = 512; WT = (unsigned char*)p.WguT + (size_t)e * D * D; item = r & 255; }
    else { gu = -1; W = p.w_down + (size_t)(l * NE + e) * 512 * D; K = 512; N = D; WT = (unsigned char*)p.WdT + (size_t)e * D * 512; item = r - 512; }
    const int nblk = N / 32, kb = item / nblk, nb = item % nblk, k0 = 64 * kb, n0 = 32 * nb;
    const int d0 = gu < 0 ? n0 : 256 * (n0 >> 7) + (n0 & 127) + 128 * gu;
    d.src = W + (size_t)(k0 + (lane >> 5)) * N + n0 + (lane & 31); d.dst = WT + (size_t)d0 * K + k0; d.N = N; d.K = K;
    return d;
}
DI void tr_load(const TrD& d, float (&v)[32]) {
#pragma unroll
    for (int i = 0; i < 32; ++i) v[i] = __builtin_nontemporal_load(d.src + (size_t)(2 * i) * d.N);
}
DI void tr_finish(const TrD& d, const float (&v)[32], float* scr, int lane) {
#pragma unroll
    for (int i = 0; i < 32; ++i) { const int kk = 2 * i + (lane >> 5); scr[kk * 33 + (lane & 31)] = v[i]; }
    const int c = lane & 7;
#pragma unroll
    for (int j = 0; j < 4; ++j) { const int n = (lane >> 3) + 8 * j; const float* q = scr + (8 * c) * 33 + n;
        typedef unsigned u32x2nt __attribute__((ext_vector_type(2)));
        const u32x2nt o = {pg8::pk4_fp8((pg8::f32x4){q[0 * 33], q[1 * 33], q[2 * 33], q[3 * 33]} * 64.0f), pg8::pk4_fp8((pg8::f32x4){q[4 * 33], q[5 * 33], q[6 * 33], q[7 * 33]} * 64.0f)};
        if (d.ok) __builtin_nontemporal_store(o, (u32x2nt*)(d.dst + (size_t)n * d.K + 8 * c)); }
}
#ifndef TR_NI
#define TR_NI 4
#endif
DI void ph_convert_experts(const P& p, int l, float* ldsf, int wk0, int nwk, int it0 = 0, int it1 = NE * 768) {
    const int tid_ = ltid(), lane = tid_ & 63, gw = ((int)blockIdx.x - wk0) * NWV + (tid_ >> 6), NW = nwk * NWV;
    float* scr = ldsf + 14 * 1024 + (tid_ >> 6) * (64 * 33 + 16);
    for (int it = it0 + gw; it < it1; it += TR_NI * NW) {
        float v[TR_NI][32]; TrD d[TR_NI];
#pragma unroll
        for (int j = 0; j < TR_NI; ++j) { d[j] = tr_desc(p, l, it + j * NW, it1, lane); tr_load(d[j], v[j]); }
#pragma unroll
        for (int j = 0; j < TR_NI; ++j) tr_finish(d[j], v[j], scr, lane);
    }
}
constexpr int NPAD_IN = 3072;
DI void ph_convert_small(const P& p, float* ldsf, int, int, int) {
    const int tid_ = ltid(), lane = tid_ & 63, gw = blockIdx.x * NWV + (tid_ >> 6), NW = gridDim.x * NWV;
    float* scr = ldsf + 14 * 1024 + (tid_ >> 6) * (64 * 33 + 16);
    constexpr int I_IN = 16 * 89, I_OUT = 16 * 32;
    for (int it = gw; it < 2 * (I_IN + I_OUT); it += NW) {
        const int l = it / (I_IN + I_OUT), r = it % (I_IN + I_OUT);
        if (r < I_IN) transpose_item<true>(p.w_in + (size_t)l * D * INDIM, D, INDIM, (bf16_t*)((unsigned char*)p.WinT + (size_t)l * NPAD_IN * D), scr, r, lane);
        else { const int kb = (r - I_IN) / 32;
            transpose_item<true>(p.w_out + (size_t)l * D * D, D, D, (bf16_t*)((unsigned char*)p.WoutT + (size_t)l * D * D), scr, r - I_IN, lane, -1, kb < 8 ? p.ssd_norm_g + l * 512 : nullptr); }
    }
    for (int idx = blockIdx.x * NTHR + tid_; idx < 32 * 1024; idx += gridDim.x * NTHR) { const int e = idx >> 10, k = idx & 1023; p.WRT[idx] = f2bf(p.w_router[k * 32 + e]); }
    const size_t nz16 = (size_t)(NPAD_IN - INDIM) * D / 16;
    for (size_t i = (size_t)blockIdx.x * NTHR + tid_; i < 2 * nz16; i += (size_t)gridDim.x * NTHR) {
        const size_t l = i / nz16, j = i % nz16;
        ((uint4*)((unsigned char*)p.WinT + (l * NPAD_IN + INDIM) * D))[j] = make_uint4(0u, 0u, 0u, 0u);
    }
}

DI void row_normmod(float4 (&v)[4], const float* g, const float* mr, int shift_idx, int scale_idx, int lane) {
    float ss = 0.f;
#pragma unroll
    for (int i = 0; i < 4; ++i) ss += v[i].x * v[i].x + v[i].y * v[i].y + v[i].z * v[i].z + v[i].w * v[i].w;
    ss = wave_sum(ss, lane);
    const float rstd = rsqrtf(ss * (1.0f / D) + 1e-6f);
#pragma unroll
    for (int i = 0; i < 4; ++i) {
        const int c = (i * 64 + lane) * 4;
        const float4 gg = *(const float4*)(g + c), sh = *(const float4*)(mr + shift_idx * 1024 + c), sc = *(const float4*)(mr + scale_idx * 1024 + c);
        v[i].x = v[i].x * rstd * gg.x * (1.f + sc.x) + sh.x; v[i].y = v[i].y * rstd * gg.y * (1.f + sc.y) + sh.y;
        v[i].z = v[i].z * rstd * gg.z * (1.f + sc.z) + sh.z; v[i].w = v[i].w * rstd * gg.w * (1.f + sc.w) + sh.w;
    }
}
DI void row_store_bf16(bf16_t* hrow, float4 (&v)[4], int lane) {
#pragma unroll
    for (int i = 0; i < 4; ++i) { ushort4 o; o.x = f2bf(v[i].x); o.y = f2bf(v[i].y); o.z = f2bf(v[i].z); o.w = f2bf(v[i].w);
        *(ushort4*)(hrow + (i * 64 + lane) * 4) = o; v[i] = make_float4(bf2f(o.x), bf2f(o.y), bf2f(o.z), bf2f(o.w)); }
}

DI void ph_normmod1(const P& p, int l, int, int, int) {
    const int tid_ = ltid(), lane = tid_ & 63, gw = blockIdx.x * NWV + (tid_ >> 6), NW = gridDim.x * NWV;
    const float* MODl = p.MOD + (size_t)l * 9 * 6144;
    for (int t = gw; t < T; t += NW) {
        float4 v[4];
#pragma unroll
        for (int i = 0; i < 4; ++i) v[i] = ((const float4*)(t < TC ? p.ctx + (size_t)t * D : p.x + (size_t)(t - TC) * D))[i * 64 + lane];
        row_normmod(v, p.norm1_g + l * D, MODl + (size_t)tok_modrow(t) * 6144, 0, 1, lane);
#pragma unroll
        for (int i = 0; i < 4; ++i) *(unsigned*)((unsigned char*)p.H + (size_t)t * D + (i * 64 + lane) * 4) = pg8::pk4_fp8((pg8::f32x4){v[i].x, v[i].y, v[i].z, v[i].w});
    }
}

typedef short s16x4 __attribute__((ext_vector_type(4)));
typedef short bf16x8v __attribute__((ext_vector_type(8)));
typedef float f32x4v __attribute__((ext_vector_type(4)));
typedef unsigned u32x4v __attribute__((ext_vector_type(4)));
typedef unsigned u32x2v __attribute__((ext_vector_type(2)));
DI u32x4v mk4(unsigned a, unsigned b, unsigned c, unsigned d) { return (u32x4v){a, b, c, d}; }
DI u32x2v mk2(unsigned a, unsigned b) { return (u32x2v){a, b}; }
DI f32x4v mkf4(float a, float b, float c, float d) { return (f32x4v){a, b, c, d}; }
#define LDSP __attribute__((address_space(3)))
constexpr int NCH = 34, NTILE = NB * NCH;
constexpr int LD64 = 72, LD128 = 136;
constexpr float LOG2E = 1.4426950408889634f;

DI int tile_tok0(int tl) { const int b = tl / NCH, cs = tl - b * NCH; return cs < 2 ? b * CTXL + cs * 128 : TC + b * SEQ + (cs - 2) * 128; }
DI f32x4v mfma16(bf16x8v a, bf16x8v b, f32x4v c) { return __builtin_amdgcn_mfma_f32_16x16x32_bf16(a, b, c, 0, 0, 0); }
DI bf16x8v frag_row(LDSP const bf16_t* base, int ld, int r0, int k0, int lane) { return *(LDSP const bf16x8v*)(base + (r0 + (lane & 15)) * ld + k0 + 8 * (lane >> 4)); }
DI bf16x8v frag_row_g(const bf16_t* base, int ld, int r0, int k0, int lane) { return *(const bf16x8v*)(base + (size_t)(r0 + (lane & 15)) * ld + k0 + 8 * (lane >> 4)); }
DI bf16x8v frag_col(LDSP const bf16_t* base, int ld, int r0, int k0, int lane) {
    const int G = lane >> 4, i = lane & 15;
    LDSP const bf16_t* a = base + (k0 + 8 * G + (i >> 2)) * ld + r0 + 4 * (i & 3);
    const s16x4 lo = __builtin_bit_cast(s16x4, __builtin_amdgcn_ds_read_tr16_b64_v4i16((LDSP s16x4*)a));
    const s16x4 hi = __builtin_bit_cast(s16x4, __builtin_amdgcn_ds_read_tr16_b64_v4i16((LDSP s16x4*)(a + 4 * ld)));
    return (bf16x8v){lo[0], lo[1], lo[2], lo[3], hi[0], hi[1], hi[2], hi[3]};
}
DI u32x2v pack4(f32x4v v) { return mk2(pk2(v[0], v[1]), pk2(v[2], v[3])); }
DI void unpack8(u32x4v v, float* o) { o[0] = __uint_as_float(v.x << 16); o[1] = __uint_as_float(v.x & 0xffff0000u); o[2] = __uint_as_float(v.y << 16); o[3] = __uint_as_float(v.y & 0xffff0000u);
    o[4] = __uint_as_float(v.z << 16); o[5] = __uint_as_float(v.z & 0xffff0000u); o[6] = __uint_as_float(v.w << 16); o[7] = __uint_as_float(v.w & 0xffff0000u); }
DI u32x4v pack8(const float* o) { return mk4(pk2(o[0], o[1]), pk2(o[2], o[3]), pk2(o[4], o[5]), pk2(o[6], o[7])); }

DI float fast_logsigmoid(float x) { return -(fmaxf(-x, 0.f) + __logf(1.0f + __expf(-fabsf(x)))); }
DI float fast_softplus(float x) { return fmaxf(x, 0.f) + __logf(1.0f + __expf(-fabsf(x))); }
struct XbcSrc { const bf16_t* base; int ld; };
DI XbcSrc xbc_src(const P& p, int tok0) { XbcSrc r; r.base = p.XBCC + (size_t)tok0 * 768; r.ld = 768; return r; }

DI void prep_conv_item(const P& p, int l, int item, int lane) {
    int piece, ch;
    if (item < T / 32) { piece = item; ch = lane * 8; } else { piece = 2 * (item - T / 32) + (lane >> 5); ch = 512 + (lane & 31) * 8; }
    const int t0 = piece * 32; int lo, hi; bf16_t* dst; int dld;
    if (t0 < TC) { lo = t0 & ~(CTXL - 1); hi = lo + CTXL - 1; } else { lo = TC + ((t0 - TC) & ~63); hi = lo + 63; }
    dst = p.XBCC + ch; dld = 768;
    const bf16_t* src = p.PROJ + OFF_XBC + ch;
    float wgt[5][8], bias[8];
#pragma unroll
    for (int k = 0; k < 5; ++k) { const f32x4v a = *(const f32x4v*)(p.conv_w + l * 5 * 768 + k * 768 + ch), c = *(const f32x4v*)(p.conv_w + l * 5 * 768 + k * 768 + ch + 4);
#pragma unroll
        for (int j = 0; j < 4; ++j) { wgt[k][j] = a[j]; wgt[k][4 + j] = c[j]; } }
    { const f32x4v a = *(const f32x4v*)(p.conv_b + l * 768 + ch), c = *(const f32x4v*)(p.conv_b + l * 768 + ch + 4);
#pragma unroll
      for (int j = 0; j < 4; ++j) { bias[j] = a[j]; bias[4 + j] = c[j]; } }
    const u32x4v zero4 = mk4(0u, 0u, 0u, 0u);
    u32x4v rw[13];
#pragma unroll
    for (int i = 0; i < 5; ++i) { const int tt = t0 - 2 + i; rw[i] = (tt >= lo && tt <= hi) ? *(const u32x4v*)(src + (size_t)tt * LDP) : zero4; }
    for (int s0 = 0; s0 < 32; s0 += 8) {
        const int t = t0 + s0;
#pragma unroll
        for (int i = 0; i < 8; ++i) { const int tt = t + 3 + i; rw[5 + i] = (tt <= hi) ? *(const u32x4v*)(src + (size_t)tt * LDP) : zero4; }
#pragma unroll
        for (int i = 0; i < 8; ++i) {
            float o[8];
#pragma unroll
            for (int c = 0; c < 8; ++c) o[c] = bias[c];
#pragma unroll
            for (int k = 0; k < 5; ++k) { float v[8]; unpack8(rw[i + k], v);
#pragma unroll
                for (int c = 0; c < 8; ++c) o[c] += wgt[k][c] * v[c]; }
#pragma unroll
            for (int c = 0; c < 8; ++c) o[c] = siluf(o[c]);
            *(u32x4v*)(dst + (size_t)(t + i) * dld) = pack8(o);
        }
#pragma unroll
        for (int i = 0; i < 5; ++i) rw[i] = rw[i + 8];
    }
}
DI void prep_ssd_item(const P& p, int l, int item, int lane) {
    const int tl = item >> 3, h = item & 7, tok0 = tile_tok0(tl);
    const float bsf = p.dt_bias_f[l * 8 + h], bsb = p.dt_bias_b[l * 8 + h];
    const float r0 = bf2f(p.PROJ[(size_t)(tok0 + 2 * lane) * LDP + OFF_DT + h]), r1 = bf2f(p.PROJ[(size_t)(tok0 + 2 * lane + 1) * LDP + OFF_DT + h]);
    const float f0 = fast_softplus(r0 + bsf), f1 = fast_softplus(r1 + bsf), b0 = fast_softplus(r0 + bsb), b1 = fast_softplus(r1 + bsb);
    float pf = f0 + f1, sb = b0 + b1;
#pragma unroll
    for (int o = 1; o < 64; o <<= 1) { const float t = shl(pf, lane >= o ? lane - o : lane); if (lane >= o) pf += t; }
#pragma unroll
    for (int o = 1; o < 64; o <<= 1) { const float t = shl(sb, lane + o < 64 ? lane + o : lane); if (lane + o < 64) sb += t; }
    const float Af = -__expf(p.a_log_f[l * 8 + h]) * LOG2E, Ab = -__expf(p.a_log_b[l * 8 + h]) * LOG2E;
    const float af0 = Af * (pf - f1), af1 = Af * pf, ab0 = Ab * sb, ab1 = Ab * (sb - b0);
    f32x4v* dst = (f32x4v*)p.SSC + (size_t)(tok0 + 2 * lane) * 8 + h;
    dst[0] = mkf4(af0, af0 - __log2f(f0), ab0, ab0 - __log2f(b0));
    dst[8] = mkf4(af1, af1 - __log2f(f1), ab1, ab1 - __log2f(b1));
    if (lane == 63) { p.STOT[(tl * 8 + h) * 2 + 0] = af1; p.SDEC[(tl * 8 + h) * 2 + 0] = __builtin_amdgcn_exp2f(af1); }
    if (lane == 0) { p.STOT[(tl * 8 + h) * 2 + 1] = ab0; p.SDEC[(tl * 8 + h) * 2 + 1] = __builtin_amdgcn_exp2f(ab0); }
}
template <int CTRL> DI float dppz(float x) { return __builtin_bit_cast(float, __builtin_amdgcn_update_dpp(0, __builtin_bit_cast(int, x), CTRL, 0xf, 0xf, true)); }
DI float row_total(float s) { s += dppz<0xB1>(s); s += dppz<0x4E>(s); s += dppz<0x141>(s); s += dppz<0x140>(s); return s; }
struct GlaPL { u32x4v qv_[2], kv_[2], vv_[4]; bf16x8v gkf[8]; float uw[8]; f32x4v bias; };
DI void prep_gla_load(const P& p, int l, int it, GlaPL& L) {
    const int tl = it >> 2, h = it & 3;
    const int tid = ltid(), lane = tid & 63, w = __builtin_amdgcn_readfirstlane(tid >> 6), kt = w & 3, dir = w >> 2, G = lane >> 4, c = lane & 15, tok0 = tile_tok0(tl);
#pragma unroll
    for (int nt = 0; nt < 8; ++nt) L.gkf[nt] = *(const bf16x8v*)(p.PROJ + (size_t)(tok0 + 16 * nt + c) * LDP + OFF_GK + (G & 1) * 8);
    { const float* up = (dir ? p.gk_up_b : p.gk_up_f) + l * 16 * 256 + (G & 1) * 8 * 256 + h * 64 + 16 * kt + c;
#pragma unroll
      for (int e = 0; e < 8; ++e) L.uw[e] = up[e * 256]; }
    L.bias = *(const f32x4v*)((dir ? p.gk_bias_b : p.gk_bias_f) + l * 256 + h * 64 + 16 * kt + 4 * G);
#pragma unroll
    for (int q = 0; q < 4; ++q) { const int cc_ = tid + q * NTHR, r = cc_ >> 4, cc = cc_ & 15; L.vv_[q] = *(const u32x4v*)(p.PROJ + (size_t)(tok0 + r) * LDP + OFF_V + h * 128 + cc * 8); }
#pragma unroll
    for (int q = 0; q < 2; ++q) { const int cc_ = tid + q * NTHR, r = cc_ >> 3, cc = cc_ & 7; const bf16_t* pr = p.PROJ + (size_t)(tok0 + r) * LDP;
        L.qv_[q] = *(const u32x4v*)(pr + OFF_Q + h * 64 + cc * 8); L.kv_[q] = *(const u32x4v*)(pr + OFF_K + h * 64 + cc * 8); }
}
DI void prep_gla_block(const P& p, int l, int it, int it_next, GlaPL& L, LDSP unsigned char* lds) {
    const int tl = it >> 2, h = it & 3;
    const int tid = ltid(), lane = tid & 63, w = __builtin_amdgcn_readfirstlane(tid >> 6), kt = w & 3, dir = w >> 2, G = lane >> 4, c = lane & 15, tok0 = tile_tok0(tl);
    LDSP bf16_t* QT = (LDSP bf16_t*)lds; LDSP bf16_t* KT = QT + 128 * LD64; LDSP bf16_t* O4 = KT + 128 * LD64; LDSP bf16_t* VT = O4 + 4 * 128 * LD64; LDSP float* DEC = (LDSP float*)(VT + 128 * LD128);
    f32x4v g[8];
    { bf16x8v af;
#pragma unroll
      for (int e = 0; e < 8; ++e) { const bf16_t hi = f2bf(L.uw[e]); const bf16_t lo = f2bf(L.uw[e] - bf2f(hi)); af[e] = (short)(G < 2 ? hi : lo); }
#pragma unroll
      for (int nt = 0; nt < 8; ++nt) g[nt] = mfma16(af, L.gkf[nt], (f32x4v){0.f, 0.f, 0.f, 0.f}); }
#pragma unroll
    for (int nt = 0; nt < 8; ++nt)
#pragma unroll
        for (int r = 0; r < 4; ++r) { const float x = (g[nt][r] + L.bias[r]) * LOG2E;
            g[nt][r] = -(fmaxf(-x, 0.f) + __log2f(1.0f + __builtin_amdgcn_exp2f(-fabsf(x)))) * (1.0f / 16.0f); }
    f32x4v tot = (f32x4v){0.f, 0.f, 0.f, 0.f};
    if (dir == 0) {
#pragma unroll
        for (int nt = 0; nt < 8; ++nt)
#pragma unroll
            for (int r = 0; r < 4; ++r) { const float s = row_total(g[nt][r]); float x = g[nt][r];
                x += dppz<0x111>(x); x += dppz<0x112>(x); x += dppz<0x114>(x); x += dppz<0x118>(x);
                g[nt][r] = tot[r] + x; tot[r] += s; }
    } else {
#pragma unroll
        for (int nt = 7; nt >= 0; --nt)
#pragma unroll
            for (int r = 0; r < 4; ++r) { const float s = row_total(g[nt][r]); float x = g[nt][r];
                x += dppz<0x101>(x); x += dppz<0x102>(x); x += dppz<0x104>(x); x += dppz<0x108>(x);
                g[nt][r] = tot[r] + x; tot[r] += s; }
    }
    __syncthreads();
#pragma unroll
    for (int q = 0; q < 2; ++q) { const int cc_ = tid + q * NTHR, r = cc_ >> 3, cc = cc_ & 7; *(LDSP u32x4v*)(QT + r * LD64 + cc * 8) = L.qv_[q]; *(LDSP u32x4v*)(KT + r * LD64 + cc * 8) = L.kv_[q]; }
#pragma unroll
    for (int q = 0; q < 4; ++q) { const int cc_ = tid + q * NTHR, r = cc_ >> 4, cc = cc_ & 15; *(LDSP u32x4v*)(VT + r * LD128 + cc * 8) = L.vv_[q]; }
    __syncthreads();
    { LDSP bf16_t* OQ = O4 + (2 * dir) * 128 * LD64; LDSP bf16_t* OK = OQ + 128 * LD64;
#pragma unroll
      for (int nt = 0; nt < 8; ++nt) { const int o = (16 * nt + c) * LD64 + 16 * kt + 4 * G;
          const u32x2v q2 = *(LDSP const u32x2v*)(QT + o), k2 = *(LDSP const u32x2v*)(KT + o);
          float eq[4], ek[4];
#pragma unroll
          for (int r = 0; r < 4; ++r) { eq[r] = __builtin_amdgcn_exp2f(g[nt][r] - 3.0f); ek[r] = __builtin_amdgcn_exp2f(-g[nt][r]); }
          *(LDSP u32x2v*)(OQ + o) = mk2(pk2(__uint_as_float(q2.x << 16) * eq[0], __uint_as_float(q2.x & 0xffff0000u) * eq[1]), pk2(__uint_as_float(q2.y << 16) * eq[2], __uint_as_float(q2.y & 0xffff0000u) * eq[3]));
          *(LDSP u32x2v*)(OK + o) = mk2(pk2(__uint_as_float(k2.x << 16) * ek[0], __uint_as_float(k2.x & 0xffff0000u) * ek[1]), pk2(__uint_as_float(k2.y << 16) * ek[2], __uint_as_float(k2.y & 0xffff0000u) * ek[3])); }
      if (c == 0) { const f32x4v d = mkf4(__builtin_amdgcn_exp2f(tot[0]), __builtin_amdgcn_exp2f(tot[1]), __builtin_amdgcn_exp2f(tot[2]), __builtin_amdgcn_exp2f(tot[3]));
          *(f32x4v*)(p.GDEC + (size_t)((tl * 4 + h) * 2 + dir) * 64 + 16 * kt + 4 * G) = d; *(LDSP f32x4v*)(DEC + dir * 64 + 16 * kt + 4 * G) = d; } }
    __syncthreads();
    if (it_next >= 0) prep_gla_load(p, l, it_next, L);
#pragma unroll
    for (int q = 0; q < 8; ++q) { const int cc_ = tid + q * NTHR, a4 = cc_ >> 10, r = (cc_ >> 3) & 127, cc = cc_ & 7;
        *(u32x4v*)(p.QKB + (size_t)(tok0 + r) * 1024 + a4 * 256 + h * 64 + cc * 8) = *(LDSP const u32x4v*)(O4 + (a4 * 128 + r) * LD64 + cc * 8); }
    { const int ut = kt; LDSP const bf16_t* KE = O4 + (dir ? 3 : 1) * 128 * LD64;
      f32x4v acc[8];
#pragma unroll
      for (int q = 0; q < 8; ++q) acc[q] = (f32x4v){0.f, 0.f, 0.f, 0.f};
#pragma unroll
      for (int ks = 0; ks < 4; ++ks) { const bf16x8v u = frag_col(KE, LD64, 16 * ut, 32 * ks, lane);
#pragma unroll
          for (int q = 0; q < 8; ++q) acc[q] = mfma16(u, frag_col(VT, LD128, 16 * q, 32 * ks, lane), acc[q]); }
      const f32x4v dec = *(LDSP const f32x4v*)(DEC + dir * 64 + 16 * ut + 4 * (lane >> 4));
      bf16_t* dst = p.GS + ((size_t)((tl * 4 + h) * 2 + dir) * 128) * 64;
#pragma unroll
      for (int q = 0; q < 8; ++q) *(u32x2v*)(dst + (size_t)(16 * q + (lane & 15)) * 64 + 16 * ut + 4 * (lane >> 4)) = pack4(acc[q] * dec); }
}
constexpr int NPREP_A = T / 32 + T / 64, NPREP_B = NTILE * 8;
DI void ph_prep(const P& p, int l, LDSP unsigned char* lds) {
    const int tid_ = ltid(), lane = tid_ & 63, gw = blockIdx.x * NWV + (tid_ >> 6), NW = gridDim.x * NWV;
    for (int it = gw; it < NPREP_A + NPREP_B; it += NW) {
        if (it < NPREP_A) prep_conv_item(p, l, it, lane); else prep_ssd_item(p, l, it - NPREP_A, lane);
    }
    { const int G_ = gridDim.x; int it = G_ - 1 - (int)blockIdx.x;
      GlaPL L; if (it < NTILE * 4) prep_gla_load(p, l, it, L);
      for (; it < NTILE * 4; it += G_) prep_gla_block(p, l, it, it + G_ < NTILE * 4 ? it + G_ : -1, L, lds); }
}

DI int ssd_item(int k, int ntile) {
    const int G_ = gridDim.x, b = blockIdx.x;
    if (G_ != 256) { const int it = b + k * G_; return it < ntile * 8 ? it : -1; }
    const int xcd = b & 7, slot = b >> 3, pp = ((xcd + 4) & 7) * 8 + (slot >> 2), q = k * 32 + (pp >> 1);
    return q < ntile ? q * 8 + 4 * (pp & 1) + (slot & 3) : -1;
}
struct S1Pre { u32x4v x0, x1, b0, b1; f32x4v sc; float tf, tb; };
DI void s1_load(const P& p, int tl, int h, int tid, S1Pre& r) {
    const int tok0 = tile_tok0(tl), g = h >> 2; const XbcSrc xs = xbc_src(p, tok0);
    const int j = tid >> 2, cq = tid & 3;
    const bf16_t* row = xs.base + (size_t)j * xs.ld;
    r.x0 = *(const u32x4v*)(row + h * 64 + cq * 16); r.x1 = *(const u32x4v*)(row + h * 64 + cq * 16 + 8);
    r.b0 = *(const u32x4v*)(row + 512 + g * 64 + cq * 16); r.b1 = *(const u32x4v*)(row + 512 + g * 64 + cq * 16 + 8);
    r.sc = *((const f32x4v*)p.SSC + (size_t)(tok0 + j) * 8 + h);
    r.tf = p.STOT[(tl * 8 + h) * 2 + 0]; r.tb = p.STOT[(tl * 8 + h) * 2 + 1];
}
DI void s1_ssd(const P& p, int tl, int h, S1Pre& pre, int it_n, LDSP unsigned char* lds) {
    const int tid = ltid(), lane = tid & 63, w = __builtin_amdgcn_readfirstlane(tid >> 6);
    LDSP bf16_t* XWF = (LDSP bf16_t*)lds; LDSP bf16_t* XWB = XWF + 128 * LD64; LDSP bf16_t* BG = XWB + 128 * LD64;
    const int j = tid >> 2, cq = tid & 3;
    const float wf = __builtin_amdgcn_exp2f(pre.tf - pre.sc.y), wb = __builtin_amdgcn_exp2f(pre.tb - pre.sc.w);
    float xv[16], of[16], ob[16]; unpack8(pre.x0, xv); unpack8(pre.x1, xv + 8);
#pragma unroll
    for (int c = 0; c < 16; ++c) { of[c] = xv[c] * wf; ob[c] = xv[c] * wb; }
    __syncthreads();
    *(LDSP u32x4v*)(XWF + j * LD64 + cq * 16) = pack8(of); *(LDSP u32x4v*)(XWF + j * LD64 + cq * 16 + 8) = pack8(of + 8);
    *(LDSP u32x4v*)(XWB + j * LD64 + cq * 16) = pack8(ob); *(LDSP u32x4v*)(XWB + j * LD64 + cq * 16 + 8) = pack8(ob + 8);
    *(LDSP u32x4v*)(BG + j * LD64 + cq * 16) = pre.b0; *(LDSP u32x4v*)(BG + j * LD64 + cq * 16 + 8) = pre.b1;
    if (it_n >= 0) s1_load(p, it_n >> 3, it_n & 7, tid, pre);
    __syncthreads();
    const int dir = w >> 2, ut = w & 3; LDSP const bf16_t* XW = dir ? XWB : XWF;
    f32x4v acc[4];
#pragma unroll
    for (int q = 0; q < 4; ++q) acc[q] = (f32x4v){0.f, 0.f, 0.f, 0.f};
#pragma unroll
    for (int ks = 0; ks < 4; ++ks) { const bf16x8v u = frag_col(BG, LD64, 16 * ut, 32 * ks, lane);
#pragma unroll
        for (int q = 0; q < 4; ++q) acc[q] = mfma16(u, frag_col(XW, LD64, 16 * q, 32 * ks, lane), acc[q]); }
    bf16_t* dst = p.SS + ((size_t)((tl * 8 + h) * 2 + dir) * 64) * 64;
#pragma unroll
    for (int q = 0; q < 4; ++q) *(u32x2v*)(dst + (size_t)(16 * q + (lane & 15)) * 64 + 16 * ut + 4 * (lane >> 4)) = pack4(acc[q]);
}
DI void ph_s1(const P& p, int l, LDSP unsigned char* lds) {
    S1Pre pre; int it = ssd_item(0, NTILE);
    if (it >= 0) s1_load(p, it >> 3, it & 7, ltid(), pre);
    for (int k = 0; it >= 0; ++k) { const int nx = ssd_item(k + 1, NTILE); s1_ssd(p, it >> 3, it & 7, pre, nx, lds); it = nx; }
}

DI int s2_chunk(int dir, int s) { return dir == 0 ? s : (s < 2 ? 1 - s : 35 - s); }
DI void ph_s2(const P& p) {
    const int g = blockIdx.x * NTHR + ltid();
    for (int v = g; v < 131072; v += gridDim.x * NTHR) {
        const bool gla = v >= 65536; const int r = v & 65535;
        int b, h, dir, vi;
        if (!gla) { vi = r & 511; dir = (r >> 9) & 1; h = (r >> 10) & 7; b = r >> 13; } else { vi = r & 1023; dir = (r >> 10) & 1; h = (r >> 11) & 3; b = r >> 13; }
        float st[8];
#pragma unroll
        for (int e = 0; e < 8; ++e) st[e] = 0.f;
        for (int s0 = 0; s0 < NCH; s0 += 6) {
            u32x4v sv[6]; float dsc[6]; f32x4v dv0[6], dv1[6];
#pragma unroll
            for (int u = 0; u < 6; ++u) { if (s0 + u >= NCH) continue; const int tl = b * NCH + s2_chunk(dir, s0 + u);
                if (!gla) { sv[u] = *(const u32x4v*)(p.SS + ((size_t)((tl * 8 + h) * 2 + dir) * 512 + vi) * 8); dsc[u] = p.SDEC[(tl * 8 + h) * 2 + dir]; }
                else { sv[u] = *(const u32x4v*)(p.GS + ((size_t)((tl * 4 + h) * 2 + dir) * 1024 + vi) * 8); const f32x4v* d = (const f32x4v*)(p.GDEC + (size_t)((tl * 4 + h) * 2 + dir) * 64 + (vi & 7) * 8); dv0[u] = d[0]; dv1[u] = d[1]; } }
#pragma unroll
            for (int u = 0; u < 6; ++u) { if (s0 + u >= NCH) continue; const int tl = b * NCH + s2_chunk(dir, s0 + u);
                float loc[8]; unpack8(sv[u], loc);
                const u32x4v hin = pack8(st);
                if (!gla) { *(u32x4v*)(p.SS + ((size_t)((tl * 8 + h) * 2 + dir) * 512 + vi) * 8) = hin;
#pragma unroll
                    for (int e = 0; e < 8; ++e) st[e] = dsc[u] * st[e] + loc[e]; }
                else { *(u32x4v*)(p.GS + ((size_t)((tl * 4 + h) * 2 + dir) * 1024 + vi) * 8) = hin;
                    const float dd[8] = {dv0[u].x, dv0[u].y, dv0[u].z, dv0[u].w, dv1[u].x, dv1[u].y, dv1[u].z, dv1[u].w};
#pragma unroll
                    for (int e = 0; e < 8; ++e) st[e] = dd[e] * st[e] + loc[e]; } }
        }
    }
}

DI int s3_tile(int l, int q) { return l == 0 ? q : (q >> 5) * NCH + 2 + (q & 31); }
struct SsdPre { u32x4v x0, x1, b0, b1, c0, c1, hf, hb; f32x4v sc; };
DI void s3_ssd_load(const P& p, int tl, int h, int tid, int i, int G, SsdPre& r) {
    const int tok0 = tile_tok0(tl), g = h >> 2; const XbcSrc xs = xbc_src(p, tok0);
    const int j = tid >> 2, cq = tid & 3; const bf16_t* row = xs.base + (size_t)j * xs.ld;
    r.x0 = *(const u32x4v*)(row + h * 64 + cq * 16); r.x1 = *(const u32x4v*)(row + h * 64 + cq * 16 + 8);
    r.b0 = *(const u32x4v*)(row + 512 + g * 64 + cq * 16); r.b1 = *(const u32x4v*)(row + 512 + g * 64 + cq * 16 + 8);
    r.c0 = *(const u32x4v*)(row + 640 + g * 64 + cq * 16); r.c1 = *(const u32x4v*)(row + 640 + g * 64 + cq * 16 + 8);
    const bf16_t* Hf = p.SS + (size_t)((tl * 8 + h) * 2 + 0) * 4096 + (tid >> 3) * 64 + (tid & 7) * 8;
    r.hf = *(const u32x4v*)Hf; r.hb = *(const u32x4v*)(Hf + 4096);
    r.sc = *((const f32x4v*)p.SSC + (size_t)(tok0 + (tid & 127)) * 8 + h);
}
DI void ph_s3_ssd(const P& p, int l, LDSP unsigned char* lds) {
    const int tid = ltid(), lane = tid & 63, w = __builtin_amdgcn_readfirstlane(tid >> 6), G = lane >> 4, li = lane & 15, i = 16 * w + li;
    LDSP bf16_t* XH = (LDSP bf16_t*)lds; LDSP bf16_t* BG = XH + 128 * LD64; LDSP bf16_t* CG = BG + 128 * LD64; LDSP bf16_t* MM = CG + 128 * LD64; LDSP f32x4v* SC = (LDSP f32x4v*)(MM + 128 * LD128);
    LDSP bf16_t* HF = (LDSP bf16_t*)(SC + 128); LDSP bf16_t* HB = HF + 64 * LD64;
    const int ntl = l == 0 ? NTILE : NB * 32;
    int it = ssd_item(0, ntl); SsdPre pre;
    if (it >= 0) s3_ssd_load(p, s3_tile(l, it >> 3), it & 7, tid, i, G, pre);
    for (int k_ = 0; it >= 0; ++k_) {
        const int it_n = ssd_item(k_ + 1, ntl);
        const int tl = s3_tile(l, it >> 3), h = it & 7, tok0 = tile_tok0(tl);
        __syncthreads();
        { const int j = tid >> 2, cq = tid & 3;
          *(LDSP u32x4v*)(XH + j * LD64 + cq * 16) = pre.x0; *(LDSP u32x4v*)(XH + j * LD64 + cq * 16 + 8) = pre.x1;
          *(LDSP u32x4v*)(BG + j * LD64 + cq * 16) = pre.b0; *(LDSP u32x4v*)(BG + j * LD64 + cq * 16 + 8) = pre.b1;
          *(LDSP u32x4v*)(CG + j * LD64 + cq * 16) = pre.c0; *(LDSP u32x4v*)(CG + j * LD64 + cq * 16 + 8) = pre.c1;
          *(LDSP u32x4v*)(HF + (tid >> 3) * LD64 + (tid & 7) * 8) = pre.hf; *(LDSP u32x4v*)(HB + (tid >> 3) * LD64 + (tid & 7) * 8) = pre.hb;
          if (tid < 128) SC[tid] = pre.sc; }
        if (it_n >= 0) s3_ssd_load(p, s3_tile(l, it_n >> 3), it_n & 7, tid, i, G, pre);
        __syncthreads();
        u32x2v zr[4];
#pragma unroll
        for (int pt = 0; pt < 4; ++pt) zr[pt] = *(const u32x2v*)(p.PROJ + (size_t)(tok0 + i) * LDP + OFF_Z + h * 64 + 16 * pt + 4 * G);
        const f32x4v sci = SC[i];
        {
            f32x4v am[8];
#pragma unroll
            for (int ut = 0; ut < 8; ++ut) am[ut] = (f32x4v){0.f, 0.f, 0.f, 0.f};
#pragma unroll
            for (int ks = 0; ks < 2; ++ks) { const bf16x8v vfr = frag_row(CG, LD64, 16 * w, 32 * ks, lane);
#pragma unroll
                for (int ut = 0; ut < 8; ++ut) am[ut] = mfma16(frag_row(BG, LD64, 16 * ut, 32 * ks, lane), vfr, am[ut]); }
#pragma unroll
            for (int ut = 0; ut < 8; ++ut) { f32x4v m;
#pragma unroll
                for (int r = 0; r < 4; ++r) { const int jj = 16 * ut + 4 * G + r; const f32x4v scj = SC[jj];
                    const float Lf = jj <= i ? __builtin_amdgcn_exp2f(fminf(sci.x - scj.y, 30.f)) : 0.f, Lb = jj >= i ? __builtin_amdgcn_exp2f(fminf(sci.z - scj.w, 30.f)) : 0.f;
                    m[r] = am[ut][r] * (Lf + Lb); }
                *(LDSP u32x2v*)(MM + i * LD128 + 16 * ut + 4 * G) = pack4(m); }
        }
        asm volatile("s_waitcnt lgkmcnt(0)" ::: "memory");
        f32x4v ay[4], af_[4], ab_[4];
#pragma unroll
        for (int pt = 0; pt < 4; ++pt) { ay[pt] = (f32x4v){0.f, 0.f, 0.f, 0.f}; af_[pt] = ay[pt]; ab_[pt] = ay[pt]; }
#pragma unroll
        for (int ks = 0; ks < 2; ++ks) { const bf16x8v vfr = frag_row(CG, LD64, 16 * w, 32 * ks, lane);
#pragma unroll
            for (int pt = 0; pt < 4; ++pt) { af_[pt] = mfma16(frag_row(HF, LD64, 16 * pt, 32 * ks, lane), vfr, af_[pt]); ab_[pt] = mfma16(frag_row(HB, LD64, 16 * pt, 32 * ks, lane), vfr, ab_[pt]); } }
#pragma unroll
        for (int ks = 0; ks < 4; ++ks) { const bf16x8v vfr = frag_row(MM, LD128, 16 * w, 32 * ks, lane);
#pragma unroll
            for (int pt = 0; pt < 4; ++pt) ay[pt] = mfma16(frag_col(XH, LD64, 16 * pt, 32 * ks, lane), vfr, ay[pt]); }
        const float sf = __builtin_amdgcn_exp2f(sci.x), sb = __builtin_amdgcn_exp2f(sci.z), dsk = p.d_skip[l * 8 + h];
        float ssq = 0.f;
#pragma unroll
        for (int pt = 0; pt < 4; ++pt) { const int pc = 16 * pt + 4 * G;
            const u32x2v xr = *(LDSP const u32x2v*)(XH + i * LD64 + pc);
            const float xv[4] = {__uint_as_float(xr.x << 16), __uint_as_float(xr.x & 0xffff0000u), __uint_as_float(xr.y << 16), __uint_as_float(xr.y & 0xffff0000u)};
            const float zv[4] = {__uint_as_float(zr[pt].x << 16), __uint_as_float(zr[pt].x & 0xffff0000u), __uint_as_float(zr[pt].y << 16), __uint_as_float(zr[pt].y & 0xffff0000u)};
            float yv[4];
#pragma unroll
            for (int r = 0; r < 4; ++r) { yv[r] = (ay[pt][r] + sf * af_[pt][r] + sb * ab_[pt][r] + dsk * xv[r]) * siluf(zv[r]); ssq += yv[r] * yv[r]; }
            *(unsigned*)((unsigned char*)p.H + (size_t)(tok0 + i) * D + h * 64 + pc) = pg8::pk4_fp8((pg8::f32x4){yv[0], yv[1], yv[2], yv[3]} * 2.0f); }
        ssq += shx(ssq, 16, lane); ssq += shx(ssq, 32, lane);
        if (G == 0) p.SSQ[(size_t)(tok0 + i) * 8 + h] = ssq;
        it = it_n;
    }
}
DI int gla_item(int k, int nit) {
    const int G_ = gridDim.x, b = blockIdx.x;
    if (G_ != 256) { const int it = b + k * G_; return it < nit ? it : -1; }
    const int full = nit >> 8;
    if (k < full) return b + (k << 8);
    if (k > full || (b & 7) >= 4) return -1;
    const int idx = (b >> 3) * 4 + (b & 7);
    return idx < (nit & 255) ? (full << 8) + idx : -1;
}
struct GlaPre { u32x4v qk[2][4], vv[4], sf[2], sb[2]; };
DI void s3_gla_load(const P& p, int tl, int h, int tid, int i, int G, GlaPre& r) {
    const int tok0 = tile_tok0(tl);
#pragma unroll
    for (int q = 0; q < 2; ++q) { const int c = tid + q * NTHR, rr = c >> 3, cc = c & 7; const bf16_t* qb = p.QKB + (size_t)(tok0 + rr) * 1024 + h * 64 + cc * 8;
        r.qk[q][0] = *(const u32x4v*)qb; r.qk[q][1] = *(const u32x4v*)(qb + 256);
        r.qk[q][2] = *(const u32x4v*)(qb + 512); r.qk[q][3] = *(const u32x4v*)(qb + 768);
        const bf16_t* Sg = p.GS + (size_t)((tl * 4 + h) * 2 + 0) * 8192 + (size_t)rr * 64 + cc * 8; r.sf[q] = *(const u32x4v*)Sg; r.sb[q] = *(const u32x4v*)(Sg + 8192); }
#pragma unroll
    for (int q = 0; q < 4; ++q) { const int c = tid + q * NTHR, rr = c >> 4, cc = c & 15; r.vv[q] = *(const u32x4v*)(p.PROJ + (size_t)(tok0 + rr) * LDP + OFF_V + h * 128 + cc * 8); }
}
DI void ph_s3_gla(const P& p, int l, LDSP unsigned char* lds) {
    const int tid = ltid(), lane = tid & 63, w = __builtin_amdgcn_readfirstlane(tid >> 6), G = lane >> 4, li = lane & 15, i = 16 * w + li;
    LDSP bf16_t* Q2 = (LDSP bf16_t*)lds;
    LDSP bf16_t* KF = Q2 + 8 * 2 * 16 * LD64; LDSP bf16_t* KB = KF + 128 * LD64; LDSP bf16_t* VT = KB + 128 * LD64; LDSP bf16_t* SF = VT + 128 * LD128; LDSP bf16_t* SB = SF + 128 * LD64;
    LDSP bf16_t* AMw = SF + w * 16 * LD128;
    const int nit = (l == 0 ? NTILE : NB * 32) * 4;
    int it = gla_item(0, nit); GlaPre pre;
    if (it >= 0) s3_gla_load(p, s3_tile(l, it >> 2), it & 3, tid, i, G, pre);
    for (int k_ = 0; it >= 0; ++k_) {
        const int it_n = gla_item(k_ + 1, nit);
        const int tl = s3_tile(l, it >> 2), h = it & 3, tok0 = tile_tok0(tl);
        __syncthreads();
#pragma unroll
        for (int q = 0; q < 2; ++q) { const int c = tid + q * NTHR, rr = c >> 3, cc = c & 7; LDSP bf16_t* qrow = Q2 + (rr >> 4) * (2 * 16 * LD64) + (rr & 15) * LD64 + cc * 8;
            *(LDSP u32x4v*)qrow = pre.qk[q][0]; *(LDSP u32x4v*)(qrow + 16 * LD64) = pre.qk[q][2];
            *(LDSP u32x4v*)(KF + rr * LD64 + cc * 8) = pre.qk[q][1]; *(LDSP u32x4v*)(KB + rr * LD64 + cc * 8) = pre.qk[q][3];
            *(LDSP u32x4v*)(SF + rr * LD64 + cc * 8) = pre.sf[q]; *(LDSP u32x4v*)(SB + rr * LD64 + cc * 8) = pre.sb[q]; }
#pragma unroll
        for (int q = 0; q < 4; ++q) { const int c = tid + q * NTHR, rr = c >> 4, cc = c & 15; *(LDSP u32x4v*)(VT + rr * LD128 + cc * 8) = pre.vv[q]; }
        if (it_n >= 0) s3_gla_load(p, s3_tile(l, it_n >> 2), it_n & 3, tid, i, G, pre);
        __syncthreads();
        f32x4v ao[8];
#pragma unroll
        for (int q = 0; q < 8; ++q) ao[q] = (f32x4v){0.f, 0.f, 0.f, 0.f};
        bf16x8v qfr[2][2];
#pragma unroll
        for (int dir = 0; dir < 2; ++dir)
#pragma unroll
            for (int ks = 0; ks < 2; ++ks) qfr[dir][ks] = frag_row(Q2 + w * (2 * 16 * LD64) + dir * 16 * LD64, LD64, 0, 32 * ks, lane);
#pragma unroll
        for (int dir = 0; dir < 2; ++dir) {
            LDSP const bf16_t* SS_ = dir ? SB : SF;
#pragma unroll
            for (int ks = 0; ks < 2; ++ks) {
#pragma unroll
                for (int vt = 0; vt < 8; ++vt) ao[vt] = mfma16(frag_row(SS_, LD64, 16 * vt, 32 * ks, lane), qfr[dir][ks], ao[vt]); }
        }
        __syncthreads();
#pragma unroll
        for (int uh = 0; uh < 4; ++uh) {
            f32x4v a2[2]; a2[0] = (f32x4v){0.f, 0.f, 0.f, 0.f}; a2[1] = a2[0];
#pragma unroll
            for (int dir = 0; dir < 2; ++dir) {
                LDSP const bf16_t* KS = dir ? KB : KF;
                f32x4v as[2]; as[0] = (f32x4v){0.f, 0.f, 0.f, 0.f}; as[1] = as[0];
#pragma unroll
                for (int ks = 0; ks < 2; ++ks) {
#pragma unroll
                    for (int q = 0; q < 2; ++q) as[q] = mfma16(frag_row(KS, LD64, 16 * (2 * uh + q), 32 * ks, lane), qfr[dir][ks], as[q]); }
#pragma unroll
                for (int q = 0; q < 2; ++q)
#pragma unroll
                    for (int r = 0; r < 4; ++r) { const int jj = 16 * (2 * uh + q) + 4 * G + r; const bool keep = dir == 0 ? (jj <= i) : (jj >= i); a2[q][r] += keep ? as[q][r] : 0.f; }
            }
#pragma unroll
            for (int q = 0; q < 2; ++q) *(LDSP u32x2v*)(AMw + li * LD128 + 16 * (2 * uh + q) + 4 * G) = pack4(a2[q]);
        }
        u32x2v gr[8];
#pragma unroll
        for (int vt = 0; vt < 8; ++vt) gr[vt] = *(const u32x2v*)(p.PROJ + (size_t)(tok0 + i) * LDP + OFF_GO + h * 128 + 16 * vt + 4 * G);
        asm volatile("s_waitcnt lgkmcnt(0)" ::: "memory");
#pragma unroll
        for (int ks = 0; ks < 4; ++ks) { const bf16x8v vfr = frag_row(AMw, LD128, 0, 32 * ks, lane);
#pragma unroll
            for (int vt = 0; vt < 8; ++vt) ao[vt] = mfma16(frag_col(VT, LD128, 16 * vt, 32 * ks, lane), vfr, ao[vt]); }
        float so = 0.f;
#pragma unroll
        for (int vt = 0; vt < 8; ++vt)
#pragma unroll
            for (int r = 0; r < 4; ++r) so += ao[vt][r] * ao[vt][r];
        so += shx(so, 16, lane); so += shx(so, 32, lane);
        const float ro = rsqrtf(so * (1.0f / 128.0f) + 1e-6f);
#pragma unroll
        for (int vt = 0; vt < 8; ++vt) { const int vc = 16 * vt + 4 * G; const f32x4v gg = *(const f32x4v*)(p.gla_norm_g + l * 128 + vc);
            const float g0 = __uint_as_float(gr[vt].x << 16), g1 = __uint_as_float(gr[vt].x & 0xffff0000u), g2 = __uint_as_float(gr[vt].y << 16), g3 = __uint_as_float(gr[vt].y & 0xffff0000u);
            *(unsigned*)((unsigned char*)p.H + (size_t)(tok0 + i) * D + 512 + h * 128 + vc) = pg8::pk4_fp8((pg8::f32x4){ao[vt][0] * gg.x * siluf(g0), ao[vt][1] * gg.y * siluf(g1), ao[vt][2] * gg.z * siluf(g2), ao[vt][3] * gg.w * siluf(g3)} * (8.0f * ro)); }
        it = it_n;
    }
}
DI void ph_s3(const P& p, int l, LDSP unsigned char* lds) { ph_s3_gla(p, l, lds); ph_s3_ssd(p, l, lds); }
struct RouteR { bool own; int t, e1, e2, r1, r2; };
template <int NR> DI void normroute_tile(const P& p, int tb, const float* MODl, LDSP int* lcnt, const float* g2, LDSP bf16_t* WR, LDSP bf16_t* HT, int lane, int G, int li, RouteR& R) {
    constexpr int LDW = 1032, LDT = 264;
        const float* mr = MODl + (size_t)tok_modrow(tb) * 6144;
        float rs[NR];
        { const f32x4v* q = (const f32x4v*)(p.XSS + (size_t)(tb + (li < NR ? li : 0)) * 16); const f32x4v a = q[0], b = q[1], c = q[2], d = q[3];
          const float ss = (((a.x + a.y) + (a.z + a.w)) + ((b.x + b.y) + (b.z + b.w))) + (((c.x + c.y) + (c.z + c.w)) + ((d.x + d.y) + (d.z + d.w)));
          const float r = rsqrtf(ss * (1.0f / D) + 1e-6f);
#pragma unroll
          for (int i = 0; i < NR; ++i) rs[i] = shl(r, i); }
        f32x4v acc[2]; acc[0] = (f32x4v){0.f, 0.f, 0.f, 0.f}; acc[1] = acc[0];
        u32x2v xq[NR];
#pragma unroll
        for (int i = 0; i < NR; ++i) xq[i] = *(const u32x2v*)(xrow(p, tb + i) + lane * 4);
#pragma unroll
        for (int kc = 0; kc < 4; ++kc) {
            const int kk = kc * 256 + lane * 4;
            const f32x4v gg = *(const f32x4v*)(g2 + kk), sh = *(const f32x4v*)(mr + 3 * 1024 + kk), sc = *(const f32x4v*)(mr + 4 * 1024 + kk);
            f32x4v gs;
#pragma unroll
            for (int j = 0; j < 4; ++j) gs[j] = gg[j] * (1.f + sc[j]);
#pragma unroll
            for (int i = 0; i < NR; ++i) { const u32x2v r = xq[i];
                const f32x4v xv = mkf4(__uint_as_float(r.x << 16), __uint_as_float(r.x & 0xffff0000u), __uint_as_float(r.y << 16), __uint_as_float(r.y & 0xffff0000u));
                const f32x4v h = xv * rs[i] * gs + sh; const u32x2v hb = pack4(h);
                *(unsigned*)((unsigned char*)p.H + (size_t)(tb + i) * D + kk) = pg8::pk4_fp8(h);
                *(LDSP u32x2v*)(HT + i * LDT + lane * 4) = hb; }
            if (kc < 3) {
#pragma unroll
                for (int i = 0; i < NR; ++i) xq[i] = *(const u32x2v*)(xrow(p, tb + i) + kk + 256); }
            asm volatile("s_waitcnt lgkmcnt(0)" ::: "memory");
#pragma unroll
            for (int ks = 0; ks < 8; ++ks) { const bf16x8v vfr = frag_row(HT, LDT, 0, 32 * ks, lane);
                acc[0] = mfma16(frag_row(WR, LDW, 0, kc * 256 + 32 * ks, lane), vfr, acc[0]);
                acc[1] = mfma16(frag_row(WR, LDW, 16, kc * 256 + 32 * ks, lane), vfr, acc[1]); }
            asm volatile("s_waitcnt lgkmcnt(0)" ::: "memory");
        }
        float bgs = -1e30f; int bgi = 0, e1 = 0, e2 = 0; float w1 = 0.f, w2 = 0.f;
#pragma unroll
        for (int ut = 0; ut < 2; ++ut) { const int gi = ut * 4 + G; float m1 = -1e30f, m2 = -1e30f, s1 = 0.f, s2 = 0.f; int i1 = 0, i2 = 0;
#pragma unroll
            for (int r = 0; r < 4; ++r) { const float sv = 1.0f / (1.0f + __expf(-acc[ut][r])), vv = sv + p.router_bias[gi * 4 + r];
                if (vv > m1) { m2 = m1; i2 = i1; s2 = s1; m1 = vv; i1 = gi * 4 + r; s1 = sv; } else if (vv > m2) { m2 = vv; i2 = gi * 4 + r; s2 = sv; } }
            if (m1 + m2 > bgs) { bgs = m1 + m2; bgi = gi; e1 = i1; e2 = i2; w1 = s1; w2 = s2; } }
#pragma unroll
        for (int o = 16; o <= 32; o <<= 1) {
            const float ogs = shx(bgs, o, lane), ow1 = shx(w1, o, lane), ow2 = shx(w2, o, lane); const int ogi = shxi(bgi, o, lane), oe1 = shxi(e1, o, lane), oe2 = shxi(e2, o, lane);
            if (ogs > bgs || (ogs == bgs && ogi < bgi)) { bgs = ogs; bgi = ogi; e1 = oe1; e2 = oe2; w1 = ow1; w2 = ow2; } }
        R.own = (G == 0 && li < NR); R.t = tb + li; R.e1 = e1; R.e2 = e2;
        if (R.own) { const float inv = 1.0f / (w1 + w2); p.EW[R.t * 2 + 0] = w1 * inv; p.EW[R.t * 2 + 1] = w2 * inv;
            R.r1 = __hip_atomic_fetch_add(&lcnt[e1], 1, __ATOMIC_RELAXED, __HIP_MEMORY_SCOPE_WORKGROUP); R.r2 = __hip_atomic_fetch_add(&lcnt[e2], 1, __ATOMIC_RELAXED, __HIP_MEMORY_SCOPE_WORKGROUP); }
}
DI void ph_normroute(const P& p, int l, int t0, LDSP unsigned char* lds) {
    const int tid_ = ltid(), lane = tid_ & 63, wv = tid_ >> 6, gw = blockIdx.x * NWV + wv, NW = gridDim.x * NWV, G = lane >> 4, li = lane & 15;
    const float* MODl = p.MOD + (size_t)l * 9 * 6144; int* counts = p.counts + l * 32 * 32;
    constexpr int LDW = 1032, LDT = 264;
    LDSP bf16_t* WR = (LDSP bf16_t*)lds;
    LDSP bf16_t* HT = WR + 32 * LDW + wv * 16 * LDT;
    { u32x4v wv_[8];
#pragma unroll
      for (int q = 0; q < 8; ++q) wv_[q] = *(const u32x4v*)(p.WRT + (size_t)(tid_ + q * NTHR) * 8);
#pragma unroll
      for (int q = 0; q < 8; ++q) { const int c = tid_ + q * NTHR; *(LDSP u32x4v*)(WR + (c >> 7) * LDW + (c & 127) * 8) = wv_[q]; } }
    __syncthreads();
    const float* g2 = p.norm2_g + l * D;
    const int ntok = T - t0, nfull = (ntok >> 4) / NW * NW, nrem = ntok - nfull * 16;
    LDSP int* lcnt = (LDSP int*)(WR + 32 * LDW + NWV * 16 * LDT);
    LDSP int* lbase = lcnt + 32;
    const int rf = (nfull + NW - 1) / NW, rr = (nrem + NW - 1) / NW;
    for (int rd = 0; rd < rf + rr; ++rd) {
        if (tid_ < 32) lcnt[tid_] = 0;
        __syncthreads();
        RouteR R; R.own = false; R.t = 0; R.e1 = 0; R.e2 = 0; R.r1 = 0; R.r2 = 0;
        if (rd < rf) { const int tile = rd * NW + gw; if (tile < nfull) normroute_tile<16>(p, t0 + tile * 16, MODl, lcnt, g2, WR, HT, lane, G, li, R); }
        else { const int e = (rd - rf) * NW + gw; if (e < nrem) normroute_tile<1>(p, t0 + nfull * 16 + e, MODl, lcnt, g2, WR, HT, lane, G, li, R); }
        __syncthreads();
        if (tid_ < 32) { const int c = lcnt[tid_]; lbase[tid_] = c > 0 ? atomicAdd(&counts[tid_ * 32], c) : 0; }
        __syncthreads();
        if (R.own) { const int r1 = lbase[R.e1] + R.r1, r2 = lbase[R.e2] + R.r2;
            p.MAP[(size_t)R.e1 * T + r1] = R.t; p.MAP[(size_t)R.e2 * T + r2] = R.t;
            *(int4*)(p.TOKSLOT + (size_t)R.t * 4) = make_int4(R.e1, r1, R.e2, r2); }
    }
}

DI void ph_combine(const P& p, int l, int t0, const unsigned char* Y  , LDSP int* ps  ) {
    const int tid_ = ltid(), lane = tid_ & 63, gw = blockIdx.x * NWV + __builtin_amdgcn_readfirstlane(tid_ >> 6)  , NW = gridDim.x * NWV;
    const float* MODl = p.MOD + (size_t)l * 9 * 6144; const int* counts = p.counts + l * 32 * 32;
    if (tid_ < 64) { const int cnt = tid_ < 32 ? counts[tid_ * 32] : 0; int pc = cnt;
#pragma unroll
        for (int o = 1; o < 32; o <<= 1) { const int src = lane >= o ? lane - o : lane; const int a = shli(pc, src); if (lane >= o) pc += a; }
        if (tid_ < 32) ps[tid_] = pc - cnt; }
    __syncthreads();
    for (int t = t0 + 4 * gw; t < T; t += 4 * NW) {
        int4 sl[4]; float4 ew[2];
#pragma unroll
        for (int u = 0; u < 4; ++u) sl[u] = *(const int4*)(p.TOKSLOT + (size_t)(t + u) * 4);
        ew[0] = *(const float4*)(p.EW + (size_t)t * 2); ew[1] = *(const float4*)(p.EW + (size_t)(t + 2) * 2);
        unsigned yr[4][2][4];
#pragma unroll
        for (int u = 0; u < 4; ++u) { const unsigned char* y0 = Y + (size_t)__builtin_amdgcn_readfirstlane(ps[sl[u].x] + sl[u].y) * D; const unsigned char* y1 = Y + (size_t)__builtin_amdgcn_readfirstlane(ps[sl[u].z] + sl[u].w) * D;
#pragma unroll
            for (int i = 0; i < 4; ++i) { yr[u][0][i] = *(const unsigned*)(y0 + (i * 64 + lane) * 4); yr[u][1][i] = *(const unsigned*)(y1 + (i * 64 + lane) * 4); } }
        const float* mrow = MODl + (size_t)tok_modrow(t) * 6144; const float* g5 = mrow + 5 * 1024;
        const float* mr1 = p.MOD + (size_t)9 * 6144 + (size_t)tok_modrow(t) * 6144;
#pragma unroll
        for (int pr = 0; pr < 2; ++pr) {
            const float wgt[2][2] = {{ew[pr].x, ew[pr].y}, {ew[pr].z, ew[pr].w}};
            u32x2v xr[2][4];
#pragma unroll
            for (int u = 0; u < 2; ++u)
#pragma unroll
                for (int i = 0; i < 4; ++i) xr[u][i] = *(const u32x2v*)(xrow(p, t + 2 * pr + u) + (i * 64 + lane) * 4);
            float4 v[2][4];
#pragma unroll
            for (int i = 0; i < 4; ++i) { const int c = (i * 64 + lane) * 4; const float4 gg = *(const float4*)(g5 + c);
#pragma unroll
                for (int u = 0; u < 2; ++u) { const u32x2v x = xr[u][i]; const int a = (int)yr[2 * pr + u][0][i], b = (int)yr[2 * pr + u][1][i]; const float w1 = wgt[u][0], w2 = wgt[u][1];
                    v[u][i].x = __uint_as_float(x.x << 16) + gg.x * (w1 * __builtin_amdgcn_cvt_f32_fp8(a, 0) + w2 * __builtin_amdgcn_cvt_f32_fp8(b, 0));
                    v[u][i].y = __uint_as_float(x.x & 0xffff0000u) + gg.y * (w1 * __builtin_amdgcn_cvt_f32_fp8(a, 1) + w2 * __builtin_amdgcn_cvt_f32_fp8(b, 1));
                    v[u][i].z = __uint_as_float(x.y << 16) + gg.z * (w1 * __builtin_amdgcn_cvt_f32_fp8(a, 2) + w2 * __builtin_amdgcn_cvt_f32_fp8(b, 2));
                    v[u][i].w = __uint_as_float(x.y & 0xffff0000u) + gg.w * (w1 * __builtin_amdgcn_cvt_f32_fp8(a, 3) + w2 * __builtin_amdgcn_cvt_f32_fp8(b, 3));
                    if (l == 0) *(u32x2v*)(xrow(p, t + 2 * pr + u) + c) = mk2(pk2(v[u][i].x, v[u][i].y), pk2(v[u][i].z, v[u][i].w)); } }
            float rstd[2];
#pragma unroll
            for (int u = 0; u < 2; ++u) { float ss = 0.f;
#pragma unroll
                for (int i = 0; i < 4; ++i) ss += v[u][i].x * v[u][i].x + v[u][i].y * v[u][i].y + v[u][i].z * v[u][i].z + v[u][i].w * v[u][i].w;
                rstd[u] = rsqrtf(wave_sum(ss, lane) * (1.0f / D) + 1e-6f); }
            if (l == 0) {
#pragma unroll
                for (int i = 0; i < 4; ++i) { const int c = (i * 64 + lane) * 4;
                    const float4 gg = *(const float4*)(p.norm1_g + D + c), sh = *(const float4*)(mr1 + c), sc = *(const float4*)(mr1 + 1024 + c);
#pragma unroll
                    for (int u = 0; u < 2; ++u) { const float r = rstd[u];
                        *(unsigned*)((unsigned char*)p.H + (size_t)(t + 2 * pr + u) * D + c) = pg8::pk4_fp8((pg8::f32x4){v[u][i].x * r * gg.x * (1.f + sc.x) + sh.x, v[u][i].y * r * gg.y * (1.f + sc.y) + sh.y, v[u][i].z * r * gg.z * (1.f + sc.z) + sh.z, v[u][i].w * r * gg.w * (1.f + sc.w) + sh.w}); } }
            } else {
#pragma unroll
                for (int u = 0; u < 2; ++u)
#pragma unroll
                    for (int i = 0; i < 4; ++i) { const float4 gg = ((const float4*)p.final_g)[i * 64 + lane]; const float r = rstd[u];
                        ((float4*)(p.out + (size_t)(t + 2 * pr + u - TC) * D))[i * 64 + lane] = make_float4(v[u][i].x * r * gg.x, v[u][i].y * r * gg.y, v[u][i].z * r * gg.z, v[u][i].w * r * gg.w); }
            }
        }
    }
}

#define XLAS __attribute__((address_space(3)))
#define XB_TMO      128
#define XB_XCNT(j)  (256  + 64 * (j))
#define XB_XSUB(j)  (1280 + 64 * (j))
#define XB_XGEN(j)  (2304 + 64 * (j))
#define XB_TOP      3328
#define XB_TOPGEN   3392
#define XCD_BAR_WORDS 3456
#define XB_SPIN_CAP (1u << 18)

__device__ __forceinline__ unsigned xb_ld(unsigned* p)              { return __hip_atomic_load(p, __ATOMIC_RELAXED, __HIP_MEMORY_SCOPE_AGENT); }
__device__ __forceinline__ unsigned xb_add(unsigned* p, unsigned v) { return __hip_atomic_fetch_add(p, v, __ATOMIC_RELAXED, __HIP_MEMORY_SCOPE_AGENT); }
__device__ __forceinline__ unsigned xb_xcc_id() { return (unsigned)__builtin_amdgcn_s_getreg((3 << 11) | 20) & 0xFu; }
#define XB_SPIN(cond, bar) do { unsigned _sp = 0; while (cond) { __builtin_amdgcn_s_sleep(1); \
    if ((++_sp & 255u) == 0u) { if (xb_ld(&(bar)[XB_TMO])) break; if (_sp > XB_SPIN_CAP) { atomicAdd(&(bar)[XB_TMO], 1u); break; } } } } while (0)

struct XcdBarrier {
    unsigned* bar; unsigned x;
    volatile XLAS unsigned* st;
};

__device__ __forceinline__ XcdBarrier xcd_barrier_post(unsigned* bar, volatile XLAS unsigned* st) {
    XcdBarrier b; b.bar = bar; b.x = xb_xcc_id(); b.st = st;
    if (ltid() == 0) (void)xb_add(&bar[XB_XCNT(b.x)], 1u);
    return b;
}
__device__ __forceinline__ void xcd_barrier_complete(unsigned* bar, unsigned x, unsigned& nloc, unsigned& nx) {
    const unsigned G = gridDim.x * gridDim.y * gridDim.z;
    unsigned sum, cnt, mine, sp = 0u;
    for (;;) {
        sum = 0u; cnt = 0u; mine = 0u;
#pragma unroll
        for (unsigned j = 0; j < 16; ++j) { const unsigned c = xb_ld(&bar[XB_XCNT(j)]); sum += c; cnt += (c > 0u) ? 1u : 0u; mine = (j == x) ? c : mine; }
        if (sum == G) break;
        __builtin_amdgcn_s_sleep(1);
        if ((++sp & 255u) == 0u) { if (xb_ld(&bar[XB_TMO])) break; if (sp > XB_SPIN_CAP) { atomicAdd(&bar[XB_TMO], 1u); break; } }
    }
    nloc = mine > 0u ? mine : 1u; nx = cnt > 0u ? cnt : 1u;
}

__device__ __forceinline__ void xcd_barrier(const XcdBarrier& b) {
    asm volatile("s_waitcnt vmcnt(0)" ::: "memory");
    __syncthreads();
    if (ltid() == 0) {
        unsigned* bar = b.bar;
        __builtin_amdgcn_s_waitcnt(0);
        unsigned nloc = b.st[0], nx = b.st[1];
        if (nloc == 0u) { xcd_barrier_complete(bar, b.x, nloc, nx); b.st[0] = nloc; b.st[1] = nx; }
        const unsigned old = xb_add(&bar[XB_XSUB(b.x)], 1u);
        const unsigned gen = old / nloc;
        if (old + 1u == (gen + 1u) * nloc) {
            __builtin_amdgcn_fence(__ATOMIC_RELEASE, "agent");
            asm volatile("s_waitcnt vmcnt(0)" ::: "memory");
            const unsigned og = xb_add(&bar[XB_TOP], 1u);
            const unsigned tg = og / nx;
            if (og + 1u == (tg + 1u) * nx) xb_add(&bar[XB_TOPGEN], 1u);
            else XB_SPIN(xb_ld(&bar[XB_TOPGEN]) == tg, bar);
            __builtin_amdgcn_fence(__ATOMIC_ACQUIRE, "agent");
            xb_add(&bar[XB_XGEN(b.x)], 1u);
            asm volatile("s_waitcnt vmcnt(0)" ::: "memory");
        } else {
            XB_SPIN(xb_ld(&bar[XB_XGEN(b.x)]) == gen, bar);
            __builtin_amdgcn_fence(__ATOMIC_ACQUIRE, "agent");
            asm volatile("s_waitcnt vmcnt(0)" ::: "memory");
        }
    }
    __syncthreads();
}

DI void moe_table(const P& p, int l, PG8_LAS int* tab) {
    const int tid_ = ltid();
    if (tid_ < 64) { const int cnt = tid_ < 32 ? p.counts[(l * 32 + tid_) * 32] : 0; const int nt = (cnt + 255) >> 8; int pt = nt, pc = cnt;
#pragma unroll
        for (int o = 1; o < 32; o <<= 1) { const int ln_ = tid_ & 63, src = ln_ >= o ? ln_ - o : ln_; const int a = shli(pt, src), b = shli(pc, src); if (ln_ >= o) { pt += a; pc += b; } }
        if (tid_ < 32) { tab[tid_ + 1] = pt; tab[33 + tid_] = cnt; tab[65 + tid_] = pc - cnt; if (tid_ == 0) tab[0] = 0; } }
    __syncthreads();
}
typedef const __attribute__((address_space(4))) P* PK;
DI PK lp(PK q) { asm volatile("" : "+s"(q)); return q; }
#define PHASE(...) do { const P p = *(const P*)lp(pk); __VA_ARGS__; } while (0)

#ifndef CV_L0
#define CV_L0 7
#endif
template <int l> DI void layer(PK pk, unsigned char* smem, const XcdBarrier& xbar) {
    float* ldsf = (float*)smem; const int gw = 0, NW = 0, lane = 0;
    {
        constexpr int NG = l == 0 ? 234 : 182;
        constexpr int CV1 = l == 0 ? CV_L0 * 768 : NE * 768;
        const int G = (int)gridDim.x == 256 ? NG : (int)gridDim.x;
        if ((int)blockIdx.x < G) PHASE({ pg8::Gemm g{p.H, (const bf16_t*)((const unsigned char*)p.WinT + (size_t)l * NPAD_IN * D), T, NPAD_IN, D / 2}; pg8::StaticOrder S; S.init(T, NPAD_IN, G, (int)blockIdx.x);
            pg8::EpiProj E{p.PROJ, LDP, INDIM, 1.0f / 64.0f};
            pg8::gemm_phase<pg8::EpiProj, pg8::StaticOrder, false, PG8_SP2, 1>((PG8_LAS unsigned char*)smem, g, S, E, nullptr); });
        else PHASE(ph_convert_experts(p, l, ldsf, G, (int)gridDim.x - G, 0, CV1));
        if ((int)gridDim.x != 256) PHASE(ph_convert_experts(p, l, ldsf, 0, (int)gridDim.x, 0, CV1));
    }
    xcd_barrier(xbar);
    PHASE(ph_prep(p, l, (LDSP unsigned char*)smem));
    xcd_barrier(xbar);
    PHASE(ph_s1(p, l, (LDSP unsigned char*)smem));
    xcd_barrier(xbar);
    PHASE(ph_s2(p));
    xcd_barrier(xbar);
    PHASE(ph_s3(p, l, (LDSP unsigned char*)smem));
    xcd_barrier(xbar);
    {
        constexpr int ro = l == 0 ? 0 : TC;
        constexpr int NG = l == 0 ? 182 : 256;
        const int G = (int)gridDim.x == 256 ? NG : (int)gridDim.x;
        if ((int)blockIdx.x < G) PHASE({ pg8::Gemm g{(const bf16_t*)((const unsigned char*)p.H + (size_t)ro * D), (const bf16_t*)((const unsigned char*)p.WoutT + (size_t)l * D * D), T - ro, D, D / 2}; pg8::StaticOrder S; S.init(T - ro, D, G, (int)blockIdx.x);
            pg8::EpiResGate<l != 0> E{p.SSQ, p.ctx, p.x, p.XB, p.MOD + (size_t)l * 9 * 6144 + 2 * 1024, p.XSS, ro};
            pg8::gemm_phase<pg8::EpiResGate<l != 0>, pg8::StaticOrder, false, PG8_SP2, 1>((PG8_LAS unsigned char*)smem, g, S, E, nullptr); });
        else if (l == 0) PHASE(ph_convert_experts(p, l, ldsf, G, (int)gridDim.x - G, CV_L0 * 768, NE * 768));
        if (l == 0 && (int)gridDim.x != 256) PHASE(ph_convert_experts(p, l, ldsf, 0, (int)gridDim.x, CV_L0 * 768, NE * 768));
    }
    xcd_barrier(xbar);
    const int t0 = l == 0 ? 0 : TC;
    PHASE(ph_normroute(p, l, t0, (LDSP unsigned char*)smem));
    xcd_barrier(xbar);
    PG8_LAS int* tab = (PG8_LAS int*)((PG8_LAS unsigned char*)smem + pg8::STAGE_BYTES);
#pragma unroll
    for (int ph = 0; ph < 2; ++ph) {
        PHASE(moe_table(p, l, tab));
        const int U = __builtin_amdgcn_readfirstlane(tab[32]) * 4;
        if (ph == 0) PHASE({ pg8::Gemm g{p.H, p.WguT, T, D, D / 2}; pg8::MoeSched S{tab, p.MAP, U, (int)gridDim.x, (int)blockIdx.x, 4, 1, (size_t)D * D};
            pg8::EpiAct E{(unsigned char*)p.SS}; pg8::gemm_phase_moe<pg8::EpiAct, pg8::MoeSched, false, PG8_SP2, 1>((PG8_LAS unsigned char*)smem, g, S, E, nullptr); });
        else PHASE({ pg8::Gemm g{p.SS, p.WdT, T, D, 256}; pg8::MoeSched S{tab, p.MAP, U, (int)gridDim.x, (int)blockIdx.x, 4, 0, (size_t)D * 512};
            pg8::EpiY E{(unsigned char*)p.PROJ}; pg8::gemm_phase_moe<pg8::EpiY, pg8::MoeSched, false, PG8_SP2, 1>((PG8_LAS unsigned char*)smem, g, S, E, nullptr); });
        xcd_barrier(xbar);
    }
    PHASE(ph_combine(p, l, t0, (const unsigned char*)p.PROJ, (LDSP int*)smem));
    xcd_barrier(xbar);
}

__global__ void __launch_bounds__(NTHR) mega(P p_arg) {
    extern __shared__ __attribute__((aligned(16))) unsigned char smem[];
    cg::grid_group grid = cg::this_grid();
    PK pk = (PK)__builtin_amdgcn_kernarg_segment_ptr();
    const int lane = 0, gw = 0, NW = 0;
    float* ldsf = (float*)smem;
    volatile XLAS unsigned* bst = (volatile XLAS unsigned*)((XLAS unsigned char*)smem + LDS_BYTES - 16);
    { const int t_ = ltid(); if (t_ < 2) bst[t_] = 0u; }
    __syncthreads();
    const XcdBarrier xbar = xcd_barrier_post(pk->BAR, bst);
    PHASE(ph_init(p)); PHASE(ph_mod(p, ldsf)); PHASE(ph_convert_small(p, ldsf, gw, NW, lane));
    if (__builtin_expect(pk->BAR == nullptr, 0)) grid.sync();
    xcd_barrier(xbar);
    PHASE(ph_normmod1(p, 0, gw, NW, lane));
    xcd_barrier(xbar);
    layer<0>(pk, smem, xbar);
    layer<1>(pk, smem, xbar);
}

static inline size_t al(size_t x) { return (x + 255) & ~(size_t)255; }

extern "C" void kernel_launch(void* const* d_in, const int* in_sizes, int n_in, void* d_out, int out_size, void* d_ws, size_t ws_size, hipStream_t stream) {
    static int grid_blocks = 0;
    if (grid_blocks == 0) {
        int dev = 0, cus = 0, per_cu = 0;
        if (hipFuncSetAttribute((const void*)mega, hipFuncAttributeMaxDynamicSharedMemorySize, LDS_BYTES) != hipSuccess) { fprintf(stderr, "hipFuncSetAttribute failed\n"); grid_blocks = -1; return; }
        (void)hipGetDevice(&dev); (void)hipDeviceGetAttribute(&cus, hipDeviceAttributeMultiprocessorCount, dev);
        if (hipOccupancyMaxActiveBlocksPerMultiprocessor(&per_cu, (const void*)mega, NTHR, LDS_BYTES) != hipSuccess || per_cu < 1) { fprintf(stderr, "occupancy query: %d blocks/CU\n", per_cu); grid_blocks = -1; return; }
        grid_blocks = cus;
    }
    if (grid_blocks < 0) return;
    P p{};
    const float** pin = (const float**)&p;
    for (int i = 0; i < 29; ++i) pin[i] = (const float*)d_in[i];
    p.out = (float*)d_out;
    char* ws = (char*)d_ws; size_t off = 0;
    auto take = [&](size_t bytes) { char* q = ws + off; off += al(bytes); return q; };
    p.XB = (bf16_t*)take((size_t)T * D * 2);
    p.H = (bf16_t*)take((size_t)T * D * 2);
    p.PROJ = (bf16_t*)take((size_t)T * LDP * 2);
    p.SS = (bf16_t*)take((size_t)NTILE * 8 * 2 * 4096 * 2);
    p.GS = (bf16_t*)take((size_t)NTILE * 4 * 2 * 8192 * 2);
    p.SDEC = (float*)take((size_t)NTILE * 8 * 2 * 4);
    p.GDEC = (float*)take((size_t)NTILE * 4 * 2 * 64 * 4);
    p.MOD = (float*)take((size_t)2 * 9 * 6144 * 4);
    p.counts = (int*)take(64 * 32 * 4);
    p.TOKSLOT = (int*)take((size_t)T * 4 * 4);
    p.EW = (float*)take((size_t)T * 2 * 4);
    p.MAP = (int*)take((size_t)NE * T * 4);
    p.WinT = (bf16_t*)take((size_t)2 * NPAD_IN * D * 2);
    p.WoutT = (bf16_t*)take((size_t)2 * D * D * 2);
    p.WguT = (bf16_t*)take((size_t)NE * D * D * 2);
    p.WdT = (bf16_t*)take((size_t)NE * D * 512 * 2);
    p.WRT = (bf16_t*)take((size_t)32 * 1024 * 2);
    p.BAR = (unsigned*)take(XCD_BAR_WORDS * 4);
    p.XBCC = (bf16_t*)d_out;
    p.QKB = (bf16_t*)d_out + (size_t)T * 768;
    p.SSC = (float*)take((size_t)T * 8 * 4 * 4);
    p.STOT = (float*)take((size_t)NTILE * 8 * 2 * 4);
    p.SSQ = (float*)take((size_t)T * 8 * 4);
    p.XSS = (float*)take((size_t)T * 16 * 4);
    if (off > ws_size) { fprintf(stderr, "workspace too small: need %zu have %zu\n", off, ws_size); return; }
    if (hipMemsetAsync(p.BAR, 0, XCD_BAR_WORDS * 4, stream) != hipSuccess) { fprintf(stderr, "memset of barrier words failed\n"); return; }
    void* args[] = {&p};
    hipError_t e = hipLaunchCooperativeKernel((void*)mega, dim3(grid_blocks), dim3(NTHR), args, LDS_BYTES, stream);
    if (e != hipSuccess) fprintf(stderr, "cooperative launch failed: %s (grid %d)\n", hipGetErrorString(e), grid_blocks);
}
```

```cpp
#include <hip/hip_runtime.h>
#include <hip/hip_cooperative_groups.h>
#include <stdint.h>
#include <cstdio>
namespace cg = cooperative_groups;

typedef unsigned short bf16_t;
#define DI __device__ __forceinline__

constexpr int D = 1024, NB = 8, SEQ = 4096, CTXL = 256, TC = NB * CTXL, TL = NB * SEQ, T = TC + TL;
constexpr int INDIM = 2840, LDP = 2848;
constexpr int OFF_Z = 0, OFF_XBC = 512, OFF_DT = 1280, OFF_Q = 1288, OFF_K = 1544, OFF_V = 1800, OFF_GO = 2312, OFF_GK = 2824;
constexpr int NE = 32;

DI float bf2f(bf16_t v) { return __uint_as_float(((unsigned)v) << 16); }
typedef float f32x2v_ __attribute__((ext_vector_type(2)));
typedef __bf16 bf16x2v_ __attribute__((ext_vector_type(2)));
DI bf16_t f2bf(float f) { return __builtin_bit_cast(unsigned short, (__bf16)f); }
DI float siluf(float x) { return x * __builtin_amdgcn_rcpf(1.0f + __builtin_amdgcn_exp2f(-1.4426950408889634f * x)); }
DI float softplusf(float x) { return fmaxf(x, 0.f) + log1pf(__expf(-fabsf(x))); }
DI float logsigmoidf(float x) { return -softplusf(-x); }
DI float shx(float v, int o, int lane) { return __int_as_float(__builtin_amdgcn_ds_bpermute((lane ^ o) << 2, __float_as_int(v))); }
DI int shxi(int v, int o, int lane) { return __builtin_amdgcn_ds_bpermute((lane ^ o) << 2, v); }
DI float shl(float v, int src) { return __int_as_float(__builtin_amdgcn_ds_bpermute(src << 2, __float_as_int(v))); }
DI int shli(int v, int src) { return __builtin_amdgcn_ds_bpermute(src << 2, v); }
DI float wave_sum(float v, int lane) {
#pragma unroll
    for (int o = 32; o >= 1; o >>= 1) v += shx(v, o, lane);
    return v;
}
DI int ltid() { const int wv = __builtin_amdgcn_readfirstlane(threadIdx.x >> 6);
    int ln; asm volatile("v_mbcnt_lo_u32_b32 %0, -1, 0\n\tv_mbcnt_hi_u32_b32 %0, -1, %0" : "=v"(ln));
    return wv * 64 + ln; }
DI int tok_modrow(int t) { return t < TC ? 8 : ((t - TC) >> 12); }
template <class PT> DI bf16_t* xrow(const PT& p, int t) { return p.XB + (size_t)t * D; }


#ifndef PG8_SP2
#define PG8_SP2 true
#endif
namespace pg8 {
#define PG8_LAS __attribute__((address_space(3)))
typedef unsigned short bf16_t;
typedef short bf16x8 __attribute__((ext_vector_type(8)));
typedef float f32x4 __attribute__((ext_vector_type(4)));
typedef unsigned u32x4 __attribute__((ext_vector_type(4)));
constexpr int BM = 256, BK = 64, HALF = 128, HTB = HALF * BK * 2  , STAGE_BYTES = 8 * HTB, NXCD = 8, WGM = 4;

__host__ __device__ __forceinline__ int lds_byte(int r, int c) { const int st = (r >> 4) * 2 + (c >> 5), rr = r & 15, cc = c & 31, ob = rr * 64 + cc * 2; return st * 1024 + (ob ^ (((ob >> 9) & 1) << 5)); }
__host__ __device__ __forceinline__ void stage_rc(int b, int& R, int& C) { const int st = b / 1024, sb = b % 1024, swz = sb ^ (((sb >> 9) & 1) << 5); R = (st >> 1) * 16 + swz / 64; C = (st & 1) * 32 + (swz % 64) / 2; }
__host__ __device__ __forceinline__ int perm32(int rho) { const int n = rho >> 4, i = rho & 15; return 8 * (i >> 2) + 4 * n + (i & 3); }

struct Unit { int pm, pn; };
struct Gemm { const bf16_t* A; const bf16_t* Bt; int M, N, K; };

struct StaticOrder {
    int nM, nN, nwg, G, c;
    __host__ __device__ void init(int M, int N, int G_, int c_) { nM = M / BM; nN = N / BM; nwg = nM * nN; G = G_; c = c_; }
    __host__ __device__ bool next(int i, Unit& u) const {
        const long L = (long)i * G + c; if (L >= nwg) return false;
        int wgid = (int)L; { const int q = nwg / NXCD, r = nwg % NXCD, xcd = wgid % NXCD, off = wgid / NXCD; wgid = (xcd < r ? xcd * (q + 1) : r * (q + 1) + (xcd - r) * q) + off; }
        const int nig = WGM * nN, gid = wgid / nig, fm = gid * WGM, gsz = (nM - fm) < WGM ? (nM - fm) : WGM;
        u.pm = fm + ((wgid % nig) % gsz); u.pn = (wgid % nig) / gsz; return true;
    }
    __device__ __forceinline__ void a_ready(const Unit&) const {}
    __device__ __forceinline__ void done(const Unit&) const {}
};
__device__ __forceinline__ unsigned cvt_pk_bf16(float lo, float hi) { unsigned r; asm volatile("v_cvt_pk_bf16_f32 %0, %1, %2" : "=v"(r) : "v"(lo), "v"(hi)); return r; }
typedef float f32x2 __attribute__((ext_vector_type(2)));

typedef int i32x4 __attribute__((ext_vector_type(4)));
typedef int i32x8 __attribute__((ext_vector_type(8)));
__device__ __forceinline__ i32x8 cat8(bf16x8 a, bf16x8 b) { return __builtin_shufflevector(__builtin_bit_cast(i32x4, a), __builtin_bit_cast(i32x4, b), 0, 1, 2, 3, 4, 5, 6, 7); }
__device__ __forceinline__ void mfma8(f32x4& c, i32x8 a, i32x8 b) { asm volatile("v_mfma_f32_16x16x128_f8f6f4 %0, %1, %2, %0" : "+v"(c) : "v"(a), "v"(b)); }
__device__ __forceinline__ unsigned pk4_fp8(const f32x4 v) { const float lim = 440.f;
    int w = __builtin_amdgcn_cvt_pk_fp8_f32(__builtin_amdgcn_fmed3f(v[0], -lim, lim), __builtin_amdgcn_fmed3f(v[1], -lim, lim), 0, false);
    return (unsigned)__builtin_amdgcn_cvt_pk_fp8_f32(__builtin_amdgcn_fmed3f(v[2], -lim, lim), __builtin_amdgcn_fmed3f(v[3], -lim, lim), w, true); }
struct EpiProj {
    static constexpr bool PERM = true, AFTER_DRAIN = false, MIDK = false;
    bf16_t* O; int ldc; int ncols; float osc;
    __device__ __forceinline__ void operator()(const f32x4 (&acc)[2][2][4][2], const Unit& u, int wr, int wc, int fr, int fq) const {
        const int row0 = u.pm * BM + wr * 64 + fr, col0 = u.pn * BM + wc * 32 + 8 * fq;
#pragma unroll
        for (int ai = 0; ai < 2; ++ai)
#pragma unroll
            for (int m = 0; m < 4; ++m) { bf16_t* rowp = O + (size_t)(row0 + ai * HALF + m * 16) * ldc + col0;
#pragma unroll
                for (int bj = 0; bj < 2; ++bj) { const f32x4 v0 = acc[ai][bj][m][0] * osc, v1 = acc[ai][bj][m][1] * osc;
                    u32x4 w; w.x = cvt_pk_bf16(v0[0], v0[1]); w.y = cvt_pk_bf16(v0[2], v0[3]); w.z = cvt_pk_bf16(v1[0], v1[1]); w.w = cvt_pk_bf16(v1[2], v1[3]);
                    if (col0 + bj * HALF + 8 <= ncols) *(u32x4*)(rowp + bj * HALF) = w; } }
    }
};
template <bool SRC_BF16> struct EpiResGate {
    static constexpr bool PERM = true, AFTER_DRAIN = false, MIDK = true;
    const float* ssq;
    const float* Sc; const float* Sl;
    bf16_t* XB;
    const float* gate_rows; float* xss; int rowoff;
    template <class Sched> __device__ __forceinline__ void prep(PG8_LAS unsigned char* lds, const Sched& S, int tid) const {
        PG8_LAS float* RS = (PG8_LAS float*)(lds + STAGE_BYTES);
        const int r = tid & 255, i0 = tid >> 8;
        for (int i = i0; ; i += 2) { Unit u; if (!S.next(i, u)) break;
            const f32x4* q = (const f32x4*)(ssq + (size_t)(rowoff + u.pm * BM + r) * 8); const f32x4 a = q[0], b = q[1];
            RS[i * 256 + r] = 4.0f * __builtin_amdgcn_rsqf((((a[0] + a[1]) + (a[2] + a[3])) + ((b[0] + b[1]) + (b[2] + b[3]))) * (1.0f / 512.0f) + 1e-6f); }
    }
    __device__ __forceinline__ void midk(f32x4 (&acc)[2][2][4][2], PG8_LAS unsigned char* lds, int ui, int wr, int fr) const {
        int fr_ = fr; asm volatile("" : "+v"(fr_));
        PG8_LAS const float* RS = (PG8_LAS const float*)(lds + STAGE_BYTES) + ui * 256 + wr * 64 + fr_;
#pragma unroll
        for (int ai = 0; ai < 2; ++ai)
#pragma unroll
            for (int m = 0; m < 4; ++m) { const float rs = RS[ai * HALF + m * 16];
#pragma unroll
                for (int bj = 0; bj < 2; ++bj)
#pragma unroll
                    for (int n = 0; n < 2; ++n) acc[ai][bj][m][n] *= rs; }
    }
    __device__ __forceinline__ void operator()(const f32x4 (&acc)[2][2][4][2], const Unit& u, int wr, int wc, int fr, int fq) const {
        const int row0 = rowoff + u.pm * BM + wr * 64 + fr, col0 = u.pn * BM + wc * 32 + 8 * fq;
        const int t0 = rowoff + u.pm * BM; const int mrow = t0 < 2048 ? 8 : ((t0 - 2048) >> 12);
        const float* gr = gate_rows + (size_t)mrow * 6144 + col0;
        f32x4 gv[2][2];
#pragma unroll
        for (int bj = 0; bj < 2; ++bj)
#pragma unroll
            for (int n = 0; n < 2; ++n) gv[bj][n] = *(const f32x4*)(gr + bj * HALF + n * 4);
#pragma unroll
        for (int ai = 0; ai < 2; ++ai) {
            u32x4 rb[4][2]; f32x4 xf[SRC_BF16 ? 1 : 4][2][2];
#pragma unroll
            for (int m = 0; m < 4; ++m) { const int rr = row0 + ai * HALF + m * 16;
                const float* sp = (rr < 2048 ? Sc + (size_t)rr * 1024 : Sl + (size_t)(rr - 2048) * 1024) + col0; const bf16_t* dp = XB + (size_t)rr * 1024 + col0;
#pragma unroll
                for (int bj = 0; bj < 2; ++bj) {
                    if (SRC_BF16) rb[m][bj] = *(const u32x4*)(dp + bj * HALF);
                    else { xf[SRC_BF16 ? 0 : m][bj][0] = *(const f32x4*)(sp + bj * HALF); xf[SRC_BF16 ? 0 : m][bj][1] = *(const f32x4*)(sp + bj * HALF + 4); } } }
#pragma unroll
            for (int m = 0; m < 4; ++m) { const int rr = row0 + ai * HALF + m * 16;
                bf16_t* dp = XB + (size_t)rr * 1024 + col0; float ss = 0.f;
#pragma unroll
                for (int bj = 0; bj < 2; ++bj) { f32x4 x0, x1;
                    if (SRC_BF16) { const u32x4 r = rb[m][bj];
                        x0 = (f32x4){__uint_as_float(r.x << 16), __uint_as_float(r.x & 0xffff0000u), __uint_as_float(r.y << 16), __uint_as_float(r.y & 0xffff0000u)};
                        x1 = (f32x4){__uint_as_float(r.z << 16), __uint_as_float(r.z & 0xffff0000u), __uint_as_float(r.w << 16), __uint_as_float(r.w & 0xffff0000u)}; }
                    else { x0 = xf[SRC_BF16 ? 0 : m][bj][0]; x1 = xf[SRC_BF16 ? 0 : m][bj][1]; }
                    const f32x4 v0 = x0 + gv[bj][0] * (acc[ai][bj][m][0] * (1.0f / 512.0f)), v1 = x1 + gv[bj][1] * (acc[ai][bj][m][1] * (1.0f / 512.0f));
                    u32x4 w; w.x = cvt_pk_bf16(v0[0], v0[1]); w.y = cvt_pk_bf16(v0[2], v0[3]); w.z = cvt_pk_bf16(v1[0], v1[1]); w.w = cvt_pk_bf16(v1[2], v1[3]);
                    *(u32x4*)(dp + bj * HALF) = w;
#pragma unroll
                    for (int j = 0; j < 4; ++j) { const float lo = __uint_as_float(w[j] << 16), hi = __uint_as_float(w[j] & 0xffff0000u); ss += lo * lo + hi * hi; } }
                { const int ln_ = fq * 16 + fr; ss += __int_as_float(__builtin_amdgcn_ds_bpermute((ln_ ^ 16) << 2, __float_as_int(ss))); ss += __int_as_float(__builtin_amdgcn_ds_bpermute((ln_ ^ 32) << 2, __float_as_int(ss))); }
                if (fq == 0) xss[(size_t)rr * 16 + u.pn * 4 + wc] = ss; }
        }
    }
};
template <class Epi, class Sched, bool STAMP = false, bool SP2 = PG8_SP2, int SCW = -1>
__device__ __forceinline__ void gemm_phase(PG8_LAS unsigned char* lds, const Gemm g, const Sched& S, const Epi& E, unsigned long long* stamps) {
    int tid_l = __builtin_amdgcn_readfirstlane(threadIdx.x >> 6) * 64 + (int)__builtin_amdgcn_mbcnt_hi(~0u, __builtin_amdgcn_mbcnt_lo(~0u, 0u)); asm volatile("" : "+v"(tid_l));
    const int tid = tid_l, wid = __builtin_amdgcn_readfirstlane(tid >> 6), lane = tid & 63, wr = wid >> 2, wc = wid & 3, fr = lane & 15, fq = lane >> 4;
    const int K = g.K, nt = K / BK;
    int ts_lo = 0, ts_hi = 0, nts = 0; const unsigned long long rt_entry = STAMP ? (unsigned long long)wall_clock64() : 0ull;
#define PG8_STAMP() do { if (STAMP && wid == 0 && nts < 64) { const unsigned long long _c = (unsigned long long)clock64(); \
        ts_lo = (lane == nts) ? (int)(unsigned)_c : ts_lo; ts_hi = (lane == nts) ? (int)(unsigned)(_c >> 32) : ts_hi; ++nts; } } while (0)
    PG8_STAMP();
    unsigned voffA[2], voffB[2];
#pragma unroll
    for (int i = 0; i < 2; ++i) { int R, C; stage_rc(tid * 16 + i * 8192, R, C); const int Rb = Epi::PERM ? ((R & ~31) + perm32(R & 31)) : R;
        voffA[i] = (unsigned)(R * K + C) * 2u; voffB[i] = (unsigned)(Rb * K + C) * 2u; }
    const size_t kstep = (size_t)(BK * 2);
    const size_t hstep = (size_t)HALF * K * 2;
    const size_t tstep = 2 * hstep;
    const unsigned ldsw = (unsigned)wid * 1024u;
    const int aoff = lds_byte(wr * 64 + fr, fq * 8), boff = lds_byte(wc * 32 + fr, fq * 8);
#define PG8_SA(b, h) (((b) * 2 + (h)) * HTB)
#define PG8_SB(b, h) ((4 + (b) * 2 + (h)) * HTB)
#define PG8_STAGE(bufoff, gbase, voff) do { _Pragma("unroll") for (int _i = 0; _i < 2; ++_i) \
        __builtin_amdgcn_global_load_lds((const unsigned*)((const char*)(gbase) + (voff)[_i]), (PG8_LAS unsigned*)(lds + (bufoff) + ldsw + _i * 8192), 16, 0, 0); } while (0)
#define PG8_LDA(dst, b, h) do { _Pragma("unroll") for (int m = 0; m < 4; ++m) _Pragma("unroll") for (int k = 0; k < 2; ++k) dst[m][k] = *(const PG8_LAS bf16x8*)(lds + PG8_SA(b, h) + aoff + m * 2048 + k * 1024); } while (0)
#define PG8_LDB(dst, b, h) do { _Pragma("unroll") for (int n = 0; n < 2; ++n) _Pragma("unroll") for (int k = 0; k < 2; ++k) dst[n][k] = *(const PG8_LAS bf16x8*)(lds + PG8_SB(b, h) + boff + n * 2048 + k * 1024); } while (0)
#define PG8_MMA(ai, bj, At, Bt) do { __builtin_amdgcn_s_setprio(1); _Pragma("unroll") for (int m = 0; m < 4; ++m) _Pragma("unroll") for (int n = 0; n < 2; ++n) { \
        if constexpr (SCW >= 0) mfma8(acc[ai][bj][m][n], cat8(Bt[n][0], Bt[n][1]), cat8(At[m][0], At[m][1])); \
        else { _Pragma("unroll") for (int k = 0; k < 2; ++k) acc[ai][bj][m][n] = __builtin_amdgcn_mfma_f32_16x16x32_bf16(Bt[n][k], At[m][k], acc[ai][bj][m][n], 0, 0, 0); } } __builtin_amdgcn_s_setprio(0); } while (0)
#define PG8_WAIT_V(n) asm volatile("s_waitcnt vmcnt(" #n ")" ::: "memory")
#define PG8_WAIT_L(n) asm volatile("s_waitcnt lgkmcnt(" #n ")" ::: "memory")
#define PG8_BAR __builtin_amdgcn_s_barrier()
#define PG8_SCHED __builtin_amdgcn_sched_barrier(0)
    Unit cur, nxt; int ui = 0;
    if (!S.next(0, cur)) return;
    f32x4 acc[2][2][4][2];
#pragma unroll
    for (int a = 0; a < 2; ++a)
#pragma unroll
        for (int b = 0; b < 2; ++b)
#pragma unroll
            for (int m = 0; m < 4; ++m)
#pragma unroll
                for (int n = 0; n < 2; ++n) acc[a][b][m][n] = (f32x4){0.f, 0.f, 0.f, 0.f};
    bf16x8 At[4][2], B0[2][2], B1[2][2];
    const char* cA = (const char*)g.A + (size_t)cur.pm * tstep; const char* cB = (const char*)g.Bt + (size_t)cur.pn * tstep;
    S.a_ready(cur);
    if constexpr (Epi::MIDK) E.prep(lds, S, tid);
    if constexpr (SP2) {
        PG8_STAGE(PG8_SB(0, 0), cB, voffB); PG8_STAGE(PG8_SB(0, 1), cB + hstep, voffB); PG8_STAGE(PG8_SA(0, 0), cA, voffA); PG8_STAGE(PG8_SA(0, 1), cA + hstep, voffA);
        if (wr == 1) PG8_BAR;
        PG8_WAIT_V(2); PG8_BAR;
        PG8_STAGE(PG8_SB(1, 0), cB + kstep, voffB); PG8_STAGE(PG8_SA(1, 0), cA + kstep, voffA); PG8_STAGE(PG8_SB(1, 1), cB + hstep + kstep, voffB);
        PG8_WAIT_V(6); PG8_BAR;
    } else {
    PG8_STAGE(PG8_SB(0, 0), cB, voffB); PG8_STAGE(PG8_SA(0, 0), cA, voffA); PG8_STAGE(PG8_SB(0, 1), cB + hstep, voffB); PG8_STAGE(PG8_SA(0, 1), cA + hstep, voffA);
    if (wr == 1) PG8_BAR;
    PG8_WAIT_V(4); PG8_BAR;
    PG8_STAGE(PG8_SB(1, 0), cB + kstep, voffB); PG8_STAGE(PG8_SA(1, 0), cA + kstep, voffA); PG8_STAGE(PG8_SB(1, 1), cB + hstep + kstep, voffB);
    PG8_WAIT_V(6); PG8_BAR;
    }
    PG8_STAMP();
    for (;;) {
        const bool has_next = S.next(ui + 1, nxt);
        const char* nA = has_next ? (const char*)g.A + (size_t)nxt.pm * tstep : cA; const char* nB = has_next ? (const char*)g.Bt + (size_t)nxt.pn * tstep : cB;
        for (int t = 0; t < nt; t += 2) {
            const bool last = (t == nt - 2);
            const char* a1 = cA + (size_t)(t + 1) * kstep;
            const char* a2 = last ? nA : cA + (size_t)(t + 2) * kstep; const char* b2 = last ? nB : cB + (size_t)(t + 2) * kstep;
            const char* a3 = a2 + kstep; const char* b3 = b2 + kstep;
            if (last && has_next) S.a_ready(nxt);
            if constexpr (SP2) {
            PG8_LDB(B0, 0, 0); PG8_LDB(B1, 0, 1); PG8_SCHED; PG8_LDA(At, 0, 0); PG8_STAGE(PG8_SA(1, 1), a1 + hstep, voffA);
            PG8_WAIT_V(8); PG8_WAIT_L(0); PG8_BAR; PG8_MMA(0, 0, At, B0); PG8_MMA(0, 1, At, B1); PG8_BAR; PG8_SCHED;
            PG8_LDA(At, 0, 1); PG8_STAGE(PG8_SB(0, 0), b2, voffB); PG8_STAGE(PG8_SB(0, 1), b2 + hstep, voffB); PG8_STAGE(PG8_SA(0, 0), a2, voffA);
            PG8_WAIT_V(8); PG8_WAIT_L(0); PG8_BAR; PG8_MMA(1, 0, At, B0); PG8_MMA(1, 1, At, B1); PG8_BAR; PG8_SCHED;
            PG8_LDB(B0, 1, 0); PG8_LDB(B1, 1, 1); PG8_SCHED; PG8_LDA(At, 1, 0); PG8_STAGE(PG8_SA(0, 1), a2 + hstep, voffA);
            PG8_WAIT_V(8); PG8_WAIT_L(0); PG8_BAR; PG8_MMA(0, 0, At, B0); PG8_MMA(0, 1, At, B1); PG8_BAR; PG8_SCHED;
            PG8_LDA(At, 1, 1); PG8_STAGE(PG8_SB(1, 0), b3, voffB); PG8_STAGE(PG8_SB(1, 1), b3 + hstep, voffB); PG8_STAGE(PG8_SA(1, 0), a3, voffA);
            PG8_WAIT_V(8); PG8_WAIT_L(0); PG8_BAR; PG8_MMA(1, 0, At, B0); PG8_MMA(1, 1, At, B1); PG8_BAR; PG8_SCHED;
            } else {
            PG8_LDB(B0, 0, 0); PG8_SCHED; PG8_LDA(At, 0, 0); PG8_STAGE(PG8_SA(1, 1), a1 + hstep, voffA);
            PG8_WAIT_L(8); PG8_BAR; PG8_WAIT_L(0); PG8_MMA(0, 0, At, B0); PG8_BAR; PG8_SCHED;
            PG8_LDB(B1, 0, 1); PG8_STAGE(PG8_SB(0, 0), b2, voffB);
            PG8_BAR; PG8_WAIT_L(0); PG8_MMA(0, 1, At, B1); PG8_BAR;
            PG8_LDA(At, 0, 1); PG8_STAGE(PG8_SA(0, 0), a2, voffA);
            PG8_BAR; PG8_WAIT_L(0); PG8_MMA(1, 0, At, B0); PG8_BAR; PG8_SCHED;
            PG8_STAGE(PG8_SB(0, 1), b2 + hstep, voffB);
            PG8_WAIT_V(6); PG8_BAR; PG8_MMA(1, 1, At, B1); PG8_BAR;
            PG8_LDB(B0, 1, 0); PG8_SCHED; PG8_LDA(At, 1, 0); PG8_STAGE(PG8_SA(0, 1), a2 + hstep, voffA);
            PG8_WAIT_L(8); PG8_BAR; PG8_WAIT_L(0); PG8_MMA(0, 0, At, B0); PG8_BAR; PG8_SCHED;
            PG8_LDB(B1, 1, 1); PG8_STAGE(PG8_SB(1, 0), b3, voffB);
            PG8_BAR; PG8_WAIT_L(0); PG8_MMA(0, 1, At, B1); PG8_BAR;
            PG8_LDA(At, 1, 1); PG8_STAGE(PG8_SA(1, 0), a3, voffA);
            PG8_BAR; PG8_WAIT_L(0); PG8_MMA(1, 0, At, B0); PG8_BAR; PG8_SCHED;
            PG8_STAGE(PG8_SB(1, 1), b3 + hstep, voffB);
            PG8_WAIT_V(6); PG8_BAR; PG8_MMA(1, 1, At, B1); PG8_BAR;
            }
            if constexpr (Epi::MIDK) { if (t + 2 == nt / 2) { if constexpr (SCW >= 0) asm volatile("s_nop 15\n\ts_nop 15" ::: "memory");
                E.midk(acc, lds, ui, wr, fr); } }
        }
        PG8_STAMP();
        if (wr == 0) PG8_BAR;
        if constexpr (SCW >= 0) asm volatile("s_nop 15\n\ts_nop 15" ::: "memory");
        if constexpr (!Epi::AFTER_DRAIN) { E(acc, cur, wr, wc, fr, fq); S.done(cur); }
        PG8_STAMP();
        if (!has_next) break;
#pragma unroll
        for (int a = 0; a < 2; ++a)
#pragma unroll
            for (int b = 0; b < 2; ++b)
#pragma unroll
                for (int m = 0; m < 4; ++m)
#pragma unroll
                    for (int n = 0; n < 2; ++n) acc[a][b][m][n] = (f32x4){0.f, 0.f, 0.f, 0.f};
        cur = nxt; cA = nA; cB = nB; ++ui;
        if (wr == 1) PG8_BAR;
    }
    PG8_WAIT_V(0);
    PG8_BAR;
    if constexpr (Epi::AFTER_DRAIN) { E.fused(acc, cur, wr, wc, fr, fq, lds, wid, lane); S.done(cur); }
    PG8_STAMP();
    if (STAMP && wid == 0) { stamps[lane] = lane < nts ? (((unsigned long long)(unsigned)ts_hi << 32) | (unsigned)ts_lo) : 0ull;
        if (lane == 62) stamps[62] = rt_entry; if (lane == 63) stamps[63] = (unsigned long long)wall_clock64(); }
#undef PG8_STAMP
#undef PG8_SA
#undef PG8_SB
#undef PG8_STAGE
#undef PG8_LDA
#undef PG8_LDB
#undef PG8_MMA
#undef PG8_WAIT_V
#undef PG8_WAIT_L
#undef PG8_BAR
#undef PG8_SCHED
}

struct MoeUnit { int e, mt, pn, cnt, pstart; };
struct MoeSched {
    typedef MoeUnit UnitT;
    PG8_LAS const int* tab; const int* map; int U, G, c, npn, gather; size_t bstride;
    __device__ __forceinline__ bool next(int i, MoeUnit& u) const {
        const long L = (long)i * G + c; if (L >= U) return false;
        int idx = (int)L; { const int q = U / NXCD, r = U % NXCD, xcd = idx % NXCD, off = idx / NXCD; idx = (xcd < r ? xcd * (q + 1) : r * (q + 1) + (xcd - r) * q) + off; }
        const int tau = idx / npn; u.pn = idx - tau * npn;
        int e = 0;
#pragma unroll
        for (int st = 16; st >= 1; st >>= 1) { if (__builtin_amdgcn_readfirstlane(tab[e + st]) <= tau) e += st; }
        u.e = e; u.mt = tau - __builtin_amdgcn_readfirstlane(tab[e]); u.cnt = __builtin_amdgcn_readfirstlane(tab[33 + e]); u.pstart = __builtin_amdgcn_readfirstlane(tab[65 + e]);
        return true;
    }
    __device__ __forceinline__ const char* bbase(const Gemm& g, const MoeUnit& u) const { return (const char*)g.Bt + (size_t)u.e * bstride + (size_t)u.pn * BM * g.K * 2; }
    __device__ __forceinline__ void a_offsets(const Gemm& g, const MoeUnit& u, int tid, unsigned (&va)[2][2]) const {
        int tl = tid; asm volatile("" : "+v"(tl));
        int RA[2], CA[2];
#pragma unroll
        for (int i = 0; i < 2; ++i) { int R, C; stage_rc(tl * 16 + i * 8192, R, C); RA[i] = R; CA[i] = C * 2; }
#pragma unroll
        for (int hf = 0; hf < 2; ++hf)
#pragma unroll
            for (int i = 0; i < 2; ++i) { int rl = u.mt * BM + hf * HALF + RA[i]; rl = rl < u.cnt ? rl : u.cnt - 1;
                const unsigned row = gather ? (unsigned)map[(size_t)u.e * 34816 + rl] : (unsigned)(u.pstart + rl);
                va[hf][i] = row * (unsigned)(g.K * 2) + (unsigned)CA[i]; }
    }
};
struct EpiAct {
    static constexpr bool PERM = true, AFTER_DRAIN = false;
    unsigned char* O;
    __device__ __forceinline__ void operator()(const f32x4 (&acc)[2][2][4][2], const MoeUnit& u, int wr, int wc, int fr, int fq) const {
        typedef unsigned u32x2 __attribute__((ext_vector_type(2)));
        const int rl0 = u.mt * BM + wr * 64 + fr, col0 = u.pn * HALF + wc * 32 + 8 * fq;
#pragma unroll
        for (int ai = 0; ai < 2; ++ai)
#pragma unroll
            for (int m = 0; m < 4; ++m) { const int rl = rl0 + ai * HALF + m * 16;
                if (rl < u.cnt) { f32x4 o[2];
#pragma unroll
                    for (int n = 0; n < 2; ++n)
#pragma unroll
                        for (int j = 0; j < 4; ++j) { const float gv = acc[ai][0][m][n][j] * (1.0f / 64.0f)  ; o[n][j] = gv * __builtin_amdgcn_rcpf(1.0f + __builtin_amdgcn_exp2f(-1.4426950408889634f * gv)) * (acc[ai][1][m][n][j] * 0.125f)  ; }
                    *(u32x2*)(O + (size_t)(u.pstart + rl) * 512 + col0) = (u32x2){pk4_fp8(o[0]), pk4_fp8(o[1])}; } }
    }
};
struct EpiY {
    static constexpr bool PERM = true, AFTER_DRAIN = false;
    unsigned char* O;
    static __device__ __forceinline__ unsigned pk4(const f32x4 v) { const float lim = 440.f;
        int w = __builtin_amdgcn_cvt_pk_fp8_f32(fminf(fmaxf(v[0], -lim), lim), fminf(fmaxf(v[1], -lim), lim), 0, false);
        return (unsigned)__builtin_amdgcn_cvt_pk_fp8_f32(fminf(fmaxf(v[2], -lim), lim), fminf(fmaxf(v[3], -lim), lim), w, true); }
    __device__ __forceinline__ void operator()(const f32x4 (&acc)[2][2][4][2], const MoeUnit& u, int wr, int wc, int fr, int fq) const {
        typedef unsigned u32x2 __attribute__((ext_vector_type(2)));
        const int rl0 = u.mt * BM + wr * 64 + fr, col0 = u.pn * BM + wc * 32 + 8 * fq;
#pragma unroll
        for (int ai = 0; ai < 2; ++ai)
#pragma unroll
            for (int m = 0; m < 4; ++m) { const int rl = rl0 + ai * HALF + m * 16;
                if (rl < u.cnt) { unsigned char* rowp = O + (size_t)(u.pstart + rl) * 1024 + col0;
#pragma unroll
                    for (int bj = 0; bj < 2; ++bj) *(u32x2*)(rowp + bj * HALF) = (u32x2){pk4(acc[ai][bj][m][0] * (1.0f / 512.0f)), pk4(acc[ai][bj][m][1] * (1.0f / 512.0f))}; } }
    }
};
template <class Epi, class Sched, bool STAMP = false, bool SP2 = PG8_SP2, int SCW = -1, int SCA = 127>
__device__ __forceinline__ void gemm_phase_moe(PG8_LAS unsigned char* lds, const Gemm g, const Sched& S, const Epi& E, unsigned long long* stamps) {
    int tid_l = __builtin_amdgcn_readfirstlane(threadIdx.x >> 6) * 64 + (int)__builtin_amdgcn_mbcnt_hi(~0u, __builtin_amdgcn_mbcnt_lo(~0u, 0u)); asm volatile("" : "+v"(tid_l));
    const int tid = tid_l, wid = __builtin_amdgcn_readfirstlane(tid >> 6), lane = tid & 63, wr = wid >> 2, wc = wid & 3, fr = lane & 15, fq = lane >> 4;
    const int K = g.K, nt = K / BK;
    int ts_lo = 0, ts_hi = 0, nts = 0; const unsigned long long rt_entry = STAMP ? (unsigned long long)wall_clock64() : 0ull;
#define PG8_STAMP() do { if (STAMP && wid == 0 && nts < 64) { const unsigned long long _c = (unsigned long long)clock64(); \
        ts_lo = (lane == nts) ? (int)(unsigned)_c : ts_lo; ts_hi = (lane == nts) ? (int)(unsigned)(_c >> 32) : ts_hi; ++nts; } } while (0)
    PG8_STAMP();
    unsigned voffB[2];
#pragma unroll
    for (int i = 0; i < 2; ++i) { int R, C; stage_rc(tid * 16 + i * 8192, R, C); const int Rb = Epi::PERM ? ((R & ~31) + perm32(R & 31)) : R;
        voffB[i] = (unsigned)(Rb * K + C) * 2u; }
    unsigned vaC[2][2];
    PG8_LAS unsigned* vtab = (PG8_LAS unsigned*)(lds + STAGE_BYTES + 1024) + tid;
    const size_t kstep = (size_t)(BK * 2);
    const size_t hstep = (size_t)HALF * K * 2;
    const size_t tstep = 2 * hstep;
    const unsigned ldsw = (unsigned)wid * 1024u;
    const int aoff = lds_byte(wr * 64 + fr, fq * 8), boff = lds_byte(wc * 32 + fr, fq * 8);
#define PG8_SA(b, h) (((b) * 2 + (h)) * HTB)
#define PG8_SB(b, h) ((4 + (b) * 2 + (h)) * HTB)
#define PG8_STAGE(bufoff, gbase, voff) do { _Pragma("unroll") for (int _i = 0; _i < 2; ++_i) \
        __builtin_amdgcn_global_load_lds((const unsigned*)((const char*)(gbase) + (voff)[_i]), (PG8_LAS unsigned*)(lds + (bufoff) + ldsw + _i * 8192), 16, 0, 0); } while (0)
#define PG8_STAGEA(bufoff, kbyte, va) do { _Pragma("unroll") for (int _i = 0; _i < 2; ++_i) \
        __builtin_amdgcn_global_load_lds((const unsigned*)((const char*)g.A + (kbyte) + (va)[_i]), (PG8_LAS unsigned*)(lds + (bufoff) + ldsw + _i * 8192), 16, 0, 0); } while (0)
#define PG8_LDA(dst, b, h) do { _Pragma("unroll") for (int m = 0; m < 4; ++m) _Pragma("unroll") for (int k = 0; k < 2; ++k) dst[m][k] = *(const PG8_LAS bf16x8*)(lds + PG8_SA(b, h) + aoff + m * 2048 + k * 1024); } while (0)
#define PG8_LDB(dst, b, h) do { _Pragma("unroll") for (int n = 0; n < 2; ++n) _Pragma("unroll") for (int k = 0; k < 2; ++k) dst[n][k] = *(const PG8_LAS bf16x8*)(lds + PG8_SB(b, h) + boff + n * 2048 + k * 1024); } while (0)
#define PG8_MMA(ai, bj, At, Bt) do { __builtin_amdgcn_s_setprio(1); _Pragma("unroll") for (int m = 0; m < 4; ++m) _Pragma("unroll") for (int n = 0; n < 2; ++n) { \
        if constexpr (SCW >= 0) mfma8(acc[ai][bj][m][n], cat8(Bt[n][0], Bt[n][1]), cat8(At[m][0], At[m][1])); \
        else { _Pragma("unroll") for (int k = 0; k < 2; ++k) acc[ai][bj][m][n] = __builtin_amdgcn_mfma_f32_16x16x32_bf16(Bt[n][k], At[m][k], acc[ai][bj][m][n], 0, 0, 0); } } __builtin_amdgcn_s_setprio(0); } while (0)
#define PG8_WAIT_V(n) asm volatile("s_waitcnt vmcnt(" #n ")" ::: "memory")
#define PG8_WAIT_L(n) asm volatile("s_waitcnt lgkmcnt(" #n ")" ::: "memory")
#define PG8_BAR __builtin_amdgcn_s_barrier()
#define PG8_SCHED __builtin_amdgcn_sched_barrier(0)
    typename Sched::UnitT cur, nxt; int ui = 0;
    if (!S.next(0, cur)) return;
    f32x4 acc[2][2][4][2];
#pragma unroll
    for (int a = 0; a < 2; ++a)
#pragma unroll
        for (int b = 0; b < 2; ++b)
#pragma unroll
            for (int m = 0; m < 4; ++m)
#pragma unroll
                for (int n = 0; n < 2; ++n) acc[a][b][m][n] = (f32x4){0.f, 0.f, 0.f, 0.f};
    bf16x8 At[4][2], B0[2][2], B1[2][2];
    const char* cB = S.bbase(g, cur); S.a_offsets(g, cur, tid, vaC);
    if constexpr (SP2) {
        PG8_STAGE(PG8_SB(0, 0), cB, voffB); PG8_STAGE(PG8_SB(0, 1), cB + hstep, voffB); PG8_STAGEA(PG8_SA(0, 0), 0, vaC[0]); PG8_STAGEA(PG8_SA(0, 1), 0, vaC[1]);
        if (wr == 1) PG8_BAR;
        PG8_WAIT_V(2); PG8_BAR;
        PG8_STAGE(PG8_SB(1, 0), cB + kstep, voffB); PG8_STAGEA(PG8_SA(1, 0), kstep, vaC[0]); PG8_STAGE(PG8_SB(1, 1), cB + hstep + kstep, voffB);
        PG8_WAIT_V(6); PG8_BAR;
    } else {
    PG8_STAGE(PG8_SB(0, 0), cB, voffB); PG8_STAGEA(PG8_SA(0, 0), 0, vaC[0]); PG8_STAGE(PG8_SB(0, 1), cB + hstep, voffB); PG8_STAGEA(PG8_SA(0, 1), 0, vaC[1]);
    if (wr == 1) PG8_BAR;
    PG8_WAIT_V(4); PG8_BAR;
    PG8_STAGE(PG8_SB(1, 0), cB + kstep, voffB); PG8_STAGEA(PG8_SA(1, 0), kstep, vaC[0]); PG8_STAGE(PG8_SB(1, 1), cB + hstep + kstep, voffB);
    PG8_WAIT_V(6); PG8_BAR;
    }
    PG8_STAMP();
    for (;;) {
        const bool has_next = S.next(ui + 1, nxt);
        const char* nB = has_next ? S.bbase(g, nxt) : cB;
        { unsigned vaN[2][2];
          if (has_next) S.a_offsets(g, nxt, tid, vaN); else {
#pragma unroll
            for (int hf = 0; hf < 2; ++hf)
#pragma unroll
                for (int i = 0; i < 2; ++i) vaN[hf][i] = vaC[hf][i]; }
#pragma unroll
          for (int hf = 0; hf < 2; ++hf)
#pragma unroll
              for (int i = 0; i < 2; ++i) vtab[(hf * 2 + i) * 512] = vaN[hf][i]; }
        unsigned v2[2][2];
        for (int t = 0; t < nt; t += 2) {
            const bool last = (t == nt - 2);
            const size_t k1 = (size_t)(t + 1) * kstep, k2 = last ? (size_t)0 : (size_t)(t + 2) * kstep, k3 = k2 + kstep;
            const char* b2 = last ? nB : cB + (size_t)(t + 2) * kstep; const char* b3 = b2 + kstep;
#pragma unroll
            for (int hf = 0; hf < 2; ++hf)
#pragma unroll
                for (int i = 0; i < 2; ++i) v2[hf][i] = last ? vtab[(hf * 2 + i) * 512] : vaC[hf][i];
            if constexpr (SP2) {
            PG8_LDB(B0, 0, 0); PG8_LDB(B1, 0, 1); PG8_SCHED; PG8_LDA(At, 0, 0); PG8_STAGEA(PG8_SA(1, 1), k1, vaC[1]);
            PG8_WAIT_V(8); PG8_WAIT_L(0); PG8_BAR; PG8_MMA(0, 0, At, B0); PG8_MMA(0, 1, At, B1); PG8_BAR; PG8_SCHED;
            PG8_LDA(At, 0, 1); PG8_STAGE(PG8_SB(0, 0), b2, voffB); PG8_STAGE(PG8_SB(0, 1), b2 + hstep, voffB); PG8_STAGEA(PG8_SA(0, 0), k2, v2[0]);
            PG8_WAIT_V(8); PG8_WAIT_L(0); PG8_BAR; PG8_MMA(1, 0, At, B0); PG8_MMA(1, 1, At, B1); PG8_BAR; PG8_SCHED;
            PG8_LDB(B0, 1, 0); PG8_LDB(B1, 1, 1); PG8_SCHED; PG8_LDA(At, 1, 0); PG8_STAGEA(PG8_SA(0, 1), k2, v2[1]);
            PG8_WAIT_V(8); PG8_WAIT_L(0); PG8_BAR; PG8_MMA(0, 0, At, B0); PG8_MMA(0, 1, At, B1); PG8_BAR; PG8_SCHED;
            PG8_LDA(At, 1, 1); PG8_STAGE(PG8_SB(1, 0), b3, voffB); PG8_STAGE(PG8_SB(1, 1), b3 + hstep, voffB); PG8_STAGEA(PG8_SA(1, 0), k3, v2[0]);
            PG8_WAIT_V(8); PG8_WAIT_L(0); PG8_BAR; PG8_MMA(1, 0, At, B0); PG8_MMA(1, 1, At, B1); PG8_BAR; PG8_SCHED;
            } else {
            PG8_LDB(B0, 0, 0); PG8_SCHED; PG8_LDA(At, 0, 0); PG8_STAGEA(PG8_SA(1, 1), k1, vaC[1]);
            PG8_WAIT_L(8); PG8_BAR; PG8_WAIT_L(0); PG8_MMA(0, 0, At, B0); PG8_BAR; PG8_SCHED;
            PG8_LDB(B1, 0, 1); PG8_STAGE(PG8_SB(0, 0), b2, voffB);
            PG8_BAR; PG8_WAIT_L(0); PG8_MMA(0, 1, At, B1); PG8_BAR;
            PG8_LDA(At, 0, 1); PG8_STAGEA(PG8_SA(0, 0), k2, v2[0]);
            PG8_BAR; PG8_WAIT_L(0); PG8_MMA(1, 0, At, B0); PG8_BAR; PG8_SCHED;
            PG8_STAGE(PG8_SB(0, 1), b2 + hstep, voffB);
            PG8_WAIT_V(6); PG8_BAR; PG8_MMA(1, 1, At, B1); PG8_BAR;
            PG8_LDB(B0, 1, 0); PG8_SCHED; PG8_LDA(At, 1, 0); PG8_STAGEA(PG8_SA(0, 1), k2, v2[1]);
            PG8_WAIT_L(8); PG8_BAR; PG8_WAIT_L(0); PG8_MMA(0, 0, At, B0); PG8_BAR; PG8_SCHED;
            PG8_LDB(B1, 1, 1); PG8_STAGE(PG8_SB(1, 0), b3, voffB);
            PG8_BAR; PG8_WAIT_L(0); PG8_MMA(0, 1, At, B1); PG8_BAR;
            PG8_LDA(At, 1, 1); PG8_STAGEA(PG8_SA(1, 0), k3, v2[0]);
            PG8_BAR; PG8_WAIT_L(0); PG8_MMA(1, 0, At, B0); PG8_BAR; PG8_SCHED;
            PG8_STAGE(PG8_SB(1, 1), b3 + hstep, voffB);
            PG8_WAIT_V(6); PG8_BAR; PG8_MMA(1, 1, At, B1); PG8_BAR;
            }
        }
        PG8_STAMP();
        if (wr == 0) PG8_BAR;
        if constexpr (SCW >= 0) asm volatile("s_nop 15\n\ts_nop 15" ::: "memory");
        E(acc, cur, wr, wc, fr, fq);
        PG8_STAMP();
        if (!has_next) break;
#pragma unroll
        for (int a = 0; a < 2; ++a)
#pragma unroll
            for (int b = 0; b < 2; ++b)
#pragma unroll
                for (int m = 0; m < 4; ++m)
#pragma unroll
                    for (int n = 0; n < 2; ++n) acc[a][b][m][n] = (f32x4){0.f, 0.f, 0.f, 0.f};
        cur = nxt; cB = nB; ++ui;
#pragma unroll
        for (int hf = 0; hf < 2; ++hf)
#pragma unroll
            for (int i = 0; i < 2; ++i) vaC[hf][i] = v2[hf][i];
        if (wr == 1) PG8_BAR;
    }
    PG8_WAIT_V(0);
    PG8_BAR;
    PG8_STAMP();
    if (STAMP && wid == 0) { stamps[lane] = lane < nts ? (((unsigned long long)(unsigned)ts_hi << 32) | (unsigned)ts_lo) : 0ull;
        if (lane == 62) stamps[62] = rt_entry; if (lane == 63) stamps[63] = (unsigned long long)wall_clock64(); }
#undef PG8_STAMP
#undef PG8_SA
#undef PG8_SB
#undef PG8_STAGE
#undef PG8_STAGEA
#undef PG8_LDA
#undef PG8_LDB
#undef PG8_MMA
#undef PG8_WAIT_V
#undef PG8_WAIT_L
#undef PG8_BAR
#undef PG8_SCHED
}
}

constexpr int NTHR = 512, NWV = 8, LDS_BYTES = 147456;

struct P {
    const float *x, *c, *ctx, *c_ctx, *w_mod, *b_mod, *norm1_g, *norm2_g, *w_in, *conv_w, *conv_b, *dt_bias_f, *dt_bias_b, *a_log_f, *a_log_b, *d_skip, *ssd_norm_g,
        *gk_up_f, *gk_bias_f, *gk_up_b, *gk_bias_b, *gla_norm_g, *w_out, *w_router, *router_bias, *w_gate, *w_up, *w_down, *final_g;
    float* out; bf16_t* XB; bf16_t* H; bf16_t* PROJ; bf16_t* SS; bf16_t* GS; float* SDEC; float* GDEC; float* MOD; int* counts; int* TOKSLOT; float* EW; int* MAP; bf16_t* WinT; bf16_t* WoutT; bf16_t* WguT; bf16_t* WdT; bf16_t* WRT; unsigned* BAR; bf16_t* XBCC; bf16_t* QKB; float* SSC; float* STOT; float* SSQ; float* XSS;
};

DI void ph_init(const P& p) { const size_t i = (size_t)blockIdx.x * NTHR + ltid(); if (i < 64) p.counts[i * 32] = 0; }

DI void ph_mod(const P& p, float* s  ) {
    const int tid_ = ltid(), lane = tid_ & 63, w = tid_ >> 6;
    if (blockIdx.x >= 192) return;
    float* part = s + 9 * 1024;
    { float cv[18];
#pragma unroll
      for (int q = 0; q < 18; ++q) { const int i = tid_ + q * NTHR, r = i >> 10, k = i & 1023; cv[q] = r < 8 ? p.c[r * 1024 + k] : p.c_ctx[k]; }
#pragma unroll
      for (int q = 0; q < 18; ++q) s[tid_ + q * NTHR] = siluf(cv[q]); }
    __syncthreads();
    for (int vb = blockIdx.x; vb < 192; vb += gridDim.x) {
        const int l = vb / 96, n = (vb % 96) * 64 + lane;
        float acc[9];
#pragma unroll
        for (int r = 0; r < 9; ++r) acc[r] = 0.f;
        const float* wp = p.w_mod + (size_t)l * 1024 * 6144 + (size_t)(128 * w) * 6144 + n;
#pragma unroll 8
        for (int k = 0; k < 128; ++k) { const float wv = wp[(size_t)k * 6144];
#pragma unroll
            for (int r = 0; r < 9; ++r) acc[r] += s[r * 1024 + 128 * w + k] * wv; }
#pragma unroll
        for (int r = 0; r < 9; ++r) part[(w * 9 + r) * 64 + lane] = acc[r];
        __syncthreads();
        for (int o = tid_; o < 9 * 64; o += NTHR) { const int r = o >> 6, c = o & 63; float a = p.b_mod[l * 6144 + (vb % 96) * 64 + c];
#pragma unroll
            for (int q = 0; q < 8; ++q) a += part[(q * 9 + r) * 64 + c];
            p.MOD[((size_t)l * 9 + r) * 6144 + (vb % 96) * 64 + c] = a; }
        __syncthreads();
    }
}

DI unsigned pk2(float lo, float hi) { return __builtin_bit_cast(unsigned, __builtin_convertvector((f32x2v_){lo, hi}, bf16x2v_)); }
template <bool F8 = false> DI void transpose_item(const float* W, int K, int N, bf16_t* WT, float* scr, int item, int lane, int gu = -1, const float* kscale = nullptr) {
    const int nblk = (N + 31) / 32, kb = item / nblk, nb = item % nblk, k0 = 64 * kb, n0 = 32 * nb;
    const int d0 = gu < 0 ? n0 : 256 * (n0 >> 7) + (n0 & 127) + 128 * gu;
    const int ncl = n0 + (lane & 31) < N ? n0 + (lane & 31) : N - 1;
    float wv_[32];
#pragma unroll
    for (int i = 0; i < 32; ++i) { const int kk = 2 * i + (lane >> 5); wv_[i] = __builtin_nontemporal_load(W + (size_t)(k0 + kk) * N + ncl); }
#pragma unroll
    for (int i = 0; i < 32; ++i) { const int kk = 2 * i + (lane >> 5); scr[kk * 33 + (lane & 31)] = wv_[i] * (kscale ? kscale[k0 + kk] : 1.0f); }
    const int c = lane & 7;
#pragma unroll
    for (int j = 0; j < 4; ++j) { const int n = (lane >> 3) + 8 * j; const float* q = scr + (8 * c) * 33 + n;
        if constexpr (F8) { typedef unsigned u32x2nt __attribute__((ext_vector_type(2)));
            const u32x2nt o = {pg8::pk4_fp8((pg8::f32x4){q[0 * 33], q[1 * 33], q[2 * 33], q[3 * 33]} * 64.0f), pg8::pk4_fp8((pg8::f32x4){q[4 * 33], q[5 * 33], q[6 * 33], q[7 * 33]} * 64.0f)};
            if (n0 + n < N) __builtin_nontemporal_store(o, (u32x2nt*)((unsigned char*)WT + (size_t)(d0 + n) * K + k0 + 8 * c)); }
        else {
        uint4 o; o.x = pk2(q[0 * 33], q[1 * 33]); o.y = pk2(q[2 * 33], q[3 * 33]); o.z = pk2(q[4 * 33], q[5 * 33]); o.w = pk2(q[6 * 33], q[7 * 33]);
        if (n0 + n < N) { typedef unsigned u32x4nt __attribute__((ext_vector_type(4))); __builtin_nontemporal_store((u32x4nt){o.x, o.y, o.z, o.w}, (u32x4nt*)(WT + (size_t)(d0 + n) * K + k0 + 8 * c)); } } }
}

struct TrD { const float* src; unsigned char* dst; int N, K; bool ok; };
DI TrD tr_desc(const P& p, int l, int it, int it1, int lane) {
    TrD d; d.ok = it < it1; const int itc = d.ok ? it : it1 - 1;
    const int e = itc / 768, r = itc - e * 768;
    const float* W; unsigned char* WT; int K, N, item, gu;
    if (r < 512) { gu = r >> 8; W = (gu ? p.w_up : p.w_gate) + (size_t)(l * NE + e) * D * 512; K = D; N = 512; WT = (unsigned char*)p.WguT + (size_t)e * D * D; item = r & 255; }
    else { gu = -1; W = p.w_down + (size_t)(l * NE + e) * 512 * D; K = 512; N = D; WT = (unsigned char*)p.WdT + (size_t)e * D * 512; item = r - 512; }
    const int nblk = N / 32, kb = item / nblk, nb = item % nblk, k0 = 64 * kb, n0 = 32 * nb;
    const int d0 = gu < 0 ? n0 : 256 * (n0 >> 7) + (n0 & 127) + 128 * gu;
    d.src = W + (size_t)(k0 + (lane >> 5)) * N + n0 + (lane & 31); d.dst = WT + (size_t)d0 * K + k0; d.N = N; d.K = K;
    return d;
}
DI void tr_load(const TrD& d, float (&v)[32]) {
#pragma unroll
    for (int i = 0; i < 32; ++i) v[i] = __builtin_nontemporal_load(d.src + (size_t)(2 * i) * d.N);
}
DI void tr_finish(const TrD& d, const float (&v)[32], float* scr, int lane) {
#pragma unroll
    for (int i = 0; i < 32; ++i) { const int kk = 2 * i + (lane >> 5); scr[kk * 33 + (lane & 31)] = v[i]; }
    const int c = lane & 7;
#pragma unroll
    for (int j = 0; j < 4; ++j) { const int n = (lane >> 3) + 8 * j; const float* q = scr + (8 * c) * 33 + n;
        typedef unsigned u32x2nt __attribute__((ext_vector_type(2)));
        const u32x2nt o = {pg8::pk4_fp8((pg8::f32x4){q[0 * 33], q[1 * 33], q[2 * 33], q[3 * 33]} * 64.0f), pg8::pk4_fp8((pg8::f32x4){q[4 * 33], q[5 * 33], q[6 * 33], q[7 * 33]} * 64.0f)};
        if (d.ok) __builtin_nontemporal_store(o, (u32x2nt*)(d.dst + (size_t)n * d.K + 8 * c)); }
}
#ifndef TR_NI
#define TR_NI 1
#endif
DI void ph_convert_experts(const P& p, int l, float* ldsf, int wk0, int nwk, int it0 = 0, int it1 = NE * 768) {
    const int tid_ = ltid(), lane = tid_ & 63, gw = ((int)blockIdx.x - wk0) * NWV + (tid_ >> 6), NW = nwk * NWV;
    float* scr = ldsf + 14 * 1024 + (tid_ >> 6) * (64 * 33 + 16);
    for (int it = it0 + gw; it < it1; it += TR_NI * NW) {
        float v[TR_NI][32]; TrD d[TR_NI];
#pragma unroll
        for (int j = 0; j < TR_NI; ++j) { d[j] = tr_desc(p, l, it + j * NW, it1, lane); tr_load(d[j], v[j]); }
#pragma unroll
        for (int j = 0; j < TR_NI; ++j) tr_finish(d[j], v[j], scr, lane);
    }
}
constexpr int NPAD_IN = 3072;
DI void ph_convert_small(const P& p, float* ldsf, int, int, int) {
    const int tid_ = ltid(), lane = tid_ & 63, gw = blockIdx.x * NWV + (tid_ >> 6), NW = gridDim.x * NWV;
    float* scr = ldsf + 14 * 1024 + (tid_ >> 6) * (64 * 33 + 16);
    constexpr int I_IN = 16 * 89, I_OUT = 16 * 32;
    for (int it = gw; it < 2 * (I_IN + I_OUT); it += NW) {
        const int l = it / (I_IN + I_OUT), r = it % (I_IN + I_OUT);
        if (r < I_IN) transpose_item<true>(p.w_in + (size_t)l * D * INDIM, D, INDIM, (bf16_t*)((unsigned char*)p.WinT + (size_t)l * NPAD_IN * D), scr, r, lane);
        else { const int kb = (r - I_IN) / 32;
            transpose_item<true>(p.w_out + (size_t)l * D * D, D, D, (bf16_t*)((unsigned char*)p.WoutT + (size_t)l * D * D), scr, r - I_IN, lane, -1, kb < 8 ? p.ssd_norm_g + l * 512 : nullptr); }
    }
    for (int idx = blockIdx.x * NTHR + tid_; idx < 32 * 1024; idx += gridDim.x * NTHR) { const int e = idx >> 10, k = idx & 1023; p.WRT[idx] = f2bf(p.w_router[k * 32 + e]); }
    const size_t nz16 = (size_t)(NPAD_IN - INDIM) * D / 16;
    for (size_t i = (size_t)blockIdx.x * NTHR + tid_; i < 2 * nz16; i += (size_t)gridDim.x * NTHR) {
        const size_t l = i / nz16, j = i % nz16;
        ((uint4*)((unsigned char*)p.WinT + (l * NPAD_IN + INDIM) * D))[j] = make_uint4(0u, 0u, 0u, 0u);
    }
}

DI void row_normmod(float4 (&v)[4], const float* g, const float* mr, int shift_idx, int scale_idx, int lane) {
    float ss = 0.f;
#pragma unroll
    for (int i = 0; i < 4; ++i) ss += v[i].x * v[i].x + v[i].y * v[i].y + v[i].z * v[i].z + v[i].w * v[i].w;
    ss = wave_sum(ss, lane);
    const float rstd = rsqrtf(ss * (1.0f / D) + 1e-6f);
#pragma unroll
    for (int i = 0; i < 4; ++i) {
        const int c = (i * 64 + lane) * 4;
        const float4 gg = *(const float4*)(g + c), sh = *(const float4*)(mr + shift_idx * 1024 + c), sc = *(const float4*)(mr + scale_idx * 1024 + c);
        v[i].x = v[i].x * rstd * gg.x * (1.f + sc.x) + sh.x; v[i].y = v[i].y * rstd * gg.y * (1.f + sc.y) + sh.y;
        v[i].z = v[i].z * rstd * gg.z * (1.f + sc.z) + sh.z; v[i].w = v[i].w * rstd * gg.w * (1.f + sc.w) + sh.w;
    }
}
DI void row_store_bf16(bf16_t* hrow, float4 (&v)[4], int lane) {
#pragma unroll
    for (int i = 0; i < 4; ++i) { ushort4 o; o.x = f2bf(v[i].x); o.y = f2bf(v[i].y); o.z = f2bf(v[i].z); o.w = f2bf(v[i].w);
        *(ushort4*)(hrow + (i * 64 + lane) * 4) = o; v[i] = make_float4(bf2f(o.x), bf2f(o.y), bf2f(o.z), bf2f(o.w)); }
}

DI void ph_normmod1(const P& p, int l, int, int, int) {
    const int tid_ = ltid(), lane = tid_ & 63, gw = blockIdx.x * NWV + (tid_ >> 6), NW = gridDim.x * NWV;
    const float* MODl = p.MOD + (size_t)l * 9 * 6144;
    for (int t = gw; t < T; t += NW) {
        float4 v[4];
#pragma unroll
        for (int i = 0; i < 4; ++i) v[i] = ((const float4*)(t < TC ? p.ctx + (size_t)t * D : p.x + (size_t)(t - TC) * D))[i * 64 + lane];
        row_normmod(v, p.norm1_g + l * D, MODl + (size_t)tok_modrow(t) * 6144, 0, 1, lane);
#pragma unroll
        for (int i = 0; i < 4; ++i) *(unsigned*)((unsigned char*)p.H + (size_t)t * D + (i * 64 + lane) * 4) = pg8::pk4_fp8((pg8::f32x4){v[i].x, v[i].y, v[i].z, v[i].w});
    }
}

typedef short s16x4 __attribute__((ext_vector_type(4)));
typedef short bf16x8v __attribute__((ext_vector_type(8)));
typedef float f32x4v __attribute__((ext_vector_type(4)));
typedef unsigned u32x4v __attribute__((ext_vector_type(4)));
typedef unsigned u32x2v __attribute__((ext_vector_type(2)));
DI u32x4v mk4(unsigned a, unsigned b, unsigned c, unsigned d) { return (u32x4v){a, b, c, d}; }
DI u32x2v mk2(unsigned a, unsigned b) { return (u32x2v){a, b}; }
DI f32x4v mkf4(float a, float b, float c, float d) { return (f32x4v){a, b, c, d}; }
#define LDSP __attribute__((address_space(3)))
constexpr int NCH = 34, NTILE = NB * NCH;
constexpr int LD64 = 72, LD128 = 136;
constexpr float LOG2E = 1.4426950408889634f;

DI int tile_tok0(int tl) { const int b = tl / NCH, cs = tl - b * NCH; return cs < 2 ? b * CTXL + cs * 128 : TC + b * SEQ + (cs - 2) * 128; }
DI f32x4v mfma16(bf16x8v a, bf16x8v b, f32x4v c) { return __builtin_amdgcn_mfma_f32_16x16x32_bf16(a, b, c, 0, 0, 0); }
DI bf16x8v frag_row(LDSP const bf16_t* base, int ld, int r0, int k0, int lane) { return *(LDSP const bf16x8v*)(base + (r0 + (lane & 15)) * ld + k0 + 8 * (lane >> 4)); }
DI bf16x8v frag_row_g(const bf16_t* base, int ld, int r0, int k0, int lane) { return *(const bf16x8v*)(base + (size_t)(r0 + (lane & 15)) * ld + k0 + 8 * (lane >> 4)); }
DI bf16x8v frag_col(LDSP const bf16_t* base, int ld, int r0, int k0, int lane) {
    const int G = lane >> 4, i = lane & 15;
    LDSP const bf16_t* a = base + (k0 + 8 * G + (i >> 2)) * ld + r0 + 4 * (i & 3);
    const s16x4 lo = __builtin_bit_cast(s16x4, __builtin_amdgcn_ds_read_tr16_b64_v4i16((LDSP s16x4*)a));
    const s16x4 hi = __builtin_bit_cast(s16x4, __builtin_amdgcn_ds_read_tr16_b64_v4i16((LDSP s16x4*)(a + 4 * ld)));
    return (bf16x8v){lo[0], lo[1], lo[2], lo[3], hi[0], hi[1], hi[2], hi[3]};
}
DI u32x2v pack4(f32x4v v) { return mk2(pk2(v[0], v[1]), pk2(v[2], v[3])); }
DI void unpack8(u32x4v v, float* o) { o[0] = __uint_as_float(v.x << 16); o[1] = __uint_as_float(v.x & 0xffff0000u); o[2] = __uint_as_float(v.y << 16); o[3] = __uint_as_float(v.y & 0xffff0000u);
    o[4] = __uint_as_float(v.z << 16); o[5] = __uint_as_float(v.z & 0xffff0000u); o[6] = __uint_as_float(v.w << 16); o[7] = __uint_as_float(v.w & 0xffff0000u); }
DI u32x4v pack8(const float* o) { return mk4(pk2(o[0], o[1]), pk2(o[2], o[3]), pk2(o[4], o[5]), pk2(o[6], o[7])); }

DI float fast_logsigmoid(float x) { return -(fmaxf(-x, 0.f) + __logf(1.0f + __expf(-fabsf(x)))); }
DI float fast_softplus(float x) { return fmaxf(x, 0.f) + __logf(1.0f + __expf(-fabsf(x))); }
struct XbcSrc { const bf16_t* base; int ld; };
DI XbcSrc xbc_src(const P& p, int tok0) { XbcSrc r; r.base = p.XBCC + (size_t)tok0 * 768; r.ld = 768; return r; }

DI void prep_conv_item(const P& p, int l, int item, int lane) {
    int piece, ch;
    if (item < T / 32) { piece = item; ch = lane * 8; } else { piece = 2 * (item - T / 32) + (lane >> 5); ch = 512 + (lane & 31) * 8; }
    const int t0 = piece * 32; int lo, hi; bf16_t* dst; int dld;
    if (t0 < TC) { lo = t0 & ~(CTXL - 1); hi = lo + CTXL - 1; } else { lo = TC + ((t0 - TC) & ~63); hi = lo + 63; }
    dst = p.XBCC + ch; dld = 768;
    const bf16_t* src = p.PROJ + OFF_XBC + ch;
    float wgt[5][8], bias[8];
#pragma unroll
    for (int k = 0; k < 5; ++k) { const f32x4v a = *(const f32x4v*)(p.conv_w + l * 5 * 768 + k * 768 + ch), c = *(const f32x4v*)(p.conv_w + l * 5 * 768 + k * 768 + ch + 4);
#pragma unroll
        for (int j = 0; j < 4; ++j) { wgt[k][j] = a[j]; wgt[k][4 + j] = c[j]; } }
    { const f32x4v a = *(const f32x4v*)(p.conv_b + l * 768 + ch), c = *(const f32x4v*)(p.conv_b + l * 768 + ch + 4);
#pragma unroll
      for (int j = 0; j < 4; ++j) { bias[j] = a[j]; bias[4 + j] = c[j]; } }
    const u32x4v zero4 = mk4(0u, 0u, 0u, 0u);
    u32x4v rw[13];
#pragma unroll
    for (int i = 0; i < 5; ++i) { const int tt = t0 - 2 + i; rw[i] = (tt >= lo && tt <= hi) ? *(const u32x4v*)(src + (size_t)tt * LDP) : zero4; }
    for (int s0 = 0; s0 < 32; s0 += 8) {
        const int t = t0 + s0;
#pragma unroll
        for (int i = 0; i < 8; ++i) { const int tt = t + 3 + i; rw[5 + i] = (tt <= hi) ? *(const u32x4v*)(src + (size_t)tt * LDP) : zero4; }
#pragma unroll
        for (int i = 0; i < 8; ++i) {
            float o[8];
#pragma unroll
            for (int c = 0; c < 8; ++c) o[c] = bias[c];
#pragma unroll
            for (int k = 0; k < 5; ++k) { float v[8]; unpack8(rw[i + k], v);
#pragma unroll
                for (int c = 0; c < 8; ++c) o[c] += wgt[k][c] * v[c]; }
#pragma unroll
            for (int c = 0; c < 8; ++c) o[c] = siluf(o[c]);
            *(u32x4v*)(dst + (size_t)(t + i) * dld) = pack8(o);
        }
#pragma unroll
        for (int i = 0; i < 5; ++i) rw[i] = rw[i + 8];
    }
}
DI void prep_ssd_item(const P& p, int l, int item, int lane) {
    const int tl = item >> 3, h = item & 7, tok0 = tile_tok0(tl);
    const float bsf = p.dt_bias_f[l * 8 + h], bsb = p.dt_bias_b[l * 8 + h];
    const float r0 = bf2f(p.PROJ[(size_t)(tok0 + 2 * lane) * LDP + OFF_DT + h]), r1 = bf2f(p.PROJ[(size_t)(tok0 + 2 * lane + 1) * LDP + OFF_DT + h]);
    const float f0 = fast_softplus(r0 + bsf), f1 = fast_softplus(r1 + bsf), b0 = fast_softplus(r0 + bsb), b1 = fast_softplus(r1 + bsb);
    float pf = f0 + f1, sb = b0 + b1;
#pragma unroll
    for (int o = 1; o < 64; o <<= 1) { const float t = shl(pf, lane >= o ? lane - o : lane); if (lane >= o) pf += t; }
#pragma unroll
    for (int o = 1; o < 64; o <<= 1) { const float t = shl(sb, lane + o < 64 ? lane + o : lane); if (lane + o < 64) sb += t; }
    const float Af = -__expf(p.a_log_f[l * 8 + h]) * LOG2E, Ab = -__expf(p.a_log_b[l * 8 + h]) * LOG2E;
    const float af0 = Af * (pf - f1), af1 = Af * pf, ab0 = Ab * sb, ab1 = Ab * (sb - b0);
    f32x4v* dst = (f32x4v*)p.SSC + (size_t)(tl * 8 + h) * 128 + 2 * lane;
    dst[0] = mkf4(af0, af0 - __log2f(f0), ab0, ab0 - __log2f(b0));
    dst[1] = mkf4(af1, af1 - __log2f(f1), ab1, ab1 - __log2f(b1));
    if (lane == 63) { p.STOT[(tl * 8 + h) * 2 + 0] = af1; p.SDEC[(tl * 8 + h) * 2 + 0] = __builtin_amdgcn_exp2f(af1); }
    if (lane == 0) { p.STOT[(tl * 8 + h) * 2 + 1] = ab0; p.SDEC[(tl * 8 + h) * 2 + 1] = __builtin_amdgcn_exp2f(ab0); }
}
template <int CTRL> DI float dppz(float x) { return __builtin_bit_cast(float, __builtin_amdgcn_update_dpp(0, __builtin_bit_cast(int, x), CTRL, 0xf, 0xf, true)); }
DI float row_total(float s) { s += dppz<0xB1>(s); s += dppz<0x4E>(s); s += dppz<0x141>(s); s += dppz<0x140>(s); return s; }
struct GateOp { bf16x8v gkf[8]; float uw[8]; f32x4v bias; };
DI void gate_load(const P& p, int l, int tl, int h, GateOp& L) {
    const int tid = ltid(), lane = tid & 63, w = __builtin_amdgcn_readfirstlane(tid >> 6), kt = w & 3, dir = w >> 2, G = lane >> 4, c = lane & 15, tok0 = tile_tok0(tl);
#pragma unroll
    for (int nt = 0; nt < 8; ++nt) L.gkf[nt] = *(const bf16x8v*)(p.PROJ + (size_t)(tok0 + 16 * nt + c) * LDP + OFF_GK + (G & 1) * 8);
    { const float* up = (dir ? p.gk_up_b : p.gk_up_f) + l * 16 * 256 + (G & 1) * 8 * 256 + h * 64 + 16 * kt + c;
#pragma unroll
      for (int e = 0; e < 8; ++e) L.uw[e] = up[e * 256]; }
    L.bias = *(const f32x4v*)((dir ? p.gk_bias_b : p.gk_bias_f) + l * 256 + h * 64 + 16 * kt + 4 * G);
}
DI void gate_scan(const GateOp& L, f32x4v (&g)[8], f32x4v& tot) {
    const int tid = ltid(), lane = tid & 63, dir = __builtin_amdgcn_readfirstlane(tid >> 6) >> 2, G = lane >> 4;
    { bf16x8v af;
#pragma unroll
      for (int e = 0; e < 8; ++e) { const bf16_t hi = f2bf(L.uw[e]); const bf16_t lo = f2bf(L.uw[e] - bf2f(hi)); af[e] = (short)(G < 2 ? hi : lo); }
#pragma unroll
      for (int nt = 0; nt < 8; ++nt) g[nt] = mfma16(af, L.gkf[nt], (f32x4v){0.f, 0.f, 0.f, 0.f}); }
#pragma unroll
    for (int nt = 0; nt < 8; ++nt)
#pragma unroll
        for (int r = 0; r < 4; ++r) { const float x = (g[nt][r] + L.bias[r]) * LOG2E;
            g[nt][r] = -(fmaxf(-x, 0.f) + __log2f(1.0f + __builtin_amdgcn_exp2f(-fabsf(x)))) * (1.0f / 16.0f); }
    tot = (f32x4v){0.f, 0.f, 0.f, 0.f};
    if (dir == 0) {
#pragma unroll
        for (int nt = 0; nt < 8; ++nt)
#pragma unroll
            for (int r = 0; r < 4; ++r) { float x = g[nt][r];
                x += dppz<0x111>(x); x += dppz<0x112>(x); x += dppz<0x114>(x); x += dppz<0x118>(x);
                g[nt][r] = tot[r] + x; tot[r] += dppz<0x15F>(x); }
    } else {
#pragma unroll
        for (int nt = 7; nt >= 0; --nt)
#pragma unroll
            for (int r = 0; r < 4; ++r) { float x = g[nt][r];
                x += dppz<0x101>(x); x += dppz<0x102>(x); x += dppz<0x104>(x); x += dppz<0x108>(x);
                g[nt][r] = tot[r] + x; tot[r] += dppz<0x150>(x); }
    }
}
struct GlaPL { u32x4v kv_[2], vv_[4]; GateOp go; };
DI void prep_gla_load(const P& p, int l, int it, GlaPL& L) {
    const int tl = it >> 2, h = it & 3;
    const int tid = ltid(), tok0 = tile_tok0(tl);
    gate_load(p, l, tl, h, L.go);
#pragma unroll
    for (int q = 0; q < 4; ++q) { const int cc_ = tid + q * NTHR, r = cc_ >> 4, cc = cc_ & 15; L.vv_[q] = *(const u32x4v*)(p.PROJ + (size_t)(tok0 + r) * LDP + OFF_V + h * 128 + cc * 8); }
#pragma unroll
    for (int q = 0; q < 2; ++q) { const int cc_ = tid + q * NTHR, r = cc_ >> 3, cc = cc_ & 7; L.kv_[q] = *(const u32x4v*)(p.PROJ + (size_t)(tok0 + r) * LDP + OFF_K + h * 64 + cc * 8); }
}
DI void prep_gla_block(const P& p, int l, int it, int it_next, GlaPL& L, LDSP unsigned char* lds) {
    const int tl = it >> 2, h = it & 3;
    const int tid = ltid(), lane = tid & 63, w = __builtin_amdgcn_readfirstlane(tid >> 6), kt = w & 3, dir = w >> 2, G = lane >> 4, c = lane & 15;
    LDSP bf16_t* KT = (LDSP bf16_t*)lds; LDSP bf16_t* O2 = KT + 128 * LD64; LDSP bf16_t* VT = O2 + 2 * 128 * LD64; LDSP float* DEC = (LDSP float*)(VT + 128 * LD128);
    f32x4v g[8], tot;
    gate_scan(L.go, g, tot);
    __syncthreads();
#pragma unroll
    for (int q = 0; q < 2; ++q) { const int cc_ = tid + q * NTHR, r = cc_ >> 3, cc = cc_ & 7; *(LDSP u32x4v*)(KT + r * LD64 + cc * 8) = L.kv_[q]; }
#pragma unroll
    for (int q = 0; q < 4; ++q) { const int cc_ = tid + q * NTHR, r = cc_ >> 4, cc = cc_ & 15; *(LDSP u32x4v*)(VT + r * LD128 + cc * 8) = L.vv_[q]; }
    __syncthreads();
    { LDSP bf16_t* OK = O2 + dir * 128 * LD64;
#pragma unroll
      for (int nt = 0; nt < 8; ++nt) { const int o = (16 * nt + c) * LD64 + 16 * kt + 4 * G;
          const u32x2v k2 = *(LDSP const u32x2v*)(KT + o);
          float ek[4];
#pragma unroll
          for (int r = 0; r < 4; ++r) ek[r] = __builtin_amdgcn_exp2f(-g[nt][r]);
          *(LDSP u32x2v*)(OK + o) = mk2(pk2(__uint_as_float(k2.x << 16) * ek[0], __uint_as_float(k2.x & 0xffff0000u) * ek[1]), pk2(__uint_as_float(k2.y << 16) * ek[2], __uint_as_float(k2.y & 0xffff0000u) * ek[3])); }
      if (c == 0) { const f32x4v d = mkf4(__builtin_amdgcn_exp2f(tot[0]), __builtin_amdgcn_exp2f(tot[1]), __builtin_amdgcn_exp2f(tot[2]), __builtin_amdgcn_exp2f(tot[3]));
          *(f32x4v*)(p.GDEC + (size_t)((tl * 4 + h) * 2 + dir) * 64 + 16 * kt + 4 * G) = d; *(LDSP f32x4v*)(DEC + dir * 64 + 16 * kt + 4 * G) = d; } }
    __syncthreads();
    if (it_next >= 0) prep_gla_load(p, l, it_next, L);
    { const int ut = kt; LDSP const bf16_t* KE = O2 + dir * 128 * LD64;
      f32x4v acc[8];
#pragma unroll
      for (int q = 0; q < 8; ++q) acc[q] = (f32x4v){0.f, 0.f, 0.f, 0.f};
#pragma unroll
      for (int ks = 0; ks < 4; ++ks) { const bf16x8v u = frag_col(KE, LD64, 16 * ut, 32 * ks, lane);
#pragma unroll
          for (int q = 0; q < 8; ++q) acc[q] = mfma16(u, frag_col(VT, LD128, 16 * q, 32 * ks, lane), acc[q]); }
      const f32x4v dec = *(LDSP const f32x4v*)(DEC + dir * 64 + 16 * ut + 4 * (lane >> 4));
      bf16_t* dst = p.GS + ((size_t)((tl * 4 + h) * 2 + dir) * 128) * 64;
#pragma unroll
      for (int q = 0; q < 8; ++q) *(u32x2v*)(dst + (size_t)(16 * q + (lane & 15)) * 64 + 16 * ut + 4 * (lane >> 4)) = pack4(acc[q] * dec); }
}
constexpr int NPREP_A = T / 32 + T / 64, NPREP_B = NTILE * 8;
DI void ph_prep(const P& p, int l, LDSP unsigned char* lds) {
    const int tid_ = ltid(), lane = tid_ & 63, gw = blockIdx.x * NWV + (tid_ >> 6), NW = gridDim.x * NWV;
    for (int it = gw; it < NPREP_A + NPREP_B; it += NW) {
        if (it < NPREP_A) prep_conv_item(p, l, it, lane); else prep_ssd_item(p, l, it - NPREP_A, lane);
    }
    { const int G_ = gridDim.x; int it = G_ - 1 - (int)blockIdx.x;
      GlaPL L; if (it < NTILE * 4) prep_gla_load(p, l, it, L);
      for (; it < NTILE * 4; it += G_) prep_gla_block(p, l, it, it + G_ < NTILE * 4 ? it + G_ : -1, L, lds); }
}

DI int ssd_item(int k, int ntile) {
    const int G_ = gridDim.x, b = blockIdx.x;
    if (G_ != 256) { const int it = b + k * G_; return it < ntile * 8 ? it : -1; }
    const int xcd = b & 7, slot = b >> 3, pp = ((xcd + 4) & 7) * 8 + (slot >> 2), q = k * 32 + (pp >> 1);
    return q < ntile ? q * 8 + 4 * (pp & 1) + (slot & 3) : -1;
}
struct S1Pre { u32x4v x0, x1, b0, b1; f32x4v sc; float tf, tb; };
DI void s1_load(const P& p, int tl, int h, int tid, S1Pre& r) {
    const int tok0 = tile_tok0(tl), g = h >> 2; const XbcSrc xs = xbc_src(p, tok0);
    const int j = tid >> 2, cq = tid & 3;
    const bf16_t* row = xs.base + (size_t)j * xs.ld;
    r.x0 = *(const u32x4v*)(row + h * 64 + cq * 16); r.x1 = *(const u32x4v*)(row + h * 64 + cq * 16 + 8);
    r.b0 = *(const u32x4v*)(row + 512 + g * 64 + cq * 16); r.b1 = *(const u32x4v*)(row + 512 + g * 64 + cq * 16 + 8);
    r.sc = *((const f32x4v*)p.SSC + (size_t)(tl * 8 + h) * 128 + j);
    r.tf = p.STOT[(tl * 8 + h) * 2 + 0]; r.tb = p.STOT[(tl * 8 + h) * 2 + 1];
}
DI void s1_ssd(const P& p, int tl, int h, S1Pre& pre, int it_n, LDSP unsigned char* lds) {
    const int tid = ltid(), lane = tid & 63, w = __builtin_amdgcn_readfirstlane(tid >> 6);
    LDSP bf16_t* XWF = (LDSP bf16_t*)lds; LDSP bf16_t* XWB = XWF + 128 * LD64; LDSP bf16_t* BG = XWB + 128 * LD64;
    const int j = tid >> 2, cq = tid & 3;
    const float wf = __builtin_amdgcn_exp2f(pre.tf - pre.sc.y), wb = __builtin_amdgcn_exp2f(pre.tb - pre.sc.w);
    float xv[16], of[16], ob[16]; unpack8(pre.x0, xv); unpack8(pre.x1, xv + 8);
#pragma unroll
    for (int c = 0; c < 16; ++c) { of[c] = xv[c] * wf; ob[c] = xv[c] * wb; }
    __syncthreads();
    *(LDSP u32x4v*)(XWF + j * LD64 + cq * 16) = pack8(of); *(LDSP u32x4v*)(XWF + j * LD64 + cq * 16 + 8) = pack8(of + 8);
    *(LDSP u32x4v*)(XWB + j * LD64 + cq * 16) = pack8(ob); *(LDSP u32x4v*)(XWB + j * LD64 + cq * 16 + 8) = pack8(ob + 8);
    *(LDSP u32x4v*)(BG + j * LD64 + cq * 16) = pre.b0; *(LDSP u32x4v*)(BG + j * LD64 + cq * 16 + 8) = pre.b1;
    if (it_n >= 0) s1_load(p, it_n >> 3, it_n & 7, tid, pre);
    __syncthreads();
    const int dir = w >> 2, ut = w & 3; LDSP const bf16_t* XW = dir ? XWB : XWF;
    f32x4v acc[4];
#pragma unroll
    for (int q = 0; q < 4; ++q) acc[q] = (f32x4v){0.f, 0.f, 0.f, 0.f};
#pragma unroll
    for (int ks = 0; ks < 4; ++ks) { const bf16x8v u = frag_col(BG, LD64, 16 * ut, 32 * ks, lane);
#pragma unroll
        for (int q = 0; q < 4; ++q) acc[q] = mfma16(u, frag_col(XW, LD64, 16 * q, 32 * ks, lane), acc[q]); }
    bf16_t* dst = p.SS + ((size_t)((tl * 8 + h) * 2 + dir) * 64) * 64;
#pragma unroll
    for (int q = 0; q < 4; ++q) *(u32x2v*)(dst + (size_t)(16 * q + (lane & 15)) * 64 + 16 * ut + 4 * (lane >> 4)) = pack4(acc[q]);
}
DI void ph_s1(const P& p, int l, LDSP unsigned char* lds) {
    S1Pre pre; int it = ssd_item(0, NTILE);
    if (it >= 0) s1_load(p, it >> 3, it & 7, ltid(), pre);
    for (int k = 0; it >= 0; ++k) { const int nx = ssd_item(k + 1, NTILE); s1_ssd(p, it >> 3, it & 7, pre, nx, lds); it = nx; }
}

DI int s2_chunk(int dir, int s) { return dir == 0 ? s : (s < 2 ? 1 - s : 35 - s); }
DI void ph_s2(const P& p) {
    const int g = blockIdx.x * NTHR + ltid();
    for (int v = g; v < 131072; v += gridDim.x * NTHR) {
        const bool gla = v >= 65536; const int r = v & 65535;
        int b, h, dir, vi;
        if (!gla) { vi = r & 511; dir = (r >> 9) & 1; h = (r >> 10) & 7; b = r >> 13; } else { vi = r & 1023; dir = (r >> 10) & 1; h = (r >> 11) & 3; b = r >> 13; }
        float st[8];
#pragma unroll
        for (int e = 0; e < 8; ++e) st[e] = 0.f;
        for (int s0 = 0; s0 < NCH; s0 += 6) {
            u32x4v sv[6]; float dsc[6]; f32x4v dv0[6], dv1[6];
#pragma unroll
            for (int u = 0; u < 6; ++u) { if (s0 + u >= NCH) continue; const int tl = b * NCH + s2_chunk(dir, s0 + u);
                if (!gla) { sv[u] = *(const u32x4v*)(p.SS + ((size_t)((tl * 8 + h) * 2 + dir) * 512 + vi) * 8); dsc[u] = p.SDEC[(tl * 8 + h) * 2 + dir]; }
                else { sv[u] = *(const u32x4v*)(p.GS + ((size_t)((tl * 4 + h) * 2 + dir) * 1024 + vi) * 8); const f32x4v* d = (const f32x4v*)(p.GDEC + (size_t)((tl * 4 + h) * 2 + dir) * 64 + (vi & 7) * 8); dv0[u] = d[0]; dv1[u] = d[1]; } }
#pragma unroll
            for (int u = 0; u < 6; ++u) { if (s0 + u >= NCH) continue; const int tl = b * NCH + s2_chunk(dir, s0 + u);
                float loc[8]; unpack8(sv[u], loc);
                const u32x4v hin = pack8(st);
                if (!gla) { *(u32x4v*)(p.SS + ((size_t)((tl * 8 + h) * 2 + dir) * 512 + vi) * 8) = hin;
#pragma unroll
                    for (int e = 0; e < 8; ++e) st[e] = dsc[u] * st[e] + loc[e]; }
                else { *(u32x4v*)(p.GS + ((size_t)((tl * 4 + h) * 2 + dir) * 1024 + vi) * 8) = hin;
                    const float dd[8] = {dv0[u].x, dv0[u].y, dv0[u].z, dv0[u].w, dv1[u].x, dv1[u].y, dv1[u].z, dv1[u].w};
#pragma unroll
                    for (int e = 0; e < 8; ++e) st[e] = dd[e] * st[e] + loc[e]; } }
        }
    }
}

DI int s3_tile(int l, int q) { return l == 0 ? q : (q >> 5) * NCH + 2 + (q & 31); }
struct SsdPre { u32x4v x0, x1, b0, b1, c0, c1, hf, hb; f32x4v sc; };
DI void s3_ssd_load(const P& p, int tl, int h, int tid, int i, int G, SsdPre& r) {
    const int tok0 = tile_tok0(tl), g = h >> 2; const XbcSrc xs = xbc_src(p, tok0);
    const int j = tid >> 2, cq = tid & 3; const bf16_t* row = xs.base + (size_t)j * xs.ld;
    r.x0 = *(const u32x4v*)(row + h * 64 + cq * 16); r.x1 = *(const u32x4v*)(row + h * 64 + cq * 16 + 8);
    r.b0 = *(const u32x4v*)(row + 512 + g * 64 + cq * 16); r.b1 = *(const u32x4v*)(row + 512 + g * 64 + cq * 16 + 8);
    r.c0 = *(const u32x4v*)(row + 640 + g * 64 + cq * 16); r.c1 = *(const u32x4v*)(row + 640 + g * 64 + cq * 16 + 8);
    const bf16_t* Hf = p.SS + (size_t)((tl * 8 + h) * 2 + 0) * 4096 + (tid >> 3) * 64 + (tid & 7) * 8;
    r.hf = *(const u32x4v*)Hf; r.hb = *(const u32x4v*)(Hf + 4096);
    r.sc = *((const f32x4v*)p.SSC + (size_t)(tl * 8 + h) * 128 + (tid & 127));
}
DI void ph_s3_ssd(const P& p, int l, LDSP unsigned char* lds) {
    const int tid = ltid(), lane = tid & 63, w = __builtin_amdgcn_readfirstlane(tid >> 6), G = lane >> 4, li = lane & 15, i = 16 * w + li;
    LDSP bf16_t* XH = (LDSP bf16_t*)lds; LDSP bf16_t* BG = XH + 128 * LD64; LDSP bf16_t* CG = BG + 128 * LD64; LDSP bf16_t* MM = CG + 128 * LD64; LDSP f32x4v* SC = (LDSP f32x4v*)(MM + 128 * LD128);
    LDSP bf16_t* HF = (LDSP bf16_t*)(SC + 128); LDSP bf16_t* HB = HF + 64 * LD64;
    const int ntl = l == 0 ? NTILE : NB * 32;
    int it = ssd_item(0, ntl); SsdPre pre;
    if (it >= 0) s3_ssd_load(p, s3_tile(l, it >> 3), it & 7, tid, i, G, pre);
    for (int k_ = 0; it >= 0; ++k_) {
        const int it_n = ssd_item(k_ + 1, ntl);
        const int tl = s3_tile(l, it >> 3), h = it & 7, tok0 = tile_tok0(tl);
        __syncthreads();
        { const int j = tid >> 2, cq = tid & 3;
          *(LDSP u32x4v*)(XH + j * LD64 + cq * 16) = pre.x0; *(LDSP u32x4v*)(XH + j * LD64 + cq * 16 + 8) = pre.x1;
          *(LDSP u32x4v*)(BG + j * LD64 + cq * 16) = pre.b0; *(LDSP u32x4v*)(BG + j * LD64 + cq * 16 + 8) = pre.b1;
          *(LDSP u32x4v*)(CG + j * LD64 + cq * 16) = pre.c0; *(LDSP u32x4v*)(CG + j * LD64 + cq * 16 + 8) = pre.c1;
          *(LDSP u32x4v*)(HF + (tid >> 3) * LD64 + (tid & 7) * 8) = pre.hf; *(LDSP u32x4v*)(HB + (tid >> 3) * LD64 + (tid & 7) * 8) = pre.hb;
          if (tid < 128) SC[tid] = pre.sc; }
        if (it_n >= 0) s3_ssd_load(p, s3_tile(l, it_n >> 3), it_n & 7, tid, i, G, pre);
        __syncthreads();
        u32x2v zr[4];
#pragma unroll
        for (int pt = 0; pt < 4; ++pt) zr[pt] = *(const u32x2v*)(p.PROJ + (size_t)(tok0 + i) * LDP + OFF_Z + h * 64 + 16 * pt + 4 * G);
        const f32x4v sci = SC[i];
        {
            f32x4v am[8];
#pragma unroll
            for (int ut = 0; ut < 8; ++ut) am[ut] = (f32x4v){0.f, 0.f, 0.f, 0.f};
#pragma unroll
            for (int ks = 0; ks < 2; ++ks) { const bf16x8v vfr = frag_row(CG, LD64, 16 * w, 32 * ks, lane);
#pragma unroll
                for (int ut = 0; ut < 8; ++ut) am[ut] = mfma16(frag_row(BG, LD64, 16 * ut, 32 * ks, lane), vfr, am[ut]); }
#pragma unroll
            for (int ut = 0; ut < 8; ++ut) { f32x4v m;
#pragma unroll
                for (int r = 0; r < 4; ++r) { const int jj = 16 * ut + 4 * G + r; const f32x4v scj = SC[jj];
                    const float Lf = jj <= i ? __builtin_amdgcn_exp2f(fminf(sci.x - scj.y, 30.f)) : 0.f, Lb = jj >= i ? __builtin_amdgcn_exp2f(fminf(sci.z - scj.w, 30.f)) : 0.f;
                    m[r] = am[ut][r] * (Lf + Lb); }
                *(LDSP u32x2v*)(MM + i * LD128 + 16 * ut + 4 * G) = pack4(m); }
        }
        asm volatile("s_waitcnt lgkmcnt(0)" ::: "memory");
        f32x4v ay[4], af_[4], ab_[4];
#pragma unroll
        for (int pt = 0; pt < 4; ++pt) { ay[pt] = (f32x4v){0.f, 0.f, 0.f, 0.f}; af_[pt] = ay[pt]; ab_[pt] = ay[pt]; }
#pragma unroll
        for (int ks = 0; ks < 2; ++ks) { const bf16x8v vfr = frag_row(CG, LD64, 16 * w, 32 * ks, lane);
#pragma unroll
            for (int pt = 0; pt < 4; ++pt) { af_[pt] = mfma16(frag_row(HF, LD64, 16 * pt, 32 * ks, lane), vfr, af_[pt]); ab_[pt] = mfma16(frag_row(HB, LD64, 16 * pt, 32 * ks, lane), vfr, ab_[pt]); } }
#pragma unroll
        for (int ks = 0; ks < 4; ++ks) { const bf16x8v vfr = frag_row(MM, LD128, 16 * w, 32 * ks, lane);
#pragma unroll
            for (int pt = 0; pt < 4; ++pt) ay[pt] = mfma16(frag_col(XH, LD64, 16 * pt, 32 * ks, lane), vfr, ay[pt]); }
        const float sf = __builtin_amdgcn_exp2f(sci.x), sb = __builtin_amdgcn_exp2f(sci.z), dsk = p.d_skip[l * 8 + h];
        float ssq = 0.f;
#pragma unroll
        for (int pt = 0; pt < 4; ++pt) { const int pc = 16 * pt + 4 * G;
            const u32x2v xr = *(LDSP const u32x2v*)(XH + i * LD64 + pc);
            const float xv[4] = {__uint_as_float(xr.x << 16), __uint_as_float(xr.x & 0xffff0000u), __uint_as_float(xr.y << 16), __uint_as_float(xr.y & 0xffff0000u)};
            const float zv[4] = {__uint_as_float(zr[pt].x << 16), __uint_as_float(zr[pt].x & 0xffff0000u), __uint_as_float(zr[pt].y << 16), __uint_as_float(zr[pt].y & 0xffff0000u)};
            float yv[4];
#pragma unroll
            for (int r = 0; r < 4; ++r) { yv[r] = (ay[pt][r] + sf * af_[pt][r] + sb * ab_[pt][r] + dsk * xv[r]) * siluf(zv[r]); ssq += yv[r] * yv[r]; }
            *(unsigned*)((unsigned char*)p.H + (size_t)(tok0 + i) * D + h * 64 + pc) = pg8::pk4_fp8((pg8::f32x4){yv[0], yv[1], yv[2], yv[3]} * 2.0f); }
        ssq += shx(ssq, 16, lane); ssq += shx(ssq, 32, lane);
        if (G == 0) p.SSQ[(size_t)(tok0 + i) * 8 + h] = ssq;
        it = it_n;
    }
}
DI int gla_item(int k, int nit) {
    const int G_ = gridDim.x, b = blockIdx.x;
    if (G_ != 256) { const int it = b + k * G_; return it < nit ? it : -1; }
    const int full = nit >> 8;
    if (k < full) return b + (k << 8);
    if (k > full || (b & 7) >= 4) return -1;
    const int idx = (b >> 3) * 4 + (b & 7);
    return idx < (nit & 255) ? (full << 8) + idx : -1;
}
struct GlaPre { u32x4v qv[2], kv[2], vv[4], sf[2], sb[2], gk; };
DI void s3_gla_load(const P& p, int l, int tl, int h, int tid, GlaPre& r) {
    const int tok0 = tile_tok0(tl);
    r.gk = mk4(0u, 0u, 0u, 0u); if (tid < 256) r.gk = *(const u32x4v*)((const char*)p.PROJ + (unsigned)(((tok0 + (tid >> 1)) * LDP + OFF_GK + (tid & 1) * 8) * 2));
#pragma unroll
    for (int q = 0; q < 2; ++q) { const int c = tid + q * NTHR, rr = c >> 3, cc = c & 7; const bf16_t* pr = p.PROJ + (size_t)(tok0 + rr) * LDP;
        r.qv[q] = *(const u32x4v*)(pr + OFF_Q + h * 64 + cc * 8); r.kv[q] = *(const u32x4v*)(pr + OFF_K + h * 64 + cc * 8);
        const bf16_t* Sg = p.GS + (size_t)((tl * 4 + h) * 2 + 0) * 8192 + (size_t)rr * 64 + cc * 8; r.sf[q] = *(const u32x4v*)Sg; r.sb[q] = *(const u32x4v*)(Sg + 8192); }
#pragma unroll
    for (int q = 0; q < 4; ++q) { const int c = tid + q * NTHR, rr = c >> 4, cc = c & 15; r.vv[q] = *(const u32x4v*)(p.PROJ + (size_t)(tok0 + rr) * LDP + OFF_V + h * 128 + cc * 8); }
}
DI void ph_s3_gla(const P& p, int l, LDSP unsigned char* lds) {
    const int tid = ltid(), lane = tid & 63, w = __builtin_amdgcn_readfirstlane(tid >> 6), G = lane >> 4, li = lane & 15, i = 16 * w + li;
    LDSP bf16_t* Q2 = (LDSP bf16_t*)lds;
    LDSP bf16_t* KF = Q2 + 8 * 2 * 16 * LD64; LDSP bf16_t* KB = KF + 128 * LD64; LDSP bf16_t* VT = KB + 128 * LD64; LDSP bf16_t* SF = VT + 128 * LD128; LDSP bf16_t* SB = SF + 128 * LD64;
    LDSP bf16_t* AMw = SF + w * 16 * LD128;
    const int nit = (l == 0 ? NTILE : NB * 32) * 4;
    int it = gla_item(0, nit); GlaPre pre;
    if (it >= 0) s3_gla_load(p, l, s3_tile(l, it >> 2), it & 3, tid, pre);
    for (int k_ = 0; it >= 0; ++k_) {
        const int it_n = gla_item(k_ + 1, nit);
        const int tl = s3_tile(l, it >> 2), h = it & 3, tok0 = tile_tok0(tl);
        __syncthreads();
        if (tid < 256) *(LDSP u32x4v*)(((tid & 1) ? KB : KF) + (tid >> 1) * LD64 + 64) = pre.gk;
        GateOp go;
        { const int kt_ = w & 3, dr_ = w >> 2; const float* up = (dr_ ? p.gk_up_b : p.gk_up_f) + l * 16 * 256 + (G & 1) * 8 * 256 + h * 64 + 16 * kt_ + li;
#pragma unroll
          for (int e = 0; e < 8; ++e) go.uw[e] = up[e * 256];
          go.bias = *(const f32x4v*)((dr_ ? p.gk_bias_b : p.gk_bias_f) + l * 256 + h * 64 + 16 * kt_ + 4 * G); }
#pragma unroll
        for (int q = 0; q < 2; ++q) { const int c = tid + q * NTHR, rr = c >> 3, cc = c & 7; LDSP bf16_t* qrow = Q2 + (rr >> 4) * (2 * 16 * LD64) + (rr & 15) * LD64 + cc * 8;
            *(LDSP u32x4v*)qrow = pre.qv[q]; *(LDSP u32x4v*)(qrow + 16 * LD64) = pre.qv[q];
            *(LDSP u32x4v*)(KF + rr * LD64 + cc * 8) = pre.kv[q]; *(LDSP u32x4v*)(KB + rr * LD64 + cc * 8) = pre.kv[q];
            *(LDSP u32x4v*)(SF + rr * LD64 + cc * 8) = pre.sf[q]; *(LDSP u32x4v*)(SB + rr * LD64 + cc * 8) = pre.sb[q]; }
#pragma unroll
        for (int q = 0; q < 4; ++q) { const int c = tid + q * NTHR, rr = c >> 4, cc = c & 15; *(LDSP u32x4v*)(VT + rr * LD128 + cc * 8) = pre.vv[q]; }
        if (it_n >= 0) s3_gla_load(p, l, s3_tile(l, it_n >> 2), it_n & 3, tid, pre);
        __syncthreads();
        f32x4v gsc[8];
        {
#pragma unroll
          for (int nt = 0; nt < 8; ++nt) go.gkf[nt] = *(LDSP const bf16x8v*)(((G & 1) ? KB : KF) + (16 * nt + li) * LD64 + 64);
          f32x4v tot_; gate_scan(go, gsc, tot_); }
        { const int kt_ = w & 3, dr_ = w >> 2; LDSP bf16_t* KS_ = dr_ ? KB : KF;
#pragma unroll
          for (int nt = 0; nt < 8; ++nt) { LDSP bf16_t* qa = Q2 + nt * (2 * 16 * LD64) + dr_ * 16 * LD64 + li * LD64 + 16 * kt_ + 4 * G; LDSP bf16_t* ka = KS_ + (16 * nt + li) * LD64 + 16 * kt_ + 4 * G;
              const u32x2v q2 = *(LDSP const u32x2v*)qa, k2 = *(LDSP const u32x2v*)ka;
              float eq[4], ek[4];
#pragma unroll
              for (int r = 0; r < 4; ++r) { eq[r] = __builtin_amdgcn_exp2f(gsc[nt][r] - 3.0f); ek[r] = __builtin_amdgcn_exp2f(-gsc[nt][r]); }
              *(LDSP u32x2v*)qa = mk2(pk2(__uint_as_float(q2.x << 16) * eq[0], __uint_as_float(q2.x & 0xffff0000u) * eq[1]), pk2(__uint_as_float(q2.y << 16) * eq[2], __uint_as_float(q2.y & 0xffff0000u) * eq[3]));
              *(LDSP u32x2v*)ka = mk2(pk2(__uint_as_float(k2.x << 16) * ek[0], __uint_as_float(k2.x & 0xffff0000u) * ek[1]), pk2(__uint_as_float(k2.y << 16) * ek[2], __uint_as_float(k2.y & 0xffff0000u) * ek[3])); } }
        __syncthreads();
        f32x4v ao[8];
#pragma unroll
        for (int q = 0; q < 8; ++q) ao[q] = (f32x4v){0.f, 0.f, 0.f, 0.f};
        bf16x8v qfr[2][2];
#pragma unroll
        for (int dir = 0; dir < 2; ++dir)
#pragma unroll
            for (int ks = 0; ks < 2; ++ks) qfr[dir][ks] = frag_row(Q2 + w * (2 * 16 * LD64) + dir * 16 * LD64, LD64, 0, 32 * ks, lane);
#pragma unroll
        for (int dir = 0; dir < 2; ++dir) {
            LDSP const bf16_t* SS_ = dir ? SB : SF;
#pragma unroll
            for (int ks = 0; ks < 2; ++ks) {
#pragma unroll
                for (int vt = 0; vt < 8; ++vt) ao[vt] = mfma16(frag_row(SS_, LD64, 16 * vt, 32 * ks, lane), qfr[dir][ks], ao[vt]); }
        }
        __syncthreads();
#pragma unroll
        for (int uh = 0; uh < 4; ++uh) {
            f32x4v a2[2]; a2[0] = (f32x4v){0.f, 0.f, 0.f, 0.f}; a2[1] = a2[0];
#pragma unroll
            for (int dir = 0; dir < 2; ++dir) {
                LDSP const bf16_t* KS = dir ? KB : KF;
                f32x4v as[2]; as[0] = (f32x4v){0.f, 0.f, 0.f, 0.f}; as[1] = as[0];
#pragma unroll
                for (int ks = 0; ks < 2; ++ks) {
#pragma unroll
                    for (int q = 0; q < 2; ++q) as[q] = mfma16(frag_row(KS, LD64, 16 * (2 * uh + q), 32 * ks, lane), qfr[dir][ks], as[q]); }
#pragma unroll
                for (int q = 0; q < 2; ++q)
#pragma unroll
                    for (int r = 0; r < 4; ++r) { const int jj = 16 * (2 * uh + q) + 4 * G + r; const bool keep = dir == 0 ? (jj <= i) : (jj >= i); a2[q][r] += keep ? as[q][r] : 0.f; }
            }
#pragma unroll
            for (int q = 0; q < 2; ++q) *(LDSP u32x2v*)(AMw + li * LD128 + 16 * (2 * uh + q) + 4 * G) = pack4(a2[q]);
        }
        u32x4v gq[4];
#pragma unroll
        for (int j = 0; j < 4; ++j) gq[j] = *(const u32x4v*)((const char*)p.PROJ + (unsigned)(((tok0 + 16 * w + 4 * j + G) * LDP + OFF_GO + h * 128 + li * 8) * 2));
        LDSP bf16_t* GW = Q2 + w * (2 * 16 * LD64);
        asm volatile("s_waitcnt lgkmcnt(0)" ::: "memory");
#pragma unroll
        for (int ks = 0; ks < 4; ++ks) { const bf16x8v vfr = frag_row(AMw, LD128, 0, 32 * ks, lane);
#pragma unroll
            for (int vt = 0; vt < 8; ++vt) ao[vt] = mfma16(frag_col(VT, LD128, 16 * vt, 32 * ks, lane), vfr, ao[vt]); }
#pragma unroll
        for (int j = 0; j < 4; ++j) *(LDSP u32x4v*)(GW + (4 * j + G) * LD128 + li * 8) = gq[j];
        float so = 0.f;
#pragma unroll
        for (int vt = 0; vt < 8; ++vt)
#pragma unroll
            for (int r = 0; r < 4; ++r) so += ao[vt][r] * ao[vt][r];
        so += shx(so, 16, lane); so += shx(so, 32, lane);
        const float ro = rsqrtf(so * (1.0f / 128.0f) + 1e-6f);
        LDSP unsigned char* OW = (LDSP unsigned char*)AMw;
#pragma unroll
        for (int vt = 0; vt < 8; ++vt) { const int vc = 16 * vt + 4 * G; const f32x4v gg = *(const f32x4v*)(p.gla_norm_g + l * 128 + vc);
            const u32x2v gr = *(LDSP const u32x2v*)(GW + li * LD128 + vc);
            const float g0 = __uint_as_float(gr.x << 16), g1 = __uint_as_float(gr.x & 0xffff0000u), g2 = __uint_as_float(gr.y << 16), g3 = __uint_as_float(gr.y & 0xffff0000u);
            *(LDSP unsigned*)(OW + li * 144 + vc) = pg8::pk4_fp8((pg8::f32x4){ao[vt][0] * gg.x * siluf(g0), ao[vt][1] * gg.y * siluf(g1), ao[vt][2] * gg.z * siluf(g2), ao[vt][3] * gg.w * siluf(g3)} * (8.0f * ro)); }
#pragma unroll
        for (int j = 0; j < 2; ++j) { const int rr = (lane >> 3) + 8 * j, pc = lane & 7;
            *(u32x4v*)((char*)p.H + (unsigned)((tok0 + 16 * w + rr) * D + 512 + h * 128 + pc * 16)) = *(LDSP const u32x4v*)(OW + rr * 144 + pc * 16); }
        it = it_n;
    }
}
DI void ph_s3(const P& p, int l, LDSP unsigned char* lds) {
    if (((int)blockIdx.x >> 5) & 1) { ph_s3_ssd(p, l, lds); ph_s3_gla(p, l, lds); }
    else { ph_s3_gla(p, l, lds); ph_s3_ssd(p, l, lds); }
}
struct RouteR { bool own; int t, e1, e2, r1, r2; };
template <int NR> DI void normroute_tile(const P& p, int tb, const float* MODl, LDSP int* lcnt, const float* g2, LDSP bf16_t* WR, LDSP bf16_t* HT, int lane, int G, int li, RouteR& R) {
    constexpr int LDW = 1032, LDT = 264;
        const float* mr = MODl + (size_t)tok_modrow(tb) * 6144;
        float rs[NR];
        { const f32x4v* q = (const f32x4v*)(p.XSS + (size_t)(tb + (li < NR ? li : 0)) * 16); const f32x4v a = q[0], b = q[1], c = q[2], d = q[3];
          const float ss = (((a.x + a.y) + (a.z + a.w)) + ((b.x + b.y) + (b.z + b.w))) + (((c.x + c.y) + (c.z + c.w)) + ((d.x + d.y) + (d.z + d.w)));
          const float r = rsqrtf(ss * (1.0f / D) + 1e-6f);
#pragma unroll
          for (int i = 0; i < NR; ++i) rs[i] = shl(r, i); }
        f32x4v acc[2]; acc[0] = (f32x4v){0.f, 0.f, 0.f, 0.f}; acc[1] = acc[0];
        u32x2v xq[NR];
#pragma unroll
        for (int i = 0; i < NR; ++i) xq[i] = *(const u32x2v*)(xrow(p, tb + i) + lane * 4);
#pragma unroll
        for (int kc = 0; kc < 4; ++kc) {
            const int kk = kc * 256 + lane * 4;
            const f32x4v gg = *(const f32x4v*)(g2 + kk), sh = *(const f32x4v*)(mr + 3 * 1024 + kk), sc = *(const f32x4v*)(mr + 4 * 1024 + kk);
            f32x4v gs;
#pragma unroll
            for (int j = 0; j < 4; ++j) gs[j] = gg[j] * (1.f + sc[j]);
#pragma unroll
            for (int i = 0; i < NR; ++i) { const u32x2v r = xq[i];
                const f32x4v xv = mkf4(__uint_as_float(r.x << 16), __uint_as_float(r.x & 0xffff0000u), __uint_as_float(r.y << 16), __uint_as_float(r.y & 0xffff0000u));
                const f32x4v h = xv * rs[i] * gs + sh; const u32x2v hb = pack4(h);
                *(unsigned*)((unsigned char*)p.H + (size_t)(tb + i) * D + kk) = pg8::pk4_fp8(h);
                *(LDSP u32x2v*)(HT + i * LDT + lane * 4) = hb; }
            if (kc < 3) {
#pragma unroll
                for (int i = 0; i < NR; ++i) xq[i] = *(const u32x2v*)(xrow(p, tb + i) + kk + 256); }
            asm volatile("s_waitcnt lgkmcnt(0)" ::: "memory");
#pragma unroll
            for (int ks = 0; ks < 8; ++ks) { const bf16x8v vfr = frag_row(HT, LDT, 0, 32 * ks, lane);
                acc[0] = mfma16(frag_row(WR, LDW, 0, kc * 256 + 32 * ks, lane), vfr, acc[0]);
                acc[1] = mfma16(frag_row(WR, LDW, 16, kc * 256 + 32 * ks, lane), vfr, acc[1]); }
            asm volatile("s_waitcnt lgkmcnt(0)" ::: "memory");
        }
        float bgs = -1e30f; int bgi = 0, e1 = 0, e2 = 0; float w1 = 0.f, w2 = 0.f;
#pragma unroll
        for (int ut = 0; ut < 2; ++ut) { const int gi = ut * 4 + G; float m1 = -1e30f, m2 = -1e30f, s1 = 0.f, s2 = 0.f; int i1 = 0, i2 = 0;
#pragma unroll
            for (int r = 0; r < 4; ++r) { const float sv = 1.0f / (1.0f + __expf(-acc[ut][r])), vv = sv + p.router_bias[gi * 4 + r];
                if (vv > m1) { m2 = m1; i2 = i1; s2 = s1; m1 = vv; i1 = gi * 4 + r; s1 = sv; } else if (vv > m2) { m2 = vv; i2 = gi * 4 + r; s2 = sv; } }
            if (m1 + m2 > bgs) { bgs = m1 + m2; bgi = gi; e1 = i1; e2 = i2; w1 = s1; w2 = s2; } }
#pragma unroll
        for (int o = 16; o <= 32; o <<= 1) {
            const float ogs = shx(bgs, o, lane), ow1 = shx(w1, o, lane), ow2 = shx(w2, o, lane); const int ogi = shxi(bgi, o, lane), oe1 = shxi(e1, o, lane), oe2 = shxi(e2, o, lane);
            if (ogs > bgs || (ogs == bgs && ogi < bgi)) { bgs = ogs; bgi = ogi; e1 = oe1; e2 = oe2; w1 = ow1; w2 = ow2; } }
        R.own = (G == 0 && li < NR); R.t = tb + li; R.e1 = e1; R.e2 = e2;
        if (R.own) { const float inv = 1.0f / (w1 + w2); p.EW[R.t * 2 + 0] = w1 * inv; p.EW[R.t * 2 + 1] = w2 * inv;
            R.r1 = __hip_atomic_fetch_add(&lcnt[e1], 1, __ATOMIC_RELAXED, __HIP_MEMORY_SCOPE_WORKGROUP); R.r2 = __hip_atomic_fetch_add(&lcnt[e2], 1, __ATOMIC_RELAXED, __HIP_MEMORY_SCOPE_WORKGROUP); }
}
DI void ph_normroute(const P& p, int l, int t0, LDSP unsigned char* lds) {
    const int tid_ = ltid(), lane = tid_ & 63, wv = tid_ >> 6, gw = blockIdx.x * NWV + wv, NW = gridDim.x * NWV, G = lane >> 4, li = lane & 15;
    const float* MODl = p.MOD + (size_t)l * 9 * 6144; int* counts = p.counts + l * 32 * 32;
    constexpr int LDW = 1032, LDT = 264;
    LDSP bf16_t* WR = (LDSP bf16_t*)lds;
    LDSP bf16_t* HT = WR + 32 * LDW + wv * 16 * LDT;
    { u32x4v wv_[8];
#pragma unroll
      for (int q = 0; q < 8; ++q) wv_[q] = *(const u32x4v*)(p.WRT + (size_t)(tid_ + q * NTHR) * 8);
#pragma unroll
      for (int q = 0; q < 8; ++q) { const int c = tid_ + q * NTHR; *(LDSP u32x4v*)(WR + (c >> 7) * LDW + (c & 127) * 8) = wv_[q]; } }
    __syncthreads();
    const float* g2 = p.norm2_g + l * D;
    const int ntok = T - t0, nfull = (ntok >> 4) / NW * NW, nrem = ntok - nfull * 16;
    LDSP int* lcnt = (LDSP int*)(WR + 32 * LDW + NWV * 16 * LDT);
    LDSP int* lbase = lcnt + 32;
    const int rf = (nfull + NW - 1) / NW, rr = (nrem + NW - 1) / NW;
    for (int rd = 0; rd < rf + rr; ++rd) {
        if (tid_ < 32) lcnt[tid_] = 0;
        __syncthreads();
        RouteR R; R.own = false; R.t = 0; R.e1 = 0; R.e2 = 0; R.r1 = 0; R.r2 = 0;
        if (rd < rf) { const int tile = rd * NW + gw; if (tile < nfull) normroute_tile<16>(p, t0 + tile * 16, MODl, lcnt, g2, WR, HT, lane, G, li, R); }
        else { const int e = (rd - rf) * NW + gw; if (e < nrem) normroute_tile<1>(p, t0 + nfull * 16 + e, MODl, lcnt, g2, WR, HT, lane, G, li, R); }
        __syncthreads();
        if (tid_ < 32) { const int c = lcnt[tid_]; lbase[tid_] = c > 0 ? atomicAdd(&counts[tid_ * 32], c) : 0; }
        __syncthreads();
        if (R.own) { const int r1 = lbase[R.e1] + R.r1, r2 = lbase[R.e2] + R.r2;
            p.MAP[(size_t)R.e1 * T + r1] = R.t; p.MAP[(size_t)R.e2 * T + r2] = R.t;
            *(int4*)(p.TOKSLOT + (size_t)R.t * 4) = make_int4(R.e1, r1, R.e2, r2); }
    }
}

DI void ph_combine(const P& p, int l, int t0, const unsigned char* Y  , LDSP int* ps  ) {
    const int tid_ = ltid(), lane = tid_ & 63, gw = blockIdx.x * NWV + __builtin_amdgcn_readfirstlane(tid_ >> 6)  , NW = gridDim.x * NWV;
    const float* MODl = p.MOD + (size_t)l * 9 * 6144; const int* counts = p.counts + l * 32 * 32;
    if (tid_ < 64) { const int cnt = tid_ < 32 ? counts[tid_ * 32] : 0; int pc = cnt;
#pragma unroll
        for (int o = 1; o < 32; o <<= 1) { const int src = lane >= o ? lane - o : lane; const int a = shli(pc, src); if (lane >= o) pc += a; }
        if (tid_ < 32) ps[tid_] = pc - cnt; }
    __syncthreads();
    for (int t = t0 + 4 * gw; t < T; t += 4 * NW) {
        int4 sl[4]; float4 ew[2];
#pragma unroll
        for (int u = 0; u < 4; ++u) sl[u] = *(const int4*)(p.TOKSLOT + (size_t)(t + u) * 4);
        ew[0] = *(const float4*)(p.EW + (size_t)t * 2); ew[1] = *(const float4*)(p.EW + (size_t)(t + 2) * 2);
        unsigned yr[4][2][4];
#pragma unroll
        for (int u = 0; u < 4; ++u) { const unsigned char* y0 = Y + (size_t)__builtin_amdgcn_readfirstlane(ps[sl[u].x] + sl[u].y) * D; const unsigned char* y1 = Y + (size_t)__builtin_amdgcn_readfirstlane(ps[sl[u].z] + sl[u].w) * D;
#pragma unroll
            for (int i = 0; i < 4; ++i) { yr[u][0][i] = *(const unsigned*)(y0 + (i * 64 + lane) * 4); yr[u][1][i] = *(const unsigned*)(y1 + (i * 64 + lane) * 4); } }
        const float* mrow = MODl + (size_t)tok_modrow(t) * 6144; const float* g5 = mrow + 5 * 1024;
        const float* mr1 = p.MOD + (size_t)9 * 6144 + (size_t)tok_modrow(t) * 6144;
#pragma unroll
        for (int pr = 0; pr < 2; ++pr) {
            const float wgt[2][2] = {{ew[pr].x, ew[pr].y}, {ew[pr].z, ew[pr].w}};
            u32x2v xr[2][4];
#pragma unroll
            for (int u = 0; u < 2; ++u)
#pragma unroll
                for (int i = 0; i < 4; ++i) xr[u][i] = *(const u32x2v*)(xrow(p, t + 2 * pr + u) + (i * 64 + lane) * 4);
            float4 v[2][4];
#pragma unroll
            for (int i = 0; i < 4; ++i) { const int c = (i * 64 + lane) * 4; const float4 gg = *(const float4*)(g5 + c);
#pragma unroll
                for (int u = 0; u < 2; ++u) { const u32x2v x = xr[u][i]; const int a = (int)yr[2 * pr + u][0][i], b = (int)yr[2 * pr + u][1][i]; const float w1 = wgt[u][0], w2 = wgt[u][1];
                    v[u][i].x = __uint_as_float(x.x << 16) + gg.x * (w1 * __builtin_amdgcn_cvt_f32_fp8(a, 0) + w2 * __builtin_amdgcn_cvt_f32_fp8(b, 0));
                    v[u][i].y = __uint_as_float(x.x & 0xffff0000u) + gg.y * (w1 * __builtin_amdgcn_cvt_f32_fp8(a, 1) + w2 * __builtin_amdgcn_cvt_f32_fp8(b, 1));
                    v[u][i].z = __uint_as_float(x.y << 16) + gg.z * (w1 * __builtin_amdgcn_cvt_f32_fp8(a, 2) + w2 * __builtin_amdgcn_cvt_f32_fp8(b, 2));
                    v[u][i].w = __uint_as_float(x.y & 0xffff0000u) + gg.w * (w1 * __builtin_amdgcn_cvt_f32_fp8(a, 3) + w2 * __builtin_amdgcn_cvt_f32_fp8(b, 3));
                    if (l == 0) *(u32x2v*)(xrow(p, t + 2 * pr + u) + c) = mk2(pk2(v[u][i].x, v[u][i].y), pk2(v[u][i].z, v[u][i].w)); } }
            float rstd[2];
#pragma unroll
            for (int u = 0; u < 2; ++u) { float ss = 0.f;
#pragma unroll
                for (int i = 0; i < 4; ++i) ss += v[u][i].x * v[u][i].x + v[u][i].y * v[u][i].y + v[u][i].z * v[u][i].z + v[u][i].w * v[u][i].w;
                rstd[u] = rsqrtf(wave_sum(ss, lane) * (1.0f / D) + 1e-6f); }
            if (l == 0) {
#pragma unroll
                for (int i = 0; i < 4; ++i) { const int c = (i * 64 + lane) * 4;
                    const float4 gg = *(const float4*)(p.norm1_g + D + c), sh = *(const float4*)(mr1 + c), sc = *(const float4*)(mr1 + 1024 + c);
#pragma unroll
                    for (int u = 0; u < 2; ++u) { const float r = rstd[u];
                        *(unsigned*)((unsigned char*)p.H + (size_t)(t + 2 * pr + u) * D + c) = pg8::pk4_fp8((pg8::f32x4){v[u][i].x * r * gg.x * (1.f + sc.x) + sh.x, v[u][i].y * r * gg.y * (1.f + sc.y) + sh.y, v[u][i].z * r * gg.z * (1.f + sc.z) + sh.z, v[u][i].w * r * gg.w * (1.f + sc.w) + sh.w}); } }
            } else {
#pragma unroll
                for (int u = 0; u < 2; ++u)
#pragma unroll
                    for (int i = 0; i < 4; ++i) { const float4 gg = ((const float4*)p.final_g)[i * 64 + lane]; const float r = rstd[u];
                        ((float4*)(p.out + (size_t)(t + 2 * pr + u - TC) * D))[i * 64 + lane] = make_float4(v[u][i].x * r * gg.x, v[u][i].y * r * gg.y, v[u][i].z * r * gg.z, v[u][i].w * r * gg.w); }
            }
        }
    }
}

#define XLAS __attribute__((address_space(3)))
#define XB_TMO      128
#define XB_XCNT(j)  (256  + 64 * (j))
#define XB_XSUB(j)  (1280 + 64 * (j))
#define XB_XGEN(j)  (2304 + 64 * (j))
#define XB_TOP      3328
#define XB_TOPGEN   3392
#define XCD_BAR_WORDS 3456
#define XB_SPIN_CAP (1u << 18)

__device__ __forceinline__ unsigned xb_ld(unsigned* p)              { return __hip_atomic_load(p, __ATOMIC_RELAXED, __HIP_MEMORY_SCOPE_AGENT); }
__device__ __forceinline__ unsigned xb_add(unsigned* p, unsigned v) { return __hip_atomic_fetch_add(p, v, __ATOMIC_RELAXED, __HIP_MEMORY_SCOPE_AGENT); }
__device__ __forceinline__ unsigned xb_xcc_id() { return (unsigned)__builtin_amdgcn_s_getreg((3 << 11) | 20) & 0xFu; }
#define XB_SPIN(cond, bar) do { unsigned _sp = 0; while (cond) { __builtin_amdgcn_s_sleep(1); \
    if ((++_sp & 255u) == 0u) { if (xb_ld(&(bar)[XB_TMO])) break; if (_sp > XB_SPIN_CAP) { atomicAdd(&(bar)[XB_TMO], 1u); break; } } } } while (0)

struct XcdBarrier {
    unsigned* bar; unsigned x;
    volatile XLAS unsigned* st;
};

__device__ __forceinline__ XcdBarrier xcd_barrier_post(unsigned* bar, volatile XLAS unsigned* st) {
    XcdBarrier b; b.bar = bar; b.x = xb_xcc_id(); b.st = st;
    if (ltid() == 0) (void)xb_add(&bar[XB_XCNT(b.x)], 1u);
    return b;
}
__device__ __forceinline__ void xcd_barrier_complete(unsigned* bar, unsigned x, unsigned& nloc, unsigned& nx) {
    const unsigned G = gridDim.x * gridDim.y * gridDim.z;
    unsigned sum, cnt, mine, sp = 0u;
    for (;;) {
        sum = 0u; cnt = 0u; mine = 0u;
#pragma unroll
        for (unsigned j = 0; j < 16; ++j) { const unsigned c = xb_ld(&bar[XB_XCNT(j)]); sum += c; cnt += (c > 0u) ? 1u : 0u; mine = (j == x) ? c : mine; }
        if (sum == G) break;
        __builtin_amdgcn_s_sleep(1);
        if ((++sp & 255u) == 0u) { if (xb_ld(&bar[XB_TMO])) break; if (sp > XB_SPIN_CAP) { atomicAdd(&bar[XB_TMO], 1u); break; } }
    }
    nloc = mine > 0u ? mine : 1u; nx = cnt > 0u ? cnt : 1u;
}

__device__ __forceinline__ void xcd_barrier(const XcdBarrier& b) {
    asm volatile("s_waitcnt vmcnt(0)" ::: "memory");
    __syncthreads();
    if (ltid() == 0) {
        unsigned* bar = b.bar;
        __builtin_amdgcn_s_waitcnt(0);
        unsigned nloc = b.st[0], nx = b.st[1];
        if (nloc == 0u) { xcd_barrier_complete(bar, b.x, nloc, nx); b.st[0] = nloc; b.st[1] = nx; }
        const unsigned old = xb_add(&bar[XB_XSUB(b.x)], 1u);
        const unsigned gen = old / nloc;
        if (old + 1u == (gen + 1u) * nloc) {
            __builtin_amdgcn_fence(__ATOMIC_RELEASE, "agent");
            asm volatile("s_waitcnt vmcnt(0)" ::: "memory");
            const unsigned og = xb_add(&bar[XB_TOP], 1u);
            const unsigned tg = og / nx;
            if (og + 1u == (tg + 1u) * nx) xb_add(&bar[XB_TOPGEN], 1u);
            else XB_SPIN(xb_ld(&bar[XB_TOPGEN]) == tg, bar);
            __builtin_amdgcn_fence(__ATOMIC_ACQUIRE, "agent");
            xb_add(&bar[XB_XGEN(b.x)], 1u);
            asm volatile("s_waitcnt vmcnt(0)" ::: "memory");
        } else {
            XB_SPIN(xb_ld(&bar[XB_XGEN(b.x)]) == gen, bar);
            __builtin_amdgcn_fence(__ATOMIC_ACQUIRE, "agent");
            asm volatile("s_waitcnt vmcnt(0)" ::: "memory");
        }
    }
    __syncthreads();
}

DI void moe_table(const P& p, int l, PG8_LAS int* tab) {
    const int tid_ = ltid();
    if (tid_ < 64) { const int cnt = tid_ < 32 ? p.counts[(l * 32 + tid_) * 32] : 0; const int nt = (cnt + 255) >> 8; int pt = nt, pc = cnt;
#pragma unroll
        for (int o = 1; o < 32; o <<= 1) { const int ln_ = tid_ & 63, src = ln_ >= o ? ln_ - o : ln_; const int a = shli(pt, src), b = shli(pc, src); if (ln_ >= o) { pt += a; pc += b; } }
        if (tid_ < 32) { tab[tid_ + 1] = pt; tab[33 + tid_] = cnt; tab[65 + tid_] = pc - cnt; if (tid_ == 0) tab[0] = 0; } }
    __syncthreads();
}
typedef const __attribute__((address_space(4))) P* PK;
DI PK lp(PK q) { asm volatile("" : "+s"(q)); return q; }
#define PHASE(...) do { const P p = *(const P*)lp(pk); __VA_ARGS__; } while (0)

#ifndef CV_L0
#define CV_L0 7
#endif
template <int l> DI void layer(PK pk, unsigned char* smem, const XcdBarrier& xbar) {
    float* ldsf = (float*)smem; const int gw = 0, NW = 0, lane = 0;
    {
        constexpr int NG = l == 0 ? 234 : 182;
        constexpr int CV1 = l == 0 ? CV_L0 * 768 : NE * 768;
        const int G = (int)gridDim.x == 256 ? NG : (int)gridDim.x;
        if ((int)blockIdx.x < G) PHASE({ pg8::Gemm g{p.H, (const bf16_t*)((const unsigned char*)p.WinT + (size_t)l * NPAD_IN * D), T, NPAD_IN, D / 2}; pg8::StaticOrder S; S.init(T, NPAD_IN, G, (int)blockIdx.x);
            pg8::EpiProj E{p.PROJ, LDP, INDIM, 1.0f / 64.0f};
            pg8::gemm_phase<pg8::EpiProj, pg8::StaticOrder, false, PG8_SP2, 1>((PG8_LAS unsigned char*)smem, g, S, E, nullptr); });
        else PHASE(ph_convert_experts(p, l, ldsf, G, (int)gridDim.x - G, 0, CV1));
        if ((int)gridDim.x != 256) PHASE(ph_convert_experts(p, l, ldsf, 0, (int)gridDim.x, 0, CV1));
    }
    xcd_barrier(xbar);
    PHASE(ph_prep(p, l, (LDSP unsigned char*)smem));
    xcd_barrier(xbar);
    PHASE(ph_s1(p, l, (LDSP unsigned char*)smem));
    xcd_barrier(xbar);
    PHASE(ph_s2(p));
    xcd_barrier(xbar);
    PHASE(ph_s3(p, l, (LDSP unsigned char*)smem));
    xcd_barrier(xbar);
    {
        constexpr int ro = l == 0 ? 0 : TC;
        constexpr int NG = l == 0 ? 182 : 256;
        const int G = (int)gridDim.x == 256 ? NG : (int)gridDim.x;
        if ((int)blockIdx.x < G) PHASE({ pg8::Gemm g{(const bf16_t*)((const unsigned char*)p.H + (size_t)ro * D), (const bf16_t*)((const unsigned char*)p.WoutT + (size_t)l * D * D), T - ro, D, D / 2}; pg8::StaticOrder S; S.init(T - ro, D, G, (int)blockIdx.x);
            pg8::EpiResGate<l != 0> E{p.SSQ, p.ctx, p.x, p.XB, p.MOD + (size_t)l * 9 * 6144 + 2 * 1024, p.XSS, ro};
            pg8::gemm_phase<pg8::EpiResGate<l != 0>, pg8::StaticOrder, false, PG8_SP2, 1>((PG8_LAS unsigned char*)smem, g, S, E, nullptr); });
        else if (l == 0) PHASE(ph_convert_experts(p, l, ldsf, G, (int)gridDim.x - G, CV_L0 * 768, NE * 768));
        if (l == 0 && (int)gridDim.x != 256) PHASE(ph_convert_experts(p, l, ldsf, 0, (int)gridDim.x, CV_L0 * 768, NE * 768));
    }
    xcd_barrier(xbar);
    const int t0 = l == 0 ? 0 : TC;
    PHASE(ph_normroute(p, l, t0, (LDSP unsigned char*)smem));
    xcd_barrier(xbar);
    PG8_LAS int* tab = (PG8_LAS int*)((PG8_LAS unsigned char*)smem + pg8::STAGE_BYTES);
#pragma unroll
    for (int ph = 0; ph < 2; ++ph) {
        PHASE(moe_table(p, l, tab));
        const int U = __builtin_amdgcn_readfirstlane(tab[32]) * 4;
        if (ph == 0) PHASE({ pg8::Gemm g{p.H, p.WguT, T, D, D / 2}; pg8::MoeSched S{tab, p.MAP, U, (int)gridDim.x, (int)blockIdx.x, 4, 1, (size_t)D * D};
            pg8::EpiAct E{(unsigned char*)p.SS}; pg8::gemm_phase_moe<pg8::EpiAct, pg8::MoeSched, false, PG8_SP2, 1>((PG8_LAS unsigned char*)smem, g, S, E, nullptr); });
        else PHASE({ pg8::Gemm g{p.SS, p.WdT, T, D, 256}; pg8::MoeSched S{tab, p.MAP, U, (int)gridDim.x, (int)blockIdx.x, 4, 0, (size_t)D * 512};
            pg8::EpiY E{(unsigned char*)p.PROJ}; pg8::gemm_phase_moe<pg8::EpiY, pg8::MoeSched, false, PG8_SP2, 1>((PG8_LAS unsigned char*)smem, g, S, E, nullptr); });
        xcd_barrier(xbar);
    }
    PHASE(ph_combine(p, l, t0, (const unsigned char*)p.PROJ, (LDSP int*)smem));
    xcd_barrier(xbar);
}

__global__ void __launch_bounds__(NTHR) mega(P p_arg) {
    extern __shared__ __attribute__((aligned(16))) unsigned char smem[];
    cg::grid_group grid = cg::this_grid();
    PK pk = (PK)__builtin_amdgcn_kernarg_segment_ptr();
    const int lane = 0, gw = 0, NW = 0;
    float* ldsf = (float*)smem;
    volatile XLAS unsigned* bst = (volatile XLAS unsigned*)((XLAS unsigned char*)smem + LDS_BYTES - 16);
    { const int t_ = ltid(); if (t_ < 2) bst[t_] = 0u; }
    __syncthreads();
    const XcdBarrier xbar = xcd_barrier_post(pk->BAR, bst);
    PHASE(ph_init(p)); PHASE(ph_mod(p, ldsf)); PHASE(ph_convert_small(p, ldsf, gw, NW, lane));
    if (__builtin_expect(pk->BAR == nullptr, 0)) grid.sync();
    xcd_barrier(xbar);
    PHASE(ph_normmod1(p, 0, gw, NW, lane));
    xcd_barrier(xbar);
    layer<0>(pk, smem, xbar);
    layer<1>(pk, smem, xbar);
}

static inline size_t al(size_t x) { return (x + 255) & ~(size_t)255; }

extern "C" void kernel_launch(void* const* d_in, const int* in_sizes, int n_in, void* d_out, int out_size, void* d_ws, size_t ws_size, hipStream_t stream) {
    static int grid_blocks = 0;
    if (grid_blocks == 0) {
        int dev = 0, cus = 0, per_cu = 0;
        if (hipFuncSetAttribute((const void*)mega, hipFuncAttributeMaxDynamicSharedMemorySize, LDS_BYTES) != hipSuccess) { fprintf(stderr, "hipFuncSetAttribute failed\n"); grid_blocks = -1; return; }
        (void)hipGetDevice(&dev); (void)hipDeviceGetAttribute(&cus, hipDeviceAttributeMultiprocessorCount, dev);
        if (hipOccupancyMaxActiveBlocksPerMultiprocessor(&per_cu, (const void*)mega, NTHR, LDS_BYTES) != hipSuccess || per_cu < 1) { fprintf(stderr, "occupancy query: %d blocks/CU\n", per_cu); grid_blocks = -1; return; }
        grid_blocks = cus;
    }
    if (grid_blocks < 0) return;
    P p{};
    const float** pin = (const float**)&p;
    for (int i = 0; i < 29; ++i) pin[i] = (const float*)d_in[i];
    p.out = (float*)d_out;
    char* ws = (char*)d_ws; size_t off = 0;
    auto take = [&](size_t bytes) { char* q = ws + off; off += al(bytes); return q; };
    p.XB = (bf16_t*)take((size_t)T * D * 2);
    p.H = (bf16_t*)take((size_t)T * D * 2);
    p.PROJ = (bf16_t*)take((size_t)T * LDP * 2);
    p.SS = (bf16_t*)take((size_t)NTILE * 8 * 2 * 4096 * 2);
    p.GS = (bf16_t*)take((size_t)NTILE * 4 * 2 * 8192 * 2);
    p.SDEC = (float*)take((size_t)NTILE * 8 * 2 * 4);
    p.GDEC = (float*)take((size_t)NTILE * 4 * 2 * 64 * 4);
    p.MOD = (float*)take((size_t)2 * 9 * 6144 * 4);
    p.counts = (int*)take(64 * 32 * 4);
    p.TOKSLOT = (int*)take((size_t)T * 4 * 4);
    p.EW = (float*)take((size_t)T * 2 * 4);
    p.MAP = (int*)take((size_t)NE * T * 4);
    p.WinT = (bf16_t*)take((size_t)2 * NPAD_IN * D * 2);
    p.WoutT = (bf16_t*)take((size_t)2 * D * D * 2);
    p.WguT = (bf16_t*)take((size_t)NE * D * D * 2);
    p.WdT = (bf16_t*)take((size_t)NE * D * 512 * 2);
    p.WRT = (bf16_t*)take((size_t)32 * 1024 * 2);
    p.BAR = (unsigned*)take(XCD_BAR_WORDS * 4);
    p.XBCC = (bf16_t*)d_out;
    p.QKB = (bf16_t*)d_out + (size_t)T * 768;
    p.SSC = (float*)take((size_t)T * 8 * 4 * 4);
    p.STOT = (float*)take((size_t)NTILE * 8 * 2 * 4);
    p.SSQ = (float*)take((size_t)T * 8 * 4);
    p.XSS = (float*)take((size_t)T * 16 * 4);
    if (off > ws_size) { fprintf(stderr, "workspace too small: need %zu have %zu\n", off, ws_size); return; }
    if (hipMemsetAsync(p.BAR, 0, XCD_BAR_WORDS * 4, stream) != hipSuccess) { fprintf(stderr, "memset of barrier words failed\n"); return; }
    void* args[] = {&p};
    hipError_t e = hipLaunchCooperativeKernel((void*)mega, dim3(grid_blocks), dim3(NTHR), args, LDS_BYTES, stream);
    if (e != hipSuccess) fprintf(stderr, "cooperative launch failed: %s (grid %d)\n", hipGetErrorString(e), grid_blocks);
}
```
